# Optimizing an MI355X kernel written in HIP

```python
import math, functools
import jax, jax.numpy as jnp
from jax import lax
import numpy as np

D_MODEL = 1024
BATCH = 16
SEQ = 2048
DEPTH = 2

CHUNK = 64
Q_BLOCK = 128
EPS = 1e-6
MAX_START = 4096

MLA_HEADS = 4
MLA_Q_LORA = 384
MLA_KV_LORA = 256
MLA_NOPE = 128
MLA_ROPE = 64
MLA_V = 128
ROPE_THETA = 10000.0

RWKV_HEADS = 8
RWKV_HEAD = 64
RWKV_WIDTH = RWKV_HEADS * RWKV_HEAD
RWKV_DECAY_LORA = 64
RWKV_A_LORA = 64
RWKV_GATE_LORA = 160
RWKV_GN_EPS = 64e-5

GDN_HEADS = 4
GDN_HEAD = 128
GDN_WIDTH = GDN_HEADS * GDN_HEAD
CONV_K = 4

SSD_HEADS = 8
SSD_HEAD = 64
SSD_WIDTH = SSD_HEADS * SSD_HEAD
SSD_GROUPS = 2
SSD_STATE = 128
SSD_CONV_DIM = SSD_WIDTH + 2 * SSD_GROUPS * SSD_STATE
DT_MIN = 0.001
DT_MAX = 0.1

N_BRANCH = 4
BRANCH_WIDTH = 512

FF_DENSE = 2816
N_EXPERTS = 8
TOP_K = 2
FF_EXPERT = 3584
MOE_BLOCK = 512

MLA_COLS = MLA_Q_LORA + MLA_KV_LORA + MLA_ROPE
RWKV_COLS = 3 * RWKV_WIDTH + RWKV_DECAY_LORA + RWKV_A_LORA + RWKV_GATE_LORA
GDN_COLS = 4 * GDN_WIDTH + 2 * GDN_HEADS
SSD_COLS = SSD_WIDTH + SSD_CONV_DIM + SSD_HEADS
GATE_COLS = N_BRANCH * D_MODEL
OFF_RWKV = MLA_COLS
OFF_GDN = OFF_RWKV + RWKV_COLS
OFF_SSD = OFF_GDN + GDN_COLS
OFF_GATE = OFF_SSD + SSD_COLS
IN_COLS = OFF_GATE + GATE_COLS

kernel_name = "hybrid_mla_rwkv7_gdn_ssd_moe_trunk"


def rms_norm(x, g, eps=EPS):
    xf = x.astype(jnp.float32)
    y = xf * lax.rsqrt(jnp.mean(xf * xf, axis=-1, keepdims=True) + eps)
    return (y * g.astype(jnp.float32)).astype(x.dtype)


def rope(x, positions):
    half = x.shape[-1] // 2
    inv_freq = ROPE_THETA ** (-jnp.arange(half, dtype=jnp.float32) / half)
    ang = positions.astype(jnp.float32)[..., None] * inv_freq
    ang = ang.reshape(ang.shape[:2] + (1,) * (x.ndim - 3) + (half,))
    cos, sin = jnp.cos(ang), jnp.sin(ang)
    x1 = x[..., :half].astype(jnp.float32)
    x2 = x[..., half:].astype(jnp.float32)
    return jnp.concatenate([x1 * cos - x2 * sin, x2 * cos + x1 * sin], axis=-1).astype(x.dtype)


def causal_dwconv(x, w):
    k, c = w.shape
    return lax.conv_general_dilated(
        x, w.astype(x.dtype)[:, None, :], window_strides=(1,), padding=[(k - 1, 0)],
        dimension_numbers=("NWC", "WIO", "NWC"), feature_group_count=c)


def segsum_exp(a):
    cs = jnp.cumsum(a, axis=-1)
    t = a.shape[-1]
    mask = jnp.tril(jnp.ones((t, t), bool))
    return jnp.exp(jnp.where(mask, cs[..., :, None] - cs[..., None, :], -jnp.inf))


def l2norm(x):
    return x * lax.rsqrt(jnp.sum(x * x, axis=-1, keepdims=True) + EPS)


def mla_attention(p, positions, q_norm, kv_norm, w_uq, w_ukv):
    B, S, _ = p.shape
    H = MLA_HEADS
    c_q = p[..., :MLA_Q_LORA]
    c_kv = p[..., MLA_Q_LORA:MLA_Q_LORA + MLA_KV_LORA]
    k_rope = rope(p[..., MLA_Q_LORA + MLA_KV_LORA:], positions)
    q = (rms_norm(c_q, q_norm) @ w_uq).reshape(B, S, H, MLA_NOPE + MLA_ROPE)
    q_nope, q_rope = q[..., :MLA_NOPE], rope(q[..., MLA_NOPE:], positions)
    kv = (rms_norm(c_kv, kv_norm) @ w_ukv).reshape(B, S, H, MLA_NOPE + MLA_V)
    k_nope, v = kv[..., :MLA_NOPE], kv[..., MLA_NOPE:]
    scale = (MLA_NOPE + MLA_ROPE) ** -0.5
    chunk_id = jnp.arange(S) // CHUNK
    outs = []
    for blk in range(S // Q_BLOCK):
        q0, q1 = blk * Q_BLOCK, (blk + 1) * Q_BLOCK
        s = (jnp.einsum("bqhd,bkhd->bhqk", q_nope[:, q0:q1], k_nope[:, :q1])
             + jnp.einsum("bqhr,bkr->bhqk", q_rope[:, q0:q1], k_rope[:, :q1]))
        s = s.astype(jnp.float32) * scale
        allowed = chunk_id[None, :q1] <= chunk_id[q0:q1, None]
        prob = jax.nn.softmax(jnp.where(allowed, s, -jnp.inf), axis=-1).astype(v.dtype)
        outs.append(jnp.einsum("bhqk,bkhd->bqhd", prob, v[:, :q1]))
    return jnp.concatenate(outs, axis=1).reshape(B, S, H * MLA_V)


def rwkv7_time_mix(p, mu, w0, w2, a0, a2, g2, k_k, k_a, r_k, ln_w, ln_b):
    B, S, _ = p.shape
    H, N = RWKV_HEADS, RWKV_HEAD
    f32 = jnp.float32
    prev = jnp.pad(p, ((0, 0), (1, 0), (0, 0)))[:, :-1]
    p = p + (prev - p) * mu
    o1, o2, o3 = RWKV_WIDTH, 2 * RWKV_WIDTH, 3 * RWKV_WIDTH
    o4 = o3 + RWKV_DECAY_LORA
    o5 = o4 + RWKV_A_LORA
    r, k, v = p[..., :o1], p[..., o1:o2], p[..., o2:o3]
    xw, xa, xg = p[..., o3:o4], p[..., o4:o5], p[..., o5:]
    w = -jax.nn.softplus(-(w0 + jnp.tanh(xw) @ w2).astype(f32)) - 0.5
    decay = jnp.exp(-jnp.exp(w))
    a = jax.nn.sigmoid((a0 + xa @ a2).astype(f32))
    g = (jax.nn.sigmoid(xg) @ g2).astype(f32)
    k = k.astype(f32)
    heads = lambda t: t.astype(f32).reshape(B, S, H, N)
    kk = l2norm(heads(k * k_k))
    k_mod = heads(k * (1.0 + (a - 1.0) * k_a))
    r_h, v_h, a_h = heads(r), heads(v), heads(a)
    xs = tuple(jnp.moveaxis(t, 1, 0) for t in (r_h, heads(decay), k_mod, v_h, kk, kk * a_h))

    def step(state, inp):
        r_t, w_t, k_t, v_t, kk_t, kka_t = inp
        sa = jnp.einsum("bhij,bhj->bhi", state, kk_t)
        state = (state * w_t[:, :, None, :] - sa[..., None] * kka_t[:, :, None, :]
                 + v_t[..., None] * k_t[:, :, None, :])
        return state, jnp.einsum("bhij,bhj->bhi", state, r_t)

    _, o = lax.scan(step, jnp.zeros((B, H, N, N), f32), xs)
    o = jnp.moveaxis(o, 0, 1)
    mean = jnp.mean(o, axis=-1, keepdims=True)
    var = jnp.mean(jnp.square(o - mean), axis=-1, keepdims=True)
    o = ((o - mean) * lax.rsqrt(var + RWKV_GN_EPS)).reshape(B, S, RWKV_WIDTH) * ln_w + ln_b
    bonus = jnp.sum(r_h * k_mod * r_k, axis=-1, keepdims=True) * v_h
    o = o + bonus.reshape(B, S, RWKV_WIDTH)
    return (o * g).astype(p.dtype)


def chunk_gated_delta_rule(q, k, v, beta, g):
    B, S, H, Dk = q.shape
    Dv = v.shape[-1]
    nc = S // CHUNK

    def blocks(t):
        return jnp.moveaxis(t.reshape((B, nc, CHUNK, H) + t.shape[3:]), 3, 1)

    q, k, v, beta, g = map(blocks, (q, k, v, beta, g))
    g_cum = jnp.cumsum(g, axis=-1)
    decay = segsum_exp(g)
    kb = k * beta[..., None]
    strict = jnp.tril(jnp.ones((CHUNK, CHUNK), bool), -1)
    lower = jnp.where(strict, jnp.einsum("bhnid,bhnjd->bhnij", kb, k) * decay, 0.0)
    solve = functools.partial(lax.linalg.triangular_solve, left_side=True, lower=True,
                              unit_diagonal=True)
    u = solve(lower, v * beta[..., None])
    w = solve(lower, kb * jnp.exp(g_cum)[..., None])
    qk = jnp.einsum("bhnid,bhnjd->bhnij", q, k) * decay
    g_last = g_cum[..., -1]
    k_tail = k * jnp.exp(g_last[..., None] - g_cum)[..., None]
    q_head = q * jnp.exp(g_cum)[..., None]
    xs = tuple(jnp.moveaxis(t, 2, 0) for t in (q_head, k_tail, u, w, qk, g_last))

    def step(state, inp):
        qh, kt, uc, wc, qkc, gl = inp
        v_new = uc - jnp.einsum("bhck,bhkv->bhcv", wc, state)
        o = jnp.einsum("bhck,bhkv->bhcv", qh, state) + jnp.einsum("bhij,bhjv->bhiv", qkc, v_new)
        state = state * jnp.exp(gl)[..., None, None] + jnp.einsum("bhck,bhcv->bhkv", kt, v_new)
        return state, o

    _, o = lax.scan(step, jnp.zeros((B, H, Dk, Dv), q.dtype), xs)
    return jnp.transpose(o, (1, 0, 3, 2, 4)).reshape(B, S, H, Dv)


def gated_deltanet(p, conv_w, a_log, dt_bias, norm_w):
    B, S, _ = p.shape
    H, Dh, W = GDN_HEADS, GDN_HEAD, GDN_WIDTH
    f32 = jnp.float32
    qkv = jax.nn.silu(causal_dwconv(p[..., :3 * W], conv_w)).astype(f32)
    b_p = p[..., 3 * W:3 * W + H].astype(f32)
    a_p = p[..., 3 * W + H:3 * W + 2 * H].astype(f32)
    z = p[..., 3 * W + 2 * H:].astype(f32).reshape(B, S, H, Dh)
    q = l2norm(qkv[..., :W].reshape(B, S, H, Dh)) * Dh ** -0.5
    k = l2norm(qkv[..., W:2 * W].reshape(B, S, H, Dh))
    v = qkv[..., 2 * W:].reshape(B, S, H, Dh)
    beta = jax.nn.sigmoid(b_p)
    g = -jnp.exp(a_log.astype(f32)) * jax.nn.softplus(a_p + dt_bias.astype(f32))
    o = chunk_gated_delta_rule(q, k, v, beta, g)
    o = rms_norm(o, norm_w) * jax.nn.silu(z)
    return o.reshape(B, S, W).astype(p.dtype)


def mamba2_ssd(p, conv_w, conv_b, dt_bias, a_log, d_skip, norm_w):
    B, S, _ = p.shape
    W, G, N, P, C = SSD_WIDTH, SSD_GROUPS, SSD_STATE, SSD_HEAD, CHUNK
    HG = SSD_HEADS // G
    nc = S // C
    f32 = jnp.float32
    z = p[..., :W].astype(f32)
    xbc = jax.nn.silu(causal_dwconv(p[..., W:W + SSD_CONV_DIM], conv_w) + conv_b).astype(f32)
    dt_p = p[..., W + SSD_CONV_DIM:].astype(f32)
    x = xbc[..., :W].reshape(B, nc, C, G, HG, P)
    Bm = xbc[..., W:W + G * N].reshape(B, nc, C, G, N)
    Cm = xbc[..., W + G * N:].reshape(B, nc, C, G, N)
    dt = jax.nn.softplus(dt_p + dt_bias.astype(f32)).reshape(B, nc, C, G, HG)
    A = -jnp.exp(a_log.astype(f32)).reshape(G, HG)
    a = jnp.transpose(dt * A, (0, 3, 4, 1, 2))
    a_cum = jnp.cumsum(a, axis=-1)
    xdt = x * dt[..., None]
    cb = jnp.einsum("bclgn,bcsgn->bgcls", Cm, Bm)
    y_diag = jnp.einsum("bgcls,bghcls,bcsghp->bclghp", cb, segsum_exp(a), xdt)
    decay_states = jnp.exp(a_cum[..., -1:] - a_cum)
    states = jnp.einsum("bclgn,bghcl,bclghp->bcghpn", Bm, decay_states, xdt)
    states = jnp.concatenate([jnp.zeros_like(states[:, :1]), states], axis=1)
    chunk_decay = jnp.pad(a_cum[..., -1], ((0, 0), (0, 0), (0, 0), (1, 0)))
    new_states = jnp.einsum("bghzc,bcghpn->bzghpn", segsum_exp(chunk_decay), states)
    y_off = jnp.einsum("bclgn,bcghpn,bghcl->bclghp", Cm, new_states[:, :-1], jnp.exp(a_cum))
    y = y_diag + y_off + d_skip.astype(f32).reshape(G, HG)[..., None] * x
    y = y.reshape(B, S, W) * jax.nn.silu(z)
    y = rms_norm(y.reshape(B, S, G, W // G), norm_w.reshape(G, W // G))
    return y.reshape(B, S, W).astype(p.dtype)


def swiglu(h, w_gu, w_down):
    g, u = jnp.split(h @ w_gu, 2, axis=-1)
    return (jax.nn.silu(g) * u) @ w_down


def moe_swiglu(h, router, w_gu, w_down):
    B, S, D = h.shape
    T = B * S
    A = T * TOP_K
    n_blk = -(-(A + N_EXPERTS * (MOE_BLOCK - 1)) // MOE_BLOCK)
    n_slot = n_blk * MOE_BLOCK
    hf = h.reshape(T, D)
    logits = (hf @ router).astype(jnp.float32)
    top_logit, top_idx = lax.top_k(logits, TOP_K)
    top_w = jax.nn.softmax(top_logit, axis=-1)
    flat_e = top_idx.reshape(A)
    flat_tok = jnp.repeat(jnp.arange(T, dtype=jnp.int32), TOP_K)
    flat_w = top_w.reshape(A)
    order = jnp.argsort(flat_e)
    e_sorted = flat_e[order]
    counts = jnp.bincount(flat_e, length=N_EXPERTS)
    padded = (counts + MOE_BLOCK - 1) // MOE_BLOCK * MOE_BLOCK
    start = jnp.cumsum(counts) - counts
    pad_end = jnp.cumsum(padded)
    pad_start = pad_end - padded
    dest = pad_start[e_sorted] + jnp.arange(A, dtype=jnp.int32) - start[e_sorted]
    slot_tok = jnp.zeros((n_slot,), jnp.int32).at[dest].set(flat_tok[order])
    slot_w = jnp.zeros((n_slot,), jnp.float32).at[dest].set(flat_w[order])
    blk_e = jnp.minimum(jnp.searchsorted(pad_end, jnp.arange(n_blk, dtype=jnp.int32) * MOE_BLOCK,
                                         side="right"), N_EXPERTS - 1)
    xb = hf[slot_tok].reshape(n_blk, MOE_BLOCK, D)

    def expert_block(args):
        xi, e = args
        g, u = jnp.split(xi @ w_gu[e], 2, axis=-1)
        return (jax.nn.silu(g) * u) @ w_down[e]

    yb = lax.map(expert_block, (xb, blk_e)).reshape(n_slot, D)
    out = jnp.zeros((T, D), jnp.float32).at[slot_tok].add(yb.astype(jnp.float32) * slot_w[:, None])
    return out.astype(h.dtype).reshape(B, S, D)


def setup_inputs(seed: int = 0) -> dict:
    key = jax.random.key(seed)
    keys = iter(jax.random.split(key, 48))
    f32 = jnp.float32

    def normal(shape, scale):
        return scale * jax.random.normal(next(keys), shape, f32)

    def gain(shape):
        return 1.0 + 0.02 * jax.random.normal(next(keys), shape, f32)

    def uniform(shape, lo, hi):
        return jax.random.uniform(next(keys), shape, f32, lo, hi)

    def dt_bias(shape):
        dt = jnp.exp(uniform(shape, math.log(DT_MIN), math.log(DT_MAX)))
        return dt + jnp.log(-jnp.expm1(-dt))

    L, nd, nm = DEPTH, (DEPTH + 1) // 2, DEPTH // 2
    start = jax.random.randint(next(keys), (BATCH, 1), 0, MAX_START, dtype=jnp.int32)
    return {
        "x": normal((BATCH, SEQ, D_MODEL), 1.0),
        "positions": start + jnp.arange(SEQ, dtype=jnp.int32)[None, :],
        "norm_mix": gain((L, D_MODEL)),
        "w_in": normal((L, D_MODEL, IN_COLS), D_MODEL ** -0.5),
        "mla_q_norm": gain((L, MLA_Q_LORA)),
        "mla_kv_norm": gain((L, MLA_KV_LORA)),
        "mla_w_uq": normal((L, MLA_Q_LORA, MLA_HEADS * (MLA_NOPE + MLA_ROPE)), MLA_Q_LORA ** -0.5),
        "mla_w_ukv": normal((L, MLA_KV_LORA, MLA_HEADS * (MLA_NOPE + MLA_V)), MLA_KV_LORA ** -0.5),
        "rwkv_mu": uniform((L, RWKV_COLS), 0.0, 1.0),
        "rwkv_w0": uniform((L, RWKV_WIDTH), -3.0, 0.0),
        "rwkv_w2": normal((L, RWKV_DECAY_LORA, RWKV_WIDTH), 0.1),
        "rwkv_a0": normal((L, RWKV_WIDTH), 0.1),
        "rwkv_a2": normal((L, RWKV_A_LORA, RWKV_WIDTH), 0.1),
        "rwkv_g2": normal((L, RWKV_GATE_LORA, RWKV_WIDTH), RWKV_GATE_LORA ** -0.5),
        "rwkv_k_k": 0.85 + normal((L, RWKV_WIDTH), 0.05),
        "rwkv_k_a": 1.0 + normal((L, RWKV_WIDTH), 0.05),
        "rwkv_r_k": normal((L, RWKV_HEADS, RWKV_HEAD), 0.1),
        "rwkv_ln_w": gain((L, RWKV_WIDTH)),
        "rwkv_ln_b": normal((L, RWKV_WIDTH), 0.02),
        "gdn_conv": normal((L, CONV_K, 3 * GDN_WIDTH), CONV_K ** -0.5),
        "gdn_a_log": jnp.log(uniform((L, GDN_HEADS), 1.0, 16.0)),
        "gdn_dt_bias": dt_bias((L, GDN_HEADS)),
        "gdn_norm": gain((L, GDN_HEAD)),
        "ssd_conv_w": normal((L, CONV_K, SSD_CONV_DIM), CONV_K ** -0.5),
        "ssd_conv_b": normal((L, SSD_CONV_DIM), 0.02),
        "ssd_dt_bias": dt_bias((L, SSD_HEADS)),
        "ssd_a_log": jnp.log(uniform((L, SSD_HEADS), 1.0, 16.0)),
        "ssd_d": gain((L, SSD_HEADS)),
        "ssd_norm": gain((L, SSD_WIDTH)),
        "gate_b": normal((L, N_BRANCH, D_MODEL), 0.02),
        "w_branch": normal((L, N_BRANCH, BRANCH_WIDTH, D_MODEL), BRANCH_WIDTH ** -0.5),
        "w_out": normal((L, D_MODEL, D_MODEL), D_MODEL ** -0.5),
        "norm_ffn": gain((L, D_MODEL)),
        "ffn_w_gu": normal((nd, D_MODEL, 2 * FF_DENSE), D_MODEL ** -0.5),
        "ffn_w_down": normal((nd, FF_DENSE, D_MODEL), FF_DENSE ** -0.5),
        "moe_router": normal((nm, D_MODEL, N_EXPERTS), D_MODEL ** -0.5),
        "moe_w_gu": normal((nm, N_EXPERTS, D_MODEL, 2 * FF_EXPERT), D_MODEL ** -0.5),
        "moe_w_down": normal((nm, N_EXPERTS, FF_EXPERT, D_MODEL), FF_EXPERT ** -0.5),
        "norm_final": gain((D_MODEL,)),
    }


def reference(x, positions, norm_mix, w_in, mla_q_norm, mla_kv_norm, mla_w_uq, mla_w_ukv,
              rwkv_mu, rwkv_w0, rwkv_w2, rwkv_a0, rwkv_a2, rwkv_g2, rwkv_k_k, rwkv_k_a, rwkv_r_k,
              rwkv_ln_w, rwkv_ln_b, gdn_conv, gdn_a_log, gdn_dt_bias, gdn_norm,
              ssd_conv_w, ssd_conv_b, ssd_dt_bias, ssd_a_log, ssd_d, ssd_norm,
              gate_b, w_branch, w_out, norm_ffn, ffn_w_gu, ffn_w_down,
              moe_router, moe_w_gu, moe_w_down, norm_final):
    for layer in range(DEPTH):
        h = rms_norm(x, norm_mix[layer])
        proj = h @ w_in[layer]
        y_a = mla_attention(proj[..., :OFF_RWKV], positions, mla_q_norm[layer], mla_kv_norm[layer],
                            mla_w_uq[layer], mla_w_ukv[layer])
        y_b = rwkv7_time_mix(proj[..., OFF_RWKV:OFF_GDN], rwkv_mu[layer], rwkv_w0[layer],
                             rwkv_w2[layer], rwkv_a0[layer], rwkv_a2[layer], rwkv_g2[layer],
                             rwkv_k_k[layer], rwkv_k_a[layer], rwkv_r_k[layer],
                             rwkv_ln_w[layer], rwkv_ln_b[layer])
        y_c = gated_deltanet(proj[..., OFF_GDN:OFF_SSD], gdn_conv[layer], gdn_a_log[layer],
                             gdn_dt_bias[layer], gdn_norm[layer])
        y_d = mamba2_ssd(proj[..., OFF_SSD:OFF_GATE], ssd_conv_w[layer], ssd_conv_b[layer],
                         ssd_dt_bias[layer], ssd_a_log[layer], ssd_d[layer], ssd_norm[layer])
        merged = None
        for i, y_i in enumerate((y_a, y_b, y_c, y_d)):
            g0 = OFF_GATE + i * D_MODEL
            gate = jax.nn.sigmoid(proj[..., g0:g0 + D_MODEL] + gate_b[layer, i])
            term = gate * (y_i @ w_branch[layer, i])
            merged = term if merged is None else merged + term
        x = x + merged @ w_out[layer]
        h = rms_norm(x, norm_ffn[layer])
        if layer % 2 == 0:
            f = swiglu(h, ffn_w_gu[layer // 2], ffn_w_down[layer // 2])
        else:
            f = moe_swiglu(h, moe_router[layer // 2], moe_w_gu[layer // 2], moe_w_down[layer // 2])
        x = x + f
    return rms_norm(x, norm_final)
```

```cpp
#ifndef EMU
#include <hip/hip_runtime.h>
#include <cstdio>
#include <cstdint>
#endif

#ifdef EMU
constexpr int BATCH = EMU_B, SEQ = EMU_S, NHALF = EMU_NHALF;
#else
constexpr int BATCH = 16, SEQ = 2048, NHALF = 2;
#endif
constexpr int D = 1024, DEPTH = 2, CH = 64;
constexpr int T = BATCH * SEQ, TH = T / NHALF, BH = BATCH / NHALF, NCH = SEQ / CH;
constexpr int C_MLA = 0, C_RWKV = 704, C_GDN = 2528, C_SSD = 4584, C_GATE = 6128, IN_COLS = 10224, PW = 6144;
constexpr int FF_D = 2816, FF_E = 3584, NEXP = 8;
constexpr int MOE_ROWS = ((TH * 2 + NEXP * 255) / 256) * 256;
constexpr float EPS = 1e-6f;
static_assert(TH % 256 == 0 && SEQ % 128 == 0 && BATCH % NHALF == 0, "shape");

typedef unsigned short bf16;
typedef float f32x4 __attribute__((ext_vector_type(4)));
typedef float f32x2 __attribute__((ext_vector_type(2)));
typedef short bf16x8 __attribute__((ext_vector_type(8)));
typedef short bf16x4 __attribute__((ext_vector_type(4)));
typedef unsigned u32x4 __attribute__((ext_vector_type(4)));
typedef unsigned u32x2 __attribute__((ext_vector_type(2)));
#ifdef EMU
#define LAS
#define GAS
#define MFMA_F32(a, b, c) emu_mfma_16x16x4f32(a, b, c)
#define MFMA_BF16(a, b, c) emu_mfma_16x16x32bf16(a, b, c)
#define ATOMIC_ADD_U32(p, v) emu_atomic_add_u32(p, v)
#define RFL(x) (x)
#define LDS_WAIT()
#define VM_WAIT()
__device__ __forceinline__ float fast_exp(float x) { return expf(x); }
__device__ __forceinline__ float fast_rcp(float x) { return 1.0f / x; }
__device__ __forceinline__ float fast_rsqrt(float x) { return 1.0f / sqrtf(x); }
#else
#define LAS __attribute__((address_space(3)))
#define GAS __attribute__((address_space(1)))
#define MFMA_F32(a, b, c) __builtin_amdgcn_mfma_f32_16x16x4f32(a, b, c, 0, 0, 0)
#define MFMA_BF16(a, b, c) __builtin_amdgcn_mfma_f32_16x16x32_bf16(a, b, c, 0, 0, 0)
#define ATOMIC_ADD_U32(p, v) __hip_atomic_fetch_add(p, v, __ATOMIC_RELAXED, __HIP_MEMORY_SCOPE_AGENT)
#define RFL(x) __builtin_amdgcn_readfirstlane(x)
#define LDS_WAIT() asm volatile("s_waitcnt lgkmcnt(0)" ::: "memory")
#define VM_WAIT() asm volatile("s_waitcnt vmcnt(0)" ::: "memory")
__device__ __forceinline__ float fast_exp(float x) { return __expf(x); }
__device__ __forceinline__ float fast_rcp(float x) { return __builtin_amdgcn_rcpf(x); }
__device__ __forceinline__ float fast_rsqrt(float x) { return __builtin_amdgcn_rsqf(x); }
#endif
__device__ __forceinline__ unsigned f2u(float f) { return __builtin_bit_cast(unsigned, f); }
__device__ __forceinline__ float u2f(unsigned u) { return __builtin_bit_cast(float, u); }
__device__ __forceinline__ unsigned f2bf(float f) { unsigned u = f2u(f); return (u + 0x7fffu + ((u >> 16) & 1u)) >> 16; }
__device__ __forceinline__ float bf2f(unsigned h) { return u2f(h << 16); }
__device__ __forceinline__ unsigned pk2(float lo, float hi) { return f2bf(lo) | (f2bf(hi) << 16); }
__device__ __forceinline__ float sigmoidf_(float x) { return 1.0f / (1.0f + expf(-x)); }
__device__ __forceinline__ float siluf_(float x) { return x / (1.0f + expf(-x)); }
__device__ __forceinline__ float softplusf_(float x) { return x > 20.f ? x : log1pf(expf(x)); }
__device__ __forceinline__ float wave_sum(float v) {
#pragma unroll
    for (int o = 1; o < 64; o <<= 1) v += __shfl_xor(v, o);
    return v;
}
__device__ __forceinline__ float wave_max(float v) {
#pragma unroll
    for (int o = 1; o < 64; o <<= 1) v = fmaxf(v, __shfl_xor(v, o));
    return v;
}
__device__ __forceinline__ f32x4 ld_bf16x4(const bf16* p) { const u32x2 w = *(const u32x2*)p; return (f32x4){bf2f(w.x & 0xffffu), bf2f(w.x >> 16), bf2f(w.y & 0xffffu), bf2f(w.y >> 16)}; }
__device__ __forceinline__ void st_bf16x4(bf16* p, f32x4 v) { u32x2 w; w.x = pk2(v.x, v.y); w.y = pk2(v.z, v.w); *(u32x2*)p = w; }

namespace pg8 {
#define PG8_LAS LAS
typedef unsigned short bf16_t;
constexpr int BM = 256, BK = 64, HALF = 128, HTB = HALF * BK * 2, STAGE_BYTES = 8 * HTB, NXCD = 8, WGM = 8;
__host__ __device__ __forceinline__ int lds_byte(int r, int c) { const int st = (r >> 4) * 2 + (c >> 5), rr = r & 15, cc = c & 31, ob = rr * 64 + cc * 2; return st * 1024 + (ob ^ (((ob >> 9) & 1) << 5)); }
__host__ __device__ __forceinline__ void stage_rc(int b, int& R, int& C) { const int st = b / 1024, sb = b % 1024, swz = sb ^ (((sb >> 9) & 1) << 5); R = (st >> 1) * 16 + swz / 64; C = (st & 1) * 32 + (swz % 64) / 2; }
__host__ __device__ __forceinline__ int perm32(int rho) { const int n = rho >> 4, i = rho & 15; return 8 * (i >> 2) + 4 * n + (i & 3); }
struct Unit { int pm, pn; };
struct Gemm { const bf16_t* A; const bf16_t* Bt; int lda, K; };
struct StaticOrder {
    int nM, nN, nwg, G, c;
    __host__ __device__ void init(int M, int N, int G_, int c_) { nM = M / BM; nN = N / BM; nwg = nM * nN; G = G_; c = c_; }
    __host__ __device__ bool next(int i, Unit& u) const {
        const long L = (long)i * G + c; if (L >= nwg) return false;
        int wgid = (int)L; { const int q = nwg / NXCD, r = nwg % NXCD, xcd = wgid % NXCD, off = wgid / NXCD; wgid = (xcd < r ? xcd * (q + 1) : r * (q + 1) + (xcd - r) * q) + off; }
        const int nig = WGM * nN, gid = wgid / nig, fm = gid * WGM, gsz = (nM - fm) < WGM ? (nM - fm) : WGM;
        u.pm = fm + ((wgid % nig) % gsz); u.pn = (wgid % nig) / gsz; return true;
    }
    __device__ __forceinline__ void a_ready(const Unit&) const {}
    __device__ __forceinline__ void done(const Unit&) const {}
};
#ifndef EMU
template <class Epi, class Sched>
__device__ __forceinline__ void gemm_phase(PG8_LAS unsigned char* lds, const Gemm g, const Sched& S, const Epi& E, const int tid) {
    const int wid = __builtin_amdgcn_readfirstlane(tid >> 6), lane = tid & 63, wr = wid >> 2, wc = wid & 3, fr = lane & 15, fq = lane >> 4;
    int Kq = g.K; asm volatile("" : "+s"(Kq));
    const int K = Kq, nt = K / BK, lda = g.lda;
    unsigned voffA[2], voffB[2];
#pragma unroll
    for (int i = 0; i < 2; ++i) { int R, C; stage_rc(tid * 16 + i * 8192, R, C); const int Rb = Epi::PERM ? ((R & ~31) + perm32(R & 31)) : R;
        voffA[i] = (unsigned)(R * lda + C) * 2u; voffB[i] = (unsigned)(Rb * K + C) * 2u; }
    const size_t kstep = (size_t)(BK * 2);
    const size_t hstep = (size_t)HALF * K * 2, hstepA = (size_t)HALF * lda * 2;
    const size_t tstep = 2 * hstep, tstepA = 2 * hstepA;
    const unsigned ldsw = (unsigned)wid * 1024u;
    const int aoff = lds_byte(wr * 64 + fr, fq * 8), boff = lds_byte(wc * 32 + fr, fq * 8);
#define PG8_SA(b, h) (((b) * 2 + (h)) * HTB)
#define PG8_SB(b, h) ((4 + (b) * 2 + (h)) * HTB)
#define PG8_STAGE(bufoff, gbase, voff) do { _Pragma("unroll") for (int _i = 0; _i < 2; ++_i) \
        __builtin_amdgcn_global_load_lds((const unsigned*)((const char*)(gbase) + (voff)[_i]), (PG8_LAS unsigned*)(lds + (bufoff) + ldsw + _i * 8192), 16, 0, 0); } while (0)
#define PG8_LDA(dst, b, h) do { _Pragma("unroll") for (int m = 0; m < 4; ++m) _Pragma("unroll") for (int k = 0; k < 2; ++k) dst[m][k] = *(const PG8_LAS bf16x8*)(lds + PG8_SA(b, h) + aoff + m * 2048 + k * 1024); } while (0)
#define PG8_LDB(dst, b, h) do { _Pragma("unroll") for (int n = 0; n < 2; ++n) _Pragma("unroll") for (int k = 0; k < 2; ++k) dst[n][k] = *(const PG8_LAS bf16x8*)(lds + PG8_SB(b, h) + boff + n * 2048 + k * 1024); } while (0)
#define PG8_MMA(ai, bj, At, Bt) do { __builtin_amdgcn_s_setprio(1); _Pragma("unroll") for (int m = 0; m < 4; ++m) _Pragma("unroll") for (int n = 0; n < 2; ++n) _Pragma("unroll") for (int k = 0; k < 2; ++k) \
        acc[ai][bj][m][n] = __builtin_amdgcn_mfma_f32_16x16x32_bf16(Bt[n][k], At[m][k], acc[ai][bj][m][n], 0, 0, 0); __builtin_amdgcn_s_setprio(0); } while (0)
#define PG8_WAIT_V(n) asm volatile("s_waitcnt vmcnt(" #n ")" ::: "memory")
#define PG8_WAIT_L(n) asm volatile("s_waitcnt lgkmcnt(" #n ")" ::: "memory")
#define PG8_BAR __builtin_amdgcn_s_barrier()
#define PG8_SCHED __builtin_amdgcn_sched_barrier(0)
    Unit cur, nxt; int ui = 0;
    if (!S.next(0, cur)) return;
    f32x4 acc[2][2][4][2];
#pragma unroll
    for (int a = 0; a < 2; ++a)
#pragma unroll
        for (int b = 0; b < 2; ++b)
#pragma unroll
            for (int m = 0; m < 4; ++m)
#pragma unroll
                for (int n = 0; n < 2; ++n) acc[a][b][m][n] = (f32x4){0.f, 0.f, 0.f, 0.f};
    bf16x8 At[4][2], B0[2][2], B1[2][2];
    const char* cA = (const char*)g.A + (size_t)cur.pm * tstepA; const char* cB = (const char*)g.Bt + (size_t)cur.pn * tstep;
    S.a_ready(cur);
    PG8_STAGE(PG8_SB(0, 0), cB, voffB); PG8_STAGE(PG8_SA(0, 0), cA, voffA); PG8_STAGE(PG8_SB(0, 1), cB + hstep, voffB); PG8_STAGE(PG8_SA(0, 1), cA + hstepA, voffA);
    if (wr == 1) PG8_BAR;
    PG8_WAIT_V(4); PG8_BAR;
    PG8_STAGE(PG8_SB(1, 0), cB + kstep, voffB); PG8_STAGE(PG8_SA(1, 0), cA + kstep, voffA); PG8_STAGE(PG8_SB(1, 1), cB + hstep + kstep, voffB);
    PG8_WAIT_V(6); PG8_BAR;
    for (;;) {
        const bool has_next = S.next(ui + 1, nxt);
        const char* nA = has_next ? (const char*)g.A + (size_t)nxt.pm * tstepA : cA; const char* nB = has_next ? (const char*)g.Bt + (size_t)nxt.pn * tstep : cB;
        for (int t = 0; t < nt; t += 2) {
            const bool last = (t == nt - 2);
            const char* a1 = cA + (size_t)(t + 1) * kstep;
            const char* a2 = last ? nA : cA + (size_t)(t + 2) * kstep; const char* b2 = last ? nB : cB + (size_t)(t + 2) * kstep;
            const char* a3 = a2 + kstep; const char* b3 = b2 + kstep;
            if (last && has_next) S.a_ready(nxt);
            PG8_LDB(B0, 0, 0); PG8_SCHED; PG8_LDA(At, 0, 0); PG8_STAGE(PG8_SA(1, 1), a1 + hstepA, voffA);
            PG8_WAIT_L(8); PG8_BAR; PG8_WAIT_L(0); PG8_MMA(0, 0, At, B0); PG8_BAR; PG8_SCHED;
            PG8_LDB(B1, 0, 1); PG8_STAGE(PG8_SB(0, 0), b2, voffB);
            PG8_BAR; PG8_WAIT_L(0); PG8_MMA(0, 1, At, B1); PG8_BAR;
            PG8_LDA(At, 0, 1); PG8_STAGE(PG8_SA(0, 0), a2, voffA);
            PG8_BAR; PG8_WAIT_L(0); PG8_MMA(1, 0, At, B0); PG8_BAR; PG8_SCHED;
            PG8_STAGE(PG8_SB(0, 1), b2 + hstep, voffB);
            PG8_WAIT_V(6); PG8_BAR; PG8_MMA(1, 1, At, B1); PG8_BAR;
            PG8_LDB(B0, 1, 0); PG8_SCHED; PG8_LDA(At, 1, 0); PG8_STAGE(PG8_SA(0, 1), a2 + hstepA, voffA);
            PG8_WAIT_L(8); PG8_BAR; PG8_WAIT_L(0); PG8_MMA(0, 0, At, B0); PG8_BAR; PG8_SCHED;
            PG8_LDB(B1, 1, 1); PG8_STAGE(PG8_SB(1, 0), b3, voffB);
            PG8_BAR; PG8_WAIT_L(0); PG8_MMA(0, 1, At, B1); PG8_BAR;
            PG8_LDA(At, 1, 1); PG8_STAGE(PG8_SA(1, 0), a3, voffA);
            PG8_BAR; PG8_WAIT_L(0); PG8_MMA(1, 0, At, B0); PG8_BAR; PG8_SCHED;
            PG8_STAGE(PG8_SB(1, 1), b3 + hstep, voffB);
            PG8_WAIT_V(6); PG8_BAR; PG8_MMA(1, 1, At, B1); PG8_BAR;
        }
        if constexpr (!Epi::AFTER_DRAIN) { E(acc, cur, wr, wc, fr, fq); S.done(cur); }
        if (!has_next) break;
#pragma unroll
        for (int a = 0; a < 2; ++a)
#pragma unroll
            for (int b = 0; b < 2; ++b)
#pragma unroll
                for (int m = 0; m < 4; ++m)
#pragma unroll
                    for (int n = 0; n < 2; ++n) acc[a][b][m][n] = (f32x4){0.f, 0.f, 0.f, 0.f};
        cur = nxt; cA = nA; cB = nB; ++ui;
    }
    PG8_WAIT_V(0);
    if (wr == 0) PG8_BAR;
    PG8_BAR;
    if constexpr (Epi::AFTER_DRAIN) { E.fused(acc, cur, wr, wc, fr, fq, lds, wid, lane); S.done(cur); }
#undef PG8_SA
#undef PG8_SB
#undef PG8_STAGE
#undef PG8_LDA
#undef PG8_LDB
#undef PG8_MMA
#undef PG8_WAIT_V
#undef PG8_WAIT_L
#undef PG8_BAR
#undef PG8_SCHED
}
#else
template <class Epi, class Sched>
__device__ __forceinline__ void gemm_phase(PG8_LAS unsigned char* lds, const Gemm g, const Sched& S, const Epi& E, const int tid) {
    const int wid = tid >> 6, lane = tid & 63, wr = wid >> 2, wc = wid & 3, fr = lane & 15, fq = lane >> 4;
    Unit cur;
    for (int ui = 0; S.next(ui, cur); ++ui) {
        f32x4 acc[2][2][4][2];
        for (int ai = 0; ai < 2; ++ai) for (int m = 0; m < 4; ++m) {
            const size_t row = (size_t)cur.pm * 256 + ai * 128 + wr * 64 + m * 16 + fr;
            const bf16_t* ap = g.A + row * g.lda;
            for (int bj = 0; bj < 2; ++bj) for (int n = 0; n < 2; ++n) for (int j = 0; j < 4; ++j) {
                const size_t col = (size_t)cur.pn * 256 + bj * 128 + wc * 32 + (Epi::PERM ? 8 * fq + 4 * n : 16 * n + 4 * fq) + j;
                const bf16_t* bp = g.Bt + col * g.K; float s = 0.f;
                for (int k = 0; k < g.K; ++k) s += bf2f(ap[k]) * bf2f(bp[k]);
                acc[ai][bj][m][n][j] = s; } }
        E(acc, cur, wr, wc, fr, fq);
    }
    __syncthreads();
}
#endif
}

using pg8::Unit;
constexpr int HALFT = 128;
struct EpiF32 {
    static constexpr bool PERM = false, AFTER_DRAIN = false;
    float* C; int ldc;
    __device__ __forceinline__ void operator()(const f32x4 (&acc)[2][2][4][2], const Unit& u, int wr, int wc, int fr, int fq) const {
        const int row0 = u.pm * 256 + wr * 64 + fr, col0 = u.pn * 256 + wc * 32 + 4 * fq;
#pragma unroll
        for (int ai = 0; ai < 2; ++ai)
#pragma unroll
            for (int m = 0; m < 4; ++m) { float* rowp = C + (size_t)(row0 + ai * HALFT + m * 16) * ldc + col0;
#pragma unroll
                for (int bj = 0; bj < 2; ++bj)
#pragma unroll
                    for (int n = 0; n < 2; ++n) *(f32x4*)(rowp + bj * HALFT + n * 16) = acc[ai][bj][m][n]; }
    }
};
struct EpiResidual {
    static constexpr bool PERM = false, AFTER_DRAIN = false;
    const float* res; float* out;
    __device__ __forceinline__ void operator()(const f32x4 (&acc)[2][2][4][2], const Unit& u, int wr, int wc, int fr, int fq) const {
        const int row0 = u.pm * 256 + wr * 64 + fr, col0 = u.pn * 256 + wc * 32 + 4 * fq;
#pragma unroll
        for (int ai = 0; ai < 2; ++ai)
#pragma unroll
            for (int m = 0; m < 4; ++m) { const size_t o = (size_t)(row0 + ai * HALFT + m * 16) * D + col0;
#pragma unroll
                for (int bj = 0; bj < 2; ++bj)
#pragma unroll
                    for (int n = 0; n < 2; ++n) { const f32x4 r = *(const f32x4*)(res + o + bj * HALFT + n * 16); *(f32x4*)(out + o + bj * HALFT + n * 16) = r + acc[ai][bj][m][n]; } }
    }
};
struct EpiBf16 {
    static constexpr bool PERM = true, AFTER_DRAIN = false;
    bf16* O; int ldc; const float* rowscale; int rs_stride;
    __device__ __forceinline__ void operator()(const f32x4 (&acc)[2][2][4][2], const Unit& u, int wr, int wc, int fr, int fq) const {
        const int row0 = u.pm * 256 + wr * 64 + fr, col0 = u.pn * 256 + wc * 32 + 8 * fq;
#pragma unroll
        for (int ai = 0; ai < 2; ++ai)
#pragma unroll
            for (int m = 0; m < 4; ++m) { const int row = row0 + ai * HALFT + m * 16; bf16* rowp = O + (size_t)row * ldc + col0;
                const float sc = rowscale ? rowscale[(size_t)row * rs_stride] : 1.0f;
#pragma unroll
                for (int bj = 0; bj < 2; ++bj) { const f32x4 v0 = acc[ai][bj][m][0] * sc, v1 = acc[ai][bj][m][1] * sc;
                    u32x4 w; w.x = pk2(v0[0], v0[1]); w.y = pk2(v0[2], v0[3]); w.z = pk2(v1[0], v1[1]); w.w = pk2(v1[2], v1[3]);
                    *(u32x4*)(rowp + bj * HALFT) = w; } }
    }
};
struct EpiSwiGLU {
    static constexpr bool PERM = true, AFTER_DRAIN = false;
    bf16* O; int ldc; int ntile;
    __device__ __forceinline__ void operator()(const f32x4 (&acc)[2][2][4][2], const Unit& u, int wr, int wc, int fr, int fq) const {
        const int row0 = u.pm * 256 + wr * 64 + fr, col0 = (u.pn % ntile) * 128 + wc * 32 + 8 * fq;
#pragma unroll
        for (int ai = 0; ai < 2; ++ai)
#pragma unroll
            for (int m = 0; m < 4; ++m) { bf16* rowp = O + (size_t)(row0 + ai * HALFT + m * 16) * ldc + col0;
                float a[8];
#pragma unroll
                for (int n = 0; n < 2; ++n)
#pragma unroll
                    for (int j = 0; j < 4; ++j) { const float g = acc[ai][0][m][n][j], up = acc[ai][1][m][n][j]; a[4 * n + j] = g * fast_rcp(1.0f + fast_exp(-g)) * up; }
                u32x4 w; w.x = pk2(a[0], a[1]); w.y = pk2(a[2], a[3]); w.z = pk2(a[4], a[5]); w.w = pk2(a[6], a[7]);
                *(u32x4*)rowp = w; }
    }
};
struct EpiMerge {
    static constexpr bool PERM = false, AFTER_DRAIN = false;
    const bf16* Z; const float* gate_b; bf16* MG;
    __device__ __forceinline__ void operator()(const f32x4 (&acc)[2][2][4][2], const Unit& u, int wr, int wc, int fr, int fq) const {
        const int row0 = u.pm * 256 + wr * 64 + fr, col = u.pn * 64 + wc * 16 + 4 * fq;
        f32x4 gb[4];
#pragma unroll
        for (int i = 0; i < 4; ++i) gb[i] = *(const f32x4*)(gate_b + i * D + col);
#pragma unroll
        for (int ai = 0; ai < 2; ++ai)
#pragma unroll
            for (int m = 0; m < 4; ++m) { const size_t row = (size_t)(row0 + ai * HALFT + m * 16);
                f32x4 s = (f32x4){0.f, 0.f, 0.f, 0.f};
#pragma unroll
                for (int bj = 0; bj < 2; ++bj)
#pragma unroll
                    for (int n = 0; n < 2; ++n) { const int i = 2 * bj + n; const f32x4 z = ld_bf16x4(Z + row * 4096 + i * D + col); const f32x4 a = acc[ai][bj][m][n] + gb[i];
#pragma unroll
                        for (int j = 0; j < 4; ++j) s[j] += z[j] * fast_rcp(1.0f + fast_exp(-a[j])); }
                st_bf16x4(MG + row * D + col, s); }
    }
};

constexpr size_t MiB = 1u << 20;
constexpr size_t al(size_t x) { return (x + 255) & ~(size_t)255; }
constexpr size_t WS_CTL = 0, CTL_BYTES = 1 * MiB;
constexpr size_t W_IN = 1 * MiB;
constexpr size_t W_GATE = W_IN + (size_t)PW * D * 2;
constexpr size_t W_UQ = W_GATE + (size_t)4096 * D * 2;
constexpr size_t W_UKV = W_UQ + (size_t)768 * 384 * 2;
constexpr size_t W_LORA = W_UKV + (size_t)1024 * 256 * 2;
constexpr size_t W_BR = W_LORA + (size_t)1536 * 384 * 2;
constexpr size_t W_OUT = W_BR + (size_t)4 * 1024 * 512 * 2;
constexpr size_t W_FGU = W_OUT + (size_t)D * D * 2;
constexpr size_t W_FDN = W_FGU + (size_t)NEXP * 2 * FF_E * D * 2;
constexpr size_t W_END = W_FDN + (size_t)NEXP * D * FF_E * 2;
constexpr size_t A_H = al(W_END);
constexpr size_t A_ROPE = A_H + (size_t)TH * D * 2;
constexpr size_t A_Y = A_ROPE + (size_t)TH * 64 * 4;
constexpr size_t A_P = A_Y + (size_t)4 * TH * 512 * 2;
constexpr size_t A_MIX = A_P + (size_t)TH * PW * 2;
constexpr size_t M_STAT = A_MIX;
constexpr size_t M_KR = M_STAT + (size_t)TH * 2 * 4;
constexpr size_t M_Q = M_KR + (size_t)TH * 64 * 2;
constexpr size_t M_KV = M_Q + (size_t)TH * 768 * 2;
constexpr size_t M_END = M_KV + (size_t)TH * 1024 * 2;
constexpr size_t R_RKV = A_MIX;
constexpr size_t R_LIN = R_RKV + (size_t)TH * 1536 * 2;
constexpr size_t R_LOUT = R_LIN + (size_t)TH * 384 * 2;
constexpr size_t R_O = R_LOUT + (size_t)TH * 1536 * 4;
constexpr size_t R_END = R_O + (size_t)TH * 512 * 4;
constexpr int GDN_CHUNK_F = 4 * 64 * 128 + 64 * 64;
constexpr size_t G_CH = A_MIX;
constexpr size_t G_GL = G_CH + (size_t)BH * 4 * NCH * GDN_CHUNK_F * 4;
constexpr size_t G_O = G_GL + al((size_t)BH * 4 * NCH * 4);
constexpr size_t G_END = G_O + (size_t)TH * 512 * 4;
constexpr size_t S_ST = A_MIX;
constexpr size_t S_YD = S_ST + (size_t)BH * NCH * 8 * 64 * 128 * 4;
constexpr size_t S_C = S_YD + (size_t)TH * 512 * 4;
constexpr size_t S_AC = S_C + (size_t)TH * 256 * 4;
constexpr size_t S_END = S_AC + (size_t)TH * 8 * 4;
constexpr size_t A_Z = A_P;
constexpr size_t A_MG = A_MIX;
constexpr size_t F_ACT = A_P;
constexpr size_t F_GA = F_ACT + (size_t)MOE_ROWS * FF_E * 2;
constexpr size_t F_YE = F_GA + (size_t)MOE_ROWS * D * 2;
constexpr size_t F_TOPE = F_YE + (size_t)MOE_ROWS * D * 4;
constexpr size_t F_TOPW = F_TOPE + (size_t)TH * 2 * 4;
constexpr size_t F_SLOT = F_TOPW + (size_t)TH * 2 * 4;
constexpr size_t F_END = F_SLOT + (size_t)TH * 2 * 4;
constexpr size_t cmax(size_t a, size_t b) { return a > b ? a : b; }
constexpr size_t WS_NEED = cmax(cmax(cmax(M_END, R_END), cmax(G_END, S_END)), F_END);
#ifndef EMU
static_assert(WS_NEED <= (size_t)896 * MiB, "workspace");
#endif
constexpr int CW_BAR = 4096;
constexpr int CW_CNT = 16384;
constexpr int CW_FILL = 16384 + 64;

#ifdef EMU
#define WAVE_SYNC() emu_wave_sync()
#else
#define WAVE_SYNC() do { asm volatile("s_waitcnt lgkmcnt(0)" ::: "memory"); } while (0)
#endif
struct Frame {
    LAS unsigned char* lds; int tid, lane, wave, G, gw, NGW, bid;
    float* out; unsigned char* ws; unsigned* ctl;
};
struct Args { const float* in[39]; float* out; unsigned char* ws; int lo, hi; };
#define WSP(type, off) ((type*)(F.ws + (off)))

template <class FN>
__device__ __forceinline__ void cvt_matrix(const Frame& F, const float* W, int ldw, int K, bf16* WT, int Ndst, const float* kscale, FN srccol) {
    LAS float* scr = (LAS float*)(F.lds + F.wave * 16384);
    const int nblk = Ndst / 32, nitems = (K / 64) * nblk, lane = F.lane;
    for (int item = F.gw; item < nitems; item += F.NGW) {
        const int kb = item / nblk, nb = item % nblk, k0 = 64 * kb, n0 = 32 * nb;
        const int sc = srccol(n0 + (lane & 31));
#pragma unroll 8
        for (int i = 0; i < 32; ++i) { const int kk = 2 * i + (lane >> 5); float v = sc >= 0 ? W[(size_t)(k0 + kk) * ldw + sc] : 0.f; if (kscale) v *= kscale[k0 + kk]; scr[kk * 33 + (lane & 31)] = v; }
        WAVE_SYNC();
        const int c = lane & 7;
#pragma unroll
        for (int j = 0; j < 4; ++j) { const int n = (lane >> 3) + 8 * j; const LAS float* s = scr + (8 * c) * 33 + n;
            u32x4 o; o.x = pk2(s[0 * 33], s[1 * 33]); o.y = pk2(s[2 * 33], s[3 * 33]); o.z = pk2(s[4 * 33], s[5 * 33]); o.w = pk2(s[6 * 33], s[7 * 33]);
            *(u32x4*)(WT + (size_t)(n0 + n) * K + k0 + 8 * c) = o; }
        WAVE_SYNC();
    }
}
__device__ __forceinline__ void phase_convert(const Frame& F, const Args& A, int layer) {
    const float* w_in = A.in[3] + (size_t)layer * D * IN_COLS;
    cvt_matrix(F, w_in, IN_COLS, D, WSP(bf16, W_IN), PW, nullptr, [](int n) { return n < C_GATE ? n : -1; });
    cvt_matrix(F, w_in, IN_COLS, D, WSP(bf16, W_GATE), 4096, nullptr, [](int n) {
        const int pn = n >> 8, c = n & 255, bj = c >> 7, wc = (c >> 5) & 3, nn = (c >> 4) & 1, r = c & 15; return C_GATE + (2 * bj + nn) * D + 64 * pn + 16 * wc + r; });
    cvt_matrix(F, A.in[6] + (size_t)layer * 384 * 768, 768, 384, WSP(bf16, W_UQ), 768, A.in[4] + layer * 384, [](int n) { return n; });
    cvt_matrix(F, A.in[7] + (size_t)layer * 256 * 1024, 1024, 256, WSP(bf16, W_UKV), 1024, A.in[5] + layer * 256, [](int n) { return n; });
    for (int i = 0; i < 4; ++i) cvt_matrix(F, A.in[30] + ((size_t)layer * 4 + i) * 512 * D, D, 512, WSP(bf16, W_BR) + (size_t)i * D * 512, D, nullptr, [](int n) { return n; });
    cvt_matrix(F, A.in[31] + (size_t)layer * D * D, D, D, WSP(bf16, W_OUT), D, nullptr, [](int n) { return n; });
    if (layer == 0) {
        cvt_matrix(F, A.in[33], 2 * FF_D, D, WSP(bf16, W_FGU), 2 * FF_D, nullptr, [](int n) { const int pn = n >> 8, c = n & 255; return c < 128 ? 128 * pn + c : FF_D + 128 * pn + (c - 128); });
        cvt_matrix(F, A.in[34], D, FF_D, WSP(bf16, W_FDN), D, nullptr, [](int n) { return n; });
    } else {
        for (int e = 0; e < NEXP; ++e) {
            cvt_matrix(F, A.in[36] + (size_t)e * D * 2 * FF_E, 2 * FF_E, D, WSP(bf16, W_FGU) + (size_t)e * 2 * FF_E * D, 2 * FF_E, nullptr, [](int n) { const int pn = n >> 8, c = n & 255; return c < 128 ? 128 * pn + c : FF_E + 128 * pn + (c - 128); });
            cvt_matrix(F, A.in[37] + (size_t)e * FF_E * D, D, FF_E, WSP(bf16, W_FDN) + (size_t)e * D * FF_E, D, nullptr, [](int n) { return n; });
        }
    }
    { const float* w2 = A.in[10] + (size_t)layer * 64 * 512; const float* a2 = A.in[12] + (size_t)layer * 64 * 512; const float* g2 = A.in[13] + (size_t)layer * 160 * 512;
      bf16* L = WSP(bf16, W_LORA);
      for (int idx = F.bid * 512 + F.tid; idx < 1536 * 384; idx += F.G * 512) { const int n = idx / 384, k = idx % 384; float v = 0.f;
          if (n < 512) { if (k < 64) v = w2[k * 512 + n]; } else if (n < 1024) { if (k >= 64 && k < 128) v = a2[(k - 64) * 512 + (n - 512)]; } else { if (k >= 128 && k < 288) v = g2[(k - 128) * 512 + (n - 1024)]; }
          L[idx] = (bf16)f2bf(v); } }
}

template <bool ROUTER>
__device__ __forceinline__ void phase_norm(const Frame& F, const Args& A, const float* xin, const float* gain, bf16* H, const float* router, int* tope, float* topw, unsigned* cnt) {
    const int lane = F.lane;
    f32x4 gv[4];
#pragma unroll
    for (int j = 0; j < 4; ++j) gv[j] = *(const f32x4*)(gain + 4 * lane + 256 * j);
    for (int m = F.gw; m < TH; m += F.NGW) {
        const float* xr = xin + (size_t)m * D; f32x4 v[4]; float ss = 0.f;
#pragma unroll
        for (int j = 0; j < 4; ++j) { v[j] = *(const f32x4*)(xr + 4 * lane + 256 * j); ss += (v[j].x * v[j].x + v[j].y * v[j].y) + (v[j].z * v[j].z + v[j].w * v[j].w); }
        const float rstd = 1.0f / sqrtf(wave_sum(ss) * (1.0f / D) + EPS);
#pragma unroll
        for (int j = 0; j < 4; ++j) { v[j] = v[j] * rstd * gv[j]; st_bf16x4(H + (size_t)m * D + 4 * lane + 256 * j, v[j]); }
        if (ROUTER) {
            float lg[8];
#pragma unroll
            for (int e = 0; e < 8; ++e) lg[e] = 0.f;
#pragma unroll
            for (int j = 0; j < 4; ++j)
#pragma unroll
                for (int q = 0; q < 4; ++q) { const float* rp = router + (size_t)(4 * lane + 256 * j + q) * 8; const f32x4 r0 = *(const f32x4*)rp, r1 = *(const f32x4*)(rp + 4); const float hv = v[j][q];
                    lg[0] += hv * r0.x; lg[1] += hv * r0.y; lg[2] += hv * r0.z; lg[3] += hv * r0.w; lg[4] += hv * r1.x; lg[5] += hv * r1.y; lg[6] += hv * r1.z; lg[7] += hv * r1.w; }
#pragma unroll
            for (int e = 0; e < 8; ++e) lg[e] = wave_sum(lg[e]);
            if (lane == 0) {
                int e1 = 0; float l1 = lg[0];
#pragma unroll
                for (int e = 1; e < 8; ++e) if (lg[e] > l1) { l1 = lg[e]; e1 = e; }
                int e2 = -1; float l2 = -3.0e38f;
#pragma unroll
                for (int e = 0; e < 8; ++e) if (e != e1 && lg[e] > l2) { l2 = lg[e]; e2 = e; }
                const float w1 = 1.0f / (1.0f + expf(l2 - l1));
                tope[2 * m] = e1; tope[2 * m + 1] = e2; topw[2 * m] = w1; topw[2 * m + 1] = 1.0f - w1;
                ATOMIC_ADD_U32(cnt + e1, 1u); ATOMIC_ADD_U32(cnt + e2, 1u);
            }
        }
    }
}
__device__ __forceinline__ void phase_rope_table(const Frame& F, const Args& A, const int* pos, float* rope) {
    for (int idx = F.bid * 512 + F.tid; idx < TH * 32; idx += F.G * 512) { const int t = idx >> 5, i = idx & 31;
        const float inv = powf(10000.0f, -(float)i / 32.0f);
        const float ang = (float)pos[t] * inv; float sn, cs; sincosf(ang, &sn, &cs);
        rope[(size_t)t * 64 + i] = cs; rope[(size_t)t * 64 + 32 + i] = sn; }
}
__device__ __forceinline__ void phase_final_norm(const Frame& F, const Args& A, float* x, const float* gain) {
    const int lane = F.lane;
    for (int m = F.gw; m < T; m += F.NGW) {
        float* xr = x + (size_t)m * D; f32x4 v[4]; float ss = 0.f;
#pragma unroll
        for (int j = 0; j < 4; ++j) { v[j] = *(const f32x4*)(xr + 4 * lane + 256 * j); ss += (v[j].x * v[j].x + v[j].y * v[j].y) + (v[j].z * v[j].z + v[j].w * v[j].w); }
        const float rstd = 1.0f / sqrtf(wave_sum(ss) * (1.0f / D) + EPS);
#pragma unroll
        for (int j = 0; j < 4; ++j) *(f32x4*)(xr + 4 * lane + 256 * j) = v[j] * rstd * *(const f32x4*)(gain + 4 * lane + 256 * j);
    }
}

__device__ __forceinline__ void phase_mla_prep(const Frame& F, const Args& A) {
    bf16* P = WSP(bf16, A_P); bf16* kr = WSP(bf16, M_KR); const float* rope = WSP(float, A_ROPE);
    const int lane = F.lane;
    for (int m = F.gw; m < TH; m += F.NGW) {
        bf16* pr = P + (size_t)m * PW; float sq = 0.f, skv = 0.f; f32x4 v[3];
#pragma unroll
        for (int j = 0; j < 3; ++j) { const int c = 4 * lane + 256 * j; v[j] = ld_bf16x4(pr + c); const float s = (v[j].x * v[j].x + v[j].y * v[j].y) + (v[j].z * v[j].z + v[j].w * v[j].w);
            if (c < 384) sq += s; else if (c < 640) skv += s; }
        sq = wave_sum(sq); skv = wave_sum(skv);
        const float rq = 1.0f / sqrtf(sq * (1.0f / 384.0f) + EPS), rkv = 1.0f / sqrtf(skv * (1.0f / 256.0f) + EPS);
#pragma unroll
        for (int j = 0; j < 3; ++j) { const int c = 4 * lane + 256 * j; if (c < 640) st_bf16x4(pr + c, v[j] * (c < 384 ? rq : rkv)); }
        if (lane < 32) { const float x1 = bf2f(pr[640 + lane]), x2 = bf2f(pr[672 + lane]), c = rope[(size_t)m * 64 + lane], s = rope[(size_t)m * 64 + 32 + lane];
            kr[(size_t)m * 64 + lane] = (bf16)f2bf(x1 * c - x2 * s); kr[(size_t)m * 64 + 32 + lane] = (bf16)f2bf(x2 * c + x1 * s); }
    }
}
__device__ __forceinline__ void phase_mla_q(const Frame& F, const Args& A) {
    pg8::Gemm g{WSP(bf16, A_P) + 0, WSP(bf16, W_UQ), PW, 384}; pg8::StaticOrder S; S.init(TH, 768, F.G, F.bid);
    EpiBf16 E{WSP(bf16, M_Q), 768, nullptr, 0}; pg8::gemm_phase(F.lds, g, S, E, F.tid);
}
__device__ __forceinline__ void phase_mla_kv(const Frame& F, const Args& A) {
    pg8::Gemm g{WSP(bf16, A_P) + 384, WSP(bf16, W_UKV), PW, 256}; pg8::StaticOrder S; S.init(TH, 1024, F.G, F.bid);
    EpiBf16 E{WSP(bf16, M_KV), 1024, nullptr, 0}; pg8::gemm_phase(F.lds, g, S, E, F.tid);
}
constexpr int AT_KS = 200, AT_VS = 72;
__device__ __forceinline__ void phase_attention(const Frame& F, const Args& A) {
    const bf16* Q = WSP(bf16, M_Q); const bf16* KV = WSP(bf16, M_KV); const bf16* KR = WSP(bf16, M_KR); const float* rope = WSP(float, A_ROPE); bf16* Y = WSP(bf16, A_Y);
    LAS bf16* Ks = (LAS bf16*)F.lds; LAS bf16* Vt = (LAS bf16*)(F.lds + 64 * AT_KS * 2);
    const int lane = F.lane, w = F.wave, l15 = lane & 15, q4 = lane >> 4, tid = F.tid;
    const int NQB = SEQ / 128, nunits = BH * 4 * NQB;
    const float scale = 0.07216878364870322f;
    for (int unit = F.bid; unit < nunits; unit += F.G) {
        const int qb = NQB - 1 - (unit % NQB), bh = unit / NQB, h = bh & 3, b = bh >> 2;
        const size_t t0 = (size_t)b * SEQ;
        const size_t tq = t0 + qb * 128 + w * 16 + l15;
        bf16x8 qf[6];
#pragma unroll
        for (int ks = 0; ks < 6; ++ks) qf[ks] = *(const bf16x8*)(Q + tq * 768 + h * 192 + 32 * ks + 8 * q4);
        {
            bf16x8 a = qf[4], c2 = qf[5];
#pragma unroll
            for (int j = 0; j < 8; ++j) { const float x1 = bf2f((unsigned short)a[j]), x2 = bf2f((unsigned short)c2[j]), c = rope[tq * 64 + 8 * q4 + j], s = rope[tq * 64 + 32 + 8 * q4 + j];
                qf[4][j] = (short)f2bf(x1 * c - x2 * s); qf[5][j] = (short)f2bf(x2 * c + x1 * s); }
        }
        f32x4 o[8];
#pragma unroll
        for (int mb = 0; mb < 8; ++mb) o[mb] = (f32x4){0.f, 0.f, 0.f, 0.f};
        float mrow = -3.0e38f, lrow = 0.f;
        const int qchunk = 2 * qb + (w >> 2), ntile = 2 * qb + 2;
        for (int kt = 0; kt < ntile; ++kt) {
            __syncthreads();
            const size_t k0 = t0 + (size_t)kt * 64;
#pragma unroll
            for (int i = 0; i < 3; ++i) { const int idx = tid + 512 * i, key = idx / 24, c = idx % 24;
                const u32x4 v = (c < 16) ? *(const u32x4*)(KV + (k0 + key) * 1024 + h * 256 + 8 * c) : *(const u32x4*)(KR + (k0 + key) * 64 + 8 * (c - 16));
                *(LAS u32x4*)(Ks + key * AT_KS + 8 * c) = v; }
#pragma unroll
            for (int i = 0; i < 2; ++i) { const int idx = tid + 512 * i, key = idx >> 4, c = idx & 15;
                const bf16x8 v = *(const bf16x8*)(KV + (k0 + key) * 1024 + h * 256 + 128 + 8 * c);
#pragma unroll
                for (int j = 0; j < 8; ++j) Vt[(8 * c + j) * AT_VS + key] = (bf16)v[j]; }
            __syncthreads();
            if (kt <= qchunk) {
                f32x4 st[4];
#pragma unroll
                for (int kb = 0; kb < 4; ++kb) { st[kb] = (f32x4){0.f, 0.f, 0.f, 0.f};
#pragma unroll
                    for (int ks = 0; ks < 6; ++ks) { const bf16x8 kf = *(const LAS bf16x8*)(Ks + (16 * kb + l15) * AT_KS + 32 * ks + 8 * q4); st[kb] = MFMA_BF16(kf, qf[ks], st[kb]); } }
                float mx = -3.0e38f;
#pragma unroll
                for (int kb = 0; kb < 4; ++kb) { st[kb] = st[kb] * scale; mx = fmaxf(mx, fmaxf(fmaxf(st[kb].x, st[kb].y), fmaxf(st[kb].z, st[kb].w))); }
                mx = fmaxf(mx, __shfl_xor(mx, 16)); mx = fmaxf(mx, __shfl_xor(mx, 32));
                const float mnew = fmaxf(mrow, mx), alpha = expf(mrow - mnew); mrow = mnew;
                float ps = 0.f;
#pragma unroll
                for (int kb = 0; kb < 4; ++kb)
#pragma unroll
                    for (int r = 0; r < 4; ++r) { const float p = expf(st[kb][r] - mnew); st[kb][r] = p; ps += p; }
                lrow = lrow * alpha + ps;
#pragma unroll
                for (int mb = 0; mb < 8; ++mb) o[mb] = o[mb] * alpha;
#pragma unroll
                for (int kg = 0; kg < 2; ++kg) {
                    bf16x8 pb;
#pragma unroll
                    for (int j = 0; j < 4; ++j) { pb[j] = (short)f2bf(st[2 * kg][j]); pb[4 + j] = (short)f2bf(st[2 * kg + 1][j]); }
#pragma unroll
                    for (int mb = 0; mb < 8; ++mb) { const LAS bf16* vp = Vt + (16 * mb + l15) * AT_VS + 32 * kg + 4 * q4;
                        const bf16x4 v0 = *(const LAS bf16x4*)vp, v1 = *(const LAS bf16x4*)(vp + 16);
                        bf16x8 vf; vf[0] = v0[0]; vf[1] = v0[1]; vf[2] = v0[2]; vf[3] = v0[3]; vf[4] = v1[0]; vf[5] = v1[1]; vf[6] = v1[2]; vf[7] = v1[3];
                        o[mb] = MFMA_BF16(vf, pb, o[mb]); }
                }
            }
        }
        lrow += __shfl_xor(lrow, 16); lrow += __shfl_xor(lrow, 32);
        const float inv = 1.0f / lrow;
#pragma unroll
        for (int mb = 0; mb < 8; ++mb) st_bf16x4(Y + tq * 512 + h * 128 + 16 * mb + 4 * q4, o[mb] * inv);
    }
    __syncthreads();
}

__device__ __forceinline__ void phase_rwkv_prep(const Frame& F, const Args& A, int layer) {
    const bf16* P = WSP(bf16, A_P); bf16* RKV = WSP(bf16, R_RKV); bf16* LIN = WSP(bf16, R_LIN); const float* mu = A.in[8] + (size_t)layer * 1824;
    const int lane = F.lane;
    for (int m = F.gw; m < TH; m += F.NGW) {
        const bool first = (m % SEQ) == 0; const bf16* pr = P + (size_t)m * PW + C_RWKV;
#pragma unroll
        for (int j = 0; j < 8; ++j) { const int c = 4 * lane + 256 * j;
            if (c < 1824) { const f32x4 p = ld_bf16x4(pr + c); const f32x4 pv = first ? (f32x4){0.f, 0.f, 0.f, 0.f} : ld_bf16x4(pr - PW + c); const f32x4 muv = *(const f32x4*)(mu + c);
                f32x4 x = p + (pv - p) * muv;
                if (c < 1536) st_bf16x4(RKV + (size_t)m * 1536 + c, x);
                else { if (c < 1600) { x.x = tanhf(x.x); x.y = tanhf(x.y); x.z = tanhf(x.z); x.w = tanhf(x.w); }
                       else if (c >= 1664) { x.x = sigmoidf_(x.x); x.y = sigmoidf_(x.y); x.z = sigmoidf_(x.z); x.w = sigmoidf_(x.w); }
                       st_bf16x4(LIN + (size_t)m * 384 + (c - 1536), x); } } }
        if (lane < 24) st_bf16x4(LIN + (size_t)m * 384 + 288 + 4 * lane, (f32x4){0.f, 0.f, 0.f, 0.f});
    }
}
__device__ __forceinline__ void phase_rwkv_lora(const Frame& F, const Args& A) {
    pg8::Gemm g{WSP(bf16, R_LIN), WSP(bf16, W_LORA), 384, 384}; pg8::StaticOrder S; S.init(TH, 1536, F.G, F.bid);
    EpiF32 E{WSP(float, R_LOUT), 1536}; pg8::gemm_phase(F.lds, g, S, E, F.tid);
}
constexpr int RW_TB = 32;
__device__ __forceinline__ void phase_rwkv_scan(const Frame& F, const Args& A, int layer) {
    const bf16* RKV = WSP(bf16, R_RKV); const float* LOUT = WSP(float, R_LOUT); float* RO = WSP(float, R_O);
    const float* w0 = A.in[9] + layer * 512; const float* a0 = A.in[11] + layer * 512; const float* k_k = A.in[14] + layer * 512; const float* k_a = A.in[15] + layer * 512;
    LAS float* sr = (LAS float*)F.lds; LAS float* sd = sr + RW_TB * 64; LAS float* skm = sd + RW_TB * 64; LAS float* skk = skm + RW_TB * 64; LAS float* ska = skk + RW_TB * 64; LAS float* sv = ska + RW_TB * 64;
    const int tid = F.tid, lane = F.lane, il = tid >> 5, jq = tid & 31;
    const int nunits = BH * 8 * 4;
    for (int unit = F.bid; unit < nunits; unit += F.G) {
        const int rq = unit & 3, h = (unit >> 2) & 7, b = unit >> 5; const int i = 16 * rq + il;
        float s0 = 0.f, s1 = 0.f;
        const int cj = h * 64 + (tid & 63);
        const float w0c = w0[cj], a0c = a0[cj], kkc = k_k[cj], kac = k_a[cj];
        for (int tb = 0; tb < SEQ / RW_TB; ++tb) {
            const size_t tok0 = (size_t)b * SEQ + (size_t)tb * RW_TB;
            __syncthreads();
#pragma unroll
            for (int q = 0; q < RW_TB / 8; ++q) { const int tt = (tid >> 6) + 8 * q; const size_t tok = tok0 + tt;
                const float r = bf2f(RKV[tok * 1536 + cj]), k = bf2f(RKV[tok * 1536 + 512 + cj]);
                const float wpre = LOUT[tok * 1536 + cj], apre = LOUT[tok * 1536 + 512 + cj];
                const float w = -softplusf_(-(w0c + wpre)) - 0.5f, dec = expf(-expf(w)), a = sigmoidf_(a0c + apre);
                const float kr = k * kkc, ss = wave_sum(kr * kr), kk = kr / sqrtf(ss + EPS);
                const int o = tt * 64 + (tid & 63);
                sr[o] = r; sd[o] = dec; skm[o] = k * (1.0f + (a - 1.0f) * kac); skk[o] = kk; ska[o] = kk * a; }
            { const int tt = tid >> 4, ii = tid & 15; sv[tt * 16 + ii] = bf2f(RKV[(tok0 + tt) * 1536 + 1024 + h * 64 + 16 * rq + ii]); }
            __syncthreads();
            for (int tt = 0; tt < RW_TB; ++tt) {
                const int o = tt * 64 + 2 * jq;
                const f32x2 kk = *(const LAS f32x2*)(skk + o), dc = *(const LAS f32x2*)(sd + o), ka = *(const LAS f32x2*)(ska + o), km = *(const LAS f32x2*)(skm + o), rr = *(const LAS f32x2*)(sr + o);
                const float vi = sv[tt * 16 + il];
                float sa = s0 * kk.x + s1 * kk.y;
                sa += __shfl_xor(sa, 1); sa += __shfl_xor(sa, 2); sa += __shfl_xor(sa, 4); sa += __shfl_xor(sa, 8); sa += __shfl_xor(sa, 16);
                s0 = s0 * dc.x - sa * ka.x + vi * km.x; s1 = s1 * dc.y - sa * ka.y + vi * km.y;
                float op = s0 * rr.x + s1 * rr.y;
                op += __shfl_xor(op, 1); op += __shfl_xor(op, 2); op += __shfl_xor(op, 4); op += __shfl_xor(op, 8); op += __shfl_xor(op, 16);
                if (jq == 0) RO[(tok0 + tt) * 512 + h * 64 + i] = op;
            }
        }
    }
    __syncthreads();
}
__device__ __forceinline__ void phase_rwkv_post(const Frame& F, const Args& A, int layer) {
    const bf16* RKV = WSP(bf16, R_RKV); const float* LOUT = WSP(float, R_LOUT); const float* RO = WSP(float, R_O); bf16* Y = WSP(bf16, A_Y) + (size_t)1 * TH * 512;
    const float* a0 = A.in[11] + layer * 512; const float* k_a = A.in[15] + layer * 512; const float* r_k = A.in[16] + layer * 512; const float* ln_w = A.in[17] + layer * 512; const float* ln_b = A.in[18] + layer * 512;
    const int lane = F.lane, c0 = 8 * lane;
    for (int m = F.gw; m < TH; m += F.NGW) {
        float o[8], r[8], k[8], v[8], ap[8], g[8];
        { const f32x4 a = *(const f32x4*)(RO + (size_t)m * 512 + c0), b2 = *(const f32x4*)(RO + (size_t)m * 512 + c0 + 4); o[0] = a.x; o[1] = a.y; o[2] = a.z; o[3] = a.w; o[4] = b2.x; o[5] = b2.y; o[6] = b2.z; o[7] = b2.w; }
#pragma unroll
        for (int hh = 0; hh < 2; ++hh) { const f32x4 rv = ld_bf16x4(RKV + (size_t)m * 1536 + c0 + 4 * hh), kv = ld_bf16x4(RKV + (size_t)m * 1536 + 512 + c0 + 4 * hh), vv = ld_bf16x4(RKV + (size_t)m * 1536 + 1024 + c0 + 4 * hh);
            const f32x4 av = *(const f32x4*)(LOUT + (size_t)m * 1536 + 512 + c0 + 4 * hh), gv = *(const f32x4*)(LOUT + (size_t)m * 1536 + 1024 + c0 + 4 * hh);
#pragma unroll
            for (int q = 0; q < 4; ++q) { r[4 * hh + q] = rv[q]; k[4 * hh + q] = kv[q]; v[4 * hh + q] = vv[q]; ap[4 * hh + q] = av[q]; g[4 * hh + q] = gv[q]; } }
        float bon = 0.f, sm = 0.f;
#pragma unroll
        for (int q = 0; q < 8; ++q) { const float a = sigmoidf_(a0[c0 + q] + ap[q]); const float km = k[q] * (1.0f + (a - 1.0f) * k_a[c0 + q]); bon += r[q] * km * r_k[c0 + q]; sm += o[q]; }
        bon += __shfl_xor(bon, 1); bon += __shfl_xor(bon, 2); bon += __shfl_xor(bon, 4);
        sm += __shfl_xor(sm, 1); sm += __shfl_xor(sm, 2); sm += __shfl_xor(sm, 4);
        const float mean = sm * (1.0f / 64.0f); float vs = 0.f;
#pragma unroll
        for (int q = 0; q < 8; ++q) { const float d = o[q] - mean; vs += d * d; }
        vs += __shfl_xor(vs, 1); vs += __shfl_xor(vs, 2); vs += __shfl_xor(vs, 4);
        const float rstd = 1.0f / sqrtf(vs * (1.0f / 64.0f) + 64e-5f);
        float y[8];
#pragma unroll
        for (int q = 0; q < 8; ++q) y[q] = ((o[q] - mean) * rstd * ln_w[c0 + q] + ln_b[c0 + q] + bon * v[q]) * g[q];
        u32x4 wv; wv.x = pk2(y[0], y[1]); wv.y = pk2(y[2], y[3]); wv.z = pk2(y[4], y[5]); wv.w = pk2(y[6], y[7]);
        *(u32x4*)(Y + (size_t)m * 512 + c0) = wv;
    }
}

__device__ __forceinline__ f32x4 tile_mm(const LAS float* a, int lda, int ska, const LAS float* b, int ldb, int scb, int K, f32x4 acc, int l15, int q4) {
    const LAS float* ap = a + l15 * lda + q4 * ska; const LAS float* bp = b + q4 * ldb + l15 * scb;
#pragma unroll 8
    for (int ks = 0; ks < K / 4; ++ks) acc = MFMA_F32(ap[ks * 4 * ska], bp[ks * 4 * ldb], acc);
    return acc;
}
constexpr int GS = 132, GS2 = 68;
__device__ __forceinline__ void phase_gdn_g1(const Frame& F, const Args& A, int layer) {
    const bf16* P = WSP(bf16, A_P); float* CHR = WSP(float, G_CH); float* GL = WSP(float, G_GL);
    const float* convw = A.in[19] + (size_t)layer * 4 * 1536; const float* a_log = A.in[20] + layer * 4; const float* dtb = A.in[21] + layer * 4;
    LAS float* qs = (LAS float*)F.lds; LAS float* ks = qs + 64 * GS; LAS float* vs = ks + 64 * GS; LAS float* Lm = vs + 64 * GS; LAS float* QK = Lm + 64 * GS2;
    LAS float* beta = QK + 64 * GS2; LAS float* gc = beta + 64; LAS float* egc = gc + 64;
    const int tid = F.tid, lane = F.lane, w = F.wave, l15 = lane & 15, q4 = lane >> 4;
    const int nunits = BH * 4 * NCH;
    for (int unit = F.bid; unit < nunits; unit += F.G) {
        const int c = unit % NCH, h = (unit / NCH) & 3, b = unit / (NCH * 4);
        const size_t tok0 = (size_t)b * SEQ + (size_t)c * 64;
        __syncthreads();
        for (int e = tid; e < 64 * 384; e += 512) { const int l = e / 384, cc = e % 384, part = cc >> 7, d = cc & 127, col = part * 512 + h * 128 + d;
            float acc = 0.f;
#pragma unroll
            for (int j = 0; j < 4; ++j) { const int tl = c * 64 + l - 3 + j; if (tl >= 0) acc += convw[j * 1536 + col] * bf2f(P[((size_t)b * SEQ + tl) * PW + C_GDN + col]); }
            (part == 0 ? qs : part == 1 ? ks : vs)[l * GS + d] = siluf_(acc); }
        if (tid < 64) { const size_t tok = tok0 + tid; beta[tid] = sigmoidf_(bf2f(P[tok * PW + C_GDN + 1536 + h]));
            float g = -expf(a_log[h]) * softplusf_(bf2f(P[tok * PW + C_GDN + 1540 + h]) + dtb[h]);
#pragma unroll
            for (int o = 1; o < 64; o <<= 1) { const float t = __shfl_up(g, o); if (lane >= o) g += t; }
            gc[tid] = g; egc[tid] = expf(g); }
        __syncthreads();
        for (int rr = 0; rr < 8; ++rr) { const int l = 8 * w + rr;
            const float q0 = qs[l * GS + lane], q1 = qs[l * GS + 64 + lane], k0 = ks[l * GS + lane], k1 = ks[l * GS + 64 + lane];
            const float sq = wave_sum(q0 * q0 + q1 * q1), sk = wave_sum(k0 * k0 + k1 * k1);
            const float iq = 0.08838834764831845f / sqrtf(sq + EPS), ik = 1.0f / sqrtf(sk + EPS);
            qs[l * GS + lane] = q0 * iq; qs[l * GS + 64 + lane] = q1 * iq; ks[l * GS + lane] = k0 * ik; ks[l * GS + 64 + lane] = k1 * ik; }
        __syncthreads();
        for (int tt = 0; tt < 4; ++tt) { const int tile = w * 4 + tt, which = tile >> 4, ti = (tile >> 2) & 3, tj = tile & 3;
            f32x4 acc = (f32x4){0.f, 0.f, 0.f, 0.f};
            if (tj <= ti) acc = tile_mm((which ? qs : ks) + 16 * ti * GS, GS, 1, ks + 16 * tj * GS, 1, GS, 128, acc, l15, q4);
            LAS float* dst = which ? QK : Lm;
#pragma unroll
            for (int r = 0; r < 4; ++r) { const int i = 16 * ti + 4 * q4 + r, j = 16 * tj + l15; float v = 0.f;
                if (which ? (j <= i) : (j < i)) v = acc[r] * expf(gc[i] - gc[j]) * (which ? 1.0f : beta[i]);
                dst[i * GS2 + j] = v; } }
        __syncthreads();
        float* rec = CHR + (size_t)unit * GDN_CHUNK_F;
        {
            const float glast = gc[63];
            for (int e = tid; e < 64 * 128; e += 512) { const int l = e >> 7, d = e & 127; rec[2 * 64 * 128 + e] = qs[l * GS + d] * egc[l]; rec[3 * 64 * 128 + e] = ks[l * GS + d] * expf(glast - gc[l]); }
            for (int e = tid; e < 64 * 64; e += 512) rec[4 * 64 * 128 + e] = QK[(e >> 6) * GS2 + (e & 63)];
            if (tid == 0) GL[unit] = expf(glast);
        }
        __syncthreads();
        for (int e = tid; e < 64 * 128; e += 512) { const int l = e >> 7, d = e & 127; vs[l * GS + d] *= beta[l]; qs[l * GS + d] = beta[l] * egc[l] * ks[l * GS + d]; }
        __syncthreads();
        for (int rb = 0; rb < 4; ++rb) {
            if (rb > 0) {
                LAS float* Xm = (w >> 2) ? qs : vs;
#pragma unroll
                for (int t2 = 0; t2 < 2; ++t2) { const int tj = 2 * (w & 3) + t2;
                    const f32x4 acc = tile_mm(Lm + 16 * rb * GS2, GS2, 1, Xm + 16 * tj, GS, 1, 16 * rb, (f32x4){0.f, 0.f, 0.f, 0.f}, l15, q4);
#pragma unroll
                    for (int r = 0; r < 4; ++r) Xm[(16 * rb + 4 * q4 + r) * GS + 16 * tj + l15] -= acc[r]; }
                __syncthreads();
            }
            if (tid < 256) { LAS float* Xm = (tid >> 7) ? qs : vs; const int col = tid & 127; float x[16];
#pragma unroll
                for (int i = 0; i < 16; ++i) { float sacc = Xm[(16 * rb + i) * GS + col];
#pragma unroll
                    for (int j = 0; j < i; ++j) sacc -= Lm[(16 * rb + i) * GS2 + 16 * rb + j] * x[j];
                    x[i] = sacc; }
#pragma unroll
                for (int i = 0; i < 16; ++i) Xm[(16 * rb + i) * GS + col] = x[i]; }
            __syncthreads();
        }
        for (int e = tid; e < 64 * 128; e += 512) { const int l = e >> 7, d = e & 127; rec[e] = vs[l * GS + d]; rec[64 * 128 + e] = qs[l * GS + d]; }
    }
    __syncthreads();
}
constexpr int GV = 36;
__device__ __forceinline__ void phase_gdn_g2(const Frame& F, const Args& A) {
    const float* CHR = WSP(float, G_CH); const float* GL = WSP(float, G_GL); float* GO = WSP(float, G_O);
    LAS float* S = (LAS float*)F.lds; LAS float* wl = S + 128 * GV; LAS float* qh = wl + 64 * GS; LAS float* kt = qh + 64 * GS; LAS float* qk = kt + 64 * GS; LAS float* vn = qk + 64 * GS2;
    const int tid = F.tid, lane = F.lane, w = F.wave, l15 = lane & 15, q4 = lane >> 4;
    const int nunits = BH * 4 * 4;
    for (int unit = F.bid; unit < nunits; unit += F.G) {
        const int vsl = unit & 3, h = (unit >> 2) & 3, b = unit >> 4;
        __syncthreads();
        for (int e = tid; e < 128 * GV; e += 512) S[e] = 0.f;
        for (int c = 0; c < NCH; ++c) {
            const int cu = (b * 4 + h) * NCH + c; const float* rec = CHR + (size_t)cu * GDN_CHUNK_F; const float egl = GL[cu];
            __syncthreads();
            for (int e = tid; e < 64 * 32; e += 512) { const int l = e >> 5, d4 = (e & 31) * 4;
                *(LAS f32x4*)(wl + l * GS + d4) = *(const f32x4*)(rec + 64 * 128 + l * 128 + d4);
                *(LAS f32x4*)(qh + l * GS + d4) = *(const f32x4*)(rec + 2 * 64 * 128 + l * 128 + d4);
                *(LAS f32x4*)(kt + l * GS + d4) = *(const f32x4*)(rec + 3 * 64 * 128 + l * 128 + d4); }
            for (int e = tid; e < 64 * 16; e += 512) { const int l = e >> 4, d4 = (e & 15) * 4; *(LAS f32x4*)(qk + l * GS2 + d4) = *(const f32x4*)(rec + 4 * 64 * 128 + l * 64 + d4); }
            __syncthreads();
            const int ti = w >> 1, tj = w & 1;
            {
                f32x4 acc = tile_mm(wl + 16 * ti * GS, GS, 1, S + 16 * tj, GV, 1, 128, (f32x4){0.f, 0.f, 0.f, 0.f}, l15, q4);
#pragma unroll
                for (int r = 0; r < 4; ++r) { const int l = 16 * ti + 4 * q4 + r; vn[l * GV + 16 * tj + l15] = rec[l * 128 + 32 * vsl + 16 * tj + l15] - acc[r]; }
            }
            __syncthreads();
            {
                f32x4 acc = tile_mm(qh + 16 * ti * GS, GS, 1, S + 16 * tj, GV, 1, 128, (f32x4){0.f, 0.f, 0.f, 0.f}, l15, q4);
                acc = tile_mm(qk + 16 * ti * GS2, GS2, 1, vn + 16 * tj, GV, 1, 64, acc, l15, q4);
#pragma unroll
                for (int r = 0; r < 4; ++r) { const size_t tok = (size_t)b * SEQ + (size_t)c * 64 + 16 * ti + 4 * q4 + r; GO[tok * 512 + h * 128 + 32 * vsl + 16 * tj + l15] = acc[r]; }
            }
            __syncthreads();
#pragma unroll
            for (int t2 = 0; t2 < 2; ++t2) {
                f32x4 acc;
#pragma unroll
                for (int r = 0; r < 4; ++r) acc[r] = S[(16 * w + 4 * q4 + r) * GV + 16 * t2 + l15] * egl;
                acc = tile_mm(kt + 16 * w, 1, GS, vn + 16 * t2, GV, 1, 64, acc, l15, q4);
#pragma unroll
                for (int r = 0; r < 4; ++r) S[(16 * w + 4 * q4 + r) * GV + 16 * t2 + l15] = acc[r];
            }
        }
    }
    __syncthreads();
}
__device__ __forceinline__ void phase_gdn_g3(const Frame& F, const Args& A, int layer) {
    const float* GO = WSP(float, G_O); const bf16* P = WSP(bf16, A_P); bf16* Y = WSP(bf16, A_Y) + (size_t)2 * TH * 512; const float* nw = A.in[22] + layer * 128;
    const int lane = F.lane, c0 = 8 * lane;
    for (int m = F.gw; m < TH; m += F.NGW) {
        const f32x4 a = *(const f32x4*)(GO + (size_t)m * 512 + c0), b2 = *(const f32x4*)(GO + (size_t)m * 512 + c0 + 4);
        float o[8] = {a.x, a.y, a.z, a.w, b2.x, b2.y, b2.z, b2.w}; float ss = 0.f;
#pragma unroll
        for (int q = 0; q < 8; ++q) ss += o[q] * o[q];
        ss += __shfl_xor(ss, 1); ss += __shfl_xor(ss, 2); ss += __shfl_xor(ss, 4); ss += __shfl_xor(ss, 8);
        const float rstd = 1.0f / sqrtf(ss * (1.0f / 128.0f) + EPS);
        const f32x4 z0 = ld_bf16x4(P + (size_t)m * PW + C_GDN + 1544 + c0), z1 = ld_bf16x4(P + (size_t)m * PW + C_GDN + 1544 + c0 + 4);
        const float z[8] = {z0.x, z0.y, z0.z, z0.w, z1.x, z1.y, z1.z, z1.w}; float y[8];
#pragma unroll
        for (int q = 0; q < 8; ++q) y[q] = o[q] * rstd * nw[(c0 + q) & 127] * siluf_(z[q]);
        u32x4 wv; wv.x = pk2(y[0], y[1]); wv.y = pk2(y[2], y[3]); wv.z = pk2(y[4], y[5]); wv.w = pk2(y[6], y[7]);
        *(u32x4*)(Y + (size_t)m * 512 + c0) = wv;
    }
}

__device__ __forceinline__ void phase_ssd_s1(const Frame& F, const Args& A, int layer) {
    const bf16* P = WSP(bf16, A_P); float* ST = WSP(float, S_ST); float* YD = WSP(float, S_YD); float* SC = WSP(float, S_C); float* AC = WSP(float, S_AC);
    const float* cw = A.in[23] + (size_t)layer * 4 * 1024; const float* cb = A.in[24] + layer * 1024; const float* dtb = A.in[25] + layer * 8; const float* a_log = A.in[26] + layer * 8; const float* dsk = A.in[27] + layer * 8;
    LAS float* X = (LAS float*)F.lds; LAS float* Bm = X + 64 * GS2; LAS float* Cm = Bm + 64 * GS; LAS float* M = Cm + 64 * GS; LAS float* Xd = M + 64 * GS2; LAS float* dt = Xd + 64 * GS2; LAS float* ac = dt + 64;
    const int tid = F.tid, lane = F.lane, w = F.wave, l15 = lane & 15, q4 = lane >> 4;
    const int nunits = BH * NCH * 8;
    for (int unit = F.bid; unit < nunits; unit += F.G) {
        const int h = unit & 7, c = (unit >> 3) % NCH, b = unit / (8 * NCH), g = h >> 2;
        const size_t tok0 = (size_t)b * SEQ + (size_t)c * 64;
        __syncthreads();
        for (int e = tid; e < 64 * 320; e += 512) { const int l = e / 320, cc = e % 320;
            const int cidx = cc < 64 ? h * 64 + cc : cc < 192 ? 512 + g * 128 + (cc - 64) : 768 + g * 128 + (cc - 192);
            float acc = cb[cidx];
#pragma unroll
            for (int j = 0; j < 4; ++j) { const int tl = c * 64 + l - 3 + j; if (tl >= 0) acc += cw[j * 1024 + cidx] * bf2f(P[((size_t)b * SEQ + tl) * PW + C_SSD + 512 + cidx]); }
            const float v = siluf_(acc);
            if (cc < 64) X[l * GS2 + cc]  = v; else if (cc < 192) Bm[l * GS + (cc - 64)] = v; else Cm[l * GS + (cc - 192)] = v; }
        if (tid < 64) { const float d = softplusf_(bf2f(P[(tok0 + tid) * PW + C_SSD + 1536 + h]) + dtb[h]); float a = -expf(a_log[h]) * d;
#pragma unroll
            for (int o = 1; o < 64; o <<= 1) { const float t = __shfl_up(a, o); if (lane >= o) a += t; }
            dt[tid] = d; ac[tid] = a; AC[(tok0 + tid) * 8 + h] = a; }
        __syncthreads();
        for (int tt = 0; tt < 2; ++tt) { const int tile = w * 2 + tt, ti = tile >> 2, tj = tile & 3; f32x4 acc = (f32x4){0.f, 0.f, 0.f, 0.f};
            if (tj <= ti) acc = tile_mm(Cm + 16 * ti * GS, GS, 1, Bm + 16 * tj * GS, 1, GS, 128, acc, l15, q4);
#pragma unroll
            for (int r = 0; r < 4; ++r) { const int l = 16 * ti + 4 * q4 + r, s = 16 * tj + l15; M[l * GS2 + s] = (s <= l) ? acc[r] * expf(ac[l] - ac[s]) * dt[s] : 0.f; } }
        for (int e = tid; e < 64 * 64; e += 512) { const int l = e >> 6, p = e & 63; Xd[l * GS2 + p] = X[l * GS2 + p] * dt[l] * expf(ac[63] - ac[l]); }
        if ((h & 3) == 0) for (int e = tid; e < 64 * 128; e += 512) { const int l = e >> 7, n = e & 127; SC[(tok0 + l) * 256 + g * 128 + n] = Cm[l * GS + n]; }
        __syncthreads();
        for (int tt = 0; tt < 2; ++tt) { const int tile = w * 2 + tt, ti = tile >> 2, tj = tile & 3;
            const f32x4 acc = tile_mm(M + 16 * ti * GS2, GS2, 1, X + 16 * tj, GS2, 1, 64, (f32x4){0.f, 0.f, 0.f, 0.f}, l15, q4);
#pragma unroll
            for (int r = 0; r < 4; ++r) { const int l = 16 * ti + 4 * q4 + r, p = 16 * tj + l15; YD[(tok0 + l) * 512 + h * 64 + p] = acc[r] + dsk[h] * X[l * GS2 + p]; } }
        float* st = ST + (size_t)unit * 64 * 128;
        for (int tt = 0; tt < 4; ++tt) { const int tile = w * 4 + tt, ti = tile >> 3, tj = tile & 7;
            const f32x4 acc = tile_mm(Xd + 16 * ti, 1, GS2, Bm + 16 * tj, GS, 1, 64, (f32x4){0.f, 0.f, 0.f, 0.f}, l15, q4);
#pragma unroll
            for (int r = 0; r < 4; ++r) st[(16 * ti + 4 * q4 + r) * 128 + 16 * tj + l15] = acc[r]; }
    }
    __syncthreads();
}
__device__ __forceinline__ void phase_ssd_s2(const Frame& F, const Args& A) {
    float* ST = WSP(float, S_ST); const float* AC = WSP(float, S_AC);
    for (int idx = F.bid * 512 + F.tid; idx < BH * 8 * 8192; idx += F.G * 512) { const int e = idx & 8191, h = (idx >> 13) & 7, b = idx >> 16;
        float Hs = 0.f;
        for (int c = 0; c < NCH; ++c) { float* p = ST + ((size_t)((b * NCH + c) * 8 + h)) * 8192 + e; const float tmp = *p; *p = Hs;
            Hs = expf(AC[((size_t)b * SEQ + c * 64 + 63) * 8 + h]) * Hs + tmp; } }
}
__device__ __forceinline__ void phase_ssd_s3(const Frame& F, const Args& A) {
    const float* ST = WSP(float, S_ST); float* YD = WSP(float, S_YD); const float* SC = WSP(float, S_C); const float* AC = WSP(float, S_AC);
    LAS float* Cm = (LAS float*)F.lds; LAS float* Hs = Cm + 64 * GS;
    const int tid = F.tid, lane = F.lane, w = F.wave, l15 = lane & 15, q4 = lane >> 4;
    const int nunits = BH * NCH * 8;
    for (int unit = F.bid; unit < nunits; unit += F.G) {
        const int h = unit & 7, c = (unit >> 3) % NCH, b = unit / (8 * NCH), g = h >> 2;
        const size_t tok0 = (size_t)b * SEQ + (size_t)c * 64; const float* st = ST + (size_t)unit * 8192;
        __syncthreads();
        for (int e = tid; e < 64 * 32; e += 512) { const int l = e >> 5, d4 = (e & 31) * 4;
            *(LAS f32x4*)(Cm + l * GS + d4) = *(const f32x4*)(SC + (tok0 + l) * 256 + g * 128 + d4); *(LAS f32x4*)(Hs + l * GS + d4) = *(const f32x4*)(st + l * 128 + d4); }
        __syncthreads();
        for (int tt = 0; tt < 2; ++tt) { const int tile = w * 2 + tt, ti = tile >> 2, tj = tile & 3;
            const f32x4 acc = tile_mm(Cm + 16 * ti * GS, GS, 1, Hs + 16 * tj * GS, 1, GS, 128, (f32x4){0.f, 0.f, 0.f, 0.f}, l15, q4);
#pragma unroll
            for (int r = 0; r < 4; ++r) { const int l = 16 * ti + 4 * q4 + r, p = 16 * tj + l15; const size_t o = (tok0 + l) * 512 + h * 64 + p; YD[o] += acc[r] * expf(AC[(tok0 + l) * 8 + h]); } }
    }
    __syncthreads();
}
__device__ __forceinline__ void phase_ssd_s4(const Frame& F, const Args& A, int layer) {
    const float* YD = WSP(float, S_YD); const bf16* P = WSP(bf16, A_P); bf16* Y = WSP(bf16, A_Y) + (size_t)3 * TH * 512; const float* nw = A.in[28] + layer * 512;
    const int lane = F.lane, c0 = 8 * lane;
    for (int m = F.gw; m < TH; m += F.NGW) {
        const f32x4 a = *(const f32x4*)(YD + (size_t)m * 512 + c0), b2 = *(const f32x4*)(YD + (size_t)m * 512 + c0 + 4);
        const f32x4 z0 = ld_bf16x4(P + (size_t)m * PW + C_SSD + c0), z1 = ld_bf16x4(P + (size_t)m * PW + C_SSD + c0 + 4);
        float y[8] = {a.x * siluf_(z0.x), a.y * siluf_(z0.y), a.z * siluf_(z0.z), a.w * siluf_(z0.w), b2.x * siluf_(z1.x), b2.y * siluf_(z1.y), b2.z * siluf_(z1.z), b2.w * siluf_(z1.w)};
        float ss = 0.f;
#pragma unroll
        for (int q = 0; q < 8; ++q) ss += y[q] * y[q];
        ss += __shfl_xor(ss, 1); ss += __shfl_xor(ss, 2); ss += __shfl_xor(ss, 4); ss += __shfl_xor(ss, 8); ss += __shfl_xor(ss, 16);
        const float rstd = 1.0f / sqrtf(ss * (1.0f / 256.0f) + EPS);
#pragma unroll
        for (int q = 0; q < 8; ++q) y[q] = y[q] * rstd * nw[c0 + q];
        u32x4 wv; wv.x = pk2(y[0], y[1]); wv.y = pk2(y[2], y[3]); wv.z = pk2(y[4], y[5]); wv.w = pk2(y[6], y[7]);
        *(u32x4*)(Y + (size_t)m * 512 + c0) = wv;
    }
}

__device__ __forceinline__ void phase_merge_z(const Frame& F, const Args& A) {
    for (int i = 0; i < 4; ++i) {
        pg8::Gemm g{WSP(bf16, A_Y) + (size_t)i * TH * 512, WSP(bf16, W_BR) + (size_t)i * D * 512, 512, 512}; pg8::StaticOrder S; S.init(TH, D, F.G, F.bid);
        EpiBf16 E{WSP(bf16, A_Z) + i * D, 4096, nullptr, 0}; pg8::gemm_phase(F.lds, g, S, E, F.tid);
        __syncthreads();
    }
}
__device__ __forceinline__ void phase_merge_gate(const Frame& F, const Args& A, int layer) {
    pg8::Gemm g{WSP(bf16, A_H), WSP(bf16, W_GATE), D, D}; pg8::StaticOrder S; S.init(TH, 4096, F.G, F.bid);
    EpiMerge E{WSP(bf16, A_Z), A.in[29] + (size_t)layer * 4 * D, WSP(bf16, A_MG)}; pg8::gemm_phase(F.lds, g, S, E, F.tid);
}
__device__ __forceinline__ void phase_merge_out(const Frame& F, const Args& A, const float* xin, float* xout) {
    pg8::Gemm g{WSP(bf16, A_MG), WSP(bf16, W_OUT), D, D}; pg8::StaticOrder S; S.init(TH, D, F.G, F.bid);
    EpiResidual E{xin, xout}; pg8::gemm_phase(F.lds, g, S, E, F.tid);
}
__device__ __forceinline__ void phase_ffn_gu(const Frame& F, const Args& A) {
    pg8::Gemm g{WSP(bf16, A_H), WSP(bf16, W_FGU), D, D}; pg8::StaticOrder S; S.init(TH, 2 * FF_D, F.G, F.bid);
    EpiSwiGLU E{WSP(bf16, F_ACT), FF_D, 1 << 20}; pg8::gemm_phase(F.lds, g, S, E, F.tid);
}
__device__ __forceinline__ void phase_ffn_down(const Frame& F, const Args& A, float* x) {
    pg8::Gemm g{WSP(bf16, F_ACT), WSP(bf16, W_FDN), FF_D, FF_D}; pg8::StaticOrder S; S.init(TH, D, F.G, F.bid);
    EpiResidual E{x, x}; pg8::gemm_phase(F.lds, g, S, E, F.tid);
}
struct MoeLayout { int pstart[NEXP + 1]; };
__device__ __forceinline__ MoeLayout moe_layout(const unsigned* cnt) {
    MoeLayout L; int s = 0;
#pragma unroll
    for (int e = 0; e < NEXP; ++e) { L.pstart[e] = s; s += ((int)cnt[e] + 255) & ~255; }
    L.pstart[NEXP] = s; return L;
}
struct MoeOrder {
    int np, nN, G, c; MoeLayout L;
    __device__ bool next(int i, Unit& u) const {
        const long Lx = (long)i * G + c; if (Lx >= (long)np * nN) return false;
        const int pm = (int)(Lx / nN), pn = (int)(Lx % nN); int e = 0;
#pragma unroll
        for (int k = 1; k < NEXP; ++k) if (pm * 256 >= L.pstart[k]) e = k;
        u.pm = pm; u.pn = e * nN + pn; return true;
    }
    __device__ __forceinline__ void a_ready(const Unit&) const {}
    __device__ __forceinline__ void done(const Unit&) const {}
};
__device__ __forceinline__ void phase_moe_route(const Frame& F, const Args& A, int half) {
    const unsigned* cnt = F.ctl + CW_CNT + half * 16; unsigned* fill = F.ctl + CW_FILL + half * 16;
    const MoeLayout L = moe_layout(cnt);
    const bf16* H = WSP(bf16, A_H); bf16* GA = WSP(bf16, F_GA); const int* tope = WSP(int, F_TOPE); int* slot = WSP(int, F_SLOT);
    const int lane = F.lane;
    for (int m = F.gw; m < TH; m += F.NGW) {
        const u32x4 v0 = *(const u32x4*)(H + (size_t)m * D + 8 * lane), v1 = *(const u32x4*)(H + (size_t)m * D + 512 + 8 * lane);
#pragma unroll
        for (int k = 0; k < 2; ++k) { const int e = tope[2 * m + k]; int s = 0;
            int ps = 0;
#pragma unroll
            for (int q = 0; q < NEXP; ++q) ps = (e == q) ? L.pstart[q] : ps;
            if (lane == 0) s = ps + (int)ATOMIC_ADD_U32(fill + e, 1u);
            s = __shfl(s, 0);
            if (lane == 0) slot[2 * m + k] = s;
            *(u32x4*)(GA + (size_t)s * D + 8 * lane) = v0; *(u32x4*)(GA + (size_t)s * D + 512 + 8 * lane) = v1; }
    }
#pragma unroll
    for (int e = 0; e < NEXP; ++e) { const int r0 = L.pstart[e] + (int)cnt[e], r1 = L.pstart[e + 1];
        for (int r = r0 + F.gw; r < r1; r += F.NGW) { *(u32x4*)(GA + (size_t)r * D + 8 * lane) = (u32x4){0u, 0u, 0u, 0u}; *(u32x4*)(GA + (size_t)r * D + 512 + 8 * lane) = (u32x4){0u, 0u, 0u, 0u}; } }
}
__device__ __forceinline__ void phase_moe_gu(const Frame& F, const Args& A, int half) {
    MoeOrder S; S.L = moe_layout(F.ctl + CW_CNT + half * 16); S.np = S.L.pstart[NEXP] / 256; S.nN = 2 * FF_E / 256; S.G = F.G; S.c = F.bid;
    pg8::Gemm g{WSP(bf16, F_GA), WSP(bf16, W_FGU), D, D}; EpiSwiGLU E{WSP(bf16, F_ACT), FF_E, 2 * FF_E / 256}; pg8::gemm_phase(F.lds, g, S, E, F.tid);
}
struct EpiF32Mod {
    static constexpr bool PERM = false, AFTER_DRAIN = false;
    float* C;
    __device__ __forceinline__ void operator()(const f32x4 (&acc)[2][2][4][2], const Unit& u, int wr, int wc, int fr, int fq) const {
        const int row0 = u.pm * 256 + wr * 64 + fr, col0 = (u.pn & 3) * 256 + wc * 32 + 4 * fq;
#pragma unroll
        for (int ai = 0; ai < 2; ++ai)
#pragma unroll
            for (int m = 0; m < 4; ++m) { float* rowp = C + (size_t)(row0 + ai * HALFT + m * 16) * D + col0;
#pragma unroll
                for (int bj = 0; bj < 2; ++bj)
#pragma unroll
                    for (int n = 0; n < 2; ++n) *(f32x4*)(rowp + bj * HALFT + n * 16) = acc[ai][bj][m][n]; }
    }
};
__device__ __forceinline__ void phase_moe_down(const Frame& F, const Args& A, int half) {
    MoeOrder S; S.L = moe_layout(F.ctl + CW_CNT + half * 16); S.np = S.L.pstart[NEXP] / 256; S.nN = D / 256; S.G = F.G; S.c = F.bid;
    pg8::Gemm g{WSP(bf16, F_ACT), WSP(bf16, W_FDN), FF_E, FF_E}; EpiF32Mod E{WSP(float, F_YE)}; pg8::gemm_phase(F.lds, g, S, E, F.tid);
}
__device__ __forceinline__ void phase_moe_combine(const Frame& F, const Args& A, float* x) {
    const float* YE = WSP(float, F_YE); const int* slot = WSP(int, F_SLOT); const float* topw = WSP(float, F_TOPW); const int lane = F.lane;
    for (int m = F.gw; m < TH; m += F.NGW) { const int s0 = slot[2 * m], s1 = slot[2 * m + 1]; const float w0 = topw[2 * m], w1 = topw[2 * m + 1];
#pragma unroll
        for (int j = 0; j < 4; ++j) { const int c = 4 * lane + 256 * j; float* xp = x + (size_t)m * D + c;
            *(f32x4*)xp = *(const f32x4*)xp + *(const f32x4*)(YE + (size_t)s0 * D + c) * w0 + *(const f32x4*)(YE + (size_t)s1 * D + c) * w1; } }
}

#ifndef EMU
#define XB_TMO      128
#define XB_XCNT(j)  (256  + 64 * (j))
#define XB_XSUB(j)  (1280 + 64 * (j))
#define XB_XGEN(j)  (2304 + 64 * (j))
#define XB_TOP      3328
#define XB_TOPGEN   3392
#define XCD_BAR_WORDS 3456
#define XB_SPIN_CAP (1u << 22)
__device__ __forceinline__ unsigned xb_ld(unsigned* p)              { return __hip_atomic_load(p, __ATOMIC_RELAXED, __HIP_MEMORY_SCOPE_AGENT); }
__device__ __forceinline__ unsigned xb_add(unsigned* p, unsigned v) { return __hip_atomic_fetch_add(p, v, __ATOMIC_RELAXED, __HIP_MEMORY_SCOPE_AGENT); }
__device__ __forceinline__ unsigned xb_xcc_id() { return (unsigned)__builtin_amdgcn_s_getreg((3 << 11) | 20) & 0xFu; }
#define XB_SPIN(cond, bar) do { unsigned _sp = 0; while (cond) { __builtin_amdgcn_s_sleep(1); \
    if ((++_sp & 255u) == 0u) { if (xb_ld(&(bar)[XB_TMO])) break; if (_sp > XB_SPIN_CAP) { atomicAdd(&(bar)[XB_TMO], 1u); break; } } } } while (0)
struct XcdBarrier { unsigned* bar; unsigned x; volatile LAS unsigned* st; };
__device__ __forceinline__ XcdBarrier xcd_barrier_post(unsigned* bar, volatile LAS unsigned* st) {
    XcdBarrier b; b.bar = bar; b.x = xb_xcc_id(); b.st = st;
    if (threadIdx.x == 0) (void)xb_add(&bar[XB_XCNT(b.x)], 1u);
    return b;
}
__device__ __forceinline__ void xcd_barrier_complete(unsigned* bar, unsigned x, unsigned& nloc, unsigned& nx) {
    const unsigned G = gridDim.x * gridDim.y * gridDim.z;
    unsigned sum, cnt, mine, sp = 0u;
    for (;;) {
        sum = 0u; cnt = 0u; mine = 0u;
#pragma unroll
        for (unsigned j = 0; j < 16; ++j) { const unsigned c = xb_ld(&bar[XB_XCNT(j)]); sum += c; cnt += (c > 0u) ? 1u : 0u; mine = (j == x) ? c : mine; }
        if (sum == G) break;
        __builtin_amdgcn_s_sleep(1);
        if ((++sp & 255u) == 0u) { if (xb_ld(&bar[XB_TMO])) break; if (sp > XB_SPIN_CAP) { atomicAdd(&bar[XB_TMO], 1u); break; } }
    }
    nloc = mine > 0u ? mine : 1u; nx = cnt > 0u ? cnt : 1u;
}
__device__ __forceinline__ void xcd_barrier(const XcdBarrier& b) {
    asm volatile("s_waitcnt vmcnt(0)" ::: "memory");
    __syncthreads();
    if (threadIdx.x == 0) {
        unsigned* bar = b.bar;
        __builtin_amdgcn_s_waitcnt(0);
        unsigned nloc = b.st[0], nx = b.st[1];
        if (nloc == 0u) { xcd_barrier_complete(bar, b.x, nloc, nx); b.st[0] = nloc; b.st[1] = nx; }
        const unsigned old = xb_add(&bar[XB_XSUB(b.x)], 1u);
        const unsigned gen = old / nloc;
        if (old + 1u == (gen + 1u) * nloc) {
            __builtin_amdgcn_fence(__ATOMIC_RELEASE, "agent");
            asm volatile("s_waitcnt vmcnt(0)" ::: "memory");
            const unsigned og = xb_add(&bar[XB_TOP], 1u);
            const unsigned tg = og / nx;
            if (og + 1u == (tg + 1u) * nx) xb_add(&bar[XB_TOPGEN], 1u);
            else XB_SPIN(xb_ld(&bar[XB_TOPGEN]) == tg, bar);
            __builtin_amdgcn_fence(__ATOMIC_ACQUIRE, "agent");
            xb_add(&bar[XB_XGEN(b.x)], 1u);
            asm volatile("s_waitcnt vmcnt(0)" ::: "memory");
        } else {
            XB_SPIN(xb_ld(&bar[XB_XGEN(b.x)]) == gen, bar);
            __builtin_amdgcn_fence(__ATOMIC_ACQUIRE, "agent");
            asm volatile("s_waitcnt vmcnt(0)" ::: "memory");
        }
    }
    __syncthreads();
}
#endif

constexpr int NPH = 25;
constexpr int NPHASES = DEPTH * (1 + NHALF * NPH) + 1;
constexpr int LDS_BYTES = 155648, MISC_OFF = 154624;

__global__ void __launch_bounds__(512, 2) fwd_kernel(Args args_k) {
#ifdef EMU
    unsigned char* lds = emu_lds_ptr;
#else
    extern __shared__ __attribute__((aligned(16))) unsigned char lds[];
#endif
    Frame F0;
    F0.lds = (LAS unsigned char*)lds; F0.tid = threadIdx.x; F0.lane = F0.tid & 63; F0.wave = RFL(F0.tid >> 6); F0.G = gridDim.x; F0.bid = blockIdx.x;
    F0.gw = F0.bid * 8 + F0.wave; F0.NGW = F0.G * 8;
    F0.out = args_k.out; F0.ws = args_k.ws; F0.ctl = (unsigned*)(args_k.ws + WS_CTL);
    const int lo = args_k.lo, hi = args_k.hi;
#ifndef EMU
    volatile LAS unsigned* misc = (volatile LAS unsigned*)(F0.lds + MISC_OFF);
    if (F0.tid < 4) misc[F0.tid] = 0u;
    __syncthreads();
    XcdBarrier bar; bar.bar = F0.ctl + CW_BAR; bar.x = 0; bar.st = misc;
    if (hi - lo > 1) bar = xcd_barrier_post(F0.ctl + CW_BAR, misc);
#define GRID_BAR() do { XcdBarrier bq = bar; asm volatile("" : "+s"(bq.bar), "+s"(bq.x)); xcd_barrier(bq); } while (0)
#else
#define GRID_BAR() do { } while (0)
#endif
    int ph = 0;
#ifndef PH_MASK
#define PH_MASK 0xFFFFFFFFFFFFFFFFull
#endif
#define PHASE(...) PHASE_I(0, __VA_ARGS__)
#ifdef EMU
#define LAUNDER(Fq) do { } while (0)
#else
#define LAUNDER(Fq) do { unsigned mq_ = ~0u; asm volatile("" : "+s"(Fq.G), "+s"(Fq.bid), "+s"(Fq.wave), "+s"(Fq.ws), "+s"(Fq.out), "+s"(Fq.ctl), "+s"(mq_)); Fq.lane = (int)__builtin_amdgcn_mbcnt_hi(mq_, __builtin_amdgcn_mbcnt_lo(mq_, 0u)); Fq.tid = Fq.wave * 64 + Fq.lane; Fq.gw = Fq.bid * 8 + Fq.wave; Fq.NGW = Fq.G * 8; } while (0)
#endif
#ifdef EMU
#define ARGS_Q() const Args& args_q = args_k
#else
#define ARGS_Q() const __attribute__((address_space(4))) Args* aq_ = (const __attribute__((address_space(4))) Args*)__builtin_amdgcn_kernarg_segment_ptr(); asm volatile("" : "+s"(aq_)); const Args& args_q = *(const Args*)aq_
#endif
#define PHASE_I(id, ...) do { if (ph >= lo && ph < hi) { { Frame Fq = F0; LAUNDER(Fq); const Frame& F = Fq; ARGS_Q(); const Args& args = args_q; __VA_ARGS__; } if (ph + 1 < hi) GRID_BAR(); } ++ph; } while (0)
#define SEGMENT(layer, half) do { \
            const size_t r0 = (size_t)(half) * TH; \
            const float* xin = ((layer) == 0 ? args_k.in[0] : F0.out) + r0 * D; float* xo = F0.out + r0 * D; \
            PHASE(phase_norm<false>(F, args, xin, args.in[2] + (layer) * D, WSP(bf16, A_H), nullptr, nullptr, nullptr, nullptr); phase_rope_table(F, args, (const int*)args.in[1] + r0, WSP(float, A_ROPE))); \
            PHASE({ pg8::Gemm g{WSP(bf16, A_H), WSP(bf16, W_IN), D, D}; pg8::StaticOrder S; S.init(TH, PW, F.G, F.bid); EpiBf16 E{WSP(bf16, A_P), PW, nullptr, 0}; pg8::gemm_phase(F.lds, g, S, E, F.tid); }); \
            PHASE(phase_mla_prep(F, args)); \
            PHASE(phase_mla_q(F, args)); \
            PHASE(phase_mla_kv(F, args)); \
            PHASE(phase_attention(F, args)); \
            PHASE(phase_rwkv_prep(F, args, layer)); \
            PHASE(phase_rwkv_lora(F, args)); \
            PHASE(phase_rwkv_scan(F, args, layer)); \
            PHASE(phase_rwkv_post(F, args, layer)); \
            PHASE(phase_gdn_g1(F, args, layer)); \
            PHASE(phase_gdn_g2(F, args)); \
            PHASE(phase_gdn_g3(F, args, layer)); \
            PHASE(phase_ssd_s1(F, args, layer)); \
            PHASE(phase_ssd_s2(F, args)); \
            PHASE(phase_ssd_s3(F, args)); \
            PHASE(phase_ssd_s4(F, args, layer)); \
            PHASE(phase_merge_z(F, args)); \
            PHASE(phase_merge_gate(F, args, layer)); \
            PHASE(phase_merge_out(F, args, xin, xo)); \
            if ((layer) == 0) { \
                PHASE(phase_norm<false>(F, args, xo, args.in[32] + (layer) * D, WSP(bf16, A_H), nullptr, nullptr, nullptr, nullptr)); \
                PHASE(phase_ffn_gu(F, args)); \
                PHASE(phase_ffn_down(F, args, xo)); \
                PHASE((void)0); \
                PHASE((void)0); \
            } else { \
                PHASE(phase_norm<true>(F, args, xo, args.in[32] + (layer) * D, WSP(bf16, A_H), args.in[35], WSP(int, F_TOPE), WSP(float, F_TOPW), F.ctl + CW_CNT + (half) * 16)); \
                PHASE(phase_moe_route(F, args, half)); \
                PHASE(phase_moe_gu(F, args, half)); \
                PHASE(phase_moe_down(F, args, half)); \
                PHASE(phase_moe_combine(F, args, xo)); \
            } } while (0)
    static_assert(DEPTH == 2 && NHALF <= 2, "segment program");
    PHASE(phase_convert(F, args, 0));
    SEGMENT(0, 0);
    if (NHALF == 2) SEGMENT(0, 1);
    PHASE(phase_convert(F, args, 1));
    SEGMENT(1, 0);
    if (NHALF == 2) SEGMENT(1, 1);
#undef SEGMENT
    PHASE(phase_final_norm(F, args, F.out, args.in[38]));
#undef PHASE
}

#ifndef ONE_LAUNCH
#define ONE_LAUNCH 0
#endif
extern "C" void kernel_launch(void* const* d_in, const int* in_sizes, int n_in, void* d_out, int out_size, void* d_ws, size_t ws_size, hipStream_t stream) {
    static int grid = 0;
    if (grid == 0) {
#ifdef EMU
        grid = EMU_GRID;
#else
        if (n_in != 39 || out_size != T * D || ws_size < WS_NEED) { fprintf(stderr, "kernel_launch: unexpected problem (n_in %d out %d ws %zu need %zu)\n", n_in, out_size, ws_size, (size_t)WS_NEED); grid = -1; return; }
        int dev = 0, cus = 0;
        if (hipGetDevice(&dev) != hipSuccess || hipDeviceGetAttribute(&cus, hipDeviceAttributeMultiprocessorCount, dev) != hipSuccess) { grid = -1; return; }
        if (hipFuncSetAttribute((const void*)fwd_kernel, hipFuncAttributeMaxDynamicSharedMemorySize, LDS_BYTES) != hipSuccess) { fprintf(stderr, "kernel_launch: hipFuncSetAttribute failed\n"); grid = -1; return; }
        int per_cu = 0;
        if (hipOccupancyMaxActiveBlocksPerMultiprocessor(&per_cu, (const void*)fwd_kernel, 512, LDS_BYTES) != hipSuccess || per_cu < 1) fprintf(stderr, "kernel_launch: occupancy query reports %d\n", per_cu);
        (void)hipGetLastError();
        grid = cus;
#endif
    }
    if (grid < 0) return;
    (void)hipMemsetAsync((char*)d_ws + WS_CTL, 0, CTL_BYTES, stream);
    Args a{};
    for (int i = 0; i < 39; ++i) a.in[i] = (const float*)d_in[i];
    a.out = (float*)d_out; a.ws = (unsigned char*)d_ws;
#ifdef EMU
    for (int p = EMU_PH_LO; p < EMU_PH_HI && p < NPHASES; ++p) { a.lo = p; a.hi = p + 1; emu_launch(fwd_kernel, grid, 512, a); emu_after_phase(p); }
#else
#if ONE_LAUNCH
    a.lo = 0; a.hi = NPHASES;
    hipLaunchKernelGGL(fwd_kernel, dim3(grid), dim3(512), LDS_BYTES, stream, a);
#else
    for (int p = 0; p < NPHASES; ++p) { a.lo = p; a.hi = p + 1; hipLaunchKernelGGL(fwd_kernel, dim3(grid), dim3(512), LDS_BYTES, stream, a); }
#endif
#endif
}
```

```cpp
#ifndef EMU
#include <hip/hip_runtime.h>
#include <cstdio>
#include <cstdint>
#endif

#ifdef EMU
constexpr int BATCH = EMU_B, SEQ = EMU_S, NHALF = EMU_NHALF;
#else
constexpr int BATCH = 16, SEQ = 2048, NHALF = 2;
#endif
constexpr int D = 1024, DEPTH = 2, CH = 64;
constexpr int T = BATCH * SEQ, TH = T / NHALF, BH = BATCH / NHALF, NCH = SEQ / CH;
constexpr int C_MLA = 0, C_RWKV = 704, C_GDN = 2528, C_SSD = 4584, C_GATE = 6128, IN_COLS = 10224, PW = 6144;
constexpr int FF_D = 2816, FF_E = 3584, NEXP = 8;
constexpr int MOE_ROWS = ((TH * 2 + NEXP * 255) / 256) * 256;
constexpr float EPS = 1e-6f;
static_assert(TH % 256 == 0 && SEQ % 128 == 0 && BATCH % NHALF == 0, "shape");

typedef unsigned short bf16;
typedef float f32x4 __attribute__((ext_vector_type(4)));
typedef float f32x2 __attribute__((ext_vector_type(2)));
typedef short bf16x8 __attribute__((ext_vector_type(8)));
typedef short bf16x4 __attribute__((ext_vector_type(4)));
typedef unsigned u32x4 __attribute__((ext_vector_type(4)));
typedef unsigned u32x2 __attribute__((ext_vector_type(2)));
#ifdef EMU
#define LAS
#define GAS
#define MFMA_F32(a, b, c) emu_mfma_16x16x4f32(a, b, c)
#define MFMA_BF16(a, b, c) emu_mfma_16x16x32bf16(a, b, c)
#define ATOMIC_ADD_U32(p, v) emu_atomic_add_u32(p, v)
#define RFL(x) (x)
#define LDS_WAIT()
#define VM_WAIT()
__device__ __forceinline__ float fast_exp(float x) { return expf(x); }
__device__ __forceinline__ float fast_rcp(float x) { return 1.0f / x; }
__device__ __forceinline__ float fast_rsqrt(float x) { return 1.0f / sqrtf(x); }
#else
#define LAS __attribute__((address_space(3)))
#define GAS __attribute__((address_space(1)))
#define MFMA_F32(a, b, c) __builtin_amdgcn_mfma_f32_16x16x4f32(a, b, c, 0, 0, 0)
#define MFMA_BF16(a, b, c) __builtin_amdgcn_mfma_f32_16x16x32_bf16(a, b, c, 0, 0, 0)
#define ATOMIC_ADD_U32(p, v) __hip_atomic_fetch_add(p, v, __ATOMIC_RELAXED, __HIP_MEMORY_SCOPE_AGENT)
#define RFL(x) __builtin_amdgcn_readfirstlane(x)
#define LDS_WAIT() asm volatile("s_waitcnt lgkmcnt(0)" ::: "memory")
#define VM_WAIT() asm volatile("s_waitcnt vmcnt(0)" ::: "memory")
__device__ __forceinline__ float fast_exp(float x) { return __expf(x); }
__device__ __forceinline__ float fast_rcp(float x) { return __builtin_amdgcn_rcpf(x); }
__device__ __forceinline__ float fast_rsqrt(float x) { return __builtin_amdgcn_rsqf(x); }
#endif
__device__ __forceinline__ unsigned f2u(float f) { return __builtin_bit_cast(unsigned, f); }
__device__ __forceinline__ float u2f(unsigned u) { return __builtin_bit_cast(float, u); }
__device__ __forceinline__ unsigned f2bf(float f) { unsigned u = f2u(f); return (u + 0x7fffu + ((u >> 16) & 1u)) >> 16; }
__device__ __forceinline__ float bf2f(unsigned h) { return u2f(h << 16); }
__device__ __forceinline__ unsigned pk2(float lo, float hi) { return f2bf(lo) | (f2bf(hi) << 16); }
__device__ __forceinline__ float sigmoidf_(float x) { return 1.0f / (1.0f + expf(-x)); }
__device__ __forceinline__ float siluf_(float x) { return x / (1.0f + expf(-x)); }
__device__ __forceinline__ float softplusf_(float x) { return x > 20.f ? x : log1pf(expf(x)); }
__device__ __forceinline__ float wave_sum(float v) {
#pragma unroll
    for (int o = 1; o < 64; o <<= 1) v += __shfl_xor(v, o);
    return v;
}
__device__ __forceinline__ float wave_max(float v) {
#pragma unroll
    for (int o = 1; o < 64; o <<= 1) v = fmaxf(v, __shfl_xor(v, o));
    return v;
}
__device__ __forceinline__ f32x4 ld_bf16x4(const bf16* p) { const u32x2 w = *(const u32x2*)p; return (f32x4){bf2f(w.x & 0xffffu), bf2f(w.x >> 16), bf2f(w.y & 0xffffu), bf2f(w.y >> 16)}; }
__device__ __forceinline__ void st_bf16x4(bf16* p, f32x4 v) { u32x2 w; w.x = pk2(v.x, v.y); w.y = pk2(v.z, v.w); *(u32x2*)p = w; }

namespace pg8 {
#define PG8_LAS LAS
typedef unsigned short bf16_t;
constexpr int BM = 256, BK = 64, HALF = 128, HTB = HALF * BK * 2, STAGE_BYTES = 8 * HTB, NXCD = 8, WGM = 8;
__host__ __device__ __forceinline__ int lds_byte(int r, int c) { const int st = (r >> 4) * 2 + (c >> 5), rr = r & 15, cc = c & 31, ob = rr * 64 + cc * 2; return st * 1024 + (ob ^ (((ob >> 9) & 1) << 5)); }
__host__ __device__ __forceinline__ void stage_rc(int b, int& R, int& C) { const int st = b / 1024, sb = b % 1024, swz = sb ^ (((sb >> 9) & 1) << 5); R = (st >> 1) * 16 + swz / 64; C = (st & 1) * 32 + (swz % 64) / 2; }
__host__ __device__ __forceinline__ int perm32(int rho) { const int n = rho >> 4, i = rho & 15; return 8 * (i >> 2) + 4 * n + (i & 3); }
struct Unit { int pm, pn; };
struct Gemm { const bf16_t* A; const bf16_t* Bt; int lda, K; };
struct StaticOrder {
    int nM, nN, nwg, G, c;
    __host__ __device__ void init(int M, int N, int G_, int c_) { nM = M / BM; nN = N / BM; nwg = nM * nN; G = G_; c = c_; }
    __host__ __device__ bool next(int i, Unit& u) const {
        const long L = (long)i * G + c; if (L >= nwg) return false;
        int wgid = (int)L; { const int q = nwg / NXCD, r = nwg % NXCD, xcd = wgid % NXCD, off = wgid / NXCD; wgid = (xcd < r ? xcd * (q + 1) : r * (q + 1) + (xcd - r) * q) + off; }
        const int nig = WGM * nN, gid = wgid / nig, fm = gid * WGM, gsz = (nM - fm) < WGM ? (nM - fm) : WGM;
        u.pm = fm + ((wgid % nig) % gsz); u.pn = (wgid % nig) / gsz; return true;
    }
    __device__ __forceinline__ void a_ready(const Unit&) const {}
    __device__ __forceinline__ void done(const Unit&) const {}
};
#ifndef EMU
template <class Epi, class Sched>
__device__ __forceinline__ void gemm_phase(PG8_LAS unsigned char* lds, const Gemm g, const Sched& S, const Epi& E, const int tid) {
    const int wid = __builtin_amdgcn_readfirstlane(tid >> 6), lane = tid & 63, wr = wid >> 2, wc = wid & 3, fr = lane & 15, fq = lane >> 4;
    int Kq = g.K; asm volatile("" : "+s"(Kq));
    const int K = Kq, nt = K / BK, lda = g.lda;
    unsigned voffA[2], voffB[2];
#pragma unroll
    for (int i = 0; i < 2; ++i) { int R, C; stage_rc(tid * 16 + i * 8192, R, C); const int Rb = Epi::PERM ? ((R & ~31) + perm32(R & 31)) : R;
        voffA[i] = (unsigned)(R * lda + C) * 2u; voffB[i] = (unsigned)(Rb * K + C) * 2u; }
    const size_t kstep = (size_t)(BK * 2);
    const size_t hstep = (size_t)HALF * K * 2, hstepA = (size_t)HALF * lda * 2;
    const size_t tstep = 2 * hstep, tstepA = 2 * hstepA;
    const unsigned ldsw = (unsigned)wid * 1024u;
    const int aoff = lds_byte(wr * 64 + fr, fq * 8), boff = lds_byte(wc * 32 + fr, fq * 8);
#define PG8_SA(b, h) (((b) * 2 + (h)) * HTB)
#define PG8_SB(b, h) ((4 + (b) * 2 + (h)) * HTB)
#define PG8_STAGE(bufoff, gbase, voff) do { _Pragma("unroll") for (int _i = 0; _i < 2; ++_i) \
        __builtin_amdgcn_global_load_lds((const unsigned*)((const char*)(gbase) + (voff)[_i]), (PG8_LAS unsigned*)(lds + (bufoff) + ldsw + _i * 8192), 16, 0, 0); } while (0)
#define PG8_LDA(dst, b, h) do { _Pragma("unroll") for (int m = 0; m < 4; ++m) _Pragma("unroll") for (int k = 0; k < 2; ++k) dst[m][k] = *(const PG8_LAS bf16x8*)(lds + PG8_SA(b, h) + aoff + m * 2048 + k * 1024); } while (0)
#define PG8_LDB(dst, b, h) do { _Pragma("unroll") for (int n = 0; n < 2; ++n) _Pragma("unroll") for (int k = 0; k < 2; ++k) dst[n][k] = *(const PG8_LAS bf16x8*)(lds + PG8_SB(b, h) + boff + n * 2048 + k * 1024); } while (0)
#define PG8_MMA(ai, bj, At, Bt) do { __builtin_amdgcn_s_setprio(1); _Pragma("unroll") for (int m = 0; m < 4; ++m) _Pragma("unroll") for (int n = 0; n < 2; ++n) _Pragma("unroll") for (int k = 0; k < 2; ++k) \
        acc[ai][bj][m][n] = __builtin_amdgcn_mfma_f32_16x16x32_bf16(Bt[n][k], At[m][k], acc[ai][bj][m][n], 0, 0, 0); __builtin_amdgcn_s_setprio(0); } while (0)
#define PG8_WAIT_V(n) asm volatile("s_waitcnt vmcnt(" #n ")" ::: "memory")
#define PG8_WAIT_L(n) asm volatile("s_waitcnt lgkmcnt(" #n ")" ::: "memory")
#define PG8_BAR __builtin_amdgcn_s_barrier()
#define PG8_SCHED __builtin_amdgcn_sched_barrier(0)
    Unit cur, nxt; int ui = 0;
    if (!S.next(0, cur)) return;
    f32x4 acc[2][2][4][2];
#pragma unroll
    for (int a = 0; a < 2; ++a)
#pragma unroll
        for (int b = 0; b < 2; ++b)
#pragma unroll
            for (int m = 0; m < 4; ++m)
#pragma unroll
                for (int n = 0; n < 2; ++n) acc[a][b][m][n] = (f32x4){0.f, 0.f, 0.f, 0.f};
    bf16x8 At[4][2], B0[2][2], B1[2][2];
    const char* cA = (const char*)g.A + (size_t)cur.pm * tstepA; const char* cB = (const char*)g.Bt + (size_t)cur.pn * tstep;
    S.a_ready(cur);
    PG8_STAGE(PG8_SB(0, 0), cB, voffB); PG8_STAGE(PG8_SA(0, 0), cA, voffA); PG8_STAGE(PG8_SB(0, 1), cB + hstep, voffB); PG8_STAGE(PG8_SA(0, 1), cA + hstepA, voffA);
    if (wr == 1) PG8_BAR;
    PG8_WAIT_V(4); PG8_BAR;
    PG8_STAGE(PG8_SB(1, 0), cB + kstep, voffB); PG8_STAGE(PG8_SA(1, 0), cA + kstep, voffA); PG8_STAGE(PG8_SB(1, 1), cB + hstep + kstep, voffB);
    PG8_WAIT_V(6); PG8_BAR;
    for (;;) {
        const bool has_next = S.next(ui + 1, nxt);
        const char* nA = has_next ? (const char*)g.A + (size_t)nxt.pm * tstepA : cA; const char* nB = has_next ? (const char*)g.Bt + (size_t)nxt.pn * tstep : cB;
        for (int t = 0; t < nt; t += 2) {
            const bool last = (t == nt - 2);
            const char* a1 = cA + (size_t)(t + 1) * kstep;
            const char* a2 = last ? nA : cA + (size_t)(t + 2) * kstep; const char* b2 = last ? nB : cB + (size_t)(t + 2) * kstep;
            const char* a3 = a2 + kstep; const char* b3 = b2 + kstep;
            if (last && has_next) S.a_ready(nxt);
            PG8_LDB(B0, 0, 0); PG8_SCHED; PG8_LDA(At, 0, 0); PG8_STAGE(PG8_SA(1, 1), a1 + hstepA, voffA);
            PG8_WAIT_L(8); PG8_BAR; PG8_WAIT_L(0); PG8_MMA(0, 0, At, B0); PG8_BAR; PG8_SCHED;
            PG8_LDB(B1, 0, 1); PG8_STAGE(PG8_SB(0, 0), b2, voffB);
            PG8_BAR; PG8_WAIT_L(0); PG8_MMA(0, 1, At, B1); PG8_BAR;
            PG8_LDA(At, 0, 1); PG8_STAGE(PG8_SA(0, 0), a2, voffA);
            PG8_BAR; PG8_WAIT_L(0); PG8_MMA(1, 0, At, B0); PG8_BAR; PG8_SCHED;
            PG8_STAGE(PG8_SB(0, 1), b2 + hstep, voffB);
            PG8_WAIT_V(6); PG8_BAR; PG8_MMA(1, 1, At, B1); PG8_BAR;
            PG8_LDB(B0, 1, 0); PG8_SCHED; PG8_LDA(At, 1, 0); PG8_STAGE(PG8_SA(0, 1), a2 + hstepA, voffA);
            PG8_WAIT_L(8); PG8_BAR; PG8_WAIT_L(0); PG8_MMA(0, 0, At, B0); PG8_BAR; PG8_SCHED;
            PG8_LDB(B1, 1, 1); PG8_STAGE(PG8_SB(1, 0), b3, voffB);
            PG8_BAR; PG8_WAIT_L(0); PG8_MMA(0, 1, At, B1); PG8_BAR;
            PG8_LDA(At, 1, 1); PG8_STAGE(PG8_SA(1, 0), a3, voffA);
            PG8_BAR; PG8_WAIT_L(0); PG8_MMA(1, 0, At, B0); PG8_BAR; PG8_SCHED;
            PG8_STAGE(PG8_SB(1, 1), b3 + hstep, voffB);
            PG8_WAIT_V(6); PG8_BAR; PG8_MMA(1, 1, At, B1); PG8_BAR;
        }
        if constexpr (!Epi::AFTER_DRAIN) { E(acc, cur, wr, wc, fr, fq); S.done(cur); }
        if (!has_next) break;
#pragma unroll
        for (int a = 0; a < 2; ++a)
#pragma unroll
            for (int b = 0; b < 2; ++b)
#pragma unroll
                for (int m = 0; m < 4; ++m)
#pragma unroll
                    for (int n = 0; n < 2; ++n) acc[a][b][m][n] = (f32x4){0.f, 0.f, 0.f, 0.f};
        cur = nxt; cA = nA; cB = nB; ++ui;
    }
    PG8_WAIT_V(0);
    if (wr == 0) PG8_BAR;
    PG8_BAR;
    if constexpr (Epi::AFTER_DRAIN) { E.fused(acc, cur, wr, wc, fr, fq, lds, wid, lane); S.done(cur); }
#undef PG8_SA
#undef PG8_SB
#undef PG8_STAGE
#undef PG8_LDA
#undef PG8_LDB
#undef PG8_MMA
#undef PG8_WAIT_V
#undef PG8_WAIT_L
#undef PG8_BAR
#undef PG8_SCHED
}
#else
template <class Epi, class Sched>
__device__ __forceinline__ void gemm_phase(PG8_LAS unsigned char* lds, const Gemm g, const Sched& S, const Epi& E, const int tid) {
    const int wid = tid >> 6, lane = tid & 63, wr = wid >> 2, wc = wid & 3, fr = lane & 15, fq = lane >> 4;
    Unit cur;
    for (int ui = 0; S.next(ui, cur); ++ui) {
        f32x4 acc[2][2][4][2];
        for (int ai = 0; ai < 2; ++ai) for (int m = 0; m < 4; ++m) {
            const size_t row = (size_t)cur.pm * 256 + ai * 128 + wr * 64 + m * 16 + fr;
            const bf16_t* ap = g.A + row * g.lda;
            for (int bj = 0; bj < 2; ++bj) for (int n = 0; n < 2; ++n) for (int j = 0; j < 4; ++j) {
                const size_t col = (size_t)cur.pn * 256 + bj * 128 + wc * 32 + (Epi::PERM ? 8 * fq + 4 * n : 16 * n + 4 * fq) + j;
                const bf16_t* bp = g.Bt + col * g.K; float s = 0.f;
                for (int k = 0; k < g.K; ++k) s += bf2f(ap[k]) * bf2f(bp[k]);
                acc[ai][bj][m][n][j] = s; } }
        E(acc, cur, wr, wc, fr, fq);
    }
    __syncthreads();
}
#endif
}

using pg8::Unit;
constexpr int HALFT = 128;
struct EpiF32 {
    static constexpr bool PERM = false, AFTER_DRAIN = false;
    float* C; int ldc;
    __device__ __forceinline__ void operator()(const f32x4 (&acc)[2][2][4][2], const Unit& u, int wr, int wc, int fr, int fq) const {
        const int row0 = u.pm * 256 + wr * 64 + fr, col0 = u.pn * 256 + wc * 32 + 4 * fq;
#pragma unroll
        for (int ai = 0; ai < 2; ++ai)
#pragma unroll
            for (int m = 0; m < 4; ++m) { float* rowp = C + (size_t)(row0 + ai * HALFT + m * 16) * ldc + col0;
#pragma unroll
                for (int bj = 0; bj < 2; ++bj)
#pragma unroll
                    for (int n = 0; n < 2; ++n) *(f32x4*)(rowp + bj * HALFT + n * 16) = acc[ai][bj][m][n]; }
    }
};
struct EpiResidual {
    static constexpr bool PERM = false, AFTER_DRAIN = false;
    const float* res; float* out;
    __device__ __forceinline__ void operator()(const f32x4 (&acc)[2][2][4][2], const Unit& u, int wr, int wc, int fr, int fq) const {
        const int row0 = u.pm * 256 + wr * 64 + fr, col0 = u.pn * 256 + wc * 32 + 4 * fq;
#pragma unroll
        for (int ai = 0; ai < 2; ++ai)
#pragma unroll
            for (int m = 0; m < 4; ++m) { const size_t o = (size_t)(row0 + ai * HALFT + m * 16) * D + col0;
#pragma unroll
                for (int bj = 0; bj < 2; ++bj)
#pragma unroll
                    for (int n = 0; n < 2; ++n) { const f32x4 r = *(const f32x4*)(res + o + bj * HALFT + n * 16); *(f32x4*)(out + o + bj * HALFT + n * 16) = r + acc[ai][bj][m][n]; } }
    }
};
struct EpiBf16 {
    static constexpr bool PERM = true, AFTER_DRAIN = false;
    bf16* O; int ldc; const float* rowscale; int rs_stride;
    __device__ __forceinline__ void operator()(const f32x4 (&acc)[2][2][4][2], const Unit& u, int wr, int wc, int fr, int fq) const {
        const int row0 = u.pm * 256 + wr * 64 + fr, col0 = u.pn * 256 + wc * 32 + 8 * fq;
#pragma unroll
        for (int ai = 0; ai < 2; ++ai)
#pragma unroll
            for (int m = 0; m < 4; ++m) { const int row = row0 + ai * HALFT + m * 16; bf16* rowp = O + (size_t)row * ldc + col0;
                const float sc = rowscale ? rowscale[(size_t)row * rs_stride] : 1.0f;
#pragma unroll
                for (int bj = 0; bj < 2; ++bj) { const f32x4 v0 = acc[ai][bj][m][0] * sc, v1 = acc[ai][bj][m][1] * sc;
                    u32x4 w; w.x = pk2(v0[0], v0[1]); w.y = pk2(v0[2], v0[3]); w.z = pk2(v1[0], v1[1]); w.w = pk2(v1[2], v1[3]);
                    *(u32x4*)(rowp + bj * HALFT) = w; } }
    }
};
struct EpiSwiGLU {
    static constexpr bool PERM = true, AFTER_DRAIN = false;
    bf16* O; int ldc; int ntile;
    __device__ __forceinline__ void operator()(const f32x4 (&acc)[2][2][4][2], const Unit& u, int wr, int wc, int fr, int fq) const {
        const int row0 = u.pm * 256 + wr * 64 + fr, col0 = (u.pn % ntile) * 128 + wc * 32 + 8 * fq;
#pragma unroll
        for (int ai = 0; ai < 2; ++ai)
#pragma unroll
            for (int m = 0; m < 4; ++m) { bf16* rowp = O + (size_t)(row0 + ai * HALFT + m * 16) * ldc + col0;
                float a[8];
#pragma unroll
                for (int n = 0; n < 2; ++n)
#pragma unroll
                    for (int j = 0; j < 4; ++j) { const float g = acc[ai][0][m][n][j], up = acc[ai][1][m][n][j]; a[4 * n + j] = g * fast_rcp(1.0f + fast_exp(-g)) * up; }
                u32x4 w; w.x = pk2(a[0], a[1]); w.y = pk2(a[2], a[3]); w.z = pk2(a[4], a[5]); w.w = pk2(a[6], a[7]);
                *(u32x4*)rowp = w; }
    }
};
struct EpiMerge {
    static constexpr bool PERM = false, AFTER_DRAIN = false;
    const bf16* Z; const float* gate_b; bf16* MG;
    __device__ __forceinline__ void operator()(const f32x4 (&acc)[2][2][4][2], const Unit& u, int wr, int wc, int fr, int fq) const {
        const int row0 = u.pm * 256 + wr * 64 + fr, col = u.pn * 64 + wc * 16 + 4 * fq;
        f32x4 gb[4];
#pragma unroll
        for (int i = 0; i < 4; ++i) gb[i] = *(const f32x4*)(gate_b + i * D + col);
#pragma unroll
        for (int ai = 0; ai < 2; ++ai)
#pragma unroll
            for (int m = 0; m < 4; ++m) { const size_t row = (size_t)(row0 + ai * HALFT + m * 16);
                f32x4 s = (f32x4){0.f, 0.f, 0.f, 0.f};
#pragma unroll
                for (int bj = 0; bj < 2; ++bj)
#pragma unroll
                    for (int n = 0; n < 2; ++n) { const int i = 2 * bj + n; const f32x4 z = ld_bf16x4(Z + row * 4096 + i * D + col); const f32x4 a = acc[ai][bj][m][n] + gb[i];
#pragma unroll
                        for (int j = 0; j < 4; ++j) s[j] += z[j] * fast_rcp(1.0f + fast_exp(-a[j])); }
                st_bf16x4(MG + row * D + col, s); }
    }
};

constexpr size_t MiB = 1u << 20;
constexpr size_t al(size_t x) { return (x + 255) & ~(size_t)255; }
constexpr size_t WS_CTL = 0, CTL_BYTES = 1 * MiB;
constexpr size_t W_IN = 1 * MiB;
constexpr size_t W_GATE = W_IN + (size_t)PW * D * 2;
constexpr size_t W_UQ = W_GATE + (size_t)4096 * D * 2;
constexpr size_t W_UKV = W_UQ + (size_t)768 * 384 * 2;
constexpr size_t W_LORA = W_UKV + (size_t)1024 * 256 * 2;
constexpr size_t W_BR = W_LORA + (size_t)1536 * 384 * 2;
constexpr size_t W_OUT = W_BR + (size_t)4 * 1024 * 512 * 2;
constexpr size_t W_FGU = W_OUT + (size_t)D * D * 2;
constexpr size_t W_FDN = W_FGU + (size_t)NEXP * 2 * FF_E * D * 2;
constexpr size_t W_END = W_FDN + (size_t)NEXP * D * FF_E * 2;
constexpr size_t A_H = al(W_END);
constexpr size_t A_ROPE = A_H + (size_t)TH * D * 2;
constexpr size_t A_Y = A_ROPE + (size_t)TH * 64 * 4;
constexpr size_t A_P = A_Y + (size_t)4 * TH * 512 * 2;
constexpr size_t A_MIX = A_P + (size_t)TH * PW * 2;
constexpr size_t M_STAT = A_MIX;
constexpr size_t M_KR = M_STAT + (size_t)TH * 2 * 4;
constexpr size_t M_Q = M_KR + (size_t)TH * 64 * 2;
constexpr size_t M_KV = M_Q + (size_t)TH * 768 * 2;
constexpr size_t M_END = M_KV + (size_t)TH * 1024 * 2;
constexpr size_t R_RKV = A_MIX;
constexpr size_t R_LIN = R_RKV + (size_t)TH * 1536 * 2;
constexpr size_t R_LOUT = R_LIN + (size_t)TH * 384 * 2;
constexpr size_t R_O = R_LOUT + (size_t)TH * 1536 * 4;
constexpr size_t R_END = R_O + (size_t)TH * 512 * 4;
constexpr int GDN_CHUNK_F = 4 * 64 * 128 + 64 * 64;
constexpr size_t G_CH = A_MIX;
constexpr size_t G_GL = G_CH + (size_t)BH * 4 * NCH * GDN_CHUNK_F * 4;
constexpr size_t G_O = G_GL + al((size_t)BH * 4 * NCH * 4);
constexpr size_t G_END = G_O + (size_t)TH * 512 * 4;
constexpr size_t S_ST = A_MIX;
constexpr size_t S_YD = S_ST + (size_t)BH * NCH * 8 * 64 * 128 * 4;
constexpr size_t S_C = S_YD + (size_t)TH * 512 * 4;
constexpr size_t S_AC = S_C + (size_t)TH * 256 * 4;
constexpr size_t S_END = S_AC + (size_t)TH * 8 * 4;
constexpr size_t A_Z = A_P;
constexpr size_t A_MG = A_MIX;
constexpr size_t F_ACT = A_P;
constexpr size_t F_GA = F_ACT + (size_t)MOE_ROWS * FF_E * 2;
constexpr size_t F_YE = F_GA + (size_t)MOE_ROWS * D * 2;
constexpr size_t F_TOPE = F_YE + (size_t)MOE_ROWS * D * 4;
constexpr size_t F_TOPW = F_TOPE + (size_t)TH * 2 * 4;
constexpr size_t F_SLOT = F_TOPW + (size_t)TH * 2 * 4;
constexpr size_t F_END = F_SLOT + (size_t)TH * 2 * 4;
constexpr size_t cmax(size_t a, size_t b) { return a > b ? a : b; }
constexpr size_t WS_NEED = cmax(cmax(cmax(M_END, R_END), cmax(G_END, S_END)), F_END);
#ifndef EMU
static_assert(WS_NEED <= (size_t)896 * MiB, "workspace");
#endif
constexpr int CW_BAR = 4096;
constexpr int CW_CNT = 16384;
constexpr int CW_FILL = 16384 + 64;

#ifdef EMU
#define WAVE_SYNC() emu_wave_sync()
#else
#define WAVE_SYNC() do { asm volatile("s_waitcnt lgkmcnt(0)" ::: "memory"); } while (0)
#endif
struct Frame {
    LAS unsigned char* lds; int tid, lane, wave, G, gw, NGW, bid;
    float* out; unsigned char* ws; unsigned* ctl;
};
struct Args { const float* in[39]; float* out; unsigned char* ws; int lo, hi; };
#define WSP(type, off) ((type*)(F.ws + (off)))

template <class FN>
__device__ __forceinline__ void cvt_matrix(const Frame& F, const float* W, int ldw, int K, bf16* WT, int Ndst, const float* kscale, FN srccol) {
    LAS float* scr = (LAS float*)(F.lds + F.wave * 16384);
    const int nblk = Ndst / 32, nitems = (K / 64) * nblk, lane = F.lane;
    for (int item = F.gw; item < nitems; item += F.NGW) {
        const int kb = item / nblk, nb = item % nblk, k0 = 64 * kb, n0 = 32 * nb;
        const int sc = srccol(n0 + (lane & 31));
#pragma unroll 8
        for (int i = 0; i < 32; ++i) { const int kk = 2 * i + (lane >> 5); float v = sc >= 0 ? W[(size_t)(k0 + kk) * ldw + sc] : 0.f; if (kscale) v *= kscale[k0 + kk]; scr[kk * 33 + (lane & 31)] = v; }
        WAVE_SYNC();
        const int c = lane & 7;
#pragma unroll
        for (int j = 0; j < 4; ++j) { const int n = (lane >> 3) + 8 * j; const LAS float* s = scr + (8 * c) * 33 + n;
            u32x4 o; o.x = pk2(s[0 * 33], s[1 * 33]); o.y = pk2(s[2 * 33], s[3 * 33]); o.z = pk2(s[4 * 33], s[5 * 33]); o.w = pk2(s[6 * 33], s[7 * 33]);
            *(u32x4*)(WT + (size_t)(n0 + n) * K + k0 + 8 * c) = o; }
        WAVE_SYNC();
    }
}
__device__ __forceinline__ void phase_convert(const Frame& F, const Args& A, int layer) {
    const float* w_in = A.in[3] + (size_t)layer * D * IN_COLS;
    cvt_matrix(F, w_in, IN_COLS, D, WSP(bf16, W_IN), PW, nullptr, [](int n) { return n < C_GATE ? n : -1; });
    cvt_matrix(F, w_in, IN_COLS, D, WSP(bf16, W_GATE), 4096, nullptr, [](int n) {
        const int pn = n >> 8, c = n & 255, bj = c >> 7, wc = (c >> 5) & 3, nn = (c >> 4) & 1, r = c & 15; return C_GATE + (2 * bj + nn) * D + 64 * pn + 16 * wc + r; });
    cvt_matrix(F, A.in[6] + (size_t)layer * 384 * 768, 768, 384, WSP(bf16, W_UQ), 768, A.in[4] + layer * 384, [](int n) { return n; });
    cvt_matrix(F, A.in[7] + (size_t)layer * 256 * 1024, 1024, 256, WSP(bf16, W_UKV), 1024, A.in[5] + layer * 256, [](int n) { return n; });
    for (int i = 0; i < 4; ++i) cvt_matrix(F, A.in[30] + ((size_t)layer * 4 + i) * 512 * D, D, 512, WSP(bf16, W_BR) + (size_t)i * D * 512, D, nullptr, [](int n) { return n; });
    cvt_matrix(F, A.in[31] + (size_t)layer * D * D, D, D, WSP(bf16, W_OUT), D, nullptr, [](int n) { return n; });
    if (layer == 0) {
        cvt_matrix(F, A.in[33], 2 * FF_D, D, WSP(bf16, W_FGU), 2 * FF_D, nullptr, [](int n) { const int pn = n >> 8, c = n & 255; return c < 128 ? 128 * pn + c : FF_D + 128 * pn + (c - 128); });
        cvt_matrix(F, A.in[34], D, FF_D, WSP(bf16, W_FDN), D, nullptr, [](int n) { return n; });
    } else {
        for (int e = 0; e < NEXP; ++e) {
            cvt_matrix(F, A.in[36] + (size_t)e * D * 2 * FF_E, 2 * FF_E, D, WSP(bf16, W_FGU) + (size_t)e * 2 * FF_E * D, 2 * FF_E, nullptr, [](int n) { const int pn = n >> 8, c = n & 255; return c < 128 ? 128 * pn + c : FF_E + 128 * pn + (c - 128); });
            cvt_matrix(F, A.in[37] + (size_t)e * FF_E * D, D, FF_E, WSP(bf16, W_FDN) + (size_t)e * D * FF_E, D, nullptr, [](int n) { return n; });
        }
    }
    { const float* w2 = A.in[10] + (size_t)layer * 64 * 512; const float* a2 = A.in[12] + (size_t)layer * 64 * 512; const float* g2 = A.in[13] + (size_t)layer * 160 * 512;
      bf16* L = WSP(bf16, W_LORA);
      for (int idx = F.bid * 512 + F.tid; idx < 1536 * 384; idx += F.G * 512) { const int n = idx / 384, k = idx % 384; float v = 0.f;
          if (n < 512) { if (k < 64) v = w2[k * 512 + n]; } else if (n < 1024) { if (k >= 64 && k < 128) v = a2[(k - 64) * 512 + (n - 512)]; } else { if (k >= 128 && k < 288) v = g2[(k - 128) * 512 + (n - 1024)]; }
          L[idx] = (bf16)f2bf(v); } }
}

template <bool ROUTER>
__device__ __forceinline__ void phase_norm(const Frame& F, const Args& A, const float* xin, const float* gain, bf16* H, const float* router, int* tope, float* topw, unsigned* cnt) {
    const int lane = F.lane;
    f32x4 gv[4];
#pragma unroll
    for (int j = 0; j < 4; ++j) gv[j] = *(const f32x4*)(gain + 4 * lane + 256 * j);
    for (int m = F.gw; m < TH; m += F.NGW) {
        const float* xr = xin + (size_t)m * D; f32x4 v[4]; float ss = 0.f;
#pragma unroll
        for (int j = 0; j < 4; ++j) { v[j] = *(const f32x4*)(xr + 4 * lane + 256 * j); ss += (v[j].x * v[j].x + v[j].y * v[j].y) + (v[j].z * v[j].z + v[j].w * v[j].w); }
        const float rstd = 1.0f / sqrtf(wave_sum(ss) * (1.0f / D) + EPS);
#pragma unroll
        for (int j = 0; j < 4; ++j) { v[j] = v[j] * rstd * gv[j]; st_bf16x4(H + (size_t)m * D + 4 * lane + 256 * j, v[j]); }
        if (ROUTER) {
            float lg[8];
#pragma unroll
            for (int e = 0; e < 8; ++e) lg[e] = 0.f;
#pragma unroll
            for (int j = 0; j < 4; ++j)
#pragma unroll
                for (int q = 0; q < 4; ++q) { const float* rp = router + (size_t)(4 * lane + 256 * j + q) * 8; const f32x4 r0 = *(const f32x4*)rp, r1 = *(const f32x4*)(rp + 4); const float hv = v[j][q];
                    lg[0] += hv * r0.x; lg[1] += hv * r0.y; lg[2] += hv * r0.z; lg[3] += hv * r0.w; lg[4] += hv * r1.x; lg[5] += hv * r1.y; lg[6] += hv * r1.z; lg[7] += hv * r1.w; }
#pragma unroll
            for (int e = 0; e < 8; ++e) lg[e] = wave_sum(lg[e]);
            if (lane == 0) {
                int e1 = 0; float l1 = lg[0];
#pragma unroll
                for (int e = 1; e < 8; ++e) if (lg[e] > l1) { l1 = lg[e]; e1 = e; }
                int e2 = -1; float l2 = -3.0e38f;
#pragma unroll
                for (int e = 0; e < 8; ++e) if (e != e1 && lg[e] > l2) { l2 = lg[e]; e2 = e; }
                const float w1 = 1.0f / (1.0f + expf(l2 - l1));
                tope[2 * m] = e1; tope[2 * m + 1] = e2; topw[2 * m] = w1; topw[2 * m + 1] = 1.0f - w1;
                ATOMIC_ADD_U32(cnt + e1, 1u); ATOMIC_ADD_U32(cnt + e2, 1u);
            }
        }
    }
}
__device__ __forceinline__ void phase_rope_table(const Frame& F, const Args& A, const int* pos, float* rope) {
    for (int idx = F.bid * 512 + F.tid; idx < TH * 32; idx += F.G * 512) { const int t = idx >> 5, i = idx & 31;
        const float inv = powf(10000.0f, -(float)i / 32.0f);
        const float ang = (float)pos[t] * inv; float sn, cs; sincosf(ang, &sn, &cs);
        rope[(size_t)t * 64 + i] = cs; rope[(size_t)t * 64 + 32 + i] = sn; }
}
__device__ __forceinline__ void phase_final_norm(const Frame& F, const Args& A, float* x, const float* gain) {
    const int lane = F.lane;
    for (int m = F.gw; m < T; m += F.NGW) {
        float* xr = x + (size_t)m * D; f32x4 v[4]; float ss = 0.f;
#pragma unroll
        for (int j = 0; j < 4; ++j) { v[j] = *(const f32x4*)(xr + 4 * lane + 256 * j); ss += (v[j].x * v[j].x + v[j].y * v[j].y) + (v[j].z * v[j].z + v[j].w * v[j].w); }
        const float rstd = 1.0f / sqrtf(wave_sum(ss) * (1.0f / D) + EPS);
#pragma unroll
        for (int j = 0; j < 4; ++j) *(f32x4*)(xr + 4 * lane + 256 * j) = v[j] * rstd * *(const f32x4*)(gain + 4 * lane + 256 * j);
    }
}

__device__ __forceinline__ void phase_mla_prep(const Frame& F, const Args& A) {
    bf16* P = WSP(bf16, A_P); bf16* kr = WSP(bf16, M_KR); const float* rope = WSP(float, A_ROPE);
    const int lane = F.lane;
    for (int m = F.gw; m < TH; m += F.NGW) {
        bf16* pr = P + (size_t)m * PW; float sq = 0.f, skv = 0.f; f32x4 v[3];
#pragma unroll
        for (int j = 0; j < 3; ++j) { const int c = 4 * lane + 256 * j; v[j] = ld_bf16x4(pr + c); const float s = (v[j].x * v[j].x + v[j].y * v[j].y) + (v[j].z * v[j].z + v[j].w * v[j].w);
            if (c < 384) sq += s; else if (c < 640) skv += s; }
        sq = wave_sum(sq); skv = wave_sum(skv);
        const float rq = 1.0f / sqrtf(sq * (1.0f / 384.0f) + EPS), rkv = 1.0f / sqrtf(skv * (1.0f / 256.0f) + EPS);
#pragma unroll
        for (int j = 0; j < 3; ++j) { const int c = 4 * lane + 256 * j; if (c < 640) st_bf16x4(pr + c, v[j] * (c < 384 ? rq : rkv)); }
        if (lane < 32) { const float x1 = bf2f(pr[640 + lane]), x2 = bf2f(pr[672 + lane]), c = rope[(size_t)m * 64 + lane], s = rope[(size_t)m * 64 + 32 + lane];
            kr[(size_t)m * 64 + lane] = (bf16)f2bf(x1 * c - x2 * s); kr[(size_t)m * 64 + 32 + lane] = (bf16)f2bf(x2 * c + x1 * s); }
    }
}
__device__ __forceinline__ void phase_mla_q(const Frame& F, const Args& A) {
    pg8::Gemm g{WSP(bf16, A_P) + 0, WSP(bf16, W_UQ), PW, 384}; pg8::StaticOrder S; S.init(TH, 768, F.G, F.bid);
    EpiBf16 E{WSP(bf16, M_Q), 768, nullptr, 0}; pg8::gemm_phase(F.lds, g, S, E, F.tid);
}
__device__ __forceinline__ void phase_mla_kv(const Frame& F, const Args& A) {
    pg8::Gemm g{WSP(bf16, A_P) + 384, WSP(bf16, W_UKV), PW, 256}; pg8::StaticOrder S; S.init(TH, 1024, F.G, F.bid);
    EpiBf16 E{WSP(bf16, M_KV), 1024, nullptr, 0}; pg8::gemm_phase(F.lds, g, S, E, F.tid);
}
constexpr int AT_KS = 200, AT_VS = 72;
__device__ __forceinline__ void phase_attention(const Frame& F, const Args& A) {
    const bf16* Q = WSP(bf16, M_Q); const bf16* KV = WSP(bf16, M_KV); const bf16* KR = WSP(bf16, M_KR); const float* rope = WSP(float, A_ROPE); bf16* Y = WSP(bf16, A_Y);
    LAS bf16* Ks = (LAS bf16*)F.lds; LAS bf16* Vt = (LAS bf16*)(F.lds + 64 * AT_KS * 2);
    const int lane = F.lane, w = F.wave, l15 = lane & 15, q4 = lane >> 4, tid = F.tid;
    const int NQB = SEQ / 128, nunits = BH * 4 * NQB;
    const float scale = 0.07216878364870322f;
    for (int unit = F.bid; unit < nunits; unit += F.G) {
        const int qb = NQB - 1 - (unit % NQB), bh = unit / NQB, h = bh & 3, b = bh >> 2;
        const size_t t0 = (size_t)b * SEQ;
        const size_t tq = t0 + qb * 128 + w * 16 + l15;
        bf16x8 qf[6];
#pragma unroll
        for (int ks = 0; ks < 6; ++ks) qf[ks] = *(const bf16x8*)(Q + tq * 768 + h * 192 + 32 * ks + 8 * q4);
        {
            bf16x8 a = qf[4], c2 = qf[5];
#pragma unroll
            for (int j = 0; j < 8; ++j) { const float x1 = bf2f((unsigned short)a[j]), x2 = bf2f((unsigned short)c2[j]), c = rope[tq * 64 + 8 * q4 + j], s = rope[tq * 64 + 32 + 8 * q4 + j];
                qf[4][j] = (short)f2bf(x1 * c - x2 * s); qf[5][j] = (short)f2bf(x2 * c + x1 * s); }
        }
        f32x4 o[8];
#pragma unroll
        for (int mb = 0; mb < 8; ++mb) o[mb] = (f32x4){0.f, 0.f, 0.f, 0.f};
        float mrow = -3.0e38f, lrow = 0.f;
        const int qchunk = 2 * qb + (w >> 2), ntile = 2 * qb + 2;
        for (int kt = 0; kt < ntile; ++kt) {
            __syncthreads();
            const size_t k0 = t0 + (size_t)kt * 64;
#pragma unroll
            for (int i = 0; i < 3; ++i) { const int idx = tid + 512 * i, key = idx / 24, c = idx % 24;
                const u32x4 v = (c < 16) ? *(const u32x4*)(KV + (k0 + key) * 1024 + h * 256 + 8 * c) : *(const u32x4*)(KR + (k0 + key) * 64 + 8 * (c - 16));
                *(LAS u32x4*)(Ks + key * AT_KS + 8 * c) = v; }
#pragma unroll
            for (int i = 0; i < 2; ++i) { const int idx = tid + 512 * i, key = idx >> 4, c = idx & 15;
                const bf16x8 v = *(const bf16x8*)(KV + (k0 + key) * 1024 + h * 256 + 128 + 8 * c);
#pragma unroll
                for (int j = 0; j < 8; ++j) Vt[(8 * c + j) * AT_VS + key] = (bf16)v[j]; }
            __syncthreads();
            if (kt <= qchunk) {
                f32x4 st[4];
#pragma unroll
                for (int kb = 0; kb < 4; ++kb) { st[kb] = (f32x4){0.f, 0.f, 0.f, 0.f};
#pragma unroll
                    for (int ks = 0; ks < 6; ++ks) { const bf16x8 kf = *(const LAS bf16x8*)(Ks + (16 * kb + l15) * AT_KS + 32 * ks + 8 * q4); st[kb] = MFMA_BF16(kf, qf[ks], st[kb]); } }
                float mx = -3.0e38f;
#pragma unroll
                for (int kb = 0; kb < 4; ++kb) { st[kb] = st[kb] * scale; mx = fmaxf(mx, fmaxf(fmaxf(st[kb].x, st[kb].y), fmaxf(st[kb].z, st[kb].w))); }
                mx = fmaxf(mx, __shfl_xor(mx, 16)); mx = fmaxf(mx, __shfl_xor(mx, 32));
                const float mnew = fmaxf(mrow, mx), alpha = expf(mrow - mnew); mrow = mnew;
                float ps = 0.f;
#pragma unroll
                for (int kb = 0; kb < 4; ++kb)
#pragma unroll
                    for (int r = 0; r < 4; ++r) { const float p = expf(st[kb][r] - mnew); st[kb][r] = p; ps += p; }
                lrow = lrow * alpha + ps;
#pragma unroll
                for (int mb = 0; mb < 8; ++mb) o[mb] = o[mb] * alpha;
#pragma unroll
                for (int kg = 0; kg < 2; ++kg) {
                    bf16x8 pb;
#pragma unroll
                    for (int j = 0; j < 4; ++j) { pb[j] = (short)f2bf(st[2 * kg][j]); pb[4 + j] = (short)f2bf(st[2 * kg + 1][j]); }
#pragma unroll
                    for (int mb = 0; mb < 8; ++mb) { const LAS bf16* vp = Vt + (16 * mb + l15) * AT_VS + 32 * kg + 4 * q4;
                        const bf16x4 v0 = *(const LAS bf16x4*)vp, v1 = *(const LAS bf16x4*)(vp + 16);
                        bf16x8 vf; vf[0] = v0[0]; vf[1] = v0[1]; vf[2] = v0[2]; vf[3] = v0[3]; vf[4] = v1[0]; vf[5] = v1[1]; vf[6] = v1[2]; vf[7] = v1[3];
                        o[mb] = MFMA_BF16(vf, pb, o[mb]); }
                }
            }
        }
        lrow += __shfl_xor(lrow, 16); lrow += __shfl_xor(lrow, 32);
        const float inv = 1.0f / lrow;
#pragma unroll
        for (int mb = 0; mb < 8; ++mb) st_bf16x4(Y + tq * 512 + h * 128 + 16 * mb + 4 * q4, o[mb] * inv);
    }
    __syncthreads();
}

__device__ __forceinline__ void phase_rwkv_prep(const Frame& F, const Args& A, int layer) {
    const bf16* P = WSP(bf16, A_P); bf16* RKV = WSP(bf16, R_RKV); bf16* LIN = WSP(bf16, R_LIN); const float* mu = A.in[8] + (size_t)layer * 1824;
    const int lane = F.lane;
    for (int m = F.gw; m < TH; m += F.NGW) {
        const bool first = (m % SEQ) == 0; const bf16* pr = P + (size_t)m * PW + C_RWKV;
#pragma unroll
        for (int j = 0; j < 8; ++j) { const int c = 4 * lane + 256 * j;
            if (c < 1824) { const f32x4 p = ld_bf16x4(pr + c); const f32x4 pv = first ? (f32x4){0.f, 0.f, 0.f, 0.f} : ld_bf16x4(pr - PW + c); const f32x4 muv = *(const f32x4*)(mu + c);
                f32x4 x = p + (pv - p) * muv;
                if (c < 1536) st_bf16x4(RKV + (size_t)m * 1536 + c, x);
                else { if (c < 1600) { x.x = tanhf(x.x); x.y = tanhf(x.y); x.z = tanhf(x.z); x.w = tanhf(x.w); }
                       else if (c >= 1664) { x.x = sigmoidf_(x.x); x.y = sigmoidf_(x.y); x.z = sigmoidf_(x.z); x.w = sigmoidf_(x.w); }
                       st_bf16x4(LIN + (size_t)m * 384 + (c - 1536), x); } } }
        if (lane < 24) st_bf16x4(LIN + (size_t)m * 384 + 288 + 4 * lane, (f32x4){0.f, 0.f, 0.f, 0.f});
    }
}
__device__ __forceinline__ void phase_rwkv_lora(const Frame& F, const Args& A) {
    pg8::Gemm g{WSP(bf16, R_LIN), WSP(bf16, W_LORA), 384, 384}; pg8::StaticOrder S; S.init(TH, 1536, F.G, F.bid);
    EpiF32 E{WSP(float, R_LOUT), 1536}; pg8::gemm_phase(F.lds, g, S, E, F.tid);
}
constexpr int RW_TB = 32;
__device__ __forceinline__ void phase_rwkv_scan(const Frame& F, const Args& A, int layer) {
    const bf16* RKV = WSP(bf16, R_RKV); const float* LOUT = WSP(float, R_LOUT); float* RO = WSP(float, R_O);
    const float* w0 = A.in[9] + layer * 512; const float* a0 = A.in[11] + layer * 512; const float* k_k = A.in[14] + layer * 512; const float* k_a = A.in[15] + layer * 512;
    LAS float* sr = (LAS float*)F.lds; LAS float* sd = sr + RW_TB * 64; LAS float* skm = sd + RW_TB * 64; LAS float* skk = skm + RW_TB * 64; LAS float* ska = skk + RW_TB * 64; LAS float* sv = ska + RW_TB * 64;
    const int tid = F.tid, lane = F.lane, il = tid >> 5, jq = tid & 31;
    const int nunits = BH * 8 * 4;
    for (int unit = F.bid; unit < nunits; unit += F.G) {
        const int rq = unit & 3, h = (unit >> 2) & 7, b = unit >> 5; const int i = 16 * rq + il;
        float s0 = 0.f, s1 = 0.f;
        const int cj = h * 64 + (tid & 63);
        const float w0c = w0[cj], a0c = a0[cj], kkc = k_k[cj], kac = k_a[cj];
        for (int tb = 0; tb < SEQ / RW_TB; ++tb) {
            const size_t tok0 = (size_t)b * SEQ + (size_t)tb * RW_TB;
            __syncthreads();
#pragma unroll
            for (int q = 0; q < RW_TB / 8; ++q) { const int tt = (tid >> 6) + 8 * q; const size_t tok = tok0 + tt;
                const float r = bf2f(RKV[tok * 1536 + cj]), k = bf2f(RKV[tok * 1536 + 512 + cj]);
                const float wpre = LOUT[tok * 1536 + cj], apre = LOUT[tok * 1536 + 512 + cj];
                const float w = -softplusf_(-(w0c + wpre)) - 0.5f, dec = expf(-expf(w)), a = sigmoidf_(a0c + apre);
                const float kr = k * kkc, ss = wave_sum(kr * kr), kk = kr / sqrtf(ss + EPS);
                const int o = tt * 64 + (tid & 63);
                sr[o] = r; sd[o] = dec; skm[o] = k * (1.0f + (a - 1.0f) * kac); skk[o] = kk; ska[o] = kk * a; }
            { const int tt = tid >> 4, ii = tid & 15; sv[tt * 16 + ii] = bf2f(RKV[(tok0 + tt) * 1536 + 1024 + h * 64 + 16 * rq + ii]); }
            __syncthreads();
            for (int tt = 0; tt < RW_TB; ++tt) {
                const int o = tt * 64 + 2 * jq;
                const f32x2 kk = *(const LAS f32x2*)(skk + o), dc = *(const LAS f32x2*)(sd + o), ka = *(const LAS f32x2*)(ska + o), km = *(const LAS f32x2*)(skm + o), rr = *(const LAS f32x2*)(sr + o);
                const float vi = sv[tt * 16 + il];
                float sa = s0 * kk.x + s1 * kk.y;
                sa += __shfl_xor(sa, 1); sa += __shfl_xor(sa, 2); sa += __shfl_xor(sa, 4); sa += __shfl_xor(sa, 8); sa += __shfl_xor(sa, 16);
                s0 = s0 * dc.x - sa * ka.x + vi * km.x; s1 = s1 * dc.y - sa * ka.y + vi * km.y;
                float op = s0 * rr.x + s1 * rr.y;
                op += __shfl_xor(op, 1); op += __shfl_xor(op, 2); op += __shfl_xor(op, 4); op += __shfl_xor(op, 8); op += __shfl_xor(op, 16);
                if (jq == 0) RO[(tok0 + tt) * 512 + h * 64 + i] = op;
            }
        }
    }
    __syncthreads();
}
__device__ __forceinline__ void phase_rwkv_post(const Frame& F, const Args& A, int layer) {
    const bf16* RKV = WSP(bf16, R_RKV); const float* LOUT = WSP(float, R_LOUT); const float* RO = WSP(float, R_O); bf16* Y = WSP(bf16, A_Y) + (size_t)1 * TH * 512;
    const float* a0 = A.in[11] + layer * 512; const float* k_a = A.in[15] + layer * 512; const float* r_k = A.in[16] + layer * 512; const float* ln_w = A.in[17] + layer * 512; const float* ln_b = A.in[18] + layer * 512;
    const int lane = F.lane, c0 = 8 * lane;
    for (int m = F.gw; m < TH; m += F.NGW) {
        float o[8], r[8], k[8], v[8], ap[8], g[8];
        { const f32x4 a = *(const f32x4*)(RO + (size_t)m * 512 + c0), b2 = *(const f32x4*)(RO + (size_t)m * 512 + c0 + 4); o[0] = a.x; o[1] = a.y; o[2] = a.z; o[3] = a.w; o[4] = b2.x; o[5] = b2.y; o[6] = b2.z; o[7] = b2.w; }
#pragma unroll
        for (int hh = 0; hh < 2; ++hh) { const f32x4 rv = ld_bf16x4(RKV + (size_t)m * 1536 + c0 + 4 * hh), kv = ld_bf16x4(RKV + (size_t)m * 1536 + 512 + c0 + 4 * hh), vv = ld_bf16x4(RKV + (size_t)m * 1536 + 1024 + c0 + 4 * hh);
            const f32x4 av = *(const f32x4*)(LOUT + (size_t)m * 1536 + 512 + c0 + 4 * hh), gv = *(const f32x4*)(LOUT + (size_t)m * 1536 + 1024 + c0 + 4 * hh);
#pragma unroll
            for (int q = 0; q < 4; ++q) { r[4 * hh + q] = rv[q]; k[4 * hh + q] = kv[q]; v[4 * hh + q] = vv[q]; ap[4 * hh + q] = av[q]; g[4 * hh + q] = gv[q]; } }
        float bon = 0.f, sm = 0.f;
#pragma unroll
        for (int q = 0; q < 8; ++q) { const float a = sigmoidf_(a0[c0 + q] + ap[q]); const float km = k[q] * (1.0f + (a - 1.0f) * k_a[c0 + q]); bon += r[q] * km * r_k[c0 + q]; sm += o[q]; }
        bon += __shfl_xor(bon, 1); bon += __shfl_xor(bon, 2); bon += __shfl_xor(bon, 4);
        sm += __shfl_xor(sm, 1); sm += __shfl_xor(sm, 2); sm += __shfl_xor(sm, 4);
        const float mean = sm * (1.0f / 64.0f); float vs = 0.f;
#pragma unroll
        for (int q = 0; q < 8; ++q) { const float d = o[q] - mean; vs += d * d; }
        vs += __shfl_xor(vs, 1); vs += __shfl_xor(vs, 2); vs += __shfl_xor(vs, 4);
        const float rstd = 1.0f / sqrtf(vs * (1.0f / 64.0f) + 64e-5f);
        float y[8];
#pragma unroll
        for (int q = 0; q < 8; ++q) y[q] = ((o[q] - mean) * rstd * ln_w[c0 + q] + ln_b[c0 + q] + bon * v[q]) * g[q];
        u32x4 wv; wv.x = pk2(y[0], y[1]); wv.y = pk2(y[2], y[3]); wv.z = pk2(y[4], y[5]); wv.w = pk2(y[6], y[7]);
        *(u32x4*)(Y + (size_t)m * 512 + c0) = wv;
    }
}

__device__ __forceinline__ f32x4 tile_mm(const LAS float* a, int lda, int ska, const LAS float* b, int ldb, int scb, int K, f32x4 acc, int l15, int q4) {
    const LAS float* ap = a + l15 * lda + q4 * ska; const LAS float* bp = b + q4 * ldb + l15 * scb;
#pragma unroll 8
    for (int ks = 0; ks < K / 4; ++ks) acc = MFMA_F32(ap[ks * 4 * ska], bp[ks * 4 * ldb], acc);
    return acc;
}
constexpr int GS = 132, GS2 = 68;
__device__ __forceinline__ void phase_gdn_g1(const Frame& F, const Args& A, int layer) {
    const bf16* P = WSP(bf16, A_P); float* CHR = WSP(float, G_CH); float* GL = WSP(float, G_GL);
    const float* convw = A.in[19] + (size_t)layer * 4 * 1536; const float* a_log = A.in[20] + layer * 4; const float* dtb = A.in[21] + layer * 4;
    LAS float* qs = (LAS float*)F.lds; LAS float* ks = qs + 64 * GS; LAS float* vs = ks + 64 * GS; LAS float* Lm = vs + 64 * GS; LAS float* QK = Lm + 64 * GS2;
    LAS float* beta = QK + 64 * GS2; LAS float* gc = beta + 64; LAS float* egc = gc + 64;
    const int tid = F.tid, lane = F.lane, w = F.wave, l15 = lane & 15, q4 = lane >> 4;
    const int nunits = BH * 4 * NCH;
    for (int unit = F.bid; unit < nunits; unit += F.G) {
        const int c = unit % NCH, h = (unit / NCH) & 3, b = unit / (NCH * 4);
        const size_t tok0 = (size_t)b * SEQ + (size_t)c * 64;
        __syncthreads();
        for (int e = tid; e < 64 * 384; e += 512) { const int l = e / 384, cc = e % 384, part = cc >> 7, d = cc & 127, col = part * 512 + h * 128 + d;
            float acc = 0.f;
#pragma unroll
            for (int j = 0; j < 4; ++j) { const int tl = c * 64 + l - 3 + j; if (tl >= 0) acc += convw[j * 1536 + col] * bf2f(P[((size_t)b * SEQ + tl) * PW + C_GDN + col]); }
            (part == 0 ? qs : part == 1 ? ks : vs)[l * GS + d] = siluf_(acc); }
        if (tid < 64) { const size_t tok = tok0 + tid; beta[tid] = sigmoidf_(bf2f(P[tok * PW + C_GDN + 1536 + h]));
            float g = -expf(a_log[h]) * softplusf_(bf2f(P[tok * PW + C_GDN + 1540 + h]) + dtb[h]);
#pragma unroll
            for (int o = 1; o < 64; o <<= 1) { const float t = __shfl_up(g, o); if (lane >= o) g += t; }
            gc[tid] = g; egc[tid] = expf(g); }
        __syncthreads();
        for (int rr = 0; rr < 8; ++rr) { const int l = 8 * w + rr;
            const float q0 = qs[l * GS + lane], q1 = qs[l * GS + 64 + lane], k0 = ks[l * GS + lane], k1 = ks[l * GS + 64 + lane];
            const float sq = wave_sum(q0 * q0 + q1 * q1), sk = wave_sum(k0 * k0 + k1 * k1);
            const float iq = 0.08838834764831845f / sqrtf(sq + EPS), ik = 1.0f / sqrtf(sk + EPS);
            qs[l * GS + lane] = q0 * iq; qs[l * GS + 64 + lane] = q1 * iq; ks[l * GS + lane] = k0 * ik; ks[l * GS + 64 + lane] = k1 * ik; }
        __syncthreads();
        for (int tt = 0; tt < 4; ++tt) { const int tile = w * 4 + tt, which = tile >> 4, ti = (tile >> 2) & 3, tj = tile & 3;
            f32x4 acc = (f32x4){0.f, 0.f, 0.f, 0.f};
            if (tj <= ti) acc = tile_mm((which ? qs : ks) + 16 * ti * GS, GS, 1, ks + 16 * tj * GS, 1, GS, 128, acc, l15, q4);
            LAS float* dst = which ? QK : Lm;
#pragma unroll
            for (int r = 0; r < 4; ++r) { const int i = 16 * ti + 4 * q4 + r, j = 16 * tj + l15; float v = 0.f;
                if (which ? (j <= i) : (j < i)) v = acc[r] * expf(gc[i] - gc[j]) * (which ? 1.0f : beta[i]);
                dst[i * GS2 + j] = v; } }
        __syncthreads();
        float* rec = CHR + (size_t)unit * GDN_CHUNK_F;
        {
            const float glast = gc[63];
            for (int e = tid; e < 64 * 128; e += 512) { const int l = e >> 7, d = e & 127; rec[2 * 64 * 128 + e] = qs[l * GS + d] * egc[l]; rec[3 * 64 * 128 + e] = ks[l * GS + d] * expf(glast - gc[l]); }
            for (int e = tid; e < 64 * 64; e += 512) rec[4 * 64 * 128 + e] = QK[(e >> 6) * GS2 + (e & 63)];
            if (tid == 0) GL[unit] = expf(glast);
        }
        __syncthreads();
        for (int e = tid; e < 64 * 128; e += 512) { const int l = e >> 7, d = e & 127; vs[l * GS + d] *= beta[l]; qs[l * GS + d] = beta[l] * egc[l] * ks[l * GS + d]; }
        __syncthreads();
        for (int rb = 0; rb < 4; ++rb) {
            if (rb > 0) {
                LAS float* Xm = (w >> 2) ? qs : vs;
#pragma unroll
                for (int t2 = 0; t2 < 2; ++t2) { const int tj = 2 * (w & 3) + t2;
                    const f32x4 acc = tile_mm(Lm + 16 * rb * GS2, GS2, 1, Xm + 16 * tj, GS, 1, 16 * rb, (f32x4){0.f, 0.f, 0.f, 0.f}, l15, q4);
#pragma unroll
                    for (int r = 0; r < 4; ++r) Xm[(16 * rb + 4 * q4 + r) * GS + 16 * tj + l15] -= acc[r]; }
                __syncthreads();
            }
            if (tid < 256) { LAS float* Xm = (tid >> 7) ? qs : vs; const int col = tid & 127; float x[16];
#pragma unroll
                for (int i = 0; i < 16; ++i) { float sacc = Xm[(16 * rb + i) * GS + col];
#pragma unroll
                    for (int j = 0; j < i; ++j) sacc -= Lm[(16 * rb + i) * GS2 + 16 * rb + j] * x[j];
                    x[i] = sacc; }
#pragma unroll
                for (int i = 0; i < 16; ++i) Xm[(16 * rb + i) * GS + col] = x[i]; }
            __syncthreads();
        }
        for (int e = tid; e < 64 * 128; e += 512) { const int l = e >> 7, d = e & 127; rec[e] = vs[l * GS + d]; rec[64 * 128 + e] = qs[l * GS + d]; }
    }
    __syncthreads();
}
constexpr int GV = 36;
__device__ __forceinline__ void phase_gdn_g2(const Frame& F, const Args& A) {
    const float* CHR = WSP(float, G_CH); const float* GL = WSP(float, G_GL); float* GO = WSP(float, G_O);
    LAS float* S = (LAS float*)F.lds; LAS float* wl = S + 128 * GV; LAS float* qh = wl + 64 * GS; LAS float* kt = qh + 64 * GS; LAS float* qk = kt + 64 * GS; LAS float* vn = qk + 64 * GS2;
    const int tid = F.tid, lane = F.lane, w = F.wave, l15 = lane & 15, q4 = lane >> 4;
    const int nunits = BH * 4 * 4;
    for (int unit = F.bid; unit < nunits; unit += F.G) {
        const int vsl = unit & 3, h = (unit >> 2) & 3, b = unit >> 4;
        __syncthreads();
        for (int e = tid; e < 128 * GV; e += 512) S[e] = 0.f;
        for (int c = 0; c < NCH; ++c) {
            const int cu = (b * 4 + h) * NCH + c; const float* rec = CHR + (size_t)cu * GDN_CHUNK_F; const float egl = GL[cu];
            __syncthreads();
            for (int e = tid; e < 64 * 32; e += 512) { const int l = e >> 5, d4 = (e & 31) * 4;
                *(LAS f32x4*)(wl + l * GS + d4) = *(const f32x4*)(rec + 64 * 128 + l * 128 + d4);
                *(LAS f32x4*)(qh + l * GS + d4) = *(const f32x4*)(rec + 2 * 64 * 128 + l * 128 + d4);
                *(LAS f32x4*)(kt + l * GS + d4) = *(const f32x4*)(rec + 3 * 64 * 128 + l * 128 + d4); }
            for (int e = tid; e < 64 * 16; e += 512) { const int l = e >> 4, d4 = (e & 15) * 4; *(LAS f32x4*)(qk + l * GS2 + d4) = *(const f32x4*)(rec + 4 * 64 * 128 + l * 64 + d4); }
            __syncthreads();
            const int ti = w >> 1, tj = w & 1;
            {
                f32x4 acc = tile_mm(wl + 16 * ti * GS, GS, 1, S + 16 * tj, GV, 1, 128, (f32x4){0.f, 0.f, 0.f, 0.f}, l15, q4);
#pragma unroll
                for (int r = 0; r < 4; ++r) { const int l = 16 * ti + 4 * q4 + r; vn[l * GV + 16 * tj + l15] = rec[l * 128 + 32 * vsl + 16 * tj + l15] - acc[r]; }
            }
            __syncthreads();
            {
                f32x4 acc = tile_mm(qh + 16 * ti * GS, GS, 1, S + 16 * tj, GV, 1, 128, (f32x4){0.f, 0.f, 0.f, 0.f}, l15, q4);
                acc = tile_mm(qk + 16 * ti * GS2, GS2, 1, vn + 16 * tj, GV, 1, 64, acc, l15, q4);
#pragma unroll
                for (int r = 0; r < 4; ++r) { const size_t tok = (size_t)b * SEQ + (size_t)c * 64 + 16 * ti + 4 * q4 + r; GO[tok * 512 + h * 128 + 32 * vsl + 16 * tj + l15] = acc[r]; }
            }
            __syncthreads();
#pragma unroll
            for (int t2 = 0; t2 < 2; ++t2) {
                f32x4 acc;
#pragma unroll
                for (int r = 0; r < 4; ++r) acc[r] = S[(16 * w + 4 * q4 + r) * GV + 16 * t2 + l15] * egl;
                acc = tile_mm(kt + 16 * w, 1, GS, vn + 16 * t2, GV, 1, 64, acc, l15, q4);
#pragma unroll
                for (int r = 0; r < 4; ++r) S[(16 * w + 4 * q4 + r) * GV + 16 * t2 + l15] = acc[r];
            }
        }
    }
    __syncthreads();
}
__device__ __forceinline__ void phase_gdn_g3(const Frame& F, const Args& A, int layer) {
    const float* GO = WSP(float, G_O); const bf16* P = WSP(bf16, A_P); bf16* Y = WSP(bf16, A_Y) + (size_t)2 * TH * 512; const float* nw = A.in[22] + layer * 128;
    const int lane = F.lane, c0 = 8 * lane;
    for (int m = F.gw; m < TH; m += F.NGW) {
        const f32x4 a = *(const f32x4*)(GO + (size_t)m * 512 + c0), b2 = *(const f32x4*)(GO + (size_t)m * 512 + c0 + 4);
        float o[8] = {a.x, a.y, a.z, a.w, b2.x, b2.y, b2.z, b2.w}; float ss = 0.f;
#pragma unroll
        for (int q = 0; q < 8; ++q) ss += o[q] * o[q];
        ss += __shfl_xor(ss, 1); ss += __shfl_xor(ss, 2); ss += __shfl_xor(ss, 4); ss += __shfl_xor(ss, 8);
        const float rstd = 1.0f / sqrtf(ss * (1.0f / 128.0f) + EPS);
        const f32x4 z0 = ld_bf16x4(P + (size_t)m * PW + C_GDN + 1544 + c0), z1 = ld_bf16x4(P + (size_t)m * PW + C_GDN + 1544 + c0 + 4);
        const float z[8] = {z0.x, z0.y, z0.z, z0.w, z1.x, z1.y, z1.z, z1.w}; float y[8];
#pragma unroll
        for (int q = 0; q < 8; ++q) y[q] = o[q] * rstd * nw[(c0 + q) & 127] * siluf_(z[q]);
        u32x4 wv; wv.x = pk2(y[0], y[1]); wv.y = pk2(y[2], y[3]); wv.z = pk2(y[4], y[5]); wv.w = pk2(y[6], y[7]);
        *(u32x4*)(Y + (size_t)m * 512 + c0) = wv;
    }
}

__device__ __forceinline__ void phase_ssd_s1(const Frame& F, const Args& A, int layer) {
    const bf16* P = WSP(bf16, A_P); float* ST = WSP(float, S_ST); float* YD = WSP(float, S_YD); float* SC = WSP(float, S_C); float* AC = WSP(float, S_AC);
    const float* cw = A.in[23] + (size_t)layer * 4 * 1024; const float* cb = A.in[24] + layer * 1024; const float* dtb = A.in[25] + layer * 8; const float* a_log = A.in[26] + layer * 8; const float* dsk = A.in[27] + layer * 8;
    LAS float* X = (LAS float*)F.lds; LAS float* Bm = X + 64 * GS2; LAS float* Cm = Bm + 64 * GS; LAS float* M = Cm + 64 * GS; LAS float* Xd = M + 64 * GS2; LAS float* dt = Xd + 64 * GS2; LAS float* ac = dt + 64;
    const int tid = F.tid, lane = F.lane, w = F.wave, l15 = lane & 15, q4 = lane >> 4;
    const int nunits = BH * NCH * 8;
    for (int unit = F.bid; unit < nunits; unit += F.G) {
        const int h = unit & 7, c = (unit >> 3) % NCH, b = unit / (8 * NCH), g = h >> 2;
        const size_t tok0 = (size_t)b * SEQ + (size_t)c * 64;
        __syncthreads();
        for (int e = tid; e < 64 * 320; e += 512) { const int l = e / 320, cc = e % 320;
            const int cidx = cc < 64 ? h * 64 + cc : cc < 192 ? 512 + g * 128 + (cc - 64) : 768 + g * 128 + (cc - 192);
            float acc = cb[cidx];
#pragma unroll
            for (int j = 0; j < 4; ++j) { const int tl = c * 64 + l - 3 + j; if (tl >= 0) acc += cw[j * 1024 + cidx] * bf2f(P[((size_t)b * SEQ + tl) * PW + C_SSD + 512 + cidx]); }
            const float v = siluf_(acc);
            if (cc < 64) X[l * GS2 + cc]  = v; else if (cc < 192) Bm[l * GS + (cc - 64)] = v; else Cm[l * GS + (cc - 192)] = v; }
        if (tid < 64) { const float d = softplusf_(bf2f(P[(tok0 + tid) * PW + C_SSD + 1536 + h]) + dtb[h]); float a = -expf(a_log[h]) * d;
#pragma unroll
            for (int o = 1; o < 64; o <<= 1) { const float t = __shfl_up(a, o); if (lane >= o) a += t; }
            dt[tid] = d; ac[tid] = a; AC[(tok0 + tid) * 8 + h] = a; }
        __syncthreads();
        for (int tt = 0; tt < 2; ++tt) { const int tile = w * 2 + tt, ti = tile >> 2, tj = tile & 3; f32x4 acc = (f32x4){0.f, 0.f, 0.f, 0.f};
            if (tj <= ti) acc = tile_mm(Cm + 16 * ti * GS, GS, 1, Bm + 16 * tj * GS, 1, GS, 128, acc, l15, q4);
#pragma unroll
            for (int r = 0; r < 4; ++r) { const int l = 16 * ti + 4 * q4 + r, s = 16 * tj + l15; M[l * GS2 + s] = (s <= l) ? acc[r] * expf(ac[l] - ac[s]) * dt[s] : 0.f; } }
        for (int e = tid; e < 64 * 64; e += 512) { const int l = e >> 6, p = e & 63; Xd[l * GS2 + p] = X[l * GS2 + p] * dt[l] * expf(ac[63] - ac[l]); }
        if ((h & 3) == 0) for (int e = tid; e < 64 * 128; e += 512) { const int l = e >> 7, n = e & 127; SC[(tok0 + l) * 256 + g * 128 + n] = Cm[l * GS + n]; }
        __syncthreads();
        for (int tt = 0; tt < 2; ++tt) { const int tile = w * 2 + tt, ti = tile >> 2, tj = tile & 3;
            const f32x4 acc = tile_mm(M + 16 * ti * GS2, GS2, 1, X + 16 * tj, GS2, 1, 64, (f32x4){0.f, 0.f, 0.f, 0.f}, l15, q4);
#pragma unroll
            for (int r = 0; r < 4; ++r) { const int l = 16 * ti + 4 * q4 + r, p = 16 * tj + l15; YD[(tok0 + l) * 512 + h * 64 + p] = acc[r] + dsk[h] * X[l * GS2 + p]; } }
        float* st = ST + (size_t)unit * 64 * 128;
        for (int tt = 0; tt < 4; ++tt) { const int tile = w * 4 + tt, ti = tile >> 3, tj = tile & 7;
            const f32x4 acc = tile_mm(Xd + 16 * ti, 1, GS2, Bm + 16 * tj, GS, 1, 64, (f32x4){0.f, 0.f, 0.f, 0.f}, l15, q4);
#pragma unroll
            for (int r = 0; r < 4; ++r) st[(16 * ti + 4 * q4 + r) * 128 + 16 * tj + l15] = acc[r]; }
    }
    __syncthreads();
}
__device__ __forceinline__ void phase_ssd_s2(const Frame& F, const Args& A) {
    float* ST = WSP(float, S_ST); const float* AC = WSP(float, S_AC);
    for (int idx = F.bid * 512 + F.tid; idx < BH * 8 * 8192; idx += F.G * 512) { const int e = idx & 8191, h = (idx >> 13) & 7, b = idx >> 16;
        float Hs = 0.f;
        for (int c = 0; c < NCH; ++c) { float* p = ST + ((size_t)((b * NCH + c) * 8 + h)) * 8192 + e; const float tmp = *p; *p = Hs;
            Hs = expf(AC[((size_t)b * SEQ + c * 64 + 63) * 8 + h]) * Hs + tmp; } }
}
__device__ __forceinline__ void phase_ssd_s3(const Frame& F, const Args& A) {
    const float* ST = WSP(float, S_ST); float* YD = WSP(float, S_YD); const float* SC = WSP(float, S_C); const float* AC = WSP(float, S_AC);
    LAS float* Cm = (LAS float*)F.lds; LAS float* Hs = Cm + 64 * GS;
    const int tid = F.tid, lane = F.lane, w = F.wave, l15 = lane & 15, q4 = lane >> 4;
    const int nunits = BH * NCH * 8;
    for (int unit = F.bid; unit < nunits; unit += F.G) {
        const int h = unit & 7, c = (unit >> 3) % NCH, b = unit / (8 * NCH), g = h >> 2;
        const size_t tok0 = (size_t)b * SEQ + (size_t)c * 64; const float* st = ST + (size_t)unit * 8192;
        __syncthreads();
        for (int e = tid; e < 64 * 32; e += 512) { const int l = e >> 5, d4 = (e & 31) * 4;
            *(LAS f32x4*)(Cm + l * GS + d4) = *(const f32x4*)(SC + (tok0 + l) * 256 + g * 128 + d4); *(LAS f32x4*)(Hs + l * GS + d4) = *(const f32x4*)(st + l * 128 + d4); }
        __syncthreads();
        for (int tt = 0; tt < 2; ++tt) { const int tile = w * 2 + tt, ti = tile >> 2, tj = tile & 3;
            const f32x4 acc = tile_mm(Cm + 16 * ti * GS, GS, 1, Hs + 16 * tj * GS, 1, GS, 128, (f32x4){0.f, 0.f, 0.f, 0.f}, l15, q4);
#pragma unroll
            for (int r = 0; r < 4; ++r) { const int l = 16 * ti + 4 * q4 + r, p = 16 * tj + l15; const size_t o = (tok0 + l) * 512 + h * 64 + p; YD[o] += acc[r] * expf(AC[(tok0 + l) * 8 + h]); } }
    }
    __syncthreads();
}
__device__ __forceinline__ void phase_ssd_s4(const Frame& F, const Args& A, int layer) {
    const float* YD = WSP(float, S_YD); const bf16* P = WSP(bf16, A_P); bf16* Y = WSP(bf16, A_Y) + (size_t)3 * TH * 512; const float* nw = A.in[28] + layer * 512;
    const int lane = F.lane, c0 = 8 * lane;
    for (int m = F.gw; m < TH; m += F.NGW) {
        const f32x4 a = *(const f32x4*)(YD + (size_t)m * 512 + c0), b2 = *(const f32x4*)(YD + (size_t)m * 512 + c0 + 4);
        const f32x4 z0 = ld_bf16x4(P + (size_t)m * PW + C_SSD + c0), z1 = ld_bf16x4(P + (size_t)m * PW + C_SSD + c0 + 4);
        float y[8] = {a.x * siluf_(z0.x), a.y * siluf_(z0.y), a.z * siluf_(z0.z), a.w * siluf_(z0.w), b2.x * siluf_(z1.x), b2.y * siluf_(z1.y), b2.z * siluf_(z1.z), b2.w * siluf_(z1.w)};
        float ss = 0.f;
#pragma unroll
        for (int q = 0; q < 8; ++q) ss += y[q] * y[q];
        ss += __shfl_xor(ss, 1); ss += __shfl_xor(ss, 2); ss += __shfl_xor(ss, 4); ss += __shfl_xor(ss, 8); ss += __shfl_xor(ss, 16);
        const float rstd = 1.0f / sqrtf(ss * (1.0f / 256.0f) + EPS);
#pragma unroll
        for (int q = 0; q < 8; ++q) y[q] = y[q] * rstd * nw[c0 + q];
        u32x4 wv; wv.x = pk2(y[0], y[1]); wv.y = pk2(y[2], y[3]); wv.z = pk2(y[4], y[5]); wv.w = pk2(y[6], y[7]);
        *(u32x4*)(Y + (size_t)m * 512 + c0) = wv;
    }
}

__device__ __forceinline__ void phase_merge_z(const Frame& F, const Args& A) {
    for (int i = 0; i < 4; ++i) {
        pg8::Gemm g{WSP(bf16, A_Y) + (size_t)i * TH * 512, WSP(bf16, W_BR) + (size_t)i * D * 512, 512, 512}; pg8::StaticOrder S; S.init(TH, D, F.G, F.bid);
        EpiBf16 E{WSP(bf16, A_Z) + i * D, 4096, nullptr, 0}; pg8::gemm_phase(F.lds, g, S, E, F.tid);
        __syncthreads();
    }
}
__device__ __forceinline__ void phase_merge_gate(const Frame& F, const Args& A, int layer) {
    pg8::Gemm g{WSP(bf16, A_H), WSP(bf16, W_GATE), D, D}; pg8::StaticOrder S; S.init(TH, 4096, F.G, F.bid);
    EpiMerge E{WSP(bf16, A_Z), A.in[29] + (size_t)layer * 4 * D, WSP(bf16, A_MG)}; pg8::gemm_phase(F.lds, g, S, E, F.tid);
}
__device__ __forceinline__ void phase_merge_out(const Frame& F, const Args& A, const float* xin, float* xout) {
    pg8::Gemm g{WSP(bf16, A_MG), WSP(bf16, W_OUT), D, D}; pg8::StaticOrder S; S.init(TH, D, F.G, F.bid);
    EpiResidual E{xin, xout}; pg8::gemm_phase(F.lds, g, S, E, F.tid);
}
__device__ __forceinline__ void phase_ffn_gu(const Frame& F, const Args& A) {
    pg8::Gemm g{WSP(bf16, A_H), WSP(bf16, W_FGU), D, D}; pg8::StaticOrder S; S.init(TH, 2 * FF_D, F.G, F.bid);
    EpiSwiGLU E{WSP(bf16, F_ACT), FF_D, 1 << 20}; pg8::gemm_phase(F.lds, g, S, E, F.tid);
}
__device__ __forceinline__ void phase_ffn_down(const Frame& F, const Args& A, float* x) {
    pg8::Gemm g{WSP(bf16, F_ACT), WSP(bf16, W_FDN), FF_D, FF_D}; pg8::StaticOrder S; S.init(TH, D, F.G, F.bid);
    EpiResidual E{x, x}; pg8::gemm_phase(F.lds, g, S, E, F.tid);
}
struct MoeLayout { int pstart[NEXP + 1]; };
__device__ __forceinline__ MoeLayout moe_layout(const unsigned* cnt) {
    MoeLayout L; int s = 0;
#pragma unroll
    for (int e = 0; e < NEXP; ++e) { L.pstart[e] = s; s += ((int)cnt[e] + 255) & ~255; }
    L.pstart[NEXP] = s; return L;
}
struct MoeOrder {
    int np, nN, G, c; MoeLayout L;
    __device__ bool next(int i, Unit& u) const {
        const long Lx = (long)i * G + c; if (Lx >= (long)np * nN) return false;
        const int pm = (int)(Lx / nN), pn = (int)(Lx % nN); int e = 0;
#pragma unroll
        for (int k = 1; k < NEXP; ++k) if (pm * 256 >= L.pstart[k]) e = k;
        u.pm = pm; u.pn = e * nN + pn; return true;
    }
    __device__ __forceinline__ void a_ready(const Unit&) const {}
    __device__ __forceinline__ void done(const Unit&) const {}
};
__device__ __forceinline__ void phase_moe_route(const Frame& F, const Args& A, int half) {
    const unsigned* cnt = F.ctl + CW_CNT + half * 16; unsigned* fill = F.ctl + CW_FILL + half * 16;
    const MoeLayout L = moe_layout(cnt);
    const bf16* H = WSP(bf16, A_H); bf16* GA = WSP(bf16, F_GA); const int* tope = WSP(int, F_TOPE); int* slot = WSP(int, F_SLOT);
    const int lane = F.lane;
    for (int m = F.gw; m < TH; m += F.NGW) {
        const u32x4 v0 = *(const u32x4*)(H + (size_t)m * D + 8 * lane), v1 = *(const u32x4*)(H + (size_t)m * D + 512 + 8 * lane);
#pragma unroll
        for (int k = 0; k < 2; ++k) { const int e = tope[2 * m + k]; int s = 0;
            int ps = 0;
#pragma unroll
            for (int q = 0; q < NEXP; ++q) ps = (e == q) ? L.pstart[q] : ps;
            if (lane == 0) s = ps + (int)ATOMIC_ADD_U32(fill + e, 1u);
            s = __shfl(s, 0);
            if (lane == 0) slot[2 * m + k] = s;
            *(u32x4*)(GA + (size_t)s * D + 8 * lane) = v0; *(u32x4*)(GA + (size_t)s * D + 512 + 8 * lane) = v1; }
    }
#pragma unroll
    for (int e = 0; e < NEXP; ++e) { const int r0 = L.pstart[e] + (int)cnt[e], r1 = L.pstart[e + 1];
        for (int r = r0 + F.gw; r < r1; r += F.NGW) { *(u32x4*)(GA + (size_t)r * D + 8 * lane) = (u32x4){0u, 0u, 0u, 0u}; *(u32x4*)(GA + (size_t)r * D + 512 + 8 * lane) = (u32x4){0u, 0u, 0u, 0u}; } }
}
__device__ __forceinline__ void phase_moe_gu(const Frame& F, const Args& A, int half) {
    MoeOrder S; S.L = moe_layout(F.ctl + CW_CNT + half * 16); S.np = S.L.pstart[NEXP] / 256; S.nN = 2 * FF_E / 256; S.G = F.G; S.c = F.bid;
    pg8::Gemm g{WSP(bf16, F_GA), WSP(bf16, W_FGU), D, D}; EpiSwiGLU E{WSP(bf16, F_ACT), FF_E, 2 * FF_E / 256}; pg8::gemm_phase(F.lds, g, S, E, F.tid);
}
struct EpiF32Mod {
    static constexpr bool PERM = false, AFTER_DRAIN = false;
    float* C;
    __device__ __forceinline__ void operator()(const f32x4 (&acc)[2][2][4][2], const Unit& u, int wr, int wc, int fr, int fq) const {
        const int row0 = u.pm * 256 + wr * 64 + fr, col0 = (u.pn & 3) * 256 + wc * 32 + 4 * fq;
#pragma unroll
        for (int ai = 0; ai < 2; ++ai)
#pragma unroll
            for (int m = 0; m < 4; ++m) { float* rowp = C + (size_t)(row0 + ai * HALFT + m * 16) * D + col0;
#pragma unroll
                for (int bj = 0; bj < 2; ++bj)
#pragma unroll
                    for (int n = 0; n < 2; ++n) *(f32x4*)(rowp + bj * HALFT + n * 16) = acc[ai][bj][m][n]; }
    }
};
__device__ __forceinline__ void phase_moe_down(const Frame& F, const Args& A, int half) {
    MoeOrder S; S.L = moe_layout(F.ctl + CW_CNT + half * 16); S.np = S.L.pstart[NEXP] / 256; S.nN = D / 256; S.G = F.G; S.c = F.bid;
    pg8::Gemm g{WSP(bf16, F_ACT), WSP(bf16, W_FDN), FF_E, FF_E}; EpiF32Mod E{WSP(float, F_YE)}; pg8::gemm_phase(F.lds, g, S, E, F.tid);
}
__device__ __forceinline__ void phase_moe_combine(const Frame& F, const Args& A, float* x) {
    const float* YE = WSP(float, F_YE); const int* slot = WSP(int, F_SLOT); const float* topw = WSP(float, F_TOPW); const int lane = F.lane;
    for (int m = F.gw; m < TH; m += F.NGW) { const int s0 = slot[2 * m], s1 = slot[2 * m + 1]; const float w0 = topw[2 * m], w1 = topw[2 * m + 1];
#pragma unroll
        for (int j = 0; j < 4; ++j) { const int c = 4 * lane + 256 * j; float* xp = x + (size_t)m * D + c;
            *(f32x4*)xp = *(const f32x4*)xp + *(const f32x4*)(YE + (size_t)s0 * D + c) * w0 + *(const f32x4*)(YE + (size_t)s1 * D + c) * w1; } }
}

#ifndef EMU
#define XB_TMO      128
#define XB_XCNT(j)  (256  + 64 * (j))
#define XB_XSUB(j)  (1280 + 64 * (j))
#define XB_XGEN(j)  (2304 + 64 * (j))
#define XB_TOP      3328
#define XB_TOPGEN   3392
#define XCD_BAR_WORDS 3456
#define XB_SPIN_CAP (1u << 22)
__device__ __forceinline__ unsigned xb_ld(unsigned* p)              { return __hip_atomic_load(p, __ATOMIC_RELAXED, __HIP_MEMORY_SCOPE_AGENT); }
__device__ __forceinline__ unsigned xb_add(unsigned* p, unsigned v) { return __hip_atomic_fetch_add(p, v, __ATOMIC_RELAXED, __HIP_MEMORY_SCOPE_AGENT); }
__device__ __forceinline__ unsigned xb_xcc_id() { return (unsigned)__builtin_amdgcn_s_getreg((3 << 11) | 20) & 0xFu; }
#define XB_SPIN(cond, bar) do { unsigned _sp = 0; while (cond) { __builtin_amdgcn_s_sleep(1); \
    if ((++_sp & 255u) == 0u) { if (xb_ld(&(bar)[XB_TMO])) break; if (_sp > XB_SPIN_CAP) { atomicAdd(&(bar)[XB_TMO], 1u); break; } } } } while (0)
struct XcdBarrier { unsigned* bar; unsigned x; volatile LAS unsigned* st; };
__device__ __forceinline__ XcdBarrier xcd_barrier_post(unsigned* bar, volatile LAS unsigned* st) {
    XcdBarrier b; b.bar = bar; b.x = xb_xcc_id(); b.st = st;
    if (threadIdx.x == 0) (void)xb_add(&bar[XB_XCNT(b.x)], 1u);
    return b;
}
__device__ __forceinline__ void xcd_barrier_complete(unsigned* bar, unsigned x, unsigned& nloc, unsigned& nx) {
    const unsigned G = gridDim.x * gridDim.y * gridDim.z;
    unsigned sum, cnt, mine, sp = 0u;
    for (;;) {
        sum = 0u; cnt = 0u; mine = 0u;
#pragma unroll
        for (unsigned j = 0; j < 16; ++j) { const unsigned c = xb_ld(&bar[XB_XCNT(j)]); sum += c; cnt += (c > 0u) ? 1u : 0u; mine = (j == x) ? c : mine; }
        if (sum == G) break;
        __builtin_amdgcn_s_sleep(1);
        if ((++sp & 255u) == 0u) { if (xb_ld(&bar[XB_TMO])) break; if (sp > XB_SPIN_CAP) { atomicAdd(&bar[XB_TMO], 1u); break; } }
    }
    nloc = mine > 0u ? mine : 1u; nx = cnt > 0u ? cnt : 1u;
}
__device__ __forceinline__ void xcd_barrier(const XcdBarrier& b) {
    asm volatile("s_waitcnt vmcnt(0)" ::: "memory");
    __syncthreads();
    if (threadIdx.x == 0) {
        unsigned* bar = b.bar;
        __builtin_amdgcn_s_waitcnt(0);
        unsigned nloc = b.st[0], nx = b.st[1];
        if (nloc == 0u) { xcd_barrier_complete(bar, b.x, nloc, nx); b.st[0] = nloc; b.st[1] = nx; }
        const unsigned old = xb_add(&bar[XB_XSUB(b.x)], 1u);
        const unsigned gen = old / nloc;
        if (old + 1u == (gen + 1u) * nloc) {
            __builtin_amdgcn_fence(__ATOMIC_RELEASE, "agent");
            asm volatile("s_waitcnt vmcnt(0)" ::: "memory");
            const unsigned og = xb_add(&bar[XB_TOP], 1u);
            const unsigned tg = og / nx;
            if (og + 1u == (tg + 1u) * nx) xb_add(&bar[XB_TOPGEN], 1u);
            else XB_SPIN(xb_ld(&bar[XB_TOPGEN]) == tg, bar);
            __builtin_amdgcn_fence(__ATOMIC_ACQUIRE, "agent");
            xb_add(&bar[XB_XGEN(b.x)], 1u);
            asm volatile("s_waitcnt vmcnt(0)" ::: "memory");
        } else {
            XB_SPIN(xb_ld(&bar[XB_XGEN(b.x)]) == gen, bar);
            __builtin_amdgcn_fence(__ATOMIC_ACQUIRE, "agent");
            asm volatile("s_waitcnt vmcnt(0)" ::: "memory");
        }
    }
    __syncthreads();
}
#endif

constexpr int NPH = 25;
constexpr int NPHASES = DEPTH * (1 + NHALF * NPH) + 1;
constexpr int LDS_BYTES = 155648, MISC_OFF = 154624;

__global__ void __launch_bounds__(512, 2) fwd_kernel(Args args_k) {
#ifdef EMU
    unsigned char* lds = emu_lds_ptr;
#else
    extern __shared__ __attribute__((aligned(16))) unsigned char lds[];
#endif
    Frame F0;
    F0.lds = (LAS unsigned char*)lds; F0.tid = threadIdx.x; F0.lane = F0.tid & 63; F0.wave = RFL(F0.tid >> 6); F0.G = gridDim.x; F0.bid = blockIdx.x;
    F0.gw = F0.bid * 8 + F0.wave; F0.NGW = F0.G * 8;
    F0.out = args_k.out; F0.ws = args_k.ws; F0.ctl = (unsigned*)(args_k.ws + WS_CTL);
    const int lo = args_k.lo, hi = args_k.hi;
#ifndef EMU
    volatile LAS unsigned* misc = (volatile LAS unsigned*)(F0.lds + MISC_OFF);
    if (F0.tid < 4) misc[F0.tid] = 0u;
    __syncthreads();
    XcdBarrier bar; bar.bar = F0.ctl + CW_BAR; bar.x = 0; bar.st = misc;
    if (hi - lo > 1) bar = xcd_barrier_post(F0.ctl + CW_BAR, misc);
#define GRID_BAR() do { XcdBarrier bq = bar; asm volatile("" : "+s"(bq.bar), "+s"(bq.x)); xcd_barrier(bq); } while (0)
#else
#define GRID_BAR() do { } while (0)
#endif
    int ph = 0;
#ifndef PH_MASK
#define PH_MASK 0xFFFFFFFFFFFFFFFFull
#endif
#define PHASE(...) PHASE_I(0, __VA_ARGS__)
#ifdef EMU
#define LAUNDER(Fq) do { } while (0)
#else
#define LAUNDER(Fq) do { unsigned mq_ = ~0u; asm volatile("" : "+s"(Fq.G), "+s"(Fq.bid), "+s"(Fq.wave), "+s"(Fq.ws), "+s"(Fq.out), "+s"(Fq.ctl), "+s"(mq_)); Fq.lane = (int)__builtin_amdgcn_mbcnt_hi(mq_, __builtin_amdgcn_mbcnt_lo(mq_, 0u)); Fq.tid = Fq.wave * 64 + Fq.lane; Fq.gw = Fq.bid * 8 + Fq.wave; Fq.NGW = Fq.G * 8; } while (0)
#endif
#ifdef EMU
#define ARGS_Q() const Args& args_q = args_k
#else
#define ARGS_Q() const __attribute__((address_space(4))) Args* aq_ = (const __attribute__((address_space(4))) Args*)__builtin_amdgcn_kernarg_segment_ptr(); asm volatile("" : "+s"(aq_)); const Args& args_q = *(const Args*)aq_
#endif
#define PHASE_I(id, ...) do { if (ph >= lo && ph < hi) { { Frame Fq = F0; LAUNDER(Fq); const Frame& F = Fq; ARGS_Q(); const Args& args = args_q; __VA_ARGS__; } if (ph + 1 < hi) GRID_BAR(); } ++ph; } while (0)
#define SEGMENT(layer, half) do { \
            const size_t r0 = (size_t)(half) * TH; \
            const float* xin = ((layer) == 0 ? args_k.in[0] : F0.out) + r0 * D; float* xo = F0.out + r0 * D; \
            PHASE(phase_norm<false>(F, args, xin, args.in[2] + (layer) * D, WSP(bf16, A_H), nullptr, nullptr, nullptr, nullptr); phase_rope_table(F, args, (const int*)args.in[1] + r0, WSP(float, A_ROPE))); \
            PHASE({ pg8::Gemm g{WSP(bf16, A_H), WSP(bf16, W_IN), D, D}; pg8::StaticOrder S; S.init(TH, PW, F.G, F.bid); EpiBf16 E{WSP(bf16, A_P), PW, nullptr, 0}; pg8::gemm_phase(F.lds, g, S, E, F.tid); }); \
            PHASE(phase_mla_prep(F, args)); \
            PHASE(phase_mla_q(F, args)); \
            PHASE(phase_mla_kv(F, args)); \
            PHASE(phase_attention(F, args)); \
            PHASE(phase_rwkv_prep(F, args, layer)); \
            PHASE(phase_rwkv_lora(F, args)); \
            PHASE(phase_rwkv_scan(F, args, layer)); \
            PHASE(phase_rwkv_post(F, args, layer)); \
            PHASE(phase_gdn_g1(F, args, layer)); \
            PHASE(phase_gdn_g2(F, args)); \
            PHASE(phase_gdn_g3(F, args, layer)); \
            PHASE(phase_ssd_s1(F, args, layer)); \
            PHASE(phase_ssd_s2(F, args)); \
            PHASE(phase_ssd_s3(F, args)); \
            PHASE(phase_ssd_s4(F, args, layer)); \
            PHASE(phase_merge_z(F, args)); \
            PHASE(phase_merge_gate(F, args, layer)); \
            PHASE(phase_merge_out(F, args, xin, xo)); \
            if ((layer) == 0) { \
                PHASE(phase_norm<false>(F, args, xo, args.in[32] + (layer) * D, WSP(bf16, A_H), nullptr, nullptr, nullptr, nullptr)); \
                PHASE(phase_ffn_gu(F, args)); \
                PHASE(phase_ffn_down(F, args, xo)); \
                PHASE((void)0); \
                PHASE((void)0); \
            } else { \
                PHASE(phase_norm<true>(F, args, xo, args.in[32] + (layer) * D, WSP(bf16, A_H), args.in[35], WSP(int, F_TOPE), WSP(float, F_TOPW), F.ctl + CW_CNT + (half) * 16)); \
                PHASE(phase_moe_route(F, args, half)); \
                PHASE(phase_moe_gu(F, args, half)); \
                PHASE(phase_moe_down(F, args, half)); \
                PHASE(phase_moe_combine(F, args, xo)); \
            } } while (0)
    static_assert(DEPTH == 2 && NHALF <= 2, "segment program");
    PHASE(phase_convert(F, args, 0));
    SEGMENT(0, 0);
    if (NHALF == 2) SEGMENT(0, 1);
    PHASE(phase_convert(F, args, 1));
    SEGMENT(1, 0);
    if (NHALF == 2) SEGMENT(1, 1);
#undef SEGMENT
    PHASE(phase_final_norm(F, args, F.out, args.in[38]));
#undef PHASE
}

#ifndef ONE_LAUNCH
#define ONE_LAUNCH 1
#endif
extern "C" void kernel_launch(void* const* d_in, const int* in_sizes, int n_in, void* d_out, int out_size, void* d_ws, size_t ws_size, hipStream_t stream) {
    static int grid = 0;
    if (grid == 0) {
#ifdef EMU
        grid = EMU_GRID;
#else
        if (n_in != 39 || out_size != T * D || ws_size < WS_NEED) { fprintf(stderr, "kernel_launch: unexpected problem (n_in %d out %d ws %zu need %zu)\n", n_in, out_size, ws_size, (size_t)WS_NEED); grid = -1; return; }
        int dev = 0, cus = 0;
        if (hipGetDevice(&dev) != hipSuccess || hipDeviceGetAttribute(&cus, hipDeviceAttributeMultiprocessorCount, dev) != hipSuccess) { grid = -1; return; }
        if (hipFuncSetAttribute((const void*)fwd_kernel, hipFuncAttributeMaxDynamicSharedMemorySize, LDS_BYTES) != hipSuccess) { fprintf(stderr, "kernel_launch: hipFuncSetAttribute failed\n"); grid = -1; return; }
        int per_cu = 0;
        if (hipOccupancyMaxActiveBlocksPerMultiprocessor(&per_cu, (const void*)fwd_kernel, 512, LDS_BYTES) != hipSuccess || per_cu < 1) fprintf(stderr, "kernel_launch: occupancy query reports %d\n", per_cu);
        (void)hipGetLastError();
        grid = cus;
#endif
    }
    if (grid < 0) return;
    (void)hipMemsetAsync((char*)d_ws + WS_CTL, 0, CTL_BYTES, stream);
    Args a{};
    for (int i = 0; i < 39; ++i) a.in[i] = (const float*)d_in[i];
    a.out = (float*)d_out; a.ws = (unsigned char*)d_ws;
#ifdef EMU
    for (int p = EMU_PH_LO; p < EMU_PH_HI && p < NPHASES; ++p) { a.lo = p; a.hi = p + 1; emu_launch(fwd_kernel, grid, 512, a); emu_after_phase(p); }
#else
#if ONE_LAUNCH
    a.lo = 0; a.hi = NPHASES;
    hipLaunchKernelGGL(fwd_kernel, dim3(grid), dim3(512), LDS_BYTES, stream, a);
#else
    for (int p = 0; p < NPHASES; ++p) { a.lo = p; a.hi = p + 1; hipLaunchKernelGGL(fwd_kernel, dim3(grid), dim3(512), LDS_BYTES, stream, a); }
#endif
#endif
}
```

```cpp
#ifndef EMU
#include <hip/hip_runtime.h>
#include <cstdio>
#include <cstdint>
#endif

#ifdef EMU
constexpr int BATCH = EMU_B, SEQ = EMU_S, NHALF = EMU_NHALF;
#else
constexpr int BATCH = 16, SEQ = 2048, NHALF = 2;
#endif
constexpr int D = 1024, DEPTH = 2, CH = 64;
constexpr int T = BATCH * SEQ, TH = T / NHALF, BH = BATCH / NHALF, NCH = SEQ / CH;
constexpr int C_MLA = 0, C_RWKV = 704, C_GDN = 2528, C_SSD = 4584, C_GATE = 6128, IN_COLS = 10224, PW = 6144;
constexpr int FF_D = 2816, FF_E = 3584, NEXP = 8;
constexpr int MOE_ROWS = ((TH * 2 + NEXP * 255) / 256) * 256;
constexpr float EPS = 1e-6f;
static_assert(TH % 256 == 0 && SEQ % 128 == 0 && BATCH % NHALF == 0, "shape");

typedef unsigned short bf16;
typedef float f32x4 __attribute__((ext_vector_type(4)));
typedef float f32x2 __attribute__((ext_vector_type(2)));
typedef short bf16x8 __attribute__((ext_vector_type(8)));
typedef short bf16x4 __attribute__((ext_vector_type(4)));
typedef unsigned u32x4 __attribute__((ext_vector_type(4)));
typedef unsigned u32x2 __attribute__((ext_vector_type(2)));
#ifdef EMU
#define LAS
#define GAS
#define MFMA_F32(a, b, c) emu_mfma_16x16x4f32(a, b, c)
#define MFMA_BF16(a, b, c) emu_mfma_16x16x32bf16(a, b, c)
#define ATOMIC_ADD_U32(p, v) emu_atomic_add_u32(p, v)
#define RFL(x) (x)
#define LDS_WAIT()
#define VM_WAIT()
__device__ __forceinline__ float fast_exp(float x) { return expf(x); }
__device__ __forceinline__ float fast_rcp(float x) { return 1.0f / x; }
__device__ __forceinline__ float fast_rsqrt(float x) { return 1.0f / sqrtf(x); }
#else
#define LAS __attribute__((address_space(3)))
#define GAS __attribute__((address_space(1)))
#define MFMA_F32(a, b, c) __builtin_amdgcn_mfma_f32_16x16x4f32(a, b, c, 0, 0, 0)
#define MFMA_BF16(a, b, c) __builtin_amdgcn_mfma_f32_16x16x32_bf16(a, b, c, 0, 0, 0)
#define ATOMIC_ADD_U32(p, v) __hip_atomic_fetch_add(p, v, __ATOMIC_RELAXED, __HIP_MEMORY_SCOPE_AGENT)
#define RFL(x) __builtin_amdgcn_readfirstlane(x)
#define LDS_WAIT() asm volatile("s_waitcnt lgkmcnt(0)" ::: "memory")
#define VM_WAIT() asm volatile("s_waitcnt vmcnt(0)" ::: "memory")
__device__ __forceinline__ float fast_exp(float x) { return __expf(x); }
__device__ __forceinline__ float fast_rcp(float x) { return __builtin_amdgcn_rcpf(x); }
__device__ __forceinline__ float fast_rsqrt(float x) { return __builtin_amdgcn_rsqf(x); }
#endif
__device__ __forceinline__ unsigned f2u(float f) { return __builtin_bit_cast(unsigned, f); }
__device__ __forceinline__ float u2f(unsigned u) { return __builtin_bit_cast(float, u); }
__device__ __forceinline__ unsigned f2bf(float f) { unsigned u = f2u(f); return (u + 0x7fffu + ((u >> 16) & 1u)) >> 16; }
__device__ __forceinline__ float bf2f(unsigned h) { return u2f(h << 16); }
__device__ __forceinline__ unsigned pk2(float lo, float hi) { return f2bf(lo) | (f2bf(hi) << 16); }
__device__ __forceinline__ float sigmoidf_(float x) { return 1.0f / (1.0f + expf(-x)); }
__device__ __forceinline__ float siluf_(float x) { return x / (1.0f + expf(-x)); }
__device__ __forceinline__ float softplusf_(float x) { return x > 20.f ? x : log1pf(expf(x)); }
__device__ __forceinline__ float wave_sum(float v) {
#pragma unroll
    for (int o = 1; o < 64; o <<= 1) v += __shfl_xor(v, o);
    return v;
}
__device__ __forceinline__ float wave_max(float v) {
#pragma unroll
    for (int o = 1; o < 64; o <<= 1) v = fmaxf(v, __shfl_xor(v, o));
    return v;
}
__device__ __forceinline__ f32x4 ld_bf16x4(const bf16* p) { const u32x2 w = *(const u32x2*)p; return (f32x4){bf2f(w.x & 0xffffu), bf2f(w.x >> 16), bf2f(w.y & 0xffffu), bf2f(w.y >> 16)}; }
__device__ __forceinline__ void st_bf16x4(bf16* p, f32x4 v) { u32x2 w; w.x = pk2(v.x, v.y); w.y = pk2(v.z, v.w); *(u32x2*)p = w; }

namespace pg8 {
#define PG8_LAS LAS
typedef unsigned short bf16_t;
constexpr int BM = 256, BK = 64, HALF = 128, HTB = HALF * BK * 2, STAGE_BYTES = 8 * HTB, NXCD = 8, WGM = 8;
__host__ __device__ __forceinline__ int lds_byte(int r, int c) { const int st = (r >> 4) * 2 + (c >> 5), rr = r & 15, cc = c & 31, ob = rr * 64 + cc * 2; return st * 1024 + (ob ^ (((ob >> 9) & 1) << 5)); }
__host__ __device__ __forceinline__ void stage_rc(int b, int& R, int& C) { const int st = b / 1024, sb = b % 1024, swz = sb ^ (((sb >> 9) & 1) << 5); R = (st >> 1) * 16 + swz / 64; C = (st & 1) * 32 + (swz % 64) / 2; }
__host__ __device__ __forceinline__ int perm32(int rho) { const int n = rho >> 4, i = rho & 15; return 8 * (i >> 2) + 4 * n + (i & 3); }
struct Unit { int pm, pn; };
struct Gemm { const bf16_t* A; const bf16_t* Bt; int lda, K; };
struct StaticOrder {
    int nM, nN, nwg, G, c;
    __host__ __device__ void init(int M, int N, int G_, int c_) { nM = M / BM; nN = N / BM; nwg = nM * nN; G = G_; c = c_; }
    __host__ __device__ bool next(int i, Unit& u) const {
        const long L = (long)i * G + c; if (L >= nwg) return false;
        int wgid = (int)L; { const int q = nwg / NXCD, r = nwg % NXCD, xcd = wgid % NXCD, off = wgid / NXCD; wgid = (xcd < r ? xcd * (q + 1) : r * (q + 1) + (xcd - r) * q) + off; }
        const int nig = WGM * nN, gid = wgid / nig, fm = gid * WGM, gsz = (nM - fm) < WGM ? (nM - fm) : WGM;
        u.pm = fm + ((wgid % nig) % gsz); u.pn = (wgid % nig) / gsz; return true;
    }
    __device__ __forceinline__ void a_ready(const Unit&) const {}
    __device__ __forceinline__ void done(const Unit&) const {}
};
#ifndef EMU
template <class Epi, class Sched>
__device__ __forceinline__ void gemm_phase(PG8_LAS unsigned char* lds, const Gemm g, const Sched& S, const Epi& E, const int tid) {
    const int wid = __builtin_amdgcn_readfirstlane(tid >> 6), lane = tid & 63, wr = wid >> 2, wc = wid & 3, fr = lane & 15, fq = lane >> 4;
    int Kq = g.K; asm volatile("" : "+s"(Kq));
    const int K = Kq, nt = K / BK, lda = g.lda;
    unsigned voffA[2], voffB[2];
#pragma unroll
    for (int i = 0; i < 2; ++i) { int R, C; stage_rc(tid * 16 + i * 8192, R, C); const int Rb = Epi::PERM ? ((R & ~31) + perm32(R & 31)) : R;
        voffA[i] = (unsigned)(R * lda + C) * 2u; voffB[i] = (unsigned)(Rb * K + C) * 2u; }
    const size_t kstep = (size_t)(BK * 2);
    const size_t hstep = (size_t)HALF * K * 2, hstepA = (size_t)HALF * lda * 2;
    const size_t tstep = 2 * hstep, tstepA = 2 * hstepA;
    const unsigned ldsw = (unsigned)wid * 1024u;
    const int aoff = lds_byte(wr * 64 + fr, fq * 8), boff = lds_byte(wc * 32 + fr, fq * 8);
#define PG8_SA(b, h) (((b) * 2 + (h)) * HTB)
#define PG8_SB(b, h) ((4 + (b) * 2 + (h)) * HTB)
#define PG8_STAGE(bufoff, gbase, voff) do { _Pragma("unroll") for (int _i = 0; _i < 2; ++_i) \
        __builtin_amdgcn_global_load_lds((const unsigned*)((const char*)(gbase) + (voff)[_i]), (PG8_LAS unsigned*)(lds + (bufoff) + ldsw + _i * 8192), 16, 0, 0); } while (0)
#define PG8_LDA(dst, b, h) do { _Pragma("unroll") for (int m = 0; m < 4; ++m) _Pragma("unroll") for (int k = 0; k < 2; ++k) dst[m][k] = *(const PG8_LAS bf16x8*)(lds + PG8_SA(b, h) + aoff + m * 2048 + k * 1024); } while (0)
#define PG8_LDB(dst, b, h) do { _Pragma("unroll") for (int n = 0; n < 2; ++n) _Pragma("unroll") for (int k = 0; k < 2; ++k) dst[n][k] = *(const PG8_LAS bf16x8*)(lds + PG8_SB(b, h) + boff + n * 2048 + k * 1024); } while (0)
#define PG8_MMA(ai, bj, At, Bt) do { __builtin_amdgcn_s_setprio(1); _Pragma("unroll") for (int m = 0; m < 4; ++m) _Pragma("unroll") for (int n = 0; n < 2; ++n) _Pragma("unroll") for (int k = 0; k < 2; ++k) \
        acc[ai][bj][m][n] = __builtin_amdgcn_mfma_f32_16x16x32_bf16(Bt[n][k], At[m][k], acc[ai][bj][m][n], 0, 0, 0); __builtin_amdgcn_s_setprio(0); } while (0)
#define PG8_WAIT_V(n) asm volatile("s_waitcnt vmcnt(" #n ")" ::: "memory")
#define PG8_WAIT_L(n) asm volatile("s_waitcnt lgkmcnt(" #n ")" ::: "memory")
#define PG8_BAR __builtin_amdgcn_s_barrier()
#define PG8_SCHED __builtin_amdgcn_sched_barrier(0)
    Unit cur, nxt; int ui = 0;
    if (!S.next(0, cur)) return;
    f32x4 acc[2][2][4][2];
#pragma unroll
    for (int a = 0; a < 2; ++a)
#pragma unroll
        for (int b = 0; b < 2; ++b)
#pragma unroll
            for (int m = 0; m < 4; ++m)
#pragma unroll
                for (int n = 0; n < 2; ++n) acc[a][b][m][n] = (f32x4){0.f, 0.f, 0.f, 0.f};
    bf16x8 At[4][2], B0[2][2], B1[2][2];
    const char* cA = (const char*)g.A + (size_t)cur.pm * tstepA; const char* cB = (const char*)g.Bt + (size_t)cur.pn * tstep;
    S.a_ready(cur);
    PG8_STAGE(PG8_SB(0, 0), cB, voffB); PG8_STAGE(PG8_SA(0, 0), cA, voffA); PG8_STAGE(PG8_SB(0, 1), cB + hstep, voffB); PG8_STAGE(PG8_SA(0, 1), cA + hstepA, voffA);
    if (wr == 1) PG8_BAR;
    PG8_WAIT_V(4); PG8_BAR;
    PG8_STAGE(PG8_SB(1, 0), cB + kstep, voffB); PG8_STAGE(PG8_SA(1, 0), cA + kstep, voffA); PG8_STAGE(PG8_SB(1, 1), cB + hstep + kstep, voffB);
    PG8_WAIT_V(6); PG8_BAR;
    for (;;) {
        const bool has_next = S.next(ui + 1, nxt);
        const char* nA = has_next ? (const char*)g.A + (size_t)nxt.pm * tstepA : cA; const char* nB = has_next ? (const char*)g.Bt + (size_t)nxt.pn * tstep : cB;
        for (int t = 0; t < nt; t += 2) {
            const bool last = (t == nt - 2);
            const char* a1 = cA + (size_t)(t + 1) * kstep;
            const char* a2 = last ? nA : cA + (size_t)(t + 2) * kstep; const char* b2 = last ? nB : cB + (size_t)(t + 2) * kstep;
            const char* a3 = a2 + kstep; const char* b3 = b2 + kstep;
            if (last && has_next) S.a_ready(nxt);
            PG8_LDB(B0, 0, 0); PG8_SCHED; PG8_LDA(At, 0, 0); PG8_STAGE(PG8_SA(1, 1), a1 + hstepA, voffA);
            PG8_WAIT_L(8); PG8_BAR; PG8_WAIT_L(0); PG8_MMA(0, 0, At, B0); PG8_BAR; PG8_SCHED;
            PG8_LDB(B1, 0, 1); PG8_STAGE(PG8_SB(0, 0), b2, voffB);
            PG8_BAR; PG8_WAIT_L(0); PG8_MMA(0, 1, At, B1); PG8_BAR;
            PG8_LDA(At, 0, 1); PG8_STAGE(PG8_SA(0, 0), a2, voffA);
            PG8_BAR; PG8_WAIT_L(0); PG8_MMA(1, 0, At, B0); PG8_BAR; PG8_SCHED;
            PG8_STAGE(PG8_SB(0, 1), b2 + hstep, voffB);
            PG8_WAIT_V(6); PG8_BAR; PG8_MMA(1, 1, At, B1); PG8_BAR;
            PG8_LDB(B0, 1, 0); PG8_SCHED; PG8_LDA(At, 1, 0); PG8_STAGE(PG8_SA(0, 1), a2 + hstepA, voffA);
            PG8_WAIT_L(8); PG8_BAR; PG8_WAIT_L(0); PG8_MMA(0, 0, At, B0); PG8_BAR; PG8_SCHED;
            PG8_LDB(B1, 1, 1); PG8_STAGE(PG8_SB(1, 0), b3, voffB);
            PG8_BAR; PG8_WAIT_L(0); PG8_MMA(0, 1, At, B1); PG8_BAR;
            PG8_LDA(At, 1, 1); PG8_STAGE(PG8_SA(1, 0), a3, voffA);
            PG8_BAR; PG8_WAIT_L(0); PG8_MMA(1, 0, At, B0); PG8_BAR; PG8_SCHED;
            PG8_STAGE(PG8_SB(1, 1), b3 + hstep, voffB);
            PG8_WAIT_V(6); PG8_BAR; PG8_MMA(1, 1, At, B1); PG8_BAR;
        }
        if constexpr (!Epi::AFTER_DRAIN) { E(acc, cur, wr, wc, fr, fq); S.done(cur); }
        if (!has_next) break;
#pragma unroll
        for (int a = 0; a < 2; ++a)
#pragma unroll
            for (int b = 0; b < 2; ++b)
#pragma unroll
                for (int m = 0; m < 4; ++m)
#pragma unroll
                    for (int n = 0; n < 2; ++n) acc[a][b][m][n] = (f32x4){0.f, 0.f, 0.f, 0.f};
        cur = nxt; cA = nA; cB = nB; ++ui;
    }
    PG8_WAIT_V(0);
    if (wr == 0) PG8_BAR;
    PG8_BAR;
    if constexpr (Epi::AFTER_DRAIN) { E.fused(acc, cur, wr, wc, fr, fq, lds, wid, lane); S.done(cur); }
#undef PG8_SA
#undef PG8_SB
#undef PG8_STAGE
#undef PG8_LDA
#undef PG8_LDB
#undef PG8_MMA
#undef PG8_WAIT_V
#undef PG8_WAIT_L
#undef PG8_BAR
#undef PG8_SCHED
}
#else
template <class Epi, class Sched>
__device__ __forceinline__ void gemm_phase(PG8_LAS unsigned char* lds, const Gemm g, const Sched& S, const Epi& E, const int tid) {
    const int wid = tid >> 6, lane = tid & 63, wr = wid >> 2, wc = wid & 3, fr = lane & 15, fq = lane >> 4;
    Unit cur;
    for (int ui = 0; S.next(ui, cur); ++ui) {
        f32x4 acc[2][2][4][2];
        for (int ai = 0; ai < 2; ++ai) for (int m = 0; m < 4; ++m) {
            const size_t row = (size_t)cur.pm * 256 + ai * 128 + wr * 64 + m * 16 + fr;
            const bf16_t* ap = g.A + row * g.lda;
            for (int bj = 0; bj < 2; ++bj) for (int n = 0; n < 2; ++n) for (int j = 0; j < 4; ++j) {
                const size_t col = (size_t)cur.pn * 256 + bj * 128 + wc * 32 + (Epi::PERM ? 8 * fq + 4 * n : 16 * n + 4 * fq) + j;
                const bf16_t* bp = g.Bt + col * g.K; float s = 0.f;
                for (int k = 0; k < g.K; ++k) s += bf2f(ap[k]) * bf2f(bp[k]);
                acc[ai][bj][m][n][j] = s; } }
        E(acc, cur, wr, wc, fr, fq);
    }
    __syncthreads();
}
#endif
}

using pg8::Unit;
constexpr int HALFT = 128;
struct EpiF32 {
    static constexpr bool PERM = false, AFTER_DRAIN = false;
    float* C; int ldc;
    __device__ __forceinline__ void operator()(const f32x4 (&acc)[2][2][4][2], const Unit& u, int wr, int wc, int fr, int fq) const {
        const int row0 = u.pm * 256 + wr * 64 + fr, col0 = u.pn * 256 + wc * 32 + 4 * fq;
#pragma unroll
        for (int ai = 0; ai < 2; ++ai)
#pragma unroll
            for (int m = 0; m < 4; ++m) { float* rowp = C + (size_t)(row0 + ai * HALFT + m * 16) * ldc + col0;
#pragma unroll
                for (int bj = 0; bj < 2; ++bj)
#pragma unroll
                    for (int n = 0; n < 2; ++n) *(f32x4*)(rowp + bj * HALFT + n * 16) = acc[ai][bj][m][n]; }
    }
};
struct EpiResidual {
    static constexpr bool PERM = false, AFTER_DRAIN = false;
    const float* res; float* out;
    __device__ __forceinline__ void operator()(const f32x4 (&acc)[2][2][4][2], const Unit& u, int wr, int wc, int fr, int fq) const {
        const int row0 = u.pm * 256 + wr * 64 + fr, col0 = u.pn * 256 + wc * 32 + 4 * fq;
#pragma unroll
        for (int ai = 0; ai < 2; ++ai)
#pragma unroll
            for (int m = 0; m < 4; ++m) { const size_t o = (size_t)(row0 + ai * HALFT + m * 16) * D + col0;
#pragma unroll
                for (int bj = 0; bj < 2; ++bj)
#pragma unroll
                    for (int n = 0; n < 2; ++n) { const f32x4 r = *(const f32x4*)(res + o + bj * HALFT + n * 16); *(f32x4*)(out + o + bj * HALFT + n * 16) = r + acc[ai][bj][m][n]; } }
    }
};
struct EpiBf16 {
    static constexpr bool PERM = true, AFTER_DRAIN = false;
    bf16* O; int ldc; const float* rowscale; int rs_stride;
    __device__ __forceinline__ void operator()(const f32x4 (&acc)[2][2][4][2], const Unit& u, int wr, int wc, int fr, int fq) const {
        const int row0 = u.pm * 256 + wr * 64 + fr, col0 = u.pn * 256 + wc * 32 + 8 * fq;
#pragma unroll
        for (int ai = 0; ai < 2; ++ai)
#pragma unroll
            for (int m = 0; m < 4; ++m) { const int row = row0 + ai * HALFT + m * 16; bf16* rowp = O + (size_t)row * ldc + col0;
                const float sc = rowscale ? rowscale[(size_t)row * rs_stride] : 1.0f;
#pragma unroll
                for (int bj = 0; bj < 2; ++bj) { const f32x4 v0 = acc[ai][bj][m][0] * sc, v1 = acc[ai][bj][m][1] * sc;
                    u32x4 w; w.x = pk2(v0[0], v0[1]); w.y = pk2(v0[2], v0[3]); w.z = pk2(v1[0], v1[1]); w.w = pk2(v1[2], v1[3]);
                    *(u32x4*)(rowp + bj * HALFT) = w; } }
    }
};
struct EpiSwiGLU {
    static constexpr bool PERM = true, AFTER_DRAIN = false;
    bf16* O; int ldc; int ntile;
    __device__ __forceinline__ void operator()(const f32x4 (&acc)[2][2][4][2], const Unit& u, int wr, int wc, int fr, int fq) const {
        const int row0 = u.pm * 256 + wr * 64 + fr, col0 = (u.pn % ntile) * 128 + wc * 32 + 8 * fq;
#pragma unroll
        for (int ai = 0; ai < 2; ++ai)
#pragma unroll
            for (int m = 0; m < 4; ++m) { bf16* rowp = O + (size_t)(row0 + ai * HALFT + m * 16) * ldc + col0;
                float a[8];
#pragma unroll
                for (int n = 0; n < 2; ++n)
#pragma unroll
                    for (int j = 0; j < 4; ++j) { const float g = acc[ai][0][m][n][j], up = acc[ai][1][m][n][j]; a[4 * n + j] = g * fast_rcp(1.0f + fast_exp(-g)) * up; }
                u32x4 w; w.x = pk2(a[0], a[1]); w.y = pk2(a[2], a[3]); w.z = pk2(a[4], a[5]); w.w = pk2(a[6], a[7]);
                *(u32x4*)rowp = w; }
    }
};
struct EpiMerge {
    static constexpr bool PERM = false, AFTER_DRAIN = false;
    const bf16* Z; const float* gate_b; bf16* MG;
    __device__ __forceinline__ void operator()(const f32x4 (&acc)[2][2][4][2], const Unit& u, int wr, int wc, int fr, int fq) const {
        const int row0 = u.pm * 256 + wr * 64 + fr, col = u.pn * 64 + wc * 16 + 4 * fq;
        f32x4 gb[4];
#pragma unroll
        for (int i = 0; i < 4; ++i) gb[i] = *(const f32x4*)(gate_b + i * D + col);
#pragma unroll
        for (int ai = 0; ai < 2; ++ai)
#pragma unroll
            for (int m = 0; m < 4; ++m) { const size_t row = (size_t)(row0 + ai * HALFT + m * 16);
                f32x4 s = (f32x4){0.f, 0.f, 0.f, 0.f};
#pragma unroll
                for (int bj = 0; bj < 2; ++bj)
#pragma unroll
                    for (int n = 0; n < 2; ++n) { const int i = 2 * bj + n; const f32x4 z = ld_bf16x4(Z + row * 4096 + i * D + col); const f32x4 a = acc[ai][bj][m][n] + gb[i];
#pragma unroll
                        for (int j = 0; j < 4; ++j) s[j] += z[j] * fast_rcp(1.0f + fast_exp(-a[j])); }
                st_bf16x4(MG + row * D + col, s); }
    }
};

constexpr size_t MiB = 1u << 20;
constexpr size_t al(size_t x) { return (x + 255) & ~(size_t)255; }
constexpr size_t WS_CTL = 0, CTL_BYTES = 1 * MiB;
constexpr size_t W_IN = 1 * MiB;
constexpr size_t W_GATE = W_IN + (size_t)PW * D * 2;
constexpr size_t W_UQ = W_GATE + (size_t)4096 * D * 2;
constexpr size_t W_UKV = W_UQ + (size_t)768 * 384 * 2;
constexpr size_t W_LORA = W_UKV + (size_t)1024 * 256 * 2;
constexpr size_t W_BR = W_LORA + (size_t)1536 * 384 * 2;
constexpr size_t W_OUT = W_BR + (size_t)4 * 1024 * 512 * 2;
constexpr size_t W_FGU = W_OUT + (size_t)D * D * 2;
constexpr size_t W_FDN = W_FGU + (size_t)NEXP * 2 * FF_E * D * 2;
constexpr size_t W_END = W_FDN + (size_t)NEXP * D * FF_E * 2;
constexpr size_t A_H = al(W_END);
constexpr size_t A_ROPE = A_H + (size_t)TH * D * 2;
constexpr size_t A_Y = A_ROPE + (size_t)TH * 64 * 4;
constexpr size_t A_P = A_Y + (size_t)4 * TH * 512 * 2;
constexpr size_t A_MIX = A_P + (size_t)TH * PW * 2;
constexpr size_t M_STAT = A_MIX;
constexpr size_t M_KR = M_STAT + (size_t)TH * 2 * 4;
constexpr size_t M_Q = M_KR + (size_t)TH * 64 * 2;
constexpr size_t M_KV = M_Q + (size_t)TH * 768 * 2;
constexpr size_t M_END = M_KV + (size_t)TH * 1024 * 2;
constexpr size_t R_RKV = A_MIX;
constexpr size_t R_LIN = R_RKV + (size_t)TH * 1536 * 2;
constexpr size_t R_LOUT = R_LIN + (size_t)TH * 384 * 2;
constexpr size_t R_REC = R_LOUT + (size_t)TH * 1536 * 4;
constexpr size_t R_O = R_REC + (size_t)BH * 8 * NCH * 92416;
constexpr size_t R_END = R_O + (size_t)TH * 512 * 4;
constexpr int GDN_CHUNK_F = 4 * 64 * 128 + 64 * 64;
constexpr size_t G_CH = A_MIX;
constexpr size_t G_GL = G_CH + (size_t)BH * 4 * NCH * GDN_CHUNK_F * 4;
constexpr size_t G_O = G_GL + al((size_t)BH * 4 * NCH * 4);
constexpr size_t G_END = G_O + (size_t)TH * 512 * 4;
constexpr size_t S_ST = A_MIX;
constexpr size_t S_YD = S_ST + (size_t)BH * NCH * 8 * 64 * 128 * 4;
constexpr size_t S_C = S_YD + (size_t)TH * 512 * 4;
constexpr size_t S_AC = S_C + (size_t)TH * 256 * 4;
constexpr size_t S_END = S_AC + (size_t)TH * 8 * 4;
constexpr size_t A_Z = A_P;
constexpr size_t A_MG = A_MIX;
constexpr size_t F_ACT = A_P;
constexpr size_t F_GA = F_ACT + (size_t)MOE_ROWS * FF_E * 2;
constexpr size_t F_YE = F_GA + (size_t)MOE_ROWS * D * 2;
constexpr size_t F_TOPE = F_YE + (size_t)MOE_ROWS * D * 4;
constexpr size_t F_TOPW = F_TOPE + (size_t)TH * 2 * 4;
constexpr size_t F_SLOT = F_TOPW + (size_t)TH * 2 * 4;
constexpr size_t F_END = F_SLOT + (size_t)TH * 2 * 4;
constexpr size_t cmax(size_t a, size_t b) { return a > b ? a : b; }
constexpr size_t WS_NEED = cmax(cmax(cmax(M_END, R_END), cmax(G_END, S_END)), F_END);
#ifndef EMU
static_assert(WS_NEED <= (size_t)896 * MiB, "workspace");
#endif
constexpr int CW_BAR = 4096;
constexpr int CW_CNT = 16384;
constexpr int CW_FILL = 16384 + 64;

#ifdef EMU
#define WAVE_SYNC() emu_wave_sync()
#else
#define WAVE_SYNC() do { asm volatile("s_waitcnt lgkmcnt(0)" ::: "memory"); } while (0)
#endif
struct Frame {
    LAS unsigned char* lds; int tid, lane, wave, G, gw, NGW, bid;
    float* out; unsigned char* ws; unsigned* ctl;
};
struct Args { const float* in[39]; float* out; unsigned char* ws; int lo, hi; };
#define WSP(type, off) ((type*)(F.ws + (off)))

template <class FN>
__device__ __forceinline__ void cvt_matrix(const Frame& F, const float* W, int ldw, int K, bf16* WT, int Ndst, const float* kscale, FN srccol) {
    LAS float* scr = (LAS float*)(F.lds + F.wave * 16384);
    const int nblk = Ndst / 32, nitems = (K / 64) * nblk, lane = F.lane;
    for (int item = F.gw; item < nitems; item += F.NGW) {
        const int kb = item / nblk, nb = item % nblk, k0 = 64 * kb, n0 = 32 * nb;
        const int sc = srccol(n0 + (lane & 31));
#pragma unroll 8
        for (int i = 0; i < 32; ++i) { const int kk = 2 * i + (lane >> 5); float v = sc >= 0 ? W[(size_t)(k0 + kk) * ldw + sc] : 0.f; if (kscale) v *= kscale[k0 + kk]; scr[kk * 33 + (lane & 31)] = v; }
        WAVE_SYNC();
        const int c = lane & 7;
#pragma unroll
        for (int j = 0; j < 4; ++j) { const int n = (lane >> 3) + 8 * j; const LAS float* s = scr + (8 * c) * 33 + n;
            u32x4 o; o.x = pk2(s[0 * 33], s[1 * 33]); o.y = pk2(s[2 * 33], s[3 * 33]); o.z = pk2(s[4 * 33], s[5 * 33]); o.w = pk2(s[6 * 33], s[7 * 33]);
            *(u32x4*)(WT + (size_t)(n0 + n) * K + k0 + 8 * c) = o; }
        WAVE_SYNC();
    }
}
__device__ __forceinline__ void phase_convert(const Frame& F, const Args& A, int layer) {
    const float* w_in = A.in[3] + (size_t)layer * D * IN_COLS;
    cvt_matrix(F, w_in, IN_COLS, D, WSP(bf16, W_IN), PW, nullptr, [](int n) { return n < C_GATE ? n : -1; });
    cvt_matrix(F, w_in, IN_COLS, D, WSP(bf16, W_GATE), 4096, nullptr, [](int n) {
        const int pn = n >> 8, c = n & 255, bj = c >> 7, wc = (c >> 5) & 3, nn = (c >> 4) & 1, r = c & 15; return C_GATE + (2 * bj + nn) * D + 64 * pn + 16 * wc + r; });
    cvt_matrix(F, A.in[6] + (size_t)layer * 384 * 768, 768, 384, WSP(bf16, W_UQ), 768, A.in[4] + layer * 384, [](int n) { return n; });
    cvt_matrix(F, A.in[7] + (size_t)layer * 256 * 1024, 1024, 256, WSP(bf16, W_UKV), 1024, A.in[5] + layer * 256, [](int n) { return n; });
    for (int i = 0; i < 4; ++i) cvt_matrix(F, A.in[30] + ((size_t)layer * 4 + i) * 512 * D, D, 512, WSP(bf16, W_BR) + (size_t)i * D * 512, D, nullptr, [](int n) { return n; });
    cvt_matrix(F, A.in[31] + (size_t)layer * D * D, D, D, WSP(bf16, W_OUT), D, nullptr, [](int n) { return n; });
    if (layer == 0) {
        cvt_matrix(F, A.in[33], 2 * FF_D, D, WSP(bf16, W_FGU), 2 * FF_D, nullptr, [](int n) { const int pn = n >> 8, c = n & 255; return c < 128 ? 128 * pn + c : FF_D + 128 * pn + (c - 128); });
        cvt_matrix(F, A.in[34], D, FF_D, WSP(bf16, W_FDN), D, nullptr, [](int n) { return n; });
    } else {
        for (int e = 0; e < NEXP; ++e) {
            cvt_matrix(F, A.in[36] + (size_t)e * D * 2 * FF_E, 2 * FF_E, D, WSP(bf16, W_FGU) + (size_t)e * 2 * FF_E * D, 2 * FF_E, nullptr, [](int n) { const int pn = n >> 8, c = n & 255; return c < 128 ? 128 * pn + c : FF_E + 128 * pn + (c - 128); });
            cvt_matrix(F, A.in[37] + (size_t)e * FF_E * D, D, FF_E, WSP(bf16, W_FDN) + (size_t)e * D * FF_E, D, nullptr, [](int n) { return n; });
        }
    }
    { const float* w2 = A.in[10] + (size_t)layer * 64 * 512; const float* a2 = A.in[12] + (size_t)layer * 64 * 512; const float* g2 = A.in[13] + (size_t)layer * 160 * 512;
      bf16* L = WSP(bf16, W_LORA);
      for (int idx = F.bid * 512 + F.tid; idx < 1536 * 384; idx += F.G * 512) { const int n = idx / 384, k = idx % 384; float v = 0.f;
          if (n < 512) { if (k < 64) v = w2[k * 512 + n]; } else if (n < 1024) { if (k >= 64 && k < 128) v = a2[(k - 64) * 512 + (n - 512)]; } else { if (k >= 128 && k < 288) v = g2[(k - 128) * 512 + (n - 1024)]; }
          L[idx] = (bf16)f2bf(v); } }
}

template <bool ROUTER>
__device__ __forceinline__ void phase_norm(const Frame& F, const Args& A, const float* xin, const float* gain, bf16* H, const float* router, int* tope, float* topw, unsigned* cnt) {
    const int lane = F.lane;
    f32x4 gv[4];
#pragma unroll
    for (int j = 0; j < 4; ++j) gv[j] = *(const f32x4*)(gain + 4 * lane + 256 * j);
    for (int m = F.gw; m < TH; m += F.NGW) {
        const float* xr = xin + (size_t)m * D; f32x4 v[4]; float ss = 0.f;
#pragma unroll
        for (int j = 0; j < 4; ++j) { v[j] = *(const f32x4*)(xr + 4 * lane + 256 * j); ss += (v[j].x * v[j].x + v[j].y * v[j].y) + (v[j].z * v[j].z + v[j].w * v[j].w); }
        const float rstd = 1.0f / sqrtf(wave_sum(ss) * (1.0f / D) + EPS);
#pragma unroll
        for (int j = 0; j < 4; ++j) { v[j] = v[j] * rstd * gv[j]; st_bf16x4(H + (size_t)m * D + 4 * lane + 256 * j, v[j]); }
        if (ROUTER) {
            float lg[8];
#pragma unroll
            for (int e = 0; e < 8; ++e) lg[e] = 0.f;
#pragma unroll
            for (int j = 0; j < 4; ++j)
#pragma unroll
                for (int q = 0; q < 4; ++q) { const float* rp = router + (size_t)(4 * lane + 256 * j + q) * 8; const f32x4 r0 = *(const f32x4*)rp, r1 = *(const f32x4*)(rp + 4); const float hv = v[j][q];
                    lg[0] += hv * r0.x; lg[1] += hv * r0.y; lg[2] += hv * r0.z; lg[3] += hv * r0.w; lg[4] += hv * r1.x; lg[5] += hv * r1.y; lg[6] += hv * r1.z; lg[7] += hv * r1.w; }
#pragma unroll
            for (int e = 0; e < 8; ++e) lg[e] = wave_sum(lg[e]);
            if (lane == 0) {
                int e1 = 0; float l1 = lg[0];
#pragma unroll
                for (int e = 1; e < 8; ++e) if (lg[e] > l1) { l1 = lg[e]; e1 = e; }
                int e2 = -1; float l2 = -3.0e38f;
#pragma unroll
                for (int e = 0; e < 8; ++e) if (e != e1 && lg[e] > l2) { l2 = lg[e]; e2 = e; }
                const float w1 = 1.0f / (1.0f + expf(l2 - l1));
                tope[2 * m] = e1; tope[2 * m + 1] = e2; topw[2 * m] = w1; topw[2 * m + 1] = 1.0f - w1;
                ATOMIC_ADD_U32(cnt + e1, 1u); ATOMIC_ADD_U32(cnt + e2, 1u);
            }
        }
    }
}
__device__ __forceinline__ void phase_rope_table(const Frame& F, const Args& A, const int* pos, float* rope) {
    for (int idx = F.bid * 512 + F.tid; idx < TH * 32; idx += F.G * 512) { const int t = idx >> 5, i = idx & 31;
        const float inv = powf(10000.0f, -(float)i / 32.0f);
        const float ang = (float)pos[t] * inv; float sn, cs; sincosf(ang, &sn, &cs);
        rope[(size_t)t * 64 + i] = cs; rope[(size_t)t * 64 + 32 + i] = sn; }
}
__device__ __forceinline__ void phase_final_norm(const Frame& F, const Args& A, float* x, const float* gain) {
    const int lane = F.lane;
    for (int m = F.gw; m < T; m += F.NGW) {
        float* xr = x + (size_t)m * D; f32x4 v[4]; float ss = 0.f;
#pragma unroll
        for (int j = 0; j < 4; ++j) { v[j] = *(const f32x4*)(xr + 4 * lane + 256 * j); ss += (v[j].x * v[j].x + v[j].y * v[j].y) + (v[j].z * v[j].z + v[j].w * v[j].w); }
        const float rstd = 1.0f / sqrtf(wave_sum(ss) * (1.0f / D) + EPS);
#pragma unroll
        for (int j = 0; j < 4; ++j) *(f32x4*)(xr + 4 * lane + 256 * j) = v[j] * rstd * *(const f32x4*)(gain + 4 * lane + 256 * j);
    }
}

__device__ __forceinline__ void phase_mla_prep(const Frame& F, const Args& A) {
    bf16* P = WSP(bf16, A_P); bf16* kr = WSP(bf16, M_KR); const float* rope = WSP(float, A_ROPE);
    const int lane = F.lane;
    for (int m = F.gw; m < TH; m += F.NGW) {
        bf16* pr = P + (size_t)m * PW; float sq = 0.f, skv = 0.f; f32x4 v[3];
#pragma unroll
        for (int j = 0; j < 3; ++j) { const int c = 4 * lane + 256 * j; v[j] = ld_bf16x4(pr + c); const float s = (v[j].x * v[j].x + v[j].y * v[j].y) + (v[j].z * v[j].z + v[j].w * v[j].w);
            if (c < 384) sq += s; else if (c < 640) skv += s; }
        sq = wave_sum(sq); skv = wave_sum(skv);
        const float rq = 1.0f / sqrtf(sq * (1.0f / 384.0f) + EPS), rkv = 1.0f / sqrtf(skv * (1.0f / 256.0f) + EPS);
#pragma unroll
        for (int j = 0; j < 3; ++j) { const int c = 4 * lane + 256 * j; if (c < 640) st_bf16x4(pr + c, v[j] * (c < 384 ? rq : rkv)); }
        if (lane < 32) { const float x1 = bf2f(pr[640 + lane]), x2 = bf2f(pr[672 + lane]), c = rope[(size_t)m * 64 + lane], s = rope[(size_t)m * 64 + 32 + lane];
            kr[(size_t)m * 64 + lane] = (bf16)f2bf(x1 * c - x2 * s); kr[(size_t)m * 64 + 32 + lane] = (bf16)f2bf(x2 * c + x1 * s); }
    }
}
__device__ __forceinline__ void phase_mla_q(const Frame& F, const Args& A) {
    pg8::Gemm g{WSP(bf16, A_P) + 0, WSP(bf16, W_UQ), PW, 384}; pg8::StaticOrder S; S.init(TH, 768, F.G, F.bid);
    EpiBf16 E{WSP(bf16, M_Q), 768, nullptr, 0}; pg8::gemm_phase(F.lds, g, S, E, F.tid);
}
__device__ __forceinline__ void phase_mla_kv(const Frame& F, const Args& A) {
    pg8::Gemm g{WSP(bf16, A_P) + 384, WSP(bf16, W_UKV), PW, 256}; pg8::StaticOrder S; S.init(TH, 1024, F.G, F.bid);
    EpiBf16 E{WSP(bf16, M_KV), 1024, nullptr, 0}; pg8::gemm_phase(F.lds, g, S, E, F.tid);
}
constexpr int AT_KS = 200, AT_VS = 72;
__device__ __forceinline__ void phase_attention(const Frame& F, const Args& A) {
    const bf16* Q = WSP(bf16, M_Q); const bf16* KV = WSP(bf16, M_KV); const bf16* KR = WSP(bf16, M_KR); const float* rope = WSP(float, A_ROPE); bf16* Y = WSP(bf16, A_Y);
    LAS bf16* Ks = (LAS bf16*)F.lds; LAS bf16* Vt = (LAS bf16*)(F.lds + 64 * AT_KS * 2);
    const int lane = F.lane, w = F.wave, l15 = lane & 15, q4 = lane >> 4, tid = F.tid;
    const int NQB = SEQ / 128, nunits = BH * 4 * NQB;
    const float scale = 0.07216878364870322f;
    for (int unit = F.bid; unit < nunits; unit += F.G) {
        const int qb = NQB - 1 - (unit % NQB), bh = unit / NQB, h = bh & 3, b = bh >> 2;
        const size_t t0 = (size_t)b * SEQ;
        const size_t tq = t0 + qb * 128 + w * 16 + l15;
        bf16x8 qf[6];
#pragma unroll
        for (int ks = 0; ks < 6; ++ks) qf[ks] = *(const bf16x8*)(Q + tq * 768 + h * 192 + 32 * ks + 8 * q4);
        {
            bf16x8 a = qf[4], c2 = qf[5];
#pragma unroll
            for (int j = 0; j < 8; ++j) { const float x1 = bf2f((unsigned short)a[j]), x2 = bf2f((unsigned short)c2[j]), c = rope[tq * 64 + 8 * q4 + j], s = rope[tq * 64 + 32 + 8 * q4 + j];
                qf[4][j] = (short)f2bf(x1 * c - x2 * s); qf[5][j] = (short)f2bf(x2 * c + x1 * s); }
        }
        f32x4 o[8];
#pragma unroll
        for (int mb = 0; mb < 8; ++mb) o[mb] = (f32x4){0.f, 0.f, 0.f, 0.f};
        float mrow = -3.0e38f, lrow = 0.f;
        const int qchunk = 2 * qb + (w >> 2), ntile = 2 * qb + 2;
        for (int kt = 0; kt < ntile; ++kt) {
            __syncthreads();
            const size_t k0 = t0 + (size_t)kt * 64;
#pragma unroll
            for (int i = 0; i < 3; ++i) { const int idx = tid + 512 * i, key = idx / 24, c = idx % 24;
                const u32x4 v = (c < 16) ? *(const u32x4*)(KV + (k0 + key) * 1024 + h * 256 + 8 * c) : *(const u32x4*)(KR + (k0 + key) * 64 + 8 * (c - 16));
                *(LAS u32x4*)(Ks + key * AT_KS + 8 * c) = v; }
#pragma unroll
            for (int i = 0; i < 2; ++i) { const int idx = tid + 512 * i, key = idx >> 4, c = idx & 15;
                const bf16x8 v = *(const bf16x8*)(KV + (k0 + key) * 1024 + h * 256 + 128 + 8 * c);
#pragma unroll
                for (int j = 0; j < 8; ++j) Vt[(8 * c + j) * AT_VS + key] = (bf16)v[j]; }
            __syncthreads();
            if (kt <= qchunk) {
                f32x4 st[4];
#pragma unroll
                for (int kb = 0; kb < 4; ++kb) { st[kb] = (f32x4){0.f, 0.f, 0.f, 0.f};
#pragma unroll
                    for (int ks = 0; ks < 6; ++ks) { const bf16x8 kf = *(const LAS bf16x8*)(Ks + (16 * kb + l15) * AT_KS + 32 * ks + 8 * q4); st[kb] = MFMA_BF16(kf, qf[ks], st[kb]); } }
                float mx = -3.0e38f;
#pragma unroll
                for (int kb = 0; kb < 4; ++kb) { st[kb] = st[kb] * scale; mx = fmaxf(mx, fmaxf(fmaxf(st[kb].x, st[kb].y), fmaxf(st[kb].z, st[kb].w))); }
                mx = fmaxf(mx, __shfl_xor(mx, 16)); mx = fmaxf(mx, __shfl_xor(mx, 32));
                const float mnew = fmaxf(mrow, mx), alpha = expf(mrow - mnew); mrow = mnew;
                float ps = 0.f;
#pragma unroll
                for (int kb = 0; kb < 4; ++kb)
#pragma unroll
                    for (int r = 0; r < 4; ++r) { const float p = expf(st[kb][r] - mnew); st[kb][r] = p; ps += p; }
                lrow = lrow * alpha + ps;
#pragma unroll
                for (int mb = 0; mb < 8; ++mb) o[mb] = o[mb] * alpha;
#pragma unroll
                for (int kg = 0; kg < 2; ++kg) {
                    bf16x8 pb;
#pragma unroll
                    for (int j = 0; j < 4; ++j) { pb[j] = (short)f2bf(st[2 * kg][j]); pb[4 + j] = (short)f2bf(st[2 * kg + 1][j]); }
#pragma unroll
                    for (int mb = 0; mb < 8; ++mb) { const LAS bf16* vp = Vt + (16 * mb + l15) * AT_VS + 32 * kg + 4 * q4;
                        const bf16x4 v0 = *(const LAS bf16x4*)vp, v1 = *(const LAS bf16x4*)(vp + 16);
                        bf16x8 vf; vf[0] = v0[0]; vf[1] = v0[1]; vf[2] = v0[2]; vf[3] = v0[3]; vf[4] = v1[0]; vf[5] = v1[1]; vf[6] = v1[2]; vf[7] = v1[3];
                        o[mb] = MFMA_BF16(vf, pb, o[mb]); }
                }
            }
        }
        lrow += __shfl_xor(lrow, 16); lrow += __shfl_xor(lrow, 32);
        const float inv = 1.0f / lrow;
#pragma unroll
        for (int mb = 0; mb < 8; ++mb) st_bf16x4(Y + tq * 512 + h * 128 + 16 * mb + 4 * q4, o[mb] * inv);
    }
    __syncthreads();
}

__device__ __forceinline__ f32x4 tile_bf(const LAS bf16* a, int lda, const LAS bf16* bt, int ldb, int K, f32x4 acc, int l15, int q4) {
    const LAS bf16* ap = a + l15 * lda + 8 * q4; const LAS bf16* bp = bt + l15 * ldb + 8 * q4;
#pragma unroll 4
    for (int ks = 0; ks < K / 32; ++ks) acc = MFMA_BF16(*(const LAS bf16x8*)(ap + 32 * ks), *(const LAS bf16x8*)(bp + 32 * ks), acc);
    return acc;
}
__device__ __forceinline__ f32x4 tile_mm(const LAS float* a, int lda, int ska, const LAS float* b, int ldb, int scb, int K, f32x4 acc, int l15, int q4);

__device__ __forceinline__ void phase_rwkv_prep(const Frame& F, const Args& A, int layer) {
    const bf16* P = WSP(bf16, A_P); bf16* RKV = WSP(bf16, R_RKV); bf16* LIN = WSP(bf16, R_LIN); const float* mu = A.in[8] + (size_t)layer * 1824;
    const int lane = F.lane;
    for (int m = F.gw; m < TH; m += F.NGW) {
        const bool first = (m % SEQ) == 0; const bf16* pr = P + (size_t)m * PW + C_RWKV;
#pragma unroll
        for (int j = 0; j < 8; ++j) { const int c = 4 * lane + 256 * j;
            if (c < 1824) { const f32x4 p = ld_bf16x4(pr + c); const f32x4 pv = first ? (f32x4){0.f, 0.f, 0.f, 0.f} : ld_bf16x4(pr - PW + c); const f32x4 muv = *(const f32x4*)(mu + c);
                f32x4 x = p + (pv - p) * muv;
                if (c < 1536) st_bf16x4(RKV + (size_t)m * 1536 + c, x);
                else { if (c < 1600) { x.x = tanhf(x.x); x.y = tanhf(x.y); x.z = tanhf(x.z); x.w = tanhf(x.w); }
                       else if (c >= 1664) { x.x = sigmoidf_(x.x); x.y = sigmoidf_(x.y); x.z = sigmoidf_(x.z); x.w = sigmoidf_(x.w); }
                       st_bf16x4(LIN + (size_t)m * 384 + (c - 1536), x); } } }
        if (lane < 24) st_bf16x4(LIN + (size_t)m * 384 + 288 + 4 * lane, (f32x4){0.f, 0.f, 0.f, 0.f});
    }
}
__device__ __forceinline__ void phase_rwkv_lora(const Frame& F, const Args& A) {
    pg8::Gemm g{WSP(bf16, R_LIN), WSP(bf16, W_LORA), 384, 384}; pg8::StaticOrder S; S.init(TH, 1536, F.G, F.bid);
    EpiF32 E{WSP(float, R_LOUT), 1536}; pg8::gemm_phase(F.lds, g, S, E, F.tid);
}
constexpr int RS = 72;
constexpr int RREC_COMMON = 4 * 64 * RS * 2 + 256;
constexpr int RREC_SLICE = 3 * 64 * 36 * 4;
constexpr int RREC_BYTES = RREC_COMMON + 2 * RREC_SLICE;
static_assert(RREC_BYTES == 92416, "record size (see R_REC in the workspace map)");
static_assert(RREC_COMMON % 16 == 0 && RREC_SLICE % 16 == 0, "record alignment");
__device__ __forceinline__ void phase_rwkv_r1(const Frame& F, const Args& A, int layer) {
    const bf16* RKV = WSP(bf16, R_RKV); const float* LOUT = WSP(float, R_LOUT); unsigned char* REC = WSP(unsigned char, R_REC);
    const float* w0 = A.in[9] + layer * 512; const float* a0 = A.in[11] + layer * 512; const float* k_k = A.in[14] + layer * 512; const float* k_a = A.in[15] + layer * 512;
    LAS bf16* kbar = (LAS bf16*)F.lds; LAS bf16* atil = kbar + 64 * RS; LAS bf16* khat = atil + 64 * RS; LAS bf16* rbar = khat + 64 * RS;
    LAS bf16* atT = rbar + 64 * RS; LAS bf16* khT = atT + 64 * RS; LAS bf16* vT = khT + 64 * RS; LAS bf16* Bm = vT + 64 * RS; LAS bf16* Em = Bm + 64 * RS;
    LAS float* Am = (LAS float*)(Em + 64 * RS);
    LAS float* X = Am + 64 * 68;
    LAS float* lam = Am;
    const int tid = F.tid, lane = F.lane, w = F.wave, l15 = lane & 15, q4 = lane >> 4;
    const int nunits = BH * 8 * NCH;
    for (int unit = F.bid; unit < nunits; unit += F.G) {
        const int c = unit % NCH, h = (unit / NCH) & 7, b = unit / (NCH * 8);
        const size_t tok0 = (size_t)b * SEQ + (size_t)c * 64;
        const int j = lane, cj = h * 64 + j;
        __syncthreads();
        float r_[8], km_[8], kk_[8], ka_[8], v_[8];
        { const float w0c = w0[cj], a0c = a0[cj], kkc = k_k[cj], kac = k_a[cj];
#pragma unroll
          for (int q = 0; q < 8; ++q) { const int t = w + 8 * q; const size_t tok = tok0 + t;
              const float r = bf2f(RKV[tok * 1536 + cj]), k = bf2f(RKV[tok * 1536 + 512 + cj]); v_[q] = bf2f(RKV[tok * 1536 + 1024 + cj]);
              const float wpre = LOUT[tok * 1536 + cj], apre = LOUT[tok * 1536 + 512 + cj];
              const float wl = -softplusf_(-(w0c + wpre)) - 0.5f, a = sigmoidf_(a0c + apre);
              const float kr = k * kkc, ss = wave_sum(kr * kr), kk = kr / sqrtf(ss + EPS);
              r_[q] = r; km_[q] = k * (1.0f + (a - 1.0f) * kac); kk_[q] = kk; ka_[q] = kk * a;
              lam[t * 64 + j] = -expf(wl); } }
        __syncthreads();
        if (w == 0) { float s = 0.f; for (int t = 0; t < 64; ++t) { s += lam[t * 64 + j]; lam[t * 64 + j] = s; } }
        __syncthreads();
        { const float Lend = lam[63 * 64 + j];
#pragma unroll
          for (int q = 0; q < 8; ++q) { const int t = w + 8 * q; const float L = lam[t * 64 + j], Lm1 = t ? lam[(t - 1) * 64 + j] : 0.f;
              const float eG = expf(L), eGi = expf(-L), eGm1 = expf(Lm1), eT = expf(Lend - L);
              const float kb = kk_[q] * eGm1;
              kbar[t * RS + j] = (bf16)f2bf(kb); X[t * 132 + j] = kb;
              atil[t * RS + j] = (bf16)f2bf(ka_[q] * eGi); khat[t * RS + j] = (bf16)f2bf(km_[q] * eGi); rbar[t * RS + j] = (bf16)f2bf(r_[q] * eG);
              atT[j * RS + t] = (bf16)f2bf(-ka_[q] * eT); khT[j * RS + t] = (bf16)f2bf(km_[q] * eT); vT[j * RS + t] = (bf16)f2bf(v_[q]); }
          if (w == 0) { float* gc = (float*)(REC + (size_t)unit * RREC_BYTES + 4 * 64 * RS * 2); gc[j] = expf(Lend); } }
        __syncthreads();
        unsigned char* rec = REC + (size_t)unit * RREC_BYTES;
        for (int tt = 0; tt < 8; ++tt) { const int tile = w * 8 + tt, which = tile >> 4, ti = (tile >> 2) & 3, tj = tile & 3;
            f32x4 acc = (f32x4){0.f, 0.f, 0.f, 0.f};
            if (tj <= ti) acc = tile_bf(((which & 2) ? rbar : kbar) + 16 * ti * RS, RS, ((which & 1) ? khat : atil) + 16 * tj * RS, RS, 64, acc, l15, q4);
#pragma unroll
            for (int r = 0; r < 4; ++r) { const int i = 16 * ti + 4 * q4 + r, jj = 16 * tj + l15; const bool keep = (which & 2) ? (jj <= i) : (jj < i); const float v = keep ? acc[r] : 0.f;
                if (which == 0) Am[i * 68 + jj] = v; else if (which == 1) Bm[i * RS + jj] = (bf16)f2bf(v); else if (which == 3) Em[i * RS + jj] = (bf16)f2bf(v);
                else ((bf16*)(rec + 2 * 64 * RS * 2))[i * RS + jj] = (bf16)f2bf(-v); } }
        __syncthreads();
        for (int tt = 0; tt < 6; ++tt) { const int tile = w * 6 + tt, which = tile >> 4, ti = (tile >> 2) & 3, tj = tile & 3;
            const LAS bf16* aop = which == 0 ? Bm : which == 1 ? Em : khT;
            const f32x4 acc = tile_bf(aop + 16 * ti * RS, RS, vT + 16 * tj * RS, RS, 64, (f32x4){0.f, 0.f, 0.f, 0.f}, l15, q4);
#pragma unroll
            for (int r = 0; r < 4; ++r) { const int i = 16 * ti + 4 * q4 + r, vv = 16 * tj + l15;
                if (which == 0) X[i * 132 + 64 + vv] = acc[r];
                else { float* dst = (float*)(rec + RREC_COMMON + (vv >> 5) * RREC_SLICE + (which == 1 ? 1 : 2) * 64 * 36 * 4); dst[i * 36 + (vv & 31)] = acc[r]; } } }
        __syncthreads();
        for (int rb = 0; rb < 4; ++rb) {
            if (rb > 0) {
                const f32x4 acc = tile_mm(Am + 16 * rb * 68, 68, 1, X + 16 * w, 132, 1, 16 * rb, (f32x4){0.f, 0.f, 0.f, 0.f}, l15, q4);
#pragma unroll
                for (int r = 0; r < 4; ++r) X[(16 * rb + 4 * q4 + r) * 132 + 16 * w + l15] -= acc[r];
                __syncthreads();
            }
            if (tid < 128) { float x[16];
#pragma unroll
                for (int i = 0; i < 16; ++i) { float sacc = X[(16 * rb + i) * 132 + tid];
#pragma unroll
                    for (int jj = 0; jj < i; ++jj) sacc -= Am[(16 * rb + i) * 68 + 16 * rb + jj] * x[jj];
                    x[i] = sacc; }
#pragma unroll
                for (int i = 0; i < 16; ++i) X[(16 * rb + i) * 132 + tid] = x[i]; }
            __syncthreads();
        }
        for (int e = tid; e < 64 * 64; e += 512) { const int t = e >> 6, jj = e & 63; ((bf16*)rec)[t * RS + jj] = (bf16)f2bf(X[t * 132 + jj]);
            float* ub = (float*)(rec + RREC_COMMON + (jj >> 5) * RREC_SLICE); ub[t * 36 + (jj & 31)] = X[t * 132 + 64 + jj]; }
        for (int e = tid; e < 64 * RS / 8; e += 512) { ((u32x4*)(rec + 64 * RS * 2))[e] = ((const LAS u32x4*)rbar)[e]; ((u32x4*)(rec + 3 * 64 * RS * 2))[e] = ((const LAS u32x4*)atT)[e]; }
    }
    __syncthreads();
}
constexpr int R2_BUF = RREC_COMMON + RREC_SLICE;
__device__ __forceinline__ void phase_rwkv_r2(const Frame& F, const Args& A) {
    const unsigned char* REC = WSP(unsigned char, R_REC); float* RO = WSP(float, R_O);
    LAS unsigned char* buf0 = F.lds; LAS bf16* HT = (LAS bf16*)(F.lds + 2 * R2_BUF); LAS bf16* UT = HT + 2 * 32 * RS;
    const int tid = F.tid, lane = F.lane, w = F.wave, l15 = lane & 15, q4 = lane >> 4, ti = w >> 1, tj = w & 1;
    const int nunits = BH * 8 * 2;
    constexpr int NCHK = R2_BUF / 16;
    for (int unit = F.bid; unit < nunits; unit += F.G) {
        const int vs = unit & 1, h = (unit >> 1) & 7, b = unit >> 4;
        __syncthreads();
        for (int e = tid; e < 2 * 32 * RS / 2; e += 512) ((LAS unsigned*)HT)[e] = 0u;
        f32x4 Hreg = (f32x4){0.f, 0.f, 0.f, 0.f};
        u32x4 pre[8];
        { const unsigned char* rec = REC + (size_t)((b * 8 + h) * NCH) * RREC_BYTES;
#pragma unroll
          for (int q = 0; q < 8; ++q) { const int e = tid + 512 * q; if (e < NCHK) { const size_t off = (size_t)e * 16; pre[q] = *(const u32x4*)(rec + (off < RREC_COMMON ? off : off + (size_t)vs * RREC_SLICE)); } }
#pragma unroll
          for (int q = 0; q < 8; ++q) { const int e = tid + 512 * q; if (e < NCHK) *(LAS u32x4*)(buf0 + (size_t)e * 16) = pre[q]; } }
        __syncthreads();
        for (int c = 0; c < NCH; ++c) {
            LAS unsigned char* buf = buf0 + (c & 1) * R2_BUF; LAS unsigned char* nbuf = buf0 + ((c + 1) & 1) * R2_BUF;
            if (c + 1 < NCH) { const unsigned char* rec = REC + (size_t)((b * 8 + h) * NCH + c + 1) * RREC_BYTES;
#pragma unroll
                for (int q = 0; q < 8; ++q) { const int e = tid + 512 * q; if (e < NCHK) { const size_t off = (size_t)e * 16; pre[q] = *(const u32x4*)(rec + (off < RREC_COMMON ? off : off + (size_t)vs * RREC_SLICE)); } } }
            const LAS bf16* KB = (const LAS bf16*)buf; const LAS bf16* RB = KB + 64 * RS; const LAS bf16* FMn = RB + 64 * RS; const LAS bf16* ATn = FMn + 64 * RS;
            const LAS float* GC = (const LAS float*)(buf + 4 * 64 * RS * 2); const LAS float* UB = (const LAS float*)(buf + RREC_COMMON); const LAS float* OB = UB + 64 * 36; const LAS float* KV = OB + 64 * 36;
            const LAS bf16* H0 = HT + (c & 1) * 32 * RS; LAS bf16* H1 = HT + ((c + 1) & 1) * 32 * RS;
            f32x4 u;
#pragma unroll
            for (int r = 0; r < 4; ++r) u[r] = UB[(16 * ti + 4 * q4 + r) * 36 + 16 * tj + l15];
            u = tile_bf(KB + 16 * ti * RS, RS, H0 + 16 * tj * RS, RS, 64, u, l15, q4);
            { u32x2 pk; pk.x = pk2(u[0], u[1]); pk.y = pk2(u[2], u[3]); *(LAS u32x2*)(UT + (16 * tj + l15) * RS + 16 * ti + 4 * q4) = pk; }
            __syncthreads();
            f32x4 o;
#pragma unroll
            for (int r = 0; r < 4; ++r) o[r] = OB[(16 * ti + 4 * q4 + r) * 36 + 16 * tj + l15];
            o = tile_bf(RB + 16 * ti * RS, RS, H0 + 16 * tj * RS, RS, 64, o, l15, q4);
            o = tile_bf(FMn + 16 * ti * RS, RS, UT + 16 * tj * RS, RS, 64, o, l15, q4);
#pragma unroll
            for (int r = 0; r < 4; ++r) RO[((size_t)b * SEQ + (size_t)c * 64 + 16 * ti + 4 * q4 + r) * 512 + h * 64 + 32 * vs + 16 * tj + l15] = o[r];
#pragma unroll
            for (int r = 0; r < 4; ++r) Hreg[r] = Hreg[r] * GC[16 * ti + 4 * q4 + r] + KV[(16 * ti + 4 * q4 + r) * 36 + 16 * tj + l15];
            Hreg = tile_bf(ATn + 16 * ti * RS, RS, UT + 16 * tj * RS, RS, 64, Hreg, l15, q4);
            { u32x2 pk; pk.x = pk2(Hreg[0], Hreg[1]); pk.y = pk2(Hreg[2], Hreg[3]); *(LAS u32x2*)(H1 + (16 * tj + l15) * RS + 16 * ti + 4 * q4) = pk; }
            if (c + 1 < NCH) {
#pragma unroll
                for (int q = 0; q < 8; ++q) { const int e = tid + 512 * q; if (e < NCHK) *(LAS u32x4*)(nbuf + (size_t)e * 16) = pre[q]; } }
            __syncthreads();
        }
    }
    __syncthreads();
}
__device__ __forceinline__ void phase_rwkv_post(const Frame& F, const Args& A, int layer) {
    const bf16* RKV = WSP(bf16, R_RKV); const float* LOUT = WSP(float, R_LOUT); const float* RO = WSP(float, R_O); bf16* Y = WSP(bf16, A_Y) + (size_t)1 * TH * 512;
    const float* a0 = A.in[11] + layer * 512; const float* k_a = A.in[15] + layer * 512; const float* r_k = A.in[16] + layer * 512; const float* ln_w = A.in[17] + layer * 512; const float* ln_b = A.in[18] + layer * 512;
    const int lane = F.lane, c0 = 8 * lane;
    for (int m = F.gw; m < TH; m += F.NGW) {
        float o[8], r[8], k[8], v[8], ap[8], g[8];
        { const f32x4 a = *(const f32x4*)(RO + (size_t)m * 512 + c0), b2 = *(const f32x4*)(RO + (size_t)m * 512 + c0 + 4); o[0] = a.x; o[1] = a.y; o[2] = a.z; o[3] = a.w; o[4] = b2.x; o[5] = b2.y; o[6] = b2.z; o[7] = b2.w; }
#pragma unroll
        for (int hh = 0; hh < 2; ++hh) { const f32x4 rv = ld_bf16x4(RKV + (size_t)m * 1536 + c0 + 4 * hh), kv = ld_bf16x4(RKV + (size_t)m * 1536 + 512 + c0 + 4 * hh), vv = ld_bf16x4(RKV + (size_t)m * 1536 + 1024 + c0 + 4 * hh);
            const f32x4 av = *(const f32x4*)(LOUT + (size_t)m * 1536 + 512 + c0 + 4 * hh), gv = *(const f32x4*)(LOUT + (size_t)m * 1536 + 1024 + c0 + 4 * hh);
#pragma unroll
            for (int q = 0; q < 4; ++q) { r[4 * hh + q] = rv[q]; k[4 * hh + q] = kv[q]; v[4 * hh + q] = vv[q]; ap[4 * hh + q] = av[q]; g[4 * hh + q] = gv[q]; } }
        float bon = 0.f, sm = 0.f;
#pragma unroll
        for (int q = 0; q < 8; ++q) { const float a = sigmoidf_(a0[c0 + q] + ap[q]); const float km = k[q] * (1.0f + (a - 1.0f) * k_a[c0 + q]); bon += r[q] * km * r_k[c0 + q]; sm += o[q]; }
        bon += __shfl_xor(bon, 1); bon += __shfl_xor(bon, 2); bon += __shfl_xor(bon, 4);
        sm += __shfl_xor(sm, 1); sm += __shfl_xor(sm, 2); sm += __shfl_xor(sm, 4);
        const float mean = sm * (1.0f / 64.0f); float vs = 0.f;
#pragma unroll
        for (int q = 0; q < 8; ++q) { const float d = o[q] - mean; vs += d * d; }
        vs += __shfl_xor(vs, 1); vs += __shfl_xor(vs, 2); vs += __shfl_xor(vs, 4);
        const float rstd = 1.0f / sqrtf(vs * (1.0f / 64.0f) + 64e-5f);
        float y[8];
#pragma unroll
        for (int q = 0; q < 8; ++q) y[q] = ((o[q] - mean) * rstd * ln_w[c0 + q] + ln_b[c0 + q] + bon * v[q]) * g[q];
        u32x4 wv; wv.x = pk2(y[0], y[1]); wv.y = pk2(y[2], y[3]); wv.z = pk2(y[4], y[5]); wv.w = pk2(y[6], y[7]);
        *(u32x4*)(Y + (size_t)m * 512 + c0) = wv;
    }
}

__device__ __forceinline__ f32x4 tile_mm(const LAS float* a, int lda, int ska, const LAS float* b, int ldb, int scb, int K, f32x4 acc, int l15, int q4) {
    const LAS float* ap = a + l15 * lda + q4 * ska; const LAS float* bp = b + q4 * ldb + l15 * scb;
#pragma unroll 8
    for (int ks = 0; ks < K / 4; ++ks) acc = MFMA_F32(ap[ks * 4 * ska], bp[ks * 4 * ldb], acc);
    return acc;
}
constexpr int GS = 132, GS2 = 68;
__device__ __forceinline__ void phase_gdn_g1(const Frame& F, const Args& A, int layer) {
    const bf16* P = WSP(bf16, A_P); float* CHR = WSP(float, G_CH); float* GL = WSP(float, G_GL);
    const float* convw = A.in[19] + (size_t)layer * 4 * 1536; const float* a_log = A.in[20] + layer * 4; const float* dtb = A.in[21] + layer * 4;
    LAS float* qs = (LAS float*)F.lds; LAS float* ks = qs + 64 * GS; LAS float* vs = ks + 64 * GS; LAS float* Lm = vs + 64 * GS; LAS float* QK = Lm + 64 * GS2;
    LAS float* beta = QK + 64 * GS2; LAS float* gc = beta + 64; LAS float* egc = gc + 64;
    const int tid = F.tid, lane = F.lane, w = F.wave, l15 = lane & 15, q4 = lane >> 4;
    const int nunits = BH * 4 * NCH;
    for (int unit = F.bid; unit < nunits; unit += F.G) {
        const int c = unit % NCH, h = (unit / NCH) & 3, b = unit / (NCH * 4);
        const size_t tok0 = (size_t)b * SEQ + (size_t)c * 64;
        __syncthreads();
        for (int e = tid; e < 64 * 384; e += 512) { const int l = e / 384, cc = e % 384, part = cc >> 7, d = cc & 127, col = part * 512 + h * 128 + d;
            float acc = 0.f;
#pragma unroll
            for (int j = 0; j < 4; ++j) { const int tl = c * 64 + l - 3 + j; if (tl >= 0) acc += convw[j * 1536 + col] * bf2f(P[((size_t)b * SEQ + tl) * PW + C_GDN + col]); }
            (part == 0 ? qs : part == 1 ? ks : vs)[l * GS + d] = siluf_(acc); }
        if (tid < 64) { const size_t tok = tok0 + tid; beta[tid] = sigmoidf_(bf2f(P[tok * PW + C_GDN + 1536 + h]));
            float g = -expf(a_log[h]) * softplusf_(bf2f(P[tok * PW + C_GDN + 1540 + h]) + dtb[h]);
#pragma unroll
            for (int o = 1; o < 64; o <<= 1) { const float t = __shfl_up(g, o); if (lane >= o) g += t; }
            gc[tid] = g; egc[tid] = expf(g); }
        __syncthreads();
        for (int rr = 0; rr < 8; ++rr) { const int l = 8 * w + rr;
            const float q0 = qs[l * GS + lane], q1 = qs[l * GS + 64 + lane], k0 = ks[l * GS + lane], k1 = ks[l * GS + 64 + lane];
            const float sq = wave_sum(q0 * q0 + q1 * q1), sk = wave_sum(k0 * k0 + k1 * k1);
            const float iq = 0.08838834764831845f / sqrtf(sq + EPS), ik = 1.0f / sqrtf(sk + EPS);
            qs[l * GS + lane] = q0 * iq; qs[l * GS + 64 + lane] = q1 * iq; ks[l * GS + lane] = k0 * ik; ks[l * GS + 64 + lane] = k1 * ik; }
        __syncthreads();
        for (int tt = 0; tt < 4; ++tt) { const int tile = w * 4 + tt, which = tile >> 4, ti = (tile >> 2) & 3, tj = tile & 3;
            f32x4 acc = (f32x4){0.f, 0.f, 0.f, 0.f};
            if (tj <= ti) acc = tile_mm((which ? qs : ks) + 16 * ti * GS, GS, 1, ks + 16 * tj * GS, 1, GS, 128, acc, l15, q4);
            LAS float* dst = which ? QK : Lm;
#pragma unroll
            for (int r = 0; r < 4; ++r) { const int i = 16 * ti + 4 * q4 + r, j = 16 * tj + l15; float v = 0.f;
                if (which ? (j <= i) : (j < i)) v = acc[r] * expf(gc[i] - gc[j]) * (which ? 1.0f : beta[i]);
                dst[i * GS2 + j] = v; } }
        __syncthreads();
        float* rec = CHR + (size_t)unit * GDN_CHUNK_F;
        {
            const float glast = gc[63];
            for (int e = tid; e < 64 * 128; e += 512) { const int l = e >> 7, d = e & 127; rec[2 * 64 * 128 + e] = qs[l * GS + d] * egc[l]; rec[3 * 64 * 128 + e] = ks[l * GS + d] * expf(glast - gc[l]); }
            for (int e = tid; e < 64 * 64; e += 512) rec[4 * 64 * 128 + e] = QK[(e >> 6) * GS2 + (e & 63)];
            if (tid == 0) GL[unit] = expf(glast);
        }
        __syncthreads();
        for (int e = tid; e < 64 * 128; e += 512) { const int l = e >> 7, d = e & 127; vs[l * GS + d] *= beta[l]; qs[l * GS + d] = beta[l] * egc[l] * ks[l * GS + d]; }
        __syncthreads();
        for (int rb = 0; rb < 4; ++rb) {
            if (rb > 0) {
                LAS float* Xm = (w >> 2) ? qs : vs;
#pragma unroll
                for (int t2 = 0; t2 < 2; ++t2) { const int tj = 2 * (w & 3) + t2;
                    const f32x4 acc = tile_mm(Lm + 16 * rb * GS2, GS2, 1, Xm + 16 * tj, GS, 1, 16 * rb, (f32x4){0.f, 0.f, 0.f, 0.f}, l15, q4);
#pragma unroll
                    for (int r = 0; r < 4; ++r) Xm[(16 * rb + 4 * q4 + r) * GS + 16 * tj + l15] -= acc[r]; }
                __syncthreads();
            }
            if (tid < 256) { LAS float* Xm = (tid >> 7) ? qs : vs; const int col = tid & 127; float x[16];
#pragma unroll
                for (int i = 0; i < 16; ++i) { float sacc = Xm[(16 * rb + i) * GS + col];
#pragma unroll
                    for (int j = 0; j < i; ++j) sacc -= Lm[(16 * rb + i) * GS2 + 16 * rb + j] * x[j];
                    x[i] = sacc; }
#pragma unroll
                for (int i = 0; i < 16; ++i) Xm[(16 * rb + i) * GS + col] = x[i]; }
            __syncthreads();
        }
        for (int e = tid; e < 64 * 128; e += 512) { const int l = e >> 7, d = e & 127; rec[e] = vs[l * GS + d]; rec[64 * 128 + e] = qs[l * GS + d]; }
    }
    __syncthreads();
}
constexpr int GV = 36;
__device__ __forceinline__ void phase_gdn_g2(const Frame& F, const Args& A) {
    const float* CHR = WSP(float, G_CH); const float* GL = WSP(float, G_GL); float* GO = WSP(float, G_O);
    LAS float* S = (LAS float*)F.lds; LAS float* wl = S + 128 * GV; LAS float* qh = wl + 64 * GS; LAS float* kt = qh + 64 * GS; LAS float* qk = kt + 64 * GS; LAS float* vn = qk + 64 * GS2;
    const int tid = F.tid, lane = F.lane, w = F.wave, l15 = lane & 15, q4 = lane >> 4;
    const int nunits = BH * 4 * 4;
    for (int unit = F.bid; unit < nunits; unit += F.G) {
        const int vsl = unit & 3, h = (unit >> 2) & 3, b = unit >> 4;
        __syncthreads();
        for (int e = tid; e < 128 * GV; e += 512) S[e] = 0.f;
        for (int c = 0; c < NCH; ++c) {
            const int cu = (b * 4 + h) * NCH + c; const float* rec = CHR + (size_t)cu * GDN_CHUNK_F; const float egl = GL[cu];
            __syncthreads();
            for (int e = tid; e < 64 * 32; e += 512) { const int l = e >> 5, d4 = (e & 31) * 4;
                *(LAS f32x4*)(wl + l * GS + d4) = *(const f32x4*)(rec + 64 * 128 + l * 128 + d4);
                *(LAS f32x4*)(qh + l * GS + d4) = *(const f32x4*)(rec + 2 * 64 * 128 + l * 128 + d4);
                *(LAS f32x4*)(kt + l * GS + d4) = *(const f32x4*)(rec + 3 * 64 * 128 + l * 128 + d4); }
            for (int e = tid; e < 64 * 16; e += 512) { const int l = e >> 4, d4 = (e & 15) * 4; *(LAS f32x4*)(qk + l * GS2 + d4) = *(const f32x4*)(rec + 4 * 64 * 128 + l * 64 + d4); }
            __syncthreads();
            const int ti = w >> 1, tj = w & 1;
            {
                f32x4 acc = tile_mm(wl + 16 * ti * GS, GS, 1, S + 16 * tj, GV, 1, 128, (f32x4){0.f, 0.f, 0.f, 0.f}, l15, q4);
#pragma unroll
                for (int r = 0; r < 4; ++r) { const int l = 16 * ti + 4 * q4 + r; vn[l * GV + 16 * tj + l15] = rec[l * 128 + 32 * vsl + 16 * tj + l15] - acc[r]; }
            }
            __syncthreads();
            {
                f32x4 acc = tile_mm(qh + 16 * ti * GS, GS, 1, S + 16 * tj, GV, 1, 128, (f32x4){0.f, 0.f, 0.f, 0.f}, l15, q4);
                acc = tile_mm(qk + 16 * ti * GS2, GS2, 1, vn + 16 * tj, GV, 1, 64, acc, l15, q4);
#pragma unroll
                for (int r = 0; r < 4; ++r) { const size_t tok = (size_t)b * SEQ + (size_t)c * 64 + 16 * ti + 4 * q4 + r; GO[tok * 512 + h * 128 + 32 * vsl + 16 * tj + l15] = acc[r]; }
            }
            __syncthreads();
#pragma unroll
            for (int t2 = 0; t2 < 2; ++t2) {
                f32x4 acc;
#pragma unroll
                for (int r = 0; r < 4; ++r) acc[r] = S[(16 * w + 4 * q4 + r) * GV + 16 * t2 + l15] * egl;
                acc = tile_mm(kt + 16 * w, 1, GS, vn + 16 * t2, GV, 1, 64, acc, l15, q4);
#pragma unroll
                for (int r = 0; r < 4; ++r) S[(16 * w + 4 * q4 + r) * GV + 16 * t2 + l15] = acc[r];
            }
        }
    }
    __syncthreads();
}
__device__ __forceinline__ void phase_gdn_g3(const Frame& F, const Args& A, int layer) {
    const float* GO = WSP(float, G_O); const bf16* P = WSP(bf16, A_P); bf16* Y = WSP(bf16, A_Y) + (size_t)2 * TH * 512; const float* nw = A.in[22] + layer * 128;
    const int lane = F.lane, c0 = 8 * lane;
    for (int m = F.gw; m < TH; m += F.NGW) {
        const f32x4 a = *(const f32x4*)(GO + (size_t)m * 512 + c0), b2 = *(const f32x4*)(GO + (size_t)m * 512 + c0 + 4);
        float o[8] = {a.x, a.y, a.z, a.w, b2.x, b2.y, b2.z, b2.w}; float ss = 0.f;
#pragma unroll
        for (int q = 0; q < 8; ++q) ss += o[q] * o[q];
        ss += __shfl_xor(ss, 1); ss += __shfl_xor(ss, 2); ss += __shfl_xor(ss, 4); ss += __shfl_xor(ss, 8);
        const float rstd = 1.0f / sqrtf(ss * (1.0f / 128.0f) + EPS);
        const f32x4 z0 = ld_bf16x4(P + (size_t)m * PW + C_GDN + 1544 + c0), z1 = ld_bf16x4(P + (size_t)m * PW + C_GDN + 1544 + c0 + 4);
        const float z[8] = {z0.x, z0.y, z0.z, z0.w, z1.x, z1.y, z1.z, z1.w}; float y[8];
#pragma unroll
        for (int q = 0; q < 8; ++q) y[q] = o[q] * rstd * nw[(c0 + q) & 127] * siluf_(z[q]);
        u32x4 wv; wv.x = pk2(y[0], y[1]); wv.y = pk2(y[2], y[3]); wv.z = pk2(y[4], y[5]); wv.w = pk2(y[6], y[7]);
        *(u32x4*)(Y + (size_t)m * 512 + c0) = wv;
    }
}

__device__ __forceinline__ void phase_ssd_s1(const Frame& F, const Args& A, int layer) {
    const bf16* P = WSP(bf16, A_P); float* ST = WSP(float, S_ST); float* YD = WSP(float, S_YD); float* SC = WSP(float, S_C); float* AC = WSP(float, S_AC);
    const float* cw = A.in[23] + (size_t)layer * 4 * 1024; const float* cb = A.in[24] + layer * 1024; const float* dtb = A.in[25] + layer * 8; const float* a_log = A.in[26] + layer * 8; const float* dsk = A.in[27] + layer * 8;
    LAS float* X = (LAS float*)F.lds; LAS float* Bm = X + 64 * GS2; LAS float* Cm = Bm + 64 * GS; LAS float* M = Cm + 64 * GS; LAS float* Xd = M + 64 * GS2; LAS float* dt = Xd + 64 * GS2; LAS float* ac = dt + 64;
    const int tid = F.tid, lane = F.lane, w = F.wave, l15 = lane & 15, q4 = lane >> 4;
    const int nunits = BH * NCH * 8;
    for (int unit = F.bid; unit < nunits; unit += F.G) {
        const int h = unit & 7, c = (unit >> 3) % NCH, b = unit / (8 * NCH), g = h >> 2;
        const size_t tok0 = (size_t)b * SEQ + (size_t)c * 64;
        __syncthreads();
        for (int e = tid; e < 64 * 320; e += 512) { const int l = e / 320, cc = e % 320;
            const int cidx = cc < 64 ? h * 64 + cc : cc < 192 ? 512 + g * 128 + (cc - 64) : 768 + g * 128 + (cc - 192);
            float acc = cb[cidx];
#pragma unroll
            for (int j = 0; j < 4; ++j) { const int tl = c * 64 + l - 3 + j; if (tl >= 0) acc += cw[j * 1024 + cidx] * bf2f(P[((size_t)b * SEQ + tl) * PW + C_SSD + 512 + cidx]); }
            const float v = siluf_(acc);
            if (cc < 64) X[l * GS2 + cc]  = v; else if (cc < 192) Bm[l * GS + (cc - 64)] = v; else Cm[l * GS + (cc - 192)] = v; }
        if (tid < 64) { const float d = softplusf_(bf2f(P[(tok0 + tid) * PW + C_SSD + 1536 + h]) + dtb[h]); float a = -expf(a_log[h]) * d;
#pragma unroll
            for (int o = 1; o < 64; o <<= 1) { const float t = __shfl_up(a, o); if (lane >= o) a += t; }
            dt[tid] = d; ac[tid] = a; AC[(tok0 + tid) * 8 + h] = a; }
        __syncthreads();
        for (int tt = 0; tt < 2; ++tt) { const int tile = w * 2 + tt, ti = tile >> 2, tj = tile & 3; f32x4 acc = (f32x4){0.f, 0.f, 0.f, 0.f};
            if (tj <= ti) acc = tile_mm(Cm + 16 * ti * GS, GS, 1, Bm + 16 * tj * GS, 1, GS, 128, acc, l15, q4);
#pragma unroll
            for (int r = 0; r < 4; ++r) { const int l = 16 * ti + 4 * q4 + r, s = 16 * tj + l15; M[l * GS2 + s] = (s <= l) ? acc[r] * expf(ac[l] - ac[s]) * dt[s] : 0.f; } }
        for (int e = tid; e < 64 * 64; e += 512) { const int l = e >> 6, p = e & 63; Xd[l * GS2 + p] = X[l * GS2 + p] * dt[l] * expf(ac[63] - ac[l]); }
        if ((h & 3) == 0) for (int e = tid; e < 64 * 128; e += 512) { const int l = e >> 7, n = e & 127; SC[(tok0 + l) * 256 + g * 128 + n] = Cm[l * GS + n]; }
        __syncthreads();
        for (int tt = 0; tt < 2; ++tt) { const int tile = w * 2 + tt, ti = tile >> 2, tj = tile & 3;
            const f32x4 acc = tile_mm(M + 16 * ti * GS2, GS2, 1, X + 16 * tj, GS2, 1, 64, (f32x4){0.f, 0.f, 0.f, 0.f}, l15, q4);
#pragma unroll
            for (int r = 0; r < 4; ++r) { const int l = 16 * ti + 4 * q4 + r, p = 16 * tj + l15; YD[(tok0 + l) * 512 + h * 64 + p] = acc[r] + dsk[h] * X[l * GS2 + p]; } }
        float* st = ST + (size_t)unit * 64 * 128;
        for (int tt = 0; tt < 4; ++tt) { const int tile = w * 4 + tt, ti = tile >> 3, tj = tile & 7;
            const f32x4 acc = tile_mm(Xd + 16 * ti, 1, GS2, Bm + 16 * tj, GS, 1, 64, (f32x4){0.f, 0.f, 0.f, 0.f}, l15, q4);
#pragma unroll
            for (int r = 0; r < 4; ++r) st[(16 * ti + 4 * q4 + r) * 128 + 16 * tj + l15] = acc[r]; }
    }
    __syncthreads();
}
__device__ __forceinline__ void phase_ssd_s2(const Frame& F, const Args& A) {
    float* ST = WSP(float, S_ST); const float* AC = WSP(float, S_AC);
    for (int idx = F.bid * 512 + F.tid; idx < BH * 8 * 8192; idx += F.G * 512) { const int e = idx & 8191, h = (idx >> 13) & 7, b = idx >> 16;
        float Hs = 0.f;
        for (int c = 0; c < NCH; ++c) { float* p = ST + ((size_t)((b * NCH + c) * 8 + h)) * 8192 + e; const float tmp = *p; *p = Hs;
            Hs = expf(AC[((size_t)b * SEQ + c * 64 + 63) * 8 + h]) * Hs + tmp; } }
}
__device__ __forceinline__ void phase_ssd_s3(const Frame& F, const Args& A) {
    const float* ST = WSP(float, S_ST); float* YD = WSP(float, S_YD); const float* SC = WSP(float, S_C); const float* AC = WSP(float, S_AC);
    LAS float* Cm = (LAS float*)F.lds; LAS float* Hs = Cm + 64 * GS;
    const int tid = F.tid, lane = F.lane, w = F.wave, l15 = lane & 15, q4 = lane >> 4;
    const int nunits = BH * NCH * 8;
    for (int unit = F.bid; unit < nunits; unit += F.G) {
        const int h = unit & 7, c = (unit >> 3) % NCH, b = unit / (8 * NCH), g = h >> 2;
        const size_t tok0 = (size_t)b * SEQ + (size_t)c * 64; const float* st = ST + (size_t)unit * 8192;
        __syncthreads();
        for (int e = tid; e < 64 * 32; e += 512) { const int l = e >> 5, d4 = (e & 31) * 4;
            *(LAS f32x4*)(Cm + l * GS + d4) = *(const f32x4*)(SC + (tok0 + l) * 256 + g * 128 + d4); *(LAS f32x4*)(Hs + l * GS + d4) = *(const f32x4*)(st + l * 128 + d4); }
        __syncthreads();
        for (int tt = 0; tt < 2; ++tt) { const int tile = w * 2 + tt, ti = tile >> 2, tj = tile & 3;
            const f32x4 acc = tile_mm(Cm + 16 * ti * GS, GS, 1, Hs + 16 * tj * GS, 1, GS, 128, (f32x4){0.f, 0.f, 0.f, 0.f}, l15, q4);
#pragma unroll
            for (int r = 0; r < 4; ++r) { const int l = 16 * ti + 4 * q4 + r, p = 16 * tj + l15; const size_t o = (tok0 + l) * 512 + h * 64 + p; YD[o] += acc[r] * expf(AC[(tok0 + l) * 8 + h]); } }
    }
    __syncthreads();
}
__device__ __forceinline__ void phase_ssd_s4(const Frame& F, const Args& A, int layer) {
    const float* YD = WSP(float, S_YD); const bf16* P = WSP(bf16, A_P); bf16* Y = WSP(bf16, A_Y) + (size_t)3 * TH * 512; const float* nw = A.in[28] + layer * 512;
    const int lane = F.lane, c0 = 8 * lane;
    for (int m = F.gw; m < TH; m += F.NGW) {
        const f32x4 a = *(const f32x4*)(YD + (size_t)m * 512 + c0), b2 = *(const f32x4*)(YD + (size_t)m * 512 + c0 + 4);
        const f32x4 z0 = ld_bf16x4(P + (size_t)m * PW + C_SSD + c0), z1 = ld_bf16x4(P + (size_t)m * PW + C_SSD + c0 + 4);
        float y[8] = {a.x * siluf_(z0.x), a.y * siluf_(z0.y), a.z * siluf_(z0.z), a.w * siluf_(z0.w), b2.x * siluf_(z1.x), b2.y * siluf_(z1.y), b2.z * siluf_(z1.z), b2.w * siluf_(z1.w)};
        float ss = 0.f;
#pragma unroll
        for (int q = 0; q < 8; ++q) ss += y[q] * y[q];
        ss += __shfl_xor(ss, 1); ss += __shfl_xor(ss, 2); ss += __shfl_xor(ss, 4); ss += __shfl_xor(ss, 8); ss += __shfl_xor(ss, 16);
        const float rstd = 1.0f / sqrtf(ss * (1.0f / 256.0f) + EPS);
#pragma unroll
        for (int q = 0; q < 8; ++q) y[q] = y[q] * rstd * nw[c0 + q];
        u32x4 wv; wv.x = pk2(y[0], y[1]); wv.y = pk2(y[2], y[3]); wv.z = pk2(y[4], y[5]); wv.w = pk2(y[6], y[7]);
        *(u32x4*)(Y + (size_t)m * 512 + c0) = wv;
    }
}

__device__ __forceinline__ void phase_merge_z(const Frame& F, const Args& A) {
    for (int i = 0; i < 4; ++i) {
        pg8::Gemm g{WSP(bf16, A_Y) + (size_t)i * TH * 512, WSP(bf16, W_BR) + (size_t)i * D * 512, 512, 512}; pg8::StaticOrder S; S.init(TH, D, F.G, F.bid);
        EpiBf16 E{WSP(bf16, A_Z) + i * D, 4096, nullptr, 0}; pg8::gemm_phase(F.lds, g, S, E, F.tid);
        __syncthreads();
    }
}
__device__ __forceinline__ void phase_merge_gate(const Frame& F, const Args& A, int layer) {
    pg8::Gemm g{WSP(bf16, A_H), WSP(bf16, W_GATE), D, D}; pg8::StaticOrder S; S.init(TH, 4096, F.G, F.bid);
    EpiMerge E{WSP(bf16, A_Z), A.in[29] + (size_t)layer * 4 * D, WSP(bf16, A_MG)}; pg8::gemm_phase(F.lds, g, S, E, F.tid);
}
__device__ __forceinline__ void phase_merge_out(const Frame& F, const Args& A, const float* xin, float* xout) {
    pg8::Gemm g{WSP(bf16, A_MG), WSP(bf16, W_OUT), D, D}; pg8::StaticOrder S; S.init(TH, D, F.G, F.bid);
    EpiResidual E{xin, xout}; pg8::gemm_phase(F.lds, g, S, E, F.tid);
}
__device__ __forceinline__ void phase_ffn_gu(const Frame& F, const Args& A) {
    pg8::Gemm g{WSP(bf16, A_H), WSP(bf16, W_FGU), D, D}; pg8::StaticOrder S; S.init(TH, 2 * FF_D, F.G, F.bid);
    EpiSwiGLU E{WSP(bf16, F_ACT), FF_D, 1 << 20}; pg8::gemm_phase(F.lds, g, S, E, F.tid);
}
__device__ __forceinline__ void phase_ffn_down(const Frame& F, const Args& A, float* x) {
    pg8::Gemm g{WSP(bf16, F_ACT), WSP(bf16, W_FDN), FF_D, FF_D}; pg8::StaticOrder S; S.init(TH, D, F.G, F.bid);
    EpiResidual E{x, x}; pg8::gemm_phase(F.lds, g, S, E, F.tid);
}
struct MoeLayout { int pstart[NEXP + 1]; };
__device__ __forceinline__ MoeLayout moe_layout(const unsigned* cnt) {
    MoeLayout L; int s = 0;
#pragma unroll
    for (int e = 0; e < NEXP; ++e) { L.pstart[e] = s; s += ((int)cnt[e] + 255) & ~255; }
    L.pstart[NEXP] = s; return L;
}
struct MoeOrder {
    int np, nN, G, c; MoeLayout L;
    __device__ bool next(int i, Unit& u) const {
        const long Lx = (long)i * G + c; if (Lx >= (long)np * nN) return false;
        const int pm = (int)(Lx / nN), pn = (int)(Lx % nN); int e = 0;
#pragma unroll
        for (int k = 1; k < NEXP; ++k) if (pm * 256 >= L.pstart[k]) e = k;
        u.pm = pm; u.pn = e * nN + pn; return true;
    }
    __device__ __forceinline__ void a_ready(const Unit&) const {}
    __device__ __forceinline__ void done(const Unit&) const {}
};
__device__ __forceinline__ void phase_moe_route(const Frame& F, const Args& A, int half) {
    const unsigned* cnt = F.ctl + CW_CNT + half * 16; unsigned* fill = F.ctl + CW_FILL + half * 16;
    const MoeLayout L = moe_layout(cnt);
    const bf16* H = WSP(bf16, A_H); bf16* GA = WSP(bf16, F_GA); const int* tope = WSP(int, F_TOPE); int* slot = WSP(int, F_SLOT);
    const int lane = F.lane;
    for (int m = F.gw; m < TH; m += F.NGW) {
        const u32x4 v0 = *(const u32x4*)(H + (size_t)m * D + 8 * lane), v1 = *(const u32x4*)(H + (size_t)m * D + 512 + 8 * lane);
#pragma unroll
        for (int k = 0; k < 2; ++k) { const int e = tope[2 * m + k]; int s = 0;
            int ps = 0;
#pragma unroll
            for (int q = 0; q < NEXP; ++q) ps = (e == q) ? L.pstart[q] : ps;
            if (lane == 0) s = ps + (int)ATOMIC_ADD_U32(fill + e, 1u);
            s = __shfl(s, 0);
            if (lane == 0) slot[2 * m + k] = s;
            *(u32x4*)(GA + (size_t)s * D + 8 * lane) = v0; *(u32x4*)(GA + (size_t)s * D + 512 + 8 * lane) = v1; }
    }
#pragma unroll
    for (int e = 0; e < NEXP; ++e) { const int r0 = L.pstart[e] + (int)cnt[e], r1 = L.pstart[e + 1];
        for (int r = r0 + F.gw; r < r1; r += F.NGW) { *(u32x4*)(GA + (size_t)r * D + 8 * lane) = (u32x4){0u, 0u, 0u, 0u}; *(u32x4*)(GA + (size_t)r * D + 512 + 8 * lane) = (u32x4){0u, 0u, 0u, 0u}; } }
}
__device__ __forceinline__ void phase_moe_gu(const Frame& F, const Args& A, int half) {
    MoeOrder S; S.L = moe_layout(F.ctl + CW_CNT + half * 16); S.np = S.L.pstart[NEXP] / 256; S.nN = 2 * FF_E / 256; S.G = F.G; S.c = F.bid;
    pg8::Gemm g{WSP(bf16, F_GA), WSP(bf16, W_FGU), D, D}; EpiSwiGLU E{WSP(bf16, F_ACT), FF_E, 2 * FF_E / 256}; pg8::gemm_phase(F.lds, g, S, E, F.tid);
}
struct EpiF32Mod {
    static constexpr bool PERM = false, AFTER_DRAIN = false;
    float* C;
    __device__ __forceinline__ void operator()(const f32x4 (&acc)[2][2][4][2], const Unit& u, int wr, int wc, int fr, int fq) const {
        const int row0 = u.pm * 256 + wr * 64 + fr, col0 = (u.pn & 3) * 256 + wc * 32 + 4 * fq;
#pragma unroll
        for (int ai = 0; ai < 2; ++ai)
#pragma unroll
            for (int m = 0; m < 4; ++m) { float* rowp = C + (size_t)(row0 + ai * HALFT + m * 16) * D + col0;
#pragma unroll
                for (int bj = 0; bj < 2; ++bj)
#pragma unroll
                    for (int n = 0; n < 2; ++n) *(f32x4*)(rowp + bj * HALFT + n * 16) = acc[ai][bj][m][n]; }
    }
};
__device__ __forceinline__ void phase_moe_down(const Frame& F, const Args& A, int half) {
    MoeOrder S; S.L = moe_layout(F.ctl + CW_CNT + half * 16); S.np = S.L.pstart[NEXP] / 256; S.nN = D / 256; S.G = F.G; S.c = F.bid;
    pg8::Gemm g{WSP(bf16, F_ACT), WSP(bf16, W_FDN), FF_E, FF_E}; EpiF32Mod E{WSP(float, F_YE)}; pg8::gemm_phase(F.lds, g, S, E, F.tid);
}
__device__ __forceinline__ void phase_moe_combine(const Frame& F, const Args& A, float* x) {
    const float* YE = WSP(float, F_YE); const int* slot = WSP(int, F_SLOT); const float* topw = WSP(float, F_TOPW); const int lane = F.lane;
    for (int m = F.gw; m < TH; m += F.NGW) { const int s0 = slot[2 * m], s1 = slot[2 * m + 1]; const float w0 = topw[2 * m], w1 = topw[2 * m + 1];
#pragma unroll
        for (int j = 0; j < 4; ++j) { const int c = 4 * lane + 256 * j; float* xp = x + (size_t)m * D + c;
            *(f32x4*)xp = *(const f32x4*)xp + *(const f32x4*)(YE + (size_t)s0 * D + c) * w0 + *(const f32x4*)(YE + (size_t)s1 * D + c) * w1; } }
}

#ifndef EMU
#define XB_TMO      128
#define XB_XCNT(j)  (256  + 64 * (j))
#define XB_XSUB(j)  (1280 + 64 * (j))
#define XB_XGEN(j)  (2304 + 64 * (j))
#define XB_TOP      3328
#define XB_TOPGEN   3392
#define XCD_BAR_WORDS 3456
#define XB_SPIN_CAP (1u << 22)
__device__ __forceinline__ unsigned xb_ld(unsigned* p)              { return __hip_atomic_load(p, __ATOMIC_RELAXED, __HIP_MEMORY_SCOPE_AGENT); }
__device__ __forceinline__ unsigned xb_add(unsigned* p, unsigned v) { return __hip_atomic_fetch_add(p, v, __ATOMIC_RELAXED, __HIP_MEMORY_SCOPE_AGENT); }
__device__ __forceinline__ unsigned xb_xcc_id() { return (unsigned)__builtin_amdgcn_s_getreg((3 << 11) | 20) & 0xFu; }
#define XB_SPIN(cond, bar) do { unsigned _sp = 0; while (cond) { __builtin_amdgcn_s_sleep(1); \
    if ((++_sp & 255u) == 0u) { if (xb_ld(&(bar)[XB_TMO])) break; if (_sp > XB_SPIN_CAP) { atomicAdd(&(bar)[XB_TMO], 1u); break; } } } } while (0)
struct XcdBarrier { unsigned* bar; unsigned x; volatile LAS unsigned* st; };
__device__ __forceinline__ XcdBarrier xcd_barrier_post(unsigned* bar, volatile LAS unsigned* st) {
    XcdBarrier b; b.bar = bar; b.x = xb_xcc_id(); b.st = st;
    if (threadIdx.x == 0) (void)xb_add(&bar[XB_XCNT(b.x)], 1u);
    return b;
}
__device__ __forceinline__ void xcd_barrier_complete(unsigned* bar, unsigned x, unsigned& nloc, unsigned& nx) {
    const unsigned G = gridDim.x * gridDim.y * gridDim.z;
    unsigned sum, cnt, mine, sp = 0u;
    for (;;) {
        sum = 0u; cnt = 0u; mine = 0u;
#pragma unroll
        for (unsigned j = 0; j < 16; ++j) { const unsigned c = xb_ld(&bar[XB_XCNT(j)]); sum += c; cnt += (c > 0u) ? 1u : 0u; mine = (j == x) ? c : mine; }
        if (sum == G) break;
        __builtin_amdgcn_s_sleep(1);
        if ((++sp & 255u) == 0u) { if (xb_ld(&bar[XB_TMO])) break; if (sp > XB_SPIN_CAP) { atomicAdd(&bar[XB_TMO], 1u); break; } }
    }
    nloc = mine > 0u ? mine : 1u; nx = cnt > 0u ? cnt : 1u;
}
__device__ __forceinline__ void xcd_barrier(const XcdBarrier& b) {
    asm volatile("s_waitcnt vmcnt(0)" ::: "memory");
    __syncthreads();
    if (threadIdx.x == 0) {
        unsigned* bar = b.bar;
        __builtin_amdgcn_s_waitcnt(0);
        unsigned nloc = b.st[0], nx = b.st[1];
        if (nloc == 0u) { xcd_barrier_complete(bar, b.x, nloc, nx); b.st[0] = nloc; b.st[1] = nx; }
        const unsigned old = xb_add(&bar[XB_XSUB(b.x)], 1u);
        const unsigned gen = old / nloc;
        if (old + 1u == (gen + 1u) * nloc) {
            __builtin_amdgcn_fence(__ATOMIC_RELEASE, "agent");
            asm volatile("s_waitcnt vmcnt(0)" ::: "memory");
            const unsigned og = xb_add(&bar[XB_TOP], 1u);
            const unsigned tg = og / nx;
            if (og + 1u == (tg + 1u) * nx) xb_add(&bar[XB_TOPGEN], 1u);
            else XB_SPIN(xb_ld(&bar[XB_TOPGEN]) == tg, bar);
            __builtin_amdgcn_fence(__ATOMIC_ACQUIRE, "agent");
            xb_add(&bar[XB_XGEN(b.x)], 1u);
            asm volatile("s_waitcnt vmcnt(0)" ::: "memory");
        } else {
            XB_SPIN(xb_ld(&bar[XB_XGEN(b.x)]) == gen, bar);
            __builtin_amdgcn_fence(__ATOMIC_ACQUIRE, "agent");
            asm volatile("s_waitcnt vmcnt(0)" ::: "memory");
        }
    }
    __syncthreads();
}
#endif

constexpr int NPH = 26;
constexpr int NPHASES = DEPTH * (1 + NHALF * NPH) + 1;
constexpr int LDS_BYTES = 155648, MISC_OFF = 154624;

__global__ void __launch_bounds__(512, 2) fwd_kernel(Args args_k) {
#ifdef EMU
    unsigned char* lds = emu_lds_ptr;
#else
    extern __shared__ __attribute__((aligned(16))) unsigned char lds[];
#endif
    Frame F0;
    F0.lds = (LAS unsigned char*)lds; F0.tid = threadIdx.x; F0.lane = F0.tid & 63; F0.wave = RFL(F0.tid >> 6); F0.G = gridDim.x; F0.bid = blockIdx.x;
    F0.gw = F0.bid * 8 + F0.wave; F0.NGW = F0.G * 8;
    F0.out = args_k.out; F0.ws = args_k.ws; F0.ctl = (unsigned*)(args_k.ws + WS_CTL);
    const int lo = args_k.lo, hi = args_k.hi;
#ifndef EMU
    volatile LAS unsigned* misc = (volatile LAS unsigned*)(F0.lds + MISC_OFF);
    if (F0.tid < 4) misc[F0.tid] = 0u;
    __syncthreads();
    XcdBarrier bar; bar.bar = F0.ctl + CW_BAR; bar.x = 0; bar.st = misc;
    if (hi - lo > 1) bar = xcd_barrier_post(F0.ctl + CW_BAR, misc);
#define GRID_BAR() do { XcdBarrier bq = bar; asm volatile("" : "+s"(bq.bar), "+s"(bq.x)); xcd_barrier(bq); } while (0)
#else
#define GRID_BAR() do { } while (0)
#endif
    int ph = 0;
#ifndef PH_MASK
#define PH_MASK 0xFFFFFFFFFFFFFFFFull
#endif
#define PHASE(...) PHASE_I(31, __VA_ARGS__)
#ifdef EMU
#define LAUNDER(Fq) do { } while (0)
#else
#define LAUNDER(Fq) do { unsigned mq_ = ~0u; asm volatile("" : "+s"(Fq.G), "+s"(Fq.bid), "+s"(Fq.wave), "+s"(Fq.ws), "+s"(Fq.out), "+s"(Fq.ctl), "+s"(mq_)); Fq.lane = (int)__builtin_amdgcn_mbcnt_hi(mq_, __builtin_amdgcn_mbcnt_lo(mq_, 0u)); Fq.tid = Fq.wave * 64 + Fq.lane; Fq.gw = Fq.bid * 8 + Fq.wave; Fq.NGW = Fq.G * 8; } while (0)
#endif
#ifdef EMU
#define ARGS_Q() const Args& args_q = args_k
#else
#define ARGS_Q() const __attribute__((address_space(4))) Args* aq_ = (const __attribute__((address_space(4))) Args*)__builtin_amdgcn_kernarg_segment_ptr(); asm volatile("" : "+s"(aq_)); const Args& args_q = *(const Args*)aq_
#endif
#ifndef REPEAT_MASK
#define REPEAT_MASK 0u
#endif
#define PHASE_I(kind, ...) do { if (ph >= lo && ph < hi) { constexpr int reps_ = (((REPEAT_MASK) >> (kind)) & 1u) ? 2 : 1; for (int rr_ = 0; rr_ < reps_; ++rr_) { { Frame Fq = F0; LAUNDER(Fq); const Frame& F = Fq; ARGS_Q(); const Args& args = args_q; __VA_ARGS__; } if (rr_ + 1 < reps_ || ph + 1 < hi) GRID_BAR(); } } ++ph; } while (0)
#define PHASEK(kind, ...) PHASE_I(kind, __VA_ARGS__)
#define SEGMENT(layer, half) do { \
            const size_t r0 = (size_t)(half) * TH; \
            const float* xin = ((layer) == 0 ? args_k.in[0] : F0.out) + r0 * D; float* xo = F0.out + r0 * D; \
            PHASEK(0, phase_norm<false>(F, args, xin, args.in[2] + (layer) * D, WSP(bf16, A_H), nullptr, nullptr, nullptr, nullptr); phase_rope_table(F, args, (const int*)args.in[1] + r0, WSP(float, A_ROPE))); \
            PHASEK(1, { pg8::Gemm g{WSP(bf16, A_H), WSP(bf16, W_IN), D, D}; pg8::StaticOrder S; S.init(TH, PW, F.G, F.bid); EpiBf16 E{WSP(bf16, A_P), PW, nullptr, 0}; pg8::gemm_phase(F.lds, g, S, E, F.tid); }); \
            PHASEK(2, phase_mla_prep(F, args)); \
            PHASEK(3, phase_mla_q(F, args)); \
            PHASEK(4, phase_mla_kv(F, args)); \
            PHASEK(5, phase_attention(F, args)); \
            PHASEK(6, phase_rwkv_prep(F, args, layer)); \
            PHASEK(7, phase_rwkv_lora(F, args)); \
            PHASEK(8, phase_rwkv_r1(F, args, layer)); \
            PHASEK(24, phase_rwkv_r2(F, args)); \
            PHASEK(9, phase_rwkv_post(F, args, layer)); \
            PHASEK(10, phase_gdn_g1(F, args, layer)); \
            PHASEK(11, phase_gdn_g2(F, args)); \
            PHASEK(12, phase_gdn_g3(F, args, layer)); \
            for (int rs_ = 0; rs_ < ((((REPEAT_MASK) >> 25) & 1u) ? 2 : 1); ++rs_) { if (rs_) { ph -= 3; GRID_BAR(); } \
            PHASEK(13, phase_ssd_s1(F, args, layer)); \
            PHASEK(14, phase_ssd_s2(F, args)); \
            PHASEK(15, phase_ssd_s3(F, args)); } \
            PHASEK(16, phase_ssd_s4(F, args, layer)); \
            PHASEK(17, phase_merge_z(F, args)); \
            PHASEK(18, phase_merge_gate(F, args, layer)); \
            PHASEK(19, phase_merge_out(F, args, xin, xo)); \
            if ((layer) == 0) { \
                PHASEK(20, phase_norm<false>(F, args, xo, args.in[32] + (layer) * D, WSP(bf16, A_H), nullptr, nullptr, nullptr, nullptr)); \
                PHASEK(21, phase_ffn_gu(F, args)); \
                PHASE(phase_ffn_down(F, args, xo)); \
                PHASE((void)0); \
                PHASE((void)0); \
            } else { \
                PHASE(phase_norm<true>(F, args, xo, args.in[32] + (layer) * D, WSP(bf16, A_H), args.in[35], WSP(int, F_TOPE), WSP(float, F_TOPW), F.ctl + CW_CNT + (half) * 16)); \
                PHASE(phase_moe_route(F, args, half)); \
                PHASEK(22, phase_moe_gu(F, args, half)); \
                PHASEK(23, phase_moe_down(F, args, half)); \
                PHASE(phase_moe_combine(F, args, xo)); \
            } } while (0)
    static_assert(DEPTH == 2 && NHALF <= 2, "segment program");
    PHASE(phase_convert(F, args, 0));
    SEGMENT(0, 0);
    if (NHALF == 2) SEGMENT(0, 1);
    PHASE(phase_convert(F, args, 1));
    SEGMENT(1, 0);
    if (NHALF == 2) SEGMENT(1, 1);
#undef SEGMENT
    PHASE(phase_final_norm(F, args, F.out, args.in[38]));
#undef PHASE
}

#ifndef ONE_LAUNCH
#define ONE_LAUNCH 1
#endif
extern "C" void kernel_launch(void* const* d_in, const int* in_sizes, int n_in, void* d_out, int out_size, void* d_ws, size_t ws_size, hipStream_t stream) {
    static int grid = 0;
    if (grid == 0) {
#ifdef EMU
        grid = EMU_GRID;
#else
        if (n_in != 39 || out_size != T * D || ws_size < WS_NEED) { fprintf(stderr, "kernel_launch: unexpected problem (n_in %d out %d ws %zu need %zu)\n", n_in, out_size, ws_size, (size_t)WS_NEED); grid = -1; return; }
        int dev = 0, cus = 0;
        if (hipGetDevice(&dev) != hipSuccess || hipDeviceGetAttribute(&cus, hipDeviceAttributeMultiprocessorCount, dev) != hipSuccess) { grid = -1; return; }
        if (hipFuncSetAttribute((const void*)fwd_kernel, hipFuncAttributeMaxDynamicSharedMemorySize, LDS_BYTES) != hipSuccess) { fprintf(stderr, "kernel_launch: hipFuncSetAttribute failed\n"); grid = -1; return; }
        int per_cu = 0;
        if (hipOccupancyMaxActiveBlocksPerMultiprocessor(&per_cu, (const void*)fwd_kernel, 512, LDS_BYTES) != hipSuccess || per_cu < 1) fprintf(stderr, "kernel_launch: occupancy query reports %d\n", per_cu);
        (void)hipGetLastError();
        grid = cus;
#endif
    }
    if (grid < 0) return;
    (void)hipMemsetAsync((char*)d_ws + WS_CTL, 0, CTL_BYTES, stream);
    Args a{};
    for (int i = 0; i < 39; ++i) a.in[i] = (const float*)d_in[i];
    a.out = (float*)d_out; a.ws = (unsigned char*)d_ws;
#ifdef EMU
    for (int p = EMU_PH_LO; p < EMU_PH_HI && p < NPHASES; ++p) { a.lo = p; a.hi = p + 1; emu_launch(fwd_kernel, grid, 512, a); emu_after_phase(p); }
#else
#if ONE_LAUNCH
    a.lo = 0; a.hi = NPHASES;
    hipLaunchKernelGGL(fwd_kernel, dim3(grid), dim3(512), LDS_BYTES, stream, a);
#else
    for (int p = 0; p < NPHASES; ++p) { a.lo = p; a.hi = p + 1; hipLaunchKernelGGL(fwd_kernel, dim3(grid), dim3(512), LDS_BYTES, stream, a); }
#endif
#endif
}
```

```cpp
#ifndef EMU
#include <hip/hip_runtime.h>
#include <cstdio>
#include <cstdint>
#endif

#ifdef EMU
constexpr int BATCH = EMU_B, SEQ = EMU_S, NHALF = EMU_NHALF;
#else
constexpr int BATCH = 16, SEQ = 2048, NHALF = 2;
#endif
constexpr int D = 1024, DEPTH = 2, CH = 64;
constexpr int T = BATCH * SEQ, TH = T / NHALF, BH = BATCH / NHALF, NCH = SEQ / CH;
constexpr int C_MLA = 0, C_RWKV = 704, C_GDN = 2528, C_SSD = 4584, C_GATE = 6128, IN_COLS = 10224, PW = 6144;
constexpr int FF_D = 2816, FF_E = 3584, NEXP = 8;
constexpr int MOE_ROWS = ((TH * 2 + NEXP * 255) / 256) * 256;
constexpr float EPS = 1e-6f;
static_assert(TH % 256 == 0 && SEQ % 128 == 0 && BATCH % NHALF == 0, "shape");

typedef unsigned short bf16;
typedef float f32x4 __attribute__((ext_vector_type(4)));
typedef float f32x2 __attribute__((ext_vector_type(2)));
typedef short bf16x8 __attribute__((ext_vector_type(8)));
typedef short bf16x4 __attribute__((ext_vector_type(4)));
typedef unsigned u32x4 __attribute__((ext_vector_type(4)));
typedef unsigned u32x2 __attribute__((ext_vector_type(2)));
#ifdef EMU
#define LAS
#define GAS
#define MFMA_F32(a, b, c) emu_mfma_16x16x4f32(a, b, c)
#define MFMA_BF16(a, b, c) emu_mfma_16x16x32bf16(a, b, c)
#define ATOMIC_ADD_U32(p, v) emu_atomic_add_u32(p, v)
#define RFL(x) (x)
#define LDS_WAIT()
#define VM_WAIT()
__device__ __forceinline__ float fast_exp(float x) { return expf(x); }
__device__ __forceinline__ float fast_rcp(float x) { return 1.0f / x; }
__device__ __forceinline__ float fast_rsqrt(float x) { return 1.0f / sqrtf(x); }
#else
#define LAS __attribute__((address_space(3)))
#define GAS __attribute__((address_space(1)))
#define MFMA_F32(a, b, c) __builtin_amdgcn_mfma_f32_16x16x4f32(a, b, c, 0, 0, 0)
#define MFMA_BF16(a, b, c) __builtin_amdgcn_mfma_f32_16x16x32_bf16(a, b, c, 0, 0, 0)
#define ATOMIC_ADD_U32(p, v) __hip_atomic_fetch_add(p, v, __ATOMIC_RELAXED, __HIP_MEMORY_SCOPE_AGENT)
#define RFL(x) __builtin_amdgcn_readfirstlane(x)
#define LDS_WAIT() asm volatile("s_waitcnt lgkmcnt(0)" ::: "memory")
#define VM_WAIT() asm volatile("s_waitcnt vmcnt(0)" ::: "memory")
__device__ __forceinline__ float fast_exp(float x) { return __expf(x); }
__device__ __forceinline__ float fast_rcp(float x) { return __builtin_amdgcn_rcpf(x); }
__device__ __forceinline__ float fast_rsqrt(float x) { return __builtin_amdgcn_rsqf(x); }
#endif
__device__ __forceinline__ unsigned f2u(float f) { return __builtin_bit_cast(unsigned, f); }
__device__ __forceinline__ float u2f(unsigned u) { return __builtin_bit_cast(float, u); }
__device__ __forceinline__ unsigned f2bf(float f) { unsigned u = f2u(f); return (u + 0x7fffu + ((u >> 16) & 1u)) >> 16; }
__device__ __forceinline__ float bf2f(unsigned h) { return u2f(h << 16); }
__device__ __forceinline__ unsigned pk2(float lo, float hi) { return f2bf(lo) | (f2bf(hi) << 16); }
__device__ __forceinline__ float sigmoidf_(float x) { return 1.0f / (1.0f + expf(-x)); }
__device__ __forceinline__ float siluf_(float x) { return x / (1.0f + expf(-x)); }
__device__ __forceinline__ float softplusf_(float x) { return x > 20.f ? x : log1pf(expf(x)); }
__device__ __forceinline__ float wave_sum(float v) {
#pragma unroll
    for (int o = 1; o < 64; o <<= 1) v += __shfl_xor(v, o);
    return v;
}
__device__ __forceinline__ float wave_max(float v) {
#pragma unroll
    for (int o = 1; o < 64; o <<= 1) v = fmaxf(v, __shfl_xor(v, o));
    return v;
}
__device__ __forceinline__ f32x4 ld_bf16x4(const bf16* p) { const u32x2 w = *(const u32x2*)p; return (f32x4){bf2f(w.x & 0xffffu), bf2f(w.x >> 16), bf2f(w.y & 0xffffu), bf2f(w.y >> 16)}; }
__device__ __forceinline__ void st_bf16x4(bf16* p, f32x4 v) { u32x2 w; w.x = pk2(v.x, v.y); w.y = pk2(v.z, v.w); *(u32x2*)p = w; }

namespace pg8 {
#define PG8_LAS LAS
typedef unsigned short bf16_t;
constexpr int BM = 256, BK = 64, HALF = 128, HTB = HALF * BK * 2, STAGE_BYTES = 8 * HTB, NXCD = 8, WGM = 8;
__host__ __device__ __forceinline__ int lds_byte(int r, int c) { const int st = (r >> 4) * 2 + (c >> 5), rr = r & 15, cc = c & 31, ob = rr * 64 + cc * 2; return st * 1024 + (ob ^ (((ob >> 9) & 1) << 5)); }
__host__ __device__ __forceinline__ void stage_rc(int b, int& R, int& C) { const int st = b / 1024, sb = b % 1024, swz = sb ^ (((sb >> 9) & 1) << 5); R = (st >> 1) * 16 + swz / 64; C = (st & 1) * 32 + (swz % 64) / 2; }
__host__ __device__ __forceinline__ int perm32(int rho) { const int n = rho >> 4, i = rho & 15; return 8 * (i >> 2) + 4 * n + (i & 3); }
struct Unit { int pm, pn; };
struct Gemm { const bf16_t* A; const bf16_t* Bt; int lda, K; };
struct StaticOrder {
    int nM, nN, nwg, G, c;
    __host__ __device__ void init(int M, int N, int G_, int c_) { nM = M / BM; nN = N / BM; nwg = nM * nN; G = G_; c = c_; }
    __host__ __device__ bool next(int i, Unit& u) const {
        const long L = (long)i * G + c; if (L >= nwg) return false;
        int wgid = (int)L; { const int q = nwg / NXCD, r = nwg % NXCD, xcd = wgid % NXCD, off = wgid / NXCD; wgid = (xcd < r ? xcd * (q + 1) : r * (q + 1) + (xcd - r) * q) + off; }
        const int nig = WGM * nN, gid = wgid / nig, fm = gid * WGM, gsz = (nM - fm) < WGM ? (nM - fm) : WGM;
        u.pm = fm + ((wgid % nig) % gsz); u.pn = (wgid % nig) / gsz; return true;
    }
    __device__ __forceinline__ void a_ready(const Unit&) const {}
    __device__ __forceinline__ void done(const Unit&) const {}
};
#ifndef EMU
template <class Epi, class Sched>
__device__ __forceinline__ void gemm_phase(PG8_LAS unsigned char* lds, const Gemm g, const Sched& S, const Epi& E, const int tid) {
    const int wid = __builtin_amdgcn_readfirstlane(tid >> 6), lane = tid & 63, wr = wid >> 2, wc = wid & 3, fr = lane & 15, fq = lane >> 4;
    int Kq = g.K; asm volatile("" : "+s"(Kq));
    const int K = Kq, nt = K / BK, lda = g.lda;
    unsigned voffA[2], voffB[2];
#pragma unroll
    for (int i = 0; i < 2; ++i) { int R, C; stage_rc(tid * 16 + i * 8192, R, C); const int Rb = Epi::PERM ? ((R & ~31) + perm32(R & 31)) : R;
        voffA[i] = (unsigned)(R * lda + C) * 2u; voffB[i] = (unsigned)(Rb * K + C) * 2u; }
    const size_t kstep = (size_t)(BK * 2);
    const size_t hstep = (size_t)HALF * K * 2, hstepA = (size_t)HALF * lda * 2;
    const size_t tstep = 2 * hstep, tstepA = 2 * hstepA;
    const unsigned ldsw = (unsigned)wid * 1024u;
    const int aoff = lds_byte(wr * 64 + fr, fq * 8), boff = lds_byte(wc * 32 + fr, fq * 8);
#define PG8_SA(b, h) (((b) * 2 + (h)) * HTB)
#define PG8_SB(b, h) ((4 + (b) * 2 + (h)) * HTB)
#define PG8_STAGE(bufoff, gbase, voff) do { _Pragma("unroll") for (int _i = 0; _i < 2; ++_i) \
        __builtin_amdgcn_global_load_lds((const unsigned*)((const char*)(gbase) + (voff)[_i]), (PG8_LAS unsigned*)(lds + (bufoff) + ldsw + _i * 8192), 16, 0, 0); } while (0)
#define PG8_LDA(dst, b, h) do { _Pragma("unroll") for (int m = 0; m < 4; ++m) _Pragma("unroll") for (int k = 0; k < 2; ++k) dst[m][k] = *(const PG8_LAS bf16x8*)(lds + PG8_SA(b, h) + aoff + m * 2048 + k * 1024); } while (0)
#define PG8_LDB(dst, b, h) do { _Pragma("unroll") for (int n = 0; n < 2; ++n) _Pragma("unroll") for (int k = 0; k < 2; ++k) dst[n][k] = *(const PG8_LAS bf16x8*)(lds + PG8_SB(b, h) + boff + n * 2048 + k * 1024); } while (0)
#define PG8_MMA(ai, bj, At, Bt) do { __builtin_amdgcn_s_setprio(1); _Pragma("unroll") for (int m = 0; m < 4; ++m) _Pragma("unroll") for (int n = 0; n < 2; ++n) _Pragma("unroll") for (int k = 0; k < 2; ++k) \
        acc[ai][bj][m][n] = __builtin_amdgcn_mfma_f32_16x16x32_bf16(Bt[n][k], At[m][k], acc[ai][bj][m][n], 0, 0, 0); __builtin_amdgcn_s_setprio(0); } while (0)
#define PG8_WAIT_V(n) asm volatile("s_waitcnt vmcnt(" #n ")" ::: "memory")
#define PG8_WAIT_L(n) asm volatile("s_waitcnt lgkmcnt(" #n ")" ::: "memory")
#define PG8_BAR __builtin_amdgcn_s_barrier()
#define PG8_SCHED __builtin_amdgcn_sched_barrier(0)
    Unit cur, nxt; int ui = 0;
    if (!S.next(0, cur)) return;
    f32x4 acc[2][2][4][2];
#pragma unroll
    for (int a = 0; a < 2; ++a)
#pragma unroll
        for (int b = 0; b < 2; ++b)
#pragma unroll
            for (int m = 0; m < 4; ++m)
#pragma unroll
                for (int n = 0; n < 2; ++n) acc[a][b][m][n] = (f32x4){0.f, 0.f, 0.f, 0.f};
    bf16x8 At[4][2], B0[2][2], B1[2][2];
    const char* cA = (const char*)g.A + (size_t)cur.pm * tstepA; const char* cB = (const char*)g.Bt + (size_t)cur.pn * tstep;
    S.a_ready(cur);
    PG8_STAGE(PG8_SB(0, 0), cB, voffB); PG8_STAGE(PG8_SA(0, 0), cA, voffA); PG8_STAGE(PG8_SB(0, 1), cB + hstep, voffB); PG8_STAGE(PG8_SA(0, 1), cA + hstepA, voffA);
    if (wr == 1) PG8_BAR;
    PG8_WAIT_V(4); PG8_BAR;
    PG8_STAGE(PG8_SB(1, 0), cB + kstep, voffB); PG8_STAGE(PG8_SA(1, 0), cA + kstep, voffA); PG8_STAGE(PG8_SB(1, 1), cB + hstep + kstep, voffB);
    PG8_WAIT_V(6); PG8_BAR;
    for (;;) {
        const bool has_next = S.next(ui + 1, nxt);
        const char* nA = has_next ? (const char*)g.A + (size_t)nxt.pm * tstepA : cA; const char* nB = has_next ? (const char*)g.Bt + (size_t)nxt.pn * tstep : cB;
        for (int t = 0; t < nt; t += 2) {
            const bool last = (t == nt - 2);
            const char* a1 = cA + (size_t)(t + 1) * kstep;
            const char* a2 = last ? nA : cA + (size_t)(t + 2) * kstep; const char* b2 = last ? nB : cB + (size_t)(t + 2) * kstep;
            const char* a3 = a2 + kstep; const char* b3 = b2 + kstep;
            if (last && has_next) S.a_ready(nxt);
            PG8_LDB(B0, 0, 0); PG8_SCHED; PG8_LDA(At, 0, 0); PG8_STAGE(PG8_SA(1, 1), a1 + hstepA, voffA);
            PG8_WAIT_L(8); PG8_BAR; PG8_WAIT_L(0); PG8_MMA(0, 0, At, B0); PG8_BAR; PG8_SCHED;
            PG8_LDB(B1, 0, 1); PG8_STAGE(PG8_SB(0, 0), b2, voffB);
            PG8_BAR; PG8_WAIT_L(0); PG8_MMA(0, 1, At, B1); PG8_BAR;
            PG8_LDA(At, 0, 1); PG8_STAGE(PG8_SA(0, 0), a2, voffA);
            PG8_BAR; PG8_WAIT_L(0); PG8_MMA(1, 0, At, B0); PG8_BAR; PG8_SCHED;
            PG8_STAGE(PG8_SB(0, 1), b2 + hstep, voffB);
            PG8_WAIT_V(6); PG8_BAR; PG8_MMA(1, 1, At, B1); PG8_BAR;
            PG8_LDB(B0, 1, 0); PG8_SCHED; PG8_LDA(At, 1, 0); PG8_STAGE(PG8_SA(0, 1), a2 + hstepA, voffA);
            PG8_WAIT_L(8); PG8_BAR; PG8_WAIT_L(0); PG8_MMA(0, 0, At, B0); PG8_BAR; PG8_SCHED;
            PG8_LDB(B1, 1, 1); PG8_STAGE(PG8_SB(1, 0), b3, voffB);
            PG8_BAR; PG8_WAIT_L(0); PG8_MMA(0, 1, At, B1); PG8_BAR;
            PG8_LDA(At, 1, 1); PG8_STAGE(PG8_SA(1, 0), a3, voffA);
            PG8_BAR; PG8_WAIT_L(0); PG8_MMA(1, 0, At, B0); PG8_BAR; PG8_SCHED;
            PG8_STAGE(PG8_SB(1, 1), b3 + hstep, voffB);
            PG8_WAIT_V(6); PG8_BAR; PG8_MMA(1, 1, At, B1); PG8_BAR;
        }
        if constexpr (!Epi::AFTER_DRAIN) { E(acc, cur, wr, wc, fr, fq); S.done(cur); }
        if (!has_next) break;
#pragma unroll
        for (int a = 0; a < 2; ++a)
#pragma unroll
            for (int b = 0; b < 2; ++b)
#pragma unroll
                for (int m = 0; m < 4; ++m)
#pragma unroll
                    for (int n = 0; n < 2; ++n) acc[a][b][m][n] = (f32x4){0.f, 0.f, 0.f, 0.f};
        cur = nxt; cA = nA; cB = nB; ++ui;
    }
    PG8_WAIT_V(0);
    if (wr == 0) PG8_BAR;
    PG8_BAR;
    if constexpr (Epi::AFTER_DRAIN) { E.fused(acc, cur, wr, wc, fr, fq, lds, wid, lane); S.done(cur); }
#undef PG8_SA
#undef PG8_SB
#undef PG8_STAGE
#undef PG8_LDA
#undef PG8_LDB
#undef PG8_MMA
#undef PG8_WAIT_V
#undef PG8_WAIT_L
#undef PG8_BAR
#undef PG8_SCHED
}
#else
template <class Epi, class Sched>
__device__ __forceinline__ void gemm_phase(PG8_LAS unsigned char* lds, const Gemm g, const Sched& S, const Epi& E, const int tid) {
    const int wid = tid >> 6, lane = tid & 63, wr = wid >> 2, wc = wid & 3, fr = lane & 15, fq = lane >> 4;
    Unit cur;
    for (int ui = 0; S.next(ui, cur); ++ui) {
        f32x4 acc[2][2][4][2];
        for (int ai = 0; ai < 2; ++ai) for (int m = 0; m < 4; ++m) {
            const size_t row = (size_t)cur.pm * 256 + ai * 128 + wr * 64 + m * 16 + fr;
            const bf16_t* ap = g.A + row * g.lda;
            for (int bj = 0; bj < 2; ++bj) for (int n = 0; n < 2; ++n) for (int j = 0; j < 4; ++j) {
                const size_t col = (size_t)cur.pn * 256 + bj * 128 + wc * 32 + (Epi::PERM ? 8 * fq + 4 * n : 16 * n + 4 * fq) + j;
                const bf16_t* bp = g.Bt + col * g.K; float s = 0.f;
                for (int k = 0; k < g.K; ++k) s += bf2f(ap[k]) * bf2f(bp[k]);
                acc[ai][bj][m][n][j] = s; } }
        E(acc, cur, wr, wc, fr, fq);
    }
    __syncthreads();
}
#endif
}

using pg8::Unit;
constexpr int HALFT = 128;
struct EpiF32 {
    static constexpr bool PERM = false, AFTER_DRAIN = false;
    float* C; int ldc;
    __device__ __forceinline__ void operator()(const f32x4 (&acc)[2][2][4][2], const Unit& u, int wr, int wc, int fr, int fq) const {
        const int row0 = u.pm * 256 + wr * 64 + fr, col0 = u.pn * 256 + wc * 32 + 4 * fq;
#pragma unroll
        for (int ai = 0; ai < 2; ++ai)
#pragma unroll
            for (int m = 0; m < 4; ++m) { float* rowp = C + (size_t)(row0 + ai * HALFT + m * 16) * ldc + col0;
#pragma unroll
                for (int bj = 0; bj < 2; ++bj)
#pragma unroll
                    for (int n = 0; n < 2; ++n) *(f32x4*)(rowp + bj * HALFT + n * 16) = acc[ai][bj][m][n]; }
    }
};
struct EpiResidual {
    static constexpr bool PERM = false, AFTER_DRAIN = false;
    const float* res; float* out;
    __device__ __forceinline__ void operator()(const f32x4 (&acc)[2][2][4][2], const Unit& u, int wr, int wc, int fr, int fq) const {
        const int row0 = u.pm * 256 + wr * 64 + fr, col0 = u.pn * 256 + wc * 32 + 4 * fq;
#pragma unroll
        for (int ai = 0; ai < 2; ++ai)
#pragma unroll
            for (int m = 0; m < 4; ++m) { const size_t o = (size_t)(row0 + ai * HALFT + m * 16) * D + col0;
#pragma unroll
                for (int bj = 0; bj < 2; ++bj)
#pragma unroll
                    for (int n = 0; n < 2; ++n) { const f32x4 r = *(const f32x4*)(res + o + bj * HALFT + n * 16); *(f32x4*)(out + o + bj * HALFT + n * 16) = r + acc[ai][bj][m][n]; } }
    }
};
struct EpiBf16 {
    static constexpr bool PERM = true, AFTER_DRAIN = false;
    bf16* O; int ldc; const float* rowscale; int rs_stride;
    __device__ __forceinline__ void operator()(const f32x4 (&acc)[2][2][4][2], const Unit& u, int wr, int wc, int fr, int fq) const {
        const int row0 = u.pm * 256 + wr * 64 + fr, col0 = u.pn * 256 + wc * 32 + 8 * fq;
#pragma unroll
        for (int ai = 0; ai < 2; ++ai)
#pragma unroll
            for (int m = 0; m < 4; ++m) { const int row = row0 + ai * HALFT + m * 16; bf16* rowp = O + (size_t)row * ldc + col0;
                const float sc = rowscale ? rowscale[(size_t)row * rs_stride] : 1.0f;
#pragma unroll
                for (int bj = 0; bj < 2; ++bj) { const f32x4 v0 = acc[ai][bj][m][0] * sc, v1 = acc[ai][bj][m][1] * sc;
                    u32x4 w; w.x = pk2(v0[0], v0[1]); w.y = pk2(v0[2], v0[3]); w.z = pk2(v1[0], v1[1]); w.w = pk2(v1[2], v1[3]);
                    *(u32x4*)(rowp + bj * HALFT) = w; } }
    }
};
struct EpiSwiGLU {
    static constexpr bool PERM = true, AFTER_DRAIN = false;
    bf16* O; int ldc; int ntile;
    __device__ __forceinline__ void operator()(const f32x4 (&acc)[2][2][4][2], const Unit& u, int wr, int wc, int fr, int fq) const {
        const int row0 = u.pm * 256 + wr * 64 + fr, col0 = (u.pn % ntile) * 128 + wc * 32 + 8 * fq;
#pragma unroll
        for (int ai = 0; ai < 2; ++ai)
#pragma unroll
            for (int m = 0; m < 4; ++m) { bf16* rowp = O + (size_t)(row0 + ai * HALFT + m * 16) * ldc + col0;
                float a[8];
#pragma unroll
                for (int n = 0; n < 2; ++n)
#pragma unroll
                    for (int j = 0; j < 4; ++j) { const float g = acc[ai][0][m][n][j], up = acc[ai][1][m][n][j]; a[4 * n + j] = g * fast_rcp(1.0f + fast_exp(-g)) * up; }
                u32x4 w; w.x = pk2(a[0], a[1]); w.y = pk2(a[2], a[3]); w.z = pk2(a[4], a[5]); w.w = pk2(a[6], a[7]);
                *(u32x4*)rowp = w; }
    }
};
struct EpiMerge {
    static constexpr bool PERM = false, AFTER_DRAIN = false;
    const bf16* Z; const float* gate_b; bf16* MG;
    __device__ __forceinline__ void operator()(const f32x4 (&acc)[2][2][4][2], const Unit& u, int wr, int wc, int fr, int fq) const {
        const int row0 = u.pm * 256 + wr * 64 + fr, col = u.pn * 64 + wc * 16 + 4 * fq;
        f32x4 gb[4];
#pragma unroll
        for (int i = 0; i < 4; ++i) gb[i] = *(const f32x4*)(gate_b + i * D + col);
#pragma unroll
        for (int ai = 0; ai < 2; ++ai)
#pragma unroll
            for (int m = 0; m < 4; ++m) { const size_t row = (size_t)(row0 + ai * HALFT + m * 16);
                f32x4 s = (f32x4){0.f, 0.f, 0.f, 0.f};
#pragma unroll
                for (int bj = 0; bj < 2; ++bj)
#pragma unroll
                    for (int n = 0; n < 2; ++n) { const int i = 2 * bj + n; const f32x4 z = ld_bf16x4(Z + row * 4096 + i * D + col); const f32x4 a = acc[ai][bj][m][n] + gb[i];
#pragma unroll
                        for (int j = 0; j < 4; ++j) s[j] += z[j] * fast_rcp(1.0f + fast_exp(-a[j])); }
                st_bf16x4(MG + row * D + col, s); }
    }
};

constexpr size_t MiB = 1u << 20;
constexpr size_t al(size_t x) { return (x + 255) & ~(size_t)255; }
constexpr size_t WS_CTL = 0, CTL_BYTES = 1 * MiB;
constexpr size_t W_IN = 1 * MiB;
constexpr size_t W_GATE = W_IN + (size_t)PW * D * 2;
constexpr size_t W_UQ = W_GATE + (size_t)4096 * D * 2;
constexpr size_t W_UKV = W_UQ + (size_t)768 * 384 * 2;
constexpr size_t W_LORA = W_UKV + (size_t)1024 * 256 * 2;
constexpr size_t W_BR = W_LORA + (size_t)1536 * 384 * 2;
constexpr size_t W_OUT = W_BR + (size_t)4 * 1024 * 512 * 2;
constexpr size_t W_FGU = W_OUT + (size_t)D * D * 2;
constexpr size_t W_FDN = W_FGU + (size_t)NEXP * 2 * FF_E * D * 2;
constexpr size_t W_END = W_FDN + (size_t)NEXP * D * FF_E * 2;
constexpr size_t A_H = al(W_END);
constexpr size_t A_ROPE = A_H + (size_t)TH * D * 2;
constexpr size_t A_Y = A_ROPE + (size_t)TH * 64 * 4;
constexpr size_t A_P = A_Y + (size_t)4 * TH * 512 * 2;
constexpr size_t A_MIX = A_P + (size_t)TH * PW * 2;
constexpr size_t M_STAT = A_MIX;
constexpr size_t M_KR = M_STAT + (size_t)TH * 2 * 4;
constexpr size_t M_Q = M_KR + (size_t)TH * 64 * 2;
constexpr size_t M_KV = M_Q + (size_t)TH * 768 * 2;
constexpr size_t M_END = M_KV + (size_t)TH * 1024 * 2;
constexpr size_t R_RKV = A_MIX;
constexpr size_t R_LIN = R_RKV + (size_t)TH * 1536 * 2;
constexpr size_t R_LOUT = R_LIN + (size_t)TH * 384 * 2;
constexpr size_t R_REC = R_LOUT + (size_t)TH * 1536 * 4;
constexpr size_t R_O = R_REC + (size_t)BH * 8 * NCH * 92416;
constexpr size_t R_END = R_O + (size_t)TH * 512 * 4;
constexpr size_t G_CH = A_MIX;
constexpr size_t G_O = G_CH + al((size_t)BH * 4 * NCH * 103440);
constexpr size_t G_END = G_O + (size_t)TH * 512 * 4;
constexpr size_t S_ST = A_MIX;
constexpr size_t S_YD = S_ST + (size_t)BH * NCH * 8 * 64 * 128 * 4;
constexpr size_t S_C = S_YD + (size_t)TH * 512 * 4;
constexpr size_t S_AC = S_C + (size_t)TH * 256 * 4;
constexpr size_t S_END = S_AC + (size_t)TH * 8 * 4;
constexpr size_t A_Z = A_P;
constexpr size_t A_MG = A_MIX;
constexpr size_t F_ACT = A_P;
constexpr size_t F_GA = F_ACT + (size_t)MOE_ROWS * FF_E * 2;
constexpr size_t F_YE = F_GA + (size_t)MOE_ROWS * D * 2;
constexpr size_t F_TOPE = F_YE + (size_t)MOE_ROWS * D * 4;
constexpr size_t F_TOPW = F_TOPE + (size_t)TH * 2 * 4;
constexpr size_t F_SLOT = F_TOPW + (size_t)TH * 2 * 4;
constexpr size_t F_END = F_SLOT + (size_t)TH * 2 * 4;
constexpr size_t cmax(size_t a, size_t b) { return a > b ? a : b; }
constexpr size_t WS_NEED = cmax(cmax(cmax(M_END, R_END), cmax(G_END, S_END)), F_END);
#ifndef EMU
static_assert(WS_NEED <= (size_t)896 * MiB, "workspace");
#endif
constexpr int CW_BAR = 4096;
constexpr int CW_CNT = 16384;
constexpr int CW_FILL = 16384 + 64;

#ifdef EMU
#define WAVE_SYNC() emu_wave_sync()
#else
#define WAVE_SYNC() do { asm volatile("s_waitcnt lgkmcnt(0)" ::: "memory"); } while (0)
#endif
struct Frame {
    LAS unsigned char* lds; int tid, lane, wave, G, gw, NGW, bid;
    float* out; unsigned char* ws; unsigned* ctl;
};
struct Args { const float* in[39]; float* out; unsigned char* ws; int lo, hi; };
#define WSP(type, off) ((type*)(F.ws + (off)))

template <class FN>
__device__ __forceinline__ void cvt_matrix(const Frame& F, const float* W, int ldw, int K, bf16* WT, int Ndst, const float* kscale, FN srccol) {
    LAS float* scr = (LAS float*)(F.lds + F.wave * 16384);
    const int nblk = Ndst / 32, nitems = (K / 64) * nblk, lane = F.lane;
    for (int item = F.gw; item < nitems; item += F.NGW) {
        const int kb = item / nblk, nb = item % nblk, k0 = 64 * kb, n0 = 32 * nb;
        const int sc = srccol(n0 + (lane & 31));
#pragma unroll 8
        for (int i = 0; i < 32; ++i) { const int kk = 2 * i + (lane >> 5); float v = sc >= 0 ? W[(size_t)(k0 + kk) * ldw + sc] : 0.f; if (kscale) v *= kscale[k0 + kk]; scr[kk * 33 + (lane & 31)] = v; }
        WAVE_SYNC();
        const int c = lane & 7;
#pragma unroll
        for (int j = 0; j < 4; ++j) { const int n = (lane >> 3) + 8 * j; const LAS float* s = scr + (8 * c) * 33 + n;
            u32x4 o; o.x = pk2(s[0 * 33], s[1 * 33]); o.y = pk2(s[2 * 33], s[3 * 33]); o.z = pk2(s[4 * 33], s[5 * 33]); o.w = pk2(s[6 * 33], s[7 * 33]);
            *(u32x4*)(WT + (size_t)(n0 + n) * K + k0 + 8 * c) = o; }
        WAVE_SYNC();
    }
}
__device__ __forceinline__ void phase_convert(const Frame& F, const Args& A, int layer) {
    const float* w_in = A.in[3] + (size_t)layer * D * IN_COLS;
    cvt_matrix(F, w_in, IN_COLS, D, WSP(bf16, W_IN), PW, nullptr, [](int n) { return n < C_GATE ? n : -1; });
    cvt_matrix(F, w_in, IN_COLS, D, WSP(bf16, W_GATE), 4096, nullptr, [](int n) {
        const int pn = n >> 8, c = n & 255, bj = c >> 7, wc = (c >> 5) & 3, nn = (c >> 4) & 1, r = c & 15; return C_GATE + (2 * bj + nn) * D + 64 * pn + 16 * wc + r; });
    cvt_matrix(F, A.in[6] + (size_t)layer * 384 * 768, 768, 384, WSP(bf16, W_UQ), 768, A.in[4] + layer * 384, [](int n) { return n; });
    cvt_matrix(F, A.in[7] + (size_t)layer * 256 * 1024, 1024, 256, WSP(bf16, W_UKV), 1024, A.in[5] + layer * 256, [](int n) { return n; });
    for (int i = 0; i < 4; ++i) cvt_matrix(F, A.in[30] + ((size_t)layer * 4 + i) * 512 * D, D, 512, WSP(bf16, W_BR) + (size_t)i * D * 512, D, nullptr, [](int n) { return n; });
    cvt_matrix(F, A.in[31] + (size_t)layer * D * D, D, D, WSP(bf16, W_OUT), D, nullptr, [](int n) { return n; });
    if (layer == 0) {
        cvt_matrix(F, A.in[33], 2 * FF_D, D, WSP(bf16, W_FGU), 2 * FF_D, nullptr, [](int n) { const int pn = n >> 8, c = n & 255; return c < 128 ? 128 * pn + c : FF_D + 128 * pn + (c - 128); });
        cvt_matrix(F, A.in[34], D, FF_D, WSP(bf16, W_FDN), D, nullptr, [](int n) { return n; });
    } else {
        for (int e = 0; e < NEXP; ++e) {
            cvt_matrix(F, A.in[36] + (size_t)e * D * 2 * FF_E, 2 * FF_E, D, WSP(bf16, W_FGU) + (size_t)e * 2 * FF_E * D, 2 * FF_E, nullptr, [](int n) { const int pn = n >> 8, c = n & 255; return c < 128 ? 128 * pn + c : FF_E + 128 * pn + (c - 128); });
            cvt_matrix(F, A.in[37] + (size_t)e * FF_E * D, D, FF_E, WSP(bf16, W_FDN) + (size_t)e * D * FF_E, D, nullptr, [](int n) { return n; });
        }
    }
    { const float* w2 = A.in[10] + (size_t)layer * 64 * 512; const float* a2 = A.in[12] + (size_t)layer * 64 * 512; const float* g2 = A.in[13] + (size_t)layer * 160 * 512;
      bf16* L = WSP(bf16, W_LORA);
      for (int idx = F.bid * 512 + F.tid; idx < 1536 * 384; idx += F.G * 512) { const int n = idx / 384, k = idx % 384; float v = 0.f;
          if (n < 512) { if (k < 64) v = w2[k * 512 + n]; } else if (n < 1024) { if (k >= 64 && k < 128) v = a2[(k - 64) * 512 + (n - 512)]; } else { if (k >= 128 && k < 288) v = g2[(k - 128) * 512 + (n - 1024)]; }
          L[idx] = (bf16)f2bf(v); } }
}

template <bool ROUTER>
__device__ __forceinline__ void phase_norm(const Frame& F, const Args& A, const float* xin, const float* gain, bf16* H, const float* router, int* tope, float* topw, unsigned* cnt) {
    const int lane = F.lane;
    f32x4 gv[4];
#pragma unroll
    for (int j = 0; j < 4; ++j) gv[j] = *(const f32x4*)(gain + 4 * lane + 256 * j);
    for (int m = F.gw; m < TH; m += F.NGW) {
        const float* xr = xin + (size_t)m * D; f32x4 v[4]; float ss = 0.f;
#pragma unroll
        for (int j = 0; j < 4; ++j) { v[j] = *(const f32x4*)(xr + 4 * lane + 256 * j); ss += (v[j].x * v[j].x + v[j].y * v[j].y) + (v[j].z * v[j].z + v[j].w * v[j].w); }
        const float rstd = 1.0f / sqrtf(wave_sum(ss) * (1.0f / D) + EPS);
#pragma unroll
        for (int j = 0; j < 4; ++j) { v[j] = v[j] * rstd * gv[j]; st_bf16x4(H + (size_t)m * D + 4 * lane + 256 * j, v[j]); }
        if (ROUTER) {
            float lg[8];
#pragma unroll
            for (int e = 0; e < 8; ++e) lg[e] = 0.f;
#pragma unroll
            for (int j = 0; j < 4; ++j)
#pragma unroll
                for (int q = 0; q < 4; ++q) { const float* rp = router + (size_t)(4 * lane + 256 * j + q) * 8; const f32x4 r0 = *(const f32x4*)rp, r1 = *(const f32x4*)(rp + 4); const float hv = v[j][q];
                    lg[0] += hv * r0.x; lg[1] += hv * r0.y; lg[2] += hv * r0.z; lg[3] += hv * r0.w; lg[4] += hv * r1.x; lg[5] += hv * r1.y; lg[6] += hv * r1.z; lg[7] += hv * r1.w; }
#pragma unroll
            for (int e = 0; e < 8; ++e) lg[e] = wave_sum(lg[e]);
            if (lane == 0) {
                int e1 = 0; float l1 = lg[0];
#pragma unroll
                for (int e = 1; e < 8; ++e) if (lg[e] > l1) { l1 = lg[e]; e1 = e; }
                int e2 = -1; float l2 = -3.0e38f;
#pragma unroll
                for (int e = 0; e < 8; ++e) if (e != e1 && lg[e] > l2) { l2 = lg[e]; e2 = e; }
                const float w1 = 1.0f / (1.0f + expf(l2 - l1));
                tope[2 * m] = e1; tope[2 * m + 1] = e2; topw[2 * m] = w1; topw[2 * m + 1] = 1.0f - w1;
                ATOMIC_ADD_U32(cnt + e1, 1u); ATOMIC_ADD_U32(cnt + e2, 1u);
            }
        }
    }
}
__device__ __forceinline__ void phase_rope_table(const Frame& F, const Args& A, const int* pos, float* rope) {
    for (int idx = F.bid * 512 + F.tid; idx < TH * 32; idx += F.G * 512) { const int t = idx >> 5, i = idx & 31;
        const float inv = powf(10000.0f, -(float)i / 32.0f);
        const float ang = (float)pos[t] * inv; float sn, cs; sincosf(ang, &sn, &cs);
        rope[(size_t)t * 64 + i] = cs; rope[(size_t)t * 64 + 32 + i] = sn; }
}
__device__ __forceinline__ void phase_final_norm(const Frame& F, const Args& A, float* x, const float* gain) {
    const int lane = F.lane;
    for (int m = F.gw; m < T; m += F.NGW) {
        float* xr = x + (size_t)m * D; f32x4 v[4]; float ss = 0.f;
#pragma unroll
        for (int j = 0; j < 4; ++j) { v[j] = *(const f32x4*)(xr + 4 * lane + 256 * j); ss += (v[j].x * v[j].x + v[j].y * v[j].y) + (v[j].z * v[j].z + v[j].w * v[j].w); }
        const float rstd = 1.0f / sqrtf(wave_sum(ss) * (1.0f / D) + EPS);
#pragma unroll
        for (int j = 0; j < 4; ++j) *(f32x4*)(xr + 4 * lane + 256 * j) = v[j] * rstd * *(const f32x4*)(gain + 4 * lane + 256 * j);
    }
}

__device__ __forceinline__ void phase_mla_prep(const Frame& F, const Args& A) {
    bf16* P = WSP(bf16, A_P); bf16* kr = WSP(bf16, M_KR); const float* rope = WSP(float, A_ROPE);
    const int lane = F.lane;
    for (int m = F.gw; m < TH; m += F.NGW) {
        bf16* pr = P + (size_t)m * PW; float sq = 0.f, skv = 0.f; f32x4 v[3];
#pragma unroll
        for (int j = 0; j < 3; ++j) { const int c = 4 * lane + 256 * j; v[j] = ld_bf16x4(pr + c); const float s = (v[j].x * v[j].x + v[j].y * v[j].y) + (v[j].z * v[j].z + v[j].w * v[j].w);
            if (c < 384) sq += s; else if (c < 640) skv += s; }
        sq = wave_sum(sq); skv = wave_sum(skv);
        const float rq = 1.0f / sqrtf(sq * (1.0f / 384.0f) + EPS), rkv = 1.0f / sqrtf(skv * (1.0f / 256.0f) + EPS);
#pragma unroll
        for (int j = 0; j < 3; ++j) { const int c = 4 * lane + 256 * j; if (c < 640) st_bf16x4(pr + c, v[j] * (c < 384 ? rq : rkv)); }
        if (lane < 32) { const float x1 = bf2f(pr[640 + lane]), x2 = bf2f(pr[672 + lane]), c = rope[(size_t)m * 64 + lane], s = rope[(size_t)m * 64 + 32 + lane];
            kr[(size_t)m * 64 + lane] = (bf16)f2bf(x1 * c - x2 * s); kr[(size_t)m * 64 + 32 + lane] = (bf16)f2bf(x2 * c + x1 * s); }
    }
}
__device__ __forceinline__ void phase_mla_q(const Frame& F, const Args& A) {
    pg8::Gemm g{WSP(bf16, A_P) + 0, WSP(bf16, W_UQ), PW, 384}; pg8::StaticOrder S; S.init(TH, 768, F.G, F.bid);
    EpiBf16 E{WSP(bf16, M_Q), 768, nullptr, 0}; pg8::gemm_phase(F.lds, g, S, E, F.tid);
}
__device__ __forceinline__ void phase_mla_kv(const Frame& F, const Args& A) {
    pg8::Gemm g{WSP(bf16, A_P) + 384, WSP(bf16, W_UKV), PW, 256}; pg8::StaticOrder S; S.init(TH, 1024, F.G, F.bid);
    EpiBf16 E{WSP(bf16, M_KV), 1024, nullptr, 0}; pg8::gemm_phase(F.lds, g, S, E, F.tid);
}
constexpr int AT_KS = 200, AT_VS = 72;
__device__ __forceinline__ void phase_attention(const Frame& F, const Args& A) {
    const bf16* Q = WSP(bf16, M_Q); const bf16* KV = WSP(bf16, M_KV); const bf16* KR = WSP(bf16, M_KR); const float* rope = WSP(float, A_ROPE); bf16* Y = WSP(bf16, A_Y);
    LAS bf16* Ks = (LAS bf16*)F.lds; LAS bf16* Vt = (LAS bf16*)(F.lds + 64 * AT_KS * 2);
    const int lane = F.lane, w = F.wave, l15 = lane & 15, q4 = lane >> 4, tid = F.tid;
    const int NQB = SEQ / 128, nunits = BH * 4 * NQB;
    const float scale = 0.07216878364870322f;
    for (int unit = F.bid; unit < nunits; unit += F.G) {
        const int qb = NQB - 1 - (unit % NQB), bh = unit / NQB, h = bh & 3, b = bh >> 2;
        const size_t t0 = (size_t)b * SEQ;
        const size_t tq = t0 + qb * 128 + w * 16 + l15;
        bf16x8 qf[6];
#pragma unroll
        for (int ks = 0; ks < 6; ++ks) qf[ks] = *(const bf16x8*)(Q + tq * 768 + h * 192 + 32 * ks + 8 * q4);
        {
            bf16x8 a = qf[4], c2 = qf[5];
#pragma unroll
            for (int j = 0; j < 8; ++j) { const float x1 = bf2f((unsigned short)a[j]), x2 = bf2f((unsigned short)c2[j]), c = rope[tq * 64 + 8 * q4 + j], s = rope[tq * 64 + 32 + 8 * q4 + j];
                qf[4][j] = (short)f2bf(x1 * c - x2 * s); qf[5][j] = (short)f2bf(x2 * c + x1 * s); }
        }
        f32x4 o[8];
#pragma unroll
        for (int mb = 0; mb < 8; ++mb) o[mb] = (f32x4){0.f, 0.f, 0.f, 0.f};
        float mrow = -3.0e38f, lrow = 0.f;
        const int qchunk = 2 * qb + (w >> 2), ntile = 2 * qb + 2;
        for (int kt = 0; kt < ntile; ++kt) {
            __syncthreads();
            const size_t k0 = t0 + (size_t)kt * 64;
#pragma unroll
            for (int i = 0; i < 3; ++i) { const int idx = tid + 512 * i, key = idx / 24, c = idx % 24;
                const u32x4 v = (c < 16) ? *(const u32x4*)(KV + (k0 + key) * 1024 + h * 256 + 8 * c) : *(const u32x4*)(KR + (k0 + key) * 64 + 8 * (c - 16));
                *(LAS u32x4*)(Ks + key * AT_KS + 8 * c) = v; }
#pragma unroll
            for (int i = 0; i < 2; ++i) { const int idx = tid + 512 * i, key = idx >> 4, c = idx & 15;
                const bf16x8 v = *(const bf16x8*)(KV + (k0 + key) * 1024 + h * 256 + 128 + 8 * c);
#pragma unroll
                for (int j = 0; j < 8; ++j) Vt[(8 * c + j) * AT_VS + key] = (bf16)v[j]; }
            __syncthreads();
            if (kt <= qchunk) {
                f32x4 st[4];
#pragma unroll
                for (int kb = 0; kb < 4; ++kb) { st[kb] = (f32x4){0.f, 0.f, 0.f, 0.f};
#pragma unroll
                    for (int ks = 0; ks < 6; ++ks) { const bf16x8 kf = *(const LAS bf16x8*)(Ks + (16 * kb + l15) * AT_KS + 32 * ks + 8 * q4); st[kb] = MFMA_BF16(kf, qf[ks], st[kb]); } }
                float mx = -3.0e38f;
#pragma unroll
                for (int kb = 0; kb < 4; ++kb) { st[kb] = st[kb] * scale; mx = fmaxf(mx, fmaxf(fmaxf(st[kb].x, st[kb].y), fmaxf(st[kb].z, st[kb].w))); }
                mx = fmaxf(mx, __shfl_xor(mx, 16)); mx = fmaxf(mx, __shfl_xor(mx, 32));
                const float mnew = fmaxf(mrow, mx), alpha = expf(mrow - mnew); mrow = mnew;
                float ps = 0.f;
#pragma unroll
                for (int kb = 0; kb < 4; ++kb)
#pragma unroll
                    for (int r = 0; r < 4; ++r) { const float p = expf(st[kb][r] - mnew); st[kb][r] = p; ps += p; }
                lrow = lrow * alpha + ps;
#pragma unroll
                for (int mb = 0; mb < 8; ++mb) o[mb] = o[mb] * alpha;
#pragma unroll
                for (int kg = 0; kg < 2; ++kg) {
                    bf16x8 pb;
#pragma unroll
                    for (int j = 0; j < 4; ++j) { pb[j] = (short)f2bf(st[2 * kg][j]); pb[4 + j] = (short)f2bf(st[2 * kg + 1][j]); }
#pragma unroll
                    for (int mb = 0; mb < 8; ++mb) { const LAS bf16* vp = Vt + (16 * mb + l15) * AT_VS + 32 * kg + 4 * q4;
                        const bf16x4 v0 = *(const LAS bf16x4*)vp, v1 = *(const LAS bf16x4*)(vp + 16);
                        bf16x8 vf; vf[0] = v0[0]; vf[1] = v0[1]; vf[2] = v0[2]; vf[3] = v0[3]; vf[4] = v1[0]; vf[5] = v1[1]; vf[6] = v1[2]; vf[7] = v1[3];
                        o[mb] = MFMA_BF16(vf, pb, o[mb]); }
                }
            }
        }
        lrow += __shfl_xor(lrow, 16); lrow += __shfl_xor(lrow, 32);
        const float inv = 1.0f / lrow;
#pragma unroll
        for (int mb = 0; mb < 8; ++mb) st_bf16x4(Y + tq * 512 + h * 128 + 16 * mb + 4 * q4, o[mb] * inv);
    }
    __syncthreads();
}

__device__ __forceinline__ f32x4 tile_bf(const LAS bf16* a, int lda, const LAS bf16* bt, int ldb, int K, f32x4 acc, int l15, int q4) {
    const LAS bf16* ap = a + l15 * lda + 8 * q4; const LAS bf16* bp = bt + l15 * ldb + 8 * q4;
#pragma unroll 4
    for (int ks = 0; ks < K / 32; ++ks) acc = MFMA_BF16(*(const LAS bf16x8*)(ap + 32 * ks), *(const LAS bf16x8*)(bp + 32 * ks), acc);
    return acc;
}
__device__ __forceinline__ f32x4 tile_mm(const LAS float* a, int lda, int ska, const LAS float* b, int ldb, int scb, int K, f32x4 acc, int l15, int q4);

__device__ __forceinline__ void phase_rwkv_prep(const Frame& F, const Args& A, int layer) {
    const bf16* P = WSP(bf16, A_P); bf16* RKV = WSP(bf16, R_RKV); bf16* LIN = WSP(bf16, R_LIN); const float* mu = A.in[8] + (size_t)layer * 1824;
    const int lane = F.lane;
    for (int m = F.gw; m < TH; m += F.NGW) {
        const bool first = (m % SEQ) == 0; const bf16* pr = P + (size_t)m * PW + C_RWKV;
#pragma unroll
        for (int j = 0; j < 8; ++j) { const int c = 4 * lane + 256 * j;
            if (c < 1824) { const f32x4 p = ld_bf16x4(pr + c); const f32x4 pv = first ? (f32x4){0.f, 0.f, 0.f, 0.f} : ld_bf16x4(pr - PW + c); const f32x4 muv = *(const f32x4*)(mu + c);
                f32x4 x = p + (pv - p) * muv;
                if (c < 1536) st_bf16x4(RKV + (size_t)m * 1536 + c, x);
                else { if (c < 1600) { x.x = tanhf(x.x); x.y = tanhf(x.y); x.z = tanhf(x.z); x.w = tanhf(x.w); }
                       else if (c >= 1664) { x.x = sigmoidf_(x.x); x.y = sigmoidf_(x.y); x.z = sigmoidf_(x.z); x.w = sigmoidf_(x.w); }
                       st_bf16x4(LIN + (size_t)m * 384 + (c - 1536), x); } } }
        if (lane < 24) st_bf16x4(LIN + (size_t)m * 384 + 288 + 4 * lane, (f32x4){0.f, 0.f, 0.f, 0.f});
    }
}
__device__ __forceinline__ void phase_rwkv_lora(const Frame& F, const Args& A) {
    pg8::Gemm g{WSP(bf16, R_LIN), WSP(bf16, W_LORA), 384, 384}; pg8::StaticOrder S; S.init(TH, 1536, F.G, F.bid);
    EpiF32 E{WSP(float, R_LOUT), 1536}; pg8::gemm_phase(F.lds, g, S, E, F.tid);
}
constexpr int RS = 72;
constexpr int RREC_COMMON = 4 * 64 * RS * 2 + 256;
constexpr int RREC_SLICE = 3 * 64 * 36 * 4;
constexpr int RREC_BYTES = RREC_COMMON + 2 * RREC_SLICE;
static_assert(RREC_BYTES == 92416, "record size (see R_REC in the workspace map)");
static_assert(RREC_COMMON % 16 == 0 && RREC_SLICE % 16 == 0, "record alignment");
__device__ __forceinline__ void phase_rwkv_r1(const Frame& F, const Args& A, int layer) {
    const bf16* RKV = WSP(bf16, R_RKV); const float* LOUT = WSP(float, R_LOUT); unsigned char* REC = WSP(unsigned char, R_REC);
    const float* w0 = A.in[9] + layer * 512; const float* a0 = A.in[11] + layer * 512; const float* k_k = A.in[14] + layer * 512; const float* k_a = A.in[15] + layer * 512;
    LAS bf16* kbar = (LAS bf16*)F.lds; LAS bf16* atil = kbar + 64 * RS; LAS bf16* khat = atil + 64 * RS; LAS bf16* rbar = khat + 64 * RS;
    LAS bf16* atT = rbar + 64 * RS; LAS bf16* khT = atT + 64 * RS; LAS bf16* vT = khT + 64 * RS; LAS bf16* Bm = vT + 64 * RS; LAS bf16* Em = Bm + 64 * RS;
    LAS float* Am = (LAS float*)(Em + 64 * RS);
    LAS float* X = Am + 64 * 68;
    LAS float* lam = Am;
    const int tid = F.tid, lane = F.lane, w = F.wave, l15 = lane & 15, q4 = lane >> 4;
    const int nunits = BH * 8 * NCH;
    for (int unit = F.bid; unit < nunits; unit += F.G) {
        const int c = unit % NCH, h = (unit / NCH) & 7, b = unit / (NCH * 8);
        const size_t tok0 = (size_t)b * SEQ + (size_t)c * 64;
        const int j = lane, cj = h * 64 + j;
        __syncthreads();
        float r_[8], km_[8], kk_[8], ka_[8], v_[8];
        { const float w0c = w0[cj], a0c = a0[cj], kkc = k_k[cj], kac = k_a[cj];
#pragma unroll
          for (int q = 0; q < 8; ++q) { const int t = w + 8 * q; const size_t tok = tok0 + t;
              const float r = bf2f(RKV[tok * 1536 + cj]), k = bf2f(RKV[tok * 1536 + 512 + cj]); v_[q] = bf2f(RKV[tok * 1536 + 1024 + cj]);
              const float wpre = LOUT[tok * 1536 + cj], apre = LOUT[tok * 1536 + 512 + cj];
              const float wl = -softplusf_(-(w0c + wpre)) - 0.5f, a = sigmoidf_(a0c + apre);
              const float kr = k * kkc, ss = wave_sum(kr * kr), kk = kr / sqrtf(ss + EPS);
              r_[q] = r; km_[q] = k * (1.0f + (a - 1.0f) * kac); kk_[q] = kk; ka_[q] = kk * a;
              lam[t * 64 + j] = -expf(wl); } }
        __syncthreads();
        if (w == 0) { float s = 0.f; for (int t = 0; t < 64; ++t) { s += lam[t * 64 + j]; lam[t * 64 + j] = s; } }
        __syncthreads();
        { const float Lend = lam[63 * 64 + j];
#pragma unroll
          for (int q = 0; q < 8; ++q) { const int t = w + 8 * q; const float L = lam[t * 64 + j], Lm1 = t ? lam[(t - 1) * 64 + j] : 0.f;
              const float eG = expf(L), eGi = expf(-L), eGm1 = expf(Lm1), eT = expf(Lend - L);
              const float kb = kk_[q] * eGm1;
              kbar[t * RS + j] = (bf16)f2bf(kb); X[t * 132 + j] = kb;
              atil[t * RS + j] = (bf16)f2bf(ka_[q] * eGi); khat[t * RS + j] = (bf16)f2bf(km_[q] * eGi); rbar[t * RS + j] = (bf16)f2bf(r_[q] * eG);
              atT[j * RS + t] = (bf16)f2bf(-ka_[q] * eT); khT[j * RS + t] = (bf16)f2bf(km_[q] * eT); vT[j * RS + t] = (bf16)f2bf(v_[q]); }
          if (w == 0) { float* gc = (float*)(REC + (size_t)unit * RREC_BYTES + 4 * 64 * RS * 2); gc[j] = expf(Lend); } }
        __syncthreads();
        unsigned char* rec = REC + (size_t)unit * RREC_BYTES;
        for (int tt = 0; tt < 8; ++tt) { const int tile = w * 8 + tt, which = tile >> 4, ti = (tile >> 2) & 3, tj = tile & 3;
            f32x4 acc = (f32x4){0.f, 0.f, 0.f, 0.f};
            if (tj <= ti) acc = tile_bf(((which & 2) ? rbar : kbar) + 16 * ti * RS, RS, ((which & 1) ? khat : atil) + 16 * tj * RS, RS, 64, acc, l15, q4);
#pragma unroll
            for (int r = 0; r < 4; ++r) { const int i = 16 * ti + 4 * q4 + r, jj = 16 * tj + l15; const bool keep = (which & 2) ? (jj <= i) : (jj < i); const float v = keep ? acc[r] : 0.f;
                if (which == 0) Am[i * 68 + jj] = v; else if (which == 1) Bm[i * RS + jj] = (bf16)f2bf(v); else if (which == 3) Em[i * RS + jj] = (bf16)f2bf(v);
                else ((bf16*)(rec + 2 * 64 * RS * 2))[i * RS + jj] = (bf16)f2bf(-v); } }
        __syncthreads();
        for (int tt = 0; tt < 6; ++tt) { const int tile = w * 6 + tt, which = tile >> 4, ti = (tile >> 2) & 3, tj = tile & 3;
            const LAS bf16* aop = which == 0 ? Bm : which == 1 ? Em : khT;
            const f32x4 acc = tile_bf(aop + 16 * ti * RS, RS, vT + 16 * tj * RS, RS, 64, (f32x4){0.f, 0.f, 0.f, 0.f}, l15, q4);
#pragma unroll
            for (int r = 0; r < 4; ++r) { const int i = 16 * ti + 4 * q4 + r, vv = 16 * tj + l15;
                if (which == 0) X[i * 132 + 64 + vv] = acc[r];
                else { float* dst = (float*)(rec + RREC_COMMON + (vv >> 5) * RREC_SLICE + (which == 1 ? 1 : 2) * 64 * 36 * 4); dst[i * 36 + (vv & 31)] = acc[r]; } } }
        __syncthreads();
        for (int rb = 0; rb < 4; ++rb) {
            if (rb > 0) {
                const f32x4 acc = tile_mm(Am + 16 * rb * 68, 68, 1, X + 16 * w, 132, 1, 16 * rb, (f32x4){0.f, 0.f, 0.f, 0.f}, l15, q4);
#pragma unroll
                for (int r = 0; r < 4; ++r) X[(16 * rb + 4 * q4 + r) * 132 + 16 * w + l15] -= acc[r];
                __syncthreads();
            }
            if (tid < 128) { float x[16];
#pragma unroll
                for (int i = 0; i < 16; ++i) { float sacc = X[(16 * rb + i) * 132 + tid];
#pragma unroll
                    for (int jj = 0; jj < i; ++jj) sacc -= Am[(16 * rb + i) * 68 + 16 * rb + jj] * x[jj];
                    x[i] = sacc; }
#pragma unroll
                for (int i = 0; i < 16; ++i) X[(16 * rb + i) * 132 + tid] = x[i]; }
            __syncthreads();
        }
        for (int e = tid; e < 64 * 64; e += 512) { const int t = e >> 6, jj = e & 63; ((bf16*)rec)[t * RS + jj] = (bf16)f2bf(X[t * 132 + jj]);
            float* ub = (float*)(rec + RREC_COMMON + (jj >> 5) * RREC_SLICE); ub[t * 36 + (jj & 31)] = X[t * 132 + 64 + jj]; }
        for (int e = tid; e < 64 * RS / 8; e += 512) { ((u32x4*)(rec + 64 * RS * 2))[e] = ((const LAS u32x4*)rbar)[e]; ((u32x4*)(rec + 3 * 64 * RS * 2))[e] = ((const LAS u32x4*)atT)[e]; }
    }
    __syncthreads();
}
constexpr int R2_BUF = RREC_COMMON + RREC_SLICE;
__device__ __forceinline__ void phase_rwkv_r2(const Frame& F, const Args& A) {
    const unsigned char* REC = WSP(unsigned char, R_REC); float* RO = WSP(float, R_O);
    LAS unsigned char* buf0 = F.lds; LAS bf16* HT = (LAS bf16*)(F.lds + 2 * R2_BUF); LAS bf16* UT = HT + 2 * 32 * RS;
    const int tid = F.tid, lane = F.lane, w = F.wave, l15 = lane & 15, q4 = lane >> 4, ti = w >> 1, tj = w & 1;
    const int nunits = BH * 8 * 2;
    constexpr int NCHK = R2_BUF / 16;
    for (int unit = F.bid; unit < nunits; unit += F.G) {
        const int vs = unit & 1, h = (unit >> 1) & 7, b = unit >> 4;
        __syncthreads();
        for (int e = tid; e < 2 * 32 * RS / 2; e += 512) ((LAS unsigned*)HT)[e] = 0u;
        f32x4 Hreg = (f32x4){0.f, 0.f, 0.f, 0.f};
        u32x4 pre[8];
        { const unsigned char* rec = REC + (size_t)((b * 8 + h) * NCH) * RREC_BYTES;
#pragma unroll
          for (int q = 0; q < 8; ++q) { const int e = tid + 512 * q; if (e < NCHK) { const size_t off = (size_t)e * 16; pre[q] = *(const u32x4*)(rec + (off < RREC_COMMON ? off : off + (size_t)vs * RREC_SLICE)); } }
#pragma unroll
          for (int q = 0; q < 8; ++q) { const int e = tid + 512 * q; if (e < NCHK) *(LAS u32x4*)(buf0 + (size_t)e * 16) = pre[q]; } }
        __syncthreads();
        for (int c = 0; c < NCH; ++c) {
            LAS unsigned char* buf = buf0 + (c & 1) * R2_BUF; LAS unsigned char* nbuf = buf0 + ((c + 1) & 1) * R2_BUF;
            if (c + 1 < NCH) { const unsigned char* rec = REC + (size_t)((b * 8 + h) * NCH + c + 1) * RREC_BYTES;
#pragma unroll
                for (int q = 0; q < 8; ++q) { const int e = tid + 512 * q; if (e < NCHK) { const size_t off = (size_t)e * 16; pre[q] = *(const u32x4*)(rec + (off < RREC_COMMON ? off : off + (size_t)vs * RREC_SLICE)); } } }
            const LAS bf16* KB = (const LAS bf16*)buf; const LAS bf16* RB = KB + 64 * RS; const LAS bf16* FMn = RB + 64 * RS; const LAS bf16* ATn = FMn + 64 * RS;
            const LAS float* GC = (const LAS float*)(buf + 4 * 64 * RS * 2); const LAS float* UB = (const LAS float*)(buf + RREC_COMMON); const LAS float* OB = UB + 64 * 36; const LAS float* KV = OB + 64 * 36;
            const LAS bf16* H0 = HT + (c & 1) * 32 * RS; LAS bf16* H1 = HT + ((c + 1) & 1) * 32 * RS;
            f32x4 u;
#pragma unroll
            for (int r = 0; r < 4; ++r) u[r] = UB[(16 * ti + 4 * q4 + r) * 36 + 16 * tj + l15];
            u = tile_bf(KB + 16 * ti * RS, RS, H0 + 16 * tj * RS, RS, 64, u, l15, q4);
            { u32x2 pk; pk.x = pk2(u[0], u[1]); pk.y = pk2(u[2], u[3]); *(LAS u32x2*)(UT + (16 * tj + l15) * RS + 16 * ti + 4 * q4) = pk; }
            __syncthreads();
            f32x4 o;
#pragma unroll
            for (int r = 0; r < 4; ++r) o[r] = OB[(16 * ti + 4 * q4 + r) * 36 + 16 * tj + l15];
            o = tile_bf(RB + 16 * ti * RS, RS, H0 + 16 * tj * RS, RS, 64, o, l15, q4);
            o = tile_bf(FMn + 16 * ti * RS, RS, UT + 16 * tj * RS, RS, 64, o, l15, q4);
#pragma unroll
            for (int r = 0; r < 4; ++r) RO[((size_t)b * SEQ + (size_t)c * 64 + 16 * ti + 4 * q4 + r) * 512 + h * 64 + 32 * vs + 16 * tj + l15] = o[r];
#pragma unroll
            for (int r = 0; r < 4; ++r) Hreg[r] = Hreg[r] * GC[16 * ti + 4 * q4 + r] + KV[(16 * ti + 4 * q4 + r) * 36 + 16 * tj + l15];
            Hreg = tile_bf(ATn + 16 * ti * RS, RS, UT + 16 * tj * RS, RS, 64, Hreg, l15, q4);
            { u32x2 pk; pk.x = pk2(Hreg[0], Hreg[1]); pk.y = pk2(Hreg[2], Hreg[3]); *(LAS u32x2*)(H1 + (16 * tj + l15) * RS + 16 * ti + 4 * q4) = pk; }
            if (c + 1 < NCH) {
#pragma unroll
                for (int q = 0; q < 8; ++q) { const int e = tid + 512 * q; if (e < NCHK) *(LAS u32x4*)(nbuf + (size_t)e * 16) = pre[q]; } }
            __syncthreads();
        }
    }
    __syncthreads();
}
__device__ __forceinline__ void phase_rwkv_post(const Frame& F, const Args& A, int layer) {
    const bf16* RKV = WSP(bf16, R_RKV); const float* LOUT = WSP(float, R_LOUT); const float* RO = WSP(float, R_O); bf16* Y = WSP(bf16, A_Y) + (size_t)1 * TH * 512;
    const float* a0 = A.in[11] + layer * 512; const float* k_a = A.in[15] + layer * 512; const float* r_k = A.in[16] + layer * 512; const float* ln_w = A.in[17] + layer * 512; const float* ln_b = A.in[18] + layer * 512;
    const int lane = F.lane, c0 = 8 * lane;
    for (int m = F.gw; m < TH; m += F.NGW) {
        float o[8], r[8], k[8], v[8], ap[8], g[8];
        { const f32x4 a = *(const f32x4*)(RO + (size_t)m * 512 + c0), b2 = *(const f32x4*)(RO + (size_t)m * 512 + c0 + 4); o[0] = a.x; o[1] = a.y; o[2] = a.z; o[3] = a.w; o[4] = b2.x; o[5] = b2.y; o[6] = b2.z; o[7] = b2.w; }
#pragma unroll
        for (int hh = 0; hh < 2; ++hh) { const f32x4 rv = ld_bf16x4(RKV + (size_t)m * 1536 + c0 + 4 * hh), kv = ld_bf16x4(RKV + (size_t)m * 1536 + 512 + c0 + 4 * hh), vv = ld_bf16x4(RKV + (size_t)m * 1536 + 1024 + c0 + 4 * hh);
            const f32x4 av = *(const f32x4*)(LOUT + (size_t)m * 1536 + 512 + c0 + 4 * hh), gv = *(const f32x4*)(LOUT + (size_t)m * 1536 + 1024 + c0 + 4 * hh);
#pragma unroll
            for (int q = 0; q < 4; ++q) { r[4 * hh + q] = rv[q]; k[4 * hh + q] = kv[q]; v[4 * hh + q] = vv[q]; ap[4 * hh + q] = av[q]; g[4 * hh + q] = gv[q]; } }
        float bon = 0.f, sm = 0.f;
#pragma unroll
        for (int q = 0; q < 8; ++q) { const float a = sigmoidf_(a0[c0 + q] + ap[q]); const float km = k[q] * (1.0f + (a - 1.0f) * k_a[c0 + q]); bon += r[q] * km * r_k[c0 + q]; sm += o[q]; }
        bon += __shfl_xor(bon, 1); bon += __shfl_xor(bon, 2); bon += __shfl_xor(bon, 4);
        sm += __shfl_xor(sm, 1); sm += __shfl_xor(sm, 2); sm += __shfl_xor(sm, 4);
        const float mean = sm * (1.0f / 64.0f); float vs = 0.f;
#pragma unroll
        for (int q = 0; q < 8; ++q) { const float d = o[q] - mean; vs += d * d; }
        vs += __shfl_xor(vs, 1); vs += __shfl_xor(vs, 2); vs += __shfl_xor(vs, 4);
        const float rstd = 1.0f / sqrtf(vs * (1.0f / 64.0f) + 64e-5f);
        float y[8];
#pragma unroll
        for (int q = 0; q < 8; ++q) y[q] = ((o[q] - mean) * rstd * ln_w[c0 + q] + ln_b[c0 + q] + bon * v[q]) * g[q];
        u32x4 wv; wv.x = pk2(y[0], y[1]); wv.y = pk2(y[2], y[3]); wv.z = pk2(y[4], y[5]); wv.w = pk2(y[6], y[7]);
        *(u32x4*)(Y + (size_t)m * 512 + c0) = wv;
    }
}

__device__ __forceinline__ void conv8x8(const bf16* src, int tl0  , const float* w  , int wld, const float* bias, float (&out)[8][8]) {
    float x[11][8];
#pragma unroll
    for (int i = 0; i < 11; ++i) { const int tl = tl0 - 3 + i;
        if (tl >= 0) { const u32x4 v = *(const u32x4*)(src + (ptrdiff_t)(i - 3) * PW);
            x[i][0] = bf2f(v.x & 0xffffu); x[i][1] = bf2f(v.x >> 16); x[i][2] = bf2f(v.y & 0xffffu); x[i][3] = bf2f(v.y >> 16); x[i][4] = bf2f(v.z & 0xffffu); x[i][5] = bf2f(v.z >> 16); x[i][6] = bf2f(v.w & 0xffffu); x[i][7] = bf2f(v.w >> 16); }
        else {
#pragma unroll
            for (int ch = 0; ch < 8; ++ch) x[i][ch] = 0.f; } }
    float wv[4][8], bv[8];
#pragma unroll
    for (int j = 0; j < 4; ++j) { const f32x4 a = *(const f32x4*)(w + j * wld), b = *(const f32x4*)(w + j * wld + 4); wv[j][0] = a.x; wv[j][1] = a.y; wv[j][2] = a.z; wv[j][3] = a.w; wv[j][4] = b.x; wv[j][5] = b.y; wv[j][6] = b.z; wv[j][7] = b.w; }
    if (bias) { const f32x4 a = *(const f32x4*)bias, b = *(const f32x4*)(bias + 4); bv[0] = a.x; bv[1] = a.y; bv[2] = a.z; bv[3] = a.w; bv[4] = b.x; bv[5] = b.y; bv[6] = b.z; bv[7] = b.w; }
    else {
#pragma unroll
        for (int ch = 0; ch < 8; ++ch) bv[ch] = 0.f; }
#pragma unroll
    for (int i = 0; i < 8; ++i)
#pragma unroll
        for (int ch = 0; ch < 8; ++ch) { const float a = bv[ch] + wv[0][ch] * x[i][ch] + wv[1][ch] * x[i + 1][ch] + wv[2][ch] * x[i + 2][ch] + wv[3][ch] * x[i + 3][ch]; out[i][ch] = a * fast_rcp(1.0f + fast_exp(-a)); }
}
__device__ __forceinline__ u32x4 pack8(const float* v) { u32x4 o; o.x = pk2(v[0], v[1]); o.y = pk2(v[2], v[3]); o.z = pk2(v[4], v[5]); o.w = pk2(v[6], v[7]); return o; }
constexpr int SB = 136;
constexpr int SC_IMG = 64 * SB * 2;
__device__ __forceinline__ void phase_ssd_s1(const Frame& F, const Args& A, int layer) {
    const bf16* P = WSP(bf16, A_P); bf16* ST = WSP(bf16, S_ST); float* YD = WSP(float, S_YD); unsigned char* SCB = WSP(unsigned char, S_C); float* AC = WSP(float, S_AC);
    const float* cw = A.in[23] + (size_t)layer * 4 * 1024; const float* cb = A.in[24] + layer * 1024; const float* dtb = A.in[25] + layer * 8; const float* a_log = A.in[26] + layer * 8; const float* dsk = A.in[27] + layer * 8;
    LAS bf16* Bt_ = (LAS bf16*)F.lds; LAS bf16* Ct_ = Bt_ + 64 * SB; LAS bf16* BT = Ct_ + 64 * SB; LAS bf16* xT = BT + 128 * RS;
    LAS bf16* Mb = xT + 4 * 64 * RS; LAS bf16* xdT = Mb + 2 * 64 * RS; LAS float* dt = (LAS float*)(xdT + 2 * 64 * RS); LAS float* ac = dt + 256;
    const int tid = F.tid, lane = F.lane, w = F.wave, l15 = lane & 15, q4 = lane >> 4;
    const int nunits = BH * NCH * 2;
    for (int unit = F.bid; unit < nunits; unit += F.G) {
        const int g = unit & 1, c = (unit >> 1) % NCH, b = unit / (2 * NCH);
        const size_t tok0 = (size_t)b * SEQ + (size_t)c * 64;
        __syncthreads();
        {
            const int cg = tid & 63, rb = tid >> 6;
            const int cidx = cg < 32 ? g * 256 + 8 * cg : cg < 48 ? 512 + g * 128 + 8 * (cg - 32) : 768 + g * 128 + 8 * (cg - 48);
            float o[8][8];
            conv8x8(P + (tok0 + 8 * rb) * PW + C_SSD + 512 + cidx, c * 64 + 8 * rb, cw + cidx, 1024, cb + cidx, o);
            if (cg < 32) {
                const int hh = cg >> 3, p0 = 8 * (cg & 7);
#pragma unroll
                for (int ch = 0; ch < 8; ++ch) { float col[8];
#pragma unroll
                    for (int i = 0; i < 8; ++i) col[i] = o[i][ch];
                    *(LAS u32x4*)(xT + (hh * 64 + p0 + ch) * RS + 8 * rb) = pack8(col); }
            } else if (cg < 48) {
                const int n0 = 8 * (cg - 32);
#pragma unroll
                for (int i = 0; i < 8; ++i) *(LAS u32x4*)(Bt_ + (8 * rb + i) * SB + n0) = pack8(o[i]);
#pragma unroll
                for (int ch = 0; ch < 8; ++ch) { float col[8];
#pragma unroll
                    for (int i = 0; i < 8; ++i) col[i] = o[i][ch];
                    *(LAS u32x4*)(BT + (n0 + ch) * RS + 8 * rb) = pack8(col); }
            } else { const int n0 = 8 * (cg - 48);
#pragma unroll
                for (int i = 0; i < 8; ++i) *(LAS u32x4*)(Ct_ + (8 * rb + i) * SB + n0) = pack8(o[i]); }
        }
        if (tid < 256) { const int hh = tid >> 6, h = 4 * g + hh; const float d = softplusf_(bf2f(P[(tok0 + lane) * PW + C_SSD + 1536 + h]) + dtb[h]); float a = -expf(a_log[h]) * d;
#pragma unroll
            for (int o = 1; o < 64; o <<= 1) { const float t = __shfl_up(a, o); if (lane >= o) a += t; }
            dt[tid] = d; ac[tid] = a; AC[(tok0 + lane) * 8 + h] = a; }
        __syncthreads();
        { unsigned char* dst = SCB + (size_t)unit * SC_IMG; for (int e = tid; e < SC_IMG / 16; e += 512) ((u32x4*)dst)[e] = ((const LAS u32x4*)Ct_)[e]; }
        f32x4 cbt[2];
#pragma unroll
        for (int tt = 0; tt < 2; ++tt) { const int tile = w * 2 + tt, ti = tile >> 2, tj = tile & 3; cbt[tt] = (f32x4){0.f, 0.f, 0.f, 0.f};
            if (tj <= ti) cbt[tt] = tile_bf(Ct_ + 16 * ti * SB, SB, Bt_ + 16 * tj * SB, SB, 128, cbt[tt], l15, q4); }
        for (int hh = 0; hh < 4; ++hh) { const int h = 4 * g + hh; LAS bf16* M = Mb + (hh & 1) * 64 * RS; LAS bf16* xd = xdT + (hh & 1) * 64 * RS; const LAS float* dth = dt + hh * 64; const LAS float* ach = ac + hh * 64;
#pragma unroll
            for (int tt = 0; tt < 2; ++tt) { const int tile = w * 2 + tt, ti = tile >> 2, tj = tile & 3;
#pragma unroll
                for (int r = 0; r < 4; ++r) { const int l = 16 * ti + 4 * q4 + r, s = 16 * tj + l15; M[l * RS + s] = (bf16)f2bf((s <= l) ? cbt[tt][r] * expf(ach[l] - ach[s]) * dth[s] : 0.f); } }
            { const int p = tid >> 3, l0 = 8 * (tid & 7); const u32x4 v = *(const LAS u32x4*)(xT + (hh * 64 + p) * RS + l0); const float a63 = ach[63]; float xv[8] = {bf2f(v.x & 0xffffu), bf2f(v.x >> 16), bf2f(v.y & 0xffffu), bf2f(v.y >> 16), bf2f(v.z & 0xffffu), bf2f(v.z >> 16), bf2f(v.w & 0xffffu), bf2f(v.w >> 16)};
#pragma unroll
              for (int i = 0; i < 8; ++i) xv[i] *= dth[l0 + i] * expf(a63 - ach[l0 + i]);
              *(LAS u32x4*)(xd + p * RS + l0) = pack8(xv); }
            __syncthreads();
#pragma unroll
            for (int tt = 0; tt < 2; ++tt) { const int tile = w * 2 + tt, ti = tile >> 2, tj = tile & 3;
                const f32x4 acc = tile_bf(M + 16 * ti * RS, RS, xT + (hh * 64 + 16 * tj) * RS, RS, 64, (f32x4){0.f, 0.f, 0.f, 0.f}, l15, q4);
                const f32x4 xs = ld_bf16x4((const bf16*)(xT + (hh * 64 + 16 * tj + l15) * RS + 16 * ti + 4 * q4));
#pragma unroll
                for (int r = 0; r < 4; ++r) YD[(tok0 + 16 * ti + 4 * q4 + r) * 512 + h * 64 + 16 * tj + l15] = acc[r] + dsk[h] * xs[r]; }
            bf16* st = ST + ((size_t)((b * NCH + c) * 8 + h)) * 64 * 128;
#pragma unroll
            for (int tt = 0; tt < 4; ++tt) { const int tile = w * 4 + tt, ti = tile >> 2, tj = tile & 3;
                const f32x4 acc = tile_bf(BT + 16 * ti * RS, RS, xd + 16 * tj * RS, RS, 64, (f32x4){0.f, 0.f, 0.f, 0.f}, l15, q4);
                st_bf16x4(st + (16 * tj + l15) * 128 + 16 * ti + 4 * q4, acc); }
        }
    }
    __syncthreads();
}
__device__ __forceinline__ void phase_ssd_s23(const Frame& F, const Args& A) {
    const bf16* ST = WSP(bf16, S_ST); float* YD = WSP(float, S_YD); const unsigned char* SCB = WSP(unsigned char, S_C); const float* AC = WSP(float, S_AC);
    LAS bf16* Cimg = (LAS bf16*)F.lds; LAS bf16* Hb = Cimg + 2 * 64 * SB;
    const int tid = F.tid, lane = F.lane, w = F.wave, l15 = lane & 15, q4 = lane >> 4;
    const int nunits = BH * 8 * 4, hp = tid >> 5, hn = 4 * (tid & 31);
    constexpr int NCK = SC_IMG / 16;
    for (int unit = F.bid; unit < nunits; unit += F.G) {
        const int ps = unit & 3, h = (unit >> 2) & 7, b = unit >> 5, g = h >> 2;
        __syncthreads();
        f32x4 Hr = (f32x4){0.f, 0.f, 0.f, 0.f};
        u32x4 pre[3]; u32x2 pst;
        { const unsigned char* src = SCB + (size_t)((b * NCH + 0) * 2 + g) * SC_IMG;
#pragma unroll
          for (int q = 0; q < 3; ++q) { const int e = tid + 512 * q; if (e < NCK) ((LAS u32x4*)Cimg)[e] = *(const u32x4*)(src + (size_t)e * 16); } }
        pst = *(const u32x2*)(ST + ((size_t)((b * NCH + 0) * 8 + h)) * 8192 + (16 * ps + hp) * 128 + hn);
        for (int c = 0; c < NCH; ++c) {
            const size_t tok0 = (size_t)b * SEQ + (size_t)c * 64;
            const u32x2 stc = pst;
            if (c + 1 < NCH) { const unsigned char* src = SCB + (size_t)((b * NCH + c + 1) * 2 + g) * SC_IMG;
#pragma unroll
                for (int q = 0; q < 3; ++q) { const int e = tid + 512 * q; if (e < NCK) pre[q] = *(const u32x4*)(src + (size_t)e * 16); }
                pst = *(const u32x2*)(ST + ((size_t)((b * NCH + c + 1) * 8 + h)) * 8192 + (16 * ps + hp) * 128 + hn); }
            st_bf16x4((bf16*)(Hb + hp * SB + hn), Hr);
            __syncthreads();
            if (w < 4) { const LAS bf16* Ci = Cimg + (c & 1) * 64 * SB;
                const f32x4 acc = tile_bf(Ci + 16 * w * SB, SB, Hb, SB, 128, (f32x4){0.f, 0.f, 0.f, 0.f}, l15, q4);
#pragma unroll
                for (int r = 0; r < 4; ++r) { const size_t tok = tok0 + 16 * w + 4 * q4 + r; const size_t o = tok * 512 + h * 64 + 16 * ps + l15; YD[o] += acc[r] * expf(AC[tok * 8 + h]); } }
            { const float dec = expf(AC[(tok0 + 63) * 8 + h]); Hr.x = dec * Hr.x + bf2f(stc.x & 0xffffu); Hr.y = dec * Hr.y + bf2f(stc.x >> 16); Hr.z = dec * Hr.z + bf2f(stc.y & 0xffffu); Hr.w = dec * Hr.w + bf2f(stc.y >> 16); }
            if (c + 1 < NCH) { LAS u32x4* dst = (LAS u32x4*)(Cimg + ((c + 1) & 1) * 64 * SB);
#pragma unroll
                for (int q = 0; q < 3; ++q) { const int e = tid + 512 * q; if (e < NCK) dst[e] = pre[q]; } }
            __syncthreads();
        }
    }
    __syncthreads();
}
__device__ __forceinline__ void phase_ssd_s4(const Frame& F, const Args& A, int layer) {
    const float* YD = WSP(float, S_YD); const bf16* P = WSP(bf16, A_P); bf16* Y = WSP(bf16, A_Y) + (size_t)3 * TH * 512; const float* nw = A.in[28] + layer * 512;
    const int lane = F.lane, c0 = 8 * lane;
    for (int m = F.gw; m < TH; m += F.NGW) {
        const f32x4 a = *(const f32x4*)(YD + (size_t)m * 512 + c0), b2 = *(const f32x4*)(YD + (size_t)m * 512 + c0 + 4);
        const f32x4 z0 = ld_bf16x4(P + (size_t)m * PW + C_SSD + c0), z1 = ld_bf16x4(P + (size_t)m * PW + C_SSD + c0 + 4);
        float y[8] = {a.x * siluf_(z0.x), a.y * siluf_(z0.y), a.z * siluf_(z0.z), a.w * siluf_(z0.w), b2.x * siluf_(z1.x), b2.y * siluf_(z1.y), b2.z * siluf_(z1.z), b2.w * siluf_(z1.w)};
        float ss = 0.f;
#pragma unroll
        for (int q = 0; q < 8; ++q) ss += y[q] * y[q];
        ss += __shfl_xor(ss, 1); ss += __shfl_xor(ss, 2); ss += __shfl_xor(ss, 4); ss += __shfl_xor(ss, 8); ss += __shfl_xor(ss, 16);
        const float rstd = 1.0f / sqrtf(ss * (1.0f / 256.0f) + EPS);
#pragma unroll
        for (int q = 0; q < 8; ++q) y[q] = y[q] * rstd * nw[c0 + q];
        u32x4 wv; wv.x = pk2(y[0], y[1]); wv.y = pk2(y[2], y[3]); wv.z = pk2(y[4], y[5]); wv.w = pk2(y[6], y[7]);
        *(u32x4*)(Y + (size_t)m * 512 + c0) = wv;
    }
}

__device__ __forceinline__ f32x4 tile_mm(const LAS float* a, int lda, int ska, const LAS float* b, int ldb, int scb, int K, f32x4 acc, int l15, int q4) {
    const LAS float* ap = a + l15 * lda + q4 * ska; const LAS float* bp = b + q4 * ldb + l15 * scb;
#pragma unroll 8
    for (int ks = 0; ks < K / 4; ++ks) acc = MFMA_F32(ap[ks * 4 * ska], bp[ks * 4 * ldb], acc);
    return acc;
}
constexpr int GS = 132, GS2 = 68;
constexpr int GR_W = 0, GR_QH = 64 * 136 * 2, GR_KT = 2 * 64 * 136 * 2, GR_QK = GR_KT + 128 * 72 * 2, GR_GL = GR_QK + 64 * 72 * 2, GR_COMMON = GR_GL + 16, GR_USL = 64 * 20 * 4, GR_BYTES = GR_COMMON + 8 * GR_USL;
static_assert(GR_BYTES == 103440 && GR_COMMON % 16 == 0, "GDN record");
constexpr int GX = 264;
__device__ __forceinline__ void phase_gdn_g1(const Frame& F, const Args& A, int layer) {
    const bf16* P = WSP(bf16, A_P); unsigned char* CHR = WSP(unsigned char, G_CH);
    const float* convw = A.in[19] + (size_t)layer * 4 * 1536; const float* a_log = A.in[20] + layer * 4; const float* dtb = A.in[21] + layer * 4;
    LAS bf16* qb = (LAS bf16*)F.lds; LAS bf16* kb = qb + 64 * SB; LAS bf16* qkimg = kb + 64 * SB;
    LAS float* X = (LAS float*)(qkimg + 64 * RS); LAS float* Lm = X + 64 * GX; LAS float* ssq = Lm + 64 * GS2;
    LAS float* beta = ssq + 2 * 64 * 16; LAS float* gc = beta + 64; LAS float* egc = gc + 64; LAS float* inorm = egc + 64;
    const int tid = F.tid, lane = F.lane, w = F.wave, l15 = lane & 15, q4 = lane >> 4;
    const int nunits = BH * 4 * NCH;
    for (int unit = F.bid; unit < nunits; unit += F.G) {
        const int c = unit % NCH, h = (unit / NCH) & 3, b = unit / (NCH * 4);
        const size_t tok0 = (size_t)b * SEQ + (size_t)c * 64;
        unsigned char* rec = CHR + (size_t)unit * GR_BYTES;
        __syncthreads();
        const int rb = tid / 48, pc = tid % 48, part = pc >> 4, cgl = pc & 15;
        float o[8][8];
        if (tid < 384) { const int col = part * 512 + h * 128 + 8 * cgl;
            conv8x8(P + (tok0 + 8 * rb) * PW + C_GDN + col, c * 64 + 8 * rb, convw + col, 1536, nullptr, o);
            if (part < 2) {
#pragma unroll
                for (int i = 0; i < 8; ++i) { float sacc = 0.f;
#pragma unroll
                    for (int ch = 0; ch < 8; ++ch) sacc += o[i][ch] * o[i][ch];
                    ssq[(part * 64 + 8 * rb + i) * 16 + cgl] = sacc; } } }
        if (w == 7) { const size_t tok = tok0 + lane; beta[lane] = sigmoidf_(bf2f(P[tok * PW + C_GDN + 1536 + h]));
            float g = -expf(a_log[h]) * softplusf_(bf2f(P[tok * PW + C_GDN + 1540 + h]) + dtb[h]);
#pragma unroll
            for (int o2 = 1; o2 < 64; o2 <<= 1) { const float t = __shfl_up(g, o2); if (lane >= o2) g += t; }
            gc[lane] = g; egc[lane] = expf(g); }
        __syncthreads();
        if (tid < 128) { float sacc = 0.f;
#pragma unroll
            for (int i = 0; i < 16; ++i) sacc += ssq[tid * 16 + i];
            inorm[tid] = (tid < 64 ? 0.08838834764831845f : 1.0f) / sqrtf(sacc + EPS); }
        __syncthreads();
        if (tid < 384) {
#pragma unroll
            for (int i = 0; i < 8; ++i) { const int l = 8 * rb + i;
                if (part < 2) { const float sc = inorm[part * 64 + l]; float v[8];
#pragma unroll
                    for (int ch = 0; ch < 8; ++ch) v[ch] = o[i][ch] * sc;
                    *(LAS u32x4*)((part ? kb : qb) + l * SB + 8 * cgl) = pack8(v); }
                else { const float bl = beta[l]; *(LAS f32x4*)(X + l * GX + 8 * cgl) = (f32x4){o[i][0] * bl, o[i][1] * bl, o[i][2] * bl, o[i][3] * bl}; *(LAS f32x4*)(X + l * GX + 8 * cgl + 4) = (f32x4){o[i][4] * bl, o[i][5] * bl, o[i][6] * bl, o[i][7] * bl}; } } }
        __syncthreads();
        for (int tt = 0; tt < 4; ++tt) { const int tile = w * 4 + tt, which = tile >> 4, ti = (tile >> 2) & 3, tj = tile & 3;
            f32x4 acc = (f32x4){0.f, 0.f, 0.f, 0.f};
            if (tj <= ti) acc = tile_bf((which ? qb : kb) + 16 * ti * SB, SB, kb + 16 * tj * SB, SB, 128, acc, l15, q4);
#pragma unroll
            for (int r = 0; r < 4; ++r) { const int i = 16 * ti + 4 * q4 + r, j = 16 * tj + l15; float v = 0.f;
                if (which ? (j <= i) : (j < i)) v = acc[r] * expf(gc[i] - gc[j]) * (which ? 1.0f : beta[i]);
                if (which) qkimg[i * RS + j] = (bf16)f2bf(v); else Lm[i * GS2 + j] = v; } }
        { const float glast = gc[63];
          for (int e = tid; e < 64 * 16; e += 512) { const int l = e >> 4, d0 = 8 * (e & 15); const u32x4 kv = *(const LAS u32x4*)(kb + l * SB + d0), qv = *(const LAS u32x4*)(qb + l * SB + d0);
              const float kf[8] = {bf2f(kv.x & 0xffffu), bf2f(kv.x >> 16), bf2f(kv.y & 0xffffu), bf2f(kv.y >> 16), bf2f(kv.z & 0xffffu), bf2f(kv.z >> 16), bf2f(kv.w & 0xffffu), bf2f(kv.w >> 16)};
              float qf[8] = {bf2f(qv.x & 0xffffu), bf2f(qv.x >> 16), bf2f(qv.y & 0xffffu), bf2f(qv.y >> 16), bf2f(qv.z & 0xffffu), bf2f(qv.z >> 16), bf2f(qv.w & 0xffffu), bf2f(qv.w >> 16)};
              const float sc = beta[l] * egc[l], eg = egc[l];
              *(LAS f32x4*)(X + l * GX + 128 + d0) = (f32x4){kf[0] * sc, kf[1] * sc, kf[2] * sc, kf[3] * sc}; *(LAS f32x4*)(X + l * GX + 132 + d0) = (f32x4){kf[4] * sc, kf[5] * sc, kf[6] * sc, kf[7] * sc};
#pragma unroll
              for (int q = 0; q < 8; ++q) qf[q] *= eg;
              *(u32x4*)(rec + GR_QH + (size_t)(l * SB + d0) * 2) = pack8(qf); }
          for (int e = tid; e < 128 * 8; e += 512) { const int d = e >> 3, l0 = 8 * (e & 7); float kt[8];
#pragma unroll
              for (int q = 0; q < 8; ++q) kt[q] = bf2f(kb[(l0 + q) * SB + d]) * expf(glast - gc[l0 + q]);
              *(u32x4*)(rec + GR_KT + (size_t)(d * RS + l0) * 2) = pack8(kt); }
          if (tid == 0) *(float*)(rec + GR_GL) = expf(glast); }
        __syncthreads();
        for (int e = tid; e < 64 * RS / 8; e += 512) ((u32x4*)(rec + GR_QK))[e] = ((const LAS u32x4*)qkimg)[e];
        for (int rbk = 0; rbk < 4; ++rbk) {
            if (rbk > 0) {
#pragma unroll
                for (int t2 = 0; t2 < 2; ++t2) { const int tj = 2 * w + t2;
                    const f32x4 acc = tile_mm(Lm + 16 * rbk * GS2, GS2, 1, X + 16 * tj, GX, 1, 16 * rbk, (f32x4){0.f, 0.f, 0.f, 0.f}, l15, q4);
#pragma unroll
                    for (int r = 0; r < 4; ++r) X[(16 * rbk + 4 * q4 + r) * GX + 16 * tj + l15] -= acc[r]; }
                __syncthreads();
            }
            if (tid < 256) { float x[16];
#pragma unroll
                for (int i = 0; i < 16; ++i) { float sacc = X[(16 * rbk + i) * GX + tid];
#pragma unroll
                    for (int j = 0; j < i; ++j) sacc -= Lm[(16 * rbk + i) * GS2 + 16 * rbk + j] * x[j];
                    x[i] = sacc; }
#pragma unroll
                for (int i = 0; i < 16; ++i) X[(16 * rbk + i) * GX + tid] = x[i]; }
            __syncthreads();
        }
        for (int e = tid; e < 64 * 16; e += 512) { const int l = e >> 4, d0 = 8 * (e & 15); const f32x4 a = *(const LAS f32x4*)(X + l * GX + 128 + d0), b2 = *(const LAS f32x4*)(X + l * GX + 132 + d0);
            const float v[8] = {a.x, a.y, a.z, a.w, b2.x, b2.y, b2.z, b2.w}; *(u32x4*)(rec + GR_W + (size_t)(l * SB + d0) * 2) = pack8(v); }
        for (int e = tid; e < 64 * 32; e += 512) { const int l = e >> 5, c4 = 4 * (e & 31); *(f32x4*)(rec + GR_COMMON + (size_t)(c4 >> 4) * GR_USL + (size_t)(l * 20 + (c4 & 15)) * 4) = *(const LAS f32x4*)(X + l * GX + c4); }
    }
    __syncthreads();
}
constexpr int G2_STAGE = GR_COMMON + GR_USL;
__device__ __forceinline__ void phase_gdn_g2(const Frame& F, const Args& A) {
    const unsigned char* CHR = WSP(unsigned char, G_CH); float* GO = WSP(float, G_O);
    LAS unsigned char* buf0 = F.lds; LAS bf16* STt = (LAS bf16*)(F.lds + 2 * G2_STAGE); LAS bf16* vnT = STt + 2 * 16 * SB;
    const int tid = F.tid, lane = F.lane, w = F.wave, l15 = lane & 15, q4 = lane >> 4;
    const int nunits = BH * 4 * 8;
    constexpr int NCK = G2_STAGE / 16;
    for (int unit = F.bid; unit < nunits; unit += F.G) {
        const int vs = unit & 7, h = (unit >> 3) & 3, b = unit >> 5;
        __syncthreads();
        for (int e = tid; e < 2 * 16 * SB / 2; e += 512) ((LAS unsigned*)STt)[e] = 0u;
        f32x4 Sreg = (f32x4){0.f, 0.f, 0.f, 0.f};
        u32x4 pre[9];
        { const unsigned char* rec = CHR + (size_t)((b * 4 + h) * NCH) * GR_BYTES;
#pragma unroll
          for (int q = 0; q < 9; ++q) { const int e = tid + 512 * q; if (e < NCK) { const size_t off = (size_t)e * 16; *(LAS u32x4*)(buf0 + off) = *(const u32x4*)(rec + (off < GR_COMMON ? off : off + (size_t)vs * GR_USL)); } } }
        __syncthreads();
        for (int c = 0; c < NCH; ++c) {
            LAS unsigned char* buf = buf0 + (c & 1) * G2_STAGE; LAS unsigned char* nbuf = buf0 + ((c + 1) & 1) * G2_STAGE;
            if (c + 1 < NCH) { const unsigned char* rec = CHR + (size_t)((b * 4 + h) * NCH + c + 1) * GR_BYTES;
#pragma unroll
                for (int q = 0; q < 9; ++q) { const int e = tid + 512 * q; if (e < NCK) { const size_t off = (size_t)e * 16; pre[q] = *(const u32x4*)(rec + (off < GR_COMMON ? off : off + (size_t)vs * GR_USL)); } } }
            const LAS bf16* Wi = (const LAS bf16*)(buf + GR_W); const LAS bf16* QH = (const LAS bf16*)(buf + GR_QH); const LAS bf16* KT = (const LAS bf16*)(buf + GR_KT); const LAS bf16* QK = (const LAS bf16*)(buf + GR_QK);
            const float egl = *(const LAS float*)(buf + GR_GL); const LAS float* U = (const LAS float*)(buf + GR_COMMON);
            const LAS bf16* S0 = STt + (c & 1) * 16 * SB; LAS bf16* S1 = STt + ((c + 1) & 1) * 16 * SB;
            if (w < 4) {
                const f32x4 acc = tile_bf(Wi + 16 * w * SB, SB, S0, SB, 128, (f32x4){0.f, 0.f, 0.f, 0.f}, l15, q4);
                f32x4 vn;
#pragma unroll
                for (int r = 0; r < 4; ++r) vn[r] = U[(16 * w + 4 * q4 + r) * 20 + l15] - acc[r];
                u32x2 pk; pk.x = pk2(vn[0], vn[1]); pk.y = pk2(vn[2], vn[3]); *(LAS u32x2*)(vnT + l15 * RS + 16 * w + 4 * q4) = pk; }
            __syncthreads();
            if (w < 4) {
                f32x4 acc = tile_bf(QH + 16 * w * SB, SB, S0, SB, 128, (f32x4){0.f, 0.f, 0.f, 0.f}, l15, q4);
                acc = tile_bf(QK + 16 * w * RS, RS, vnT, RS, 64, acc, l15, q4);
#pragma unroll
                for (int r = 0; r < 4; ++r) GO[((size_t)b * SEQ + (size_t)c * 64 + 16 * w + 4 * q4 + r) * 512 + h * 128 + 16 * vs + l15] = acc[r]; }
            Sreg = Sreg * egl;
            Sreg = tile_bf(KT + 16 * w * RS, RS, vnT, RS, 64, Sreg, l15, q4);
            { u32x2 pk; pk.x = pk2(Sreg[0], Sreg[1]); pk.y = pk2(Sreg[2], Sreg[3]); *(LAS u32x2*)(S1 + l15 * SB + 16 * w + 4 * q4) = pk; }
            if (c + 1 < NCH) {
#pragma unroll
                for (int q = 0; q < 9; ++q) { const int e = tid + 512 * q; if (e < NCK) *(LAS u32x4*)(nbuf + (size_t)e * 16) = pre[q]; } }
            __syncthreads();
        }
    }
    __syncthreads();
}
__device__ __forceinline__ void phase_gdn_g3(const Frame& F, const Args& A, int layer) {
    const float* GO = WSP(float, G_O); const bf16* P = WSP(bf16, A_P); bf16* Y = WSP(bf16, A_Y) + (size_t)2 * TH * 512; const float* nw = A.in[22] + layer * 128;
    const int lane = F.lane, c0 = 8 * lane;
    for (int m = F.gw; m < TH; m += F.NGW) {
        const f32x4 a = *(const f32x4*)(GO + (size_t)m * 512 + c0), b2 = *(const f32x4*)(GO + (size_t)m * 512 + c0 + 4);
        float o[8] = {a.x, a.y, a.z, a.w, b2.x, b2.y, b2.z, b2.w}; float ss = 0.f;
#pragma unroll
        for (int q = 0; q < 8; ++q) ss += o[q] * o[q];
        ss += __shfl_xor(ss, 1); ss += __shfl_xor(ss, 2); ss += __shfl_xor(ss, 4); ss += __shfl_xor(ss, 8);
        const float rstd = 1.0f / sqrtf(ss * (1.0f / 128.0f) + EPS);
        const f32x4 z0 = ld_bf16x4(P + (size_t)m * PW + C_GDN + 1544 + c0), z1 = ld_bf16x4(P + (size_t)m * PW + C_GDN + 1544 + c0 + 4);
        const float z[8] = {z0.x, z0.y, z0.z, z0.w, z1.x, z1.y, z1.z, z1.w}; float y[8];
#pragma unroll
        for (int q = 0; q < 8; ++q) y[q] = o[q] * rstd * nw[(c0 + q) & 127] * siluf_(z[q]);
        u32x4 wv; wv.x = pk2(y[0], y[1]); wv.y = pk2(y[2], y[3]); wv.z = pk2(y[4], y[5]); wv.w = pk2(y[6], y[7]);
        *(u32x4*)(Y + (size_t)m * 512 + c0) = wv;
    }
}

__device__ __forceinline__ void phase_merge_z(const Frame& F, const Args& A) {
    for (int i = 0; i < 4; ++i) {
        pg8::Gemm g{WSP(bf16, A_Y) + (size_t)i * TH * 512, WSP(bf16, W_BR) + (size_t)i * D * 512, 512, 512}; pg8::StaticOrder S; S.init(TH, D, F.G, F.bid);
        EpiBf16 E{WSP(bf16, A_Z) + i * D, 4096, nullptr, 0}; pg8::gemm_phase(F.lds, g, S, E, F.tid);
        __syncthreads();
    }
}
__device__ __forceinline__ void phase_merge_gate(const Frame& F, const Args& A, int layer) {
    pg8::Gemm g{WSP(bf16, A_H), WSP(bf16, W_GATE), D, D}; pg8::StaticOrder S; S.init(TH, 4096, F.G, F.bid);
    EpiMerge E{WSP(bf16, A_Z), A.in[29] + (size_t)layer * 4 * D, WSP(bf16, A_MG)}; pg8::gemm_phase(F.lds, g, S, E, F.tid);
}
__device__ __forceinline__ void phase_merge_out(const Frame& F, const Args& A, const float* xin, float* xout) {
    pg8::Gemm g{WSP(bf16, A_MG), WSP(bf16, W_OUT), D, D}; pg8::StaticOrder S; S.init(TH, D, F.G, F.bid);
    EpiResidual E{xin, xout}; pg8::gemm_phase(F.lds, g, S, E, F.tid);
}
__device__ __forceinline__ void phase_ffn_gu(const Frame& F, const Args& A) {
    pg8::Gemm g{WSP(bf16, A_H), WSP(bf16, W_FGU), D, D}; pg8::StaticOrder S; S.init(TH, 2 * FF_D, F.G, F.bid);
    EpiSwiGLU E{WSP(bf16, F_ACT), FF_D, 1 << 20}; pg8::gemm_phase(F.lds, g, S, E, F.tid);
}
__device__ __forceinline__ void phase_ffn_down(const Frame& F, const Args& A, float* x) {
    pg8::Gemm g{WSP(bf16, F_ACT), WSP(bf16, W_FDN), FF_D, FF_D}; pg8::StaticOrder S; S.init(TH, D, F.G, F.bid);
    EpiResidual E{x, x}; pg8::gemm_phase(F.lds, g, S, E, F.tid);
}
struct MoeLayout { int pstart[NEXP + 1]; };
__device__ __forceinline__ MoeLayout moe_layout(const unsigned* cnt) {
    MoeLayout L; int s = 0;
#pragma unroll
    for (int e = 0; e < NEXP; ++e) { L.pstart[e] = s; s += ((int)cnt[e] + 255) & ~255; }
    L.pstart[NEXP] = s; return L;
}
struct MoeOrder {
    int np, nN, G, c; MoeLayout L;
    __device__ bool next(int i, Unit& u) const {
        const long Lx = (long)i * G + c; if (Lx >= (long)np * nN) return false;
        const int pm = (int)(Lx / nN), pn = (int)(Lx % nN); int e = 0;
#pragma unroll
        for (int k = 1; k < NEXP; ++k) if (pm * 256 >= L.pstart[k]) e = k;
        u.pm = pm; u.pn = e * nN + pn; return true;
    }
    __device__ __forceinline__ void a_ready(const Unit&) const {}
    __device__ __forceinline__ void done(const Unit&) const {}
};
__device__ __forceinline__ void phase_moe_route(const Frame& F, const Args& A, int half) {
    const unsigned* cnt = F.ctl + CW_CNT + half * 16; unsigned* fill = F.ctl + CW_FILL + half * 16;
    const MoeLayout L = moe_layout(cnt);
    const bf16* H = WSP(bf16, A_H); bf16* GA = WSP(bf16, F_GA); const int* tope = WSP(int, F_TOPE); int* slot = WSP(int, F_SLOT);
    const int lane = F.lane;
    for (int m = F.gw; m < TH; m += F.NGW) {
        const u32x4 v0 = *(const u32x4*)(H + (size_t)m * D + 8 * lane), v1 = *(const u32x4*)(H + (size_t)m * D + 512 + 8 * lane);
#pragma unroll
        for (int k = 0; k < 2; ++k) { const int e = tope[2 * m + k]; int s = 0;
            int ps = 0;
#pragma unroll
            for (int q = 0; q < NEXP; ++q) ps = (e == q) ? L.pstart[q] : ps;
            if (lane == 0) s = ps + (int)ATOMIC_ADD_U32(fill + e, 1u);
            s = __shfl(s, 0);
            if (lane == 0) slot[2 * m + k] = s;
            *(u32x4*)(GA + (size_t)s * D + 8 * lane) = v0; *(u32x4*)(GA + (size_t)s * D + 512 + 8 * lane) = v1; }
    }
#pragma unroll
    for (int e = 0; e < NEXP; ++e) { const int r0 = L.pstart[e] + (int)cnt[e], r1 = L.pstart[e + 1];
        for (int r = r0 + F.gw; r < r1; r += F.NGW) { *(u32x4*)(GA + (size_t)r * D + 8 * lane) = (u32x4){0u, 0u, 0u, 0u}; *(u32x4*)(GA + (size_t)r * D + 512 + 8 * lane) = (u32x4){0u, 0u, 0u, 0u}; } }
}
__device__ __forceinline__ void phase_moe_gu(const Frame& F, const Args& A, int half) {
    MoeOrder S; S.L = moe_layout(F.ctl + CW_CNT + half * 16); S.np = S.L.pstart[NEXP] / 256; S.nN = 2 * FF_E / 256; S.G = F.G; S.c = F.bid;
    pg8::Gemm g{WSP(bf16, F_GA), WSP(bf16, W_FGU), D, D}; EpiSwiGLU E{WSP(bf16, F_ACT), FF_E, 2 * FF_E / 256}; pg8::gemm_phase(F.lds, g, S, E, F.tid);
}
struct EpiF32Mod {
    static constexpr bool PERM = false, AFTER_DRAIN = false;
    float* C;
    __device__ __forceinline__ void operator()(const f32x4 (&acc)[2][2][4][2], const Unit& u, int wr, int wc, int fr, int fq) const {
        const int row0 = u.pm * 256 + wr * 64 + fr, col0 = (u.pn & 3) * 256 + wc * 32 + 4 * fq;
#pragma unroll
        for (int ai = 0; ai < 2; ++ai)
#pragma unroll
            for (int m = 0; m < 4; ++m) { float* rowp = C + (size_t)(row0 + ai * HALFT + m * 16) * D + col0;
#pragma unroll
                for (int bj = 0; bj < 2; ++bj)
#pragma unroll
                    for (int n = 0; n < 2; ++n) *(f32x4*)(rowp + bj * HALFT + n * 16) = acc[ai][bj][m][n]; }
    }
};
__device__ __forceinline__ void phase_moe_down(const Frame& F, const Args& A, int half) {
    MoeOrder S; S.L = moe_layout(F.ctl + CW_CNT + half * 16); S.np = S.L.pstart[NEXP] / 256; S.nN = D / 256; S.G = F.G; S.c = F.bid;
    pg8::Gemm g{WSP(bf16, F_ACT), WSP(bf16, W_FDN), FF_E, FF_E}; EpiF32Mod E{WSP(float, F_YE)}; pg8::gemm_phase(F.lds, g, S, E, F.tid);
}
__device__ __forceinline__ void phase_moe_combine(const Frame& F, const Args& A, float* x) {
    const float* YE = WSP(float, F_YE); const int* slot = WSP(int, F_SLOT); const float* topw = WSP(float, F_TOPW); const int lane = F.lane;
    for (int m = F.gw; m < TH; m += F.NGW) { const int s0 = slot[2 * m], s1 = slot[2 * m + 1]; const float w0 = topw[2 * m], w1 = topw[2 * m + 1];
#pragma unroll
        for (int j = 0; j < 4; ++j) { const int c = 4 * lane + 256 * j; float* xp = x + (size_t)m * D + c;
            *(f32x4*)xp = *(const f32x4*)xp + *(const f32x4*)(YE + (size_t)s0 * D + c) * w0 + *(const f32x4*)(YE + (size_t)s1 * D + c) * w1; } }
}

#ifndef EMU
#define XB_TMO      128
#define XB_XCNT(j)  (256  + 64 * (j))
#define XB_XSUB(j)  (1280 + 64 * (j))
#define XB_XGEN(j)  (2304 + 64 * (j))
#define XB_TOP      3328
#define XB_TOPGEN   3392
#define XCD_BAR_WORDS 3456
#define XB_SPIN_CAP (1u << 22)
__device__ __forceinline__ unsigned xb_ld(unsigned* p)              { return __hip_atomic_load(p, __ATOMIC_RELAXED, __HIP_MEMORY_SCOPE_AGENT); }
__device__ __forceinline__ unsigned xb_add(unsigned* p, unsigned v) { return __hip_atomic_fetch_add(p, v, __ATOMIC_RELAXED, __HIP_MEMORY_SCOPE_AGENT); }
__device__ __forceinline__ unsigned xb_xcc_id() { return (unsigned)__builtin_amdgcn_s_getreg((3 << 11) | 20) & 0xFu; }
#define XB_SPIN(cond, bar) do { unsigned _sp = 0; while (cond) { __builtin_amdgcn_s_sleep(1); \
    if ((++_sp & 255u) == 0u) { if (xb_ld(&(bar)[XB_TMO])) break; if (_sp > XB_SPIN_CAP) { atomicAdd(&(bar)[XB_TMO], 1u); break; } } } } while (0)
struct XcdBarrier { unsigned* bar; unsigned x; volatile LAS unsigned* st; };
__device__ __forceinline__ XcdBarrier xcd_barrier_post(unsigned* bar, volatile LAS unsigned* st) {
    XcdBarrier b; b.bar = bar; b.x = xb_xcc_id(); b.st = st;
    if (threadIdx.x == 0) (void)xb_add(&bar[XB_XCNT(b.x)], 1u);
    return b;
}
__device__ __forceinline__ void xcd_barrier_complete(unsigned* bar, unsigned x, unsigned& nloc, unsigned& nx) {
    const unsigned G = gridDim.x * gridDim.y * gridDim.z;
    unsigned sum, cnt, mine, sp = 0u;
    for (;;) {
        sum = 0u; cnt = 0u; mine = 0u;
#pragma unroll
        for (unsigned j = 0; j < 16; ++j) { const unsigned c = xb_ld(&bar[XB_XCNT(j)]); sum += c; cnt += (c > 0u) ? 1u : 0u; mine = (j == x) ? c : mine; }
        if (sum == G) break;
        __builtin_amdgcn_s_sleep(1);
        if ((++sp & 255u) == 0u) { if (xb_ld(&bar[XB_TMO])) break; if (sp > XB_SPIN_CAP) { atomicAdd(&bar[XB_TMO], 1u); break; } }
    }
    nloc = mine > 0u ? mine : 1u; nx = cnt > 0u ? cnt : 1u;
}
__device__ __forceinline__ void xcd_barrier(const XcdBarrier& b) {
    asm volatile("s_waitcnt vmcnt(0)" ::: "memory");
    __syncthreads();
    if (threadIdx.x == 0) {
        unsigned* bar = b.bar;
        __builtin_amdgcn_s_waitcnt(0);
        unsigned nloc = b.st[0], nx = b.st[1];
        if (nloc == 0u) { xcd_barrier_complete(bar, b.x, nloc, nx); b.st[0] = nloc; b.st[1] = nx; }
        const unsigned old = xb_add(&bar[XB_XSUB(b.x)], 1u);
        const unsigned gen = old / nloc;
        if (old + 1u == (gen + 1u) * nloc) {
            __builtin_amdgcn_fence(__ATOMIC_RELEASE, "agent");
            asm volatile("s_waitcnt vmcnt(0)" ::: "memory");
            const unsigned og = xb_add(&bar[XB_TOP], 1u);
            const unsigned tg = og / nx;
            if (og + 1u == (tg + 1u) * nx) xb_add(&bar[XB_TOPGEN], 1u);
            else XB_SPIN(xb_ld(&bar[XB_TOPGEN]) == tg, bar);
            __builtin_amdgcn_fence(__ATOMIC_ACQUIRE, "agent");
            xb_add(&bar[XB_XGEN(b.x)], 1u);
            asm volatile("s_waitcnt vmcnt(0)" ::: "memory");
        } else {
            XB_SPIN(xb_ld(&bar[XB_XGEN(b.x)]) == gen, bar);
            __builtin_amdgcn_fence(__ATOMIC_ACQUIRE, "agent");
            asm volatile("s_waitcnt vmcnt(0)" ::: "memory");
        }
    }
    __syncthreads();
}
#endif

constexpr int NPH = 25;
constexpr int NPHASES = DEPTH * (1 + NHALF * NPH) + 1;
constexpr int LDS_BYTES = 155648, MISC_OFF = 154624;

__global__ void __launch_bounds__(512, 2) fwd_kernel(Args args_k) {
#ifdef EMU
    unsigned char* lds = emu_lds_ptr;
#else
    extern __shared__ __attribute__((aligned(16))) unsigned char lds[];
#endif
    Frame F0;
    F0.lds = (LAS unsigned char*)lds; F0.tid = threadIdx.x; F0.lane = F0.tid & 63; F0.wave = RFL(F0.tid >> 6); F0.G = gridDim.x; F0.bid = blockIdx.x;
    F0.gw = F0.bid * 8 + F0.wave; F0.NGW = F0.G * 8;
    F0.out = args_k.out; F0.ws = args_k.ws; F0.ctl = (unsigned*)(args_k.ws + WS_CTL);
    const int lo = args_k.lo, hi = args_k.hi;
#ifndef EMU
    volatile LAS unsigned* misc = (volatile LAS unsigned*)(F0.lds + MISC_OFF);
    if (F0.tid < 4) misc[F0.tid] = 0u;
    __syncthreads();
    XcdBarrier bar; bar.bar = F0.ctl + CW_BAR; bar.x = 0; bar.st = misc;
    if (hi - lo > 1) bar = xcd_barrier_post(F0.ctl + CW_BAR, misc);
#define GRID_BAR() do { XcdBarrier bq = bar; asm volatile("" : "+s"(bq.bar), "+s"(bq.x)); xcd_barrier(bq); } while (0)
#else
#define GRID_BAR() do { } while (0)
#endif
    int ph = 0;
#ifndef PH_MASK
#define PH_MASK 0xFFFFFFFFFFFFFFFFull
#endif
#define PHASE(...) PHASE_I(31, __VA_ARGS__)
#ifdef EMU
#define LAUNDER(Fq) do { } while (0)
#else
#define LAUNDER(Fq) do { unsigned mq_ = ~0u; asm volatile("" : "+s"(Fq.G), "+s"(Fq.bid), "+s"(Fq.wave), "+s"(Fq.ws), "+s"(Fq.out), "+s"(Fq.ctl), "+s"(mq_)); Fq.lane = (int)__builtin_amdgcn_mbcnt_hi(mq_, __builtin_amdgcn_mbcnt_lo(mq_, 0u)); Fq.tid = Fq.wave * 64 + Fq.lane; Fq.gw = Fq.bid * 8 + Fq.wave; Fq.NGW = Fq.G * 8; } while (0)
#endif
#ifdef EMU
#define ARGS_Q() const Args& args_q = args_k
#else
#define ARGS_Q() const __attribute__((address_space(4))) Args* aq_ = (const __attribute__((address_space(4))) Args*)__builtin_amdgcn_kernarg_segment_ptr(); asm volatile("" : "+s"(aq_)); const Args& args_q = *(const Args*)aq_
#endif
#ifndef REPEAT_MASK
#define REPEAT_MASK 0u
#endif
#define PHASE_I(kind, ...) do { if (ph >= lo && ph < hi) { constexpr int reps_ = (((REPEAT_MASK) >> (kind)) & 1u) ? 2 : 1; for (int rr_ = 0; rr_ < reps_; ++rr_) { { Frame Fq = F0; LAUNDER(Fq); const Frame& F = Fq; ARGS_Q(); const Args& args = args_q; __VA_ARGS__; } if (rr_ + 1 < reps_ || ph + 1 < hi) GRID_BAR(); } } ++ph; } while (0)
#define PHASEK(kind, ...) PHASE_I(kind, __VA_ARGS__)
#define SEGMENT(layer, half) do { \
            const size_t r0 = (size_t)(half) * TH; \
            const float* xin = ((layer) == 0 ? args_k.in[0] : F0.out) + r0 * D; float* xo = F0.out + r0 * D; \
            PHASEK(0, phase_norm<false>(F, args, xin, args.in[2] + (layer) * D, WSP(bf16, A_H), nullptr, nullptr, nullptr, nullptr); phase_rope_table(F, args, (const int*)args.in[1] + r0, WSP(float, A_ROPE))); \
            PHASEK(1, { pg8::Gemm g{WSP(bf16, A_H), WSP(bf16, W_IN), D, D}; pg8::StaticOrder S; S.init(TH, PW, F.G, F.bid); EpiBf16 E{WSP(bf16, A_P), PW, nullptr, 0}; pg8::gemm_phase(F.lds, g, S, E, F.tid); }); \
            PHASEK(2, phase_mla_prep(F, args)); \
            PHASEK(3, phase_mla_q(F, args)); \
            PHASEK(4, phase_mla_kv(F, args)); \
            PHASEK(5, phase_attention(F, args)); \
            PHASEK(6, phase_rwkv_prep(F, args, layer)); \
            PHASEK(7, phase_rwkv_lora(F, args)); \
            PHASEK(8, phase_rwkv_r1(F, args, layer)); \
            PHASEK(24, phase_rwkv_r2(F, args)); \
            PHASEK(9, phase_rwkv_post(F, args, layer)); \
            PHASEK(10, phase_gdn_g1(F, args, layer)); \
            PHASEK(11, phase_gdn_g2(F, args)); \
            PHASEK(12, phase_gdn_g3(F, args, layer)); \
            PHASEK(13, phase_ssd_s1(F, args, layer)); \
            PHASEK(14, phase_ssd_s23(F, args)); \
            PHASEK(16, phase_ssd_s4(F, args, layer)); \
            PHASEK(17, phase_merge_z(F, args)); \
            PHASEK(18, phase_merge_gate(F, args, layer)); \
            PHASEK(19, phase_merge_out(F, args, xin, xo)); \
            if ((layer) == 0) { \
                PHASEK(20, phase_norm<false>(F, args, xo, args.in[32] + (layer) * D, WSP(bf16, A_H), nullptr, nullptr, nullptr, nullptr)); \
                PHASEK(21, phase_ffn_gu(F, args)); \
                PHASE(phase_ffn_down(F, args, xo)); \
                PHASE((void)0); \
                PHASE((void)0); \
            } else { \
                PHASE(phase_norm<true>(F, args, xo, args.in[32] + (layer) * D, WSP(bf16, A_H), args.in[35], WSP(int, F_TOPE), WSP(float, F_TOPW), F.ctl + CW_CNT + (half) * 16)); \
                PHASE(phase_moe_route(F, args, half)); \
                PHASEK(22, phase_moe_gu(F, args, half)); \
                PHASEK(23, phase_moe_down(F, args, half)); \
                PHASE(phase_moe_combine(F, args, xo)); \
            } } while (0)
    static_assert(DEPTH == 2 && NHALF <= 2, "segment program");
    PHASE(phase_convert(F, args, 0));
    SEGMENT(0, 0);
    if (NHALF == 2) SEGMENT(0, 1);
    PHASE(phase_convert(F, args, 1));
    SEGMENT(1, 0);
    if (NHALF == 2) SEGMENT(1, 1);
#undef SEGMENT
    PHASE(phase_final_norm(F, args, F.out, args.in[38]));
#undef PHASE
}

#ifndef ONE_LAUNCH
#define ONE_LAUNCH 1
#endif
extern "C" void kernel_launch(void* const* d_in, const int* in_sizes, int n_in, void* d_out, int out_size, void* d_ws, size_t ws_size, hipStream_t stream) {
    static int grid = 0;
    if (grid == 0) {
#ifdef EMU
        grid = EMU_GRID;
#else
        if (n_in != 39 || out_size != T * D || ws_size < WS_NEED) { fprintf(stderr, "kernel_launch: unexpected problem (n_in %d out %d ws %zu need %zu)\n", n_in, out_size, ws_size, (size_t)WS_NEED); grid = -1; return; }
        int dev = 0, cus = 0;
        if (hipGetDevice(&dev) != hipSuccess || hipDeviceGetAttribute(&cus, hipDeviceAttributeMultiprocessorCount, dev) != hipSuccess) { grid = -1; return; }
        if (hipFuncSetAttribute((const void*)fwd_kernel, hipFuncAttributeMaxDynamicSharedMemorySize, LDS_BYTES) != hipSuccess) { fprintf(stderr, "kernel_launch: hipFuncSetAttribute failed\n"); grid = -1; return; }
        int per_cu = 0;
        if (hipOccupancyMaxActiveBlocksPerMultiprocessor(&per_cu, (const void*)fwd_kernel, 512, LDS_BYTES) != hipSuccess || per_cu < 1) fprintf(stderr, "kernel_launch: occupancy query reports %d\n", per_cu);
        (void)hipGetLastError();
        grid = cus;
#endif
    }
    if (grid < 0) return;
    (void)hipMemsetAsync((char*)d_ws + WS_CTL, 0, CTL_BYTES, stream);
    Args a{};
    for (int i = 0; i < 39; ++i) a.in[i] = (const float*)d_in[i];
    a.out = (float*)d_out; a.ws = (unsigned char*)d_ws;
#ifdef EMU
    for (int p = EMU_PH_LO; p < EMU_PH_HI && p < NPHASES; ++p) { a.lo = p; a.hi = p + 1; emu_launch(fwd_kernel, grid, 512, a); emu_after_phase(p); }
#else
#if ONE_LAUNCH
    a.lo = 0; a.hi = NPHASES;
    hipLaunchKernelGGL(fwd_kernel, dim3(grid), dim3(512), LDS_BYTES, stream, a);
#else
    for (int p = 0; p < NPHASES; ++p) { a.lo = p; a.hi = p + 1; hipLaunchKernelGGL(fwd_kernel, dim3(grid), dim3(512), LDS_BYTES, stream, a); }
#endif
#endif
}
```

```cpp
#ifndef EMU
#include <hip/hip_runtime.h>
#include <cstdio>
#include <cstdint>
#endif

#ifdef EMU
constexpr int BATCH = EMU_B, SEQ = EMU_S, NHALF = EMU_NHALF;
#else
constexpr int BATCH = 16, SEQ = 2048, NHALF = 2;
#endif
constexpr int D = 1024, DEPTH = 2, CH = 64;
constexpr int T = BATCH * SEQ, TH = T / NHALF, BH = BATCH / NHALF, NCH = SEQ / CH;
constexpr int C_MLA = 0, C_RWKV = 704, C_GDN = 2528, C_SSD = 4584, C_GATE = 6128, IN_COLS = 10224, PW = 6144;
constexpr int FF_D = 2816, FF_E = 3584, NEXP = 8;
constexpr int MOE_ROWS = ((TH * 2 + NEXP * 255) / 256) * 256;
constexpr float EPS = 1e-6f;
static_assert(TH % 256 == 0 && SEQ % 128 == 0 && BATCH % NHALF == 0, "shape");

typedef unsigned short bf16;
typedef float f32x4 __attribute__((ext_vector_type(4)));
typedef float f32x2 __attribute__((ext_vector_type(2)));
typedef short bf16x8 __attribute__((ext_vector_type(8)));
typedef short bf16x4 __attribute__((ext_vector_type(4)));
typedef unsigned u32x4 __attribute__((ext_vector_type(4)));
typedef unsigned u32x2 __attribute__((ext_vector_type(2)));
#ifdef EMU
#define LAS
#define GAS
#define MFMA_F32(a, b, c) emu_mfma_16x16x4f32(a, b, c)
#define MFMA_BF16(a, b, c) emu_mfma_16x16x32bf16(a, b, c)
#define ATOMIC_ADD_U32(p, v) emu_atomic_add_u32(p, v)
#define RFL(x) (x)
#define LDS_WAIT()
#define VM_WAIT()
__device__ __forceinline__ float fast_exp(float x) { return expf(x); }
__device__ __forceinline__ float fast_rcp(float x) { return 1.0f / x; }
__device__ __forceinline__ float fast_rsqrt(float x) { return 1.0f / sqrtf(x); }
#else
#define LAS __attribute__((address_space(3)))
#define GAS __attribute__((address_space(1)))
#define MFMA_F32(a, b, c) __builtin_amdgcn_mfma_f32_16x16x4f32(a, b, c, 0, 0, 0)
#define MFMA_BF16(a, b, c) __builtin_amdgcn_mfma_f32_16x16x32_bf16(a, b, c, 0, 0, 0)
#define ATOMIC_ADD_U32(p, v) __hip_atomic_fetch_add(p, v, __ATOMIC_RELAXED, __HIP_MEMORY_SCOPE_AGENT)
#define RFL(x) __builtin_amdgcn_readfirstlane(x)
#define LDS_WAIT() asm volatile("s_waitcnt lgkmcnt(0)" ::: "memory")
#define VM_WAIT() asm volatile("s_waitcnt vmcnt(0)" ::: "memory")
__device__ __forceinline__ float fast_exp(float x) { return __expf(x); }
__device__ __forceinline__ float fast_rcp(float x) { return __builtin_amdgcn_rcpf(x); }
__device__ __forceinline__ float fast_rsqrt(float x) { return __builtin_amdgcn_rsqf(x); }
#endif
__device__ __forceinline__ unsigned f2u(float f) { return __builtin_bit_cast(unsigned, f); }
__device__ __forceinline__ float u2f(unsigned u) { return __builtin_bit_cast(float, u); }
__device__ __forceinline__ unsigned f2bf(float f) { unsigned u = f2u(f); return (u + 0x7fffu + ((u >> 16) & 1u)) >> 16; }
__device__ __forceinline__ float bf2f(unsigned h) { return u2f(h << 16); }
__device__ __forceinline__ unsigned pk2(float lo, float hi) { return f2bf(lo) | (f2bf(hi) << 16); }
__device__ __forceinline__ float sigmoidf_(float x) { return 1.0f / (1.0f + expf(-x)); }
__device__ __forceinline__ float siluf_(float x) { return x / (1.0f + expf(-x)); }
__device__ __forceinline__ float softplusf_(float x) { return x > 20.f ? x : log1pf(expf(x)); }
__device__ __forceinline__ float wave_sum(float v) {
#pragma unroll
    for (int o = 1; o < 64; o <<= 1) v += __shfl_xor(v, o);
    return v;
}
__device__ __forceinline__ float wave_max(float v) {
#pragma unroll
    for (int o = 1; o < 64; o <<= 1) v = fmaxf(v, __shfl_xor(v, o));
    return v;
}
__device__ __forceinline__ f32x4 ld_bf16x4(const bf16* p) { const u32x2 w = *(const u32x2*)p; return (f32x4){bf2f(w.x & 0xffffu), bf2f(w.x >> 16), bf2f(w.y & 0xffffu), bf2f(w.y >> 16)}; }
__device__ __forceinline__ void st_bf16x4(bf16* p, f32x4 v) { u32x2 w; w.x = pk2(v.x, v.y); w.y = pk2(v.z, v.w); *(u32x2*)p = w; }

namespace pg8 {
#define PG8_LAS LAS
typedef unsigned short bf16_t;
constexpr int BM = 256, BK = 64, HALF = 128, HTB = HALF * BK * 2, STAGE_BYTES = 8 * HTB, NXCD = 8, WGM = 8;
__host__ __device__ __forceinline__ int lds_byte(int r, int c) { const int st = (r >> 4) * 2 + (c >> 5), rr = r & 15, cc = c & 31, ob = rr * 64 + cc * 2; return st * 1024 + (ob ^ (((ob >> 9) & 1) << 5)); }
__host__ __device__ __forceinline__ void stage_rc(int b, int& R, int& C) { const int st = b / 1024, sb = b % 1024, swz = sb ^ (((sb >> 9) & 1) << 5); R = (st >> 1) * 16 + swz / 64; C = (st & 1) * 32 + (swz % 64) / 2; }
__host__ __device__ __forceinline__ int perm32(int rho) { const int n = rho >> 4, i = rho & 15; return 8 * (i >> 2) + 4 * n + (i & 3); }
struct Unit { int pm, pn; };
struct Gemm { const bf16_t* A; const bf16_t* Bt; int lda, K; };
struct StaticOrder {
    int nM, nN, nwg, G, c;
    __host__ __device__ void init(int M, int N, int G_, int c_) { nM = M / BM; nN = N / BM; nwg = nM * nN; G = G_; c = c_; }
    __host__ __device__ bool next(int i, Unit& u) const {
        const long L = (long)i * G + c; if (L >= nwg) return false;
        int wgid = (int)L; { const int q = nwg / NXCD, r = nwg % NXCD, xcd = wgid % NXCD, off = wgid / NXCD; wgid = (xcd < r ? xcd * (q + 1) : r * (q + 1) + (xcd - r) * q) + off; }
        const int nig = WGM * nN, gid = wgid / nig, fm = gid * WGM, gsz = (nM - fm) < WGM ? (nM - fm) : WGM;
        u.pm = fm + ((wgid % nig) % gsz); u.pn = (wgid % nig) / gsz; return true;
    }
    __device__ __forceinline__ void a_ready(const Unit&) const {}
    __device__ __forceinline__ void done(const Unit&) const {}
};
#ifndef EMU
template <class Epi, class Sched>
__device__ __forceinline__ void gemm_phase(PG8_LAS unsigned char* lds, const Gemm g, const Sched& S, const Epi& E, const int tid) {
    const int wid = __builtin_amdgcn_readfirstlane(tid >> 6), lane = tid & 63, wr = wid >> 2, wc = wid & 3, fr = lane & 15, fq = lane >> 4;
    int Kq = g.K; asm volatile("" : "+s"(Kq));
    const int K = Kq, nt = K / BK, lda = g.lda;
    unsigned voffA[2], voffB[2];
#pragma unroll
    for (int i = 0; i < 2; ++i) { int R, C; stage_rc(tid * 16 + i * 8192, R, C); const int Rb = Epi::PERM ? ((R & ~31) + perm32(R & 31)) : R;
        voffA[i] = (unsigned)(R * lda + C) * 2u; voffB[i] = (unsigned)(Rb * K + C) * 2u; }
    const size_t kstep = (size_t)(BK * 2);
    const size_t hstep = (size_t)HALF * K * 2, hstepA = (size_t)HALF * lda * 2;
    const size_t tstep = 2 * hstep, tstepA = 2 * hstepA;
    const unsigned ldsw = (unsigned)wid * 1024u;
    const int aoff = lds_byte(wr * 64 + fr, fq * 8), boff = lds_byte(wc * 32 + fr, fq * 8);
#define PG8_SA(b, h) (((b) * 2 + (h)) * HTB)
#define PG8_SB(b, h) ((4 + (b) * 2 + (h)) * HTB)
#define PG8_STAGE(bufoff, gbase, voff) do { _Pragma("unroll") for (int _i = 0; _i < 2; ++_i) \
        __builtin_amdgcn_global_load_lds((const unsigned*)((const char*)(gbase) + (voff)[_i]), (PG8_LAS unsigned*)(lds + (bufoff) + ldsw + _i * 8192), 16, 0, 0); } while (0)
#define PG8_LDA(dst, b, h) do { _Pragma("unroll") for (int m = 0; m < 4; ++m) _Pragma("unroll") for (int k = 0; k < 2; ++k) dst[m][k] = *(const PG8_LAS bf16x8*)(lds + PG8_SA(b, h) + aoff + m * 2048 + k * 1024); } while (0)
#define PG8_LDB(dst, b, h) do { _Pragma("unroll") for (int n = 0; n < 2; ++n) _Pragma("unroll") for (int k = 0; k < 2; ++k) dst[n][k] = *(const PG8_LAS bf16x8*)(lds + PG8_SB(b, h) + boff + n * 2048 + k * 1024); } while (0)
#define PG8_MMA(ai, bj, At, Bt) do { __builtin_amdgcn_s_setprio(1); _Pragma("unroll") for (int m = 0; m < 4; ++m) _Pragma("unroll") for (int n = 0; n < 2; ++n) _Pragma("unroll") for (int k = 0; k < 2; ++k) \
        acc[ai][bj][m][n] = __builtin_amdgcn_mfma_f32_16x16x32_bf16(Bt[n][k], At[m][k], acc[ai][bj][m][n], 0, 0, 0); __builtin_amdgcn_s_setprio(0); } while (0)
#define PG8_WAIT_V(n) asm volatile("s_waitcnt vmcnt(" #n ")" ::: "memory")
#define PG8_WAIT_L(n) asm volatile("s_waitcnt lgkmcnt(" #n ")" ::: "memory")
#define PG8_BAR __builtin_amdgcn_s_barrier()
#define PG8_SCHED __builtin_amdgcn_sched_barrier(0)
    Unit cur, nxt; int ui = 0;
    if (!S.next(0, cur)) return;
    f32x4 acc[2][2][4][2];
#pragma unroll
    for (int a = 0; a < 2; ++a)
#pragma unroll
        for (int b = 0; b < 2; ++b)
#pragma unroll
            for (int m = 0; m < 4; ++m)
#pragma unroll
                for (int n = 0; n < 2; ++n) acc[a][b][m][n] = (f32x4){0.f, 0.f, 0.f, 0.f};
    bf16x8 At[4][2], B0[2][2], B1[2][2];
    const char* cA = (const char*)g.A + (size_t)cur.pm * tstepA; const char* cB = (const char*)g.Bt + (size_t)cur.pn * tstep;
    S.a_ready(cur);
    PG8_STAGE(PG8_SB(0, 0), cB, voffB); PG8_STAGE(PG8_SA(0, 0), cA, voffA); PG8_STAGE(PG8_SB(0, 1), cB + hstep, voffB); PG8_STAGE(PG8_SA(0, 1), cA + hstepA, voffA);
    if (wr == 1) PG8_BAR;
    PG8_WAIT_V(4); PG8_BAR;
    PG8_STAGE(PG8_SB(1, 0), cB + kstep, voffB); PG8_STAGE(PG8_SA(1, 0), cA + kstep, voffA); PG8_STAGE(PG8_SB(1, 1), cB + hstep + kstep, voffB);
    PG8_WAIT_V(6); PG8_BAR;
    for (;;) {
        const bool has_next = S.next(ui + 1, nxt);
        const char* nA = has_next ? (const char*)g.A + (size_t)nxt.pm * tstepA : cA; const char* nB = has_next ? (const char*)g.Bt + (size_t)nxt.pn * tstep : cB;
        for (int t = 0; t < nt; t += 2) {
            const bool last = (t == nt - 2);
            const char* a1 = cA + (size_t)(t + 1) * kstep;
            const char* a2 = last ? nA : cA + (size_t)(t + 2) * kstep; const char* b2 = last ? nB : cB + (size_t)(t + 2) * kstep;
            const char* a3 = a2 + kstep; const char* b3 = b2 + kstep;
            if (last && has_next) S.a_ready(nxt);
            PG8_LDB(B0, 0, 0); PG8_SCHED; PG8_LDA(At, 0, 0); PG8_STAGE(PG8_SA(1, 1), a1 + hstepA, voffA);
            PG8_WAIT_L(8); PG8_BAR; PG8_WAIT_L(0); PG8_MMA(0, 0, At, B0); PG8_BAR; PG8_SCHED;
            PG8_LDB(B1, 0, 1); PG8_STAGE(PG8_SB(0, 0), b2, voffB);
            PG8_BAR; PG8_WAIT_L(0); PG8_MMA(0, 1, At, B1); PG8_BAR;
            PG8_LDA(At, 0, 1); PG8_STAGE(PG8_SA(0, 0), a2, voffA);
            PG8_BAR; PG8_WAIT_L(0); PG8_MMA(1, 0, At, B0); PG8_BAR; PG8_SCHED;
            PG8_STAGE(PG8_SB(0, 1), b2 + hstep, voffB);
            PG8_WAIT_V(6); PG8_BAR; PG8_MMA(1, 1, At, B1); PG8_BAR;
            PG8_LDB(B0, 1, 0); PG8_SCHED; PG8_LDA(At, 1, 0); PG8_STAGE(PG8_SA(0, 1), a2 + hstepA, voffA);
            PG8_WAIT_L(8); PG8_BAR; PG8_WAIT_L(0); PG8_MMA(0, 0, At, B0); PG8_BAR; PG8_SCHED;
            PG8_LDB(B1, 1, 1); PG8_STAGE(PG8_SB(1, 0), b3, voffB);
            PG8_BAR; PG8_WAIT_L(0); PG8_MMA(0, 1, At, B1); PG8_BAR;
            PG8_LDA(At, 1, 1); PG8_STAGE(PG8_SA(1, 0), a3, voffA);
            PG8_BAR; PG8_WAIT_L(0); PG8_MMA(1, 0, At, B0); PG8_BAR; PG8_SCHED;
            PG8_STAGE(PG8_SB(1, 1), b3 + hstep, voffB);
            PG8_WAIT_V(6); PG8_BAR; PG8_MMA(1, 1, At, B1); PG8_BAR;
        }
        if constexpr (!Epi::AFTER_DRAIN) { E(acc, cur, wr, wc, fr, fq); S.done(cur); }
        if (!has_next) break;
#pragma unroll
        for (int a = 0; a < 2; ++a)
#pragma unroll
            for (int b = 0; b < 2; ++b)
#pragma unroll
                for (int m = 0; m < 4; ++m)
#pragma unroll
                    for (int n = 0; n < 2; ++n) acc[a][b][m][n] = (f32x4){0.f, 0.f, 0.f, 0.f};
        cur = nxt; cA = nA; cB = nB; ++ui;
    }
    PG8_WAIT_V(0);
    if (wr == 0) PG8_BAR;
    PG8_BAR;
    if constexpr (Epi::AFTER_DRAIN) { E.fused(acc, cur, wr, wc, fr, fq, lds, wid, lane); S.done(cur); }
#undef PG8_SA
#undef PG8_SB
#undef PG8_STAGE
#undef PG8_LDA
#undef PG8_LDB
#undef PG8_MMA
#undef PG8_WAIT_V
#undef PG8_WAIT_L
#undef PG8_BAR
#undef PG8_SCHED
}
#else
template <class Epi, class Sched>
__device__ __forceinline__ void gemm_phase(PG8_LAS unsigned char* lds, const Gemm g, const Sched& S, const Epi& E, const int tid) {
    const int wid = tid >> 6, lane = tid & 63, wr = wid >> 2, wc = wid & 3, fr = lane & 15, fq = lane >> 4;
    Unit cur;
    for (int ui = 0; S.next(ui, cur); ++ui) {
        f32x4 acc[2][2][4][2];
        for (int ai = 0; ai < 2; ++ai) for (int m = 0; m < 4; ++m) {
            const size_t row = (size_t)cur.pm * 256 + ai * 128 + wr * 64 + m * 16 + fr;
            const bf16_t* ap = g.A + row * g.lda;
            for (int bj = 0; bj < 2; ++bj) for (int n = 0; n < 2; ++n) for (int j = 0; j < 4; ++j) {
                const size_t col = (size_t)cur.pn * 256 + bj * 128 + wc * 32 + (Epi::PERM ? 8 * fq + 4 * n : 16 * n + 4 * fq) + j;
                const bf16_t* bp = g.Bt + col * g.K; float s = 0.f;
                for (int k = 0; k < g.K; ++k) s += bf2f(ap[k]) * bf2f(bp[k]);
                acc[ai][bj][m][n][j] = s; } }
        E(acc, cur, wr, wc, fr, fq);
    }
    __syncthreads();
}
#endif
}

using pg8::Unit;
constexpr int HALFT = 128;
struct EpiF32 {
    static constexpr bool PERM = false, AFTER_DRAIN = false;
    float* C; int ldc;
    __device__ __forceinline__ void operator()(const f32x4 (&acc)[2][2][4][2], const Unit& u, int wr, int wc, int fr, int fq) const {
        const int row0 = u.pm * 256 + wr * 64 + fr, col0 = u.pn * 256 + wc * 32 + 4 * fq;
#pragma unroll
        for (int ai = 0; ai < 2; ++ai)
#pragma unroll
            for (int m = 0; m < 4; ++m) { float* rowp = C + (size_t)(row0 + ai * HALFT + m * 16) * ldc + col0;
#pragma unroll
                for (int bj = 0; bj < 2; ++bj)
#pragma unroll
                    for (int n = 0; n < 2; ++n) *(f32x4*)(rowp + bj * HALFT + n * 16) = acc[ai][bj][m][n]; }
    }
};
struct EpiResidual {
    static constexpr bool PERM = false, AFTER_DRAIN = false;
    const float* res; float* out;
    __device__ __forceinline__ void operator()(const f32x4 (&acc)[2][2][4][2], const Unit& u, int wr, int wc, int fr, int fq) const {
        const int row0 = u.pm * 256 + wr * 64 + fr, col0 = u.pn * 256 + wc * 32 + 4 * fq;
#pragma unroll
        for (int ai = 0; ai < 2; ++ai)
#pragma unroll
            for (int m = 0; m < 4; ++m) { const size_t o = (size_t)(row0 + ai * HALFT + m * 16) * D + col0;
#pragma unroll
                for (int bj = 0; bj < 2; ++bj)
#pragma unroll
                    for (int n = 0; n < 2; ++n) { const f32x4 r = *(const f32x4*)(res + o + bj * HALFT + n * 16); *(f32x4*)(out + o + bj * HALFT + n * 16) = r + acc[ai][bj][m][n]; } }
    }
};
struct EpiBf16 {
    static constexpr bool PERM = true, AFTER_DRAIN = false;
    bf16* O; int ldc; const float* rowscale; int rs_stride;
    __device__ __forceinline__ void operator()(const f32x4 (&acc)[2][2][4][2], const Unit& u, int wr, int wc, int fr, int fq) const {
        const int row0 = u.pm * 256 + wr * 64 + fr, col0 = u.pn * 256 + wc * 32 + 8 * fq;
#pragma unroll
        for (int ai = 0; ai < 2; ++ai)
#pragma unroll
            for (int m = 0; m < 4; ++m) { const int row = row0 + ai * HALFT + m * 16; bf16* rowp = O + (size_t)row * ldc + col0;
                const float sc = rowscale ? rowscale[(size_t)row * rs_stride] : 1.0f;
#pragma unroll
                for (int bj = 0; bj < 2; ++bj) { const f32x4 v0 = acc[ai][bj][m][0] * sc, v1 = acc[ai][bj][m][1] * sc;
                    u32x4 w; w.x = pk2(v0[0], v0[1]); w.y = pk2(v0[2], v0[3]); w.z = pk2(v1[0], v1[1]); w.w = pk2(v1[2], v1[3]);
                    *(u32x4*)(rowp + bj * HALFT) = w; } }
    }
};
struct EpiSwiGLU {
    static constexpr bool PERM = true, AFTER_DRAIN = false;
    bf16* O; int ldc; int ntile;
    __device__ __forceinline__ void operator()(const f32x4 (&acc)[2][2][4][2], const Unit& u, int wr, int wc, int fr, int fq) const {
        const int row0 = u.pm * 256 + wr * 64 + fr, col0 = (u.pn % ntile) * 128 + wc * 32 + 8 * fq;
#pragma unroll
        for (int ai = 0; ai < 2; ++ai)
#pragma unroll
            for (int m = 0; m < 4; ++m) { bf16* rowp = O + (size_t)(row0 + ai * HALFT + m * 16) * ldc + col0;
                float a[8];
#pragma unroll
                for (int n = 0; n < 2; ++n)
#pragma unroll
                    for (int j = 0; j < 4; ++j) { const float g = acc[ai][0][m][n][j], up = acc[ai][1][m][n][j]; a[4 * n + j] = g * fast_rcp(1.0f + fast_exp(-g)) * up; }
                u32x4 w; w.x = pk2(a[0], a[1]); w.y = pk2(a[2], a[3]); w.z = pk2(a[4], a[5]); w.w = pk2(a[6], a[7]);
                *(u32x4*)rowp = w; }
    }
};
struct EpiZ {
    static constexpr bool PERM = false, AFTER_DRAIN = false;
    bf16* Z;
    __device__ __forceinline__ void operator()(const f32x4 (&acc)[2][2][4][2], const Unit& u, int wr, int wc, int fr, int fq) const {
        const int i = u.pn >> 2, pnl = u.pn & 3, pml = u.pm - i * (TH / 256);
        const int row0 = pml * 256 + wr * 64 + fr, col0 = pnl * 256 + wc * 32 + 4 * fq;
#pragma unroll
        for (int ai = 0; ai < 2; ++ai)
#pragma unroll
            for (int m = 0; m < 4; ++m) { bf16* rowp = Z + (size_t)(row0 + ai * HALFT + m * 16) * 4096 + i * 4;
#pragma unroll
                for (int bj = 0; bj < 2; ++bj)
#pragma unroll
                    for (int n = 0; n < 2; ++n) st_bf16x4(rowp + (col0 + bj * HALFT + n * 16) * 4, acc[ai][bj][m][n]); }
    }
};
struct BranchOrder {
    int nP, G, c;
    __device__ bool next(int i, Unit& u) const {
        const long L = (long)i * G + c; if (L >= (long)16 * nP) return false;
        const int br = (int)(L / (4 * nP)), r = (int)(L % (4 * nP)); u.pm = br * nP + (r >> 2); u.pn = br * 4 + (r & 3); return true;
    }
    __device__ __forceinline__ void a_ready(const Unit&) const {}
    __device__ __forceinline__ void done(const Unit&) const {}
};
struct EpiMerge {
    static constexpr bool PERM = false, AFTER_DRAIN = false;
    const bf16* Z; const float* gate_b; bf16* MG;
    __device__ __forceinline__ void operator()(const f32x4 (&acc)[2][2][4][2], const Unit& u, int wr, int wc, int fr, int fq) const {
        const int row0 = u.pm * 256 + wr * 64 + fr, col = u.pn * 64 + wc * 16 + 4 * fq;
        f32x4 gb[4];
#pragma unroll
        for (int i = 0; i < 4; ++i) gb[i] = *(const f32x4*)(gate_b + i * D + col);
#pragma unroll
        for (int ai = 0; ai < 2; ++ai)
#pragma unroll
            for (int m = 0; m < 4; ++m) { const size_t row = (size_t)(row0 + ai * HALFT + m * 16);
                f32x4 s = (f32x4){0.f, 0.f, 0.f, 0.f};
#pragma unroll
                for (int bj = 0; bj < 2; ++bj)
#pragma unroll
                    for (int n = 0; n < 2; ++n) { const int i = 2 * bj + n; const f32x4 z = ld_bf16x4(Z + row * 4096 + col * 4 + i * 4); const f32x4 a = acc[ai][bj][m][n] + gb[i];
#pragma unroll
                        for (int j = 0; j < 4; ++j) s[j] += z[j] * fast_rcp(1.0f + fast_exp(-a[j])); }
                st_bf16x4(MG + row * D + col, s); }
    }
};

constexpr size_t MiB = 1u << 20;
constexpr size_t al(size_t x) { return (x + 255) & ~(size_t)255; }
constexpr size_t WS_CTL = 0, CTL_BYTES = 1 * MiB;
constexpr size_t W_IN = 1 * MiB;
constexpr size_t W_GATE = W_IN + (size_t)PW * D * 2;
constexpr size_t W_UQ = W_GATE + (size_t)4096 * D * 2;
constexpr size_t W_UKV = W_UQ + (size_t)768 * 384 * 2;
constexpr size_t W_LORA = W_UKV + (size_t)1024 * 256 * 2;
constexpr size_t W_BR = W_LORA + (size_t)1536 * 384 * 2;
constexpr size_t W_OUT = W_BR + (size_t)4 * 1024 * 512 * 2;
constexpr size_t W_FGU = W_OUT + (size_t)D * D * 2;
constexpr size_t W_FDN = W_FGU + (size_t)NEXP * 2 * FF_E * D * 2;
constexpr size_t W_END = W_FDN + (size_t)NEXP * D * FF_E * 2;
constexpr size_t A_H = al(W_END);
constexpr size_t A_ROPE = A_H + (size_t)TH * D * 2;
constexpr size_t A_Y = A_ROPE + (size_t)TH * 64 * 4;
constexpr size_t A_P = A_Y + (size_t)4 * TH * 512 * 2;
constexpr size_t A_MIX = A_P + (size_t)TH * PW * 2;
constexpr size_t M_STAT = A_MIX;
constexpr size_t M_KR = M_STAT + (size_t)TH * 2 * 4;
constexpr size_t M_Q = M_KR + (size_t)TH * 64 * 2;
constexpr size_t M_KV = M_Q + (size_t)TH * 768 * 2;
constexpr size_t M_VT = M_KV + (size_t)TH * 1024 * 2;
constexpr size_t M_END = M_VT + (size_t)TH * 512 * 2;
constexpr size_t R_RKV = A_MIX;
constexpr size_t R_LIN = R_RKV + (size_t)TH * 1536 * 2;
constexpr size_t R_LOUT = R_LIN + (size_t)TH * 384 * 2;
constexpr size_t R_REC = R_LOUT + (size_t)TH * 1536 * 4;
constexpr size_t R_O = R_REC + (size_t)BH * 8 * NCH * 92416;
constexpr size_t R_END = R_O + (size_t)TH * 512 * 4;
constexpr size_t G_CH = A_MIX;
constexpr size_t G_O = G_CH + al((size_t)BH * 4 * NCH * 103440);
constexpr size_t G_END = G_O + (size_t)TH * 512 * 4;
constexpr size_t S_ST = A_MIX;
constexpr size_t S_YD = S_ST + (size_t)BH * NCH * 8 * 64 * 128 * 4;
constexpr size_t S_C = S_YD + (size_t)TH * 512 * 4;
constexpr size_t S_AC = S_C + (size_t)TH * 256 * 4;
constexpr size_t S_END = S_AC + (size_t)TH * 8 * 4;
constexpr size_t A_Z = A_P;
constexpr size_t A_MG = A_MIX;
constexpr size_t F_ACT = A_P;
constexpr size_t F_GA = F_ACT + (size_t)MOE_ROWS * FF_E * 2;
constexpr size_t F_YE = F_GA + (size_t)MOE_ROWS * D * 2;
constexpr size_t F_TOPE = F_YE + (size_t)MOE_ROWS * D * 4;
constexpr size_t F_TOPW = F_TOPE + (size_t)TH * 2 * 4;
constexpr size_t F_SLOT = F_TOPW + (size_t)TH * 2 * 4;
constexpr size_t F_END = F_SLOT + (size_t)TH * 2 * 4;
constexpr size_t cmax(size_t a, size_t b) { return a > b ? a : b; }
constexpr size_t WS_NEED = cmax(cmax(cmax(M_END, R_END), cmax(G_END, S_END)), F_END);
#ifndef EMU
static_assert(WS_NEED <= (size_t)896 * MiB, "workspace");
#endif
constexpr int CW_BAR = 4096;
constexpr int CW_CNT = 16384;
constexpr int CW_FILL = 16384 + 64;

#ifdef EMU
#define WAVE_SYNC() emu_wave_sync()
#else
#define WAVE_SYNC() do { asm volatile("s_waitcnt lgkmcnt(0)" ::: "memory"); } while (0)
#endif
struct Frame {
    LAS unsigned char* lds; int tid, lane, wave, G, gw, NGW, bid;
    float* out; unsigned char* ws; unsigned* ctl;
};
struct Args { const float* in[39]; float* out; unsigned char* ws; int lo, hi; };
#define WSP(type, off) ((type*)(F.ws + (off)))

template <class FN>
__device__ __forceinline__ void cvt_matrix(const Frame& F, const float* W, int ldw, int K, bf16* WT, int Ndst, const float* kscale, FN srccol) {
    LAS float* scr = (LAS float*)(F.lds + F.wave * 16384);
    const int nblk = Ndst / 32, nitems = (K / 64) * nblk, lane = F.lane;
    for (int item = F.gw; item < nitems; item += F.NGW) {
        const int kb = item / nblk, nb = item % nblk, k0 = 64 * kb, n0 = 32 * nb;
        const int sc = srccol(n0 + (lane & 31));
#pragma unroll 8
        for (int i = 0; i < 32; ++i) { const int kk = 2 * i + (lane >> 5); float v = sc >= 0 ? W[(size_t)(k0 + kk) * ldw + sc] : 0.f; if (kscale) v *= kscale[k0 + kk]; scr[kk * 33 + (lane & 31)] = v; }
        WAVE_SYNC();
        const int c = lane & 7;
#pragma unroll
        for (int j = 0; j < 4; ++j) { const int n = (lane >> 3) + 8 * j; const LAS float* s = scr + (8 * c) * 33 + n;
            u32x4 o; o.x = pk2(s[0 * 33], s[1 * 33]); o.y = pk2(s[2 * 33], s[3 * 33]); o.z = pk2(s[4 * 33], s[5 * 33]); o.w = pk2(s[6 * 33], s[7 * 33]);
            *(u32x4*)(WT + (size_t)(n0 + n) * K + k0 + 8 * c) = o; }
        WAVE_SYNC();
    }
}
__device__ __forceinline__ void phase_convert(const Frame& F, const Args& A, int layer) {
    const float* w_in = A.in[3] + (size_t)layer * D * IN_COLS;
    cvt_matrix(F, w_in, IN_COLS, D, WSP(bf16, W_IN), PW, nullptr, [](int n) { return n < C_GATE ? n : -1; });
    cvt_matrix(F, w_in, IN_COLS, D, WSP(bf16, W_GATE), 4096, nullptr, [](int n) {
        const int pn = n >> 8, c = n & 255, bj = c >> 7, wc = (c >> 5) & 3, nn = (c >> 4) & 1, r = c & 15; return C_GATE + (2 * bj + nn) * D + 64 * pn + 16 * wc + r; });
    cvt_matrix(F, A.in[6] + (size_t)layer * 384 * 768, 768, 384, WSP(bf16, W_UQ), 768, A.in[4] + layer * 384, [](int n) { return n; });
    cvt_matrix(F, A.in[7] + (size_t)layer * 256 * 1024, 1024, 256, WSP(bf16, W_UKV), 1024, A.in[5] + layer * 256, [](int n) { return n; });
    for (int i = 0; i < 4; ++i) cvt_matrix(F, A.in[30] + ((size_t)layer * 4 + i) * 512 * D, D, 512, WSP(bf16, W_BR) + (size_t)i * D * 512, D, nullptr, [](int n) { return n; });
    cvt_matrix(F, A.in[31] + (size_t)layer * D * D, D, D, WSP(bf16, W_OUT), D, nullptr, [](int n) { return n; });
    if (layer == 0) {
        cvt_matrix(F, A.in[33], 2 * FF_D, D, WSP(bf16, W_FGU), 2 * FF_D, nullptr, [](int n) { const int pn = n >> 8, c = n & 255; return c < 128 ? 128 * pn + c : FF_D + 128 * pn + (c - 128); });
        cvt_matrix(F, A.in[34], D, FF_D, WSP(bf16, W_FDN), D, nullptr, [](int n) { return n; });
    } else {
        for (int e = 0; e < NEXP; ++e) {
            cvt_matrix(F, A.in[36] + (size_t)e * D * 2 * FF_E, 2 * FF_E, D, WSP(bf16, W_FGU) + (size_t)e * 2 * FF_E * D, 2 * FF_E, nullptr, [](int n) { const int pn = n >> 8, c = n & 255; return c < 128 ? 128 * pn + c : FF_E + 128 * pn + (c - 128); });
            cvt_matrix(F, A.in[37] + (size_t)e * FF_E * D, D, FF_E, WSP(bf16, W_FDN) + (size_t)e * D * FF_E, D, nullptr, [](int n) { return n; });
        }
    }
    { const float* w2 = A.in[10] + (size_t)layer * 64 * 512; const float* a2 = A.in[12] + (size_t)layer * 64 * 512; const float* g2 = A.in[13] + (size_t)layer * 160 * 512;
      bf16* L = WSP(bf16, W_LORA);
      for (int idx = F.bid * 512 + F.tid; idx < 1536 * 384; idx += F.G * 512) { const int n = idx / 384, k = idx % 384; float v = 0.f;
          if (n < 512) { if (k < 64) v = w2[k * 512 + n]; } else if (n < 1024) { if (k >= 64 && k < 128) v = a2[(k - 64) * 512 + (n - 512)]; } else { if (k >= 128 && k < 288) v = g2[(k - 128) * 512 + (n - 1024)]; }
          L[idx] = (bf16)f2bf(v); } }
}

template <bool ROUTER>
__device__ __forceinline__ void phase_norm(const Frame& F, const Args& A, const float* xin, const float* gain, bf16* H, const float* router, int* tope, float* topw, unsigned* cnt) {
    const int lane = F.lane;
    f32x4 gv[4];
#pragma unroll
    for (int j = 0; j < 4; ++j) gv[j] = *(const f32x4*)(gain + 4 * lane + 256 * j);
    for (int m = F.gw; m < TH; m += F.NGW) {
        const float* xr = xin + (size_t)m * D; f32x4 v[4]; float ss = 0.f;
#pragma unroll
        for (int j = 0; j < 4; ++j) { v[j] = *(const f32x4*)(xr + 4 * lane + 256 * j); ss += (v[j].x * v[j].x + v[j].y * v[j].y) + (v[j].z * v[j].z + v[j].w * v[j].w); }
        const float rstd = 1.0f / sqrtf(wave_sum(ss) * (1.0f / D) + EPS);
#pragma unroll
        for (int j = 0; j < 4; ++j) { v[j] = v[j] * rstd * gv[j]; st_bf16x4(H + (size_t)m * D + 4 * lane + 256 * j, v[j]); }
        if (ROUTER) {
            float lg[8];
#pragma unroll
            for (int e = 0; e < 8; ++e) lg[e] = 0.f;
#pragma unroll
            for (int j = 0; j < 4; ++j)
#pragma unroll
                for (int q = 0; q < 4; ++q) { const float* rp = router + (size_t)(4 * lane + 256 * j + q) * 8; const f32x4 r0 = *(const f32x4*)rp, r1 = *(const f32x4*)(rp + 4); const float hv = v[j][q];
                    lg[0] += hv * r0.x; lg[1] += hv * r0.y; lg[2] += hv * r0.z; lg[3] += hv * r0.w; lg[4] += hv * r1.x; lg[5] += hv * r1.y; lg[6] += hv * r1.z; lg[7] += hv * r1.w; }
#pragma unroll
            for (int e = 0; e < 8; ++e) lg[e] = wave_sum(lg[e]);
            if (lane == 0) {
                int e1 = 0; float l1 = lg[0];
#pragma unroll
                for (int e = 1; e < 8; ++e) if (lg[e] > l1) { l1 = lg[e]; e1 = e; }
                int e2 = -1; float l2 = -3.0e38f;
#pragma unroll
                for (int e = 0; e < 8; ++e) if (e != e1 && lg[e] > l2) { l2 = lg[e]; e2 = e; }
                const float w1 = 1.0f / (1.0f + expf(l2 - l1));
                tope[2 * m] = e1; tope[2 * m + 1] = e2; topw[2 * m] = w1; topw[2 * m + 1] = 1.0f - w1;
                ATOMIC_ADD_U32(cnt + e1, 1u); ATOMIC_ADD_U32(cnt + e2, 1u);
            }
        }
    }
}
__device__ __forceinline__ void phase_rope_table(const Frame& F, const Args& A, const int* pos, float* rope) {
    for (int idx = F.bid * 512 + F.tid; idx < TH * 32; idx += F.G * 512) { const int t = idx >> 5, i = idx & 31;
        const float inv = powf(10000.0f, -(float)i / 32.0f);
        const float ang = (float)pos[t] * inv; float sn, cs; sincosf(ang, &sn, &cs);
        rope[(size_t)t * 64 + i] = cs; rope[(size_t)t * 64 + 32 + i] = sn; }
}
__device__ __forceinline__ void phase_final_norm(const Frame& F, const Args& A, float* x, const float* gain) {
    const int lane = F.lane;
    for (int m = F.gw; m < T; m += F.NGW) {
        float* xr = x + (size_t)m * D; f32x4 v[4]; float ss = 0.f;
#pragma unroll
        for (int j = 0; j < 4; ++j) { v[j] = *(const f32x4*)(xr + 4 * lane + 256 * j); ss += (v[j].x * v[j].x + v[j].y * v[j].y) + (v[j].z * v[j].z + v[j].w * v[j].w); }
        const float rstd = 1.0f / sqrtf(wave_sum(ss) * (1.0f / D) + EPS);
#pragma unroll
        for (int j = 0; j < 4; ++j) *(f32x4*)(xr + 4 * lane + 256 * j) = v[j] * rstd * *(const f32x4*)(gain + 4 * lane + 256 * j);
    }
}

__device__ __forceinline__ void phase_mla_prep(const Frame& F, const Args& A) {
    bf16* P = WSP(bf16, A_P); bf16* kr = WSP(bf16, M_KR); const float* rope = WSP(float, A_ROPE);
    const int lane = F.lane;
    for (int m = F.gw; m < TH; m += F.NGW) {
        bf16* pr = P + (size_t)m * PW; float sq = 0.f, skv = 0.f; f32x4 v[3];
#pragma unroll
        for (int j = 0; j < 3; ++j) { const int c = 4 * lane + 256 * j; v[j] = ld_bf16x4(pr + c); const float s = (v[j].x * v[j].x + v[j].y * v[j].y) + (v[j].z * v[j].z + v[j].w * v[j].w);
            if (c < 384) sq += s; else if (c < 640) skv += s; }
        sq = wave_sum(sq); skv = wave_sum(skv);
        const float rq = 1.0f / sqrtf(sq * (1.0f / 384.0f) + EPS), rkv = 1.0f / sqrtf(skv * (1.0f / 256.0f) + EPS);
#pragma unroll
        for (int j = 0; j < 3; ++j) { const int c = 4 * lane + 256 * j; if (c < 640) st_bf16x4(pr + c, v[j] * (c < 384 ? rq : rkv)); }
        if (lane < 32) { const float x1 = bf2f(pr[640 + lane]), x2 = bf2f(pr[672 + lane]), c = rope[(size_t)m * 64 + lane], s = rope[(size_t)m * 64 + 32 + lane];
            kr[(size_t)m * 64 + lane] = (bf16)f2bf(x1 * c - x2 * s); kr[(size_t)m * 64 + 32 + lane] = (bf16)f2bf(x2 * c + x1 * s); }
    }
}
__device__ __forceinline__ void phase_mla_q(const Frame& F, const Args& A) {
    pg8::Gemm g{WSP(bf16, A_P) + 0, WSP(bf16, W_UQ), PW, 384}; pg8::StaticOrder S; S.init(TH, 768, F.G, F.bid);
    EpiBf16 E{WSP(bf16, M_Q), 768, nullptr, 0}; pg8::gemm_phase(F.lds, g, S, E, F.tid);
}
struct EpiKV {
    static constexpr bool PERM = true, AFTER_DRAIN = false;
    bf16* KV; bf16* VT;
    __device__ __forceinline__ void operator()(const f32x4 (&acc)[2][2][4][2], const Unit& u, int wr, int wc, int fr, int fq) const {
        const int row0 = u.pm * 256 + wr * 64 + fr, col0 = wc * 32 + 8 * fq;
#pragma unroll
        for (int ai = 0; ai < 2; ++ai)
#pragma unroll
            for (int m = 0; m < 4; ++m) { const int row = row0 + ai * HALFT + m * 16;
                { const f32x4 v0 = acc[ai][0][m][0], v1 = acc[ai][0][m][1]; u32x4 w; w.x = pk2(v0[0], v0[1]); w.y = pk2(v0[2], v0[3]); w.z = pk2(v1[0], v1[1]); w.w = pk2(v1[2], v1[3]);
                  *(u32x4*)(KV + (size_t)row * 1024 + u.pn * 256 + col0) = w; }
                const int b = row / SEQ, t = row % SEQ; bf16* vt = VT + ((size_t)(b * 4 + u.pn) * 128 + col0) * SEQ + t;
#pragma unroll
                for (int n = 0; n < 2; ++n)
#pragma unroll
                    for (int j = 0; j < 4; ++j) vt[(size_t)(4 * n + j) * SEQ] = (bf16)f2bf(acc[ai][1][m][n][j]); }
    }
};
__device__ __forceinline__ void phase_mla_kv(const Frame& F, const Args& A) {
    pg8::Gemm g{WSP(bf16, A_P) + 384, WSP(bf16, W_UKV), PW, 256}; pg8::StaticOrder S; S.init(TH, 1024, F.G, F.bid);
    EpiKV E{WSP(bf16, M_KV), WSP(bf16, M_VT)}; pg8::gemm_phase(F.lds, g, S, E, F.tid);
}
constexpr int AT_KS = 200, AT_VS = 72;
constexpr int AT_KBYTES = 64 * AT_KS * 2, AT_VBYTES = 128 * AT_VS * 2;
__device__ __forceinline__ void phase_attention(const Frame& F, const Args& A) {
    const bf16* Q = WSP(bf16, M_Q); const bf16* KV = WSP(bf16, M_KV); const bf16* KR = WSP(bf16, M_KR); const bf16* VTg = WSP(bf16, M_VT); const float* rope = WSP(float, A_ROPE); bf16* Y = WSP(bf16, A_Y);
    const int lane = F.lane, w = F.wave, l15 = lane & 15, q4 = lane >> 4, tid = F.tid, grp = w >> 2, wq = w & 3;
    const int NQB = SEQ / 128, nunits = BH * 4 * NQB;
    const float sc2 = 0.07216878364870322f * 1.4426950408889634f;
    for (int unit = F.bid; unit < nunits; unit += F.G) {
        const int qb = NQB - 1 - (unit / (BH * 4)), bh = unit % (BH * 4), h = bh & 3, b = bh >> 2;
        const size_t t0 = (size_t)b * SEQ;
        bf16x8 qf[2][6];
#pragma unroll
        for (int f = 0; f < 2; ++f) { const size_t tq = t0 + qb * 128 + wq * 32 + 16 * f + l15;
#pragma unroll
            for (int ks = 0; ks < 6; ++ks) qf[f][ks] = *(const bf16x8*)(Q + tq * 768 + h * 192 + 32 * ks + 8 * q4);
            const bf16x8 a = qf[f][4], c2 = qf[f][5];
#pragma unroll
            for (int j = 0; j < 8; ++j) { const float x1 = bf2f((unsigned short)a[j]), x2 = bf2f((unsigned short)c2[j]), c = rope[tq * 64 + 8 * q4 + j], sn = rope[tq * 64 + 32 + 8 * q4 + j];
                qf[f][4][j] = (short)f2bf(x1 * c - x2 * sn); qf[f][5][j] = (short)f2bf(x2 * c + x1 * sn); } }
        f32x4 o[2][8];
#pragma unroll
        for (int f = 0; f < 2; ++f)
#pragma unroll
            for (int mb = 0; mb < 8; ++mb) o[f][mb] = (f32x4){0.f, 0.f, 0.f, 0.f};
        float mrow[2] = {-3.0e38f, -3.0e38f}, lrow[2] = {0.f, 0.f};
        const int qchunk = 2 * qb + (wq >> 1), ntile = 2 * qb + 2;
        u32x4 pk_[3], pv_[2];
        const int skey = tid >> 3, c8 = tid & 7;
        const int okv = skey * 1024 + 8 * c8, okr = skey * 64 + 8 * c8, ovt = skey * SEQ + 8 * c8;
        const bf16* kvb = KV + t0 * 1024 + h * 256; const bf16* krb = KR + t0 * 64; const bf16* vtb = VTg + (size_t)(b * 4 + h) * 128 * SEQ;
#define AT_LOAD(kt) do { const bf16* kv_ = kvb + (size_t)(kt) * 65536; const bf16* kr_ = krb + (size_t)(kt) * 4096; const bf16* vt_ = vtb + (size_t)(kt) * 64; \
            pk_[0] = *(const u32x4*)(kv_ + okv); pk_[1] = *(const u32x4*)(kv_ + okv + 64); pk_[2] = *(const u32x4*)(kr_ + okr); \
            pv_[0] = *(const u32x4*)(vt_ + ovt); pv_[1] = *(const u32x4*)(vt_ + ovt + 64 * SEQ); } while (0)
#define AT_STORE(bufi) do { LAS bf16* Ks_ = (LAS bf16*)(F.lds + (bufi) * (AT_KBYTES + AT_VBYTES)); LAS bf16* Vt_ = (LAS bf16*)((LAS unsigned char*)Ks_ + AT_KBYTES); \
            *(LAS u32x4*)(Ks_ + skey * AT_KS + 8 * c8) = pk_[0]; *(LAS u32x4*)(Ks_ + skey * AT_KS + 8 * c8 + 64) = pk_[1]; *(LAS u32x4*)(Ks_ + skey * AT_KS + 8 * c8 + 128) = pk_[2]; \
            *(LAS u32x4*)(Vt_ + skey * AT_VS + 8 * c8) = pv_[0]; *(LAS u32x4*)(Vt_ + (skey + 64) * AT_VS + 8 * c8) = pv_[1]; } while (0)
        __syncthreads();
        AT_LOAD(0); AT_STORE(0);
        __syncthreads();
        for (int kt = 0; kt < ntile; ++kt) {
            if (kt + 1 < ntile) AT_LOAD(kt + 1);
            if (kt <= qchunk) {
                const LAS bf16* Ks = (const LAS bf16*)(F.lds + (kt & 1) * (AT_KBYTES + AT_VBYTES)); const LAS bf16* Vt = (const LAS bf16*)((const LAS unsigned char*)Ks + AT_KBYTES);
                f32x4 st[2][2];
#pragma unroll
                for (int kb = 0; kb < 2; ++kb) { st[0][kb] = (f32x4){0.f, 0.f, 0.f, 0.f}; st[1][kb] = (f32x4){0.f, 0.f, 0.f, 0.f};
#pragma unroll
                    for (int ks = 0; ks < 6; ++ks) { const bf16x8 kf = *(const LAS bf16x8*)(Ks + (32 * grp + 16 * kb + l15) * AT_KS + 32 * ks + 8 * q4);
                        st[0][kb] = MFMA_BF16(kf, qf[0][ks], st[0][kb]); st[1][kb] = MFMA_BF16(kf, qf[1][ks], st[1][kb]); } }
                bf16x8 pb[2];
#pragma unroll
                for (int f = 0; f < 2; ++f) {
                    float mx = -3.0e38f;
#pragma unroll
                    for (int kb = 0; kb < 2; ++kb) { st[f][kb] = st[f][kb] * sc2; mx = fmaxf(mx, fmaxf(fmaxf(st[f][kb].x, st[f][kb].y), fmaxf(st[f][kb].z, st[f][kb].w))); }
                    mx = fmaxf(mx, __shfl_xor(mx, 16)); mx = fmaxf(mx, __shfl_xor(mx, 32));
                    const float mnew = fmaxf(mrow[f], mx), alpha = exp2f(mrow[f] - mnew); mrow[f] = mnew;
                    float ps = 0.f;
#pragma unroll
                    for (int kb = 0; kb < 2; ++kb)
#pragma unroll
                        for (int r = 0; r < 4; ++r) { const float p = exp2f(st[f][kb][r] - mnew); ps += p; pb[f][4 * kb + r] = (short)f2bf(p); }
                    lrow[f] = lrow[f] * alpha + ps;
#pragma unroll
                    for (int mb = 0; mb < 8; ++mb) o[f][mb] = o[f][mb] * alpha;
                }
#pragma unroll
                for (int mb = 0; mb < 8; ++mb) { const LAS bf16* vp = Vt + (16 * mb + l15) * AT_VS + 32 * grp + 4 * q4;
                    const bf16x4 v0 = *(const LAS bf16x4*)vp, v1 = *(const LAS bf16x4*)(vp + 16);
                    bf16x8 vf; vf[0] = v0[0]; vf[1] = v0[1]; vf[2] = v0[2]; vf[3] = v0[3]; vf[4] = v1[0]; vf[5] = v1[1]; vf[6] = v1[2]; vf[7] = v1[3];
                    o[0][mb] = MFMA_BF16(vf, pb[0], o[0][mb]); o[1][mb] = MFMA_BF16(vf, pb[1], o[1][mb]); }
            }
            if (kt + 1 < ntile) AT_STORE((kt + 1) & 1);
            __syncthreads();
        }
#undef AT_LOAD
#undef AT_STORE
#pragma unroll
        for (int f = 0; f < 2; ++f) { lrow[f] += __shfl_xor(lrow[f], 16); lrow[f] += __shfl_xor(lrow[f], 32); }
        LAS float* xo = (LAS float*)F.lds + (size_t)wq * (2 * 8 * 4 * 64 + 4 * 64);
        if (grp == 1) {
#pragma unroll
            for (int f = 0; f < 2; ++f) {
#pragma unroll
                for (int mb = 0; mb < 8; ++mb)
#pragma unroll
                    for (int r = 0; r < 4; ++r) xo[((f * 8 + mb) * 4 + r) * 64 + lane] = o[f][mb][r];
                xo[2 * 8 * 4 * 64 + f * 64 + lane] = mrow[f]; xo[2 * 8 * 4 * 64 + 128 + f * 64 + lane] = lrow[f]; } }
        __syncthreads();
        if (grp == 0) {
#pragma unroll
            for (int f = 0; f < 2; ++f) { const float m1 = xo[2 * 8 * 4 * 64 + f * 64 + lane], l1 = xo[2 * 8 * 4 * 64 + 128 + f * 64 + lane];
                const float m = fmaxf(mrow[f], m1), a0 = exp2f(mrow[f] - m), a1 = exp2f(m1 - m), inv = 1.0f / (lrow[f] * a0 + l1 * a1);
                const size_t tq = t0 + qb * 128 + wq * 32 + 16 * f + l15;
#pragma unroll
                for (int mb = 0; mb < 8; ++mb) { f32x4 v;
#pragma unroll
                    for (int r = 0; r < 4; ++r) v[r] = (o[f][mb][r] * a0 + xo[((f * 8 + mb) * 4 + r) * 64 + lane] * a1) * inv;
                    st_bf16x4(Y + tq * 512 + h * 128 + 16 * mb + 4 * q4, v); } } }
    }
    __syncthreads();
}

__device__ __forceinline__ f32x4 tile_bf(const LAS bf16* a, int lda, const LAS bf16* bt, int ldb, int K, f32x4 acc, int l15, int q4) {
    const LAS bf16* ap = a + l15 * lda + 8 * q4; const LAS bf16* bp = bt + l15 * ldb + 8 * q4;
#pragma unroll 4
    for (int ks = 0; ks < K / 32; ++ks) acc = MFMA_BF16(*(const LAS bf16x8*)(ap + 32 * ks), *(const LAS bf16x8*)(bp + 32 * ks), acc);
    return acc;
}
__device__ __forceinline__ f32x4 tile_mm(const LAS float* a, int lda, int ska, const LAS float* b, int ldb, int scb, int K, f32x4 acc, int l15, int q4);

__device__ __forceinline__ void phase_rwkv_prep(const Frame& F, const Args& A, int layer) {
    const bf16* P = WSP(bf16, A_P); bf16* RKV = WSP(bf16, R_RKV); bf16* LIN = WSP(bf16, R_LIN); const float* mu = A.in[8] + (size_t)layer * 1824;
    const int lane = F.lane;
    for (int m = F.gw; m < TH; m += F.NGW) {
        const bool first = (m % SEQ) == 0; const bf16* pr = P + (size_t)m * PW + C_RWKV;
#pragma unroll
        for (int j = 0; j < 8; ++j) { const int c = 4 * lane + 256 * j;
            if (c < 1824) { const f32x4 p = ld_bf16x4(pr + c); const f32x4 pv = first ? (f32x4){0.f, 0.f, 0.f, 0.f} : ld_bf16x4(pr - PW + c); const f32x4 muv = *(const f32x4*)(mu + c);
                f32x4 x = p + (pv - p) * muv;
                if (c < 1536) st_bf16x4(RKV + (size_t)m * 1536 + c, x);
                else { if (c < 1600) { x.x = tanhf(x.x); x.y = tanhf(x.y); x.z = tanhf(x.z); x.w = tanhf(x.w); }
                       else if (c >= 1664) { x.x = sigmoidf_(x.x); x.y = sigmoidf_(x.y); x.z = sigmoidf_(x.z); x.w = sigmoidf_(x.w); }
                       st_bf16x4(LIN + (size_t)m * 384 + (c - 1536), x); } } }
        if (lane < 24) st_bf16x4(LIN + (size_t)m * 384 + 288 + 4 * lane, (f32x4){0.f, 0.f, 0.f, 0.f});
    }
}
__device__ __forceinline__ void phase_rwkv_lora(const Frame& F, const Args& A) {
    pg8::Gemm g{WSP(bf16, R_LIN), WSP(bf16, W_LORA), 384, 384}; pg8::StaticOrder S; S.init(TH, 1536, F.G, F.bid);
    EpiF32 E{WSP(float, R_LOUT), 1536}; pg8::gemm_phase(F.lds, g, S, E, F.tid);
}
constexpr int RS = 72;
constexpr int RREC_COMMON = 4 * 64 * RS * 2 + 256;
constexpr int RREC_SLICE = 3 * 64 * 36 * 4;
constexpr int RREC_BYTES = RREC_COMMON + 2 * RREC_SLICE;
static_assert(RREC_BYTES == 92416, "record size (see R_REC in the workspace map)");
static_assert(RREC_COMMON % 16 == 0 && RREC_SLICE % 16 == 0, "record alignment");
__device__ __forceinline__ void phase_rwkv_r1(const Frame& F, const Args& A, int layer) {
    const bf16* RKV = WSP(bf16, R_RKV); const float* LOUT = WSP(float, R_LOUT); unsigned char* REC = WSP(unsigned char, R_REC);
    const float* w0 = A.in[9] + layer * 512; const float* a0 = A.in[11] + layer * 512; const float* k_k = A.in[14] + layer * 512; const float* k_a = A.in[15] + layer * 512;
    LAS bf16* kbar = (LAS bf16*)F.lds; LAS bf16* atil = kbar + 64 * RS; LAS bf16* khat = atil + 64 * RS; LAS bf16* rbar = khat + 64 * RS;
    LAS bf16* atT = rbar + 64 * RS; LAS bf16* khT = atT + 64 * RS; LAS bf16* vT = khT + 64 * RS; LAS bf16* Bm = vT + 64 * RS; LAS bf16* Em = Bm + 64 * RS;
    LAS float* Am = (LAS float*)(Em + 64 * RS);
    LAS float* X = Am + 64 * 68;
    LAS float* lam = Am;
    const int tid = F.tid, lane = F.lane, w = F.wave, l15 = lane & 15, q4 = lane >> 4;
    const int nunits = BH * 8 * NCH;
    for (int unit = F.bid; unit < nunits; unit += F.G) {
        const int c = unit % NCH, h = (unit / NCH) & 7, b = unit / (NCH * 8);
        const size_t tok0 = (size_t)b * SEQ + (size_t)c * 64;
        const int j = lane, cj = h * 64 + j;
        __syncthreads();
        float r_[8], km_[8], kk_[8], ka_[8], v_[8];
        { const float w0c = w0[cj], a0c = a0[cj], kkc = k_k[cj], kac = k_a[cj];
#pragma unroll
          for (int q = 0; q < 8; ++q) { const int t = w + 8 * q; const size_t tok = tok0 + t;
              const float r = bf2f(RKV[tok * 1536 + cj]), k = bf2f(RKV[tok * 1536 + 512 + cj]); v_[q] = bf2f(RKV[tok * 1536 + 1024 + cj]);
              const float wpre = LOUT[tok * 1536 + cj], apre = LOUT[tok * 1536 + 512 + cj];
              const float wl = -softplusf_(-(w0c + wpre)) - 0.5f, a = sigmoidf_(a0c + apre);
              const float kr = k * kkc, ss = wave_sum(kr * kr), kk = kr / sqrtf(ss + EPS);
              r_[q] = r; km_[q] = k * (1.0f + (a - 1.0f) * kac); kk_[q] = kk; ka_[q] = kk * a;
              lam[t * 64 + j] = -expf(wl); } }
        __syncthreads();
        if (w == 0) { float s = 0.f; for (int t = 0; t < 64; ++t) { s += lam[t * 64 + j]; lam[t * 64 + j] = s; } }
        __syncthreads();
        { const float Lend = lam[63 * 64 + j];
#pragma unroll
          for (int q = 0; q < 8; ++q) { const int t = w + 8 * q; const float L = lam[t * 64 + j], Lm1 = t ? lam[(t - 1) * 64 + j] : 0.f;
              const float eG = expf(L), eGi = expf(-L), eGm1 = expf(Lm1), eT = expf(Lend - L);
              const float kb = kk_[q] * eGm1;
              kbar[t * RS + j] = (bf16)f2bf(kb); X[t * 132 + j] = kb;
              atil[t * RS + j] = (bf16)f2bf(ka_[q] * eGi); khat[t * RS + j] = (bf16)f2bf(km_[q] * eGi); rbar[t * RS + j] = (bf16)f2bf(r_[q] * eG);
              atT[j * RS + t] = (bf16)f2bf(-ka_[q] * eT); khT[j * RS + t] = (bf16)f2bf(km_[q] * eT); vT[j * RS + t] = (bf16)f2bf(v_[q]); }
          if (w == 0) { float* gc = (float*)(REC + (size_t)unit * RREC_BYTES + 4 * 64 * RS * 2); gc[j] = expf(Lend); } }
        __syncthreads();
        unsigned char* rec = REC + (size_t)unit * RREC_BYTES;
        for (int tt = 0; tt < 8; ++tt) { const int tile = w * 8 + tt, which = tile >> 4, ti = (tile >> 2) & 3, tj = tile & 3;
            f32x4 acc = (f32x4){0.f, 0.f, 0.f, 0.f};
            if (tj <= ti) acc = tile_bf(((which & 2) ? rbar : kbar) + 16 * ti * RS, RS, ((which & 1) ? khat : atil) + 16 * tj * RS, RS, 64, acc, l15, q4);
#pragma unroll
            for (int r = 0; r < 4; ++r) { const int i = 16 * ti + 4 * q4 + r, jj = 16 * tj + l15; const bool keep = (which & 2) ? (jj <= i) : (jj < i); const float v = keep ? acc[r] : 0.f;
                if (which == 0) Am[i * 68 + jj] = v; else if (which == 1) Bm[i * RS + jj] = (bf16)f2bf(v); else if (which == 3) Em[i * RS + jj] = (bf16)f2bf(v);
                else ((bf16*)(rec + 2 * 64 * RS * 2))[i * RS + jj] = (bf16)f2bf(-v); } }
        __syncthreads();
        for (int tt = 0; tt < 6; ++tt) { const int tile = w * 6 + tt, which = tile >> 4, ti = (tile >> 2) & 3, tj = tile & 3;
            const LAS bf16* aop = which == 0 ? Bm : which == 1 ? Em : khT;
            const f32x4 acc = tile_bf(aop + 16 * ti * RS, RS, vT + 16 * tj * RS, RS, 64, (f32x4){0.f, 0.f, 0.f, 0.f}, l15, q4);
#pragma unroll
            for (int r = 0; r < 4; ++r) { const int i = 16 * ti + 4 * q4 + r, vv = 16 * tj + l15;
                if (which == 0) X[i * 132 + 64 + vv] = acc[r];
                else { float* dst = (float*)(rec + RREC_COMMON + (vv >> 5) * RREC_SLICE + (which == 1 ? 1 : 2) * 64 * 36 * 4); dst[i * 36 + (vv & 31)] = acc[r]; } } }
        __syncthreads();
        for (int rb = 0; rb < 4; ++rb) {
            if (rb > 0) {
                const f32x4 acc = tile_mm(Am + 16 * rb * 68, 68, 1, X + 16 * w, 132, 1, 16 * rb, (f32x4){0.f, 0.f, 0.f, 0.f}, l15, q4);
#pragma unroll
                for (int r = 0; r < 4; ++r) X[(16 * rb + 4 * q4 + r) * 132 + 16 * w + l15] -= acc[r];
                __syncthreads();
            }
            if (tid < 128) { float x[16];
#pragma unroll
                for (int i = 0; i < 16; ++i) { float sacc = X[(16 * rb + i) * 132 + tid];
#pragma unroll
                    for (int jj = 0; jj < i; ++jj) sacc -= Am[(16 * rb + i) * 68 + 16 * rb + jj] * x[jj];
                    x[i] = sacc; }
#pragma unroll
                for (int i = 0; i < 16; ++i) X[(16 * rb + i) * 132 + tid] = x[i]; }
            __syncthreads();
        }
        for (int e = tid; e < 64 * 64; e += 512) { const int t = e >> 6, jj = e & 63; ((bf16*)rec)[t * RS + jj] = (bf16)f2bf(X[t * 132 + jj]);
            float* ub = (float*)(rec + RREC_COMMON + (jj >> 5) * RREC_SLICE); ub[t * 36 + (jj & 31)] = X[t * 132 + 64 + jj]; }
        for (int e = tid; e < 64 * RS / 8; e += 512) { ((u32x4*)(rec + 64 * RS * 2))[e] = ((const LAS u32x4*)rbar)[e]; ((u32x4*)(rec + 3 * 64 * RS * 2))[e] = ((const LAS u32x4*)atT)[e]; }
    }
    __syncthreads();
}
constexpr int R2_BUF = RREC_COMMON + RREC_SLICE;
__device__ __forceinline__ void phase_rwkv_r2(const Frame& F, const Args& A) {
    const unsigned char* REC = WSP(unsigned char, R_REC); float* RO = WSP(float, R_O);
    LAS unsigned char* buf0 = F.lds; LAS bf16* HT = (LAS bf16*)(F.lds + 2 * R2_BUF); LAS bf16* UT = HT + 2 * 32 * RS;
    const int tid = F.tid, lane = F.lane, w = F.wave, l15 = lane & 15, q4 = lane >> 4, ti = w >> 1, tj = w & 1;
    const int nunits = BH * 8 * 2;
    constexpr int NCHK = R2_BUF / 16;
    for (int unit = F.bid; unit < nunits; unit += F.G) {
        const int vs = unit & 1, h = (unit >> 1) & 7, b = unit >> 4;
        __syncthreads();
        for (int e = tid; e < 2 * 32 * RS / 2; e += 512) ((LAS unsigned*)HT)[e] = 0u;
        f32x4 Hreg = (f32x4){0.f, 0.f, 0.f, 0.f};
        u32x4 pre[8];
        { const unsigned char* rec = REC + (size_t)((b * 8 + h) * NCH) * RREC_BYTES;
#pragma unroll
          for (int q = 0; q < 8; ++q) { const int e = tid + 512 * q; if (e < NCHK) { const size_t off = (size_t)e * 16; pre[q] = *(const u32x4*)(rec + (off < RREC_COMMON ? off : off + (size_t)vs * RREC_SLICE)); } }
#pragma unroll
          for (int q = 0; q < 8; ++q) { const int e = tid + 512 * q; if (e < NCHK) *(LAS u32x4*)(buf0 + (size_t)e * 16) = pre[q]; } }
        __syncthreads();
        for (int c = 0; c < NCH; ++c) {
            LAS unsigned char* buf = buf0 + (c & 1) * R2_BUF; LAS unsigned char* nbuf = buf0 + ((c + 1) & 1) * R2_BUF;
            if (c + 1 < NCH) { const unsigned char* rec = REC + (size_t)((b * 8 + h) * NCH + c + 1) * RREC_BYTES;
#pragma unroll
                for (int q = 0; q < 8; ++q) { const int e = tid + 512 * q; if (e < NCHK) { const size_t off = (size_t)e * 16; pre[q] = *(const u32x4*)(rec + (off < RREC_COMMON ? off : off + (size_t)vs * RREC_SLICE)); } } }
            const LAS bf16* KB = (const LAS bf16*)buf; const LAS bf16* RB = KB + 64 * RS; const LAS bf16* FMn = RB + 64 * RS; const LAS bf16* ATn = FMn + 64 * RS;
            const LAS float* GC = (const LAS float*)(buf + 4 * 64 * RS * 2); const LAS float* UB = (const LAS float*)(buf + RREC_COMMON); const LAS float* OB = UB + 64 * 36; const LAS float* KV = OB + 64 * 36;
            const LAS bf16* H0 = HT + (c & 1) * 32 * RS; LAS bf16* H1 = HT + ((c + 1) & 1) * 32 * RS;
            f32x4 u;
#pragma unroll
            for (int r = 0; r < 4; ++r) u[r] = UB[(16 * ti + 4 * q4 + r) * 36 + 16 * tj + l15];
            u = tile_bf(KB + 16 * ti * RS, RS, H0 + 16 * tj * RS, RS, 64, u, l15, q4);
            { u32x2 pk; pk.x = pk2(u[0], u[1]); pk.y = pk2(u[2], u[3]); *(LAS u32x2*)(UT + (16 * tj + l15) * RS + 16 * ti + 4 * q4) = pk; }
            __syncthreads();
            f32x4 o;
#pragma unroll
            for (int r = 0; r < 4; ++r) o[r] = OB[(16 * ti + 4 * q4 + r) * 36 + 16 * tj + l15];
            o = tile_bf(RB + 16 * ti * RS, RS, H0 + 16 * tj * RS, RS, 64, o, l15, q4);
            o = tile_bf(FMn + 16 * ti * RS, RS, UT + 16 * tj * RS, RS, 64, o, l15, q4);
#pragma unroll
            for (int r = 0; r < 4; ++r) RO[((size_t)b * SEQ + (size_t)c * 64 + 16 * ti + 4 * q4 + r) * 512 + h * 64 + 32 * vs + 16 * tj + l15] = o[r];
#pragma unroll
            for (int r = 0; r < 4; ++r) Hreg[r] = Hreg[r] * GC[16 * ti + 4 * q4 + r] + KV[(16 * ti + 4 * q4 + r) * 36 + 16 * tj + l15];
            Hreg = tile_bf(ATn + 16 * ti * RS, RS, UT + 16 * tj * RS, RS, 64, Hreg, l15, q4);
            { u32x2 pk; pk.x = pk2(Hreg[0], Hreg[1]); pk.y = pk2(Hreg[2], Hreg[3]); *(LAS u32x2*)(H1 + (16 * tj + l15) * RS + 16 * ti + 4 * q4) = pk; }
            if (c + 1 < NCH) {
#pragma unroll
                for (int q = 0; q < 8; ++q) { const int e = tid + 512 * q; if (e < NCHK) *(LAS u32x4*)(nbuf + (size_t)e * 16) = pre[q]; } }
            __syncthreads();
        }
    }
    __syncthreads();
}
__device__ __forceinline__ void phase_rwkv_post(const Frame& F, const Args& A, int layer) {
    const bf16* RKV = WSP(bf16, R_RKV); const float* LOUT = WSP(float, R_LOUT); const float* RO = WSP(float, R_O); bf16* Y = WSP(bf16, A_Y) + (size_t)1 * TH * 512;
    const float* a0 = A.in[11] + layer * 512; const float* k_a = A.in[15] + layer * 512; const float* r_k = A.in[16] + layer * 512; const float* ln_w = A.in[17] + layer * 512; const float* ln_b = A.in[18] + layer * 512;
    const int lane = F.lane, c0 = 8 * lane;
    for (int m = F.gw; m < TH; m += F.NGW) {
        float o[8], r[8], k[8], v[8], ap[8], g[8];
        { const f32x4 a = *(const f32x4*)(RO + (size_t)m * 512 + c0), b2 = *(const f32x4*)(RO + (size_t)m * 512 + c0 + 4); o[0] = a.x; o[1] = a.y; o[2] = a.z; o[3] = a.w; o[4] = b2.x; o[5] = b2.y; o[6] = b2.z; o[7] = b2.w; }
#pragma unroll
        for (int hh = 0; hh < 2; ++hh) { const f32x4 rv = ld_bf16x4(RKV + (size_t)m * 1536 + c0 + 4 * hh), kv = ld_bf16x4(RKV + (size_t)m * 1536 + 512 + c0 + 4 * hh), vv = ld_bf16x4(RKV + (size_t)m * 1536 + 1024 + c0 + 4 * hh);
            const f32x4 av = *(const f32x4*)(LOUT + (size_t)m * 1536 + 512 + c0 + 4 * hh), gv = *(const f32x4*)(LOUT + (size_t)m * 1536 + 1024 + c0 + 4 * hh);
#pragma unroll
            for (int q = 0; q < 4; ++q) { r[4 * hh + q] = rv[q]; k[4 * hh + q] = kv[q]; v[4 * hh + q] = vv[q]; ap[4 * hh + q] = av[q]; g[4 * hh + q] = gv[q]; } }
        float bon = 0.f, sm = 0.f;
#pragma unroll
        for (int q = 0; q < 8; ++q) { const float a = sigmoidf_(a0[c0 + q] + ap[q]); const float km = k[q] * (1.0f + (a - 1.0f) * k_a[c0 + q]); bon += r[q] * km * r_k[c0 + q]; sm += o[q]; }
        bon += __shfl_xor(bon, 1); bon += __shfl_xor(bon, 2); bon += __shfl_xor(bon, 4);
        sm += __shfl_xor(sm, 1); sm += __shfl_xor(sm, 2); sm += __shfl_xor(sm, 4);
        const float mean = sm * (1.0f / 64.0f); float vs = 0.f;
#pragma unroll
        for (int q = 0; q < 8; ++q) { const float d = o[q] - mean; vs += d * d; }
        vs += __shfl_xor(vs, 1); vs += __shfl_xor(vs, 2); vs += __shfl_xor(vs, 4);
        const float rstd = 1.0f / sqrtf(vs * (1.0f / 64.0f) + 64e-5f);
        float y[8];
#pragma unroll
        for (int q = 0; q < 8; ++q) y[q] = ((o[q] - mean) * rstd * ln_w[c0 + q] + ln_b[c0 + q] + bon * v[q]) * g[q];
        u32x4 wv; wv.x = pk2(y[0], y[1]); wv.y = pk2(y[2], y[3]); wv.z = pk2(y[4], y[5]); wv.w = pk2(y[6], y[7]);
        *(u32x4*)(Y + (size_t)m * 512 + c0) = wv;
    }
}

__device__ __forceinline__ void conv8x8(const bf16* src, int tl0  , const float* w  , int wld, const float* bias, float (&out)[8][8]) {
    float x[11][8];
#pragma unroll
    for (int i = 0; i < 11; ++i) { const int tl = tl0 - 3 + i;
        if (tl >= 0) { const u32x4 v = *(const u32x4*)(src + (ptrdiff_t)(i - 3) * PW);
            x[i][0] = bf2f(v.x & 0xffffu); x[i][1] = bf2f(v.x >> 16); x[i][2] = bf2f(v.y & 0xffffu); x[i][3] = bf2f(v.y >> 16); x[i][4] = bf2f(v.z & 0xffffu); x[i][5] = bf2f(v.z >> 16); x[i][6] = bf2f(v.w & 0xffffu); x[i][7] = bf2f(v.w >> 16); }
        else {
#pragma unroll
            for (int ch = 0; ch < 8; ++ch) x[i][ch] = 0.f; } }
    float wv[4][8], bv[8];
#pragma unroll
    for (int j = 0; j < 4; ++j) { const f32x4 a = *(const f32x4*)(w + j * wld), b = *(const f32x4*)(w + j * wld + 4); wv[j][0] = a.x; wv[j][1] = a.y; wv[j][2] = a.z; wv[j][3] = a.w; wv[j][4] = b.x; wv[j][5] = b.y; wv[j][6] = b.z; wv[j][7] = b.w; }
    if (bias) { const f32x4 a = *(const f32x4*)bias, b = *(const f32x4*)(bias + 4); bv[0] = a.x; bv[1] = a.y; bv[2] = a.z; bv[3] = a.w; bv[4] = b.x; bv[5] = b.y; bv[6] = b.z; bv[7] = b.w; }
    else {
#pragma unroll
        for (int ch = 0; ch < 8; ++ch) bv[ch] = 0.f; }
#pragma unroll
    for (int i = 0; i < 8; ++i)
#pragma unroll
        for (int ch = 0; ch < 8; ++ch) { const float a = bv[ch] + wv[0][ch] * x[i][ch] + wv[1][ch] * x[i + 1][ch] + wv[2][ch] * x[i + 2][ch] + wv[3][ch] * x[i + 3][ch]; out[i][ch] = a * fast_rcp(1.0f + fast_exp(-a)); }
}
__device__ __forceinline__ u32x4 pack8(const float* v) { u32x4 o; o.x = pk2(v[0], v[1]); o.y = pk2(v[2], v[3]); o.z = pk2(v[4], v[5]); o.w = pk2(v[6], v[7]); return o; }
constexpr int SB = 136;
constexpr int SC_IMG = 64 * SB * 2;
__device__ __forceinline__ void phase_ssd_s1(const Frame& F, const Args& A, int layer) {
    const bf16* P = WSP(bf16, A_P); bf16* ST = WSP(bf16, S_ST); float* YD = WSP(float, S_YD); unsigned char* SCB = WSP(unsigned char, S_C); float* AC = WSP(float, S_AC);
    const float* cw = A.in[23] + (size_t)layer * 4 * 1024; const float* cb = A.in[24] + layer * 1024; const float* dtb = A.in[25] + layer * 8; const float* a_log = A.in[26] + layer * 8; const float* dsk = A.in[27] + layer * 8;
    LAS bf16* Bt_ = (LAS bf16*)F.lds; LAS bf16* Ct_ = Bt_ + 64 * SB; LAS bf16* BT = Ct_ + 64 * SB; LAS bf16* xT = BT + 128 * RS;
    LAS bf16* Mb = xT + 4 * 64 * RS; LAS bf16* xdT = Mb + 2 * 64 * RS; LAS float* dt = (LAS float*)(xdT + 2 * 64 * RS); LAS float* ac = dt + 256;
    const int tid = F.tid, lane = F.lane, w = F.wave, l15 = lane & 15, q4 = lane >> 4;
    const int nunits = BH * NCH * 2;
    for (int unit = F.bid; unit < nunits; unit += F.G) {
        const int g = unit & 1, c = (unit >> 1) % NCH, b = unit / (2 * NCH);
        const size_t tok0 = (size_t)b * SEQ + (size_t)c * 64;
        __syncthreads();
        {
            const int cg = tid & 63, rb = tid >> 6;
            const int cidx = cg < 32 ? g * 256 + 8 * cg : cg < 48 ? 512 + g * 128 + 8 * (cg - 32) : 768 + g * 128 + 8 * (cg - 48);
            float o[8][8];
            conv8x8(P + (tok0 + 8 * rb) * PW + C_SSD + 512 + cidx, c * 64 + 8 * rb, cw + cidx, 1024, cb + cidx, o);
            if (cg < 32) {
                const int hh = cg >> 3, p0 = 8 * (cg & 7);
#pragma unroll
                for (int ch = 0; ch < 8; ++ch) { float col[8];
#pragma unroll
                    for (int i = 0; i < 8; ++i) col[i] = o[i][ch];
                    *(LAS u32x4*)(xT + (hh * 64 + p0 + ch) * RS + 8 * rb) = pack8(col); }
            } else if (cg < 48) {
                const int n0 = 8 * (cg - 32);
#pragma unroll
                for (int i = 0; i < 8; ++i) *(LAS u32x4*)(Bt_ + (8 * rb + i) * SB + n0) = pack8(o[i]);
#pragma unroll
                for (int ch = 0; ch < 8; ++ch) { float col[8];
#pragma unroll
                    for (int i = 0; i < 8; ++i) col[i] = o[i][ch];
                    *(LAS u32x4*)(BT + (n0 + ch) * RS + 8 * rb) = pack8(col); }
            } else { const int n0 = 8 * (cg - 48);
#pragma unroll
                for (int i = 0; i < 8; ++i) *(LAS u32x4*)(Ct_ + (8 * rb + i) * SB + n0) = pack8(o[i]); }
        }
        if (tid < 256) { const int hh = tid >> 6, h = 4 * g + hh; const float d = softplusf_(bf2f(P[(tok0 + lane) * PW + C_SSD + 1536 + h]) + dtb[h]); float a = -expf(a_log[h]) * d;
#pragma unroll
            for (int o = 1; o < 64; o <<= 1) { const float t = __shfl_up(a, o); if (lane >= o) a += t; }
            dt[tid] = d; ac[tid] = a; AC[(tok0 + lane) * 8 + h] = a; }
        __syncthreads();
        { unsigned char* dst = SCB + (size_t)unit * SC_IMG; for (int e = tid; e < SC_IMG / 16; e += 512) ((u32x4*)dst)[e] = ((const LAS u32x4*)Ct_)[e]; }
        f32x4 cbt[2];
#pragma unroll
        for (int tt = 0; tt < 2; ++tt) { const int tile = w * 2 + tt, ti = tile >> 2, tj = tile & 3; cbt[tt] = (f32x4){0.f, 0.f, 0.f, 0.f};
            if (tj <= ti) cbt[tt] = tile_bf(Ct_ + 16 * ti * SB, SB, Bt_ + 16 * tj * SB, SB, 128, cbt[tt], l15, q4); }
        for (int hh = 0; hh < 4; ++hh) { const int h = 4 * g + hh; LAS bf16* M = Mb + (hh & 1) * 64 * RS; LAS bf16* xd = xdT + (hh & 1) * 64 * RS; const LAS float* dth = dt + hh * 64; const LAS float* ach = ac + hh * 64;
#pragma unroll
            for (int tt = 0; tt < 2; ++tt) { const int tile = w * 2 + tt, ti = tile >> 2, tj = tile & 3;
#pragma unroll
                for (int r = 0; r < 4; ++r) { const int l = 16 * ti + 4 * q4 + r, s = 16 * tj + l15; M[l * RS + s] = (bf16)f2bf((s <= l) ? cbt[tt][r] * expf(ach[l] - ach[s]) * dth[s] : 0.f); } }
            { const int p = tid >> 3, l0 = 8 * (tid & 7); const u32x4 v = *(const LAS u32x4*)(xT + (hh * 64 + p) * RS + l0); const float a63 = ach[63]; float xv[8] = {bf2f(v.x & 0xffffu), bf2f(v.x >> 16), bf2f(v.y & 0xffffu), bf2f(v.y >> 16), bf2f(v.z & 0xffffu), bf2f(v.z >> 16), bf2f(v.w & 0xffffu), bf2f(v.w >> 16)};
#pragma unroll
              for (int i = 0; i < 8; ++i) xv[i] *= dth[l0 + i] * expf(a63 - ach[l0 + i]);
              *(LAS u32x4*)(xd + p * RS + l0) = pack8(xv); }
            __syncthreads();
#pragma unroll
            for (int tt = 0; tt < 2; ++tt) { const int tile = w * 2 + tt, ti = tile >> 2, tj = tile & 3;
                const f32x4 acc = tile_bf(M + 16 * ti * RS, RS, xT + (hh * 64 + 16 * tj) * RS, RS, 64, (f32x4){0.f, 0.f, 0.f, 0.f}, l15, q4);
                const f32x4 xs = ld_bf16x4((const bf16*)(xT + (hh * 64 + 16 * tj + l15) * RS + 16 * ti + 4 * q4));
#pragma unroll
                for (int r = 0; r < 4; ++r) YD[(tok0 + 16 * ti + 4 * q4 + r) * 512 + h * 64 + 16 * tj + l15] = acc[r] + dsk[h] * xs[r]; }
            bf16* st = ST + ((size_t)((b * NCH + c) * 8 + h)) * 64 * 128;
#pragma unroll
            for (int tt = 0; tt < 4; ++tt) { const int tile = w * 4 + tt, ti = tile >> 2, tj = tile & 3;
                const f32x4 acc = tile_bf(BT + 16 * ti * RS, RS, xd + 16 * tj * RS, RS, 64, (f32x4){0.f, 0.f, 0.f, 0.f}, l15, q4);
                st_bf16x4(st + (16 * tj + l15) * 128 + 16 * ti + 4 * q4, acc); }
        }
    }
    __syncthreads();
}
__device__ __forceinline__ void phase_ssd_s23(const Frame& F, const Args& A) {
    const bf16* ST = WSP(bf16, S_ST); float* YD = WSP(float, S_YD); const unsigned char* SCB = WSP(unsigned char, S_C); const float* AC = WSP(float, S_AC);
    LAS bf16* Cimg = (LAS bf16*)F.lds; LAS bf16* Hb = Cimg + 2 * 64 * SB;
    const int tid = F.tid, lane = F.lane, w = F.wave, l15 = lane & 15, q4 = lane >> 4;
    const int nunits = BH * 8 * 4, hp = tid >> 5, hn = 4 * (tid & 31);
    constexpr int NCK = SC_IMG / 16;
    for (int unit = F.bid; unit < nunits; unit += F.G) {
        const int ps = unit & 3, h = (unit >> 2) & 7, b = unit >> 5, g = h >> 2;
        __syncthreads();
        f32x4 Hr = (f32x4){0.f, 0.f, 0.f, 0.f};
        u32x4 pre[3]; u32x2 pst;
        { const unsigned char* src = SCB + (size_t)((b * NCH + 0) * 2 + g) * SC_IMG;
#pragma unroll
          for (int q = 0; q < 3; ++q) { const int e = tid + 512 * q; if (e < NCK) ((LAS u32x4*)Cimg)[e] = *(const u32x4*)(src + (size_t)e * 16); } }
        pst = *(const u32x2*)(ST + ((size_t)((b * NCH + 0) * 8 + h)) * 8192 + (16 * ps + hp) * 128 + hn);
        for (int c = 0; c < NCH; ++c) {
            const size_t tok0 = (size_t)b * SEQ + (size_t)c * 64;
            const u32x2 stc = pst;
            if (c + 1 < NCH) { const unsigned char* src = SCB + (size_t)((b * NCH + c + 1) * 2 + g) * SC_IMG;
#pragma unroll
                for (int q = 0; q < 3; ++q) { const int e = tid + 512 * q; if (e < NCK) pre[q] = *(const u32x4*)(src + (size_t)e * 16); }
                pst = *(const u32x2*)(ST + ((size_t)((b * NCH + c + 1) * 8 + h)) * 8192 + (16 * ps + hp) * 128 + hn); }
            st_bf16x4((bf16*)(Hb + hp * SB + hn), Hr);
            __syncthreads();
            if (w < 4) { const LAS bf16* Ci = Cimg + (c & 1) * 64 * SB;
                const f32x4 acc = tile_bf(Ci + 16 * w * SB, SB, Hb, SB, 128, (f32x4){0.f, 0.f, 0.f, 0.f}, l15, q4);
#pragma unroll
                for (int r = 0; r < 4; ++r) { const size_t tok = tok0 + 16 * w + 4 * q4 + r; const size_t o = tok * 512 + h * 64 + 16 * ps + l15; YD[o] += acc[r] * expf(AC[tok * 8 + h]); } }
            { const float dec = expf(AC[(tok0 + 63) * 8 + h]); Hr.x = dec * Hr.x + bf2f(stc.x & 0xffffu); Hr.y = dec * Hr.y + bf2f(stc.x >> 16); Hr.z = dec * Hr.z + bf2f(stc.y & 0xffffu); Hr.w = dec * Hr.w + bf2f(stc.y >> 16); }
            if (c + 1 < NCH) { LAS u32x4* dst = (LAS u32x4*)(Cimg + ((c + 1) & 1) * 64 * SB);
#pragma unroll
                for (int q = 0; q < 3; ++q) { const int e = tid + 512 * q; if (e < NCK) dst[e] = pre[q]; } }
            __syncthreads();
        }
    }
    __syncthreads();
}
__device__ __forceinline__ void phase_ssd_s4(const Frame& F, const Args& A, int layer) {
    const float* YD = WSP(float, S_YD); const bf16* P = WSP(bf16, A_P); bf16* Y = WSP(bf16, A_Y) + (size_t)3 * TH * 512; const float* nw = A.in[28] + layer * 512;
    const int lane = F.lane, c0 = 8 * lane;
    for (int m = F.gw; m < TH; m += F.NGW) {
        const f32x4 a = *(const f32x4*)(YD + (size_t)m * 512 + c0), b2 = *(const f32x4*)(YD + (size_t)m * 512 + c0 + 4);
        const f32x4 z0 = ld_bf16x4(P + (size_t)m * PW + C_SSD + c0), z1 = ld_bf16x4(P + (size_t)m * PW + C_SSD + c0 + 4);
        float y[8] = {a.x * siluf_(z0.x), a.y * siluf_(z0.y), a.z * siluf_(z0.z), a.w * siluf_(z0.w), b2.x * siluf_(z1.x), b2.y * siluf_(z1.y), b2.z * siluf_(z1.z), b2.w * siluf_(z1.w)};
        float ss = 0.f;
#pragma unroll
        for (int q = 0; q < 8; ++q) ss += y[q] * y[q];
        ss += __shfl_xor(ss, 1); ss += __shfl_xor(ss, 2); ss += __shfl_xor(ss, 4); ss += __shfl_xor(ss, 8); ss += __shfl_xor(ss, 16);
        const float rstd = 1.0f / sqrtf(ss * (1.0f / 256.0f) + EPS);
#pragma unroll
        for (int q = 0; q < 8; ++q) y[q] = y[q] * rstd * nw[c0 + q];
        u32x4 wv; wv.x = pk2(y[0], y[1]); wv.y = pk2(y[2], y[3]); wv.z = pk2(y[4], y[5]); wv.w = pk2(y[6], y[7]);
        *(u32x4*)(Y + (size_t)m * 512 + c0) = wv;
    }
}

__device__ __forceinline__ f32x4 tile_mm(const LAS float* a, int lda, int ska, const LAS float* b, int ldb, int scb, int K, f32x4 acc, int l15, int q4) {
    const LAS float* ap = a + l15 * lda + q4 * ska; const LAS float* bp = b + q4 * ldb + l15 * scb;
#pragma unroll 8
    for (int ks = 0; ks < K / 4; ++ks) acc = MFMA_F32(ap[ks * 4 * ska], bp[ks * 4 * ldb], acc);
    return acc;
}
constexpr int GS = 132, GS2 = 68;
constexpr int GR_W = 0, GR_QH = 64 * 136 * 2, GR_KT = 2 * 64 * 136 * 2, GR_QK = GR_KT + 128 * 72 * 2, GR_GL = GR_QK + 64 * 72 * 2, GR_COMMON = GR_GL + 16, GR_USL = 64 * 20 * 4, GR_BYTES = GR_COMMON + 8 * GR_USL;
static_assert(GR_BYTES == 103440 && GR_COMMON % 16 == 0, "GDN record");
constexpr int GX = 264;
__device__ __forceinline__ void phase_gdn_g1(const Frame& F, const Args& A, int layer) {
    const bf16* P = WSP(bf16, A_P); unsigned char* CHR = WSP(unsigned char, G_CH);
    const float* convw = A.in[19] + (size_t)layer * 4 * 1536; const float* a_log = A.in[20] + layer * 4; const float* dtb = A.in[21] + layer * 4;
    LAS bf16* qb = (LAS bf16*)F.lds; LAS bf16* kb = qb + 64 * SB; LAS bf16* qkimg = kb + 64 * SB;
    LAS float* X = (LAS float*)(qkimg + 64 * RS); LAS float* Lm = X + 64 * GX; LAS float* ssq = Lm + 64 * GS2;
    LAS float* beta = ssq + 2 * 64 * 16; LAS float* gc = beta + 64; LAS float* egc = gc + 64; LAS float* inorm = egc + 64;
    const int tid = F.tid, lane = F.lane, w = F.wave, l15 = lane & 15, q4 = lane >> 4;
    const int nunits = BH * 4 * NCH;
    for (int unit = F.bid; unit < nunits; unit += F.G) {
        const int c = unit % NCH, h = (unit / NCH) & 3, b = unit / (NCH * 4);
        const size_t tok0 = (size_t)b * SEQ + (size_t)c * 64;
        unsigned char* rec = CHR + (size_t)unit * GR_BYTES;
        __syncthreads();
        const int rb = tid / 48, pc = tid % 48, part = pc >> 4, cgl = pc & 15;
        float o[8][8];
        if (tid < 384) { const int col = part * 512 + h * 128 + 8 * cgl;
            conv8x8(P + (tok0 + 8 * rb) * PW + C_GDN + col, c * 64 + 8 * rb, convw + col, 1536, nullptr, o);
            if (part < 2) {
#pragma unroll
                for (int i = 0; i < 8; ++i) { float sacc = 0.f;
#pragma unroll
                    for (int ch = 0; ch < 8; ++ch) sacc += o[i][ch] * o[i][ch];
                    ssq[(part * 64 + 8 * rb + i) * 16 + cgl] = sacc; } } }
        if (w == 7) { const size_t tok = tok0 + lane; beta[lane] = sigmoidf_(bf2f(P[tok * PW + C_GDN + 1536 + h]));
            float g = -expf(a_log[h]) * softplusf_(bf2f(P[tok * PW + C_GDN + 1540 + h]) + dtb[h]);
#pragma unroll
            for (int o2 = 1; o2 < 64; o2 <<= 1) { const float t = __shfl_up(g, o2); if (lane >= o2) g += t; }
            gc[lane] = g; egc[lane] = expf(g); }
        __syncthreads();
        if (tid < 128) { float sacc = 0.f;
#pragma unroll
            for (int i = 0; i < 16; ++i) sacc += ssq[tid * 16 + i];
            inorm[tid] = (tid < 64 ? 0.08838834764831845f : 1.0f) / sqrtf(sacc + EPS); }
        __syncthreads();
        if (tid < 384) {
#pragma unroll
            for (int i = 0; i < 8; ++i) { const int l = 8 * rb + i;
                if (part < 2) { const float sc = inorm[part * 64 + l]; float v[8];
#pragma unroll
                    for (int ch = 0; ch < 8; ++ch) v[ch] = o[i][ch] * sc;
                    *(LAS u32x4*)((part ? kb : qb) + l * SB + 8 * cgl) = pack8(v); }
                else { const float bl = beta[l]; *(LAS f32x4*)(X + l * GX + 8 * cgl) = (f32x4){o[i][0] * bl, o[i][1] * bl, o[i][2] * bl, o[i][3] * bl}; *(LAS f32x4*)(X + l * GX + 8 * cgl + 4) = (f32x4){o[i][4] * bl, o[i][5] * bl, o[i][6] * bl, o[i][7] * bl}; } } }
        __syncthreads();
        for (int tt = 0; tt < 4; ++tt) { const int tile = w * 4 + tt, which = tile >> 4, ti = (tile >> 2) & 3, tj = tile & 3;
            f32x4 acc = (f32x4){0.f, 0.f, 0.f, 0.f};
            if (tj <= ti) acc = tile_bf((which ? qb : kb) + 16 * ti * SB, SB, kb + 16 * tj * SB, SB, 128, acc, l15, q4);
#pragma unroll
            for (int r = 0; r < 4; ++r) { const int i = 16 * ti + 4 * q4 + r, j = 16 * tj + l15; float v = 0.f;
                if (which ? (j <= i) : (j < i)) v = acc[r] * expf(gc[i] - gc[j]) * (which ? 1.0f : beta[i]);
                if (which) qkimg[i * RS + j] = (bf16)f2bf(v); else Lm[i * GS2 + j] = v; } }
        { const float glast = gc[63];
          for (int e = tid; e < 64 * 16; e += 512) { const int l = e >> 4, d0 = 8 * (e & 15); const u32x4 kv = *(const LAS u32x4*)(kb + l * SB + d0), qv = *(const LAS u32x4*)(qb + l * SB + d0);
              const float kf[8] = {bf2f(kv.x & 0xffffu), bf2f(kv.x >> 16), bf2f(kv.y & 0xffffu), bf2f(kv.y >> 16), bf2f(kv.z & 0xffffu), bf2f(kv.z >> 16), bf2f(kv.w & 0xffffu), bf2f(kv.w >> 16)};
              float qf[8] = {bf2f(qv.x & 0xffffu), bf2f(qv.x >> 16), bf2f(qv.y & 0xffffu), bf2f(qv.y >> 16), bf2f(qv.z & 0xffffu), bf2f(qv.z >> 16), bf2f(qv.w & 0xffffu), bf2f(qv.w >> 16)};
              const float sc = beta[l] * egc[l], eg = egc[l];
              *(LAS f32x4*)(X + l * GX + 128 + d0) = (f32x4){kf[0] * sc, kf[1] * sc, kf[2] * sc, kf[3] * sc}; *(LAS f32x4*)(X + l * GX + 132 + d0) = (f32x4){kf[4] * sc, kf[5] * sc, kf[6] * sc, kf[7] * sc};
#pragma unroll
              for (int q = 0; q < 8; ++q) qf[q] *= eg;
              *(u32x4*)(rec + GR_QH + (size_t)(l * SB + d0) * 2) = pack8(qf); }
          for (int e = tid; e < 128 * 8; e += 512) { const int d = e >> 3, l0 = 8 * (e & 7); float kt[8];
#pragma unroll
              for (int q = 0; q < 8; ++q) kt[q] = bf2f(kb[(l0 + q) * SB + d]) * expf(glast - gc[l0 + q]);
              *(u32x4*)(rec + GR_KT + (size_t)(d * RS + l0) * 2) = pack8(kt); }
          if (tid == 0) *(float*)(rec + GR_GL) = expf(glast); }
        __syncthreads();
        for (int e = tid; e < 64 * RS / 8; e += 512) ((u32x4*)(rec + GR_QK))[e] = ((const LAS u32x4*)qkimg)[e];
        for (int rbk = 0; rbk < 4; ++rbk) {
            if (rbk > 0) {
#pragma unroll
                for (int t2 = 0; t2 < 2; ++t2) { const int tj = 2 * w + t2;
                    const f32x4 acc = tile_mm(Lm + 16 * rbk * GS2, GS2, 1, X + 16 * tj, GX, 1, 16 * rbk, (f32x4){0.f, 0.f, 0.f, 0.f}, l15, q4);
#pragma unroll
                    for (int r = 0; r < 4; ++r) X[(16 * rbk + 4 * q4 + r) * GX + 16 * tj + l15] -= acc[r]; }
                __syncthreads();
            }
            if (tid < 256) { float x[16];
#pragma unroll
                for (int i = 0; i < 16; ++i) { float sacc = X[(16 * rbk + i) * GX + tid];
#pragma unroll
                    for (int j = 0; j < i; ++j) sacc -= Lm[(16 * rbk + i) * GS2 + 16 * rbk + j] * x[j];
                    x[i] = sacc; }
#pragma unroll
                for (int i = 0; i < 16; ++i) X[(16 * rbk + i) * GX + tid] = x[i]; }
            __syncthreads();
        }
        for (int e = tid; e < 64 * 16; e += 512) { const int l = e >> 4, d0 = 8 * (e & 15); const f32x4 a = *(const LAS f32x4*)(X + l * GX + 128 + d0), b2 = *(const LAS f32x4*)(X + l * GX + 132 + d0);
            const float v[8] = {a.x, a.y, a.z, a.w, b2.x, b2.y, b2.z, b2.w}; *(u32x4*)(rec + GR_W + (size_t)(l * SB + d0) * 2) = pack8(v); }
        for (int e = tid; e < 64 * 32; e += 512) { const int l = e >> 5, c4 = 4 * (e & 31); *(f32x4*)(rec + GR_COMMON + (size_t)(c4 >> 4) * GR_USL + (size_t)(l * 20 + (c4 & 15)) * 4) = *(const LAS f32x4*)(X + l * GX + c4); }
    }
    __syncthreads();
}
constexpr int G2_STAGE = GR_COMMON + GR_USL;
__device__ __forceinline__ void phase_gdn_g2(const Frame& F, const Args& A) {
    const unsigned char* CHR = WSP(unsigned char, G_CH); float* GO = WSP(float, G_O);
    LAS unsigned char* buf0 = F.lds; LAS bf16* STt = (LAS bf16*)(F.lds + 2 * G2_STAGE); LAS bf16* vnT = STt + 2 * 16 * SB;
    const int tid = F.tid, lane = F.lane, w = F.wave, l15 = lane & 15, q4 = lane >> 4;
    const int nunits = BH * 4 * 8;
    constexpr int NCK = G2_STAGE / 16;
    for (int unit = F.bid; unit < nunits; unit += F.G) {
        const int vs = unit & 7, h = (unit >> 3) & 3, b = unit >> 5;
        __syncthreads();
        for (int e = tid; e < 2 * 16 * SB / 2; e += 512) ((LAS unsigned*)STt)[e] = 0u;
        f32x4 Sreg = (f32x4){0.f, 0.f, 0.f, 0.f};
        u32x4 pre[9];
        { const unsigned char* rec = CHR + (size_t)((b * 4 + h) * NCH) * GR_BYTES;
#pragma unroll
          for (int q = 0; q < 9; ++q) { const int e = tid + 512 * q; if (e < NCK) { const size_t off = (size_t)e * 16; *(LAS u32x4*)(buf0 + off) = *(const u32x4*)(rec + (off < GR_COMMON ? off : off + (size_t)vs * GR_USL)); } } }
        __syncthreads();
        for (int c = 0; c < NCH; ++c) {
            LAS unsigned char* buf = buf0 + (c & 1) * G2_STAGE; LAS unsigned char* nbuf = buf0 + ((c + 1) & 1) * G2_STAGE;
            if (c + 1 < NCH) { const unsigned char* rec = CHR + (size_t)((b * 4 + h) * NCH + c + 1) * GR_BYTES;
#pragma unroll
                for (int q = 0; q < 9; ++q) { const int e = tid + 512 * q; if (e < NCK) { const size_t off = (size_t)e * 16; pre[q] = *(const u32x4*)(rec + (off < GR_COMMON ? off : off + (size_t)vs * GR_USL)); } } }
            const LAS bf16* Wi = (const LAS bf16*)(buf + GR_W); const LAS bf16* QH = (const LAS bf16*)(buf + GR_QH); const LAS bf16* KT = (const LAS bf16*)(buf + GR_KT); const LAS bf16* QK = (const LAS bf16*)(buf + GR_QK);
            const float egl = *(const LAS float*)(buf + GR_GL); const LAS float* U = (const LAS float*)(buf + GR_COMMON);
            const LAS bf16* S0 = STt + (c & 1) * 16 * SB; LAS bf16* S1 = STt + ((c + 1) & 1) * 16 * SB;
            if (w < 4) {
                const f32x4 acc = tile_bf(Wi + 16 * w * SB, SB, S0, SB, 128, (f32x4){0.f, 0.f, 0.f, 0.f}, l15, q4);
                f32x4 vn;
#pragma unroll
                for (int r = 0; r < 4; ++r) vn[r] = U[(16 * w + 4 * q4 + r) * 20 + l15] - acc[r];
                u32x2 pk; pk.x = pk2(vn[0], vn[1]); pk.y = pk2(vn[2], vn[3]); *(LAS u32x2*)(vnT + l15 * RS + 16 * w + 4 * q4) = pk; }
            __syncthreads();
            if (w < 4) {
                f32x4 acc = tile_bf(QH + 16 * w * SB, SB, S0, SB, 128, (f32x4){0.f, 0.f, 0.f, 0.f}, l15, q4);
                acc = tile_bf(QK + 16 * w * RS, RS, vnT, RS, 64, acc, l15, q4);
#pragma unroll
                for (int r = 0; r < 4; ++r) GO[((size_t)b * SEQ + (size_t)c * 64 + 16 * w + 4 * q4 + r) * 512 + h * 128 + 16 * vs + l15] = acc[r]; }
            Sreg = Sreg * egl;
            Sreg = tile_bf(KT + 16 * w * RS, RS, vnT, RS, 64, Sreg, l15, q4);
            { u32x2 pk; pk.x = pk2(Sreg[0], Sreg[1]); pk.y = pk2(Sreg[2], Sreg[3]); *(LAS u32x2*)(S1 + l15 * SB + 16 * w + 4 * q4) = pk; }
            if (c + 1 < NCH) {
#pragma unroll
                for (int q = 0; q < 9; ++q) { const int e = tid + 512 * q; if (e < NCK) *(LAS u32x4*)(nbuf + (size_t)e * 16) = pre[q]; } }
            __syncthreads();
        }
    }
    __syncthreads();
}
__device__ __forceinline__ void phase_gdn_g3(const Frame& F, const Args& A, int layer) {
    const float* GO = WSP(float, G_O); const bf16* P = WSP(bf16, A_P); bf16* Y = WSP(bf16, A_Y) + (size_t)2 * TH * 512; const float* nw = A.in[22] + layer * 128;
    const int lane = F.lane, c0 = 8 * lane;
    for (int m = F.gw; m < TH; m += F.NGW) {
        const f32x4 a = *(const f32x4*)(GO + (size_t)m * 512 + c0), b2 = *(const f32x4*)(GO + (size_t)m * 512 + c0 + 4);
        float o[8] = {a.x, a.y, a.z, a.w, b2.x, b2.y, b2.z, b2.w}; float ss = 0.f;
#pragma unroll
        for (int q = 0; q < 8; ++q) ss += o[q] * o[q];
        ss += __shfl_xor(ss, 1); ss += __shfl_xor(ss, 2); ss += __shfl_xor(ss, 4); ss += __shfl_xor(ss, 8);
        const float rstd = 1.0f / sqrtf(ss * (1.0f / 128.0f) + EPS);
        const f32x4 z0 = ld_bf16x4(P + (size_t)m * PW + C_GDN + 1544 + c0), z1 = ld_bf16x4(P + (size_t)m * PW + C_GDN + 1544 + c0 + 4);
        const float z[8] = {z0.x, z0.y, z0.z, z0.w, z1.x, z1.y, z1.z, z1.w}; float y[8];
#pragma unroll
        for (int q = 0; q < 8; ++q) y[q] = o[q] * rstd * nw[(c0 + q) & 127] * siluf_(z[q]);
        u32x4 wv; wv.x = pk2(y[0], y[1]); wv.y = pk2(y[2], y[3]); wv.z = pk2(y[4], y[5]); wv.w = pk2(y[6], y[7]);
        *(u32x4*)(Y + (size_t)m * 512 + c0) = wv;
    }
}

__device__ __forceinline__ void phase_merge_z(const Frame& F, const Args& A) {
    pg8::Gemm g{WSP(bf16, A_Y), WSP(bf16, W_BR), 512, 512}; BranchOrder S; S.nP = TH / 256; S.G = F.G; S.c = F.bid;
    EpiZ E{WSP(bf16, A_Z)}; pg8::gemm_phase(F.lds, g, S, E, F.tid);
}
__device__ __forceinline__ void phase_merge_gate(const Frame& F, const Args& A, int layer) {
    pg8::Gemm g{WSP(bf16, A_H), WSP(bf16, W_GATE), D, D}; pg8::StaticOrder S; S.init(TH, 4096, F.G, F.bid);
    EpiMerge E{WSP(bf16, A_Z), A.in[29] + (size_t)layer * 4 * D, WSP(bf16, A_MG)}; pg8::gemm_phase(F.lds, g, S, E, F.tid);
}
__device__ __forceinline__ void phase_merge_out(const Frame& F, const Args& A, const float* xin, float* xout) {
    pg8::Gemm g{WSP(bf16, A_MG), WSP(bf16, W_OUT), D, D}; pg8::StaticOrder S; S.init(TH, D, F.G, F.bid);
    EpiResidual E{xin, xout}; pg8::gemm_phase(F.lds, g, S, E, F.tid);
}
__device__ __forceinline__ void phase_ffn_gu(const Frame& F, const Args& A) {
    pg8::Gemm g{WSP(bf16, A_H), WSP(bf16, W_FGU), D, D}; pg8::StaticOrder S; S.init(TH, 2 * FF_D, F.G, F.bid);
    EpiSwiGLU E{WSP(bf16, F_ACT), FF_D, 1 << 20}; pg8::gemm_phase(F.lds, g, S, E, F.tid);
}
__device__ __forceinline__ void phase_ffn_down(const Frame& F, const Args& A, float* x) {
    pg8::Gemm g{WSP(bf16, F_ACT), WSP(bf16, W_FDN), FF_D, FF_D}; pg8::StaticOrder S; S.init(TH, D, F.G, F.bid);
    EpiResidual E{x, x}; pg8::gemm_phase(F.lds, g, S, E, F.tid);
}
struct MoeLayout { int pstart[NEXP + 1]; };
__device__ __forceinline__ MoeLayout moe_layout(const unsigned* cnt) {
    MoeLayout L; int s = 0;
#pragma unroll
    for (int e = 0; e < NEXP; ++e) { L.pstart[e] = s; s += ((int)cnt[e] + 255) & ~255; }
    L.pstart[NEXP] = s; return L;
}
struct MoeOrder {
    int np, nN, G, c; MoeLayout L;
    __device__ bool next(int i, Unit& u) const {
        const long Lx = (long)i * G + c; if (Lx >= (long)np * nN) return false;
        const int pm = (int)(Lx / nN), pn = (int)(Lx % nN); int e = 0;
#pragma unroll
        for (int k = 1; k < NEXP; ++k) if (pm * 256 >= L.pstart[k]) e = k;
        u.pm = pm; u.pn = e * nN + pn; return true;
    }
    __device__ __forceinline__ void a_ready(const Unit&) const {}
    __device__ __forceinline__ void done(const Unit&) const {}
};
__device__ __forceinline__ void phase_moe_route(const Frame& F, const Args& A, int half) {
    const unsigned* cnt = F.ctl + CW_CNT + half * 16; unsigned* fill = F.ctl + CW_FILL + half * 16;
    const MoeLayout L = moe_layout(cnt);
    const bf16* H = WSP(bf16, A_H); bf16* GA = WSP(bf16, F_GA); const int* tope = WSP(int, F_TOPE); int* slot = WSP(int, F_SLOT);
    const int lane = F.lane;
    for (int m = F.gw; m < TH; m += F.NGW) {
        const u32x4 v0 = *(const u32x4*)(H + (size_t)m * D + 8 * lane), v1 = *(const u32x4*)(H + (size_t)m * D + 512 + 8 * lane);
#pragma unroll
        for (int k = 0; k < 2; ++k) { const int e = tope[2 * m + k]; int s = 0;
            int ps = 0;
#pragma unroll
            for (int q = 0; q < NEXP; ++q) ps = (e == q) ? L.pstart[q] : ps;
            if (lane == 0) s = ps + (int)ATOMIC_ADD_U32(fill + e, 1u);
            s = __shfl(s, 0);
            if (lane == 0) slot[2 * m + k] = s;
            *(u32x4*)(GA + (size_t)s * D + 8 * lane) = v0; *(u32x4*)(GA + (size_t)s * D + 512 + 8 * lane) = v1; }
    }
#pragma unroll
    for (int e = 0; e < NEXP; ++e) { const int r0 = L.pstart[e] + (int)cnt[e], r1 = L.pstart[e + 1];
        for (int r = r0 + F.gw; r < r1; r += F.NGW) { *(u32x4*)(GA + (size_t)r * D + 8 * lane) = (u32x4){0u, 0u, 0u, 0u}; *(u32x4*)(GA + (size_t)r * D + 512 + 8 * lane) = (u32x4){0u, 0u, 0u, 0u}; } }
}
__device__ __forceinline__ void phase_moe_gu(const Frame& F, const Args& A, int half) {
    MoeOrder S; S.L = moe_layout(F.ctl + CW_CNT + half * 16); S.np = S.L.pstart[NEXP] / 256; S.nN = 2 * FF_E / 256; S.G = F.G; S.c = F.bid;
    pg8::Gemm g{WSP(bf16, F_GA), WSP(bf16, W_FGU), D, D}; EpiSwiGLU E{WSP(bf16, F_ACT), FF_E, 2 * FF_E / 256}; pg8::gemm_phase(F.lds, g, S, E, F.tid);
}
struct EpiF32Mod {
    static constexpr bool PERM = false, AFTER_DRAIN = false;
    float* C;
    __device__ __forceinline__ void operator()(const f32x4 (&acc)[2][2][4][2], const Unit& u, int wr, int wc, int fr, int fq) const {
        const int row0 = u.pm * 256 + wr * 64 + fr, col0 = (u.pn & 3) * 256 + wc * 32 + 4 * fq;
#pragma unroll
        for (int ai = 0; ai < 2; ++ai)
#pragma unroll
            for (int m = 0; m < 4; ++m) { float* rowp = C + (size_t)(row0 + ai * HALFT + m * 16) * D + col0;
#pragma unroll
                for (int bj = 0; bj < 2; ++bj)
#pragma unroll
                    for (int n = 0; n < 2; ++n) *(f32x4*)(rowp + bj * HALFT + n * 16) = acc[ai][bj][m][n]; }
    }
};
__device__ __forceinline__ void phase_moe_down(const Frame& F, const Args& A, int half) {
    MoeOrder S; S.L = moe_layout(F.ctl + CW_CNT + half * 16); S.np = S.L.pstart[NEXP] / 256; S.nN = D / 256; S.G = F.G; S.c = F.bid;
    pg8::Gemm g{WSP(bf16, F_ACT), WSP(bf16, W_FDN), FF_E, FF_E}; EpiF32Mod E{WSP(float, F_YE)}; pg8::gemm_phase(F.lds, g, S, E, F.tid);
}
__device__ __forceinline__ void phase_moe_combine(const Frame& F, const Args& A, float* x) {
    const float* YE = WSP(float, F_YE); const int* slot = WSP(int, F_SLOT); const float* topw = WSP(float, F_TOPW); const int lane = F.lane;
    for (int m = F.gw; m < TH; m += F.NGW) { const int s0 = slot[2 * m], s1 = slot[2 * m + 1]; const float w0 = topw[2 * m], w1 = topw[2 * m + 1];
#pragma unroll
        for (int j = 0; j < 4; ++j) { const int c = 4 * lane + 256 * j; float* xp = x + (size_t)m * D + c;
            *(f32x4*)xp = *(const f32x4*)xp + *(const f32x4*)(YE + (size_t)s0 * D + c) * w0 + *(const f32x4*)(YE + (size_t)s1 * D + c) * w1; } }
}

#ifndef EMU
#define XB_TMO      128
#define XB_XCNT(j)  (256  + 64 * (j))
#define XB_XSUB(j)  (1280 + 64 * (j))
#define XB_XGEN(j)  (2304 + 64 * (j))
#define XB_TOP      3328
#define XB_TOPGEN   3392
#define XCD_BAR_WORDS 3456
#define XB_SPIN_CAP (1u << 22)
__device__ __forceinline__ unsigned xb_ld(unsigned* p)              { return __hip_atomic_load(p, __ATOMIC_RELAXED, __HIP_MEMORY_SCOPE_AGENT); }
__device__ __forceinline__ unsigned xb_add(unsigned* p, unsigned v) { return __hip_atomic_fetch_add(p, v, __ATOMIC_RELAXED, __HIP_MEMORY_SCOPE_AGENT); }
__device__ __forceinline__ unsigned xb_xcc_id() { return (unsigned)__builtin_amdgcn_s_getreg((3 << 11) | 20) & 0xFu; }
#define XB_SPIN(cond, bar) do { unsigned _sp = 0; while (cond) { __builtin_amdgcn_s_sleep(1); \
    if ((++_sp & 255u) == 0u) { if (xb_ld(&(bar)[XB_TMO])) break; if (_sp > XB_SPIN_CAP) { atomicAdd(&(bar)[XB_TMO], 1u); break; } } } } while (0)
struct XcdBarrier { unsigned* bar; unsigned x; volatile LAS unsigned* st; };
__device__ __forceinline__ XcdBarrier xcd_barrier_post(unsigned* bar, volatile LAS unsigned* st) {
    XcdBarrier b; b.bar = bar; b.x = xb_xcc_id(); b.st = st;
    if (threadIdx.x == 0) (void)xb_add(&bar[XB_XCNT(b.x)], 1u);
    return b;
}
__device__ __forceinline__ void xcd_barrier_complete(unsigned* bar, unsigned x, unsigned& nloc, unsigned& nx) {
    const unsigned G = gridDim.x * gridDim.y * gridDim.z;
    unsigned sum, cnt, mine, sp = 0u;
    for (;;) {
        sum = 0u; cnt = 0u; mine = 0u;
#pragma unroll
        for (unsigned j = 0; j < 16; ++j) { const unsigned c = xb_ld(&bar[XB_XCNT(j)]); sum += c; cnt += (c > 0u) ? 1u : 0u; mine = (j == x) ? c : mine; }
        if (sum == G) break;
        __builtin_amdgcn_s_sleep(1);
        if ((++sp & 255u) == 0u) { if (xb_ld(&bar[XB_TMO])) break; if (sp > XB_SPIN_CAP) { atomicAdd(&bar[XB_TMO], 1u); break; } }
    }
    nloc = mine > 0u ? mine : 1u; nx = cnt > 0u ? cnt : 1u;
}
__device__ __forceinline__ void xcd_barrier(const XcdBarrier& b) {
    asm volatile("s_waitcnt vmcnt(0)" ::: "memory");
    __syncthreads();
    if (threadIdx.x == 0) {
        unsigned* bar = b.bar;
        __builtin_amdgcn_s_waitcnt(0);
        unsigned nloc = b.st[0], nx = b.st[1];
        if (nloc == 0u) { xcd_barrier_complete(bar, b.x, nloc, nx); b.st[0] = nloc; b.st[1] = nx; }
        const unsigned old = xb_add(&bar[XB_XSUB(b.x)], 1u);
        const unsigned gen = old / nloc;
        if (old + 1u == (gen + 1u) * nloc) {
            __builtin_amdgcn_fence(__ATOMIC_RELEASE, "agent");
            asm volatile("s_waitcnt vmcnt(0)" ::: "memory");
            const unsigned og = xb_add(&bar[XB_TOP], 1u);
            const unsigned tg = og / nx;
            if (og + 1u == (tg + 1u) * nx) xb_add(&bar[XB_TOPGEN], 1u);
            else XB_SPIN(xb_ld(&bar[XB_TOPGEN]) == tg, bar);
            __builtin_amdgcn_fence(__ATOMIC_ACQUIRE, "agent");
            xb_add(&bar[XB_XGEN(b.x)], 1u);
            asm volatile("s_waitcnt vmcnt(0)" ::: "memory");
        } else {
            XB_SPIN(xb_ld(&bar[XB_XGEN(b.x)]) == gen, bar);
            __builtin_amdgcn_fence(__ATOMIC_ACQUIRE, "agent");
            asm volatile("s_waitcnt vmcnt(0)" ::: "memory");
        }
    }
    __syncthreads();
}
#endif

constexpr int NPH = 25;
constexpr int NPHASES = DEPTH * (1 + NHALF * NPH) + 1;
constexpr int LDS_BYTES = 155648, MISC_OFF = 154624;

__global__ void __launch_bounds__(512, 2) fwd_kernel(Args args_k) {
#ifdef EMU
    unsigned char* lds = emu_lds_ptr;
#else
    extern __shared__ __attribute__((aligned(16))) unsigned char lds[];
#endif
    Frame F0;
    F0.lds = (LAS unsigned char*)lds; F0.tid = threadIdx.x; F0.lane = F0.tid & 63; F0.wave = RFL(F0.tid >> 6); F0.G = gridDim.x; F0.bid = blockIdx.x;
    F0.gw = F0.bid * 8 + F0.wave; F0.NGW = F0.G * 8;
    F0.out = args_k.out; F0.ws = args_k.ws; F0.ctl = (unsigned*)(args_k.ws + WS_CTL);
    const int lo = args_k.lo, hi = args_k.hi;
#ifndef EMU
    volatile LAS unsigned* misc = (volatile LAS unsigned*)(F0.lds + MISC_OFF);
    if (F0.tid < 4) misc[F0.tid] = 0u;
    __syncthreads();
    XcdBarrier bar; bar.bar = F0.ctl + CW_BAR; bar.x = 0; bar.st = misc;
    if (hi - lo > 1) bar = xcd_barrier_post(F0.ctl + CW_BAR, misc);
#define GRID_BAR() do { XcdBarrier bq = bar; asm volatile("" : "+s"(bq.bar), "+s"(bq.x)); xcd_barrier(bq); } while (0)
#else
#define GRID_BAR() do { } while (0)
#endif
    int ph = 0;
#ifndef PH_MASK
#define PH_MASK 0xFFFFFFFFFFFFFFFFull
#endif
#define PHASE(...) PHASE_I(31, __VA_ARGS__)
#ifdef EMU
#define LAUNDER(Fq) do { } while (0)
#else
#define LAUNDER(Fq) do { unsigned mq_ = ~0u; asm volatile("" : "+s"(Fq.G), "+s"(Fq.bid), "+s"(Fq.wave), "+s"(Fq.ws), "+s"(Fq.out), "+s"(Fq.ctl), "+s"(mq_)); Fq.lane = (int)__builtin_amdgcn_mbcnt_hi(mq_, __builtin_amdgcn_mbcnt_lo(mq_, 0u)); Fq.tid = Fq.wave * 64 + Fq.lane; Fq.gw = Fq.bid * 8 + Fq.wave; Fq.NGW = Fq.G * 8; } while (0)
#endif
#ifdef EMU
#define ARGS_Q() const Args& args_q = args_k
#else
#define ARGS_Q() const __attribute__((address_space(4))) Args* aq_ = (const __attribute__((address_space(4))) Args*)__builtin_amdgcn_kernarg_segment_ptr(); asm volatile("" : "+s"(aq_)); const Args& args_q = *(const Args*)aq_
#endif
#ifndef REPEAT_MASK
#define REPEAT_MASK 0u
#endif
#define PHASE_I(kind, ...) do { if (ph >= lo && ph < hi) { constexpr int reps_ = (((REPEAT_MASK) >> (kind)) & 1u) ? 2 : 1; for (int rr_ = 0; rr_ < reps_; ++rr_) { { Frame Fq = F0; LAUNDER(Fq); const Frame& F = Fq; ARGS_Q(); const Args& args = args_q; __VA_ARGS__; } if (rr_ + 1 < reps_ || ph + 1 < hi) { GRID_BAR(); if (((REPEAT_MASK) >> 26) & 1u) GRID_BAR(); } } } ++ph; } while (0)
#define PHASEK(kind, ...) PHASE_I(kind, __VA_ARGS__)
#define SEGMENT(layer, half) do { \
            const size_t r0 = (size_t)(half) * TH; \
            const float* xin = ((layer) == 0 ? args_k.in[0] : F0.out) + r0 * D; float* xo = F0.out + r0 * D; \
            PHASEK(0, phase_norm<false>(F, args, xin, args.in[2] + (layer) * D, WSP(bf16, A_H), nullptr, nullptr, nullptr, nullptr); phase_rope_table(F, args, (const int*)args.in[1] + r0, WSP(float, A_ROPE))); \
            PHASEK(1, { pg8::Gemm g{WSP(bf16, A_H), WSP(bf16, W_IN), D, D}; pg8::StaticOrder S; S.init(TH, PW, F.G, F.bid); EpiBf16 E{WSP(bf16, A_P), PW, nullptr, 0}; pg8::gemm_phase(F.lds, g, S, E, F.tid); }); \
            PHASEK(2, phase_mla_prep(F, args)); \
            PHASEK(3, phase_mla_q(F, args)); \
            PHASEK(4, phase_mla_kv(F, args)); \
            PHASEK(5, phase_attention(F, args)); \
            PHASEK(6, phase_rwkv_prep(F, args, layer)); \
            PHASEK(7, phase_rwkv_lora(F, args)); \
            PHASEK(8, phase_rwkv_r1(F, args, layer)); \
            PHASEK(24, phase_rwkv_r2(F, args)); \
            PHASEK(9, phase_rwkv_post(F, args, layer)); \
            PHASEK(10, phase_gdn_g1(F, args, layer)); \
            PHASEK(11, phase_gdn_g2(F, args)); \
            PHASEK(12, phase_gdn_g3(F, args, layer)); \
            PHASEK(13, phase_ssd_s1(F, args, layer)); \
            PHASEK(14, phase_ssd_s23(F, args)); \
            PHASEK(16, phase_ssd_s4(F, args, layer)); \
            PHASEK(17, phase_merge_z(F, args)); \
            PHASEK(18, phase_merge_gate(F, args, layer)); \
            PHASEK(19, phase_merge_out(F, args, xin, xo)); \
            if ((layer) == 0) { \
                PHASEK(20, phase_norm<false>(F, args, xo, args.in[32] + (layer) * D, WSP(bf16, A_H), nullptr, nullptr, nullptr, nullptr)); \
                PHASEK(21, phase_ffn_gu(F, args)); \
                PHASE(phase_ffn_down(F, args, xo)); \
                PHASE((void)0); \
                PHASE((void)0); \
            } else { \
                PHASE(phase_norm<true>(F, args, xo, args.in[32] + (layer) * D, WSP(bf16, A_H), args.in[35], WSP(int, F_TOPE), WSP(float, F_TOPW), F.ctl + CW_CNT + (half) * 16)); \
                PHASE(phase_moe_route(F, args, half)); \
                PHASEK(22, phase_moe_gu(F, args, half)); \
                PHASEK(23, phase_moe_down(F, args, half)); \
                PHASE(phase_moe_combine(F, args, xo)); \
            } } while (0)
    static_assert(DEPTH == 2 && NHALF <= 2, "segment program");
    PHASEK(27, phase_convert(F, args, 0));
    SEGMENT(0, 0);
    if (NHALF == 2) SEGMENT(0, 1);
    PHASEK(27, phase_convert(F, args, 1));
    SEGMENT(1, 0);
    if (NHALF == 2) SEGMENT(1, 1);
#undef SEGMENT
    PHASE(phase_final_norm(F, args, F.out, args.in[38]));
#undef PHASE
}

#ifndef ONE_LAUNCH
#define ONE_LAUNCH 1
#endif
extern "C" void kernel_launch(void* const* d_in, const int* in_sizes, int n_in, void* d_out, int out_size, void* d_ws, size_t ws_size, hipStream_t stream) {
    static int grid = 0;
    if (grid == 0) {
#ifdef EMU
        grid = EMU_GRID;
#else
        if (n_in != 39 || out_size != T * D || ws_size < WS_NEED) { fprintf(stderr, "kernel_launch: unexpected problem (n_in %d out %d ws %zu need %zu)\n", n_in, out_size, ws_size, (size_t)WS_NEED); grid = -1; return; }
        int dev = 0, cus = 0;
        if (hipGetDevice(&dev) != hipSuccess || hipDeviceGetAttribute(&cus, hipDeviceAttributeMultiprocessorCount, dev) != hipSuccess) { grid = -1; return; }
        if (hipFuncSetAttribute((const void*)fwd_kernel, hipFuncAttributeMaxDynamicSharedMemorySize, LDS_BYTES) != hipSuccess) { fprintf(stderr, "kernel_launch: hipFuncSetAttribute failed\n"); grid = -1; return; }
        int per_cu = 0;
        if (hipOccupancyMaxActiveBlocksPerMultiprocessor(&per_cu, (const void*)fwd_kernel, 512, LDS_BYTES) != hipSuccess || per_cu < 1) fprintf(stderr, "kernel_launch: occupancy query reports %d\n", per_cu);
        (void)hipGetLastError();
        grid = cus;
#endif
    }
    if (grid < 0) return;
    (void)hipMemsetAsync((char*)d_ws + WS_CTL, 0, CTL_BYTES, stream);
    Args a{};
    for (int i = 0; i < 39; ++i) a.in[i] = (const float*)d_in[i];
    a.out = (float*)d_out; a.ws = (unsigned char*)d_ws;
#ifdef EMU
    for (int p = EMU_PH_LO; p < EMU_PH_HI && p < NPHASES; ++p) { a.lo = p; a.hi = p + 1; emu_launch(fwd_kernel, grid, 512, a); emu_after_phase(p); }
#else
#if ONE_LAUNCH
    a.lo = 0; a.hi = NPHASES;
    hipLaunchKernelGGL(fwd_kernel, dim3(grid), dim3(512), LDS_BYTES, stream, a);
#else
    for (int p = 0; p < NPHASES; ++p) { a.lo = p; a.hi = p + 1; hipLaunchKernelGGL(fwd_kernel, dim3(grid), dim3(512), LDS_BYTES, stream, a); }
#endif
#endif
}
```

```cpp
#ifndef EMU
#include <hip/hip_runtime.h>
#include <cstdio>
#include <cstdint>
#endif

#ifndef REPEAT_MASK
#define REPEAT_MASK 0u
#endif
#ifdef EMU
constexpr int BATCH = EMU_B, SEQ = EMU_S, NHALF = EMU_NHALF;
#else
constexpr int BATCH = 16, SEQ = 2048, NHALF = 2;
#endif
constexpr int D = 1024, DEPTH = 2, CH = 64;
constexpr int T = BATCH * SEQ, TH = T / NHALF, BH = BATCH / NHALF, NCH = SEQ / CH;
constexpr int C_MLA = 0, C_RWKV = 704, C_GDN = 2528, C_SSD = 4584, C_GATE = 6128, IN_COLS = 10224, PW = 6144;
constexpr int FF_D = 2816, FF_E = 3584, NEXP = 8;
constexpr int MOE_ROWS = ((TH * 2 + NEXP * 255) / 256) * 256;
constexpr float EPS = 1e-6f;
static_assert(TH % 256 == 0 && SEQ % 128 == 0 && BATCH % NHALF == 0, "shape");

typedef unsigned short bf16;
typedef float f32x4 __attribute__((ext_vector_type(4)));
typedef float f32x2 __attribute__((ext_vector_type(2)));
typedef short bf16x8 __attribute__((ext_vector_type(8)));
typedef short bf16x4 __attribute__((ext_vector_type(4)));
typedef unsigned u32x4 __attribute__((ext_vector_type(4)));
typedef unsigned u32x2 __attribute__((ext_vector_type(2)));
#ifdef EMU
#define LAS
#define GAS
#define MFMA_F32(a, b, c) emu_mfma_16x16x4f32(a, b, c)
#define MFMA_BF16(a, b, c) emu_mfma_16x16x32bf16(a, b, c)
#define ATOMIC_ADD_U32(p, v) emu_atomic_add_u32(p, v)
#define RFL(x) (x)
#define LDS_WAIT()
#define VM_WAIT()
__device__ __forceinline__ float fast_exp(float x) { return expf(x); }
__device__ __forceinline__ float fast_rcp(float x) { return 1.0f / x; }
__device__ __forceinline__ float fast_rsqrt(float x) { return 1.0f / sqrtf(x); }
#else
#define LAS __attribute__((address_space(3)))
#define GAS __attribute__((address_space(1)))
#define MFMA_F32(a, b, c) __builtin_amdgcn_mfma_f32_16x16x4f32(a, b, c, 0, 0, 0)
#define MFMA_BF16(a, b, c) __builtin_amdgcn_mfma_f32_16x16x32_bf16(a, b, c, 0, 0, 0)
#define ATOMIC_ADD_U32(p, v) __hip_atomic_fetch_add(p, v, __ATOMIC_RELAXED, __HIP_MEMORY_SCOPE_AGENT)
#define RFL(x) __builtin_amdgcn_readfirstlane(x)
#define LDS_WAIT() asm volatile("s_waitcnt lgkmcnt(0)" ::: "memory")
#define VM_WAIT() asm volatile("s_waitcnt vmcnt(0)" ::: "memory")
__device__ __forceinline__ float fast_exp(float x) { return __expf(x); }
__device__ __forceinline__ float fast_rcp(float x) { return __builtin_amdgcn_rcpf(x); }
__device__ __forceinline__ float fast_rsqrt(float x) { return __builtin_amdgcn_rsqf(x); }
#endif
__device__ __forceinline__ unsigned f2u(float f) { return __builtin_bit_cast(unsigned, f); }
__device__ __forceinline__ float u2f(unsigned u) { return __builtin_bit_cast(float, u); }
__device__ __forceinline__ unsigned f2bf(float f) { unsigned u = f2u(f); return (u + 0x7fffu + ((u >> 16) & 1u)) >> 16; }
__device__ __forceinline__ float bf2f(unsigned h) { return u2f(h << 16); }
__device__ __forceinline__ unsigned pk2(float lo, float hi) { return f2bf(lo) | (f2bf(hi) << 16); }
__device__ __forceinline__ float sigmoidf_(float x) { return 1.0f / (1.0f + expf(-x)); }
__device__ __forceinline__ float siluf_(float x) { return x / (1.0f + expf(-x)); }
__device__ __forceinline__ float softplusf_(float x) { return x > 20.f ? x : log1pf(expf(x)); }
__device__ __forceinline__ float wave_sum(float v) {
#pragma unroll
    for (int o = 1; o < 64; o <<= 1) v += __shfl_xor(v, o);
    return v;
}
__device__ __forceinline__ float wave_max(float v) {
#pragma unroll
    for (int o = 1; o < 64; o <<= 1) v = fmaxf(v, __shfl_xor(v, o));
    return v;
}
__device__ __forceinline__ f32x4 ld_bf16x4(const bf16* p) { const u32x2 w = *(const u32x2*)p; return (f32x4){bf2f(w.x & 0xffffu), bf2f(w.x >> 16), bf2f(w.y & 0xffffu), bf2f(w.y >> 16)}; }
__device__ __forceinline__ void st_bf16x4(bf16* p, f32x4 v) { u32x2 w; w.x = pk2(v.x, v.y); w.y = pk2(v.z, v.w); *(u32x2*)p = w; }

namespace pg8 {
#define PG8_LAS LAS
typedef unsigned short bf16_t;
constexpr int BM = 256, BK = 64, HALF = 128, HTB = HALF * BK * 2, STAGE_BYTES = 8 * HTB, NXCD = 8, WGM = 8;
__host__ __device__ __forceinline__ int lds_byte(int r, int c) { const int st = (r >> 4) * 2 + (c >> 5), rr = r & 15, cc = c & 31, ob = rr * 64 + cc * 2; return st * 1024 + (ob ^ (((ob >> 9) & 1) << 5)); }
__host__ __device__ __forceinline__ void stage_rc(int b, int& R, int& C) { const int st = b / 1024, sb = b % 1024, swz = sb ^ (((sb >> 9) & 1) << 5); R = (st >> 1) * 16 + swz / 64; C = (st & 1) * 32 + (swz % 64) / 2; }
__host__ __device__ __forceinline__ int perm32(int rho) { const int n = rho >> 4, i = rho & 15; return 8 * (i >> 2) + 4 * n + (i & 3); }
struct Unit { int pm, pn; };
struct Gemm { const bf16_t* A; const bf16_t* Bt; int lda, K; };
struct StaticOrder {
    int nM, nN, nwg, G, c;
    __host__ __device__ void init(int M, int N, int G_, int c_) { nM = M / BM; nN = N / BM; nwg = nM * nN; G = G_; c = c_; }
    __host__ __device__ bool next(int i, Unit& u) const {
        const long L = (long)i * G + c; if (L >= nwg) return false;
        int wgid = (int)L; { const int q = nwg / NXCD, r = nwg % NXCD, xcd = wgid % NXCD, off = wgid / NXCD; wgid = (xcd < r ? xcd * (q + 1) : r * (q + 1) + (xcd - r) * q) + off; }
        const int nig = WGM * nN, gid = wgid / nig, fm = gid * WGM, gsz = (nM - fm) < WGM ? (nM - fm) : WGM;
        u.pm = fm + ((wgid % nig) % gsz); u.pn = (wgid % nig) / gsz; return true;
    }
    __device__ __forceinline__ void a_ready(const Unit&) const {}
    __device__ __forceinline__ void done(const Unit&) const {}
};
#ifndef EMU
template <class Epi, class Sched>
__device__ __forceinline__ void gemm_phase(PG8_LAS unsigned char* lds, const Gemm g, const Sched& S, const Epi& E, const int tid) {
    const int wid = __builtin_amdgcn_readfirstlane(tid >> 6), lane = tid & 63, wr = wid >> 2, wc = wid & 3, fr = lane & 15, fq = lane >> 4;
    int Kq = g.K; asm volatile("" : "+s"(Kq));
    const int K = Kq, nt = K / BK, lda = g.lda;
    unsigned voffA[2], voffB[2];
#pragma unroll
    for (int i = 0; i < 2; ++i) { int R, C; stage_rc(tid * 16 + i * 8192, R, C); const int Rb = Epi::PERM ? ((R & ~31) + perm32(R & 31)) : R;
        voffA[i] = (unsigned)(R * lda + C) * 2u; voffB[i] = (unsigned)(Rb * K + C) * 2u; }
    const size_t kstep = (size_t)(BK * 2);
    const size_t hstep = (size_t)HALF * K * 2, hstepA = (size_t)HALF * lda * 2;
    const size_t tstep = 2 * hstep, tstepA = 2 * hstepA;
    const unsigned ldsw = (unsigned)wid * 1024u;
    const int aoff = lds_byte(wr * 64 + fr, fq * 8), boff = lds_byte(wc * 32 + fr, fq * 8);
#define PG8_SA(b, h) (((b) * 2 + (h)) * HTB)
#define PG8_SB(b, h) ((4 + (b) * 2 + (h)) * HTB)
#define PG8_STAGE(bufoff, gbase, voff) do { _Pragma("unroll") for (int _i = 0; _i < 2; ++_i) \
        __builtin_amdgcn_global_load_lds((const unsigned*)((const char*)(gbase) + (voff)[_i]), (PG8_LAS unsigned*)(lds + (bufoff) + ldsw + _i * 8192), 16, 0, 0); } while (0)
#define PG8_LDA(dst, b, h) do { _Pragma("unroll") for (int m = 0; m < 4; ++m) _Pragma("unroll") for (int k = 0; k < 2; ++k) dst[m][k] = *(const PG8_LAS bf16x8*)(lds + PG8_SA(b, h) + aoff + m * 2048 + k * 1024); } while (0)
#define PG8_LDB(dst, b, h) do { _Pragma("unroll") for (int n = 0; n < 2; ++n) _Pragma("unroll") for (int k = 0; k < 2; ++k) dst[n][k] = *(const PG8_LAS bf16x8*)(lds + PG8_SB(b, h) + boff + n * 2048 + k * 1024); } while (0)
#define PG8_MMA(ai, bj, At, Bt) do { __builtin_amdgcn_s_setprio(1); _Pragma("unroll") for (int m = 0; m < 4; ++m) _Pragma("unroll") for (int n = 0; n < 2; ++n) _Pragma("unroll") for (int k = 0; k < 2; ++k) \
        acc[ai][bj][m][n] = __builtin_amdgcn_mfma_f32_16x16x32_bf16(Bt[n][k], At[m][k], acc[ai][bj][m][n], 0, 0, 0); __builtin_amdgcn_s_setprio(0); } while (0)
#define PG8_WAIT_V(n) asm volatile("s_waitcnt vmcnt(" #n ")" ::: "memory")
#define PG8_WAIT_L(n) asm volatile("s_waitcnt lgkmcnt(" #n ")" ::: "memory")
#define PG8_BAR __builtin_amdgcn_s_barrier()
#define PG8_SCHED __builtin_amdgcn_sched_barrier(0)
    Unit cur, nxt; int ui = 0;
    if (!S.next(0, cur)) return;
    f32x4 acc[2][2][4][2];
#pragma unroll
    for (int a = 0; a < 2; ++a)
#pragma unroll
        for (int b = 0; b < 2; ++b)
#pragma unroll
            for (int m = 0; m < 4; ++m)
#pragma unroll
                for (int n = 0; n < 2; ++n) acc[a][b][m][n] = (f32x4){0.f, 0.f, 0.f, 0.f};
    bf16x8 At[4][2], B0[2][2], B1[2][2];
    const char* cA = (const char*)g.A + (size_t)cur.pm * tstepA; const char* cB = (const char*)g.Bt + (size_t)cur.pn * tstep;
    S.a_ready(cur);
    PG8_STAGE(PG8_SB(0, 0), cB, voffB); PG8_STAGE(PG8_SA(0, 0), cA, voffA); PG8_STAGE(PG8_SB(0, 1), cB + hstep, voffB); PG8_STAGE(PG8_SA(0, 1), cA + hstepA, voffA);
    if (wr == 1) PG8_BAR;
    PG8_WAIT_V(4); PG8_BAR;
    PG8_STAGE(PG8_SB(1, 0), cB + kstep, voffB); PG8_STAGE(PG8_SA(1, 0), cA + kstep, voffA); PG8_STAGE(PG8_SB(1, 1), cB + hstep + kstep, voffB);
    PG8_WAIT_V(6); PG8_BAR;
    for (;;) {
        const bool has_next = S.next(ui + 1, nxt);
        const char* nA = has_next ? (const char*)g.A + (size_t)nxt.pm * tstepA : cA; const char* nB = has_next ? (const char*)g.Bt + (size_t)nxt.pn * tstep : cB;
        for (int t = 0; t < nt; t += 2) {
            const bool last = (t == nt - 2);
            const char* a1 = cA + (size_t)(t + 1) * kstep;
            const char* a2 = last ? nA : cA + (size_t)(t + 2) * kstep; const char* b2 = last ? nB : cB + (size_t)(t + 2) * kstep;
            const char* a3 = a2 + kstep; const char* b3 = b2 + kstep;
            if (last && has_next) S.a_ready(nxt);
            PG8_LDB(B0, 0, 0); PG8_SCHED; PG8_LDA(At, 0, 0); PG8_STAGE(PG8_SA(1, 1), a1 + hstepA, voffA);
            PG8_WAIT_L(8); PG8_BAR; PG8_WAIT_L(0); PG8_MMA(0, 0, At, B0); PG8_BAR; PG8_SCHED;
            PG8_LDB(B1, 0, 1); PG8_STAGE(PG8_SB(0, 0), b2, voffB);
            PG8_BAR; PG8_WAIT_L(0); PG8_MMA(0, 1, At, B1); PG8_BAR;
            PG8_LDA(At, 0, 1); PG8_STAGE(PG8_SA(0, 0), a2, voffA);
            PG8_BAR; PG8_WAIT_L(0); PG8_MMA(1, 0, At, B0); PG8_BAR; PG8_SCHED;
            PG8_STAGE(PG8_SB(0, 1), b2 + hstep, voffB);
            PG8_WAIT_V(6); PG8_BAR; PG8_MMA(1, 1, At, B1); PG8_BAR;
            PG8_LDB(B0, 1, 0); PG8_SCHED; PG8_LDA(At, 1, 0); PG8_STAGE(PG8_SA(0, 1), a2 + hstepA, voffA);
            PG8_WAIT_L(8); PG8_BAR; PG8_WAIT_L(0); PG8_MMA(0, 0, At, B0); PG8_BAR; PG8_SCHED;
            PG8_LDB(B1, 1, 1); PG8_STAGE(PG8_SB(1, 0), b3, voffB);
            PG8_BAR; PG8_WAIT_L(0); PG8_MMA(0, 1, At, B1); PG8_BAR;
            PG8_LDA(At, 1, 1); PG8_STAGE(PG8_SA(1, 0), a3, voffA);
            PG8_BAR; PG8_WAIT_L(0); PG8_MMA(1, 0, At, B0); PG8_BAR; PG8_SCHED;
            PG8_STAGE(PG8_SB(1, 1), b3 + hstep, voffB);
            PG8_WAIT_V(6); PG8_BAR; PG8_MMA(1, 1, At, B1); PG8_BAR;
        }
        if constexpr (!Epi::AFTER_DRAIN) { E(acc, cur, wr, wc, fr, fq); S.done(cur); }
        if (!has_next) break;
#pragma unroll
        for (int a = 0; a < 2; ++a)
#pragma unroll
            for (int b = 0; b < 2; ++b)
#pragma unroll
                for (int m = 0; m < 4; ++m)
#pragma unroll
                    for (int n = 0; n < 2; ++n) acc[a][b][m][n] = (f32x4){0.f, 0.f, 0.f, 0.f};
        cur = nxt; cA = nA; cB = nB; ++ui;
    }
    PG8_WAIT_V(0);
    if (wr == 0) PG8_BAR;
    PG8_BAR;
    if constexpr (Epi::AFTER_DRAIN) { E.fused(acc, cur, wr, wc, fr, fq, lds, wid, lane); S.done(cur); }
#undef PG8_SA
#undef PG8_SB
#undef PG8_STAGE
#undef PG8_LDA
#undef PG8_LDB
#undef PG8_MMA
#undef PG8_WAIT_V
#undef PG8_WAIT_L
#undef PG8_BAR
#undef PG8_SCHED
}
#else
template <class Epi, class Sched>
__device__ __forceinline__ void gemm_phase(PG8_LAS unsigned char* lds, const Gemm g, const Sched& S, const Epi& E, const int tid) {
    const int wid = tid >> 6, lane = tid & 63, wr = wid >> 2, wc = wid & 3, fr = lane & 15, fq = lane >> 4;
    Unit cur;
    for (int ui = 0; S.next(ui, cur); ++ui) {
        f32x4 acc[2][2][4][2];
        for (int ai = 0; ai < 2; ++ai) for (int m = 0; m < 4; ++m) {
            const size_t row = (size_t)cur.pm * 256 + ai * 128 + wr * 64 + m * 16 + fr;
            const bf16_t* ap = g.A + row * g.lda;
            for (int bj = 0; bj < 2; ++bj) for (int n = 0; n < 2; ++n) for (int j = 0; j < 4; ++j) {
                const size_t col = (size_t)cur.pn * 256 + bj * 128 + wc * 32 + (Epi::PERM ? 8 * fq + 4 * n : 16 * n + 4 * fq) + j;
                const bf16_t* bp = g.Bt + col * g.K; float s = 0.f;
                for (int k = 0; k < g.K; ++k) s += bf2f(ap[k]) * bf2f(bp[k]);
                acc[ai][bj][m][n][j] = s; } }
        E(acc, cur, wr, wc, fr, fq);
    }
    __syncthreads();
}
#endif
}

using pg8::Unit;
constexpr int HALFT = 128;
struct EpiF32 {
    static constexpr bool PERM = false, AFTER_DRAIN = false;
    float* C; int ldc;
    __device__ __forceinline__ void operator()(const f32x4 (&acc)[2][2][4][2], const Unit& u, int wr, int wc, int fr, int fq) const {
        const int row0 = u.pm * 256 + wr * 64 + fr, col0 = u.pn * 256 + wc * 32 + 4 * fq;
#pragma unroll
        for (int ai = 0; ai < 2; ++ai)
#pragma unroll
            for (int m = 0; m < 4; ++m) { float* rowp = C + (size_t)(row0 + ai * HALFT + m * 16) * ldc + col0;
#pragma unroll
                for (int bj = 0; bj < 2; ++bj)
#pragma unroll
                    for (int n = 0; n < 2; ++n) *(f32x4*)(rowp + bj * HALFT + n * 16) = acc[ai][bj][m][n]; }
    }
};
struct EpiResidual {
    static constexpr bool PERM = false, AFTER_DRAIN = false;
    const float* res; float* out;
    __device__ __forceinline__ void operator()(const f32x4 (&acc)[2][2][4][2], const Unit& u, int wr, int wc, int fr, int fq) const {
        const int row0 = u.pm * 256 + wr * 64 + fr, col0 = u.pn * 256 + wc * 32 + 4 * fq;
#pragma unroll
        for (int ai = 0; ai < 2; ++ai) {
            f32x4 rv[4][2][2];
#pragma unroll
            for (int m = 0; m < 4; ++m) { const size_t o = (size_t)(row0 + ai * HALFT + m * 16) * D + col0;
#pragma unroll
                for (int bj = 0; bj < 2; ++bj)
#pragma unroll
                    for (int n = 0; n < 2; ++n) rv[m][bj][n] = *(const GAS f32x4*)(res + o + bj * HALFT + n * 16); }
#pragma unroll
            for (int m = 0; m < 4; ++m) { const size_t o = (size_t)(row0 + ai * HALFT + m * 16) * D + col0;
#pragma unroll
                for (int bj = 0; bj < 2; ++bj)
#pragma unroll
                    for (int n = 0; n < 2; ++n) *(GAS f32x4*)(out + o + bj * HALFT + n * 16) = rv[m][bj][n] + acc[ai][bj][m][n]; }
        }
    }
};
struct EpiBf16 {
    static constexpr bool PERM = true, AFTER_DRAIN = false;
    bf16* O; int ldc; const float* rowscale; int rs_stride;
    __device__ __forceinline__ void operator()(const f32x4 (&acc)[2][2][4][2], const Unit& u, int wr, int wc, int fr, int fq) const {
        const int row0 = u.pm * 256 + wr * 64 + fr, col0 = u.pn * 256 + wc * 32 + 8 * fq;
#pragma unroll
        for (int ai = 0; ai < 2; ++ai)
#pragma unroll
            for (int m = 0; m < 4; ++m) { const int row = row0 + ai * HALFT + m * 16; bf16* rowp = O + (size_t)row * ldc + col0;
                const float sc = rowscale ? rowscale[(size_t)row * rs_stride] : 1.0f;
#pragma unroll
                for (int bj = 0; bj < 2; ++bj) { const f32x4 v0 = acc[ai][bj][m][0] * sc, v1 = acc[ai][bj][m][1] * sc;
                    u32x4 w; w.x = pk2(v0[0], v0[1]); w.y = pk2(v0[2], v0[3]); w.z = pk2(v1[0], v1[1]); w.w = pk2(v1[2], v1[3]);
                    *(u32x4*)(rowp + bj * HALFT) = w; } }
    }
};
struct EpiSwiGLU {
    static constexpr bool PERM = true, AFTER_DRAIN = false;
    bf16* O; int ldc; int ntile;
    __device__ __forceinline__ void operator()(const f32x4 (&acc)[2][2][4][2], const Unit& u, int wr, int wc, int fr, int fq) const {
        const int row0 = u.pm * 256 + wr * 64 + fr, col0 = (u.pn % ntile) * 128 + wc * 32 + 8 * fq;
#pragma unroll
        for (int ai = 0; ai < 2; ++ai)
#pragma unroll
            for (int m = 0; m < 4; ++m) { bf16* rowp = O + (size_t)(row0 + ai * HALFT + m * 16) * ldc + col0;
                float a[8];
#pragma unroll
                for (int n = 0; n < 2; ++n)
#pragma unroll
                    for (int j = 0; j < 4; ++j) { const float g = acc[ai][0][m][n][j], up = acc[ai][1][m][n][j]; a[4 * n + j] = g * fast_rcp(1.0f + fast_exp(-g)) * up; }
                u32x4 w; w.x = pk2(a[0], a[1]); w.y = pk2(a[2], a[3]); w.z = pk2(a[4], a[5]); w.w = pk2(a[6], a[7]);
                *(u32x4*)rowp = w; }
    }
};
struct EpiZ {
    static constexpr bool PERM = true, AFTER_DRAIN = false;
    bf16* Z;
    __device__ __forceinline__ void operator()(const f32x4 (&acc)[2][2][4][2], const Unit& u, int wr, int wc, int fr, int fq) const {
        const int i = u.pn >> 2, pnl = u.pn & 3, pml = u.pm - i * (TH / 256);
        const int row0 = pml * 256 + wr * 64 + fr, col0 = i * D + pnl * 256 + wc * 32 + 8 * fq;
#pragma unroll
        for (int ai = 0; ai < 2; ++ai)
#pragma unroll
            for (int m = 0; m < 4; ++m) { bf16* rowp = Z + (size_t)(row0 + ai * HALFT + m * 16) * 4096 + col0;
#pragma unroll
                for (int bj = 0; bj < 2; ++bj) { const f32x4 v0 = acc[ai][bj][m][0], v1 = acc[ai][bj][m][1];
                    u32x4 w; w.x = pk2(v0[0], v0[1]); w.y = pk2(v0[2], v0[3]); w.z = pk2(v1[0], v1[1]); w.w = pk2(v1[2], v1[3]);
                    *(GAS u32x4*)(rowp + bj * HALFT) = w; } }
    }
};
struct BranchOrder {
    int nP, G, c;
    __device__ bool next(int i, Unit& u) const {
        const long L = (long)i * G + c; if (L >= (long)16 * nP) return false;
        const int br = (int)(L / (4 * nP)), r = (int)(L % (4 * nP)); u.pm = br * nP + (r >> 2); u.pn = br * 4 + (r & 3); return true;
    }
    __device__ __forceinline__ void a_ready(const Unit&) const {}
    __device__ __forceinline__ void done(const Unit&) const {}
};
struct EpiMerge {
    static constexpr bool PERM = false, AFTER_DRAIN = false;
    const bf16* Z; const float* gate_b; bf16* MG;
    __device__ __forceinline__ void operator()(const f32x4 (&acc)[2][2][4][2], const Unit& u, int wr, int wc, int fr, int fq) const {
        const int row0 = u.pm * 256 + wr * 64 + fr, col = u.pn * 64 + wc * 16 + 4 * fq;
        f32x4 gb[4];
#pragma unroll
        for (int i = 0; i < 4; ++i) gb[i] = *(const GAS f32x4*)(gate_b + i * D + col);
#pragma unroll
        for (int ai = 0; ai < 2; ++ai) {
            u32x2 zv[4][4];
#pragma unroll
            for (int m = 0; m < 4; ++m)
#pragma unroll
                for (int i = 0; i < 4; ++i) zv[m][i] = *(const GAS u32x2*)(Z + (size_t)(row0 + ai * HALFT + m * 16) * 4096 + i * D + col);
#pragma unroll
            for (int m = 0; m < 4; ++m) { const size_t row = (size_t)(row0 + ai * HALFT + m * 16);
                f32x4 s = (f32x4){0.f, 0.f, 0.f, 0.f};
#pragma unroll
                for (int bj = 0; bj < 2; ++bj)
#pragma unroll
                    for (int n = 0; n < 2; ++n) { const int i = 2 * bj + n; const unsigned z01 = zv[m][i].x, z23 = zv[m][i].y;
                        const f32x4 z = (f32x4){bf2f(z01 & 0xffffu), bf2f(z01 >> 16), bf2f(z23 & 0xffffu), bf2f(z23 >> 16)}; const f32x4 a = acc[ai][bj][m][n] + gb[i];
#pragma unroll
                        for (int j = 0; j < 4; ++j) s[j] += z[j] * fast_rcp(1.0f + fast_exp(-a[j])); }
                u32x2 w; w.x = pk2(s.x, s.y); w.y = pk2(s.z, s.w); *(GAS u32x2*)(MG + row * D + col) = w; }
        }
    }
};

constexpr size_t MiB = 1u << 20;
constexpr size_t al(size_t x) { return (x + 255) & ~(size_t)255; }
constexpr size_t WS_CTL = 0, CTL_BYTES = 1 * MiB;
constexpr size_t W_IN = 1 * MiB;
constexpr size_t W_GATE = W_IN + (size_t)PW * D * 2;
constexpr size_t W_UQ = W_GATE + (size_t)4096 * D * 2;
constexpr size_t W_UKV = W_UQ + (size_t)768 * 384 * 2;
constexpr size_t W_LORA = W_UKV + (size_t)1024 * 256 * 2;
constexpr size_t W_BR = W_LORA + (size_t)1536 * 384 * 2;
constexpr size_t W_OUT = W_BR + (size_t)4 * 1024 * 512 * 2;
constexpr size_t W_FGU = W_OUT + (size_t)D * D * 2;
constexpr size_t W_FDN = W_FGU + (size_t)NEXP * 2 * FF_E * D * 2;
constexpr size_t W_END = W_FDN + (size_t)NEXP * D * FF_E * 2;
constexpr size_t A_H = al(W_END);
constexpr size_t A_ROPE = A_H + (size_t)TH * D * 2;
constexpr size_t A_Y = A_ROPE + (size_t)TH * 64 * 4;
constexpr size_t A_P = A_Y + (size_t)4 * TH * 512 * 2;
constexpr size_t A_MIX = A_P + (size_t)TH * PW * 2;
constexpr size_t M_STAT = A_MIX;
constexpr size_t M_KR = M_STAT + (size_t)TH * 2 * 4;
constexpr size_t M_Q = M_KR + (size_t)TH * 64 * 2;
constexpr size_t M_KV = M_Q + (size_t)TH * 768 * 2;
constexpr size_t M_VT = M_KV + (size_t)TH * 1024 * 2;
constexpr size_t M_END = M_VT + (size_t)TH * 512 * 2;
constexpr size_t R_RKV = A_MIX;
constexpr size_t R_LIN = R_RKV + (size_t)TH * 1536 * 2;
constexpr size_t R_LOUT = R_LIN + (size_t)TH * 384 * 2;
constexpr size_t R_REC = R_LOUT + (size_t)TH * 1536 * 4;
constexpr size_t R_O = R_REC + (size_t)BH * 8 * NCH * 92416;
constexpr size_t R_END = R_O + (size_t)TH * 512 * 4;
constexpr size_t G_CH = A_MIX;
constexpr size_t G_O = G_CH + al((size_t)BH * 4 * NCH * 103440);
constexpr size_t G_END = G_O + (size_t)TH * 512 * 4;
constexpr size_t S_ST = A_MIX;
constexpr size_t S_YD = S_ST + (size_t)BH * NCH * 8 * 64 * 128 * 4;
constexpr size_t S_C = S_YD + (size_t)TH * 512 * 4;
constexpr size_t S_AC = S_C + (size_t)TH * 256 * 4;
constexpr size_t S_END = S_AC + (size_t)TH * 8 * 4;
constexpr size_t A_Z = A_P;
constexpr size_t A_MG = A_MIX;
constexpr size_t F_ACT = A_P;
constexpr size_t F_GA = F_ACT + (size_t)MOE_ROWS * FF_E * 2;
constexpr size_t F_YE = F_GA + (size_t)MOE_ROWS * D * 2;
constexpr size_t F_TOPE = F_YE + (size_t)MOE_ROWS * D * 4;
constexpr size_t F_TOPW = F_TOPE + (size_t)TH * 2 * 4;
constexpr size_t F_SLOT = F_TOPW + (size_t)TH * 2 * 4;
constexpr size_t F_END = F_SLOT + (size_t)TH * 2 * 4;
constexpr size_t cmax(size_t a, size_t b) { return a > b ? a : b; }
constexpr size_t WS_NEED = cmax(cmax(cmax(M_END, R_END), cmax(G_END, S_END)), F_END);
#ifndef EMU
static_assert(WS_NEED <= (size_t)896 * MiB, "workspace");
#endif
constexpr int CW_BAR = 4096;
constexpr int CW_CNT = 16384;
constexpr int CW_FILL = 16384 + 64;

#ifdef EMU
#define WAVE_SYNC() emu_wave_sync()
#else
#define WAVE_SYNC() do { asm volatile("s_waitcnt lgkmcnt(0)" ::: "memory"); } while (0)
#endif
struct Frame {
    LAS unsigned char* lds; int tid, lane, wave, G, gw, NGW, bid;
    float* out; unsigned char* ws; unsigned* ctl;
};
struct Args { const float* in[39]; float* out; unsigned char* ws; int lo, hi; };
#define WSP(type, off) ((type*)(F.ws + (off)))

template <class FN>
__device__ __forceinline__ void cvt_matrix(const Frame& F, const float* W, int ldw, int K, bf16* WT, int Ndst, const float* kscale, FN srccol) {
    LAS float* scr = (LAS float*)(F.lds + F.wave * 16384);
    const int nblk = Ndst / 32, nitems = (K / 64) * nblk, lane = F.lane;
    for (int item = F.gw; item < nitems; item += F.NGW) {
        const int kb = item / nblk, nb = item % nblk, k0 = 64 * kb, n0 = 32 * nb;
        const int sc = srccol(n0 + (lane & 31));
#pragma unroll 8
        for (int i = 0; i < 32; ++i) { const int kk = 2 * i + (lane >> 5); float v = sc >= 0 ? W[(size_t)(k0 + kk) * ldw + sc] : 0.f; if (kscale) v *= kscale[k0 + kk]; scr[kk * 33 + (lane & 31)] = v; }
        WAVE_SYNC();
        const int c = lane & 7;
#pragma unroll
        for (int j = 0; j < 4; ++j) { const int n = (lane >> 3) + 8 * j; const LAS float* s = scr + (8 * c) * 33 + n;
            u32x4 o; o.x = pk2(s[0 * 33], s[1 * 33]); o.y = pk2(s[2 * 33], s[3 * 33]); o.z = pk2(s[4 * 33], s[5 * 33]); o.w = pk2(s[6 * 33], s[7 * 33]);
            *(u32x4*)(WT + (size_t)(n0 + n) * K + k0 + 8 * c) = o; }
        WAVE_SYNC();
    }
}
__device__ __forceinline__ void phase_convert(const Frame& F, const Args& A, int layer) {
    const float* w_in = A.in[3] + (size_t)layer * D * IN_COLS;
    cvt_matrix(F, w_in, IN_COLS, D, WSP(bf16, W_IN), PW, nullptr, [](int n) { return n < C_GATE ? n : -1; });
    cvt_matrix(F, w_in, IN_COLS, D, WSP(bf16, W_GATE), 4096, nullptr, [](int n) {
        const int pn = n >> 8, c = n & 255, bj = c >> 7, wc = (c >> 5) & 3, nn = (c >> 4) & 1, r = c & 15; return C_GATE + (2 * bj + nn) * D + 64 * pn + 16 * wc + r; });
    cvt_matrix(F, A.in[6] + (size_t)layer * 384 * 768, 768, 384, WSP(bf16, W_UQ), 768, A.in[4] + layer * 384, [](int n) { return n; });
    cvt_matrix(F, A.in[7] + (size_t)layer * 256 * 1024, 1024, 256, WSP(bf16, W_UKV), 1024, A.in[5] + layer * 256, [](int n) { return n; });
    for (int i = 0; i < 4; ++i) cvt_matrix(F, A.in[30] + ((size_t)layer * 4 + i) * 512 * D, D, 512, WSP(bf16, W_BR) + (size_t)i * D * 512, D, nullptr, [](int n) { return n; });
    cvt_matrix(F, A.in[31] + (size_t)layer * D * D, D, D, WSP(bf16, W_OUT), D, nullptr, [](int n) { return n; });
    if (layer == 0) {
        cvt_matrix(F, A.in[33], 2 * FF_D, D, WSP(bf16, W_FGU), 2 * FF_D, nullptr, [](int n) { const int pn = n >> 8, c = n & 255; return c < 128 ? 128 * pn + c : FF_D + 128 * pn + (c - 128); });
        cvt_matrix(F, A.in[34], D, FF_D, WSP(bf16, W_FDN), D, nullptr, [](int n) { return n; });
    } else {
        for (int e = 0; e < NEXP; ++e) {
            cvt_matrix(F, A.in[36] + (size_t)e * D * 2 * FF_E, 2 * FF_E, D, WSP(bf16, W_FGU) + (size_t)e * 2 * FF_E * D, 2 * FF_E, nullptr, [](int n) { const int pn = n >> 8, c = n & 255; return c < 128 ? 128 * pn + c : FF_E + 128 * pn + (c - 128); });
            cvt_matrix(F, A.in[37] + (size_t)e * FF_E * D, D, FF_E, WSP(bf16, W_FDN) + (size_t)e * D * FF_E, D, nullptr, [](int n) { return n; });
        }
    }
    { const float* w2 = A.in[10] + (size_t)layer * 64 * 512; const float* a2 = A.in[12] + (size_t)layer * 64 * 512; const float* g2 = A.in[13] + (size_t)layer * 160 * 512;
      bf16* L = WSP(bf16, W_LORA);
      for (int idx = F.bid * 512 + F.tid; idx < 1536 * 384; idx += F.G * 512) { const int n = idx / 384, k = idx % 384; float v = 0.f;
          if (n < 512) { if (k < 64) v = w2[k * 512 + n]; } else if (n < 1024) { if (k >= 64 && k < 128) v = a2[(k - 64) * 512 + (n - 512)]; } else { if (k >= 128 && k < 288) v = g2[(k - 128) * 512 + (n - 1024)]; }
          L[idx] = (bf16)f2bf(v); } }
}

template <bool ROUTER>
__device__ __forceinline__ void phase_norm(const Frame& F, const Args& A, const float* xin, const float* gain, bf16* H, const float* router, int* tope, float* topw, unsigned* cnt) {
    const int lane = F.lane;
    f32x4 gv[4];
#pragma unroll
    for (int j = 0; j < 4; ++j) gv[j] = *(const f32x4*)(gain + 4 * lane + 256 * j);
    for (int m = F.gw; m < TH; m += F.NGW) {
        const float* xr = xin + (size_t)m * D; f32x4 v[4]; float ss = 0.f;
#pragma unroll
        for (int j = 0; j < 4; ++j) { v[j] = *(const f32x4*)(xr + 4 * lane + 256 * j); ss += (v[j].x * v[j].x + v[j].y * v[j].y) + (v[j].z * v[j].z + v[j].w * v[j].w); }
        const float rstd = 1.0f / sqrtf(wave_sum(ss) * (1.0f / D) + EPS);
#pragma unroll
        for (int j = 0; j < 4; ++j) { v[j] = v[j] * rstd * gv[j]; st_bf16x4(H + (size_t)m * D + 4 * lane + 256 * j, v[j]); }
        if (ROUTER) {
            float lg[8];
#pragma unroll
            for (int e = 0; e < 8; ++e) lg[e] = 0.f;
#pragma unroll
            for (int j = 0; j < 4; ++j)
#pragma unroll
                for (int q = 0; q < 4; ++q) { const float* rp = router + (size_t)(4 * lane + 256 * j + q) * 8; const f32x4 r0 = *(const f32x4*)rp, r1 = *(const f32x4*)(rp + 4); const float hv = v[j][q];
                    lg[0] += hv * r0.x; lg[1] += hv * r0.y; lg[2] += hv * r0.z; lg[3] += hv * r0.w; lg[4] += hv * r1.x; lg[5] += hv * r1.y; lg[6] += hv * r1.z; lg[7] += hv * r1.w; }
#pragma unroll
            for (int e = 0; e < 8; ++e) lg[e] = wave_sum(lg[e]);
            if (lane == 0) {
                int e1 = 0; float l1 = lg[0];
#pragma unroll
                for (int e = 1; e < 8; ++e) if (lg[e] > l1) { l1 = lg[e]; e1 = e; }
                int e2 = -1; float l2 = -3.0e38f;
#pragma unroll
                for (int e = 0; e < 8; ++e) if (e != e1 && lg[e] > l2) { l2 = lg[e]; e2 = e; }
                const float w1 = 1.0f / (1.0f + expf(l2 - l1));
                tope[2 * m] = e1; tope[2 * m + 1] = e2; topw[2 * m] = w1; topw[2 * m + 1] = 1.0f - w1;
                ATOMIC_ADD_U32(cnt + e1, 1u); ATOMIC_ADD_U32(cnt + e2, 1u);
            }
        }
    }
}
__device__ __forceinline__ void phase_rope_table(const Frame& F, const Args& A, const int* pos, float* rope) {
    for (int idx = F.bid * 512 + F.tid; idx < TH * 32; idx += F.G * 512) { const int t = idx >> 5, i = idx & 31;
        const float inv = powf(10000.0f, -(float)i / 32.0f);
        const float ang = (float)pos[t] * inv; float sn, cs; sincosf(ang, &sn, &cs);
        rope[(size_t)t * 64 + i] = cs; rope[(size_t)t * 64 + 32 + i] = sn; }
}
__device__ __forceinline__ void phase_final_norm(const Frame& F, const Args& A, float* x, const float* gain) {
    const int lane = F.lane;
    for (int m = F.gw; m < T; m += F.NGW) {
        float* xr = x + (size_t)m * D; f32x4 v[4]; float ss = 0.f;
#pragma unroll
        for (int j = 0; j < 4; ++j) { v[j] = *(const f32x4*)(xr + 4 * lane + 256 * j); ss += (v[j].x * v[j].x + v[j].y * v[j].y) + (v[j].z * v[j].z + v[j].w * v[j].w); }
        const float rstd = 1.0f / sqrtf(wave_sum(ss) * (1.0f / D) + EPS);
#pragma unroll
        for (int j = 0; j < 4; ++j) *(f32x4*)(xr + 4 * lane + 256 * j) = v[j] * rstd * *(const f32x4*)(gain + 4 * lane + 256 * j);
    }
}

__device__ __forceinline__ void phase_mla_prep(const Frame& F, const Args& A) {
    bf16* P = WSP(bf16, A_P); bf16* kr = WSP(bf16, M_KR); const float* rope = WSP(float, A_ROPE);
    const int lane = F.lane;
    for (int m = F.gw; m < TH; m += F.NGW) {
        bf16* pr = P + (size_t)m * PW; float sq = 0.f, skv = 0.f; f32x4 v[3];
#pragma unroll
        for (int j = 0; j < 3; ++j) { const int c = 4 * lane + 256 * j; v[j] = ld_bf16x4(pr + c); const float s = (v[j].x * v[j].x + v[j].y * v[j].y) + (v[j].z * v[j].z + v[j].w * v[j].w);
            if (c < 384) sq += s; else if (c < 640) skv += s; }
        sq = wave_sum(sq); skv = wave_sum(skv);
        const float rq = 1.0f / sqrtf(sq * (1.0f / 384.0f) + EPS), rkv = 1.0f / sqrtf(skv * (1.0f / 256.0f) + EPS);
#pragma unroll
        for (int j = 0; j < 3; ++j) { const int c = 4 * lane + 256 * j; if (c < 640) st_bf16x4(pr + c, v[j] * (c < 384 ? rq : rkv)); }
        if (lane < 32) { const float x1 = bf2f(pr[640 + lane]), x2 = bf2f(pr[672 + lane]), c = rope[(size_t)m * 64 + lane], s = rope[(size_t)m * 64 + 32 + lane];
            kr[(size_t)m * 64 + lane] = (bf16)f2bf(x1 * c - x2 * s); kr[(size_t)m * 64 + 32 + lane] = (bf16)f2bf(x2 * c + x1 * s); }
    }
}
__device__ __forceinline__ void phase_mla_q(const Frame& F, const Args& A) {
    pg8::Gemm g{WSP(bf16, A_P) + 0, WSP(bf16, W_UQ), PW, 384}; pg8::StaticOrder S; S.init(TH, 768, F.G, F.bid);
    EpiBf16 E{WSP(bf16, M_Q), 768, nullptr, 0}; pg8::gemm_phase(F.lds, g, S, E, F.tid);
}
struct EpiKV {
    static constexpr bool PERM = true, AFTER_DRAIN = false;
    bf16* KV; bf16* VT;
    __device__ __forceinline__ void operator()(const f32x4 (&acc)[2][2][4][2], const Unit& u, int wr, int wc, int fr, int fq) const {
        const int row0 = u.pm * 256 + wr * 64 + fr, col0 = wc * 32 + 8 * fq;
#pragma unroll
        for (int ai = 0; ai < 2; ++ai)
#pragma unroll
            for (int m = 0; m < 4; ++m) { const int row = row0 + ai * HALFT + m * 16;
                { const f32x4 v0 = acc[ai][0][m][0], v1 = acc[ai][0][m][1]; u32x4 w; w.x = pk2(v0[0], v0[1]); w.y = pk2(v0[2], v0[3]); w.z = pk2(v1[0], v1[1]); w.w = pk2(v1[2], v1[3]);
                  *(u32x4*)(KV + (size_t)row * 1024 + u.pn * 256 + col0) = w; }
                const int b = row / SEQ, t = row % SEQ; bf16* vt = VT + ((size_t)(b * 4 + u.pn) * 128 + col0) * SEQ + t;
#pragma unroll
                for (int n = 0; n < 2; ++n)
#pragma unroll
                    for (int j = 0; j < 4; ++j) vt[(size_t)(4 * n + j) * SEQ] = (bf16)f2bf(acc[ai][1][m][n][j]); }
    }
};
__device__ __forceinline__ void phase_mla_kv(const Frame& F, const Args& A) {
    pg8::Gemm g{WSP(bf16, A_P) + 384, WSP(bf16, W_UKV), PW, 256}; pg8::StaticOrder S; S.init(TH, 1024, F.G, F.bid);
    EpiKV E{WSP(bf16, M_KV), WSP(bf16, M_VT)}; pg8::gemm_phase(F.lds, g, S, E, F.tid);
}
constexpr int AT_KS = 200, AT_VS = 72;
constexpr int AT_KBYTES = 64 * AT_KS * 2, AT_VBYTES = 128 * AT_VS * 2;
__device__ __forceinline__ void phase_attention(const Frame& F, const Args& A) {
    const bf16* Q = WSP(bf16, M_Q); const bf16* KV = WSP(bf16, M_KV); const bf16* KR = WSP(bf16, M_KR); const bf16* VTg = WSP(bf16, M_VT); const float* rope = WSP(float, A_ROPE); bf16* Y = WSP(bf16, A_Y);
    const int lane = F.lane, w = F.wave, l15 = lane & 15, q4 = lane >> 4, tid = F.tid, grp = w >> 2, wq = w & 3;
    const int NQB = SEQ / 128, nunits = BH * 4 * NQB;
    const float sc2 = 0.07216878364870322f * 1.4426950408889634f;
    for (int unit = F.bid; unit < nunits; unit += F.G) {
        const int qb = NQB - 1 - (unit / (BH * 4)), bh = unit % (BH * 4), h = bh & 3, b = bh >> 2;
        const size_t t0 = (size_t)b * SEQ;
        bf16x8 qf[2][6];
#pragma unroll
        for (int f = 0; f < 2; ++f) { const size_t tq = t0 + qb * 128 + wq * 32 + 16 * f + l15;
#pragma unroll
            for (int ks = 0; ks < 6; ++ks) qf[f][ks] = *(const bf16x8*)(Q + tq * 768 + h * 192 + 32 * ks + 8 * q4);
            const bf16x8 a = qf[f][4], c2 = qf[f][5];
#pragma unroll
            for (int j = 0; j < 8; ++j) { const float x1 = bf2f((unsigned short)a[j]), x2 = bf2f((unsigned short)c2[j]), c = rope[tq * 64 + 8 * q4 + j], sn = rope[tq * 64 + 32 + 8 * q4 + j];
                qf[f][4][j] = (short)f2bf(x1 * c - x2 * sn); qf[f][5][j] = (short)f2bf(x2 * c + x1 * sn); } }
        f32x4 o[2][8];
#pragma unroll
        for (int f = 0; f < 2; ++f)
#pragma unroll
            for (int mb = 0; mb < 8; ++mb) o[f][mb] = (f32x4){0.f, 0.f, 0.f, 0.f};
        float mrow[2] = {-3.0e38f, -3.0e38f}, lrow[2] = {0.f, 0.f};
        const int qchunk = 2 * qb + (wq >> 1), ntile = 2 * qb + 2;
        u32x4 pk_[3], pv_[2];
        const int skey = tid >> 3, c8 = tid & 7;
        const int okv = skey * 1024 + 8 * c8, okr = skey * 64 + 8 * c8, ovt = skey * SEQ + 8 * c8;
        const bf16* kvb = KV + t0 * 1024 + h * 256; const bf16* krb = KR + t0 * 64; const bf16* vtb = VTg + (size_t)(b * 4 + h) * 128 * SEQ;
#define AT_LOAD(kt) do { const bf16* kv_ = kvb + (size_t)(kt) * 65536; const bf16* kr_ = krb + (size_t)(kt) * 4096; const bf16* vt_ = vtb + (size_t)(kt) * 64; \
            pk_[0] = *(const u32x4*)(kv_ + okv); pk_[1] = *(const u32x4*)(kv_ + okv + 64); pk_[2] = *(const u32x4*)(kr_ + okr); \
            pv_[0] = *(const u32x4*)(vt_ + ovt); pv_[1] = *(const u32x4*)(vt_ + ovt + 64 * SEQ); } while (0)
#define AT_STORE(bufi) do { LAS bf16* Ks_ = (LAS bf16*)(F.lds + (bufi) * (AT_KBYTES + AT_VBYTES)); LAS bf16* Vt_ = (LAS bf16*)((LAS unsigned char*)Ks_ + AT_KBYTES); \
            *(LAS u32x4*)(Ks_ + skey * AT_KS + 8 * c8) = pk_[0]; *(LAS u32x4*)(Ks_ + skey * AT_KS + 8 * c8 + 64) = pk_[1]; *(LAS u32x4*)(Ks_ + skey * AT_KS + 8 * c8 + 128) = pk_[2]; \
            *(LAS u32x4*)(Vt_ + skey * AT_VS + 8 * c8) = pv_[0]; *(LAS u32x4*)(Vt_ + (skey + 64) * AT_VS + 8 * c8) = pv_[1]; } while (0)
        __syncthreads();
        AT_LOAD(0); AT_STORE(0);
        __syncthreads();
        for (int kt = 0; kt < ntile; ++kt) {
            if (kt + 1 < ntile) AT_LOAD(kt + 1);
            if (kt <= qchunk) {
                const LAS bf16* Ks = (const LAS bf16*)(F.lds + (kt & 1) * (AT_KBYTES + AT_VBYTES)); const LAS bf16* Vt = (const LAS bf16*)((const LAS unsigned char*)Ks + AT_KBYTES);
                f32x4 st[2][2];
#pragma unroll
                for (int kb = 0; kb < 2; ++kb) { st[0][kb] = (f32x4){0.f, 0.f, 0.f, 0.f}; st[1][kb] = (f32x4){0.f, 0.f, 0.f, 0.f};
#pragma unroll
                    for (int ks = 0; ks < 6; ++ks) { const bf16x8 kf = *(const LAS bf16x8*)(Ks + (32 * grp + 16 * kb + l15) * AT_KS + 32 * ks + 8 * q4);
                        st[0][kb] = MFMA_BF16(kf, qf[0][ks], st[0][kb]); st[1][kb] = MFMA_BF16(kf, qf[1][ks], st[1][kb]); } }
                bf16x8 pb[2];
#pragma unroll
                for (int f = 0; f < 2; ++f) {
                    float mx = -3.0e38f;
#pragma unroll
                    for (int kb = 0; kb < 2; ++kb) { st[f][kb] = st[f][kb] * sc2; mx = fmaxf(mx, fmaxf(fmaxf(st[f][kb].x, st[f][kb].y), fmaxf(st[f][kb].z, st[f][kb].w))); }
                    mx = fmaxf(mx, __shfl_xor(mx, 16)); mx = fmaxf(mx, __shfl_xor(mx, 32));
                    const float mnew = fmaxf(mrow[f], mx), alpha = exp2f(mrow[f] - mnew); mrow[f] = mnew;
                    float ps = 0.f;
#pragma unroll
                    for (int kb = 0; kb < 2; ++kb)
#pragma unroll
                        for (int r = 0; r < 4; ++r) { const float p = exp2f(st[f][kb][r] - mnew); ps += p; pb[f][4 * kb + r] = (short)f2bf(p); }
                    lrow[f] = lrow[f] * alpha + ps;
#pragma unroll
                    for (int mb = 0; mb < 8; ++mb) o[f][mb] = o[f][mb] * alpha;
                }
#pragma unroll
                for (int mb = 0; mb < 8; ++mb) { const LAS bf16* vp = Vt + (16 * mb + l15) * AT_VS + 32 * grp + 4 * q4;
                    const bf16x4 v0 = *(const LAS bf16x4*)vp, v1 = *(const LAS bf16x4*)(vp + 16);
                    bf16x8 vf; vf[0] = v0[0]; vf[1] = v0[1]; vf[2] = v0[2]; vf[3] = v0[3]; vf[4] = v1[0]; vf[5] = v1[1]; vf[6] = v1[2]; vf[7] = v1[3];
                    o[0][mb] = MFMA_BF16(vf, pb[0], o[0][mb]); o[1][mb] = MFMA_BF16(vf, pb[1], o[1][mb]); }
            }
            if (kt + 1 < ntile) AT_STORE((kt + 1) & 1);
            __syncthreads();
        }
#undef AT_LOAD
#undef AT_STORE
#pragma unroll
        for (int f = 0; f < 2; ++f) { lrow[f] += __shfl_xor(lrow[f], 16); lrow[f] += __shfl_xor(lrow[f], 32); }
        LAS float* xo = (LAS float*)F.lds + (size_t)wq * (2 * 8 * 4 * 64 + 4 * 64);
        if (grp == 1) {
#pragma unroll
            for (int f = 0; f < 2; ++f) {
#pragma unroll
                for (int mb = 0; mb < 8; ++mb)
#pragma unroll
                    for (int r = 0; r < 4; ++r) xo[((f * 8 + mb) * 4 + r) * 64 + lane] = o[f][mb][r];
                xo[2 * 8 * 4 * 64 + f * 64 + lane] = mrow[f]; xo[2 * 8 * 4 * 64 + 128 + f * 64 + lane] = lrow[f]; } }
        __syncthreads();
        if (grp == 0) {
#pragma unroll
            for (int f = 0; f < 2; ++f) { const float m1 = xo[2 * 8 * 4 * 64 + f * 64 + lane], l1 = xo[2 * 8 * 4 * 64 + 128 + f * 64 + lane];
                const float m = fmaxf(mrow[f], m1), a0 = exp2f(mrow[f] - m), a1 = exp2f(m1 - m), inv = 1.0f / (lrow[f] * a0 + l1 * a1);
                const size_t tq = t0 + qb * 128 + wq * 32 + 16 * f + l15;
#pragma unroll
                for (int mb = 0; mb < 8; ++mb) { f32x4 v;
#pragma unroll
                    for (int r = 0; r < 4; ++r) v[r] = (o[f][mb][r] * a0 + xo[((f * 8 + mb) * 4 + r) * 64 + lane] * a1) * inv;
                    st_bf16x4(Y + tq * 512 + h * 128 + 16 * mb + 4 * q4, v); } } }
    }
    __syncthreads();
}

__device__ __forceinline__ f32x4 tile_bf(const LAS bf16* a, int lda, const LAS bf16* bt, int ldb, int K, f32x4 acc, int l15, int q4) {
    const LAS bf16* ap = a + l15 * lda + 8 * q4; const LAS bf16* bp = bt + l15 * ldb + 8 * q4;
#pragma unroll 4
    for (int ks = 0; ks < K / 32; ++ks) acc = MFMA_BF16(*(const LAS bf16x8*)(ap + 32 * ks), *(const LAS bf16x8*)(bp + 32 * ks), acc);
    return acc;
}
__device__ __forceinline__ f32x4 tile_mm(const LAS float* a, int lda, int ska, const LAS float* b, int ldb, int scb, int K, f32x4 acc, int l15, int q4);

__device__ __forceinline__ void phase_rwkv_prep(const Frame& F, const Args& A, int layer) {
    const bf16* P = WSP(bf16, A_P); bf16* RKV = WSP(bf16, R_RKV); bf16* LIN = WSP(bf16, R_LIN); const float* mu = A.in[8] + (size_t)layer * 1824;
    const int lane = F.lane;
    for (int m = F.gw; m < TH; m += F.NGW) {
        const bool first = (m % SEQ) == 0; const bf16* pr = P + (size_t)m * PW + C_RWKV;
#pragma unroll
        for (int j = 0; j < 8; ++j) { const int c = 4 * lane + 256 * j;
            if (c < 1824) { const f32x4 p = ld_bf16x4(pr + c); const f32x4 pv = first ? (f32x4){0.f, 0.f, 0.f, 0.f} : ld_bf16x4(pr - PW + c); const f32x4 muv = *(const f32x4*)(mu + c);
                f32x4 x = p + (pv - p) * muv;
                if (c < 1536) st_bf16x4(RKV + (size_t)m * 1536 + c, x);
                else { if (c < 1600) { x.x = tanhf(x.x); x.y = tanhf(x.y); x.z = tanhf(x.z); x.w = tanhf(x.w); }
                       else if (c >= 1664) { x.x = sigmoidf_(x.x); x.y = sigmoidf_(x.y); x.z = sigmoidf_(x.z); x.w = sigmoidf_(x.w); }
                       st_bf16x4(LIN + (size_t)m * 384 + (c - 1536), x); } } }
        if (lane < 24) st_bf16x4(LIN + (size_t)m * 384 + 288 + 4 * lane, (f32x4){0.f, 0.f, 0.f, 0.f});
    }
}
__device__ __forceinline__ void phase_rwkv_lora(const Frame& F, const Args& A) {
    pg8::Gemm g{WSP(bf16, R_LIN), WSP(bf16, W_LORA), 384, 384}; pg8::StaticOrder S; S.init(TH, 1536, F.G, F.bid);
    EpiF32 E{WSP(float, R_LOUT), 1536}; pg8::gemm_phase(F.lds, g, S, E, F.tid);
}
constexpr int RS = 72;
constexpr int RREC_COMMON = 4 * 64 * RS * 2 + 256;
constexpr int RREC_SLICE = 3 * 64 * 36 * 4;
constexpr int RREC_BYTES = RREC_COMMON + 2 * RREC_SLICE;
static_assert(RREC_BYTES == 92416, "record size (see R_REC in the workspace map)");
static_assert(RREC_COMMON % 16 == 0 && RREC_SLICE % 16 == 0, "record alignment");
__device__ __forceinline__ void phase_rwkv_r1(const Frame& F, const Args& A, int layer) {
    const bf16* RKV = WSP(bf16, R_RKV); const float* LOUT = WSP(float, R_LOUT); unsigned char* REC = WSP(unsigned char, R_REC);
    const float* w0 = A.in[9] + layer * 512; const float* a0 = A.in[11] + layer * 512; const float* k_k = A.in[14] + layer * 512; const float* k_a = A.in[15] + layer * 512;
    LAS bf16* kbar = (LAS bf16*)F.lds; LAS bf16* atil = kbar + 64 * RS; LAS bf16* khat = atil + 64 * RS; LAS bf16* rbar = khat + 64 * RS;
    LAS bf16* atT = rbar + 64 * RS; LAS bf16* khT = atT + 64 * RS; LAS bf16* vT = khT + 64 * RS; LAS bf16* Bm = vT + 64 * RS; LAS bf16* Em = Bm + 64 * RS;
    LAS float* Am = (LAS float*)(Em + 64 * RS);
    LAS float* X = Am + 64 * 68;
    LAS float* lam = Am;
    const int tid = F.tid, lane = F.lane, w = F.wave, l15 = lane & 15, q4 = lane >> 4;
    const int nunits = BH * 8 * NCH;
    for (int unit = F.bid; unit < nunits; unit += F.G) {
        const int c = unit % NCH, h = (unit / NCH) & 7, b = unit / (NCH * 8);
        const size_t tok0 = (size_t)b * SEQ + (size_t)c * 64;
        const int j = lane, cj = h * 64 + j;
        __syncthreads();
        float r_[8], km_[8], kk_[8], ka_[8], v_[8];
        { const float w0c = w0[cj], a0c = a0[cj], kkc = k_k[cj], kac = k_a[cj];
#pragma unroll
          for (int q = 0; q < 8; ++q) { const int t = w + 8 * q; const size_t tok = tok0 + t;
              const float r = bf2f(RKV[tok * 1536 + cj]), k = bf2f(RKV[tok * 1536 + 512 + cj]); v_[q] = bf2f(RKV[tok * 1536 + 1024 + cj]);
              const float wpre = LOUT[tok * 1536 + cj], apre = LOUT[tok * 1536 + 512 + cj];
              const float wl = -softplusf_(-(w0c + wpre)) - 0.5f, a = sigmoidf_(a0c + apre);
              const float kr = k * kkc, ss = wave_sum(kr * kr), kk = kr / sqrtf(ss + EPS);
              r_[q] = r; km_[q] = k * (1.0f + (a - 1.0f) * kac); kk_[q] = kk; ka_[q] = kk * a;
              lam[t * 64 + j] = -expf(wl); } }
        __syncthreads();
        if (w == 0) { float s = 0.f; for (int t = 0; t < 64; ++t) { s += lam[t * 64 + j]; lam[t * 64 + j] = s; } }
        __syncthreads();
        { const float Lend = lam[63 * 64 + j];
#pragma unroll
          for (int q = 0; q < 8; ++q) { const int t = w + 8 * q; const float L = lam[t * 64 + j], Lm1 = t ? lam[(t - 1) * 64 + j] : 0.f;
              const float eG = expf(L), eGi = expf(-L), eGm1 = expf(Lm1), eT = expf(Lend - L);
              const float kb = kk_[q] * eGm1;
              kbar[t * RS + j] = (bf16)f2bf(kb); X[t * 132 + j] = kb;
              atil[t * RS + j] = (bf16)f2bf(ka_[q] * eGi); khat[t * RS + j] = (bf16)f2bf(km_[q] * eGi); rbar[t * RS + j] = (bf16)f2bf(r_[q] * eG);
              atT[j * RS + t] = (bf16)f2bf(-ka_[q] * eT); khT[j * RS + t] = (bf16)f2bf(km_[q] * eT); vT[j * RS + t] = (bf16)f2bf(v_[q]); }
          if (w == 0) { float* gc = (float*)(REC + (size_t)unit * RREC_BYTES + 4 * 64 * RS * 2); gc[j] = expf(Lend); } }
        __syncthreads();
        unsigned char* rec = REC + (size_t)unit * RREC_BYTES;
        for (int tt = 0; tt < 8; ++tt) { const int tile = w * 8 + tt, which = tile >> 4, ti = (tile >> 2) & 3, tj = tile & 3;
            f32x4 acc = (f32x4){0.f, 0.f, 0.f, 0.f};
            if (tj <= ti) acc = tile_bf(((which & 2) ? rbar : kbar) + 16 * ti * RS, RS, ((which & 1) ? khat : atil) + 16 * tj * RS, RS, 64, acc, l15, q4);
#pragma unroll
            for (int r = 0; r < 4; ++r) { const int i = 16 * ti + 4 * q4 + r, jj = 16 * tj + l15; const bool keep = (which & 2) ? (jj <= i) : (jj < i); const float v = keep ? acc[r] : 0.f;
                if (which == 0) Am[i * 68 + jj] = v; else if (which == 1) Bm[i * RS + jj] = (bf16)f2bf(v); else if (which == 3) Em[i * RS + jj] = (bf16)f2bf(v);
                else ((bf16*)(rec + 2 * 64 * RS * 2))[i * RS + jj] = (bf16)f2bf(-v); } }
        __syncthreads();
        for (int tt = 0; tt < 6; ++tt) { const int tile = w * 6 + tt, which = tile >> 4, ti = (tile >> 2) & 3, tj = tile & 3;
            const LAS bf16* aop = which == 0 ? Bm : which == 1 ? Em : khT;
            const f32x4 acc = tile_bf(aop + 16 * ti * RS, RS, vT + 16 * tj * RS, RS, 64, (f32x4){0.f, 0.f, 0.f, 0.f}, l15, q4);
#pragma unroll
            for (int r = 0; r < 4; ++r) { const int i = 16 * ti + 4 * q4 + r, vv = 16 * tj + l15;
                if (which == 0) X[i * 132 + 64 + vv] = acc[r];
                else { float* dst = (float*)(rec + RREC_COMMON + (vv >> 5) * RREC_SLICE + (which == 1 ? 1 : 2) * 64 * 36 * 4); dst[i * 36 + (vv & 31)] = acc[r]; } } }
        __syncthreads();
        for (int rb = 0; rb < 4; ++rb) {
            if (rb > 0) {
                const f32x4 acc = tile_mm(Am + 16 * rb * 68, 68, 1, X + 16 * w, 132, 1, 16 * rb, (f32x4){0.f, 0.f, 0.f, 0.f}, l15, q4);
#pragma unroll
                for (int r = 0; r < 4; ++r) X[(16 * rb + 4 * q4 + r) * 132 + 16 * w + l15] -= acc[r];
                __syncthreads();
            }
            if (tid < 128) { float x[16];
#pragma unroll
                for (int i = 0; i < 16; ++i) { float sacc = X[(16 * rb + i) * 132 + tid];
#pragma unroll
                    for (int jj = 0; jj < i; ++jj) sacc -= Am[(16 * rb + i) * 68 + 16 * rb + jj] * x[jj];
                    x[i] = sacc; }
#pragma unroll
                for (int i = 0; i < 16; ++i) X[(16 * rb + i) * 132 + tid] = x[i]; }
            __syncthreads();
        }
        for (int e = tid; e < 64 * 64; e += 512) { const int t = e >> 6, jj = e & 63; ((bf16*)rec)[t * RS + jj] = (bf16)f2bf(X[t * 132 + jj]);
            float* ub = (float*)(rec + RREC_COMMON + (jj >> 5) * RREC_SLICE); ub[t * 36 + (jj & 31)] = X[t * 132 + 64 + jj]; }
        for (int e = tid; e < 64 * RS / 8; e += 512) { ((u32x4*)(rec + 64 * RS * 2))[e] = ((const LAS u32x4*)rbar)[e]; ((u32x4*)(rec + 3 * 64 * RS * 2))[e] = ((const LAS u32x4*)atT)[e]; }
    }
    __syncthreads();
}
constexpr int R2_BUF = RREC_COMMON + RREC_SLICE;
__device__ __forceinline__ void phase_rwkv_r2(const Frame& F, const Args& A) {
    const unsigned char* REC = WSP(unsigned char, R_REC); float* RO = WSP(float, R_O);
    LAS unsigned char* buf0 = F.lds; LAS bf16* HT = (LAS bf16*)(F.lds + 2 * R2_BUF); LAS bf16* UT = HT + 2 * 32 * RS;
    const int tid = F.tid, lane = F.lane, w = F.wave, l15 = lane & 15, q4 = lane >> 4, ti = w >> 1, tj = w & 1;
    const int nunits = BH * 8 * 2;
    constexpr int NCHK = R2_BUF / 16;
    for (int unit = F.bid; unit < nunits; unit += F.G) {
        const int vs = unit & 1, h = (unit >> 1) & 7, b = unit >> 4;
        __syncthreads();
        for (int e = tid; e < 2 * 32 * RS / 2; e += 512) ((LAS unsigned*)HT)[e] = 0u;
        f32x4 Hreg = (f32x4){0.f, 0.f, 0.f, 0.f};
        u32x4 pre[8];
        { const unsigned char* rec = REC + (size_t)((b * 8 + h) * NCH) * RREC_BYTES;
#pragma unroll
          for (int q = 0; q < 8; ++q) { const int e = tid + 512 * q; if (e < NCHK) { const size_t off = (size_t)e * 16; pre[q] = *(const u32x4*)(rec + (off < RREC_COMMON ? off : off + (size_t)vs * RREC_SLICE)); } }
#pragma unroll
          for (int q = 0; q < 8; ++q) { const int e = tid + 512 * q; if (e < NCHK) *(LAS u32x4*)(buf0 + (size_t)e * 16) = pre[q]; } }
        __syncthreads();
        for (int c = 0; c < NCH; ++c) {
            LAS unsigned char* buf = buf0 + (c & 1) * R2_BUF; LAS unsigned char* nbuf = buf0 + ((c + 1) & 1) * R2_BUF;
            if (c + 1 < NCH) { const unsigned char* rec = REC + (size_t)((b * 8 + h) * NCH + c + 1) * RREC_BYTES;
#pragma unroll
                for (int q = 0; q < 8; ++q) { const int e = tid + 512 * q; if (e < NCHK) { const size_t off = (size_t)e * 16; pre[q] = *(const u32x4*)(rec + (off < RREC_COMMON ? off : off + (size_t)vs * RREC_SLICE)); } } }
            const LAS bf16* KB = (const LAS bf16*)buf; const LAS bf16* RB = KB + 64 * RS; const LAS bf16* FMn = RB + 64 * RS; const LAS bf16* ATn = FMn + 64 * RS;
            const LAS float* GC = (const LAS float*)(buf + 4 * 64 * RS * 2); const LAS float* UB = (const LAS float*)(buf + RREC_COMMON); const LAS float* OB = UB + 64 * 36; const LAS float* KV = OB + 64 * 36;
            const LAS bf16* H0 = HT + (c & 1) * 32 * RS; LAS bf16* H1 = HT + ((c + 1) & 1) * 32 * RS;
            f32x4 u;
#pragma unroll
            for (int r = 0; r < 4; ++r) u[r] = UB[(16 * ti + 4 * q4 + r) * 36 + 16 * tj + l15];
            u = tile_bf(KB + 16 * ti * RS, RS, H0 + 16 * tj * RS, RS, 64, u, l15, q4);
            { u32x2 pk; pk.x = pk2(u[0], u[1]); pk.y = pk2(u[2], u[3]); *(LAS u32x2*)(UT + (16 * tj + l15) * RS + 16 * ti + 4 * q4) = pk; }
            __syncthreads();
            f32x4 o;
#pragma unroll
            for (int r = 0; r < 4; ++r) o[r] = OB[(16 * ti + 4 * q4 + r) * 36 + 16 * tj + l15];
            o = tile_bf(RB + 16 * ti * RS, RS, H0 + 16 * tj * RS, RS, 64, o, l15, q4);
            o = tile_bf(FMn + 16 * ti * RS, RS, UT + 16 * tj * RS, RS, 64, o, l15, q4);
#pragma unroll
            for (int r = 0; r < 4; ++r) RO[((size_t)b * SEQ + (size_t)c * 64 + 16 * ti + 4 * q4 + r) * 512 + h * 64 + 32 * vs + 16 * tj + l15] = o[r];
#pragma unroll
            for (int r = 0; r < 4; ++r) Hreg[r] = Hreg[r] * GC[16 * ti + 4 * q4 + r] + KV[(16 * ti + 4 * q4 + r) * 36 + 16 * tj + l15];
            Hreg = tile_bf(ATn + 16 * ti * RS, RS, UT + 16 * tj * RS, RS, 64, Hreg, l15, q4);
            { u32x2 pk; pk.x = pk2(Hreg[0], Hreg[1]); pk.y = pk2(Hreg[2], Hreg[3]); *(LAS u32x2*)(H1 + (16 * tj + l15) * RS + 16 * ti + 4 * q4) = pk; }
            if (c + 1 < NCH) {
#pragma unroll
                for (int q = 0; q < 8; ++q) { const int e = tid + 512 * q; if (e < NCHK) *(LAS u32x4*)(nbuf + (size_t)e * 16) = pre[q]; } }
            __syncthreads();
        }
    }
    __syncthreads();
}
__device__ __forceinline__ void phase_rwkv_post(const Frame& F, const Args& A, int layer) {
    const bf16* RKV = WSP(bf16, R_RKV); const float* LOUT = WSP(float, R_LOUT); const float* RO = WSP(float, R_O); bf16* Y = WSP(bf16, A_Y) + (size_t)1 * TH * 512;
    const float* a0 = A.in[11] + layer * 512; const float* k_a = A.in[15] + layer * 512; const float* r_k = A.in[16] + layer * 512; const float* ln_w = A.in[17] + layer * 512; const float* ln_b = A.in[18] + layer * 512;
    const int lane = F.lane, c0 = 8 * lane;
    for (int m = F.gw; m < TH; m += F.NGW) {
        float o[8], r[8], k[8], v[8], ap[8], g[8];
        { const f32x4 a = *(const f32x4*)(RO + (size_t)m * 512 + c0), b2 = *(const f32x4*)(RO + (size_t)m * 512 + c0 + 4); o[0] = a.x; o[1] = a.y; o[2] = a.z; o[3] = a.w; o[4] = b2.x; o[5] = b2.y; o[6] = b2.z; o[7] = b2.w; }
#pragma unroll
        for (int hh = 0; hh < 2; ++hh) { const f32x4 rv = ld_bf16x4(RKV + (size_t)m * 1536 + c0 + 4 * hh), kv = ld_bf16x4(RKV + (size_t)m * 1536 + 512 + c0 + 4 * hh), vv = ld_bf16x4(RKV + (size_t)m * 1536 + 1024 + c0 + 4 * hh);
            const f32x4 av = *(const f32x4*)(LOUT + (size_t)m * 1536 + 512 + c0 + 4 * hh), gv = *(const f32x4*)(LOUT + (size_t)m * 1536 + 1024 + c0 + 4 * hh);
#pragma unroll
            for (int q = 0; q < 4; ++q) { r[4 * hh + q] = rv[q]; k[4 * hh + q] = kv[q]; v[4 * hh + q] = vv[q]; ap[4 * hh + q] = av[q]; g[4 * hh + q] = gv[q]; } }
        float bon = 0.f, sm = 0.f;
#pragma unroll
        for (int q = 0; q < 8; ++q) { const float a = sigmoidf_(a0[c0 + q] + ap[q]); const float km = k[q] * (1.0f + (a - 1.0f) * k_a[c0 + q]); bon += r[q] * km * r_k[c0 + q]; sm += o[q]; }
        bon += __shfl_xor(bon, 1); bon += __shfl_xor(bon, 2); bon += __shfl_xor(bon, 4);
        sm += __shfl_xor(sm, 1); sm += __shfl_xor(sm, 2); sm += __shfl_xor(sm, 4);
        const float mean = sm * (1.0f / 64.0f); float vs = 0.f;
#pragma unroll
        for (int q = 0; q < 8; ++q) { const float d = o[q] - mean; vs += d * d; }
        vs += __shfl_xor(vs, 1); vs += __shfl_xor(vs, 2); vs += __shfl_xor(vs, 4);
        const float rstd = 1.0f / sqrtf(vs * (1.0f / 64.0f) + 64e-5f);
        float y[8];
#pragma unroll
        for (int q = 0; q < 8; ++q) y[q] = ((o[q] - mean) * rstd * ln_w[c0 + q] + ln_b[c0 + q] + bon * v[q]) * g[q];
        u32x4 wv; wv.x = pk2(y[0], y[1]); wv.y = pk2(y[2], y[3]); wv.z = pk2(y[4], y[5]); wv.w = pk2(y[6], y[7]);
        *(u32x4*)(Y + (size_t)m * 512 + c0) = wv;
    }
}

__device__ __forceinline__ void conv8x8(const bf16* src, int tl0  , const float* w  , int wld, const float* bias, float (&out)[8][8]) {
    float x[11][8];
#pragma unroll
    for (int i = 0; i < 11; ++i) { const int tl = tl0 - 3 + i;
        if (tl >= 0) { const u32x4 v = *(const u32x4*)(src + (ptrdiff_t)(i - 3) * PW);
            x[i][0] = bf2f(v.x & 0xffffu); x[i][1] = bf2f(v.x >> 16); x[i][2] = bf2f(v.y & 0xffffu); x[i][3] = bf2f(v.y >> 16); x[i][4] = bf2f(v.z & 0xffffu); x[i][5] = bf2f(v.z >> 16); x[i][6] = bf2f(v.w & 0xffffu); x[i][7] = bf2f(v.w >> 16); }
        else {
#pragma unroll
            for (int ch = 0; ch < 8; ++ch) x[i][ch] = 0.f; } }
    float wv[4][8], bv[8];
#pragma unroll
    for (int j = 0; j < 4; ++j) { const f32x4 a = *(const f32x4*)(w + j * wld), b = *(const f32x4*)(w + j * wld + 4); wv[j][0] = a.x; wv[j][1] = a.y; wv[j][2] = a.z; wv[j][3] = a.w; wv[j][4] = b.x; wv[j][5] = b.y; wv[j][6] = b.z; wv[j][7] = b.w; }
    if (bias) { const f32x4 a = *(const f32x4*)bias, b = *(const f32x4*)(bias + 4); bv[0] = a.x; bv[1] = a.y; bv[2] = a.z; bv[3] = a.w; bv[4] = b.x; bv[5] = b.y; bv[6] = b.z; bv[7] = b.w; }
    else {
#pragma unroll
        for (int ch = 0; ch < 8; ++ch) bv[ch] = 0.f; }
#pragma unroll
    for (int i = 0; i < 8; ++i)
#pragma unroll
        for (int ch = 0; ch < 8; ++ch) { const float a = bv[ch] + wv[0][ch] * x[i][ch] + wv[1][ch] * x[i + 1][ch] + wv[2][ch] * x[i + 2][ch] + wv[3][ch] * x[i + 3][ch]; out[i][ch] = a * fast_rcp(1.0f + fast_exp(-a)); }
}
__device__ __forceinline__ u32x4 pack8(const float* v) { u32x4 o; o.x = pk2(v[0], v[1]); o.y = pk2(v[2], v[3]); o.z = pk2(v[4], v[5]); o.w = pk2(v[6], v[7]); return o; }
constexpr int SB = 136;
constexpr int SC_IMG = 64 * SB * 2;
__device__ __forceinline__ void phase_ssd_s1(const Frame& F, const Args& A, int layer) {
    const bf16* P = WSP(bf16, A_P); bf16* ST = WSP(bf16, S_ST); float* YD = WSP(float, S_YD); unsigned char* SCB = WSP(unsigned char, S_C); float* AC = WSP(float, S_AC);
    const float* cw = A.in[23] + (size_t)layer * 4 * 1024; const float* cb = A.in[24] + layer * 1024; const float* dtb = A.in[25] + layer * 8; const float* a_log = A.in[26] + layer * 8; const float* dsk = A.in[27] + layer * 8;
    LAS bf16* Bt_ = (LAS bf16*)F.lds; LAS bf16* Ct_ = Bt_ + 64 * SB; LAS bf16* BT = Ct_ + 64 * SB; LAS bf16* xT = BT + 128 * RS;
    LAS bf16* Mb = xT + 4 * 64 * RS; LAS bf16* xdT = Mb + 2 * 64 * RS; LAS float* dt = (LAS float*)(xdT + 2 * 64 * RS); LAS float* ac = dt + 256;
    const int tid = F.tid, lane = F.lane, w = F.wave, l15 = lane & 15, q4 = lane >> 4;
    const int nunits = BH * NCH * 2;
    for (int unit = F.bid; unit < nunits; unit += F.G) {
        const int g = unit & 1, c = (unit >> 1) % NCH, b = unit / (2 * NCH);
        const size_t tok0 = (size_t)b * SEQ + (size_t)c * 64;
        __syncthreads();
        {
            const int cg = tid & 63, rb = tid >> 6;
            const int cidx = cg < 32 ? g * 256 + 8 * cg : cg < 48 ? 512 + g * 128 + 8 * (cg - 32) : 768 + g * 128 + 8 * (cg - 48);
            float o[8][8];
            conv8x8(P + (tok0 + 8 * rb) * PW + C_SSD + 512 + cidx, c * 64 + 8 * rb, cw + cidx, 1024, cb + cidx, o);
            if (cg < 32) {
                const int hh = cg >> 3, p0 = 8 * (cg & 7);
#pragma unroll
                for (int ch = 0; ch < 8; ++ch) { float col[8];
#pragma unroll
                    for (int i = 0; i < 8; ++i) col[i] = o[i][ch];
                    *(LAS u32x4*)(xT + (hh * 64 + p0 + ch) * RS + 8 * rb) = pack8(col); }
            } else if (cg < 48) {
                const int n0 = 8 * (cg - 32);
#pragma unroll
                for (int i = 0; i < 8; ++i) *(LAS u32x4*)(Bt_ + (8 * rb + i) * SB + n0) = pack8(o[i]);
#pragma unroll
                for (int ch = 0; ch < 8; ++ch) { float col[8];
#pragma unroll
                    for (int i = 0; i < 8; ++i) col[i] = o[i][ch];
                    *(LAS u32x4*)(BT + (n0 + ch) * RS + 8 * rb) = pack8(col); }
            } else { const int n0 = 8 * (cg - 48);
#pragma unroll
                for (int i = 0; i < 8; ++i) *(LAS u32x4*)(Ct_ + (8 * rb + i) * SB + n0) = pack8(o[i]); }
        }
        if (tid < 256) { const int hh = tid >> 6, h = 4 * g + hh; const float d = softplusf_(bf2f(P[(tok0 + lane) * PW + C_SSD + 1536 + h]) + dtb[h]); float a = -expf(a_log[h]) * d;
#pragma unroll
            for (int o = 1; o < 64; o <<= 1) { const float t = __shfl_up(a, o); if (lane >= o) a += t; }
            dt[tid] = d; ac[tid] = a; AC[(tok0 + lane) * 8 + h] = a; }
        __syncthreads();
        { unsigned char* dst = SCB + (size_t)unit * SC_IMG; for (int e = tid; e < SC_IMG / 16; e += 512) ((u32x4*)dst)[e] = ((const LAS u32x4*)Ct_)[e]; }
        f32x4 cbt[2];
#pragma unroll
        for (int tt = 0; tt < 2; ++tt) { const int tile = w * 2 + tt, ti = tile >> 2, tj = tile & 3; cbt[tt] = (f32x4){0.f, 0.f, 0.f, 0.f};
            if (tj <= ti) cbt[tt] = tile_bf(Ct_ + 16 * ti * SB, SB, Bt_ + 16 * tj * SB, SB, 128, cbt[tt], l15, q4); }
        for (int hh = 0; hh < 4; ++hh) { const int h = 4 * g + hh; LAS bf16* M = Mb + (hh & 1) * 64 * RS; LAS bf16* xd = xdT + (hh & 1) * 64 * RS; const LAS float* dth = dt + hh * 64; const LAS float* ach = ac + hh * 64;
#pragma unroll
            for (int tt = 0; tt < 2; ++tt) { const int tile = w * 2 + tt, ti = tile >> 2, tj = tile & 3;
#pragma unroll
                for (int r = 0; r < 4; ++r) { const int l = 16 * ti + 4 * q4 + r, s = 16 * tj + l15; M[l * RS + s] = (bf16)f2bf((s <= l) ? cbt[tt][r] * expf(ach[l] - ach[s]) * dth[s] : 0.f); } }
            { const int p = tid >> 3, l0 = 8 * (tid & 7); const u32x4 v = *(const LAS u32x4*)(xT + (hh * 64 + p) * RS + l0); const float a63 = ach[63]; float xv[8] = {bf2f(v.x & 0xffffu), bf2f(v.x >> 16), bf2f(v.y & 0xffffu), bf2f(v.y >> 16), bf2f(v.z & 0xffffu), bf2f(v.z >> 16), bf2f(v.w & 0xffffu), bf2f(v.w >> 16)};
#pragma unroll
              for (int i = 0; i < 8; ++i) xv[i] *= dth[l0 + i] * expf(a63 - ach[l0 + i]);
              *(LAS u32x4*)(xd + p * RS + l0) = pack8(xv); }
            __syncthreads();
#pragma unroll
            for (int tt = 0; tt < 2; ++tt) { const int tile = w * 2 + tt, ti = tile >> 2, tj = tile & 3;
                const f32x4 acc = tile_bf(M + 16 * ti * RS, RS, xT + (hh * 64 + 16 * tj) * RS, RS, 64, (f32x4){0.f, 0.f, 0.f, 0.f}, l15, q4);
                const f32x4 xs = ld_bf16x4((const bf16*)(xT + (hh * 64 + 16 * tj + l15) * RS + 16 * ti + 4 * q4));
#pragma unroll
                for (int r = 0; r < 4; ++r) YD[(tok0 + 16 * ti + 4 * q4 + r) * 512 + h * 64 + 16 * tj + l15] = acc[r] + dsk[h] * xs[r]; }
            bf16* st = ST + ((size_t)((b * NCH + c) * 8 + h)) * 64 * 128;
#pragma unroll
            for (int tt = 0; tt < 4; ++tt) { const int tile = w * 4 + tt, ti = tile >> 2, tj = tile & 3;
                const f32x4 acc = tile_bf(BT + 16 * ti * RS, RS, xd + 16 * tj * RS, RS, 64, (f32x4){0.f, 0.f, 0.f, 0.f}, l15, q4);
                st_bf16x4(st + (16 * tj + l15) * 128 + 16 * ti + 4 * q4, acc); }
        }
    }
    __syncthreads();
}
__device__ __forceinline__ void phase_ssd_s23(const Frame& F, const Args& A) {
    const bf16* ST = WSP(bf16, S_ST); float* YD = WSP(float, S_YD); const unsigned char* SCB = WSP(unsigned char, S_C); const float* AC = WSP(float, S_AC);
    LAS bf16* Cimg = (LAS bf16*)F.lds; LAS bf16* Hb = Cimg + 2 * 64 * SB;
    const int tid = F.tid, lane = F.lane, w = F.wave, l15 = lane & 15, q4 = lane >> 4;
    const int nunits = BH * 8 * 4, hp = tid >> 5, hn = 4 * (tid & 31);
    constexpr int NCK = SC_IMG / 16;
    for (int unit = F.bid; unit < nunits; unit += F.G) {
        const int ps = unit & 3, h = (unit >> 2) & 7, b = unit >> 5, g = h >> 2;
        __syncthreads();
        f32x4 Hr = (f32x4){0.f, 0.f, 0.f, 0.f};
        u32x4 pre[3]; u32x2 pst;
        { const unsigned char* src = SCB + (size_t)((b * NCH + 0) * 2 + g) * SC_IMG;
#pragma unroll
          for (int q = 0; q < 3; ++q) { const int e = tid + 512 * q; if (e < NCK) ((LAS u32x4*)Cimg)[e] = *(const u32x4*)(src + (size_t)e * 16); } }
        pst = *(const u32x2*)(ST + ((size_t)((b * NCH + 0) * 8 + h)) * 8192 + (16 * ps + hp) * 128 + hn);
        for (int c = 0; c < NCH; ++c) {
            const size_t tok0 = (size_t)b * SEQ + (size_t)c * 64;
            const u32x2 stc = pst;
            if (c + 1 < NCH) { const unsigned char* src = SCB + (size_t)((b * NCH + c + 1) * 2 + g) * SC_IMG;
#pragma unroll
                for (int q = 0; q < 3; ++q) { const int e = tid + 512 * q; if (e < NCK) pre[q] = *(const u32x4*)(src + (size_t)e * 16); }
                pst = *(const u32x2*)(ST + ((size_t)((b * NCH + c + 1) * 8 + h)) * 8192 + (16 * ps + hp) * 128 + hn); }
            st_bf16x4((bf16*)(Hb + hp * SB + hn), Hr);
            __syncthreads();
            if (w < 4) { const LAS bf16* Ci = Cimg + (c & 1) * 64 * SB;
                const f32x4 acc = tile_bf(Ci + 16 * w * SB, SB, Hb, SB, 128, (f32x4){0.f, 0.f, 0.f, 0.f}, l15, q4);
#pragma unroll
                for (int r = 0; r < 4; ++r) { const size_t tok = tok0 + 16 * w + 4 * q4 + r; const size_t o = tok * 512 + h * 64 + 16 * ps + l15; YD[o] += acc[r] * expf(AC[tok * 8 + h]); } }
            { const float dec = expf(AC[(tok0 + 63) * 8 + h]); Hr.x = dec * Hr.x + bf2f(stc.x & 0xffffu); Hr.y = dec * Hr.y + bf2f(stc.x >> 16); Hr.z = dec * Hr.z + bf2f(stc.y & 0xffffu); Hr.w = dec * Hr.w + bf2f(stc.y >> 16); }
            if (c + 1 < NCH) { LAS u32x4* dst = (LAS u32x4*)(Cimg + ((c + 1) & 1) * 64 * SB);
#pragma unroll
                for (int q = 0; q < 3; ++q) { const int e = tid + 512 * q; if (e < NCK) dst[e] = pre[q]; } }
            __syncthreads();
        }
    }
    __syncthreads();
}
__device__ __forceinline__ void phase_ssd_s4(const Frame& F, const Args& A, int layer) {
    const float* YD = WSP(float, S_YD); const bf16* P = WSP(bf16, A_P); bf16* Y = WSP(bf16, A_Y) + (size_t)3 * TH * 512; const float* nw = A.in[28] + layer * 512;
    const int lane = F.lane, c0 = 8 * lane;
    for (int m = F.gw; m < TH; m += F.NGW) {
        const f32x4 a = *(const f32x4*)(YD + (size_t)m * 512 + c0), b2 = *(const f32x4*)(YD + (size_t)m * 512 + c0 + 4);
        const f32x4 z0 = ld_bf16x4(P + (size_t)m * PW + C_SSD + c0), z1 = ld_bf16x4(P + (size_t)m * PW + C_SSD + c0 + 4);
        float y[8] = {a.x * siluf_(z0.x), a.y * siluf_(z0.y), a.z * siluf_(z0.z), a.w * siluf_(z0.w), b2.x * siluf_(z1.x), b2.y * siluf_(z1.y), b2.z * siluf_(z1.z), b2.w * siluf_(z1.w)};
        float ss = 0.f;
#pragma unroll
        for (int q = 0; q < 8; ++q) ss += y[q] * y[q];
        ss += __shfl_xor(ss, 1); ss += __shfl_xor(ss, 2); ss += __shfl_xor(ss, 4); ss += __shfl_xor(ss, 8); ss += __shfl_xor(ss, 16);
        const float rstd = 1.0f / sqrtf(ss * (1.0f / 256.0f) + EPS);
#pragma unroll
        for (int q = 0; q < 8; ++q) y[q] = y[q] * rstd * nw[c0 + q];
        u32x4 wv; wv.x = pk2(y[0], y[1]); wv.y = pk2(y[2], y[3]); wv.z = pk2(y[4], y[5]); wv.w = pk2(y[6], y[7]);
        *(u32x4*)(Y + (size_t)m * 512 + c0) = wv;
    }
}

__device__ __forceinline__ f32x4 tile_mm(const LAS float* a, int lda, int ska, const LAS float* b, int ldb, int scb, int K, f32x4 acc, int l15, int q4) {
    const LAS float* ap = a + l15 * lda + q4 * ska; const LAS float* bp = b + q4 * ldb + l15 * scb;
#pragma unroll 8
    for (int ks = 0; ks < K / 4; ++ks) acc = MFMA_F32(ap[ks * 4 * ska], bp[ks * 4 * ldb], acc);
    return acc;
}
constexpr int GS = 132, GS2 = 68;
constexpr int GR_W = 0, GR_QH = 64 * 136 * 2, GR_KT = 2 * 64 * 136 * 2, GR_QK = GR_KT + 128 * 72 * 2, GR_GL = GR_QK + 64 * 72 * 2, GR_COMMON = GR_GL + 16, GR_USL = 64 * 20 * 4, GR_BYTES = GR_COMMON + 8 * GR_USL;
static_assert(GR_BYTES == 103440 && GR_COMMON % 16 == 0, "GDN record");
constexpr int GX = 264;
__device__ __forceinline__ void phase_gdn_g1(const Frame& F, const Args& A, int layer) {
    const bf16* P = WSP(bf16, A_P); unsigned char* CHR = WSP(unsigned char, G_CH);
    const float* convw = A.in[19] + (size_t)layer * 4 * 1536; const float* a_log = A.in[20] + layer * 4; const float* dtb = A.in[21] + layer * 4;
    LAS bf16* qb = (LAS bf16*)F.lds; LAS bf16* kb = qb + 64 * SB; LAS bf16* qkimg = kb + 64 * SB;
    LAS float* X = (LAS float*)(qkimg + 64 * RS); LAS float* Lm = X + 64 * GX; LAS float* ssq = Lm + 64 * GS2;
    LAS float* beta = ssq + 2 * 64 * 16; LAS float* gc = beta + 64; LAS float* egc = gc + 64; LAS float* inorm = egc + 64;
    const int tid = F.tid, lane = F.lane, w = F.wave, l15 = lane & 15, q4 = lane >> 4;
    const int nunits = BH * 4 * NCH;
    for (int unit = F.bid; unit < nunits; unit += F.G) {
        const int c = unit % NCH, h = (unit / NCH) & 3, b = unit / (NCH * 4);
        const size_t tok0 = (size_t)b * SEQ + (size_t)c * 64;
        unsigned char* rec = CHR + (size_t)unit * GR_BYTES;
        __syncthreads();
        const int rb = tid / 48, pc = tid % 48, part = pc >> 4, cgl = pc & 15;
        float o[8][8];
        if (tid < 384) { const int col = part * 512 + h * 128 + 8 * cgl;
            conv8x8(P + (tok0 + 8 * rb) * PW + C_GDN + col, c * 64 + 8 * rb, convw + col, 1536, nullptr, o);
            if (part < 2) {
#pragma unroll
                for (int i = 0; i < 8; ++i) { float sacc = 0.f;
#pragma unroll
                    for (int ch = 0; ch < 8; ++ch) sacc += o[i][ch] * o[i][ch];
                    ssq[(part * 64 + 8 * rb + i) * 16 + cgl] = sacc; } } }
        if (w == 7) { const size_t tok = tok0 + lane; beta[lane] = sigmoidf_(bf2f(P[tok * PW + C_GDN + 1536 + h]));
            float g = -expf(a_log[h]) * softplusf_(bf2f(P[tok * PW + C_GDN + 1540 + h]) + dtb[h]);
#pragma unroll
            for (int o2 = 1; o2 < 64; o2 <<= 1) { const float t = __shfl_up(g, o2); if (lane >= o2) g += t; }
            gc[lane] = g; egc[lane] = expf(g); }
        __syncthreads();
        if (tid < 128) { float sacc = 0.f;
#pragma unroll
            for (int i = 0; i < 16; ++i) sacc += ssq[tid * 16 + i];
            inorm[tid] = (tid < 64 ? 0.08838834764831845f : 1.0f) / sqrtf(sacc + EPS); }
        __syncthreads();
        if (tid < 384) {
#pragma unroll
            for (int i = 0; i < 8; ++i) { const int l = 8 * rb + i;
                if (part < 2) { const float sc = inorm[part * 64 + l]; float v[8];
#pragma unroll
                    for (int ch = 0; ch < 8; ++ch) v[ch] = o[i][ch] * sc;
                    *(LAS u32x4*)((part ? kb : qb) + l * SB + 8 * cgl) = pack8(v); }
                else { const float bl = beta[l]; *(LAS f32x4*)(X + l * GX + 8 * cgl) = (f32x4){o[i][0] * bl, o[i][1] * bl, o[i][2] * bl, o[i][3] * bl}; *(LAS f32x4*)(X + l * GX + 8 * cgl + 4) = (f32x4){o[i][4] * bl, o[i][5] * bl, o[i][6] * bl, o[i][7] * bl}; } } }
        __syncthreads();
        for (int tt = 0; tt < 4; ++tt) { const int tile = w * 4 + tt, which = tile >> 4, ti = (tile >> 2) & 3, tj = tile & 3;
            f32x4 acc = (f32x4){0.f, 0.f, 0.f, 0.f};
            if (tj <= ti) acc = tile_bf((which ? qb : kb) + 16 * ti * SB, SB, kb + 16 * tj * SB, SB, 128, acc, l15, q4);
#pragma unroll
            for (int r = 0; r < 4; ++r) { const int i = 16 * ti + 4 * q4 + r, j = 16 * tj + l15; float v = 0.f;
                if (which ? (j <= i) : (j < i)) v = acc[r] * expf(gc[i] - gc[j]) * (which ? 1.0f : beta[i]);
                if (which) qkimg[i * RS + j] = (bf16)f2bf(v); else Lm[i * GS2 + j] = v; } }
        { const float glast = gc[63];
          for (int e = tid; e < 64 * 16; e += 512) { const int l = e >> 4, d0 = 8 * (e & 15); const u32x4 kv = *(const LAS u32x4*)(kb + l * SB + d0), qv = *(const LAS u32x4*)(qb + l * SB + d0);
              const float kf[8] = {bf2f(kv.x & 0xffffu), bf2f(kv.x >> 16), bf2f(kv.y & 0xffffu), bf2f(kv.y >> 16), bf2f(kv.z & 0xffffu), bf2f(kv.z >> 16), bf2f(kv.w & 0xffffu), bf2f(kv.w >> 16)};
              float qf[8] = {bf2f(qv.x & 0xffffu), bf2f(qv.x >> 16), bf2f(qv.y & 0xffffu), bf2f(qv.y >> 16), bf2f(qv.z & 0xffffu), bf2f(qv.z >> 16), bf2f(qv.w & 0xffffu), bf2f(qv.w >> 16)};
              const float sc = beta[l] * egc[l], eg = egc[l];
              *(LAS f32x4*)(X + l * GX + 128 + d0) = (f32x4){kf[0] * sc, kf[1] * sc, kf[2] * sc, kf[3] * sc}; *(LAS f32x4*)(X + l * GX + 132 + d0) = (f32x4){kf[4] * sc, kf[5] * sc, kf[6] * sc, kf[7] * sc};
#pragma unroll
              for (int q = 0; q < 8; ++q) qf[q] *= eg;
              *(u32x4*)(rec + GR_QH + (size_t)(l * SB + d0) * 2) = pack8(qf); }
          for (int e = tid; e < 128 * 8; e += 512) { const int d = e >> 3, l0 = 8 * (e & 7); float kt[8];
#pragma unroll
              for (int q = 0; q < 8; ++q) kt[q] = bf2f(kb[(l0 + q) * SB + d]) * expf(glast - gc[l0 + q]);
              *(u32x4*)(rec + GR_KT + (size_t)(d * RS + l0) * 2) = pack8(kt); }
          if (tid == 0) *(float*)(rec + GR_GL) = expf(glast); }
        __syncthreads();
        for (int e = tid; e < 64 * RS / 8; e += 512) ((u32x4*)(rec + GR_QK))[e] = ((const LAS u32x4*)qkimg)[e];
        for (int rbk = 0; rbk < 4; ++rbk) {
            if (rbk > 0) {
#pragma unroll
                for (int t2 = 0; t2 < 2; ++t2) { const int tj = 2 * w + t2;
                    const f32x4 acc = tile_mm(Lm + 16 * rbk * GS2, GS2, 1, X + 16 * tj, GX, 1, 16 * rbk, (f32x4){0.f, 0.f, 0.f, 0.f}, l15, q4);
#pragma unroll
                    for (int r = 0; r < 4; ++r) X[(16 * rbk + 4 * q4 + r) * GX + 16 * tj + l15] -= acc[r]; }
                __syncthreads();
            }
            if (tid < 256) { float x[16];
#pragma unroll
                for (int i = 0; i < 16; ++i) { float sacc = X[(16 * rbk + i) * GX + tid];
#pragma unroll
                    for (int j = 0; j < i; ++j) sacc -= Lm[(16 * rbk + i) * GS2 + 16 * rbk + j] * x[j];
                    x[i] = sacc; }
#pragma unroll
                for (int i = 0; i < 16; ++i) X[(16 * rbk + i) * GX + tid] = x[i]; }
            __syncthreads();
        }
        for (int e = tid; e < 64 * 16; e += 512) { const int l = e >> 4, d0 = 8 * (e & 15); const f32x4 a = *(const LAS f32x4*)(X + l * GX + 128 + d0), b2 = *(const LAS f32x4*)(X + l * GX + 132 + d0);
            const float v[8] = {a.x, a.y, a.z, a.w, b2.x, b2.y, b2.z, b2.w}; *(u32x4*)(rec + GR_W + (size_t)(l * SB + d0) * 2) = pack8(v); }
        for (int e = tid; e < 64 * 32; e += 512) { const int l = e >> 5, c4 = 4 * (e & 31); *(f32x4*)(rec + GR_COMMON + (size_t)(c4 >> 4) * GR_USL + (size_t)(l * 20 + (c4 & 15)) * 4) = *(const LAS f32x4*)(X + l * GX + c4); }
    }
    __syncthreads();
}
constexpr int G2_STAGE = GR_COMMON + GR_USL;
__device__ __forceinline__ void phase_gdn_g2(const Frame& F, const Args& A) {
    const unsigned char* CHR = WSP(unsigned char, G_CH); float* GO = WSP(float, G_O);
    LAS unsigned char* buf0 = F.lds; LAS bf16* STt = (LAS bf16*)(F.lds + 2 * G2_STAGE); LAS bf16* vnT = STt + 2 * 16 * SB;
    const int tid = F.tid, lane = F.lane, w = F.wave, l15 = lane & 15, q4 = lane >> 4;
    const int nunits = BH * 4 * 8;
    constexpr int NCK = G2_STAGE / 16;
    for (int unit = F.bid; unit < nunits; unit += F.G) {
        const int vs = unit & 7, h = (unit >> 3) & 3, b = unit >> 5;
        __syncthreads();
        for (int e = tid; e < 2 * 16 * SB / 2; e += 512) ((LAS unsigned*)STt)[e] = 0u;
        f32x4 Sreg = (f32x4){0.f, 0.f, 0.f, 0.f};
        u32x4 pre[9];
        { const unsigned char* rec = CHR + (size_t)((b * 4 + h) * NCH) * GR_BYTES;
#pragma unroll
          for (int q = 0; q < 9; ++q) { const int e = tid + 512 * q; if (e < NCK) { const size_t off = (size_t)e * 16; *(LAS u32x4*)(buf0 + off) = *(const u32x4*)(rec + (off < GR_COMMON ? off : off + (size_t)vs * GR_USL)); } } }
        __syncthreads();
        for (int c = 0; c < NCH; ++c) {
            LAS unsigned char* buf = buf0 + (c & 1) * G2_STAGE; LAS unsigned char* nbuf = buf0 + ((c + 1) & 1) * G2_STAGE;
            if (c + 1 < NCH) { const unsigned char* rec = CHR + (size_t)((b * 4 + h) * NCH + c + 1) * GR_BYTES;
#pragma unroll
                for (int q = 0; q < 9; ++q) { const int e = tid + 512 * q; if (e < NCK) { const size_t off = (size_t)e * 16; pre[q] = *(const u32x4*)(rec + (off < GR_COMMON ? off : off + (size_t)vs * GR_USL)); } } }
            const LAS bf16* Wi = (const LAS bf16*)(buf + GR_W); const LAS bf16* QH = (const LAS bf16*)(buf + GR_QH); const LAS bf16* KT = (const LAS bf16*)(buf + GR_KT); const LAS bf16* QK = (const LAS bf16*)(buf + GR_QK);
            const float egl = *(const LAS float*)(buf + GR_GL); const LAS float* U = (const LAS float*)(buf + GR_COMMON);
            const LAS bf16* S0 = STt + (c & 1) * 16 * SB; LAS bf16* S1 = STt + ((c + 1) & 1) * 16 * SB;
            if (w < 4) {
                const f32x4 acc = tile_bf(Wi + 16 * w * SB, SB, S0, SB, 128, (f32x4){0.f, 0.f, 0.f, 0.f}, l15, q4);
                f32x4 vn;
#pragma unroll
                for (int r = 0; r < 4; ++r) vn[r] = U[(16 * w + 4 * q4 + r) * 20 + l15] - acc[r];
                u32x2 pk; pk.x = pk2(vn[0], vn[1]); pk.y = pk2(vn[2], vn[3]); *(LAS u32x2*)(vnT + l15 * RS + 16 * w + 4 * q4) = pk; }
            __syncthreads();
            if (w < 4) {
                f32x4 acc = tile_bf(QH + 16 * w * SB, SB, S0, SB, 128, (f32x4){0.f, 0.f, 0.f, 0.f}, l15, q4);
                acc = tile_bf(QK + 16 * w * RS, RS, vnT, RS, 64, acc, l15, q4);
#pragma unroll
                for (int r = 0; r < 4; ++r) GO[((size_t)b * SEQ + (size_t)c * 64 + 16 * w + 4 * q4 + r) * 512 + h * 128 + 16 * vs + l15] = acc[r]; }
            Sreg = Sreg * egl;
            Sreg = tile_bf(KT + 16 * w * RS, RS, vnT, RS, 64, Sreg, l15, q4);
            { u32x2 pk; pk.x = pk2(Sreg[0], Sreg[1]); pk.y = pk2(Sreg[2], Sreg[3]); *(LAS u32x2*)(S1 + l15 * SB + 16 * w + 4 * q4) = pk; }
            if (c + 1 < NCH) {
#pragma unroll
                for (int q = 0; q < 9; ++q) { const int e = tid + 512 * q; if (e < NCK) *(LAS u32x4*)(nbuf + (size_t)e * 16) = pre[q]; } }
            __syncthreads();
        }
    }
    __syncthreads();
}
__device__ __forceinline__ void phase_gdn_g3(const Frame& F, const Args& A, int layer) {
    const float* GO = WSP(float, G_O); const bf16* P = WSP(bf16, A_P); bf16* Y = WSP(bf16, A_Y) + (size_t)2 * TH * 512; const float* nw = A.in[22] + layer * 128;
    const int lane = F.lane, c0 = 8 * lane;
    for (int m = F.gw; m < TH; m += F.NGW) {
        const f32x4 a = *(const f32x4*)(GO + (size_t)m * 512 + c0), b2 = *(const f32x4*)(GO + (size_t)m * 512 + c0 + 4);
        float o[8] = {a.x, a.y, a.z, a.w, b2.x, b2.y, b2.z, b2.w}; float ss = 0.f;
#pragma unroll
        for (int q = 0; q < 8; ++q) ss += o[q] * o[q];
        ss += __shfl_xor(ss, 1); ss += __shfl_xor(ss, 2); ss += __shfl_xor(ss, 4); ss += __shfl_xor(ss, 8);
        const float rstd = 1.0f / sqrtf(ss * (1.0f / 128.0f) + EPS);
        const f32x4 z0 = ld_bf16x4(P + (size_t)m * PW + C_GDN + 1544 + c0), z1 = ld_bf16x4(P + (size_t)m * PW + C_GDN + 1544 + c0 + 4);
        const float z[8] = {z0.x, z0.y, z0.z, z0.w, z1.x, z1.y, z1.z, z1.w}; float y[8];
#pragma unroll
        for (int q = 0; q < 8; ++q) y[q] = o[q] * rstd * nw[(c0 + q) & 127] * siluf_(z[q]);
        u32x4 wv; wv.x = pk2(y[0], y[1]); wv.y = pk2(y[2], y[3]); wv.z = pk2(y[4], y[5]); wv.w = pk2(y[6], y[7]);
        *(u32x4*)(Y + (size_t)m * 512 + c0) = wv;
    }
}

__device__ __forceinline__ void phase_merge_z(const Frame& F, const Args& A) {
    pg8::Gemm g{WSP(bf16, A_Y), WSP(bf16, W_BR), 512, 512}; BranchOrder S; S.nP = TH / 256; S.G = F.G; S.c = F.bid;
    EpiZ E{WSP(bf16, A_Z)}; pg8::gemm_phase(F.lds, g, S, E, F.tid);
}
__device__ __forceinline__ void phase_merge_gate(const Frame& F, const Args& A, int layer) {
    pg8::Gemm g{WSP(bf16, A_H), WSP(bf16, W_GATE), D, D}; pg8::StaticOrder S; S.init(TH, 4096, F.G, F.bid);
    EpiMerge E{WSP(bf16, A_Z), A.in[29] + (size_t)layer * 4 * D, WSP(bf16, A_MG)}; pg8::gemm_phase(F.lds, g, S, E, F.tid);
#if 1
    if (((REPEAT_MASK) >> 28) & 1u) { __syncthreads(); EpiBf16 E2{WSP(bf16, A_MIX + (size_t)64 * MiB), 4096, nullptr, 0}; pg8::gemm_phase(F.lds, g, S, E2, F.tid); }
#endif
}
__device__ __forceinline__ void phase_merge_out(const Frame& F, const Args& A, const float* xin, float* xout) {
    pg8::Gemm g{WSP(bf16, A_MG), WSP(bf16, W_OUT), D, D}; pg8::StaticOrder S; S.init(TH, D, F.G, F.bid);
    EpiResidual E{xin, xout}; pg8::gemm_phase(F.lds, g, S, E, F.tid);
}
__device__ __forceinline__ void phase_ffn_gu(const Frame& F, const Args& A) {
    pg8::Gemm g{WSP(bf16, A_H), WSP(bf16, W_FGU), D, D}; pg8::StaticOrder S; S.init(TH, 2 * FF_D, F.G, F.bid);
    EpiSwiGLU E{WSP(bf16, F_ACT), FF_D, 1 << 20}; pg8::gemm_phase(F.lds, g, S, E, F.tid);
}
__device__ __forceinline__ void phase_ffn_down(const Frame& F, const Args& A, float* x) {
    pg8::Gemm g{WSP(bf16, F_ACT), WSP(bf16, W_FDN), FF_D, FF_D}; pg8::StaticOrder S; S.init(TH, D, F.G, F.bid);
    EpiResidual E{x, x}; pg8::gemm_phase(F.lds, g, S, E, F.tid);
}
struct MoeLayout { int pstart[NEXP + 1]; };
__device__ __forceinline__ MoeLayout moe_layout(const unsigned* cnt) {
    MoeLayout L; int s = 0;
#pragma unroll
    for (int e = 0; e < NEXP; ++e) { L.pstart[e] = s; s += ((int)cnt[e] + 255) & ~255; }
    L.pstart[NEXP] = s; return L;
}
struct MoeOrder {
    int np, nN, G, c; MoeLayout L;
    __device__ bool next(int i, Unit& u) const {
        const long Lx = (long)i * G + c; if (Lx >= (long)np * nN) return false;
        const int pm = (int)(Lx / nN), pn = (int)(Lx % nN); int e = 0;
#pragma unroll
        for (int k = 1; k < NEXP; ++k) if (pm * 256 >= L.pstart[k]) e = k;
        u.pm = pm; u.pn = e * nN + pn; return true;
    }
    __device__ __forceinline__ void a_ready(const Unit&) const {}
    __device__ __forceinline__ void done(const Unit&) const {}
};
__device__ __forceinline__ void phase_moe_route(const Frame& F, const Args& A, int half) {
    const unsigned* cnt = F.ctl + CW_CNT + half * 16; unsigned* fill = F.ctl + CW_FILL + half * 16;
    const MoeLayout L = moe_layout(cnt);
    const bf16* H = WSP(bf16, A_H); bf16* GA = WSP(bf16, F_GA); const int* tope = WSP(int, F_TOPE); int* slot = WSP(int, F_SLOT);
    const int lane = F.lane;
    for (int m = F.gw; m < TH; m += F.NGW) {
        const u32x4 v0 = *(const u32x4*)(H + (size_t)m * D + 8 * lane), v1 = *(const u32x4*)(H + (size_t)m * D + 512 + 8 * lane);
#pragma unroll
        for (int k = 0; k < 2; ++k) { const int e = tope[2 * m + k]; int s = 0;
            int ps = 0;
#pragma unroll
            for (int q = 0; q < NEXP; ++q) ps = (e == q) ? L.pstart[q] : ps;
            if (lane == 0) s = ps + (int)ATOMIC_ADD_U32(fill + e, 1u);
            s = __shfl(s, 0);
            if (lane == 0) slot[2 * m + k] = s;
            *(u32x4*)(GA + (size_t)s * D + 8 * lane) = v0; *(u32x4*)(GA + (size_t)s * D + 512 + 8 * lane) = v1; }
    }
#pragma unroll
    for (int e = 0; e < NEXP; ++e) { const int r0 = L.pstart[e] + (int)cnt[e], r1 = L.pstart[e + 1];
        for (int r = r0 + F.gw; r < r1; r += F.NGW) { *(u32x4*)(GA + (size_t)r * D + 8 * lane) = (u32x4){0u, 0u, 0u, 0u}; *(u32x4*)(GA + (size_t)r * D + 512 + 8 * lane) = (u32x4){0u, 0u, 0u, 0u}; } }
}
__device__ __forceinline__ void phase_moe_gu(const Frame& F, const Args& A, int half) {
    MoeOrder S; S.L = moe_layout(F.ctl + CW_CNT + half * 16); S.np = S.L.pstart[NEXP] / 256; S.nN = 2 * FF_E / 256; S.G = F.G; S.c = F.bid;
    pg8::Gemm g{WSP(bf16, F_GA), WSP(bf16, W_FGU), D, D}; EpiSwiGLU E{WSP(bf16, F_ACT), FF_E, 2 * FF_E / 256}; pg8::gemm_phase(F.lds, g, S, E, F.tid);
}
struct EpiF32Mod {
    static constexpr bool PERM = false, AFTER_DRAIN = false;
    float* C;
    __device__ __forceinline__ void operator()(const f32x4 (&acc)[2][2][4][2], const Unit& u, int wr, int wc, int fr, int fq) const {
        const int row0 = u.pm * 256 + wr * 64 + fr, col0 = (u.pn & 3) * 256 + wc * 32 + 4 * fq;
#pragma unroll
        for (int ai = 0; ai < 2; ++ai)
#pragma unroll
            for (int m = 0; m < 4; ++m) { float* rowp = C + (size_t)(row0 + ai * HALFT + m * 16) * D + col0;
#pragma unroll
                for (int bj = 0; bj < 2; ++bj)
#pragma unroll
                    for (int n = 0; n < 2; ++n) *(f32x4*)(rowp + bj * HALFT + n * 16) = acc[ai][bj][m][n]; }
    }
};
__device__ __forceinline__ void phase_moe_down(const Frame& F, const Args& A, int half) {
    MoeOrder S; S.L = moe_layout(F.ctl + CW_CNT + half * 16); S.np = S.L.pstart[NEXP] / 256; S.nN = D / 256; S.G = F.G; S.c = F.bid;
    pg8::Gemm g{WSP(bf16, F_ACT), WSP(bf16, W_FDN), FF_E, FF_E}; EpiF32Mod E{WSP(float, F_YE)}; pg8::gemm_phase(F.lds, g, S, E, F.tid);
}
__device__ __forceinline__ void phase_moe_combine(const Frame& F, const Args& A, float* x) {
    const float* YE = WSP(float, F_YE); const int* slot = WSP(int, F_SLOT); const float* topw = WSP(float, F_TOPW); const int lane = F.lane;
    for (int m = F.gw; m < TH; m += F.NGW) { const int s0 = slot[2 * m], s1 = slot[2 * m + 1]; const float w0 = topw[2 * m], w1 = topw[2 * m + 1];
#pragma unroll
        for (int j = 0; j < 4; ++j) { const int c = 4 * lane + 256 * j; float* xp = x + (size_t)m * D + c;
            *(f32x4*)xp = *(const f32x4*)xp + *(const f32x4*)(YE + (size_t)s0 * D + c) * w0 + *(const f32x4*)(YE + (size_t)s1 * D + c) * w1; } }
}

#ifndef EMU
#define XB_TMO      128
#define XB_XCNT(j)  (256  + 64 * (j))
#define XB_XSUB(j)  (1280 + 64 * (j))
#define XB_XGEN(j)  (2304 + 64 * (j))
#define XB_TOP      3328
#define XB_TOPGEN   3392
#define XCD_BAR_WORDS 3456
#define XB_SPIN_CAP (1u << 22)
__device__ __forceinline__ unsigned xb_ld(unsigned* p)              { return __hip_atomic_load(p, __ATOMIC_RELAXED, __HIP_MEMORY_SCOPE_AGENT); }
__device__ __forceinline__ unsigned xb_add(unsigned* p, unsigned v) { return __hip_atomic_fetch_add(p, v, __ATOMIC_RELAXED, __HIP_MEMORY_SCOPE_AGENT); }
__device__ __forceinline__ unsigned xb_xcc_id() { return (unsigned)__builtin_amdgcn_s_getreg((3 << 11) | 20) & 0xFu; }
#define XB_SPIN(cond, bar) do { unsigned _sp = 0; while (cond) { __builtin_amdgcn_s_sleep(1); \
    if ((++_sp & 255u) == 0u) { if (xb_ld(&(bar)[XB_TMO])) break; if (_sp > XB_SPIN_CAP) { atomicAdd(&(bar)[XB_TMO], 1u); break; } } } } while (0)
struct XcdBarrier { unsigned* bar; unsigned x; volatile LAS unsigned* st; };
__device__ __forceinline__ XcdBarrier xcd_barrier_post(unsigned* bar, volatile LAS unsigned* st) {
    XcdBarrier b; b.bar = bar; b.x = xb_xcc_id(); b.st = st;
    if (threadIdx.x == 0) (void)xb_add(&bar[XB_XCNT(b.x)], 1u);
    return b;
}
__device__ __forceinline__ void xcd_barrier_complete(unsigned* bar, unsigned x, unsigned& nloc, unsigned& nx) {
    const unsigned G = gridDim.x * gridDim.y * gridDim.z;
    unsigned sum, cnt, mine, sp = 0u;
    for (;;) {
        sum = 0u; cnt = 0u; mine = 0u;
#pragma unroll
        for (unsigned j = 0; j < 16; ++j) { const unsigned c = xb_ld(&bar[XB_XCNT(j)]); sum += c; cnt += (c > 0u) ? 1u : 0u; mine = (j == x) ? c : mine; }
        if (sum == G) break;
        __builtin_amdgcn_s_sleep(1);
        if ((++sp & 255u) == 0u) { if (xb_ld(&bar[XB_TMO])) break; if (sp > XB_SPIN_CAP) { atomicAdd(&bar[XB_TMO], 1u); break; } }
    }
    nloc = mine > 0u ? mine : 1u; nx = cnt > 0u ? cnt : 1u;
}
__device__ __forceinline__ void xcd_barrier(const XcdBarrier& b) {
    asm volatile("s_waitcnt vmcnt(0)" ::: "memory");
    __syncthreads();
    if (threadIdx.x == 0) {
        unsigned* bar = b.bar;
        __builtin_amdgcn_s_waitcnt(0);
        unsigned nloc = b.st[0], nx = b.st[1];
        if (nloc == 0u) { xcd_barrier_complete(bar, b.x, nloc, nx); b.st[0] = nloc; b.st[1] = nx; }
        const unsigned old = xb_add(&bar[XB_XSUB(b.x)], 1u);
        const unsigned gen = old / nloc;
        if (old + 1u == (gen + 1u) * nloc) {
            __builtin_amdgcn_fence(__ATOMIC_RELEASE, "agent");
            asm volatile("s_waitcnt vmcnt(0)" ::: "memory");
            const unsigned og = xb_add(&bar[XB_TOP], 1u);
            const unsigned tg = og / nx;
            if (og + 1u == (tg + 1u) * nx) xb_add(&bar[XB_TOPGEN], 1u);
            else XB_SPIN(xb_ld(&bar[XB_TOPGEN]) == tg, bar);
            __builtin_amdgcn_fence(__ATOMIC_ACQUIRE, "agent");
            xb_add(&bar[XB_XGEN(b.x)], 1u);
            asm volatile("s_waitcnt vmcnt(0)" ::: "memory");
        } else {
            XB_SPIN(xb_ld(&bar[XB_XGEN(b.x)]) == gen, bar);
            __builtin_amdgcn_fence(__ATOMIC_ACQUIRE, "agent");
            asm volatile("s_waitcnt vmcnt(0)" ::: "memory");
        }
    }
    __syncthreads();
}
#endif

constexpr int NPH = 25;
constexpr int NPHASES = DEPTH * (1 + NHALF * NPH) + 1;
constexpr int LDS_BYTES = 155648, MISC_OFF = 154624;

__global__ void __launch_bounds__(512, 2) fwd_kernel(Args args_k) {
#ifdef EMU
    unsigned char* lds = emu_lds_ptr;
#else
    extern __shared__ __attribute__((aligned(16))) unsigned char lds[];
#endif
    Frame F0;
    F0.lds = (LAS unsigned char*)lds; F0.tid = threadIdx.x; F0.lane = F0.tid & 63; F0.wave = RFL(F0.tid >> 6); F0.G = gridDim.x; F0.bid = blockIdx.x;
    F0.gw = F0.bid * 8 + F0.wave; F0.NGW = F0.G * 8;
    F0.out = args_k.out; F0.ws = args_k.ws; F0.ctl = (unsigned*)(args_k.ws + WS_CTL);
    const int lo = args_k.lo, hi = args_k.hi;
#ifndef EMU
    volatile LAS unsigned* misc = (volatile LAS unsigned*)(F0.lds + MISC_OFF);
    if (F0.tid < 4) misc[F0.tid] = 0u;
    __syncthreads();
    XcdBarrier bar; bar.bar = F0.ctl + CW_BAR; bar.x = 0; bar.st = misc;
    if (hi - lo > 1) bar = xcd_barrier_post(F0.ctl + CW_BAR, misc);
#define GRID_BAR() do { XcdBarrier bq = bar; asm volatile("" : "+s"(bq.bar), "+s"(bq.x)); xcd_barrier(bq); } while (0)
#else
#define GRID_BAR() do { } while (0)
#endif
    int ph = 0;
#ifndef PH_MASK
#define PH_MASK 0xFFFFFFFFFFFFFFFFull
#endif
#define PHASE(...) PHASE_I(31, __VA_ARGS__)
#ifdef EMU
#define LAUNDER(Fq) do { } while (0)
#else
#define LAUNDER(Fq) do { unsigned mq_ = ~0u; asm volatile("" : "+s"(Fq.G), "+s"(Fq.bid), "+s"(Fq.wave), "+s"(Fq.ws), "+s"(Fq.out), "+s"(Fq.ctl), "+s"(mq_)); Fq.lane = (int)__builtin_amdgcn_mbcnt_hi(mq_, __builtin_amdgcn_mbcnt_lo(mq_, 0u)); Fq.tid = Fq.wave * 64 + Fq.lane; Fq.gw = Fq.bid * 8 + Fq.wave; Fq.NGW = Fq.G * 8; } while (0)
#endif
#ifdef EMU
#define ARGS_Q() const Args& args_q = args_k
#else
#define ARGS_Q() const __attribute__((address_space(4))) Args* aq_ = (const __attribute__((address_space(4))) Args*)__builtin_amdgcn_kernarg_segment_ptr(); asm volatile("" : "+s"(aq_)); const Args& args_q = *(const Args*)aq_
#endif
#define PHASE_I(kind, ...) do { if (ph >= lo && ph < hi) { constexpr int reps_ = (((REPEAT_MASK) >> (kind)) & 1u) ? 2 : 1; for (int rr_ = 0; rr_ < reps_; ++rr_) { { Frame Fq = F0; LAUNDER(Fq); const Frame& F = Fq; ARGS_Q(); const Args& args = args_q; __VA_ARGS__; } if (rr_ + 1 < reps_ || ph + 1 < hi) { GRID_BAR(); if (((REPEAT_MASK) >> 26) & 1u) GRID_BAR(); } } } ++ph; } while (0)
#define PHASEK(kind, ...) PHASE_I(kind, __VA_ARGS__)
#define SEGMENT(layer, half) do { \
            const size_t r0 = (size_t)(half) * TH; \
            const float* xin = ((layer) == 0 ? args_k.in[0] : F0.out) + r0 * D; float* xo = F0.out + r0 * D; \
            PHASEK(0, phase_norm<false>(F, args, xin, args.in[2] + (layer) * D, WSP(bf16, A_H), nullptr, nullptr, nullptr, nullptr); phase_rope_table(F, args, (const int*)args.in[1] + r0, WSP(float, A_ROPE))); \
            PHASEK(1, { pg8::Gemm g{WSP(bf16, A_H), WSP(bf16, W_IN), D, D}; pg8::StaticOrder S; S.init(TH, PW, F.G, F.bid); EpiBf16 E{WSP(bf16, A_P), PW, nullptr, 0}; pg8::gemm_phase(F.lds, g, S, E, F.tid); }); \
            PHASEK(2, phase_mla_prep(F, args)); \
            PHASEK(3, phase_mla_q(F, args)); \
            PHASEK(4, phase_mla_kv(F, args)); \
            PHASEK(5, phase_attention(F, args)); \
            PHASEK(6, phase_rwkv_prep(F, args, layer)); \
            PHASEK(7, phase_rwkv_lora(F, args)); \
            PHASEK(8, phase_rwkv_r1(F, args, layer)); \
            PHASEK(24, phase_rwkv_r2(F, args)); \
            PHASEK(9, phase_rwkv_post(F, args, layer)); \
            PHASEK(10, phase_gdn_g1(F, args, layer)); \
            PHASEK(11, phase_gdn_g2(F, args)); \
            PHASEK(12, phase_gdn_g3(F, args, layer)); \
            PHASEK(13, phase_ssd_s1(F, args, layer)); \
            PHASEK(14, phase_ssd_s23(F, args)); \
            PHASEK(16, phase_ssd_s4(F, args, layer)); \
            PHASEK(17, phase_merge_z(F, args)); \
            PHASEK(18, phase_merge_gate(F, args, layer)); \
            PHASEK(19, phase_merge_out(F, args, xin, xo)); \
            if ((layer) == 0) { \
                PHASEK(20, phase_norm<false>(F, args, xo, args.in[32] + (layer) * D, WSP(bf16, A_H), nullptr, nullptr, nullptr, nullptr)); \
                PHASEK(21, phase_ffn_gu(F, args)); \
                PHASE(phase_ffn_down(F, args, xo)); \
                PHASE((void)0); \
                PHASE((void)0); \
            } else { \
                PHASE(phase_norm<true>(F, args, xo, args.in[32] + (layer) * D, WSP(bf16, A_H), args.in[35], WSP(int, F_TOPE), WSP(float, F_TOPW), F.ctl + CW_CNT + (half) * 16)); \
                PHASE(phase_moe_route(F, args, half)); \
                PHASEK(22, phase_moe_gu(F, args, half)); \
                PHASEK(23, phase_moe_down(F, args, half)); \
                PHASE(phase_moe_combine(F, args, xo)); \
            } } while (0)
    static_assert(DEPTH == 2 && NHALF <= 2, "segment program");
    PHASEK(27, phase_convert(F, args, 0));
    SEGMENT(0, 0);
    if (NHALF == 2) SEGMENT(0, 1);
    PHASEK(27, phase_convert(F, args, 1));
    SEGMENT(1, 0);
    if (NHALF == 2) SEGMENT(1, 1);
#undef SEGMENT
    PHASE(phase_final_norm(F, args, F.out, args.in[38]));
#undef PHASE
}

#ifndef ONE_LAUNCH
#define ONE_LAUNCH 1
#endif
extern "C" void kernel_launch(void* const* d_in, const int* in_sizes, int n_in, void* d_out, int out_size, void* d_ws, size_t ws_size, hipStream_t stream) {
    static int grid = 0;
    if (grid == 0) {
#ifdef EMU
        grid = EMU_GRID;
#else
        if (n_in != 39 || out_size != T * D || ws_size < WS_NEED) { fprintf(stderr, "kernel_launch: unexpected problem (n_in %d out %d ws %zu need %zu)\n", n_in, out_size, ws_size, (size_t)WS_NEED); grid = -1; return; }
        int dev = 0, cus = 0;
        if (hipGetDevice(&dev) != hipSuccess || hipDeviceGetAttribute(&cus, hipDeviceAttributeMultiprocessorCount, dev) != hipSuccess) { grid = -1; return; }
        if (hipFuncSetAttribute((const void*)fwd_kernel, hipFuncAttributeMaxDynamicSharedMemorySize, LDS_BYTES) != hipSuccess) { fprintf(stderr, "kernel_launch: hipFuncSetAttribute failed\n"); grid = -1; return; }
        int per_cu = 0;
        if (hipOccupancyMaxActiveBlocksPerMultiprocessor(&per_cu, (const void*)fwd_kernel, 512, LDS_BYTES) != hipSuccess || per_cu < 1) fprintf(stderr, "kernel_launch: occupancy query reports %d\n", per_cu);
        (void)hipGetLastError();
        grid = cus;
#endif
    }
    if (grid < 0) return;
    (void)hipMemsetAsync((char*)d_ws + WS_CTL, 0, CTL_BYTES, stream);
    Args a{};
    for (int i = 0; i < 39; ++i) a.in[i] = (const float*)d_in[i];
    a.out = (float*)d_out; a.ws = (unsigned char*)d_ws;
#ifdef EMU
    for (int p = EMU_PH_LO; p < EMU_PH_HI && p < NPHASES; ++p) { a.lo = p; a.hi = p + 1; emu_launch(fwd_kernel, grid, 512, a); emu_after_phase(p); }
#else
#if ONE_LAUNCH
    a.lo = 0; a.hi = NPHASES;
    hipLaunchKernelGGL(fwd_kernel, dim3(grid), dim3(512), LDS_BYTES, stream, a);
#else
    for (int p = 0; p < NPHASES; ++p) { a.lo = p; a.hi = p + 1; hipLaunchKernelGGL(fwd_kernel, dim3(grid), dim3(512), LDS_BYTES, stream, a); }
#endif
#endif
}
```

```cpp
#ifndef EMU
#include <hip/hip_runtime.h>
#include <cstdio>
#include <cstdint>
#endif

#ifndef REPEAT_MASK
#define REPEAT_MASK 0u
#endif
#ifdef EMU
constexpr int BATCH = EMU_B, SEQ = EMU_S, NHALF = EMU_NHALF;
#else
constexpr int BATCH = 16, SEQ = 2048, NHALF = 2;
#endif
constexpr int D = 1024, DEPTH = 2, CH = 64;
constexpr int T = BATCH * SEQ, TH = T / NHALF, BH = BATCH / NHALF, NCH = SEQ / CH;
constexpr int C_MLA = 0, C_RWKV = 704, C_GDN = 2528, C_SSD = 4584, C_GATE = 6128, IN_COLS = 10224, PW = 6144;
constexpr int FF_D = 2816, FF_E = 3584, NEXP = 8;
constexpr int MOE_ROWS = ((TH * 2 + NEXP * 255) / 256) * 256;
constexpr float EPS = 1e-6f;
static_assert(TH % 256 == 0 && SEQ % 128 == 0 && BATCH % NHALF == 0, "shape");

typedef unsigned short bf16;
typedef float f32x4 __attribute__((ext_vector_type(4)));
typedef float f32x2 __attribute__((ext_vector_type(2)));
typedef short bf16x8 __attribute__((ext_vector_type(8)));
typedef short bf16x4 __attribute__((ext_vector_type(4)));
typedef unsigned u32x4 __attribute__((ext_vector_type(4)));
typedef unsigned u32x2 __attribute__((ext_vector_type(2)));
#ifdef EMU
#define LAS
#define GAS
#define MFMA_F32(a, b, c) emu_mfma_16x16x4f32(a, b, c)
#define MFMA_BF16(a, b, c) emu_mfma_16x16x32bf16(a, b, c)
#define ATOMIC_ADD_U32(p, v) emu_atomic_add_u32(p, v)
#define ATOMIC_ADD_LDS(p, v) emu_atomic_add_u32((unsigned*)(p), v)
#define RFL(x) (x)
#define LDS_WAIT()
#define VM_WAIT()
__device__ __forceinline__ float fast_exp(float x) { return expf(x); }
__device__ __forceinline__ float fast_rcp(float x) { return 1.0f / x; }
__device__ __forceinline__ float fast_rsqrt(float x) { return 1.0f / sqrtf(x); }
#else
#define LAS __attribute__((address_space(3)))
#define GAS __attribute__((address_space(1)))
#define MFMA_F32(a, b, c) __builtin_amdgcn_mfma_f32_16x16x4f32(a, b, c, 0, 0, 0)
#define MFMA_BF16(a, b, c) __builtin_amdgcn_mfma_f32_16x16x32_bf16(a, b, c, 0, 0, 0)
#define ATOMIC_ADD_U32(p, v) __hip_atomic_fetch_add(p, v, __ATOMIC_RELAXED, __HIP_MEMORY_SCOPE_AGENT)
#define ATOMIC_ADD_LDS(p, v) __hip_atomic_fetch_add((LAS unsigned*)(p), v, __ATOMIC_RELAXED, __HIP_MEMORY_SCOPE_WORKGROUP)
#define RFL(x) __builtin_amdgcn_readfirstlane(x)
#define LDS_WAIT() asm volatile("s_waitcnt lgkmcnt(0)" ::: "memory")
#define VM_WAIT() asm volatile("s_waitcnt vmcnt(0)" ::: "memory")
__device__ __forceinline__ float fast_exp(float x) { return __expf(x); }
__device__ __forceinline__ float fast_rcp(float x) { return __builtin_amdgcn_rcpf(x); }
__device__ __forceinline__ float fast_rsqrt(float x) { return __builtin_amdgcn_rsqf(x); }
#endif
__device__ __forceinline__ unsigned f2u(float f) { return __builtin_bit_cast(unsigned, f); }
__device__ __forceinline__ float u2f(unsigned u) { return __builtin_bit_cast(float, u); }
__device__ __forceinline__ unsigned f2bf(float f) { unsigned u = f2u(f); return (u + 0x7fffu + ((u >> 16) & 1u)) >> 16; }
__device__ __forceinline__ float bf2f(unsigned h) { return u2f(h << 16); }
__device__ __forceinline__ unsigned pk2(float lo, float hi) { return f2bf(lo) | (f2bf(hi) << 16); }
__device__ __forceinline__ float sigmoidf_(float x) { return 1.0f / (1.0f + expf(-x)); }
__device__ __forceinline__ float siluf_(float x) { return x / (1.0f + expf(-x)); }
__device__ __forceinline__ float softplusf_(float x) { return x > 20.f ? x : log1pf(expf(x)); }
__device__ __forceinline__ float wave_sum(float v) {
#pragma unroll
    for (int o = 1; o < 64; o <<= 1) v += __shfl_xor(v, o);
    return v;
}
__device__ __forceinline__ float wave_max(float v) {
#pragma unroll
    for (int o = 1; o < 64; o <<= 1) v = fmaxf(v, __shfl_xor(v, o));
    return v;
}
__device__ __forceinline__ f32x4 ld_bf16x4(const bf16* p) { const u32x2 w = *(const u32x2*)p; return (f32x4){bf2f(w.x & 0xffffu), bf2f(w.x >> 16), bf2f(w.y & 0xffffu), bf2f(w.y >> 16)}; }
__device__ __forceinline__ void st_bf16x4(bf16* p, f32x4 v) { u32x2 w; w.x = pk2(v.x, v.y); w.y = pk2(v.z, v.w); *(u32x2*)p = w; }

namespace pg8 {
#define PG8_LAS LAS
typedef unsigned short bf16_t;
constexpr int BM = 256, BK = 64, HALF = 128, HTB = HALF * BK * 2, STAGE_BYTES = 8 * HTB, NXCD = 8, WGM = 8;
__host__ __device__ __forceinline__ int lds_byte(int r, int c) { const int st = (r >> 4) * 2 + (c >> 5), rr = r & 15, cc = c & 31, ob = rr * 64 + cc * 2; return st * 1024 + (ob ^ (((ob >> 9) & 1) << 5)); }
__host__ __device__ __forceinline__ void stage_rc(int b, int& R, int& C) { const int st = b / 1024, sb = b % 1024, swz = sb ^ (((sb >> 9) & 1) << 5); R = (st >> 1) * 16 + swz / 64; C = (st & 1) * 32 + (swz % 64) / 2; }
__host__ __device__ __forceinline__ int perm32(int rho) { const int n = rho >> 4, i = rho & 15; return 8 * (i >> 2) + 4 * n + (i & 3); }
struct Unit { int pm, pn; };
struct Gemm { const bf16_t* A; const bf16_t* Bt; int lda, K; };
struct StaticOrder {
    int nM, nN, nwg, G, c;
    __host__ __device__ void init(int M, int N, int G_, int c_) { nM = M / BM; nN = N / BM; nwg = nM * nN; G = G_; c = c_; }
    __host__ __device__ bool next(int i, Unit& u) const {
        const long L = (long)i * G + c; if (L >= nwg) return false;
        int wgid = (int)L; { const int q = nwg / NXCD, r = nwg % NXCD, xcd = wgid % NXCD, off = wgid / NXCD; wgid = (xcd < r ? xcd * (q + 1) : r * (q + 1) + (xcd - r) * q) + off; }
        const int nig = WGM * nN, gid = wgid / nig, fm = gid * WGM, gsz = (nM - fm) < WGM ? (nM - fm) : WGM;
        u.pm = fm + ((wgid % nig) % gsz); u.pn = (wgid % nig) / gsz; return true;
    }
    __device__ __forceinline__ void a_ready(const Unit&) const {}
    __device__ __forceinline__ void done(const Unit&) const {}
};
#ifndef EMU
template <class Epi, class Sched>
__device__ __forceinline__ void gemm_phase(PG8_LAS unsigned char* lds, const Gemm g, const Sched& S, const Epi& E, const int tid) {
    const int wid = __builtin_amdgcn_readfirstlane(tid >> 6), lane = tid & 63, wr = wid >> 2, wc = wid & 3, fr = lane & 15, fq = lane >> 4;
    int Kq = g.K; asm volatile("" : "+s"(Kq));
    const int K = Kq, nt = K / BK, lda = g.lda;
    unsigned voffA[2], voffB[2];
#pragma unroll
    for (int i = 0; i < 2; ++i) { int R, C; stage_rc(tid * 16 + i * 8192, R, C); const int Rb = Epi::PERM ? ((R & ~31) + perm32(R & 31)) : R;
        voffA[i] = (unsigned)(R * lda + C) * 2u; voffB[i] = (unsigned)(Rb * K + C) * 2u; }
    const size_t kstep = (size_t)(BK * 2);
    const size_t hstep = (size_t)HALF * K * 2, hstepA = (size_t)HALF * lda * 2;
    const size_t tstep = 2 * hstep, tstepA = 2 * hstepA;
    const unsigned ldsw = (unsigned)wid * 1024u;
    const int aoff = lds_byte(wr * 64 + fr, fq * 8), boff = lds_byte(wc * 32 + fr, fq * 8);
#define PG8_SA(b, h) (((b) * 2 + (h)) * HTB)
#define PG8_SB(b, h) ((4 + (b) * 2 + (h)) * HTB)
#define PG8_STAGE(bufoff, gbase, voff) do { _Pragma("unroll") for (int _i = 0; _i < 2; ++_i) \
        __builtin_amdgcn_global_load_lds((const unsigned*)((const char*)(gbase) + (voff)[_i]), (PG8_LAS unsigned*)(lds + (bufoff) + ldsw + _i * 8192), 16, 0, 0); } while (0)
#define PG8_LDA(dst, b, h) do { _Pragma("unroll") for (int m = 0; m < 4; ++m) _Pragma("unroll") for (int k = 0; k < 2; ++k) dst[m][k] = *(const PG8_LAS bf16x8*)(lds + PG8_SA(b, h) + aoff + m * 2048 + k * 1024); } while (0)
#define PG8_LDB(dst, b, h) do { _Pragma("unroll") for (int n = 0; n < 2; ++n) _Pragma("unroll") for (int k = 0; k < 2; ++k) dst[n][k] = *(const PG8_LAS bf16x8*)(lds + PG8_SB(b, h) + boff + n * 2048 + k * 1024); } while (0)
#define PG8_MMA(ai, bj, At, Bt) do { __builtin_amdgcn_s_setprio(1); _Pragma("unroll") for (int m = 0; m < 4; ++m) _Pragma("unroll") for (int n = 0; n < 2; ++n) _Pragma("unroll") for (int k = 0; k < 2; ++k) \
        acc[ai][bj][m][n] = __builtin_amdgcn_mfma_f32_16x16x32_bf16(Bt[n][k], At[m][k], acc[ai][bj][m][n], 0, 0, 0); __builtin_amdgcn_s_setprio(0); } while (0)
#define PG8_WAIT_V(n) asm volatile("s_waitcnt vmcnt(" #n ")" ::: "memory")
#define PG8_WAIT_L(n) asm volatile("s_waitcnt lgkmcnt(" #n ")" ::: "memory")
#define PG8_BAR __builtin_amdgcn_s_barrier()
#define PG8_SCHED __builtin_amdgcn_sched_barrier(0)
    Unit cur, nxt; int ui = 0;
    if (!S.next(0, cur)) return;
    f32x4 acc[2][2][4][2];
#pragma unroll
    for (int a = 0; a < 2; ++a)
#pragma unroll
        for (int b = 0; b < 2; ++b)
#pragma unroll
            for (int m = 0; m < 4; ++m)
#pragma unroll
                for (int n = 0; n < 2; ++n) acc[a][b][m][n] = (f32x4){0.f, 0.f, 0.f, 0.f};
    bf16x8 At[4][2], B0[2][2], B1[2][2];
    const char* cA = (const char*)g.A + (size_t)cur.pm * tstepA; const char* cB = (const char*)g.Bt + (size_t)cur.pn * tstep;
    S.a_ready(cur);
    PG8_STAGE(PG8_SB(0, 0), cB, voffB); PG8_STAGE(PG8_SA(0, 0), cA, voffA); PG8_STAGE(PG8_SB(0, 1), cB + hstep, voffB); PG8_STAGE(PG8_SA(0, 1), cA + hstepA, voffA);
    if (wr == 1) PG8_BAR;
    PG8_WAIT_V(4); PG8_BAR;
    PG8_STAGE(PG8_SB(1, 0), cB + kstep, voffB); PG8_STAGE(PG8_SA(1, 0), cA + kstep, voffA); PG8_STAGE(PG8_SB(1, 1), cB + hstep + kstep, voffB);
    PG8_WAIT_V(6); PG8_BAR;
    for (;;) {
        const bool has_next = S.next(ui + 1, nxt);
        const char* nA = has_next ? (const char*)g.A + (size_t)nxt.pm * tstepA : cA; const char* nB = has_next ? (const char*)g.Bt + (size_t)nxt.pn * tstep : cB;
        for (int t = 0; t < nt; t += 2) {
            const bool last = (t == nt - 2);
            const char* a1 = cA + (size_t)(t + 1) * kstep;
            const char* a2 = last ? nA : cA + (size_t)(t + 2) * kstep; const char* b2 = last ? nB : cB + (size_t)(t + 2) * kstep;
            const char* a3 = a2 + kstep; const char* b3 = b2 + kstep;
            if (last && has_next) S.a_ready(nxt);
            PG8_LDB(B0, 0, 0); PG8_SCHED; PG8_LDA(At, 0, 0); PG8_STAGE(PG8_SA(1, 1), a1 + hstepA, voffA);
            PG8_WAIT_L(8); PG8_BAR; PG8_WAIT_L(0); PG8_MMA(0, 0, At, B0); PG8_BAR; PG8_SCHED;
            PG8_LDB(B1, 0, 1); PG8_STAGE(PG8_SB(0, 0), b2, voffB);
            PG8_BAR; PG8_WAIT_L(0); PG8_MMA(0, 1, At, B1); PG8_BAR;
            PG8_LDA(At, 0, 1); PG8_STAGE(PG8_SA(0, 0), a2, voffA);
            PG8_BAR; PG8_WAIT_L(0); PG8_MMA(1, 0, At, B0); PG8_BAR; PG8_SCHED;
            PG8_STAGE(PG8_SB(0, 1), b2 + hstep, voffB);
            PG8_WAIT_V(6); PG8_BAR; PG8_MMA(1, 1, At, B1); PG8_BAR;
            PG8_LDB(B0, 1, 0); PG8_SCHED; PG8_LDA(At, 1, 0); PG8_STAGE(PG8_SA(0, 1), a2 + hstepA, voffA);
            PG8_WAIT_L(8); PG8_BAR; PG8_WAIT_L(0); PG8_MMA(0, 0, At, B0); PG8_BAR; PG8_SCHED;
            PG8_LDB(B1, 1, 1); PG8_STAGE(PG8_SB(1, 0), b3, voffB);
            PG8_BAR; PG8_WAIT_L(0); PG8_MMA(0, 1, At, B1); PG8_BAR;
            PG8_LDA(At, 1, 1); PG8_STAGE(PG8_SA(1, 0), a3, voffA);
            PG8_BAR; PG8_WAIT_L(0); PG8_MMA(1, 0, At, B0); PG8_BAR; PG8_SCHED;
            PG8_STAGE(PG8_SB(1, 1), b3 + hstep, voffB);
            PG8_WAIT_V(6); PG8_BAR; PG8_MMA(1, 1, At, B1); PG8_BAR;
        }
        if constexpr (!Epi::AFTER_DRAIN) { E(acc, cur, wr, wc, fr, fq); S.done(cur); }
        if (!has_next) break;
#pragma unroll
        for (int a = 0; a < 2; ++a)
#pragma unroll
            for (int b = 0; b < 2; ++b)
#pragma unroll
                for (int m = 0; m < 4; ++m)
#pragma unroll
                    for (int n = 0; n < 2; ++n) acc[a][b][m][n] = (f32x4){0.f, 0.f, 0.f, 0.f};
        cur = nxt; cA = nA; cB = nB; ++ui;
    }
    PG8_WAIT_V(0);
    if (wr == 0) PG8_BAR;
    PG8_BAR;
    if constexpr (Epi::AFTER_DRAIN) { E.fused(acc, cur, wr, wc, fr, fq, lds, wid, lane); S.done(cur); }
#undef PG8_SA
#undef PG8_SB
#undef PG8_STAGE
#undef PG8_LDA
#undef PG8_LDB
#undef PG8_MMA
#undef PG8_WAIT_V
#undef PG8_WAIT_L
#undef PG8_BAR
#undef PG8_SCHED
}
#else
template <class Epi, class Sched>
__device__ __forceinline__ void gemm_phase(PG8_LAS unsigned char* lds, const Gemm g, const Sched& S, const Epi& E, const int tid) {
    const int wid = tid >> 6, lane = tid & 63, wr = wid >> 2, wc = wid & 3, fr = lane & 15, fq = lane >> 4;
    Unit cur;
    for (int ui = 0; S.next(ui, cur); ++ui) {
        f32x4 acc[2][2][4][2];
        for (int ai = 0; ai < 2; ++ai) for (int m = 0; m < 4; ++m) {
            const size_t row = (size_t)cur.pm * 256 + ai * 128 + wr * 64 + m * 16 + fr;
            const bf16_t* ap = g.A + row * g.lda;
            for (int bj = 0; bj < 2; ++bj) for (int n = 0; n < 2; ++n) for (int j = 0; j < 4; ++j) {
                const size_t col = (size_t)cur.pn * 256 + bj * 128 + wc * 32 + (Epi::PERM ? 8 * fq + 4 * n : 16 * n + 4 * fq) + j;
                const bf16_t* bp = g.Bt + col * g.K; float s = 0.f;
                for (int k = 0; k < g.K; ++k) s += bf2f(ap[k]) * bf2f(bp[k]);
                acc[ai][bj][m][n][j] = s; } }
        E(acc, cur, wr, wc, fr, fq);
    }
    __syncthreads();
}
#endif
}

using pg8::Unit;
constexpr int HALFT = 128;
struct EpiF32 {
    static constexpr bool PERM = false, AFTER_DRAIN = false;
    float* C; int ldc;
    __device__ __forceinline__ void operator()(const f32x4 (&acc)[2][2][4][2], const Unit& u, int wr, int wc, int fr, int fq) const {
        const int row0 = u.pm * 256 + wr * 64 + fr, col0 = u.pn * 256 + wc * 32 + 4 * fq;
#pragma unroll
        for (int ai = 0; ai < 2; ++ai)
#pragma unroll
            for (int m = 0; m < 4; ++m) { float* rowp = C + (size_t)(row0 + ai * HALFT + m * 16) * ldc + col0;
#pragma unroll
                for (int bj = 0; bj < 2; ++bj)
#pragma unroll
                    for (int n = 0; n < 2; ++n) *(f32x4*)(rowp + bj * HALFT + n * 16) = acc[ai][bj][m][n]; }
    }
};
struct EpiResidual {
    static constexpr bool PERM = false, AFTER_DRAIN = false;
    const float* res; float* out;
    __device__ __forceinline__ void operator()(const f32x4 (&acc)[2][2][4][2], const Unit& u, int wr, int wc, int fr, int fq) const {
        const int row0 = u.pm * 256 + wr * 64 + fr, col0 = u.pn * 256 + wc * 32 + 4 * fq;
#pragma unroll
        for (int ai = 0; ai < 2; ++ai) {
            f32x4 rv[4][2][2];
#pragma unroll
            for (int m = 0; m < 4; ++m) { const size_t o = (size_t)(row0 + ai * HALFT + m * 16) * D + col0;
#pragma unroll
                for (int bj = 0; bj < 2; ++bj)
#pragma unroll
                    for (int n = 0; n < 2; ++n) rv[m][bj][n] = *(const GAS f32x4*)(res + o + bj * HALFT + n * 16); }
#pragma unroll
            for (int m = 0; m < 4; ++m) { const size_t o = (size_t)(row0 + ai * HALFT + m * 16) * D + col0;
#pragma unroll
                for (int bj = 0; bj < 2; ++bj)
#pragma unroll
                    for (int n = 0; n < 2; ++n) *(GAS f32x4*)(out + o + bj * HALFT + n * 16) = rv[m][bj][n] + acc[ai][bj][m][n]; }
        }
    }
};
struct EpiBf16 {
    static constexpr bool PERM = true, AFTER_DRAIN = false;
    bf16* O; int ldc; const float* rowscale; int rs_stride;
    __device__ __forceinline__ void operator()(const f32x4 (&acc)[2][2][4][2], const Unit& u, int wr, int wc, int fr, int fq) const {
        const int row0 = u.pm * 256 + wr * 64 + fr, col0 = u.pn * 256 + wc * 32 + 8 * fq;
#pragma unroll
        for (int ai = 0; ai < 2; ++ai)
#pragma unroll
            for (int m = 0; m < 4; ++m) { const int row = row0 + ai * HALFT + m * 16; bf16* rowp = O + (size_t)row * ldc + col0;
                const float sc = rowscale ? rowscale[(size_t)row * rs_stride] : 1.0f;
#pragma unroll
                for (int bj = 0; bj < 2; ++bj) { const f32x4 v0 = acc[ai][bj][m][0] * sc, v1 = acc[ai][bj][m][1] * sc;
                    u32x4 w; w.x = pk2(v0[0], v0[1]); w.y = pk2(v0[2], v0[3]); w.z = pk2(v1[0], v1[1]); w.w = pk2(v1[2], v1[3]);
                    *(u32x4*)(rowp + bj * HALFT) = w; } }
    }
};
struct EpiSwiGLU {
    static constexpr bool PERM = true, AFTER_DRAIN = false;
    bf16* O; int ldc; int ntile;
    __device__ __forceinline__ void operator()(const f32x4 (&acc)[2][2][4][2], const Unit& u, int wr, int wc, int fr, int fq) const {
        const int row0 = u.pm * 256 + wr * 64 + fr, col0 = (u.pn % ntile) * 128 + wc * 32 + 8 * fq;
#pragma unroll
        for (int ai = 0; ai < 2; ++ai)
#pragma unroll
            for (int m = 0; m < 4; ++m) { bf16* rowp = O + (size_t)(row0 + ai * HALFT + m * 16) * ldc + col0;
                float a[8];
#pragma unroll
                for (int n = 0; n < 2; ++n)
#pragma unroll
                    for (int j = 0; j < 4; ++j) { const float g = acc[ai][0][m][n][j], up = acc[ai][1][m][n][j]; a[4 * n + j] = g * fast_rcp(1.0f + fast_exp(-g)) * up; }
                u32x4 w; w.x = pk2(a[0], a[1]); w.y = pk2(a[2], a[3]); w.z = pk2(a[4], a[5]); w.w = pk2(a[6], a[7]);
                *(u32x4*)rowp = w; }
    }
};
struct EpiZ {
    static constexpr bool PERM = true, AFTER_DRAIN = false;
    bf16* Z;
    __device__ __forceinline__ void operator()(const f32x4 (&acc)[2][2][4][2], const Unit& u, int wr, int wc, int fr, int fq) const {
        const int i = u.pn >> 2, pnl = u.pn & 3, pml = u.pm - i * (TH / 256);
        const int row0 = pml * 256 + wr * 64 + fr, col0 = i * D + pnl * 256 + wc * 32 + 8 * fq;
#pragma unroll
        for (int ai = 0; ai < 2; ++ai)
#pragma unroll
            for (int m = 0; m < 4; ++m) { bf16* rowp = Z + (size_t)(row0 + ai * HALFT + m * 16) * 4096 + col0;
#pragma unroll
                for (int bj = 0; bj < 2; ++bj) { const f32x4 v0 = acc[ai][bj][m][0], v1 = acc[ai][bj][m][1];
                    u32x4 w; w.x = pk2(v0[0], v0[1]); w.y = pk2(v0[2], v0[3]); w.z = pk2(v1[0], v1[1]); w.w = pk2(v1[2], v1[3]);
                    *(GAS u32x4*)(rowp + bj * HALFT) = w; } }
    }
};
struct BranchOrder {
    int nP, G, c;
    __device__ bool next(int i, Unit& u) const {
        const long L = (long)i * G + c; if (L >= (long)16 * nP) return false;
        const int br = (int)(L / (4 * nP)), r = (int)(L % (4 * nP)); u.pm = br * nP + (r >> 2); u.pn = br * 4 + (r & 3); return true;
    }
    __device__ __forceinline__ void a_ready(const Unit&) const {}
    __device__ __forceinline__ void done(const Unit&) const {}
};
struct EpiMerge {
    static constexpr bool PERM = false, AFTER_DRAIN = false;
    const bf16* Z; const float* gate_b; bf16* MG;
    __device__ __forceinline__ void operator()(const f32x4 (&acc)[2][2][4][2], const Unit& u, int wr, int wc, int fr, int fq) const {
        const int row0 = u.pm * 256 + wr * 64 + fr, col = u.pn * 64 + wc * 16 + 4 * fq;
        f32x4 gb[4];
#pragma unroll
        for (int i = 0; i < 4; ++i) gb[i] = *(const GAS f32x4*)(gate_b + i * D + col);
#pragma unroll
        for (int ai = 0; ai < 2; ++ai) {
            u32x2 zv[4][4];
#pragma unroll
            for (int m = 0; m < 4; ++m)
#pragma unroll
                for (int i = 0; i < 4; ++i) zv[m][i] = *(const GAS u32x2*)(Z + (size_t)(row0 + ai * HALFT + m * 16) * 4096 + i * D + col);
#pragma unroll
            for (int m = 0; m < 4; ++m) { const size_t row = (size_t)(row0 + ai * HALFT + m * 16);
                f32x4 s = (f32x4){0.f, 0.f, 0.f, 0.f};
#pragma unroll
                for (int bj = 0; bj < 2; ++bj)
#pragma unroll
                    for (int n = 0; n < 2; ++n) { const int i = 2 * bj + n; const unsigned z01 = zv[m][i].x, z23 = zv[m][i].y;
                        const f32x4 z = (f32x4){bf2f(z01 & 0xffffu), bf2f(z01 >> 16), bf2f(z23 & 0xffffu), bf2f(z23 >> 16)}; const f32x4 a = acc[ai][bj][m][n] + gb[i];
#pragma unroll
                        for (int j = 0; j < 4; ++j) s[j] += z[j] * fast_rcp(1.0f + fast_exp(-a[j])); }
                u32x2 w; w.x = pk2(s.x, s.y); w.y = pk2(s.z, s.w); *(GAS u32x2*)(MG + row * D + col) = w; }
        }
    }
};

constexpr size_t MiB = 1u << 20;
constexpr size_t al(size_t x) { return (x + 255) & ~(size_t)255; }
constexpr size_t WS_CTL = 0, CTL_BYTES = 1 * MiB;
constexpr size_t W_IN = 1 * MiB;
constexpr size_t W_GATE = W_IN + (size_t)PW * D * 2;
constexpr size_t W_UQ = W_GATE + (size_t)4096 * D * 2;
constexpr size_t W_UKV = W_UQ + (size_t)768 * 384 * 2;
constexpr size_t W_LORA = W_UKV + (size_t)1024 * 256 * 2;
constexpr size_t W_BR = W_LORA + (size_t)1536 * 384 * 2;
constexpr size_t W_OUT = W_BR + (size_t)4 * 1024 * 512 * 2;
constexpr size_t W_FGU = W_OUT + (size_t)D * D * 2;
constexpr size_t W_FDN = W_FGU + (size_t)NEXP * 2 * FF_E * D * 2;
constexpr size_t W_END = W_FDN + (size_t)NEXP * D * FF_E * 2;
constexpr size_t A_H = al(W_END);
constexpr size_t A_ROPE = A_H + (size_t)TH * D * 2;
constexpr size_t A_Y = A_ROPE + (size_t)TH * 64 * 4;
constexpr size_t A_P = A_Y + (size_t)4 * TH * 512 * 2;
constexpr size_t A_MIX = A_P + (size_t)TH * PW * 2;
constexpr size_t M_STAT = A_MIX;
constexpr size_t M_KR = M_STAT + (size_t)TH * 2 * 4;
constexpr size_t M_Q = M_KR + (size_t)TH * 64 * 2;
constexpr size_t M_KV = M_Q + (size_t)TH * 768 * 2;
constexpr size_t M_VT = M_KV + (size_t)TH * 1024 * 2;
constexpr size_t M_END = M_VT + (size_t)TH * 512 * 2;
constexpr size_t R_RKV = A_MIX;
constexpr size_t R_LIN = R_RKV + (size_t)TH * 1536 * 2;
constexpr size_t R_LOUT = R_LIN + (size_t)TH * 384 * 2;
constexpr size_t R_REC = R_LOUT + (size_t)TH * 1536 * 4;
constexpr size_t R_O = R_REC + (size_t)BH * 8 * NCH * 92416;
constexpr size_t R_END = R_O + (size_t)TH * 512 * 4;
constexpr size_t G_CH = A_MIX;
constexpr size_t G_O = G_CH + al((size_t)BH * 4 * NCH * 103440);
constexpr size_t G_END = G_O + (size_t)TH * 512 * 4;
constexpr size_t S_ST = A_MIX;
constexpr size_t S_YD = S_ST + (size_t)BH * NCH * 8 * 64 * 128 * 4;
constexpr size_t S_C = S_YD + (size_t)TH * 512 * 4;
constexpr size_t S_AC = S_C + (size_t)TH * 256 * 4;
constexpr size_t S_END = S_AC + (size_t)TH * 8 * 4;
constexpr size_t A_Z = A_P;
constexpr size_t A_MG = A_MIX;
constexpr size_t F_ACT = A_P;
constexpr size_t F_GA = F_ACT + (size_t)MOE_ROWS * FF_E * 2;
constexpr size_t F_YE = F_GA + (size_t)MOE_ROWS * D * 2;
constexpr size_t F_TOPE = F_YE + (size_t)MOE_ROWS * D * 4;
constexpr size_t F_TOPW = F_TOPE + (size_t)TH * 2 * 4;
constexpr size_t F_SLOT = F_TOPW + (size_t)TH * 2 * 4;
constexpr size_t F_END = F_SLOT + (size_t)TH * 2 * 4;
constexpr size_t cmax(size_t a, size_t b) { return a > b ? a : b; }
constexpr size_t WS_NEED = cmax(cmax(cmax(M_END, R_END), cmax(G_END, S_END)), F_END);
#ifndef EMU
static_assert(WS_NEED <= (size_t)896 * MiB, "workspace");
#endif
constexpr int CW_BAR = 4096;
constexpr int CW_CNT = 16384;
constexpr int CW_WGC = 32768;

#ifdef EMU
#define WAVE_SYNC() emu_wave_sync()
#else
#define WAVE_SYNC() do { asm volatile("s_waitcnt lgkmcnt(0)" ::: "memory"); } while (0)
#endif
struct Frame {
    LAS unsigned char* lds; int tid, lane, wave, G, gw, NGW, bid;
    float* out; unsigned char* ws; unsigned* ctl;
};
struct Args { const float* in[39]; float* out; unsigned char* ws; int lo, hi; };
#define WSP(type, off) ((type*)(F.ws + (off)))

template <class FN>
__device__ __forceinline__ void cvt_matrix(const Frame& F, const float* W, int ldw, int K, bf16* WT, int Ndst, const float* kscale, FN srccol) {
    LAS float* scr = (LAS float*)(F.lds + F.wave * 16384);
    const int nblk = Ndst / 32, nitems = (K / 64) * nblk, lane = F.lane;
    for (int item = F.gw; item < nitems; item += F.NGW) {
        const int kb = item / nblk, nb = item % nblk, k0 = 64 * kb, n0 = 32 * nb;
        const int sc = srccol(n0 + (lane & 31));
#pragma unroll 8
        for (int i = 0; i < 32; ++i) { const int kk = 2 * i + (lane >> 5); float v = sc >= 0 ? W[(size_t)(k0 + kk) * ldw + sc] : 0.f; if (kscale) v *= kscale[k0 + kk]; scr[kk * 33 + (lane & 31)] = v; }
        WAVE_SYNC();
        const int c = lane & 7;
#pragma unroll
        for (int j = 0; j < 4; ++j) { const int n = (lane >> 3) + 8 * j; const LAS float* s = scr + (8 * c) * 33 + n;
            u32x4 o; o.x = pk2(s[0 * 33], s[1 * 33]); o.y = pk2(s[2 * 33], s[3 * 33]); o.z = pk2(s[4 * 33], s[5 * 33]); o.w = pk2(s[6 * 33], s[7 * 33]);
            *(u32x4*)(WT + (size_t)(n0 + n) * K + k0 + 8 * c) = o; }
        WAVE_SYNC();
    }
}
__device__ __forceinline__ void phase_convert(const Frame& F, const Args& A, int layer) {
    const float* w_in = A.in[3] + (size_t)layer * D * IN_COLS;
    cvt_matrix(F, w_in, IN_COLS, D, WSP(bf16, W_IN), PW, nullptr, [](int n) { return n < C_GATE ? n : -1; });
    cvt_matrix(F, w_in, IN_COLS, D, WSP(bf16, W_GATE), 4096, nullptr, [](int n) {
        const int pn = n >> 8, c = n & 255, bj = c >> 7, wc = (c >> 5) & 3, nn = (c >> 4) & 1, r = c & 15; return C_GATE + (2 * bj + nn) * D + 64 * pn + 16 * wc + r; });
    cvt_matrix(F, A.in[6] + (size_t)layer * 384 * 768, 768, 384, WSP(bf16, W_UQ), 768, A.in[4] + layer * 384, [](int n) { return n; });
    cvt_matrix(F, A.in[7] + (size_t)layer * 256 * 1024, 1024, 256, WSP(bf16, W_UKV), 1024, A.in[5] + layer * 256, [](int n) { return n; });
    for (int i = 0; i < 4; ++i) cvt_matrix(F, A.in[30] + ((size_t)layer * 4 + i) * 512 * D, D, 512, WSP(bf16, W_BR) + (size_t)i * D * 512, D, nullptr, [](int n) { return n; });
    cvt_matrix(F, A.in[31] + (size_t)layer * D * D, D, D, WSP(bf16, W_OUT), D, nullptr, [](int n) { return n; });
    if (layer == 0) {
        cvt_matrix(F, A.in[33], 2 * FF_D, D, WSP(bf16, W_FGU), 2 * FF_D, nullptr, [](int n) { const int pn = n >> 8, c = n & 255; return c < 128 ? 128 * pn + c : FF_D + 128 * pn + (c - 128); });
        cvt_matrix(F, A.in[34], D, FF_D, WSP(bf16, W_FDN), D, nullptr, [](int n) { return n; });
    } else {
        for (int e = 0; e < NEXP; ++e) {
            cvt_matrix(F, A.in[36] + (size_t)e * D * 2 * FF_E, 2 * FF_E, D, WSP(bf16, W_FGU) + (size_t)e * 2 * FF_E * D, 2 * FF_E, nullptr, [](int n) { const int pn = n >> 8, c = n & 255; return c < 128 ? 128 * pn + c : FF_E + 128 * pn + (c - 128); });
            cvt_matrix(F, A.in[37] + (size_t)e * FF_E * D, D, FF_E, WSP(bf16, W_FDN) + (size_t)e * D * FF_E, D, nullptr, [](int n) { return n; });
        }
    }
    { const float* w2 = A.in[10] + (size_t)layer * 64 * 512; const float* a2 = A.in[12] + (size_t)layer * 64 * 512; const float* g2 = A.in[13] + (size_t)layer * 160 * 512;
      bf16* L = WSP(bf16, W_LORA);
      for (int idx = F.bid * 512 + F.tid; idx < 1536 * 384; idx += F.G * 512) { const int n = idx / 384, k = idx % 384; float v = 0.f;
          if (n < 512) { if (k < 64) v = w2[k * 512 + n]; } else if (n < 1024) { if (k >= 64 && k < 128) v = a2[(k - 64) * 512 + (n - 512)]; } else { if (k >= 128 && k < 288) v = g2[(k - 128) * 512 + (n - 1024)]; }
          L[idx] = (bf16)f2bf(v); } }
}

template <bool ROUTER>
__device__ __forceinline__ void phase_norm(const Frame& F, const Args& A, const float* xin, const float* gain, bf16* H, const float* router, int* tope, float* topw, unsigned* cnt) {
    const int lane = F.lane;
    LAS unsigned* lcnt = (LAS unsigned*)F.lds;
    if (ROUTER) { __syncthreads(); if (F.tid < 8) lcnt[F.tid] = 0u; __syncthreads(); }
    f32x4 gv[4];
#pragma unroll
    for (int j = 0; j < 4; ++j) gv[j] = *(const f32x4*)(gain + 4 * lane + 256 * j);
    for (int m = F.gw; m < TH; m += F.NGW) {
        const float* xr = xin + (size_t)m * D; f32x4 v[4]; float ss = 0.f;
#pragma unroll
        for (int j = 0; j < 4; ++j) { v[j] = *(const f32x4*)(xr + 4 * lane + 256 * j); ss += (v[j].x * v[j].x + v[j].y * v[j].y) + (v[j].z * v[j].z + v[j].w * v[j].w); }
        const float rstd = 1.0f / sqrtf(wave_sum(ss) * (1.0f / D) + EPS);
#pragma unroll
        for (int j = 0; j < 4; ++j) { v[j] = v[j] * rstd * gv[j]; st_bf16x4(H + (size_t)m * D + 4 * lane + 256 * j, v[j]); }
        if (ROUTER) {
            float lg[8];
#pragma unroll
            for (int e = 0; e < 8; ++e) lg[e] = 0.f;
#pragma unroll
            for (int j = 0; j < 4; ++j)
#pragma unroll
                for (int q = 0; q < 4; ++q) { const float* rp = router + (size_t)(4 * lane + 256 * j + q) * 8; const f32x4 r0 = *(const f32x4*)rp, r1 = *(const f32x4*)(rp + 4); const float hv = v[j][q];
                    lg[0] += hv * r0.x; lg[1] += hv * r0.y; lg[2] += hv * r0.z; lg[3] += hv * r0.w; lg[4] += hv * r1.x; lg[5] += hv * r1.y; lg[6] += hv * r1.z; lg[7] += hv * r1.w; }
#pragma unroll
            for (int e = 0; e < 8; ++e) lg[e] = wave_sum(lg[e]);
            if (lane == 0) {
                int e1 = 0; float l1 = lg[0];
#pragma unroll
                for (int e = 1; e < 8; ++e) if (lg[e] > l1) { l1 = lg[e]; e1 = e; }
                int e2 = -1; float l2 = -3.0e38f;
#pragma unroll
                for (int e = 0; e < 8; ++e) if (e != e1 && lg[e] > l2) { l2 = lg[e]; e2 = e; }
                const float w1 = 1.0f / (1.0f + expf(l2 - l1));
                tope[2 * m] = e1; tope[2 * m + 1] = e2; topw[2 * m] = w1; topw[2 * m + 1] = 1.0f - w1;
                ATOMIC_ADD_LDS(lcnt + e1, 1u); ATOMIC_ADD_LDS(lcnt + e2, 1u);
            }
        }
    }
    if (ROUTER) { __syncthreads(); if (F.tid < 8) cnt[F.bid * 8 + F.tid] = lcnt[F.tid]; __syncthreads(); }
}
__device__ __forceinline__ void phase_rope_table(const Frame& F, const Args& A, const int* pos, float* rope) {
    for (int idx = F.bid * 512 + F.tid; idx < TH * 32; idx += F.G * 512) { const int t = idx >> 5, i = idx & 31;
        const float inv = powf(10000.0f, -(float)i / 32.0f);
        const float ang = (float)pos[t] * inv; float sn, cs; sincosf(ang, &sn, &cs);
        rope[(size_t)t * 64 + i] = cs; rope[(size_t)t * 64 + 32 + i] = sn; }
}
__device__ __forceinline__ void phase_final_norm(const Frame& F, const Args& A, float* x, const float* gain) {
    const int lane = F.lane;
    for (int m = F.gw; m < T; m += F.NGW) {
        float* xr = x + (size_t)m * D; f32x4 v[4]; float ss = 0.f;
#pragma unroll
        for (int j = 0; j < 4; ++j) { v[j] = *(const f32x4*)(xr + 4 * lane + 256 * j); ss += (v[j].x * v[j].x + v[j].y * v[j].y) + (v[j].z * v[j].z + v[j].w * v[j].w); }
        const float rstd = 1.0f / sqrtf(wave_sum(ss) * (1.0f / D) + EPS);
#pragma unroll
        for (int j = 0; j < 4; ++j) *(f32x4*)(xr + 4 * lane + 256 * j) = v[j] * rstd * *(const f32x4*)(gain + 4 * lane + 256 * j);
    }
}

__device__ __forceinline__ void phase_mla_prep(const Frame& F, const Args& A) {
    bf16* P = WSP(bf16, A_P); bf16* kr = WSP(bf16, M_KR); const float* rope = WSP(float, A_ROPE);
    const int lane = F.lane;
    for (int m = F.gw; m < TH; m += F.NGW) {
        bf16* pr = P + (size_t)m * PW; float sq = 0.f, skv = 0.f; f32x4 v[3];
#pragma unroll
        for (int j = 0; j < 3; ++j) { const int c = 4 * lane + 256 * j; v[j] = ld_bf16x4(pr + c); const float s = (v[j].x * v[j].x + v[j].y * v[j].y) + (v[j].z * v[j].z + v[j].w * v[j].w);
            if (c < 384) sq += s; else if (c < 640) skv += s; }
        sq = wave_sum(sq); skv = wave_sum(skv);
        const float rq = 1.0f / sqrtf(sq * (1.0f / 384.0f) + EPS), rkv = 1.0f / sqrtf(skv * (1.0f / 256.0f) + EPS);
#pragma unroll
        for (int j = 0; j < 3; ++j) { const int c = 4 * lane + 256 * j; if (c < 640) st_bf16x4(pr + c, v[j] * (c < 384 ? rq : rkv)); }
        if (lane < 32) { const float x1 = bf2f(pr[640 + lane]), x2 = bf2f(pr[672 + lane]), c = rope[(size_t)m * 64 + lane], s = rope[(size_t)m * 64 + 32 + lane];
            kr[(size_t)m * 64 + lane] = (bf16)f2bf(x1 * c - x2 * s); kr[(size_t)m * 64 + 32 + lane] = (bf16)f2bf(x2 * c + x1 * s); }
    }
}
__device__ __forceinline__ void phase_mla_q(const Frame& F, const Args& A) {
    pg8::Gemm g{WSP(bf16, A_P) + 0, WSP(bf16, W_UQ), PW, 384}; pg8::StaticOrder S; S.init(TH, 768, F.G, F.bid);
    EpiBf16 E{WSP(bf16, M_Q), 768, nullptr, 0}; pg8::gemm_phase(F.lds, g, S, E, F.tid);
}
struct EpiKV {
    static constexpr bool PERM = true, AFTER_DRAIN = false;
    bf16* KV; bf16* VT;
    __device__ __forceinline__ void operator()(const f32x4 (&acc)[2][2][4][2], const Unit& u, int wr, int wc, int fr, int fq) const {
        const int row0 = u.pm * 256 + wr * 64 + fr, col0 = wc * 32 + 8 * fq;
#pragma unroll
        for (int ai = 0; ai < 2; ++ai)
#pragma unroll
            for (int m = 0; m < 4; ++m) { const int row = row0 + ai * HALFT + m * 16;
                { const f32x4 v0 = acc[ai][0][m][0], v1 = acc[ai][0][m][1]; u32x4 w; w.x = pk2(v0[0], v0[1]); w.y = pk2(v0[2], v0[3]); w.z = pk2(v1[0], v1[1]); w.w = pk2(v1[2], v1[3]);
                  *(u32x4*)(KV + (size_t)row * 1024 + u.pn * 256 + col0) = w; }
                const int b = row / SEQ, t = row % SEQ; bf16* vt = VT + ((size_t)(b * 4 + u.pn) * 128 + col0) * SEQ + t;
#pragma unroll
                for (int n = 0; n < 2; ++n)
#pragma unroll
                    for (int j = 0; j < 4; ++j) vt[(size_t)(4 * n + j) * SEQ] = (bf16)f2bf(acc[ai][1][m][n][j]); }
    }
};
__device__ __forceinline__ void phase_mla_kv(const Frame& F, const Args& A) {
    pg8::Gemm g{WSP(bf16, A_P) + 384, WSP(bf16, W_UKV), PW, 256}; pg8::StaticOrder S; S.init(TH, 1024, F.G, F.bid);
    EpiKV E{WSP(bf16, M_KV), WSP(bf16, M_VT)}; pg8::gemm_phase(F.lds, g, S, E, F.tid);
}
constexpr int AT_KS = 200, AT_VS = 72;
constexpr int AT_KBYTES = 64 * AT_KS * 2, AT_VBYTES = 128 * AT_VS * 2;
__device__ __forceinline__ void phase_attention(const Frame& F, const Args& A) {
    const bf16* Q = WSP(bf16, M_Q); const bf16* KV = WSP(bf16, M_KV); const bf16* KR = WSP(bf16, M_KR); const bf16* VTg = WSP(bf16, M_VT); const float* rope = WSP(float, A_ROPE); bf16* Y = WSP(bf16, A_Y);
    const int lane = F.lane, w = F.wave, l15 = lane & 15, q4 = lane >> 4, tid = F.tid, grp = w >> 2, wq = w & 3;
    const int NQB = SEQ / 128, nunits = BH * 4 * NQB;
    const float sc2 = 0.07216878364870322f * 1.4426950408889634f;
    for (int unit = F.bid; unit < nunits; unit += F.G) {
        const int qb = NQB - 1 - (unit / (BH * 4)), bh = unit % (BH * 4), h = bh & 3, b = bh >> 2;
        const size_t t0 = (size_t)b * SEQ;
        bf16x8 qf[2][6];
#pragma unroll
        for (int f = 0; f < 2; ++f) { const size_t tq = t0 + qb * 128 + wq * 32 + 16 * f + l15;
#pragma unroll
            for (int ks = 0; ks < 6; ++ks) qf[f][ks] = *(const bf16x8*)(Q + tq * 768 + h * 192 + 32 * ks + 8 * q4);
            const bf16x8 a = qf[f][4], c2 = qf[f][5];
#pragma unroll
            for (int j = 0; j < 8; ++j) { const float x1 = bf2f((unsigned short)a[j]), x2 = bf2f((unsigned short)c2[j]), c = rope[tq * 64 + 8 * q4 + j], sn = rope[tq * 64 + 32 + 8 * q4 + j];
                qf[f][4][j] = (short)f2bf(x1 * c - x2 * sn); qf[f][5][j] = (short)f2bf(x2 * c + x1 * sn); } }
        f32x4 o[2][8];
#pragma unroll
        for (int f = 0; f < 2; ++f)
#pragma unroll
            for (int mb = 0; mb < 8; ++mb) o[f][mb] = (f32x4){0.f, 0.f, 0.f, 0.f};
        float mrow[2] = {-3.0e38f, -3.0e38f}, lrow[2] = {0.f, 0.f};
        const int qchunk = 2 * qb + (wq >> 1), ntile = 2 * qb + 2;
        u32x4 pk_[3], pv_[2];
        const int skey = tid >> 3, c8 = tid & 7;
        const int okv = skey * 1024 + 8 * c8, okr = skey * 64 + 8 * c8, ovt = skey * SEQ + 8 * c8;
        const bf16* kvb = KV + t0 * 1024 + h * 256; const bf16* krb = KR + t0 * 64; const bf16* vtb = VTg + (size_t)(b * 4 + h) * 128 * SEQ;
#define AT_LOAD(kt) do { const bf16* kv_ = kvb + (size_t)(kt) * 65536; const bf16* kr_ = krb + (size_t)(kt) * 4096; const bf16* vt_ = vtb + (size_t)(kt) * 64; \
            pk_[0] = *(const u32x4*)(kv_ + okv); pk_[1] = *(const u32x4*)(kv_ + okv + 64); pk_[2] = *(const u32x4*)(kr_ + okr); \
            pv_[0] = *(const u32x4*)(vt_ + ovt); pv_[1] = *(const u32x4*)(vt_ + ovt + 64 * SEQ); } while (0)
#define AT_STORE(bufi) do { LAS bf16* Ks_ = (LAS bf16*)(F.lds + (bufi) * (AT_KBYTES + AT_VBYTES)); LAS bf16* Vt_ = (LAS bf16*)((LAS unsigned char*)Ks_ + AT_KBYTES); \
            *(LAS u32x4*)(Ks_ + skey * AT_KS + 8 * c8) = pk_[0]; *(LAS u32x4*)(Ks_ + skey * AT_KS + 8 * c8 + 64) = pk_[1]; *(LAS u32x4*)(Ks_ + skey * AT_KS + 8 * c8 + 128) = pk_[2]; \
            *(LAS u32x4*)(Vt_ + skey * AT_VS + 8 * c8) = pv_[0]; *(LAS u32x4*)(Vt_ + (skey + 64) * AT_VS + 8 * c8) = pv_[1]; } while (0)
        __syncthreads();
        AT_LOAD(0); AT_STORE(0);
        __syncthreads();
        for (int kt = 0; kt < ntile; ++kt) {
            if (kt + 1 < ntile) AT_LOAD(kt + 1);
            if (kt <= qchunk) {
                const LAS bf16* Ks = (const LAS bf16*)(F.lds + (kt & 1) * (AT_KBYTES + AT_VBYTES)); const LAS bf16* Vt = (const LAS bf16*)((const LAS unsigned char*)Ks + AT_KBYTES);
                f32x4 st[2][2];
#pragma unroll
                for (int kb = 0; kb < 2; ++kb) { st[0][kb] = (f32x4){0.f, 0.f, 0.f, 0.f}; st[1][kb] = (f32x4){0.f, 0.f, 0.f, 0.f};
#pragma unroll
                    for (int ks = 0; ks < 6; ++ks) { const bf16x8 kf = *(const LAS bf16x8*)(Ks + (32 * grp + 16 * kb + l15) * AT_KS + 32 * ks + 8 * q4);
                        st[0][kb] = MFMA_BF16(kf, qf[0][ks], st[0][kb]); st[1][kb] = MFMA_BF16(kf, qf[1][ks], st[1][kb]); } }
                bf16x8 pb[2];
#pragma unroll
                for (int f = 0; f < 2; ++f) {
                    float mx = -3.0e38f;
#pragma unroll
                    for (int kb = 0; kb < 2; ++kb) { st[f][kb] = st[f][kb] * sc2; mx = fmaxf(mx, fmaxf(fmaxf(st[f][kb].x, st[f][kb].y), fmaxf(st[f][kb].z, st[f][kb].w))); }
                    mx = fmaxf(mx, __shfl_xor(mx, 16)); mx = fmaxf(mx, __shfl_xor(mx, 32));
                    const float mnew = fmaxf(mrow[f], mx), alpha = exp2f(mrow[f] - mnew); mrow[f] = mnew;
                    float ps = 0.f;
#pragma unroll
                    for (int kb = 0; kb < 2; ++kb)
#pragma unroll
                        for (int r = 0; r < 4; ++r) { const float p = exp2f(st[f][kb][r] - mnew); ps += p; pb[f][4 * kb + r] = (short)f2bf(p); }
                    lrow[f] = lrow[f] * alpha + ps;
#pragma unroll
                    for (int mb = 0; mb < 8; ++mb) o[f][mb] = o[f][mb] * alpha;
                }
#pragma unroll
                for (int mb = 0; mb < 8; ++mb) { const LAS bf16* vp = Vt + (16 * mb + l15) * AT_VS + 32 * grp + 4 * q4;
                    const bf16x4 v0 = *(const LAS bf16x4*)vp, v1 = *(const LAS bf16x4*)(vp + 16);
                    bf16x8 vf; vf[0] = v0[0]; vf[1] = v0[1]; vf[2] = v0[2]; vf[3] = v0[3]; vf[4] = v1[0]; vf[5] = v1[1]; vf[6] = v1[2]; vf[7] = v1[3];
                    o[0][mb] = MFMA_BF16(vf, pb[0], o[0][mb]); o[1][mb] = MFMA_BF16(vf, pb[1], o[1][mb]); }
            }
            if (kt + 1 < ntile) AT_STORE((kt + 1) & 1);
            __syncthreads();
        }
#undef AT_LOAD
#undef AT_STORE
#pragma unroll
        for (int f = 0; f < 2; ++f) { lrow[f] += __shfl_xor(lrow[f], 16); lrow[f] += __shfl_xor(lrow[f], 32); }
        LAS float* xo = (LAS float*)F.lds + (size_t)wq * (2 * 8 * 4 * 64 + 4 * 64);
        if (grp == 1) {
#pragma unroll
            for (int f = 0; f < 2; ++f) {
#pragma unroll
                for (int mb = 0; mb < 8; ++mb)
#pragma unroll
                    for (int r = 0; r < 4; ++r) xo[((f * 8 + mb) * 4 + r) * 64 + lane] = o[f][mb][r];
                xo[2 * 8 * 4 * 64 + f * 64 + lane] = mrow[f]; xo[2 * 8 * 4 * 64 + 128 + f * 64 + lane] = lrow[f]; } }
        __syncthreads();
        if (grp == 0) {
#pragma unroll
            for (int f = 0; f < 2; ++f) { const float m1 = xo[2 * 8 * 4 * 64 + f * 64 + lane], l1 = xo[2 * 8 * 4 * 64 + 128 + f * 64 + lane];
                const float m = fmaxf(mrow[f], m1), a0 = exp2f(mrow[f] - m), a1 = exp2f(m1 - m), inv = 1.0f / (lrow[f] * a0 + l1 * a1);
                const size_t tq = t0 + qb * 128 + wq * 32 + 16 * f + l15;
#pragma unroll
                for (int mb = 0; mb < 8; ++mb) { f32x4 v;
#pragma unroll
                    for (int r = 0; r < 4; ++r) v[r] = (o[f][mb][r] * a0 + xo[((f * 8 + mb) * 4 + r) * 64 + lane] * a1) * inv;
                    st_bf16x4(Y + tq * 512 + h * 128 + 16 * mb + 4 * q4, v); } } }
    }
    __syncthreads();
}

__device__ __forceinline__ f32x4 tile_bf(const LAS bf16* a, int lda, const LAS bf16* bt, int ldb, int K, f32x4 acc, int l15, int q4) {
    const LAS bf16* ap = a + l15 * lda + 8 * q4; const LAS bf16* bp = bt + l15 * ldb + 8 * q4;
#pragma unroll 4
    for (int ks = 0; ks < K / 32; ++ks) acc = MFMA_BF16(*(const LAS bf16x8*)(ap + 32 * ks), *(const LAS bf16x8*)(bp + 32 * ks), acc);
    return acc;
}
__device__ __forceinline__ f32x4 tile_mm(const LAS float* a, int lda, int ska, const LAS float* b, int ldb, int scb, int K, f32x4 acc, int l15, int q4);

__device__ __forceinline__ void phase_rwkv_prep(const Frame& F, const Args& A, int layer) {
    const bf16* P = WSP(bf16, A_P); bf16* RKV = WSP(bf16, R_RKV); bf16* LIN = WSP(bf16, R_LIN); const float* mu = A.in[8] + (size_t)layer * 1824;
    const int lane = F.lane;
    for (int m = F.gw; m < TH; m += F.NGW) {
        const bool first = (m % SEQ) == 0; const bf16* pr = P + (size_t)m * PW + C_RWKV;
#pragma unroll
        for (int j = 0; j < 8; ++j) { const int c = 4 * lane + 256 * j;
            if (c < 1824) { const f32x4 p = ld_bf16x4(pr + c); const f32x4 pv = first ? (f32x4){0.f, 0.f, 0.f, 0.f} : ld_bf16x4(pr - PW + c); const f32x4 muv = *(const f32x4*)(mu + c);
                f32x4 x = p + (pv - p) * muv;
                if (c < 1536) st_bf16x4(RKV + (size_t)m * 1536 + c, x);
                else { if (c < 1600) { x.x = tanhf(x.x); x.y = tanhf(x.y); x.z = tanhf(x.z); x.w = tanhf(x.w); }
                       else if (c >= 1664) { x.x = sigmoidf_(x.x); x.y = sigmoidf_(x.y); x.z = sigmoidf_(x.z); x.w = sigmoidf_(x.w); }
                       st_bf16x4(LIN + (size_t)m * 384 + (c - 1536), x); } } }
        if (lane < 24) st_bf16x4(LIN + (size_t)m * 384 + 288 + 4 * lane, (f32x4){0.f, 0.f, 0.f, 0.f});
    }
}
__device__ __forceinline__ void phase_rwkv_lora(const Frame& F, const Args& A) {
    pg8::Gemm g{WSP(bf16, R_LIN), WSP(bf16, W_LORA), 384, 384}; pg8::StaticOrder S; S.init(TH, 1536, F.G, F.bid);
    EpiF32 E{WSP(float, R_LOUT), 1536}; pg8::gemm_phase(F.lds, g, S, E, F.tid);
}
constexpr int RS = 72;
constexpr int RREC_COMMON = 4 * 64 * RS * 2 + 256;
constexpr int RREC_SLICE = 3 * 64 * 36 * 4;
constexpr int RREC_BYTES = RREC_COMMON + 2 * RREC_SLICE;
static_assert(RREC_BYTES == 92416, "record size (see R_REC in the workspace map)");
static_assert(RREC_COMMON % 16 == 0 && RREC_SLICE % 16 == 0, "record alignment");
__device__ __forceinline__ void phase_rwkv_r1(const Frame& F, const Args& A, int layer) {
    const bf16* RKV = WSP(bf16, R_RKV); const float* LOUT = WSP(float, R_LOUT); unsigned char* REC = WSP(unsigned char, R_REC);
    const float* w0 = A.in[9] + layer * 512; const float* a0 = A.in[11] + layer * 512; const float* k_k = A.in[14] + layer * 512; const float* k_a = A.in[15] + layer * 512;
    LAS bf16* kbar = (LAS bf16*)F.lds; LAS bf16* atil = kbar + 64 * RS; LAS bf16* khat = atil + 64 * RS; LAS bf16* rbar = khat + 64 * RS;
    LAS bf16* atT = rbar + 64 * RS; LAS bf16* khT = atT + 64 * RS; LAS bf16* vT = khT + 64 * RS; LAS bf16* Bm = vT + 64 * RS; LAS bf16* Em = Bm + 64 * RS;
    LAS float* Am = (LAS float*)(Em + 64 * RS);
    LAS float* X = Am + 64 * 68;
    LAS float* lam = Am;
    const int tid = F.tid, lane = F.lane, w = F.wave, l15 = lane & 15, q4 = lane >> 4;
    const int nunits = BH * 8 * NCH;
    for (int unit = F.bid; unit < nunits; unit += F.G) {
        const int c = unit % NCH, h = (unit / NCH) & 7, b = unit / (NCH * 8);
        const size_t tok0 = (size_t)b * SEQ + (size_t)c * 64;
        const int j = lane, cj = h * 64 + j;
        __syncthreads();
        float r_[8], km_[8], kk_[8], ka_[8], v_[8];
        { const float w0c = w0[cj], a0c = a0[cj], kkc = k_k[cj], kac = k_a[cj];
#pragma unroll
          for (int q = 0; q < 8; ++q) { const int t = w + 8 * q; const size_t tok = tok0 + t;
              const float r = bf2f(RKV[tok * 1536 + cj]), k = bf2f(RKV[tok * 1536 + 512 + cj]); v_[q] = bf2f(RKV[tok * 1536 + 1024 + cj]);
              const float wpre = LOUT[tok * 1536 + cj], apre = LOUT[tok * 1536 + 512 + cj];
              const float wl = -softplusf_(-(w0c + wpre)) - 0.5f, a = sigmoidf_(a0c + apre);
              const float kr = k * kkc, ss = wave_sum(kr * kr), kk = kr / sqrtf(ss + EPS);
              r_[q] = r; km_[q] = k * (1.0f + (a - 1.0f) * kac); kk_[q] = kk; ka_[q] = kk * a;
              lam[t * 64 + j] = -expf(wl); } }
        __syncthreads();
        if (w == 0) { float s = 0.f; for (int t = 0; t < 64; ++t) { s += lam[t * 64 + j]; lam[t * 64 + j] = s; } }
        __syncthreads();
        { const float Lend = lam[63 * 64 + j];
#pragma unroll
          for (int q = 0; q < 8; ++q) { const int t = w + 8 * q; const float L = lam[t * 64 + j], Lm1 = t ? lam[(t - 1) * 64 + j] : 0.f;
              const float eG = expf(L), eGi = expf(-L), eGm1 = expf(Lm1), eT = expf(Lend - L);
              const float kb = kk_[q] * eGm1;
              kbar[t * RS + j] = (bf16)f2bf(kb); X[t * 132 + j] = kb;
              atil[t * RS + j] = (bf16)f2bf(ka_[q] * eGi); khat[t * RS + j] = (bf16)f2bf(km_[q] * eGi); rbar[t * RS + j] = (bf16)f2bf(r_[q] * eG);
              atT[j * RS + t] = (bf16)f2bf(-ka_[q] * eT); khT[j * RS + t] = (bf16)f2bf(km_[q] * eT); vT[j * RS + t] = (bf16)f2bf(v_[q]); }
          if (w == 0) { float* gc = (float*)(REC + (size_t)unit * RREC_BYTES + 4 * 64 * RS * 2); gc[j] = expf(Lend); } }
        __syncthreads();
        unsigned char* rec = REC + (size_t)unit * RREC_BYTES;
        for (int tt = 0; tt < 8; ++tt) { const int tile = w * 8 + tt, which = tile >> 4, ti = (tile >> 2) & 3, tj = tile & 3;
            f32x4 acc = (f32x4){0.f, 0.f, 0.f, 0.f};
            if (tj <= ti) acc = tile_bf(((which & 2) ? rbar : kbar) + 16 * ti * RS, RS, ((which & 1) ? khat : atil) + 16 * tj * RS, RS, 64, acc, l15, q4);
#pragma unroll
            for (int r = 0; r < 4; ++r) { const int i = 16 * ti + 4 * q4 + r, jj = 16 * tj + l15; const bool keep = (which & 2) ? (jj <= i) : (jj < i); const float v = keep ? acc[r] : 0.f;
                if (which == 0) Am[i * 68 + jj] = v; else if (which == 1) Bm[i * RS + jj] = (bf16)f2bf(v); else if (which == 3) Em[i * RS + jj] = (bf16)f2bf(v);
                else ((bf16*)(rec + 2 * 64 * RS * 2))[i * RS + jj] = (bf16)f2bf(-v); } }
        __syncthreads();
        for (int tt = 0; tt < 6; ++tt) { const int tile = w * 6 + tt, which = tile >> 4, ti = (tile >> 2) & 3, tj = tile & 3;
            const LAS bf16* aop = which == 0 ? Bm : which == 1 ? Em : khT;
            const f32x4 acc = tile_bf(aop + 16 * ti * RS, RS, vT + 16 * tj * RS, RS, 64, (f32x4){0.f, 0.f, 0.f, 0.f}, l15, q4);
#pragma unroll
            for (int r = 0; r < 4; ++r) { const int i = 16 * ti + 4 * q4 + r, vv = 16 * tj + l15;
                if (which == 0) X[i * 132 + 64 + vv] = acc[r];
                else { float* dst = (float*)(rec + RREC_COMMON + (vv >> 5) * RREC_SLICE + (which == 1 ? 1 : 2) * 64 * 36 * 4); dst[i * 36 + (vv & 31)] = acc[r]; } } }
        __syncthreads();
        for (int rb = 0; rb < 4; ++rb) {
            if (rb > 0) {
                const f32x4 acc = tile_mm(Am + 16 * rb * 68, 68, 1, X + 16 * w, 132, 1, 16 * rb, (f32x4){0.f, 0.f, 0.f, 0.f}, l15, q4);
#pragma unroll
                for (int r = 0; r < 4; ++r) X[(16 * rb + 4 * q4 + r) * 132 + 16 * w + l15] -= acc[r];
                __syncthreads();
            }
            if (tid < 128) { float x[16];
#pragma unroll
                for (int i = 0; i < 16; ++i) { float sacc = X[(16 * rb + i) * 132 + tid];
#pragma unroll
                    for (int jj = 0; jj < i; ++jj) sacc -= Am[(16 * rb + i) * 68 + 16 * rb + jj] * x[jj];
                    x[i] = sacc; }
#pragma unroll
                for (int i = 0; i < 16; ++i) X[(16 * rb + i) * 132 + tid] = x[i]; }
            __syncthreads();
        }
        for (int e = tid; e < 64 * 64; e += 512) { const int t = e >> 6, jj = e & 63; ((bf16*)rec)[t * RS + jj] = (bf16)f2bf(X[t * 132 + jj]);
            float* ub = (float*)(rec + RREC_COMMON + (jj >> 5) * RREC_SLICE); ub[t * 36 + (jj & 31)] = X[t * 132 + 64 + jj]; }
        for (int e = tid; e < 64 * RS / 8; e += 512) { ((u32x4*)(rec + 64 * RS * 2))[e] = ((const LAS u32x4*)rbar)[e]; ((u32x4*)(rec + 3 * 64 * RS * 2))[e] = ((const LAS u32x4*)atT)[e]; }
    }
    __syncthreads();
}
constexpr int R2_BUF = RREC_COMMON + RREC_SLICE;
__device__ __forceinline__ void phase_rwkv_r2(const Frame& F, const Args& A) {
    const unsigned char* REC = WSP(unsigned char, R_REC); float* RO = WSP(float, R_O);
    LAS unsigned char* buf0 = F.lds; LAS bf16* HT = (LAS bf16*)(F.lds + 2 * R2_BUF); LAS bf16* UT = HT + 2 * 32 * RS;
    const int tid = F.tid, lane = F.lane, w = F.wave, l15 = lane & 15, q4 = lane >> 4, ti = w >> 1, tj = w & 1;
    const int nunits = BH * 8 * 2;
    constexpr int NCHK = R2_BUF / 16;
    for (int unit = F.bid; unit < nunits; unit += F.G) {
        const int vs = unit & 1, h = (unit >> 1) & 7, b = unit >> 4;
        __syncthreads();
        for (int e = tid; e < 2 * 32 * RS / 2; e += 512) ((LAS unsigned*)HT)[e] = 0u;
        f32x4 Hreg = (f32x4){0.f, 0.f, 0.f, 0.f};
        u32x4 pre[8];
        { const unsigned char* rec = REC + (size_t)((b * 8 + h) * NCH) * RREC_BYTES;
#pragma unroll
          for (int q = 0; q < 8; ++q) { const int e = tid + 512 * q; if (e < NCHK) { const size_t off = (size_t)e * 16; pre[q] = *(const u32x4*)(rec + (off < RREC_COMMON ? off : off + (size_t)vs * RREC_SLICE)); } }
#pragma unroll
          for (int q = 0; q < 8; ++q) { const int e = tid + 512 * q; if (e < NCHK) *(LAS u32x4*)(buf0 + (size_t)e * 16) = pre[q]; } }
        __syncthreads();
        for (int c = 0; c < NCH; ++c) {
            LAS unsigned char* buf = buf0 + (c & 1) * R2_BUF; LAS unsigned char* nbuf = buf0 + ((c + 1) & 1) * R2_BUF;
            if (c + 1 < NCH) { const unsigned char* rec = REC + (size_t)((b * 8 + h) * NCH + c + 1) * RREC_BYTES;
#pragma unroll
                for (int q = 0; q < 8; ++q) { const int e = tid + 512 * q; if (e < NCHK) { const size_t off = (size_t)e * 16; pre[q] = *(const u32x4*)(rec + (off < RREC_COMMON ? off : off + (size_t)vs * RREC_SLICE)); } } }
            const LAS bf16* KB = (const LAS bf16*)buf; const LAS bf16* RB = KB + 64 * RS; const LAS bf16* FMn = RB + 64 * RS; const LAS bf16* ATn = FMn + 64 * RS;
            const LAS float* GC = (const LAS float*)(buf + 4 * 64 * RS * 2); const LAS float* UB = (const LAS float*)(buf + RREC_COMMON); const LAS float* OB = UB + 64 * 36; const LAS float* KV = OB + 64 * 36;
            const LAS bf16* H0 = HT + (c & 1) * 32 * RS; LAS bf16* H1 = HT + ((c + 1) & 1) * 32 * RS;
            f32x4 u;
#pragma unroll
            for (int r = 0; r < 4; ++r) u[r] = UB[(16 * ti + 4 * q4 + r) * 36 + 16 * tj + l15];
            u = tile_bf(KB + 16 * ti * RS, RS, H0 + 16 * tj * RS, RS, 64, u, l15, q4);
            { u32x2 pk; pk.x = pk2(u[0], u[1]); pk.y = pk2(u[2], u[3]); *(LAS u32x2*)(UT + (16 * tj + l15) * RS + 16 * ti + 4 * q4) = pk; }
            __syncthreads();
            f32x4 o;
#pragma unroll
            for (int r = 0; r < 4; ++r) o[r] = OB[(16 * ti + 4 * q4 + r) * 36 + 16 * tj + l15];
            o = tile_bf(RB + 16 * ti * RS, RS, H0 + 16 * tj * RS, RS, 64, o, l15, q4);
            o = tile_bf(FMn + 16 * ti * RS, RS, UT + 16 * tj * RS, RS, 64, o, l15, q4);
#pragma unroll
            for (int r = 0; r < 4; ++r) RO[((size_t)b * SEQ + (size_t)c * 64 + 16 * ti + 4 * q4 + r) * 512 + h * 64 + 32 * vs + 16 * tj + l15] = o[r];
#pragma unroll
            for (int r = 0; r < 4; ++r) Hreg[r] = Hreg[r] * GC[16 * ti + 4 * q4 + r] + KV[(16 * ti + 4 * q4 + r) * 36 + 16 * tj + l15];
            Hreg = tile_bf(ATn + 16 * ti * RS, RS, UT + 16 * tj * RS, RS, 64, Hreg, l15, q4);
            { u32x2 pk; pk.x = pk2(Hreg[0], Hreg[1]); pk.y = pk2(Hreg[2], Hreg[3]); *(LAS u32x2*)(H1 + (16 * tj + l15) * RS + 16 * ti + 4 * q4) = pk; }
            if (c + 1 < NCH) {
#pragma unroll
                for (int q = 0; q < 8; ++q) { const int e = tid + 512 * q; if (e < NCHK) *(LAS u32x4*)(nbuf + (size_t)e * 16) = pre[q]; } }
            __syncthreads();
        }
    }
    __syncthreads();
}
__device__ __forceinline__ void phase_rwkv_post(const Frame& F, const Args& A, int layer) {
    const bf16* RKV = WSP(bf16, R_RKV); const float* LOUT = WSP(float, R_LOUT); const float* RO = WSP(float, R_O); bf16* Y = WSP(bf16, A_Y) + (size_t)1 * TH * 512;
    const float* a0 = A.in[11] + layer * 512; const float* k_a = A.in[15] + layer * 512; const float* r_k = A.in[16] + layer * 512; const float* ln_w = A.in[17] + layer * 512; const float* ln_b = A.in[18] + layer * 512;
    const int lane = F.lane, c0 = 8 * lane;
    for (int m = F.gw; m < TH; m += F.NGW) {
        float o[8], r[8], k[8], v[8], ap[8], g[8];
        { const f32x4 a = *(const f32x4*)(RO + (size_t)m * 512 + c0), b2 = *(const f32x4*)(RO + (size_t)m * 512 + c0 + 4); o[0] = a.x; o[1] = a.y; o[2] = a.z; o[3] = a.w; o[4] = b2.x; o[5] = b2.y; o[6] = b2.z; o[7] = b2.w; }
#pragma unroll
        for (int hh = 0; hh < 2; ++hh) { const f32x4 rv = ld_bf16x4(RKV + (size_t)m * 1536 + c0 + 4 * hh), kv = ld_bf16x4(RKV + (size_t)m * 1536 + 512 + c0 + 4 * hh), vv = ld_bf16x4(RKV + (size_t)m * 1536 + 1024 + c0 + 4 * hh);
            const f32x4 av = *(const f32x4*)(LOUT + (size_t)m * 1536 + 512 + c0 + 4 * hh), gv = *(const f32x4*)(LOUT + (size_t)m * 1536 + 1024 + c0 + 4 * hh);
#pragma unroll
            for (int q = 0; q < 4; ++q) { r[4 * hh + q] = rv[q]; k[4 * hh + q] = kv[q]; v[4 * hh + q] = vv[q]; ap[4 * hh + q] = av[q]; g[4 * hh + q] = gv[q]; } }
        float bon = 0.f, sm = 0.f;
#pragma unroll
        for (int q = 0; q < 8; ++q) { const float a = sigmoidf_(a0[c0 + q] + ap[q]); const float km = k[q] * (1.0f + (a - 1.0f) * k_a[c0 + q]); bon += r[q] * km * r_k[c0 + q]; sm += o[q]; }
        bon += __shfl_xor(bon, 1); bon += __shfl_xor(bon, 2); bon += __shfl_xor(bon, 4);
        sm += __shfl_xor(sm, 1); sm += __shfl_xor(sm, 2); sm += __shfl_xor(sm, 4);
        const float mean = sm * (1.0f / 64.0f); float vs = 0.f;
#pragma unroll
        for (int q = 0; q < 8; ++q) { const float d = o[q] - mean; vs += d * d; }
        vs += __shfl_xor(vs, 1); vs += __shfl_xor(vs, 2); vs += __shfl_xor(vs, 4);
        const float rstd = 1.0f / sqrtf(vs * (1.0f / 64.0f) + 64e-5f);
        float y[8];
#pragma unroll
        for (int q = 0; q < 8; ++q) y[q] = ((o[q] - mean) * rstd * ln_w[c0 + q] + ln_b[c0 + q] + bon * v[q]) * g[q];
        u32x4 wv; wv.x = pk2(y[0], y[1]); wv.y = pk2(y[2], y[3]); wv.z = pk2(y[4], y[5]); wv.w = pk2(y[6], y[7]);
        *(u32x4*)(Y + (size_t)m * 512 + c0) = wv;
    }
}

__device__ __forceinline__ void conv8x8(const bf16* src, int tl0  , const float* w  , int wld, const float* bias, float (&out)[8][8]) {
    float x[11][8];
#pragma unroll
    for (int i = 0; i < 11; ++i) { const int tl = tl0 - 3 + i;
        if (tl >= 0) { const u32x4 v = *(const u32x4*)(src + (ptrdiff_t)(i - 3) * PW);
            x[i][0] = bf2f(v.x & 0xffffu); x[i][1] = bf2f(v.x >> 16); x[i][2] = bf2f(v.y & 0xffffu); x[i][3] = bf2f(v.y >> 16); x[i][4] = bf2f(v.z & 0xffffu); x[i][5] = bf2f(v.z >> 16); x[i][6] = bf2f(v.w & 0xffffu); x[i][7] = bf2f(v.w >> 16); }
        else {
#pragma unroll
            for (int ch = 0; ch < 8; ++ch) x[i][ch] = 0.f; } }
    float wv[4][8], bv[8];
#pragma unroll
    for (int j = 0; j < 4; ++j) { const f32x4 a = *(const f32x4*)(w + j * wld), b = *(const f32x4*)(w + j * wld + 4); wv[j][0] = a.x; wv[j][1] = a.y; wv[j][2] = a.z; wv[j][3] = a.w; wv[j][4] = b.x; wv[j][5] = b.y; wv[j][6] = b.z; wv[j][7] = b.w; }
    if (bias) { const f32x4 a = *(const f32x4*)bias, b = *(const f32x4*)(bias + 4); bv[0] = a.x; bv[1] = a.y; bv[2] = a.z; bv[3] = a.w; bv[4] = b.x; bv[5] = b.y; bv[6] = b.z; bv[7] = b.w; }
    else {
#pragma unroll
        for (int ch = 0; ch < 8; ++ch) bv[ch] = 0.f; }
#pragma unroll
    for (int i = 0; i < 8; ++i)
#pragma unroll
        for (int ch = 0; ch < 8; ++ch) { const float a = bv[ch] + wv[0][ch] * x[i][ch] + wv[1][ch] * x[i + 1][ch] + wv[2][ch] * x[i + 2][ch] + wv[3][ch] * x[i + 3][ch]; out[i][ch] = a * fast_rcp(1.0f + fast_exp(-a)); }
}
__device__ __forceinline__ u32x4 pack8(const float* v) { u32x4 o; o.x = pk2(v[0], v[1]); o.y = pk2(v[2], v[3]); o.z = pk2(v[4], v[5]); o.w = pk2(v[6], v[7]); return o; }
constexpr int SB = 136;
constexpr int SC_IMG = 64 * SB * 2;
__device__ __forceinline__ void phase_ssd_s1(const Frame& F, const Args& A, int layer) {
    const bf16* P = WSP(bf16, A_P); bf16* ST = WSP(bf16, S_ST); float* YD = WSP(float, S_YD); unsigned char* SCB = WSP(unsigned char, S_C); float* AC = WSP(float, S_AC);
    const float* cw = A.in[23] + (size_t)layer * 4 * 1024; const float* cb = A.in[24] + layer * 1024; const float* dtb = A.in[25] + layer * 8; const float* a_log = A.in[26] + layer * 8; const float* dsk = A.in[27] + layer * 8;
    LAS bf16* Bt_ = (LAS bf16*)F.lds; LAS bf16* Ct_ = Bt_ + 64 * SB; LAS bf16* BT = Ct_ + 64 * SB; LAS bf16* xT = BT + 128 * RS;
    LAS bf16* Mb = xT + 4 * 64 * RS; LAS bf16* xdT = Mb + 2 * 64 * RS; LAS float* dt = (LAS float*)(xdT + 2 * 64 * RS); LAS float* ac = dt + 256;
    const int tid = F.tid, lane = F.lane, w = F.wave, l15 = lane & 15, q4 = lane >> 4;
    const int nunits = BH * NCH * 2;
    for (int unit = F.bid; unit < nunits; unit += F.G) {
        const int g = unit & 1, c = (unit >> 1) % NCH, b = unit / (2 * NCH);
        const size_t tok0 = (size_t)b * SEQ + (size_t)c * 64;
        __syncthreads();
        {
            const int cg = tid & 63, rb = tid >> 6;
            const int cidx = cg < 32 ? g * 256 + 8 * cg : cg < 48 ? 512 + g * 128 + 8 * (cg - 32) : 768 + g * 128 + 8 * (cg - 48);
            float o[8][8];
            conv8x8(P + (tok0 + 8 * rb) * PW + C_SSD + 512 + cidx, c * 64 + 8 * rb, cw + cidx, 1024, cb + cidx, o);
            if (cg < 32) {
                const int hh = cg >> 3, p0 = 8 * (cg & 7);
#pragma unroll
                for (int ch = 0; ch < 8; ++ch) { float col[8];
#pragma unroll
                    for (int i = 0; i < 8; ++i) col[i] = o[i][ch];
                    *(LAS u32x4*)(xT + (hh * 64 + p0 + ch) * RS + 8 * rb) = pack8(col); }
            } else if (cg < 48) {
                const int n0 = 8 * (cg - 32);
#pragma unroll
                for (int i = 0; i < 8; ++i) *(LAS u32x4*)(Bt_ + (8 * rb + i) * SB + n0) = pack8(o[i]);
#pragma unroll
                for (int ch = 0; ch < 8; ++ch) { float col[8];
#pragma unroll
                    for (int i = 0; i < 8; ++i) col[i] = o[i][ch];
                    *(LAS u32x4*)(BT + (n0 + ch) * RS + 8 * rb) = pack8(col); }
            } else { const int n0 = 8 * (cg - 48);
#pragma unroll
                for (int i = 0; i < 8; ++i) *(LAS u32x4*)(Ct_ + (8 * rb + i) * SB + n0) = pack8(o[i]); }
        }
        if (tid < 256) { const int hh = tid >> 6, h = 4 * g + hh; const float d = softplusf_(bf2f(P[(tok0 + lane) * PW + C_SSD + 1536 + h]) + dtb[h]); float a = -expf(a_log[h]) * d;
#pragma unroll
            for (int o = 1; o < 64; o <<= 1) { const float t = __shfl_up(a, o); if (lane >= o) a += t; }
            dt[tid] = d; ac[tid] = a; AC[(tok0 + lane) * 8 + h] = a; }
        __syncthreads();
        { unsigned char* dst = SCB + (size_t)unit * SC_IMG; for (int e = tid; e < SC_IMG / 16; e += 512) ((u32x4*)dst)[e] = ((const LAS u32x4*)Ct_)[e]; }
        f32x4 cbt[2];
#pragma unroll
        for (int tt = 0; tt < 2; ++tt) { const int tile = w * 2 + tt, ti = tile >> 2, tj = tile & 3; cbt[tt] = (f32x4){0.f, 0.f, 0.f, 0.f};
            if (tj <= ti) cbt[tt] = tile_bf(Ct_ + 16 * ti * SB, SB, Bt_ + 16 * tj * SB, SB, 128, cbt[tt], l15, q4); }
        for (int hh = 0; hh < 4; ++hh) { const int h = 4 * g + hh; LAS bf16* M = Mb + (hh & 1) * 64 * RS; LAS bf16* xd = xdT + (hh & 1) * 64 * RS; const LAS float* dth = dt + hh * 64; const LAS float* ach = ac + hh * 64;
#pragma unroll
            for (int tt = 0; tt < 2; ++tt) { const int tile = w * 2 + tt, ti = tile >> 2, tj = tile & 3;
#pragma unroll
                for (int r = 0; r < 4; ++r) { const int l = 16 * ti + 4 * q4 + r, s = 16 * tj + l15; M[l * RS + s] = (bf16)f2bf((s <= l) ? cbt[tt][r] * expf(ach[l] - ach[s]) * dth[s] : 0.f); } }
            { const int p = tid >> 3, l0 = 8 * (tid & 7); const u32x4 v = *(const LAS u32x4*)(xT + (hh * 64 + p) * RS + l0); const float a63 = ach[63]; float xv[8] = {bf2f(v.x & 0xffffu), bf2f(v.x >> 16), bf2f(v.y & 0xffffu), bf2f(v.y >> 16), bf2f(v.z & 0xffffu), bf2f(v.z >> 16), bf2f(v.w & 0xffffu), bf2f(v.w >> 16)};
#pragma unroll
              for (int i = 0; i < 8; ++i) xv[i] *= dth[l0 + i] * expf(a63 - ach[l0 + i]);
              *(LAS u32x4*)(xd + p * RS + l0) = pack8(xv); }
            __syncthreads();
#pragma unroll
            for (int tt = 0; tt < 2; ++tt) { const int tile = w * 2 + tt, ti = tile >> 2, tj = tile & 3;
                const f32x4 acc = tile_bf(M + 16 * ti * RS, RS, xT + (hh * 64 + 16 * tj) * RS, RS, 64, (f32x4){0.f, 0.f, 0.f, 0.f}, l15, q4);
                const f32x4 xs = ld_bf16x4((const bf16*)(xT + (hh * 64 + 16 * tj + l15) * RS + 16 * ti + 4 * q4));
#pragma unroll
                for (int r = 0; r < 4; ++r) YD[(tok0 + 16 * ti + 4 * q4 + r) * 512 + h * 64 + 16 * tj + l15] = acc[r] + dsk[h] * xs[r]; }
            bf16* st = ST + ((size_t)((b * NCH + c) * 8 + h)) * 64 * 128;
#pragma unroll
            for (int tt = 0; tt < 4; ++tt) { const int tile = w * 4 + tt, ti = tile >> 2, tj = tile & 3;
                const f32x4 acc = tile_bf(BT + 16 * ti * RS, RS, xd + 16 * tj * RS, RS, 64, (f32x4){0.f, 0.f, 0.f, 0.f}, l15, q4);
                st_bf16x4(st + (16 * tj + l15) * 128 + 16 * ti + 4 * q4, acc); }
        }
    }
    __syncthreads();
}
__device__ __forceinline__ void phase_ssd_s23(const Frame& F, const Args& A) {
    const bf16* ST = WSP(bf16, S_ST); float* YD = WSP(float, S_YD); const unsigned char* SCB = WSP(unsigned char, S_C); const float* AC = WSP(float, S_AC);
    LAS bf16* Cimg = (LAS bf16*)F.lds; LAS bf16* Hb = Cimg + 2 * 64 * SB;
    const int tid = F.tid, lane = F.lane, w = F.wave, l15 = lane & 15, q4 = lane >> 4;
    const int nunits = BH * 8 * 4, hp = tid >> 5, hn = 4 * (tid & 31);
    constexpr int NCK = SC_IMG / 16;
    for (int unit = F.bid; unit < nunits; unit += F.G) {
        const int ps = unit & 3, h = (unit >> 2) & 7, b = unit >> 5, g = h >> 2;
        __syncthreads();
        f32x4 Hr = (f32x4){0.f, 0.f, 0.f, 0.f};
        u32x4 pre[3]; u32x2 pst;
        { const unsigned char* src = SCB + (size_t)((b * NCH + 0) * 2 + g) * SC_IMG;
#pragma unroll
          for (int q = 0; q < 3; ++q) { const int e = tid + 512 * q; if (e < NCK) ((LAS u32x4*)Cimg)[e] = *(const u32x4*)(src + (size_t)e * 16); } }
        pst = *(const u32x2*)(ST + ((size_t)((b * NCH + 0) * 8 + h)) * 8192 + (16 * ps + hp) * 128 + hn);
        for (int c = 0; c < NCH; ++c) {
            const size_t tok0 = (size_t)b * SEQ + (size_t)c * 64;
            const u32x2 stc = pst;
            if (c + 1 < NCH) { const unsigned char* src = SCB + (size_t)((b * NCH + c + 1) * 2 + g) * SC_IMG;
#pragma unroll
                for (int q = 0; q < 3; ++q) { const int e = tid + 512 * q; if (e < NCK) pre[q] = *(const u32x4*)(src + (size_t)e * 16); }
                pst = *(const u32x2*)(ST + ((size_t)((b * NCH + c + 1) * 8 + h)) * 8192 + (16 * ps + hp) * 128 + hn); }
            st_bf16x4((bf16*)(Hb + hp * SB + hn), Hr);
            __syncthreads();
            if (w < 4) { const LAS bf16* Ci = Cimg + (c & 1) * 64 * SB;
                const f32x4 acc = tile_bf(Ci + 16 * w * SB, SB, Hb, SB, 128, (f32x4){0.f, 0.f, 0.f, 0.f}, l15, q4);
#pragma unroll
                for (int r = 0; r < 4; ++r) { const size_t tok = tok0 + 16 * w + 4 * q4 + r; const size_t o = tok * 512 + h * 64 + 16 * ps + l15; YD[o] += acc[r] * expf(AC[tok * 8 + h]); } }
            { const float dec = expf(AC[(tok0 + 63) * 8 + h]); Hr.x = dec * Hr.x + bf2f(stc.x & 0xffffu); Hr.y = dec * Hr.y + bf2f(stc.x >> 16); Hr.z = dec * Hr.z + bf2f(stc.y & 0xffffu); Hr.w = dec * Hr.w + bf2f(stc.y >> 16); }
            if (c + 1 < NCH) { LAS u32x4* dst = (LAS u32x4*)(Cimg + ((c + 1) & 1) * 64 * SB);
#pragma unroll
                for (int q = 0; q < 3; ++q) { const int e = tid + 512 * q; if (e < NCK) dst[e] = pre[q]; } }
            __syncthreads();
        }
    }
    __syncthreads();
}
__device__ __forceinline__ void phase_ssd_s4(const Frame& F, const Args& A, int layer) {
    const float* YD = WSP(float, S_YD); const bf16* P = WSP(bf16, A_P); bf16* Y = WSP(bf16, A_Y) + (size_t)3 * TH * 512; const float* nw = A.in[28] + layer * 512;
    const int lane = F.lane, c0 = 8 * lane;
    for (int m = F.gw; m < TH; m += F.NGW) {
        const f32x4 a = *(const f32x4*)(YD + (size_t)m * 512 + c0), b2 = *(const f32x4*)(YD + (size_t)m * 512 + c0 + 4);
        const f32x4 z0 = ld_bf16x4(P + (size_t)m * PW + C_SSD + c0), z1 = ld_bf16x4(P + (size_t)m * PW + C_SSD + c0 + 4);
        float y[8] = {a.x * siluf_(z0.x), a.y * siluf_(z0.y), a.z * siluf_(z0.z), a.w * siluf_(z0.w), b2.x * siluf_(z1.x), b2.y * siluf_(z1.y), b2.z * siluf_(z1.z), b2.w * siluf_(z1.w)};
        float ss = 0.f;
#pragma unroll
        for (int q = 0; q < 8; ++q) ss += y[q] * y[q];
        ss += __shfl_xor(ss, 1); ss += __shfl_xor(ss, 2); ss += __shfl_xor(ss, 4); ss += __shfl_xor(ss, 8); ss += __shfl_xor(ss, 16);
        const float rstd = 1.0f / sqrtf(ss * (1.0f / 256.0f) + EPS);
#pragma unroll
        for (int q = 0; q < 8; ++q) y[q] = y[q] * rstd * nw[c0 + q];
        u32x4 wv; wv.x = pk2(y[0], y[1]); wv.y = pk2(y[2], y[3]); wv.z = pk2(y[4], y[5]); wv.w = pk2(y[6], y[7]);
        *(u32x4*)(Y + (size_t)m * 512 + c0) = wv;
    }
}

__device__ __forceinline__ f32x4 tile_mm(const LAS float* a, int lda, int ska, const LAS float* b, int ldb, int scb, int K, f32x4 acc, int l15, int q4) {
    const LAS float* ap = a + l15 * lda + q4 * ska; const LAS float* bp = b + q4 * ldb + l15 * scb;
#pragma unroll 8
    for (int ks = 0; ks < K / 4; ++ks) acc = MFMA_F32(ap[ks * 4 * ska], bp[ks * 4 * ldb], acc);
    return acc;
}
constexpr int GS = 132, GS2 = 68;
constexpr int GR_W = 0, GR_QH = 64 * 136 * 2, GR_KT = 2 * 64 * 136 * 2, GR_QK = GR_KT + 128 * 72 * 2, GR_GL = GR_QK + 64 * 72 * 2, GR_COMMON = GR_GL + 16, GR_USL = 64 * 20 * 4, GR_BYTES = GR_COMMON + 8 * GR_USL;
static_assert(GR_BYTES == 103440 && GR_COMMON % 16 == 0, "GDN record");
constexpr int GX = 264;
__device__ __forceinline__ void phase_gdn_g1(const Frame& F, const Args& A, int layer) {
    const bf16* P = WSP(bf16, A_P); unsigned char* CHR = WSP(unsigned char, G_CH);
    const float* convw = A.in[19] + (size_t)layer * 4 * 1536; const float* a_log = A.in[20] + layer * 4; const float* dtb = A.in[21] + layer * 4;
    LAS bf16* qb = (LAS bf16*)F.lds; LAS bf16* kb = qb + 64 * SB; LAS bf16* qkimg = kb + 64 * SB;
    LAS float* X = (LAS float*)(qkimg + 64 * RS); LAS float* Lm = X + 64 * GX; LAS float* ssq = Lm + 64 * GS2;
    LAS float* beta = ssq + 2 * 64 * 16; LAS float* gc = beta + 64; LAS float* egc = gc + 64; LAS float* inorm = egc + 64;
    const int tid = F.tid, lane = F.lane, w = F.wave, l15 = lane & 15, q4 = lane >> 4;
    const int nunits = BH * 4 * NCH;
    for (int unit = F.bid; unit < nunits; unit += F.G) {
        const int c = unit % NCH, h = (unit / NCH) & 3, b = unit / (NCH * 4);
        const size_t tok0 = (size_t)b * SEQ + (size_t)c * 64;
        unsigned char* rec = CHR + (size_t)unit * GR_BYTES;
        __syncthreads();
        const int rb = tid / 48, pc = tid % 48, part = pc >> 4, cgl = pc & 15;
        float o[8][8];
        if (tid < 384) { const int col = part * 512 + h * 128 + 8 * cgl;
            conv8x8(P + (tok0 + 8 * rb) * PW + C_GDN + col, c * 64 + 8 * rb, convw + col, 1536, nullptr, o);
            if (part < 2) {
#pragma unroll
                for (int i = 0; i < 8; ++i) { float sacc = 0.f;
#pragma unroll
                    for (int ch = 0; ch < 8; ++ch) sacc += o[i][ch] * o[i][ch];
                    ssq[(part * 64 + 8 * rb + i) * 16 + cgl] = sacc; } } }
        if (w == 7) { const size_t tok = tok0 + lane; beta[lane] = sigmoidf_(bf2f(P[tok * PW + C_GDN + 1536 + h]));
            float g = -expf(a_log[h]) * softplusf_(bf2f(P[tok * PW + C_GDN + 1540 + h]) + dtb[h]);
#pragma unroll
            for (int o2 = 1; o2 < 64; o2 <<= 1) { const float t = __shfl_up(g, o2); if (lane >= o2) g += t; }
            gc[lane] = g; egc[lane] = expf(g); }
        __syncthreads();
        if (tid < 128) { float sacc = 0.f;
#pragma unroll
            for (int i = 0; i < 16; ++i) sacc += ssq[tid * 16 + i];
            inorm[tid] = (tid < 64 ? 0.08838834764831845f : 1.0f) / sqrtf(sacc + EPS); }
        __syncthreads();
        if (tid < 384) {
#pragma unroll
            for (int i = 0; i < 8; ++i) { const int l = 8 * rb + i;
                if (part < 2) { const float sc = inorm[part * 64 + l]; float v[8];
#pragma unroll
                    for (int ch = 0; ch < 8; ++ch) v[ch] = o[i][ch] * sc;
                    *(LAS u32x4*)((part ? kb : qb) + l * SB + 8 * cgl) = pack8(v); }
                else { const float bl = beta[l]; *(LAS f32x4*)(X + l * GX + 8 * cgl) = (f32x4){o[i][0] * bl, o[i][1] * bl, o[i][2] * bl, o[i][3] * bl}; *(LAS f32x4*)(X + l * GX + 8 * cgl + 4) = (f32x4){o[i][4] * bl, o[i][5] * bl, o[i][6] * bl, o[i][7] * bl}; } } }
        __syncthreads();
        for (int tt = 0; tt < 4; ++tt) { const int tile = w * 4 + tt, which = tile >> 4, ti = (tile >> 2) & 3, tj = tile & 3;
            f32x4 acc = (f32x4){0.f, 0.f, 0.f, 0.f};
            if (tj <= ti) acc = tile_bf((which ? qb : kb) + 16 * ti * SB, SB, kb + 16 * tj * SB, SB, 128, acc, l15, q4);
#pragma unroll
            for (int r = 0; r < 4; ++r) { const int i = 16 * ti + 4 * q4 + r, j = 16 * tj + l15; float v = 0.f;
                if (which ? (j <= i) : (j < i)) v = acc[r] * expf(gc[i] - gc[j]) * (which ? 1.0f : beta[i]);
                if (which) qkimg[i * RS + j] = (bf16)f2bf(v); else Lm[i * GS2 + j] = v; } }
        { const float glast = gc[63];
          for (int e = tid; e < 64 * 16; e += 512) { const int l = e >> 4, d0 = 8 * (e & 15); const u32x4 kv = *(const LAS u32x4*)(kb + l * SB + d0), qv = *(const LAS u32x4*)(qb + l * SB + d0);
              const float kf[8] = {bf2f(kv.x & 0xffffu), bf2f(kv.x >> 16), bf2f(kv.y & 0xffffu), bf2f(kv.y >> 16), bf2f(kv.z & 0xffffu), bf2f(kv.z >> 16), bf2f(kv.w & 0xffffu), bf2f(kv.w >> 16)};
              float qf[8] = {bf2f(qv.x & 0xffffu), bf2f(qv.x >> 16), bf2f(qv.y & 0xffffu), bf2f(qv.y >> 16), bf2f(qv.z & 0xffffu), bf2f(qv.z >> 16), bf2f(qv.w & 0xffffu), bf2f(qv.w >> 16)};
              const float sc = beta[l] * egc[l], eg = egc[l];
              *(LAS f32x4*)(X + l * GX + 128 + d0) = (f32x4){kf[0] * sc, kf[1] * sc, kf[2] * sc, kf[3] * sc}; *(LAS f32x4*)(X + l * GX + 132 + d0) = (f32x4){kf[4] * sc, kf[5] * sc, kf[6] * sc, kf[7] * sc};
#pragma unroll
              for (int q = 0; q < 8; ++q) qf[q] *= eg;
              *(u32x4*)(rec + GR_QH + (size_t)(l * SB + d0) * 2) = pack8(qf); }
          for (int e = tid; e < 128 * 8; e += 512) { const int d = e >> 3, l0 = 8 * (e & 7); float kt[8];
#pragma unroll
              for (int q = 0; q < 8; ++q) kt[q] = bf2f(kb[(l0 + q) * SB + d]) * expf(glast - gc[l0 + q]);
              *(u32x4*)(rec + GR_KT + (size_t)(d * RS + l0) * 2) = pack8(kt); }
          if (tid == 0) *(float*)(rec + GR_GL) = expf(glast); }
        __syncthreads();
        for (int e = tid; e < 64 * RS / 8; e += 512) ((u32x4*)(rec + GR_QK))[e] = ((const LAS u32x4*)qkimg)[e];
        for (int rbk = 0; rbk < 4; ++rbk) {
            if (rbk > 0) {
#pragma unroll
                for (int t2 = 0; t2 < 2; ++t2) { const int tj = 2 * w + t2;
                    const f32x4 acc = tile_mm(Lm + 16 * rbk * GS2, GS2, 1, X + 16 * tj, GX, 1, 16 * rbk, (f32x4){0.f, 0.f, 0.f, 0.f}, l15, q4);
#pragma unroll
                    for (int r = 0; r < 4; ++r) X[(16 * rbk + 4 * q4 + r) * GX + 16 * tj + l15] -= acc[r]; }
                __syncthreads();
            }
            if (tid < 256) { float x[16];
#pragma unroll
                for (int i = 0; i < 16; ++i) { float sacc = X[(16 * rbk + i) * GX + tid];
#pragma unroll
                    for (int j = 0; j < i; ++j) sacc -= Lm[(16 * rbk + i) * GS2 + 16 * rbk + j] * x[j];
                    x[i] = sacc; }
#pragma unroll
                for (int i = 0; i < 16; ++i) X[(16 * rbk + i) * GX + tid] = x[i]; }
            __syncthreads();
        }
        for (int e = tid; e < 64 * 16; e += 512) { const int l = e >> 4, d0 = 8 * (e & 15); const f32x4 a = *(const LAS f32x4*)(X + l * GX + 128 + d0), b2 = *(const LAS f32x4*)(X + l * GX + 132 + d0);
            const float v[8] = {a.x, a.y, a.z, a.w, b2.x, b2.y, b2.z, b2.w}; *(u32x4*)(rec + GR_W + (size_t)(l * SB + d0) * 2) = pack8(v); }
        for (int e = tid; e < 64 * 32; e += 512) { const int l = e >> 5, c4 = 4 * (e & 31); *(f32x4*)(rec + GR_COMMON + (size_t)(c4 >> 4) * GR_USL + (size_t)(l * 20 + (c4 & 15)) * 4) = *(const LAS f32x4*)(X + l * GX + c4); }
    }
    __syncthreads();
}
constexpr int G2_STAGE = GR_COMMON + GR_USL;
__device__ __forceinline__ void phase_gdn_g2(const Frame& F, const Args& A) {
    const unsigned char* CHR = WSP(unsigned char, G_CH); float* GO = WSP(float, G_O);
    LAS unsigned char* buf0 = F.lds; LAS bf16* STt = (LAS bf16*)(F.lds + 2 * G2_STAGE); LAS bf16* vnT = STt + 2 * 16 * SB;
    const int tid = F.tid, lane = F.lane, w = F.wave, l15 = lane & 15, q4 = lane >> 4;
    const int nunits = BH * 4 * 8;
    constexpr int NCK = G2_STAGE / 16;
    for (int unit = F.bid; unit < nunits; unit += F.G) {
        const int vs = unit & 7, h = (unit >> 3) & 3, b = unit >> 5;
        __syncthreads();
        for (int e = tid; e < 2 * 16 * SB / 2; e += 512) ((LAS unsigned*)STt)[e] = 0u;
        f32x4 Sreg = (f32x4){0.f, 0.f, 0.f, 0.f};
        u32x4 pre[9];
        { const unsigned char* rec = CHR + (size_t)((b * 4 + h) * NCH) * GR_BYTES;
#pragma unroll
          for (int q = 0; q < 9; ++q) { const int e = tid + 512 * q; if (e < NCK) { const size_t off = (size_t)e * 16; *(LAS u32x4*)(buf0 + off) = *(const u32x4*)(rec + (off < GR_COMMON ? off : off + (size_t)vs * GR_USL)); } } }
        __syncthreads();
        for (int c = 0; c < NCH; ++c) {
            LAS unsigned char* buf = buf0 + (c & 1) * G2_STAGE; LAS unsigned char* nbuf = buf0 + ((c + 1) & 1) * G2_STAGE;
            if (c + 1 < NCH) { const unsigned char* rec = CHR + (size_t)((b * 4 + h) * NCH + c + 1) * GR_BYTES;
#pragma unroll
                for (int q = 0; q < 9; ++q) { const int e = tid + 512 * q; if (e < NCK) { const size_t off = (size_t)e * 16; pre[q] = *(const u32x4*)(rec + (off < GR_COMMON ? off : off + (size_t)vs * GR_USL)); } } }
            const LAS bf16* Wi = (const LAS bf16*)(buf + GR_W); const LAS bf16* QH = (const LAS bf16*)(buf + GR_QH); const LAS bf16* KT = (const LAS bf16*)(buf + GR_KT); const LAS bf16* QK = (const LAS bf16*)(buf + GR_QK);
            const float egl = *(const LAS float*)(buf + GR_GL); const LAS float* U = (const LAS float*)(buf + GR_COMMON);
            const LAS bf16* S0 = STt + (c & 1) * 16 * SB; LAS bf16* S1 = STt + ((c + 1) & 1) * 16 * SB;
            if (w < 4) {
                const f32x4 acc = tile_bf(Wi + 16 * w * SB, SB, S0, SB, 128, (f32x4){0.f, 0.f, 0.f, 0.f}, l15, q4);
                f32x4 vn;
#pragma unroll
                for (int r = 0; r < 4; ++r) vn[r] = U[(16 * w + 4 * q4 + r) * 20 + l15] - acc[r];
                u32x2 pk; pk.x = pk2(vn[0], vn[1]); pk.y = pk2(vn[2], vn[3]); *(LAS u32x2*)(vnT + l15 * RS + 16 * w + 4 * q4) = pk; }
            __syncthreads();
            if (w < 4) {
                f32x4 acc = tile_bf(QH + 16 * w * SB, SB, S0, SB, 128, (f32x4){0.f, 0.f, 0.f, 0.f}, l15, q4);
                acc = tile_bf(QK + 16 * w * RS, RS, vnT, RS, 64, acc, l15, q4);
#pragma unroll
                for (int r = 0; r < 4; ++r) GO[((size_t)b * SEQ + (size_t)c * 64 + 16 * w + 4 * q4 + r) * 512 + h * 128 + 16 * vs + l15] = acc[r]; }
            Sreg = Sreg * egl;
            Sreg = tile_bf(KT + 16 * w * RS, RS, vnT, RS, 64, Sreg, l15, q4);
            { u32x2 pk; pk.x = pk2(Sreg[0], Sreg[1]); pk.y = pk2(Sreg[2], Sreg[3]); *(LAS u32x2*)(S1 + l15 * SB + 16 * w + 4 * q4) = pk; }
            if (c + 1 < NCH) {
#pragma unroll
                for (int q = 0; q < 9; ++q) { const int e = tid + 512 * q; if (e < NCK) *(LAS u32x4*)(nbuf + (size_t)e * 16) = pre[q]; } }
            __syncthreads();
        }
    }
    __syncthreads();
}
__device__ __forceinline__ void phase_gdn_g3(const Frame& F, const Args& A, int layer) {
    const float* GO = WSP(float, G_O); const bf16* P = WSP(bf16, A_P); bf16* Y = WSP(bf16, A_Y) + (size_t)2 * TH * 512; const float* nw = A.in[22] + layer * 128;
    const int lane = F.lane, c0 = 8 * lane;
    for (int m = F.gw; m < TH; m += F.NGW) {
        const f32x4 a = *(const f32x4*)(GO + (size_t)m * 512 + c0), b2 = *(const f32x4*)(GO + (size_t)m * 512 + c0 + 4);
        float o[8] = {a.x, a.y, a.z, a.w, b2.x, b2.y, b2.z, b2.w}; float ss = 0.f;
#pragma unroll
        for (int q = 0; q < 8; ++q) ss += o[q] * o[q];
        ss += __shfl_xor(ss, 1); ss += __shfl_xor(ss, 2); ss += __shfl_xor(ss, 4); ss += __shfl_xor(ss, 8);
        const float rstd = 1.0f / sqrtf(ss * (1.0f / 128.0f) + EPS);
        const f32x4 z0 = ld_bf16x4(P + (size_t)m * PW + C_GDN + 1544 + c0), z1 = ld_bf16x4(P + (size_t)m * PW + C_GDN + 1544 + c0 + 4);
        const float z[8] = {z0.x, z0.y, z0.z, z0.w, z1.x, z1.y, z1.z, z1.w}; float y[8];
#pragma unroll
        for (int q = 0; q < 8; ++q) y[q] = o[q] * rstd * nw[(c0 + q) & 127] * siluf_(z[q]);
        u32x4 wv; wv.x = pk2(y[0], y[1]); wv.y = pk2(y[2], y[3]); wv.z = pk2(y[4], y[5]); wv.w = pk2(y[6], y[7]);
        *(u32x4*)(Y + (size_t)m * 512 + c0) = wv;
    }
}

__device__ __forceinline__ void phase_merge_z(const Frame& F, const Args& A) {
    pg8::Gemm g{WSP(bf16, A_Y), WSP(bf16, W_BR), 512, 512}; BranchOrder S; S.nP = TH / 256; S.G = F.G; S.c = F.bid;
    EpiZ E{WSP(bf16, A_Z)}; pg8::gemm_phase(F.lds, g, S, E, F.tid);
}
__device__ __forceinline__ void phase_merge_gate(const Frame& F, const Args& A, int layer) {
    pg8::Gemm g{WSP(bf16, A_H), WSP(bf16, W_GATE), D, D}; pg8::StaticOrder S; S.init(TH, 4096, F.G, F.bid);
    EpiMerge E{WSP(bf16, A_Z), A.in[29] + (size_t)layer * 4 * D, WSP(bf16, A_MG)}; pg8::gemm_phase(F.lds, g, S, E, F.tid);
#if 1
    if (((REPEAT_MASK) >> 28) & 1u) { __syncthreads(); EpiBf16 E2{WSP(bf16, A_MIX + (size_t)64 * MiB), 4096, nullptr, 0}; pg8::gemm_phase(F.lds, g, S, E2, F.tid); }
#endif
}
__device__ __forceinline__ void phase_merge_out(const Frame& F, const Args& A, const float* xin, float* xout) {
    pg8::Gemm g{WSP(bf16, A_MG), WSP(bf16, W_OUT), D, D}; pg8::StaticOrder S; S.init(TH, D, F.G, F.bid);
    EpiResidual E{xin, xout}; pg8::gemm_phase(F.lds, g, S, E, F.tid);
}
__device__ __forceinline__ void phase_ffn_gu(const Frame& F, const Args& A) {
    pg8::Gemm g{WSP(bf16, A_H), WSP(bf16, W_FGU), D, D}; pg8::StaticOrder S; S.init(TH, 2 * FF_D, F.G, F.bid);
    EpiSwiGLU E{WSP(bf16, F_ACT), FF_D, 1 << 20}; pg8::gemm_phase(F.lds, g, S, E, F.tid);
}
__device__ __forceinline__ void phase_ffn_down(const Frame& F, const Args& A, float* x) {
    pg8::Gemm g{WSP(bf16, F_ACT), WSP(bf16, W_FDN), FF_D, FF_D}; pg8::StaticOrder S; S.init(TH, D, F.G, F.bid);
    EpiResidual E{x, x}; pg8::gemm_phase(F.lds, g, S, E, F.tid);
}
struct MoeLayout { int pstart[NEXP + 1]; };
__device__ __forceinline__ MoeLayout moe_layout(const unsigned* cnt) {
    MoeLayout L; int s = 0;
#pragma unroll
    for (int e = 0; e < NEXP; ++e) { L.pstart[e] = s; s += ((int)cnt[e] + 255) & ~255; }
    L.pstart[NEXP] = s; return L;
}
struct MoeOrder {
    int np, nN, G, c; MoeLayout L;
    __device__ bool next(int i, Unit& u) const {
        const long Lx = (long)i * G + c; if (Lx >= (long)np * nN) return false;
        const int pm = (int)(Lx / nN), pn = (int)(Lx % nN); int e = 0;
#pragma unroll
        for (int k = 1; k < NEXP; ++k) if (pm * 256 >= L.pstart[k]) e = k;
        u.pm = pm; u.pn = e * nN + pn; return true;
    }
    __device__ __forceinline__ void a_ready(const Unit&) const {}
    __device__ __forceinline__ void done(const Unit&) const {}
};
__device__ __forceinline__ void phase_moe_route(const Frame& F, const Args& A, int half) {
    const unsigned* wgc = F.ctl + CW_WGC + half * 8192; unsigned* cnt = F.ctl + CW_CNT + half * 16;
    LAS unsigned* tab = (LAS unsigned*)F.lds; LAS unsigned* tot = tab + 8192; LAS unsigned* bef = tot + 8; LAS unsigned* cur = bef + 8;
    __syncthreads();
    for (int e = F.tid; e < F.G * 8; e += 512) tab[e] = wgc[e];
    __syncthreads();
    if (F.tid < 8) { unsigned t = 0, bsum = 0; for (int g = 0; g < F.G; ++g) { const unsigned v = tab[g * 8 + F.tid]; if (g < F.bid) bsum += v; t += v; } tot[F.tid] = t; bef[F.tid] = bsum; cur[F.tid] = 0u; if (F.bid == 0) cnt[F.tid] = t; }
    __syncthreads();
    unsigned totr[8];
#pragma unroll
    for (int e = 0; e < 8; ++e) totr[e] = tot[e];
    const MoeLayout L = moe_layout(totr);
    const bf16* H = WSP(bf16, A_H); bf16* GA = WSP(bf16, F_GA); const int* tope = WSP(int, F_TOPE); int* slot = WSP(int, F_SLOT);
    const int lane = F.lane;
    for (int m = F.gw; m < TH; m += F.NGW) {
        const u32x4 v0 = *(const u32x4*)(H + (size_t)m * D + 8 * lane), v1 = *(const u32x4*)(H + (size_t)m * D + 512 + 8 * lane);
#pragma unroll
        for (int k = 0; k < 2; ++k) { const int e = tope[2 * m + k]; int s = 0;
            int ps = 0;
#pragma unroll
            for (int q = 0; q < NEXP; ++q) ps = (e == q) ? L.pstart[q] : ps;
            if (lane == 0) s = ps + (int)bef[e] + (int)ATOMIC_ADD_LDS(cur + e, 1u);
            s = __shfl(s, 0);
            if (lane == 0) slot[2 * m + k] = s;
            *(u32x4*)(GA + (size_t)s * D + 8 * lane) = v0; *(u32x4*)(GA + (size_t)s * D + 512 + 8 * lane) = v1; }
    }
#pragma unroll
    for (int e = 0; e < NEXP; ++e) { const int r0 = L.pstart[e] + (int)totr[e], r1 = L.pstart[e + 1];
        for (int r = r0 + F.gw; r < r1; r += F.NGW) { *(u32x4*)(GA + (size_t)r * D + 8 * lane) = (u32x4){0u, 0u, 0u, 0u}; *(u32x4*)(GA + (size_t)r * D + 512 + 8 * lane) = (u32x4){0u, 0u, 0u, 0u}; } }
    __syncthreads();
}
__device__ __forceinline__ void phase_moe_gu(const Frame& F, const Args& A, int half) {
    MoeOrder S; S.L = moe_layout(F.ctl + CW_CNT + half * 16); S.np = S.L.pstart[NEXP] / 256; S.nN = 2 * FF_E / 256; S.G = F.G; S.c = F.bid;
    pg8::Gemm g{WSP(bf16, F_GA), WSP(bf16, W_FGU), D, D}; EpiSwiGLU E{WSP(bf16, F_ACT), FF_E, 2 * FF_E / 256}; pg8::gemm_phase(F.lds, g, S, E, F.tid);
}
struct EpiF32Mod {
    static constexpr bool PERM = false, AFTER_DRAIN = false;
    float* C;
    __device__ __forceinline__ void operator()(const f32x4 (&acc)[2][2][4][2], const Unit& u, int wr, int wc, int fr, int fq) const {
        const int row0 = u.pm * 256 + wr * 64 + fr, col0 = (u.pn & 3) * 256 + wc * 32 + 4 * fq;
#pragma unroll
        for (int ai = 0; ai < 2; ++ai)
#pragma unroll
            for (int m = 0; m < 4; ++m) { float* rowp = C + (size_t)(row0 + ai * HALFT + m * 16) * D + col0;
#pragma unroll
                for (int bj = 0; bj < 2; ++bj)
#pragma unroll
                    for (int n = 0; n < 2; ++n) *(f32x4*)(rowp + bj * HALFT + n * 16) = acc[ai][bj][m][n]; }
    }
};
__device__ __forceinline__ void phase_moe_down(const Frame& F, const Args& A, int half) {
    MoeOrder S; S.L = moe_layout(F.ctl + CW_CNT + half * 16); S.np = S.L.pstart[NEXP] / 256; S.nN = D / 256; S.G = F.G; S.c = F.bid;
    pg8::Gemm g{WSP(bf16, F_ACT), WSP(bf16, W_FDN), FF_E, FF_E}; EpiF32Mod E{WSP(float, F_YE)}; pg8::gemm_phase(F.lds, g, S, E, F.tid);
}
__device__ __forceinline__ void phase_moe_combine(const Frame& F, const Args& A, float* x) {
    const float* YE = WSP(float, F_YE); const int* slot = WSP(int, F_SLOT); const float* topw = WSP(float, F_TOPW); const int lane = F.lane;
    for (int m = F.gw; m < TH; m += F.NGW) { const int s0 = slot[2 * m], s1 = slot[2 * m + 1]; const float w0 = topw[2 * m], w1 = topw[2 * m + 1];
#pragma unroll
        for (int j = 0; j < 4; ++j) { const int c = 4 * lane + 256 * j; float* xp = x + (size_t)m * D + c;
            *(f32x4*)xp = *(const f32x4*)xp + *(const f32x4*)(YE + (size_t)s0 * D + c) * w0 + *(const f32x4*)(YE + (size_t)s1 * D + c) * w1; } }
}

#ifndef EMU
#define XB_TMO      128
#define XB_XCNT(j)  (256  + 64 * (j))
#define XB_XSUB(j)  (1280 + 64 * (j))
#define XB_XGEN(j)  (2304 + 64 * (j))
#define XB_TOP      3328
#define XB_TOPGEN   3392
#define XCD_BAR_WORDS 3456
#define XB_SPIN_CAP (1u << 22)
__device__ __forceinline__ unsigned xb_ld(unsigned* p)              { return __hip_atomic_load(p, __ATOMIC_RELAXED, __HIP_MEMORY_SCOPE_AGENT); }
__device__ __forceinline__ unsigned xb_add(unsigned* p, unsigned v) { return __hip_atomic_fetch_add(p, v, __ATOMIC_RELAXED, __HIP_MEMORY_SCOPE_AGENT); }
__device__ __forceinline__ unsigned xb_xcc_id() { return (unsigned)__builtin_amdgcn_s_getreg((3 << 11) | 20) & 0xFu; }
#define XB_SPIN(cond, bar) do { unsigned _sp = 0; while (cond) { __builtin_amdgcn_s_sleep(1); \
    if ((++_sp & 255u) == 0u) { if (xb_ld(&(bar)[XB_TMO])) break; if (_sp > XB_SPIN_CAP) { atomicAdd(&(bar)[XB_TMO], 1u); break; } } } } while (0)
struct XcdBarrier { unsigned* bar; unsigned x; volatile LAS unsigned* st; };
__device__ __forceinline__ XcdBarrier xcd_barrier_post(unsigned* bar, volatile LAS unsigned* st) {
    XcdBarrier b; b.bar = bar; b.x = xb_xcc_id(); b.st = st;
    if (threadIdx.x == 0) (void)xb_add(&bar[XB_XCNT(b.x)], 1u);
    return b;
}
__device__ __forceinline__ void xcd_barrier_complete(unsigned* bar, unsigned x, unsigned& nloc, unsigned& nx) {
    const unsigned G = gridDim.x * gridDim.y * gridDim.z;
    unsigned sum, cnt, mine, sp = 0u;
    for (;;) {
        sum = 0u; cnt = 0u; mine = 0u;
#pragma unroll
        for (unsigned j = 0; j < 16; ++j) { const unsigned c = xb_ld(&bar[XB_XCNT(j)]); sum += c; cnt += (c > 0u) ? 1u : 0u; mine = (j == x) ? c : mine; }
        if (sum == G) break;
        __builtin_amdgcn_s_sleep(1);
        if ((++sp & 255u) == 0u) { if (xb_ld(&bar[XB_TMO])) break; if (sp > XB_SPIN_CAP) { atomicAdd(&bar[XB_TMO], 1u); break; } }
    }
    nloc = mine > 0u ? mine : 1u; nx = cnt > 0u ? cnt : 1u;
}
__device__ __forceinline__ void xcd_barrier(const XcdBarrier& b) {
    asm volatile("s_waitcnt vmcnt(0)" ::: "memory");
    __syncthreads();
    if (threadIdx.x == 0) {
        unsigned* bar = b.bar;
        __builtin_amdgcn_s_waitcnt(0);
        unsigned nloc = b.st[0], nx = b.st[1];
        if (nloc == 0u) { xcd_barrier_complete(bar, b.x, nloc, nx); b.st[0] = nloc; b.st[1] = nx; }
        const unsigned old = xb_add(&bar[XB_XSUB(b.x)], 1u);
        const unsigned gen = old / nloc;
        if (old + 1u == (gen + 1u) * nloc) {
            __builtin_amdgcn_fence(__ATOMIC_RELEASE, "agent");
            asm volatile("s_waitcnt vmcnt(0)" ::: "memory");
            const unsigned og = xb_add(&bar[XB_TOP], 1u);
            const unsigned tg = og / nx;
            if (og + 1u == (tg + 1u) * nx) xb_add(&bar[XB_TOPGEN], 1u);
            else XB_SPIN(xb_ld(&bar[XB_TOPGEN]) == tg, bar);
            __builtin_amdgcn_fence(__ATOMIC_ACQUIRE, "agent");
            xb_add(&bar[XB_XGEN(b.x)], 1u);
            asm volatile("s_waitcnt vmcnt(0)" ::: "memory");
        } else {
            XB_SPIN(xb_ld(&bar[XB_XGEN(b.x)]) == gen, bar);
            __builtin_amdgcn_fence(__ATOMIC_ACQUIRE, "agent");
            asm volatile("s_waitcnt vmcnt(0)" ::: "memory");
        }
    }
    __syncthreads();
}
#endif

constexpr int NPH = 25;
constexpr int NPHASES = DEPTH * (1 + NHALF * NPH) + 1;
constexpr int LDS_BYTES = 155648, MISC_OFF = 154624;

__global__ void __launch_bounds__(512, 2) fwd_kernel(Args args_k) {
#ifdef EMU
    unsigned char* lds = emu_lds_ptr;
#else
    extern __shared__ __attribute__((aligned(16))) unsigned char lds[];
#endif
    Frame F0;
    F0.lds = (LAS unsigned char*)lds; F0.tid = threadIdx.x; F0.lane = F0.tid & 63; F0.wave = RFL(F0.tid >> 6); F0.G = gridDim.x; F0.bid = blockIdx.x;
    F0.gw = F0.bid * 8 + F0.wave; F0.NGW = F0.G * 8;
    F0.out = args_k.out; F0.ws = args_k.ws; F0.ctl = (unsigned*)(args_k.ws + WS_CTL);
    const int lo = args_k.lo, hi = args_k.hi;
#ifndef EMU
    volatile LAS unsigned* misc = (volatile LAS unsigned*)(F0.lds + MISC_OFF);
    if (F0.tid < 4) misc[F0.tid] = 0u;
    __syncthreads();
    XcdBarrier bar; bar.bar = F0.ctl + CW_BAR; bar.x = 0; bar.st = misc;
    if (hi - lo > 1) bar = xcd_barrier_post(F0.ctl + CW_BAR, misc);
#define GRID_BAR() do { XcdBarrier bq = bar; asm volatile("" : "+s"(bq.bar), "+s"(bq.x)); xcd_barrier(bq); } while (0)
#else
#define GRID_BAR() do { } while (0)
#endif
    int ph = 0;
#ifndef PH_MASK
#define PH_MASK 0xFFFFFFFFFFFFFFFFull
#endif
#define PHASE(...) PHASE_I(31, __VA_ARGS__)
#ifdef EMU
#define LAUNDER(Fq) do { } while (0)
#else
#define LAUNDER(Fq) do { unsigned mq_ = ~0u; asm volatile("" : "+s"(Fq.G), "+s"(Fq.bid), "+s"(Fq.wave), "+s"(Fq.ws), "+s"(Fq.out), "+s"(Fq.ctl), "+s"(mq_)); Fq.lane = (int)__builtin_amdgcn_mbcnt_hi(mq_, __builtin_amdgcn_mbcnt_lo(mq_, 0u)); Fq.tid = Fq.wave * 64 + Fq.lane; Fq.gw = Fq.bid * 8 + Fq.wave; Fq.NGW = Fq.G * 8; } while (0)
#endif
#ifdef EMU
#define ARGS_Q() const Args& args_q = args_k
#else
#define ARGS_Q() const __attribute__((address_space(4))) Args* aq_ = (const __attribute__((address_space(4))) Args*)__builtin_amdgcn_kernarg_segment_ptr(); asm volatile("" : "+s"(aq_)); const Args& args_q = *(const Args*)aq_
#endif
#define PHASE_I(kind, ...) do { if (ph >= lo && ph < hi) { constexpr int reps_ = (((REPEAT_MASK) >> (kind)) & 1u) ? 2 : 1; for (int rr_ = 0; rr_ < reps_; ++rr_) { { Frame Fq = F0; LAUNDER(Fq); const Frame& F = Fq; ARGS_Q(); const Args& args = args_q; __VA_ARGS__; } if (rr_ + 1 < reps_ || ph + 1 < hi) { GRID_BAR(); if (((REPEAT_MASK) >> 26) & 1u) GRID_BAR(); } } } ++ph; } while (0)
#define PHASEK(kind, ...) PHASE_I(kind, __VA_ARGS__)
#define SEGMENT(layer, half) do { \
            const size_t r0 = (size_t)(half) * TH; \
            const float* xin = ((layer) == 0 ? args_k.in[0] : F0.out) + r0 * D; float* xo = F0.out + r0 * D; \
            PHASEK(0, phase_norm<false>(F, args, xin, args.in[2] + (layer) * D, WSP(bf16, A_H), nullptr, nullptr, nullptr, nullptr); phase_rope_table(F, args, (const int*)args.in[1] + r0, WSP(float, A_ROPE))); \
            PHASEK(1, { pg8::Gemm g{WSP(bf16, A_H), WSP(bf16, W_IN), D, D}; pg8::StaticOrder S; S.init(TH, PW, F.G, F.bid); EpiBf16 E{WSP(bf16, A_P), PW, nullptr, 0}; pg8::gemm_phase(F.lds, g, S, E, F.tid); }); \
            PHASEK(2, phase_mla_prep(F, args)); \
            PHASEK(3, phase_mla_q(F, args)); \
            PHASEK(4, phase_mla_kv(F, args)); \
            PHASEK(5, phase_attention(F, args)); \
            PHASEK(6, phase_rwkv_prep(F, args, layer)); \
            PHASEK(7, phase_rwkv_lora(F, args)); \
            PHASEK(8, phase_rwkv_r1(F, args, layer)); \
            PHASEK(24, phase_rwkv_r2(F, args)); \
            PHASEK(9, phase_rwkv_post(F, args, layer)); \
            PHASEK(10, phase_gdn_g1(F, args, layer)); \
            PHASEK(11, phase_gdn_g2(F, args)); \
            PHASEK(12, phase_gdn_g3(F, args, layer)); \
            PHASEK(13, phase_ssd_s1(F, args, layer)); \
            PHASEK(14, phase_ssd_s23(F, args)); \
            PHASEK(16, phase_ssd_s4(F, args, layer)); \
            PHASEK(17, phase_merge_z(F, args)); \
            PHASEK(18, phase_merge_gate(F, args, layer)); \
            PHASEK(19, phase_merge_out(F, args, xin, xo)); \
            if ((layer) == 0) { \
                PHASEK(20, phase_norm<false>(F, args, xo, args.in[32] + (layer) * D, WSP(bf16, A_H), nullptr, nullptr, nullptr, nullptr)); \
                PHASEK(21, phase_ffn_gu(F, args)); \
                PHASE(phase_ffn_down(F, args, xo)); \
                PHASE((void)0); \
                PHASE((void)0); \
            } else { \
                PHASE(phase_norm<true>(F, args, xo, args.in[32] + (layer) * D, WSP(bf16, A_H), args.in[35], WSP(int, F_TOPE), WSP(float, F_TOPW), F.ctl + CW_WGC + (half) * 8192)); \
                PHASE(phase_moe_route(F, args, half)); \
                PHASEK(22, phase_moe_gu(F, args, half)); \
                PHASEK(23, phase_moe_down(F, args, half)); \
                PHASE(phase_moe_combine(F, args, xo)); \
            } } while (0)
    static_assert(DEPTH == 2 && NHALF <= 2, "segment program");
    PHASEK(27, phase_convert(F, args, 0));
    SEGMENT(0, 0);
    if (NHALF == 2) SEGMENT(0, 1);
    PHASEK(27, phase_convert(F, args, 1));
    SEGMENT(1, 0);
    if (NHALF == 2) SEGMENT(1, 1);
#undef SEGMENT
    PHASE(phase_final_norm(F, args, F.out, args.in[38]));
#undef PHASE
}

#ifndef ONE_LAUNCH
#define ONE_LAUNCH 1
#endif
extern "C" void kernel_launch(void* const* d_in, const int* in_sizes, int n_in, void* d_out, int out_size, void* d_ws, size_t ws_size, hipStream_t stream) {
    static int grid = 0;
    if (grid == 0) {
#ifdef EMU
        grid = EMU_GRID;
#else
        if (n_in != 39 || out_size != T * D || ws_size < WS_NEED) { fprintf(stderr, "kernel_launch: unexpected problem (n_in %d out %d ws %zu need %zu)\n", n_in, out_size, ws_size, (size_t)WS_NEED); grid = -1; return; }
        int dev = 0, cus = 0;
        if (hipGetDevice(&dev) != hipSuccess || hipDeviceGetAttribute(&cus, hipDeviceAttributeMultiprocessorCount, dev) != hipSuccess) { grid = -1; return; }
        if (hipFuncSetAttribute((const void*)fwd_kernel, hipFuncAttributeMaxDynamicSharedMemorySize, LDS_BYTES) != hipSuccess) { fprintf(stderr, "kernel_launch: hipFuncSetAttribute failed\n"); grid = -1; return; }
        int per_cu = 0;
        if (hipOccupancyMaxActiveBlocksPerMultiprocessor(&per_cu, (const void*)fwd_kernel, 512, LDS_BYTES) != hipSuccess || per_cu < 1) fprintf(stderr, "kernel_launch: occupancy query reports %d\n", per_cu);
        (void)hipGetLastError();
        grid = cus;
#endif
    }
    if (grid < 0) return;
    (void)hipMemsetAsync((char*)d_ws + WS_CTL, 0, CTL_BYTES, stream);
    Args a{};
    for (int i = 0; i < 39; ++i) a.in[i] = (const float*)d_in[i];
    a.out = (float*)d_out; a.ws = (unsigned char*)d_ws;
#ifdef EMU
    for (int p = EMU_PH_LO; p < EMU_PH_HI && p < NPHASES; ++p) { a.lo = p; a.hi = p + 1; emu_launch(fwd_kernel, grid, 512, a); emu_after_phase(p); }
#else
#if ONE_LAUNCH
    a.lo = 0; a.hi = NPHASES;
    hipLaunchKernelGGL(fwd_kernel, dim3(grid), dim3(512), LDS_BYTES, stream, a);
#else
    for (int p = 0; p < NPHASES; ++p) { a.lo = p; a.hi = p + 1; hipLaunchKernelGGL(fwd_kernel, dim3(grid), dim3(512), LDS_BYTES, stream, a); }
#endif
#endif
}
```

```cpp
#ifndef EMU
#include <hip/hip_runtime.h>
#include <cstdio>
#include <cstdint>
#endif

#ifndef REPEAT_MASK
#define REPEAT_MASK 0u
#endif
#ifdef EMU
constexpr int BATCH = EMU_B, SEQ = EMU_S, NHALF = EMU_NHALF;
#else
constexpr int BATCH = 16, SEQ = 2048, NHALF = 2;
#endif
constexpr int D = 1024, DEPTH = 2, CH = 64;
constexpr int T = BATCH * SEQ, TH = T / NHALF, BH = BATCH / NHALF, NCH = SEQ / CH;
constexpr int C_MLA = 0, C_RWKV = 704, C_GDN = 2528, C_SSD = 4584, C_GATE = 6128, IN_COLS = 10224, PW = 6144;
constexpr int FF_D = 2816, FF_E = 3584, NEXP = 8;
constexpr int MOE_ROWS = ((TH * 2 + NEXP * 255) / 256) * 256;
constexpr float EPS = 1e-6f;
static_assert(TH % 256 == 0 && SEQ % 128 == 0 && BATCH % NHALF == 0, "shape");

typedef unsigned short bf16;
typedef float f32x4 __attribute__((ext_vector_type(4)));
typedef float f32x2 __attribute__((ext_vector_type(2)));
typedef short bf16x8 __attribute__((ext_vector_type(8)));
typedef short bf16x4 __attribute__((ext_vector_type(4)));
typedef unsigned u32x4 __attribute__((ext_vector_type(4)));
typedef unsigned u32x2 __attribute__((ext_vector_type(2)));
#ifdef EMU
#define LAS
#define GAS
#define MFMA_F32(a, b, c) emu_mfma_16x16x4f32(a, b, c)
#define MFMA_BF16(a, b, c) emu_mfma_16x16x32bf16(a, b, c)
#define ATOMIC_ADD_U32(p, v) emu_atomic_add_u32(p, v)
#define ATOMIC_ADD_LDS(p, v) emu_atomic_add_u32((unsigned*)(p), v)
#define RFL(x) (x)
#define LDS_WAIT()
#define VM_WAIT()
__device__ __forceinline__ float fast_exp(float x) { return expf(x); }
__device__ __forceinline__ float fast_rcp(float x) { return 1.0f / x; }
__device__ __forceinline__ float fast_rsqrt(float x) { return 1.0f / sqrtf(x); }
#else
#define LAS __attribute__((address_space(3)))
#define GAS __attribute__((address_space(1)))
#define MFMA_F32(a, b, c) __builtin_amdgcn_mfma_f32_16x16x4f32(a, b, c, 0, 0, 0)
#define MFMA_BF16(a, b, c) __builtin_amdgcn_mfma_f32_16x16x32_bf16(a, b, c, 0, 0, 0)
#define ATOMIC_ADD_U32(p, v) __hip_atomic_fetch_add(p, v, __ATOMIC_RELAXED, __HIP_MEMORY_SCOPE_AGENT)
#define ATOMIC_ADD_LDS(p, v) __hip_atomic_fetch_add((LAS unsigned*)(p), v, __ATOMIC_RELAXED, __HIP_MEMORY_SCOPE_WORKGROUP)
#define RFL(x) __builtin_amdgcn_readfirstlane(x)
#define LDS_WAIT() asm volatile("s_waitcnt lgkmcnt(0)" ::: "memory")
#define VM_WAIT() asm volatile("s_waitcnt vmcnt(0)" ::: "memory")
__device__ __forceinline__ float fast_exp(float x) { return __expf(x); }
__device__ __forceinline__ float fast_rcp(float x) { return __builtin_amdgcn_rcpf(x); }
__device__ __forceinline__ float fast_rsqrt(float x) { return __builtin_amdgcn_rsqf(x); }
#endif
__device__ __forceinline__ unsigned f2u(float f) { return __builtin_bit_cast(unsigned, f); }
__device__ __forceinline__ float u2f(unsigned u) { return __builtin_bit_cast(float, u); }
__device__ __forceinline__ unsigned f2bf(float f) { unsigned u = f2u(f); return (u + 0x7fffu + ((u >> 16) & 1u)) >> 16; }
__device__ __forceinline__ float bf2f(unsigned h) { return u2f(h << 16); }
__device__ __forceinline__ unsigned pk2(float lo, float hi) { return f2bf(lo) | (f2bf(hi) << 16); }
__device__ __forceinline__ float sigmoidf_(float x) { return 1.0f / (1.0f + expf(-x)); }
__device__ __forceinline__ float siluf_(float x) { return x / (1.0f + expf(-x)); }
__device__ __forceinline__ float softplusf_(float x) { return x > 20.f ? x : log1pf(expf(x)); }
__device__ __forceinline__ float wave_sum(float v) {
#pragma unroll
    for (int o = 1; o < 64; o <<= 1) v += __shfl_xor(v, o);
    return v;
}
__device__ __forceinline__ float wave_max(float v) {
#pragma unroll
    for (int o = 1; o < 64; o <<= 1) v = fmaxf(v, __shfl_xor(v, o));
    return v;
}
__device__ __forceinline__ f32x4 ld_bf16x4(const bf16* p) { const u32x2 w = *(const u32x2*)p; return (f32x4){bf2f(w.x & 0xffffu), bf2f(w.x >> 16), bf2f(w.y & 0xffffu), bf2f(w.y >> 16)}; }
__device__ __forceinline__ void st_bf16x4(bf16* p, f32x4 v) { u32x2 w; w.x = pk2(v.x, v.y); w.y = pk2(v.z, v.w); *(u32x2*)p = w; }

namespace pg8 {
#define PG8_LAS LAS
typedef unsigned short bf16_t;
constexpr int BM = 256, BK = 64, HALF = 128, HTB = HALF * BK * 2, STAGE_BYTES = 8 * HTB, NXCD = 8, WGM = 8;
__host__ __device__ __forceinline__ int lds_byte(int r, int c) { const int st = (r >> 4) * 2 + (c >> 5), rr = r & 15, cc = c & 31, ob = rr * 64 + cc * 2; return st * 1024 + (ob ^ (((ob >> 9) & 1) << 5)); }
__host__ __device__ __forceinline__ void stage_rc(int b, int& R, int& C) { const int st = b / 1024, sb = b % 1024, swz = sb ^ (((sb >> 9) & 1) << 5); R = (st >> 1) * 16 + swz / 64; C = (st & 1) * 32 + (swz % 64) / 2; }
__host__ __device__ __forceinline__ int perm32(int rho) { const int n = rho >> 4, i = rho & 15; return 8 * (i >> 2) + 4 * n + (i & 3); }
struct Unit { int pm, pn; };
struct Gemm { const bf16_t* A; const bf16_t* Bt; int lda, K; };
struct StaticOrder {
    int nM, nN, nwg, G, c;
    __host__ __device__ void init(int M, int N, int G_, int c_) { nM = M / BM; nN = N / BM; nwg = nM * nN; G = G_; c = c_; }
    __host__ __device__ bool next(int i, Unit& u) const {
        const long L = (long)i * G + c; if (L >= nwg) return false;
        int wgid = (int)L; { const int q = nwg / NXCD, r = nwg % NXCD, xcd = wgid % NXCD, off = wgid / NXCD; wgid = (xcd < r ? xcd * (q + 1) : r * (q + 1) + (xcd - r) * q) + off; }
        const int nig = WGM * nN, gid = wgid / nig, fm = gid * WGM, gsz = (nM - fm) < WGM ? (nM - fm) : WGM;
        u.pm = fm + ((wgid % nig) % gsz); u.pn = (wgid % nig) / gsz; return true;
    }
    __device__ __forceinline__ void a_ready(const Unit&) const {}
    __device__ __forceinline__ void done(const Unit&) const {}
};
#ifndef EMU
template <class Epi, class Sched>
__device__ __forceinline__ void gemm_phase(PG8_LAS unsigned char* lds, const Gemm g, const Sched& S, const Epi& E, const int tid) {
    const int wid = __builtin_amdgcn_readfirstlane(tid >> 6), lane = tid & 63, wr = wid >> 2, wc = wid & 3, fr = lane & 15, fq = lane >> 4;
    int Kq = g.K; asm volatile("" : "+s"(Kq));
    const int K = Kq, nt = K / BK, lda = g.lda;
    unsigned voffA[2], voffB[2];
#pragma unroll
    for (int i = 0; i < 2; ++i) { int R, C; stage_rc(tid * 16 + i * 8192, R, C); const int Rb = Epi::PERM ? ((R & ~31) + perm32(R & 31)) : R;
        voffA[i] = (unsigned)(R * lda + C) * 2u; voffB[i] = (unsigned)(Rb * K + C) * 2u; }
    const size_t kstep = (size_t)(BK * 2);
    const size_t hstep = (size_t)HALF * K * 2, hstepA = (size_t)HALF * lda * 2;
    const size_t tstep = 2 * hstep, tstepA = 2 * hstepA;
    const unsigned ldsw = (unsigned)wid * 1024u;
    const int aoff = lds_byte(wr * 64 + fr, fq * 8), boff = lds_byte(wc * 32 + fr, fq * 8);
#define PG8_SA(b, h) (((b) * 2 + (h)) * HTB)
#define PG8_SB(b, h) ((4 + (b) * 2 + (h)) * HTB)
#define PG8_STAGE(bufoff, gbase, voff) do { _Pragma("unroll") for (int _i = 0; _i < 2; ++_i) \
        __builtin_amdgcn_global_load_lds((const unsigned*)((const char*)(gbase) + (voff)[_i]), (PG8_LAS unsigned*)(lds + (bufoff) + ldsw + _i * 8192), 16, 0, 0); } while (0)
#define PG8_LDA(dst, b, h) do { _Pragma("unroll") for (int m = 0; m < 4; ++m) _Pragma("unroll") for (int k = 0; k < 2; ++k) dst[m][k] = *(const PG8_LAS bf16x8*)(lds + PG8_SA(b, h) + aoff + m * 2048 + k * 1024); } while (0)
#define PG8_LDB(dst, b, h) do { _Pragma("unroll") for (int n = 0; n < 2; ++n) _Pragma("unroll") for (int k = 0; k < 2; ++k) dst[n][k] = *(const PG8_LAS bf16x8*)(lds + PG8_SB(b, h) + boff + n * 2048 + k * 1024); } while (0)
#define PG8_MMA(ai, bj, At, Bt) do { __builtin_amdgcn_s_setprio(1); _Pragma("unroll") for (int m = 0; m < 4; ++m) _Pragma("unroll") for (int n = 0; n < 2; ++n) _Pragma("unroll") for (int k = 0; k < 2; ++k) \
        acc[ai][bj][m][n] = __builtin_amdgcn_mfma_f32_16x16x32_bf16(Bt[n][k], At[m][k], acc[ai][bj][m][n], 0, 0, 0); __builtin_amdgcn_s_setprio(0); } while (0)
#define PG8_WAIT_V(n) asm volatile("s_waitcnt vmcnt(" #n ")" ::: "memory")
#define PG8_WAIT_L(n) asm volatile("s_waitcnt lgkmcnt(" #n ")" ::: "memory")
#define PG8_BAR __builtin_amdgcn_s_barrier()
#define PG8_SCHED __builtin_amdgcn_sched_barrier(0)
    Unit cur, nxt; int ui = 0;
    if (!S.next(0, cur)) return;
    f32x4 acc[2][2][4][2];
#pragma unroll
    for (int a = 0; a < 2; ++a)
#pragma unroll
        for (int b = 0; b < 2; ++b)
#pragma unroll
            for (int m = 0; m < 4; ++m)
#pragma unroll
                for (int n = 0; n < 2; ++n) acc[a][b][m][n] = (f32x4){0.f, 0.f, 0.f, 0.f};
    bf16x8 At[4][2], B0[2][2], B1[2][2];
    const char* cA = (const char*)g.A + (size_t)cur.pm * tstepA; const char* cB = (const char*)g.Bt + (size_t)cur.pn * tstep;
    S.a_ready(cur);
    PG8_STAGE(PG8_SB(0, 0), cB, voffB); PG8_STAGE(PG8_SA(0, 0), cA, voffA); PG8_STAGE(PG8_SB(0, 1), cB + hstep, voffB); PG8_STAGE(PG8_SA(0, 1), cA + hstepA, voffA);
    if (wr == 1) PG8_BAR;
    PG8_WAIT_V(4); PG8_BAR;
    PG8_STAGE(PG8_SB(1, 0), cB + kstep, voffB); PG8_STAGE(PG8_SA(1, 0), cA + kstep, voffA); PG8_STAGE(PG8_SB(1, 1), cB + hstep + kstep, voffB);
    PG8_WAIT_V(6); PG8_BAR;
    for (;;) {
        const bool has_next = S.next(ui + 1, nxt);
        const char* nA = has_next ? (const char*)g.A + (size_t)nxt.pm * tstepA : cA; const char* nB = has_next ? (const char*)g.Bt + (size_t)nxt.pn * tstep : cB;
        for (int t = 0; t < nt; t += 2) {
            const bool last = (t == nt - 2);
            const char* a1 = cA + (size_t)(t + 1) * kstep;
            const char* a2 = last ? nA : cA + (size_t)(t + 2) * kstep; const char* b2 = last ? nB : cB + (size_t)(t + 2) * kstep;
            const char* a3 = a2 + kstep; const char* b3 = b2 + kstep;
            if (last && has_next) S.a_ready(nxt);
            PG8_LDB(B0, 0, 0); PG8_SCHED; PG8_LDA(At, 0, 0); PG8_STAGE(PG8_SA(1, 1), a1 + hstepA, voffA);
            PG8_WAIT_L(8); PG8_BAR; PG8_WAIT_L(0); PG8_MMA(0, 0, At, B0); PG8_BAR; PG8_SCHED;
            PG8_LDB(B1, 0, 1); PG8_STAGE(PG8_SB(0, 0), b2, voffB);
            PG8_BAR; PG8_WAIT_L(0); PG8_MMA(0, 1, At, B1); PG8_BAR;
            PG8_LDA(At, 0, 1); PG8_STAGE(PG8_SA(0, 0), a2, voffA);
            PG8_BAR; PG8_WAIT_L(0); PG8_MMA(1, 0, At, B0); PG8_BAR; PG8_SCHED;
            PG8_STAGE(PG8_SB(0, 1), b2 + hstep, voffB);
            PG8_WAIT_V(6); PG8_BAR; PG8_MMA(1, 1, At, B1); PG8_BAR;
            PG8_LDB(B0, 1, 0); PG8_SCHED; PG8_LDA(At, 1, 0); PG8_STAGE(PG8_SA(0, 1), a2 + hstepA, voffA);
            PG8_WAIT_L(8); PG8_BAR; PG8_WAIT_L(0); PG8_MMA(0, 0, At, B0); PG8_BAR; PG8_SCHED;
            PG8_LDB(B1, 1, 1); PG8_STAGE(PG8_SB(1, 0), b3, voffB);
            PG8_BAR; PG8_WAIT_L(0); PG8_MMA(0, 1, At, B1); PG8_BAR;
            PG8_LDA(At, 1, 1); PG8_STAGE(PG8_SA(1, 0), a3, voffA);
            PG8_BAR; PG8_WAIT_L(0); PG8_MMA(1, 0, At, B0); PG8_BAR; PG8_SCHED;
            PG8_STAGE(PG8_SB(1, 1), b3 + hstep, voffB);
            PG8_WAIT_V(6); PG8_BAR; PG8_MMA(1, 1, At, B1); PG8_BAR;
        }
        if constexpr (!Epi::AFTER_DRAIN) { E(acc, cur, wr, wc, fr, fq); S.done(cur); }
        if (!has_next) break;
#pragma unroll
        for (int a = 0; a < 2; ++a)
#pragma unroll
            for (int b = 0; b < 2; ++b)
#pragma unroll
                for (int m = 0; m < 4; ++m)
#pragma unroll
                    for (int n = 0; n < 2; ++n) acc[a][b][m][n] = (f32x4){0.f, 0.f, 0.f, 0.f};
        cur = nxt; cA = nA; cB = nB; ++ui;
    }
    PG8_WAIT_V(0);
    if (wr == 0) PG8_BAR;
    PG8_BAR;
    if constexpr (Epi::AFTER_DRAIN) { E.fused(acc, cur, wr, wc, fr, fq, lds, wid, lane); S.done(cur); }
#undef PG8_SA
#undef PG8_SB
#undef PG8_STAGE
#undef PG8_LDA
#undef PG8_LDB
#undef PG8_MMA
#undef PG8_WAIT_V
#undef PG8_WAIT_L
#undef PG8_BAR
#undef PG8_SCHED
}
#else
template <class Epi, class Sched>
__device__ __forceinline__ void gemm_phase(PG8_LAS unsigned char* lds, const Gemm g, const Sched& S, const Epi& E, const int tid) {
    const int wid = tid >> 6, lane = tid & 63, wr = wid >> 2, wc = wid & 3, fr = lane & 15, fq = lane >> 4;
    Unit cur;
    for (int ui = 0; S.next(ui, cur); ++ui) {
        f32x4 acc[2][2][4][2];
        for (int ai = 0; ai < 2; ++ai) for (int m = 0; m < 4; ++m) {
            const size_t row = (size_t)cur.pm * 256 + ai * 128 + wr * 64 + m * 16 + fr;
            const bf16_t* ap = g.A + row * g.lda;
            for (int bj = 0; bj < 2; ++bj) for (int n = 0; n < 2; ++n) for (int j = 0; j < 4; ++j) {
                const size_t col = (size_t)cur.pn * 256 + bj * 128 + wc * 32 + (Epi::PERM ? 8 * fq + 4 * n : 16 * n + 4 * fq) + j;
                const bf16_t* bp = g.Bt + col * g.K; float s = 0.f;
                for (int k = 0; k < g.K; ++k) s += bf2f(ap[k]) * bf2f(bp[k]);
                acc[ai][bj][m][n][j] = s; } }
        E(acc, cur, wr, wc, fr, fq);
    }
    __syncthreads();
}
#endif
}

using pg8::Unit;
constexpr int HALFT = 128;
struct EpiF32 {
    static constexpr bool PERM = false, AFTER_DRAIN = false;
    float* C; int ldc;
    __device__ __forceinline__ void operator()(const f32x4 (&acc)[2][2][4][2], const Unit& u, int wr, int wc, int fr, int fq) const {
        const int row0 = u.pm * 256 + wr * 64 + fr, col0 = u.pn * 256 + wc * 32 + 4 * fq;
#pragma unroll
        for (int ai = 0; ai < 2; ++ai)
#pragma unroll
            for (int m = 0; m < 4; ++m) { float* rowp = C + (size_t)(row0 + ai * HALFT + m * 16) * ldc + col0;
#pragma unroll
                for (int bj = 0; bj < 2; ++bj)
#pragma unroll
                    for (int n = 0; n < 2; ++n) *(f32x4*)(rowp + bj * HALFT + n * 16) = acc[ai][bj][m][n]; }
    }
};
struct EpiResidual {
    static constexpr bool PERM = false, AFTER_DRAIN = false;
    const float* res; float* out;
    __device__ __forceinline__ void operator()(const f32x4 (&acc)[2][2][4][2], const Unit& u, int wr, int wc, int fr, int fq) const {
        const int row0 = u.pm * 256 + wr * 64 + fr, col0 = u.pn * 256 + wc * 32 + 4 * fq;
#pragma unroll
        for (int ai = 0; ai < 2; ++ai) {
            f32x4 rv[4][2][2];
#pragma unroll
            for (int m = 0; m < 4; ++m) { const size_t o = (size_t)(row0 + ai * HALFT + m * 16) * D + col0;
#pragma unroll
                for (int bj = 0; bj < 2; ++bj)
#pragma unroll
                    for (int n = 0; n < 2; ++n) rv[m][bj][n] = *(const GAS f32x4*)(res + o + bj * HALFT + n * 16); }
#pragma unroll
            for (int m = 0; m < 4; ++m) { const size_t o = (size_t)(row0 + ai * HALFT + m * 16) * D + col0;
#pragma unroll
                for (int bj = 0; bj < 2; ++bj)
#pragma unroll
                    for (int n = 0; n < 2; ++n) *(GAS f32x4*)(out + o + bj * HALFT + n * 16) = rv[m][bj][n] + acc[ai][bj][m][n]; }
        }
    }
};
struct EpiBf16 {
    static constexpr bool PERM = true, AFTER_DRAIN = false;
    bf16* O; int ldc; const float* rowscale; int rs_stride;
    __device__ __forceinline__ void operator()(const f32x4 (&acc)[2][2][4][2], const Unit& u, int wr, int wc, int fr, int fq) const {
        const int row0 = u.pm * 256 + wr * 64 + fr, col0 = u.pn * 256 + wc * 32 + 8 * fq;
#pragma unroll
        for (int ai = 0; ai < 2; ++ai)
#pragma unroll
            for (int m = 0; m < 4; ++m) { const int row = row0 + ai * HALFT + m * 16; bf16* rowp = O + (size_t)row * ldc + col0;
                const float sc = rowscale ? rowscale[(size_t)row * rs_stride] : 1.0f;
#pragma unroll
                for (int bj = 0; bj < 2; ++bj) { const f32x4 v0 = acc[ai][bj][m][0] * sc, v1 = acc[ai][bj][m][1] * sc;
                    u32x4 w; w.x = pk2(v0[0], v0[1]); w.y = pk2(v0[2], v0[3]); w.z = pk2(v1[0], v1[1]); w.w = pk2(v1[2], v1[3]);
                    *(u32x4*)(rowp + bj * HALFT) = w; } }
    }
};
struct EpiSwiGLU {
    static constexpr bool PERM = true, AFTER_DRAIN = false;
    bf16* O; int ldc; int ntile;
    __device__ __forceinline__ void operator()(const f32x4 (&acc)[2][2][4][2], const Unit& u, int wr, int wc, int fr, int fq) const {
        const int row0 = u.pm * 256 + wr * 64 + fr, col0 = (u.pn % ntile) * 128 + wc * 32 + 8 * fq;
#pragma unroll
        for (int ai = 0; ai < 2; ++ai)
#pragma unroll
            for (int m = 0; m < 4; ++m) { bf16* rowp = O + (size_t)(row0 + ai * HALFT + m * 16) * ldc + col0;
                float a[8];
#pragma unroll
                for (int n = 0; n < 2; ++n)
#pragma unroll
                    for (int j = 0; j < 4; ++j) { const float g = acc[ai][0][m][n][j], up = acc[ai][1][m][n][j]; a[4 * n + j] = g * fast_rcp(1.0f + fast_exp(-g)) * up; }
                u32x4 w; w.x = pk2(a[0], a[1]); w.y = pk2(a[2], a[3]); w.z = pk2(a[4], a[5]); w.w = pk2(a[6], a[7]);
                *(u32x4*)rowp = w; }
    }
};
struct EpiZ {
    static constexpr bool PERM = true, AFTER_DRAIN = false;
    bf16* Z;
    __device__ __forceinline__ void operator()(const f32x4 (&acc)[2][2][4][2], const Unit& u, int wr, int wc, int fr, int fq) const {
        const int i = u.pn >> 2, pnl = u.pn & 3, pml = u.pm - i * (TH / 256);
        const int row0 = pml * 256 + wr * 64 + fr, col0 = i * D + pnl * 256 + wc * 32 + 8 * fq;
#pragma unroll
        for (int ai = 0; ai < 2; ++ai)
#pragma unroll
            for (int m = 0; m < 4; ++m) { bf16* rowp = Z + (size_t)(row0 + ai * HALFT + m * 16) * 4096 + col0;
#pragma unroll
                for (int bj = 0; bj < 2; ++bj) { const f32x4 v0 = acc[ai][bj][m][0], v1 = acc[ai][bj][m][1];
                    u32x4 w; w.x = pk2(v0[0], v0[1]); w.y = pk2(v0[2], v0[3]); w.z = pk2(v1[0], v1[1]); w.w = pk2(v1[2], v1[3]);
                    *(GAS u32x4*)(rowp + bj * HALFT) = w; } }
    }
};
struct BranchOrder {
    int nP, G, c;
    __device__ bool next(int i, Unit& u) const {
        const long L = (long)i * G + c; if (L >= (long)16 * nP) return false;
        const int br = (int)(L / (4 * nP)), r = (int)(L % (4 * nP)); u.pm = br * nP + (r >> 2); u.pn = br * 4 + (r & 3); return true;
    }
    __device__ __forceinline__ void a_ready(const Unit&) const {}
    __device__ __forceinline__ void done(const Unit&) const {}
};
struct EpiMerge {
    static constexpr bool PERM = false, AFTER_DRAIN = false;
    const bf16* Z; const float* gate_b; bf16* MG;
    __device__ __forceinline__ void operator()(const f32x4 (&acc)[2][2][4][2], const Unit& u, int wr, int wc, int fr, int fq) const {
        const int row0 = u.pm * 256 + wr * 64 + fr, col = u.pn * 64 + wc * 16 + 4 * fq;
        f32x4 gb[4];
#pragma unroll
        for (int i = 0; i < 4; ++i) gb[i] = *(const GAS f32x4*)(gate_b + i * D + col);
#pragma unroll
        for (int ai = 0; ai < 2; ++ai) {
            u32x2 zv[4][4];
#pragma unroll
            for (int m = 0; m < 4; ++m)
#pragma unroll
                for (int i = 0; i < 4; ++i) zv[m][i] = *(const GAS u32x2*)(Z + (size_t)(row0 + ai * HALFT + m * 16) * 4096 + i * D + col);
#pragma unroll
            for (int m = 0; m < 4; ++m) { const size_t row = (size_t)(row0 + ai * HALFT + m * 16);
                f32x4 s = (f32x4){0.f, 0.f, 0.f, 0.f};
#pragma unroll
                for (int bj = 0; bj < 2; ++bj)
#pragma unroll
                    for (int n = 0; n < 2; ++n) { const int i = 2 * bj + n; const unsigned z01 = zv[m][i].x, z23 = zv[m][i].y;
                        const f32x4 z = (f32x4){bf2f(z01 & 0xffffu), bf2f(z01 >> 16), bf2f(z23 & 0xffffu), bf2f(z23 >> 16)}; const f32x4 a = acc[ai][bj][m][n] + gb[i];
#pragma unroll
                        for (int j = 0; j < 4; ++j) s[j] += z[j] * fast_rcp(1.0f + fast_exp(-a[j])); }
                u32x2 w; w.x = pk2(s.x, s.y); w.y = pk2(s.z, s.w); *(GAS u32x2*)(MG + row * D + col) = w; }
        }
    }
};

constexpr size_t MiB = 1u << 20;
constexpr size_t al(size_t x) { return (x + 255) & ~(size_t)255; }
constexpr size_t WS_CTL = 0, CTL_BYTES = 1 * MiB;
constexpr size_t W_IN = 1 * MiB;
constexpr size_t W_GATE = W_IN + (size_t)PW * D * 2;
constexpr size_t W_UQ = W_GATE + (size_t)4096 * D * 2;
constexpr size_t W_UKV = W_UQ + (size_t)768 * 384 * 2;
constexpr size_t W_LORA = W_UKV + (size_t)1024 * 256 * 2;
constexpr size_t W_BR = W_LORA + (size_t)1536 * 384 * 2;
constexpr size_t W_OUT = W_BR + (size_t)4 * 1024 * 512 * 2;
constexpr size_t W_FGU = W_OUT + (size_t)D * D * 2;
constexpr size_t W_FDN = W_FGU + (size_t)NEXP * 2 * FF_E * D * 2;
constexpr size_t W_END = W_FDN + (size_t)NEXP * D * FF_E * 2;
constexpr size_t A_H = al(W_END);
constexpr size_t A_ROPE = A_H + (size_t)TH * D * 2;
constexpr size_t A_Y = A_ROPE + (size_t)TH * 64 * 4;
constexpr size_t A_P = A_Y + (size_t)4 * TH * 512 * 2;
constexpr size_t A_MIX = A_P + (size_t)TH * PW * 2;
constexpr size_t M_STAT = A_MIX;
constexpr size_t M_KR = M_STAT + (size_t)TH * 2 * 4;
constexpr size_t M_Q = M_KR + (size_t)TH * 64 * 2;
constexpr size_t M_KV = M_Q + (size_t)TH * 768 * 2;
constexpr size_t M_VT = M_KV + (size_t)TH * 1024 * 2;
constexpr size_t M_END = M_VT + (size_t)TH * 512 * 2;
constexpr size_t R_RKV = A_MIX;
constexpr size_t R_LIN = R_RKV + (size_t)TH * 1536 * 2;
constexpr size_t R_LOUT = R_LIN + (size_t)TH * 384 * 2;
constexpr size_t R_REC = R_LOUT + (size_t)TH * 1536 * 4;
constexpr size_t R_O = R_REC + (size_t)BH * 8 * NCH * 92416;
constexpr size_t R_END = R_O + (size_t)TH * 512 * 4;
constexpr size_t G_CH = A_MIX;
constexpr size_t G_O = G_CH + al((size_t)BH * 4 * NCH * 103440);
constexpr size_t G_END = G_O + (size_t)TH * 512 * 4;
constexpr size_t S_ST = A_MIX;
constexpr size_t S_YD = S_ST + (size_t)BH * NCH * 8 * 64 * 128 * 4;
constexpr size_t S_C = S_YD + (size_t)TH * 512 * 4;
constexpr size_t S_AC = S_C + (size_t)TH * 256 * 4;
constexpr size_t S_YO = S_AC + (size_t)TH * 8 * 4;
constexpr size_t S_END = S_YO + (size_t)TH * 512 * 4;
constexpr size_t A_Z = A_P;
constexpr size_t A_MG = A_MIX;
constexpr size_t F_ACT = A_P;
constexpr size_t F_GA = F_ACT + (size_t)MOE_ROWS * FF_E * 2;
constexpr size_t F_YE = F_GA + (size_t)MOE_ROWS * D * 2;
constexpr size_t F_TOPE = F_YE + (size_t)MOE_ROWS * D * 4;
constexpr size_t F_TOPW = F_TOPE + (size_t)TH * 2 * 4;
constexpr size_t F_SLOT = F_TOPW + (size_t)TH * 2 * 4;
constexpr size_t F_END = F_SLOT + (size_t)TH * 2 * 4;
constexpr size_t cmax(size_t a, size_t b) { return a > b ? a : b; }
constexpr size_t WS_NEED = cmax(cmax(cmax(M_END, R_END), cmax(G_END, S_END)), F_END);
#ifndef EMU
static_assert(WS_NEED <= (size_t)896 * MiB, "workspace");
#endif
constexpr int CW_BAR = 4096;
constexpr int CW_CNT = 16384;
constexpr int CW_WGC = 32768;

#ifdef EMU
#define WAVE_SYNC() emu_wave_sync()
#else
#define WAVE_SYNC() do { asm volatile("s_waitcnt lgkmcnt(0)" ::: "memory"); } while (0)
#endif
struct Frame {
    LAS unsigned char* lds; int tid, lane, wave, G, gw, NGW, bid;
    float* out; unsigned char* ws; unsigned* ctl;
};
struct Args { const float* in[39]; float* out; unsigned char* ws; int lo, hi; };
#define WSP(type, off) ((type*)(F.ws + (off)))

template <class FN>
__device__ __forceinline__ void cvt_matrix(const Frame& F, const float* W, int ldw, int K, bf16* WT, int Ndst, const float* kscale, FN srccol) {
    LAS float* scr = (LAS float*)(F.lds + F.wave * 16384);
    const int nblk = Ndst / 32, nitems = (K / 64) * nblk, lane = F.lane;
    for (int item = F.gw; item < nitems; item += F.NGW) {
        const int kb = item / nblk, nb = item % nblk, k0 = 64 * kb, n0 = 32 * nb;
        const int sc = srccol(n0 + (lane & 31));
        float wv[32];
#pragma unroll
        for (int i = 0; i < 32; ++i) { const int kk = 2 * i + (lane >> 5); wv[i] = sc >= 0 ? W[(size_t)(k0 + kk) * ldw + sc] : 0.f; }
#pragma unroll
        for (int i = 0; i < 32; ++i) { const int kk = 2 * i + (lane >> 5); float v = wv[i]; if (kscale) v *= kscale[k0 + kk]; scr[kk * 33 + (lane & 31)] = v; }
        WAVE_SYNC();
        const int c = lane & 7;
#pragma unroll
        for (int j = 0; j < 4; ++j) { const int n = (lane >> 3) + 8 * j; const LAS float* s = scr + (8 * c) * 33 + n;
            u32x4 o; o.x = pk2(s[0 * 33], s[1 * 33]); o.y = pk2(s[2 * 33], s[3 * 33]); o.z = pk2(s[4 * 33], s[5 * 33]); o.w = pk2(s[6 * 33], s[7 * 33]);
            *(u32x4*)(WT + (size_t)(n0 + n) * K + k0 + 8 * c) = o; }
        WAVE_SYNC();
    }
}
__device__ __forceinline__ void phase_convert(const Frame& F, const Args& A, int layer) {
    const float* w_in = A.in[3] + (size_t)layer * D * IN_COLS;
    cvt_matrix(F, w_in, IN_COLS, D, WSP(bf16, W_IN), PW, nullptr, [](int n) { return n < C_GATE ? n : -1; });
    cvt_matrix(F, w_in, IN_COLS, D, WSP(bf16, W_GATE), 4096, nullptr, [](int n) {
        const int pn = n >> 8, c = n & 255, bj = c >> 7, wc = (c >> 5) & 3, nn = (c >> 4) & 1, r = c & 15; return C_GATE + (2 * bj + nn) * D + 64 * pn + 16 * wc + r; });
    cvt_matrix(F, A.in[6] + (size_t)layer * 384 * 768, 768, 384, WSP(bf16, W_UQ), 768, A.in[4] + layer * 384, [](int n) { return n; });
    cvt_matrix(F, A.in[7] + (size_t)layer * 256 * 1024, 1024, 256, WSP(bf16, W_UKV), 1024, A.in[5] + layer * 256, [](int n) { return n; });
    for (int i = 0; i < 4; ++i) cvt_matrix(F, A.in[30] + ((size_t)layer * 4 + i) * 512 * D, D, 512, WSP(bf16, W_BR) + (size_t)i * D * 512, D, nullptr, [](int n) { return n; });
    cvt_matrix(F, A.in[31] + (size_t)layer * D * D, D, D, WSP(bf16, W_OUT), D, nullptr, [](int n) { return n; });
    if (layer == 0) {
        cvt_matrix(F, A.in[33], 2 * FF_D, D, WSP(bf16, W_FGU), 2 * FF_D, nullptr, [](int n) { const int pn = n >> 8, c = n & 255; return c < 128 ? 128 * pn + c : FF_D + 128 * pn + (c - 128); });
        cvt_matrix(F, A.in[34], D, FF_D, WSP(bf16, W_FDN), D, nullptr, [](int n) { return n; });
    } else {
        for (int e = 0; e < NEXP; ++e) {
            cvt_matrix(F, A.in[36] + (size_t)e * D * 2 * FF_E, 2 * FF_E, D, WSP(bf16, W_FGU) + (size_t)e * 2 * FF_E * D, 2 * FF_E, nullptr, [](int n) { const int pn = n >> 8, c = n & 255; return c < 128 ? 128 * pn + c : FF_E + 128 * pn + (c - 128); });
            cvt_matrix(F, A.in[37] + (size_t)e * FF_E * D, D, FF_E, WSP(bf16, W_FDN) + (size_t)e * D * FF_E, D, nullptr, [](int n) { return n; });
        }
    }
    { const float* w2 = A.in[10] + (size_t)layer * 64 * 512; const float* a2 = A.in[12] + (size_t)layer * 64 * 512; const float* g2 = A.in[13] + (size_t)layer * 160 * 512;
      bf16* L = WSP(bf16, W_LORA);
      for (int idx = F.bid * 512 + F.tid; idx < 1536 * 384; idx += F.G * 512) { const int n = idx / 384, k = idx % 384; float v = 0.f;
          if (n < 512) { if (k < 64) v = w2[k * 512 + n]; } else if (n < 1024) { if (k >= 64 && k < 128) v = a2[(k - 64) * 512 + (n - 512)]; } else { if (k >= 128 && k < 288) v = g2[(k - 128) * 512 + (n - 1024)]; }
          L[idx] = (bf16)f2bf(v); } }
}

template <bool ROUTER>
__device__ __forceinline__ void phase_norm(const Frame& F, const Args& A, const float* xin, const float* gain, bf16* H, const float* router, int* tope, float* topw, unsigned* cnt) {
    const int lane = F.lane;
    LAS unsigned* lcnt = (LAS unsigned*)F.lds;
    if (ROUTER) { __syncthreads(); if (F.tid < 8) lcnt[F.tid] = 0u; __syncthreads(); }
    f32x4 gv[4];
#pragma unroll
    for (int j = 0; j < 4; ++j) gv[j] = *(const f32x4*)(gain + 4 * lane + 256 * j);
    for (int m = F.gw; m < TH; m += F.NGW) {
        const float* xr = xin + (size_t)m * D; f32x4 v[4]; float ss = 0.f;
#pragma unroll
        for (int j = 0; j < 4; ++j) { v[j] = *(const f32x4*)(xr + 4 * lane + 256 * j); ss += (v[j].x * v[j].x + v[j].y * v[j].y) + (v[j].z * v[j].z + v[j].w * v[j].w); }
        const float rstd = 1.0f / sqrtf(wave_sum(ss) * (1.0f / D) + EPS);
#pragma unroll
        for (int j = 0; j < 4; ++j) { v[j] = v[j] * rstd * gv[j]; st_bf16x4(H + (size_t)m * D + 4 * lane + 256 * j, v[j]); }
        if (ROUTER) {
            float lg[8];
#pragma unroll
            for (int e = 0; e < 8; ++e) lg[e] = 0.f;
#pragma unroll
            for (int j = 0; j < 4; ++j)
#pragma unroll
                for (int q = 0; q < 4; ++q) { const float* rp = router + (size_t)(4 * lane + 256 * j + q) * 8; const f32x4 r0 = *(const f32x4*)rp, r1 = *(const f32x4*)(rp + 4); const float hv = v[j][q];
                    lg[0] += hv * r0.x; lg[1] += hv * r0.y; lg[2] += hv * r0.z; lg[3] += hv * r0.w; lg[4] += hv * r1.x; lg[5] += hv * r1.y; lg[6] += hv * r1.z; lg[7] += hv * r1.w; }
#pragma unroll
            for (int e = 0; e < 8; ++e) lg[e] = wave_sum(lg[e]);
            if (lane == 0) {
                int e1 = 0; float l1 = lg[0];
#pragma unroll
                for (int e = 1; e < 8; ++e) if (lg[e] > l1) { l1 = lg[e]; e1 = e; }
                int e2 = -1; float l2 = -3.0e38f;
#pragma unroll
                for (int e = 0; e < 8; ++e) if (e != e1 && lg[e] > l2) { l2 = lg[e]; e2 = e; }
                const float w1 = 1.0f / (1.0f + expf(l2 - l1));
                tope[2 * m] = e1; tope[2 * m + 1] = e2; topw[2 * m] = w1; topw[2 * m + 1] = 1.0f - w1;
                ATOMIC_ADD_LDS(lcnt + e1, 1u); ATOMIC_ADD_LDS(lcnt + e2, 1u);
            }
        }
    }
    if (ROUTER) { __syncthreads(); if (F.tid < 8) cnt[F.bid * 8 + F.tid] = lcnt[F.tid]; __syncthreads(); }
}
__device__ __forceinline__ void phase_rope_table(const Frame& F, const Args& A, const int* pos, float* rope) {
    for (int idx = F.bid * 512 + F.tid; idx < TH * 32; idx += F.G * 512) { const int t = idx >> 5, i = idx & 31;
        const float inv = powf(10000.0f, -(float)i / 32.0f);
        const float ang = (float)pos[t] * inv; float sn, cs; sincosf(ang, &sn, &cs);
        rope[(size_t)t * 64 + i] = cs; rope[(size_t)t * 64 + 32 + i] = sn; }
}
__device__ __forceinline__ void phase_final_norm(const Frame& F, const Args& A, float* x, const float* gain) {
    const int lane = F.lane;
    for (int m = F.gw; m < T; m += F.NGW) {
        float* xr = x + (size_t)m * D; f32x4 v[4]; float ss = 0.f;
#pragma unroll
        for (int j = 0; j < 4; ++j) { v[j] = *(const f32x4*)(xr + 4 * lane + 256 * j); ss += (v[j].x * v[j].x + v[j].y * v[j].y) + (v[j].z * v[j].z + v[j].w * v[j].w); }
        const float rstd = 1.0f / sqrtf(wave_sum(ss) * (1.0f / D) + EPS);
#pragma unroll
        for (int j = 0; j < 4; ++j) *(f32x4*)(xr + 4 * lane + 256 * j) = v[j] * rstd * *(const f32x4*)(gain + 4 * lane + 256 * j);
    }
}

__device__ __forceinline__ void phase_mla_prep(const Frame& F, const Args& A) {
    bf16* P = WSP(bf16, A_P); bf16* kr = WSP(bf16, M_KR); const float* rope = WSP(float, A_ROPE);
    const int lane = F.lane;
    for (int m = F.gw; m < TH; m += F.NGW) {
        bf16* pr = P + (size_t)m * PW; float sq = 0.f, skv = 0.f; f32x4 v[3];
#pragma unroll
        for (int j = 0; j < 3; ++j) { const int c = 4 * lane + 256 * j; v[j] = ld_bf16x4(pr + c); const float s = (v[j].x * v[j].x + v[j].y * v[j].y) + (v[j].z * v[j].z + v[j].w * v[j].w);
            if (c < 384) sq += s; else if (c < 640) skv += s; }
        sq = wave_sum(sq); skv = wave_sum(skv);
        const float rq = 1.0f / sqrtf(sq * (1.0f / 384.0f) + EPS), rkv = 1.0f / sqrtf(skv * (1.0f / 256.0f) + EPS);
#pragma unroll
        for (int j = 0; j < 3; ++j) { const int c = 4 * lane + 256 * j; if (c < 640) st_bf16x4(pr + c, v[j] * (c < 384 ? rq : rkv)); }
        if (lane < 32) { const float x1 = bf2f(pr[640 + lane]), x2 = bf2f(pr[672 + lane]), c = rope[(size_t)m * 64 + lane], s = rope[(size_t)m * 64 + 32 + lane];
            kr[(size_t)m * 64 + lane] = (bf16)f2bf(x1 * c - x2 * s); kr[(size_t)m * 64 + 32 + lane] = (bf16)f2bf(x2 * c + x1 * s); }
    }
}
__device__ __forceinline__ void phase_mla_q(const Frame& F, const Args& A) {
    pg8::Gemm g{WSP(bf16, A_P) + 0, WSP(bf16, W_UQ), PW, 384}; pg8::StaticOrder S; S.init(TH, 768, F.G, F.bid);
    EpiBf16 E{WSP(bf16, M_Q), 768, nullptr, 0}; pg8::gemm_phase(F.lds, g, S, E, F.tid);
}
struct EpiKV {
    static constexpr bool PERM = true, AFTER_DRAIN = false;
    bf16* KV; bf16* VT;
    __device__ __forceinline__ void operator()(const f32x4 (&acc)[2][2][4][2], const Unit& u, int wr, int wc, int fr, int fq) const {
        const int row0 = u.pm * 256 + wr * 64 + fr, col0 = wc * 32 + 8 * fq;
#pragma unroll
        for (int ai = 0; ai < 2; ++ai)
#pragma unroll
            for (int m = 0; m < 4; ++m) { const int row = row0 + ai * HALFT + m * 16;
                { const f32x4 v0 = acc[ai][0][m][0], v1 = acc[ai][0][m][1]; u32x4 w; w.x = pk2(v0[0], v0[1]); w.y = pk2(v0[2], v0[3]); w.z = pk2(v1[0], v1[1]); w.w = pk2(v1[2], v1[3]);
                  *(u32x4*)(KV + (size_t)row * 1024 + u.pn * 256 + col0) = w; }
                const int b = row / SEQ, t = row % SEQ; bf16* vt = VT + ((size_t)(b * 4 + u.pn) * 128 + col0) * SEQ + t;
#pragma unroll
                for (int n = 0; n < 2; ++n)
#pragma unroll
                    for (int j = 0; j < 4; ++j) vt[(size_t)(4 * n + j) * SEQ] = (bf16)f2bf(acc[ai][1][m][n][j]); }
    }
};
__device__ __forceinline__ void phase_mla_kv(const Frame& F, const Args& A) {
    pg8::Gemm g{WSP(bf16, A_P) + 384, WSP(bf16, W_UKV), PW, 256}; pg8::StaticOrder S; S.init(TH, 1024, F.G, F.bid);
    EpiKV E{WSP(bf16, M_KV), WSP(bf16, M_VT)}; pg8::gemm_phase(F.lds, g, S, E, F.tid);
}
constexpr int AT_KS = 200, AT_VS = 72;
constexpr int AT_KBYTES = 64 * AT_KS * 2, AT_VBYTES = 128 * AT_VS * 2;
__device__ __forceinline__ void phase_attention(const Frame& F, const Args& A) {
    const bf16* Q = WSP(bf16, M_Q); const bf16* KV = WSP(bf16, M_KV); const bf16* KR = WSP(bf16, M_KR); const bf16* VTg = WSP(bf16, M_VT); const float* rope = WSP(float, A_ROPE); bf16* Y = WSP(bf16, A_Y);
    const int lane = F.lane, w = F.wave, l15 = lane & 15, q4 = lane >> 4, tid = F.tid, grp = w >> 2, wq = w & 3;
    const int NQB = SEQ / 128, nunits = BH * 4 * NQB;
    const float sc2 = 0.07216878364870322f * 1.4426950408889634f;
    for (int unit = F.bid; unit < nunits; unit += F.G) {
        const int qb = NQB - 1 - (unit / (BH * 4)), bh = unit % (BH * 4), h = bh & 3, b = bh >> 2;
        const size_t t0 = (size_t)b * SEQ;
        bf16x8 qf[2][6];
#pragma unroll
        for (int f = 0; f < 2; ++f) { const size_t tq = t0 + qb * 128 + wq * 32 + 16 * f + l15;
#pragma unroll
            for (int ks = 0; ks < 6; ++ks) qf[f][ks] = *(const bf16x8*)(Q + tq * 768 + h * 192 + 32 * ks + 8 * q4);
            const bf16x8 a = qf[f][4], c2 = qf[f][5];
#pragma unroll
            for (int j = 0; j < 8; ++j) { const float x1 = bf2f((unsigned short)a[j]), x2 = bf2f((unsigned short)c2[j]), c = rope[tq * 64 + 8 * q4 + j], sn = rope[tq * 64 + 32 + 8 * q4 + j];
                qf[f][4][j] = (short)f2bf(x1 * c - x2 * sn); qf[f][5][j] = (short)f2bf(x2 * c + x1 * sn); } }
        f32x4 o[2][8];
#pragma unroll
        for (int f = 0; f < 2; ++f)
#pragma unroll
            for (int mb = 0; mb < 8; ++mb) o[f][mb] = (f32x4){0.f, 0.f, 0.f, 0.f};
        float mrow[2] = {-3.0e38f, -3.0e38f}, lrow[2] = {0.f, 0.f};
        const int qchunk = 2 * qb + (wq >> 1), ntile = 2 * qb + 2;
        u32x4 pk_[3], pv_[2];
        const int skey = tid >> 3, c8 = tid & 7;
        const int okv = skey * 1024 + 8 * c8, okr = skey * 64 + 8 * c8, ovt = skey * SEQ + 8 * c8;
        const bf16* kvb = KV + t0 * 1024 + h * 256; const bf16* krb = KR + t0 * 64; const bf16* vtb = VTg + (size_t)(b * 4 + h) * 128 * SEQ;
#define AT_LOAD(kt) do { const bf16* kv_ = kvb + (size_t)(kt) * 65536; const bf16* kr_ = krb + (size_t)(kt) * 4096; const bf16* vt_ = vtb + (size_t)(kt) * 64; \
            pk_[0] = *(const u32x4*)(kv_ + okv); pk_[1] = *(const u32x4*)(kv_ + okv + 64); pk_[2] = *(const u32x4*)(kr_ + okr); \
            pv_[0] = *(const u32x4*)(vt_ + ovt); pv_[1] = *(const u32x4*)(vt_ + ovt + 64 * SEQ); } while (0)
#define AT_STORE(bufi) do { LAS bf16* Ks_ = (LAS bf16*)(F.lds + (bufi) * (AT_KBYTES + AT_VBYTES)); LAS bf16* Vt_ = (LAS bf16*)((LAS unsigned char*)Ks_ + AT_KBYTES); \
            *(LAS u32x4*)(Ks_ + skey * AT_KS + 8 * c8) = pk_[0]; *(LAS u32x4*)(Ks_ + skey * AT_KS + 8 * c8 + 64) = pk_[1]; *(LAS u32x4*)(Ks_ + skey * AT_KS + 8 * c8 + 128) = pk_[2]; \
            *(LAS u32x4*)(Vt_ + skey * AT_VS + 8 * c8) = pv_[0]; *(LAS u32x4*)(Vt_ + (skey + 64) * AT_VS + 8 * c8) = pv_[1]; } while (0)
        __syncthreads();
        AT_LOAD(0); AT_STORE(0);
        __syncthreads();
        for (int kt = 0; kt < ntile; ++kt) {
            if (kt + 1 < ntile) AT_LOAD(kt + 1);
            if (kt <= qchunk) {
                const LAS bf16* Ks = (const LAS bf16*)(F.lds + (kt & 1) * (AT_KBYTES + AT_VBYTES)); const LAS bf16* Vt = (const LAS bf16*)((const LAS unsigned char*)Ks + AT_KBYTES);
                f32x4 st[2][2];
#pragma unroll
                for (int kb = 0; kb < 2; ++kb) { st[0][kb] = (f32x4){0.f, 0.f, 0.f, 0.f}; st[1][kb] = (f32x4){0.f, 0.f, 0.f, 0.f};
#pragma unroll
                    for (int ks = 0; ks < 6; ++ks) { const bf16x8 kf = *(const LAS bf16x8*)(Ks + (32 * grp + 16 * kb + l15) * AT_KS + 32 * ks + 8 * q4);
                        st[0][kb] = MFMA_BF16(kf, qf[0][ks], st[0][kb]); st[1][kb] = MFMA_BF16(kf, qf[1][ks], st[1][kb]); } }
                bf16x8 pb[2];
#pragma unroll
                for (int f = 0; f < 2; ++f) {
                    float mx = -3.0e38f;
#pragma unroll
                    for (int kb = 0; kb < 2; ++kb) { st[f][kb] = st[f][kb] * sc2; mx = fmaxf(mx, fmaxf(fmaxf(st[f][kb].x, st[f][kb].y), fmaxf(st[f][kb].z, st[f][kb].w))); }
                    mx = fmaxf(mx, __shfl_xor(mx, 16)); mx = fmaxf(mx, __shfl_xor(mx, 32));
                    const float mnew = fmaxf(mrow[f], mx), alpha = exp2f(mrow[f] - mnew); mrow[f] = mnew;
                    float ps = 0.f;
#pragma unroll
                    for (int kb = 0; kb < 2; ++kb)
#pragma unroll
                        for (int r = 0; r < 4; ++r) { const float p = exp2f(st[f][kb][r] - mnew); ps += p; pb[f][4 * kb + r] = (short)f2bf(p); }
                    lrow[f] = lrow[f] * alpha + ps;
#pragma unroll
                    for (int mb = 0; mb < 8; ++mb) o[f][mb] = o[f][mb] * alpha;
                }
#pragma unroll
                for (int mb = 0; mb < 8; ++mb) { const LAS bf16* vp = Vt + (16 * mb + l15) * AT_VS + 32 * grp + 4 * q4;
                    const bf16x4 v0 = *(const LAS bf16x4*)vp, v1 = *(const LAS bf16x4*)(vp + 16);
                    bf16x8 vf; vf[0] = v0[0]; vf[1] = v0[1]; vf[2] = v0[2]; vf[3] = v0[3]; vf[4] = v1[0]; vf[5] = v1[1]; vf[6] = v1[2]; vf[7] = v1[3];
                    o[0][mb] = MFMA_BF16(vf, pb[0], o[0][mb]); o[1][mb] = MFMA_BF16(vf, pb[1], o[1][mb]); }
            }
            if (kt + 1 < ntile) AT_STORE((kt + 1) & 1);
            __syncthreads();
        }
#undef AT_LOAD
#undef AT_STORE
#pragma unroll
        for (int f = 0; f < 2; ++f) { lrow[f] += __shfl_xor(lrow[f], 16); lrow[f] += __shfl_xor(lrow[f], 32); }
        LAS float* xo = (LAS float*)F.lds + (size_t)wq * (2 * 8 * 4 * 64 + 4 * 64);
        if (grp == 1) {
#pragma unroll
            for (int f = 0; f < 2; ++f) {
#pragma unroll
                for (int mb = 0; mb < 8; ++mb)
#pragma unroll
                    for (int r = 0; r < 4; ++r) xo[((f * 8 + mb) * 4 + r) * 64 + lane] = o[f][mb][r];
                xo[2 * 8 * 4 * 64 + f * 64 + lane] = mrow[f]; xo[2 * 8 * 4 * 64 + 128 + f * 64 + lane] = lrow[f]; } }
        __syncthreads();
        if (grp == 0) {
#pragma unroll
            for (int f = 0; f < 2; ++f) { const float m1 = xo[2 * 8 * 4 * 64 + f * 64 + lane], l1 = xo[2 * 8 * 4 * 64 + 128 + f * 64 + lane];
                const float m = fmaxf(mrow[f], m1), a0 = exp2f(mrow[f] - m), a1 = exp2f(m1 - m), inv = 1.0f / (lrow[f] * a0 + l1 * a1);
                const size_t tq = t0 + qb * 128 + wq * 32 + 16 * f + l15;
#pragma unroll
                for (int mb = 0; mb < 8; ++mb) { f32x4 v;
#pragma unroll
                    for (int r = 0; r < 4; ++r) v[r] = (o[f][mb][r] * a0 + xo[((f * 8 + mb) * 4 + r) * 64 + lane] * a1) * inv;
                    st_bf16x4(Y + tq * 512 + h * 128 + 16 * mb + 4 * q4, v); } } }
    }
    __syncthreads();
}

__device__ __forceinline__ f32x4 tile_bf(const LAS bf16* a, int lda, const LAS bf16* bt, int ldb, int K, f32x4 acc, int l15, int q4) {
    const LAS bf16* ap = a + l15 * lda + 8 * q4; const LAS bf16* bp = bt + l15 * ldb + 8 * q4;
#pragma unroll 4
    for (int ks = 0; ks < K / 32; ++ks) acc = MFMA_BF16(*(const LAS bf16x8*)(ap + 32 * ks), *(const LAS bf16x8*)(bp + 32 * ks), acc);
    return acc;
}
__device__ __forceinline__ f32x4 tile_mm(const LAS float* a, int lda, int ska, const LAS float* b, int ldb, int scb, int K, f32x4 acc, int l15, int q4);

__device__ __forceinline__ void phase_rwkv_prep(const Frame& F, const Args& A, int layer) {
    const bf16* P = WSP(bf16, A_P); bf16* RKV = WSP(bf16, R_RKV); bf16* LIN = WSP(bf16, R_LIN); const float* mu = A.in[8] + (size_t)layer * 1824;
    const int lane = F.lane;
    for (int m = F.gw; m < TH; m += F.NGW) {
        const bool first = (m % SEQ) == 0; const bf16* pr = P + (size_t)m * PW + C_RWKV;
#pragma unroll
        for (int j = 0; j < 8; ++j) { const int c = 4 * lane + 256 * j;
            if (c < 1824) { const f32x4 p = ld_bf16x4(pr + c); const f32x4 pv = first ? (f32x4){0.f, 0.f, 0.f, 0.f} : ld_bf16x4(pr - PW + c); const f32x4 muv = *(const f32x4*)(mu + c);
                f32x4 x = p + (pv - p) * muv;
                if (c < 1536) st_bf16x4(RKV + (size_t)m * 1536 + c, x);
                else { if (c < 1600) { x.x = tanhf(x.x); x.y = tanhf(x.y); x.z = tanhf(x.z); x.w = tanhf(x.w); }
                       else if (c >= 1664) { x.x = sigmoidf_(x.x); x.y = sigmoidf_(x.y); x.z = sigmoidf_(x.z); x.w = sigmoidf_(x.w); }
                       st_bf16x4(LIN + (size_t)m * 384 + (c - 1536), x); } } }
        if (lane < 24) st_bf16x4(LIN + (size_t)m * 384 + 288 + 4 * lane, (f32x4){0.f, 0.f, 0.f, 0.f});
    }
}
__device__ __forceinline__ void phase_rwkv_lora(const Frame& F, const Args& A) {
    pg8::Gemm g{WSP(bf16, R_LIN), WSP(bf16, W_LORA), 384, 384}; pg8::StaticOrder S; S.init(TH, 1536, F.G, F.bid);
    EpiF32 E{WSP(float, R_LOUT), 1536}; pg8::gemm_phase(F.lds, g, S, E, F.tid);
}
constexpr int RS = 72;
constexpr int RREC_COMMON = 4 * 64 * RS * 2 + 256;
constexpr int RREC_SLICE = 3 * 64 * 36 * 4;
constexpr int RREC_BYTES = RREC_COMMON + 2 * RREC_SLICE;
static_assert(RREC_BYTES == 92416, "record size (see R_REC in the workspace map)");
static_assert(RREC_COMMON % 16 == 0 && RREC_SLICE % 16 == 0, "record alignment");
__device__ __forceinline__ void phase_rwkv_r1(const Frame& F, const Args& A, int layer) {
    const bf16* RKV = WSP(bf16, R_RKV); const float* LOUT = WSP(float, R_LOUT); unsigned char* REC = WSP(unsigned char, R_REC);
    const float* w0 = A.in[9] + layer * 512; const float* a0 = A.in[11] + layer * 512; const float* k_k = A.in[14] + layer * 512; const float* k_a = A.in[15] + layer * 512;
    LAS bf16* kbar = (LAS bf16*)F.lds; LAS bf16* atil = kbar + 64 * RS; LAS bf16* khat = atil + 64 * RS; LAS bf16* rbar = khat + 64 * RS;
    LAS bf16* atT = rbar + 64 * RS; LAS bf16* khT = atT + 64 * RS; LAS bf16* vT = khT + 64 * RS; LAS bf16* Bm = vT + 64 * RS; LAS bf16* Em = Bm + 64 * RS;
    LAS float* Am = (LAS float*)(Em + 64 * RS);
    LAS float* X = Am + 64 * 68;
    LAS float* lam = Am;
    const int tid = F.tid, lane = F.lane, w = F.wave, l15 = lane & 15, q4 = lane >> 4;
    const int nunits = BH * 8 * NCH;
    for (int unit = F.bid; unit < nunits; unit += F.G) {
        const int c = unit % NCH, h = (unit / NCH) & 7, b = unit / (NCH * 8);
        const size_t tok0 = (size_t)b * SEQ + (size_t)c * 64;
        const int j = lane, cj = h * 64 + j;
        __syncthreads();
        float r_[8], km_[8], kk_[8], ka_[8], v_[8];
        { const float w0c = w0[cj], a0c = a0[cj], kkc = k_k[cj], kac = k_a[cj];
#pragma unroll
          for (int q = 0; q < 8; ++q) { const int t = w + 8 * q; const size_t tok = tok0 + t;
              const float r = bf2f(RKV[tok * 1536 + cj]), k = bf2f(RKV[tok * 1536 + 512 + cj]); v_[q] = bf2f(RKV[tok * 1536 + 1024 + cj]);
              const float wpre = LOUT[tok * 1536 + cj], apre = LOUT[tok * 1536 + 512 + cj];
              const float wl = -softplusf_(-(w0c + wpre)) - 0.5f, a = sigmoidf_(a0c + apre);
              const float kr = k * kkc, ss = wave_sum(kr * kr), kk = kr / sqrtf(ss + EPS);
              r_[q] = r; km_[q] = k * (1.0f + (a - 1.0f) * kac); kk_[q] = kk; ka_[q] = kk * a;
              lam[t * 64 + j] = -expf(wl); } }
        __syncthreads();
        if (w == 0) { float s = 0.f; for (int t = 0; t < 64; ++t) { s += lam[t * 64 + j]; lam[t * 64 + j] = s; } }
        __syncthreads();
        { const float Lend = lam[63 * 64 + j];
#pragma unroll
          for (int q = 0; q < 8; ++q) { const int t = w + 8 * q; const float L = lam[t * 64 + j], Lm1 = t ? lam[(t - 1) * 64 + j] : 0.f;
              const float eG = expf(L), eGi = expf(-L), eGm1 = expf(Lm1), eT = expf(Lend - L);
              const float kb = kk_[q] * eGm1;
              kbar[t * RS + j] = (bf16)f2bf(kb); X[t * 132 + j] = kb;
              atil[t * RS + j] = (bf16)f2bf(ka_[q] * eGi); khat[t * RS + j] = (bf16)f2bf(km_[q] * eGi); rbar[t * RS + j] = (bf16)f2bf(r_[q] * eG);
              atT[j * RS + t] = (bf16)f2bf(-ka_[q] * eT); khT[j * RS + t] = (bf16)f2bf(km_[q] * eT); vT[j * RS + t] = (bf16)f2bf(v_[q]); }
          if (w == 0) { float* gc = (float*)(REC + (size_t)unit * RREC_BYTES + 4 * 64 * RS * 2); gc[j] = expf(Lend); } }
        __syncthreads();
        unsigned char* rec = REC + (size_t)unit * RREC_BYTES;
        for (int tt = 0; tt < 8; ++tt) { const int tile = w * 8 + tt, which = tile >> 4, ti = (tile >> 2) & 3, tj = tile & 3;
            f32x4 acc = (f32x4){0.f, 0.f, 0.f, 0.f};
            if (tj <= ti) acc = tile_bf(((which & 2) ? rbar : kbar) + 16 * ti * RS, RS, ((which & 1) ? khat : atil) + 16 * tj * RS, RS, 64, acc, l15, q4);
#pragma unroll
            for (int r = 0; r < 4; ++r) { const int i = 16 * ti + 4 * q4 + r, jj = 16 * tj + l15; const bool keep = (which & 2) ? (jj <= i) : (jj < i); const float v = keep ? acc[r] : 0.f;
                if (which == 0) Am[i * 68 + jj] = v; else if (which == 1) Bm[i * RS + jj] = (bf16)f2bf(v); else if (which == 3) Em[i * RS + jj] = (bf16)f2bf(v);
                else ((bf16*)(rec + 2 * 64 * RS * 2))[i * RS + jj] = (bf16)f2bf(-v); } }
        __syncthreads();
        for (int tt = 0; tt < 6; ++tt) { const int tile = w * 6 + tt, which = tile >> 4, ti = (tile >> 2) & 3, tj = tile & 3;
            const LAS bf16* aop = which == 0 ? Bm : which == 1 ? Em : khT;
            const f32x4 acc = tile_bf(aop + 16 * ti * RS, RS, vT + 16 * tj * RS, RS, 64, (f32x4){0.f, 0.f, 0.f, 0.f}, l15, q4);
#pragma unroll
            for (int r = 0; r < 4; ++r) { const int i = 16 * ti + 4 * q4 + r, vv = 16 * tj + l15;
                if (which == 0) X[i * 132 + 64 + vv] = acc[r];
                else { float* dst = (float*)(rec + RREC_COMMON + (vv >> 5) * RREC_SLICE + (which == 1 ? 1 : 2) * 64 * 36 * 4); dst[i * 36 + (vv & 31)] = acc[r]; } } }
        __syncthreads();
        for (int rb = 0; rb < 4; ++rb) {
            if (rb > 0) {
                const f32x4 acc = tile_mm(Am + 16 * rb * 68, 68, 1, X + 16 * w, 132, 1, 16 * rb, (f32x4){0.f, 0.f, 0.f, 0.f}, l15, q4);
#pragma unroll
                for (int r = 0; r < 4; ++r) X[(16 * rb + 4 * q4 + r) * 132 + 16 * w + l15] -= acc[r];
                __syncthreads();
            }
            if (tid < 128) { float x[16];
#pragma unroll
                for (int i = 0; i < 16; ++i) { float sacc = X[(16 * rb + i) * 132 + tid];
#pragma unroll
                    for (int jj = 0; jj < i; ++jj) sacc -= Am[(16 * rb + i) * 68 + 16 * rb + jj] * x[jj];
                    x[i] = sacc; }
#pragma unroll
                for (int i = 0; i < 16; ++i) X[(16 * rb + i) * 132 + tid] = x[i]; }
            __syncthreads();
        }
        for (int e = tid; e < 64 * 64; e += 512) { const int t = e >> 6, jj = e & 63; ((bf16*)rec)[t * RS + jj] = (bf16)f2bf(X[t * 132 + jj]);
            float* ub = (float*)(rec + RREC_COMMON + (jj >> 5) * RREC_SLICE); ub[t * 36 + (jj & 31)] = X[t * 132 + 64 + jj]; }
        for (int e = tid; e < 64 * RS / 8; e += 512) { ((u32x4*)(rec + 64 * RS * 2))[e] = ((const LAS u32x4*)rbar)[e]; ((u32x4*)(rec + 3 * 64 * RS * 2))[e] = ((const LAS u32x4*)atT)[e]; }
    }
    __syncthreads();
}
constexpr int R2_BUF = RREC_COMMON + RREC_SLICE;
__device__ __forceinline__ void phase_rwkv_r2(const Frame& F, const Args& A) {
    const unsigned char* REC = WSP(unsigned char, R_REC); float* RO = WSP(float, R_O);
    LAS unsigned char* buf0 = F.lds; LAS bf16* HT = (LAS bf16*)(F.lds + 2 * R2_BUF); LAS bf16* UT = HT + 2 * 32 * RS;
    const int tid = F.tid, lane = F.lane, w = F.wave, l15 = lane & 15, q4 = lane >> 4, ti = w >> 1, tj = w & 1;
    const int nunits = BH * 8 * 2;
    constexpr int NCHK = R2_BUF / 16;
    for (int unit = F.bid; unit < nunits; unit += F.G) {
        const int vs = unit & 1, h = (unit >> 1) & 7, b = unit >> 4;
        __syncthreads();
        for (int e = tid; e < 2 * 32 * RS / 2; e += 512) ((LAS unsigned*)HT)[e] = 0u;
        f32x4 Hreg = (f32x4){0.f, 0.f, 0.f, 0.f};
        u32x4 pre[8];
        { const unsigned char* rec = REC + (size_t)((b * 8 + h) * NCH) * RREC_BYTES;
#pragma unroll
          for (int q = 0; q < 8; ++q) { const int e = tid + 512 * q; if (e < NCHK) { const size_t off = (size_t)e * 16; pre[q] = *(const u32x4*)(rec + (off < RREC_COMMON ? off : off + (size_t)vs * RREC_SLICE)); } }
#pragma unroll
          for (int q = 0; q < 8; ++q) { const int e = tid + 512 * q; if (e < NCHK) *(LAS u32x4*)(buf0 + (size_t)e * 16) = pre[q]; } }
        __syncthreads();
        for (int c = 0; c < NCH; ++c) {
            LAS unsigned char* buf = buf0 + (c & 1) * R2_BUF; LAS unsigned char* nbuf = buf0 + ((c + 1) & 1) * R2_BUF;
            if (c + 1 < NCH) { const unsigned char* rec = REC + (size_t)((b * 8 + h) * NCH + c + 1) * RREC_BYTES;
#pragma unroll
                for (int q = 0; q < 8; ++q) { const int e = tid + 512 * q; if (e < NCHK) { const size_t off = (size_t)e * 16; pre[q] = *(const u32x4*)(rec + (off < RREC_COMMON ? off : off + (size_t)vs * RREC_SLICE)); } } }
            const LAS bf16* KB = (const LAS bf16*)buf; const LAS bf16* RB = KB + 64 * RS; const LAS bf16* FMn = RB + 64 * RS; const LAS bf16* ATn = FMn + 64 * RS;
            const LAS float* GC = (const LAS float*)(buf + 4 * 64 * RS * 2); const LAS float* UB = (const LAS float*)(buf + RREC_COMMON); const LAS float* OB = UB + 64 * 36; const LAS float* KV = OB + 64 * 36;
            const LAS bf16* H0 = HT + (c & 1) * 32 * RS; LAS bf16* H1 = HT + ((c + 1) & 1) * 32 * RS;
            f32x4 u;
#pragma unroll
            for (int r = 0; r < 4; ++r) u[r] = UB[(16 * ti + 4 * q4 + r) * 36 + 16 * tj + l15];
            u = tile_bf(KB + 16 * ti * RS, RS, H0 + 16 * tj * RS, RS, 64, u, l15, q4);
            { u32x2 pk; pk.x = pk2(u[0], u[1]); pk.y = pk2(u[2], u[3]); *(LAS u32x2*)(UT + (16 * tj + l15) * RS + 16 * ti + 4 * q4) = pk; }
            __syncthreads();
            f32x4 o;
#pragma unroll
            for (int r = 0; r < 4; ++r) o[r] = OB[(16 * ti + 4 * q4 + r) * 36 + 16 * tj + l15];
            o = tile_bf(RB + 16 * ti * RS, RS, H0 + 16 * tj * RS, RS, 64, o, l15, q4);
            o = tile_bf(FMn + 16 * ti * RS, RS, UT + 16 * tj * RS, RS, 64, o, l15, q4);
#pragma unroll
            for (int r = 0; r < 4; ++r) RO[((size_t)b * SEQ + (size_t)c * 64 + 16 * ti + 4 * q4 + r) * 512 + h * 64 + 32 * vs + 16 * tj + l15] = o[r];
#pragma unroll
            for (int r = 0; r < 4; ++r) Hreg[r] = Hreg[r] * GC[16 * ti + 4 * q4 + r] + KV[(16 * ti + 4 * q4 + r) * 36 + 16 * tj + l15];
            Hreg = tile_bf(ATn + 16 * ti * RS, RS, UT + 16 * tj * RS, RS, 64, Hreg, l15, q4);
            { u32x2 pk; pk.x = pk2(Hreg[0], Hreg[1]); pk.y = pk2(Hreg[2], Hreg[3]); *(LAS u32x2*)(H1 + (16 * tj + l15) * RS + 16 * ti + 4 * q4) = pk; }
            if (c + 1 < NCH) {
#pragma unroll
                for (int q = 0; q < 8; ++q) { const int e = tid + 512 * q; if (e < NCHK) *(LAS u32x4*)(nbuf + (size_t)e * 16) = pre[q]; } }
            __syncthreads();
        }
    }
    __syncthreads();
}
__device__ __forceinline__ void phase_rwkv_post(const Frame& F, const Args& A, int layer) {
    const bf16* RKV = WSP(bf16, R_RKV); const float* LOUT = WSP(float, R_LOUT); const float* RO = WSP(float, R_O); bf16* Y = WSP(bf16, A_Y) + (size_t)1 * TH * 512;
    const float* a0 = A.in[11] + layer * 512; const float* k_a = A.in[15] + layer * 512; const float* r_k = A.in[16] + layer * 512; const float* ln_w = A.in[17] + layer * 512; const float* ln_b = A.in[18] + layer * 512;
    const int lane = F.lane, c0 = 8 * lane;
    for (int m = F.gw; m < TH; m += F.NGW) {
        float o[8], r[8], k[8], v[8], ap[8], g[8];
        { const f32x4 a = *(const f32x4*)(RO + (size_t)m * 512 + c0), b2 = *(const f32x4*)(RO + (size_t)m * 512 + c0 + 4); o[0] = a.x; o[1] = a.y; o[2] = a.z; o[3] = a.w; o[4] = b2.x; o[5] = b2.y; o[6] = b2.z; o[7] = b2.w; }
#pragma unroll
        for (int hh = 0; hh < 2; ++hh) { const f32x4 rv = ld_bf16x4(RKV + (size_t)m * 1536 + c0 + 4 * hh), kv = ld_bf16x4(RKV + (size_t)m * 1536 + 512 + c0 + 4 * hh), vv = ld_bf16x4(RKV + (size_t)m * 1536 + 1024 + c0 + 4 * hh);
            const f32x4 av = *(const f32x4*)(LOUT + (size_t)m * 1536 + 512 + c0 + 4 * hh), gv = *(const f32x4*)(LOUT + (size_t)m * 1536 + 1024 + c0 + 4 * hh);
#pragma unroll
            for (int q = 0; q < 4; ++q) { r[4 * hh + q] = rv[q]; k[4 * hh + q] = kv[q]; v[4 * hh + q] = vv[q]; ap[4 * hh + q] = av[q]; g[4 * hh + q] = gv[q]; } }
        float bon = 0.f, sm = 0.f;
#pragma unroll
        for (int q = 0; q < 8; ++q) { const float a = sigmoidf_(a0[c0 + q] + ap[q]); const float km = k[q] * (1.0f + (a - 1.0f) * k_a[c0 + q]); bon += r[q] * km * r_k[c0 + q]; sm += o[q]; }
        bon += __shfl_xor(bon, 1); bon += __shfl_xor(bon, 2); bon += __shfl_xor(bon, 4);
        sm += __shfl_xor(sm, 1); sm += __shfl_xor(sm, 2); sm += __shfl_xor(sm, 4);
        const float mean = sm * (1.0f / 64.0f); float vs = 0.f;
#pragma unroll
        for (int q = 0; q < 8; ++q) { const float d = o[q] - mean; vs += d * d; }
        vs += __shfl_xor(vs, 1); vs += __shfl_xor(vs, 2); vs += __shfl_xor(vs, 4);
        const float rstd = 1.0f / sqrtf(vs * (1.0f / 64.0f) + 64e-5f);
        float y[8];
#pragma unroll
        for (int q = 0; q < 8; ++q) y[q] = ((o[q] - mean) * rstd * ln_w[c0 + q] + ln_b[c0 + q] + bon * v[q]) * g[q];
        u32x4 wv; wv.x = pk2(y[0], y[1]); wv.y = pk2(y[2], y[3]); wv.z = pk2(y[4], y[5]); wv.w = pk2(y[6], y[7]);
        *(u32x4*)(Y + (size_t)m * 512 + c0) = wv;
    }
}

__device__ __forceinline__ void conv8x8(const bf16* src, int tl0  , const float* w  , int wld, const float* bias, float (&out)[8][8]) {
    float x[11][8];
#pragma unroll
    for (int i = 0; i < 11; ++i) { const int tl = tl0 - 3 + i;
        if (tl >= 0) { const u32x4 v = *(const u32x4*)(src + (ptrdiff_t)(i - 3) * PW);
            x[i][0] = bf2f(v.x & 0xffffu); x[i][1] = bf2f(v.x >> 16); x[i][2] = bf2f(v.y & 0xffffu); x[i][3] = bf2f(v.y >> 16); x[i][4] = bf2f(v.z & 0xffffu); x[i][5] = bf2f(v.z >> 16); x[i][6] = bf2f(v.w & 0xffffu); x[i][7] = bf2f(v.w >> 16); }
        else {
#pragma unroll
            for (int ch = 0; ch < 8; ++ch) x[i][ch] = 0.f; } }
    float wv[4][8], bv[8];
#pragma unroll
    for (int j = 0; j < 4; ++j) { const f32x4 a = *(const f32x4*)(w + j * wld), b = *(const f32x4*)(w + j * wld + 4); wv[j][0] = a.x; wv[j][1] = a.y; wv[j][2] = a.z; wv[j][3] = a.w; wv[j][4] = b.x; wv[j][5] = b.y; wv[j][6] = b.z; wv[j][7] = b.w; }
    if (bias) { const f32x4 a = *(const f32x4*)bias, b = *(const f32x4*)(bias + 4); bv[0] = a.x; bv[1] = a.y; bv[2] = a.z; bv[3] = a.w; bv[4] = b.x; bv[5] = b.y; bv[6] = b.z; bv[7] = b.w; }
    else {
#pragma unroll
        for (int ch = 0; ch < 8; ++ch) bv[ch] = 0.f; }
#pragma unroll
    for (int i = 0; i < 8; ++i)
#pragma unroll
        for (int ch = 0; ch < 8; ++ch) { const float a = bv[ch] + wv[0][ch] * x[i][ch] + wv[1][ch] * x[i + 1][ch] + wv[2][ch] * x[i + 2][ch] + wv[3][ch] * x[i + 3][ch]; out[i][ch] = a * fast_rcp(1.0f + fast_exp(-a)); }
}
__device__ __forceinline__ u32x4 pack8(const float* v) { u32x4 o; o.x = pk2(v[0], v[1]); o.y = pk2(v[2], v[3]); o.z = pk2(v[4], v[5]); o.w = pk2(v[6], v[7]); return o; }
constexpr int SB = 136;
constexpr int SC_IMG = 64 * SB * 2;
__device__ __forceinline__ void phase_ssd_s1(const Frame& F, const Args& A, int layer) {
    const bf16* P = WSP(bf16, A_P); bf16* ST = WSP(bf16, S_ST); float* YD = WSP(float, S_YD); unsigned char* SCB = WSP(unsigned char, S_C); float* AC = WSP(float, S_AC);
    const float* cw = A.in[23] + (size_t)layer * 4 * 1024; const float* cb = A.in[24] + layer * 1024; const float* dtb = A.in[25] + layer * 8; const float* a_log = A.in[26] + layer * 8; const float* dsk = A.in[27] + layer * 8;
    LAS bf16* Bt_ = (LAS bf16*)F.lds; LAS bf16* Ct_ = Bt_ + 64 * SB; LAS bf16* BT = Ct_ + 64 * SB; LAS bf16* xT = BT + 128 * RS;
    LAS bf16* Mb = xT + 4 * 64 * RS; LAS bf16* xdT = Mb + 2 * 64 * RS; LAS float* dt = (LAS float*)(xdT + 2 * 64 * RS); LAS float* ac = dt + 256;
    const int tid = F.tid, lane = F.lane, w = F.wave, l15 = lane & 15, q4 = lane >> 4;
    const int nunits = BH * NCH * 2;
    for (int unit = F.bid; unit < nunits; unit += F.G) {
        const int g = unit & 1, c = (unit >> 1) % NCH, b = unit / (2 * NCH);
        const size_t tok0 = (size_t)b * SEQ + (size_t)c * 64;
        __syncthreads();
        {
            const int cg = tid & 63, rb = tid >> 6;
            const int cidx = cg < 32 ? g * 256 + 8 * cg : cg < 48 ? 512 + g * 128 + 8 * (cg - 32) : 768 + g * 128 + 8 * (cg - 48);
            float o[8][8];
            conv8x8(P + (tok0 + 8 * rb) * PW + C_SSD + 512 + cidx, c * 64 + 8 * rb, cw + cidx, 1024, cb + cidx, o);
            if (cg < 32) {
                const int hh = cg >> 3, p0 = 8 * (cg & 7);
#pragma unroll
                for (int ch = 0; ch < 8; ++ch) { float col[8];
#pragma unroll
                    for (int i = 0; i < 8; ++i) col[i] = o[i][ch];
                    *(LAS u32x4*)(xT + (hh * 64 + p0 + ch) * RS + 8 * rb) = pack8(col); }
            } else if (cg < 48) {
                const int n0 = 8 * (cg - 32);
#pragma unroll
                for (int i = 0; i < 8; ++i) *(LAS u32x4*)(Bt_ + (8 * rb + i) * SB + n0) = pack8(o[i]);
#pragma unroll
                for (int ch = 0; ch < 8; ++ch) { float col[8];
#pragma unroll
                    for (int i = 0; i < 8; ++i) col[i] = o[i][ch];
                    *(LAS u32x4*)(BT + (n0 + ch) * RS + 8 * rb) = pack8(col); }
            } else { const int n0 = 8 * (cg - 48);
#pragma unroll
                for (int i = 0; i < 8; ++i) *(LAS u32x4*)(Ct_ + (8 * rb + i) * SB + n0) = pack8(o[i]); }
        }
        if (tid < 256) { const int hh = tid >> 6, h = 4 * g + hh; const float d = softplusf_(bf2f(P[(tok0 + lane) * PW + C_SSD + 1536 + h]) + dtb[h]); float a = -expf(a_log[h]) * d;
#pragma unroll
            for (int o = 1; o < 64; o <<= 1) { const float t = __shfl_up(a, o); if (lane >= o) a += t; }
            dt[tid] = d; ac[tid] = a; AC[(tok0 + lane) * 8 + h] = a; }
        __syncthreads();
        { unsigned char* dst = SCB + (size_t)unit * SC_IMG; for (int e = tid; e < SC_IMG / 16; e += 512) ((u32x4*)dst)[e] = ((const LAS u32x4*)Ct_)[e]; }
        f32x4 cbt[2];
#pragma unroll
        for (int tt = 0; tt < 2; ++tt) { const int tile = w * 2 + tt, ti = tile >> 2, tj = tile & 3; cbt[tt] = (f32x4){0.f, 0.f, 0.f, 0.f};
            if (tj <= ti) cbt[tt] = tile_bf(Ct_ + 16 * ti * SB, SB, Bt_ + 16 * tj * SB, SB, 128, cbt[tt], l15, q4); }
        for (int hh = 0; hh < 4; ++hh) { const int h = 4 * g + hh; LAS bf16* M = Mb + (hh & 1) * 64 * RS; LAS bf16* xd = xdT + (hh & 1) * 64 * RS; const LAS float* dth = dt + hh * 64; const LAS float* ach = ac + hh * 64;
#pragma unroll
            for (int tt = 0; tt < 2; ++tt) { const int tile = w * 2 + tt, ti = tile >> 2, tj = tile & 3;
#pragma unroll
                for (int r = 0; r < 4; ++r) { const int l = 16 * ti + 4 * q4 + r, s = 16 * tj + l15; M[l * RS + s] = (bf16)f2bf((s <= l) ? cbt[tt][r] * expf(ach[l] - ach[s]) * dth[s] : 0.f); } }
            { const int p = tid >> 3, l0 = 8 * (tid & 7); const u32x4 v = *(const LAS u32x4*)(xT + (hh * 64 + p) * RS + l0); const float a63 = ach[63]; float xv[8] = {bf2f(v.x & 0xffffu), bf2f(v.x >> 16), bf2f(v.y & 0xffffu), bf2f(v.y >> 16), bf2f(v.z & 0xffffu), bf2f(v.z >> 16), bf2f(v.w & 0xffffu), bf2f(v.w >> 16)};
#pragma unroll
              for (int i = 0; i < 8; ++i) xv[i] *= dth[l0 + i] * expf(a63 - ach[l0 + i]);
              *(LAS u32x4*)(xd + p * RS + l0) = pack8(xv); }
            __syncthreads();
#pragma unroll
            for (int tt = 0; tt < 2; ++tt) { const int tile = w * 2 + tt, ti = tile >> 2, tj = tile & 3;
                const f32x4 acc = tile_bf(M + 16 * ti * RS, RS, xT + (hh * 64 + 16 * tj) * RS, RS, 64, (f32x4){0.f, 0.f, 0.f, 0.f}, l15, q4);
                const f32x4 xs = ld_bf16x4((const bf16*)(xT + (hh * 64 + 16 * tj + l15) * RS + 16 * ti + 4 * q4));
#pragma unroll
                for (int r = 0; r < 4; ++r) YD[(tok0 + 16 * ti + 4 * q4 + r) * 512 + h * 64 + 16 * tj + l15] = acc[r] + dsk[h] * xs[r]; }
            bf16* st = ST + ((size_t)((b * NCH + c) * 8 + h)) * 64 * 128;
#pragma unroll
            for (int tt = 0; tt < 4; ++tt) { const int tile = w * 4 + tt, ti = tile >> 2, tj = tile & 3;
                const f32x4 acc = tile_bf(BT + 16 * ti * RS, RS, xd + 16 * tj * RS, RS, 64, (f32x4){0.f, 0.f, 0.f, 0.f}, l15, q4);
                st_bf16x4(st + (16 * tj + l15) * 128 + 16 * ti + 4 * q4, acc); }
        }
    }
    __syncthreads();
}
__device__ __forceinline__ void phase_ssd_s23(const Frame& F, const Args& A) {
    const bf16* ST = WSP(bf16, S_ST); float* YO = WSP(float, S_YO); const unsigned char* SCB = WSP(unsigned char, S_C); const float* AC = WSP(float, S_AC);
    LAS bf16* Cimg = (LAS bf16*)F.lds; LAS bf16* Hb = Cimg + 2 * 64 * SB;
    const int tid = F.tid, lane = F.lane, w = F.wave, l15 = lane & 15, q4 = lane >> 4;
    const int nunits = BH * 8 * 4, hp = tid >> 5, hn = 4 * (tid & 31);
    constexpr int NCK = SC_IMG / 16;
    for (int unit = F.bid; unit < nunits; unit += F.G) {
        const int ps = unit & 3, h = (unit >> 2) & 7, b = unit >> 5, g = h >> 2;
        __syncthreads();
        f32x4 Hr = (f32x4){0.f, 0.f, 0.f, 0.f};
        u32x4 pre[3]; u32x2 pst;
        { const unsigned char* src = SCB + (size_t)((b * NCH + 0) * 2 + g) * SC_IMG;
#pragma unroll
          for (int q = 0; q < 3; ++q) { const int e = tid + 512 * q; if (e < NCK) ((LAS u32x4*)Cimg)[e] = *(const u32x4*)(src + (size_t)e * 16); } }
        pst = *(const u32x2*)(ST + ((size_t)((b * NCH + 0) * 8 + h)) * 8192 + (16 * ps + hp) * 128 + hn);
        for (int c = 0; c < NCH; ++c) {
            const size_t tok0 = (size_t)b * SEQ + (size_t)c * 64;
            const u32x2 stc = pst;
            if (c + 1 < NCH) { const unsigned char* src = SCB + (size_t)((b * NCH + c + 1) * 2 + g) * SC_IMG;
#pragma unroll
                for (int q = 0; q < 3; ++q) { const int e = tid + 512 * q; if (e < NCK) pre[q] = *(const u32x4*)(src + (size_t)e * 16); }
                pst = *(const u32x2*)(ST + ((size_t)((b * NCH + c + 1) * 8 + h)) * 8192 + (16 * ps + hp) * 128 + hn); }
            st_bf16x4((bf16*)(Hb + hp * SB + hn), Hr);
            float eac[4]; if (w < 4) {
#pragma unroll
                for (int r = 0; r < 4; ++r) eac[r] = AC[(tok0 + 16 * w + 4 * q4 + r) * 8 + h]; }
            const float alast = AC[(tok0 + 63) * 8 + h];
            __syncthreads();
            if (w < 4) { const LAS bf16* Ci = Cimg + (c & 1) * 64 * SB;
                const f32x4 acc = tile_bf(Ci + 16 * w * SB, SB, Hb, SB, 128, (f32x4){0.f, 0.f, 0.f, 0.f}, l15, q4);
#pragma unroll
                for (int r = 0; r < 4; ++r) { const size_t tok = tok0 + 16 * w + 4 * q4 + r; YO[tok * 512 + h * 64 + 16 * ps + l15] = acc[r] * expf(eac[r]); } }
            { const float dec = expf(alast); Hr.x = dec * Hr.x + bf2f(stc.x & 0xffffu); Hr.y = dec * Hr.y + bf2f(stc.x >> 16); Hr.z = dec * Hr.z + bf2f(stc.y & 0xffffu); Hr.w = dec * Hr.w + bf2f(stc.y >> 16); }
            if (c + 1 < NCH) { LAS u32x4* dst = (LAS u32x4*)(Cimg + ((c + 1) & 1) * 64 * SB);
#pragma unroll
                for (int q = 0; q < 3; ++q) { const int e = tid + 512 * q; if (e < NCK) dst[e] = pre[q]; } }
            __syncthreads();
        }
    }
    __syncthreads();
}
__device__ __forceinline__ void phase_ssd_s4(const Frame& F, const Args& A, int layer) {
    const float* YD = WSP(float, S_YD); const float* YO = WSP(float, S_YO); const bf16* P = WSP(bf16, A_P); bf16* Y = WSP(bf16, A_Y) + (size_t)3 * TH * 512; const float* nw = A.in[28] + layer * 512;
    const int lane = F.lane, c0 = 8 * lane;
    for (int m = F.gw; m < TH; m += F.NGW) {
        const f32x4 a = *(const f32x4*)(YD + (size_t)m * 512 + c0) + *(const f32x4*)(YO + (size_t)m * 512 + c0), b2 = *(const f32x4*)(YD + (size_t)m * 512 + c0 + 4) + *(const f32x4*)(YO + (size_t)m * 512 + c0 + 4);
        const f32x4 z0 = ld_bf16x4(P + (size_t)m * PW + C_SSD + c0), z1 = ld_bf16x4(P + (size_t)m * PW + C_SSD + c0 + 4);
        float y[8] = {a.x * siluf_(z0.x), a.y * siluf_(z0.y), a.z * siluf_(z0.z), a.w * siluf_(z0.w), b2.x * siluf_(z1.x), b2.y * siluf_(z1.y), b2.z * siluf_(z1.z), b2.w * siluf_(z1.w)};
        float ss = 0.f;
#pragma unroll
        for (int q = 0; q < 8; ++q) ss += y[q] * y[q];
        ss += __shfl_xor(ss, 1); ss += __shfl_xor(ss, 2); ss += __shfl_xor(ss, 4); ss += __shfl_xor(ss, 8); ss += __shfl_xor(ss, 16);
        const float rstd = 1.0f / sqrtf(ss * (1.0f / 256.0f) + EPS);
#pragma unroll
        for (int q = 0; q < 8; ++q) y[q] = y[q] * rstd * nw[c0 + q];
        u32x4 wv; wv.x = pk2(y[0], y[1]); wv.y = pk2(y[2], y[3]); wv.z = pk2(y[4], y[5]); wv.w = pk2(y[6], y[7]);
        *(u32x4*)(Y + (size_t)m * 512 + c0) = wv;
    }
}

__device__ __forceinline__ f32x4 tile_mm(const LAS float* a, int lda, int ska, const LAS float* b, int ldb, int scb, int K, f32x4 acc, int l15, int q4) {
    const LAS float* ap = a + l15 * lda + q4 * ska; const LAS float* bp = b + q4 * ldb + l15 * scb;
#pragma unroll 8
    for (int ks = 0; ks < K / 4; ++ks) acc = MFMA_F32(ap[ks * 4 * ska], bp[ks * 4 * ldb], acc);
    return acc;
}
constexpr int GS = 132, GS2 = 68;
constexpr int GR_W = 0, GR_QH = 64 * 136 * 2, GR_KT = 2 * 64 * 136 * 2, GR_QK = GR_KT + 128 * 72 * 2, GR_GL = GR_QK + 64 * 72 * 2, GR_COMMON = GR_GL + 16, GR_USL = 64 * 20 * 4, GR_BYTES = GR_COMMON + 8 * GR_USL;
static_assert(GR_BYTES == 103440 && GR_COMMON % 16 == 0, "GDN record");
constexpr int GX = 264;
__device__ __forceinline__ void phase_gdn_g1(const Frame& F, const Args& A, int layer) {
    const bf16* P = WSP(bf16, A_P); unsigned char* CHR = WSP(unsigned char, G_CH);
    const float* convw = A.in[19] + (size_t)layer * 4 * 1536; const float* a_log = A.in[20] + layer * 4; const float* dtb = A.in[21] + layer * 4;
    LAS bf16* qb = (LAS bf16*)F.lds; LAS bf16* kb = qb + 64 * SB; LAS bf16* qkimg = kb + 64 * SB;
    LAS float* X = (LAS float*)(qkimg + 64 * RS); LAS float* Lm = X + 64 * GX; LAS float* ssq = Lm + 64 * GS2;
    LAS float* beta = ssq + 2 * 64 * 16; LAS float* gc = beta + 64; LAS float* egc = gc + 64; LAS float* inorm = egc + 64;
    const int tid = F.tid, lane = F.lane, w = F.wave, l15 = lane & 15, q4 = lane >> 4;
    const int nunits = BH * 4 * NCH;
    for (int unit = F.bid; unit < nunits; unit += F.G) {
        const int c = unit % NCH, h = (unit / NCH) & 3, b = unit / (NCH * 4);
        const size_t tok0 = (size_t)b * SEQ + (size_t)c * 64;
        unsigned char* rec = CHR + (size_t)unit * GR_BYTES;
        __syncthreads();
        const int rb = tid / 48, pc = tid % 48, part = pc >> 4, cgl = pc & 15;
        float o[8][8];
        if (tid < 384) { const int col = part * 512 + h * 128 + 8 * cgl;
            conv8x8(P + (tok0 + 8 * rb) * PW + C_GDN + col, c * 64 + 8 * rb, convw + col, 1536, nullptr, o);
            if (part < 2) {
#pragma unroll
                for (int i = 0; i < 8; ++i) { float sacc = 0.f;
#pragma unroll
                    for (int ch = 0; ch < 8; ++ch) sacc += o[i][ch] * o[i][ch];
                    ssq[(part * 64 + 8 * rb + i) * 16 + cgl] = sacc; } } }
        if (w == 7) { const size_t tok = tok0 + lane; beta[lane] = sigmoidf_(bf2f(P[tok * PW + C_GDN + 1536 + h]));
            float g = -expf(a_log[h]) * softplusf_(bf2f(P[tok * PW + C_GDN + 1540 + h]) + dtb[h]);
#pragma unroll
            for (int o2 = 1; o2 < 64; o2 <<= 1) { const float t = __shfl_up(g, o2); if (lane >= o2) g += t; }
            gc[lane] = g; egc[lane] = expf(g); }
        __syncthreads();
        if (tid < 128) { float sacc = 0.f;
#pragma unroll
            for (int i = 0; i < 16; ++i) sacc += ssq[tid * 16 + i];
            inorm[tid] = (tid < 64 ? 0.08838834764831845f : 1.0f) / sqrtf(sacc + EPS); }
        __syncthreads();
        if (tid < 384) {
#pragma unroll
            for (int i = 0; i < 8; ++i) { const int l = 8 * rb + i;
                if (part < 2) { const float sc = inorm[part * 64 + l]; float v[8];
#pragma unroll
                    for (int ch = 0; ch < 8; ++ch) v[ch] = o[i][ch] * sc;
                    *(LAS u32x4*)((part ? kb : qb) + l * SB + 8 * cgl) = pack8(v); }
                else { const float bl = beta[l]; *(LAS f32x4*)(X + l * GX + 8 * cgl) = (f32x4){o[i][0] * bl, o[i][1] * bl, o[i][2] * bl, o[i][3] * bl}; *(LAS f32x4*)(X + l * GX + 8 * cgl + 4) = (f32x4){o[i][4] * bl, o[i][5] * bl, o[i][6] * bl, o[i][7] * bl}; } } }
        __syncthreads();
        for (int tt = 0; tt < 4; ++tt) { const int tile = w * 4 + tt, which = tile >> 4, ti = (tile >> 2) & 3, tj = tile & 3;
            f32x4 acc = (f32x4){0.f, 0.f, 0.f, 0.f};
            if (tj <= ti) acc = tile_bf((which ? qb : kb) + 16 * ti * SB, SB, kb + 16 * tj * SB, SB, 128, acc, l15, q4);
#pragma unroll
            for (int r = 0; r < 4; ++r) { const int i = 16 * ti + 4 * q4 + r, j = 16 * tj + l15; float v = 0.f;
                if (which ? (j <= i) : (j < i)) v = acc[r] * expf(gc[i] - gc[j]) * (which ? 1.0f : beta[i]);
                if (which) qkimg[i * RS + j] = (bf16)f2bf(v); else Lm[i * GS2 + j] = v; } }
        { const float glast = gc[63];
          for (int e = tid; e < 64 * 16; e += 512) { const int l = e >> 4, d0 = 8 * (e & 15); const u32x4 kv = *(const LAS u32x4*)(kb + l * SB + d0), qv = *(const LAS u32x4*)(qb + l * SB + d0);
              const float kf[8] = {bf2f(kv.x & 0xffffu), bf2f(kv.x >> 16), bf2f(kv.y & 0xffffu), bf2f(kv.y >> 16), bf2f(kv.z & 0xffffu), bf2f(kv.z >> 16), bf2f(kv.w & 0xffffu), bf2f(kv.w >> 16)};
              float qf[8] = {bf2f(qv.x & 0xffffu), bf2f(qv.x >> 16), bf2f(qv.y & 0xffffu), bf2f(qv.y >> 16), bf2f(qv.z & 0xffffu), bf2f(qv.z >> 16), bf2f(qv.w & 0xffffu), bf2f(qv.w >> 16)};
              const float sc = beta[l] * egc[l], eg = egc[l];
              *(LAS f32x4*)(X + l * GX + 128 + d0) = (f32x4){kf[0] * sc, kf[1] * sc, kf[2] * sc, kf[3] * sc}; *(LAS f32x4*)(X + l * GX + 132 + d0) = (f32x4){kf[4] * sc, kf[5] * sc, kf[6] * sc, kf[7] * sc};
#pragma unroll
              for (int q = 0; q < 8; ++q) qf[q] *= eg;
              *(u32x4*)(rec + GR_QH + (size_t)(l * SB + d0) * 2) = pack8(qf); }
          for (int e = tid; e < 128 * 8; e += 512) { const int d = e >> 3, l0 = 8 * (e & 7); float kt[8];
#pragma unroll
              for (int q = 0; q < 8; ++q) kt[q] = bf2f(kb[(l0 + q) * SB + d]) * expf(glast - gc[l0 + q]);
              *(u32x4*)(rec + GR_KT + (size_t)(d * RS + l0) * 2) = pack8(kt); }
          if (tid == 0) *(float*)(rec + GR_GL) = expf(glast); }
        __syncthreads();
        for (int e = tid; e < 64 * RS / 8; e += 512) ((u32x4*)(rec + GR_QK))[e] = ((const LAS u32x4*)qkimg)[e];
        for (int rbk = 0; rbk < 4; ++rbk) {
            if (rbk > 0) {
#pragma unroll
                for (int t2 = 0; t2 < 2; ++t2) { const int tj = 2 * w + t2;
                    const f32x4 acc = tile_mm(Lm + 16 * rbk * GS2, GS2, 1, X + 16 * tj, GX, 1, 16 * rbk, (f32x4){0.f, 0.f, 0.f, 0.f}, l15, q4);
#pragma unroll
                    for (int r = 0; r < 4; ++r) X[(16 * rbk + 4 * q4 + r) * GX + 16 * tj + l15] -= acc[r]; }
                __syncthreads();
            }
            if (tid < 256) { float x[16];
#pragma unroll
                for (int i = 0; i < 16; ++i) { float sacc = X[(16 * rbk + i) * GX + tid];
#pragma unroll
                    for (int j = 0; j < i; ++j) sacc -= Lm[(16 * rbk + i) * GS2 + 16 * rbk + j] * x[j];
                    x[i] = sacc; }
#pragma unroll
                for (int i = 0; i < 16; ++i) X[(16 * rbk + i) * GX + tid] = x[i]; }
            __syncthreads();
        }
        for (int e = tid; e < 64 * 16; e += 512) { const int l = e >> 4, d0 = 8 * (e & 15); const f32x4 a = *(const LAS f32x4*)(X + l * GX + 128 + d0), b2 = *(const LAS f32x4*)(X + l * GX + 132 + d0);
            const float v[8] = {a.x, a.y, a.z, a.w, b2.x, b2.y, b2.z, b2.w}; *(u32x4*)(rec + GR_W + (size_t)(l * SB + d0) * 2) = pack8(v); }
        for (int e = tid; e < 64 * 32; e += 512) { const int l = e >> 5, c4 = 4 * (e & 31); *(f32x4*)(rec + GR_COMMON + (size_t)(c4 >> 4) * GR_USL + (size_t)(l * 20 + (c4 & 15)) * 4) = *(const LAS f32x4*)(X + l * GX + c4); }
    }
    __syncthreads();
}
constexpr int G2_STAGE = GR_COMMON + GR_USL;
__device__ __forceinline__ void phase_gdn_g2(const Frame& F, const Args& A) {
    const unsigned char* CHR = WSP(unsigned char, G_CH); float* GO = WSP(float, G_O);
    LAS unsigned char* buf0 = F.lds; LAS bf16* STt = (LAS bf16*)(F.lds + 2 * G2_STAGE); LAS bf16* vnT = STt + 2 * 16 * SB;
    const int tid = F.tid, lane = F.lane, w = F.wave, l15 = lane & 15, q4 = lane >> 4;
    const int nunits = BH * 4 * 8;
    constexpr int NCK = G2_STAGE / 16;
    for (int unit = F.bid; unit < nunits; unit += F.G) {
        const int vs = unit & 7, h = (unit >> 3) & 3, b = unit >> 5;
        __syncthreads();
        for (int e = tid; e < 2 * 16 * SB / 2; e += 512) ((LAS unsigned*)STt)[e] = 0u;
        f32x4 Sreg = (f32x4){0.f, 0.f, 0.f, 0.f};
        u32x4 pre[9];
        { const unsigned char* rec = CHR + (size_t)((b * 4 + h) * NCH) * GR_BYTES;
#pragma unroll
          for (int q = 0; q < 9; ++q) { const int e = tid + 512 * q; if (e < NCK) { const size_t off = (size_t)e * 16; *(LAS u32x4*)(buf0 + off) = *(const u32x4*)(rec + (off < GR_COMMON ? off : off + (size_t)vs * GR_USL)); } } }
        __syncthreads();
        for (int c = 0; c < NCH; ++c) {
            LAS unsigned char* buf = buf0 + (c & 1) * G2_STAGE; LAS unsigned char* nbuf = buf0 + ((c + 1) & 1) * G2_STAGE;
            if (c + 1 < NCH) { const unsigned char* rec = CHR + (size_t)((b * 4 + h) * NCH + c + 1) * GR_BYTES;
#pragma unroll
                for (int q = 0; q < 9; ++q) { const int e = tid + 512 * q; if (e < NCK) { const size_t off = (size_t)e * 16; pre[q] = *(const u32x4*)(rec + (off < GR_COMMON ? off : off + (size_t)vs * GR_USL)); } } }
            const LAS bf16* Wi = (const LAS bf16*)(buf + GR_W); const LAS bf16* QH = (const LAS bf16*)(buf + GR_QH); const LAS bf16* KT = (const LAS bf16*)(buf + GR_KT); const LAS bf16* QK = (const LAS bf16*)(buf + GR_QK);
            const float egl = *(const LAS float*)(buf + GR_GL); const LAS float* U = (const LAS float*)(buf + GR_COMMON);
            const LAS bf16* S0 = STt + (c & 1) * 16 * SB; LAS bf16* S1 = STt + ((c + 1) & 1) * 16 * SB;
            if (w < 4) {
                const f32x4 acc = tile_bf(Wi + 16 * w * SB, SB, S0, SB, 128, (f32x4){0.f, 0.f, 0.f, 0.f}, l15, q4);
                f32x4 vn;
#pragma unroll
                for (int r = 0; r < 4; ++r) vn[r] = U[(16 * w + 4 * q4 + r) * 20 + l15] - acc[r];
                u32x2 pk; pk.x = pk2(vn[0], vn[1]); pk.y = pk2(vn[2], vn[3]); *(LAS u32x2*)(vnT + l15 * RS + 16 * w + 4 * q4) = pk; }
            __syncthreads();
            if (w < 4) {
                f32x4 acc = tile_bf(QH + 16 * w * SB, SB, S0, SB, 128, (f32x4){0.f, 0.f, 0.f, 0.f}, l15, q4);
                acc = tile_bf(QK + 16 * w * RS, RS, vnT, RS, 64, acc, l15, q4);
#pragma unroll
                for (int r = 0; r < 4; ++r) GO[((size_t)b * SEQ + (size_t)c * 64 + 16 * w + 4 * q4 + r) * 512 + h * 128 + 16 * vs + l15] = acc[r]; }
            Sreg = Sreg * egl;
            Sreg = tile_bf(KT + 16 * w * RS, RS, vnT, RS, 64, Sreg, l15, q4);
            { u32x2 pk; pk.x = pk2(Sreg[0], Sreg[1]); pk.y = pk2(Sreg[2], Sreg[3]); *(LAS u32x2*)(S1 + l15 * SB + 16 * w + 4 * q4) = pk; }
            if (c + 1 < NCH) {
#pragma unroll
                for (int q = 0; q < 9; ++q) { const int e = tid + 512 * q; if (e < NCK) *(LAS u32x4*)(nbuf + (size_t)e * 16) = pre[q]; } }
            __syncthreads();
        }
    }
    __syncthreads();
}
__device__ __forceinline__ void phase_gdn_g3(const Frame& F, const Args& A, int layer) {
    const float* GO = WSP(float, G_O); const bf16* P = WSP(bf16, A_P); bf16* Y = WSP(bf16, A_Y) + (size_t)2 * TH * 512; const float* nw = A.in[22] + layer * 128;
    const int lane = F.lane, c0 = 8 * lane;
    for (int m = F.gw; m < TH; m += F.NGW) {
        const f32x4 a = *(const f32x4*)(GO + (size_t)m * 512 + c0), b2 = *(const f32x4*)(GO + (size_t)m * 512 + c0 + 4);
        float o[8] = {a.x, a.y, a.z, a.w, b2.x, b2.y, b2.z, b2.w}; float ss = 0.f;
#pragma unroll
        for (int q = 0; q < 8; ++q) ss += o[q] * o[q];
        ss += __shfl_xor(ss, 1); ss += __shfl_xor(ss, 2); ss += __shfl_xor(ss, 4); ss += __shfl_xor(ss, 8);
        const float rstd = 1.0f / sqrtf(ss * (1.0f / 128.0f) + EPS);
        const f32x4 z0 = ld_bf16x4(P + (size_t)m * PW + C_GDN + 1544 + c0), z1 = ld_bf16x4(P + (size_t)m * PW + C_GDN + 1544 + c0 + 4);
        const float z[8] = {z0.x, z0.y, z0.z, z0.w, z1.x, z1.y, z1.z, z1.w}; float y[8];
#pragma unroll
        for (int q = 0; q < 8; ++q) y[q] = o[q] * rstd * nw[(c0 + q) & 127] * siluf_(z[q]);
        u32x4 wv; wv.x = pk2(y[0], y[1]); wv.y = pk2(y[2], y[3]); wv.z = pk2(y[4], y[5]); wv.w = pk2(y[6], y[7]);
        *(u32x4*)(Y + (size_t)m * 512 + c0) = wv;
    }
}

__device__ __forceinline__ void phase_merge_z(const Frame& F, const Args& A) {
    pg8::Gemm g{WSP(bf16, A_Y), WSP(bf16, W_BR), 512, 512}; BranchOrder S; S.nP = TH / 256; S.G = F.G; S.c = F.bid;
    EpiZ E{WSP(bf16, A_Z)}; pg8::gemm_phase(F.lds, g, S, E, F.tid);
}
__device__ __forceinline__ void phase_merge_gate(const Frame& F, const Args& A, int layer) {
    pg8::Gemm g{WSP(bf16, A_H), WSP(bf16, W_GATE), D, D}; pg8::StaticOrder S; S.init(TH, 4096, F.G, F.bid);
    EpiMerge E{WSP(bf16, A_Z), A.in[29] + (size_t)layer * 4 * D, WSP(bf16, A_MG)}; pg8::gemm_phase(F.lds, g, S, E, F.tid);
#if 1
    if (((REPEAT_MASK) >> 28) & 1u) { __syncthreads(); EpiBf16 E2{WSP(bf16, A_MIX + (size_t)64 * MiB), 4096, nullptr, 0}; pg8::gemm_phase(F.lds, g, S, E2, F.tid); }
#endif
}
__device__ __forceinline__ void phase_merge_out(const Frame& F, const Args& A, const float* xin, float* xout) {
    pg8::Gemm g{WSP(bf16, A_MG), WSP(bf16, W_OUT), D, D}; pg8::StaticOrder S; S.init(TH, D, F.G, F.bid);
    EpiResidual E{xin, xout}; pg8::gemm_phase(F.lds, g, S, E, F.tid);
}
__device__ __forceinline__ void phase_ffn_gu(const Frame& F, const Args& A) {
    pg8::Gemm g{WSP(bf16, A_H), WSP(bf16, W_FGU), D, D}; pg8::StaticOrder S; S.init(TH, 2 * FF_D, F.G, F.bid);
    EpiSwiGLU E{WSP(bf16, F_ACT), FF_D, 1 << 20}; pg8::gemm_phase(F.lds, g, S, E, F.tid);
}
__device__ __forceinline__ void phase_ffn_down(const Frame& F, const Args& A, float* x) {
    pg8::Gemm g{WSP(bf16, F_ACT), WSP(bf16, W_FDN), FF_D, FF_D}; pg8::StaticOrder S; S.init(TH, D, F.G, F.bid);
    EpiResidual E{x, x}; pg8::gemm_phase(F.lds, g, S, E, F.tid);
}
struct MoeLayout { int pstart[NEXP + 1]; };
__device__ __forceinline__ MoeLayout moe_layout(const unsigned* cnt) {
    MoeLayout L; int s = 0;
#pragma unroll
    for (int e = 0; e < NEXP; ++e) { L.pstart[e] = s; s += ((int)cnt[e] + 255) & ~255; }
    L.pstart[NEXP] = s; return L;
}
struct MoeOrder {
    int np, nN, G, c; MoeLayout L;
    __device__ bool next(int i, Unit& u) const {
        const long Lx = (long)i * G + c; if (Lx >= (long)np * nN) return false;
        const int pm = (int)(Lx / nN), pn = (int)(Lx % nN); int e = 0;
#pragma unroll
        for (int k = 1; k < NEXP; ++k) if (pm * 256 >= L.pstart[k]) e = k;
        u.pm = pm; u.pn = e * nN + pn; return true;
    }
    __device__ __forceinline__ void a_ready(const Unit&) const {}
    __device__ __forceinline__ void done(const Unit&) const {}
};
__device__ __forceinline__ void phase_moe_route(const Frame& F, const Args& A, int half) {
    const unsigned* wgc = F.ctl + CW_WGC + half * 8192; unsigned* cnt = F.ctl + CW_CNT + half * 16;
    LAS unsigned* tab = (LAS unsigned*)F.lds; LAS unsigned* tot = tab + 8192; LAS unsigned* bef = tot + 8; LAS unsigned* cur = bef + 8;
    __syncthreads();
    for (int e = F.tid; e < F.G * 8; e += 512) tab[e] = wgc[e];
    __syncthreads();
    if (F.tid < 8) { unsigned t = 0, bsum = 0; for (int g = 0; g < F.G; ++g) { const unsigned v = tab[g * 8 + F.tid]; if (g < F.bid) bsum += v; t += v; } tot[F.tid] = t; bef[F.tid] = bsum; cur[F.tid] = 0u; if (F.bid == 0) cnt[F.tid] = t; }
    __syncthreads();
    unsigned totr[8];
#pragma unroll
    for (int e = 0; e < 8; ++e) totr[e] = tot[e];
    const MoeLayout L = moe_layout(totr);
    const bf16* H = WSP(bf16, A_H); bf16* GA = WSP(bf16, F_GA); const int* tope = WSP(int, F_TOPE); int* slot = WSP(int, F_SLOT);
    const int lane = F.lane;
    for (int m = F.gw; m < TH; m += F.NGW) {
        const u32x4 v0 = *(const u32x4*)(H + (size_t)m * D + 8 * lane), v1 = *(const u32x4*)(H + (size_t)m * D + 512 + 8 * lane);
#pragma unroll
        for (int k = 0; k < 2; ++k) { const int e = tope[2 * m + k]; int s = 0;
            int ps = 0;
#pragma unroll
            for (int q = 0; q < NEXP; ++q) ps = (e == q) ? L.pstart[q] : ps;
            if (lane == 0) s = ps + (int)bef[e] + (int)ATOMIC_ADD_LDS(cur + e, 1u);
            s = __shfl(s, 0);
            if (lane == 0) slot[2 * m + k] = s;
            *(u32x4*)(GA + (size_t)s * D + 8 * lane) = v0; *(u32x4*)(GA + (size_t)s * D + 512 + 8 * lane) = v1; }
    }
#pragma unroll
    for (int e = 0; e < NEXP; ++e) { const int r0 = L.pstart[e] + (int)totr[e], r1 = L.pstart[e + 1];
        for (int r = r0 + F.gw; r < r1; r += F.NGW) { *(u32x4*)(GA + (size_t)r * D + 8 * lane) = (u32x4){0u, 0u, 0u, 0u}; *(u32x4*)(GA + (size_t)r * D + 512 + 8 * lane) = (u32x4){0u, 0u, 0u, 0u}; } }
    __syncthreads();
}
__device__ __forceinline__ void phase_moe_gu(const Frame& F, const Args& A, int half) {
    MoeOrder S; S.L = moe_layout(F.ctl + CW_CNT + half * 16); S.np = S.L.pstart[NEXP] / 256; S.nN = 2 * FF_E / 256; S.G = F.G; S.c = F.bid;
    pg8::Gemm g{WSP(bf16, F_GA), WSP(bf16, W_FGU), D, D}; EpiSwiGLU E{WSP(bf16, F_ACT), FF_E, 2 * FF_E / 256}; pg8::gemm_phase(F.lds, g, S, E, F.tid);
}
struct EpiF32Mod {
    static constexpr bool PERM = false, AFTER_DRAIN = false;
    float* C;
    __device__ __forceinline__ void operator()(const f32x4 (&acc)[2][2][4][2], const Unit& u, int wr, int wc, int fr, int fq) const {
        const int row0 = u.pm * 256 + wr * 64 + fr, col0 = (u.pn & 3) * 256 + wc * 32 + 4 * fq;
#pragma unroll
        for (int ai = 0; ai < 2; ++ai)
#pragma unroll
            for (int m = 0; m < 4; ++m) { float* rowp = C + (size_t)(row0 + ai * HALFT + m * 16) * D + col0;
#pragma unroll
                for (int bj = 0; bj < 2; ++bj)
#pragma unroll
                    for (int n = 0; n < 2; ++n) *(f32x4*)(rowp + bj * HALFT + n * 16) = acc[ai][bj][m][n]; }
    }
};
__device__ __forceinline__ void phase_moe_down(const Frame& F, const Args& A, int half) {
    MoeOrder S; S.L = moe_layout(F.ctl + CW_CNT + half * 16); S.np = S.L.pstart[NEXP] / 256; S.nN = D / 256; S.G = F.G; S.c = F.bid;
    pg8::Gemm g{WSP(bf16, F_ACT), WSP(bf16, W_FDN), FF_E, FF_E}; EpiF32Mod E{WSP(float, F_YE)}; pg8::gemm_phase(F.lds, g, S, E, F.tid);
}
__device__ __forceinline__ void phase_moe_combine(const Frame& F, const Args& A, float* x) {
    const float* YE = WSP(float, F_YE); const int* slot = WSP(int, F_SLOT); const float* topw = WSP(float, F_TOPW); const int lane = F.lane;
    for (int m = F.gw; m < TH; m += F.NGW) { const int s0 = slot[2 * m], s1 = slot[2 * m + 1]; const float w0 = topw[2 * m], w1 = topw[2 * m + 1];
#pragma unroll
        for (int j = 0; j < 4; ++j) { const int c = 4 * lane + 256 * j; float* xp = x + (size_t)m * D + c;
            *(f32x4*)xp = *(const f32x4*)xp + *(const f32x4*)(YE + (size_t)s0 * D + c) * w0 + *(const f32x4*)(YE + (size_t)s1 * D + c) * w1; } }
}

#ifndef EMU
#define XB_TMO      128
#define XB_XCNT(j)  (256  + 64 * (j))
#define XB_XSUB(j)  (1280 + 64 * (j))
#define XB_XGEN(j)  (2304 + 64 * (j))
#define XB_TOP      3328
#define XB_TOPGEN   3392
#define XCD_BAR_WORDS 3456
#define XB_SPIN_CAP (1u << 22)
__device__ __forceinline__ unsigned xb_ld(unsigned* p)              { return __hip_atomic_load(p, __ATOMIC_RELAXED, __HIP_MEMORY_SCOPE_AGENT); }
__device__ __forceinline__ unsigned xb_add(unsigned* p, unsigned v) { return __hip_atomic_fetch_add(p, v, __ATOMIC_RELAXED, __HIP_MEMORY_SCOPE_AGENT); }
__device__ __forceinline__ unsigned xb_xcc_id() { return (unsigned)__builtin_amdgcn_s_getreg((3 << 11) | 20) & 0xFu; }
#define XB_SPIN(cond, bar) do { unsigned _sp = 0; while (cond) { __builtin_amdgcn_s_sleep(1); \
    if ((++_sp & 255u) == 0u) { if (xb_ld(&(bar)[XB_TMO])) break; if (_sp > XB_SPIN_CAP) { atomicAdd(&(bar)[XB_TMO], 1u); break; } } } } while (0)
struct XcdBarrier { unsigned* bar; unsigned x; volatile LAS unsigned* st; };
__device__ __forceinline__ XcdBarrier xcd_barrier_post(unsigned* bar, volatile LAS unsigned* st) {
    XcdBarrier b; b.bar = bar; b.x = xb_xcc_id(); b.st = st;
    if (threadIdx.x == 0) (void)xb_add(&bar[XB_XCNT(b.x)], 1u);
    return b;
}
__device__ __forceinline__ void xcd_barrier_complete(unsigned* bar, unsigned x, unsigned& nloc, unsigned& nx) {
    const unsigned G = gridDim.x * gridDim.y * gridDim.z;
    unsigned sum, cnt, mine, sp = 0u;
    for (;;) {
        sum = 0u; cnt = 0u; mine = 0u;
#pragma unroll
        for (unsigned j = 0; j < 16; ++j) { const unsigned c = xb_ld(&bar[XB_XCNT(j)]); sum += c; cnt += (c > 0u) ? 1u : 0u; mine = (j == x) ? c : mine; }
        if (sum == G) break;
        __builtin_amdgcn_s_sleep(1);
        if ((++sp & 255u) == 0u) { if (xb_ld(&bar[XB_TMO])) break; if (sp > XB_SPIN_CAP) { atomicAdd(&bar[XB_TMO], 1u); break; } }
    }
    nloc = mine > 0u ? mine : 1u; nx = cnt > 0u ? cnt : 1u;
}
__device__ __forceinline__ void xcd_barrier(const XcdBarrier& b) {
    asm volatile("s_waitcnt vmcnt(0)" ::: "memory");
    __syncthreads();
    if (threadIdx.x == 0) {
        unsigned* bar = b.bar;
        __builtin_amdgcn_s_waitcnt(0);
        unsigned nloc = b.st[0], nx = b.st[1];
        if (nloc == 0u) { xcd_barrier_complete(bar, b.x, nloc, nx); b.st[0] = nloc; b.st[1] = nx; }
        const unsigned old = xb_add(&bar[XB_XSUB(b.x)], 1u);
        const unsigned gen = old / nloc;
        if (old + 1u == (gen + 1u) * nloc) {
            __builtin_amdgcn_fence(__ATOMIC_RELEASE, "agent");
            asm volatile("s_waitcnt vmcnt(0)" ::: "memory");
            const unsigned og = xb_add(&bar[XB_TOP], 1u);
            const unsigned tg = og / nx;
            if (og + 1u == (tg + 1u) * nx) xb_add(&bar[XB_TOPGEN], 1u);
            else XB_SPIN(xb_ld(&bar[XB_TOPGEN]) == tg, bar);
            __builtin_amdgcn_fence(__ATOMIC_ACQUIRE, "agent");
            xb_add(&bar[XB_XGEN(b.x)], 1u);
            asm volatile("s_waitcnt vmcnt(0)" ::: "memory");
        } else {
            XB_SPIN(xb_ld(&bar[XB_XGEN(b.x)]) == gen, bar);
            __builtin_amdgcn_fence(__ATOMIC_ACQUIRE, "agent");
            asm volatile("s_waitcnt vmcnt(0)" ::: "memory");
        }
    }
    __syncthreads();
}
#endif

constexpr int NPH = 25;
constexpr int NPHASES = DEPTH * (1 + NHALF * NPH) + 1;
constexpr int LDS_BYTES = 155648, MISC_OFF = 154624;

__global__ void __launch_bounds__(512, 2) fwd_kernel(Args args_k) {
#ifdef EMU
    unsigned char* lds = emu_lds_ptr;
#else
    extern __shared__ __attribute__((aligned(16))) unsigned char lds[];
#endif
    Frame F0;
    F0.lds = (LAS unsigned char*)lds; F0.tid = threadIdx.x; F0.lane = F0.tid & 63; F0.wave = RFL(F0.tid >> 6); F0.G = gridDim.x; F0.bid = blockIdx.x;
    F0.gw = F0.bid * 8 + F0.wave; F0.NGW = F0.G * 8;
    F0.out = args_k.out; F0.ws = args_k.ws; F0.ctl = (unsigned*)(args_k.ws + WS_CTL);
    const int lo = args_k.lo, hi = args_k.hi;
#ifndef EMU
    volatile LAS unsigned* misc = (volatile LAS unsigned*)(F0.lds + MISC_OFF);
    if (F0.tid < 4) misc[F0.tid] = 0u;
    __syncthreads();
    XcdBarrier bar; bar.bar = F0.ctl + CW_BAR; bar.x = 0; bar.st = misc;
    if (hi - lo > 1) bar = xcd_barrier_post(F0.ctl + CW_BAR, misc);
#define GRID_BAR() do { XcdBarrier bq = bar; asm volatile("" : "+s"(bq.bar), "+s"(bq.x)); xcd_barrier(bq); } while (0)
#else
#define GRID_BAR() do { } while (0)
#endif
    int ph = 0;
#ifndef PH_MASK
#define PH_MASK 0xFFFFFFFFFFFFFFFFull
#endif
#define PHASE(...) PHASE_I(31, __VA_ARGS__)
#ifdef EMU
#define LAUNDER(Fq) do { } while (0)
#else
#define LAUNDER(Fq) do { unsigned mq_ = ~0u; asm volatile("" : "+s"(Fq.G), "+s"(Fq.bid), "+s"(Fq.wave), "+s"(Fq.ws), "+s"(Fq.out), "+s"(Fq.ctl), "+s"(mq_)); Fq.lane = (int)__builtin_amdgcn_mbcnt_hi(mq_, __builtin_amdgcn_mbcnt_lo(mq_, 0u)); Fq.tid = Fq.wave * 64 + Fq.lane; Fq.gw = Fq.bid * 8 + Fq.wave; Fq.NGW = Fq.G * 8; } while (0)
#endif
#ifdef EMU
#define ARGS_Q() const Args& args_q = args_k
#else
#define ARGS_Q() const __attribute__((address_space(4))) Args* aq_ = (const __attribute__((address_space(4))) Args*)__builtin_amdgcn_kernarg_segment_ptr(); asm volatile("" : "+s"(aq_)); const Args& args_q = *(const Args*)aq_
#endif
#define PHASE_I(kind, ...) do { if (ph >= lo && ph < hi) { constexpr int reps_ = (((REPEAT_MASK) >> (kind)) & 1u) ? 2 : 1; for (int rr_ = 0; rr_ < reps_; ++rr_) { { Frame Fq = F0; LAUNDER(Fq); const Frame& F = Fq; ARGS_Q(); const Args& args = args_q; __VA_ARGS__; } if (rr_ + 1 < reps_ || ph + 1 < hi) { GRID_BAR(); if (((REPEAT_MASK) >> 26) & 1u) GRID_BAR(); } } } ++ph; } while (0)
#define PHASEK(kind, ...) PHASE_I(kind, __VA_ARGS__)
#define SEGMENT(layer, half) do { \
            const size_t r0 = (size_t)(half) * TH; \
            const float* xin = ((layer) == 0 ? args_k.in[0] : F0.out) + r0 * D; float* xo = F0.out + r0 * D; \
            PHASEK(0, phase_norm<false>(F, args, xin, args.in[2] + (layer) * D, WSP(bf16, A_H), nullptr, nullptr, nullptr, nullptr); phase_rope_table(F, args, (const int*)args.in[1] + r0, WSP(float, A_ROPE))); \
            PHASEK(1, { pg8::Gemm g{WSP(bf16, A_H), WSP(bf16, W_IN), D, D}; pg8::StaticOrder S; S.init(TH, PW, F.G, F.bid); EpiBf16 E{WSP(bf16, A_P), PW, nullptr, 0}; pg8::gemm_phase(F.lds, g, S, E, F.tid); }); \
            PHASEK(2, phase_mla_prep(F, args)); \
            PHASEK(3, phase_mla_q(F, args)); \
            PHASEK(4, phase_mla_kv(F, args)); \
            PHASEK(5, phase_attention(F, args)); \
            PHASEK(6, phase_rwkv_prep(F, args, layer)); \
            PHASEK(7, phase_rwkv_lora(F, args)); \
            PHASEK(8, phase_rwkv_r1(F, args, layer)); \
            PHASEK(24, phase_rwkv_r2(F, args)); \
            PHASEK(9, phase_rwkv_post(F, args, layer)); \
            PHASEK(10, phase_gdn_g1(F, args, layer)); \
            PHASEK(11, phase_gdn_g2(F, args)); \
            PHASEK(12, phase_gdn_g3(F, args, layer)); \
            PHASEK(13, phase_ssd_s1(F, args, layer)); \
            PHASEK(14, phase_ssd_s23(F, args)); \
            PHASEK(16, phase_ssd_s4(F, args, layer)); \
            PHASEK(17, phase_merge_z(F, args)); \
            PHASEK(18, phase_merge_gate(F, args, layer)); \
            PHASEK(19, phase_merge_out(F, args, xin, xo)); \
            if ((layer) == 0) { \
                PHASEK(20, phase_norm<false>(F, args, xo, args.in[32] + (layer) * D, WSP(bf16, A_H), nullptr, nullptr, nullptr, nullptr)); \
                PHASEK(21, phase_ffn_gu(F, args)); \
                PHASE(phase_ffn_down(F, args, xo)); \
                PHASE((void)0); \
                PHASE((void)0); \
            } else { \
                PHASE(phase_norm<true>(F, args, xo, args.in[32] + (layer) * D, WSP(bf16, A_H), args.in[35], WSP(int, F_TOPE), WSP(float, F_TOPW), F.ctl + CW_WGC + (half) * 8192)); \
                PHASE(phase_moe_route(F, args, half)); \
                PHASEK(22, phase_moe_gu(F, args, half)); \
                PHASEK(23, phase_moe_down(F, args, half)); \
                PHASE(phase_moe_combine(F, args, xo)); \
            } } while (0)
    static_assert(DEPTH == 2 && NHALF <= 2, "segment program");
    PHASEK(27, phase_convert(F, args, 0));
    SEGMENT(0, 0);
    if (NHALF == 2) SEGMENT(0, 1);
    PHASEK(27, phase_convert(F, args, 1));
    SEGMENT(1, 0);
    if (NHALF == 2) SEGMENT(1, 1);
#undef SEGMENT
    PHASE(phase_final_norm(F, args, F.out, args.in[38]));
#undef PHASE
}

#ifndef ONE_LAUNCH
#define ONE_LAUNCH 1
#endif
extern "C" void kernel_launch(void* const* d_in, const int* in_sizes, int n_in, void* d_out, int out_size, void* d_ws, size_t ws_size, hipStream_t stream) {
    static int grid = 0;
    if (grid == 0) {
#ifdef EMU
        grid = EMU_GRID;
#else
        if (n_in != 39 || out_size != T * D || ws_size < WS_NEED) { fprintf(stderr, "kernel_launch: unexpected problem (n_in %d out %d ws %zu need %zu)\n", n_in, out_size, ws_size, (size_t)WS_NEED); grid = -1; return; }
        int dev = 0, cus = 0;
        if (hipGetDevice(&dev) != hipSuccess || hipDeviceGetAttribute(&cus, hipDeviceAttributeMultiprocessorCount, dev) != hipSuccess) { grid = -1; return; }
        if (hipFuncSetAttribute((const void*)fwd_kernel, hipFuncAttributeMaxDynamicSharedMemorySize, LDS_BYTES) != hipSuccess) { fprintf(stderr, "kernel_launch: hipFuncSetAttribute failed\n"); grid = -1; return; }
        int per_cu = 0;
        if (hipOccupancyMaxActiveBlocksPerMultiprocessor(&per_cu, (const void*)fwd_kernel, 512, LDS_BYTES) != hipSuccess || per_cu < 1) fprintf(stderr, "kernel_launch: occupancy query reports %d\n", per_cu);
        (void)hipGetLastError();
        grid = cus;
#endif
    }
    if (grid < 0) return;
    (void)hipMemsetAsync((char*)d_ws + WS_CTL, 0, CTL_BYTES, stream);
    Args a{};
    for (int i = 0; i < 39; ++i) a.in[i] = (const float*)d_in[i];
    a.out = (float*)d_out; a.ws = (unsigned char*)d_ws;
#ifdef EMU
    for (int p = EMU_PH_LO; p < EMU_PH_HI && p < NPHASES; ++p) { a.lo = p; a.hi = p + 1; emu_launch(fwd_kernel, grid, 512, a); emu_after_phase(p); }
#else
#if ONE_LAUNCH
    a.lo = 0; a.hi = NPHASES;
    hipLaunchKernelGGL(fwd_kernel, dim3(grid), dim3(512), LDS_BYTES, stream, a);
#else
    for (int p = 0; p < NPHASES; ++p) { a.lo = p; a.hi = p + 1; hipLaunchKernelGGL(fwd_kernel, dim3(grid), dim3(512), LDS_BYTES, stream, a); }
#endif
#endif
}
```

```cpp
#ifndef EMU
#include <hip/hip_runtime.h>
#include <cstdio>
#include <cstdint>
#endif

#ifndef REPEAT_MASK
#define REPEAT_MASK 0u
#endif
#ifdef EMU
constexpr int BATCH = EMU_B, SEQ = EMU_S, NHALF = EMU_NHALF;
#else
constexpr int BATCH = 16, SEQ = 2048, NHALF = 2;
#endif
constexpr int D = 1024, DEPTH = 2, CH = 64;
constexpr int T = BATCH * SEQ, TH = T / NHALF, BH = BATCH / NHALF, NCH = SEQ / CH;
constexpr int C_MLA = 0, C_RWKV = 704, C_GDN = 2528, C_SSD = 4584, C_GATE = 6128, IN_COLS = 10224, PW = 6144;
constexpr int FF_D = 2816, FF_E = 3584, NEXP = 8;
constexpr int MOE_ROWS = ((TH * 2 + NEXP * 255) / 256) * 256;
constexpr float EPS = 1e-6f;
static_assert(TH % 256 == 0 && SEQ % 128 == 0 && BATCH % NHALF == 0 && (SEQ / 64) % 2 == 0, "shape");

typedef unsigned short bf16;
typedef float f32x4 __attribute__((ext_vector_type(4)));
typedef float f32x2 __attribute__((ext_vector_type(2)));
typedef short bf16x8 __attribute__((ext_vector_type(8)));
typedef short bf16x4 __attribute__((ext_vector_type(4)));
typedef unsigned u32x4 __attribute__((ext_vector_type(4)));
typedef unsigned u32x2 __attribute__((ext_vector_type(2)));
#ifdef EMU
#define LAS
#define GAS
#define MFMA_F32(a, b, c) emu_mfma_16x16x4f32(a, b, c)
#define MFMA_BF16(a, b, c) emu_mfma_16x16x32bf16(a, b, c)
#define ATOMIC_ADD_U32(p, v) emu_atomic_add_u32(p, v)
#define ATOMIC_ADD_LDS(p, v) emu_atomic_add_u32((unsigned*)(p), v)
#define RFL(x) (x)
#define LDS_WAIT()
#define VM_WAIT()
__device__ __forceinline__ float fast_exp(float x) { return expf(x); }
__device__ __forceinline__ float fast_rcp(float x) { return 1.0f / x; }
__device__ __forceinline__ float fast_rsqrt(float x) { return 1.0f / sqrtf(x); }
#else
#define LAS __attribute__((address_space(3)))
#define GAS __attribute__((address_space(1)))
#define MFMA_F32(a, b, c) __builtin_amdgcn_mfma_f32_16x16x4f32(a, b, c, 0, 0, 0)
#define MFMA_BF16(a, b, c) __builtin_amdgcn_mfma_f32_16x16x32_bf16(a, b, c, 0, 0, 0)
#define ATOMIC_ADD_U32(p, v) __hip_atomic_fetch_add(p, v, __ATOMIC_RELAXED, __HIP_MEMORY_SCOPE_AGENT)
#define ATOMIC_ADD_LDS(p, v) __hip_atomic_fetch_add((LAS unsigned*)(p), v, __ATOMIC_RELAXED, __HIP_MEMORY_SCOPE_WORKGROUP)
#define RFL(x) __builtin_amdgcn_readfirstlane(x)
#define LDS_WAIT() asm volatile("s_waitcnt lgkmcnt(0)" ::: "memory")
#define VM_WAIT() asm volatile("s_waitcnt vmcnt(0)" ::: "memory")
__device__ __forceinline__ float fast_exp(float x) { return __expf(x); }
__device__ __forceinline__ float fast_rcp(float x) { return __builtin_amdgcn_rcpf(x); }
__device__ __forceinline__ float fast_rsqrt(float x) { return __builtin_amdgcn_rsqf(x); }
#endif
__device__ __forceinline__ unsigned f2u(float f) { return __builtin_bit_cast(unsigned, f); }
__device__ __forceinline__ float u2f(unsigned u) { return __builtin_bit_cast(float, u); }
__device__ __forceinline__ unsigned f2bf(float f) { unsigned u = f2u(f); return (u + 0x7fffu + ((u >> 16) & 1u)) >> 16; }
__device__ __forceinline__ float bf2f(unsigned h) { return u2f(h << 16); }
__device__ __forceinline__ unsigned pk2(float lo, float hi) { return f2bf(lo) | (f2bf(hi) << 16); }
__device__ __forceinline__ float sigmoidf_(float x) { return 1.0f / (1.0f + expf(-x)); }
__device__ __forceinline__ float siluf_(float x) { return x / (1.0f + expf(-x)); }
__device__ __forceinline__ float softplusf_(float x) { return x > 20.f ? x : log1pf(expf(x)); }
__device__ __forceinline__ float wave_sum(float v) {
#pragma unroll
    for (int o = 1; o < 64; o <<= 1) v += __shfl_xor(v, o);
    return v;
}
__device__ __forceinline__ float wave_max(float v) {
#pragma unroll
    for (int o = 1; o < 64; o <<= 1) v = fmaxf(v, __shfl_xor(v, o));
    return v;
}
__device__ __forceinline__ f32x4 ld_bf16x4(const bf16* p) { const u32x2 w = *(const u32x2*)p; return (f32x4){bf2f(w.x & 0xffffu), bf2f(w.x >> 16), bf2f(w.y & 0xffffu), bf2f(w.y >> 16)}; }
__device__ __forceinline__ void st_bf16x4(bf16* p, f32x4 v) { u32x2 w; w.x = pk2(v.x, v.y); w.y = pk2(v.z, v.w); *(u32x2*)p = w; }
__device__ __forceinline__ u32x4 pack8(const float* v) { u32x4 o; o.x = pk2(v[0], v[1]); o.y = pk2(v[2], v[3]); o.z = pk2(v[4], v[5]); o.w = pk2(v[6], v[7]); return o; }

namespace pg8 {
#define PG8_LAS LAS
typedef unsigned short bf16_t;
constexpr int BM = 256, BK = 64, HALF = 128, HTB = HALF * BK * 2, STAGE_BYTES = 8 * HTB, NXCD = 8, WGM = 8;
__host__ __device__ __forceinline__ int lds_byte(int r, int c) { const int st = (r >> 4) * 2 + (c >> 5), rr = r & 15, cc = c & 31, ob = rr * 64 + cc * 2; return st * 1024 + (ob ^ (((ob >> 9) & 1) << 5)); }
__host__ __device__ __forceinline__ void stage_rc(int b, int& R, int& C) { const int st = b / 1024, sb = b % 1024, swz = sb ^ (((sb >> 9) & 1) << 5); R = (st >> 1) * 16 + swz / 64; C = (st & 1) * 32 + (swz % 64) / 2; }
__host__ __device__ __forceinline__ int perm32(int rho) { const int n = rho >> 4, i = rho & 15; return 8 * (i >> 2) + 4 * n + (i & 3); }
struct Unit { int pm, pn; };
struct Gemm { const bf16_t* A; const bf16_t* Bt; int lda, K; };
struct StaticOrder {
    int nM, nN, nwg, G, c;
    __host__ __device__ void init(int M, int N, int G_, int c_) { nM = M / BM; nN = N / BM; nwg = nM * nN; G = G_; c = c_; }
    __host__ __device__ bool next(int i, Unit& u) const {
        const long L = (long)i * G + c; if (L >= nwg) return false;
        int wgid = (int)L; { const int q = nwg / NXCD, r = nwg % NXCD, xcd = wgid % NXCD, off = wgid / NXCD; wgid = (xcd < r ? xcd * (q + 1) : r * (q + 1) + (xcd - r) * q) + off; }
        const int nig = WGM * nN, gid = wgid / nig, fm = gid * WGM, gsz = (nM - fm) < WGM ? (nM - fm) : WGM;
        u.pm = fm + ((wgid % nig) % gsz); u.pn = (wgid % nig) / gsz; return true;
    }
    __device__ __forceinline__ void a_ready(const Unit&) const {}
    __device__ __forceinline__ void done(const Unit&) const {}
};
#ifndef EMU
template <class Epi, class Sched>
__device__ __forceinline__ void gemm_phase(PG8_LAS unsigned char* lds, const Gemm g, const Sched& S, const Epi& E, const int tid) {
    const int wid = __builtin_amdgcn_readfirstlane(tid >> 6), lane = tid & 63, wr = wid >> 2, wc = wid & 3, fr = lane & 15, fq = lane >> 4;
    int Kq = g.K; asm volatile("" : "+s"(Kq));
    const int K = Kq, nt = K / BK, lda = g.lda;
    unsigned voffA[2], voffB[2];
#pragma unroll
    for (int i = 0; i < 2; ++i) { int R, C; stage_rc(tid * 16 + i * 8192, R, C); const int Rb = Epi::PERM ? ((R & ~31) + perm32(R & 31)) : R;
        voffA[i] = (unsigned)(R * lda + C) * 2u; voffB[i] = (unsigned)(Rb * K + C) * 2u; }
    const size_t kstep = (size_t)(BK * 2);
    const size_t hstep = (size_t)HALF * K * 2, hstepA = (size_t)HALF * lda * 2;
    const size_t tstep = 2 * hstep, tstepA = 2 * hstepA;
    const unsigned ldsw = (unsigned)wid * 1024u;
    const int aoff = lds_byte(wr * 64 + fr, fq * 8), boff = lds_byte(wc * 32 + fr, fq * 8);
#define PG8_SA(b, h) (((b) * 2 + (h)) * HTB)
#define PG8_SB(b, h) ((4 + (b) * 2 + (h)) * HTB)
#define PG8_STAGE(bufoff, gbase, voff) do { _Pragma("unroll") for (int _i = 0; _i < 2; ++_i) \
        __builtin_amdgcn_global_load_lds((const unsigned*)((const char*)(gbase) + (voff)[_i]), (PG8_LAS unsigned*)(lds + (bufoff) + ldsw + _i * 8192), 16, 0, 0); } while (0)
#define PG8_LDA(dst, b, h) do { _Pragma("unroll") for (int m = 0; m < 4; ++m) _Pragma("unroll") for (int k = 0; k < 2; ++k) dst[m][k] = *(const PG8_LAS bf16x8*)(lds + PG8_SA(b, h) + aoff + m * 2048 + k * 1024); } while (0)
#define PG8_LDB(dst, b, h) do { _Pragma("unroll") for (int n = 0; n < 2; ++n) _Pragma("unroll") for (int k = 0; k < 2; ++k) dst[n][k] = *(const PG8_LAS bf16x8*)(lds + PG8_SB(b, h) + boff + n * 2048 + k * 1024); } while (0)
#define PG8_MMA(ai, bj, At, Bt) do { __builtin_amdgcn_s_setprio(1); _Pragma("unroll") for (int m = 0; m < 4; ++m) _Pragma("unroll") for (int n = 0; n < 2; ++n) _Pragma("unroll") for (int k = 0; k < 2; ++k) \
        acc[ai][bj][m][n] = __builtin_amdgcn_mfma_f32_16x16x32_bf16(Bt[n][k], At[m][k], acc[ai][bj][m][n], 0, 0, 0); __builtin_amdgcn_s_setprio(0); } while (0)
#define PG8_WAIT_V(n) asm volatile("s_waitcnt vmcnt(" #n ")" ::: "memory")
#define PG8_WAIT_L(n) asm volatile("s_waitcnt lgkmcnt(" #n ")" ::: "memory")
#define PG8_BAR __builtin_amdgcn_s_barrier()
#define PG8_SCHED __builtin_amdgcn_sched_barrier(0)
    Unit cur, nxt; int ui = 0;
    if (!S.next(0, cur)) return;
    f32x4 acc[2][2][4][2];
#pragma unroll
    for (int a = 0; a < 2; ++a)
#pragma unroll
        for (int b = 0; b < 2; ++b)
#pragma unroll
            for (int m = 0; m < 4; ++m)
#pragma unroll
                for (int n = 0; n < 2; ++n) acc[a][b][m][n] = (f32x4){0.f, 0.f, 0.f, 0.f};
    bf16x8 At[4][2], B0[2][2], B1[2][2];
    const char* cA = (const char*)g.A + (size_t)cur.pm * tstepA; const char* cB = (const char*)g.Bt + (size_t)cur.pn * tstep;
    S.a_ready(cur);
    PG8_STAGE(PG8_SB(0, 0), cB, voffB); PG8_STAGE(PG8_SA(0, 0), cA, voffA); PG8_STAGE(PG8_SB(0, 1), cB + hstep, voffB); PG8_STAGE(PG8_SA(0, 1), cA + hstepA, voffA);
    if (wr == 1) PG8_BAR;
    PG8_WAIT_V(4); PG8_BAR;
    PG8_STAGE(PG8_SB(1, 0), cB + kstep, voffB); PG8_STAGE(PG8_SA(1, 0), cA + kstep, voffA); PG8_STAGE(PG8_SB(1, 1), cB + hstep + kstep, voffB);
    PG8_WAIT_V(6); PG8_BAR;
    for (;;) {
        const bool has_next = S.next(ui + 1, nxt);
        const char* nA = has_next ? (const char*)g.A + (size_t)nxt.pm * tstepA : cA; const char* nB = has_next ? (const char*)g.Bt + (size_t)nxt.pn * tstep : cB;
        for (int t = 0; t < nt; t += 2) {
            const bool last = (t == nt - 2);
            const char* a1 = cA + (size_t)(t + 1) * kstep;
            const char* a2 = last ? nA : cA + (size_t)(t + 2) * kstep; const char* b2 = last ? nB : cB + (size_t)(t + 2) * kstep;
            const char* a3 = a2 + kstep; const char* b3 = b2 + kstep;
            if (last && has_next) S.a_ready(nxt);
            PG8_LDB(B0, 0, 0); PG8_SCHED; PG8_LDA(At, 0, 0); PG8_STAGE(PG8_SA(1, 1), a1 + hstepA, voffA);
            PG8_WAIT_L(8); PG8_BAR; PG8_WAIT_L(0); PG8_MMA(0, 0, At, B0); PG8_BAR; PG8_SCHED;
            PG8_LDB(B1, 0, 1); PG8_STAGE(PG8_SB(0, 0), b2, voffB);
            PG8_BAR; PG8_WAIT_L(0); PG8_MMA(0, 1, At, B1); PG8_BAR;
            PG8_LDA(At, 0, 1); PG8_STAGE(PG8_SA(0, 0), a2, voffA);
            PG8_BAR; PG8_WAIT_L(0); PG8_MMA(1, 0, At, B0); PG8_BAR; PG8_SCHED;
            PG8_STAGE(PG8_SB(0, 1), b2 + hstep, voffB);
            PG8_WAIT_V(6); PG8_BAR; PG8_MMA(1, 1, At, B1); PG8_BAR;
            PG8_LDB(B0, 1, 0); PG8_SCHED; PG8_LDA(At, 1, 0); PG8_STAGE(PG8_SA(0, 1), a2 + hstepA, voffA);
            PG8_WAIT_L(8); PG8_BAR; PG8_WAIT_L(0); PG8_MMA(0, 0, At, B0); PG8_BAR; PG8_SCHED;
            PG8_LDB(B1, 1, 1); PG8_STAGE(PG8_SB(1, 0), b3, voffB);
            PG8_BAR; PG8_WAIT_L(0); PG8_MMA(0, 1, At, B1); PG8_BAR;
            PG8_LDA(At, 1, 1); PG8_STAGE(PG8_SA(1, 0), a3, voffA);
            PG8_BAR; PG8_WAIT_L(0); PG8_MMA(1, 0, At, B0); PG8_BAR; PG8_SCHED;
            PG8_STAGE(PG8_SB(1, 1), b3 + hstep, voffB);
            PG8_WAIT_V(6); PG8_BAR; PG8_MMA(1, 1, At, B1); PG8_BAR;
        }
        if constexpr (!Epi::AFTER_DRAIN) { E(acc, cur, wr, wc, fr, fq); S.done(cur); }
        if (!has_next) break;
#pragma unroll
        for (int a = 0; a < 2; ++a)
#pragma unroll
            for (int b = 0; b < 2; ++b)
#pragma unroll
                for (int m = 0; m < 4; ++m)
#pragma unroll
                    for (int n = 0; n < 2; ++n) acc[a][b][m][n] = (f32x4){0.f, 0.f, 0.f, 0.f};
        cur = nxt; cA = nA; cB = nB; ++ui;
    }
    PG8_WAIT_V(0);
    if (wr == 0) PG8_BAR;
    PG8_BAR;
    if constexpr (Epi::AFTER_DRAIN) { E.fused(acc, cur, wr, wc, fr, fq, lds, wid, lane); S.done(cur); }
#undef PG8_SA
#undef PG8_SB
#undef PG8_STAGE
#undef PG8_LDA
#undef PG8_LDB
#undef PG8_MMA
#undef PG8_WAIT_V
#undef PG8_WAIT_L
#undef PG8_BAR
#undef PG8_SCHED
}
#else
template <class Epi, class Sched>
__device__ __forceinline__ void gemm_phase(PG8_LAS unsigned char* lds, const Gemm g, const Sched& S, const Epi& E, const int tid) {
    const int wid = tid >> 6, lane = tid & 63, wr = wid >> 2, wc = wid & 3, fr = lane & 15, fq = lane >> 4;
    Unit cur;
    for (int ui = 0; S.next(ui, cur); ++ui) {
        f32x4 acc[2][2][4][2];
        for (int ai = 0; ai < 2; ++ai) for (int m = 0; m < 4; ++m) {
            const size_t row = (size_t)cur.pm * 256 + ai * 128 + wr * 64 + m * 16 + fr;
            const bf16_t* ap = g.A + row * g.lda;
            for (int bj = 0; bj < 2; ++bj) for (int n = 0; n < 2; ++n) for (int j = 0; j < 4; ++j) {
                const size_t col = (size_t)cur.pn * 256 + bj * 128 + wc * 32 + (Epi::PERM ? 8 * fq + 4 * n : 16 * n + 4 * fq) + j;
                const bf16_t* bp = g.Bt + col * g.K; float s = 0.f;
                for (int k = 0; k < g.K; ++k) s += bf2f(ap[k]) * bf2f(bp[k]);
                acc[ai][bj][m][n][j] = s; } }
        E(acc, cur, wr, wc, fr, fq);
    }
    __syncthreads();
}
#endif
}

using pg8::Unit;
constexpr int HALFT = 128;
struct EpiF32 {
    static constexpr bool PERM = false, AFTER_DRAIN = false;
    float* C; int ldc;
    __device__ __forceinline__ void operator()(const f32x4 (&acc)[2][2][4][2], const Unit& u, int wr, int wc, int fr, int fq) const {
        const int row0 = u.pm * 256 + wr * 64 + fr, col0 = u.pn * 256 + wc * 32 + 4 * fq;
#pragma unroll
        for (int ai = 0; ai < 2; ++ai)
#pragma unroll
            for (int m = 0; m < 4; ++m) { float* rowp = C + (size_t)(row0 + ai * HALFT + m * 16) * ldc + col0;
#pragma unroll
                for (int bj = 0; bj < 2; ++bj)
#pragma unroll
                    for (int n = 0; n < 2; ++n) *(f32x4*)(rowp + bj * HALFT + n * 16) = acc[ai][bj][m][n]; }
    }
};
struct EpiResidual {
    static constexpr bool PERM = false, AFTER_DRAIN = false;
    const float* res; float* out;
    __device__ __forceinline__ void operator()(const f32x4 (&acc)[2][2][4][2], const Unit& u, int wr, int wc, int fr, int fq) const {
        const int row0 = u.pm * 256 + wr * 64 + fr, col0 = u.pn * 256 + wc * 32 + 4 * fq;
#pragma unroll
        for (int ai = 0; ai < 2; ++ai) {
            f32x4 rv[4][2][2];
#pragma unroll
            for (int m = 0; m < 4; ++m) { const size_t o = (size_t)(row0 + ai * HALFT + m * 16) * D + col0;
#pragma unroll
                for (int bj = 0; bj < 2; ++bj)
#pragma unroll
                    for (int n = 0; n < 2; ++n) rv[m][bj][n] = *(const GAS f32x4*)(res + o + bj * HALFT + n * 16); }
#pragma unroll
            for (int m = 0; m < 4; ++m) { const size_t o = (size_t)(row0 + ai * HALFT + m * 16) * D + col0;
#pragma unroll
                for (int bj = 0; bj < 2; ++bj)
#pragma unroll
                    for (int n = 0; n < 2; ++n) *(GAS f32x4*)(out + o + bj * HALFT + n * 16) = rv[m][bj][n] + acc[ai][bj][m][n]; }
        }
    }
};
struct EpiBf16 {
    static constexpr bool PERM = true, AFTER_DRAIN = false;
    bf16* O; int ldc; const float* rowscale; int rs_stride;
    __device__ __forceinline__ void operator()(const f32x4 (&acc)[2][2][4][2], const Unit& u, int wr, int wc, int fr, int fq) const {
        const int row0 = u.pm * 256 + wr * 64 + fr, col0 = u.pn * 256 + wc * 32 + 8 * fq;
#pragma unroll
        for (int ai = 0; ai < 2; ++ai)
#pragma unroll
            for (int m = 0; m < 4; ++m) { const int row = row0 + ai * HALFT + m * 16; bf16* rowp = O + (size_t)row * ldc + col0;
                const float sc = rowscale ? rowscale[(size_t)row * rs_stride] : 1.0f;
#pragma unroll
                for (int bj = 0; bj < 2; ++bj) { const f32x4 v0 = acc[ai][bj][m][0] * sc, v1 = acc[ai][bj][m][1] * sc;
                    u32x4 w; w.x = pk2(v0[0], v0[1]); w.y = pk2(v0[2], v0[3]); w.z = pk2(v1[0], v1[1]); w.w = pk2(v1[2], v1[3]);
                    *(u32x4*)(rowp + bj * HALFT) = w; } }
    }
};
struct EpiSwiGLU {
    static constexpr bool PERM = true, AFTER_DRAIN = false;
    bf16* O; int ldc; int ntile;
    __device__ __forceinline__ void operator()(const f32x4 (&acc)[2][2][4][2], const Unit& u, int wr, int wc, int fr, int fq) const {
        const int row0 = u.pm * 256 + wr * 64 + fr, col0 = (u.pn % ntile) * 128 + wc * 32 + 8 * fq;
#pragma unroll
        for (int ai = 0; ai < 2; ++ai)
#pragma unroll
            for (int m = 0; m < 4; ++m) { bf16* rowp = O + (size_t)(row0 + ai * HALFT + m * 16) * ldc + col0;
                float a[8];
#pragma unroll
                for (int n = 0; n < 2; ++n)
#pragma unroll
                    for (int j = 0; j < 4; ++j) { const float g = acc[ai][0][m][n][j], up = acc[ai][1][m][n][j]; a[4 * n + j] = g * fast_rcp(1.0f + fast_exp(-g)) * up; }
                u32x4 w; w.x = pk2(a[0], a[1]); w.y = pk2(a[2], a[3]); w.z = pk2(a[4], a[5]); w.w = pk2(a[6], a[7]);
                *(u32x4*)rowp = w; }
    }
};
struct EpiZ {
    static constexpr bool PERM = true, AFTER_DRAIN = false;
    bf16* Z;
    __device__ __forceinline__ void operator()(const f32x4 (&acc)[2][2][4][2], const Unit& u, int wr, int wc, int fr, int fq) const {
        const int i = u.pn >> 2, pnl = u.pn & 3, pml = u.pm - i * (TH / 256);
        const int row0 = pml * 256 + wr * 64 + fr, col0 = i * D + pnl * 256 + wc * 32 + 8 * fq;
#pragma unroll
        for (int ai = 0; ai < 2; ++ai)
#pragma unroll
            for (int m = 0; m < 4; ++m) { bf16* rowp = Z + (size_t)(row0 + ai * HALFT + m * 16) * 4096 + col0;
#pragma unroll
                for (int bj = 0; bj < 2; ++bj) { const f32x4 v0 = acc[ai][bj][m][0], v1 = acc[ai][bj][m][1];
                    u32x4 w; w.x = pk2(v0[0], v0[1]); w.y = pk2(v0[2], v0[3]); w.z = pk2(v1[0], v1[1]); w.w = pk2(v1[2], v1[3]);
                    *(GAS u32x4*)(rowp + bj * HALFT) = w; } }
    }
};
struct BranchOrder {
    int nP, G, c;
    __device__ bool next(int i, Unit& u) const {
        const long L = (long)i * G + c; if (L >= (long)16 * nP) return false;
        const int br = (int)(L / (4 * nP)), r = (int)(L % (4 * nP)); u.pm = br * nP + (r >> 2); u.pn = br * 4 + (r & 3); return true;
    }
    __device__ __forceinline__ void a_ready(const Unit&) const {}
    __device__ __forceinline__ void done(const Unit&) const {}
};
struct EpiMerge {
    static constexpr bool PERM = false, AFTER_DRAIN = false;
    const bf16* Z; const float* gate_b; bf16* MG;
    __device__ __forceinline__ void operator()(const f32x4 (&acc)[2][2][4][2], const Unit& u, int wr, int wc, int fr, int fq) const {
        const int row0 = u.pm * 256 + wr * 64 + fr, col = u.pn * 64 + wc * 16 + 4 * fq;
        f32x4 gb[4];
#pragma unroll
        for (int i = 0; i < 4; ++i) gb[i] = *(const GAS f32x4*)(gate_b + i * D + col);
#pragma unroll
        for (int ai = 0; ai < 2; ++ai) {
            u32x2 zv[4][4];
#pragma unroll
            for (int m = 0; m < 4; ++m)
#pragma unroll
                for (int i = 0; i < 4; ++i) zv[m][i] = *(const GAS u32x2*)(Z + (size_t)(row0 + ai * HALFT + m * 16) * 4096 + i * D + col);
#pragma unroll
            for (int m = 0; m < 4; ++m) { const size_t row = (size_t)(row0 + ai * HALFT + m * 16);
                f32x4 s = (f32x4){0.f, 0.f, 0.f, 0.f};
#pragma unroll
                for (int bj = 0; bj < 2; ++bj)
#pragma unroll
                    for (int n = 0; n < 2; ++n) { const int i = 2 * bj + n; const unsigned z01 = zv[m][i].x, z23 = zv[m][i].y;
                        const f32x4 z = (f32x4){bf2f(z01 & 0xffffu), bf2f(z01 >> 16), bf2f(z23 & 0xffffu), bf2f(z23 >> 16)}; const f32x4 a = acc[ai][bj][m][n] + gb[i];
#pragma unroll
                        for (int j = 0; j < 4; ++j) s[j] += z[j] * fast_rcp(1.0f + fast_exp(-a[j])); }
                u32x2 w; w.x = pk2(s.x, s.y); w.y = pk2(s.z, s.w); *(GAS u32x2*)(MG + row * D + col) = w; }
        }
    }
};

constexpr size_t MiB = 1u << 20;
constexpr size_t al(size_t x) { return (x + 255) & ~(size_t)255; }
constexpr size_t WS_CTL = 0, CTL_BYTES = 1 * MiB;
constexpr size_t W_IN = 1 * MiB;
constexpr size_t W_GATE = W_IN + (size_t)PW * D * 2;
constexpr size_t W_UQ = W_GATE + (size_t)4096 * D * 2;
constexpr size_t W_UKV = W_UQ + (size_t)768 * 384 * 2;
constexpr size_t W_LORA = W_UKV + (size_t)1024 * 256 * 2;
constexpr size_t W_BR = W_LORA + (size_t)1536 * 384 * 2;
constexpr size_t W_OUT = W_BR + (size_t)4 * 1024 * 512 * 2;
constexpr size_t W_FGU = W_OUT + (size_t)D * D * 2;
constexpr size_t W_FDN = W_FGU + (size_t)NEXP * 2 * FF_E * D * 2;
constexpr size_t W_END = W_FDN + (size_t)NEXP * D * FF_E * 2;
constexpr size_t A_H = al(W_END);
constexpr size_t A_ROPE = A_H + (size_t)TH * D * 2;
constexpr size_t A_Y = A_ROPE + (size_t)TH * 64 * 4;
constexpr size_t A_P = A_Y + (size_t)4 * TH * 512 * 2;
constexpr size_t A_MIX = A_P + (size_t)TH * PW * 2;
constexpr size_t R_RKV = A_MIX;
constexpr size_t R_LOUT = R_RKV + (size_t)TH * 1536 * 2;
constexpr size_t R_O = R_LOUT + (size_t)TH * 1536 * 4;
constexpr size_t R_LIN = R_O + (size_t)TH * 512 * 4;
constexpr size_t R_REC = R_LIN + (size_t)TH * 384 * 2;
constexpr size_t R_END = R_REC + (size_t)BH * 8 * NCH * 61696;
constexpr size_t M_KR = al(R_END);
constexpr size_t M_Q = M_KR + (size_t)TH * 64 * 2;
constexpr size_t M_KV = M_Q + (size_t)TH * 768 * 2;
constexpr size_t M_VT = M_KV + (size_t)TH * 1024 * 2;
constexpr size_t M_END = M_VT + (size_t)TH * 512 * 2;
constexpr size_t G_CH = R_LIN;
constexpr size_t G_O = G_CH + al((size_t)BH * 4 * NCH * 78864);
constexpr size_t G_END = G_O + (size_t)TH * 512 * 4;
constexpr size_t S_ST = al(G_END);
constexpr size_t S_YD = S_ST + (size_t)BH * NCH * 8 * 64 * 128 * 2;
constexpr size_t S_C = S_YD + (size_t)TH * 512 * 4;
constexpr size_t S_AC = S_C + (size_t)BH * NCH * 2 * 17408;
constexpr size_t S_YO = S_AC + (size_t)TH * 8 * 4;
constexpr size_t S_END = S_YO + (size_t)TH * 512 * 4;
constexpr size_t A_Z = A_P;
constexpr size_t A_MG = A_MIX;
constexpr size_t F_ACT = A_P;
constexpr size_t F_GA = F_ACT + (size_t)MOE_ROWS * FF_E * 2;
constexpr size_t F_YE = F_GA + (size_t)MOE_ROWS * D * 2;
constexpr size_t F_TOPE = F_YE + (size_t)MOE_ROWS * D * 4;
constexpr size_t F_TOPW = F_TOPE + (size_t)TH * 2 * 4;
constexpr size_t F_SLOT = F_TOPW + (size_t)TH * 2 * 4;
constexpr size_t F_END = F_SLOT + (size_t)TH * 2 * 4;
constexpr size_t cmax(size_t a, size_t b) { return a > b ? a : b; }
constexpr size_t WS_NEED = cmax(cmax(cmax(M_END, R_END), cmax(G_END, S_END)), F_END);
#ifndef EMU
static_assert(WS_NEED <= (size_t)896 * MiB, "workspace");
#endif
constexpr int CW_BAR = 4096;
constexpr int CW_CNT = 16384;
constexpr int CW_WGC = 32768;

#ifdef EMU
#define WAVE_SYNC() emu_wave_sync()
#else
#define WAVE_SYNC() do { asm volatile("s_waitcnt lgkmcnt(0)" ::: "memory"); } while (0)
#endif
struct Frame {
    LAS unsigned char* lds; int tid, lane, wave, G, gw, NGW, bid;
    float* out; unsigned char* ws; unsigned* ctl;
};
struct Args { const float* in[39]; float* out; unsigned char* ws; int lo, hi; };
#define WSP(type, off) ((type*)(F.ws + (off)))

template <class FN>
__device__ __forceinline__ void cvt_matrix(const Frame& F, const float* W, int ldw, int K, bf16* WT, int Ndst, const float* kscale, FN srccol) {
    LAS float* scr = (LAS float*)(F.lds + F.wave * 16384);
    const int nblk = Ndst / 32, nitems = (K / 64) * nblk, lane = F.lane;
    for (int item = F.gw; item < nitems; item += F.NGW) {
        const int kb = item / nblk, nb = item % nblk, k0 = 64 * kb, n0 = 32 * nb;
        const int sc = srccol(n0 + (lane & 31));
        float wv[32];
#pragma unroll
        for (int i = 0; i < 32; ++i) { const int kk = 2 * i + (lane >> 5); wv[i] = sc >= 0 ? W[(size_t)(k0 + kk) * ldw + sc] : 0.f; }
#pragma unroll
        for (int i = 0; i < 32; ++i) { const int kk = 2 * i + (lane >> 5); float v = wv[i]; if (kscale) v *= kscale[k0 + kk]; scr[kk * 33 + (lane & 31)] = v; }
        WAVE_SYNC();
        const int c = lane & 7;
#pragma unroll
        for (int j = 0; j < 4; ++j) { const int n = (lane >> 3) + 8 * j; const LAS float* s = scr + (8 * c) * 33 + n;
            u32x4 o; o.x = pk2(s[0 * 33], s[1 * 33]); o.y = pk2(s[2 * 33], s[3 * 33]); o.z = pk2(s[4 * 33], s[5 * 33]); o.w = pk2(s[6 * 33], s[7 * 33]);
            *(u32x4*)(WT + (size_t)(n0 + n) * K + k0 + 8 * c) = o; }
        WAVE_SYNC();
    }
}
__device__ __forceinline__ void phase_convert(const Frame& F, const Args& A, int layer) {
    const float* w_in = A.in[3] + (size_t)layer * D * IN_COLS;
    cvt_matrix(F, w_in, IN_COLS, D, WSP(bf16, W_IN), PW, nullptr, [](int n) { return n < C_GATE ? n : -1; });
    cvt_matrix(F, w_in, IN_COLS, D, WSP(bf16, W_GATE), 4096, nullptr, [](int n) {
        const int pn = n >> 8, c = n & 255, bj = c >> 7, wc = (c >> 5) & 3, nn = (c >> 4) & 1, r = c & 15; return C_GATE + (2 * bj + nn) * D + 64 * pn + 16 * wc + r; });
    cvt_matrix(F, A.in[6] + (size_t)layer * 384 * 768, 768, 384, WSP(bf16, W_UQ), 768, A.in[4] + layer * 384, [](int n) { return n; });
    cvt_matrix(F, A.in[7] + (size_t)layer * 256 * 1024, 1024, 256, WSP(bf16, W_UKV), 1024, A.in[5] + layer * 256, [](int n) { return n; });
    for (int i = 0; i < 4; ++i) cvt_matrix(F, A.in[30] + ((size_t)layer * 4 + i) * 512 * D, D, 512, WSP(bf16, W_BR) + (size_t)i * D * 512, D, nullptr, [](int n) { return n; });
    cvt_matrix(F, A.in[31] + (size_t)layer * D * D, D, D, WSP(bf16, W_OUT), D, nullptr, [](int n) { return n; });
    if (layer == 0) {
        cvt_matrix(F, A.in[33], 2 * FF_D, D, WSP(bf16, W_FGU), 2 * FF_D, nullptr, [](int n) { const int pn = n >> 8, c = n & 255; return c < 128 ? 128 * pn + c : FF_D + 128 * pn + (c - 128); });
        cvt_matrix(F, A.in[34], D, FF_D, WSP(bf16, W_FDN), D, nullptr, [](int n) { return n; });
    } else {
        for (int e = 0; e < NEXP; ++e) {
            cvt_matrix(F, A.in[36] + (size_t)e * D * 2 * FF_E, 2 * FF_E, D, WSP(bf16, W_FGU) + (size_t)e * 2 * FF_E * D, 2 * FF_E, nullptr, [](int n) { const int pn = n >> 8, c = n & 255; return c < 128 ? 128 * pn + c : FF_E + 128 * pn + (c - 128); });
            cvt_matrix(F, A.in[37] + (size_t)e * FF_E * D, D, FF_E, WSP(bf16, W_FDN) + (size_t)e * D * FF_E, D, nullptr, [](int n) { return n; });
        }
    }
    { const float* w2 = A.in[10] + (size_t)layer * 64 * 512; const float* a2 = A.in[12] + (size_t)layer * 64 * 512; const float* g2 = A.in[13] + (size_t)layer * 160 * 512;
      bf16* L = WSP(bf16, W_LORA);
      for (int idx = F.bid * 512 + F.tid; idx < 1536 * 384; idx += F.G * 512) { const int n = idx / 384, k = idx % 384; float v = 0.f;
          if (n < 512) { if (k < 64) v = w2[k * 512 + n]; } else if (n < 1024) { if (k >= 64 && k < 128) v = a2[(k - 64) * 512 + (n - 512)]; } else { if (k >= 128 && k < 288) v = g2[(k - 128) * 512 + (n - 1024)]; }
          L[idx] = (bf16)f2bf(v); } }
}

template <bool ROUTER>
__device__ __forceinline__ void phase_norm(const Frame& F, const Args& A, const float* xin, const float* gain, bf16* H, const float* router, int* tope, float* topw, unsigned* cnt) {
    const int lane = F.lane;
    LAS unsigned* lcnt = (LAS unsigned*)F.lds;
    if (ROUTER) { __syncthreads(); if (F.tid < 8) lcnt[F.tid] = 0u; __syncthreads(); }
    f32x4 gv[4];
#pragma unroll
    for (int j = 0; j < 4; ++j) gv[j] = *(const f32x4*)(gain + 4 * lane + 256 * j);
    for (int m = F.gw; m < TH; m += F.NGW) {
        const float* xr = xin + (size_t)m * D; f32x4 v[4]; float ss = 0.f;
#pragma unroll
        for (int j = 0; j < 4; ++j) { v[j] = *(const f32x4*)(xr + 4 * lane + 256 * j); ss += (v[j].x * v[j].x + v[j].y * v[j].y) + (v[j].z * v[j].z + v[j].w * v[j].w); }
        const float rstd = 1.0f / sqrtf(wave_sum(ss) * (1.0f / D) + EPS);
#pragma unroll
        for (int j = 0; j < 4; ++j) { v[j] = v[j] * rstd * gv[j]; st_bf16x4(H + (size_t)m * D + 4 * lane + 256 * j, v[j]); }
        if (ROUTER) {
            float lg[8];
#pragma unroll
            for (int e = 0; e < 8; ++e) lg[e] = 0.f;
#pragma unroll
            for (int j = 0; j < 4; ++j)
#pragma unroll
                for (int q = 0; q < 4; ++q) { const float* rp = router + (size_t)(4 * lane + 256 * j + q) * 8; const f32x4 r0 = *(const f32x4*)rp, r1 = *(const f32x4*)(rp + 4); const float hv = v[j][q];
                    lg[0] += hv * r0.x; lg[1] += hv * r0.y; lg[2] += hv * r0.z; lg[3] += hv * r0.w; lg[4] += hv * r1.x; lg[5] += hv * r1.y; lg[6] += hv * r1.z; lg[7] += hv * r1.w; }
#pragma unroll
            for (int e = 0; e < 8; ++e) lg[e] = wave_sum(lg[e]);
            if (lane == 0) {
                int e1 = 0; float l1 = lg[0];
#pragma unroll
                for (int e = 1; e < 8; ++e) if (lg[e] > l1) { l1 = lg[e]; e1 = e; }
                int e2 = -1; float l2 = -3.0e38f;
#pragma unroll
                for (int e = 0; e < 8; ++e) if (e != e1 && lg[e] > l2) { l2 = lg[e]; e2 = e; }
                const float w1 = 1.0f / (1.0f + expf(l2 - l1));
                tope[2 * m] = e1; tope[2 * m + 1] = e2; topw[2 * m] = w1; topw[2 * m + 1] = 1.0f - w1;
                ATOMIC_ADD_LDS(lcnt + e1, 1u); ATOMIC_ADD_LDS(lcnt + e2, 1u);
            }
        }
    }
    if (ROUTER) { __syncthreads(); if (F.tid < 8) cnt[F.bid * 8 + F.tid] = lcnt[F.tid]; __syncthreads(); }
}
__device__ __forceinline__ void phase_rope_table(const Frame& F, const Args& A, const int* pos, float* rope) {
    for (int idx = F.bid * 512 + F.tid; idx < TH * 32; idx += F.G * 512) { const int t = idx >> 5, i = idx & 31;
        const float inv = powf(10000.0f, -(float)i / 32.0f);
        const float ang = (float)pos[t] * inv; float sn, cs; sincosf(ang, &sn, &cs);
        rope[(size_t)t * 64 + i] = cs; rope[(size_t)t * 64 + 32 + i] = sn; }
}
__device__ __forceinline__ void phase_final_norm(const Frame& F, const Args& A, float* x, const float* gain) {
    const int lane = F.lane;
    for (int m = F.gw; m < T; m += F.NGW) {
        float* xr = x + (size_t)m * D; f32x4 v[4]; float ss = 0.f;
#pragma unroll
        for (int j = 0; j < 4; ++j) { v[j] = *(const f32x4*)(xr + 4 * lane + 256 * j); ss += (v[j].x * v[j].x + v[j].y * v[j].y) + (v[j].z * v[j].z + v[j].w * v[j].w); }
        const float rstd = 1.0f / sqrtf(wave_sum(ss) * (1.0f / D) + EPS);
#pragma unroll
        for (int j = 0; j < 4; ++j) *(f32x4*)(xr + 4 * lane + 256 * j) = v[j] * rstd * *(const f32x4*)(gain + 4 * lane + 256 * j);
    }
}

__device__ __forceinline__ void phase_mla_prep(const Frame& F, const Args& A) {
    bf16* P = WSP(bf16, A_P); bf16* kr = WSP(bf16, M_KR); const float* rope = WSP(float, A_ROPE);
    const int lane = F.lane;
    for (int m = F.gw; m < TH; m += F.NGW) {
        bf16* pr = P + (size_t)m * PW; float sq = 0.f, skv = 0.f; f32x4 v[3];
#pragma unroll
        for (int j = 0; j < 3; ++j) { const int c = 4 * lane + 256 * j; v[j] = ld_bf16x4(pr + c); const float s = (v[j].x * v[j].x + v[j].y * v[j].y) + (v[j].z * v[j].z + v[j].w * v[j].w);
            if (c < 384) sq += s; else if (c < 640) skv += s; }
        sq = wave_sum(sq); skv = wave_sum(skv);
        const float rq = 1.0f / sqrtf(sq * (1.0f / 384.0f) + EPS), rkv = 1.0f / sqrtf(skv * (1.0f / 256.0f) + EPS);
#pragma unroll
        for (int j = 0; j < 3; ++j) { const int c = 4 * lane + 256 * j; if (c < 640) st_bf16x4(pr + c, v[j] * (c < 384 ? rq : rkv)); }
        if (lane < 32) { const float x1 = bf2f(pr[640 + lane]), x2 = bf2f(pr[672 + lane]), c = rope[(size_t)m * 64 + lane], s = rope[(size_t)m * 64 + 32 + lane];
            kr[(size_t)m * 64 + lane] = (bf16)f2bf(x1 * c - x2 * s); kr[(size_t)m * 64 + 32 + lane] = (bf16)f2bf(x2 * c + x1 * s); }
    }
}
__device__ __forceinline__ void phase_mla_q(const Frame& F, const Args& A) {
    pg8::Gemm g{WSP(bf16, A_P) + 0, WSP(bf16, W_UQ), PW, 384}; pg8::StaticOrder S; S.init(TH, 768, F.G, F.bid);
    EpiBf16 E{WSP(bf16, M_Q), 768, nullptr, 0}; pg8::gemm_phase(F.lds, g, S, E, F.tid);
}
struct EpiKV {
    static constexpr bool PERM = true, AFTER_DRAIN = false;
    bf16* KV; bf16* VT;
    __device__ __forceinline__ void operator()(const f32x4 (&acc)[2][2][4][2], const Unit& u, int wr, int wc, int fr, int fq) const {
        const int row0 = u.pm * 256 + wr * 64 + fr, col0 = wc * 32 + 8 * fq;
#pragma unroll
        for (int ai = 0; ai < 2; ++ai)
#pragma unroll
            for (int m = 0; m < 4; ++m) { const int row = row0 + ai * HALFT + m * 16;
                { const f32x4 v0 = acc[ai][0][m][0], v1 = acc[ai][0][m][1]; u32x4 w; w.x = pk2(v0[0], v0[1]); w.y = pk2(v0[2], v0[3]); w.z = pk2(v1[0], v1[1]); w.w = pk2(v1[2], v1[3]);
                  *(u32x4*)(KV + (size_t)row * 1024 + u.pn * 256 + col0) = w; }
                const int b = row / SEQ, t = row % SEQ; bf16* vt = VT + ((size_t)(b * 4 + u.pn) * 128 + col0) * SEQ + t;
#pragma unroll
                for (int n = 0; n < 2; ++n)
#pragma unroll
                    for (int j = 0; j < 4; ++j) vt[(size_t)(4 * n + j) * SEQ] = (bf16)f2bf(acc[ai][1][m][n][j]); }
    }
};
__device__ __forceinline__ void phase_mla_kv(const Frame& F, const Args& A) {
    pg8::Gemm g{WSP(bf16, A_P) + 384, WSP(bf16, W_UKV), PW, 256}; pg8::StaticOrder S; S.init(TH, 1024, F.G, F.bid);
    EpiKV E{WSP(bf16, M_KV), WSP(bf16, M_VT)}; pg8::gemm_phase(F.lds, g, S, E, F.tid);
}
constexpr int AT_KS = 200, AT_VS = 72;
constexpr int AT_KBYTES = 64 * AT_KS * 2, AT_VBYTES = 128 * AT_VS * 2;
__device__ __forceinline__ void phase_attention(const Frame& F, const Args& A) {
    const bf16* Q = WSP(bf16, M_Q); const bf16* KV = WSP(bf16, M_KV); const bf16* KR = WSP(bf16, M_KR); const bf16* VTg = WSP(bf16, M_VT); const float* rope = WSP(float, A_ROPE); bf16* Y = WSP(bf16, A_Y);
    const int lane = F.lane, w = F.wave, l15 = lane & 15, q4 = lane >> 4, tid = F.tid, grp = w >> 2, wq = w & 3;
    const int NQB = SEQ / 128, nunits = BH * 4 * NQB;
    const float sc2 = 0.07216878364870322f * 1.4426950408889634f;
    for (int unit = F.bid; unit < nunits; unit += F.G) {
        const int qb = NQB - 1 - (unit / (BH * 4)), bh = unit % (BH * 4), h = bh & 3, b = bh >> 2;
        const size_t t0 = (size_t)b * SEQ;
        bf16x8 qf[2][6];
#pragma unroll
        for (int f = 0; f < 2; ++f) { const size_t tq = t0 + qb * 128 + wq * 32 + 16 * f + l15;
#pragma unroll
            for (int ks = 0; ks < 6; ++ks) qf[f][ks] = *(const bf16x8*)(Q + tq * 768 + h * 192 + 32 * ks + 8 * q4);
            const bf16x8 a = qf[f][4], c2 = qf[f][5];
#pragma unroll
            for (int j = 0; j < 8; ++j) { const float x1 = bf2f((unsigned short)a[j]), x2 = bf2f((unsigned short)c2[j]), c = rope[tq * 64 + 8 * q4 + j], sn = rope[tq * 64 + 32 + 8 * q4 + j];
                qf[f][4][j] = (short)f2bf(x1 * c - x2 * sn); qf[f][5][j] = (short)f2bf(x2 * c + x1 * sn); } }
        f32x4 o[2][8];
#pragma unroll
        for (int f = 0; f < 2; ++f)
#pragma unroll
            for (int mb = 0; mb < 8; ++mb) o[f][mb] = (f32x4){0.f, 0.f, 0.f, 0.f};
        float mrow[2] = {-3.0e38f, -3.0e38f}, lrow[2] = {0.f, 0.f};
        const int qchunk = 2 * qb + (wq >> 1), ntile = 2 * qb + 2;
        u32x4 pk_[3], pv_[2];
        const int skey = tid >> 3, c8 = tid & 7;
        const int okv = skey * 1024 + 8 * c8, okr = skey * 64 + 8 * c8, ovt = skey * SEQ + 8 * c8;
        const bf16* kvb = KV + t0 * 1024 + h * 256; const bf16* krb = KR + t0 * 64; const bf16* vtb = VTg + (size_t)(b * 4 + h) * 128 * SEQ;
#define AT_LOAD(kt) do { const bf16* kv_ = kvb + (size_t)(kt) * 65536; const bf16* kr_ = krb + (size_t)(kt) * 4096; const bf16* vt_ = vtb + (size_t)(kt) * 64; \
            pk_[0] = *(const u32x4*)(kv_ + okv); pk_[1] = *(const u32x4*)(kv_ + okv + 64); pk_[2] = *(const u32x4*)(kr_ + okr); \
            pv_[0] = *(const u32x4*)(vt_ + ovt); pv_[1] = *(const u32x4*)(vt_ + ovt + 64 * SEQ); } while (0)
#define AT_STORE(bufi) do { LAS bf16* Ks_ = (LAS bf16*)(F.lds + (bufi) * (AT_KBYTES + AT_VBYTES)); LAS bf16* Vt_ = (LAS bf16*)((LAS unsigned char*)Ks_ + AT_KBYTES); \
            *(LAS u32x4*)(Ks_ + skey * AT_KS + 8 * c8) = pk_[0]; *(LAS u32x4*)(Ks_ + skey * AT_KS + 8 * c8 + 64) = pk_[1]; *(LAS u32x4*)(Ks_ + skey * AT_KS + 8 * c8 + 128) = pk_[2]; \
            *(LAS u32x4*)(Vt_ + skey * AT_VS + 8 * c8) = pv_[0]; *(LAS u32x4*)(Vt_ + (skey + 64) * AT_VS + 8 * c8) = pv_[1]; } while (0)
        __syncthreads();
        AT_LOAD(0); AT_STORE(0);
        __syncthreads();
        for (int kt = 0; kt < ntile; ++kt) {
            if (kt + 1 < ntile) AT_LOAD(kt + 1);
            if (kt <= qchunk) {
                const LAS bf16* Ks = (const LAS bf16*)(F.lds + (kt & 1) * (AT_KBYTES + AT_VBYTES)); const LAS bf16* Vt = (const LAS bf16*)((const LAS unsigned char*)Ks + AT_KBYTES);
                f32x4 st[2][2];
#pragma unroll
                for (int kb = 0; kb < 2; ++kb) { st[0][kb] = (f32x4){0.f, 0.f, 0.f, 0.f}; st[1][kb] = (f32x4){0.f, 0.f, 0.f, 0.f};
#pragma unroll
                    for (int ks = 0; ks < 6; ++ks) { const bf16x8 kf = *(const LAS bf16x8*)(Ks + (32 * grp + 16 * kb + l15) * AT_KS + 32 * ks + 8 * q4);
                        st[0][kb] = MFMA_BF16(kf, qf[0][ks], st[0][kb]); st[1][kb] = MFMA_BF16(kf, qf[1][ks], st[1][kb]); } }
                bf16x8 pb[2];
#pragma unroll
                for (int f = 0; f < 2; ++f) {
                    float mx = -3.0e38f;
#pragma unroll
                    for (int kb = 0; kb < 2; ++kb) { st[f][kb] = st[f][kb] * sc2; mx = fmaxf(mx, fmaxf(fmaxf(st[f][kb].x, st[f][kb].y), fmaxf(st[f][kb].z, st[f][kb].w))); }
                    mx = fmaxf(mx, __shfl_xor(mx, 16)); mx = fmaxf(mx, __shfl_xor(mx, 32));
                    const float mnew = fmaxf(mrow[f], mx), alpha = exp2f(mrow[f] - mnew); mrow[f] = mnew;
                    float ps = 0.f;
#pragma unroll
                    for (int kb = 0; kb < 2; ++kb)
#pragma unroll
                        for (int r = 0; r < 4; ++r) { const float p = exp2f(st[f][kb][r] - mnew); ps += p; pb[f][4 * kb + r] = (short)f2bf(p); }
                    lrow[f] = lrow[f] * alpha + ps;
#pragma unroll
                    for (int mb = 0; mb < 8; ++mb) o[f][mb] = o[f][mb] * alpha;
                }
#pragma unroll
                for (int mb = 0; mb < 8; ++mb) { const LAS bf16* vp = Vt + (16 * mb + l15) * AT_VS + 32 * grp + 4 * q4;
                    const bf16x4 v0 = *(const LAS bf16x4*)vp, v1 = *(const LAS bf16x4*)(vp + 16);
                    bf16x8 vf; vf[0] = v0[0]; vf[1] = v0[1]; vf[2] = v0[2]; vf[3] = v0[3]; vf[4] = v1[0]; vf[5] = v1[1]; vf[6] = v1[2]; vf[7] = v1[3];
                    o[0][mb] = MFMA_BF16(vf, pb[0], o[0][mb]); o[1][mb] = MFMA_BF16(vf, pb[1], o[1][mb]); }
            }
            if (kt + 1 < ntile) AT_STORE((kt + 1) & 1);
            __syncthreads();
        }
#undef AT_LOAD
#undef AT_STORE
#pragma unroll
        for (int f = 0; f < 2; ++f) { lrow[f] += __shfl_xor(lrow[f], 16); lrow[f] += __shfl_xor(lrow[f], 32); }
        LAS float* xo = (LAS float*)F.lds + (size_t)wq * (2 * 8 * 4 * 64 + 4 * 64);
        if (grp == 1) {
#pragma unroll
            for (int f = 0; f < 2; ++f) {
#pragma unroll
                for (int mb = 0; mb < 8; ++mb)
#pragma unroll
                    for (int r = 0; r < 4; ++r) xo[((f * 8 + mb) * 4 + r) * 64 + lane] = o[f][mb][r];
                xo[2 * 8 * 4 * 64 + f * 64 + lane] = mrow[f]; xo[2 * 8 * 4 * 64 + 128 + f * 64 + lane] = lrow[f]; } }
        __syncthreads();
        if (grp == 0) {
#pragma unroll
            for (int f = 0; f < 2; ++f) { const float m1 = xo[2 * 8 * 4 * 64 + f * 64 + lane], l1 = xo[2 * 8 * 4 * 64 + 128 + f * 64 + lane];
                const float m = fmaxf(mrow[f], m1), a0 = exp2f(mrow[f] - m), a1 = exp2f(m1 - m), inv = 1.0f / (lrow[f] * a0 + l1 * a1);
                const size_t tq = t0 + qb * 128 + wq * 32 + 16 * f + l15;
#pragma unroll
                for (int mb = 0; mb < 8; ++mb) { f32x4 v;
#pragma unroll
                    for (int r = 0; r < 4; ++r) v[r] = (o[f][mb][r] * a0 + xo[((f * 8 + mb) * 4 + r) * 64 + lane] * a1) * inv;
                    st_bf16x4(Y + tq * 512 + h * 128 + 16 * mb + 4 * q4, v); } } }
    }
    __syncthreads();
}

__device__ __forceinline__ f32x4 tile_bf(const LAS bf16* a, int lda, const LAS bf16* bt, int ldb, int K, f32x4 acc, int l15, int q4) {
    const LAS bf16* ap = a + l15 * lda + 8 * q4; const LAS bf16* bp = bt + l15 * ldb + 8 * q4;
#pragma unroll 4
    for (int ks = 0; ks < K / 32; ++ks) acc = MFMA_BF16(*(const LAS bf16x8*)(ap + 32 * ks), *(const LAS bf16x8*)(bp + 32 * ks), acc);
    return acc;
}
__device__ __forceinline__ f32x4 tile_mm(const LAS float* a, int lda, int ska, const LAS float* b, int ldb, int scb, int K, f32x4 acc, int l15, int q4);

__device__ __forceinline__ void phase_rwkv_prep(const Frame& F, const Args& A, int layer) {
    const bf16* P = WSP(bf16, A_P); bf16* RKV = WSP(bf16, R_RKV); bf16* LIN = WSP(bf16, R_LIN); const float* mu = A.in[8] + (size_t)layer * 1824;
    const int lane = F.lane;
    for (int m = F.gw; m < TH; m += F.NGW) {
        const bool first = (m % SEQ) == 0; const bf16* pr = P + (size_t)m * PW + C_RWKV;
#pragma unroll
        for (int j = 0; j < 8; ++j) { const int c = 4 * lane + 256 * j;
            if (c < 1824) { const f32x4 p = ld_bf16x4(pr + c); const f32x4 pv = first ? (f32x4){0.f, 0.f, 0.f, 0.f} : ld_bf16x4(pr - PW + c); const f32x4 muv = *(const f32x4*)(mu + c);
                f32x4 x = p + (pv - p) * muv;
                if (c < 1536) st_bf16x4(RKV + (size_t)m * 1536 + c, x);
                else { if (c < 1600) { x.x = tanhf(x.x); x.y = tanhf(x.y); x.z = tanhf(x.z); x.w = tanhf(x.w); }
                       else if (c >= 1664) { x.x = sigmoidf_(x.x); x.y = sigmoidf_(x.y); x.z = sigmoidf_(x.z); x.w = sigmoidf_(x.w); }
                       st_bf16x4(LIN + (size_t)m * 384 + (c - 1536), x); } } }
        if (lane < 24) st_bf16x4(LIN + (size_t)m * 384 + 288 + 4 * lane, (f32x4){0.f, 0.f, 0.f, 0.f});
    }
}
__device__ __forceinline__ void phase_rwkv_lora(const Frame& F, const Args& A) {
    pg8::Gemm g{WSP(bf16, R_LIN), WSP(bf16, W_LORA), 384, 384}; pg8::StaticOrder S; S.init(TH, 1536, F.G, F.bid);
    EpiF32 E{WSP(float, R_LOUT), 1536}; pg8::gemm_phase(F.lds, g, S, E, F.tid);
}
constexpr int RS = 72;
constexpr int RREC_COMMON = 4 * 64 * RS * 2 + 256;
constexpr int RREC_T = 64 * 64 * 2;
constexpr int RREC_BYTES = RREC_COMMON + 3 * RREC_T;
static_assert(RREC_BYTES == 61696, "record size (see R_REC in the workspace map)");
static_assert(RREC_COMMON % 16 == 0, "record alignment");
__device__ __forceinline__ void phase_rwkv_r1(const Frame& F, const Args& A, int layer) {
    const bf16* RKV = WSP(bf16, R_RKV); const float* LOUT = WSP(float, R_LOUT); unsigned char* REC = WSP(unsigned char, R_REC);
    const float* w0 = A.in[9] + layer * 512; const float* a0 = A.in[11] + layer * 512; const float* k_k = A.in[14] + layer * 512; const float* k_a = A.in[15] + layer * 512;
    LAS bf16* kbar = (LAS bf16*)F.lds; LAS bf16* atil = kbar + 64 * RS; LAS bf16* khat = atil + 64 * RS; LAS bf16* rbar = khat + 64 * RS;
    LAS bf16* atT = rbar + 64 * RS; LAS bf16* khT = atT + 64 * RS; LAS bf16* vT = khT + 64 * RS; LAS bf16* Bm = vT + 64 * RS; LAS bf16* Em = Bm + 64 * RS;
    LAS float* Am = (LAS float*)(Em + 64 * RS);
    LAS float* X = Am + 64 * 68;
    LAS float* lam = Am;
    const int tid = F.tid, lane = F.lane, w = F.wave, l15 = lane & 15, q4 = lane >> 4;
    const int nunits = BH * 8 * NCH;
    for (int unit = F.bid; unit < nunits; unit += F.G) {
        const int c = unit % NCH, h = (unit / NCH) & 7, b = unit / (NCH * 8);
        const size_t tok0 = (size_t)b * SEQ + (size_t)c * 64;
        const int j = lane, cj = h * 64 + j;
        __syncthreads();
        float r_[8], km_[8], kk_[8], ka_[8], v_[8];
        { const float w0c = w0[cj], a0c = a0[cj], kkc = k_k[cj], kac = k_a[cj];
#pragma unroll
          for (int q = 0; q < 8; ++q) { const int t = w + 8 * q; const size_t tok = tok0 + t;
              const float r = bf2f(RKV[tok * 1536 + cj]), k = bf2f(RKV[tok * 1536 + 512 + cj]); v_[q] = bf2f(RKV[tok * 1536 + 1024 + cj]);
              const float wpre = LOUT[tok * 1536 + cj], apre = LOUT[tok * 1536 + 512 + cj];
              const float wl = -softplusf_(-(w0c + wpre)) - 0.5f, a = sigmoidf_(a0c + apre);
              const float kr = k * kkc, ss = wave_sum(kr * kr), kk = kr / sqrtf(ss + EPS);
              r_[q] = r; km_[q] = k * (1.0f + (a - 1.0f) * kac); kk_[q] = kk; ka_[q] = kk * a;
              lam[t * 64 + j] = -expf(wl); } }
        __syncthreads();
        if (w == 0) { float s = 0.f; for (int t = 0; t < 64; ++t) { s += lam[t * 64 + j]; lam[t * 64 + j] = s; } }
        __syncthreads();
        { const float Lend = lam[63 * 64 + j];
#pragma unroll
          for (int q = 0; q < 8; ++q) { const int t = w + 8 * q; const float L = lam[t * 64 + j], Lm1 = t ? lam[(t - 1) * 64 + j] : 0.f;
              const float eG = expf(L), eGi = expf(-L), eGm1 = expf(Lm1), eT = expf(Lend - L);
              const float kb = kk_[q] * eGm1;
              kbar[t * RS + j] = (bf16)f2bf(kb); X[t * 132 + j] = kb;
              atil[t * RS + j] = (bf16)f2bf(ka_[q] * eGi); khat[t * RS + j] = (bf16)f2bf(km_[q] * eGi); rbar[t * RS + j] = (bf16)f2bf(r_[q] * eG);
              atT[j * RS + t] = (bf16)f2bf(-ka_[q] * eT); khT[j * RS + t] = (bf16)f2bf(km_[q] * eT); vT[j * RS + t] = (bf16)f2bf(v_[q]); }
          if (w == 0) { float* gc = (float*)(REC + (size_t)unit * RREC_BYTES + 4 * 64 * RS * 2); gc[j] = expf(Lend); } }
        __syncthreads();
        unsigned char* rec = REC + (size_t)unit * RREC_BYTES;
        for (int tt = 0; tt < 8; ++tt) { const int tile = w * 8 + tt, which = tile >> 4, ti = (tile >> 2) & 3, tj = tile & 3;
            f32x4 acc = (f32x4){0.f, 0.f, 0.f, 0.f};
            if (tj <= ti) acc = tile_bf(((which & 2) ? rbar : kbar) + 16 * ti * RS, RS, ((which & 1) ? khat : atil) + 16 * tj * RS, RS, 64, acc, l15, q4);
#pragma unroll
            for (int r = 0; r < 4; ++r) { const int i = 16 * ti + 4 * q4 + r, jj = 16 * tj + l15; const bool keep = (which & 2) ? (jj <= i) : (jj < i); const float v = keep ? acc[r] : 0.f;
                if (which == 0) Am[i * 68 + jj] = v; else if (which == 1) Bm[i * RS + jj] = (bf16)f2bf(v); else if (which == 3) Em[i * RS + jj] = (bf16)f2bf(v);
                else ((bf16*)(rec + 2 * 64 * RS * 2))[i * RS + jj] = (bf16)f2bf(-v); } }
        __syncthreads();
        for (int tt = 0; tt < 6; ++tt) { const int tile = w * 6 + tt, which = tile >> 4, ti = (tile >> 2) & 3, tj = tile & 3;
            const LAS bf16* aop = which == 0 ? Bm : which == 1 ? Em : khT;
            const f32x4 acc = tile_bf(aop + 16 * ti * RS, RS, vT + 16 * tj * RS, RS, 64, (f32x4){0.f, 0.f, 0.f, 0.f}, l15, q4);
#pragma unroll
            for (int r = 0; r < 4; ++r) { const int i = 16 * ti + 4 * q4 + r, vv = 16 * tj + l15;
                if (which == 0) X[i * 132 + 64 + vv] = acc[r];                }
            if (which) st_bf16x4((bf16*)(rec + RREC_COMMON + which * RREC_T) + (16 * tj + l15) * 64 + 16 * ti + 4 * q4, acc); }
        __syncthreads();
        for (int rb = 0; rb < 4; ++rb) {
            if (rb > 0) {
                const f32x4 acc = tile_mm(Am + 16 * rb * 68, 68, 1, X + 16 * w, 132, 1, 16 * rb, (f32x4){0.f, 0.f, 0.f, 0.f}, l15, q4);
#pragma unroll
                for (int r = 0; r < 4; ++r) X[(16 * rb + 4 * q4 + r) * 132 + 16 * w + l15] -= acc[r];
                __syncthreads();
            }
            if (tid < 128) { float x[16];
#pragma unroll
                for (int i = 0; i < 16; ++i) { float sacc = X[(16 * rb + i) * 132 + tid];
#pragma unroll
                    for (int jj = 0; jj < i; ++jj) sacc -= Am[(16 * rb + i) * 68 + 16 * rb + jj] * x[jj];
                    x[i] = sacc; }
#pragma unroll
                for (int i = 0; i < 16; ++i) X[(16 * rb + i) * 132 + tid] = x[i]; }
            __syncthreads();
        }
        { const int t = tid >> 3, j0 = 8 * (tid & 7); float v[8];
#pragma unroll
          for (int q = 0; q < 8; ++q) v[q] = X[t * 132 + j0 + q];
          *(u32x4*)((bf16*)rec + t * RS + j0) = pack8(v);
          const int vv = tid >> 3, t0 = 8 * (tid & 7);
#pragma unroll
          for (int q = 0; q < 8; ++q) v[q] = X[(t0 + q) * 132 + 64 + vv];
          *(u32x4*)((bf16*)(rec + RREC_COMMON) + vv * 64 + t0) = pack8(v); }
        for (int e = tid; e < 64 * RS / 8; e += 512) { ((u32x4*)(rec + 64 * RS * 2))[e] = ((const LAS u32x4*)rbar)[e]; ((u32x4*)(rec + 3 * 64 * RS * 2))[e] = ((const LAS u32x4*)atT)[e]; }
    }
    __syncthreads();
}
constexpr int R2_BUF = RREC_COMMON;
__device__ __forceinline__ void phase_rwkv_r2(const Frame& F, const Args& A) {
    const unsigned char* REC = WSP(unsigned char, R_REC); float* RO = WSP(float, R_O);
    LAS unsigned char* buf0 = F.lds; LAS bf16* HT = (LAS bf16*)(F.lds + 2 * R2_BUF); LAS bf16* UT = HT + 2 * 64 * RS;
    const int tid = F.tid, lane = F.lane, w = F.wave, l15 = lane & 15, q4 = lane >> 4, ti = w >> 1;
    const int nunits = BH * 8;
    constexpr int NCHK = R2_BUF / 16;
    for (int unit = F.bid; unit < nunits; unit += F.G) {
        const int h = unit & 7, b = unit >> 3;
        __syncthreads();
        for (int e = tid; e < 2 * 64 * RS / 2; e += 512) ((LAS unsigned*)HT)[e] = 0u;
        f32x4 Hreg[2] = {(f32x4){0.f, 0.f, 0.f, 0.f}, (f32x4){0.f, 0.f, 0.f, 0.f}};
        u32x4 preA[5], preB[5]; u32x2 iniA[3][2], iniB[3][2], cur[3][2];
        const unsigned char* rec0 = REC + (size_t)((b * 8 + h) * NCH) * RREC_BYTES;
        const int tofs = ((16 * (2 * (w & 1)) + l15) * 64 + 16 * ti + 4 * q4) * 2;
#define R2_LOAD(S, recp) do { _Pragma("unroll") for (int q = 0; q < 5; ++q) { const int e = tid + 512 * q; if (e < NCHK) pre##S[q] = *(const u32x4*)((recp) + (size_t)e * 16); } \
            _Pragma("unroll") for (int mq = 0; mq < 3; ++mq) { ini##S[mq][0] = *(const u32x2*)((recp) + RREC_COMMON + mq * RREC_T + tofs); ini##S[mq][1] = *(const u32x2*)((recp) + RREC_COMMON + mq * RREC_T + tofs + 16 * 64 * 2); } } while (0)
#define R2_STORE(S, dst) do { _Pragma("unroll") for (int q = 0; q < 5; ++q) { const int e = tid + 512 * q; if (e < NCHK) *(LAS u32x4*)((dst) + (size_t)e * 16) = pre##S[q]; } } while (0)
#define R2_TAKE(S) do { _Pragma("unroll") for (int mq = 0; mq < 3; ++mq) { cur[mq][0] = ini##S[mq][0]; cur[mq][1] = ini##S[mq][1]; } } while (0)
        R2_LOAD(A, rec0); R2_STORE(A, buf0); R2_TAKE(A);
        if (NCH > 1) R2_LOAD(A, rec0 + (size_t)RREC_BYTES);
        __syncthreads();
#define R2_STEP(c, LS, SS) do { \
            LAS unsigned char* buf = buf0 + ((c) & 1) * R2_BUF; LAS unsigned char* nbuf = buf0 + (((c) + 1) & 1) * R2_BUF; \
            if ((c) + 2 < NCH) R2_LOAD(LS, rec0 + (size_t)((c) + 2) * RREC_BYTES); \
            const LAS bf16* KB = (const LAS bf16*)buf; const LAS bf16* RB = KB + 64 * RS; const LAS bf16* FMn = RB + 64 * RS; const LAS bf16* ATn = FMn + 64 * RS; \
            const LAS float* GC = (const LAS float*)(buf + 4 * 64 * RS * 2); \
            const LAS bf16* H0 = HT + ((c) & 1) * 64 * RS; LAS bf16* H1 = HT + (((c) + 1) & 1) * 64 * RS; \
            _Pragma("unroll") for (int t2 = 0; t2 < 2; ++t2) { const int tj = 2 * (w & 1) + t2; \
                f32x4 u = (f32x4){bf2f(cur[0][t2].x & 0xffffu), bf2f(cur[0][t2].x >> 16), bf2f(cur[0][t2].y & 0xffffu), bf2f(cur[0][t2].y >> 16)}; \
                u = tile_bf(KB + 16 * ti * RS, RS, H0 + 16 * tj * RS, RS, 64, u, l15, q4); \
                u32x2 pk; pk.x = pk2(u[0], u[1]); pk.y = pk2(u[2], u[3]); *(LAS u32x2*)(UT + (16 * tj + l15) * RS + 16 * ti + 4 * q4) = pk; } \
            __syncthreads(); \
            _Pragma("unroll") for (int t2 = 0; t2 < 2; ++t2) { const int tj = 2 * (w & 1) + t2; \
                f32x4 o = (f32x4){bf2f(cur[1][t2].x & 0xffffu), bf2f(cur[1][t2].x >> 16), bf2f(cur[1][t2].y & 0xffffu), bf2f(cur[1][t2].y >> 16)}; \
                o = tile_bf(RB + 16 * ti * RS, RS, H0 + 16 * tj * RS, RS, 64, o, l15, q4); \
                o = tile_bf(FMn + 16 * ti * RS, RS, UT + 16 * tj * RS, RS, 64, o, l15, q4); \
                _Pragma("unroll") for (int r = 0; r < 4; ++r) RO[((size_t)b * SEQ + (size_t)(c) * 64 + 16 * ti + 4 * q4 + r) * 512 + h * 64 + 16 * tj + l15] = o[r]; \
                const f32x4 kv = (f32x4){bf2f(cur[2][t2].x & 0xffffu), bf2f(cur[2][t2].x >> 16), bf2f(cur[2][t2].y & 0xffffu), bf2f(cur[2][t2].y >> 16)}; \
                _Pragma("unroll") for (int r = 0; r < 4; ++r) Hreg[t2][r] = Hreg[t2][r] * GC[16 * ti + 4 * q4 + r] + kv[r]; \
                Hreg[t2] = tile_bf(ATn + 16 * ti * RS, RS, UT + 16 * tj * RS, RS, 64, Hreg[t2], l15, q4); \
                u32x2 pk; pk.x = pk2(Hreg[t2][0], Hreg[t2][1]); pk.y = pk2(Hreg[t2][2], Hreg[t2][3]); *(LAS u32x2*)(H1 + (16 * tj + l15) * RS + 16 * ti + 4 * q4) = pk; } \
            if ((c) + 1 < NCH) { R2_STORE(SS, nbuf); R2_TAKE(SS); } \
            __syncthreads(); } while (0)
        for (int c = 0; c < NCH; c += 2) { R2_STEP(c, B, A); R2_STEP(c + 1, A, B); }
#undef R2_STEP
#undef R2_STORE
#undef R2_TAKE
#undef R2_LOAD
    }
    __syncthreads();
}
__device__ __forceinline__ void phase_rwkv_post(const Frame& F, const Args& A, int layer) {
    const bf16* RKV = WSP(bf16, R_RKV); const float* LOUT = WSP(float, R_LOUT); const float* RO = WSP(float, R_O); bf16* Y = WSP(bf16, A_Y) + (size_t)1 * TH * 512;
    const float* a0 = A.in[11] + layer * 512; const float* k_a = A.in[15] + layer * 512; const float* r_k = A.in[16] + layer * 512; const float* ln_w = A.in[17] + layer * 512; const float* ln_b = A.in[18] + layer * 512;
    const int lane = F.lane, c0 = 8 * lane;
    for (int m = F.gw; m < TH; m += F.NGW) {
        float o[8], r[8], k[8], v[8], ap[8], g[8];
        { const f32x4 a = *(const f32x4*)(RO + (size_t)m * 512 + c0), b2 = *(const f32x4*)(RO + (size_t)m * 512 + c0 + 4); o[0] = a.x; o[1] = a.y; o[2] = a.z; o[3] = a.w; o[4] = b2.x; o[5] = b2.y; o[6] = b2.z; o[7] = b2.w; }
#pragma unroll
        for (int hh = 0; hh < 2; ++hh) { const f32x4 rv = ld_bf16x4(RKV + (size_t)m * 1536 + c0 + 4 * hh), kv = ld_bf16x4(RKV + (size_t)m * 1536 + 512 + c0 + 4 * hh), vv = ld_bf16x4(RKV + (size_t)m * 1536 + 1024 + c0 + 4 * hh);
            const f32x4 av = *(const f32x4*)(LOUT + (size_t)m * 1536 + 512 + c0 + 4 * hh), gv = *(const f32x4*)(LOUT + (size_t)m * 1536 + 1024 + c0 + 4 * hh);
#pragma unroll
            for (int q = 0; q < 4; ++q) { r[4 * hh + q] = rv[q]; k[4 * hh + q] = kv[q]; v[4 * hh + q] = vv[q]; ap[4 * hh + q] = av[q]; g[4 * hh + q] = gv[q]; } }
        float bon = 0.f, sm = 0.f;
#pragma unroll
        for (int q = 0; q < 8; ++q) { const float a = sigmoidf_(a0[c0 + q] + ap[q]); const float km = k[q] * (1.0f + (a - 1.0f) * k_a[c0 + q]); bon += r[q] * km * r_k[c0 + q]; sm += o[q]; }
        bon += __shfl_xor(bon, 1); bon += __shfl_xor(bon, 2); bon += __shfl_xor(bon, 4);
        sm += __shfl_xor(sm, 1); sm += __shfl_xor(sm, 2); sm += __shfl_xor(sm, 4);
        const float mean = sm * (1.0f / 64.0f); float vs = 0.f;
#pragma unroll
        for (int q = 0; q < 8; ++q) { const float d = o[q] - mean; vs += d * d; }
        vs += __shfl_xor(vs, 1); vs += __shfl_xor(vs, 2); vs += __shfl_xor(vs, 4);
        const float rstd = 1.0f / sqrtf(vs * (1.0f / 64.0f) + 64e-5f);
        float y[8];
#pragma unroll
        for (int q = 0; q < 8; ++q) y[q] = ((o[q] - mean) * rstd * ln_w[c0 + q] + ln_b[c0 + q] + bon * v[q]) * g[q];
        u32x4 wv; wv.x = pk2(y[0], y[1]); wv.y = pk2(y[2], y[3]); wv.z = pk2(y[4], y[5]); wv.w = pk2(y[6], y[7]);
        *(u32x4*)(Y + (size_t)m * 512 + c0) = wv;
    }
}

__device__ __forceinline__ void conv8x8(const bf16* src, int tl0  , const float* w  , int wld, const float* bias, float (&out)[8][8]) {
    float x[11][8];
#pragma unroll
    for (int i = 0; i < 11; ++i) { const int tl = tl0 - 3 + i;
        if (tl >= 0) { const u32x4 v = *(const u32x4*)(src + (ptrdiff_t)(i - 3) * PW);
            x[i][0] = bf2f(v.x & 0xffffu); x[i][1] = bf2f(v.x >> 16); x[i][2] = bf2f(v.y & 0xffffu); x[i][3] = bf2f(v.y >> 16); x[i][4] = bf2f(v.z & 0xffffu); x[i][5] = bf2f(v.z >> 16); x[i][6] = bf2f(v.w & 0xffffu); x[i][7] = bf2f(v.w >> 16); }
        else {
#pragma unroll
            for (int ch = 0; ch < 8; ++ch) x[i][ch] = 0.f; } }
    float wv[4][8], bv[8];
#pragma unroll
    for (int j = 0; j < 4; ++j) { const f32x4 a = *(const f32x4*)(w + j * wld), b = *(const f32x4*)(w + j * wld + 4); wv[j][0] = a.x; wv[j][1] = a.y; wv[j][2] = a.z; wv[j][3] = a.w; wv[j][4] = b.x; wv[j][5] = b.y; wv[j][6] = b.z; wv[j][7] = b.w; }
    if (bias) { const f32x4 a = *(const f32x4*)bias, b = *(const f32x4*)(bias + 4); bv[0] = a.x; bv[1] = a.y; bv[2] = a.z; bv[3] = a.w; bv[4] = b.x; bv[5] = b.y; bv[6] = b.z; bv[7] = b.w; }
    else {
#pragma unroll
        for (int ch = 0; ch < 8; ++ch) bv[ch] = 0.f; }
#pragma unroll
    for (int i = 0; i < 8; ++i)
#pragma unroll
        for (int ch = 0; ch < 8; ++ch) { const float a = bv[ch] + wv[0][ch] * x[i][ch] + wv[1][ch] * x[i + 1][ch] + wv[2][ch] * x[i + 2][ch] + wv[3][ch] * x[i + 3][ch]; out[i][ch] = a * fast_rcp(1.0f + fast_exp(-a)); }
}
constexpr int SB = 136;
constexpr int SC_IMG = 64 * SB * 2;
__device__ __forceinline__ void phase_ssd_s1(const Frame& F, const Args& A, int layer) {
    const bf16* P = WSP(bf16, A_P); bf16* ST = WSP(bf16, S_ST); float* YD = WSP(float, S_YD); unsigned char* SCB = WSP(unsigned char, S_C); float* AC = WSP(float, S_AC);
    const float* cw = A.in[23] + (size_t)layer * 4 * 1024; const float* cb = A.in[24] + layer * 1024; const float* dtb = A.in[25] + layer * 8; const float* a_log = A.in[26] + layer * 8; const float* dsk = A.in[27] + layer * 8;
    LAS bf16* Bt_ = (LAS bf16*)F.lds; LAS bf16* Ct_ = Bt_ + 64 * SB; LAS bf16* BT = Ct_ + 64 * SB; LAS bf16* xT = BT + 128 * RS;
    LAS bf16* Mb = xT + 4 * 64 * RS; LAS bf16* xdT = Mb + 2 * 64 * RS; LAS float* dt = (LAS float*)(xdT + 2 * 64 * RS); LAS float* ac = dt + 256;
    const int tid = F.tid, lane = F.lane, w = F.wave, l15 = lane & 15, q4 = lane >> 4;
    const int nunits = BH * NCH * 2;
    for (int unit = F.bid; unit < nunits; unit += F.G) {
        const int g = unit & 1, c = (unit >> 1) % NCH, b = unit / (2 * NCH);
        const size_t tok0 = (size_t)b * SEQ + (size_t)c * 64;
        __syncthreads();
        {
            const int cg = tid & 63, rb = tid >> 6;
            const int cidx = cg < 32 ? g * 256 + 8 * cg : cg < 48 ? 512 + g * 128 + 8 * (cg - 32) : 768 + g * 128 + 8 * (cg - 48);
            float o[8][8];
            conv8x8(P + (tok0 + 8 * rb) * PW + C_SSD + 512 + cidx, c * 64 + 8 * rb, cw + cidx, 1024, cb + cidx, o);
            if (cg < 32) {
                const int hh = cg >> 3, p0 = 8 * (cg & 7);
#pragma unroll
                for (int ch = 0; ch < 8; ++ch) { float col[8];
#pragma unroll
                    for (int i = 0; i < 8; ++i) col[i] = o[i][ch];
                    *(LAS u32x4*)(xT + (hh * 64 + p0 + ch) * RS + 8 * rb) = pack8(col); }
            } else if (cg < 48) {
                const int n0 = 8 * (cg - 32);
#pragma unroll
                for (int i = 0; i < 8; ++i) *(LAS u32x4*)(Bt_ + (8 * rb + i) * SB + n0) = pack8(o[i]);
#pragma unroll
                for (int ch = 0; ch < 8; ++ch) { float col[8];
#pragma unroll
                    for (int i = 0; i < 8; ++i) col[i] = o[i][ch];
                    *(LAS u32x4*)(BT + (n0 + ch) * RS + 8 * rb) = pack8(col); }
            } else { const int n0 = 8 * (cg - 48);
#pragma unroll
                for (int i = 0; i < 8; ++i) *(LAS u32x4*)(Ct_ + (8 * rb + i) * SB + n0) = pack8(o[i]); }
        }
        if (tid < 256) { const int hh = tid >> 6, h = 4 * g + hh; const float d = softplusf_(bf2f(P[(tok0 + lane) * PW + C_SSD + 1536 + h]) + dtb[h]); float a = -expf(a_log[h]) * d;
#pragma unroll
            for (int o = 1; o < 64; o <<= 1) { const float t = __shfl_up(a, o); if (lane >= o) a += t; }
            dt[tid] = d; ac[tid] = a; AC[(tok0 + lane) * 8 + h] = a; }
        __syncthreads();
        { unsigned char* dst = SCB + (size_t)unit * SC_IMG; for (int e = tid; e < SC_IMG / 16; e += 512) ((u32x4*)dst)[e] = ((const LAS u32x4*)Ct_)[e]; }
        f32x4 cbt[2];
#pragma unroll
        for (int tt = 0; tt < 2; ++tt) { const int tile = w * 2 + tt, ti = tile >> 2, tj = tile & 3; cbt[tt] = (f32x4){0.f, 0.f, 0.f, 0.f};
            if (tj <= ti) cbt[tt] = tile_bf(Ct_ + 16 * ti * SB, SB, Bt_ + 16 * tj * SB, SB, 128, cbt[tt], l15, q4); }
        for (int hh = 0; hh < 4; ++hh) { const int h = 4 * g + hh; LAS bf16* M = Mb + (hh & 1) * 64 * RS; LAS bf16* xd = xdT + (hh & 1) * 64 * RS; const LAS float* dth = dt + hh * 64; const LAS float* ach = ac + hh * 64;
#pragma unroll
            for (int tt = 0; tt < 2; ++tt) { const int tile = w * 2 + tt, ti = tile >> 2, tj = tile & 3;
#pragma unroll
                for (int r = 0; r < 4; ++r) { const int l = 16 * ti + 4 * q4 + r, s = 16 * tj + l15; M[l * RS + s] = (bf16)f2bf((s <= l) ? cbt[tt][r] * expf(ach[l] - ach[s]) * dth[s] : 0.f); } }
            { const int p = tid >> 3, l0 = 8 * (tid & 7); const u32x4 v = *(const LAS u32x4*)(xT + (hh * 64 + p) * RS + l0); const float a63 = ach[63]; float xv[8] = {bf2f(v.x & 0xffffu), bf2f(v.x >> 16), bf2f(v.y & 0xffffu), bf2f(v.y >> 16), bf2f(v.z & 0xffffu), bf2f(v.z >> 16), bf2f(v.w & 0xffffu), bf2f(v.w >> 16)};
#pragma unroll
              for (int i = 0; i < 8; ++i) xv[i] *= dth[l0 + i] * expf(a63 - ach[l0 + i]);
              *(LAS u32x4*)(xd + p * RS + l0) = pack8(xv); }
            __syncthreads();
#pragma unroll
            for (int tt = 0; tt < 2; ++tt) { const int tile = w * 2 + tt, ti = tile >> 2, tj = tile & 3;
                const f32x4 acc = tile_bf(M + 16 * ti * RS, RS, xT + (hh * 64 + 16 * tj) * RS, RS, 64, (f32x4){0.f, 0.f, 0.f, 0.f}, l15, q4);
                const f32x4 xs = ld_bf16x4((const bf16*)(xT + (hh * 64 + 16 * tj + l15) * RS + 16 * ti + 4 * q4));
#pragma unroll
                for (int r = 0; r < 4; ++r) YD[(tok0 + 16 * ti + 4 * q4 + r) * 512 + h * 64 + 16 * tj + l15] = acc[r] + dsk[h] * xs[r]; }
            bf16* st = ST + ((size_t)((b * NCH + c) * 8 + h)) * 64 * 128;
#pragma unroll
            for (int tt = 0; tt < 4; ++tt) { const int tile = w * 4 + tt, ti = tile >> 2, tj = tile & 3;
                const f32x4 acc = tile_bf(BT + 16 * ti * RS, RS, xd + 16 * tj * RS, RS, 64, (f32x4){0.f, 0.f, 0.f, 0.f}, l15, q4);
                st_bf16x4(st + (16 * tj + l15) * 128 + 16 * ti + 4 * q4, acc); }
        }
    }
    __syncthreads();
}
__device__ __forceinline__ void phase_ssd_s23(const Frame& F, const Args& A) {
    const bf16* ST = WSP(bf16, S_ST); float* YO = WSP(float, S_YO); const unsigned char* SCB = WSP(unsigned char, S_C); const float* AC = WSP(float, S_AC);
    LAS bf16* Cimg = (LAS bf16*)F.lds; LAS bf16* Hb = Cimg + 2 * 64 * SB;
    const int tid = F.tid, lane = F.lane, w = F.wave, l15 = lane & 15, q4 = lane >> 4;
    const int nunits = BH * 8 * 4, hp = tid >> 5, hn = 4 * (tid & 31);
    constexpr int NCK = SC_IMG / 16;
    for (int unit = F.bid; unit < nunits; unit += F.G) {
        const int ps = unit & 3, h = (unit >> 2) & 7, b = unit >> 5, g = h >> 2;
        __syncthreads();
        f32x4 Hr = (f32x4){0.f, 0.f, 0.f, 0.f};
        u32x4 preA[3], preB[3]; u32x2 pstA, pstB, stc; float eaA[5], eaB[5], eac[5];
        const size_t tokb = (size_t)b * SEQ;
#define S23_LOAD(S, cc) do { const unsigned char* src_ = SCB + (size_t)((b * NCH + (cc)) * 2 + g) * SC_IMG; \
            _Pragma("unroll") for (int q = 0; q < 3; ++q) { const int e = tid + 512 * q; if (e < NCK) pre##S[q] = *(const u32x4*)(src_ + (size_t)e * 16); } \
            pst##S = *(const u32x2*)(ST + ((size_t)((b * NCH + (cc)) * 8 + h)) * 8192 + (16 * ps + hp) * 128 + hn); \
            _Pragma("unroll") for (int r = 0; r < 4; ++r) ea##S[r] = AC[(tokb + (size_t)(cc) * 64 + 16 * (w & 3) + 4 * q4 + r) * 8 + h]; \
            ea##S[4] = AC[(tokb + (size_t)(cc) * 64 + 63) * 8 + h]; } while (0)
#define S23_STORE(S, dst) do { _Pragma("unroll") for (int q = 0; q < 3; ++q) { const int e = tid + 512 * q; if (e < NCK) ((LAS u32x4*)(dst))[e] = pre##S[q]; } } while (0)
#define S23_TAKE(S) do { stc = pst##S; _Pragma("unroll") for (int r = 0; r < 5; ++r) eac[r] = ea##S[r]; } while (0)
        S23_LOAD(A, 0); S23_STORE(A, Cimg); S23_TAKE(A);
        if (NCH > 1) S23_LOAD(A, 1);
#define S23_STEP(c, LS, SS) do { \
            const size_t tok0 = tokb + (size_t)(c) * 64; \
            if ((c) + 2 < NCH) S23_LOAD(LS, (c) + 2); \
            st_bf16x4((bf16*)(Hb + hp * SB + hn), Hr); \
            __syncthreads(); \
            if (w < 4) { const LAS bf16* Ci = Cimg + ((c) & 1) * 64 * SB; \
                const f32x4 acc = tile_bf(Ci + 16 * w * SB, SB, Hb, SB, 128, (f32x4){0.f, 0.f, 0.f, 0.f}, l15, q4); \
                _Pragma("unroll") for (int r = 0; r < 4; ++r) { const size_t tok = tok0 + 16 * w + 4 * q4 + r; YO[tok * 512 + h * 64 + 16 * ps + l15] = acc[r] * expf(eac[r]); } } \
            { const float dec = expf(eac[4]); Hr.x = dec * Hr.x + bf2f(stc.x & 0xffffu); Hr.y = dec * Hr.y + bf2f(stc.x >> 16); Hr.z = dec * Hr.z + bf2f(stc.y & 0xffffu); Hr.w = dec * Hr.w + bf2f(stc.y >> 16); } \
            if ((c) + 1 < NCH) { S23_STORE(SS, Cimg + (((c) + 1) & 1) * 64 * SB); S23_TAKE(SS); } \
            __syncthreads(); } while (0)
        for (int c = 0; c < NCH; c += 2) { S23_STEP(c, B, A); S23_STEP(c + 1, A, B); }
#undef S23_STEP
#undef S23_TAKE
#undef S23_STORE
#undef S23_LOAD
    }
    __syncthreads();
}
__device__ __forceinline__ void phase_ssd_s4(const Frame& F, const Args& A, int layer) {
    const float* YD = WSP(float, S_YD); const float* YO = WSP(float, S_YO); const bf16* P = WSP(bf16, A_P); bf16* Y = WSP(bf16, A_Y) + (size_t)3 * TH * 512; const float* nw = A.in[28] + layer * 512;
    const int lane = F.lane, c0 = 8 * lane;
    for (int m = F.gw; m < TH; m += F.NGW) {
        const f32x4 a = *(const f32x4*)(YD + (size_t)m * 512 + c0) + *(const f32x4*)(YO + (size_t)m * 512 + c0), b2 = *(const f32x4*)(YD + (size_t)m * 512 + c0 + 4) + *(const f32x4*)(YO + (size_t)m * 512 + c0 + 4);
        const f32x4 z0 = ld_bf16x4(P + (size_t)m * PW + C_SSD + c0), z1 = ld_bf16x4(P + (size_t)m * PW + C_SSD + c0 + 4);
        float y[8] = {a.x * siluf_(z0.x), a.y * siluf_(z0.y), a.z * siluf_(z0.z), a.w * siluf_(z0.w), b2.x * siluf_(z1.x), b2.y * siluf_(z1.y), b2.z * siluf_(z1.z), b2.w * siluf_(z1.w)};
        float ss = 0.f;
#pragma unroll
        for (int q = 0; q < 8; ++q) ss += y[q] * y[q];
        ss += __shfl_xor(ss, 1); ss += __shfl_xor(ss, 2); ss += __shfl_xor(ss, 4); ss += __shfl_xor(ss, 8); ss += __shfl_xor(ss, 16);
        const float rstd = 1.0f / sqrtf(ss * (1.0f / 256.0f) + EPS);
#pragma unroll
        for (int q = 0; q < 8; ++q) y[q] = y[q] * rstd * nw[c0 + q];
        u32x4 wv; wv.x = pk2(y[0], y[1]); wv.y = pk2(y[2], y[3]); wv.z = pk2(y[4], y[5]); wv.w = pk2(y[6], y[7]);
        *(u32x4*)(Y + (size_t)m * 512 + c0) = wv;
    }
}

__device__ __forceinline__ f32x4 tile_mm(const LAS float* a, int lda, int ska, const LAS float* b, int ldb, int scb, int K, f32x4 acc, int l15, int q4) {
    const LAS float* ap = a + l15 * lda + q4 * ska; const LAS float* bp = b + q4 * ldb + l15 * scb;
#pragma unroll 8
    for (int ks = 0; ks < K / 4; ++ks) acc = MFMA_F32(ap[ks * 4 * ska], bp[ks * 4 * ldb], acc);
    return acc;
}
constexpr int GS = 132, GS2 = 68;
constexpr int GR_W = 0, GR_QH = 64 * 136 * 2, GR_KT = 2 * 64 * 136 * 2, GR_QK = GR_KT + 128 * 72 * 2, GR_GL = GR_QK + 64 * 72 * 2, GR_COMMON = GR_GL + 16, GR_UT = 128 * 64 * 2, GR_BYTES = GR_COMMON + GR_UT;
static_assert(GR_BYTES == 78864 && GR_COMMON % 16 == 0, "GDN record");
constexpr int GX = 264;
__device__ __forceinline__ void phase_gdn_g1(const Frame& F, const Args& A, int layer) {
    const bf16* P = WSP(bf16, A_P); unsigned char* CHR = WSP(unsigned char, G_CH);
    const float* convw = A.in[19] + (size_t)layer * 4 * 1536; const float* a_log = A.in[20] + layer * 4; const float* dtb = A.in[21] + layer * 4;
    LAS bf16* qb = (LAS bf16*)F.lds; LAS bf16* kb = qb + 64 * SB; LAS bf16* qkimg = kb + 64 * SB;
    LAS float* X = (LAS float*)(qkimg + 64 * RS); LAS float* Lm = X + 64 * GX; LAS float* ssq = Lm + 64 * GS2;
    LAS float* beta = ssq + 2 * 64 * 16; LAS float* gc = beta + 64; LAS float* egc = gc + 64; LAS float* inorm = egc + 64;
    const int tid = F.tid, lane = F.lane, w = F.wave, l15 = lane & 15, q4 = lane >> 4;
    const int nunits = BH * 4 * NCH;
    for (int unit = F.bid; unit < nunits; unit += F.G) {
        const int c = unit % NCH, h = (unit / NCH) & 3, b = unit / (NCH * 4);
        const size_t tok0 = (size_t)b * SEQ + (size_t)c * 64;
        unsigned char* rec = CHR + (size_t)unit * GR_BYTES;
        __syncthreads();
        const int rb = tid / 48, pc = tid % 48, part = pc >> 4, cgl = pc & 15;
        float o[8][8];
        if (tid < 384) { const int col = part * 512 + h * 128 + 8 * cgl;
            conv8x8(P + (tok0 + 8 * rb) * PW + C_GDN + col, c * 64 + 8 * rb, convw + col, 1536, nullptr, o);
            if (part < 2) {
#pragma unroll
                for (int i = 0; i < 8; ++i) { float sacc = 0.f;
#pragma unroll
                    for (int ch = 0; ch < 8; ++ch) sacc += o[i][ch] * o[i][ch];
                    ssq[(part * 64 + 8 * rb + i) * 16 + cgl] = sacc; } } }
        if (w == 7) { const size_t tok = tok0 + lane; beta[lane] = sigmoidf_(bf2f(P[tok * PW + C_GDN + 1536 + h]));
            float g = -expf(a_log[h]) * softplusf_(bf2f(P[tok * PW + C_GDN + 1540 + h]) + dtb[h]);
#pragma unroll
            for (int o2 = 1; o2 < 64; o2 <<= 1) { const float t = __shfl_up(g, o2); if (lane >= o2) g += t; }
            gc[lane] = g; egc[lane] = expf(g); }
        __syncthreads();
        if (tid < 128) { float sacc = 0.f;
#pragma unroll
            for (int i = 0; i < 16; ++i) sacc += ssq[tid * 16 + i];
            inorm[tid] = (tid < 64 ? 0.08838834764831845f : 1.0f) / sqrtf(sacc + EPS); }
        __syncthreads();
        if (tid < 384) {
#pragma unroll
            for (int i = 0; i < 8; ++i) { const int l = 8 * rb + i;
                if (part < 2) { const float sc = inorm[part * 64 + l]; float v[8];
#pragma unroll
                    for (int ch = 0; ch < 8; ++ch) v[ch] = o[i][ch] * sc;
                    *(LAS u32x4*)((part ? kb : qb) + l * SB + 8 * cgl) = pack8(v); }
                else { const float bl = beta[l]; *(LAS f32x4*)(X + l * GX + 8 * cgl) = (f32x4){o[i][0] * bl, o[i][1] * bl, o[i][2] * bl, o[i][3] * bl}; *(LAS f32x4*)(X + l * GX + 8 * cgl + 4) = (f32x4){o[i][4] * bl, o[i][5] * bl, o[i][6] * bl, o[i][7] * bl}; } } }
        __syncthreads();
        for (int tt = 0; tt < 4; ++tt) { const int tile = w * 4 + tt, which = tile >> 4, ti = (tile >> 2) & 3, tj = tile & 3;
            f32x4 acc = (f32x4){0.f, 0.f, 0.f, 0.f};
            if (tj <= ti) acc = tile_bf((which ? qb : kb) + 16 * ti * SB, SB, kb + 16 * tj * SB, SB, 128, acc, l15, q4);
#pragma unroll
            for (int r = 0; r < 4; ++r) { const int i = 16 * ti + 4 * q4 + r, j = 16 * tj + l15; float v = 0.f;
                if (which ? (j <= i) : (j < i)) v = acc[r] * expf(gc[i] - gc[j]) * (which ? 1.0f : beta[i]);
                if (which) qkimg[i * RS + j] = (bf16)f2bf(v); else Lm[i * GS2 + j] = v; } }
        { const float glast = gc[63];
          for (int e = tid; e < 64 * 16; e += 512) { const int l = e >> 4, d0 = 8 * (e & 15); const u32x4 kv = *(const LAS u32x4*)(kb + l * SB + d0), qv = *(const LAS u32x4*)(qb + l * SB + d0);
              const float kf[8] = {bf2f(kv.x & 0xffffu), bf2f(kv.x >> 16), bf2f(kv.y & 0xffffu), bf2f(kv.y >> 16), bf2f(kv.z & 0xffffu), bf2f(kv.z >> 16), bf2f(kv.w & 0xffffu), bf2f(kv.w >> 16)};
              float qf[8] = {bf2f(qv.x & 0xffffu), bf2f(qv.x >> 16), bf2f(qv.y & 0xffffu), bf2f(qv.y >> 16), bf2f(qv.z & 0xffffu), bf2f(qv.z >> 16), bf2f(qv.w & 0xffffu), bf2f(qv.w >> 16)};
              const float sc = beta[l] * egc[l], eg = egc[l];
              *(LAS f32x4*)(X + l * GX + 128 + d0) = (f32x4){kf[0] * sc, kf[1] * sc, kf[2] * sc, kf[3] * sc}; *(LAS f32x4*)(X + l * GX + 132 + d0) = (f32x4){kf[4] * sc, kf[5] * sc, kf[6] * sc, kf[7] * sc};
#pragma unroll
              for (int q = 0; q < 8; ++q) qf[q] *= eg;
              *(u32x4*)(rec + GR_QH + (size_t)(l * SB + d0) * 2) = pack8(qf); }
          for (int e = tid; e < 128 * 8; e += 512) { const int d = e >> 3, l0 = 8 * (e & 7); float kt[8];
#pragma unroll
              for (int q = 0; q < 8; ++q) kt[q] = bf2f(kb[(l0 + q) * SB + d]) * expf(glast - gc[l0 + q]);
              *(u32x4*)(rec + GR_KT + (size_t)(d * RS + l0) * 2) = pack8(kt); }
          if (tid == 0) *(float*)(rec + GR_GL) = expf(glast); }
        __syncthreads();
        for (int e = tid; e < 64 * RS / 8; e += 512) ((u32x4*)(rec + GR_QK))[e] = ((const LAS u32x4*)qkimg)[e];
        for (int rbk = 0; rbk < 4; ++rbk) {
            if (rbk > 0) {
#pragma unroll
                for (int t2 = 0; t2 < 2; ++t2) { const int tj = 2 * w + t2;
                    const f32x4 acc = tile_mm(Lm + 16 * rbk * GS2, GS2, 1, X + 16 * tj, GX, 1, 16 * rbk, (f32x4){0.f, 0.f, 0.f, 0.f}, l15, q4);
#pragma unroll
                    for (int r = 0; r < 4; ++r) X[(16 * rbk + 4 * q4 + r) * GX + 16 * tj + l15] -= acc[r]; }
                __syncthreads();
            }
            if (tid < 256) { float x[16];
#pragma unroll
                for (int i = 0; i < 16; ++i) { float sacc = X[(16 * rbk + i) * GX + tid];
#pragma unroll
                    for (int j = 0; j < i; ++j) sacc -= Lm[(16 * rbk + i) * GS2 + 16 * rbk + j] * x[j];
                    x[i] = sacc; }
#pragma unroll
                for (int i = 0; i < 16; ++i) X[(16 * rbk + i) * GX + tid] = x[i]; }
            __syncthreads();
        }
        for (int e = tid; e < 64 * 16; e += 512) { const int l = e >> 4, d0 = 8 * (e & 15); const f32x4 a = *(const LAS f32x4*)(X + l * GX + 128 + d0), b2 = *(const LAS f32x4*)(X + l * GX + 132 + d0);
            const float v[8] = {a.x, a.y, a.z, a.w, b2.x, b2.y, b2.z, b2.w}; *(u32x4*)(rec + GR_W + (size_t)(l * SB + d0) * 2) = pack8(v); }
        for (int e = tid; e < 128 * 8; e += 512) { const int vv = e >> 3, t0 = 8 * (e & 7); float v[8];
#pragma unroll
            for (int q = 0; q < 8; ++q) v[q] = X[(t0 + q) * GX + vv];
            *(u32x4*)((bf16*)(rec + GR_COMMON) + vv * 64 + t0) = pack8(v); }
    }
    __syncthreads();
}
constexpr int G2_STAGE = GR_COMMON;
__device__ __forceinline__ void phase_gdn_g2(const Frame& F, const Args& A) {
    const unsigned char* CHR = WSP(unsigned char, G_CH); float* GO = WSP(float, G_O);
    LAS unsigned char* buf0 = F.lds; LAS bf16* STt = (LAS bf16*)(F.lds + 2 * G2_STAGE); LAS bf16* vnT = STt + 2 * 32 * SB;
    const int tid = F.tid, lane = F.lane, w = F.wave, l15 = lane & 15, q4 = lane >> 4, ti = w >> 1, tj = w & 1;
    const int nunits = BH * 4 * 4;
    constexpr int NCK = G2_STAGE / 16;
    for (int unit = F.bid; unit < nunits; unit += F.G) {
        const int vs = unit & 3, h = (unit >> 2) & 3, b = unit >> 4;
        __syncthreads();
        for (int e = tid; e < 2 * 32 * SB / 2; e += 512) ((LAS unsigned*)STt)[e] = 0u;
        f32x4 Sreg[2] = {(f32x4){0.f, 0.f, 0.f, 0.f}, (f32x4){0.f, 0.f, 0.f, 0.f}};
        u32x4 preA[8], preB[8]; u32x2 uiniA, uiniB, ucur;
        const unsigned char* rec0 = CHR + (size_t)((b * 4 + h) * NCH) * GR_BYTES;
        const int uofs = GR_COMMON + ((32 * vs + 16 * tj + l15) * 64 + 16 * ti + 4 * q4) * 2;
#define G2_LOAD(S, recp) do { _Pragma("unroll") for (int q = 0; q < 8; ++q) { const int e = tid + 512 * q; if (e < NCK) pre##S[q] = *(const u32x4*)((recp) + (size_t)e * 16); } uini##S = *(const u32x2*)((recp) + uofs); } while (0)
#define G2_STORE(S, dst) do { _Pragma("unroll") for (int q = 0; q < 8; ++q) { const int e = tid + 512 * q; if (e < NCK) *(LAS u32x4*)((dst) + (size_t)e * 16) = pre##S[q]; } } while (0)
        G2_LOAD(A, rec0); G2_STORE(A, buf0); ucur = uiniA;
        if (NCH > 1) G2_LOAD(A, rec0 + (size_t)GR_BYTES);
        __syncthreads();
#define G2_STEP(c, LS, SS) do { \
            LAS unsigned char* buf = buf0 + ((c) & 1) * G2_STAGE; LAS unsigned char* nbuf = buf0 + (((c) + 1) & 1) * G2_STAGE; \
            if ((c) + 2 < NCH) G2_LOAD(LS, rec0 + (size_t)((c) + 2) * GR_BYTES); \
            const LAS bf16* Wi = (const LAS bf16*)(buf + GR_W); const LAS bf16* QH = (const LAS bf16*)(buf + GR_QH); const LAS bf16* KT = (const LAS bf16*)(buf + GR_KT); const LAS bf16* QK = (const LAS bf16*)(buf + GR_QK); \
            const float egl = *(const LAS float*)(buf + GR_GL); \
            const LAS bf16* S0 = STt + ((c) & 1) * 32 * SB; LAS bf16* S1 = STt + (((c) + 1) & 1) * 32 * SB; \
            { const f32x4 acc = tile_bf(Wi + 16 * ti * SB, SB, S0 + 16 * tj * SB, SB, 128, (f32x4){0.f, 0.f, 0.f, 0.f}, l15, q4); \
              const f32x4 vn = (f32x4){bf2f(ucur.x & 0xffffu), bf2f(ucur.x >> 16), bf2f(ucur.y & 0xffffu), bf2f(ucur.y >> 16)} - acc; \
              u32x2 pk; pk.x = pk2(vn[0], vn[1]); pk.y = pk2(vn[2], vn[3]); *(LAS u32x2*)(vnT + (16 * tj + l15) * RS + 16 * ti + 4 * q4) = pk; } \
            __syncthreads(); \
            { f32x4 acc = tile_bf(QH + 16 * ti * SB, SB, S0 + 16 * tj * SB, SB, 128, (f32x4){0.f, 0.f, 0.f, 0.f}, l15, q4); \
              acc = tile_bf(QK + 16 * ti * RS, RS, vnT + 16 * tj * RS, RS, 64, acc, l15, q4); \
              _Pragma("unroll") for (int r = 0; r < 4; ++r) GO[((size_t)b * SEQ + (size_t)(c) * 64 + 16 * ti + 4 * q4 + r) * 512 + h * 128 + 32 * vs + 16 * tj + l15] = acc[r]; } \
            _Pragma("unroll") for (int t2 = 0; t2 < 2; ++t2) { Sreg[t2] = Sreg[t2] * egl; \
                Sreg[t2] = tile_bf(KT + 16 * w * RS, RS, vnT + 16 * t2 * RS, RS, 64, Sreg[t2], l15, q4); \
                u32x2 pk; pk.x = pk2(Sreg[t2][0], Sreg[t2][1]); pk.y = pk2(Sreg[t2][2], Sreg[t2][3]); *(LAS u32x2*)(S1 + (16 * t2 + l15) * SB + 16 * w + 4 * q4) = pk; } \
            if ((c) + 1 < NCH) { G2_STORE(SS, nbuf); ucur = uini##SS; } \
            __syncthreads(); } while (0)
        for (int c = 0; c < NCH; c += 2) { G2_STEP(c, B, A); G2_STEP(c + 1, A, B); }
#undef G2_STEP
#undef G2_STORE
#undef G2_LOAD
    }
    __syncthreads();
}
__device__ __forceinline__ void phase_gdn_g3(const Frame& F, const Args& A, int layer) {
    const float* GO = WSP(float, G_O); const bf16* P = WSP(bf16, A_P); bf16* Y = WSP(bf16, A_Y) + (size_t)2 * TH * 512; const float* nw = A.in[22] + layer * 128;
    const int lane = F.lane, c0 = 8 * lane;
    for (int m = F.gw; m < TH; m += F.NGW) {
        const f32x4 a = *(const f32x4*)(GO + (size_t)m * 512 + c0), b2 = *(const f32x4*)(GO + (size_t)m * 512 + c0 + 4);
        float o[8] = {a.x, a.y, a.z, a.w, b2.x, b2.y, b2.z, b2.w}; float ss = 0.f;
#pragma unroll
        for (int q = 0; q < 8; ++q) ss += o[q] * o[q];
        ss += __shfl_xor(ss, 1); ss += __shfl_xor(ss, 2); ss += __shfl_xor(ss, 4); ss += __shfl_xor(ss, 8);
        const float rstd = 1.0f / sqrtf(ss * (1.0f / 128.0f) + EPS);
        const f32x4 z0 = ld_bf16x4(P + (size_t)m * PW + C_GDN + 1544 + c0), z1 = ld_bf16x4(P + (size_t)m * PW + C_GDN + 1544 + c0 + 4);
        const float z[8] = {z0.x, z0.y, z0.z, z0.w, z1.x, z1.y, z1.z, z1.w}; float y[8];
#pragma unroll
        for (int q = 0; q < 8; ++q) y[q] = o[q] * rstd * nw[(c0 + q) & 127] * siluf_(z[q]);
        u32x4 wv; wv.x = pk2(y[0], y[1]); wv.y = pk2(y[2], y[3]); wv.z = pk2(y[4], y[5]); wv.w = pk2(y[6], y[7]);
        *(u32x4*)(Y + (size_t)m * 512 + c0) = wv;
    }
}

__device__ __forceinline__ void phase_merge_z(const Frame& F, const Args& A) {
    pg8::Gemm g{WSP(bf16, A_Y), WSP(bf16, W_BR), 512, 512}; BranchOrder S; S.nP = TH / 256; S.G = F.G; S.c = F.bid;
    EpiZ E{WSP(bf16, A_Z)}; pg8::gemm_phase(F.lds, g, S, E, F.tid);
}
__device__ __forceinline__ void phase_merge_gate(const Frame& F, const Args& A, int layer) {
    pg8::Gemm g{WSP(bf16, A_H), WSP(bf16, W_GATE), D, D}; pg8::StaticOrder S; S.init(TH, 4096, F.G, F.bid);
    EpiMerge E{WSP(bf16, A_Z), A.in[29] + (size_t)layer * 4 * D, WSP(bf16, A_MG)}; pg8::gemm_phase(F.lds, g, S, E, F.tid);
#if 1
    if (((REPEAT_MASK) >> 28) & 1u) { __syncthreads(); EpiBf16 E2{WSP(bf16, A_MIX + (size_t)64 * MiB), 4096, nullptr, 0}; pg8::gemm_phase(F.lds, g, S, E2, F.tid); }
#endif
}
__device__ __forceinline__ void phase_merge_out(const Frame& F, const Args& A, const float* xin, float* xout) {
    pg8::Gemm g{WSP(bf16, A_MG), WSP(bf16, W_OUT), D, D}; pg8::StaticOrder S; S.init(TH, D, F.G, F.bid);
    EpiResidual E{xin, xout}; pg8::gemm_phase(F.lds, g, S, E, F.tid);
}
__device__ __forceinline__ void phase_ffn_gu(const Frame& F, const Args& A) {
    pg8::Gemm g{WSP(bf16, A_H), WSP(bf16, W_FGU), D, D}; pg8::StaticOrder S; S.init(TH, 2 * FF_D, F.G, F.bid);
    EpiSwiGLU E{WSP(bf16, F_ACT), FF_D, 1 << 20}; pg8::gemm_phase(F.lds, g, S, E, F.tid);
}
__device__ __forceinline__ void phase_ffn_down(const Frame& F, const Args& A, float* x) {
    pg8::Gemm g{WSP(bf16, F_ACT), WSP(bf16, W_FDN), FF_D, FF_D}; pg8::StaticOrder S; S.init(TH, D, F.G, F.bid);
    EpiResidual E{x, x}; pg8::gemm_phase(F.lds, g, S, E, F.tid);
}
struct MoeLayout { int pstart[NEXP + 1]; };
__device__ __forceinline__ MoeLayout moe_layout(const unsigned* cnt) {
    MoeLayout L; int s = 0;
#pragma unroll
    for (int e = 0; e < NEXP; ++e) { L.pstart[e] = s; s += ((int)cnt[e] + 255) & ~255; }
    L.pstart[NEXP] = s; return L;
}
struct MoeOrder {
    int np, nN, G, c; MoeLayout L;
    __device__ bool next(int i, Unit& u) const {
        const long Lx = (long)i * G + c; if (Lx >= (long)np * nN) return false;
        const int pm = (int)(Lx / nN), pn = (int)(Lx % nN); int e = 0;
#pragma unroll
        for (int k = 1; k < NEXP; ++k) if (pm * 256 >= L.pstart[k]) e = k;
        u.pm = pm; u.pn = e * nN + pn; return true;
    }
    __device__ __forceinline__ void a_ready(const Unit&) const {}
    __device__ __forceinline__ void done(const Unit&) const {}
};
__device__ __forceinline__ void phase_moe_route(const Frame& F, const Args& A, int half) {
    const unsigned* wgc = F.ctl + CW_WGC + half * 8192; unsigned* cnt = F.ctl + CW_CNT + half * 16;
    LAS unsigned* tab = (LAS unsigned*)F.lds; LAS unsigned* tot = tab + 8192; LAS unsigned* bef = tot + 8; LAS unsigned* cur = bef + 8;
    __syncthreads();
    for (int e = F.tid; e < F.G * 8; e += 512) tab[e] = wgc[e];
    __syncthreads();
    if (F.tid < 8) { unsigned t = 0, bsum = 0; for (int g = 0; g < F.G; ++g) { const unsigned v = tab[g * 8 + F.tid]; if (g < F.bid) bsum += v; t += v; } tot[F.tid] = t; bef[F.tid] = bsum; cur[F.tid] = 0u; if (F.bid == 0) cnt[F.tid] = t; }
    __syncthreads();
    unsigned totr[8];
#pragma unroll
    for (int e = 0; e < 8; ++e) totr[e] = tot[e];
    const MoeLayout L = moe_layout(totr);
    const bf16* H = WSP(bf16, A_H); bf16* GA = WSP(bf16, F_GA); const int* tope = WSP(int, F_TOPE); int* slot = WSP(int, F_SLOT);
    const int lane = F.lane;
    for (int m = F.gw; m < TH; m += F.NGW) {
        const u32x4 v0 = *(const u32x4*)(H + (size_t)m * D + 8 * lane), v1 = *(const u32x4*)(H + (size_t)m * D + 512 + 8 * lane);
#pragma unroll
        for (int k = 0; k < 2; ++k) { const int e = tope[2 * m + k]; int s = 0;
            int ps = 0;
#pragma unroll
            for (int q = 0; q < NEXP; ++q) ps = (e == q) ? L.pstart[q] : ps;
            if (lane == 0) s = ps + (int)bef[e] + (int)ATOMIC_ADD_LDS(cur + e, 1u);
            s = __shfl(s, 0);
            if (lane == 0) slot[2 * m + k] = s;
            *(u32x4*)(GA + (size_t)s * D + 8 * lane) = v0; *(u32x4*)(GA + (size_t)s * D + 512 + 8 * lane) = v1; }
    }
#pragma unroll
    for (int e = 0; e < NEXP; ++e) { const int r0 = L.pstart[e] + (int)totr[e], r1 = L.pstart[e + 1];
        for (int r = r0 + F.gw; r < r1; r += F.NGW) { *(u32x4*)(GA + (size_t)r * D + 8 * lane) = (u32x4){0u, 0u, 0u, 0u}; *(u32x4*)(GA + (size_t)r * D + 512 + 8 * lane) = (u32x4){0u, 0u, 0u, 0u}; } }
    __syncthreads();
}
__device__ __forceinline__ void phase_moe_gu(const Frame& F, const Args& A, int half) {
    MoeOrder S; S.L = moe_layout(F.ctl + CW_CNT + half * 16); S.np = S.L.pstart[NEXP] / 256; S.nN = 2 * FF_E / 256; S.G = F.G; S.c = F.bid;
    pg8::Gemm g{WSP(bf16, F_GA), WSP(bf16, W_FGU), D, D}; EpiSwiGLU E{WSP(bf16, F_ACT), FF_E, 2 * FF_E / 256}; pg8::gemm_phase(F.lds, g, S, E, F.tid);
}
struct EpiF32Mod {
    static constexpr bool PERM = false, AFTER_DRAIN = false;
    float* C;
    __device__ __forceinline__ void operator()(const f32x4 (&acc)[2][2][4][2], const Unit& u, int wr, int wc, int fr, int fq) const {
        const int row0 = u.pm * 256 + wr * 64 + fr, col0 = (u.pn & 3) * 256 + wc * 32 + 4 * fq;
#pragma unroll
        for (int ai = 0; ai < 2; ++ai)
#pragma unroll
            for (int m = 0; m < 4; ++m) { float* rowp = C + (size_t)(row0 + ai * HALFT + m * 16) * D + col0;
#pragma unroll
                for (int bj = 0; bj < 2; ++bj)
#pragma unroll
                    for (int n = 0; n < 2; ++n) *(f32x4*)(rowp + bj * HALFT + n * 16) = acc[ai][bj][m][n]; }
    }
};
__device__ __forceinline__ void phase_moe_down(const Frame& F, const Args& A, int half) {
    MoeOrder S; S.L = moe_layout(F.ctl + CW_CNT + half * 16); S.np = S.L.pstart[NEXP] / 256; S.nN = D / 256; S.G = F.G; S.c = F.bid;
    pg8::Gemm g{WSP(bf16, F_ACT), WSP(bf16, W_FDN), FF_E, FF_E}; EpiF32Mod E{WSP(float, F_YE)}; pg8::gemm_phase(F.lds, g, S, E, F.tid);
}
__device__ __forceinline__ void phase_moe_combine(const Frame& F, const Args& A, float* x) {
    const float* YE = WSP(float, F_YE); const int* slot = WSP(int, F_SLOT); const float* topw = WSP(float, F_TOPW); const int lane = F.lane;
    for (int m = F.gw; m < TH; m += F.NGW) { const int s0 = slot[2 * m], s1 = slot[2 * m + 1]; const float w0 = topw[2 * m], w1 = topw[2 * m + 1];
#pragma unroll
        for (int j = 0; j < 4; ++j) { const int c = 4 * lane + 256 * j; float* xp = x + (size_t)m * D + c;
            *(f32x4*)xp = *(const f32x4*)xp + *(const f32x4*)(YE + (size_t)s0 * D + c) * w0 + *(const f32x4*)(YE + (size_t)s1 * D + c) * w1; } }
}

#ifndef EMU
#define XB_TMO      128
#define XB_XCNT(j)  (256  + 64 * (j))
#define XB_XSUB(j)  (1280 + 64 * (j))
#define XB_XGEN(j)  (2304 + 64 * (j))
#define XB_TOP      3328
#define XB_TOPGEN   3392
#define XCD_BAR_WORDS 3456
#define XB_SPIN_CAP (1u << 22)
__device__ __forceinline__ unsigned xb_ld(unsigned* p)              { return __hip_atomic_load(p, __ATOMIC_RELAXED, __HIP_MEMORY_SCOPE_AGENT); }
__device__ __forceinline__ unsigned xb_add(unsigned* p, unsigned v) { return __hip_atomic_fetch_add(p, v, __ATOMIC_RELAXED, __HIP_MEMORY_SCOPE_AGENT); }
__device__ __forceinline__ unsigned xb_xcc_id() { return (unsigned)__builtin_amdgcn_s_getreg((3 << 11) | 20) & 0xFu; }
#define XB_SPIN(cond, bar) do { unsigned _sp = 0; while (cond) { __builtin_amdgcn_s_sleep(1); \
    if ((++_sp & 255u) == 0u) { if (xb_ld(&(bar)[XB_TMO])) break; if (_sp > XB_SPIN_CAP) { atomicAdd(&(bar)[XB_TMO], 1u); break; } } } } while (0)
struct XcdBarrier { unsigned* bar; unsigned x; volatile LAS unsigned* st; };
__device__ __forceinline__ XcdBarrier xcd_barrier_post(unsigned* bar, volatile LAS unsigned* st) {
    XcdBarrier b; b.bar = bar; b.x = xb_xcc_id(); b.st = st;
    if (threadIdx.x == 0) (void)xb_add(&bar[XB_XCNT(b.x)], 1u);
    return b;
}
__device__ __forceinline__ void xcd_barrier_complete(unsigned* bar, unsigned x, unsigned& nloc, unsigned& nx) {
    const unsigned G = gridDim.x * gridDim.y * gridDim.z;
    unsigned sum, cnt, mine, sp = 0u;
    for (;;) {
        sum = 0u; cnt = 0u; mine = 0u;
#pragma unroll
        for (unsigned j = 0; j < 16; ++j) { const unsigned c = xb_ld(&bar[XB_XCNT(j)]); sum += c; cnt += (c > 0u) ? 1u : 0u; mine = (j == x) ? c : mine; }
        if (sum == G) break;
        __builtin_amdgcn_s_sleep(1);
        if ((++sp & 255u) == 0u) { if (xb_ld(&bar[XB_TMO])) break; if (sp > XB_SPIN_CAP) { atomicAdd(&bar[XB_TMO], 1u); break; } }
    }
    nloc = mine > 0u ? mine : 1u; nx = cnt > 0u ? cnt : 1u;
}
__device__ __forceinline__ void xcd_barrier(const XcdBarrier& b) {
    asm volatile("s_waitcnt vmcnt(0)" ::: "memory");
    __syncthreads();
    if (threadIdx.x == 0) {
        unsigned* bar = b.bar;
        __builtin_amdgcn_s_waitcnt(0);
        unsigned nloc = b.st[0], nx = b.st[1];
        if (nloc == 0u) { xcd_barrier_complete(bar, b.x, nloc, nx); b.st[0] = nloc; b.st[1] = nx; }
        const unsigned old = xb_add(&bar[XB_XSUB(b.x)], 1u);
        const unsigned gen = old / nloc;
        if (old + 1u == (gen + 1u) * nloc) {
            __builtin_amdgcn_fence(__ATOMIC_RELEASE, "agent");
            asm volatile("s_waitcnt vmcnt(0)" ::: "memory");
            const unsigned og = xb_add(&bar[XB_TOP], 1u);
            const unsigned tg = og / nx;
            if (og + 1u == (tg + 1u) * nx) xb_add(&bar[XB_TOPGEN], 1u);
            else XB_SPIN(xb_ld(&bar[XB_TOPGEN]) == tg, bar);
            __builtin_amdgcn_fence(__ATOMIC_ACQUIRE, "agent");
            xb_add(&bar[XB_XGEN(b.x)], 1u);
            asm volatile("s_waitcnt vmcnt(0)" ::: "memory");
        } else {
            XB_SPIN(xb_ld(&bar[XB_XGEN(b.x)]) == gen, bar);
            __builtin_amdgcn_fence(__ATOMIC_ACQUIRE, "agent");
            asm volatile("s_waitcnt vmcnt(0)" ::: "memory");
        }
    }
    __syncthreads();
}
#endif

constexpr int NPH = 17;
constexpr int NPHASES = DEPTH * (1 + NHALF * NPH) + 1;
constexpr int LDS_BYTES = 155648, MISC_OFF = 154624;

__global__ void __launch_bounds__(512, 2) fwd_kernel(Args args_k) {
#ifdef EMU
    unsigned char* lds = emu_lds_ptr;
#else
    extern __shared__ __attribute__((aligned(16))) unsigned char lds[];
#endif
    Frame F0;
    F0.lds = (LAS unsigned char*)lds; F0.tid = threadIdx.x; F0.lane = F0.tid & 63; F0.wave = RFL(F0.tid >> 6); F0.G = gridDim.x; F0.bid = blockIdx.x;
    F0.gw = F0.bid * 8 + F0.wave; F0.NGW = F0.G * 8;
    F0.out = args_k.out; F0.ws = args_k.ws; F0.ctl = (unsigned*)(args_k.ws + WS_CTL);
    const int lo = args_k.lo, hi = args_k.hi;
#ifndef EMU
    volatile LAS unsigned* misc = (volatile LAS unsigned*)(F0.lds + MISC_OFF);
    if (F0.tid < 4) misc[F0.tid] = 0u;
    __syncthreads();
    XcdBarrier bar; bar.bar = F0.ctl + CW_BAR; bar.x = 0; bar.st = misc;
    if (hi - lo > 1) bar = xcd_barrier_post(F0.ctl + CW_BAR, misc);
#define GRID_BAR() do { XcdBarrier bq = bar; asm volatile("" : "+s"(bq.bar), "+s"(bq.x)); xcd_barrier(bq); } while (0)
#else
#define GRID_BAR() do { } while (0)
#endif
    int ph = 0;
#ifndef PH_MASK
#define PH_MASK 0xFFFFFFFFFFFFFFFFull
#endif
#define PHASE(...) PHASE_I(31, __VA_ARGS__)
#ifdef EMU
#define LAUNDER(Fq) do { } while (0)
#else
#define LAUNDER(Fq) do { unsigned mq_ = ~0u; asm volatile("" : "+s"(Fq.G), "+s"(Fq.bid), "+s"(Fq.wave), "+s"(Fq.ws), "+s"(Fq.out), "+s"(Fq.ctl), "+s"(mq_)); Fq.lane = (int)__builtin_amdgcn_mbcnt_hi(mq_, __builtin_amdgcn_mbcnt_lo(mq_, 0u)); Fq.tid = Fq.wave * 64 + Fq.lane; Fq.gw = Fq.bid * 8 + Fq.wave; Fq.NGW = Fq.G * 8; } while (0)
#endif
#ifdef EMU
#define ARGS_Q() const Args& args_q = args_k
#else
#define ARGS_Q() const __attribute__((address_space(4))) Args* aq_ = (const __attribute__((address_space(4))) Args*)__builtin_amdgcn_kernarg_segment_ptr(); asm volatile("" : "+s"(aq_)); const Args& args_q = *(const Args*)aq_
#endif
#define PHASE_I(kind, ...) do { if (ph >= lo && ph < hi) { constexpr int reps_ = (((REPEAT_MASK) >> (kind)) & 1u) ? 2 : 1; for (int rr_ = 0; rr_ < reps_; ++rr_) { { Frame Fq = F0; LAUNDER(Fq); const Frame& F = Fq; ARGS_Q(); const Args& args = args_q; __VA_ARGS__; } if (rr_ + 1 < reps_ || ph + 1 < hi) { GRID_BAR(); if (((REPEAT_MASK) >> 26) & 1u) GRID_BAR(); } } } ++ph; } while (0)
#define PHASEK(kind, ...) PHASE_I(kind, __VA_ARGS__)
#define SEGMENT(layer, half) do { \
            const size_t r0 = (size_t)(half) * TH; \
            const float* xin = ((layer) == 0 ? args_k.in[0] : F0.out) + r0 * D; float* xo = F0.out + r0 * D; \
            PHASEK(0, phase_norm<false>(F, args, xin, args.in[2] + (layer) * D, WSP(bf16, A_H), nullptr, nullptr, nullptr, nullptr); phase_rope_table(F, args, (const int*)args.in[1] + r0, WSP(float, A_ROPE))); \
            PHASEK(1, { pg8::Gemm g{WSP(bf16, A_H), WSP(bf16, W_IN), D, D}; pg8::StaticOrder S; S.init(TH, PW, F.G, F.bid); EpiBf16 E{WSP(bf16, A_P), PW, nullptr, 0}; pg8::gemm_phase(F.lds, g, S, E, F.tid); }); \
            PHASEK(2, phase_mla_prep(F, args); phase_rwkv_prep(F, args, layer)); \
            PHASEK(3, phase_mla_q(F, args); __syncthreads(); phase_mla_kv(F, args); __syncthreads(); phase_rwkv_lora(F, args)); \
            PHASEK(8, phase_rwkv_r1(F, args, layer)); \
            PHASEK(5, { const int ns_ = F.G >= 64 ? 32 : (F.G >= 4 ? F.G / 4 : 0); Frame Fa = F;        \
                        if (F.bid < ns_) { Fa.G = ns_; Fa.NGW = ns_ * 8; phase_rwkv_r2(Fa, args); } else { Fa.bid = F.bid - ns_; Fa.G = F.G - ns_; Fa.gw = Fa.bid * 8 + Fa.wave; Fa.NGW = Fa.G * 8; phase_attention(Fa, args); if (ns_ == 0) phase_rwkv_r2(F, args); } }); \
            PHASEK(9, phase_rwkv_post(F, args, layer); phase_gdn_g1(F, args, layer); phase_ssd_s1(F, args, layer)); \
            PHASEK(11, { const int ns_ = F.G >= 4 ? F.G / 2 : 0; Frame Fa = F;                               \
                        if (F.bid < ns_) { Fa.G = ns_; Fa.NGW = ns_ * 8; phase_gdn_g2(Fa, args); } else { Fa.bid = F.bid - ns_; Fa.G = F.G - ns_; Fa.gw = Fa.bid * 8 + Fa.wave; Fa.NGW = Fa.G * 8; phase_ssd_s23(Fa, args); if (ns_ == 0) phase_gdn_g2(F, args); } }); \
            PHASEK(12, phase_gdn_g3(F, args, layer); phase_ssd_s4(F, args, layer)); \
            PHASEK(17, phase_merge_z(F, args)); \
            PHASEK(18, phase_merge_gate(F, args, layer)); \
            PHASEK(19, phase_merge_out(F, args, xin, xo)); \
            if ((layer) == 0) { \
                PHASEK(20, phase_norm<false>(F, args, xo, args.in[32] + (layer) * D, WSP(bf16, A_H), nullptr, nullptr, nullptr, nullptr)); \
                PHASEK(21, phase_ffn_gu(F, args)); \
                PHASE(phase_ffn_down(F, args, xo)); \
                PHASE((void)0); \
                PHASE((void)0); \
            } else { \
                PHASE(phase_norm<true>(F, args, xo, args.in[32] + (layer) * D, WSP(bf16, A_H), args.in[35], WSP(int, F_TOPE), WSP(float, F_TOPW), F.ctl + CW_WGC + (half) * 8192)); \
                PHASE(phase_moe_route(F, args, half)); \
                PHASEK(22, phase_moe_gu(F, args, half)); \
                PHASEK(23, phase_moe_down(F, args, half)); \
                PHASE(phase_moe_combine(F, args, xo)); \
            } } while (0)
    static_assert(DEPTH == 2 && NHALF <= 2, "segment program");
    PHASEK(27, phase_convert(F, args, 0));
    SEGMENT(0, 0);
    if (NHALF == 2) SEGMENT(0, 1);
    PHASEK(27, phase_convert(F, args, 1));
    SEGMENT(1, 0);
    if (NHALF == 2) SEGMENT(1, 1);
#undef SEGMENT
    PHASE(phase_final_norm(F, args, F.out, args.in[38]));
#undef PHASE
}

#ifndef ONE_LAUNCH
#define ONE_LAUNCH 1
#endif
extern "C" void kernel_launch(void* const* d_in, const int* in_sizes, int n_in, void* d_out, int out_size, void* d_ws, size_t ws_size, hipStream_t stream) {
    static int grid = 0;
    if (grid == 0) {
#ifdef EMU
        grid = EMU_GRID;
#else
        if (n_in != 39 || out_size != T * D || ws_size < WS_NEED) { fprintf(stderr, "kernel_launch: unexpected problem (n_in %d out %d ws %zu need %zu)\n", n_in, out_size, ws_size, (size_t)WS_NEED); grid = -1; return; }
        int dev = 0, cus = 0;
        if (hipGetDevice(&dev) != hipSuccess || hipDeviceGetAttribute(&cus, hipDeviceAttributeMultiprocessorCount, dev) != hipSuccess) { grid = -1; return; }
        if (hipFuncSetAttribute((const void*)fwd_kernel, hipFuncAttributeMaxDynamicSharedMemorySize, LDS_BYTES) != hipSuccess) { fprintf(stderr, "kernel_launch: hipFuncSetAttribute failed\n"); grid = -1; return; }
        int per_cu = 0;
        if (hipOccupancyMaxActiveBlocksPerMultiprocessor(&per_cu, (const void*)fwd_kernel, 512, LDS_BYTES) != hipSuccess || per_cu < 1) fprintf(stderr, "kernel_launch: occupancy query reports %d\n", per_cu);
        (void)hipGetLastError();
        grid = cus;
#endif
    }
    if (grid < 0) return;
    (void)hipMemsetAsync((char*)d_ws + WS_CTL, 0, CTL_BYTES, stream);
    Args a{};
    for (int i = 0; i < 39; ++i) a.in[i] = (const float*)d_in[i];
    a.out = (float*)d_out; a.ws = (unsigned char*)d_ws;
#ifdef EMU
    for (int p = EMU_PH_LO; p < EMU_PH_HI && p < NPHASES; ++p) { a.lo = p; a.hi = p + 1; emu_launch(fwd_kernel, grid, 512, a); emu_after_phase(p); }
#else
#if ONE_LAUNCH
    a.lo = 0; a.hi = NPHASES;
    hipLaunchKernelGGL(fwd_kernel, dim3(grid), dim3(512), LDS_BYTES, stream, a);
#else
    for (int p = 0; p < NPHASES; ++p) { a.lo = p; a.hi = p + 1; hipLaunchKernelGGL(fwd_kernel, dim3(grid), dim3(512), LDS_BYTES, stream, a); }
#endif
#endif
}
```

```cpp
#ifndef EMU
#include <hip/hip_runtime.h>
#include <cstdio>
#include <cstdint>
#endif

#ifndef REPEAT_MASK
#define REPEAT_MASK 0u
#endif
#ifdef EMU
constexpr int BATCH = EMU_B, SEQ = EMU_S, NHALF = EMU_NHALF;
#else
constexpr int BATCH = 16, SEQ = 2048, NHALF = 2;
#endif
constexpr int D = 1024, DEPTH = 2, CH = 64;
constexpr int T = BATCH * SEQ, TH = T / NHALF, BH = BATCH / NHALF, NCH = SEQ / CH;
constexpr int C_MLA = 0, C_RWKV = 704, C_GDN = 2528, C_SSD = 4584, C_GATE = 6128, IN_COLS = 10224, PW = 6144;
constexpr int FF_D = 2816, FF_E = 3584, NEXP = 8;
constexpr int MOE_ROWS = ((TH * 2 + NEXP * 255) / 256) * 256;
constexpr float EPS = 1e-6f;
static_assert(TH % 256 == 0 && SEQ % 128 == 0 && BATCH % NHALF == 0 && (SEQ / 64) % 2 == 0, "shape");

typedef unsigned short bf16;
typedef float f32x4 __attribute__((ext_vector_type(4)));
typedef float f32x2 __attribute__((ext_vector_type(2)));
typedef short bf16x8 __attribute__((ext_vector_type(8)));
typedef short bf16x4 __attribute__((ext_vector_type(4)));
typedef unsigned u32x4 __attribute__((ext_vector_type(4)));
typedef unsigned u32x2 __attribute__((ext_vector_type(2)));
#ifdef EMU
#define LAS
#define GAS
#define MFMA_F32(a, b, c) emu_mfma_16x16x4f32(a, b, c)
#define MFMA_BF16(a, b, c) emu_mfma_16x16x32bf16(a, b, c)
#define ATOMIC_ADD_U32(p, v) emu_atomic_add_u32(p, v)
#define ATOMIC_ADD_LDS(p, v) emu_atomic_add_u32((unsigned*)(p), v)
#define RFL(x) (x)
#define LDS_WAIT()
#define VM_WAIT()
__device__ __forceinline__ float fast_exp(float x) { return expf(x); }
__device__ __forceinline__ float fast_rcp(float x) { return 1.0f / x; }
__device__ __forceinline__ float fast_rsqrt(float x) { return 1.0f / sqrtf(x); }
#else
#define LAS __attribute__((address_space(3)))
#define GAS __attribute__((address_space(1)))
#define MFMA_F32(a, b, c) __builtin_amdgcn_mfma_f32_16x16x4f32(a, b, c, 0, 0, 0)
#define MFMA_BF16(a, b, c) __builtin_amdgcn_mfma_f32_16x16x32_bf16(a, b, c, 0, 0, 0)
#define ATOMIC_ADD_U32(p, v) __hip_atomic_fetch_add(p, v, __ATOMIC_RELAXED, __HIP_MEMORY_SCOPE_AGENT)
#define ATOMIC_ADD_LDS(p, v) __hip_atomic_fetch_add((LAS unsigned*)(p), v, __ATOMIC_RELAXED, __HIP_MEMORY_SCOPE_WORKGROUP)
#define RFL(x) __builtin_amdgcn_readfirstlane(x)
#define LDS_WAIT() asm volatile("s_waitcnt lgkmcnt(0)" ::: "memory")
#define VM_WAIT() asm volatile("s_waitcnt vmcnt(0)" ::: "memory")
__device__ __forceinline__ float fast_exp(float x) { return __expf(x); }
__device__ __forceinline__ float fast_rcp(float x) { return __builtin_amdgcn_rcpf(x); }
__device__ __forceinline__ float fast_rsqrt(float x) { return __builtin_amdgcn_rsqf(x); }
#endif
__device__ __forceinline__ unsigned f2u(float f) { return __builtin_bit_cast(unsigned, f); }
__device__ __forceinline__ float u2f(unsigned u) { return __builtin_bit_cast(float, u); }
__device__ __forceinline__ unsigned f2bf(float f) { unsigned u = f2u(f); return (u + 0x7fffu + ((u >> 16) & 1u)) >> 16; }
__device__ __forceinline__ float bf2f(unsigned h) { return u2f(h << 16); }
__device__ __forceinline__ unsigned pk2(float lo, float hi) { return f2bf(lo) | (f2bf(hi) << 16); }
__device__ __forceinline__ float sigmoidf_(float x) { return 1.0f / (1.0f + expf(-x)); }
__device__ __forceinline__ float siluf_(float x) { return x / (1.0f + expf(-x)); }
__device__ __forceinline__ float softplusf_(float x) { return x > 20.f ? x : log1pf(expf(x)); }
__device__ __forceinline__ float wave_sum(float v) {
#pragma unroll
    for (int o = 1; o < 64; o <<= 1) v += __shfl_xor(v, o);
    return v;
}
__device__ __forceinline__ float wave_max(float v) {
#pragma unroll
    for (int o = 1; o < 64; o <<= 1) v = fmaxf(v, __shfl_xor(v, o));
    return v;
}
__device__ __forceinline__ f32x4 ld_bf16x4(const bf16* p) { const u32x2 w = *(const u32x2*)p; return (f32x4){bf2f(w.x & 0xffffu), bf2f(w.x >> 16), bf2f(w.y & 0xffffu), bf2f(w.y >> 16)}; }
__device__ __forceinline__ void st_bf16x4(bf16* p, f32x4 v) { u32x2 w; w.x = pk2(v.x, v.y); w.y = pk2(v.z, v.w); *(u32x2*)p = w; }
__device__ __forceinline__ u32x4 pack8(const float* v) { u32x4 o; o.x = pk2(v[0], v[1]); o.y = pk2(v[2], v[3]); o.z = pk2(v[4], v[5]); o.w = pk2(v[6], v[7]); return o; }

namespace pg8 {
#define PG8_LAS LAS
typedef unsigned short bf16_t;
constexpr int BM = 256, BK = 64, HALF = 128, HTB = HALF * BK * 2, STAGE_BYTES = 8 * HTB, NXCD = 8, WGM = 8;
__host__ __device__ __forceinline__ int lds_byte(int r, int c) { const int st = (r >> 4) * 2 + (c >> 5), rr = r & 15, cc = c & 31, ob = rr * 64 + cc * 2; return st * 1024 + (ob ^ (((ob >> 9) & 1) << 5)); }
__host__ __device__ __forceinline__ void stage_rc(int b, int& R, int& C) { const int st = b / 1024, sb = b % 1024, swz = sb ^ (((sb >> 9) & 1) << 5); R = (st >> 1) * 16 + swz / 64; C = (st & 1) * 32 + (swz % 64) / 2; }
__host__ __device__ __forceinline__ int perm32(int rho) { const int n = rho >> 4, i = rho & 15; return 8 * (i >> 2) + 4 * n + (i & 3); }
struct Unit { int pm, pn; };
struct Gemm { const bf16_t* A; const bf16_t* Bt; int lda, K; };
struct StaticOrder {
    int nM, nN, nwg, G, c;
    __host__ __device__ void init(int M, int N, int G_, int c_) { nM = M / BM; nN = N / BM; nwg = nM * nN; G = G_; c = c_; }
    __host__ __device__ bool next(int i, Unit& u) const {
        const long L = (long)i * G + c; if (L >= nwg) return false;
        int wgid = (int)L; { const int q = nwg / NXCD, r = nwg % NXCD, xcd = wgid % NXCD, off = wgid / NXCD; wgid = (xcd < r ? xcd * (q + 1) : r * (q + 1) + (xcd - r) * q) + off; }
        const int nig = WGM * nN, gid = wgid / nig, fm = gid * WGM, gsz = (nM - fm) < WGM ? (nM - fm) : WGM;
        u.pm = fm + ((wgid % nig) % gsz); u.pn = (wgid % nig) / gsz; return true;
    }
    __device__ __forceinline__ void a_ready(const Unit&) const {}
    __device__ __forceinline__ void done(const Unit&) const {}
};
#ifndef EMU
template <class Epi, class Sched>
__device__ __forceinline__ void gemm_phase(PG8_LAS unsigned char* lds, const Gemm g, const Sched& S, const Epi& E, const int tid) {
    const int wid = __builtin_amdgcn_readfirstlane(tid >> 6), lane = tid & 63, wr = wid >> 2, wc = wid & 3, fr = lane & 15, fq = lane >> 4;
    int Kq = g.K; asm volatile("" : "+s"(Kq));
    const int K = Kq, nt = K / BK, lda = g.lda;
    unsigned voffA[2], voffB[2];
#pragma unroll
    for (int i = 0; i < 2; ++i) { int R, C; stage_rc(tid * 16 + i * 8192, R, C); const int Rb = Epi::PERM ? ((R & ~31) + perm32(R & 31)) : R;
        voffA[i] = (unsigned)(R * lda + C) * 2u; voffB[i] = (unsigned)(Rb * K + C) * 2u; }
    const size_t kstep = (size_t)(BK * 2);
    const size_t hstep = (size_t)HALF * K * 2, hstepA = (size_t)HALF * lda * 2;
    const size_t tstep = 2 * hstep, tstepA = 2 * hstepA;
    const unsigned ldsw = (unsigned)wid * 1024u;
    const int aoff = lds_byte(wr * 64 + fr, fq * 8), boff = lds_byte(wc * 32 + fr, fq * 8);
#define PG8_SA(b, h) (((b) * 2 + (h)) * HTB)
#define PG8_SB(b, h) ((4 + (b) * 2 + (h)) * HTB)
#define PG8_STAGE(bufoff, gbase, voff) do { _Pragma("unroll") for (int _i = 0; _i < 2; ++_i) \
        __builtin_amdgcn_global_load_lds((const unsigned*)((const char*)(gbase) + (voff)[_i]), (PG8_LAS unsigned*)(lds + (bufoff) + ldsw + _i * 8192), 16, 0, 0); } while (0)
#define PG8_LDA(dst, b, h) do { _Pragma("unroll") for (int m = 0; m < 4; ++m) _Pragma("unroll") for (int k = 0; k < 2; ++k) dst[m][k] = *(const PG8_LAS bf16x8*)(lds + PG8_SA(b, h) + aoff + m * 2048 + k * 1024); } while (0)
#define PG8_LDB(dst, b, h) do { _Pragma("unroll") for (int n = 0; n < 2; ++n) _Pragma("unroll") for (int k = 0; k < 2; ++k) dst[n][k] = *(const PG8_LAS bf16x8*)(lds + PG8_SB(b, h) + boff + n * 2048 + k * 1024); } while (0)
#define PG8_MMA(ai, bj, At, Bt) do { __builtin_amdgcn_s_setprio(1); _Pragma("unroll") for (int m = 0; m < 4; ++m) _Pragma("unroll") for (int n = 0; n < 2; ++n) _Pragma("unroll") for (int k = 0; k < 2; ++k) \
        acc[ai][bj][m][n] = __builtin_amdgcn_mfma_f32_16x16x32_bf16(Bt[n][k], At[m][k], acc[ai][bj][m][n], 0, 0, 0); __builtin_amdgcn_s_setprio(0); } while (0)
#define PG8_WAIT_V(n) asm volatile("s_waitcnt vmcnt(" #n ")" ::: "memory")
#define PG8_WAIT_L(n) asm volatile("s_waitcnt lgkmcnt(" #n ")" ::: "memory")
#define PG8_BAR __builtin_amdgcn_s_barrier()
#define PG8_SCHED __builtin_amdgcn_sched_barrier(0)
    Unit cur, nxt; int ui = 0;
    if (!S.next(0, cur)) return;
    f32x4 acc[2][2][4][2];
#pragma unroll
    for (int a = 0; a < 2; ++a)
#pragma unroll
        for (int b = 0; b < 2; ++b)
#pragma unroll
            for (int m = 0; m < 4; ++m)
#pragma unroll
                for (int n = 0; n < 2; ++n) acc[a][b][m][n] = (f32x4){0.f, 0.f, 0.f, 0.f};
    bf16x8 At[4][2], B0[2][2], B1[2][2];
    const char* cA = (const char*)g.A + (size_t)cur.pm * tstepA; const char* cB = (const char*)g.Bt + (size_t)cur.pn * tstep;
    S.a_ready(cur);
    PG8_STAGE(PG8_SB(0, 0), cB, voffB); PG8_STAGE(PG8_SA(0, 0), cA, voffA); PG8_STAGE(PG8_SB(0, 1), cB + hstep, voffB); PG8_STAGE(PG8_SA(0, 1), cA + hstepA, voffA);
    if (wr == 1) PG8_BAR;
    PG8_WAIT_V(4); PG8_BAR;
    PG8_STAGE(PG8_SB(1, 0), cB + kstep, voffB); PG8_STAGE(PG8_SA(1, 0), cA + kstep, voffA); PG8_STAGE(PG8_SB(1, 1), cB + hstep + kstep, voffB);
    PG8_WAIT_V(6); PG8_BAR;
    for (;;) {
        const bool has_next = S.next(ui + 1, nxt);
        const char* nA = has_next ? (const char*)g.A + (size_t)nxt.pm * tstepA : cA; const char* nB = has_next ? (const char*)g.Bt + (size_t)nxt.pn * tstep : cB;
        for (int t = 0; t < nt; t += 2) {
            const bool last = (t == nt - 2);
            const char* a1 = cA + (size_t)(t + 1) * kstep;
            const char* a2 = last ? nA : cA + (size_t)(t + 2) * kstep; const char* b2 = last ? nB : cB + (size_t)(t + 2) * kstep;
            const char* a3 = a2 + kstep; const char* b3 = b2 + kstep;
            if (last && has_next) S.a_ready(nxt);
            PG8_LDB(B0, 0, 0); PG8_SCHED; PG8_LDA(At, 0, 0); PG8_STAGE(PG8_SA(1, 1), a1 + hstepA, voffA);
            PG8_WAIT_L(8); PG8_BAR; PG8_WAIT_L(0); PG8_MMA(0, 0, At, B0); PG8_BAR; PG8_SCHED;
            PG8_LDB(B1, 0, 1); PG8_STAGE(PG8_SB(0, 0), b2, voffB);
            PG8_BAR; PG8_WAIT_L(0); PG8_MMA(0, 1, At, B1); PG8_BAR;
            PG8_LDA(At, 0, 1); PG8_STAGE(PG8_SA(0, 0), a2, voffA);
            PG8_BAR; PG8_WAIT_L(0); PG8_MMA(1, 0, At, B0); PG8_BAR; PG8_SCHED;
            PG8_STAGE(PG8_SB(0, 1), b2 + hstep, voffB);
            PG8_WAIT_V(6); PG8_BAR; PG8_MMA(1, 1, At, B1); PG8_BAR;
            PG8_LDB(B0, 1, 0); PG8_SCHED; PG8_LDA(At, 1, 0); PG8_STAGE(PG8_SA(0, 1), a2 + hstepA, voffA);
            PG8_WAIT_L(8); PG8_BAR; PG8_WAIT_L(0); PG8_MMA(0, 0, At, B0); PG8_BAR; PG8_SCHED;
            PG8_LDB(B1, 1, 1); PG8_STAGE(PG8_SB(1, 0), b3, voffB);
            PG8_BAR; PG8_WAIT_L(0); PG8_MMA(0, 1, At, B1); PG8_BAR;
            PG8_LDA(At, 1, 1); PG8_STAGE(PG8_SA(1, 0), a3, voffA);
            PG8_BAR; PG8_WAIT_L(0); PG8_MMA(1, 0, At, B0); PG8_BAR; PG8_SCHED;
            PG8_STAGE(PG8_SB(1, 1), b3 + hstep, voffB);
            PG8_WAIT_V(6); PG8_BAR; PG8_MMA(1, 1, At, B1); PG8_BAR;
        }
        if constexpr (!Epi::AFTER_DRAIN) { E(acc, cur, wr, wc, fr, fq); S.done(cur); }
        if (!has_next) break;
#pragma unroll
        for (int a = 0; a < 2; ++a)
#pragma unroll
            for (int b = 0; b < 2; ++b)
#pragma unroll
                for (int m = 0; m < 4; ++m)
#pragma unroll
                    for (int n = 0; n < 2; ++n) acc[a][b][m][n] = (f32x4){0.f, 0.f, 0.f, 0.f};
        cur = nxt; cA = nA; cB = nB; ++ui;
    }
    PG8_WAIT_V(0);
    if (wr == 0) PG8_BAR;
    PG8_BAR;
    if constexpr (Epi::AFTER_DRAIN) { E.fused(acc, cur, wr, wc, fr, fq, lds, wid, lane); S.done(cur); }
#undef PG8_SA
#undef PG8_SB
#undef PG8_STAGE
#undef PG8_LDA
#undef PG8_LDB
#undef PG8_MMA
#undef PG8_WAIT_V
#undef PG8_WAIT_L
#undef PG8_BAR
#undef PG8_SCHED
}
#else
template <class Epi, class Sched>
__device__ __forceinline__ void gemm_phase(PG8_LAS unsigned char* lds, const Gemm g, const Sched& S, const Epi& E, const int tid) {
    const int wid = tid >> 6, lane = tid & 63, wr = wid >> 2, wc = wid & 3, fr = lane & 15, fq = lane >> 4;
    Unit cur;
    for (int ui = 0; S.next(ui, cur); ++ui) {
        f32x4 acc[2][2][4][2];
        for (int ai = 0; ai < 2; ++ai) for (int m = 0; m < 4; ++m) {
            const size_t row = (size_t)cur.pm * 256 + ai * 128 + wr * 64 + m * 16 + fr;
            const bf16_t* ap = g.A + row * g.lda;
            for (int bj = 0; bj < 2; ++bj) for (int n = 0; n < 2; ++n) for (int j = 0; j < 4; ++j) {
                const size_t col = (size_t)cur.pn * 256 + bj * 128 + wc * 32 + (Epi::PERM ? 8 * fq + 4 * n : 16 * n + 4 * fq) + j;
                const bf16_t* bp = g.Bt + col * g.K; float s = 0.f;
                for (int k = 0; k < g.K; ++k) s += bf2f(ap[k]) * bf2f(bp[k]);
                acc[ai][bj][m][n][j] = s; } }
        E(acc, cur, wr, wc, fr, fq);
    }
    __syncthreads();
}
#endif
}

using pg8::Unit;
constexpr int HALFT = 128;
struct EpiF32 {
    static constexpr bool PERM = false, AFTER_DRAIN = false;
    float* C; int ldc;
    __device__ __forceinline__ void operator()(const f32x4 (&acc)[2][2][4][2], const Unit& u, int wr, int wc, int fr, int fq) const {
        const int row0 = u.pm * 256 + wr * 64 + fr, col0 = u.pn * 256 + wc * 32 + 4 * fq;
#pragma unroll
        for (int ai = 0; ai < 2; ++ai)
#pragma unroll
            for (int m = 0; m < 4; ++m) { float* rowp = C + (size_t)(row0 + ai * HALFT + m * 16) * ldc + col0;
#pragma unroll
                for (int bj = 0; bj < 2; ++bj)
#pragma unroll
                    for (int n = 0; n < 2; ++n) *(f32x4*)(rowp + bj * HALFT + n * 16) = acc[ai][bj][m][n]; }
    }
};
struct EpiResidual {
    static constexpr bool PERM = false, AFTER_DRAIN = false;
    const float* res; float* out;
    __device__ __forceinline__ void operator()(const f32x4 (&acc)[2][2][4][2], const Unit& u, int wr, int wc, int fr, int fq) const {
        const int row0 = u.pm * 256 + wr * 64 + fr, col0 = u.pn * 256 + wc * 32 + 4 * fq;
#pragma unroll
        for (int ai = 0; ai < 2; ++ai) {
            f32x4 rv[4][2][2];
#pragma unroll
            for (int m = 0; m < 4; ++m) { const size_t o = (size_t)(row0 + ai * HALFT + m * 16) * D + col0;
#pragma unroll
                for (int bj = 0; bj < 2; ++bj)
#pragma unroll
                    for (int n = 0; n < 2; ++n) rv[m][bj][n] = *(const GAS f32x4*)(res + o + bj * HALFT + n * 16); }
#pragma unroll
            for (int m = 0; m < 4; ++m) { const size_t o = (size_t)(row0 + ai * HALFT + m * 16) * D + col0;
#pragma unroll
                for (int bj = 0; bj < 2; ++bj)
#pragma unroll
                    for (int n = 0; n < 2; ++n) *(GAS f32x4*)(out + o + bj * HALFT + n * 16) = rv[m][bj][n] + acc[ai][bj][m][n]; }
        }
    }
};
struct EpiBf16 {
    static constexpr bool PERM = true, AFTER_DRAIN = false;
    bf16* O; int ldc; const float* rowscale; int rs_stride;
    __device__ __forceinline__ void operator()(const f32x4 (&acc)[2][2][4][2], const Unit& u, int wr, int wc, int fr, int fq) const {
        const int row0 = u.pm * 256 + wr * 64 + fr, col0 = u.pn * 256 + wc * 32 + 8 * fq;
#pragma unroll
        for (int ai = 0; ai < 2; ++ai)
#pragma unroll
            for (int m = 0; m < 4; ++m) { const int row = row0 + ai * HALFT + m * 16; bf16* rowp = O + (size_t)row * ldc + col0;
                const float sc = rowscale ? rowscale[(size_t)row * rs_stride] : 1.0f;
#pragma unroll
                for (int bj = 0; bj < 2; ++bj) { const f32x4 v0 = acc[ai][bj][m][0] * sc, v1 = acc[ai][bj][m][1] * sc;
                    u32x4 w; w.x = pk2(v0[0], v0[1]); w.y = pk2(v0[2], v0[3]); w.z = pk2(v1[0], v1[1]); w.w = pk2(v1[2], v1[3]);
                    *(u32x4*)(rowp + bj * HALFT) = w; } }
    }
};
struct EpiSwiGLU {
    static constexpr bool PERM = true, AFTER_DRAIN = false;
    bf16* O; int ldc; int ntile;
    __device__ __forceinline__ void operator()(const f32x4 (&acc)[2][2][4][2], const Unit& u, int wr, int wc, int fr, int fq) const {
        const int row0 = u.pm * 256 + wr * 64 + fr, col0 = (u.pn % ntile) * 128 + wc * 32 + 8 * fq;
#pragma unroll
        for (int ai = 0; ai < 2; ++ai)
#pragma unroll
            for (int m = 0; m < 4; ++m) { bf16* rowp = O + (size_t)(row0 + ai * HALFT + m * 16) * ldc + col0;
                float a[8];
#pragma unroll
                for (int n = 0; n < 2; ++n)
#pragma unroll
                    for (int j = 0; j < 4; ++j) { const float g = acc[ai][0][m][n][j], up = acc[ai][1][m][n][j]; a[4 * n + j] = g * fast_rcp(1.0f + fast_exp(-g)) * up; }
                u32x4 w; w.x = pk2(a[0], a[1]); w.y = pk2(a[2], a[3]); w.z = pk2(a[4], a[5]); w.w = pk2(a[6], a[7]);
                *(u32x4*)rowp = w; }
    }
};
struct EpiZ {
    static constexpr bool PERM = true, AFTER_DRAIN = false;
    bf16* Z;
    __device__ __forceinline__ void operator()(const f32x4 (&acc)[2][2][4][2], const Unit& u, int wr, int wc, int fr, int fq) const {
        const int i = u.pn >> 2, pnl = u.pn & 3, pml = u.pm - i * (TH / 256);
        const int row0 = pml * 256 + wr * 64 + fr, col0 = i * D + pnl * 256 + wc * 32 + 8 * fq;
#pragma unroll
        for (int ai = 0; ai < 2; ++ai)
#pragma unroll
            for (int m = 0; m < 4; ++m) { bf16* rowp = Z + (size_t)(row0 + ai * HALFT + m * 16) * 4096 + col0;
#pragma unroll
                for (int bj = 0; bj < 2; ++bj) { const f32x4 v0 = acc[ai][bj][m][0], v1 = acc[ai][bj][m][1];
                    u32x4 w; w.x = pk2(v0[0], v0[1]); w.y = pk2(v0[2], v0[3]); w.z = pk2(v1[0], v1[1]); w.w = pk2(v1[2], v1[3]);
                    *(GAS u32x4*)(rowp + bj * HALFT) = w; } }
    }
};
struct BranchOrder {
    int nP, G, c;
    __device__ bool next(int i, Unit& u) const {
        const long L = (long)i * G + c; if (L >= (long)16 * nP) return false;
        const int br = (int)(L / (4 * nP)), r = (int)(L % (4 * nP)); u.pm = br * nP + (r >> 2); u.pn = br * 4 + (r & 3); return true;
    }
    __device__ __forceinline__ void a_ready(const Unit&) const {}
    __device__ __forceinline__ void done(const Unit&) const {}
};
struct EpiMerge {
    static constexpr bool PERM = false, AFTER_DRAIN = false;
    const bf16* Z; const float* gate_b; bf16* MG;
    __device__ __forceinline__ void operator()(const f32x4 (&acc)[2][2][4][2], const Unit& u, int wr, int wc, int fr, int fq) const {
        const int row0 = u.pm * 256 + wr * 64 + fr, col = u.pn * 64 + wc * 16 + 4 * fq;
        f32x4 gb[4];
#pragma unroll
        for (int i = 0; i < 4; ++i) gb[i] = *(const GAS f32x4*)(gate_b + i * D + col);
#pragma unroll
        for (int ai = 0; ai < 2; ++ai) {
            u32x2 zv[4][4];
#pragma unroll
            for (int m = 0; m < 4; ++m)
#pragma unroll
                for (int i = 0; i < 4; ++i) zv[m][i] = *(const GAS u32x2*)(Z + (size_t)(row0 + ai * HALFT + m * 16) * 4096 + i * D + col);
#pragma unroll
            for (int m = 0; m < 4; ++m) { const size_t row = (size_t)(row0 + ai * HALFT + m * 16);
                f32x4 s = (f32x4){0.f, 0.f, 0.f, 0.f};
#pragma unroll
                for (int bj = 0; bj < 2; ++bj)
#pragma unroll
                    for (int n = 0; n < 2; ++n) { const int i = 2 * bj + n; const unsigned z01 = zv[m][i].x, z23 = zv[m][i].y;
                        const f32x4 z = (f32x4){bf2f(z01 & 0xffffu), bf2f(z01 >> 16), bf2f(z23 & 0xffffu), bf2f(z23 >> 16)}; const f32x4 a = acc[ai][bj][m][n] + gb[i];
#pragma unroll
                        for (int j = 0; j < 4; ++j) s[j] += z[j] * fast_rcp(1.0f + fast_exp(-a[j])); }
                u32x2 w; w.x = pk2(s.x, s.y); w.y = pk2(s.z, s.w); *(GAS u32x2*)(MG + row * D + col) = w; }
        }
    }
};

constexpr size_t MiB = 1u << 20;
constexpr size_t al(size_t x) { return (x + 255) & ~(size_t)255; }
constexpr size_t WS_CTL = 0, CTL_BYTES = 1 * MiB;
constexpr size_t W_IN = 1 * MiB;
constexpr size_t W_GATE = W_IN + (size_t)PW * D * 2;
constexpr size_t W_UQ = W_GATE + (size_t)4096 * D * 2;
constexpr size_t W_UKV = W_UQ + (size_t)768 * 384 * 2;
constexpr size_t W_LORA = W_UKV + (size_t)1024 * 256 * 2;
constexpr size_t W_BR = W_LORA + (size_t)1536 * 384 * 2;
constexpr size_t W_OUT = W_BR + (size_t)4 * 1024 * 512 * 2;
constexpr size_t W_FGU = W_OUT + (size_t)D * D * 2;
constexpr size_t W_FDN = W_FGU + (size_t)NEXP * 2 * FF_E * D * 2;
constexpr size_t W_END = W_FDN + (size_t)NEXP * D * FF_E * 2;
constexpr size_t A_H = al(W_END);
constexpr size_t A_ROPE = A_H + (size_t)TH * D * 2;
constexpr size_t A_Y = A_ROPE + (size_t)TH * 64 * 4;
constexpr size_t A_P = A_Y + (size_t)4 * TH * 512 * 2;
constexpr size_t A_MIX = A_P + (size_t)TH * PW * 2;
constexpr size_t R_RKV = A_MIX;
constexpr size_t R_LOUT = R_RKV + (size_t)TH * 1536 * 2;
constexpr size_t R_O = R_LOUT + (size_t)TH * 1536 * 4;
constexpr size_t R_LIN = R_O + (size_t)TH * 512 * 4;
constexpr size_t R_REC = R_LIN + (size_t)TH * 384 * 2;
constexpr size_t R_END = R_REC + (size_t)BH * 8 * NCH * 61696;
constexpr size_t M_KR = al(R_END);
constexpr size_t M_Q = M_KR + (size_t)TH * 64 * 2;
constexpr size_t M_KV = M_Q + (size_t)TH * 768 * 2;
constexpr size_t M_VT = M_KV + (size_t)TH * 1024 * 2;
constexpr size_t M_END = M_VT + (size_t)TH * 512 * 2;
constexpr size_t G_CH = R_LIN;
constexpr size_t G_O = G_CH + al((size_t)BH * 4 * NCH * 78864);
constexpr size_t G_END = G_O + (size_t)TH * 512 * 4;
constexpr size_t S_ST = al(G_END);
constexpr size_t S_YD = S_ST + (size_t)BH * NCH * 8 * 64 * 128 * 2;
constexpr size_t S_C = S_YD + (size_t)TH * 512 * 4;
constexpr size_t S_AC = S_C + (size_t)BH * NCH * 2 * 17408;
constexpr size_t S_YO = S_AC + (size_t)TH * 8 * 4;
constexpr size_t S_END = S_YO + (size_t)TH * 512 * 4;
constexpr size_t A_Z = A_P;
constexpr size_t A_MG = A_MIX;
constexpr size_t F_ACT = A_P;
constexpr size_t F_GA = F_ACT + (size_t)MOE_ROWS * FF_E * 2;
constexpr size_t F_YE = F_GA + (size_t)MOE_ROWS * D * 2;
constexpr size_t F_TOPE = F_YE + (size_t)MOE_ROWS * D * 4;
constexpr size_t F_TOPW = F_TOPE + (size_t)TH * 2 * 4;
constexpr size_t F_SLOT = F_TOPW + (size_t)TH * 2 * 4;
constexpr size_t F_END = F_SLOT + (size_t)TH * 2 * 4;
constexpr size_t cmax(size_t a, size_t b) { return a > b ? a : b; }
constexpr size_t WS_NEED = cmax(cmax(cmax(M_END, R_END), cmax(G_END, S_END)), F_END);
#ifndef EMU
static_assert(WS_NEED <= (size_t)896 * MiB, "workspace");
#endif
constexpr int CW_BAR = 4096;
constexpr int CW_CNT = 16384;
constexpr int CW_WGC = 32768;

#ifdef EMU
#define WAVE_SYNC() emu_wave_sync()
#else
#define WAVE_SYNC() do { asm volatile("s_waitcnt lgkmcnt(0)" ::: "memory"); } while (0)
#endif
struct Frame {
    LAS unsigned char* lds; int tid, lane, wave, G, gw, NGW, bid;
    float* out; unsigned char* ws; unsigned* ctl;
};
struct Args { const float* in[39]; float* out; unsigned char* ws; int lo, hi; };
#define WSP(type, off) ((type*)(F.ws + (off)))

template <class FN>
__device__ __forceinline__ void cvt_matrix(const Frame& F, const float* W, int ldw, int K, bf16* WT, int Ndst, const float* kscale, FN srccol) {
    LAS float* scr = (LAS float*)(F.lds + F.wave * 16384);
    const int nblk = Ndst / 32, nitems = (K / 64) * nblk, lane = F.lane;
    for (int item = F.gw; item < nitems; item += F.NGW) {
        const int kb = item / nblk, nb = item % nblk, k0 = 64 * kb, n0 = 32 * nb;
        const int sc = srccol(n0 + (lane & 31));
        float wv[32];
#pragma unroll
        for (int i = 0; i < 32; ++i) { const int kk = 2 * i + (lane >> 5); wv[i] = sc >= 0 ? W[(size_t)(k0 + kk) * ldw + sc] : 0.f; }
#pragma unroll
        for (int i = 0; i < 32; ++i) { const int kk = 2 * i + (lane >> 5); float v = wv[i]; if (kscale) v *= kscale[k0 + kk]; scr[kk * 33 + (lane & 31)] = v; }
        WAVE_SYNC();
        const int c = lane & 7;
#pragma unroll
        for (int j = 0; j < 4; ++j) { const int n = (lane >> 3) + 8 * j; const LAS float* s = scr + (8 * c) * 33 + n;
            u32x4 o; o.x = pk2(s[0 * 33], s[1 * 33]); o.y = pk2(s[2 * 33], s[3 * 33]); o.z = pk2(s[4 * 33], s[5 * 33]); o.w = pk2(s[6 * 33], s[7 * 33]);
            *(u32x4*)(WT + (size_t)(n0 + n) * K + k0 + 8 * c) = o; }
        WAVE_SYNC();
    }
}
__device__ __forceinline__ void phase_convert(const Frame& F, const Args& A, int layer) {
    const float* w_in = A.in[3] + (size_t)layer * D * IN_COLS;
    cvt_matrix(F, w_in, IN_COLS, D, WSP(bf16, W_IN), PW, nullptr, [](int n) { return n < C_GATE ? n : -1; });
    cvt_matrix(F, w_in, IN_COLS, D, WSP(bf16, W_GATE), 4096, nullptr, [](int n) {
        const int pn = n >> 8, c = n & 255, bj = c >> 7, wc = (c >> 5) & 3, nn = (c >> 4) & 1, r = c & 15; return C_GATE + (2 * bj + nn) * D + 64 * pn + 16 * wc + r; });
    cvt_matrix(F, A.in[6] + (size_t)layer * 384 * 768, 768, 384, WSP(bf16, W_UQ), 768, A.in[4] + layer * 384, [](int n) { return n; });
    cvt_matrix(F, A.in[7] + (size_t)layer * 256 * 1024, 1024, 256, WSP(bf16, W_UKV), 1024, A.in[5] + layer * 256, [](int n) { return n; });
    for (int i = 0; i < 4; ++i) cvt_matrix(F, A.in[30] + ((size_t)layer * 4 + i) * 512 * D, D, 512, WSP(bf16, W_BR) + (size_t)i * D * 512, D, nullptr, [](int n) { return n; });
    cvt_matrix(F, A.in[31] + (size_t)layer * D * D, D, D, WSP(bf16, W_OUT), D, nullptr, [](int n) { return n; });
    if (layer == 0) {
        cvt_matrix(F, A.in[33], 2 * FF_D, D, WSP(bf16, W_FGU), 2 * FF_D, nullptr, [](int n) { const int pn = n >> 8, c = n & 255; return c < 128 ? 128 * pn + c : FF_D + 128 * pn + (c - 128); });
        cvt_matrix(F, A.in[34], D, FF_D, WSP(bf16, W_FDN), D, nullptr, [](int n) { return n; });
    } else {
        for (int e = 0; e < NEXP; ++e) {
            cvt_matrix(F, A.in[36] + (size_t)e * D * 2 * FF_E, 2 * FF_E, D, WSP(bf16, W_FGU) + (size_t)e * 2 * FF_E * D, 2 * FF_E, nullptr, [](int n) { const int pn = n >> 8, c = n & 255; return c < 128 ? 128 * pn + c : FF_E + 128 * pn + (c - 128); });
            cvt_matrix(F, A.in[37] + (size_t)e * FF_E * D, D, FF_E, WSP(bf16, W_FDN) + (size_t)e * D * FF_E, D, nullptr, [](int n) { return n; });
        }
    }
    { const float* w2 = A.in[10] + (size_t)layer * 64 * 512; const float* a2 = A.in[12] + (size_t)layer * 64 * 512; const float* g2 = A.in[13] + (size_t)layer * 160 * 512;
      bf16* L = WSP(bf16, W_LORA);
      for (int idx = F.bid * 512 + F.tid; idx < 1536 * 384; idx += F.G * 512) { const int n = idx / 384, k = idx % 384; float v = 0.f;
          if (n < 512) { if (k < 64) v = w2[k * 512 + n]; } else if (n < 1024) { if (k >= 64 && k < 128) v = a2[(k - 64) * 512 + (n - 512)]; } else { if (k >= 128 && k < 288) v = g2[(k - 128) * 512 + (n - 1024)]; }
          L[idx] = (bf16)f2bf(v); } }
}

template <bool ROUTER>
__device__ __forceinline__ void phase_norm(const Frame& F, const Args& A, const float* xin, const float* gain, bf16* H, const float* router, int* tope, float* topw, unsigned* cnt) {
    const int lane = F.lane;
    LAS unsigned* lcnt = (LAS unsigned*)F.lds;
    if (ROUTER) { __syncthreads(); if (F.tid < 8) lcnt[F.tid] = 0u; __syncthreads(); }
    f32x4 gv[4];
#pragma unroll
    for (int j = 0; j < 4; ++j) gv[j] = *(const f32x4*)(gain + 4 * lane + 256 * j);
    for (int m = F.gw; m < TH; m += F.NGW) {
        const float* xr = xin + (size_t)m * D; f32x4 v[4]; float ss = 0.f;
#pragma unroll
        for (int j = 0; j < 4; ++j) { v[j] = *(const f32x4*)(xr + 4 * lane + 256 * j); ss += (v[j].x * v[j].x + v[j].y * v[j].y) + (v[j].z * v[j].z + v[j].w * v[j].w); }
        const float rstd = 1.0f / sqrtf(wave_sum(ss) * (1.0f / D) + EPS);
#pragma unroll
        for (int j = 0; j < 4; ++j) { v[j] = v[j] * rstd * gv[j]; st_bf16x4(H + (size_t)m * D + 4 * lane + 256 * j, v[j]); }
        if (ROUTER) {
            float lg[8];
#pragma unroll
            for (int e = 0; e < 8; ++e) lg[e] = 0.f;
#pragma unroll
            for (int j = 0; j < 4; ++j)
#pragma unroll
                for (int q = 0; q < 4; ++q) { const float* rp = router + (size_t)(4 * lane + 256 * j + q) * 8; const f32x4 r0 = *(const f32x4*)rp, r1 = *(const f32x4*)(rp + 4); const float hv = v[j][q];
                    lg[0] += hv * r0.x; lg[1] += hv * r0.y; lg[2] += hv * r0.z; lg[3] += hv * r0.w; lg[4] += hv * r1.x; lg[5] += hv * r1.y; lg[6] += hv * r1.z; lg[7] += hv * r1.w; }
#pragma unroll
            for (int e = 0; e < 8; ++e) lg[e] = wave_sum(lg[e]);
            if (lane == 0) {
                int e1 = 0; float l1 = lg[0];
#pragma unroll
                for (int e = 1; e < 8; ++e) if (lg[e] > l1) { l1 = lg[e]; e1 = e; }
                int e2 = -1; float l2 = -3.0e38f;
#pragma unroll
                for (int e = 0; e < 8; ++e) if (e != e1 && lg[e] > l2) { l2 = lg[e]; e2 = e; }
                const float w1 = 1.0f / (1.0f + expf(l2 - l1));
                tope[2 * m] = e1; tope[2 * m + 1] = e2; topw[2 * m] = w1; topw[2 * m + 1] = 1.0f - w1;
                ATOMIC_ADD_LDS(lcnt + e1, 1u); ATOMIC_ADD_LDS(lcnt + e2, 1u);
            }
        }
    }
    if (ROUTER) { __syncthreads(); if (F.tid < 8) cnt[F.bid * 8 + F.tid] = lcnt[F.tid]; __syncthreads(); }
}
__device__ __forceinline__ void phase_rope_table(const Frame& F, const Args& A, const int* pos, float* rope) {
    for (int idx = F.bid * 512 + F.tid; idx < TH * 32; idx += F.G * 512) { const int t = idx >> 5, i = idx & 31;
        const float inv = powf(10000.0f, -(float)i / 32.0f);
        const float ang = (float)pos[t] * inv; float sn, cs; sincosf(ang, &sn, &cs);
        rope[(size_t)t * 64 + i] = cs; rope[(size_t)t * 64 + 32 + i] = sn; }
}
__device__ __forceinline__ void phase_final_norm(const Frame& F, const Args& A, float* x, const float* gain) {
    const int lane = F.lane;
    for (int m = F.gw; m < T; m += F.NGW) {
        float* xr = x + (size_t)m * D; f32x4 v[4]; float ss = 0.f;
#pragma unroll
        for (int j = 0; j < 4; ++j) { v[j] = *(const f32x4*)(xr + 4 * lane + 256 * j); ss += (v[j].x * v[j].x + v[j].y * v[j].y) + (v[j].z * v[j].z + v[j].w * v[j].w); }
        const float rstd = 1.0f / sqrtf(wave_sum(ss) * (1.0f / D) + EPS);
#pragma unroll
        for (int j = 0; j < 4; ++j) *(f32x4*)(xr + 4 * lane + 256 * j) = v[j] * rstd * *(const f32x4*)(gain + 4 * lane + 256 * j);
    }
}

__device__ __forceinline__ void phase_mla_prep(const Frame& F, const Args& A) {
    bf16* P = WSP(bf16, A_P); bf16* kr = WSP(bf16, M_KR); const float* rope = WSP(float, A_ROPE);
    const int lane = F.lane;
    for (int m = F.gw; m < TH; m += F.NGW) {
        bf16* pr = P + (size_t)m * PW; float sq = 0.f, skv = 0.f; f32x4 v[3];
#pragma unroll
        for (int j = 0; j < 3; ++j) { const int c = 4 * lane + 256 * j; v[j] = ld_bf16x4(pr + c); const float s = (v[j].x * v[j].x + v[j].y * v[j].y) + (v[j].z * v[j].z + v[j].w * v[j].w);
            if (c < 384) sq += s; else if (c < 640) skv += s; }
        sq = wave_sum(sq); skv = wave_sum(skv);
        const float rq = 1.0f / sqrtf(sq * (1.0f / 384.0f) + EPS), rkv = 1.0f / sqrtf(skv * (1.0f / 256.0f) + EPS);
#pragma unroll
        for (int j = 0; j < 3; ++j) { const int c = 4 * lane + 256 * j; if (c < 640) st_bf16x4(pr + c, v[j] * (c < 384 ? rq : rkv)); }
        if (lane < 32) { const float x1 = bf2f(pr[640 + lane]), x2 = bf2f(pr[672 + lane]), c = rope[(size_t)m * 64 + lane], s = rope[(size_t)m * 64 + 32 + lane];
            kr[(size_t)m * 64 + lane] = (bf16)f2bf(x1 * c - x2 * s); kr[(size_t)m * 64 + 32 + lane] = (bf16)f2bf(x2 * c + x1 * s); }
    }
}
__device__ __forceinline__ void phase_mla_q(const Frame& F, const Args& A) {
    pg8::Gemm g{WSP(bf16, A_P) + 0, WSP(bf16, W_UQ), PW, 384}; pg8::StaticOrder S; S.init(TH, 768, F.G, F.bid);
    EpiBf16 E{WSP(bf16, M_Q), 768, nullptr, 0}; pg8::gemm_phase(F.lds, g, S, E, F.tid);
}
struct EpiKV {
    static constexpr bool PERM = true, AFTER_DRAIN = false;
    bf16* KV; bf16* VT;
    __device__ __forceinline__ void operator()(const f32x4 (&acc)[2][2][4][2], const Unit& u, int wr, int wc, int fr, int fq) const {
        const int row0 = u.pm * 256 + wr * 64 + fr, col0 = wc * 32 + 8 * fq;
#pragma unroll
        for (int ai = 0; ai < 2; ++ai)
#pragma unroll
            for (int m = 0; m < 4; ++m) { const int row = row0 + ai * HALFT + m * 16;
                { const f32x4 v0 = acc[ai][0][m][0], v1 = acc[ai][0][m][1]; u32x4 w; w.x = pk2(v0[0], v0[1]); w.y = pk2(v0[2], v0[3]); w.z = pk2(v1[0], v1[1]); w.w = pk2(v1[2], v1[3]);
                  *(u32x4*)(KV + (size_t)row * 1024 + u.pn * 256 + col0) = w; }
                const int b = row / SEQ, t = row % SEQ; bf16* vt = VT + ((size_t)(b * 4 + u.pn) * 128 + col0) * SEQ + t;
#pragma unroll
                for (int n = 0; n < 2; ++n)
#pragma unroll
                    for (int j = 0; j < 4; ++j) vt[(size_t)(4 * n + j) * SEQ] = (bf16)f2bf(acc[ai][1][m][n][j]); }
    }
};
__device__ __forceinline__ void phase_mla_kv(const Frame& F, const Args& A) {
    pg8::Gemm g{WSP(bf16, A_P) + 384, WSP(bf16, W_UKV), PW, 256}; pg8::StaticOrder S; S.init(TH, 1024, F.G, F.bid);
    EpiKV E{WSP(bf16, M_KV), WSP(bf16, M_VT)}; pg8::gemm_phase(F.lds, g, S, E, F.tid);
}
constexpr int AT_KS = 200, AT_VS = 72;
constexpr int AT_KBYTES = 64 * AT_KS * 2, AT_VBYTES = 128 * AT_VS * 2;
__device__ __forceinline__ void phase_attention(const Frame& F, const Args& A) {
    const bf16* Q = WSP(bf16, M_Q); const bf16* KV = WSP(bf16, M_KV); const bf16* KR = WSP(bf16, M_KR); const bf16* VTg = WSP(bf16, M_VT); const float* rope = WSP(float, A_ROPE); bf16* Y = WSP(bf16, A_Y);
    const int lane = F.lane, w = F.wave, l15 = lane & 15, q4 = lane >> 4, tid = F.tid, grp = w >> 2, wq = w & 3;
    const int NQB = SEQ / 128, nunits = BH * 4 * NQB;
    const float sc2 = 0.07216878364870322f * 1.4426950408889634f;
    for (int unit = F.bid; unit < nunits; unit += F.G) {
        const int qb = NQB - 1 - (unit / (BH * 4)), bh = unit % (BH * 4), h = bh & 3, b = bh >> 2;
        const size_t t0 = (size_t)b * SEQ;
        bf16x8 qf[2][6];
#pragma unroll
        for (int f = 0; f < 2; ++f) { const size_t tq = t0 + qb * 128 + wq * 32 + 16 * f + l15;
#pragma unroll
            for (int ks = 0; ks < 6; ++ks) qf[f][ks] = *(const bf16x8*)(Q + tq * 768 + h * 192 + 32 * ks + 8 * q4);
            const bf16x8 a = qf[f][4], c2 = qf[f][5];
#pragma unroll
            for (int j = 0; j < 8; ++j) { const float x1 = bf2f((unsigned short)a[j]), x2 = bf2f((unsigned short)c2[j]), c = rope[tq * 64 + 8 * q4 + j], sn = rope[tq * 64 + 32 + 8 * q4 + j];
                qf[f][4][j] = (short)f2bf(x1 * c - x2 * sn); qf[f][5][j] = (short)f2bf(x2 * c + x1 * sn); } }
        f32x4 o[2][8];
#pragma unroll
        for (int f = 0; f < 2; ++f)
#pragma unroll
            for (int mb = 0; mb < 8; ++mb) o[f][mb] = (f32x4){0.f, 0.f, 0.f, 0.f};
        float mrow[2] = {-3.0e38f, -3.0e38f}, lrow[2] = {0.f, 0.f};
        const int qchunk = 2 * qb + (wq >> 1), ntile = 2 * qb + 2;
        u32x4 pk_[3], pv_[2];
        const int skey = tid >> 3, c8 = tid & 7;
        const int okv = skey * 1024 + 8 * c8, okr = skey * 64 + 8 * c8, ovt = skey * SEQ + 8 * c8;
        const bf16* kvb = KV + t0 * 1024 + h * 256; const bf16* krb = KR + t0 * 64; const bf16* vtb = VTg + (size_t)(b * 4 + h) * 128 * SEQ;
#define AT_LOAD(kt) do { const bf16* kv_ = kvb + (size_t)(kt) * 65536; const bf16* kr_ = krb + (size_t)(kt) * 4096; const bf16* vt_ = vtb + (size_t)(kt) * 64; \
            pk_[0] = *(const u32x4*)(kv_ + okv); pk_[1] = *(const u32x4*)(kv_ + okv + 64); pk_[2] = *(const u32x4*)(kr_ + okr); \
            pv_[0] = *(const u32x4*)(vt_ + ovt); pv_[1] = *(const u32x4*)(vt_ + ovt + 64 * SEQ); } while (0)
#define AT_STORE(bufi) do { LAS bf16* Ks_ = (LAS bf16*)(F.lds + (bufi) * (AT_KBYTES + AT_VBYTES)); LAS bf16* Vt_ = (LAS bf16*)((LAS unsigned char*)Ks_ + AT_KBYTES); \
            *(LAS u32x4*)(Ks_ + skey * AT_KS + 8 * c8) = pk_[0]; *(LAS u32x4*)(Ks_ + skey * AT_KS + 8 * c8 + 64) = pk_[1]; *(LAS u32x4*)(Ks_ + skey * AT_KS + 8 * c8 + 128) = pk_[2]; \
            *(LAS u32x4*)(Vt_ + skey * AT_VS + 8 * c8) = pv_[0]; *(LAS u32x4*)(Vt_ + (skey + 64) * AT_VS + 8 * c8) = pv_[1]; } while (0)
        __syncthreads();
        AT_LOAD(0); AT_STORE(0);
        __syncthreads();
        for (int kt = 0; kt < ntile; ++kt) {
            if (kt + 1 < ntile) AT_LOAD(kt + 1);
            if (kt <= qchunk) {
                const LAS bf16* Ks = (const LAS bf16*)(F.lds + (kt & 1) * (AT_KBYTES + AT_VBYTES)); const LAS bf16* Vt = (const LAS bf16*)((const LAS unsigned char*)Ks + AT_KBYTES);
                f32x4 st[2][2];
#pragma unroll
                for (int kb = 0; kb < 2; ++kb) { st[0][kb] = (f32x4){0.f, 0.f, 0.f, 0.f}; st[1][kb] = (f32x4){0.f, 0.f, 0.f, 0.f};
#pragma unroll
                    for (int ks = 0; ks < 6; ++ks) { const bf16x8 kf = *(const LAS bf16x8*)(Ks + (32 * grp + 16 * kb + l15) * AT_KS + 32 * ks + 8 * q4);
                        st[0][kb] = MFMA_BF16(kf, qf[0][ks], st[0][kb]); st[1][kb] = MFMA_BF16(kf, qf[1][ks], st[1][kb]); } }
                bf16x8 pb[2];
#pragma unroll
                for (int f = 0; f < 2; ++f) {
                    float mx = -3.0e38f;
#pragma unroll
                    for (int kb = 0; kb < 2; ++kb) { st[f][kb] = st[f][kb] * sc2; mx = fmaxf(mx, fmaxf(fmaxf(st[f][kb].x, st[f][kb].y), fmaxf(st[f][kb].z, st[f][kb].w))); }
                    mx = fmaxf(mx, __shfl_xor(mx, 16)); mx = fmaxf(mx, __shfl_xor(mx, 32));
                    const float mnew = fmaxf(mrow[f], mx), alpha = exp2f(mrow[f] - mnew); mrow[f] = mnew;
                    float ps = 0.f;
#pragma unroll
                    for (int kb = 0; kb < 2; ++kb)
#pragma unroll
                        for (int r = 0; r < 4; ++r) { const float p = exp2f(st[f][kb][r] - mnew); ps += p; pb[f][4 * kb + r] = (short)f2bf(p); }
                    lrow[f] = lrow[f] * alpha + ps;
#pragma unroll
                    for (int mb = 0; mb < 8; ++mb) o[f][mb] = o[f][mb] * alpha;
                }
#pragma unroll
                for (int mb = 0; mb < 8; ++mb) { const LAS bf16* vp = Vt + (16 * mb + l15) * AT_VS + 32 * grp + 4 * q4;
                    const bf16x4 v0 = *(const LAS bf16x4*)vp, v1 = *(const LAS bf16x4*)(vp + 16);
                    bf16x8 vf; vf[0] = v0[0]; vf[1] = v0[1]; vf[2] = v0[2]; vf[3] = v0[3]; vf[4] = v1[0]; vf[5] = v1[1]; vf[6] = v1[2]; vf[7] = v1[3];
                    o[0][mb] = MFMA_BF16(vf, pb[0], o[0][mb]); o[1][mb] = MFMA_BF16(vf, pb[1], o[1][mb]); }
            }
            if (kt + 1 < ntile) AT_STORE((kt + 1) & 1);
            __syncthreads();
        }
#undef AT_LOAD
#undef AT_STORE
#pragma unroll
        for (int f = 0; f < 2; ++f) { lrow[f] += __shfl_xor(lrow[f], 16); lrow[f] += __shfl_xor(lrow[f], 32); }
        LAS float* xo = (LAS float*)F.lds + (size_t)wq * (2 * 8 * 4 * 64 + 4 * 64);
        if (grp == 1) {
#pragma unroll
            for (int f = 0; f < 2; ++f) {
#pragma unroll
                for (int mb = 0; mb < 8; ++mb)
#pragma unroll
                    for (int r = 0; r < 4; ++r) xo[((f * 8 + mb) * 4 + r) * 64 + lane] = o[f][mb][r];
                xo[2 * 8 * 4 * 64 + f * 64 + lane] = mrow[f]; xo[2 * 8 * 4 * 64 + 128 + f * 64 + lane] = lrow[f]; } }
        __syncthreads();
        if (grp == 0) {
#pragma unroll
            for (int f = 0; f < 2; ++f) { const float m1 = xo[2 * 8 * 4 * 64 + f * 64 + lane], l1 = xo[2 * 8 * 4 * 64 + 128 + f * 64 + lane];
                const float m = fmaxf(mrow[f], m1), a0 = exp2f(mrow[f] - m), a1 = exp2f(m1 - m), inv = 1.0f / (lrow[f] * a0 + l1 * a1);
                const size_t tq = t0 + qb * 128 + wq * 32 + 16 * f + l15;
#pragma unroll
                for (int mb = 0; mb < 8; ++mb) { f32x4 v;
#pragma unroll
                    for (int r = 0; r < 4; ++r) v[r] = (o[f][mb][r] * a0 + xo[((f * 8 + mb) * 4 + r) * 64 + lane] * a1) * inv;
                    st_bf16x4(Y + tq * 512 + h * 128 + 16 * mb + 4 * q4, v); } } }
    }
    __syncthreads();
}

__device__ __forceinline__ f32x4 tile_bf(const LAS bf16* a, int lda, const LAS bf16* bt, int ldb, int K, f32x4 acc, int l15, int q4) {
    const LAS bf16* ap = a + l15 * lda + 8 * q4; const LAS bf16* bp = bt + l15 * ldb + 8 * q4;
#pragma unroll 4
    for (int ks = 0; ks < K / 32; ++ks) acc = MFMA_BF16(*(const LAS bf16x8*)(ap + 32 * ks), *(const LAS bf16x8*)(bp + 32 * ks), acc);
    return acc;
}
__device__ __forceinline__ f32x4 tile_mm(const LAS float* a, int lda, int ska, const LAS float* b, int ldb, int scb, int K, f32x4 acc, int l15, int q4);

__device__ __forceinline__ void phase_rwkv_prep(const Frame& F, const Args& A, int layer) {
    const bf16* P = WSP(bf16, A_P); bf16* RKV = WSP(bf16, R_RKV); bf16* LIN = WSP(bf16, R_LIN); const float* mu = A.in[8] + (size_t)layer * 1824;
    const int lane = F.lane;
    for (int m = F.gw; m < TH; m += F.NGW) {
        const bool first = (m % SEQ) == 0; const bf16* pr = P + (size_t)m * PW + C_RWKV;
#pragma unroll
        for (int j = 0; j < 8; ++j) { const int c = 4 * lane + 256 * j;
            if (c < 1824) { const f32x4 p = ld_bf16x4(pr + c); const f32x4 pv = first ? (f32x4){0.f, 0.f, 0.f, 0.f} : ld_bf16x4(pr - PW + c); const f32x4 muv = *(const f32x4*)(mu + c);
                f32x4 x = p + (pv - p) * muv;
                if (c < 1536) st_bf16x4(RKV + (size_t)m * 1536 + c, x);
                else { if (c < 1600) { x.x = tanhf(x.x); x.y = tanhf(x.y); x.z = tanhf(x.z); x.w = tanhf(x.w); }
                       else if (c >= 1664) { x.x = sigmoidf_(x.x); x.y = sigmoidf_(x.y); x.z = sigmoidf_(x.z); x.w = sigmoidf_(x.w); }
                       st_bf16x4(LIN + (size_t)m * 384 + (c - 1536), x); } } }
        if (lane < 24) st_bf16x4(LIN + (size_t)m * 384 + 288 + 4 * lane, (f32x4){0.f, 0.f, 0.f, 0.f});
    }
}
__device__ __forceinline__ void phase_rwkv_lora(const Frame& F, const Args& A) {
    pg8::Gemm g{WSP(bf16, R_LIN), WSP(bf16, W_LORA), 384, 384}; pg8::StaticOrder S; S.init(TH, 1536, F.G, F.bid);
    EpiF32 E{WSP(float, R_LOUT), 1536}; pg8::gemm_phase(F.lds, g, S, E, F.tid);
}
constexpr int RS = 72;
constexpr int RREC_COMMON = 4 * 64 * RS * 2 + 256;
constexpr int RREC_T = 64 * 64 * 2;
constexpr int RREC_BYTES = RREC_COMMON + 3 * RREC_T;
static_assert(RREC_BYTES == 61696, "record size (see R_REC in the workspace map)");
static_assert(RREC_COMMON % 16 == 0, "record alignment");
__device__ __forceinline__ void phase_rwkv_r1(const Frame& F, const Args& A, int layer) {
    const bf16* RKV = WSP(bf16, R_RKV); const float* LOUT = WSP(float, R_LOUT); unsigned char* REC = WSP(unsigned char, R_REC);
    const float* w0 = A.in[9] + layer * 512; const float* a0 = A.in[11] + layer * 512; const float* k_k = A.in[14] + layer * 512; const float* k_a = A.in[15] + layer * 512;
    LAS bf16* kbar = (LAS bf16*)F.lds; LAS bf16* atil = kbar + 64 * RS; LAS bf16* khat = atil + 64 * RS; LAS bf16* rbar = khat + 64 * RS;
    LAS bf16* atT = rbar + 64 * RS; LAS bf16* khT = atT + 64 * RS; LAS bf16* vT = khT + 64 * RS; LAS bf16* Bm = vT + 64 * RS; LAS bf16* Em = Bm + 64 * RS;
    LAS float* Am = (LAS float*)(Em + 64 * RS);
    LAS float* X = Am + 64 * 68;
    LAS float* lam = Am;
    const int tid = F.tid, lane = F.lane, w = F.wave, l15 = lane & 15, q4 = lane >> 4;
    const int nunits = BH * 8 * NCH;
    for (int unit = F.bid; unit < nunits; unit += F.G) {
        const int c = unit % NCH, h = (unit / NCH) & 7, b = unit / (NCH * 8);
        const size_t tok0 = (size_t)b * SEQ + (size_t)c * 64;
        const int j = lane, cj = h * 64 + j;
        __syncthreads();
        float r_[8], km_[8], kk_[8], ka_[8], v_[8], L_[8];
        { const float w0c = w0[cj], a0c = a0[cj], kkc = k_k[cj], kac = k_a[cj]; float run = 0.f;
#pragma unroll
          for (int q = 0; q < 8; ++q) { const int t = 8 * w + q; const size_t tok = tok0 + t;
              const float r = bf2f(RKV[tok * 1536 + cj]), k = bf2f(RKV[tok * 1536 + 512 + cj]); v_[q] = bf2f(RKV[tok * 1536 + 1024 + cj]);
              const float wpre = LOUT[tok * 1536 + cj], apre = LOUT[tok * 1536 + 512 + cj];
              const float wl = -softplusf_(-(w0c + wpre)) - 0.5f, a = sigmoidf_(a0c + apre);
              const float kr = k * kkc, ss = wave_sum(kr * kr), kk = kr / sqrtf(ss + EPS);
              r_[q] = r; km_[q] = k * (1.0f + (a - 1.0f) * kac); kk_[q] = kk; ka_[q] = kk * a;
              run += -expf(wl); L_[q] = run; }
          lam[w * 64 + j] = run; }
        __syncthreads();
        { float base = 0.f, Lend = 0.f;
#pragma unroll
          for (int ww = 0; ww < 8; ++ww) { const float tw = lam[ww * 64 + j]; if (ww < w) base += tw; Lend += tw; }
#pragma unroll
          for (int q = 0; q < 8; ++q) { const int t = 8 * w + q; const float L = base + L_[q], Lm1 = q ? base + L_[q - 1] : base;
              const float eG = expf(L), eGi = expf(-L), eGm1 = expf(Lm1), eT = expf(Lend - L);
              const float kb = kk_[q] * eGm1;
              kbar[t * RS + j] = (bf16)f2bf(kb); X[t * 132 + j] = kb;
              atil[t * RS + j] = (bf16)f2bf(ka_[q] * eGi); khat[t * RS + j] = (bf16)f2bf(km_[q] * eGi); rbar[t * RS + j] = (bf16)f2bf(r_[q] * eG);
              atT[j * RS + t] = (bf16)f2bf(-ka_[q] * eT); khT[j * RS + t] = (bf16)f2bf(km_[q] * eT); vT[j * RS + t] = (bf16)f2bf(v_[q]); }
          if (w == 0) { float* gc = (float*)(REC + (size_t)unit * RREC_BYTES + 4 * 64 * RS * 2); gc[j] = expf(Lend); } }
        __syncthreads();
        unsigned char* rec = REC + (size_t)unit * RREC_BYTES;
        for (int tt = 0; tt < 8; ++tt) { const int tile = w * 8 + tt, which = tile >> 4, ti = (tile >> 2) & 3, tj = tile & 3;
            f32x4 acc = (f32x4){0.f, 0.f, 0.f, 0.f};
            if (tj <= ti) acc = tile_bf(((which & 2) ? rbar : kbar) + 16 * ti * RS, RS, ((which & 1) ? khat : atil) + 16 * tj * RS, RS, 64, acc, l15, q4);
#pragma unroll
            for (int r = 0; r < 4; ++r) { const int i = 16 * ti + 4 * q4 + r, jj = 16 * tj + l15; const bool keep = (which & 2) ? (jj <= i) : (jj < i); const float v = keep ? acc[r] : 0.f;
                if (which == 0) Am[i * 68 + jj] = v; else if (which == 1) Bm[i * RS + jj] = (bf16)f2bf(v); else if (which == 3) Em[i * RS + jj] = (bf16)f2bf(v);
                else ((bf16*)(rec + 2 * 64 * RS * 2))[i * RS + jj] = (bf16)f2bf(-v); } }
        __syncthreads();
        for (int tt = 0; tt < 6; ++tt) { const int tile = w * 6 + tt, which = tile >> 4, ti = (tile >> 2) & 3, tj = tile & 3;
            const LAS bf16* aop = which == 0 ? Bm : which == 1 ? Em : khT;
            const f32x4 acc = tile_bf(aop + 16 * ti * RS, RS, vT + 16 * tj * RS, RS, 64, (f32x4){0.f, 0.f, 0.f, 0.f}, l15, q4);
#pragma unroll
            for (int r = 0; r < 4; ++r) { const int i = 16 * ti + 4 * q4 + r, vv = 16 * tj + l15;
                if (which == 0) X[i * 132 + 64 + vv] = acc[r];                }
            if (which) st_bf16x4((bf16*)(rec + RREC_COMMON + which * RREC_T) + (16 * tj + l15) * 64 + 16 * ti + 4 * q4, acc); }
        __syncthreads();
        for (int rb = 0; rb < 4; ++rb) {
            if (rb > 0) {
                const f32x4 acc = tile_mm(Am + 16 * rb * 68, 68, 1, X + 16 * w, 132, 1, 16 * rb, (f32x4){0.f, 0.f, 0.f, 0.f}, l15, q4);
#pragma unroll
                for (int r = 0; r < 4; ++r) X[(16 * rb + 4 * q4 + r) * 132 + 16 * w + l15] -= acc[r];
                __syncthreads();
            }
            if (tid < 128) { float x[16];
#pragma unroll
                for (int i = 0; i < 16; ++i) { float sacc = X[(16 * rb + i) * 132 + tid];
#pragma unroll
                    for (int jj = 0; jj < i; ++jj) sacc -= Am[(16 * rb + i) * 68 + 16 * rb + jj] * x[jj];
                    x[i] = sacc; }
#pragma unroll
                for (int i = 0; i < 16; ++i) X[(16 * rb + i) * 132 + tid] = x[i]; }
            __syncthreads();
        }
        { const int t = tid >> 3, j0 = 8 * (tid & 7); float v[8];
#pragma unroll
          for (int q = 0; q < 8; ++q) v[q] = X[t * 132 + j0 + q];
          *(u32x4*)((bf16*)rec + t * RS + j0) = pack8(v);
          const int vv = tid >> 3, t0 = 8 * (tid & 7);
#pragma unroll
          for (int q = 0; q < 8; ++q) v[q] = X[(t0 + q) * 132 + 64 + vv];
          *(u32x4*)((bf16*)(rec + RREC_COMMON) + vv * 64 + t0) = pack8(v); }
        for (int e = tid; e < 64 * RS / 8; e += 512) { ((u32x4*)(rec + 64 * RS * 2))[e] = ((const LAS u32x4*)rbar)[e]; ((u32x4*)(rec + 3 * 64 * RS * 2))[e] = ((const LAS u32x4*)atT)[e]; }
    }
    __syncthreads();
}
constexpr int R2_BUF = RREC_COMMON;
__device__ __forceinline__ void phase_rwkv_r2(const Frame& F, const Args& A) {
    const unsigned char* REC = WSP(unsigned char, R_REC); float* RO = WSP(float, R_O);
    LAS unsigned char* buf0 = F.lds; LAS bf16* HT = (LAS bf16*)(F.lds + 2 * R2_BUF); LAS bf16* UT = HT + 2 * 64 * RS;
    const int tid = F.tid, lane = F.lane, w = F.wave, l15 = lane & 15, q4 = lane >> 4, ti = w >> 1;
    const int nunits = BH * 8;
    constexpr int NCHK = R2_BUF / 16;
    for (int unit = F.bid; unit < nunits; unit += F.G) {
        const int h = unit & 7, b = unit >> 3;
        __syncthreads();
        for (int e = tid; e < 2 * 64 * RS / 2; e += 512) ((LAS unsigned*)HT)[e] = 0u;
        f32x4 Hreg[2] = {(f32x4){0.f, 0.f, 0.f, 0.f}, (f32x4){0.f, 0.f, 0.f, 0.f}};
        u32x4 preA[5], preB[5]; u32x2 iniA[3][2], iniB[3][2], cur[3][2];
        const unsigned char* rec0 = REC + (size_t)((b * 8 + h) * NCH) * RREC_BYTES;
        const int tofs = ((16 * (2 * (w & 1)) + l15) * 64 + 16 * ti + 4 * q4) * 2;
#define R2_LOAD(S, recp) do { _Pragma("unroll") for (int q = 0; q < 5; ++q) { const int e = tid + 512 * q; if (e < NCHK) pre##S[q] = *(const u32x4*)((recp) + (size_t)e * 16); } \
            _Pragma("unroll") for (int mq = 0; mq < 3; ++mq) { ini##S[mq][0] = *(const u32x2*)((recp) + RREC_COMMON + mq * RREC_T + tofs); ini##S[mq][1] = *(const u32x2*)((recp) + RREC_COMMON + mq * RREC_T + tofs + 16 * 64 * 2); } } while (0)
#define R2_STORE(S, dst) do { _Pragma("unroll") for (int q = 0; q < 5; ++q) { const int e = tid + 512 * q; if (e < NCHK) *(LAS u32x4*)((dst) + (size_t)e * 16) = pre##S[q]; } } while (0)
#define R2_TAKE(S) do { _Pragma("unroll") for (int mq = 0; mq < 3; ++mq) { cur[mq][0] = ini##S[mq][0]; cur[mq][1] = ini##S[mq][1]; } } while (0)
        R2_LOAD(A, rec0); R2_STORE(A, buf0); R2_TAKE(A);
        if (NCH > 1) R2_LOAD(A, rec0 + (size_t)RREC_BYTES);
        __syncthreads();
#define R2_STEP(c, LS, SS) do { \
            LAS unsigned char* buf = buf0 + ((c) & 1) * R2_BUF; LAS unsigned char* nbuf = buf0 + (((c) + 1) & 1) * R2_BUF; \
            if ((c) + 2 < NCH) R2_LOAD(LS, rec0 + (size_t)((c) + 2) * RREC_BYTES); \
            const LAS bf16* KB = (const LAS bf16*)buf; const LAS bf16* RB = KB + 64 * RS; const LAS bf16* FMn = RB + 64 * RS; const LAS bf16* ATn = FMn + 64 * RS; \
            const LAS float* GC = (const LAS float*)(buf + 4 * 64 * RS * 2); \
            const LAS bf16* H0 = HT + ((c) & 1) * 64 * RS; LAS bf16* H1 = HT + (((c) + 1) & 1) * 64 * RS; \
            _Pragma("unroll") for (int t2 = 0; t2 < 2; ++t2) { const int tj = 2 * (w & 1) + t2; \
                f32x4 u = (f32x4){bf2f(cur[0][t2].x & 0xffffu), bf2f(cur[0][t2].x >> 16), bf2f(cur[0][t2].y & 0xffffu), bf2f(cur[0][t2].y >> 16)}; \
                u = tile_bf(KB + 16 * ti * RS, RS, H0 + 16 * tj * RS, RS, 64, u, l15, q4); \
                u32x2 pk; pk.x = pk2(u[0], u[1]); pk.y = pk2(u[2], u[3]); *(LAS u32x2*)(UT + (16 * tj + l15) * RS + 16 * ti + 4 * q4) = pk; } \
            __syncthreads(); \
            _Pragma("unroll") for (int t2 = 0; t2 < 2; ++t2) { const int tj = 2 * (w & 1) + t2; \
                f32x4 o = (f32x4){bf2f(cur[1][t2].x & 0xffffu), bf2f(cur[1][t2].x >> 16), bf2f(cur[1][t2].y & 0xffffu), bf2f(cur[1][t2].y >> 16)}; \
                o = tile_bf(RB + 16 * ti * RS, RS, H0 + 16 * tj * RS, RS, 64, o, l15, q4); \
                o = tile_bf(FMn + 16 * ti * RS, RS, UT + 16 * tj * RS, RS, 64, o, l15, q4); \
                _Pragma("unroll") for (int r = 0; r < 4; ++r) RO[((size_t)b * SEQ + (size_t)(c) * 64 + 16 * ti + 4 * q4 + r) * 512 + h * 64 + 16 * tj + l15] = o[r]; \
                const f32x4 kv = (f32x4){bf2f(cur[2][t2].x & 0xffffu), bf2f(cur[2][t2].x >> 16), bf2f(cur[2][t2].y & 0xffffu), bf2f(cur[2][t2].y >> 16)}; \
                _Pragma("unroll") for (int r = 0; r < 4; ++r) Hreg[t2][r] = Hreg[t2][r] * GC[16 * ti + 4 * q4 + r] + kv[r]; \
                Hreg[t2] = tile_bf(ATn + 16 * ti * RS, RS, UT + 16 * tj * RS, RS, 64, Hreg[t2], l15, q4); \
                u32x2 pk; pk.x = pk2(Hreg[t2][0], Hreg[t2][1]); pk.y = pk2(Hreg[t2][2], Hreg[t2][3]); *(LAS u32x2*)(H1 + (16 * tj + l15) * RS + 16 * ti + 4 * q4) = pk; } \
            if ((c) + 1 < NCH) { R2_STORE(SS, nbuf); R2_TAKE(SS); } \
            __syncthreads(); } while (0)
        for (int c = 0; c < NCH; c += 2) { R2_STEP(c, B, A); R2_STEP(c + 1, A, B); }
#undef R2_STEP
#undef R2_STORE
#undef R2_TAKE
#undef R2_LOAD
    }
    __syncthreads();
}
__device__ __forceinline__ void phase_rwkv_post(const Frame& F, const Args& A, int layer) {
    const bf16* RKV = WSP(bf16, R_RKV); const float* LOUT = WSP(float, R_LOUT); const float* RO = WSP(float, R_O); bf16* Y = WSP(bf16, A_Y) + (size_t)1 * TH * 512;
    const float* a0 = A.in[11] + layer * 512; const float* k_a = A.in[15] + layer * 512; const float* r_k = A.in[16] + layer * 512; const float* ln_w = A.in[17] + layer * 512; const float* ln_b = A.in[18] + layer * 512;
    const int lane = F.lane, c0 = 8 * lane;
    for (int m = F.gw; m < TH; m += F.NGW) {
        float o[8], r[8], k[8], v[8], ap[8], g[8];
        { const f32x4 a = *(const f32x4*)(RO + (size_t)m * 512 + c0), b2 = *(const f32x4*)(RO + (size_t)m * 512 + c0 + 4); o[0] = a.x; o[1] = a.y; o[2] = a.z; o[3] = a.w; o[4] = b2.x; o[5] = b2.y; o[6] = b2.z; o[7] = b2.w; }
#pragma unroll
        for (int hh = 0; hh < 2; ++hh) { const f32x4 rv = ld_bf16x4(RKV + (size_t)m * 1536 + c0 + 4 * hh), kv = ld_bf16x4(RKV + (size_t)m * 1536 + 512 + c0 + 4 * hh), vv = ld_bf16x4(RKV + (size_t)m * 1536 + 1024 + c0 + 4 * hh);
            const f32x4 av = *(const f32x4*)(LOUT + (size_t)m * 1536 + 512 + c0 + 4 * hh), gv = *(const f32x4*)(LOUT + (size_t)m * 1536 + 1024 + c0 + 4 * hh);
#pragma unroll
            for (int q = 0; q < 4; ++q) { r[4 * hh + q] = rv[q]; k[4 * hh + q] = kv[q]; v[4 * hh + q] = vv[q]; ap[4 * hh + q] = av[q]; g[4 * hh + q] = gv[q]; } }
        float bon = 0.f, sm = 0.f;
#pragma unroll
        for (int q = 0; q < 8; ++q) { const float a = sigmoidf_(a0[c0 + q] + ap[q]); const float km = k[q] * (1.0f + (a - 1.0f) * k_a[c0 + q]); bon += r[q] * km * r_k[c0 + q]; sm += o[q]; }
        bon += __shfl_xor(bon, 1); bon += __shfl_xor(bon, 2); bon += __shfl_xor(bon, 4);
        sm += __shfl_xor(sm, 1); sm += __shfl_xor(sm, 2); sm += __shfl_xor(sm, 4);
        const float mean = sm * (1.0f / 64.0f); float vs = 0.f;
#pragma unroll
        for (int q = 0; q < 8; ++q) { const float d = o[q] - mean; vs += d * d; }
        vs += __shfl_xor(vs, 1); vs += __shfl_xor(vs, 2); vs += __shfl_xor(vs, 4);
        const float rstd = 1.0f / sqrtf(vs * (1.0f / 64.0f) + 64e-5f);
        float y[8];
#pragma unroll
        for (int q = 0; q < 8; ++q) y[q] = ((o[q] - mean) * rstd * ln_w[c0 + q] + ln_b[c0 + q] + bon * v[q]) * g[q];
        u32x4 wv; wv.x = pk2(y[0], y[1]); wv.y = pk2(y[2], y[3]); wv.z = pk2(y[4], y[5]); wv.w = pk2(y[6], y[7]);
        *(u32x4*)(Y + (size_t)m * 512 + c0) = wv;
    }
}

__device__ __forceinline__ void conv8x8(const bf16* src, int tl0  , const float* w  , int wld, const float* bias, float (&out)[8][8]) {
    float x[11][8];
#pragma unroll
    for (int i = 0; i < 11; ++i) { const int tl = tl0 - 3 + i;
        if (tl >= 0) { const u32x4 v = *(const u32x4*)(src + (ptrdiff_t)(i - 3) * PW);
            x[i][0] = bf2f(v.x & 0xffffu); x[i][1] = bf2f(v.x >> 16); x[i][2] = bf2f(v.y & 0xffffu); x[i][3] = bf2f(v.y >> 16); x[i][4] = bf2f(v.z & 0xffffu); x[i][5] = bf2f(v.z >> 16); x[i][6] = bf2f(v.w & 0xffffu); x[i][7] = bf2f(v.w >> 16); }
        else {
#pragma unroll
            for (int ch = 0; ch < 8; ++ch) x[i][ch] = 0.f; } }
    float wv[4][8], bv[8];
#pragma unroll
    for (int j = 0; j < 4; ++j) { const f32x4 a = *(const f32x4*)(w + j * wld), b = *(const f32x4*)(w + j * wld + 4); wv[j][0] = a.x; wv[j][1] = a.y; wv[j][2] = a.z; wv[j][3] = a.w; wv[j][4] = b.x; wv[j][5] = b.y; wv[j][6] = b.z; wv[j][7] = b.w; }
    if (bias) { const f32x4 a = *(const f32x4*)bias, b = *(const f32x4*)(bias + 4); bv[0] = a.x; bv[1] = a.y; bv[2] = a.z; bv[3] = a.w; bv[4] = b.x; bv[5] = b.y; bv[6] = b.z; bv[7] = b.w; }
    else {
#pragma unroll
        for (int ch = 0; ch < 8; ++ch) bv[ch] = 0.f; }
#pragma unroll
    for (int i = 0; i < 8; ++i)
#pragma unroll
        for (int ch = 0; ch < 8; ++ch) { const float a = bv[ch] + wv[0][ch] * x[i][ch] + wv[1][ch] * x[i + 1][ch] + wv[2][ch] * x[i + 2][ch] + wv[3][ch] * x[i + 3][ch]; out[i][ch] = a * fast_rcp(1.0f + fast_exp(-a)); }
}
constexpr int SB = 136;
constexpr int SC_IMG = 64 * SB * 2;
__device__ __forceinline__ void phase_ssd_s1(const Frame& F, const Args& A, int layer) {
    const bf16* P = WSP(bf16, A_P); bf16* ST = WSP(bf16, S_ST); float* YD = WSP(float, S_YD); unsigned char* SCB = WSP(unsigned char, S_C); float* AC = WSP(float, S_AC);
    const float* cw = A.in[23] + (size_t)layer * 4 * 1024; const float* cb = A.in[24] + layer * 1024; const float* dtb = A.in[25] + layer * 8; const float* a_log = A.in[26] + layer * 8; const float* dsk = A.in[27] + layer * 8;
    LAS bf16* Bt_ = (LAS bf16*)F.lds; LAS bf16* Ct_ = Bt_ + 64 * SB; LAS bf16* BT = Ct_ + 64 * SB; LAS bf16* xT = BT + 128 * RS;
    LAS bf16* Mb = xT + 4 * 64 * RS; LAS bf16* xdT = Mb + 2 * 64 * RS; LAS float* dt = (LAS float*)(xdT + 2 * 64 * RS); LAS float* ac = dt + 256;
    const int tid = F.tid, lane = F.lane, w = F.wave, l15 = lane & 15, q4 = lane >> 4;
    const int nunits = BH * NCH * 2;
    for (int unit = F.bid; unit < nunits; unit += F.G) {
        const int g = unit & 1, c = (unit >> 1) % NCH, b = unit / (2 * NCH);
        const size_t tok0 = (size_t)b * SEQ + (size_t)c * 64;
        __syncthreads();
        {
            const int cg = tid & 63, rb = tid >> 6;
            const int cidx = cg < 32 ? g * 256 + 8 * cg : cg < 48 ? 512 + g * 128 + 8 * (cg - 32) : 768 + g * 128 + 8 * (cg - 48);
            float o[8][8];
            conv8x8(P + (tok0 + 8 * rb) * PW + C_SSD + 512 + cidx, c * 64 + 8 * rb, cw + cidx, 1024, cb + cidx, o);
            if (cg < 32) {
                const int hh = cg >> 3, p0 = 8 * (cg & 7);
#pragma unroll
                for (int ch = 0; ch < 8; ++ch) { float col[8];
#pragma unroll
                    for (int i = 0; i < 8; ++i) col[i] = o[i][ch];
                    *(LAS u32x4*)(xT + (hh * 64 + p0 + ch) * RS + 8 * rb) = pack8(col); }
            } else if (cg < 48) {
                const int n0 = 8 * (cg - 32);
#pragma unroll
                for (int i = 0; i < 8; ++i) *(LAS u32x4*)(Bt_ + (8 * rb + i) * SB + n0) = pack8(o[i]);
#pragma unroll
                for (int ch = 0; ch < 8; ++ch) { float col[8];
#pragma unroll
                    for (int i = 0; i < 8; ++i) col[i] = o[i][ch];
                    *(LAS u32x4*)(BT + (n0 + ch) * RS + 8 * rb) = pack8(col); }
            } else { const int n0 = 8 * (cg - 48);
#pragma unroll
                for (int i = 0; i < 8; ++i) *(LAS u32x4*)(Ct_ + (8 * rb + i) * SB + n0) = pack8(o[i]); }
        }
        if (tid < 256) { const int hh = tid >> 6, h = 4 * g + hh; const float d = softplusf_(bf2f(P[(tok0 + lane) * PW + C_SSD + 1536 + h]) + dtb[h]); float a = -expf(a_log[h]) * d;
#pragma unroll
            for (int o = 1; o < 64; o <<= 1) { const float t = __shfl_up(a, o); if (lane >= o) a += t; }
            dt[tid] = d; ac[tid] = a; AC[(tok0 + lane) * 8 + h] = a; }
        __syncthreads();
        { unsigned char* dst = SCB + (size_t)unit * SC_IMG; for (int e = tid; e < SC_IMG / 16; e += 512) ((u32x4*)dst)[e] = ((const LAS u32x4*)Ct_)[e]; }
        f32x4 cbt[2];
#pragma unroll
        for (int tt = 0; tt < 2; ++tt) { const int tile = w * 2 + tt, ti = tile >> 2, tj = tile & 3; cbt[tt] = (f32x4){0.f, 0.f, 0.f, 0.f};
            if (tj <= ti) cbt[tt] = tile_bf(Ct_ + 16 * ti * SB, SB, Bt_ + 16 * tj * SB, SB, 128, cbt[tt], l15, q4); }
        for (int hh = 0; hh < 4; ++hh) { const int h = 4 * g + hh; LAS bf16* M = Mb + (hh & 1) * 64 * RS; LAS bf16* xd = xdT + (hh & 1) * 64 * RS; const LAS float* dth = dt + hh * 64; const LAS float* ach = ac + hh * 64;
#pragma unroll
            for (int tt = 0; tt < 2; ++tt) { const int tile = w * 2 + tt, ti = tile >> 2, tj = tile & 3;
#pragma unroll
                for (int r = 0; r < 4; ++r) { const int l = 16 * ti + 4 * q4 + r, s = 16 * tj + l15; M[l * RS + s] = (bf16)f2bf((s <= l) ? cbt[tt][r] * expf(ach[l] - ach[s]) * dth[s] : 0.f); } }
            { const int p = tid >> 3, l0 = 8 * (tid & 7); const u32x4 v = *(const LAS u32x4*)(xT + (hh * 64 + p) * RS + l0); const float a63 = ach[63]; float xv[8] = {bf2f(v.x & 0xffffu), bf2f(v.x >> 16), bf2f(v.y & 0xffffu), bf2f(v.y >> 16), bf2f(v.z & 0xffffu), bf2f(v.z >> 16), bf2f(v.w & 0xffffu), bf2f(v.w >> 16)};
#pragma unroll
              for (int i = 0; i < 8; ++i) xv[i] *= dth[l0 + i] * expf(a63 - ach[l0 + i]);
              *(LAS u32x4*)(xd + p * RS + l0) = pack8(xv); }
            __syncthreads();
#pragma unroll
            for (int tt = 0; tt < 2; ++tt) { const int tile = w * 2 + tt, ti = tile >> 2, tj = tile & 3;
                const f32x4 acc = tile_bf(M + 16 * ti * RS, RS, xT + (hh * 64 + 16 * tj) * RS, RS, 64, (f32x4){0.f, 0.f, 0.f, 0.f}, l15, q4);
                const f32x4 xs = ld_bf16x4((const bf16*)(xT + (hh * 64 + 16 * tj + l15) * RS + 16 * ti + 4 * q4));
#pragma unroll
                for (int r = 0; r < 4; ++r) YD[(tok0 + 16 * ti + 4 * q4 + r) * 512 + h * 64 + 16 * tj + l15] = acc[r] + dsk[h] * xs[r]; }
            bf16* st = ST + ((size_t)((b * NCH + c) * 8 + h)) * 64 * 128;
#pragma unroll
            for (int tt = 0; tt < 4; ++tt) { const int tile = w * 4 + tt, ti = tile >> 2, tj = tile & 3;
                const f32x4 acc = tile_bf(BT + 16 * ti * RS, RS, xd + 16 * tj * RS, RS, 64, (f32x4){0.f, 0.f, 0.f, 0.f}, l15, q4);
                st_bf16x4(st + (16 * tj + l15) * 128 + 16 * ti + 4 * q4, acc); }
        }
    }
    __syncthreads();
}
__device__ __forceinline__ void phase_ssd_s23(const Frame& F, const Args& A) {
    const bf16* ST = WSP(bf16, S_ST); float* YO = WSP(float, S_YO); const unsigned char* SCB = WSP(unsigned char, S_C); const float* AC = WSP(float, S_AC);
    LAS bf16* Cimg = (LAS bf16*)F.lds; LAS bf16* Hb = Cimg + 2 * 64 * SB;
    const int tid = F.tid, lane = F.lane, w = F.wave, l15 = lane & 15, q4 = lane >> 4;
    const int nunits = BH * 8 * 4, hp = tid >> 5, hn = 4 * (tid & 31);
    constexpr int NCK = SC_IMG / 16;
    for (int unit = F.bid; unit < nunits; unit += F.G) {
        const int ps = unit & 3, h = (unit >> 2) & 7, b = unit >> 5, g = h >> 2;
        __syncthreads();
        f32x4 Hr = (f32x4){0.f, 0.f, 0.f, 0.f};
        u32x4 preA[3], preB[3]; u32x2 pstA, pstB, stc; float eaA[5], eaB[5], eac[5];
        const size_t tokb = (size_t)b * SEQ;
#define S23_LOAD(S, cc) do { const unsigned char* src_ = SCB + (size_t)((b * NCH + (cc)) * 2 + g) * SC_IMG; \
            _Pragma("unroll") for (int q = 0; q < 3; ++q) { const int e = tid + 512 * q; if (e < NCK) pre##S[q] = *(const u32x4*)(src_ + (size_t)e * 16); } \
            pst##S = *(const u32x2*)(ST + ((size_t)((b * NCH + (cc)) * 8 + h)) * 8192 + (16 * ps + hp) * 128 + hn); \
            _Pragma("unroll") for (int r = 0; r < 4; ++r) ea##S[r] = AC[(tokb + (size_t)(cc) * 64 + 16 * (w & 3) + 4 * q4 + r) * 8 + h]; \
            ea##S[4] = AC[(tokb + (size_t)(cc) * 64 + 63) * 8 + h]; } while (0)
#define S23_STORE(S, dst) do { _Pragma("unroll") for (int q = 0; q < 3; ++q) { const int e = tid + 512 * q; if (e < NCK) ((LAS u32x4*)(dst))[e] = pre##S[q]; } } while (0)
#define S23_TAKE(S) do { stc = pst##S; _Pragma("unroll") for (int r = 0; r < 5; ++r) eac[r] = ea##S[r]; } while (0)
        S23_LOAD(A, 0); S23_STORE(A, Cimg); S23_TAKE(A);
        if (NCH > 1) S23_LOAD(A, 1);
#define S23_STEP(c, LS, SS) do { \
            const size_t tok0 = tokb + (size_t)(c) * 64; \
            if ((c) + 2 < NCH) S23_LOAD(LS, (c) + 2); \
            st_bf16x4((bf16*)(Hb + hp * SB + hn), Hr); \
            __syncthreads(); \
            if (w < 4) { const LAS bf16* Ci = Cimg + ((c) & 1) * 64 * SB; \
                const f32x4 acc = tile_bf(Ci + 16 * w * SB, SB, Hb, SB, 128, (f32x4){0.f, 0.f, 0.f, 0.f}, l15, q4); \
                _Pragma("unroll") for (int r = 0; r < 4; ++r) { const size_t tok = tok0 + 16 * w + 4 * q4 + r; YO[tok * 512 + h * 64 + 16 * ps + l15] = acc[r] * expf(eac[r]); } } \
            { const float dec = expf(eac[4]); Hr.x = dec * Hr.x + bf2f(stc.x & 0xffffu); Hr.y = dec * Hr.y + bf2f(stc.x >> 16); Hr.z = dec * Hr.z + bf2f(stc.y & 0xffffu); Hr.w = dec * Hr.w + bf2f(stc.y >> 16); } \
            if ((c) + 1 < NCH) { S23_STORE(SS, Cimg + (((c) + 1) & 1) * 64 * SB); S23_TAKE(SS); } \
            __syncthreads(); } while (0)
        for (int c = 0; c < NCH; c += 2) { S23_STEP(c, B, A); S23_STEP(c + 1, A, B); }
#undef S23_STEP
#undef S23_TAKE
#undef S23_STORE
#undef S23_LOAD
    }
    __syncthreads();
}
__device__ __forceinline__ void phase_ssd_s4(const Frame& F, const Args& A, int layer) {
    const float* YD = WSP(float, S_YD); const float* YO = WSP(float, S_YO); const bf16* P = WSP(bf16, A_P); bf16* Y = WSP(bf16, A_Y) + (size_t)3 * TH * 512; const float* nw = A.in[28] + layer * 512;
    const int lane = F.lane, c0 = 8 * lane;
    for (int m = F.gw; m < TH; m += F.NGW) {
        const f32x4 a = *(const f32x4*)(YD + (size_t)m * 512 + c0) + *(const f32x4*)(YO + (size_t)m * 512 + c0), b2 = *(const f32x4*)(YD + (size_t)m * 512 + c0 + 4) + *(const f32x4*)(YO + (size_t)m * 512 + c0 + 4);
        const f32x4 z0 = ld_bf16x4(P + (size_t)m * PW + C_SSD + c0), z1 = ld_bf16x4(P + (size_t)m * PW + C_SSD + c0 + 4);
        float y[8] = {a.x * siluf_(z0.x), a.y * siluf_(z0.y), a.z * siluf_(z0.z), a.w * siluf_(z0.w), b2.x * siluf_(z1.x), b2.y * siluf_(z1.y), b2.z * siluf_(z1.z), b2.w * siluf_(z1.w)};
        float ss = 0.f;
#pragma unroll
        for (int q = 0; q < 8; ++q) ss += y[q] * y[q];
        ss += __shfl_xor(ss, 1); ss += __shfl_xor(ss, 2); ss += __shfl_xor(ss, 4); ss += __shfl_xor(ss, 8); ss += __shfl_xor(ss, 16);
        const float rstd = 1.0f / sqrtf(ss * (1.0f / 256.0f) + EPS);
#pragma unroll
        for (int q = 0; q < 8; ++q) y[q] = y[q] * rstd * nw[c0 + q];
        u32x4 wv; wv.x = pk2(y[0], y[1]); wv.y = pk2(y[2], y[3]); wv.z = pk2(y[4], y[5]); wv.w = pk2(y[6], y[7]);
        *(u32x4*)(Y + (size_t)m * 512 + c0) = wv;
    }
}

__device__ __forceinline__ f32x4 tile_mm(const LAS float* a, int lda, int ska, const LAS float* b, int ldb, int scb, int K, f32x4 acc, int l15, int q4) {
    const LAS float* ap = a + l15 * lda + q4 * ska; const LAS float* bp = b + q4 * ldb + l15 * scb;
#pragma unroll 8
    for (int ks = 0; ks < K / 4; ++ks) acc = MFMA_F32(ap[ks * 4 * ska], bp[ks * 4 * ldb], acc);
    return acc;
}
constexpr int GS = 132, GS2 = 68;
constexpr int GR_W = 0, GR_QH = 64 * 136 * 2, GR_KT = 2 * 64 * 136 * 2, GR_QK = GR_KT + 128 * 72 * 2, GR_GL = GR_QK + 64 * 72 * 2, GR_COMMON = GR_GL + 16, GR_UT = 128 * 64 * 2, GR_BYTES = GR_COMMON + GR_UT;
static_assert(GR_BYTES == 78864 && GR_COMMON % 16 == 0, "GDN record");
constexpr int GX = 264;
__device__ __forceinline__ void phase_gdn_g1(const Frame& F, const Args& A, int layer) {
    const bf16* P = WSP(bf16, A_P); unsigned char* CHR = WSP(unsigned char, G_CH);
    const float* convw = A.in[19] + (size_t)layer * 4 * 1536; const float* a_log = A.in[20] + layer * 4; const float* dtb = A.in[21] + layer * 4;
    LAS bf16* qb = (LAS bf16*)F.lds; LAS bf16* kb = qb + 64 * SB; LAS bf16* qkimg = kb + 64 * SB;
    LAS float* X = (LAS float*)(qkimg + 64 * RS); LAS float* Lm = X + 64 * GX; LAS float* ssq = Lm + 64 * GS2;
    LAS float* beta = ssq + 2 * 64 * 16; LAS float* gc = beta + 64; LAS float* egc = gc + 64; LAS float* inorm = egc + 64;
    const int tid = F.tid, lane = F.lane, w = F.wave, l15 = lane & 15, q4 = lane >> 4;
    const int nunits = BH * 4 * NCH;
    for (int unit = F.bid; unit < nunits; unit += F.G) {
        const int c = unit % NCH, h = (unit / NCH) & 3, b = unit / (NCH * 4);
        const size_t tok0 = (size_t)b * SEQ + (size_t)c * 64;
        unsigned char* rec = CHR + (size_t)unit * GR_BYTES;
        __syncthreads();
        const int rb = tid / 48, pc = tid % 48, part = pc >> 4, cgl = pc & 15;
        float o[8][8];
        if (tid < 384) { const int col = part * 512 + h * 128 + 8 * cgl;
            conv8x8(P + (tok0 + 8 * rb) * PW + C_GDN + col, c * 64 + 8 * rb, convw + col, 1536, nullptr, o);
            if (part < 2) {
#pragma unroll
                for (int i = 0; i < 8; ++i) { float sacc = 0.f;
#pragma unroll
                    for (int ch = 0; ch < 8; ++ch) sacc += o[i][ch] * o[i][ch];
                    ssq[(part * 64 + 8 * rb + i) * 16 + cgl] = sacc; } } }
        if (w == 7) { const size_t tok = tok0 + lane; beta[lane] = sigmoidf_(bf2f(P[tok * PW + C_GDN + 1536 + h]));
            float g = -expf(a_log[h]) * softplusf_(bf2f(P[tok * PW + C_GDN + 1540 + h]) + dtb[h]);
#pragma unroll
            for (int o2 = 1; o2 < 64; o2 <<= 1) { const float t = __shfl_up(g, o2); if (lane >= o2) g += t; }
            gc[lane] = g; egc[lane] = expf(g); }
        __syncthreads();
        if (tid < 128) { float sacc = 0.f;
#pragma unroll
            for (int i = 0; i < 16; ++i) sacc += ssq[tid * 16 + i];
            inorm[tid] = (tid < 64 ? 0.08838834764831845f : 1.0f) / sqrtf(sacc + EPS); }
        __syncthreads();
        if (tid < 384) {
#pragma unroll
            for (int i = 0; i < 8; ++i) { const int l = 8 * rb + i;
                if (part < 2) { const float sc = inorm[part * 64 + l]; float v[8];
#pragma unroll
                    for (int ch = 0; ch < 8; ++ch) v[ch] = o[i][ch] * sc;
                    *(LAS u32x4*)((part ? kb : qb) + l * SB + 8 * cgl) = pack8(v); }
                else { const float bl = beta[l]; *(LAS f32x4*)(X + l * GX + 8 * cgl) = (f32x4){o[i][0] * bl, o[i][1] * bl, o[i][2] * bl, o[i][3] * bl}; *(LAS f32x4*)(X + l * GX + 8 * cgl + 4) = (f32x4){o[i][4] * bl, o[i][5] * bl, o[i][6] * bl, o[i][7] * bl}; } } }
        __syncthreads();
        for (int tt = 0; tt < 4; ++tt) { const int tile = w * 4 + tt, which = tile >> 4, ti = (tile >> 2) & 3, tj = tile & 3;
            f32x4 acc = (f32x4){0.f, 0.f, 0.f, 0.f};
            if (tj <= ti) acc = tile_bf((which ? qb : kb) + 16 * ti * SB, SB, kb + 16 * tj * SB, SB, 128, acc, l15, q4);
#pragma unroll
            for (int r = 0; r < 4; ++r) { const int i = 16 * ti + 4 * q4 + r, j = 16 * tj + l15; float v = 0.f;
                if (which ? (j <= i) : (j < i)) v = acc[r] * expf(gc[i] - gc[j]) * (which ? 1.0f : beta[i]);
                if (which) qkimg[i * RS + j] = (bf16)f2bf(v); else Lm[i * GS2 + j] = v; } }
        { const float glast = gc[63];
          for (int e = tid; e < 64 * 16; e += 512) { const int l = e >> 4, d0 = 8 * (e & 15); const u32x4 kv = *(const LAS u32x4*)(kb + l * SB + d0), qv = *(const LAS u32x4*)(qb + l * SB + d0);
              const float kf[8] = {bf2f(kv.x & 0xffffu), bf2f(kv.x >> 16), bf2f(kv.y & 0xffffu), bf2f(kv.y >> 16), bf2f(kv.z & 0xffffu), bf2f(kv.z >> 16), bf2f(kv.w & 0xffffu), bf2f(kv.w >> 16)};
              float qf[8] = {bf2f(qv.x & 0xffffu), bf2f(qv.x >> 16), bf2f(qv.y & 0xffffu), bf2f(qv.y >> 16), bf2f(qv.z & 0xffffu), bf2f(qv.z >> 16), bf2f(qv.w & 0xffffu), bf2f(qv.w >> 16)};
              const float sc = beta[l] * egc[l], eg = egc[l];
              *(LAS f32x4*)(X + l * GX + 128 + d0) = (f32x4){kf[0] * sc, kf[1] * sc, kf[2] * sc, kf[3] * sc}; *(LAS f32x4*)(X + l * GX + 132 + d0) = (f32x4){kf[4] * sc, kf[5] * sc, kf[6] * sc, kf[7] * sc};
#pragma unroll
              for (int q = 0; q < 8; ++q) qf[q] *= eg;
              *(u32x4*)(rec + GR_QH + (size_t)(l * SB + d0) * 2) = pack8(qf); }
          for (int e = tid; e < 128 * 8; e += 512) { const int d = e >> 3, l0 = 8 * (e & 7); float kt[8];
#pragma unroll
              for (int q = 0; q < 8; ++q) kt[q] = bf2f(kb[(l0 + q) * SB + d]) * expf(glast - gc[l0 + q]);
              *(u32x4*)(rec + GR_KT + (size_t)(d * RS + l0) * 2) = pack8(kt); }
          if (tid == 0) *(float*)(rec + GR_GL) = expf(glast); }
        __syncthreads();
        for (int e = tid; e < 64 * RS / 8; e += 512) ((u32x4*)(rec + GR_QK))[e] = ((const LAS u32x4*)qkimg)[e];
        for (int rbk = 0; rbk < 4; ++rbk) {
            if (rbk > 0) {
#pragma unroll
                for (int t2 = 0; t2 < 2; ++t2) { const int tj = 2 * w + t2;
                    const f32x4 acc = tile_mm(Lm + 16 * rbk * GS2, GS2, 1, X + 16 * tj, GX, 1, 16 * rbk, (f32x4){0.f, 0.f, 0.f, 0.f}, l15, q4);
#pragma unroll
                    for (int r = 0; r < 4; ++r) X[(16 * rbk + 4 * q4 + r) * GX + 16 * tj + l15] -= acc[r]; }
                __syncthreads();
            }
            if (tid < 256) { float x[16];
#pragma unroll
                for (int i = 0; i < 16; ++i) { float sacc = X[(16 * rbk + i) * GX + tid];
#pragma unroll
                    for (int j = 0; j < i; ++j) sacc -= Lm[(16 * rbk + i) * GS2 + 16 * rbk + j] * x[j];
                    x[i] = sacc; }
#pragma unroll
                for (int i = 0; i < 16; ++i) X[(16 * rbk + i) * GX + tid] = x[i]; }
            __syncthreads();
        }
        for (int e = tid; e < 64 * 16; e += 512) { const int l = e >> 4, d0 = 8 * (e & 15); const f32x4 a = *(const LAS f32x4*)(X + l * GX + 128 + d0), b2 = *(const LAS f32x4*)(X + l * GX + 132 + d0);
            const float v[8] = {a.x, a.y, a.z, a.w, b2.x, b2.y, b2.z, b2.w}; *(u32x4*)(rec + GR_W + (size_t)(l * SB + d0) * 2) = pack8(v); }
        for (int e = tid; e < 128 * 8; e += 512) { const int vv = e >> 3, t0 = 8 * (e & 7); float v[8];
#pragma unroll
            for (int q = 0; q < 8; ++q) v[q] = X[(t0 + q) * GX + vv];
            *(u32x4*)((bf16*)(rec + GR_COMMON) + vv * 64 + t0) = pack8(v); }
    }
    __syncthreads();
}
constexpr int G2_STAGE = GR_COMMON;
__device__ __forceinline__ void phase_gdn_g2(const Frame& F, const Args& A) {
    const unsigned char* CHR = WSP(unsigned char, G_CH); float* GO = WSP(float, G_O);
    LAS unsigned char* buf0 = F.lds; LAS bf16* STt = (LAS bf16*)(F.lds + 2 * G2_STAGE); LAS bf16* vnT = STt + 2 * 32 * SB;
    const int tid = F.tid, lane = F.lane, w = F.wave, l15 = lane & 15, q4 = lane >> 4, ti = w >> 1, tj = w & 1;
    const int nunits = BH * 4 * 4;
    constexpr int NCK = G2_STAGE / 16;
    for (int unit = F.bid; unit < nunits; unit += F.G) {
        const int vs = unit & 3, h = (unit >> 2) & 3, b = unit >> 4;
        __syncthreads();
        for (int e = tid; e < 2 * 32 * SB / 2; e += 512) ((LAS unsigned*)STt)[e] = 0u;
        f32x4 Sreg[2] = {(f32x4){0.f, 0.f, 0.f, 0.f}, (f32x4){0.f, 0.f, 0.f, 0.f}};
        u32x4 preA[8], preB[8]; u32x2 uiniA, uiniB, ucur;
        const unsigned char* rec0 = CHR + (size_t)((b * 4 + h) * NCH) * GR_BYTES;
        const int uofs = GR_COMMON + ((32 * vs + 16 * tj + l15) * 64 + 16 * ti + 4 * q4) * 2;
#define G2_LOAD(S, recp) do { _Pragma("unroll") for (int q = 0; q < 8; ++q) { const int e = tid + 512 * q; if (e < NCK) pre##S[q] = *(const u32x4*)((recp) + (size_t)e * 16); } uini##S = *(const u32x2*)((recp) + uofs); } while (0)
#define G2_STORE(S, dst) do { _Pragma("unroll") for (int q = 0; q < 8; ++q) { const int e = tid + 512 * q; if (e < NCK) *(LAS u32x4*)((dst) + (size_t)e * 16) = pre##S[q]; } } while (0)
        G2_LOAD(A, rec0); G2_STORE(A, buf0); ucur = uiniA;
        if (NCH > 1) G2_LOAD(A, rec0 + (size_t)GR_BYTES);
        __syncthreads();
#define G2_STEP(c, LS, SS) do { \
            LAS unsigned char* buf = buf0 + ((c) & 1) * G2_STAGE; LAS unsigned char* nbuf = buf0 + (((c) + 1) & 1) * G2_STAGE; \
            if ((c) + 2 < NCH) G2_LOAD(LS, rec0 + (size_t)((c) + 2) * GR_BYTES); \
            const LAS bf16* Wi = (const LAS bf16*)(buf + GR_W); const LAS bf16* QH = (const LAS bf16*)(buf + GR_QH); const LAS bf16* KT = (const LAS bf16*)(buf + GR_KT); const LAS bf16* QK = (const LAS bf16*)(buf + GR_QK); \
            const float egl = *(const LAS float*)(buf + GR_GL); \
            const LAS bf16* S0 = STt + ((c) & 1) * 32 * SB; LAS bf16* S1 = STt + (((c) + 1) & 1) * 32 * SB; \
            { const f32x4 acc = tile_bf(Wi + 16 * ti * SB, SB, S0 + 16 * tj * SB, SB, 128, (f32x4){0.f, 0.f, 0.f, 0.f}, l15, q4); \
              const f32x4 vn = (f32x4){bf2f(ucur.x & 0xffffu), bf2f(ucur.x >> 16), bf2f(ucur.y & 0xffffu), bf2f(ucur.y >> 16)} - acc; \
              u32x2 pk; pk.x = pk2(vn[0], vn[1]); pk.y = pk2(vn[2], vn[3]); *(LAS u32x2*)(vnT + (16 * tj + l15) * RS + 16 * ti + 4 * q4) = pk; } \
            __syncthreads(); \
            { f32x4 acc = tile_bf(QH + 16 * ti * SB, SB, S0 + 16 * tj * SB, SB, 128, (f32x4){0.f, 0.f, 0.f, 0.f}, l15, q4); \
              acc = tile_bf(QK + 16 * ti * RS, RS, vnT + 16 * tj * RS, RS, 64, acc, l15, q4); \
              _Pragma("unroll") for (int r = 0; r < 4; ++r) GO[((size_t)b * SEQ + (size_t)(c) * 64 + 16 * ti + 4 * q4 + r) * 512 + h * 128 + 32 * vs + 16 * tj + l15] = acc[r]; } \
            _Pragma("unroll") for (int t2 = 0; t2 < 2; ++t2) { Sreg[t2] = Sreg[t2] * egl; \
                Sreg[t2] = tile_bf(KT + 16 * w * RS, RS, vnT + 16 * t2 * RS, RS, 64, Sreg[t2], l15, q4); \
                u32x2 pk; pk.x = pk2(Sreg[t2][0], Sreg[t2][1]); pk.y = pk2(Sreg[t2][2], Sreg[t2][3]); *(LAS u32x2*)(S1 + (16 * t2 + l15) * SB + 16 * w + 4 * q4) = pk; } \
            if ((c) + 1 < NCH) { G2_STORE(SS, nbuf); ucur = uini##SS; } \
            __syncthreads(); } while (0)
        for (int c = 0; c < NCH; c += 2) { G2_STEP(c, B, A); G2_STEP(c + 1, A, B); }
#undef G2_STEP
#undef G2_STORE
#undef G2_LOAD
    }
    __syncthreads();
}
__device__ __forceinline__ void phase_gdn_g3(const Frame& F, const Args& A, int layer) {
    const float* GO = WSP(float, G_O); const bf16* P = WSP(bf16, A_P); bf16* Y = WSP(bf16, A_Y) + (size_t)2 * TH * 512; const float* nw = A.in[22] + layer * 128;
    const int lane = F.lane, c0 = 8 * lane;
    for (int m = F.gw; m < TH; m += F.NGW) {
        const f32x4 a = *(const f32x4*)(GO + (size_t)m * 512 + c0), b2 = *(const f32x4*)(GO + (size_t)m * 512 + c0 + 4);
        float o[8] = {a.x, a.y, a.z, a.w, b2.x, b2.y, b2.z, b2.w}; float ss = 0.f;
#pragma unroll
        for (int q = 0; q < 8; ++q) ss += o[q] * o[q];
        ss += __shfl_xor(ss, 1); ss += __shfl_xor(ss, 2); ss += __shfl_xor(ss, 4); ss += __shfl_xor(ss, 8);
        const float rstd = 1.0f / sqrtf(ss * (1.0f / 128.0f) + EPS);
        const f32x4 z0 = ld_bf16x4(P + (size_t)m * PW + C_GDN + 1544 + c0), z1 = ld_bf16x4(P + (size_t)m * PW + C_GDN + 1544 + c0 + 4);
        const float z[8] = {z0.x, z0.y, z0.z, z0.w, z1.x, z1.y, z1.z, z1.w}; float y[8];
#pragma unroll
        for (int q = 0; q < 8; ++q) y[q] = o[q] * rstd * nw[(c0 + q) & 127] * siluf_(z[q]);
        u32x4 wv; wv.x = pk2(y[0], y[1]); wv.y = pk2(y[2], y[3]); wv.z = pk2(y[4], y[5]); wv.w = pk2(y[6], y[7]);
        *(u32x4*)(Y + (size_t)m * 512 + c0) = wv;
    }
}

__device__ __forceinline__ void phase_merge_z(const Frame& F, const Args& A) {
    pg8::Gemm g{WSP(bf16, A_Y), WSP(bf16, W_BR), 512, 512}; BranchOrder S; S.nP = TH / 256; S.G = F.G; S.c = F.bid;
    EpiZ E{WSP(bf16, A_Z)}; pg8::gemm_phase(F.lds, g, S, E, F.tid);
}
__device__ __forceinline__ void phase_merge_gate(const Frame& F, const Args& A, int layer) {
    pg8::Gemm g{WSP(bf16, A_H), WSP(bf16, W_GATE), D, D}; pg8::StaticOrder S; S.init(TH, 4096, F.G, F.bid);
    EpiMerge E{WSP(bf16, A_Z), A.in[29] + (size_t)layer * 4 * D, WSP(bf16, A_MG)}; pg8::gemm_phase(F.lds, g, S, E, F.tid);
#if 1
    if (((REPEAT_MASK) >> 28) & 1u) { __syncthreads(); EpiBf16 E2{WSP(bf16, A_MIX + (size_t)64 * MiB), 4096, nullptr, 0}; pg8::gemm_phase(F.lds, g, S, E2, F.tid); }
#endif
}
__device__ __forceinline__ void phase_merge_out(const Frame& F, const Args& A, const float* xin, float* xout) {
    pg8::Gemm g{WSP(bf16, A_MG), WSP(bf16, W_OUT), D, D}; pg8::StaticOrder S; S.init(TH, D, F.G, F.bid);
    EpiResidual E{xin, xout}; pg8::gemm_phase(F.lds, g, S, E, F.tid);
}
__device__ __forceinline__ void phase_ffn_gu(const Frame& F, const Args& A) {
    pg8::Gemm g{WSP(bf16, A_H), WSP(bf16, W_FGU), D, D}; pg8::StaticOrder S; S.init(TH, 2 * FF_D, F.G, F.bid);
    EpiSwiGLU E{WSP(bf16, F_ACT), FF_D, 1 << 20}; pg8::gemm_phase(F.lds, g, S, E, F.tid);
}
__device__ __forceinline__ void phase_ffn_down(const Frame& F, const Args& A, float* x) {
    pg8::Gemm g{WSP(bf16, F_ACT), WSP(bf16, W_FDN), FF_D, FF_D}; pg8::StaticOrder S; S.init(TH, D, F.G, F.bid);
    EpiResidual E{x, x}; pg8::gemm_phase(F.lds, g, S, E, F.tid);
}
struct MoeLayout { int pstart[NEXP + 1]; };
__device__ __forceinline__ MoeLayout moe_layout(const unsigned* cnt) {
    MoeLayout L; int s = 0;
#pragma unroll
    for (int e = 0; e < NEXP; ++e) { L.pstart[e] = s; s += ((int)cnt[e] + 255) & ~255; }
    L.pstart[NEXP] = s; return L;
}
struct MoeOrder {
    int np, nN, G, c; MoeLayout L;
    __device__ bool next(int i, Unit& u) const {
        const long Lx = (long)i * G + c; if (Lx >= (long)np * nN) return false;
        const int pm = (int)(Lx / nN), pn = (int)(Lx % nN); int e = 0;
#pragma unroll
        for (int k = 1; k < NEXP; ++k) if (pm * 256 >= L.pstart[k]) e = k;
        u.pm = pm; u.pn = e * nN + pn; return true;
    }
    __device__ __forceinline__ void a_ready(const Unit&) const {}
    __device__ __forceinline__ void done(const Unit&) const {}
};
__device__ __forceinline__ void phase_moe_route(const Frame& F, const Args& A, int half) {
    const unsigned* wgc = F.ctl + CW_WGC + half * 8192; unsigned* cnt = F.ctl + CW_CNT + half * 16;
    LAS unsigned* tab = (LAS unsigned*)F.lds; LAS unsigned* tot = tab + 8192; LAS unsigned* bef = tot + 8; LAS unsigned* cur = bef + 8;
    __syncthreads();
    for (int e = F.tid; e < F.G * 8; e += 512) tab[e] = wgc[e];
    __syncthreads();
    if (F.tid < 8) { unsigned t = 0, bsum = 0; for (int g = 0; g < F.G; ++g) { const unsigned v = tab[g * 8 + F.tid]; if (g < F.bid) bsum += v; t += v; } tot[F.tid] = t; bef[F.tid] = bsum; cur[F.tid] = 0u; if (F.bid == 0) cnt[F.tid] = t; }
    __syncthreads();
    unsigned totr[8];
#pragma unroll
    for (int e = 0; e < 8; ++e) totr[e] = tot[e];
    const MoeLayout L = moe_layout(totr);
    const bf16* H = WSP(bf16, A_H); bf16* GA = WSP(bf16, F_GA); const int* tope = WSP(int, F_TOPE); int* slot = WSP(int, F_SLOT);
    const int lane = F.lane;
    for (int m = F.gw; m < TH; m += F.NGW) {
        const u32x4 v0 = *(const u32x4*)(H + (size_t)m * D + 8 * lane), v1 = *(const u32x4*)(H + (size_t)m * D + 512 + 8 * lane);
#pragma unroll
        for (int k = 0; k < 2; ++k) { const int e = tope[2 * m + k]; int s = 0;
            int ps = 0;
#pragma unroll
            for (int q = 0; q < NEXP; ++q) ps = (e == q) ? L.pstart[q] : ps;
            if (lane == 0) s = ps + (int)bef[e] + (int)ATOMIC_ADD_LDS(cur + e, 1u);
            s = __shfl(s, 0);
            if (lane == 0) slot[2 * m + k] = s;
            *(u32x4*)(GA + (size_t)s * D + 8 * lane) = v0; *(u32x4*)(GA + (size_t)s * D + 512 + 8 * lane) = v1; }
    }
#pragma unroll
    for (int e = 0; e < NEXP; ++e) { const int r0 = L.pstart[e] + (int)totr[e], r1 = L.pstart[e + 1];
        for (int r = r0 + F.gw; r < r1; r += F.NGW) { *(u32x4*)(GA + (size_t)r * D + 8 * lane) = (u32x4){0u, 0u, 0u, 0u}; *(u32x4*)(GA + (size_t)r * D + 512 + 8 * lane) = (u32x4){0u, 0u, 0u, 0u}; } }
    __syncthreads();
}
__device__ __forceinline__ void phase_moe_gu(const Frame& F, const Args& A, int half) {
    MoeOrder S; S.L = moe_layout(F.ctl + CW_CNT + half * 16); S.np = S.L.pstart[NEXP] / 256; S.nN = 2 * FF_E / 256; S.G = F.G; S.c = F.bid;
    pg8::Gemm g{WSP(bf16, F_GA), WSP(bf16, W_FGU), D, D}; EpiSwiGLU E{WSP(bf16, F_ACT), FF_E, 2 * FF_E / 256}; pg8::gemm_phase(F.lds, g, S, E, F.tid);
}
struct EpiF32Mod {
    static constexpr bool PERM = false, AFTER_DRAIN = false;
    float* C;
    __device__ __forceinline__ void operator()(const f32x4 (&acc)[2][2][4][2], const Unit& u, int wr, int wc, int fr, int fq) const {
        const int row0 = u.pm * 256 + wr * 64 + fr, col0 = (u.pn & 3) * 256 + wc * 32 + 4 * fq;
#pragma unroll
        for (int ai = 0; ai < 2; ++ai)
#pragma unroll
            for (int m = 0; m < 4; ++m) { float* rowp = C + (size_t)(row0 + ai * HALFT + m * 16) * D + col0;
#pragma unroll
                for (int bj = 0; bj < 2; ++bj)
#pragma unroll
                    for (int n = 0; n < 2; ++n) *(f32x4*)(rowp + bj * HALFT + n * 16) = acc[ai][bj][m][n]; }
    }
};
__device__ __forceinline__ void phase_moe_down(const Frame& F, const Args& A, int half) {
    MoeOrder S; S.L = moe_layout(F.ctl + CW_CNT + half * 16); S.np = S.L.pstart[NEXP] / 256; S.nN = D / 256; S.G = F.G; S.c = F.bid;
    pg8::Gemm g{WSP(bf16, F_ACT), WSP(bf16, W_FDN), FF_E, FF_E}; EpiF32Mod E{WSP(float, F_YE)}; pg8::gemm_phase(F.lds, g, S, E, F.tid);
}
__device__ __forceinline__ void phase_moe_combine(const Frame& F, const Args& A, float* x, const float* fgain) {
    const float* YE = WSP(float, F_YE); const int* slot = WSP(int, F_SLOT); const float* topw = WSP(float, F_TOPW); const int lane = F.lane;
    for (int m = F.gw; m < TH; m += F.NGW) { const int s0 = slot[2 * m], s1 = slot[2 * m + 1]; const float w0 = topw[2 * m], w1 = topw[2 * m + 1];
        f32x4 v[4]; float ss = 0.f;
#pragma unroll
        for (int j = 0; j < 4; ++j) { const int c = 4 * lane + 256 * j;
            v[j] = *(const f32x4*)(x + (size_t)m * D + c) + *(const f32x4*)(YE + (size_t)s0 * D + c) * w0 + *(const f32x4*)(YE + (size_t)s1 * D + c) * w1;
            ss += (v[j].x * v[j].x + v[j].y * v[j].y) + (v[j].z * v[j].z + v[j].w * v[j].w); }
        if (fgain) { const float rstd = 1.0f / sqrtf(wave_sum(ss) * (1.0f / D) + EPS);
#pragma unroll
            for (int j = 0; j < 4; ++j) v[j] = v[j] * rstd * *(const f32x4*)(fgain + 4 * lane + 256 * j); }
#pragma unroll
        for (int j = 0; j < 4; ++j) *(f32x4*)(x + (size_t)m * D + 4 * lane + 256 * j) = v[j]; }
}

#ifndef EMU
#define XB_TMO      128
#define XB_XCNT(j)  (256  + 64 * (j))
#define XB_XSUB(j)  (1280 + 64 * (j))
#define XB_XGEN(j)  (2304 + 64 * (j))
#define XB_TOP      3328
#define XB_TOPGEN   3392
#define XCD_BAR_WORDS 3456
#define XB_SPIN_CAP (1u << 22)
__device__ __forceinline__ unsigned xb_ld(unsigned* p)              { return __hip_atomic_load(p, __ATOMIC_RELAXED, __HIP_MEMORY_SCOPE_AGENT); }
__device__ __forceinline__ unsigned xb_add(unsigned* p, unsigned v) { return __hip_atomic_fetch_add(p, v, __ATOMIC_RELAXED, __HIP_MEMORY_SCOPE_AGENT); }
__device__ __forceinline__ unsigned xb_xcc_id() { return (unsigned)__builtin_amdgcn_s_getreg((3 << 11) | 20) & 0xFu; }
#define XB_SPIN(cond, bar) do { unsigned _sp = 0; while (cond) { __builtin_amdgcn_s_sleep(1); \
    if ((++_sp & 255u) == 0u) { if (xb_ld(&(bar)[XB_TMO])) break; if (_sp > XB_SPIN_CAP) { atomicAdd(&(bar)[XB_TMO], 1u); break; } } } } while (0)
struct XcdBarrier { unsigned* bar; unsigned x; volatile LAS unsigned* st; };
__device__ __forceinline__ XcdBarrier xcd_barrier_post(unsigned* bar, volatile LAS unsigned* st) {
    XcdBarrier b; b.bar = bar; b.x = xb_xcc_id(); b.st = st;
    if (threadIdx.x == 0) (void)xb_add(&bar[XB_XCNT(b.x)], 1u);
    return b;
}
__device__ __forceinline__ void xcd_barrier_complete(unsigned* bar, unsigned x, unsigned& nloc, unsigned& nx) {
    const unsigned G = gridDim.x * gridDim.y * gridDim.z;
    unsigned sum, cnt, mine, sp = 0u;
    for (;;) {
        sum = 0u; cnt = 0u; mine = 0u;
#pragma unroll
        for (unsigned j = 0; j < 16; ++j) { const unsigned c = xb_ld(&bar[XB_XCNT(j)]); sum += c; cnt += (c > 0u) ? 1u : 0u; mine = (j == x) ? c : mine; }
        if (sum == G) break;
        __builtin_amdgcn_s_sleep(1);
        if ((++sp & 255u) == 0u) { if (xb_ld(&bar[XB_TMO])) break; if (sp > XB_SPIN_CAP) { atomicAdd(&bar[XB_TMO], 1u); break; } }
    }
    nloc = mine > 0u ? mine : 1u; nx = cnt > 0u ? cnt : 1u;
}
__device__ __forceinline__ void xcd_barrier(const XcdBarrier& b) {
    asm volatile("s_waitcnt vmcnt(0)" ::: "memory");
    __syncthreads();
    if (threadIdx.x == 0) {
        unsigned* bar = b.bar;
        __builtin_amdgcn_s_waitcnt(0);
        unsigned nloc = b.st[0], nx = b.st[1];
        if (nloc == 0u) { xcd_barrier_complete(bar, b.x, nloc, nx); b.st[0] = nloc; b.st[1] = nx; }
        const unsigned old = xb_add(&bar[XB_XSUB(b.x)], 1u);
        const unsigned gen = old / nloc;
        if (old + 1u == (gen + 1u) * nloc) {
            __builtin_amdgcn_fence(__ATOMIC_RELEASE, "agent");
            asm volatile("s_waitcnt vmcnt(0)" ::: "memory");
            const unsigned og = xb_add(&bar[XB_TOP], 1u);
            const unsigned tg = og / nx;
            if (og + 1u == (tg + 1u) * nx) xb_add(&bar[XB_TOPGEN], 1u);
            else XB_SPIN(xb_ld(&bar[XB_TOPGEN]) == tg, bar);
            __builtin_amdgcn_fence(__ATOMIC_ACQUIRE, "agent");
            xb_add(&bar[XB_XGEN(b.x)], 1u);
            asm volatile("s_waitcnt vmcnt(0)" ::: "memory");
        } else {
            XB_SPIN(xb_ld(&bar[XB_XGEN(b.x)]) == gen, bar);
            __builtin_amdgcn_fence(__ATOMIC_ACQUIRE, "agent");
            asm volatile("s_waitcnt vmcnt(0)" ::: "memory");
        }
    }
    __syncthreads();
}
#endif

constexpr int NPH = 17;
constexpr int NPHASES = DEPTH * (1 + NHALF * NPH);
constexpr int LDS_BYTES = 155648, MISC_OFF = 154624;

__global__ void __launch_bounds__(512, 2) fwd_kernel(Args args_k) {
#ifdef EMU
    unsigned char* lds = emu_lds_ptr;
#else
    extern __shared__ __attribute__((aligned(16))) unsigned char lds[];
#endif
    Frame F0;
    F0.lds = (LAS unsigned char*)lds; F0.tid = threadIdx.x; F0.lane = F0.tid & 63; F0.wave = RFL(F0.tid >> 6); F0.G = gridDim.x; F0.bid = blockIdx.x;
    F0.gw = F0.bid * 8 + F0.wave; F0.NGW = F0.G * 8;
    F0.out = args_k.out; F0.ws = args_k.ws; F0.ctl = (unsigned*)(args_k.ws + WS_CTL);
    const int lo = args_k.lo, hi = args_k.hi;
#ifndef EMU
    volatile LAS unsigned* misc = (volatile LAS unsigned*)(F0.lds + MISC_OFF);
    if (F0.tid < 4) misc[F0.tid] = 0u;
    __syncthreads();
    XcdBarrier bar; bar.bar = F0.ctl + CW_BAR; bar.x = 0; bar.st = misc;
    if (hi - lo > 1) bar = xcd_barrier_post(F0.ctl + CW_BAR, misc);
#define GRID_BAR() do { XcdBarrier bq = bar; asm volatile("" : "+s"(bq.bar), "+s"(bq.x)); xcd_barrier(bq); } while (0)
#else
#define GRID_BAR() do { } while (0)
#endif
    int ph = 0;
#ifndef PH_MASK
#define PH_MASK 0xFFFFFFFFFFFFFFFFull
#endif
#define PHASE(...) PHASE_I(31, __VA_ARGS__)
#ifdef EMU
#define LAUNDER(Fq) do { } while (0)
#else
#define LAUNDER(Fq) do { unsigned mq_ = ~0u; asm volatile("" : "+s"(Fq.G), "+s"(Fq.bid), "+s"(Fq.wave), "+s"(Fq.ws), "+s"(Fq.out), "+s"(Fq.ctl), "+s"(mq_)); Fq.lane = (int)__builtin_amdgcn_mbcnt_hi(mq_, __builtin_amdgcn_mbcnt_lo(mq_, 0u)); Fq.tid = Fq.wave * 64 + Fq.lane; Fq.gw = Fq.bid * 8 + Fq.wave; Fq.NGW = Fq.G * 8; } while (0)
#endif
#ifdef EMU
#define ARGS_Q() const Args& args_q = args_k
#else
#define ARGS_Q() const __attribute__((address_space(4))) Args* aq_ = (const __attribute__((address_space(4))) Args*)__builtin_amdgcn_kernarg_segment_ptr(); asm volatile("" : "+s"(aq_)); const Args& args_q = *(const Args*)aq_
#endif
#define PHASE_I(kind, ...) do { if (ph >= lo && ph < hi) { constexpr int reps_ = (((REPEAT_MASK) >> (kind)) & 1u) ? 2 : 1; for (int rr_ = 0; rr_ < reps_; ++rr_) { { Frame Fq = F0; LAUNDER(Fq); const Frame& F = Fq; ARGS_Q(); const Args& args = args_q; __VA_ARGS__; } if (rr_ + 1 < reps_ || ph + 1 < hi) { GRID_BAR(); if (((REPEAT_MASK) >> 26) & 1u) GRID_BAR(); } } } ++ph; } while (0)
#define PHASEK(kind, ...) PHASE_I(kind, __VA_ARGS__)
#define SEGMENT(layer, half) do { \
            const size_t r0 = (size_t)(half) * TH; \
            const float* xin = ((layer) == 0 ? args_k.in[0] : F0.out) + r0 * D; float* xo = F0.out + r0 * D; \
            PHASEK(0, phase_norm<false>(F, args, xin, args.in[2] + (layer) * D, WSP(bf16, A_H), nullptr, nullptr, nullptr, nullptr); phase_rope_table(F, args, (const int*)args.in[1] + r0, WSP(float, A_ROPE))); \
            PHASEK(1, { pg8::Gemm g{WSP(bf16, A_H), WSP(bf16, W_IN), D, D}; pg8::StaticOrder S; S.init(TH, PW, F.G, F.bid); EpiBf16 E{WSP(bf16, A_P), PW, nullptr, 0}; pg8::gemm_phase(F.lds, g, S, E, F.tid); }); \
            PHASEK(2, phase_mla_prep(F, args); phase_rwkv_prep(F, args, layer)); \
            PHASEK(3, phase_mla_q(F, args); __syncthreads(); phase_mla_kv(F, args); __syncthreads(); phase_rwkv_lora(F, args)); \
            PHASEK(8, phase_rwkv_r1(F, args, layer)); \
            PHASEK(5, { const int ns_ = F.G >= 128 ? 64 : (F.G >= 4 ? F.G / 4 : 0); Frame Fa = F;       \
                        if (F.bid < ns_) { Fa.G = ns_; Fa.NGW = ns_ * 8; phase_rwkv_r2(Fa, args); } else { Fa.bid = F.bid - ns_; Fa.G = F.G - ns_; Fa.gw = Fa.bid * 8 + Fa.wave; Fa.NGW = Fa.G * 8; phase_attention(Fa, args); if (ns_ == 0) phase_rwkv_r2(F, args); } }); \
            PHASEK(9, phase_rwkv_post(F, args, layer); phase_gdn_g1(F, args, layer); phase_ssd_s1(F, args, layer)); \
            PHASEK(11, { const int ns_ = F.G >= 4 ? F.G / 2 : 0; Frame Fa = F;                               \
                        if (F.bid < ns_) { Fa.G = ns_; Fa.NGW = ns_ * 8; phase_gdn_g2(Fa, args); } else { Fa.bid = F.bid - ns_; Fa.G = F.G - ns_; Fa.gw = Fa.bid * 8 + Fa.wave; Fa.NGW = Fa.G * 8; phase_ssd_s23(Fa, args); if (ns_ == 0) phase_gdn_g2(F, args); } }); \
            PHASEK(12, phase_gdn_g3(F, args, layer); phase_ssd_s4(F, args, layer)); \
            PHASEK(17, phase_merge_z(F, args)); \
            PHASEK(18, phase_merge_gate(F, args, layer)); \
            PHASEK(19, phase_merge_out(F, args, xin, xo)); \
            if ((layer) == 0) { \
                PHASEK(20, phase_norm<false>(F, args, xo, args.in[32] + (layer) * D, WSP(bf16, A_H), nullptr, nullptr, nullptr, nullptr)); \
                PHASEK(21, phase_ffn_gu(F, args)); \
                PHASE(phase_ffn_down(F, args, xo)); \
                PHASE((void)0); \
                PHASE((void)0); \
            } else { \
                PHASE(phase_norm<true>(F, args, xo, args.in[32] + (layer) * D, WSP(bf16, A_H), args.in[35], WSP(int, F_TOPE), WSP(float, F_TOPW), F.ctl + CW_WGC + (half) * 8192)); \
                PHASE(phase_moe_route(F, args, half)); \
                PHASEK(22, phase_moe_gu(F, args, half)); \
                PHASEK(23, phase_moe_down(F, args, half)); \
                PHASE(phase_moe_combine(F, args, xo, (layer) == DEPTH - 1 ? args.in[38] : nullptr)); \
            } } while (0)
    static_assert(DEPTH == 2 && NHALF <= 2, "segment program");
    PHASEK(27, phase_convert(F, args, 0));
    SEGMENT(0, 0);
    if (NHALF == 2) SEGMENT(0, 1);
    PHASEK(27, phase_convert(F, args, 1));
    SEGMENT(1, 0);
    if (NHALF == 2) SEGMENT(1, 1);
#undef SEGMENT
#undef PHASE
}

#ifndef ONE_LAUNCH
#define ONE_LAUNCH 1
#endif
extern "C" void kernel_launch(void* const* d_in, const int* in_sizes, int n_in, void* d_out, int out_size, void* d_ws, size_t ws_size, hipStream_t stream) {
    static int grid = 0;
    if (grid == 0) {
#ifdef EMU
        grid = EMU_GRID;
#else
        if (n_in != 39 || out_size != T * D || ws_size < WS_NEED) { fprintf(stderr, "kernel_launch: unexpected problem (n_in %d out %d ws %zu need %zu)\n", n_in, out_size, ws_size, (size_t)WS_NEED); grid = -1; return; }
        int dev = 0, cus = 0;
        if (hipGetDevice(&dev) != hipSuccess || hipDeviceGetAttribute(&cus, hipDeviceAttributeMultiprocessorCount, dev) != hipSuccess) { grid = -1; return; }
        if (hipFuncSetAttribute((const void*)fwd_kernel, hipFuncAttributeMaxDynamicSharedMemorySize, LDS_BYTES) != hipSuccess) { fprintf(stderr, "kernel_launch: hipFuncSetAttribute failed\n"); grid = -1; return; }
        int per_cu = 0;
        if (hipOccupancyMaxActiveBlocksPerMultiprocessor(&per_cu, (const void*)fwd_kernel, 512, LDS_BYTES) != hipSuccess || per_cu < 1) fprintf(stderr, "kernel_launch: occupancy query reports %d\n", per_cu);
        (void)hipGetLastError();
        grid = cus;
#endif
    }
    if (grid < 0) return;
    (void)hipMemsetAsync((char*)d_ws + WS_CTL, 0, CTL_BYTES, stream);
    Args a{};
    for (int i = 0; i < 39; ++i) a.in[i] = (const float*)d_in[i];
    a.out = (float*)d_out; a.ws = (unsigned char*)d_ws;
#ifdef EMU
    for (int p = EMU_PH_LO; p < EMU_PH_HI && p < NPHASES; ++p) { a.lo = p; a.hi = p + 1; emu_launch(fwd_kernel, grid, 512, a); emu_after_phase(p); }
#else
#if ONE_LAUNCH
    a.lo = 0; a.hi = NPHASES;
    hipLaunchKernelGGL(fwd_kernel, dim3(grid), dim3(512), LDS_BYTES, stream, a);
#else
    for (int p = 0; p < NPHASES; ++p) { a.lo = p; a.hi = p + 1; hipLaunchKernelGGL(fwd_kernel, dim3(grid), dim3(512), LDS_BYTES, stream, a); }
#endif
#endif
}
```

```cpp
#ifndef EMU
#include <hip/hip_runtime.h>
#include <cstdio>
#include <cstdint>
#endif

#ifndef REPEAT_MASK
#define REPEAT_MASK 0u
#endif
#ifdef EMU
constexpr int BATCH = EMU_B, SEQ = EMU_S, NHALF = EMU_NHALF;
#else
constexpr int BATCH = 16, SEQ = 2048, NHALF = 2;
#endif
constexpr int D = 1024, DEPTH = 2, CH = 64;
constexpr int T = BATCH * SEQ, TH = T / NHALF, BH = BATCH / NHALF, NCH = SEQ / CH;
constexpr int C_MLA = 0, C_RWKV = 704, C_GDN = 2528, C_SSD = 4584, C_GATE = 6128, IN_COLS = 10224, PW = 6144;
constexpr int FF_D = 2816, FF_E = 3584, NEXP = 8;
constexpr int MOE_ROWS = ((TH * 2 + NEXP * 255) / 256) * 256;
constexpr float EPS = 1e-6f;
static_assert(TH % 256 == 0 && SEQ % 128 == 0 && BATCH % NHALF == 0 && (SEQ / 64) % 2 == 0, "shape");

typedef unsigned short bf16;
typedef float f32x4 __attribute__((ext_vector_type(4)));
typedef float f32x2 __attribute__((ext_vector_type(2)));
typedef short bf16x8 __attribute__((ext_vector_type(8)));
typedef short bf16x4 __attribute__((ext_vector_type(4)));
typedef unsigned u32x4 __attribute__((ext_vector_type(4)));
typedef unsigned u32x2 __attribute__((ext_vector_type(2)));
#ifdef EMU
#define LAS
#define GAS
#define MFMA_F32(a, b, c) emu_mfma_16x16x4f32(a, b, c)
#define MFMA_BF16(a, b, c) emu_mfma_16x16x32bf16(a, b, c)
#define ATOMIC_ADD_U32(p, v) emu_atomic_add_u32(p, v)
#define ATOMIC_ADD_LDS(p, v) emu_atomic_add_u32((unsigned*)(p), v)
#define RFL(x) (x)
#define OPAQUE_V(x) do { } while (0)
#define LDS_WAIT()
#define VM_WAIT()
__device__ __forceinline__ float fast_exp(float x) { return expf(x); }
__device__ __forceinline__ float fast_rcp(float x) { return 1.0f / x; }
__device__ __forceinline__ float fast_rsqrt(float x) { return 1.0f / sqrtf(x); }
#else
#define LAS __attribute__((address_space(3)))
#define GAS __attribute__((address_space(1)))
#define MFMA_F32(a, b, c) __builtin_amdgcn_mfma_f32_16x16x4f32(a, b, c, 0, 0, 0)
#define MFMA_BF16(a, b, c) __builtin_amdgcn_mfma_f32_16x16x32_bf16(a, b, c, 0, 0, 0)
#define ATOMIC_ADD_U32(p, v) __hip_atomic_fetch_add(p, v, __ATOMIC_RELAXED, __HIP_MEMORY_SCOPE_AGENT)
#define ATOMIC_ADD_LDS(p, v) __hip_atomic_fetch_add((LAS unsigned*)(p), v, __ATOMIC_RELAXED, __HIP_MEMORY_SCOPE_WORKGROUP)
#define RFL(x) __builtin_amdgcn_readfirstlane(x)
#define OPAQUE_V(x) asm volatile("" : "+v"(x))
#define LDS_WAIT() asm volatile("s_waitcnt lgkmcnt(0)" ::: "memory")
#define VM_WAIT() asm volatile("s_waitcnt vmcnt(0)" ::: "memory")
__device__ __forceinline__ float fast_exp(float x) { return __expf(x); }
__device__ __forceinline__ float fast_rcp(float x) { return __builtin_amdgcn_rcpf(x); }
__device__ __forceinline__ float fast_rsqrt(float x) { return __builtin_amdgcn_rsqf(x); }
#endif
__device__ __forceinline__ unsigned f2u(float f) { return __builtin_bit_cast(unsigned, f); }
__device__ __forceinline__ float u2f(unsigned u) { return __builtin_bit_cast(float, u); }
__device__ __forceinline__ unsigned f2bf(float f) { unsigned u = f2u(f); return (u + 0x7fffu + ((u >> 16) & 1u)) >> 16; }
__device__ __forceinline__ float bf2f(unsigned h) { return u2f(h << 16); }
__device__ __forceinline__ unsigned pk2(float lo, float hi) { return f2bf(lo) | (f2bf(hi) << 16); }
#ifndef EMU
#define expf(x) __expf(x)
#define exp2f(x) __builtin_amdgcn_exp2f(x)
#define FDIV(a, b) ((a) * __builtin_amdgcn_rcpf(b))
#define RSQRT(x) __builtin_amdgcn_rsqf(x)
__device__ __forceinline__ float softplusf_(float x) { return x > 20.f ? x : __logf(1.0f + __expf(x)); }
#else
#define FDIV(a, b) ((a) / (b))
#define RSQRT(x) (1.0f / sqrtf(x))
__device__ __forceinline__ float softplusf_(float x) { return x > 20.f ? x : log1pf(expf(x)); }
#endif
__device__ __forceinline__ float sigmoidf_(float x) { return FDIV(1.0f, 1.0f + expf(-x)); }
__device__ __forceinline__ float siluf_(float x) { return FDIV(x, 1.0f + expf(-x)); }
__device__ __forceinline__ float tanhf_(float x) { const float e = expf(2.0f * fminf(x, 15.0f)); return FDIV(e - 1.0f, e + 1.0f); }
__device__ __forceinline__ float wave_sum(float v) {
#pragma unroll
    for (int o = 1; o < 64; o <<= 1) v += __shfl_xor(v, o);
    return v;
}
__device__ __forceinline__ float wave_max(float v) {
#pragma unroll
    for (int o = 1; o < 64; o <<= 1) v = fmaxf(v, __shfl_xor(v, o));
    return v;
}
__device__ __forceinline__ f32x4 ld_bf16x4(const bf16* p) { const u32x2 w = *(const u32x2*)p; return (f32x4){bf2f(w.x & 0xffffu), bf2f(w.x >> 16), bf2f(w.y & 0xffffu), bf2f(w.y >> 16)}; }
__device__ __forceinline__ void st_bf16x4(bf16* p, f32x4 v) { u32x2 w; w.x = pk2(v.x, v.y); w.y = pk2(v.z, v.w); *(u32x2*)p = w; }
__device__ __forceinline__ u32x4 pack8(const float* v) { u32x4 o; o.x = pk2(v[0], v[1]); o.y = pk2(v[2], v[3]); o.z = pk2(v[4], v[5]); o.w = pk2(v[6], v[7]); return o; }

namespace pg8 {
#define PG8_LAS LAS
typedef unsigned short bf16_t;
constexpr int BM = 256, BK = 64, HALF = 128, HTB = HALF * BK * 2, STAGE_BYTES = 8 * HTB, NXCD = 8, WGM = 8;
__host__ __device__ __forceinline__ int lds_byte(int r, int c) { const int st = (r >> 4) * 2 + (c >> 5), rr = r & 15, cc = c & 31, ob = rr * 64 + cc * 2; return st * 1024 + (ob ^ (((ob >> 9) & 1) << 5)); }
__host__ __device__ __forceinline__ void stage_rc(int b, int& R, int& C) { const int st = b / 1024, sb = b % 1024, swz = sb ^ (((sb >> 9) & 1) << 5); R = (st >> 1) * 16 + swz / 64; C = (st & 1) * 32 + (swz % 64) / 2; }
__host__ __device__ __forceinline__ int perm32(int rho) { const int n = rho >> 4, i = rho & 15; return 8 * (i >> 2) + 4 * n + (i & 3); }
struct Unit { int pm, pn; };
struct Gemm { const bf16_t* A; const bf16_t* Bt; int lda, K; };
struct StaticOrder {
    int nM, nN, nwg, G, c;
    __host__ __device__ void init(int M, int N, int G_, int c_) { nM = M / BM; nN = N / BM; nwg = nM * nN; G = G_; c = c_; }
    __host__ __device__ bool next(int i, Unit& u) const {
        const long L = (long)i * G + c; if (L >= nwg) return false;
        int wgid = (int)L; { const int q = nwg / NXCD, r = nwg % NXCD, xcd = wgid % NXCD, off = wgid / NXCD; wgid = (xcd < r ? xcd * (q + 1) : r * (q + 1) + (xcd - r) * q) + off; }
        const int nig = WGM * nN, gid = wgid / nig, fm = gid * WGM, gsz = (nM - fm) < WGM ? (nM - fm) : WGM;
        u.pm = fm + ((wgid % nig) % gsz); u.pn = (wgid % nig) / gsz; return true;
    }
    __device__ __forceinline__ void a_ready(const Unit&) const {}
    __device__ __forceinline__ void done(const Unit&) const {}
};
#ifndef EMU
template <class Epi, class Sched>
__device__ __forceinline__ void gemm_phase(PG8_LAS unsigned char* lds, const Gemm g, const Sched& S, const Epi& E, const int tid) {
    const int wid = __builtin_amdgcn_readfirstlane(tid >> 6), lane = tid & 63, wr = wid >> 2, wc = wid & 3, fr = lane & 15, fq = lane >> 4;
    int Kq = g.K; asm volatile("" : "+s"(Kq));
    const int K = Kq, nt = K / BK, lda = g.lda;
    unsigned voffA[2], voffB[2];
#pragma unroll
    for (int i = 0; i < 2; ++i) { int R, C; stage_rc(tid * 16 + i * 8192, R, C); const int Rb = Epi::PERM ? ((R & ~31) + perm32(R & 31)) : R;
        voffA[i] = (unsigned)(R * lda + C) * 2u; voffB[i] = (unsigned)(Rb * K + C) * 2u; }
    const size_t kstep = (size_t)(BK * 2);
    const size_t hstep = (size_t)HALF * K * 2, hstepA = (size_t)HALF * lda * 2;
    const size_t tstep = 2 * hstep, tstepA = 2 * hstepA;
    const unsigned ldsw = (unsigned)wid * 1024u;
    const int aoff = lds_byte(wr * 64 + fr, fq * 8), boff = lds_byte(wc * 32 + fr, fq * 8);
#define PG8_SA(b, h) (((b) * 2 + (h)) * HTB)
#define PG8_SB(b, h) ((4 + (b) * 2 + (h)) * HTB)
#define PG8_STAGE(bufoff, gbase, voff) do { _Pragma("unroll") for (int _i = 0; _i < 2; ++_i) \
        __builtin_amdgcn_global_load_lds((const unsigned*)((const char*)(gbase) + (voff)[_i]), (PG8_LAS unsigned*)(lds + (bufoff) + ldsw + _i * 8192), 16, 0, 0); } while (0)
#define PG8_LDA(dst, b, h) do { _Pragma("unroll") for (int m = 0; m < 4; ++m) _Pragma("unroll") for (int k = 0; k < 2; ++k) dst[m][k] = *(const PG8_LAS bf16x8*)(lds + PG8_SA(b, h) + aoff + m * 2048 + k * 1024); } while (0)
#define PG8_LDB(dst, b, h) do { _Pragma("unroll") for (int n = 0; n < 2; ++n) _Pragma("unroll") for (int k = 0; k < 2; ++k) dst[n][k] = *(const PG8_LAS bf16x8*)(lds + PG8_SB(b, h) + boff + n * 2048 + k * 1024); } while (0)
#define PG8_MMA(ai, bj, At, Bt) do { __builtin_amdgcn_s_setprio(1); _Pragma("unroll") for (int m = 0; m < 4; ++m) _Pragma("unroll") for (int n = 0; n < 2; ++n) _Pragma("unroll") for (int k = 0; k < 2; ++k) \
        acc[ai][bj][m][n] = __builtin_amdgcn_mfma_f32_16x16x32_bf16(Bt[n][k], At[m][k], acc[ai][bj][m][n], 0, 0, 0); __builtin_amdgcn_s_setprio(0); } while (0)
#define PG8_WAIT_V(n) asm volatile("s_waitcnt vmcnt(" #n ")" ::: "memory")
#define PG8_WAIT_L(n) asm volatile("s_waitcnt lgkmcnt(" #n ")" ::: "memory")
#define PG8_BAR __builtin_amdgcn_s_barrier()
#define PG8_SCHED __builtin_amdgcn_sched_barrier(0)
    Unit cur, nxt; int ui = 0;
    if (!S.next(0, cur)) return;
    f32x4 acc[2][2][4][2];
#pragma unroll
    for (int a = 0; a < 2; ++a)
#pragma unroll
        for (int b = 0; b < 2; ++b)
#pragma unroll
            for (int m = 0; m < 4; ++m)
#pragma unroll
                for (int n = 0; n < 2; ++n) acc[a][b][m][n] = (f32x4){0.f, 0.f, 0.f, 0.f};
    bf16x8 At[4][2], B0[2][2], B1[2][2];
    const char* cA = (const char*)g.A + (size_t)cur.pm * tstepA; const char* cB = (const char*)g.Bt + (size_t)cur.pn * tstep;
    S.a_ready(cur);
    PG8_STAGE(PG8_SB(0, 0), cB, voffB); PG8_STAGE(PG8_SA(0, 0), cA, voffA); PG8_STAGE(PG8_SB(0, 1), cB + hstep, voffB); PG8_STAGE(PG8_SA(0, 1), cA + hstepA, voffA);
    if (wr == 1) PG8_BAR;
    PG8_WAIT_V(4); PG8_BAR;
    PG8_STAGE(PG8_SB(1, 0), cB + kstep, voffB); PG8_STAGE(PG8_SA(1, 0), cA + kstep, voffA); PG8_STAGE(PG8_SB(1, 1), cB + hstep + kstep, voffB);
    PG8_WAIT_V(6); PG8_BAR;
    for (;;) {
        const bool has_next = S.next(ui + 1, nxt);
        const char* nA = has_next ? (const char*)g.A + (size_t)nxt.pm * tstepA : cA; const char* nB = has_next ? (const char*)g.Bt + (size_t)nxt.pn * tstep : cB;
        for (int t = 0; t < nt; t += 2) {
            const bool last = (t == nt - 2);
            const char* a1 = cA + (size_t)(t + 1) * kstep;
            const char* a2 = last ? nA : cA + (size_t)(t + 2) * kstep; const char* b2 = last ? nB : cB + (size_t)(t + 2) * kstep;
            const char* a3 = a2 + kstep; const char* b3 = b2 + kstep;
            if (last && has_next) S.a_ready(nxt);
            PG8_LDB(B0, 0, 0); PG8_SCHED; PG8_LDA(At, 0, 0); PG8_STAGE(PG8_SA(1, 1), a1 + hstepA, voffA);
            PG8_WAIT_L(8); PG8_BAR; PG8_WAIT_L(0); PG8_MMA(0, 0, At, B0); PG8_BAR; PG8_SCHED;
            PG8_LDB(B1, 0, 1); PG8_STAGE(PG8_SB(0, 0), b2, voffB);
            PG8_BAR; PG8_WAIT_L(0); PG8_MMA(0, 1, At, B1); PG8_BAR;
            PG8_LDA(At, 0, 1); PG8_STAGE(PG8_SA(0, 0), a2, voffA);
            PG8_BAR; PG8_WAIT_L(0); PG8_MMA(1, 0, At, B0); PG8_BAR; PG8_SCHED;
            PG8_STAGE(PG8_SB(0, 1), b2 + hstep, voffB);
            PG8_WAIT_V(6); PG8_BAR; PG8_MMA(1, 1, At, B1); PG8_BAR;
            PG8_LDB(B0, 1, 0); PG8_SCHED; PG8_LDA(At, 1, 0); PG8_STAGE(PG8_SA(0, 1), a2 + hstepA, voffA);
            PG8_WAIT_L(8); PG8_BAR; PG8_WAIT_L(0); PG8_MMA(0, 0, At, B0); PG8_BAR; PG8_SCHED;
            PG8_LDB(B1, 1, 1); PG8_STAGE(PG8_SB(1, 0), b3, voffB);
            PG8_BAR; PG8_WAIT_L(0); PG8_MMA(0, 1, At, B1); PG8_BAR;
            PG8_LDA(At, 1, 1); PG8_STAGE(PG8_SA(1, 0), a3, voffA);
            PG8_BAR; PG8_WAIT_L(0); PG8_MMA(1, 0, At, B0); PG8_BAR; PG8_SCHED;
            PG8_STAGE(PG8_SB(1, 1), b3 + hstep, voffB);
            PG8_WAIT_V(6); PG8_BAR; PG8_MMA(1, 1, At, B1); PG8_BAR;
        }
        if constexpr (!Epi::AFTER_DRAIN) { E(acc, cur, wr, wc, fr, fq); S.done(cur); }
        if (!has_next) break;
#pragma unroll
        for (int a = 0; a < 2; ++a)
#pragma unroll
            for (int b = 0; b < 2; ++b)
#pragma unroll
                for (int m = 0; m < 4; ++m)
#pragma unroll
                    for (int n = 0; n < 2; ++n) acc[a][b][m][n] = (f32x4){0.f, 0.f, 0.f, 0.f};
        cur = nxt; cA = nA; cB = nB; ++ui;
    }
    PG8_WAIT_V(0);
    if (wr == 0) PG8_BAR;
    PG8_BAR;
    if constexpr (Epi::AFTER_DRAIN) { E.fused(acc, cur, wr, wc, fr, fq, lds, wid, lane); S.done(cur); }
#undef PG8_SA
#undef PG8_SB
#undef PG8_STAGE
#undef PG8_LDA
#undef PG8_LDB
#undef PG8_MMA
#undef PG8_WAIT_V
#undef PG8_WAIT_L
#undef PG8_BAR
#undef PG8_SCHED
}
#else
template <class Epi, class Sched>
__device__ __forceinline__ void gemm_phase(PG8_LAS unsigned char* lds, const Gemm g, const Sched& S, const Epi& E, const int tid) {
    const int wid = tid >> 6, lane = tid & 63, wr = wid >> 2, wc = wid & 3, fr = lane & 15, fq = lane >> 4;
    Unit cur;
    for (int ui = 0; S.next(ui, cur); ++ui) {
        f32x4 acc[2][2][4][2];
        for (int ai = 0; ai < 2; ++ai) for (int m = 0; m < 4; ++m) {
            const size_t row = (size_t)cur.pm * 256 + ai * 128 + wr * 64 + m * 16 + fr;
            const bf16_t* ap = g.A + row * g.lda;
            for (int bj = 0; bj < 2; ++bj) for (int n = 0; n < 2; ++n) for (int j = 0; j < 4; ++j) {
                const size_t col = (size_t)cur.pn * 256 + bj * 128 + wc * 32 + (Epi::PERM ? 8 * fq + 4 * n : 16 * n + 4 * fq) + j;
                const bf16_t* bp = g.Bt + col * g.K; float s = 0.f;
                for (int k = 0; k < g.K; ++k) s += bf2f(ap[k]) * bf2f(bp[k]);
                acc[ai][bj][m][n][j] = s; } }
        E(acc, cur, wr, wc, fr, fq);
    }
    __syncthreads();
}
#endif
}

using pg8::Unit;
constexpr int HALFT = 128;
struct EpiF32 {
    static constexpr bool PERM = false, AFTER_DRAIN = false;
    float* C; int ldc;
    __device__ __forceinline__ void operator()(const f32x4 (&acc)[2][2][4][2], const Unit& u, int wr, int wc, int fr, int fq) const {
        const int row0 = u.pm * 256 + wr * 64 + fr, col0 = u.pn * 256 + wc * 32 + 4 * fq;
#pragma unroll
        for (int ai = 0; ai < 2; ++ai)
#pragma unroll
            for (int m = 0; m < 4; ++m) { float* rowp = C + (size_t)(row0 + ai * HALFT + m * 16) * ldc + col0;
#pragma unroll
                for (int bj = 0; bj < 2; ++bj)
#pragma unroll
                    for (int n = 0; n < 2; ++n) *(f32x4*)(rowp + bj * HALFT + n * 16) = acc[ai][bj][m][n]; }
    }
};
struct EpiResidual {
    static constexpr bool PERM = false, AFTER_DRAIN = false;
    const float* res; float* out;
    __device__ __forceinline__ void operator()(const f32x4 (&acc)[2][2][4][2], const Unit& u, int wr, int wc, int fr, int fq) const {
        const int row0 = u.pm * 256 + wr * 64 + fr, col0 = u.pn * 256 + wc * 32 + 4 * fq;
#pragma unroll
        for (int ai = 0; ai < 2; ++ai) {
            f32x4 rv[4][2][2];
#pragma unroll
            for (int m = 0; m < 4; ++m) { const size_t o = (size_t)(row0 + ai * HALFT + m * 16) * D + col0;
#pragma unroll
                for (int bj = 0; bj < 2; ++bj)
#pragma unroll
                    for (int n = 0; n < 2; ++n) rv[m][bj][n] = *(const GAS f32x4*)(res + o + bj * HALFT + n * 16); }
#pragma unroll
            for (int m = 0; m < 4; ++m) { const size_t o = (size_t)(row0 + ai * HALFT + m * 16) * D + col0;
#pragma unroll
                for (int bj = 0; bj < 2; ++bj)
#pragma unroll
                    for (int n = 0; n < 2; ++n) *(GAS f32x4*)(out + o + bj * HALFT + n * 16) = rv[m][bj][n] + acc[ai][bj][m][n]; }
        }
    }
};
struct EpiBf16 {
    static constexpr bool PERM = true, AFTER_DRAIN = false;
    bf16* O; int ldc; const float* rowscale; int rs_stride;
    __device__ __forceinline__ void operator()(const f32x4 (&acc)[2][2][4][2], const Unit& u, int wr, int wc, int fr, int fq) const {
        const int row0 = u.pm * 256 + wr * 64 + fr, col0 = u.pn * 256 + wc * 32 + 8 * fq;
#pragma unroll
        for (int ai = 0; ai < 2; ++ai)
#pragma unroll
            for (int m = 0; m < 4; ++m) { const int row = row0 + ai * HALFT + m * 16; bf16* rowp = O + (size_t)row * ldc + col0;
                const float sc = rowscale ? rowscale[(size_t)row * rs_stride] : 1.0f;
#pragma unroll
                for (int bj = 0; bj < 2; ++bj) { const f32x4 v0 = acc[ai][bj][m][0] * sc, v1 = acc[ai][bj][m][1] * sc;
                    u32x4 w; w.x = pk2(v0[0], v0[1]); w.y = pk2(v0[2], v0[3]); w.z = pk2(v1[0], v1[1]); w.w = pk2(v1[2], v1[3]);
                    *(u32x4*)(rowp + bj * HALFT) = w; } }
    }
};
struct EpiSwiGLU {
    static constexpr bool PERM = true, AFTER_DRAIN = false;
    bf16* O; int ldc; int ntile;
    __device__ __forceinline__ void operator()(const f32x4 (&acc)[2][2][4][2], const Unit& u, int wr, int wc, int fr, int fq) const {
        const int row0 = u.pm * 256 + wr * 64 + fr, col0 = (u.pn % ntile) * 128 + wc * 32 + 8 * fq;
#pragma unroll
        for (int ai = 0; ai < 2; ++ai)
#pragma unroll
            for (int m = 0; m < 4; ++m) { bf16* rowp = O + (size_t)(row0 + ai * HALFT + m * 16) * ldc + col0;
                float a[8];
#pragma unroll
                for (int n = 0; n < 2; ++n)
#pragma unroll
                    for (int j = 0; j < 4; ++j) { const float g = acc[ai][0][m][n][j], up = acc[ai][1][m][n][j]; a[4 * n + j] = g * fast_rcp(1.0f + fast_exp(-g)) * up; }
                u32x4 w; w.x = pk2(a[0], a[1]); w.y = pk2(a[2], a[3]); w.z = pk2(a[4], a[5]); w.w = pk2(a[6], a[7]);
                *(u32x4*)rowp = w; }
    }
};
struct EpiZ {
    static constexpr bool PERM = true, AFTER_DRAIN = false;
    bf16* Z;
    __device__ __forceinline__ void operator()(const f32x4 (&acc)[2][2][4][2], const Unit& u, int wr, int wc, int fr, int fq) const {
        const int i = u.pn >> 2, pnl = u.pn & 3, pml = u.pm - i * (TH / 256);
        const int row0 = pml * 256 + wr * 64 + fr, col0 = i * D + pnl * 256 + wc * 32 + 8 * fq;
#pragma unroll
        for (int ai = 0; ai < 2; ++ai)
#pragma unroll
            for (int m = 0; m < 4; ++m) { bf16* rowp = Z + (size_t)(row0 + ai * HALFT + m * 16) * 4096 + col0;
#pragma unroll
                for (int bj = 0; bj < 2; ++bj) { const f32x4 v0 = acc[ai][bj][m][0], v1 = acc[ai][bj][m][1];
                    u32x4 w; w.x = pk2(v0[0], v0[1]); w.y = pk2(v0[2], v0[3]); w.z = pk2(v1[0], v1[1]); w.w = pk2(v1[2], v1[3]);
                    *(GAS u32x4*)(rowp + bj * HALFT) = w; } }
    }
};
struct BranchOrder {
    int nP, G, c;
    __device__ bool next(int i, Unit& u) const {
        const long L = (long)i * G + c; if (L >= (long)16 * nP) return false;
        const int br = (int)(L / (4 * nP)), r = (int)(L % (4 * nP)); u.pm = br * nP + (r >> 2); u.pn = br * 4 + (r & 3); return true;
    }
    __device__ __forceinline__ void a_ready(const Unit&) const {}
    __device__ __forceinline__ void done(const Unit&) const {}
};
struct EpiMerge {
    static constexpr bool PERM = false, AFTER_DRAIN = false;
    const bf16* Z; const float* gate_b; bf16* MG;
    __device__ __forceinline__ void operator()(const f32x4 (&acc)[2][2][4][2], const Unit& u, int wr, int wc, int fr, int fq) const {
        const int row0 = u.pm * 256 + wr * 64 + fr, col = u.pn * 64 + wc * 16 + 4 * fq;
        f32x4 gb[4];
#pragma unroll
        for (int i = 0; i < 4; ++i) gb[i] = *(const GAS f32x4*)(gate_b + i * D + col);
#pragma unroll
        for (int ai = 0; ai < 2; ++ai) {
            u32x2 zv[4][4];
#pragma unroll
            for (int m = 0; m < 4; ++m)
#pragma unroll
                for (int i = 0; i < 4; ++i) zv[m][i] = *(const GAS u32x2*)(Z + (size_t)(row0 + ai * HALFT + m * 16) * 4096 + i * D + col);
#pragma unroll
            for (int m = 0; m < 4; ++m) { const size_t row = (size_t)(row0 + ai * HALFT + m * 16);
                f32x4 s = (f32x4){0.f, 0.f, 0.f, 0.f};
#pragma unroll
                for (int bj = 0; bj < 2; ++bj)
#pragma unroll
                    for (int n = 0; n < 2; ++n) { const int i = 2 * bj + n; const unsigned z01 = zv[m][i].x, z23 = zv[m][i].y;
                        const f32x4 z = (f32x4){bf2f(z01 & 0xffffu), bf2f(z01 >> 16), bf2f(z23 & 0xffffu), bf2f(z23 >> 16)}; const f32x4 a = acc[ai][bj][m][n] + gb[i];
#pragma unroll
                        for (int j = 0; j < 4; ++j) s[j] += z[j] * fast_rcp(1.0f + fast_exp(-a[j])); }
                u32x2 w; w.x = pk2(s.x, s.y); w.y = pk2(s.z, s.w); *(GAS u32x2*)(MG + row * D + col) = w; }
        }
    }
};

constexpr size_t MiB = 1u << 20;
constexpr size_t al(size_t x) { return (x + 255) & ~(size_t)255; }
constexpr size_t WS_CTL = 0, CTL_BYTES = 1 * MiB;
constexpr size_t W_IN = 1 * MiB;
constexpr size_t W_GATE = W_IN + (size_t)PW * D * 2;
constexpr size_t W_UQ = W_GATE + (size_t)4096 * D * 2;
constexpr size_t W_UKV = W_UQ + (size_t)768 * 384 * 2;
constexpr size_t W_LORA = W_UKV + (size_t)1024 * 256 * 2;
constexpr size_t W_BR = W_LORA + (size_t)1536 * 384 * 2;
constexpr size_t W_OUT = W_BR + (size_t)4 * 1024 * 512 * 2;
constexpr size_t W_FGU = W_OUT + (size_t)D * D * 2;
constexpr size_t W_FDN = W_FGU + (size_t)NEXP * 2 * FF_E * D * 2;
constexpr size_t W_END = W_FDN + (size_t)NEXP * D * FF_E * 2;
constexpr size_t A_H = al(W_END);
constexpr size_t A_ROPE = A_H + (size_t)TH * D * 2;
constexpr size_t A_Y = A_ROPE + (size_t)TH * 64 * 4;
constexpr size_t A_P = A_Y + (size_t)4 * TH * 512 * 2;
constexpr size_t A_MIX = A_P + (size_t)TH * PW * 2;
constexpr size_t R_RKV = A_MIX;
constexpr size_t R_LOUT = R_RKV + (size_t)TH * 1536 * 2;
constexpr size_t R_O = R_LOUT + (size_t)TH * 1536 * 4;
constexpr size_t R_LIN = R_O + (size_t)TH * 512 * 4;
constexpr size_t R_REC = R_LIN + (size_t)TH * 384 * 2;
constexpr size_t R_END = R_REC + (size_t)BH * 8 * NCH * 61696;
constexpr size_t M_KR = al(R_END);
constexpr size_t M_Q = M_KR + (size_t)TH * 64 * 2;
constexpr size_t M_KV = M_Q + (size_t)TH * 768 * 2;
constexpr size_t M_VT = M_KV + (size_t)TH * 1024 * 2;
constexpr size_t M_END = M_VT + (size_t)TH * 512 * 2;
constexpr size_t G_CH = R_LIN;
constexpr size_t G_O = G_CH + al((size_t)BH * 4 * NCH * 78864);
constexpr size_t G_END = G_O + (size_t)TH * 512 * 4;
constexpr size_t S_ST = al(G_END);
constexpr size_t S_YD = S_ST + (size_t)BH * NCH * 8 * 64 * 128 * 2;
constexpr size_t S_C = S_YD + (size_t)TH * 512 * 4;
constexpr size_t S_AC = S_C + (size_t)BH * NCH * 2 * 17408;
constexpr size_t S_YO = S_AC + (size_t)TH * 8 * 4;
constexpr size_t S_END = S_YO + (size_t)TH * 512 * 4;
constexpr size_t A_Z = A_P;
constexpr size_t A_MG = A_MIX;
constexpr size_t F_ACT = A_P;
constexpr size_t F_GA = F_ACT + (size_t)MOE_ROWS * FF_E * 2;
constexpr size_t F_YE = F_GA + (size_t)MOE_ROWS * D * 2;
constexpr size_t F_TOPE = F_YE + (size_t)MOE_ROWS * D * 4;
constexpr size_t F_TOPW = F_TOPE + (size_t)TH * 2 * 4;
constexpr size_t F_SLOT = F_TOPW + (size_t)TH * 2 * 4;
constexpr size_t F_END = F_SLOT + (size_t)TH * 2 * 4;
constexpr size_t cmax(size_t a, size_t b) { return a > b ? a : b; }
constexpr size_t WS_NEED = cmax(cmax(cmax(M_END, R_END), cmax(G_END, S_END)), F_END);
#ifndef EMU
static_assert(WS_NEED <= (size_t)896 * MiB, "workspace");
#endif
constexpr int CW_BAR = 4096;
constexpr int CW_CNT = 16384;
constexpr int CW_WGC = 32768;

#ifdef EMU
#define WAVE_SYNC() emu_wave_sync()
#else
#define WAVE_SYNC() do { asm volatile("s_waitcnt lgkmcnt(0)" ::: "memory"); } while (0)
#endif
struct Frame {
    LAS unsigned char* lds; int tid, lane, wave, G, gw, NGW, bid;
    GAS float* out; GAS unsigned char* ws; GAS unsigned* ctl;
};
struct Args { const float* in[39]; float* out; unsigned char* ws; int lo, hi; };
#define WSP(type, off) ((type*)(F.ws + (off)))
#define AIN(A_, k) ((const float*)(const GAS float*)(A_).in[k])

template <class FN>
__device__ __forceinline__ void cvt_matrix(const Frame& F, const float* W, int ldw, int K, bf16* WT, int Ndst, const float* kscale, FN srccol) {
    LAS float* scr = (LAS float*)(F.lds + F.wave * 16384);
    const int nblk = Ndst / 32, nitems = (K / 64) * nblk, lane = F.lane;
    for (int item = F.gw; item < nitems; item += F.NGW) {
        const int kb = item / nblk, nb = item % nblk, k0 = 64 * kb, n0 = 32 * nb;
        const int sc = srccol(n0 + (lane & 31));
        float wv[32];
#pragma unroll
        for (int i = 0; i < 32; ++i) { const int kk = 2 * i + (lane >> 5); wv[i] = sc >= 0 ? W[(size_t)(k0 + kk) * ldw + sc] : 0.f; }
#pragma unroll
        for (int i = 0; i < 32; ++i) { const int kk = 2 * i + (lane >> 5); float v = wv[i]; if (kscale) v *= kscale[k0 + kk]; scr[kk * 33 + (lane & 31)] = v; }
        WAVE_SYNC();
        const int c = lane & 7;
#pragma unroll
        for (int j = 0; j < 4; ++j) { const int n = (lane >> 3) + 8 * j; const LAS float* s = scr + (8 * c) * 33 + n;
            u32x4 o; o.x = pk2(s[0 * 33], s[1 * 33]); o.y = pk2(s[2 * 33], s[3 * 33]); o.z = pk2(s[4 * 33], s[5 * 33]); o.w = pk2(s[6 * 33], s[7 * 33]);
            *(u32x4*)(WT + (size_t)(n0 + n) * K + k0 + 8 * c) = o; }
        WAVE_SYNC();
    }
}
__device__ __forceinline__ void phase_convert(const Frame& F, const Args& A, int layer) {
    const float* w_in = AIN(A, 3) + (size_t)layer * D * IN_COLS;
    cvt_matrix(F, w_in, IN_COLS, D, WSP(bf16, W_IN), PW, nullptr, [](int n) { return n < C_GATE ? n : -1; });
    cvt_matrix(F, w_in, IN_COLS, D, WSP(bf16, W_GATE), 4096, nullptr, [](int n) {
        const int pn = n >> 8, c = n & 255, bj = c >> 7, wc = (c >> 5) & 3, nn = (c >> 4) & 1, r = c & 15; return C_GATE + (2 * bj + nn) * D + 64 * pn + 16 * wc + r; });
    cvt_matrix(F, AIN(A, 6) + (size_t)layer * 384 * 768, 768, 384, WSP(bf16, W_UQ), 768, AIN(A, 4) + layer * 384, [](int n) { return n; });
    cvt_matrix(F, AIN(A, 7) + (size_t)layer * 256 * 1024, 1024, 256, WSP(bf16, W_UKV), 1024, AIN(A, 5) + layer * 256, [](int n) { return n; });
    for (int i = 0; i < 4; ++i) cvt_matrix(F, AIN(A, 30) + ((size_t)layer * 4 + i) * 512 * D, D, 512, WSP(bf16, W_BR) + (size_t)i * D * 512, D, nullptr, [](int n) { return n; });
    cvt_matrix(F, AIN(A, 31) + (size_t)layer * D * D, D, D, WSP(bf16, W_OUT), D, nullptr, [](int n) { return n; });
    if (layer == 0) {
        cvt_matrix(F, AIN(A, 33), 2 * FF_D, D, WSP(bf16, W_FGU), 2 * FF_D, nullptr, [](int n) { const int pn = n >> 8, c = n & 255; return c < 128 ? 128 * pn + c : FF_D + 128 * pn + (c - 128); });
        cvt_matrix(F, AIN(A, 34), D, FF_D, WSP(bf16, W_FDN), D, nullptr, [](int n) { return n; });
    } else {
        for (int e = 0; e < NEXP; ++e) {
            cvt_matrix(F, AIN(A, 36) + (size_t)e * D * 2 * FF_E, 2 * FF_E, D, WSP(bf16, W_FGU) + (size_t)e * 2 * FF_E * D, 2 * FF_E, nullptr, [](int n) { const int pn = n >> 8, c = n & 255; return c < 128 ? 128 * pn + c : FF_E + 128 * pn + (c - 128); });
            cvt_matrix(F, AIN(A, 37) + (size_t)e * FF_E * D, D, FF_E, WSP(bf16, W_FDN) + (size_t)e * D * FF_E, D, nullptr, [](int n) { return n; });
        }
    }
    { const float* w2 = AIN(A, 10) + (size_t)layer * 64 * 512; const float* a2 = AIN(A, 12) + (size_t)layer * 64 * 512; const float* g2 = AIN(A, 13) + (size_t)layer * 160 * 512;
      bf16* L = WSP(bf16, W_LORA);
      for (int idx = F.bid * 512 + F.tid; idx < 1536 * 384; idx += F.G * 512) { const int n = idx / 384, k = idx % 384; float v = 0.f;
          if (n < 512) { if (k < 64) v = w2[k * 512 + n]; } else if (n < 1024) { if (k >= 64 && k < 128) v = a2[(k - 64) * 512 + (n - 512)]; } else { if (k >= 128 && k < 288) v = g2[(k - 128) * 512 + (n - 1024)]; }
          L[idx] = (bf16)f2bf(v); } }
}

template <bool ROUTER>
__device__ __forceinline__ void phase_norm(const Frame& F, const Args& A, const float* xin, const float* gain, bf16* H, const float* router, int* tope, float* topw, unsigned* cnt) {
    const int lane = F.lane;
    LAS unsigned* lcnt = (LAS unsigned*)F.lds;
    if (ROUTER) { __syncthreads(); if (F.tid < 8) lcnt[F.tid] = 0u; __syncthreads(); }
    f32x4 gv[4];
#pragma unroll
    for (int j = 0; j < 4; ++j) gv[j] = *(const f32x4*)(gain + 4 * lane + 256 * j);
    for (int m = F.gw; m < TH; m += F.NGW) {
        const float* xr = xin + (size_t)m * D; f32x4 v[4]; float ss = 0.f;
#pragma unroll
        for (int j = 0; j < 4; ++j) { v[j] = *(const f32x4*)(xr + 4 * lane + 256 * j); ss += (v[j].x * v[j].x + v[j].y * v[j].y) + (v[j].z * v[j].z + v[j].w * v[j].w); }
        const float rstd = RSQRT(wave_sum(ss) * (1.0f / D) + EPS);
#pragma unroll
        for (int j = 0; j < 4; ++j) { v[j] = v[j] * rstd * gv[j]; st_bf16x4(H + (size_t)m * D + 4 * lane + 256 * j, v[j]); }
        if (ROUTER) {
            float lg[8];
#pragma unroll
            for (int e = 0; e < 8; ++e) lg[e] = 0.f;
#pragma unroll
            for (int j = 0; j < 4; ++j)
#pragma unroll
                for (int q = 0; q < 4; ++q) { const float* rp = router + (size_t)(4 * lane + 256 * j + q) * 8; const f32x4 r0 = *(const f32x4*)rp, r1 = *(const f32x4*)(rp + 4); const float hv = v[j][q];
                    lg[0] += hv * r0.x; lg[1] += hv * r0.y; lg[2] += hv * r0.z; lg[3] += hv * r0.w; lg[4] += hv * r1.x; lg[5] += hv * r1.y; lg[6] += hv * r1.z; lg[7] += hv * r1.w; }
#pragma unroll
            for (int e = 0; e < 8; ++e) lg[e] = wave_sum(lg[e]);
            if (lane == 0) {
                int e1 = 0; float l1 = lg[0];
#pragma unroll
                for (int e = 1; e < 8; ++e) if (lg[e] > l1) { l1 = lg[e]; e1 = e; }
                int e2 = -1; float l2 = -3.0e38f;
#pragma unroll
                for (int e = 0; e < 8; ++e) if (e != e1 && lg[e] > l2) { l2 = lg[e]; e2 = e; }
                const float w1 = 1.0f / (1.0f + expf(l2 - l1));
                tope[2 * m] = e1; tope[2 * m + 1] = e2; topw[2 * m] = w1; topw[2 * m + 1] = 1.0f - w1;
                ATOMIC_ADD_LDS(lcnt + e1, 1u); ATOMIC_ADD_LDS(lcnt + e2, 1u);
            }
        }
    }
    if (ROUTER) { __syncthreads(); if (F.tid < 8) cnt[F.bid * 8 + F.tid] = lcnt[F.tid]; __syncthreads(); }
}
__device__ __forceinline__ void phase_rope_table(const Frame& F, const Args& A, const int* pos, float* rope) {
    for (int idx = F.bid * 512 + F.tid; idx < TH * 32; idx += F.G * 512) { const int t = idx >> 5, i = idx & 31;
        const float inv = powf(10000.0f, -(float)i / 32.0f);
        const float ang = (float)pos[t] * inv; float sn, cs; sincosf(ang, &sn, &cs);
        rope[(size_t)t * 64 + i] = cs; rope[(size_t)t * 64 + 32 + i] = sn; }
}
__device__ __forceinline__ void phase_final_norm(const Frame& F, const Args& A, float* x, const float* gain) {
    const int lane = F.lane;
    for (int m = F.gw; m < T; m += F.NGW) {
        float* xr = x + (size_t)m * D; f32x4 v[4]; float ss = 0.f;
#pragma unroll
        for (int j = 0; j < 4; ++j) { v[j] = *(const f32x4*)(xr + 4 * lane + 256 * j); ss += (v[j].x * v[j].x + v[j].y * v[j].y) + (v[j].z * v[j].z + v[j].w * v[j].w); }
        const float rstd = RSQRT(wave_sum(ss) * (1.0f / D) + EPS);
#pragma unroll
        for (int j = 0; j < 4; ++j) *(f32x4*)(xr + 4 * lane + 256 * j) = v[j] * rstd * *(const f32x4*)(gain + 4 * lane + 256 * j);
    }
}

__device__ __forceinline__ void phase_mla_prep(const Frame& F, const Args& A) {
    bf16* P = WSP(bf16, A_P); bf16* kr = WSP(bf16, M_KR); const float* rope = WSP(float, A_ROPE);
    const int lane = F.lane;
    for (int m = F.gw; m < TH; m += F.NGW) {
        bf16* pr = P + (size_t)m * PW; float sq = 0.f, skv = 0.f; f32x4 v[3];
#pragma unroll
        for (int j = 0; j < 3; ++j) { const int c = 4 * lane + 256 * j; v[j] = ld_bf16x4(pr + c); const float s = (v[j].x * v[j].x + v[j].y * v[j].y) + (v[j].z * v[j].z + v[j].w * v[j].w);
            if (c < 384) sq += s; else if (c < 640) skv += s; }
        sq = wave_sum(sq); skv = wave_sum(skv);
        const float rq = RSQRT(sq * (1.0f / 384.0f) + EPS), rkv = RSQRT(skv * (1.0f / 256.0f) + EPS);
#pragma unroll
        for (int j = 0; j < 3; ++j) { const int c = 4 * lane + 256 * j; if (c < 640) st_bf16x4(pr + c, v[j] * (c < 384 ? rq : rkv)); }
        if (lane < 32) { const float x1 = bf2f(pr[640 + lane]), x2 = bf2f(pr[672 + lane]), c = rope[(size_t)m * 64 + lane], s = rope[(size_t)m * 64 + 32 + lane];
            kr[(size_t)m * 64 + lane] = (bf16)f2bf(x1 * c - x2 * s); kr[(size_t)m * 64 + 32 + lane] = (bf16)f2bf(x2 * c + x1 * s); }
    }
}
__device__ __forceinline__ void phase_mla_q(const Frame& F, const Args& A) {
    pg8::Gemm g{WSP(bf16, A_P) + 0, WSP(bf16, W_UQ), PW, 384}; pg8::StaticOrder S; S.init(TH, 768, F.G, F.bid);
    EpiBf16 E{WSP(bf16, M_Q), 768, nullptr, 0}; pg8::gemm_phase(F.lds, g, S, E, F.tid);
}
struct EpiKV {
    static constexpr bool PERM = true, AFTER_DRAIN = false;
    bf16* KV; bf16* VT;
    __device__ __forceinline__ void operator()(const f32x4 (&acc)[2][2][4][2], const Unit& u, int wr, int wc, int fr, int fq) const {
        const int row0 = u.pm * 256 + wr * 64 + fr, col0 = wc * 32 + 8 * fq;
#pragma unroll
        for (int ai = 0; ai < 2; ++ai)
#pragma unroll
            for (int m = 0; m < 4; ++m) { const int row = row0 + ai * HALFT + m * 16;
                { const f32x4 v0 = acc[ai][0][m][0], v1 = acc[ai][0][m][1]; u32x4 w; w.x = pk2(v0[0], v0[1]); w.y = pk2(v0[2], v0[3]); w.z = pk2(v1[0], v1[1]); w.w = pk2(v1[2], v1[3]);
                  *(u32x4*)(KV + (size_t)row * 1024 + u.pn * 256 + col0) = w; }
                const int b = row / SEQ, t = row % SEQ; bf16* vt = VT + ((size_t)(b * 4 + u.pn) * 128 + col0) * SEQ + t;
#pragma unroll
                for (int n = 0; n < 2; ++n)
#pragma unroll
                    for (int j = 0; j < 4; ++j) vt[(size_t)(4 * n + j) * SEQ] = (bf16)f2bf(acc[ai][1][m][n][j]); }
    }
};
__device__ __forceinline__ void phase_mla_kv(const Frame& F, const Args& A) {
    pg8::Gemm g{WSP(bf16, A_P) + 384, WSP(bf16, W_UKV), PW, 256}; pg8::StaticOrder S; S.init(TH, 1024, F.G, F.bid);
    EpiKV E{WSP(bf16, M_KV), WSP(bf16, M_VT)}; pg8::gemm_phase(F.lds, g, S, E, F.tid);
}
constexpr int AT_KS = 200, AT_VS = 72;
constexpr int AT_KBYTES = 64 * AT_KS * 2, AT_VBYTES = 128 * AT_VS * 2;
__device__ __forceinline__ void phase_attention(const Frame& F, const Args& A) {
    const bf16* Q = WSP(bf16, M_Q); const bf16* KV = WSP(bf16, M_KV); const bf16* KR = WSP(bf16, M_KR); const bf16* VTg = WSP(bf16, M_VT); const float* rope = WSP(float, A_ROPE); bf16* Y = WSP(bf16, A_Y);
    const int lane = F.lane, w = F.wave, l15 = lane & 15, q4 = lane >> 4, tid = F.tid, grp = w >> 2, wq = w & 3;
    const int NQB = SEQ / 128, nunits = BH * 4 * NQB;
    const float sc2 = 0.07216878364870322f * 1.4426950408889634f;
    for (int unit = F.bid; unit < nunits; unit += F.G) {
        const int qb = NQB - 1 - (unit / (BH * 4)), bh = unit % (BH * 4), h = bh & 3, b = bh >> 2;
        const size_t t0 = (size_t)b * SEQ;
        bf16x8 qf[2][6];
#pragma unroll
        for (int f = 0; f < 2; ++f) { const size_t tq = t0 + qb * 128 + wq * 32 + 16 * f + l15;
#pragma unroll
            for (int ks = 0; ks < 6; ++ks) qf[f][ks] = *(const bf16x8*)(Q + tq * 768 + h * 192 + 32 * ks + 8 * q4);
            const bf16x8 a = qf[f][4], c2 = qf[f][5];
#pragma unroll
            for (int j = 0; j < 8; ++j) { const float x1 = bf2f((unsigned short)a[j]), x2 = bf2f((unsigned short)c2[j]), c = rope[tq * 64 + 8 * q4 + j], sn = rope[tq * 64 + 32 + 8 * q4 + j];
                qf[f][4][j] = (short)f2bf(x1 * c - x2 * sn); qf[f][5][j] = (short)f2bf(x2 * c + x1 * sn); } }
        f32x4 o[2][8];
#pragma unroll
        for (int f = 0; f < 2; ++f)
#pragma unroll
            for (int mb = 0; mb < 8; ++mb) o[f][mb] = (f32x4){0.f, 0.f, 0.f, 0.f};
        float mrow[2] = {-3.0e38f, -3.0e38f}, lrow[2] = {0.f, 0.f};
        const int qchunk = 2 * qb + (wq >> 1), ntile = 2 * qb + 2;
        u32x4 pk_[3], pv_[2];
        const int skey = tid >> 3, c8 = tid & 7;
        const int okv = skey * 1024 + 8 * c8, okr = skey * 64 + 8 * c8, ovt = skey * SEQ + 8 * c8;
        const bf16* kvb = KV + t0 * 1024 + h * 256; const bf16* krb = KR + t0 * 64; const bf16* vtb = VTg + (size_t)(b * 4 + h) * 128 * SEQ;
#define AT_LOAD(kt) do { const bf16* kv_ = kvb + (size_t)(kt) * 65536; const bf16* kr_ = krb + (size_t)(kt) * 4096; const bf16* vt_ = vtb + (size_t)(kt) * 64; \
            pk_[0] = *(const u32x4*)(kv_ + okv); pk_[1] = *(const u32x4*)(kv_ + okv + 64); pk_[2] = *(const u32x4*)(kr_ + okr); \
            pv_[0] = *(const u32x4*)(vt_ + ovt); pv_[1] = *(const u32x4*)(vt_ + ovt + 64 * SEQ); } while (0)
#define AT_STORE(bufi) do { LAS bf16* Ks_ = (LAS bf16*)(F.lds + (bufi) * (AT_KBYTES + AT_VBYTES)); LAS bf16* Vt_ = (LAS bf16*)((LAS unsigned char*)Ks_ + AT_KBYTES); \
            *(LAS u32x4*)(Ks_ + skey * AT_KS + 8 * c8) = pk_[0]; *(LAS u32x4*)(Ks_ + skey * AT_KS + 8 * c8 + 64) = pk_[1]; *(LAS u32x4*)(Ks_ + skey * AT_KS + 8 * c8 + 128) = pk_[2]; \
            *(LAS u32x4*)(Vt_ + skey * AT_VS + 8 * c8) = pv_[0]; *(LAS u32x4*)(Vt_ + (skey + 64) * AT_VS + 8 * c8) = pv_[1]; } while (0)
        __syncthreads();
        AT_LOAD(0); AT_STORE(0);
        __syncthreads();
        for (int kt = 0; kt < ntile; ++kt) {
            if (kt + 1 < ntile) AT_LOAD(kt + 1);
            if (kt <= qchunk) {
                const LAS bf16* Ks = (const LAS bf16*)(F.lds + (kt & 1) * (AT_KBYTES + AT_VBYTES)); const LAS bf16* Vt = (const LAS bf16*)((const LAS unsigned char*)Ks + AT_KBYTES);
                f32x4 st[2][2];
#pragma unroll
                for (int kb = 0; kb < 2; ++kb) { st[0][kb] = (f32x4){0.f, 0.f, 0.f, 0.f}; st[1][kb] = (f32x4){0.f, 0.f, 0.f, 0.f};
#pragma unroll
                    for (int ks = 0; ks < 6; ++ks) { const bf16x8 kf = *(const LAS bf16x8*)(Ks + (32 * grp + 16 * kb + l15) * AT_KS + 32 * ks + 8 * q4);
                        st[0][kb] = MFMA_BF16(kf, qf[0][ks], st[0][kb]); st[1][kb] = MFMA_BF16(kf, qf[1][ks], st[1][kb]); } }
                bf16x8 pb[2];
#pragma unroll
                for (int f = 0; f < 2; ++f) {
                    float mx = -3.0e38f;
#pragma unroll
                    for (int kb = 0; kb < 2; ++kb) { st[f][kb] = st[f][kb] * sc2; mx = fmaxf(mx, fmaxf(fmaxf(st[f][kb].x, st[f][kb].y), fmaxf(st[f][kb].z, st[f][kb].w))); }
                    mx = fmaxf(mx, __shfl_xor(mx, 16)); mx = fmaxf(mx, __shfl_xor(mx, 32));
                    const float mnew = fmaxf(mrow[f], mx), alpha = exp2f(mrow[f] - mnew); mrow[f] = mnew;
                    float ps = 0.f;
#pragma unroll
                    for (int kb = 0; kb < 2; ++kb)
#pragma unroll
                        for (int r = 0; r < 4; ++r) { const float p = exp2f(st[f][kb][r] - mnew); ps += p; pb[f][4 * kb + r] = (short)f2bf(p); }
                    lrow[f] = lrow[f] * alpha + ps;
#pragma unroll
                    for (int mb = 0; mb < 8; ++mb) o[f][mb] = o[f][mb] * alpha;
                }
#pragma unroll
                for (int mb = 0; mb < 8; ++mb) { const LAS bf16* vp = Vt + (16 * mb + l15) * AT_VS + 32 * grp + 4 * q4;
                    const bf16x4 v0 = *(const LAS bf16x4*)vp, v1 = *(const LAS bf16x4*)(vp + 16);
                    bf16x8 vf; vf[0] = v0[0]; vf[1] = v0[1]; vf[2] = v0[2]; vf[3] = v0[3]; vf[4] = v1[0]; vf[5] = v1[1]; vf[6] = v1[2]; vf[7] = v1[3];
                    o[0][mb] = MFMA_BF16(vf, pb[0], o[0][mb]); o[1][mb] = MFMA_BF16(vf, pb[1], o[1][mb]); }
            }
            if (kt + 1 < ntile) AT_STORE((kt + 1) & 1);
            __syncthreads();
        }
#undef AT_LOAD
#undef AT_STORE
#pragma unroll
        for (int f = 0; f < 2; ++f) { lrow[f] += __shfl_xor(lrow[f], 16); lrow[f] += __shfl_xor(lrow[f], 32); }
        LAS float* xo = (LAS float*)F.lds + (size_t)wq * (2 * 8 * 4 * 64 + 4 * 64);
        if (grp == 1) {
#pragma unroll
            for (int f = 0; f < 2; ++f) {
#pragma unroll
                for (int mb = 0; mb < 8; ++mb)
#pragma unroll
                    for (int r = 0; r < 4; ++r) xo[((f * 8 + mb) * 4 + r) * 64 + lane] = o[f][mb][r];
                xo[2 * 8 * 4 * 64 + f * 64 + lane] = mrow[f]; xo[2 * 8 * 4 * 64 + 128 + f * 64 + lane] = lrow[f]; } }
        __syncthreads();
        if (grp == 0) {
#pragma unroll
            for (int f = 0; f < 2; ++f) { const float m1 = xo[2 * 8 * 4 * 64 + f * 64 + lane], l1 = xo[2 * 8 * 4 * 64 + 128 + f * 64 + lane];
                const float m = fmaxf(mrow[f], m1), a0 = exp2f(mrow[f] - m), a1 = exp2f(m1 - m), inv = 1.0f / (lrow[f] * a0 + l1 * a1);
                const size_t tq = t0 + qb * 128 + wq * 32 + 16 * f + l15;
#pragma unroll
                for (int mb = 0; mb < 8; ++mb) { f32x4 v;
#pragma unroll
                    for (int r = 0; r < 4; ++r) v[r] = (o[f][mb][r] * a0 + xo[((f * 8 + mb) * 4 + r) * 64 + lane] * a1) * inv;
                    st_bf16x4(Y + tq * 512 + h * 128 + 16 * mb + 4 * q4, v); } } }
    }
    __syncthreads();
}

__device__ __forceinline__ f32x4 tile_bf(const LAS bf16* a, int lda, const LAS bf16* bt, int ldb, int K, f32x4 acc, int l15, int q4) {
    const LAS bf16* ap = a + l15 * lda + 8 * q4; const LAS bf16* bp = bt + l15 * ldb + 8 * q4;
#pragma unroll 4
    for (int ks = 0; ks < K / 32; ++ks) acc = MFMA_BF16(*(const LAS bf16x8*)(ap + 32 * ks), *(const LAS bf16x8*)(bp + 32 * ks), acc);
    return acc;
}
__device__ __forceinline__ f32x4 tile_mm(const LAS float* a, int lda, int ska, const LAS float* b, int ldb, int scb, int K, f32x4 acc, int l15, int q4);


__device__ __forceinline__ void diag_solve16(const LAS float* Lblk  , int ldl, LAS float* xcol  , int ldx) {
    float x[16];
#pragma unroll
    for (int i = 0; i < 16; ++i) x[i] = xcol[i * ldx];
#pragma unroll
    for (int g = 0; g < 4; ++g) {
        f32x4 av[4][4];
#pragma unroll
        for (int ii = 0; ii < 4; ++ii)
#pragma unroll
            for (int c4 = 0; c4 <= g; ++c4) av[ii][c4] = *(const LAS f32x4*)(Lblk + (4 * g + ii) * ldl + 4 * c4);
#pragma unroll
        for (int ii = 0; ii < 4; ++ii) { const int i = 4 * g + ii; float sacc = x[i];
#pragma unroll
            for (int jj = 0; jj < i; ++jj) sacc -= av[ii][jj >> 2][jj & 3] * x[jj];
            x[i] = sacc; }
    }
#pragma unroll
    for (int i = 1; i < 16; ++i) xcol[i * ldx] = x[i];
}
__device__ __forceinline__ void phase_rwkv_prep(const Frame& F, const Args& A, int layer) {
    const bf16* P = WSP(bf16, A_P); bf16* RKV = WSP(bf16, R_RKV); bf16* LIN = WSP(bf16, R_LIN); const float* mu = AIN(A, 8) + (size_t)layer * 1824;
    const int lane = F.lane;
    for (int m = F.gw; m < TH; m += F.NGW) {
        const bool first = (m % SEQ) == 0; const bf16* pr = P + (size_t)m * PW + C_RWKV;
#pragma unroll
        for (int j = 0; j < 8; ++j) { const int c = 4 * lane + 256 * j;
            if (c < 1824) { const f32x4 p = ld_bf16x4(pr + c); const f32x4 pv = first ? (f32x4){0.f, 0.f, 0.f, 0.f} : ld_bf16x4(pr - PW + c); const f32x4 muv = *(const f32x4*)(mu + c);
                f32x4 x = p + (pv - p) * muv;
                if (c < 1536) st_bf16x4(RKV + (size_t)m * 1536 + c, x);
                else { if (c < 1600) { x.x = tanhf_(x.x); x.y = tanhf_(x.y); x.z = tanhf_(x.z); x.w = tanhf_(x.w); }
                       else if (c >= 1664) { x.x = sigmoidf_(x.x); x.y = sigmoidf_(x.y); x.z = sigmoidf_(x.z); x.w = sigmoidf_(x.w); }
                       st_bf16x4(LIN + (size_t)m * 384 + (c - 1536), x); } } }
        if (lane < 24) st_bf16x4(LIN + (size_t)m * 384 + 288 + 4 * lane, (f32x4){0.f, 0.f, 0.f, 0.f});
    }
}
__device__ __forceinline__ void phase_rwkv_lora(const Frame& F, const Args& A) {
    pg8::Gemm g{WSP(bf16, R_LIN), WSP(bf16, W_LORA), 384, 384}; pg8::StaticOrder S; S.init(TH, 1536, F.G, F.bid);
    EpiF32 E{WSP(float, R_LOUT), 1536}; pg8::gemm_phase(F.lds, g, S, E, F.tid);
}
constexpr int RS = 72;
constexpr int RREC_COMMON = 4 * 64 * RS * 2 + 256;
constexpr int RREC_T = 64 * 64 * 2;
constexpr int RREC_BYTES = RREC_COMMON + 3 * RREC_T;
static_assert(RREC_BYTES == 61696, "record size (see R_REC in the workspace map)");
static_assert(RREC_COMMON % 16 == 0, "record alignment");
__device__ __forceinline__ void phase_rwkv_r1(const Frame& F, const Args& A, int layer) {
    const bf16* RKV = WSP(bf16, R_RKV); const float* LOUT = WSP(float, R_LOUT); unsigned char* REC = WSP(unsigned char, R_REC);
    const float* w0 = AIN(A, 9) + layer * 512; const float* a0 = AIN(A, 11) + layer * 512; const float* k_k = AIN(A, 14) + layer * 512; const float* k_a = AIN(A, 15) + layer * 512;
    LAS bf16* kbar = (LAS bf16*)F.lds; LAS bf16* atil = kbar + 64 * RS; LAS bf16* khat = atil + 64 * RS; LAS bf16* rbar = khat + 64 * RS;
    LAS bf16* atT = rbar + 64 * RS; LAS bf16* khT = atT + 64 * RS; LAS bf16* vT = khT + 64 * RS; LAS bf16* Bm = vT + 64 * RS; LAS bf16* Em = Bm + 64 * RS;
    LAS float* Am = (LAS float*)(Em + 64 * RS);
    LAS float* X = Am + 64 * 68;
    LAS float* lam = Am;
    const int tid = F.tid, lane = F.lane, w = F.wave, l15 = lane & 15, q4 = lane >> 4;
    const int nunits = BH * 8 * NCH;
    for (int unit = F.bid; unit < nunits; unit += F.G) {
        const int c = unit % NCH, h = (unit / NCH) & 7, b = unit / (NCH * 8);
        const size_t tok0 = (size_t)b * SEQ + (size_t)c * 64;
        const int j = lane, cj = h * 64 + j;
        __syncthreads();
        float r_[8], km_[8], kk_[8], ka_[8], v_[8], L_[8];
        { const float w0c = w0[cj], a0c = a0[cj], kkc = k_k[cj], kac = k_a[cj]; float run = 0.f;
#pragma unroll
          for (int q = 0; q < 8; ++q) { const int t = 8 * w + q; const size_t tok = tok0 + t;
              const float r = bf2f(RKV[tok * 1536 + cj]), k = bf2f(RKV[tok * 1536 + 512 + cj]); v_[q] = bf2f(RKV[tok * 1536 + 1024 + cj]);
              const float wpre = LOUT[tok * 1536 + cj], apre = LOUT[tok * 1536 + 512 + cj];
              const float wl = -softplusf_(-(w0c + wpre)) - 0.5f, a = sigmoidf_(a0c + apre);
              const float kr = k * kkc, ss = wave_sum(kr * kr), kk = kr * RSQRT(ss + EPS);
              r_[q] = r; km_[q] = k * (1.0f + (a - 1.0f) * kac); kk_[q] = kk; ka_[q] = kk * a;
              run += -expf(wl); L_[q] = run; }
          lam[w * 64 + j] = run; }
        __syncthreads();
        { float base = 0.f, Lend = 0.f;
#pragma unroll
          for (int ww = 0; ww < 8; ++ww) { const float tw = lam[ww * 64 + j]; if (ww < w) base += tw; Lend += tw; }
#pragma unroll
          for (int q = 0; q < 8; ++q) { const int t = 8 * w + q; const float L = base + L_[q], Lm1 = q ? base + L_[q - 1] : base;
              const float eG = expf(L), eGi = expf(-L), eGm1 = expf(Lm1), eT = expf(Lend - L);
              const float kb = kk_[q] * eGm1;
              kbar[t * RS + j] = (bf16)f2bf(kb); X[t * 132 + j] = kb;
              atil[t * RS + j] = (bf16)f2bf(ka_[q] * eGi); khat[t * RS + j] = (bf16)f2bf(km_[q] * eGi); rbar[t * RS + j] = (bf16)f2bf(r_[q] * eG);
              atT[j * RS + t] = (bf16)f2bf(-ka_[q] * eT); khT[j * RS + t] = (bf16)f2bf(km_[q] * eT); vT[j * RS + t] = (bf16)f2bf(v_[q]); }
          if (w == 0) { float* gc = (float*)(REC + (size_t)unit * RREC_BYTES + 4 * 64 * RS * 2); gc[j] = expf(Lend); } }
        __syncthreads();
        unsigned char* rec = REC + (size_t)unit * RREC_BYTES;
        for (int tt = 0; tt < 8; ++tt) { const int tile = w * 8 + tt, which = tile >> 4, ti = (tile >> 2) & 3, tj = tile & 3;
            f32x4 acc = (f32x4){0.f, 0.f, 0.f, 0.f};
            if (tj <= ti) acc = tile_bf(((which & 2) ? rbar : kbar) + 16 * ti * RS, RS, ((which & 1) ? khat : atil) + 16 * tj * RS, RS, 64, acc, l15, q4);
#pragma unroll
            for (int r = 0; r < 4; ++r) { const int i = 16 * ti + 4 * q4 + r, jj = 16 * tj + l15; const bool keep = (which & 2) ? (jj <= i) : (jj < i); const float v = keep ? acc[r] : 0.f;
                if (which == 0) Am[i * 68 + jj] = v; else if (which == 1) Bm[i * RS + jj] = (bf16)f2bf(v); else if (which == 3) Em[i * RS + jj] = (bf16)f2bf(v);
                else ((bf16*)(rec + 2 * 64 * RS * 2))[i * RS + jj] = (bf16)f2bf(-v); } }
        __syncthreads();
        for (int tt = 0; tt < 6; ++tt) { const int tile = w * 6 + tt, which = tile >> 4, ti = (tile >> 2) & 3, tj = tile & 3;
            const LAS bf16* aop = which == 0 ? Bm : which == 1 ? Em : khT;
            const f32x4 acc = tile_bf(aop + 16 * ti * RS, RS, vT + 16 * tj * RS, RS, 64, (f32x4){0.f, 0.f, 0.f, 0.f}, l15, q4);
#pragma unroll
            for (int r = 0; r < 4; ++r) { const int i = 16 * ti + 4 * q4 + r, vv = 16 * tj + l15;
                if (which == 0) X[i * 132 + 64 + vv] = acc[r];                }
            if (which) st_bf16x4((bf16*)(rec + RREC_COMMON + which * RREC_T) + (16 * tj + l15) * 64 + 16 * ti + 4 * q4, acc); }
        __syncthreads();
        for (int rb = 0; rb < 4; ++rb) {
            if (rb > 0) {
                const f32x4 acc = tile_mm(Am + 16 * rb * 68, 68, 1, X + 16 * w, 132, 1, 16 * rb, (f32x4){0.f, 0.f, 0.f, 0.f}, l15, q4);
#pragma unroll
                for (int r = 0; r < 4; ++r) X[(16 * rb + 4 * q4 + r) * 132 + 16 * w + l15] -= acc[r];
                __syncthreads();
            }
            if (tid < 128) diag_solve16(Am + 16 * rb * 68 + 16 * rb, 68, X + 16 * rb * 132 + tid, 132);
            __syncthreads();
        }
        { const int t = tid >> 3, j0 = 8 * (tid & 7); float v[8];
#pragma unroll
          for (int q = 0; q < 8; ++q) v[q] = X[t * 132 + j0 + q];
          *(u32x4*)((bf16*)rec + t * RS + j0) = pack8(v);
          const int vv = tid >> 3, t0 = 8 * (tid & 7);
#pragma unroll
          for (int q = 0; q < 8; ++q) v[q] = X[(t0 + q) * 132 + 64 + vv];
          *(u32x4*)((bf16*)(rec + RREC_COMMON) + vv * 64 + t0) = pack8(v); }
        for (int e = tid; e < 64 * RS / 8; e += 512) { ((u32x4*)(rec + 64 * RS * 2))[e] = ((const LAS u32x4*)rbar)[e]; ((u32x4*)(rec + 3 * 64 * RS * 2))[e] = ((const LAS u32x4*)atT)[e]; }
    }
    __syncthreads();
}
constexpr int R2_BUF = RREC_COMMON;
__device__ __forceinline__ void phase_rwkv_r2(const Frame& F, const Args& A) {
    const unsigned char* REC = WSP(unsigned char, R_REC); float* RO = WSP(float, R_O);
    LAS unsigned char* buf0 = F.lds; LAS bf16* HT = (LAS bf16*)(F.lds + 2 * R2_BUF); LAS bf16* UT = HT + 2 * 64 * RS;
    const int tid = F.tid, lane = F.lane, w = F.wave, l15 = lane & 15, q4 = lane >> 4, ti = w >> 1;
    const int nunits = BH * 8;
    constexpr int NCHK = R2_BUF / 16;
    for (int unit = F.bid; unit < nunits; unit += F.G) {
        const int h = unit & 7, b = unit >> 3;
        __syncthreads();
        for (int e = tid; e < 2 * 64 * RS / 2; e += 512) ((LAS unsigned*)HT)[e] = 0u;
        f32x4 Hreg[2] = {(f32x4){0.f, 0.f, 0.f, 0.f}, (f32x4){0.f, 0.f, 0.f, 0.f}};
        u32x4 preA[5], preB[5]; u32x2 iniA[3][2], iniB[3][2], cur[3][2];
        const unsigned char* rec0 = REC + (size_t)((b * 8 + h) * NCH) * RREC_BYTES;
        const int tofs = ((16 * (2 * (w & 1)) + l15) * 64 + 16 * ti + 4 * q4) * 2;
#define R2_LOAD(S, recp) do { _Pragma("unroll") for (int q = 0; q < 5; ++q) { const int e = tid + 512 * q; if (e < NCHK) pre##S[q] = *(const u32x4*)((recp) + (size_t)e * 16); } \
            _Pragma("unroll") for (int mq = 0; mq < 3; ++mq) { ini##S[mq][0] = *(const u32x2*)((recp) + RREC_COMMON + mq * RREC_T + tofs); ini##S[mq][1] = *(const u32x2*)((recp) + RREC_COMMON + mq * RREC_T + tofs + 16 * 64 * 2); } } while (0)
#define R2_STORE(S, dst) do { _Pragma("unroll") for (int q = 0; q < 5; ++q) { const int e = tid + 512 * q; if (e < NCHK) *(LAS u32x4*)((dst) + (size_t)e * 16) = pre##S[q]; } } while (0)
#define R2_TAKE(S) do { _Pragma("unroll") for (int mq = 0; mq < 3; ++mq) { cur[mq][0] = ini##S[mq][0]; cur[mq][1] = ini##S[mq][1]; } } while (0)
        R2_LOAD(A, rec0); R2_STORE(A, buf0); R2_TAKE(A);
        if (NCH > 1) R2_LOAD(A, rec0 + (size_t)RREC_BYTES);
        __syncthreads();
#define R2_STEP(c, LS, SS) do { \
            LAS unsigned char* buf = buf0 + ((c) & 1) * R2_BUF; LAS unsigned char* nbuf = buf0 + (((c) + 1) & 1) * R2_BUF; \
            if ((c) + 2 < NCH) R2_LOAD(LS, rec0 + (size_t)((c) + 2) * RREC_BYTES); \
            const LAS bf16* KB = (const LAS bf16*)buf; const LAS bf16* RB = KB + 64 * RS; const LAS bf16* FMn = RB + 64 * RS; const LAS bf16* ATn = FMn + 64 * RS; \
            const LAS float* GC = (const LAS float*)(buf + 4 * 64 * RS * 2); \
            const LAS bf16* H0 = HT + ((c) & 1) * 64 * RS; LAS bf16* H1 = HT + (((c) + 1) & 1) * 64 * RS; \
            _Pragma("unroll") for (int t2 = 0; t2 < 2; ++t2) { const int tj = 2 * (w & 1) + t2; \
                f32x4 u = (f32x4){bf2f(cur[0][t2].x & 0xffffu), bf2f(cur[0][t2].x >> 16), bf2f(cur[0][t2].y & 0xffffu), bf2f(cur[0][t2].y >> 16)}; \
                u = tile_bf(KB + 16 * ti * RS, RS, H0 + 16 * tj * RS, RS, 64, u, l15, q4); \
                u32x2 pk; pk.x = pk2(u[0], u[1]); pk.y = pk2(u[2], u[3]); *(LAS u32x2*)(UT + (16 * tj + l15) * RS + 16 * ti + 4 * q4) = pk; } \
            __syncthreads(); \
            _Pragma("unroll") for (int t2 = 0; t2 < 2; ++t2) { const int tj = 2 * (w & 1) + t2; \
                f32x4 o = (f32x4){bf2f(cur[1][t2].x & 0xffffu), bf2f(cur[1][t2].x >> 16), bf2f(cur[1][t2].y & 0xffffu), bf2f(cur[1][t2].y >> 16)}; \
                o = tile_bf(RB + 16 * ti * RS, RS, H0 + 16 * tj * RS, RS, 64, o, l15, q4); \
                o = tile_bf(FMn + 16 * ti * RS, RS, UT + 16 * tj * RS, RS, 64, o, l15, q4); \
                _Pragma("unroll") for (int r = 0; r < 4; ++r) RO[((size_t)b * SEQ + (size_t)(c) * 64 + 16 * ti + 4 * q4 + r) * 512 + h * 64 + 16 * tj + l15] = o[r]; \
                const f32x4 kv = (f32x4){bf2f(cur[2][t2].x & 0xffffu), bf2f(cur[2][t2].x >> 16), bf2f(cur[2][t2].y & 0xffffu), bf2f(cur[2][t2].y >> 16)}; \
                _Pragma("unroll") for (int r = 0; r < 4; ++r) Hreg[t2][r] = Hreg[t2][r] * GC[16 * ti + 4 * q4 + r] + kv[r]; \
                Hreg[t2] = tile_bf(ATn + 16 * ti * RS, RS, UT + 16 * tj * RS, RS, 64, Hreg[t2], l15, q4); \
                u32x2 pk; pk.x = pk2(Hreg[t2][0], Hreg[t2][1]); pk.y = pk2(Hreg[t2][2], Hreg[t2][3]); *(LAS u32x2*)(H1 + (16 * tj + l15) * RS + 16 * ti + 4 * q4) = pk; } \
            if ((c) + 1 < NCH) { R2_STORE(SS, nbuf); R2_TAKE(SS); } \
            __syncthreads(); } while (0)
        for (int c = 0; c < NCH; c += 2) { R2_STEP(c, B, A); R2_STEP(c + 1, A, B); }
#undef R2_STEP
#undef R2_STORE
#undef R2_TAKE
#undef R2_LOAD
    }
    __syncthreads();
}
__device__ __forceinline__ void phase_rwkv_post(const Frame& F, const Args& A, int layer) {
    const bf16* RKV = WSP(bf16, R_RKV); const float* LOUT = WSP(float, R_LOUT); const float* RO = WSP(float, R_O); bf16* Y = WSP(bf16, A_Y) + (size_t)1 * TH * 512;
    const float* a0 = AIN(A, 11) + layer * 512; const float* k_a = AIN(A, 15) + layer * 512; const float* r_k = AIN(A, 16) + layer * 512; const float* ln_w = AIN(A, 17) + layer * 512; const float* ln_b = AIN(A, 18) + layer * 512;
    const int lane = F.lane, c0 = 8 * lane;
    for (int m = F.gw; m < TH; m += F.NGW) {
        float o[8], r[8], k[8], v[8], ap[8], g[8];
        { const f32x4 a = *(const f32x4*)(RO + (size_t)m * 512 + c0), b2 = *(const f32x4*)(RO + (size_t)m * 512 + c0 + 4); o[0] = a.x; o[1] = a.y; o[2] = a.z; o[3] = a.w; o[4] = b2.x; o[5] = b2.y; o[6] = b2.z; o[7] = b2.w; }
#pragma unroll
        for (int hh = 0; hh < 2; ++hh) { const f32x4 rv = ld_bf16x4(RKV + (size_t)m * 1536 + c0 + 4 * hh), kv = ld_bf16x4(RKV + (size_t)m * 1536 + 512 + c0 + 4 * hh), vv = ld_bf16x4(RKV + (size_t)m * 1536 + 1024 + c0 + 4 * hh);
            const f32x4 av = *(const f32x4*)(LOUT + (size_t)m * 1536 + 512 + c0 + 4 * hh), gv = *(const f32x4*)(LOUT + (size_t)m * 1536 + 1024 + c0 + 4 * hh);
#pragma unroll
            for (int q = 0; q < 4; ++q) { r[4 * hh + q] = rv[q]; k[4 * hh + q] = kv[q]; v[4 * hh + q] = vv[q]; ap[4 * hh + q] = av[q]; g[4 * hh + q] = gv[q]; } }
        float bon = 0.f, sm = 0.f;
#pragma unroll
        for (int q = 0; q < 8; ++q) { const float a = sigmoidf_(a0[c0 + q] + ap[q]); const float km = k[q] * (1.0f + (a - 1.0f) * k_a[c0 + q]); bon += r[q] * km * r_k[c0 + q]; sm += o[q]; }
        bon += __shfl_xor(bon, 1); bon += __shfl_xor(bon, 2); bon += __shfl_xor(bon, 4);
        sm += __shfl_xor(sm, 1); sm += __shfl_xor(sm, 2); sm += __shfl_xor(sm, 4);
        const float mean = sm * (1.0f / 64.0f); float vs = 0.f;
#pragma unroll
        for (int q = 0; q < 8; ++q) { const float d = o[q] - mean; vs += d * d; }
        vs += __shfl_xor(vs, 1); vs += __shfl_xor(vs, 2); vs += __shfl_xor(vs, 4);
        const float rstd = RSQRT(vs * (1.0f / 64.0f) + 64e-5f);
        float y[8];
#pragma unroll
        for (int q = 0; q < 8; ++q) y[q] = ((o[q] - mean) * rstd * ln_w[c0 + q] + ln_b[c0 + q] + bon * v[q]) * g[q];
        u32x4 wv; wv.x = pk2(y[0], y[1]); wv.y = pk2(y[2], y[3]); wv.z = pk2(y[4], y[5]); wv.w = pk2(y[6], y[7]);
        *(u32x4*)(Y + (size_t)m * 512 + c0) = wv;
    }
}

__device__ __forceinline__ void conv8x8(const bf16* src, int tl0  , const float* w  , int wld, const float* bias, float (&out)[8][8]) {
    float x[11][8];
#pragma unroll
    for (int i = 0; i < 11; ++i) { const int tl = tl0 - 3 + i;
        if (tl >= 0) { const u32x4 v = *(const u32x4*)(src + (ptrdiff_t)(i - 3) * PW);
            x[i][0] = bf2f(v.x & 0xffffu); x[i][1] = bf2f(v.x >> 16); x[i][2] = bf2f(v.y & 0xffffu); x[i][3] = bf2f(v.y >> 16); x[i][4] = bf2f(v.z & 0xffffu); x[i][5] = bf2f(v.z >> 16); x[i][6] = bf2f(v.w & 0xffffu); x[i][7] = bf2f(v.w >> 16); }
        else {
#pragma unroll
            for (int ch = 0; ch < 8; ++ch) x[i][ch] = 0.f; } }
    float wv[4][8], bv[8];
#pragma unroll
    for (int j = 0; j < 4; ++j) { const f32x4 a = *(const f32x4*)(w + j * wld), b = *(const f32x4*)(w + j * wld + 4); wv[j][0] = a.x; wv[j][1] = a.y; wv[j][2] = a.z; wv[j][3] = a.w; wv[j][4] = b.x; wv[j][5] = b.y; wv[j][6] = b.z; wv[j][7] = b.w; }
    if (bias) { const f32x4 a = *(const f32x4*)bias, b = *(const f32x4*)(bias + 4); bv[0] = a.x; bv[1] = a.y; bv[2] = a.z; bv[3] = a.w; bv[4] = b.x; bv[5] = b.y; bv[6] = b.z; bv[7] = b.w; }
    else {
#pragma unroll
        for (int ch = 0; ch < 8; ++ch) bv[ch] = 0.f; }
#pragma unroll
    for (int i = 0; i < 8; ++i)
#pragma unroll
        for (int ch = 0; ch < 8; ++ch) { const float a = bv[ch] + wv[0][ch] * x[i][ch] + wv[1][ch] * x[i + 1][ch] + wv[2][ch] * x[i + 2][ch] + wv[3][ch] * x[i + 3][ch]; out[i][ch] = a * fast_rcp(1.0f + fast_exp(-a)); }
}
constexpr int SB = 136;
constexpr int SC_IMG = 64 * SB * 2;
__device__ __forceinline__ void phase_ssd_s1(const Frame& F, const Args& A, int layer) {
    const bf16* P = WSP(bf16, A_P); bf16* ST = WSP(bf16, S_ST); float* YD = WSP(float, S_YD); unsigned char* SCB = WSP(unsigned char, S_C); float* AC = WSP(float, S_AC);
    const float* cw = AIN(A, 23) + (size_t)layer * 4 * 1024; const float* cb = AIN(A, 24) + layer * 1024; const float* dtb = AIN(A, 25) + layer * 8; const float* a_log = AIN(A, 26) + layer * 8; const float* dsk = AIN(A, 27) + layer * 8;
    LAS bf16* Bt_ = (LAS bf16*)F.lds; LAS bf16* Ct_ = Bt_ + 64 * SB; LAS bf16* BT = Ct_ + 64 * SB; LAS bf16* xT = BT + 128 * RS;
    LAS bf16* Mb = xT + 4 * 64 * RS; LAS bf16* xdT = Mb + 2 * 64 * RS; LAS float* dt = (LAS float*)(xdT + 2 * 64 * RS); LAS float* ac = dt + 256;
    const int tid = F.tid, lane = F.lane, w = F.wave, l15 = lane & 15, q4 = lane >> 4;
    const int nunits = BH * NCH * 2;
    for (int unit = F.bid; unit < nunits; unit += F.G) {
        const int g = unit & 1, c = (unit >> 1) % NCH, b = unit / (2 * NCH);
        const size_t tok0 = (size_t)b * SEQ + (size_t)c * 64;
        __syncthreads();
        {
            const int cg = tid & 63, rb = tid >> 6;
            const int cidx = cg < 32 ? g * 256 + 8 * cg : cg < 48 ? 512 + g * 128 + 8 * (cg - 32) : 768 + g * 128 + 8 * (cg - 48);
            float o[8][8];
            conv8x8(P + (tok0 + 8 * rb) * PW + C_SSD + 512 + cidx, c * 64 + 8 * rb, cw + cidx, 1024, cb + cidx, o);
            if (cg < 32) {
                const int hh = cg >> 3, p0 = 8 * (cg & 7);
#pragma unroll
                for (int ch = 0; ch < 8; ++ch) { float col[8];
#pragma unroll
                    for (int i = 0; i < 8; ++i) col[i] = o[i][ch];
                    *(LAS u32x4*)(xT + (hh * 64 + p0 + ch) * RS + 8 * rb) = pack8(col); }
            } else if (cg < 48) {
                const int n0 = 8 * (cg - 32);
#pragma unroll
                for (int i = 0; i < 8; ++i) *(LAS u32x4*)(Bt_ + (8 * rb + i) * SB + n0) = pack8(o[i]);
#pragma unroll
                for (int ch = 0; ch < 8; ++ch) { float col[8];
#pragma unroll
                    for (int i = 0; i < 8; ++i) col[i] = o[i][ch];
                    *(LAS u32x4*)(BT + (n0 + ch) * RS + 8 * rb) = pack8(col); }
            } else { const int n0 = 8 * (cg - 48);
#pragma unroll
                for (int i = 0; i < 8; ++i) *(LAS u32x4*)(Ct_ + (8 * rb + i) * SB + n0) = pack8(o[i]); }
        }
        if (tid < 256) { const int hh = tid >> 6, h = 4 * g + hh; const float d = softplusf_(bf2f(P[(tok0 + lane) * PW + C_SSD + 1536 + h]) + dtb[h]); float a = -expf(a_log[h]) * d;
#pragma unroll
            for (int o = 1; o < 64; o <<= 1) { const float t = __shfl_up(a, o); if (lane >= o) a += t; }
            dt[tid] = d; ac[tid] = a; AC[(tok0 + lane) * 8 + h] = a; }
        __syncthreads();
        { unsigned char* dst = SCB + (size_t)unit * SC_IMG; for (int e = tid; e < SC_IMG / 16; e += 512) ((u32x4*)dst)[e] = ((const LAS u32x4*)Ct_)[e]; }
        f32x4 cbt[2];
#pragma unroll
        for (int tt = 0; tt < 2; ++tt) { const int tile = w * 2 + tt, ti = tile >> 2, tj = tile & 3; cbt[tt] = (f32x4){0.f, 0.f, 0.f, 0.f};
            if (tj <= ti) cbt[tt] = tile_bf(Ct_ + 16 * ti * SB, SB, Bt_ + 16 * tj * SB, SB, 128, cbt[tt], l15, q4); }
        for (int hh = 0; hh < 4; ++hh) { const int h = 4 * g + hh; LAS bf16* M = Mb + (hh & 1) * 64 * RS; LAS bf16* xd = xdT + (hh & 1) * 64 * RS; const LAS float* dth = dt + hh * 64; const LAS float* ach = ac + hh * 64;
#pragma unroll
            for (int tt = 0; tt < 2; ++tt) { const int tile = w * 2 + tt, ti = tile >> 2, tj = tile & 3;
#pragma unroll
                for (int r = 0; r < 4; ++r) { const int l = 16 * ti + 4 * q4 + r, s = 16 * tj + l15; M[l * RS + s] = (bf16)f2bf((s <= l) ? cbt[tt][r] * expf(ach[l] - ach[s]) * dth[s] : 0.f); } }
            { const int p = tid >> 3, l0 = 8 * (tid & 7); const u32x4 v = *(const LAS u32x4*)(xT + (hh * 64 + p) * RS + l0); const float a63 = ach[63]; float xv[8] = {bf2f(v.x & 0xffffu), bf2f(v.x >> 16), bf2f(v.y & 0xffffu), bf2f(v.y >> 16), bf2f(v.z & 0xffffu), bf2f(v.z >> 16), bf2f(v.w & 0xffffu), bf2f(v.w >> 16)};
#pragma unroll
              for (int i = 0; i < 8; ++i) xv[i] *= dth[l0 + i] * expf(a63 - ach[l0 + i]);
              *(LAS u32x4*)(xd + p * RS + l0) = pack8(xv); }
            __syncthreads();
#pragma unroll
            for (int tt = 0; tt < 2; ++tt) { const int tile = w * 2 + tt, ti = tile >> 2, tj = tile & 3;
                const f32x4 acc = tile_bf(M + 16 * ti * RS, RS, xT + (hh * 64 + 16 * tj) * RS, RS, 64, (f32x4){0.f, 0.f, 0.f, 0.f}, l15, q4);
                const f32x4 xs = ld_bf16x4((const bf16*)(xT + (hh * 64 + 16 * tj + l15) * RS + 16 * ti + 4 * q4));
#pragma unroll
                for (int r = 0; r < 4; ++r) YD[(tok0 + 16 * ti + 4 * q4 + r) * 512 + h * 64 + 16 * tj + l15] = acc[r] + dsk[h] * xs[r]; }
            bf16* st = ST + ((size_t)((b * NCH + c) * 8 + h)) * 64 * 128;
#pragma unroll
            for (int tt = 0; tt < 4; ++tt) { const int tile = w * 4 + tt, ti = tile >> 2, tj = tile & 3;
                const f32x4 acc = tile_bf(BT + 16 * ti * RS, RS, xd + 16 * tj * RS, RS, 64, (f32x4){0.f, 0.f, 0.f, 0.f}, l15, q4);
                st_bf16x4(st + (16 * tj + l15) * 128 + 16 * ti + 4 * q4, acc); }
        }
    }
    __syncthreads();
}
__device__ __forceinline__ void phase_ssd_s23(const Frame& F, const Args& A) {
    const bf16* ST = WSP(bf16, S_ST); float* YO = WSP(float, S_YO); const unsigned char* SCB = WSP(unsigned char, S_C); const float* AC = WSP(float, S_AC);
    LAS bf16* Cimg = (LAS bf16*)F.lds; LAS bf16* Hb = Cimg + 2 * 64 * SB;
    const int tid = F.tid, lane = F.lane, w = F.wave, l15 = lane & 15, q4 = lane >> 4;
    const int nunits = BH * 8 * 4, hp = tid >> 5, hn = 4 * (tid & 31);
    constexpr int NCK = SC_IMG / 16;
    for (int unit = F.bid; unit < nunits; unit += F.G) {
        const int ps = unit & 3, h = (unit >> 2) & 7, b = unit >> 5, g = h >> 2;
        __syncthreads();
        f32x4 Hr = (f32x4){0.f, 0.f, 0.f, 0.f};
        u32x4 preA[3], preB[3]; u32x2 pstA, pstB, stc; float eaA[5], eaB[5], eac[5];
        const size_t tokb = (size_t)b * SEQ;
#define S23_LOAD(S, cc) do { const unsigned char* src_ = SCB + (size_t)((b * NCH + (cc)) * 2 + g) * SC_IMG; \
            _Pragma("unroll") for (int q = 0; q < 3; ++q) { const int e = tid + 512 * q; if (e < NCK) pre##S[q] = *(const u32x4*)(src_ + (size_t)e * 16); } \
            pst##S = *(const u32x2*)(ST + ((size_t)((b * NCH + (cc)) * 8 + h)) * 8192 + (16 * ps + hp) * 128 + hn); \
            _Pragma("unroll") for (int r = 0; r < 4; ++r) ea##S[r] = AC[(tokb + (size_t)(cc) * 64 + 16 * (w & 3) + 4 * q4 + r) * 8 + h]; \
            ea##S[4] = AC[(tokb + (size_t)(cc) * 64 + 63) * 8 + h]; } while (0)
#define S23_STORE(S, dst) do { _Pragma("unroll") for (int q = 0; q < 3; ++q) { const int e = tid + 512 * q; if (e < NCK) ((LAS u32x4*)(dst))[e] = pre##S[q]; } } while (0)
#define S23_TAKE(S) do { stc = pst##S; _Pragma("unroll") for (int r = 0; r < 5; ++r) eac[r] = ea##S[r]; } while (0)
        S23_LOAD(A, 0); S23_STORE(A, Cimg); S23_TAKE(A);
        if (NCH > 1) S23_LOAD(A, 1);
#define S23_STEP(c, LS, SS) do { \
            const size_t tok0 = tokb + (size_t)(c) * 64; \
            if ((c) + 2 < NCH) S23_LOAD(LS, (c) + 2); \
            st_bf16x4((bf16*)(Hb + hp * SB + hn), Hr); \
            __syncthreads(); \
            if (w < 4) { const LAS bf16* Ci = Cimg + ((c) & 1) * 64 * SB; \
                const f32x4 acc = tile_bf(Ci + 16 * w * SB, SB, Hb, SB, 128, (f32x4){0.f, 0.f, 0.f, 0.f}, l15, q4); \
                _Pragma("unroll") for (int r = 0; r < 4; ++r) { const size_t tok = tok0 + 16 * w + 4 * q4 + r; YO[tok * 512 + h * 64 + 16 * ps + l15] = acc[r] * expf(eac[r]); } } \
            { const float dec = expf(eac[4]); Hr.x = dec * Hr.x + bf2f(stc.x & 0xffffu); Hr.y = dec * Hr.y + bf2f(stc.x >> 16); Hr.z = dec * Hr.z + bf2f(stc.y & 0xffffu); Hr.w = dec * Hr.w + bf2f(stc.y >> 16); } \
            if ((c) + 1 < NCH) { S23_STORE(SS, Cimg + (((c) + 1) & 1) * 64 * SB); S23_TAKE(SS); } \
            __syncthreads(); } while (0)
        for (int c = 0; c < NCH; c += 2) { S23_STEP(c, B, A); S23_STEP(c + 1, A, B); }
#undef S23_STEP
#undef S23_TAKE
#undef S23_STORE
#undef S23_LOAD
    }
    __syncthreads();
}
__device__ __forceinline__ void phase_ssd_s4(const Frame& F, const Args& A, int layer) {
    const float* YD = WSP(float, S_YD); const float* YO = WSP(float, S_YO); const bf16* P = WSP(bf16, A_P); bf16* Y = WSP(bf16, A_Y) + (size_t)3 * TH * 512; const float* nw = AIN(A, 28) + layer * 512;
    const int lane = F.lane, c0 = 8 * lane;
    for (int m = F.gw; m < TH; m += F.NGW) {
        const f32x4 a = *(const f32x4*)(YD + (size_t)m * 512 + c0) + *(const f32x4*)(YO + (size_t)m * 512 + c0), b2 = *(const f32x4*)(YD + (size_t)m * 512 + c0 + 4) + *(const f32x4*)(YO + (size_t)m * 512 + c0 + 4);
        const f32x4 z0 = ld_bf16x4(P + (size_t)m * PW + C_SSD + c0), z1 = ld_bf16x4(P + (size_t)m * PW + C_SSD + c0 + 4);
        float y[8] = {a.x * siluf_(z0.x), a.y * siluf_(z0.y), a.z * siluf_(z0.z), a.w * siluf_(z0.w), b2.x * siluf_(z1.x), b2.y * siluf_(z1.y), b2.z * siluf_(z1.z), b2.w * siluf_(z1.w)};
        float ss = 0.f;
#pragma unroll
        for (int q = 0; q < 8; ++q) ss += y[q] * y[q];
        ss += __shfl_xor(ss, 1); ss += __shfl_xor(ss, 2); ss += __shfl_xor(ss, 4); ss += __shfl_xor(ss, 8); ss += __shfl_xor(ss, 16);
        const float rstd = RSQRT(ss * (1.0f / 256.0f) + EPS);
#pragma unroll
        for (int q = 0; q < 8; ++q) y[q] = y[q] * rstd * nw[c0 + q];
        u32x4 wv; wv.x = pk2(y[0], y[1]); wv.y = pk2(y[2], y[3]); wv.z = pk2(y[4], y[5]); wv.w = pk2(y[6], y[7]);
        *(u32x4*)(Y + (size_t)m * 512 + c0) = wv;
    }
}

__device__ __forceinline__ f32x4 tile_mm(const LAS float* a, int lda, int ska, const LAS float* b, int ldb, int scb, int K, f32x4 acc, int l15, int q4) {
    const LAS float* ap = a + l15 * lda + q4 * ska; const LAS float* bp = b + q4 * ldb + l15 * scb;
#pragma unroll 8
    for (int ks = 0; ks < K / 4; ++ks) acc = MFMA_F32(ap[ks * 4 * ska], bp[ks * 4 * ldb], acc);
    return acc;
}
constexpr int GS = 132, GS2 = 68;
constexpr int GR_W = 0, GR_QH = 64 * 136 * 2, GR_KT = 2 * 64 * 136 * 2, GR_QK = GR_KT + 128 * 72 * 2, GR_GL = GR_QK + 64 * 72 * 2, GR_COMMON = GR_GL + 16, GR_UT = 128 * 64 * 2, GR_BYTES = GR_COMMON + GR_UT;
static_assert(GR_BYTES == 78864 && GR_COMMON % 16 == 0, "GDN record");
constexpr int GX = 264;
__device__ __forceinline__ void phase_gdn_g1(const Frame& F, const Args& A, int layer) {
    const bf16* P = WSP(bf16, A_P); unsigned char* CHR = WSP(unsigned char, G_CH);
    const float* convw = AIN(A, 19) + (size_t)layer * 4 * 1536; const float* a_log = AIN(A, 20) + layer * 4; const float* dtb = AIN(A, 21) + layer * 4;
    LAS bf16* qb = (LAS bf16*)F.lds; LAS bf16* kb = qb + 64 * SB; LAS bf16* qkimg = kb + 64 * SB;
    LAS float* X = (LAS float*)(qkimg + 64 * RS); LAS float* Lm = X + 64 * GX; LAS float* ssq = Lm + 64 * GS2;
    LAS float* beta = ssq + 2 * 64 * 16; LAS float* gc = beta + 64; LAS float* egc = gc + 64; LAS float* inorm = egc + 64;
    const int w = F.wave;
    const int nunits = BH * 4 * NCH;
    for (int unit = F.bid; unit < nunits; unit += F.G) {
        int tid = F.tid; OPAQUE_V(tid); const int lane = tid & 63, l15 = lane & 15, q4 = lane >> 4;
        const int c = unit % NCH, h = (unit / NCH) & 3, b = unit / (NCH * 4);
        const size_t tok0 = (size_t)b * SEQ + (size_t)c * 64;
        unsigned char* rec = CHR + (size_t)unit * GR_BYTES;
        __syncthreads();
        const int rb = tid / 48, pc = tid % 48, part = pc >> 4, cgl = pc & 15;
        float o[8][8];
        if (tid < 384) { const int col = part * 512 + h * 128 + 8 * cgl;
            conv8x8(P + (tok0 + 8 * rb) * PW + C_GDN + col, c * 64 + 8 * rb, convw + col, 1536, nullptr, o);
            if (part < 2) {
#pragma unroll
                for (int i = 0; i < 8; ++i) { float sacc = 0.f;
#pragma unroll
                    for (int ch = 0; ch < 8; ++ch) sacc += o[i][ch] * o[i][ch];
                    ssq[(part * 64 + 8 * rb + i) * 16 + cgl] = sacc; } } }
        if (w == 7) { const size_t tok = tok0 + lane; beta[lane] = sigmoidf_(bf2f(P[tok * PW + C_GDN + 1536 + h]));
            float g = -expf(a_log[h]) * softplusf_(bf2f(P[tok * PW + C_GDN + 1540 + h]) + dtb[h]);
#pragma unroll
            for (int o2 = 1; o2 < 64; o2 <<= 1) { const float t = __shfl_up(g, o2); if (lane >= o2) g += t; }
            gc[lane] = g; egc[lane] = expf(g); }
        __syncthreads();
        if (tid < 128) { float sacc = 0.f;
#pragma unroll
            for (int i = 0; i < 16; ++i) sacc += ssq[tid * 16 + i];
            inorm[tid] = (tid < 64 ? 0.08838834764831845f : 1.0f) * RSQRT(sacc + EPS); }
        __syncthreads();
        if (tid < 384) {
#pragma unroll
            for (int i = 0; i < 8; ++i) { const int l = 8 * rb + i;
                if (part < 2) { const float sc = inorm[part * 64 + l]; float v[8];
#pragma unroll
                    for (int ch = 0; ch < 8; ++ch) v[ch] = o[i][ch] * sc;
                    *(LAS u32x4*)((part ? kb : qb) + l * SB + 8 * cgl) = pack8(v); }
                else { const float bl = beta[l]; *(LAS f32x4*)(X + l * GX + 8 * cgl) = (f32x4){o[i][0] * bl, o[i][1] * bl, o[i][2] * bl, o[i][3] * bl}; *(LAS f32x4*)(X + l * GX + 8 * cgl + 4) = (f32x4){o[i][4] * bl, o[i][5] * bl, o[i][6] * bl, o[i][7] * bl}; } } }
        __syncthreads();
        for (int tt = 0; tt < 4; ++tt) { const int tile = w * 4 + tt, which = tile >> 4, ti = (tile >> 2) & 3, tj = tile & 3;
            f32x4 acc = (f32x4){0.f, 0.f, 0.f, 0.f};
            if (tj <= ti) acc = tile_bf((which ? qb : kb) + 16 * ti * SB, SB, kb + 16 * tj * SB, SB, 128, acc, l15, q4);
#pragma unroll
            for (int r = 0; r < 4; ++r) { const int i = 16 * ti + 4 * q4 + r, j = 16 * tj + l15; float v = 0.f;
                if (which ? (j <= i) : (j < i)) v = acc[r] * expf(gc[i] - gc[j]) * (which ? 1.0f : beta[i]);
                if (which) qkimg[i * RS + j] = (bf16)f2bf(v); else Lm[i * GS2 + j] = v; } }
        { const float glast = gc[63];
          for (int e = tid; e < 64 * 16; e += 512) { const int l = e >> 4, d0 = 8 * (e & 15); const u32x4 kv = *(const LAS u32x4*)(kb + l * SB + d0), qv = *(const LAS u32x4*)(qb + l * SB + d0);
              const float kf[8] = {bf2f(kv.x & 0xffffu), bf2f(kv.x >> 16), bf2f(kv.y & 0xffffu), bf2f(kv.y >> 16), bf2f(kv.z & 0xffffu), bf2f(kv.z >> 16), bf2f(kv.w & 0xffffu), bf2f(kv.w >> 16)};
              float qf[8] = {bf2f(qv.x & 0xffffu), bf2f(qv.x >> 16), bf2f(qv.y & 0xffffu), bf2f(qv.y >> 16), bf2f(qv.z & 0xffffu), bf2f(qv.z >> 16), bf2f(qv.w & 0xffffu), bf2f(qv.w >> 16)};
              const float sc = beta[l] * egc[l], eg = egc[l];
              *(LAS f32x4*)(X + l * GX + 128 + d0) = (f32x4){kf[0] * sc, kf[1] * sc, kf[2] * sc, kf[3] * sc}; *(LAS f32x4*)(X + l * GX + 132 + d0) = (f32x4){kf[4] * sc, kf[5] * sc, kf[6] * sc, kf[7] * sc};
#pragma unroll
              for (int q = 0; q < 8; ++q) qf[q] *= eg;
              *(u32x4*)(rec + GR_QH + (size_t)(l * SB + d0) * 2) = pack8(qf); }
          for (int e = tid; e < 128 * 8; e += 512) { const int d = e >> 3, l0 = 8 * (e & 7); float kt[8];
#pragma unroll
              for (int q = 0; q < 8; ++q) kt[q] = bf2f(kb[(l0 + q) * SB + d]) * expf(glast - gc[l0 + q]);
              *(u32x4*)(rec + GR_KT + (size_t)(d * RS + l0) * 2) = pack8(kt); }
          if (tid == 0) *(float*)(rec + GR_GL) = expf(glast); }
        __syncthreads();
        for (int e = tid; e < 64 * RS / 8; e += 512) ((u32x4*)(rec + GR_QK))[e] = ((const LAS u32x4*)qkimg)[e];
        for (int rbk = 0; rbk < 4; ++rbk) {
            if (rbk > 0) {
#pragma unroll
                for (int t2 = 0; t2 < 2; ++t2) { const int tj = 2 * w + t2;
                    const f32x4 acc = tile_mm(Lm + 16 * rbk * GS2, GS2, 1, X + 16 * tj, GX, 1, 16 * rbk, (f32x4){0.f, 0.f, 0.f, 0.f}, l15, q4);
#pragma unroll
                    for (int r = 0; r < 4; ++r) X[(16 * rbk + 4 * q4 + r) * GX + 16 * tj + l15] -= acc[r]; }
                __syncthreads();
            }
            if (tid < 256) diag_solve16(Lm + 16 * rbk * GS2 + 16 * rbk, GS2, X + 16 * rbk * GX + tid, GX);
            __syncthreads();
        }
        for (int e = tid; e < 64 * 16; e += 512) { const int l = e >> 4, d0 = 8 * (e & 15); const f32x4 a = *(const LAS f32x4*)(X + l * GX + 128 + d0), b2 = *(const LAS f32x4*)(X + l * GX + 132 + d0);
            const float v[8] = {a.x, a.y, a.z, a.w, b2.x, b2.y, b2.z, b2.w}; *(u32x4*)(rec + GR_W + (size_t)(l * SB + d0) * 2) = pack8(v); }
        for (int e = tid; e < 128 * 8; e += 512) { const int vv = e >> 3, t0 = 8 * (e & 7); float v[8];
#pragma unroll
            for (int q = 0; q < 8; ++q) v[q] = X[(t0 + q) * GX + vv];
            *(u32x4*)((bf16*)(rec + GR_COMMON) + vv * 64 + t0) = pack8(v); }
    }
    __syncthreads();
}
constexpr int G2_STAGE = GR_COMMON;
__device__ __forceinline__ void phase_gdn_g2(const Frame& F, const Args& A) {
    const unsigned char* CHR = WSP(unsigned char, G_CH); float* GO = WSP(float, G_O);
    LAS unsigned char* buf0 = F.lds; LAS bf16* STt = (LAS bf16*)(F.lds + 2 * G2_STAGE); LAS bf16* vnT = STt + 2 * 32 * SB;
    const int tid = F.tid, lane = F.lane, w = F.wave, l15 = lane & 15, q4 = lane >> 4, ti = w >> 1, tj = w & 1;
    const int nunits = BH * 4 * 4;
    constexpr int NCK = G2_STAGE / 16;
    for (int unit = F.bid; unit < nunits; unit += F.G) {
        const int vs = unit & 3, h = (unit >> 2) & 3, b = unit >> 4;
        __syncthreads();
        for (int e = tid; e < 2 * 32 * SB / 2; e += 512) ((LAS unsigned*)STt)[e] = 0u;
        f32x4 Sreg[2] = {(f32x4){0.f, 0.f, 0.f, 0.f}, (f32x4){0.f, 0.f, 0.f, 0.f}};
        u32x4 preA[8], preB[8]; u32x2 uiniA, uiniB, ucur;
        const unsigned char* rec0 = CHR + (size_t)((b * 4 + h) * NCH) * GR_BYTES;
        const int uofs = GR_COMMON + ((32 * vs + 16 * tj + l15) * 64 + 16 * ti + 4 * q4) * 2;
#define G2_LOAD(S, recp) do { _Pragma("unroll") for (int q = 0; q < 8; ++q) { const int e = tid + 512 * q; if (e < NCK) pre##S[q] = *(const u32x4*)((recp) + (size_t)e * 16); } uini##S = *(const u32x2*)((recp) + uofs); } while (0)
#define G2_STORE(S, dst) do { _Pragma("unroll") for (int q = 0; q < 8; ++q) { const int e = tid + 512 * q; if (e < NCK) *(LAS u32x4*)((dst) + (size_t)e * 16) = pre##S[q]; } } while (0)
        G2_LOAD(A, rec0); G2_STORE(A, buf0); ucur = uiniA;
        if (NCH > 1) G2_LOAD(A, rec0 + (size_t)GR_BYTES);
        __syncthreads();
#define G2_STEP(c, LS, SS) do { \
            LAS unsigned char* buf = buf0 + ((c) & 1) * G2_STAGE; LAS unsigned char* nbuf = buf0 + (((c) + 1) & 1) * G2_STAGE; \
            if ((c) + 2 < NCH) G2_LOAD(LS, rec0 + (size_t)((c) + 2) * GR_BYTES); \
            const LAS bf16* Wi = (const LAS bf16*)(buf + GR_W); const LAS bf16* QH = (const LAS bf16*)(buf + GR_QH); const LAS bf16* KT = (const LAS bf16*)(buf + GR_KT); const LAS bf16* QK = (const LAS bf16*)(buf + GR_QK); \
            const float egl = *(const LAS float*)(buf + GR_GL); \
            const LAS bf16* S0 = STt + ((c) & 1) * 32 * SB; LAS bf16* S1 = STt + (((c) + 1) & 1) * 32 * SB; \
            { const f32x4 acc = tile_bf(Wi + 16 * ti * SB, SB, S0 + 16 * tj * SB, SB, 128, (f32x4){0.f, 0.f, 0.f, 0.f}, l15, q4); \
              const f32x4 vn = (f32x4){bf2f(ucur.x & 0xffffu), bf2f(ucur.x >> 16), bf2f(ucur.y & 0xffffu), bf2f(ucur.y >> 16)} - acc; \
              u32x2 pk; pk.x = pk2(vn[0], vn[1]); pk.y = pk2(vn[2], vn[3]); *(LAS u32x2*)(vnT + (16 * tj + l15) * RS + 16 * ti + 4 * q4) = pk; } \
            __syncthreads(); \
            { f32x4 acc = tile_bf(QH + 16 * ti * SB, SB, S0 + 16 * tj * SB, SB, 128, (f32x4){0.f, 0.f, 0.f, 0.f}, l15, q4); \
              acc = tile_bf(QK + 16 * ti * RS, RS, vnT + 16 * tj * RS, RS, 64, acc, l15, q4); \
              _Pragma("unroll") for (int r = 0; r < 4; ++r) GO[((size_t)b * SEQ + (size_t)(c) * 64 + 16 * ti + 4 * q4 + r) * 512 + h * 128 + 32 * vs + 16 * tj + l15] = acc[r]; } \
            _Pragma("unroll") for (int t2 = 0; t2 < 2; ++t2) { Sreg[t2] = Sreg[t2] * egl; \
                Sreg[t2] = tile_bf(KT + 16 * w * RS, RS, vnT + 16 * t2 * RS, RS, 64, Sreg[t2], l15, q4); \
                u32x2 pk; pk.x = pk2(Sreg[t2][0], Sreg[t2][1]); pk.y = pk2(Sreg[t2][2], Sreg[t2][3]); *(LAS u32x2*)(S1 + (16 * t2 + l15) * SB + 16 * w + 4 * q4) = pk; } \
            if ((c) + 1 < NCH) { G2_STORE(SS, nbuf); ucur = uini##SS; } \
            __syncthreads(); } while (0)
        for (int c = 0; c < NCH; c += 2) { G2_STEP(c, B, A); G2_STEP(c + 1, A, B); }
#undef G2_STEP
#undef G2_STORE
#undef G2_LOAD
    }
    __syncthreads();
}
__device__ __forceinline__ void phase_gdn_g3(const Frame& F, const Args& A, int layer) {
    const float* GO = WSP(float, G_O); const bf16* P = WSP(bf16, A_P); bf16* Y = WSP(bf16, A_Y) + (size_t)2 * TH * 512; const float* nw = AIN(A, 22) + layer * 128;
    const int lane = F.lane, c0 = 8 * lane;
    for (int m = F.gw; m < TH; m += F.NGW) {
        const f32x4 a = *(const f32x4*)(GO + (size_t)m * 512 + c0), b2 = *(const f32x4*)(GO + (size_t)m * 512 + c0 + 4);
        float o[8] = {a.x, a.y, a.z, a.w, b2.x, b2.y, b2.z, b2.w}; float ss = 0.f;
#pragma unroll
        for (int q = 0; q < 8; ++q) ss += o[q] * o[q];
        ss += __shfl_xor(ss, 1); ss += __shfl_xor(ss, 2); ss += __shfl_xor(ss, 4); ss += __shfl_xor(ss, 8);
        const float rstd = RSQRT(ss * (1.0f / 128.0f) + EPS);
        const f32x4 z0 = ld_bf16x4(P + (size_t)m * PW + C_GDN + 1544 + c0), z1 = ld_bf16x4(P + (size_t)m * PW + C_GDN + 1544 + c0 + 4);
        const float z[8] = {z0.x, z0.y, z0.z, z0.w, z1.x, z1.y, z1.z, z1.w}; float y[8];
#pragma unroll
        for (int q = 0; q < 8; ++q) y[q] = o[q] * rstd * nw[(c0 + q) & 127] * siluf_(z[q]);
        u32x4 wv; wv.x = pk2(y[0], y[1]); wv.y = pk2(y[2], y[3]); wv.z = pk2(y[4], y[5]); wv.w = pk2(y[6], y[7]);
        *(u32x4*)(Y + (size_t)m * 512 + c0) = wv;
    }
}

__device__ __forceinline__ void phase_merge_z(const Frame& F, const Args& A) {
    pg8::Gemm g{WSP(bf16, A_Y), WSP(bf16, W_BR), 512, 512}; BranchOrder S; S.nP = TH / 256; S.G = F.G; S.c = F.bid;
    EpiZ E{WSP(bf16, A_Z)}; pg8::gemm_phase(F.lds, g, S, E, F.tid);
}
__device__ __forceinline__ void phase_merge_gate(const Frame& F, const Args& A, int layer) {
    pg8::Gemm g{WSP(bf16, A_H), WSP(bf16, W_GATE), D, D}; pg8::StaticOrder S; S.init(TH, 4096, F.G, F.bid);
    EpiMerge E{WSP(bf16, A_Z), AIN(A, 29) + (size_t)layer * 4 * D, WSP(bf16, A_MG)}; pg8::gemm_phase(F.lds, g, S, E, F.tid);
#if 1
    if (((REPEAT_MASK) >> 28) & 1u) { __syncthreads(); EpiBf16 E2{WSP(bf16, A_MIX + (size_t)64 * MiB), 4096, nullptr, 0}; pg8::gemm_phase(F.lds, g, S, E2, F.tid); }
#endif
}
__device__ __forceinline__ void phase_merge_out(const Frame& F, const Args& A, const float* xin, float* xout) {
    pg8::Gemm g{WSP(bf16, A_MG), WSP(bf16, W_OUT), D, D}; pg8::StaticOrder S; S.init(TH, D, F.G, F.bid);
    EpiResidual E{xin, xout}; pg8::gemm_phase(F.lds, g, S, E, F.tid);
}
__device__ __forceinline__ void phase_ffn_gu(const Frame& F, const Args& A) {
    pg8::Gemm g{WSP(bf16, A_H), WSP(bf16, W_FGU), D, D}; pg8::StaticOrder S; S.init(TH, 2 * FF_D, F.G, F.bid);
    EpiSwiGLU E{WSP(bf16, F_ACT), FF_D, 1 << 20}; pg8::gemm_phase(F.lds, g, S, E, F.tid);
}
__device__ __forceinline__ void phase_ffn_down(const Frame& F, const Args& A, float* x) {
    pg8::Gemm g{WSP(bf16, F_ACT), WSP(bf16, W_FDN), FF_D, FF_D}; pg8::StaticOrder S; S.init(TH, D, F.G, F.bid);
    EpiResidual E{x, x}; pg8::gemm_phase(F.lds, g, S, E, F.tid);
}
struct MoeLayout { int pstart[NEXP + 1]; };
__device__ __forceinline__ MoeLayout moe_layout(const unsigned* cnt) {
    MoeLayout L; int s = 0;
#pragma unroll
    for (int e = 0; e < NEXP; ++e) { L.pstart[e] = s; s += ((int)cnt[e] + 255) & ~255; }
    L.pstart[NEXP] = s; return L;
}
struct MoeOrder {
    int np, nN, G, c; MoeLayout L;
    __device__ bool next(int i, Unit& u) const {
        const long Lx = (long)i * G + c; if (Lx >= (long)np * nN) return false;
        const int pm = (int)(Lx / nN), pn = (int)(Lx % nN); int e = 0;
#pragma unroll
        for (int k = 1; k < NEXP; ++k) if (pm * 256 >= L.pstart[k]) e = k;
        u.pm = pm; u.pn = e * nN + pn; return true;
    }
    __device__ __forceinline__ void a_ready(const Unit&) const {}
    __device__ __forceinline__ void done(const Unit&) const {}
};
__device__ __forceinline__ void phase_moe_route(const Frame& F, const Args& A, int half) {
    const unsigned* wgc = (const unsigned*)(F.ctl + CW_WGC + half * 8192); unsigned* cnt = (unsigned*)(F.ctl + CW_CNT + half * 16);
    LAS unsigned* tab = (LAS unsigned*)F.lds; LAS unsigned* tot = tab + 8192; LAS unsigned* bef = tot + 8; LAS unsigned* cur = bef + 8;
    __syncthreads();
    for (int e = F.tid; e < F.G * 8; e += 512) tab[e] = wgc[e];
    __syncthreads();
    if (F.tid < 8) { unsigned t = 0, bsum = 0; for (int g = 0; g < F.G; ++g) { const unsigned v = tab[g * 8 + F.tid]; if (g < F.bid) bsum += v; t += v; } tot[F.tid] = t; bef[F.tid] = bsum; cur[F.tid] = 0u; if (F.bid == 0) cnt[F.tid] = t; }
    __syncthreads();
    unsigned totr[8];
#pragma unroll
    for (int e = 0; e < 8; ++e) totr[e] = tot[e];
    const MoeLayout L = moe_layout(totr);
    const bf16* H = WSP(bf16, A_H); bf16* GA = WSP(bf16, F_GA); const int* tope = WSP(int, F_TOPE); int* slot = WSP(int, F_SLOT);
    const int lane = F.lane;
    for (int m = F.gw; m < TH; m += F.NGW) {
        const u32x4 v0 = *(const u32x4*)(H + (size_t)m * D + 8 * lane), v1 = *(const u32x4*)(H + (size_t)m * D + 512 + 8 * lane);
#pragma unroll
        for (int k = 0; k < 2; ++k) { const int e = tope[2 * m + k]; int s = 0;
            int ps = 0;
#pragma unroll
            for (int q = 0; q < NEXP; ++q) ps = (e == q) ? L.pstart[q] : ps;
            if (lane == 0) s = ps + (int)bef[e] + (int)ATOMIC_ADD_LDS(cur + e, 1u);
            s = __shfl(s, 0);
            if (lane == 0) slot[2 * m + k] = s;
            *(u32x4*)(GA + (size_t)s * D + 8 * lane) = v0; *(u32x4*)(GA + (size_t)s * D + 512 + 8 * lane) = v1; }
    }
#pragma unroll
    for (int e = 0; e < NEXP; ++e) { const int r0 = L.pstart[e] + (int)totr[e], r1 = L.pstart[e + 1];
        for (int r = r0 + F.gw; r < r1; r += F.NGW) { *(u32x4*)(GA + (size_t)r * D + 8 * lane) = (u32x4){0u, 0u, 0u, 0u}; *(u32x4*)(GA + (size_t)r * D + 512 + 8 * lane) = (u32x4){0u, 0u, 0u, 0u}; } }
    __syncthreads();
}
__device__ __forceinline__ void phase_moe_gu(const Frame& F, const Args& A, int half) {
    MoeOrder S; S.L = moe_layout((const unsigned*)(F.ctl + CW_CNT + half * 16)); S.np = S.L.pstart[NEXP] / 256; S.nN = 2 * FF_E / 256; S.G = F.G; S.c = F.bid;
    pg8::Gemm g{WSP(bf16, F_GA), WSP(bf16, W_FGU), D, D}; EpiSwiGLU E{WSP(bf16, F_ACT), FF_E, 2 * FF_E / 256}; pg8::gemm_phase(F.lds, g, S, E, F.tid);
}
struct EpiF32Mod {
    static constexpr bool PERM = false, AFTER_DRAIN = false;
    float* C;
    __device__ __forceinline__ void operator()(const f32x4 (&acc)[2][2][4][2], const Unit& u, int wr, int wc, int fr, int fq) const {
        const int row0 = u.pm * 256 + wr * 64 + fr, col0 = (u.pn & 3) * 256 + wc * 32 + 4 * fq;
#pragma unroll
        for (int ai = 0; ai < 2; ++ai)
#pragma unroll
            for (int m = 0; m < 4; ++m) { float* rowp = C + (size_t)(row0 + ai * HALFT + m * 16) * D + col0;
#pragma unroll
                for (int bj = 0; bj < 2; ++bj)
#pragma unroll
                    for (int n = 0; n < 2; ++n) *(f32x4*)(rowp + bj * HALFT + n * 16) = acc[ai][bj][m][n]; }
    }
};
__device__ __forceinline__ void phase_moe_down(const Frame& F, const Args& A, int half) {
    MoeOrder S; S.L = moe_layout((const unsigned*)(F.ctl + CW_CNT + half * 16)); S.np = S.L.pstart[NEXP] / 256; S.nN = D / 256; S.G = F.G; S.c = F.bid;
    pg8::Gemm g{WSP(bf16, F_ACT), WSP(bf16, W_FDN), FF_E, FF_E}; EpiF32Mod E{WSP(float, F_YE)}; pg8::gemm_phase(F.lds, g, S, E, F.tid);
}
__device__ __forceinline__ void phase_moe_combine(const Frame& F, const Args& A, float* x, const float* fgain) {
    const float* YE = WSP(float, F_YE); const int* slot = WSP(int, F_SLOT); const float* topw = WSP(float, F_TOPW); const int lane = F.lane;
    for (int m = F.gw; m < TH; m += F.NGW) { const int s0 = slot[2 * m], s1 = slot[2 * m + 1]; const float w0 = topw[2 * m], w1 = topw[2 * m + 1];
        f32x4 v[4]; float ss = 0.f;
#pragma unroll
        for (int j = 0; j < 4; ++j) { const int c = 4 * lane + 256 * j;
            v[j] = *(const f32x4*)(x + (size_t)m * D + c) + *(const f32x4*)(YE + (size_t)s0 * D + c) * w0 + *(const f32x4*)(YE + (size_t)s1 * D + c) * w1;
            ss += (v[j].x * v[j].x + v[j].y * v[j].y) + (v[j].z * v[j].z + v[j].w * v[j].w); }
        if (fgain) { const float rstd = RSQRT(wave_sum(ss) * (1.0f / D) + EPS);
#pragma unroll
            for (int j = 0; j < 4; ++j) v[j] = v[j] * rstd * *(const f32x4*)(fgain + 4 * lane + 256 * j); }
#pragma unroll
        for (int j = 0; j < 4; ++j) *(f32x4*)(x + (size_t)m * D + 4 * lane + 256 * j) = v[j]; }
}

#ifndef EMU
#define XB_TMO      128
#define XB_XCNT(j)  (256  + 64 * (j))
#define XB_XSUB(j)  (1280 + 64 * (j))
#define XB_XGEN(j)  (2304 + 64 * (j))
#define XB_TOP      3328
#define XB_TOPGEN   3392
#define XCD_BAR_WORDS 3456
#define XB_SPIN_CAP (1u << 22)
__device__ __forceinline__ unsigned xb_ld(unsigned* p)              { return __hip_atomic_load(p, __ATOMIC_RELAXED, __HIP_MEMORY_SCOPE_AGENT); }
__device__ __forceinline__ unsigned xb_add(unsigned* p, unsigned v) { return __hip_atomic_fetch_add(p, v, __ATOMIC_RELAXED, __HIP_MEMORY_SCOPE_AGENT); }
__device__ __forceinline__ unsigned xb_xcc_id() { return (unsigned)__builtin_amdgcn_s_getreg((3 << 11) | 20) & 0xFu; }
#define XB_SPIN(cond, bar) do { unsigned _sp = 0; while (cond) { __builtin_amdgcn_s_sleep(1); \
    if ((++_sp & 255u) == 0u) { if (xb_ld(&(bar)[XB_TMO])) break; if (_sp > XB_SPIN_CAP) { atomicAdd(&(bar)[XB_TMO], 1u); break; } } } } while (0)
struct XcdBarrier { unsigned* bar; unsigned x; volatile LAS unsigned* st; };
__device__ __forceinline__ XcdBarrier xcd_barrier_post(unsigned* bar, volatile LAS unsigned* st) {
    XcdBarrier b; b.bar = bar; b.x = xb_xcc_id(); b.st = st;
    if (threadIdx.x == 0) (void)xb_add(&bar[XB_XCNT(b.x)], 1u);
    return b;
}
__device__ __forceinline__ void xcd_barrier_complete(unsigned* bar, unsigned x, unsigned& nloc, unsigned& nx) {
    const unsigned G = gridDim.x * gridDim.y * gridDim.z;
    unsigned sum, cnt, mine, sp = 0u;
    for (;;) {
        sum = 0u; cnt = 0u; mine = 0u;
#pragma unroll
        for (unsigned j = 0; j < 16; ++j) { const unsigned c = xb_ld(&bar[XB_XCNT(j)]); sum += c; cnt += (c > 0u) ? 1u : 0u; mine = (j == x) ? c : mine; }
        if (sum == G) break;
        __builtin_amdgcn_s_sleep(1);
        if ((++sp & 255u) == 0u) { if (xb_ld(&bar[XB_TMO])) break; if (sp > XB_SPIN_CAP) { atomicAdd(&bar[XB_TMO], 1u); break; } }
    }
    nloc = mine > 0u ? mine : 1u; nx = cnt > 0u ? cnt : 1u;
}
__device__ __forceinline__ void xcd_barrier(const XcdBarrier& b) {
    asm volatile("s_waitcnt vmcnt(0)" ::: "memory");
    __syncthreads();
    if (threadIdx.x == 0) {
        unsigned* bar = b.bar;
        __builtin_amdgcn_s_waitcnt(0);
        unsigned nloc = b.st[0], nx = b.st[1];
        if (nloc == 0u) { xcd_barrier_complete(bar, b.x, nloc, nx); b.st[0] = nloc; b.st[1] = nx; }
        const unsigned old = xb_add(&bar[XB_XSUB(b.x)], 1u);
        const unsigned gen = old / nloc;
        if (old + 1u == (gen + 1u) * nloc) {
            __builtin_amdgcn_fence(__ATOMIC_RELEASE, "agent");
            asm volatile("s_waitcnt vmcnt(0)" ::: "memory");
            const unsigned og = xb_add(&bar[XB_TOP], 1u);
            const unsigned tg = og / nx;
            if (og + 1u == (tg + 1u) * nx) xb_add(&bar[XB_TOPGEN], 1u);
            else XB_SPIN(xb_ld(&bar[XB_TOPGEN]) == tg, bar);
            __builtin_amdgcn_fence(__ATOMIC_ACQUIRE, "agent");
            xb_add(&bar[XB_XGEN(b.x)], 1u);
            asm volatile("s_waitcnt vmcnt(0)" ::: "memory");
        } else {
            XB_SPIN(xb_ld(&bar[XB_XGEN(b.x)]) == gen, bar);
            __builtin_amdgcn_fence(__ATOMIC_ACQUIRE, "agent");
            asm volatile("s_waitcnt vmcnt(0)" ::: "memory");
        }
    }
    __syncthreads();
}
#endif

constexpr int NPH = 17;
constexpr int NPHASES = DEPTH * (1 + NHALF * NPH);
constexpr int LDS_BYTES = 155648, MISC_OFF = 154624;

__global__ void __launch_bounds__(512, 2) fwd_kernel(Args args_k) {
#ifdef EMU
    unsigned char* lds = emu_lds_ptr;
#else
    extern __shared__ __attribute__((aligned(16))) unsigned char lds[];
#endif
    Frame F0;
    F0.lds = (LAS unsigned char*)lds; F0.tid = threadIdx.x; F0.lane = F0.tid & 63; F0.wave = RFL(F0.tid >> 6); F0.G = gridDim.x; F0.bid = blockIdx.x;
    F0.gw = F0.bid * 8 + F0.wave; F0.NGW = F0.G * 8;
    F0.out = (GAS float*)args_k.out; F0.ws = (GAS unsigned char*)args_k.ws; F0.ctl = (GAS unsigned*)(F0.ws + WS_CTL);
    const int lo = args_k.lo, hi = args_k.hi;
#ifndef EMU
    volatile LAS unsigned* misc = (volatile LAS unsigned*)(F0.lds + MISC_OFF);
    if (F0.tid < 4) misc[F0.tid] = 0u;
    __syncthreads();
    XcdBarrier bar; bar.bar = (unsigned*)(F0.ctl + CW_BAR); bar.x = 0; bar.st = misc;
    if (hi - lo > 1) bar = xcd_barrier_post((unsigned*)(F0.ctl + CW_BAR), misc);
#define GRID_BAR() do { XcdBarrier bq = bar; asm volatile("" : "+s"(bq.bar), "+s"(bq.x)); xcd_barrier(bq); } while (0)
#else
#define GRID_BAR() do { } while (0)
#endif
    int ph = 0;
#ifndef PH_MASK
#define PH_MASK 0xFFFFFFFFFFFFFFFFull
#endif
#define PHASE(...) PHASE_I(31, __VA_ARGS__)
#ifdef EMU
#define LAUNDER(Fq) do { } while (0)
#else
#define LAUNDER(Fq) do { unsigned mq_ = ~0u; asm volatile("" : "+s"(Fq.G), "+s"(Fq.bid), "+s"(Fq.wave), "+s"(Fq.ws), "+s"(Fq.out), "+s"(Fq.ctl), "+s"(mq_)); Fq.lane = (int)__builtin_amdgcn_mbcnt_hi(mq_, __builtin_amdgcn_mbcnt_lo(mq_, 0u)); Fq.tid = Fq.wave * 64 + Fq.lane; Fq.gw = Fq.bid * 8 + Fq.wave; Fq.NGW = Fq.G * 8; } while (0)
#endif
#ifdef EMU
#define ARGS_Q() const Args& args_q = args_k
#else
#define ARGS_Q() const __attribute__((address_space(4))) Args* aq_ = (const __attribute__((address_space(4))) Args*)__builtin_amdgcn_kernarg_segment_ptr(); asm volatile("" : "+s"(aq_)); const Args& args_q = *(const Args*)aq_
#endif
#define PHASE_I(kind, ...) do { if (ph >= lo && ph < hi) { constexpr int reps_ = (((REPEAT_MASK) >> (kind)) & 1u) ? 2 : 1; for (int rr_ = 0; rr_ < reps_; ++rr_) { { Frame Fq = F0; LAUNDER(Fq); const Frame& F = Fq; ARGS_Q(); const Args& args = args_q; __VA_ARGS__; } if (rr_ + 1 < reps_ || ph + 1 < hi) { GRID_BAR(); if (((REPEAT_MASK) >> 26) & 1u) GRID_BAR(); } } } ++ph; } while (0)
#define PHASEK(kind, ...) PHASE_I(kind, __VA_ARGS__)
#define SEGMENT(layer, half) do { \
            const size_t r0 = (size_t)(half) * TH; \
            const float* xin = ((layer) == 0 ? AIN(args_k, 0) : (const float*)F0.out) + r0 * D; float* xo = (float*)F0.out + r0 * D; \
            PHASEK(0, phase_norm<false>(F, args, xin, AIN(args, 2) + (layer) * D, WSP(bf16, A_H), nullptr, nullptr, nullptr, nullptr); phase_rope_table(F, args, (const int*)AIN(args, 1) + r0, WSP(float, A_ROPE))); \
            PHASEK(1, { pg8::Gemm g{WSP(bf16, A_H), WSP(bf16, W_IN), D, D}; pg8::StaticOrder S; S.init(TH, PW, F.G, F.bid); EpiBf16 E{WSP(bf16, A_P), PW, nullptr, 0}; pg8::gemm_phase(F.lds, g, S, E, F.tid); }); \
            PHASEK(2, phase_mla_prep(F, args); phase_rwkv_prep(F, args, layer)); \
            PHASEK(3, phase_mla_q(F, args); __syncthreads(); phase_mla_kv(F, args); __syncthreads(); phase_rwkv_lora(F, args)); \
            PHASEK(8, phase_rwkv_r1(F, args, layer)); \
            PHASEK(5, { const int ns_ = F.G >= 128 ? 64 : (F.G >= 4 ? F.G / 4 : 0); Frame Fa = F;       \
                        if (F.bid < ns_) { Fa.G = ns_; Fa.NGW = ns_ * 8; phase_rwkv_r2(Fa, args); } else { Fa.bid = F.bid - ns_; Fa.G = F.G - ns_; Fa.gw = Fa.bid * 8 + Fa.wave; Fa.NGW = Fa.G * 8; phase_attention(Fa, args); if (ns_ == 0) phase_rwkv_r2(F, args); } }); \
            PHASEK(9, phase_rwkv_post(F, args, layer); phase_gdn_g1(F, args, layer); phase_ssd_s1(F, args, layer)); \
            PHASEK(11, { const int ns_ = F.G >= 4 ? F.G / 2 : 0; Frame Fa = F;                               \
                        if (F.bid < ns_) { Fa.G = ns_; Fa.NGW = ns_ * 8; phase_gdn_g2(Fa, args); } else { Fa.bid = F.bid - ns_; Fa.G = F.G - ns_; Fa.gw = Fa.bid * 8 + Fa.wave; Fa.NGW = Fa.G * 8; phase_ssd_s23(Fa, args); if (ns_ == 0) phase_gdn_g2(F, args); } }); \
            PHASEK(12, phase_gdn_g3(F, args, layer); phase_ssd_s4(F, args, layer)); \
            PHASEK(17, phase_merge_z(F, args)); \
            PHASEK(18, phase_merge_gate(F, args, layer)); \
            PHASEK(19, phase_merge_out(F, args, xin, xo)); \
            if ((layer) == 0) { \
                PHASEK(20, phase_norm<false>(F, args, xo, AIN(args, 32) + (layer) * D, WSP(bf16, A_H), nullptr, nullptr, nullptr, nullptr)); \
                PHASEK(21, phase_ffn_gu(F, args)); \
                PHASE(phase_ffn_down(F, args, xo)); \
                PHASE((void)0); \
                PHASE((void)0); \
            } else { \
                PHASE(phase_norm<true>(F, args, xo, AIN(args, 32) + (layer) * D, WSP(bf16, A_H), AIN(args, 35), WSP(int, F_TOPE), WSP(float, F_TOPW), (unsigned*)(F.ctl + CW_WGC + (half) * 8192))); \
                PHASE(phase_moe_route(F, args, half)); \
                PHASEK(22, phase_moe_gu(F, args, half)); \
                PHASEK(23, phase_moe_down(F, args, half)); \
                PHASE(phase_moe_combine(F, args, xo, (layer) == DEPTH - 1 ? AIN(args, 38) : nullptr)); \
            } } while (0)
    static_assert(DEPTH == 2 && NHALF <= 2, "segment program");
    PHASEK(27, phase_convert(F, args, 0));
    SEGMENT(0, 0);
    if (NHALF == 2) SEGMENT(0, 1);
    PHASEK(27, phase_convert(F, args, 1));
    SEGMENT(1, 0);
    if (NHALF == 2) SEGMENT(1, 1);
#undef SEGMENT
#undef PHASE
}

#ifndef ONE_LAUNCH
#define ONE_LAUNCH 1
#endif
extern "C" void kernel_launch(void* const* d_in, const int* in_sizes, int n_in, void* d_out, int out_size, void* d_ws, size_t ws_size, hipStream_t stream) {
    static int grid = 0;
    if (grid == 0) {
#ifdef EMU
        grid = EMU_GRID;
#else
        if (n_in != 39 || out_size != T * D || ws_size < WS_NEED) { fprintf(stderr, "kernel_launch: unexpected problem (n_in %d out %d ws %zu need %zu)\n", n_in, out_size, ws_size, (size_t)WS_NEED); grid = -1; return; }
        int dev = 0, cus = 0;
        if (hipGetDevice(&dev) != hipSuccess || hipDeviceGetAttribute(&cus, hipDeviceAttributeMultiprocessorCount, dev) != hipSuccess) { grid = -1; return; }
        if (hipFuncSetAttribute((const void*)fwd_kernel, hipFuncAttributeMaxDynamicSharedMemorySize, LDS_BYTES) != hipSuccess) { fprintf(stderr, "kernel_launch: hipFuncSetAttribute failed\n"); grid = -1; return; }
        int per_cu = 0;
        if (hipOccupancyMaxActiveBlocksPerMultiprocessor(&per_cu, (const void*)fwd_kernel, 512, LDS_BYTES) != hipSuccess || per_cu < 1) fprintf(stderr, "kernel_launch: occupancy query reports %d\n", per_cu);
        (void)hipGetLastError();
        grid = cus;
#endif
    }
    if (grid < 0) return;
    (void)hipMemsetAsync((char*)d_ws + WS_CTL, 0, CTL_BYTES, stream);
    Args a{};
    for (int i = 0; i < 39; ++i) a.in[i] = (const float*)d_in[i];
    a.out = (float*)d_out; a.ws = (unsigned char*)d_ws;
#ifdef EMU
    for (int p = EMU_PH_LO; p < EMU_PH_HI && p < NPHASES; ++p) { a.lo = p; a.hi = p + 1; emu_launch(fwd_kernel, grid, 512, a); emu_after_phase(p); }
#else
#if ONE_LAUNCH
    a.lo = 0; a.hi = NPHASES;
    hipLaunchKernelGGL(fwd_kernel, dim3(grid), dim3(512), LDS_BYTES, stream, a);
#else
    for (int p = 0; p < NPHASES; ++p) { a.lo = p; a.hi = p + 1; hipLaunchKernelGGL(fwd_kernel, dim3(grid), dim3(512), LDS_BYTES, stream, a); }
#endif
#endif
}
```

```cpp
#ifndef EMU
#include <hip/hip_runtime.h>
#include <cstdio>
#include <cstdint>
#endif

#ifndef REPEAT_MASK
#define REPEAT_MASK 0u
#endif
#ifdef EMU
constexpr int BATCH = EMU_B, SEQ = EMU_S, NHALF = EMU_NHALF;
#else
constexpr int BATCH = 16, SEQ = 2048, NHALF = 2;
#endif
constexpr int D = 1024, DEPTH = 2, CH = 64;
constexpr int T = BATCH * SEQ, TH = T / NHALF, BH = BATCH / NHALF, NCH = SEQ / CH;
constexpr int C_MLA = 0, C_RWKV = 704, C_GDN = 2528, C_SSD = 4584, C_GATE = 6128, IN_COLS = 10224, PW = 6144;
constexpr int FF_D = 2816, FF_E = 3584, NEXP = 8;
constexpr int MOE_ROWS = ((TH * 2 + NEXP * 255) / 256) * 256;
constexpr float EPS = 1e-6f;
static_assert(TH % 256 == 0 && SEQ % 128 == 0 && BATCH % NHALF == 0 && (SEQ / 64) % 2 == 0, "shape");

typedef unsigned short bf16;
typedef float f32x4 __attribute__((ext_vector_type(4)));
typedef float f32x2 __attribute__((ext_vector_type(2)));
typedef short bf16x8 __attribute__((ext_vector_type(8)));
typedef short bf16x4 __attribute__((ext_vector_type(4)));
typedef unsigned u32x4 __attribute__((ext_vector_type(4)));
typedef unsigned u32x2 __attribute__((ext_vector_type(2)));
#ifdef EMU
#define LAS
#define GAS
#define MFMA_F32(a, b, c) emu_mfma_16x16x4f32(a, b, c)
#define MFMA_BF16(a, b, c) emu_mfma_16x16x32bf16(a, b, c)
#define ATOMIC_ADD_U32(p, v) emu_atomic_add_u32(p, v)
#define ATOMIC_ADD_LDS(p, v) emu_atomic_add_u32((unsigned*)(p), v)
#define RFL(x) (x)
#define OPAQUE_V(x) do { } while (0)
#define LDS_WAIT()
#define VM_WAIT()
__device__ __forceinline__ float fast_exp(float x) { return expf(x); }
__device__ __forceinline__ float fast_rcp(float x) { return 1.0f / x; }
__device__ __forceinline__ float fast_rsqrt(float x) { return 1.0f / sqrtf(x); }
#else
#define LAS __attribute__((address_space(3)))
#define GAS __attribute__((address_space(1)))
#define MFMA_F32(a, b, c) __builtin_amdgcn_mfma_f32_16x16x4f32(a, b, c, 0, 0, 0)
#define MFMA_BF16(a, b, c) __builtin_amdgcn_mfma_f32_16x16x32_bf16(a, b, c, 0, 0, 0)
#define ATOMIC_ADD_U32(p, v) __hip_atomic_fetch_add(p, v, __ATOMIC_RELAXED, __HIP_MEMORY_SCOPE_AGENT)
#define ATOMIC_ADD_LDS(p, v) __hip_atomic_fetch_add((LAS unsigned*)(p), v, __ATOMIC_RELAXED, __HIP_MEMORY_SCOPE_WORKGROUP)
#define RFL(x) __builtin_amdgcn_readfirstlane(x)
#define OPAQUE_V(x) asm volatile("" : "+v"(x))
#define LDS_WAIT() asm volatile("s_waitcnt lgkmcnt(0)" ::: "memory")
#define VM_WAIT() asm volatile("s_waitcnt vmcnt(0)" ::: "memory")
__device__ __forceinline__ float fast_exp(float x) { return __expf(x); }
__device__ __forceinline__ float fast_rcp(float x) { return __builtin_amdgcn_rcpf(x); }
__device__ __forceinline__ float fast_rsqrt(float x) { return __builtin_amdgcn_rsqf(x); }
#endif
__device__ __forceinline__ unsigned f2u(float f) { return __builtin_bit_cast(unsigned, f); }
__device__ __forceinline__ float u2f(unsigned u) { return __builtin_bit_cast(float, u); }
__device__ __forceinline__ unsigned f2bf(float f) { unsigned u = f2u(f); return (u + 0x7fffu + ((u >> 16) & 1u)) >> 16; }
__device__ __forceinline__ float bf2f(unsigned h) { return u2f(h << 16); }
__device__ __forceinline__ unsigned pk2(float lo, float hi) { return f2bf(lo) | (f2bf(hi) << 16); }
#ifndef EMU
#define expf(x) __expf(x)
#define exp2f(x) __builtin_amdgcn_exp2f(x)
#define FDIV(a, b) ((a) * __builtin_amdgcn_rcpf(b))
#define RSQRT(x) __builtin_amdgcn_rsqf(x)
__device__ __forceinline__ float softplusf_(float x) { return x > 20.f ? x : __logf(1.0f + __expf(x)); }
#else
#define FDIV(a, b) ((a) / (b))
#define RSQRT(x) (1.0f / sqrtf(x))
__device__ __forceinline__ float softplusf_(float x) { return x > 20.f ? x : log1pf(expf(x)); }
#endif
__device__ __forceinline__ float sigmoidf_(float x) { return FDIV(1.0f, 1.0f + expf(-x)); }
__device__ __forceinline__ float siluf_(float x) { return FDIV(x, 1.0f + expf(-x)); }
__device__ __forceinline__ float tanhf_(float x) { const float e = expf(2.0f * fminf(x, 15.0f)); return FDIV(e - 1.0f, e + 1.0f); }
__device__ __forceinline__ float wave_sum(float v) {
#pragma unroll
    for (int o = 1; o < 64; o <<= 1) v += __shfl_xor(v, o);
    return v;
}
__device__ __forceinline__ float wave_max(float v) {
#pragma unroll
    for (int o = 1; o < 64; o <<= 1) v = fmaxf(v, __shfl_xor(v, o));
    return v;
}
__device__ __forceinline__ f32x4 ld_bf16x4(const bf16* p) { const u32x2 w = *(const u32x2*)p; return (f32x4){bf2f(w.x & 0xffffu), bf2f(w.x >> 16), bf2f(w.y & 0xffffu), bf2f(w.y >> 16)}; }
__device__ __forceinline__ void st_bf16x4(bf16* p, f32x4 v) { u32x2 w; w.x = pk2(v.x, v.y); w.y = pk2(v.z, v.w); *(u32x2*)p = w; }
__device__ __forceinline__ u32x4 pack8(const float* v) { u32x4 o; o.x = pk2(v[0], v[1]); o.y = pk2(v[2], v[3]); o.z = pk2(v[4], v[5]); o.w = pk2(v[6], v[7]); return o; }

namespace pg8 {
#define PG8_LAS LAS
typedef unsigned short bf16_t;
constexpr int BM = 256, BK = 64, HALF = 128, HTB = HALF * BK * 2, STAGE_BYTES = 8 * HTB, NXCD = 8, WGM = 8;
__host__ __device__ __forceinline__ int lds_byte(int r, int c) { const int st = (r >> 4) * 2 + (c >> 5), rr = r & 15, cc = c & 31, ob = rr * 64 + cc * 2; return st * 1024 + (ob ^ (((ob >> 9) & 1) << 5)); }
__host__ __device__ __forceinline__ void stage_rc(int b, int& R, int& C) { const int st = b / 1024, sb = b % 1024, swz = sb ^ (((sb >> 9) & 1) << 5); R = (st >> 1) * 16 + swz / 64; C = (st & 1) * 32 + (swz % 64) / 2; }
__host__ __device__ __forceinline__ int perm32(int rho) { const int n = rho >> 4, i = rho & 15; return 8 * (i >> 2) + 4 * n + (i & 3); }
struct Unit { int pm, pn; };
struct Gemm { const bf16_t* A; const bf16_t* Bt; int lda, K; };
struct StaticOrder {
    int nM, nN, nwg, G, c;
    __host__ __device__ void init(int M, int N, int G_, int c_) { nM = M / BM; nN = N / BM; nwg = nM * nN; G = G_; c = c_; }
    __host__ __device__ bool next(int i, Unit& u) const {
        const long L = (long)i * G + c; if (L >= nwg) return false;
        int wgid = (int)L; { const int q = nwg / NXCD, r = nwg % NXCD, xcd = wgid % NXCD, off = wgid / NXCD; wgid = (xcd < r ? xcd * (q + 1) : r * (q + 1) + (xcd - r) * q) + off; }
        const int nig = WGM * nN, gid = wgid / nig, fm = gid * WGM, gsz = (nM - fm) < WGM ? (nM - fm) : WGM;
        u.pm = fm + ((wgid % nig) % gsz); u.pn = (wgid % nig) / gsz; return true;
    }
    __device__ __forceinline__ void a_ready(const Unit&) const {}
    __device__ __forceinline__ void done(const Unit&) const {}
};
#ifndef EMU
template <class Epi, class Sched>
__device__ __forceinline__ void gemm_phase(PG8_LAS unsigned char* lds, const Gemm g, const Sched& S, const Epi& E, const int tid) {
    const int wid = __builtin_amdgcn_readfirstlane(tid >> 6), lane = tid & 63, wr = wid >> 2, wc = wid & 3, fr = lane & 15, fq = lane >> 4;
    int Kq = g.K; asm volatile("" : "+s"(Kq));
    const int K = Kq, nt = K / BK, lda = g.lda;
    unsigned voffA[2], voffB[2];
#pragma unroll
    for (int i = 0; i < 2; ++i) { int R, C; stage_rc(tid * 16 + i * 8192, R, C); const int Rb = Epi::PERM ? ((R & ~31) + perm32(R & 31)) : R;
        voffA[i] = (unsigned)(R * lda + C) * 2u; voffB[i] = (unsigned)(Rb * K + C) * 2u; }
    const size_t kstep = (size_t)(BK * 2);
    const size_t hstep = (size_t)HALF * K * 2, hstepA = (size_t)HALF * lda * 2;
    const size_t tstep = 2 * hstep, tstepA = 2 * hstepA;
    const unsigned ldsw = (unsigned)wid * 1024u;
    const int aoff = lds_byte(wr * 64 + fr, fq * 8), boff = lds_byte(wc * 32 + fr, fq * 8);
#define PG8_SA(b, h) (((b) * 2 + (h)) * HTB)
#define PG8_SB(b, h) ((4 + (b) * 2 + (h)) * HTB)
#define PG8_STAGE(bufoff, gbase, voff) do { _Pragma("unroll") for (int _i = 0; _i < 2; ++_i) \
        __builtin_amdgcn_global_load_lds((const unsigned*)((const char*)(gbase) + (voff)[_i]), (PG8_LAS unsigned*)(lds + (bufoff) + ldsw + _i * 8192), 16, 0, 0); } while (0)
#define PG8_LDA(dst, b, h) do { _Pragma("unroll") for (int m = 0; m < 4; ++m) _Pragma("unroll") for (int k = 0; k < 2; ++k) dst[m][k] = *(const PG8_LAS bf16x8*)(lds + PG8_SA(b, h) + aoff + m * 2048 + k * 1024); } while (0)
#define PG8_LDB(dst, b, h) do { _Pragma("unroll") for (int n = 0; n < 2; ++n) _Pragma("unroll") for (int k = 0; k < 2; ++k) dst[n][k] = *(const PG8_LAS bf16x8*)(lds + PG8_SB(b, h) + boff + n * 2048 + k * 1024); } while (0)
#define PG8_MMA(ai, bj, At, Bt) do { __builtin_amdgcn_s_setprio(1); _Pragma("unroll") for (int m = 0; m < 4; ++m) _Pragma("unroll") for (int n = 0; n < 2; ++n) _Pragma("unroll") for (int k = 0; k < 2; ++k) \
        acc[ai][bj][m][n] = __builtin_amdgcn_mfma_f32_16x16x32_bf16(Bt[n][k], At[m][k], acc[ai][bj][m][n], 0, 0, 0); __builtin_amdgcn_s_setprio(0); } while (0)
#define PG8_WAIT_V(n) asm volatile("s_waitcnt vmcnt(" #n ")" ::: "memory")
#define PG8_WAIT_L(n) asm volatile("s_waitcnt lgkmcnt(" #n ")" ::: "memory")
#define PG8_BAR __builtin_amdgcn_s_barrier()
#define PG8_SCHED __builtin_amdgcn_sched_barrier(0)
    Unit cur, nxt; int ui = 0;
    if (!S.next(0, cur)) return;
    f32x4 acc[2][2][4][2];
#pragma unroll
    for (int a = 0; a < 2; ++a)
#pragma unroll
        for (int b = 0; b < 2; ++b)
#pragma unroll
            for (int m = 0; m < 4; ++m)
#pragma unroll
                for (int n = 0; n < 2; ++n) acc[a][b][m][n] = (f32x4){0.f, 0.f, 0.f, 0.f};
    bf16x8 At[4][2], B0[2][2], B1[2][2];
    const char* cA = (const char*)g.A + (size_t)cur.pm * tstepA; const char* cB = (const char*)g.Bt + (size_t)cur.pn * tstep;
    S.a_ready(cur);
    PG8_STAGE(PG8_SB(0, 0), cB, voffB); PG8_STAGE(PG8_SA(0, 0), cA, voffA); PG8_STAGE(PG8_SB(0, 1), cB + hstep, voffB); PG8_STAGE(PG8_SA(0, 1), cA + hstepA, voffA);
    if (wr == 1) PG8_BAR;
    PG8_WAIT_V(4); PG8_BAR;
    PG8_STAGE(PG8_SB(1, 0), cB + kstep, voffB); PG8_STAGE(PG8_SA(1, 0), cA + kstep, voffA); PG8_STAGE(PG8_SB(1, 1), cB + hstep + kstep, voffB);
    PG8_WAIT_V(6); PG8_BAR;
    for (;;) {
        const bool has_next = S.next(ui + 1, nxt);
        const char* nA = has_next ? (const char*)g.A + (size_t)nxt.pm * tstepA : cA; const char* nB = has_next ? (const char*)g.Bt + (size_t)nxt.pn * tstep : cB;
        for (int t = 0; t < nt; t += 2) {
            const bool last = (t == nt - 2);
            const char* a1 = cA + (size_t)(t + 1) * kstep;
            const char* a2 = last ? nA : cA + (size_t)(t + 2) * kstep; const char* b2 = last ? nB : cB + (size_t)(t + 2) * kstep;
            const char* a3 = a2 + kstep; const char* b3 = b2 + kstep;
            if (last && has_next) S.a_ready(nxt);
            PG8_LDB(B0, 0, 0); PG8_SCHED; PG8_LDA(At, 0, 0); PG8_STAGE(PG8_SA(1, 1), a1 + hstepA, voffA);
            PG8_WAIT_L(8); PG8_BAR; PG8_WAIT_L(0); PG8_MMA(0, 0, At, B0); PG8_BAR; PG8_SCHED;
            PG8_LDB(B1, 0, 1); PG8_STAGE(PG8_SB(0, 0), b2, voffB);
            PG8_BAR; PG8_WAIT_L(0); PG8_MMA(0, 1, At, B1); PG8_BAR;
            PG8_LDA(At, 0, 1); PG8_STAGE(PG8_SA(0, 0), a2, voffA);
            PG8_BAR; PG8_WAIT_L(0); PG8_MMA(1, 0, At, B0); PG8_BAR; PG8_SCHED;
            PG8_STAGE(PG8_SB(0, 1), b2 + hstep, voffB);
            PG8_WAIT_V(6); PG8_BAR; PG8_MMA(1, 1, At, B1); PG8_BAR;
            PG8_LDB(B0, 1, 0); PG8_SCHED; PG8_LDA(At, 1, 0); PG8_STAGE(PG8_SA(0, 1), a2 + hstepA, voffA);
            PG8_WAIT_L(8); PG8_BAR; PG8_WAIT_L(0); PG8_MMA(0, 0, At, B0); PG8_BAR; PG8_SCHED;
            PG8_LDB(B1, 1, 1); PG8_STAGE(PG8_SB(1, 0), b3, voffB);
            PG8_BAR; PG8_WAIT_L(0); PG8_MMA(0, 1, At, B1); PG8_BAR;
            PG8_LDA(At, 1, 1); PG8_STAGE(PG8_SA(1, 0), a3, voffA);
            PG8_BAR; PG8_WAIT_L(0); PG8_MMA(1, 0, At, B0); PG8_BAR; PG8_SCHED;
            PG8_STAGE(PG8_SB(1, 1), b3 + hstep, voffB);
            PG8_WAIT_V(6); PG8_BAR; PG8_MMA(1, 1, At, B1); PG8_BAR;
        }
        if constexpr (!Epi::AFTER_DRAIN) { E(acc, cur, wr, wc, fr, fq); S.done(cur); }
        if (!has_next) break;
#pragma unroll
        for (int a = 0; a < 2; ++a)
#pragma unroll
            for (int b = 0; b < 2; ++b)
#pragma unroll
                for (int m = 0; m < 4; ++m)
#pragma unroll
                    for (int n = 0; n < 2; ++n) acc[a][b][m][n] = (f32x4){0.f, 0.f, 0.f, 0.f};
        cur = nxt; cA = nA; cB = nB; ++ui;
    }
    PG8_WAIT_V(0);
    if (wr == 0) PG8_BAR;
    PG8_BAR;
    if constexpr (Epi::AFTER_DRAIN) { E.fused(acc, cur, wr, wc, fr, fq, lds, wid, lane); S.done(cur); }
#undef PG8_SA
#undef PG8_SB
#undef PG8_STAGE
#undef PG8_LDA
#undef PG8_LDB
#undef PG8_MMA
#undef PG8_WAIT_V
#undef PG8_WAIT_L
#undef PG8_BAR
#undef PG8_SCHED
}
#else
template <class Epi, class Sched>
__device__ __forceinline__ void gemm_phase(PG8_LAS unsigned char* lds, const Gemm g, const Sched& S, const Epi& E, const int tid) {
    const int wid = tid >> 6, lane = tid & 63, wr = wid >> 2, wc = wid & 3, fr = lane & 15, fq = lane >> 4;
    Unit cur;
    for (int ui = 0; S.next(ui, cur); ++ui) {
        f32x4 acc[2][2][4][2];
        for (int ai = 0; ai < 2; ++ai) for (int m = 0; m < 4; ++m) {
            const size_t row = (size_t)cur.pm * 256 + ai * 128 + wr * 64 + m * 16 + fr;
            const bf16_t* ap = g.A + row * g.lda;
            for (int bj = 0; bj < 2; ++bj) for (int n = 0; n < 2; ++n) for (int j = 0; j < 4; ++j) {
                const size_t col = (size_t)cur.pn * 256 + bj * 128 + wc * 32 + (Epi::PERM ? 8 * fq + 4 * n : 16 * n + 4 * fq) + j;
                const bf16_t* bp = g.Bt + col * g.K; float s = 0.f;
                for (int k = 0; k < g.K; ++k) s += bf2f(ap[k]) * bf2f(bp[k]);
                acc[ai][bj][m][n][j] = s; } }
        E(acc, cur, wr, wc, fr, fq);
    }
    __syncthreads();
}
#endif
}

using pg8::Unit;
constexpr int HALFT = 128;
struct EpiF32 {
    static constexpr bool PERM = false, AFTER_DRAIN = false;
    float* C; int ldc;
    __device__ __forceinline__ void operator()(const f32x4 (&acc)[2][2][4][2], const Unit& u, int wr, int wc, int fr, int fq) const {
        const int row0 = u.pm * 256 + wr * 64 + fr, col0 = u.pn * 256 + wc * 32 + 4 * fq;
#pragma unroll
        for (int ai = 0; ai < 2; ++ai)
#pragma unroll
            for (int m = 0; m < 4; ++m) { float* rowp = C + (size_t)(row0 + ai * HALFT + m * 16) * ldc + col0;
#pragma unroll
                for (int bj = 0; bj < 2; ++bj)
#pragma unroll
                    for (int n = 0; n < 2; ++n) *(f32x4*)(rowp + bj * HALFT + n * 16) = acc[ai][bj][m][n]; }
    }
};
struct EpiResidual {
    static constexpr bool PERM = false, AFTER_DRAIN = false;
    const float* res; float* out;
    __device__ __forceinline__ void operator()(const f32x4 (&acc)[2][2][4][2], const Unit& u, int wr, int wc, int fr, int fq) const {
        const int row0 = u.pm * 256 + wr * 64 + fr, col0 = u.pn * 256 + wc * 32 + 4 * fq;
#pragma unroll
        for (int ai = 0; ai < 2; ++ai) {
            f32x4 rv[4][2][2];
#pragma unroll
            for (int m = 0; m < 4; ++m) { const size_t o = (size_t)(row0 + ai * HALFT + m * 16) * D + col0;
#pragma unroll
                for (int bj = 0; bj < 2; ++bj)
#pragma unroll
                    for (int n = 0; n < 2; ++n) rv[m][bj][n] = *(const GAS f32x4*)(res + o + bj * HALFT + n * 16); }
#pragma unroll
            for (int m = 0; m < 4; ++m) { const size_t o = (size_t)(row0 + ai * HALFT + m * 16) * D + col0;
#pragma unroll
                for (int bj = 0; bj < 2; ++bj)
#pragma unroll
                    for (int n = 0; n < 2; ++n) *(GAS f32x4*)(out + o + bj * HALFT + n * 16) = rv[m][bj][n] + acc[ai][bj][m][n]; }
        }
    }
};
struct EpiBf16 {
    static constexpr bool PERM = true, AFTER_DRAIN = false;
    bf16* O; int ldc; const float* rowscale; int rs_stride;
    __device__ __forceinline__ void operator()(const f32x4 (&acc)[2][2][4][2], const Unit& u, int wr, int wc, int fr, int fq) const {
        const int row0 = u.pm * 256 + wr * 64 + fr, col0 = u.pn * 256 + wc * 32 + 8 * fq;
#pragma unroll
        for (int ai = 0; ai < 2; ++ai)
#pragma unroll
            for (int m = 0; m < 4; ++m) { const int row = row0 + ai * HALFT + m * 16; bf16* rowp = O + (size_t)row * ldc + col0;
                const float sc = rowscale ? rowscale[(size_t)row * rs_stride] : 1.0f;
#pragma unroll
                for (int bj = 0; bj < 2; ++bj) { const f32x4 v0 = acc[ai][bj][m][0] * sc, v1 = acc[ai][bj][m][1] * sc;
                    u32x4 w; w.x = pk2(v0[0], v0[1]); w.y = pk2(v0[2], v0[3]); w.z = pk2(v1[0], v1[1]); w.w = pk2(v1[2], v1[3]);
                    *(u32x4*)(rowp + bj * HALFT) = w; } }
    }
};
struct EpiSwiGLU {
    static constexpr bool PERM = true, AFTER_DRAIN = false;
    bf16* O; int ldc; int ntile;
    __device__ __forceinline__ void operator()(const f32x4 (&acc)[2][2][4][2], const Unit& u, int wr, int wc, int fr, int fq) const {
        const int row0 = u.pm * 256 + wr * 64 + fr, col0 = (u.pn % ntile) * 128 + wc * 32 + 8 * fq;
#pragma unroll
        for (int ai = 0; ai < 2; ++ai)
#pragma unroll
            for (int m = 0; m < 4; ++m) { bf16* rowp = O + (size_t)(row0 + ai * HALFT + m * 16) * ldc + col0;
                float a[8];
#pragma unroll
                for (int n = 0; n < 2; ++n)
#pragma unroll
                    for (int j = 0; j < 4; ++j) { const float g = acc[ai][0][m][n][j], up = acc[ai][1][m][n][j]; a[4 * n + j] = g * fast_rcp(1.0f + fast_exp(-g)) * up; }
                u32x4 w; w.x = pk2(a[0], a[1]); w.y = pk2(a[2], a[3]); w.z = pk2(a[4], a[5]); w.w = pk2(a[6], a[7]);
                *(u32x4*)rowp = w; }
    }
};
struct EpiZ {
    static constexpr bool PERM = true, AFTER_DRAIN = false;
    bf16* Z;
    __device__ __forceinline__ void operator()(const f32x4 (&acc)[2][2][4][2], const Unit& u, int wr, int wc, int fr, int fq) const {
        const int i = u.pn >> 2, pnl = u.pn & 3, pml = u.pm - i * (TH / 256);
        const int row0 = pml * 256 + wr * 64 + fr, col0 = i * D + pnl * 256 + wc * 32 + 8 * fq;
#pragma unroll
        for (int ai = 0; ai < 2; ++ai)
#pragma unroll
            for (int m = 0; m < 4; ++m) { bf16* rowp = Z + (size_t)(row0 + ai * HALFT + m * 16) * 4096 + col0;
#pragma unroll
                for (int bj = 0; bj < 2; ++bj) { const f32x4 v0 = acc[ai][bj][m][0], v1 = acc[ai][bj][m][1];
                    u32x4 w; w.x = pk2(v0[0], v0[1]); w.y = pk2(v0[2], v0[3]); w.z = pk2(v1[0], v1[1]); w.w = pk2(v1[2], v1[3]);
                    *(GAS u32x4*)(rowp + bj * HALFT) = w; } }
    }
};
struct BranchOrder {
    int nP, G, c;
    __device__ bool next(int i, Unit& u) const {
        const long L = (long)i * G + c; if (L >= (long)16 * nP) return false;
        const int br = (int)(L / (4 * nP)), r = (int)(L % (4 * nP)); u.pm = br * nP + (r >> 2); u.pn = br * 4 + (r & 3); return true;
    }
    __device__ __forceinline__ void a_ready(const Unit&) const {}
    __device__ __forceinline__ void done(const Unit&) const {}
};
struct EpiMerge {
    static constexpr bool PERM = false, AFTER_DRAIN = false;
    const bf16* Z; const float* gate_b; bf16* MG;
    __device__ __forceinline__ void operator()(const f32x4 (&acc)[2][2][4][2], const Unit& u, int wr, int wc, int fr, int fq) const {
        const int row0 = u.pm * 256 + wr * 64 + fr, col = u.pn * 64 + wc * 16 + 4 * fq;
        f32x4 gb[4];
#pragma unroll
        for (int i = 0; i < 4; ++i) gb[i] = *(const GAS f32x4*)(gate_b + i * D + col);
#pragma unroll
        for (int ai = 0; ai < 2; ++ai) {
            u32x2 zv[4][4];
#pragma unroll
            for (int m = 0; m < 4; ++m)
#pragma unroll
                for (int i = 0; i < 4; ++i) zv[m][i] = *(const GAS u32x2*)(Z + (size_t)(row0 + ai * HALFT + m * 16) * 4096 + i * D + col);
#pragma unroll
            for (int m = 0; m < 4; ++m) { const size_t row = (size_t)(row0 + ai * HALFT + m * 16);
                f32x4 s = (f32x4){0.f, 0.f, 0.f, 0.f};
#pragma unroll
                for (int bj = 0; bj < 2; ++bj)
#pragma unroll
                    for (int n = 0; n < 2; ++n) { const int i = 2 * bj + n; const unsigned z01 = zv[m][i].x, z23 = zv[m][i].y;
                        const f32x4 z = (f32x4){bf2f(z01 & 0xffffu), bf2f(z01 >> 16), bf2f(z23 & 0xffffu), bf2f(z23 >> 16)}; const f32x4 a = acc[ai][bj][m][n] + gb[i];
#pragma unroll
                        for (int j = 0; j < 4; ++j) s[j] += z[j] * fast_rcp(1.0f + fast_exp(-a[j])); }
                u32x2 w; w.x = pk2(s.x, s.y); w.y = pk2(s.z, s.w); *(GAS u32x2*)(MG + row * D + col) = w; }
        }
    }
};

constexpr size_t MiB = 1u << 20;
constexpr size_t al(size_t x) { return (x + 255) & ~(size_t)255; }
constexpr size_t WS_CTL = 0, CTL_BYTES = 1 * MiB;
constexpr size_t W_IN = 1 * MiB;
constexpr size_t W_GATE = W_IN + (size_t)PW * D * 2;
constexpr size_t W_UQ = W_GATE + (size_t)4096 * D * 2;
constexpr size_t W_UKV = W_UQ + (size_t)768 * 384 * 2;
constexpr size_t W_LORA = W_UKV + (size_t)1024 * 256 * 2;
constexpr size_t W_BR = W_LORA + (size_t)1536 * 384 * 2;
constexpr size_t W_OUT = W_BR + (size_t)4 * 1024 * 512 * 2;
constexpr size_t W_FGU = W_OUT + (size_t)D * D * 2;
constexpr size_t W_FDN = W_FGU + (size_t)NEXP * 2 * FF_E * D * 2;
constexpr size_t W_END = W_FDN + (size_t)NEXP * D * FF_E * 2;
constexpr size_t A_H = al(W_END);
constexpr size_t A_ROPE = A_H + (size_t)TH * D * 2;
constexpr size_t A_Y = A_ROPE + (size_t)TH * 64 * 4;
constexpr size_t A_P = A_Y + (size_t)4 * TH * 512 * 2;
constexpr size_t A_MIX = A_P + (size_t)TH * PW * 2;
constexpr size_t R_RKV = A_MIX;
constexpr size_t R_LOUT = R_RKV + (size_t)TH * 1536 * 2;
constexpr size_t R_O = R_LOUT + (size_t)TH * 1536 * 4;
constexpr size_t R_LIN = R_O + (size_t)TH * 512 * 4;
constexpr size_t R_REC = R_LIN + (size_t)TH * 384 * 2;
constexpr size_t R_END = R_REC + (size_t)BH * 8 * NCH * 61696;
constexpr size_t M_KR = al(R_END);
constexpr size_t M_Q = M_KR + (size_t)TH * 64 * 2;
constexpr size_t M_KV = M_Q + (size_t)TH * 768 * 2;
constexpr size_t M_VT = M_KV + (size_t)TH * 1024 * 2;
constexpr size_t M_END = M_VT + (size_t)TH * 512 * 2;
constexpr size_t G_CH = R_LIN;
constexpr size_t G_O = G_CH + al((size_t)BH * 4 * NCH * 78864);
constexpr size_t G_END = G_O + (size_t)TH * 512 * 4;
constexpr size_t S_ST = al(G_END);
constexpr size_t S_YD = S_ST + (size_t)BH * NCH * 8 * 64 * 128 * 2;
constexpr size_t S_C = S_YD + (size_t)TH * 512 * 4;
constexpr size_t S_AC = S_C + (size_t)BH * NCH * 2 * 17408;
constexpr size_t S_YO = S_AC + (size_t)TH * 8 * 4;
constexpr size_t S_END = S_YO + (size_t)TH * 512 * 4;
constexpr size_t A_Z = A_P;
constexpr size_t A_MG = A_MIX;
constexpr size_t F_ACT = A_P;
constexpr size_t F_GA = F_ACT + (size_t)MOE_ROWS * FF_E * 2;
constexpr size_t F_YE = F_GA + (size_t)MOE_ROWS * D * 2;
constexpr size_t F_TOPE = F_YE + (size_t)MOE_ROWS * D * 4;
constexpr size_t F_TOPW = F_TOPE + (size_t)TH * 2 * 4;
constexpr size_t F_SLOT = F_TOPW + (size_t)TH * 2 * 4;
constexpr size_t F_END = F_SLOT + (size_t)TH * 2 * 4;
constexpr size_t cmax(size_t a, size_t b) { return a > b ? a : b; }
constexpr size_t WS_NEED = cmax(cmax(cmax(M_END, R_END), cmax(G_END, S_END)), F_END);
#ifndef EMU
static_assert(WS_NEED <= (size_t)896 * MiB, "workspace");
#endif
constexpr int CW_BAR = 4096;
constexpr int CW_CNT = 16384;
constexpr int CW_WGC = 32768;

#ifdef EMU
#define WAVE_SYNC() emu_wave_sync()
#else
#define WAVE_SYNC() do { asm volatile("s_waitcnt lgkmcnt(0)" ::: "memory"); } while (0)
#endif
struct Frame {
    LAS unsigned char* lds; int tid, lane, wave, G, gw, NGW, bid;
    GAS float* out; GAS unsigned char* ws; GAS unsigned* ctl;
};
struct Args { const float* in[39]; float* out; unsigned char* ws; int lo, hi; };
#define WSP(type, off) ((type*)(F.ws + (off)))
#define AIN(A_, k) ((const float*)(const GAS float*)(A_).in[k])

template <class FN>
__device__ __forceinline__ void cvt_matrix(const Frame& F, const float* W, int ldw, int K, bf16* WT, int Ndst, const float* kscale, FN srccol) {
    LAS float* scr = (LAS float*)(F.lds + F.wave * 16384);
    const int nblk = Ndst / 32, nitems = (K / 64) * nblk, lane = F.lane;
    for (int item = F.gw; item < nitems; item += F.NGW) {
        const int kb = item / nblk, nb = item % nblk, k0 = 64 * kb, n0 = 32 * nb;
        const int sc = srccol(n0 + (lane & 31));
        float wv[32];
#pragma unroll
        for (int i = 0; i < 32; ++i) { const int kk = 2 * i + (lane >> 5); wv[i] = sc >= 0 ? W[(size_t)(k0 + kk) * ldw + sc] : 0.f; }
#pragma unroll
        for (int i = 0; i < 32; ++i) { const int kk = 2 * i + (lane >> 5); float v = wv[i]; if (kscale) v *= kscale[k0 + kk]; scr[kk * 33 + (lane & 31)] = v; }
        WAVE_SYNC();
        const int c = lane & 7;
#pragma unroll
        for (int j = 0; j < 4; ++j) { const int n = (lane >> 3) + 8 * j; const LAS float* s = scr + (8 * c) * 33 + n;
            u32x4 o; o.x = pk2(s[0 * 33], s[1 * 33]); o.y = pk2(s[2 * 33], s[3 * 33]); o.z = pk2(s[4 * 33], s[5 * 33]); o.w = pk2(s[6 * 33], s[7 * 33]);
            *(u32x4*)(WT + (size_t)(n0 + n) * K + k0 + 8 * c) = o; }
        WAVE_SYNC();
    }
}
__device__ __forceinline__ void phase_convert(const Frame& F, const Args& A, int layer) {
    const float* w_in = AIN(A, 3) + (size_t)layer * D * IN_COLS;
    cvt_matrix(F, w_in, IN_COLS, D, WSP(bf16, W_IN), PW, nullptr, [](int n) { return n < C_GATE ? n : -1; });
    cvt_matrix(F, w_in, IN_COLS, D, WSP(bf16, W_GATE), 4096, nullptr, [](int n) {
        const int pn = n >> 8, c = n & 255, bj = c >> 7, wc = (c >> 5) & 3, nn = (c >> 4) & 1, r = c & 15; return C_GATE + (2 * bj + nn) * D + 64 * pn + 16 * wc + r; });
    cvt_matrix(F, AIN(A, 6) + (size_t)layer * 384 * 768, 768, 384, WSP(bf16, W_UQ), 768, AIN(A, 4) + layer * 384, [](int n) { return n; });
    cvt_matrix(F, AIN(A, 7) + (size_t)layer * 256 * 1024, 1024, 256, WSP(bf16, W_UKV), 1024, AIN(A, 5) + layer * 256, [](int n) { return n; });
    for (int i = 0; i < 4; ++i) cvt_matrix(F, AIN(A, 30) + ((size_t)layer * 4 + i) * 512 * D, D, 512, WSP(bf16, W_BR) + (size_t)i * D * 512, D, nullptr, [](int n) { return n; });
    cvt_matrix(F, AIN(A, 31) + (size_t)layer * D * D, D, D, WSP(bf16, W_OUT), D, nullptr, [](int n) { return n; });
    if (layer == 0) {
        cvt_matrix(F, AIN(A, 33), 2 * FF_D, D, WSP(bf16, W_FGU), 2 * FF_D, nullptr, [](int n) { const int pn = n >> 8, c = n & 255; return c < 128 ? 128 * pn + c : FF_D + 128 * pn + (c - 128); });
        cvt_matrix(F, AIN(A, 34), D, FF_D, WSP(bf16, W_FDN), D, nullptr, [](int n) { return n; });
    } else {
        for (int e = 0; e < NEXP; ++e) {
            cvt_matrix(F, AIN(A, 36) + (size_t)e * D * 2 * FF_E, 2 * FF_E, D, WSP(bf16, W_FGU) + (size_t)e * 2 * FF_E * D, 2 * FF_E, nullptr, [](int n) { const int pn = n >> 8, c = n & 255; return c < 128 ? 128 * pn + c : FF_E + 128 * pn + (c - 128); });
            cvt_matrix(F, AIN(A, 37) + (size_t)e * FF_E * D, D, FF_E, WSP(bf16, W_FDN) + (size_t)e * D * FF_E, D, nullptr, [](int n) { return n; });
        }
    }
    { const float* w2 = AIN(A, 10) + (size_t)layer * 64 * 512; const float* a2 = AIN(A, 12) + (size_t)layer * 64 * 512; const float* g2 = AIN(A, 13) + (size_t)layer * 160 * 512;
      bf16* L = WSP(bf16, W_LORA);
      for (int idx = F.bid * 512 + F.tid; idx < 1536 * 384; idx += F.G * 512) { const int n = idx / 384, k = idx % 384; float v = 0.f;
          if (n < 512) { if (k < 64) v = w2[k * 512 + n]; } else if (n < 1024) { if (k >= 64 && k < 128) v = a2[(k - 64) * 512 + (n - 512)]; } else { if (k >= 128 && k < 288) v = g2[(k - 128) * 512 + (n - 1024)]; }
          L[idx] = (bf16)f2bf(v); } }
}

template <bool ROUTER>
__device__ __forceinline__ void phase_norm(const Frame& F, const Args& A, const float* xin, const float* gain, bf16* H, const float* router, int* tope, float* topw, unsigned* cnt) {
    const int lane = F.lane;
    LAS unsigned* lcnt = (LAS unsigned*)F.lds;
    if (ROUTER) { __syncthreads(); if (F.tid < 8) lcnt[F.tid] = 0u; __syncthreads(); }
    f32x4 gv[4];
#pragma unroll
    for (int j = 0; j < 4; ++j) gv[j] = *(const f32x4*)(gain + 4 * lane + 256 * j);
    for (int m = F.gw; m < TH; m += F.NGW) {
        const float* xr = xin + (size_t)m * D; f32x4 v[4]; float ss = 0.f;
#pragma unroll
        for (int j = 0; j < 4; ++j) { v[j] = *(const f32x4*)(xr + 4 * lane + 256 * j); ss += (v[j].x * v[j].x + v[j].y * v[j].y) + (v[j].z * v[j].z + v[j].w * v[j].w); }
        const float rstd = RSQRT(wave_sum(ss) * (1.0f / D) + EPS);
#pragma unroll
        for (int j = 0; j < 4; ++j) { v[j] = v[j] * rstd * gv[j]; st_bf16x4(H + (size_t)m * D + 4 * lane + 256 * j, v[j]); }
        if (ROUTER) {
            float lg[8];
#pragma unroll
            for (int e = 0; e < 8; ++e) lg[e] = 0.f;
#pragma unroll
            for (int j = 0; j < 4; ++j)
#pragma unroll
                for (int q = 0; q < 4; ++q) { const float* rp = router + (size_t)(4 * lane + 256 * j + q) * 8; const f32x4 r0 = *(const f32x4*)rp, r1 = *(const f32x4*)(rp + 4); const float hv = v[j][q];
                    lg[0] += hv * r0.x; lg[1] += hv * r0.y; lg[2] += hv * r0.z; lg[3] += hv * r0.w; lg[4] += hv * r1.x; lg[5] += hv * r1.y; lg[6] += hv * r1.z; lg[7] += hv * r1.w; }
#pragma unroll
            for (int e = 0; e < 8; ++e) lg[e] = wave_sum(lg[e]);
            if (lane == 0) {
                int e1 = 0; float l1 = lg[0];
#pragma unroll
                for (int e = 1; e < 8; ++e) if (lg[e] > l1) { l1 = lg[e]; e1 = e; }
                int e2 = -1; float l2 = -3.0e38f;
#pragma unroll
                for (int e = 0; e < 8; ++e) if (e != e1 && lg[e] > l2) { l2 = lg[e]; e2 = e; }
                const float w1 = 1.0f / (1.0f + expf(l2 - l1));
                tope[2 * m] = e1; tope[2 * m + 1] = e2; topw[2 * m] = w1; topw[2 * m + 1] = 1.0f - w1;
                ATOMIC_ADD_LDS(lcnt + e1, 1u); ATOMIC_ADD_LDS(lcnt + e2, 1u);
            }
        }
    }
    if (ROUTER) { __syncthreads(); if (F.tid < 8) cnt[F.bid * 8 + F.tid] = lcnt[F.tid]; __syncthreads(); }
}
__device__ __forceinline__ void phase_rope_table(const Frame& F, const Args& A, const int* pos, float* rope) {
    for (int idx = F.bid * 512 + F.tid; idx < TH * 32; idx += F.G * 512) { const int t = idx >> 5, i = idx & 31;
        const float inv = powf(10000.0f, -(float)i / 32.0f);
        const float ang = (float)pos[t] * inv; float sn, cs; sincosf(ang, &sn, &cs);
        rope[(size_t)t * 64 + i] = cs; rope[(size_t)t * 64 + 32 + i] = sn; }
}
__device__ __forceinline__ void phase_final_norm(const Frame& F, const Args& A, float* x, const float* gain) {
    const int lane = F.lane;
    for (int m = F.gw; m < T; m += F.NGW) {
        float* xr = x + (size_t)m * D; f32x4 v[4]; float ss = 0.f;
#pragma unroll
        for (int j = 0; j < 4; ++j) { v[j] = *(const f32x4*)(xr + 4 * lane + 256 * j); ss += (v[j].x * v[j].x + v[j].y * v[j].y) + (v[j].z * v[j].z + v[j].w * v[j].w); }
        const float rstd = RSQRT(wave_sum(ss) * (1.0f / D) + EPS);
#pragma unroll
        for (int j = 0; j < 4; ++j) *(f32x4*)(xr + 4 * lane + 256 * j) = v[j] * rstd * *(const f32x4*)(gain + 4 * lane + 256 * j);
    }
}

__device__ __forceinline__ void phase_mla_prep(const Frame& F, const Args& A) {
    bf16* P = WSP(bf16, A_P); bf16* kr = WSP(bf16, M_KR); const float* rope = WSP(float, A_ROPE);
    const int lane = F.lane;
    for (int m = F.gw; m < TH; m += F.NGW) {
        bf16* pr = P + (size_t)m * PW; float sq = 0.f, skv = 0.f; f32x4 v[3];
#pragma unroll
        for (int j = 0; j < 3; ++j) { const int c = 4 * lane + 256 * j; v[j] = ld_bf16x4(pr + c); const float s = (v[j].x * v[j].x + v[j].y * v[j].y) + (v[j].z * v[j].z + v[j].w * v[j].w);
            if (c < 384) sq += s; else if (c < 640) skv += s; }
        sq = wave_sum(sq); skv = wave_sum(skv);
        const float rq = RSQRT(sq * (1.0f / 384.0f) + EPS), rkv = RSQRT(skv * (1.0f / 256.0f) + EPS);
#pragma unroll
        for (int j = 0; j < 3; ++j) { const int c = 4 * lane + 256 * j; if (c < 640) st_bf16x4(pr + c, v[j] * (c < 384 ? rq : rkv)); }
        if (lane < 32) { const float x1 = bf2f(pr[640 + lane]), x2 = bf2f(pr[672 + lane]), c = rope[(size_t)m * 64 + lane], s = rope[(size_t)m * 64 + 32 + lane];
            kr[(size_t)m * 64 + lane] = (bf16)f2bf(x1 * c - x2 * s); kr[(size_t)m * 64 + 32 + lane] = (bf16)f2bf(x2 * c + x1 * s); }
    }
}
__device__ __forceinline__ void phase_mla_q(const Frame& F, const Args& A) {
    pg8::Gemm g{WSP(bf16, A_P) + 0, WSP(bf16, W_UQ), PW, 384}; pg8::StaticOrder S; S.init(TH, 768, F.G, F.bid);
    EpiBf16 E{WSP(bf16, M_Q), 768, nullptr, 0}; pg8::gemm_phase(F.lds, g, S, E, F.tid);
}
struct EpiKV {
    static constexpr bool PERM = true, AFTER_DRAIN = false;
    bf16* KV; bf16* VT;
    __device__ __forceinline__ void operator()(const f32x4 (&acc)[2][2][4][2], const Unit& u, int wr, int wc, int fr, int fq) const {
        const int row0 = u.pm * 256 + wr * 64 + fr, col0 = wc * 32 + 8 * fq;
#pragma unroll
        for (int ai = 0; ai < 2; ++ai)
#pragma unroll
            for (int m = 0; m < 4; ++m) { const int row = row0 + ai * HALFT + m * 16;
                { const f32x4 v0 = acc[ai][0][m][0], v1 = acc[ai][0][m][1]; u32x4 w; w.x = pk2(v0[0], v0[1]); w.y = pk2(v0[2], v0[3]); w.z = pk2(v1[0], v1[1]); w.w = pk2(v1[2], v1[3]);
                  *(u32x4*)(KV + (size_t)row * 1024 + u.pn * 256 + col0) = w; }
                const int b = row / SEQ, t = row % SEQ; bf16* vt = VT + ((size_t)(b * 4 + u.pn) * 128 + col0) * SEQ + t;
#pragma unroll
                for (int n = 0; n < 2; ++n)
#pragma unroll
                    for (int j = 0; j < 4; ++j) vt[(size_t)(4 * n + j) * SEQ] = (bf16)f2bf(acc[ai][1][m][n][j]); }
    }
};
__device__ __forceinline__ void phase_mla_kv(const Frame& F, const Args& A) {
    pg8::Gemm g{WSP(bf16, A_P) + 384, WSP(bf16, W_UKV), PW, 256}; pg8::StaticOrder S; S.init(TH, 1024, F.G, F.bid);
    EpiKV E{WSP(bf16, M_KV), WSP(bf16, M_VT)}; pg8::gemm_phase(F.lds, g, S, E, F.tid);
}
constexpr int AT_KS = 200, AT_VS = 72;
constexpr int AT_KBYTES = 64 * AT_KS * 2, AT_VBYTES = 128 * AT_VS * 2;
__device__ __forceinline__ void phase_attention(const Frame& F, const Args& A) {
    const bf16* Q = WSP(bf16, M_Q); const bf16* KV = WSP(bf16, M_KV); const bf16* KR = WSP(bf16, M_KR); const bf16* VTg = WSP(bf16, M_VT); const float* rope = WSP(float, A_ROPE); bf16* Y = WSP(bf16, A_Y);
    const int lane = F.lane, w = F.wave, l15 = lane & 15, q4 = lane >> 4, tid = F.tid, grp = w >> 2, wq = w & 3;
    const int NQB = SEQ / 128, nunits = BH * 4 * NQB;
    const float sc2 = 0.07216878364870322f * 1.4426950408889634f;
    for (int unit = F.bid; unit < nunits; unit += F.G) {
        const int qb = NQB - 1 - (unit / (BH * 4)), bh = unit % (BH * 4), h = bh & 3, b = bh >> 2;
        const size_t t0 = (size_t)b * SEQ;
        bf16x8 qf[2][6];
#pragma unroll
        for (int f = 0; f < 2; ++f) { const size_t tq = t0 + qb * 128 + wq * 32 + 16 * f + l15;
#pragma unroll
            for (int ks = 0; ks < 6; ++ks) qf[f][ks] = *(const bf16x8*)(Q + tq * 768 + h * 192 + 32 * ks + 8 * q4);
            const bf16x8 a = qf[f][4], c2 = qf[f][5];
#pragma unroll
            for (int j = 0; j < 8; ++j) { const float x1 = bf2f((unsigned short)a[j]), x2 = bf2f((unsigned short)c2[j]), c = rope[tq * 64 + 8 * q4 + j], sn = rope[tq * 64 + 32 + 8 * q4 + j];
                qf[f][4][j] = (short)f2bf(x1 * c - x2 * sn); qf[f][5][j] = (short)f2bf(x2 * c + x1 * sn); } }
        f32x4 o[2][8];
#pragma unroll
        for (int f = 0; f < 2; ++f)
#pragma unroll
            for (int mb = 0; mb < 8; ++mb) o[f][mb] = (f32x4){0.f, 0.f, 0.f, 0.f};
        float mrow[2] = {-3.0e38f, -3.0e38f}, lrow[2] = {0.f, 0.f};
        const int qchunk = 2 * qb + (wq >> 1), ntile = 2 * qb + 2;
        u32x4 pk_[3], pv_[2];
        const int skey = tid >> 3, c8 = tid & 7;
        const int okv = skey * 1024 + 8 * c8, okr = skey * 64 + 8 * c8, ovt = skey * SEQ + 8 * c8;
        const bf16* kvb = KV + t0 * 1024 + h * 256; const bf16* krb = KR + t0 * 64; const bf16* vtb = VTg + (size_t)(b * 4 + h) * 128 * SEQ;
#define AT_LOAD(kt) do { const bf16* kv_ = kvb + (size_t)(kt) * 65536; const bf16* kr_ = krb + (size_t)(kt) * 4096; const bf16* vt_ = vtb + (size_t)(kt) * 64; \
            pk_[0] = *(const u32x4*)(kv_ + okv); pk_[1] = *(const u32x4*)(kv_ + okv + 64); pk_[2] = *(const u32x4*)(kr_ + okr); \
            pv_[0] = *(const u32x4*)(vt_ + ovt); pv_[1] = *(const u32x4*)(vt_ + ovt + 64 * SEQ); } while (0)
#define AT_STORE(bufi) do { LAS bf16* Ks_ = (LAS bf16*)(F.lds + (bufi) * (AT_KBYTES + AT_VBYTES)); LAS bf16* Vt_ = (LAS bf16*)((LAS unsigned char*)Ks_ + AT_KBYTES); \
            *(LAS u32x4*)(Ks_ + skey * AT_KS + 8 * c8) = pk_[0]; *(LAS u32x4*)(Ks_ + skey * AT_KS + 8 * c8 + 64) = pk_[1]; *(LAS u32x4*)(Ks_ + skey * AT_KS + 8 * c8 + 128) = pk_[2]; \
            *(LAS u32x4*)(Vt_ + skey * AT_VS + 8 * c8) = pv_[0]; *(LAS u32x4*)(Vt_ + (skey + 64) * AT_VS + 8 * c8) = pv_[1]; } while (0)
        __syncthreads();
        AT_LOAD(0); AT_STORE(0);
        __syncthreads();
        for (int kt = 0; kt < ntile; ++kt) {
            if (kt + 1 < ntile) AT_LOAD(kt + 1);
            if (kt <= qchunk) {
                const LAS bf16* Ks = (const LAS bf16*)(F.lds + (kt & 1) * (AT_KBYTES + AT_VBYTES)); const LAS bf16* Vt = (const LAS bf16*)((const LAS unsigned char*)Ks + AT_KBYTES);
                f32x4 st[2][2];
#pragma unroll
                for (int kb = 0; kb < 2; ++kb) { st[0][kb] = (f32x4){0.f, 0.f, 0.f, 0.f}; st[1][kb] = (f32x4){0.f, 0.f, 0.f, 0.f};
#pragma unroll
                    for (int ks = 0; ks < 6; ++ks) { const bf16x8 kf = *(const LAS bf16x8*)(Ks + (32 * grp + 16 * kb + l15) * AT_KS + 32 * ks + 8 * q4);
                        st[0][kb] = MFMA_BF16(kf, qf[0][ks], st[0][kb]); st[1][kb] = MFMA_BF16(kf, qf[1][ks], st[1][kb]); } }
                bf16x8 pb[2];
#pragma unroll
                for (int f = 0; f < 2; ++f) {
                    float mx = -3.0e38f;
#pragma unroll
                    for (int kb = 0; kb < 2; ++kb) { st[f][kb] = st[f][kb] * sc2; mx = fmaxf(mx, fmaxf(fmaxf(st[f][kb].x, st[f][kb].y), fmaxf(st[f][kb].z, st[f][kb].w))); }
                    mx = fmaxf(mx, __shfl_xor(mx, 16)); mx = fmaxf(mx, __shfl_xor(mx, 32));
                    const float mnew = fmaxf(mrow[f], mx), alpha = exp2f(mrow[f] - mnew); mrow[f] = mnew;
                    float ps = 0.f;
#pragma unroll
                    for (int kb = 0; kb < 2; ++kb)
#pragma unroll
                        for (int r = 0; r < 4; ++r) { const float p = exp2f(st[f][kb][r] - mnew); ps += p; pb[f][4 * kb + r] = (short)f2bf(p); }
                    lrow[f] = lrow[f] * alpha + ps;
#pragma unroll
                    for (int mb = 0; mb < 8; ++mb) o[f][mb] = o[f][mb] * alpha;
                }
#pragma unroll
                for (int mb = 0; mb < 8; ++mb) { const LAS bf16* vp = Vt + (16 * mb + l15) * AT_VS + 32 * grp + 4 * q4;
                    const bf16x4 v0 = *(const LAS bf16x4*)vp, v1 = *(const LAS bf16x4*)(vp + 16);
                    bf16x8 vf; vf[0] = v0[0]; vf[1] = v0[1]; vf[2] = v0[2]; vf[3] = v0[3]; vf[4] = v1[0]; vf[5] = v1[1]; vf[6] = v1[2]; vf[7] = v1[3];
                    o[0][mb] = MFMA_BF16(vf, pb[0], o[0][mb]); o[1][mb] = MFMA_BF16(vf, pb[1], o[1][mb]); }
            }
            if (kt + 1 < ntile) AT_STORE((kt + 1) & 1);
            __syncthreads();
        }
#undef AT_LOAD
#undef AT_STORE
#pragma unroll
        for (int f = 0; f < 2; ++f) { lrow[f] += __shfl_xor(lrow[f], 16); lrow[f] += __shfl_xor(lrow[f], 32); }
        LAS float* xo = (LAS float*)F.lds + (size_t)wq * (2 * 8 * 4 * 64 + 4 * 64);
        if (grp == 1) {
#pragma unroll
            for (int f = 0; f < 2; ++f) {
#pragma unroll
                for (int mb = 0; mb < 8; ++mb)
#pragma unroll
                    for (int r = 0; r < 4; ++r) xo[((f * 8 + mb) * 4 + r) * 64 + lane] = o[f][mb][r];
                xo[2 * 8 * 4 * 64 + f * 64 + lane] = mrow[f]; xo[2 * 8 * 4 * 64 + 128 + f * 64 + lane] = lrow[f]; } }
        __syncthreads();
        if (grp == 0) {
#pragma unroll
            for (int f = 0; f < 2; ++f) { const float m1 = xo[2 * 8 * 4 * 64 + f * 64 + lane], l1 = xo[2 * 8 * 4 * 64 + 128 + f * 64 + lane];
                const float m = fmaxf(mrow[f], m1), a0 = exp2f(mrow[f] - m), a1 = exp2f(m1 - m), inv = 1.0f / (lrow[f] * a0 + l1 * a1);
                const size_t tq = t0 + qb * 128 + wq * 32 + 16 * f + l15;
#pragma unroll
                for (int mb = 0; mb < 8; ++mb) { f32x4 v;
#pragma unroll
                    for (int r = 0; r < 4; ++r) v[r] = (o[f][mb][r] * a0 + xo[((f * 8 + mb) * 4 + r) * 64 + lane] * a1) * inv;
                    st_bf16x4(Y + tq * 512 + h * 128 + 16 * mb + 4 * q4, v); } } }
    }
    __syncthreads();
}

__device__ __forceinline__ f32x4 tile_bf(const LAS bf16* a, int lda, const LAS bf16* bt, int ldb, int K, f32x4 acc, int l15, int q4) {
    const LAS bf16* ap = a + l15 * lda + 8 * q4; const LAS bf16* bp = bt + l15 * ldb + 8 * q4;
#pragma unroll 4
    for (int ks = 0; ks < K / 32; ++ks) acc = MFMA_BF16(*(const LAS bf16x8*)(ap + 32 * ks), *(const LAS bf16x8*)(bp + 32 * ks), acc);
    return acc;
}
__device__ __forceinline__ f32x4 tile_mm(const LAS float* a, int lda, int ska, const LAS float* b, int ldb, int scb, int K, f32x4 acc, int l15, int q4);


__device__ __forceinline__ void diag_solve16(const LAS float* Lblk  , int ldl, LAS float* xcol  , int ldx) {
    float x[16];
#pragma unroll
    for (int i = 0; i < 16; ++i) x[i] = xcol[i * ldx];
#pragma unroll
    for (int g = 0; g < 4; ++g) {
        f32x4 av[4][4];
#pragma unroll
        for (int ii = 0; ii < 4; ++ii)
#pragma unroll
            for (int c4 = 0; c4 <= g; ++c4) av[ii][c4] = *(const LAS f32x4*)(Lblk + (4 * g + ii) * ldl + 4 * c4);
#pragma unroll
        for (int ii = 0; ii < 4; ++ii) { const int i = 4 * g + ii; float sacc = x[i];
#pragma unroll
            for (int jj = 0; jj < i; ++jj) sacc -= av[ii][jj >> 2][jj & 3] * x[jj];
            x[i] = sacc; }
    }
#pragma unroll
    for (int i = 1; i < 16; ++i) xcol[i * ldx] = x[i];
}
__device__ __forceinline__ void tri_solve64(const LAS float* L, int ldl, LAS float* X, int ldx, int nct, LAS float* scr, int w, int l15, int q4) {
    LAS float* DI = scr;
    if (w < 4) { LAS float* T = DI + w * 320; LAS float* S = scr + 4 * 320 + w * 320; const LAS float* N = L + 16 * w * ldl + 16 * w;
#pragma unroll
        for (int r = 0; r < 4; ++r) { const int i = 4 * q4 + r; T[i * 20 + l15] = (i == l15 ? 1.0f : 0.0f) - (l15 < i ? N[i * ldl + l15] : 0.0f); }
        { const f32x4 a = tile_mm(N, ldl, 1, N, ldl, 1, 16, (f32x4){0.f, 0.f, 0.f, 0.f}, l15, q4);
#pragma unroll
          for (int r = 0; r < 4; ++r) S[(4 * q4 + r) * 20 + l15] = a[r]; }
        WAVE_SYNC();
#pragma unroll
        for (int it = 0; it < 3; ++it) {
            { const f32x4 a = tile_mm(T, 20, 1, S, 20, 1, 16, (f32x4){0.f, 0.f, 0.f, 0.f}, l15, q4);
#pragma unroll
              for (int r = 0; r < 4; ++r) T[(4 * q4 + r) * 20 + l15] += a[r]; }
            if (it < 2) { const f32x4 a = tile_mm(S, 20, 1, S, 20, 1, 16, (f32x4){0.f, 0.f, 0.f, 0.f}, l15, q4);
#pragma unroll
                for (int r = 0; r < 4; ++r) S[(4 * q4 + r) * 20 + l15] = a[r]; }
            WAVE_SYNC();
        } }
    __syncthreads();
    for (int ct = w; ct < nct; ct += 8) { LAS float* Xc = X + 16 * ct;
#pragma unroll
        for (int rb = 0; rb < 4; ++rb) {
            if (rb > 0) { const f32x4 a = tile_mm(L + 16 * rb * ldl, ldl, 1, Xc, ldx, 1, 16 * rb, (f32x4){0.f, 0.f, 0.f, 0.f}, l15, q4);
#pragma unroll
                for (int r = 0; r < 4; ++r) Xc[(16 * rb + 4 * q4 + r) * ldx + l15] -= a[r];
                WAVE_SYNC(); }
            const f32x4 y = tile_mm(DI + rb * 320, 20, 1, Xc + 16 * rb * ldx, ldx, 1, 16, (f32x4){0.f, 0.f, 0.f, 0.f}, l15, q4);
#pragma unroll
            for (int r = 0; r < 4; ++r) Xc[(16 * rb + 4 * q4 + r) * ldx + l15] = y[r];
            WAVE_SYNC();
        } }
}
__device__ __forceinline__ void phase_rwkv_prep(const Frame& F, const Args& A, int layer) {
    const bf16* P = WSP(bf16, A_P); bf16* RKV = WSP(bf16, R_RKV); bf16* LIN = WSP(bf16, R_LIN); const float* mu = AIN(A, 8) + (size_t)layer * 1824;
    const int lane = F.lane;
    for (int m = F.gw; m < TH; m += F.NGW) {
        const bool first = (m % SEQ) == 0; const bf16* pr = P + (size_t)m * PW + C_RWKV;
#pragma unroll
        for (int j = 0; j < 8; ++j) { const int c = 4 * lane + 256 * j;
            if (c < 1824) { const f32x4 p = ld_bf16x4(pr + c); const f32x4 pv = first ? (f32x4){0.f, 0.f, 0.f, 0.f} : ld_bf16x4(pr - PW + c); const f32x4 muv = *(const f32x4*)(mu + c);
                f32x4 x = p + (pv - p) * muv;
                if (c < 1536) st_bf16x4(RKV + (size_t)m * 1536 + c, x);
                else { if (c < 1600) { x.x = tanhf_(x.x); x.y = tanhf_(x.y); x.z = tanhf_(x.z); x.w = tanhf_(x.w); }
                       else if (c >= 1664) { x.x = sigmoidf_(x.x); x.y = sigmoidf_(x.y); x.z = sigmoidf_(x.z); x.w = sigmoidf_(x.w); }
                       st_bf16x4(LIN + (size_t)m * 384 + (c - 1536), x); } } }
        if (lane < 24) st_bf16x4(LIN + (size_t)m * 384 + 288 + 4 * lane, (f32x4){0.f, 0.f, 0.f, 0.f});
    }
}
__device__ __forceinline__ void phase_rwkv_lora(const Frame& F, const Args& A) {
    pg8::Gemm g{WSP(bf16, R_LIN), WSP(bf16, W_LORA), 384, 384}; pg8::StaticOrder S; S.init(TH, 1536, F.G, (F.bid + F.G / 2) % F.G);
    EpiF32 E{WSP(float, R_LOUT), 1536}; pg8::gemm_phase(F.lds, g, S, E, F.tid);
}
constexpr int RS = 72;
constexpr int RREC_COMMON = 4 * 64 * RS * 2 + 256;
constexpr int RREC_T = 64 * 64 * 2;
constexpr int RREC_BYTES = RREC_COMMON + 3 * RREC_T;
static_assert(RREC_BYTES == 61696, "record size (see R_REC in the workspace map)");
static_assert(RREC_COMMON % 16 == 0, "record alignment");
__device__ __forceinline__ void phase_rwkv_r1(const Frame& F, const Args& A, int layer) {
    const bf16* RKV = WSP(bf16, R_RKV); const float* LOUT = WSP(float, R_LOUT); unsigned char* REC = WSP(unsigned char, R_REC);
    const float* w0 = AIN(A, 9) + layer * 512; const float* a0 = AIN(A, 11) + layer * 512; const float* k_k = AIN(A, 14) + layer * 512; const float* k_a = AIN(A, 15) + layer * 512;
    LAS bf16* kbar = (LAS bf16*)F.lds; LAS bf16* atil = kbar + 64 * RS; LAS bf16* khat = atil + 64 * RS; LAS bf16* rbar = khat + 64 * RS;
    LAS bf16* atT = rbar + 64 * RS; LAS bf16* khT = atT + 64 * RS; LAS bf16* vT = khT + 64 * RS; LAS bf16* Bm = vT + 64 * RS; LAS bf16* Em = Bm + 64 * RS;
    LAS float* Am = (LAS float*)(Em + 64 * RS);
    LAS float* X = Am + 64 * 68;
    LAS float* lam = Am;
    const int w = F.wave;
    const int nunits = BH * 8 * NCH;
    for (int unit = F.bid; unit < nunits; unit += F.G) {
        int tid = F.tid; OPAQUE_V(tid); const int lane = tid & 63, l15 = lane & 15, q4 = lane >> 4;
        const int c = unit % NCH, h = (unit / NCH) & 7, b = unit / (NCH * 8);
        const size_t tok0 = (size_t)b * SEQ + (size_t)c * 64;
        const int j = lane, cj = h * 64 + j;
        __syncthreads();
        float r_[8], km_[8], kk_[8], ka_[8], v_[8], L_[8];
        { const float w0c = w0[cj], a0c = a0[cj], kkc = k_k[cj], kac = k_a[cj]; float run = 0.f;
#pragma unroll
          for (int q = 0; q < 8; ++q) { const int t = 8 * w + q; const size_t tok = tok0 + t;
              const float r = bf2f(RKV[tok * 1536 + cj]), k = bf2f(RKV[tok * 1536 + 512 + cj]); v_[q] = bf2f(RKV[tok * 1536 + 1024 + cj]);
              const float wpre = LOUT[tok * 1536 + cj], apre = LOUT[tok * 1536 + 512 + cj];
              const float wl = -softplusf_(-(w0c + wpre)) - 0.5f, a = sigmoidf_(a0c + apre);
              const float kr = k * kkc, ss = wave_sum(kr * kr), kk = kr * RSQRT(ss + EPS);
              r_[q] = r; km_[q] = k * (1.0f + (a - 1.0f) * kac); kk_[q] = kk; ka_[q] = kk * a;
              run += -expf(wl); L_[q] = run; }
          lam[w * 64 + j] = run; }
        __syncthreads();
        { float base = 0.f, Lend = 0.f;
#pragma unroll
          for (int ww = 0; ww < 8; ++ww) { const float tw = lam[ww * 64 + j]; if (ww < w) base += tw; Lend += tw; }
#pragma unroll
          for (int q = 0; q < 8; ++q) { const int t = 8 * w + q; const float L = base + L_[q], Lm1 = q ? base + L_[q - 1] : base;
              const float eG = expf(L), eGi = expf(-L), eGm1 = expf(Lm1), eT = expf(Lend - L);
              const float kb = kk_[q] * eGm1;
              kbar[t * RS + j] = (bf16)f2bf(kb); X[t * 132 + j] = kb;
              atil[t * RS + j] = (bf16)f2bf(ka_[q] * eGi); khat[t * RS + j] = (bf16)f2bf(km_[q] * eGi); rbar[t * RS + j] = (bf16)f2bf(r_[q] * eG);
              atT[j * RS + t] = (bf16)f2bf(-ka_[q] * eT); khT[j * RS + t] = (bf16)f2bf(km_[q] * eT); vT[j * RS + t] = (bf16)f2bf(v_[q]); }
          if (w == 0) { float* gc = (float*)(REC + (size_t)unit * RREC_BYTES + 4 * 64 * RS * 2); gc[j] = expf(Lend); } }
        __syncthreads();
        unsigned char* rec = REC + (size_t)unit * RREC_BYTES;
        { const int which = w >> 1, tib = 2 * (w & 1);
          const LAS bf16* Aop = (which & 2) ? rbar : kbar; const LAS bf16* Bop = (which & 1) ? khat : atil;
          bf16x8 aF[2][2], bF[4][2];
#pragma unroll
          for (int t = 0; t < 2; ++t)
#pragma unroll
              for (int ks = 0; ks < 2; ++ks) aF[t][ks] = *(const LAS bf16x8*)(Aop + (16 * (tib + t) + l15) * RS + 8 * q4 + 32 * ks);
#pragma unroll
          for (int tj = 0; tj < 4; ++tj)
#pragma unroll
              for (int ks = 0; ks < 2; ++ks) bF[tj][ks] = *(const LAS bf16x8*)(Bop + (16 * tj + l15) * RS + 8 * q4 + 32 * ks);
          f32x4 acc[2][4];
#pragma unroll
          for (int t = 0; t < 2; ++t)
#pragma unroll
              for (int tj = 0; tj < 4; ++tj) { acc[t][tj] = MFMA_BF16(aF[t][0], bF[tj][0], ((f32x4){0.f, 0.f, 0.f, 0.f})); acc[t][tj] = MFMA_BF16(aF[t][1], bF[tj][1], acc[t][tj]); }
#pragma unroll
          for (int t = 0; t < 2; ++t)
#pragma unroll
              for (int tj = 0; tj < 4; ++tj)
#pragma unroll
                  for (int r = 0; r < 4; ++r) { const int i = 16 * (tib + t) + 4 * q4 + r, jj = 16 * tj + l15; const bool keep = (which & 2) ? (jj <= i) : (jj < i); const float v = keep ? acc[t][tj][r] : 0.f;
                      if (which == 0) Am[i * 68 + jj] = v; else if (which == 1) Bm[i * RS + jj] = (bf16)f2bf(v); else if (which == 3) Em[i * RS + jj] = (bf16)f2bf(v);
                      else ((bf16*)(rec + 2 * 64 * RS * 2))[i * RS + jj] = (bf16)f2bf(-v); } }
        __syncthreads();
        { const int tj = w & 3, pb = 6 * (w >> 2);
          bf16x8 bF[2]; f32x4 acc[6];
#pragma unroll
          for (int ks = 0; ks < 2; ++ks) bF[ks] = *(const LAS bf16x8*)(vT + (16 * tj + l15) * RS + 8 * q4 + 32 * ks);
#pragma unroll
          for (int pq = 0; pq < 6; ++pq) { const int pair = pb + pq, which = pair >> 2, ti = pair & 3; const LAS bf16* aop = which == 0 ? Bm : which == 1 ? Em : khT;
              const bf16x8 a0 = *(const LAS bf16x8*)(aop + (16 * ti + l15) * RS + 8 * q4), a1 = *(const LAS bf16x8*)(aop + (16 * ti + l15) * RS + 8 * q4 + 32);
              acc[pq] = MFMA_BF16(a0, bF[0], ((f32x4){0.f, 0.f, 0.f, 0.f})); acc[pq] = MFMA_BF16(a1, bF[1], acc[pq]); }
#pragma unroll
          for (int pq = 0; pq < 6; ++pq) { const int pair = pb + pq, which = pair >> 2, ti = pair & 3;
              if (which == 0) {
#pragma unroll
                  for (int r = 0; r < 4; ++r) X[(16 * ti + 4 * q4 + r) * 132 + 64 + 16 * tj + l15] = acc[pq][r]; }
              else st_bf16x4((bf16*)(rec + RREC_COMMON + which * RREC_T) + (16 * tj + l15) * 64 + 16 * ti + 4 * q4, acc[pq]); } }
        __syncthreads();
        tri_solve64(Am, 68, X, 132, 8, X + 64 * 132, w, l15, q4);
        __syncthreads();
        { const int t = tid >> 3, j0 = 8 * (tid & 7); float v[8];
#pragma unroll
          for (int q = 0; q < 8; ++q) v[q] = X[t * 132 + j0 + q];
          *(u32x4*)((bf16*)rec + t * RS + j0) = pack8(v);
          const int vv = tid >> 3, t0 = 8 * (tid & 7);
#pragma unroll
          for (int q = 0; q < 8; ++q) v[q] = X[(t0 + q) * 132 + 64 + vv];
          *(u32x4*)((bf16*)(rec + RREC_COMMON) + vv * 64 + t0) = pack8(v); }
        for (int e = tid; e < 64 * RS / 8; e += 512) { ((u32x4*)(rec + 64 * RS * 2))[e] = ((const LAS u32x4*)rbar)[e]; ((u32x4*)(rec + 3 * 64 * RS * 2))[e] = ((const LAS u32x4*)atT)[e]; }
    }
    __syncthreads();
}
constexpr int R2_BUF = RREC_COMMON;
__device__ __forceinline__ void phase_rwkv_r2(const Frame& F, const Args& A) {
    const unsigned char* REC = WSP(unsigned char, R_REC); float* RO = WSP(float, R_O);
    LAS unsigned char* buf0 = F.lds; LAS bf16* HT = (LAS bf16*)(F.lds + 2 * R2_BUF); LAS bf16* UT = HT + 2 * 64 * RS;
    const int tid = F.tid, lane = F.lane, w = F.wave, l15 = lane & 15, q4 = lane >> 4, ti = w >> 1;
    const int nunits = BH * 8;
    constexpr int NCHK = R2_BUF / 16;
    for (int unit = F.bid; unit < nunits; unit += F.G) {
        const int h = unit & 7, b = unit >> 3;
        __syncthreads();
        for (int e = tid; e < 2 * 64 * RS / 2; e += 512) ((LAS unsigned*)HT)[e] = 0u;
        f32x4 Hreg[2] = {(f32x4){0.f, 0.f, 0.f, 0.f}, (f32x4){0.f, 0.f, 0.f, 0.f}};
        u32x4 preA[5], preB[5]; u32x2 iniA[3][2], iniB[3][2], cur[3][2];
        const unsigned char* rec0 = REC + (size_t)((b * 8 + h) * NCH) * RREC_BYTES;
        const int tofs = ((16 * (2 * (w & 1)) + l15) * 64 + 16 * ti + 4 * q4) * 2;
#define R2_LOAD(S, recp) do { _Pragma("unroll") for (int q = 0; q < 5; ++q) { const int e = tid + 512 * q; if (e < NCHK) pre##S[q] = *(const u32x4*)((recp) + (size_t)e * 16); } \
            _Pragma("unroll") for (int mq = 0; mq < 3; ++mq) { ini##S[mq][0] = *(const u32x2*)((recp) + RREC_COMMON + mq * RREC_T + tofs); ini##S[mq][1] = *(const u32x2*)((recp) + RREC_COMMON + mq * RREC_T + tofs + 16 * 64 * 2); } } while (0)
#define R2_STORE(S, dst) do { _Pragma("unroll") for (int q = 0; q < 5; ++q) { const int e = tid + 512 * q; if (e < NCHK) *(LAS u32x4*)((dst) + (size_t)e * 16) = pre##S[q]; } } while (0)
#define R2_TAKE(S) do { _Pragma("unroll") for (int mq = 0; mq < 3; ++mq) { cur[mq][0] = ini##S[mq][0]; cur[mq][1] = ini##S[mq][1]; } } while (0)
        R2_LOAD(A, rec0); R2_STORE(A, buf0); R2_TAKE(A);
        if (NCH > 1) R2_LOAD(A, rec0 + (size_t)RREC_BYTES);
        __syncthreads();
#define R2_STEP(c, LS, SS) do { \
            LAS unsigned char* buf = buf0 + ((c) & 1) * R2_BUF; LAS unsigned char* nbuf = buf0 + (((c) + 1) & 1) * R2_BUF; \
            if ((c) + 2 < NCH) R2_LOAD(LS, rec0 + (size_t)((c) + 2) * RREC_BYTES); \
            const LAS bf16* KB = (const LAS bf16*)buf; const LAS bf16* RB = KB + 64 * RS; const LAS bf16* FMn = RB + 64 * RS; const LAS bf16* ATn = FMn + 64 * RS; \
            const LAS float* GC = (const LAS float*)(buf + 4 * 64 * RS * 2); \
            const LAS bf16* H0 = HT + ((c) & 1) * 64 * RS; LAS bf16* H1 = HT + (((c) + 1) & 1) * 64 * RS; \
            _Pragma("unroll") for (int t2 = 0; t2 < 2; ++t2) { const int tj = 2 * (w & 1) + t2; \
                f32x4 u = (f32x4){bf2f(cur[0][t2].x & 0xffffu), bf2f(cur[0][t2].x >> 16), bf2f(cur[0][t2].y & 0xffffu), bf2f(cur[0][t2].y >> 16)}; \
                u = tile_bf(KB + 16 * ti * RS, RS, H0 + 16 * tj * RS, RS, 64, u, l15, q4); \
                u32x2 pk; pk.x = pk2(u[0], u[1]); pk.y = pk2(u[2], u[3]); *(LAS u32x2*)(UT + (16 * tj + l15) * RS + 16 * ti + 4 * q4) = pk; } \
            __syncthreads(); \
            _Pragma("unroll") for (int t2 = 0; t2 < 2; ++t2) { const int tj = 2 * (w & 1) + t2; \
                f32x4 o = (f32x4){bf2f(cur[1][t2].x & 0xffffu), bf2f(cur[1][t2].x >> 16), bf2f(cur[1][t2].y & 0xffffu), bf2f(cur[1][t2].y >> 16)}; \
                o = tile_bf(RB + 16 * ti * RS, RS, H0 + 16 * tj * RS, RS, 64, o, l15, q4); \
                o = tile_bf(FMn + 16 * ti * RS, RS, UT + 16 * tj * RS, RS, 64, o, l15, q4); \
                _Pragma("unroll") for (int r = 0; r < 4; ++r) RO[((size_t)b * SEQ + (size_t)(c) * 64 + 16 * ti + 4 * q4 + r) * 512 + h * 64 + 16 * tj + l15] = o[r]; \
                const f32x4 kv = (f32x4){bf2f(cur[2][t2].x & 0xffffu), bf2f(cur[2][t2].x >> 16), bf2f(cur[2][t2].y & 0xffffu), bf2f(cur[2][t2].y >> 16)}; \
                _Pragma("unroll") for (int r = 0; r < 4; ++r) Hreg[t2][r] = Hreg[t2][r] * GC[16 * ti + 4 * q4 + r] + kv[r]; \
                Hreg[t2] = tile_bf(ATn + 16 * ti * RS, RS, UT + 16 * tj * RS, RS, 64, Hreg[t2], l15, q4); \
                u32x2 pk; pk.x = pk2(Hreg[t2][0], Hreg[t2][1]); pk.y = pk2(Hreg[t2][2], Hreg[t2][3]); *(LAS u32x2*)(H1 + (16 * tj + l15) * RS + 16 * ti + 4 * q4) = pk; } \
            if ((c) + 1 < NCH) { R2_STORE(SS, nbuf); R2_TAKE(SS); } \
            __syncthreads(); } while (0)
        for (int c = 0; c < NCH; c += 2) { R2_STEP(c, B, A); R2_STEP(c + 1, A, B); }
#undef R2_STEP
#undef R2_STORE
#undef R2_TAKE
#undef R2_LOAD
    }
    __syncthreads();
}
__device__ __forceinline__ void phase_rwkv_post(const Frame& F, const Args& A, int layer) {
    const bf16* RKV = WSP(bf16, R_RKV); const float* LOUT = WSP(float, R_LOUT); const float* RO = WSP(float, R_O); bf16* Y = WSP(bf16, A_Y) + (size_t)1 * TH * 512;
    const float* a0 = AIN(A, 11) + layer * 512; const float* k_a = AIN(A, 15) + layer * 512; const float* r_k = AIN(A, 16) + layer * 512; const float* ln_w = AIN(A, 17) + layer * 512; const float* ln_b = AIN(A, 18) + layer * 512;
    const int lane = F.lane, c0 = 8 * lane;
    for (int m = F.gw; m < TH; m += F.NGW) {
        float o[8], r[8], k[8], v[8], ap[8], g[8];
        { const f32x4 a = *(const f32x4*)(RO + (size_t)m * 512 + c0), b2 = *(const f32x4*)(RO + (size_t)m * 512 + c0 + 4); o[0] = a.x; o[1] = a.y; o[2] = a.z; o[3] = a.w; o[4] = b2.x; o[5] = b2.y; o[6] = b2.z; o[7] = b2.w; }
#pragma unroll
        for (int hh = 0; hh < 2; ++hh) { const f32x4 rv = ld_bf16x4(RKV + (size_t)m * 1536 + c0 + 4 * hh), kv = ld_bf16x4(RKV + (size_t)m * 1536 + 512 + c0 + 4 * hh), vv = ld_bf16x4(RKV + (size_t)m * 1536 + 1024 + c0 + 4 * hh);
            const f32x4 av = *(const f32x4*)(LOUT + (size_t)m * 1536 + 512 + c0 + 4 * hh), gv = *(const f32x4*)(LOUT + (size_t)m * 1536 + 1024 + c0 + 4 * hh);
#pragma unroll
            for (int q = 0; q < 4; ++q) { r[4 * hh + q] = rv[q]; k[4 * hh + q] = kv[q]; v[4 * hh + q] = vv[q]; ap[4 * hh + q] = av[q]; g[4 * hh + q] = gv[q]; } }
        float bon = 0.f, sm = 0.f;
#pragma unroll
        for (int q = 0; q < 8; ++q) { const float a = sigmoidf_(a0[c0 + q] + ap[q]); const float km = k[q] * (1.0f + (a - 1.0f) * k_a[c0 + q]); bon += r[q] * km * r_k[c0 + q]; sm += o[q]; }
        bon += __shfl_xor(bon, 1); bon += __shfl_xor(bon, 2); bon += __shfl_xor(bon, 4);
        sm += __shfl_xor(sm, 1); sm += __shfl_xor(sm, 2); sm += __shfl_xor(sm, 4);
        const float mean = sm * (1.0f / 64.0f); float vs = 0.f;
#pragma unroll
        for (int q = 0; q < 8; ++q) { const float d = o[q] - mean; vs += d * d; }
        vs += __shfl_xor(vs, 1); vs += __shfl_xor(vs, 2); vs += __shfl_xor(vs, 4);
        const float rstd = RSQRT(vs * (1.0f / 64.0f) + 64e-5f);
        float y[8];
#pragma unroll
        for (int q = 0; q < 8; ++q) y[q] = ((o[q] - mean) * rstd * ln_w[c0 + q] + ln_b[c0 + q] + bon * v[q]) * g[q];
        u32x4 wv; wv.x = pk2(y[0], y[1]); wv.y = pk2(y[2], y[3]); wv.z = pk2(y[4], y[5]); wv.w = pk2(y[6], y[7]);
        *(u32x4*)(Y + (size_t)m * 512 + c0) = wv;
    }
}

__device__ __forceinline__ void conv8x8(const bf16* src, int tl0  , const float* w  , int wld, const float* bias, float (&out)[8][8]) {
    float x[11][8];
#pragma unroll
    for (int i = 0; i < 11; ++i) { const int tl = tl0 - 3 + i;
        if (tl >= 0) { const u32x4 v = *(const u32x4*)(src + (ptrdiff_t)(i - 3) * PW);
            x[i][0] = bf2f(v.x & 0xffffu); x[i][1] = bf2f(v.x >> 16); x[i][2] = bf2f(v.y & 0xffffu); x[i][3] = bf2f(v.y >> 16); x[i][4] = bf2f(v.z & 0xffffu); x[i][5] = bf2f(v.z >> 16); x[i][6] = bf2f(v.w & 0xffffu); x[i][7] = bf2f(v.w >> 16); }
        else {
#pragma unroll
            for (int ch = 0; ch < 8; ++ch) x[i][ch] = 0.f; } }
    float wv[4][8], bv[8];
#pragma unroll
    for (int j = 0; j < 4; ++j) { const f32x4 a = *(const f32x4*)(w + j * wld), b = *(const f32x4*)(w + j * wld + 4); wv[j][0] = a.x; wv[j][1] = a.y; wv[j][2] = a.z; wv[j][3] = a.w; wv[j][4] = b.x; wv[j][5] = b.y; wv[j][6] = b.z; wv[j][7] = b.w; }
    if (bias) { const f32x4 a = *(const f32x4*)bias, b = *(const f32x4*)(bias + 4); bv[0] = a.x; bv[1] = a.y; bv[2] = a.z; bv[3] = a.w; bv[4] = b.x; bv[5] = b.y; bv[6] = b.z; bv[7] = b.w; }
    else {
#pragma unroll
        for (int ch = 0; ch < 8; ++ch) bv[ch] = 0.f; }
#pragma unroll
    for (int i = 0; i < 8; ++i)
#pragma unroll
        for (int ch = 0; ch < 8; ++ch) { const float a = bv[ch] + wv[0][ch] * x[i][ch] + wv[1][ch] * x[i + 1][ch] + wv[2][ch] * x[i + 2][ch] + wv[3][ch] * x[i + 3][ch]; out[i][ch] = a * fast_rcp(1.0f + fast_exp(-a)); }
}
constexpr int SB = 136;
constexpr int SC_IMG = 64 * SB * 2;
__device__ __forceinline__ void phase_ssd_s1(const Frame& F, const Args& A, int layer) {
    const bf16* P = WSP(bf16, A_P); bf16* ST = WSP(bf16, S_ST); float* YD = WSP(float, S_YD); unsigned char* SCB = WSP(unsigned char, S_C); float* AC = WSP(float, S_AC);
    const float* cw = AIN(A, 23) + (size_t)layer * 4 * 1024; const float* cb = AIN(A, 24) + layer * 1024; const float* dtb = AIN(A, 25) + layer * 8; const float* a_log = AIN(A, 26) + layer * 8; const float* dsk = AIN(A, 27) + layer * 8;
    LAS bf16* Bt_ = (LAS bf16*)F.lds; LAS bf16* Ct_ = Bt_ + 64 * SB; LAS bf16* BT = Ct_ + 64 * SB; LAS bf16* xT = BT + 128 * RS;
    LAS bf16* Mb = xT + 4 * 64 * RS; LAS bf16* xdT = Mb + 2 * 64 * RS; LAS float* dt = (LAS float*)(xdT + 2 * 64 * RS); LAS float* ac = dt + 256;
    const int tid = F.tid, lane = F.lane, w = F.wave, l15 = lane & 15, q4 = lane >> 4;
    const int nunits = BH * NCH * 2;
    for (int unit = F.bid; unit < nunits; unit += F.G) {
        const int g = unit & 1, c = (unit >> 1) % NCH, b = unit / (2 * NCH);
        const size_t tok0 = (size_t)b * SEQ + (size_t)c * 64;
        __syncthreads();
        {
            const int cg = tid & 63, rb = tid >> 6;
            const int cidx = cg < 32 ? g * 256 + 8 * cg : cg < 48 ? 512 + g * 128 + 8 * (cg - 32) : 768 + g * 128 + 8 * (cg - 48);
            float o[8][8];
            conv8x8(P + (tok0 + 8 * rb) * PW + C_SSD + 512 + cidx, c * 64 + 8 * rb, cw + cidx, 1024, cb + cidx, o);
            if (cg < 32) {
                const int hh = cg >> 3, p0 = 8 * (cg & 7);
#pragma unroll
                for (int ch = 0; ch < 8; ++ch) { float col[8];
#pragma unroll
                    for (int i = 0; i < 8; ++i) col[i] = o[i][ch];
                    *(LAS u32x4*)(xT + (hh * 64 + p0 + ch) * RS + 8 * rb) = pack8(col); }
            } else if (cg < 48) {
                const int n0 = 8 * (cg - 32);
#pragma unroll
                for (int i = 0; i < 8; ++i) *(LAS u32x4*)(Bt_ + (8 * rb + i) * SB + n0) = pack8(o[i]);
#pragma unroll
                for (int ch = 0; ch < 8; ++ch) { float col[8];
#pragma unroll
                    for (int i = 0; i < 8; ++i) col[i] = o[i][ch];
                    *(LAS u32x4*)(BT + (n0 + ch) * RS + 8 * rb) = pack8(col); }
            } else { const int n0 = 8 * (cg - 48);
#pragma unroll
                for (int i = 0; i < 8; ++i) *(LAS u32x4*)(Ct_ + (8 * rb + i) * SB + n0) = pack8(o[i]); }
        }
        if (tid < 256) { const int hh = tid >> 6, h = 4 * g + hh; const float d = softplusf_(bf2f(P[(tok0 + lane) * PW + C_SSD + 1536 + h]) + dtb[h]); float a = -expf(a_log[h]) * d;
#pragma unroll
            for (int o = 1; o < 64; o <<= 1) { const float t = __shfl_up(a, o); if (lane >= o) a += t; }
            dt[tid] = d; ac[tid] = a; AC[(tok0 + lane) * 8 + h] = a; }
        __syncthreads();
        { unsigned char* dst = SCB + (size_t)unit * SC_IMG; for (int e = tid; e < SC_IMG / 16; e += 512) ((u32x4*)dst)[e] = ((const LAS u32x4*)Ct_)[e]; }
        f32x4 cbt[2];
#pragma unroll
        for (int tt = 0; tt < 2; ++tt) { const int tile = w * 2 + tt, ti = tile >> 2, tj = tile & 3; cbt[tt] = (f32x4){0.f, 0.f, 0.f, 0.f};
            if (tj <= ti) cbt[tt] = tile_bf(Ct_ + 16 * ti * SB, SB, Bt_ + 16 * tj * SB, SB, 128, cbt[tt], l15, q4); }
        for (int hh = 0; hh < 4; ++hh) { const int h = 4 * g + hh; LAS bf16* M = Mb + (hh & 1) * 64 * RS; LAS bf16* xd = xdT + (hh & 1) * 64 * RS; const LAS float* dth = dt + hh * 64; const LAS float* ach = ac + hh * 64;
#pragma unroll
            for (int tt = 0; tt < 2; ++tt) { const int tile = w * 2 + tt, ti = tile >> 2, tj = tile & 3;
#pragma unroll
                for (int r = 0; r < 4; ++r) { const int l = 16 * ti + 4 * q4 + r, s = 16 * tj + l15; M[l * RS + s] = (bf16)f2bf((s <= l) ? cbt[tt][r] * expf(ach[l] - ach[s]) * dth[s] : 0.f); } }
            { const int p = tid >> 3, l0 = 8 * (tid & 7); const u32x4 v = *(const LAS u32x4*)(xT + (hh * 64 + p) * RS + l0); const float a63 = ach[63]; float xv[8] = {bf2f(v.x & 0xffffu), bf2f(v.x >> 16), bf2f(v.y & 0xffffu), bf2f(v.y >> 16), bf2f(v.z & 0xffffu), bf2f(v.z >> 16), bf2f(v.w & 0xffffu), bf2f(v.w >> 16)};
#pragma unroll
              for (int i = 0; i < 8; ++i) xv[i] *= dth[l0 + i] * expf(a63 - ach[l0 + i]);
              *(LAS u32x4*)(xd + p * RS + l0) = pack8(xv); }
            __syncthreads();
#pragma unroll
            for (int tt = 0; tt < 2; ++tt) { const int tile = w * 2 + tt, ti = tile >> 2, tj = tile & 3;
                const f32x4 acc = tile_bf(M + 16 * ti * RS, RS, xT + (hh * 64 + 16 * tj) * RS, RS, 64, (f32x4){0.f, 0.f, 0.f, 0.f}, l15, q4);
                const f32x4 xs = ld_bf16x4((const bf16*)(xT + (hh * 64 + 16 * tj + l15) * RS + 16 * ti + 4 * q4));
#pragma unroll
                for (int r = 0; r < 4; ++r) YD[(tok0 + 16 * ti + 4 * q4 + r) * 512 + h * 64 + 16 * tj + l15] = acc[r] + dsk[h] * xs[r]; }
            bf16* st = ST + ((size_t)((b * NCH + c) * 8 + h)) * 64 * 128;
#pragma unroll
            for (int tt = 0; tt < 4; ++tt) { const int tile = w * 4 + tt, ti = tile >> 2, tj = tile & 3;
                const f32x4 acc = tile_bf(BT + 16 * ti * RS, RS, xd + 16 * tj * RS, RS, 64, (f32x4){0.f, 0.f, 0.f, 0.f}, l15, q4);
                st_bf16x4(st + (16 * tj + l15) * 128 + 16 * ti + 4 * q4, acc); }
        }
    }
    __syncthreads();
}
__device__ __forceinline__ void phase_ssd_s23(const Frame& F, const Args& A) {
    const bf16* ST = WSP(bf16, S_ST); float* YO = WSP(float, S_YO); const unsigned char* SCB = WSP(unsigned char, S_C); const float* AC = WSP(float, S_AC);
    LAS bf16* Cimg = (LAS bf16*)F.lds; LAS bf16* Hb = Cimg + 2 * 64 * SB;
    const int tid = F.tid, lane = F.lane, w = F.wave, l15 = lane & 15, q4 = lane >> 4;
    const int nunits = BH * 8 * 4, hp = tid >> 5, hn = 4 * (tid & 31);
    constexpr int NCK = SC_IMG / 16;
    for (int unit = F.bid; unit < nunits; unit += F.G) {
        const int ps = unit & 3, h = (unit >> 2) & 7, b = unit >> 5, g = h >> 2;
        __syncthreads();
        f32x4 Hr = (f32x4){0.f, 0.f, 0.f, 0.f};
        u32x4 preA[3], preB[3]; u32x2 pstA, pstB, stc; float eaA[5], eaB[5], eac[5];
        const size_t tokb = (size_t)b * SEQ;
#define S23_LOAD(S, cc) do { const unsigned char* src_ = SCB + (size_t)((b * NCH + (cc)) * 2 + g) * SC_IMG; \
            _Pragma("unroll") for (int q = 0; q < 3; ++q) { const int e = tid + 512 * q; if (e < NCK) pre##S[q] = *(const u32x4*)(src_ + (size_t)e * 16); } \
            pst##S = *(const u32x2*)(ST + ((size_t)((b * NCH + (cc)) * 8 + h)) * 8192 + (16 * ps + hp) * 128 + hn); \
            _Pragma("unroll") for (int r = 0; r < 4; ++r) ea##S[r] = AC[(tokb + (size_t)(cc) * 64 + 16 * (w & 3) + 4 * q4 + r) * 8 + h]; \
            ea##S[4] = AC[(tokb + (size_t)(cc) * 64 + 63) * 8 + h]; } while (0)
#define S23_STORE(S, dst) do { _Pragma("unroll") for (int q = 0; q < 3; ++q) { const int e = tid + 512 * q; if (e < NCK) ((LAS u32x4*)(dst))[e] = pre##S[q]; } } while (0)
#define S23_TAKE(S) do { stc = pst##S; _Pragma("unroll") for (int r = 0; r < 5; ++r) eac[r] = ea##S[r]; } while (0)
        S23_LOAD(A, 0); S23_STORE(A, Cimg); S23_TAKE(A);
        if (NCH > 1) S23_LOAD(A, 1);
#define S23_STEP(c, LS, SS) do { \
            const size_t tok0 = tokb + (size_t)(c) * 64; \
            if ((c) + 2 < NCH) S23_LOAD(LS, (c) + 2); \
            st_bf16x4((bf16*)(Hb + hp * SB + hn), Hr); \
            __syncthreads(); \
            if (w < 4) { const LAS bf16* Ci = Cimg + ((c) & 1) * 64 * SB; \
                const f32x4 acc = tile_bf(Ci + 16 * w * SB, SB, Hb, SB, 128, (f32x4){0.f, 0.f, 0.f, 0.f}, l15, q4); \
                _Pragma("unroll") for (int r = 0; r < 4; ++r) { const size_t tok = tok0 + 16 * w + 4 * q4 + r; YO[tok * 512 + h * 64 + 16 * ps + l15] = acc[r] * expf(eac[r]); } } \
            { const float dec = expf(eac[4]); Hr.x = dec * Hr.x + bf2f(stc.x & 0xffffu); Hr.y = dec * Hr.y + bf2f(stc.x >> 16); Hr.z = dec * Hr.z + bf2f(stc.y & 0xffffu); Hr.w = dec * Hr.w + bf2f(stc.y >> 16); } \
            if ((c) + 1 < NCH) { S23_STORE(SS, Cimg + (((c) + 1) & 1) * 64 * SB); S23_TAKE(SS); } \
            __syncthreads(); } while (0)
        for (int c = 0; c < NCH; c += 2) { S23_STEP(c, B, A); S23_STEP(c + 1, A, B); }
#undef S23_STEP
#undef S23_TAKE
#undef S23_STORE
#undef S23_LOAD
    }
    __syncthreads();
}
__device__ __forceinline__ void phase_ssd_s4(const Frame& F, const Args& A, int layer) {
    const float* YD = WSP(float, S_YD); const float* YO = WSP(float, S_YO); const bf16* P = WSP(bf16, A_P); bf16* Y = WSP(bf16, A_Y) + (size_t)3 * TH * 512; const float* nw = AIN(A, 28) + layer * 512;
    const int lane = F.lane, c0 = 8 * lane;
    for (int m = F.gw; m < TH; m += F.NGW) {
        const f32x4 a = *(const f32x4*)(YD + (size_t)m * 512 + c0) + *(const f32x4*)(YO + (size_t)m * 512 + c0), b2 = *(const f32x4*)(YD + (size_t)m * 512 + c0 + 4) + *(const f32x4*)(YO + (size_t)m * 512 + c0 + 4);
        const f32x4 z0 = ld_bf16x4(P + (size_t)m * PW + C_SSD + c0), z1 = ld_bf16x4(P + (size_t)m * PW + C_SSD + c0 + 4);
        float y[8] = {a.x * siluf_(z0.x), a.y * siluf_(z0.y), a.z * siluf_(z0.z), a.w * siluf_(z0.w), b2.x * siluf_(z1.x), b2.y * siluf_(z1.y), b2.z * siluf_(z1.z), b2.w * siluf_(z1.w)};
        float ss = 0.f;
#pragma unroll
        for (int q = 0; q < 8; ++q) ss += y[q] * y[q];
        ss += __shfl_xor(ss, 1); ss += __shfl_xor(ss, 2); ss += __shfl_xor(ss, 4); ss += __shfl_xor(ss, 8); ss += __shfl_xor(ss, 16);
        const float rstd = RSQRT(ss * (1.0f / 256.0f) + EPS);
#pragma unroll
        for (int q = 0; q < 8; ++q) y[q] = y[q] * rstd * nw[c0 + q];
        u32x4 wv; wv.x = pk2(y[0], y[1]); wv.y = pk2(y[2], y[3]); wv.z = pk2(y[4], y[5]); wv.w = pk2(y[6], y[7]);
        *(u32x4*)(Y + (size_t)m * 512 + c0) = wv;
    }
}

__device__ __forceinline__ f32x4 tile_mm(const LAS float* a, int lda, int ska, const LAS float* b, int ldb, int scb, int K, f32x4 acc, int l15, int q4) {
    const LAS float* ap = a + l15 * lda + q4 * ska; const LAS float* bp = b + q4 * ldb + l15 * scb;
#pragma unroll 8
    for (int ks = 0; ks < K / 4; ++ks) acc = MFMA_F32(ap[ks * 4 * ska], bp[ks * 4 * ldb], acc);
    return acc;
}
constexpr int GS = 132, GS2 = 68;
constexpr int GR_W = 0, GR_QH = 64 * 136 * 2, GR_KT = 2 * 64 * 136 * 2, GR_QK = GR_KT + 128 * 72 * 2, GR_GL = GR_QK + 64 * 72 * 2, GR_COMMON = GR_GL + 16, GR_UT = 128 * 64 * 2, GR_BYTES = GR_COMMON + GR_UT;
static_assert(GR_BYTES == 78864 && GR_COMMON % 16 == 0, "GDN record");
constexpr int GX = 264;
__device__ __forceinline__ void phase_gdn_g1(const Frame& F, const Args& A, int layer) {
    const bf16* P = WSP(bf16, A_P); unsigned char* CHR = WSP(unsigned char, G_CH);
    const float* convw = AIN(A, 19) + (size_t)layer * 4 * 1536; const float* a_log = AIN(A, 20) + layer * 4; const float* dtb = AIN(A, 21) + layer * 4;
    LAS bf16* qb = (LAS bf16*)F.lds; LAS bf16* kb = qb + 64 * SB; LAS bf16* qkimg = kb + 64 * SB;
    LAS float* X = (LAS float*)(qkimg + 64 * RS); LAS float* Lm = X + 64 * GX; LAS float* ssq = Lm + 64 * GS2;
    LAS float* beta = ssq + 2 * 64 * 16; LAS float* gc = beta + 64; LAS float* egc = gc + 64; LAS float* inorm = egc + 64;
    const int w = F.wave;
    const int nunits = BH * 4 * NCH;
    for (int unit = F.bid; unit < nunits; unit += F.G) {
        int tid = F.tid; OPAQUE_V(tid); const int lane = tid & 63, l15 = lane & 15, q4 = lane >> 4;
        const int c = unit % NCH, h = (unit / NCH) & 3, b = unit / (NCH * 4);
        const size_t tok0 = (size_t)b * SEQ + (size_t)c * 64;
        unsigned char* rec = CHR + (size_t)unit * GR_BYTES;
        __syncthreads();
        const int rb = tid / 48, pc = tid % 48, part = pc >> 4, cgl = pc & 15;
        float o[8][8];
        if (tid < 384) { const int col = part * 512 + h * 128 + 8 * cgl;
            conv8x8(P + (tok0 + 8 * rb) * PW + C_GDN + col, c * 64 + 8 * rb, convw + col, 1536, nullptr, o);
            if (part < 2) {
#pragma unroll
                for (int i = 0; i < 8; ++i) { float sacc = 0.f;
#pragma unroll
                    for (int ch = 0; ch < 8; ++ch) sacc += o[i][ch] * o[i][ch];
                    ssq[(part * 64 + 8 * rb + i) * 16 + cgl] = sacc; } } }
        if (w == 7) { const size_t tok = tok0 + lane; beta[lane] = sigmoidf_(bf2f(P[tok * PW + C_GDN + 1536 + h]));
            float g = -expf(a_log[h]) * softplusf_(bf2f(P[tok * PW + C_GDN + 1540 + h]) + dtb[h]);
#pragma unroll
            for (int o2 = 1; o2 < 64; o2 <<= 1) { const float t = __shfl_up(g, o2); if (lane >= o2) g += t; }
            gc[lane] = g; egc[lane] = expf(g); }
        __syncthreads();
        if (tid < 128) { float sacc = 0.f;
#pragma unroll
            for (int i = 0; i < 16; ++i) sacc += ssq[tid * 16 + i];
            inorm[tid] = (tid < 64 ? 0.08838834764831845f : 1.0f) * RSQRT(sacc + EPS); }
        __syncthreads();
        if (tid < 384) {
#pragma unroll
            for (int i = 0; i < 8; ++i) { const int l = 8 * rb + i;
                if (part < 2) { const float sc = inorm[part * 64 + l]; float v[8];
#pragma unroll
                    for (int ch = 0; ch < 8; ++ch) v[ch] = o[i][ch] * sc;
                    *(LAS u32x4*)((part ? kb : qb) + l * SB + 8 * cgl) = pack8(v); }
                else { const float bl = beta[l]; *(LAS f32x4*)(X + l * GX + 8 * cgl) = (f32x4){o[i][0] * bl, o[i][1] * bl, o[i][2] * bl, o[i][3] * bl}; *(LAS f32x4*)(X + l * GX + 8 * cgl + 4) = (f32x4){o[i][4] * bl, o[i][5] * bl, o[i][6] * bl, o[i][7] * bl}; } } }
        __syncthreads();
        for (int tt = 0; tt < 4; ++tt) { const int tile = w * 4 + tt, which = tile >> 4, ti = (tile >> 2) & 3, tj = tile & 3;
            f32x4 acc = (f32x4){0.f, 0.f, 0.f, 0.f};
            if (tj <= ti) acc = tile_bf((which ? qb : kb) + 16 * ti * SB, SB, kb + 16 * tj * SB, SB, 128, acc, l15, q4);
#pragma unroll
            for (int r = 0; r < 4; ++r) { const int i = 16 * ti + 4 * q4 + r, j = 16 * tj + l15; float v = 0.f;
                if (which ? (j <= i) : (j < i)) v = acc[r] * expf(gc[i] - gc[j]) * (which ? 1.0f : beta[i]);
                if (which) qkimg[i * RS + j] = (bf16)f2bf(v); else Lm[i * GS2 + j] = v; } }
        { const float glast = gc[63];
          for (int e = tid; e < 64 * 16; e += 512) { const int l = e >> 4, d0 = 8 * (e & 15); const u32x4 kv = *(const LAS u32x4*)(kb + l * SB + d0), qv = *(const LAS u32x4*)(qb + l * SB + d0);
              const float kf[8] = {bf2f(kv.x & 0xffffu), bf2f(kv.x >> 16), bf2f(kv.y & 0xffffu), bf2f(kv.y >> 16), bf2f(kv.z & 0xffffu), bf2f(kv.z >> 16), bf2f(kv.w & 0xffffu), bf2f(kv.w >> 16)};
              float qf[8] = {bf2f(qv.x & 0xffffu), bf2f(qv.x >> 16), bf2f(qv.y & 0xffffu), bf2f(qv.y >> 16), bf2f(qv.z & 0xffffu), bf2f(qv.z >> 16), bf2f(qv.w & 0xffffu), bf2f(qv.w >> 16)};
              const float sc = beta[l] * egc[l], eg = egc[l];
              *(LAS f32x4*)(X + l * GX + 128 + d0) = (f32x4){kf[0] * sc, kf[1] * sc, kf[2] * sc, kf[3] * sc}; *(LAS f32x4*)(X + l * GX + 132 + d0) = (f32x4){kf[4] * sc, kf[5] * sc, kf[6] * sc, kf[7] * sc};
#pragma unroll
              for (int q = 0; q < 8; ++q) qf[q] *= eg;
              *(u32x4*)(rec + GR_QH + (size_t)(l * SB + d0) * 2) = pack8(qf); }
          for (int e = tid; e < 128 * 8; e += 512) { const int d = e >> 3, l0 = 8 * (e & 7); float kt[8];
#pragma unroll
              for (int q = 0; q < 8; ++q) kt[q] = bf2f(kb[(l0 + q) * SB + d]) * expf(glast - gc[l0 + q]);
              *(u32x4*)(rec + GR_KT + (size_t)(d * RS + l0) * 2) = pack8(kt); }
          if (tid == 0) *(float*)(rec + GR_GL) = expf(glast); }
        __syncthreads();
        for (int e = tid; e < 64 * RS / 8; e += 512) ((u32x4*)(rec + GR_QK))[e] = ((const LAS u32x4*)qkimg)[e];
        tri_solve64(Lm, GS2, X, GX, 16, ssq, w, l15, q4);
        __syncthreads();
        for (int e = tid; e < 64 * 16; e += 512) { const int l = e >> 4, d0 = 8 * (e & 15); const f32x4 a = *(const LAS f32x4*)(X + l * GX + 128 + d0), b2 = *(const LAS f32x4*)(X + l * GX + 132 + d0);
            const float v[8] = {a.x, a.y, a.z, a.w, b2.x, b2.y, b2.z, b2.w}; *(u32x4*)(rec + GR_W + (size_t)(l * SB + d0) * 2) = pack8(v); }
        for (int e = tid; e < 128 * 8; e += 512) { const int vv = e >> 3, t0 = 8 * (e & 7); float v[8];
#pragma unroll
            for (int q = 0; q < 8; ++q) v[q] = X[(t0 + q) * GX + vv];
            *(u32x4*)((bf16*)(rec + GR_COMMON) + vv * 64 + t0) = pack8(v); }
    }
    __syncthreads();
}
constexpr int G2_STAGE = GR_COMMON;
__device__ __forceinline__ void phase_gdn_g2(const Frame& F, const Args& A) {
    const unsigned char* CHR = WSP(unsigned char, G_CH); float* GO = WSP(float, G_O);
    LAS unsigned char* buf0 = F.lds; LAS bf16* STt = (LAS bf16*)(F.lds + 2 * G2_STAGE); LAS bf16* vnT = STt + 2 * 32 * SB;
    const int tid = F.tid, lane = F.lane, w = F.wave, l15 = lane & 15, q4 = lane >> 4, ti = w >> 1, tj = w & 1;
    const int nunits = BH * 4 * 4;
    constexpr int NCK = G2_STAGE / 16;
    for (int unit = F.bid; unit < nunits; unit += F.G) {
        const int vs = unit & 3, h = (unit >> 2) & 3, b = unit >> 4;
        __syncthreads();
        for (int e = tid; e < 2 * 32 * SB / 2; e += 512) ((LAS unsigned*)STt)[e] = 0u;
        f32x4 Sreg[2] = {(f32x4){0.f, 0.f, 0.f, 0.f}, (f32x4){0.f, 0.f, 0.f, 0.f}};
        u32x4 preA[8], preB[8]; u32x2 uiniA, uiniB, ucur;
        const unsigned char* rec0 = CHR + (size_t)((b * 4 + h) * NCH) * GR_BYTES;
        const int uofs = GR_COMMON + ((32 * vs + 16 * tj + l15) * 64 + 16 * ti + 4 * q4) * 2;
#define G2_LOAD(S, recp) do { _Pragma("unroll") for (int q = 0; q < 8; ++q) { const int e = tid + 512 * q; if (e < NCK) pre##S[q] = *(const u32x4*)((recp) + (size_t)e * 16); } uini##S = *(const u32x2*)((recp) + uofs); } while (0)
#define G2_STORE(S, dst) do { _Pragma("unroll") for (int q = 0; q < 8; ++q) { const int e = tid + 512 * q; if (e < NCK) *(LAS u32x4*)((dst) + (size_t)e * 16) = pre##S[q]; } } while (0)
        G2_LOAD(A, rec0); G2_STORE(A, buf0); ucur = uiniA;
        if (NCH > 1) G2_LOAD(A, rec0 + (size_t)GR_BYTES);
        __syncthreads();
#define G2_STEP(c, LS, SS) do { \
            LAS unsigned char* buf = buf0 + ((c) & 1) * G2_STAGE; LAS unsigned char* nbuf = buf0 + (((c) + 1) & 1) * G2_STAGE; \
            if ((c) + 2 < NCH) G2_LOAD(LS, rec0 + (size_t)((c) + 2) * GR_BYTES); \
            const LAS bf16* Wi = (const LAS bf16*)(buf + GR_W); const LAS bf16* QH = (const LAS bf16*)(buf + GR_QH); const LAS bf16* KT = (const LAS bf16*)(buf + GR_KT); const LAS bf16* QK = (const LAS bf16*)(buf + GR_QK); \
            const float egl = *(const LAS float*)(buf + GR_GL); \
            const LAS bf16* S0 = STt + ((c) & 1) * 32 * SB; LAS bf16* S1 = STt + (((c) + 1) & 1) * 32 * SB; \
            { const f32x4 acc = tile_bf(Wi + 16 * ti * SB, SB, S0 + 16 * tj * SB, SB, 128, (f32x4){0.f, 0.f, 0.f, 0.f}, l15, q4); \
              const f32x4 vn = (f32x4){bf2f(ucur.x & 0xffffu), bf2f(ucur.x >> 16), bf2f(ucur.y & 0xffffu), bf2f(ucur.y >> 16)} - acc; \
              u32x2 pk; pk.x = pk2(vn[0], vn[1]); pk.y = pk2(vn[2], vn[3]); *(LAS u32x2*)(vnT + (16 * tj + l15) * RS + 16 * ti + 4 * q4) = pk; } \
            __syncthreads(); \
            { f32x4 acc = tile_bf(QH + 16 * ti * SB, SB, S0 + 16 * tj * SB, SB, 128, (f32x4){0.f, 0.f, 0.f, 0.f}, l15, q4); \
              acc = tile_bf(QK + 16 * ti * RS, RS, vnT + 16 * tj * RS, RS, 64, acc, l15, q4); \
              _Pragma("unroll") for (int r = 0; r < 4; ++r) GO[((size_t)b * SEQ + (size_t)(c) * 64 + 16 * ti + 4 * q4 + r) * 512 + h * 128 + 32 * vs + 16 * tj + l15] = acc[r]; } \
            _Pragma("unroll") for (int t2 = 0; t2 < 2; ++t2) { Sreg[t2] = Sreg[t2] * egl; \
                Sreg[t2] = tile_bf(KT + 16 * w * RS, RS, vnT + 16 * t2 * RS, RS, 64, Sreg[t2], l15, q4); \
                u32x2 pk; pk.x = pk2(Sreg[t2][0], Sreg[t2][1]); pk.y = pk2(Sreg[t2][2], Sreg[t2][3]); *(LAS u32x2*)(S1 + (16 * t2 + l15) * SB + 16 * w + 4 * q4) = pk; } \
            if ((c) + 1 < NCH) { G2_STORE(SS, nbuf); ucur = uini##SS; } \
            __syncthreads(); } while (0)
        for (int c = 0; c < NCH; c += 2) { G2_STEP(c, B, A); G2_STEP(c + 1, A, B); }
#undef G2_STEP
#undef G2_STORE
#undef G2_LOAD
    }
    __syncthreads();
}
__device__ __forceinline__ void phase_gdn_g3(const Frame& F, const Args& A, int layer) {
    const float* GO = WSP(float, G_O); const bf16* P = WSP(bf16, A_P); bf16* Y = WSP(bf16, A_Y) + (size_t)2 * TH * 512; const float* nw = AIN(A, 22) + layer * 128;
    const int lane = F.lane, c0 = 8 * lane;
    for (int m = F.gw; m < TH; m += F.NGW) {
        const f32x4 a = *(const f32x4*)(GO + (size_t)m * 512 + c0), b2 = *(const f32x4*)(GO + (size_t)m * 512 + c0 + 4);
        float o[8] = {a.x, a.y, a.z, a.w, b2.x, b2.y, b2.z, b2.w}; float ss = 0.f;
#pragma unroll
        for (int q = 0; q < 8; ++q) ss += o[q] * o[q];
        ss += __shfl_xor(ss, 1); ss += __shfl_xor(ss, 2); ss += __shfl_xor(ss, 4); ss += __shfl_xor(ss, 8);
        const float rstd = RSQRT(ss * (1.0f / 128.0f) + EPS);
        const f32x4 z0 = ld_bf16x4(P + (size_t)m * PW + C_GDN + 1544 + c0), z1 = ld_bf16x4(P + (size_t)m * PW + C_GDN + 1544 + c0 + 4);
        const float z[8] = {z0.x, z0.y, z0.z, z0.w, z1.x, z1.y, z1.z, z1.w}; float y[8];
#pragma unroll
        for (int q = 0; q < 8; ++q) y[q] = o[q] * rstd * nw[(c0 + q) & 127] * siluf_(z[q]);
        u32x4 wv; wv.x = pk2(y[0], y[1]); wv.y = pk2(y[2], y[3]); wv.z = pk2(y[4], y[5]); wv.w = pk2(y[6], y[7]);
        *(u32x4*)(Y + (size_t)m * 512 + c0) = wv;
    }
}

__device__ __forceinline__ void phase_merge_z(const Frame& F, const Args& A) {
    pg8::Gemm g{WSP(bf16, A_Y), WSP(bf16, W_BR), 512, 512}; BranchOrder S; S.nP = TH / 256; S.G = F.G; S.c = F.bid;
    EpiZ E{WSP(bf16, A_Z)}; pg8::gemm_phase(F.lds, g, S, E, F.tid);
}
__device__ __forceinline__ void phase_merge_gate(const Frame& F, const Args& A, int layer) {
    pg8::Gemm g{WSP(bf16, A_H), WSP(bf16, W_GATE), D, D}; pg8::StaticOrder S; S.init(TH, 4096, F.G, F.bid);
    EpiMerge E{WSP(bf16, A_Z), AIN(A, 29) + (size_t)layer * 4 * D, WSP(bf16, A_MG)}; pg8::gemm_phase(F.lds, g, S, E, F.tid);
#if 1
    if (((REPEAT_MASK) >> 28) & 1u) { __syncthreads(); EpiBf16 E2{WSP(bf16, A_MIX + (size_t)64 * MiB), 4096, nullptr, 0}; pg8::gemm_phase(F.lds, g, S, E2, F.tid); }
#endif
}
__device__ __forceinline__ void phase_merge_out(const Frame& F, const Args& A, const float* xin, float* xout) {
    pg8::Gemm g{WSP(bf16, A_MG), WSP(bf16, W_OUT), D, D}; pg8::StaticOrder S; S.init(TH, D, F.G, F.bid);
    EpiResidual E{xin, xout}; pg8::gemm_phase(F.lds, g, S, E, F.tid);
}
__device__ __forceinline__ void phase_ffn_gu(const Frame& F, const Args& A) {
    pg8::Gemm g{WSP(bf16, A_H), WSP(bf16, W_FGU), D, D}; pg8::StaticOrder S; S.init(TH, 2 * FF_D, F.G, F.bid);
    EpiSwiGLU E{WSP(bf16, F_ACT), FF_D, 1 << 20}; pg8::gemm_phase(F.lds, g, S, E, F.tid);
}
__device__ __forceinline__ void phase_ffn_down(const Frame& F, const Args& A, float* x) {
    pg8::Gemm g{WSP(bf16, F_ACT), WSP(bf16, W_FDN), FF_D, FF_D}; pg8::StaticOrder S; S.init(TH, D, F.G, F.bid);
    EpiResidual E{x, x}; pg8::gemm_phase(F.lds, g, S, E, F.tid);
}
struct MoeLayout { int pstart[NEXP + 1]; };
__device__ __forceinline__ MoeLayout moe_layout(const unsigned* cnt) {
    MoeLayout L; int s = 0;
#pragma unroll
    for (int e = 0; e < NEXP; ++e) { L.pstart[e] = s; s += ((int)cnt[e] + 255) & ~255; }
    L.pstart[NEXP] = s; return L;
}
struct MoeOrder {
    int np, nN, G, c; MoeLayout L;
    __device__ bool next(int i, Unit& u) const {
        const long Lx = (long)i * G + c; if (Lx >= (long)np * nN) return false;
        const int pm = (int)(Lx / nN), pn = (int)(Lx % nN); int e = 0;
#pragma unroll
        for (int k = 1; k < NEXP; ++k) if (pm * 256 >= L.pstart[k]) e = k;
        u.pm = pm; u.pn = e * nN + pn; return true;
    }
    __device__ __forceinline__ void a_ready(const Unit&) const {}
    __device__ __forceinline__ void done(const Unit&) const {}
};
__device__ __forceinline__ void phase_moe_route(const Frame& F, const Args& A, int half) {
    const unsigned* wgc = (const unsigned*)(F.ctl + CW_WGC + half * 8192); unsigned* cnt = (unsigned*)(F.ctl + CW_CNT + half * 16);
    LAS unsigned* tab = (LAS unsigned*)F.lds; LAS unsigned* tot = tab + 8192; LAS unsigned* bef = tot + 8; LAS unsigned* cur = bef + 8;
    __syncthreads();
    for (int e = F.tid; e < F.G * 8; e += 512) tab[e] = wgc[e];
    __syncthreads();
    if (F.tid < 8) { unsigned t = 0, bsum = 0; for (int g = 0; g < F.G; ++g) { const unsigned v = tab[g * 8 + F.tid]; if (g < F.bid) bsum += v; t += v; } tot[F.tid] = t; bef[F.tid] = bsum; cur[F.tid] = 0u; if (F.bid == 0) cnt[F.tid] = t; }
    __syncthreads();
    unsigned totr[8];
#pragma unroll
    for (int e = 0; e < 8; ++e) totr[e] = tot[e];
    const MoeLayout L = moe_layout(totr);
    const bf16* H = WSP(bf16, A_H); bf16* GA = WSP(bf16, F_GA); const int* tope = WSP(int, F_TOPE); int* slot = WSP(int, F_SLOT);
    const int lane = F.lane;
    for (int m = F.gw; m < TH; m += F.NGW) {
        const u32x4 v0 = *(const u32x4*)(H + (size_t)m * D + 8 * lane), v1 = *(const u32x4*)(H + (size_t)m * D + 512 + 8 * lane);
#pragma unroll
        for (int k = 0; k < 2; ++k) { const int e = tope[2 * m + k]; int s = 0;
            int ps = 0;
#pragma unroll
            for (int q = 0; q < NEXP; ++q) ps = (e == q) ? L.pstart[q] : ps;
            if (lane == 0) s = ps + (int)bef[e] + (int)ATOMIC_ADD_LDS(cur + e, 1u);
            s = __shfl(s, 0);
            if (lane == 0) slot[2 * m + k] = s;
            *(u32x4*)(GA + (size_t)s * D + 8 * lane) = v0; *(u32x4*)(GA + (size_t)s * D + 512 + 8 * lane) = v1; }
    }
#pragma unroll
    for (int e = 0; e < NEXP; ++e) { const int r0 = L.pstart[e] + (int)totr[e], r1 = L.pstart[e + 1];
        for (int r = r0 + F.gw; r < r1; r += F.NGW) { *(u32x4*)(GA + (size_t)r * D + 8 * lane) = (u32x4){0u, 0u, 0u, 0u}; *(u32x4*)(GA + (size_t)r * D + 512 + 8 * lane) = (u32x4){0u, 0u, 0u, 0u}; } }
    __syncthreads();
}
__device__ __forceinline__ void phase_moe_gu(const Frame& F, const Args& A, int half) {
    MoeOrder S; S.L = moe_layout((const unsigned*)(F.ctl + CW_CNT + half * 16)); S.np = S.L.pstart[NEXP] / 256; S.nN = 2 * FF_E / 256; S.G = F.G; S.c = F.bid;
    pg8::Gemm g{WSP(bf16, F_GA), WSP(bf16, W_FGU), D, D}; EpiSwiGLU E{WSP(bf16, F_ACT), FF_E, 2 * FF_E / 256}; pg8::gemm_phase(F.lds, g, S, E, F.tid);
}
struct EpiF32Mod {
    static constexpr bool PERM = false, AFTER_DRAIN = false;
    float* C;
    __device__ __forceinline__ void operator()(const f32x4 (&acc)[2][2][4][2], const Unit& u, int wr, int wc, int fr, int fq) const {
        const int row0 = u.pm * 256 + wr * 64 + fr, col0 = (u.pn & 3) * 256 + wc * 32 + 4 * fq;
#pragma unroll
        for (int ai = 0; ai < 2; ++ai)
#pragma unroll
            for (int m = 0; m < 4; ++m) { float* rowp = C + (size_t)(row0 + ai * HALFT + m * 16) * D + col0;
#pragma unroll
                for (int bj = 0; bj < 2; ++bj)
#pragma unroll
                    for (int n = 0; n < 2; ++n) *(f32x4*)(rowp + bj * HALFT + n * 16) = acc[ai][bj][m][n]; }
    }
};
__device__ __forceinline__ void phase_moe_down(const Frame& F, const Args& A, int half) {
    MoeOrder S; S.L = moe_layout((const unsigned*)(F.ctl + CW_CNT + half * 16)); S.np = S.L.pstart[NEXP] / 256; S.nN = D / 256; S.G = F.G; S.c = F.bid;
    pg8::Gemm g{WSP(bf16, F_ACT), WSP(bf16, W_FDN), FF_E, FF_E}; EpiF32Mod E{WSP(float, F_YE)}; pg8::gemm_phase(F.lds, g, S, E, F.tid);
}
__device__ __forceinline__ void phase_moe_combine(const Frame& F, const Args& A, float* x, const float* fgain) {
    const float* YE = WSP(float, F_YE); const int* slot = WSP(int, F_SLOT); const float* topw = WSP(float, F_TOPW); const int lane = F.lane;
    for (int m = F.gw; m < TH; m += F.NGW) { const int s0 = slot[2 * m], s1 = slot[2 * m + 1]; const float w0 = topw[2 * m], w1 = topw[2 * m + 1];
        f32x4 v[4]; float ss = 0.f;
#pragma unroll
        for (int j = 0; j < 4; ++j) { const int c = 4 * lane + 256 * j;
            v[j] = *(const f32x4*)(x + (size_t)m * D + c) + *(const f32x4*)(YE + (size_t)s0 * D + c) * w0 + *(const f32x4*)(YE + (size_t)s1 * D + c) * w1;
            ss += (v[j].x * v[j].x + v[j].y * v[j].y) + (v[j].z * v[j].z + v[j].w * v[j].w); }
        if (fgain) { const float rstd = RSQRT(wave_sum(ss) * (1.0f / D) + EPS);
#pragma unroll
            for (int j = 0; j < 4; ++j) v[j] = v[j] * rstd * *(const f32x4*)(fgain + 4 * lane + 256 * j); }
#pragma unroll
        for (int j = 0; j < 4; ++j) *(f32x4*)(x + (size_t)m * D + 4 * lane + 256 * j) = v[j]; }
}

#ifndef EMU
#define XB_TMO      128
#define XB_XCNT(j)  (256  + 64 * (j))
#define XB_XSUB(j)  (1280 + 64 * (j))
#define XB_XGEN(j)  (2304 + 64 * (j))
#define XB_TOP      3328
#define XB_TOPGEN   3392
#define XCD_BAR_WORDS 3456
#define XB_SPIN_CAP (1u << 22)
__device__ __forceinline__ unsigned xb_ld(unsigned* p)              { return __hip_atomic_load(p, __ATOMIC_RELAXED, __HIP_MEMORY_SCOPE_AGENT); }
__device__ __forceinline__ unsigned xb_add(unsigned* p, unsigned v) { return __hip_atomic_fetch_add(p, v, __ATOMIC_RELAXED, __HIP_MEMORY_SCOPE_AGENT); }
__device__ __forceinline__ unsigned xb_xcc_id() { return (unsigned)__builtin_amdgcn_s_getreg((3 << 11) | 20) & 0xFu; }
#define XB_SPIN(cond, bar) do { unsigned _sp = 0; while (cond) { __builtin_amdgcn_s_sleep(1); \
    if ((++_sp & 255u) == 0u) { if (xb_ld(&(bar)[XB_TMO])) break; if (_sp > XB_SPIN_CAP) { atomicAdd(&(bar)[XB_TMO], 1u); break; } } } } while (0)
struct XcdBarrier { unsigned* bar; unsigned x; volatile LAS unsigned* st; };
__device__ __forceinline__ XcdBarrier xcd_barrier_post(unsigned* bar, volatile LAS unsigned* st) {
    XcdBarrier b; b.bar = bar; b.x = xb_xcc_id(); b.st = st;
    if (threadIdx.x == 0) (void)xb_add(&bar[XB_XCNT(b.x)], 1u);
    return b;
}
__device__ __forceinline__ void xcd_barrier_complete(unsigned* bar, unsigned x, unsigned& nloc, unsigned& nx) {
    const unsigned G = gridDim.x * gridDim.y * gridDim.z;
    unsigned sum, cnt, mine, sp = 0u;
    for (;;) {
        sum = 0u; cnt = 0u; mine = 0u;
#pragma unroll
        for (unsigned j = 0; j < 16; ++j) { const unsigned c = xb_ld(&bar[XB_XCNT(j)]); sum += c; cnt += (c > 0u) ? 1u : 0u; mine = (j == x) ? c : mine; }
        if (sum == G) break;
        __builtin_amdgcn_s_sleep(1);
        if ((++sp & 255u) == 0u) { if (xb_ld(&bar[XB_TMO])) break; if (sp > XB_SPIN_CAP) { atomicAdd(&bar[XB_TMO], 1u); break; } }
    }
    nloc = mine > 0u ? mine : 1u; nx = cnt > 0u ? cnt : 1u;
}
__device__ __forceinline__ void xcd_barrier(const XcdBarrier& b) {
    asm volatile("s_waitcnt vmcnt(0)" ::: "memory");
    __syncthreads();
    if (threadIdx.x == 0) {
        unsigned* bar = b.bar;
        __builtin_amdgcn_s_waitcnt(0);
        unsigned nloc = b.st[0], nx = b.st[1];
        if (nloc == 0u) { xcd_barrier_complete(bar, b.x, nloc, nx); b.st[0] = nloc; b.st[1] = nx; }
        const unsigned old = xb_add(&bar[XB_XSUB(b.x)], 1u);
        const unsigned gen = old / nloc;
        if (old + 1u == (gen + 1u) * nloc) {
            __builtin_amdgcn_fence(__ATOMIC_RELEASE, "agent");
            asm volatile("s_waitcnt vmcnt(0)" ::: "memory");
            const unsigned og = xb_add(&bar[XB_TOP], 1u);
            const unsigned tg = og / nx;
            if (og + 1u == (tg + 1u) * nx) xb_add(&bar[XB_TOPGEN], 1u);
            else XB_SPIN(xb_ld(&bar[XB_TOPGEN]) == tg, bar);
            __builtin_amdgcn_fence(__ATOMIC_ACQUIRE, "agent");
            xb_add(&bar[XB_XGEN(b.x)], 1u);
            asm volatile("s_waitcnt vmcnt(0)" ::: "memory");
        } else {
            XB_SPIN(xb_ld(&bar[XB_XGEN(b.x)]) == gen, bar);
            __builtin_amdgcn_fence(__ATOMIC_ACQUIRE, "agent");
            asm volatile("s_waitcnt vmcnt(0)" ::: "memory");
        }
    }
    __syncthreads();
}
#endif

constexpr int NPH = 17;
constexpr int NPHASES = DEPTH * (1 + NHALF * NPH);
constexpr int LDS_BYTES = 155648, MISC_OFF = 154624;

__global__ void __launch_bounds__(512, 2) fwd_kernel(Args args_k) {
#ifdef EMU
    unsigned char* lds = emu_lds_ptr;
#else
    extern __shared__ __attribute__((aligned(16))) unsigned char lds[];
#endif
    Frame F0;
    F0.lds = (LAS unsigned char*)lds; F0.tid = threadIdx.x; F0.lane = F0.tid & 63; F0.wave = RFL(F0.tid >> 6); F0.G = gridDim.x; F0.bid = blockIdx.x;
    F0.gw = F0.bid * 8 + F0.wave; F0.NGW = F0.G * 8;
    F0.out = (GAS float*)args_k.out; F0.ws = (GAS unsigned char*)args_k.ws; F0.ctl = (GAS unsigned*)(F0.ws + WS_CTL);
    const int lo = args_k.lo, hi = args_k.hi;
#ifndef EMU
    volatile LAS unsigned* misc = (volatile LAS unsigned*)(F0.lds + MISC_OFF);
    if (F0.tid < 4) misc[F0.tid] = 0u;
    __syncthreads();
    XcdBarrier bar; bar.bar = (unsigned*)(F0.ctl + CW_BAR); bar.x = 0; bar.st = misc;
    if (hi - lo > 1) bar = xcd_barrier_post((unsigned*)(F0.ctl + CW_BAR), misc);
#define GRID_BAR() do { XcdBarrier bq = bar; asm volatile("" : "+s"(bq.bar), "+s"(bq.x)); xcd_barrier(bq); } while (0)
#else
#define GRID_BAR() do { } while (0)
#endif
    int ph = 0;
#ifndef PH_MASK
#define PH_MASK 0xFFFFFFFFFFFFFFFFull
#endif
#define PHASE(...) PHASE_I(31, __VA_ARGS__)
#ifdef EMU
#define LAUNDER(Fq) do { } while (0)
#else
#define LAUNDER(Fq) do { unsigned mq_ = ~0u; asm volatile("" : "+s"(Fq.G), "+s"(Fq.bid), "+s"(Fq.wave), "+s"(Fq.ws), "+s"(Fq.out), "+s"(Fq.ctl), "+s"(mq_)); Fq.lane = (int)__builtin_amdgcn_mbcnt_hi(mq_, __builtin_amdgcn_mbcnt_lo(mq_, 0u)); Fq.tid = Fq.wave * 64 + Fq.lane; Fq.gw = Fq.bid * 8 + Fq.wave; Fq.NGW = Fq.G * 8; } while (0)
#endif
#ifdef EMU
#define ARGS_Q() const Args& args_q = args_k
#else
#define ARGS_Q() const __attribute__((address_space(4))) Args* aq_ = (const __attribute__((address_space(4))) Args*)__builtin_amdgcn_kernarg_segment_ptr(); asm volatile("" : "+s"(aq_)); const Args& args_q = *(const Args*)aq_
#endif
#define PHASE_I(kind, ...) do { if (ph >= lo && ph < hi) { constexpr int reps_ = (((REPEAT_MASK) >> (kind)) & 1u) ? 2 : 1; for (int rr_ = 0; rr_ < reps_; ++rr_) { { Frame Fq = F0; LAUNDER(Fq); const Frame& F = Fq; ARGS_Q(); const Args& args = args_q; __VA_ARGS__; } if (rr_ + 1 < reps_ || ph + 1 < hi) { GRID_BAR(); if (((REPEAT_MASK) >> 26) & 1u) GRID_BAR(); } } } ++ph; } while (0)
#define PHASEK(kind, ...) PHASE_I(kind, __VA_ARGS__)
#define SEGMENT(layer, half) do { \
            const size_t r0 = (size_t)(half) * TH; \
            const float* xin = ((layer) == 0 ? AIN(args_k, 0) : (const float*)F0.out) + r0 * D; float* xo = (float*)F0.out + r0 * D; \
            PHASEK(0, phase_norm<false>(F, args, xin, AIN(args, 2) + (layer) * D, WSP(bf16, A_H), nullptr, nullptr, nullptr, nullptr); phase_rope_table(F, args, (const int*)AIN(args, 1) + r0, WSP(float, A_ROPE))); \
            PHASEK(1, { pg8::Gemm g{WSP(bf16, A_H), WSP(bf16, W_IN), D, D}; pg8::StaticOrder S; S.init(TH, PW, F.G, F.bid); EpiBf16 E{WSP(bf16, A_P), PW, nullptr, 0}; pg8::gemm_phase(F.lds, g, S, E, F.tid); }); \
            PHASEK(2, phase_mla_prep(F, args); phase_rwkv_prep(F, args, layer)); \
            PHASEK(3, phase_mla_q(F, args); __syncthreads(); phase_mla_kv(F, args); __syncthreads(); phase_rwkv_lora(F, args)); \
            PHASEK(8, phase_rwkv_r1(F, args, layer)); \
            PHASEK(5, { const int ns_ = F.G >= 128 ? 64 : (F.G >= 4 ? F.G / 4 : 0); Frame Fa = F;       \
                        if (F.bid < ns_) { Fa.G = ns_; Fa.NGW = ns_ * 8; phase_rwkv_r2(Fa, args); } else { Fa.bid = F.bid - ns_; Fa.G = F.G - ns_; Fa.gw = Fa.bid * 8 + Fa.wave; Fa.NGW = Fa.G * 8; phase_attention(Fa, args); if (ns_ == 0) phase_rwkv_r2(F, args); } }); \
            PHASEK(9, phase_rwkv_post(F, args, layer); phase_gdn_g1(F, args, layer); phase_ssd_s1(F, args, layer)); \
            PHASEK(11, { const int ns_ = F.G >= 4 ? F.G / 2 : 0; Frame Fa = F;                               \
                        if (F.bid < ns_) { Fa.G = ns_; Fa.NGW = ns_ * 8; phase_gdn_g2(Fa, args); } else { Fa.bid = F.bid - ns_; Fa.G = F.G - ns_; Fa.gw = Fa.bid * 8 + Fa.wave; Fa.NGW = Fa.G * 8; phase_ssd_s23(Fa, args); if (ns_ == 0) phase_gdn_g2(F, args); } }); \
            PHASEK(12, phase_gdn_g3(F, args, layer); phase_ssd_s4(F, args, layer)); \
            PHASEK(17, phase_merge_z(F, args)); \
            PHASEK(18, phase_merge_gate(F, args, layer)); \
            PHASEK(19, phase_merge_out(F, args, xin, xo)); \
            if ((layer) == 0) { \
                PHASEK(20, phase_norm<false>(F, args, xo, AIN(args, 32) + (layer) * D, WSP(bf16, A_H), nullptr, nullptr, nullptr, nullptr)); \
                PHASEK(21, phase_ffn_gu(F, args)); \
                PHASE(phase_ffn_down(F, args, xo)); \
                PHASE((void)0); \
                PHASE((void)0); \
            } else { \
                PHASE(phase_norm<true>(F, args, xo, AIN(args, 32) + (layer) * D, WSP(bf16, A_H), AIN(args, 35), WSP(int, F_TOPE), WSP(float, F_TOPW), (unsigned*)(F.ctl + CW_WGC + (half) * 8192))); \
                PHASE(phase_moe_route(F, args, half)); \
                PHASEK(22, phase_moe_gu(F, args, half)); \
                PHASEK(23, phase_moe_down(F, args, half)); \
                PHASE(phase_moe_combine(F, args, xo, (layer) == DEPTH - 1 ? AIN(args, 38) : nullptr)); \
            } } while (0)
    static_assert(DEPTH == 2 && NHALF <= 2, "segment program");
    PHASEK(27, phase_convert(F, args, 0));
    SEGMENT(0, 0);
    if (NHALF == 2) SEGMENT(0, 1);
    PHASEK(27, phase_convert(F, args, 1));
    SEGMENT(1, 0);
    if (NHALF == 2) SEGMENT(1, 1);
#undef SEGMENT
#undef PHASE
}

#ifndef ONE_LAUNCH
#define ONE_LAUNCH 1
#endif
extern "C" void kernel_launch(void* const* d_in, const int* in_sizes, int n_in, void* d_out, int out_size, void* d_ws, size_t ws_size, hipStream_t stream) {
    static int grid = 0;
    if (grid == 0) {
#ifdef EMU
        grid = EMU_GRID;
#else
        if (n_in != 39 || out_size != T * D || ws_size < WS_NEED) { fprintf(stderr, "kernel_launch: unexpected problem (n_in %d out %d ws %zu need %zu)\n", n_in, out_size, ws_size, (size_t)WS_NEED); grid = -1; return; }
        int dev = 0, cus = 0;
        if (hipGetDevice(&dev) != hipSuccess || hipDeviceGetAttribute(&cus, hipDeviceAttributeMultiprocessorCount, dev) != hipSuccess) { grid = -1; return; }
        if (hipFuncSetAttribute((const void*)fwd_kernel, hipFuncAttributeMaxDynamicSharedMemorySize, LDS_BYTES) != hipSuccess) { fprintf(stderr, "kernel_launch: hipFuncSetAttribute failed\n"); grid = -1; return; }
        int per_cu = 0;
        if (hipOccupancyMaxActiveBlocksPerMultiprocessor(&per_cu, (const void*)fwd_kernel, 512, LDS_BYTES) != hipSuccess || per_cu < 1) fprintf(stderr, "kernel_launch: occupancy query reports %d\n", per_cu);
        (void)hipGetLastError();
        grid = cus;
#endif
    }
    if (grid < 0) return;
    (void)hipMemsetAsync((char*)d_ws + WS_CTL, 0, CTL_BYTES, stream);
    Args a{};
    for (int i = 0; i < 39; ++i) a.in[i] = (const float*)d_in[i];
    a.out = (float*)d_out; a.ws = (unsigned char*)d_ws;
#ifdef EMU
    for (int p = EMU_PH_LO; p < EMU_PH_HI && p < NPHASES; ++p) { a.lo = p; a.hi = p + 1; emu_launch(fwd_kernel, grid, 512, a); emu_after_phase(p); }
#else
#if ONE_LAUNCH
    a.lo = 0; a.hi = NPHASES;
    hipLaunchKernelGGL(fwd_kernel, dim3(grid), dim3(512), LDS_BYTES, stream, a);
#else
    for (int p = 0; p < NPHASES; ++p) { a.lo = p; a.hi = p + 1; hipLaunchKernelGGL(fwd_kernel, dim3(grid), dim3(512), LDS_BYTES, stream, a); }
#endif
#endif
}
```

```cpp
#ifndef EMU
#include <hip/hip_runtime.h>
#include <cstdio>
#include <cstdint>
#endif

#ifndef REPEAT_MASK
#define REPEAT_MASK 0u
#endif
#ifdef EMU
constexpr int BATCH = EMU_B, SEQ = EMU_S, NHALF = EMU_NHALF;
#else
constexpr int BATCH = 16, SEQ = 2048, NHALF = 2;
#endif
constexpr int D = 1024, DEPTH = 2, CH = 64;
constexpr int T = BATCH * SEQ, TH = T / NHALF, BH = BATCH / NHALF, NCH = SEQ / CH;
constexpr int C_MLA = 0, C_RWKV = 704, C_GDN = 2528, C_SSD = 4584, C_GATE = 6128, IN_COLS = 10224, PW = 6144;
constexpr int FF_D = 2816, FF_E = 3584, NEXP = 8;
constexpr int MOE_ROWS = ((TH * 2 + NEXP * 255) / 256) * 256;
constexpr float EPS = 1e-6f;
static_assert(TH % 256 == 0 && SEQ % 128 == 0 && BATCH % NHALF == 0 && (SEQ / 64) % 2 == 0, "shape");

typedef unsigned short bf16;
typedef float f32x4 __attribute__((ext_vector_type(4)));
typedef float f32x2 __attribute__((ext_vector_type(2)));
typedef short bf16x8 __attribute__((ext_vector_type(8)));
typedef short bf16x4 __attribute__((ext_vector_type(4)));
typedef unsigned u32x4 __attribute__((ext_vector_type(4)));
typedef unsigned u32x2 __attribute__((ext_vector_type(2)));
#ifdef EMU
#define LAS
#define GAS
#define MFMA_F32(a, b, c) emu_mfma_16x16x4f32(a, b, c)
#define MFMA_BF16(a, b, c) emu_mfma_16x16x32bf16(a, b, c)
#define ATOMIC_ADD_U32(p, v) emu_atomic_add_u32(p, v)
#define ATOMIC_ADD_LDS(p, v) emu_atomic_add_u32((unsigned*)(p), v)
#define RFL(x) (x)
#define OPAQUE_V(x) do { } while (0)
#define LDS_WAIT()
#define VM_WAIT()
__device__ __forceinline__ float fast_exp(float x) { return expf(x); }
__device__ __forceinline__ float fast_rcp(float x) { return 1.0f / x; }
__device__ __forceinline__ float fast_rsqrt(float x) { return 1.0f / sqrtf(x); }
#else
#define LAS __attribute__((address_space(3)))
#define GAS __attribute__((address_space(1)))
#define MFMA_F32(a, b, c) __builtin_amdgcn_mfma_f32_16x16x4f32(a, b, c, 0, 0, 0)
#define MFMA_BF16(a, b, c) __builtin_amdgcn_mfma_f32_16x16x32_bf16(a, b, c, 0, 0, 0)
#define ATOMIC_ADD_U32(p, v) __hip_atomic_fetch_add(p, v, __ATOMIC_RELAXED, __HIP_MEMORY_SCOPE_AGENT)
#define ATOMIC_ADD_LDS(p, v) __hip_atomic_fetch_add((LAS unsigned*)(p), v, __ATOMIC_RELAXED, __HIP_MEMORY_SCOPE_WORKGROUP)
#define RFL(x) __builtin_amdgcn_readfirstlane(x)
#define OPAQUE_V(x) asm volatile("" : "+v"(x))
#define LDS_WAIT() asm volatile("s_waitcnt lgkmcnt(0)" ::: "memory")
#define VM_WAIT() asm volatile("s_waitcnt vmcnt(0)" ::: "memory")
__device__ __forceinline__ float fast_exp(float x) { return __expf(x); }
__device__ __forceinline__ float fast_rcp(float x) { return __builtin_amdgcn_rcpf(x); }
__device__ __forceinline__ float fast_rsqrt(float x) { return __builtin_amdgcn_rsqf(x); }
#endif
__device__ __forceinline__ unsigned f2u(float f) { return __builtin_bit_cast(unsigned, f); }
__device__ __forceinline__ float u2f(unsigned u) { return __builtin_bit_cast(float, u); }
__device__ __forceinline__ unsigned f2bf(float f) { unsigned u = f2u(f); return (u + 0x7fffu + ((u >> 16) & 1u)) >> 16; }
__device__ __forceinline__ float bf2f(unsigned h) { return u2f(h << 16); }
__device__ __forceinline__ unsigned pk2(float lo, float hi) { return f2bf(lo) | (f2bf(hi) << 16); }
#ifndef EMU
#define expf(x) __expf(x)
#define exp2f(x) __builtin_amdgcn_exp2f(x)
#define FDIV(a, b) ((a) * __builtin_amdgcn_rcpf(b))
#define RSQRT(x) __builtin_amdgcn_rsqf(x)
__device__ __forceinline__ float softplusf_(float x) { return x > 20.f ? x : __logf(1.0f + __expf(x)); }
#else
#define FDIV(a, b) ((a) / (b))
#define RSQRT(x) (1.0f / sqrtf(x))
__device__ __forceinline__ float softplusf_(float x) { return x > 20.f ? x : log1pf(expf(x)); }
#endif
__device__ __forceinline__ float sigmoidf_(float x) { return FDIV(1.0f, 1.0f + expf(-x)); }
__device__ __forceinline__ float siluf_(float x) { return FDIV(x, 1.0f + expf(-x)); }
__device__ __forceinline__ float tanhf_(float x) { const float e = expf(2.0f * fminf(x, 15.0f)); return FDIV(e - 1.0f, e + 1.0f); }
__device__ __forceinline__ float wave_sum(float v) {
#pragma unroll
    for (int o = 1; o < 64; o <<= 1) v += __shfl_xor(v, o);
    return v;
}
__device__ __forceinline__ float wave_max(float v) {
#pragma unroll
    for (int o = 1; o < 64; o <<= 1) v = fmaxf(v, __shfl_xor(v, o));
    return v;
}
__device__ __forceinline__ f32x4 ld_bf16x4(const bf16* p) { const u32x2 w = *(const u32x2*)p; return (f32x4){bf2f(w.x & 0xffffu), bf2f(w.x >> 16), bf2f(w.y & 0xffffu), bf2f(w.y >> 16)}; }
__device__ __forceinline__ void st_bf16x4(bf16* p, f32x4 v) { u32x2 w; w.x = pk2(v.x, v.y); w.y = pk2(v.z, v.w); *(u32x2*)p = w; }
__device__ __forceinline__ u32x4 pack8(const float* v) { u32x4 o; o.x = pk2(v[0], v[1]); o.y = pk2(v[2], v[3]); o.z = pk2(v[4], v[5]); o.w = pk2(v[6], v[7]); return o; }

namespace pg8 {
#define PG8_LAS LAS
typedef unsigned short bf16_t;
constexpr int BM = 256, BK = 64, HALF = 128, HTB = HALF * BK * 2, STAGE_BYTES = 8 * HTB, NXCD = 8, WGM = 8;
__host__ __device__ __forceinline__ int lds_byte(int r, int c) { const int st = (r >> 4) * 2 + (c >> 5), rr = r & 15, cc = c & 31, ob = rr * 64 + cc * 2; return st * 1024 + (ob ^ (((ob >> 9) & 1) << 5)); }
__host__ __device__ __forceinline__ void stage_rc(int b, int& R, int& C) { const int st = b / 1024, sb = b % 1024, swz = sb ^ (((sb >> 9) & 1) << 5); R = (st >> 1) * 16 + swz / 64; C = (st & 1) * 32 + (swz % 64) / 2; }
__host__ __device__ __forceinline__ int perm32(int rho) { const int n = rho >> 4, i = rho & 15; return 8 * (i >> 2) + 4 * n + (i & 3); }
struct Unit { int pm, pn; };
struct Gemm { const bf16_t* A; const bf16_t* Bt; int lda, K; };
struct StaticOrder {
    int nM, nN, nwg, G, c;
    __host__ __device__ void init(int M, int N, int G_, int c_) { nM = M / BM; nN = N / BM; nwg = nM * nN; G = G_; c = c_; }
    __host__ __device__ bool next(int i, Unit& u) const {
        const long L = (long)i * G + c; if (L >= nwg) return false;
        int wgid = (int)L; { const int q = nwg / NXCD, r = nwg % NXCD, xcd = wgid % NXCD, off = wgid / NXCD; wgid = (xcd < r ? xcd * (q + 1) : r * (q + 1) + (xcd - r) * q) + off; }
        const int nig = WGM * nN, gid = wgid / nig, fm = gid * WGM, gsz = (nM - fm) < WGM ? (nM - fm) : WGM;
        u.pm = fm + ((wgid % nig) % gsz); u.pn = (wgid % nig) / gsz; return true;
    }
    __device__ __forceinline__ void a_ready(const Unit&) const {}
    __device__ __forceinline__ void done(const Unit&) const {}
};
#ifndef EMU
template <class Epi, class Sched>
__device__ __forceinline__ void gemm_phase(PG8_LAS unsigned char* lds, const Gemm g, const Sched& S, const Epi& E, const int tid) {
    const int wid = __builtin_amdgcn_readfirstlane(tid >> 6), lane = tid & 63, wr = wid >> 2, wc = wid & 3, fr = lane & 15, fq = lane >> 4;
    int Kq = g.K; asm volatile("" : "+s"(Kq));
    const int K = Kq, nt = K / BK, lda = g.lda;
    unsigned voffA[2], voffB[2];
#pragma unroll
    for (int i = 0; i < 2; ++i) { int R, C; stage_rc(tid * 16 + i * 8192, R, C); const int Rb = Epi::PERM ? ((R & ~31) + perm32(R & 31)) : R;
        voffA[i] = (unsigned)(R * lda + C) * 2u; voffB[i] = (unsigned)(Rb * K + C) * 2u; }
    const size_t kstep = (size_t)(BK * 2);
    const size_t hstep = (size_t)HALF * K * 2, hstepA = (size_t)HALF * lda * 2;
    const size_t tstep = 2 * hstep, tstepA = 2 * hstepA;
    const unsigned ldsw = (unsigned)wid * 1024u;
    const int aoff = lds_byte(wr * 64 + fr, fq * 8), boff = lds_byte(wc * 32 + fr, fq * 8);
#define PG8_SA(b, h) (((b) * 2 + (h)) * HTB)
#define PG8_SB(b, h) ((4 + (b) * 2 + (h)) * HTB)
#define PG8_STAGE(bufoff, gbase, voff) do { _Pragma("unroll") for (int _i = 0; _i < 2; ++_i) \
        __builtin_amdgcn_global_load_lds((const unsigned*)((const char*)(gbase) + (voff)[_i]), (PG8_LAS unsigned*)(lds + (bufoff) + ldsw + _i * 8192), 16, 0, 0); } while (0)
#define PG8_LDA(dst, b, h) do { _Pragma("unroll") for (int m = 0; m < 4; ++m) _Pragma("unroll") for (int k = 0; k < 2; ++k) dst[m][k] = *(const PG8_LAS bf16x8*)(lds + PG8_SA(b, h) + aoff + m * 2048 + k * 1024); } while (0)
#define PG8_LDB(dst, b, h) do { _Pragma("unroll") for (int n = 0; n < 2; ++n) _Pragma("unroll") for (int k = 0; k < 2; ++k) dst[n][k] = *(const PG8_LAS bf16x8*)(lds + PG8_SB(b, h) + boff + n * 2048 + k * 1024); } while (0)
#define PG8_MMA(ai, bj, At, Bt) do { __builtin_amdgcn_s_setprio(1); _Pragma("unroll") for (int m = 0; m < 4; ++m) _Pragma("unroll") for (int n = 0; n < 2; ++n) _Pragma("unroll") for (int k = 0; k < 2; ++k) \
        acc[ai][bj][m][n] = __builtin_amdgcn_mfma_f32_16x16x32_bf16(Bt[n][k], At[m][k], acc[ai][bj][m][n], 0, 0, 0); __builtin_amdgcn_s_setprio(0); } while (0)
#define PG8_WAIT_V(n) asm volatile("s_waitcnt vmcnt(" #n ")" ::: "memory")
#define PG8_WAIT_L(n) asm volatile("s_waitcnt lgkmcnt(" #n ")" ::: "memory")
#define PG8_BAR __builtin_amdgcn_s_barrier()
#define PG8_SCHED __builtin_amdgcn_sched_barrier(0)
    Unit cur, nxt; int ui = 0;
    if (!S.next(0, cur)) return;
    f32x4 acc[2][2][4][2];
#pragma unroll
    for (int a = 0; a < 2; ++a)
#pragma unroll
        for (int b = 0; b < 2; ++b)
#pragma unroll
            for (int m = 0; m < 4; ++m)
#pragma unroll
                for (int n = 0; n < 2; ++n) acc[a][b][m][n] = (f32x4){0.f, 0.f, 0.f, 0.f};
    bf16x8 At[4][2], B0[2][2], B1[2][2];
    const char* cA = (const char*)g.A + (size_t)cur.pm * tstepA; const char* cB = (const char*)g.Bt + (size_t)cur.pn * tstep;
    S.a_ready(cur);
    PG8_STAGE(PG8_SB(0, 0), cB, voffB); PG8_STAGE(PG8_SA(0, 0), cA, voffA); PG8_STAGE(PG8_SB(0, 1), cB + hstep, voffB); PG8_STAGE(PG8_SA(0, 1), cA + hstepA, voffA);
    if (wr == 1) PG8_BAR;
    PG8_WAIT_V(4); PG8_BAR;
    PG8_STAGE(PG8_SB(1, 0), cB + kstep, voffB); PG8_STAGE(PG8_SA(1, 0), cA + kstep, voffA); PG8_STAGE(PG8_SB(1, 1), cB + hstep + kstep, voffB);
    PG8_WAIT_V(6); PG8_BAR;
    for (;;) {
        const bool has_next = S.next(ui + 1, nxt);
        const char* nA = has_next ? (const char*)g.A + (size_t)nxt.pm * tstepA : cA; const char* nB = has_next ? (const char*)g.Bt + (size_t)nxt.pn * tstep : cB;
        for (int t = 0; t < nt; t += 2) {
            const bool last = (t == nt - 2);
            const char* a1 = cA + (size_t)(t + 1) * kstep;
            const char* a2 = last ? nA : cA + (size_t)(t + 2) * kstep; const char* b2 = last ? nB : cB + (size_t)(t + 2) * kstep;
            const char* a3 = a2 + kstep; const char* b3 = b2 + kstep;
            if (last && has_next) S.a_ready(nxt);
            PG8_LDB(B0, 0, 0); PG8_SCHED; PG8_LDA(At, 0, 0); PG8_STAGE(PG8_SA(1, 1), a1 + hstepA, voffA);
            PG8_WAIT_L(8); PG8_BAR; PG8_WAIT_L(0); PG8_MMA(0, 0, At, B0); PG8_BAR; PG8_SCHED;
            PG8_LDB(B1, 0, 1); PG8_STAGE(PG8_SB(0, 0), b2, voffB);
            PG8_BAR; PG8_WAIT_L(0); PG8_MMA(0, 1, At, B1); PG8_BAR;
            PG8_LDA(At, 0, 1); PG8_STAGE(PG8_SA(0, 0), a2, voffA);
            PG8_BAR; PG8_WAIT_L(0); PG8_MMA(1, 0, At, B0); PG8_BAR; PG8_SCHED;
            PG8_STAGE(PG8_SB(0, 1), b2 + hstep, voffB);
            PG8_WAIT_V(6); PG8_BAR; PG8_MMA(1, 1, At, B1); PG8_BAR;
            PG8_LDB(B0, 1, 0); PG8_SCHED; PG8_LDA(At, 1, 0); PG8_STAGE(PG8_SA(0, 1), a2 + hstepA, voffA);
            PG8_WAIT_L(8); PG8_BAR; PG8_WAIT_L(0); PG8_MMA(0, 0, At, B0); PG8_BAR; PG8_SCHED;
            PG8_LDB(B1, 1, 1); PG8_STAGE(PG8_SB(1, 0), b3, voffB);
            PG8_BAR; PG8_WAIT_L(0); PG8_MMA(0, 1, At, B1); PG8_BAR;
            PG8_LDA(At, 1, 1); PG8_STAGE(PG8_SA(1, 0), a3, voffA);
            PG8_BAR; PG8_WAIT_L(0); PG8_MMA(1, 0, At, B0); PG8_BAR; PG8_SCHED;
            PG8_STAGE(PG8_SB(1, 1), b3 + hstep, voffB);
            PG8_WAIT_V(6); PG8_BAR; PG8_MMA(1, 1, At, B1); PG8_BAR;
        }
        if constexpr (!Epi::AFTER_DRAIN) { E(acc, cur, wr, wc, fr, fq); S.done(cur); }
        if (!has_next) break;
#pragma unroll
        for (int a = 0; a < 2; ++a)
#pragma unroll
            for (int b = 0; b < 2; ++b)
#pragma unroll
                for (int m = 0; m < 4; ++m)
#pragma unroll
                    for (int n = 0; n < 2; ++n) acc[a][b][m][n] = (f32x4){0.f, 0.f, 0.f, 0.f};
        cur = nxt; cA = nA; cB = nB; ++ui;
    }
    PG8_WAIT_V(0);
    if (wr == 0) PG8_BAR;
    PG8_BAR;
    if constexpr (Epi::AFTER_DRAIN) { E.fused(acc, cur, wr, wc, fr, fq, lds, wid, lane); S.done(cur); }
#undef PG8_SA
#undef PG8_SB
#undef PG8_STAGE
#undef PG8_LDA
#undef PG8_LDB
#undef PG8_MMA
#undef PG8_WAIT_V
#undef PG8_WAIT_L
#undef PG8_BAR
#undef PG8_SCHED
}
#else
template <class Epi, class Sched>
__device__ __forceinline__ void gemm_phase(PG8_LAS unsigned char* lds, const Gemm g, const Sched& S, const Epi& E, const int tid) {
    const int wid = tid >> 6, lane = tid & 63, wr = wid >> 2, wc = wid & 3, fr = lane & 15, fq = lane >> 4;
    Unit cur;
    for (int ui = 0; S.next(ui, cur); ++ui) {
        f32x4 acc[2][2][4][2];
        for (int ai = 0; ai < 2; ++ai) for (int m = 0; m < 4; ++m) {
            const size_t row = (size_t)cur.pm * 256 + ai * 128 + wr * 64 + m * 16 + fr;
            const bf16_t* ap = g.A + row * g.lda;
            for (int bj = 0; bj < 2; ++bj) for (int n = 0; n < 2; ++n) for (int j = 0; j < 4; ++j) {
                const size_t col = (size_t)cur.pn * 256 + bj * 128 + wc * 32 + (Epi::PERM ? 8 * fq + 4 * n : 16 * n + 4 * fq) + j;
                const bf16_t* bp = g.Bt + col * g.K; float s = 0.f;
                for (int k = 0; k < g.K; ++k) s += bf2f(ap[k]) * bf2f(bp[k]);
                acc[ai][bj][m][n][j] = s; } }
        E(acc, cur, wr, wc, fr, fq);
    }
    __syncthreads();
}
#endif
}

using pg8::Unit;
constexpr int HALFT = 128;
struct EpiF32 {
    static constexpr bool PERM = false, AFTER_DRAIN = false;
    float* C; int ldc;
    __device__ __forceinline__ void operator()(const f32x4 (&acc)[2][2][4][2], const Unit& u, int wr, int wc, int fr, int fq) const {
        const int row0 = u.pm * 256 + wr * 64 + fr, col0 = u.pn * 256 + wc * 32 + 4 * fq;
#pragma unroll
        for (int ai = 0; ai < 2; ++ai)
#pragma unroll
            for (int m = 0; m < 4; ++m) { float* rowp = C + (size_t)(row0 + ai * HALFT + m * 16) * ldc + col0;
#pragma unroll
                for (int bj = 0; bj < 2; ++bj)
#pragma unroll
                    for (int n = 0; n < 2; ++n) *(f32x4*)(rowp + bj * HALFT + n * 16) = acc[ai][bj][m][n]; }
    }
};
struct EpiResidual {
    static constexpr bool PERM = false, AFTER_DRAIN = false;
    const float* res; float* out;
    __device__ __forceinline__ void operator()(const f32x4 (&acc)[2][2][4][2], const Unit& u, int wr, int wc, int fr, int fq) const {
        const int row0 = u.pm * 256 + wr * 64 + fr, col0 = u.pn * 256 + wc * 32 + 4 * fq;
#pragma unroll
        for (int ai = 0; ai < 2; ++ai) {
            f32x4 rv[4][2][2];
#pragma unroll
            for (int m = 0; m < 4; ++m) { const size_t o = (size_t)(row0 + ai * HALFT + m * 16) * D + col0;
#pragma unroll
                for (int bj = 0; bj < 2; ++bj)
#pragma unroll
                    for (int n = 0; n < 2; ++n) rv[m][bj][n] = *(const GAS f32x4*)(res + o + bj * HALFT + n * 16); }
#pragma unroll
            for (int m = 0; m < 4; ++m) { const size_t o = (size_t)(row0 + ai * HALFT + m * 16) * D + col0;
#pragma unroll
                for (int bj = 0; bj < 2; ++bj)
#pragma unroll
                    for (int n = 0; n < 2; ++n) *(GAS f32x4*)(out + o + bj * HALFT + n * 16) = rv[m][bj][n] + acc[ai][bj][m][n]; }
        }
    }
};
struct EpiBf16 {
    static constexpr bool PERM = true, AFTER_DRAIN = false;
    bf16* O; int ldc; const float* rowscale; int rs_stride;
    __device__ __forceinline__ void operator()(const f32x4 (&acc)[2][2][4][2], const Unit& u, int wr, int wc, int fr, int fq) const {
        const int row0 = u.pm * 256 + wr * 64 + fr, col0 = u.pn * 256 + wc * 32 + 8 * fq;
#pragma unroll
        for (int ai = 0; ai < 2; ++ai)
#pragma unroll
            for (int m = 0; m < 4; ++m) { const int row = row0 + ai * HALFT + m * 16; bf16* rowp = O + (size_t)row * ldc + col0;
                const float sc = rowscale ? rowscale[(size_t)row * rs_stride] : 1.0f;
#pragma unroll
                for (int bj = 0; bj < 2; ++bj) { const f32x4 v0 = acc[ai][bj][m][0] * sc, v1 = acc[ai][bj][m][1] * sc;
                    u32x4 w; w.x = pk2(v0[0], v0[1]); w.y = pk2(v0[2], v0[3]); w.z = pk2(v1[0], v1[1]); w.w = pk2(v1[2], v1[3]);
                    *(u32x4*)(rowp + bj * HALFT) = w; } }
    }
};
struct EpiSwiGLU {
    static constexpr bool PERM = true, AFTER_DRAIN = false;
    bf16* O; int ldc; int ntile;
    __device__ __forceinline__ void operator()(const f32x4 (&acc)[2][2][4][2], const Unit& u, int wr, int wc, int fr, int fq) const {
        const int row0 = u.pm * 256 + wr * 64 + fr, col0 = (u.pn % ntile) * 128 + wc * 32 + 8 * fq;
#pragma unroll
        for (int ai = 0; ai < 2; ++ai)
#pragma unroll
            for (int m = 0; m < 4; ++m) { bf16* rowp = O + (size_t)(row0 + ai * HALFT + m * 16) * ldc + col0;
                float a[8];
#pragma unroll
                for (int n = 0; n < 2; ++n)
#pragma unroll
                    for (int j = 0; j < 4; ++j) { const float g = acc[ai][0][m][n][j], up = acc[ai][1][m][n][j]; a[4 * n + j] = g * fast_rcp(1.0f + fast_exp(-g)) * up; }
                u32x4 w; w.x = pk2(a[0], a[1]); w.y = pk2(a[2], a[3]); w.z = pk2(a[4], a[5]); w.w = pk2(a[6], a[7]);
                *(u32x4*)rowp = w; }
    }
};
struct EpiZ {
    static constexpr bool PERM = true, AFTER_DRAIN = false;
    bf16* Z;
    __device__ __forceinline__ void operator()(const f32x4 (&acc)[2][2][4][2], const Unit& u, int wr, int wc, int fr, int fq) const {
        const int i = u.pn >> 2, pnl = u.pn & 3, pml = u.pm - i * (TH / 256);
        const int row0 = pml * 256 + wr * 64 + fr, col0 = i * D + pnl * 256 + wc * 32 + 8 * fq;
#pragma unroll
        for (int ai = 0; ai < 2; ++ai)
#pragma unroll
            for (int m = 0; m < 4; ++m) { bf16* rowp = Z + (size_t)(row0 + ai * HALFT + m * 16) * 4096 + col0;
#pragma unroll
                for (int bj = 0; bj < 2; ++bj) { const f32x4 v0 = acc[ai][bj][m][0], v1 = acc[ai][bj][m][1];
                    u32x4 w; w.x = pk2(v0[0], v0[1]); w.y = pk2(v0[2], v0[3]); w.z = pk2(v1[0], v1[1]); w.w = pk2(v1[2], v1[3]);
                    *(GAS u32x4*)(rowp + bj * HALFT) = w; } }
    }
};
struct BranchOrder {
    int nP, G, c;
    __device__ bool next(int i, Unit& u) const {
        const long L = (long)i * G + c; if (L >= (long)16 * nP) return false;
        const int br = (int)(L / (4 * nP)), r = (int)(L % (4 * nP)); u.pm = br * nP + (r >> 2); u.pn = br * 4 + (r & 3); return true;
    }
    __device__ __forceinline__ void a_ready(const Unit&) const {}
    __device__ __forceinline__ void done(const Unit&) const {}
};
struct EpiMerge {
    static constexpr bool PERM = false, AFTER_DRAIN = false;
    const bf16* Z; const float* gate_b; bf16* MG;
    __device__ __forceinline__ void operator()(const f32x4 (&acc)[2][2][4][2], const Unit& u, int wr, int wc, int fr, int fq) const {
        const int row0 = u.pm * 256 + wr * 64 + fr, col = u.pn * 64 + wc * 16 + 4 * fq;
        f32x4 gb[4];
#pragma unroll
        for (int i = 0; i < 4; ++i) gb[i] = *(const GAS f32x4*)(gate_b + i * D + col);
#pragma unroll
        for (int ai = 0; ai < 2; ++ai) {
            u32x2 zv[4][4];
#pragma unroll
            for (int m = 0; m < 4; ++m)
#pragma unroll
                for (int i = 0; i < 4; ++i) zv[m][i] = *(const GAS u32x2*)(Z + (size_t)(row0 + ai * HALFT + m * 16) * 4096 + i * D + col);
#pragma unroll
            for (int m = 0; m < 4; ++m) { const size_t row = (size_t)(row0 + ai * HALFT + m * 16);
                f32x4 s = (f32x4){0.f, 0.f, 0.f, 0.f};
#pragma unroll
                for (int bj = 0; bj < 2; ++bj)
#pragma unroll
                    for (int n = 0; n < 2; ++n) { const int i = 2 * bj + n; const unsigned z01 = zv[m][i].x, z23 = zv[m][i].y;
                        const f32x4 z = (f32x4){bf2f(z01 & 0xffffu), bf2f(z01 >> 16), bf2f(z23 & 0xffffu), bf2f(z23 >> 16)}; const f32x4 a = acc[ai][bj][m][n] + gb[i];
#pragma unroll
                        for (int j = 0; j < 4; ++j) s[j] += z[j] * fast_rcp(1.0f + fast_exp(-a[j])); }
                u32x2 w; w.x = pk2(s.x, s.y); w.y = pk2(s.z, s.w); *(GAS u32x2*)(MG + row * D + col) = w; }
        }
    }
};

constexpr size_t MiB = 1u << 20;
constexpr size_t al(size_t x) { return (x + 255) & ~(size_t)255; }
constexpr size_t WS_CTL = 0, CTL_BYTES = 1 * MiB;
constexpr size_t W_IN = 1 * MiB;
constexpr size_t W_GATE = W_IN + (size_t)PW * D * 2;
constexpr size_t W_UQ = W_GATE + (size_t)4096 * D * 2;
constexpr size_t W_UKV = W_UQ + (size_t)768 * 384 * 2;
constexpr size_t W_LORA = W_UKV + (size_t)1024 * 256 * 2;
constexpr size_t W_BR = W_LORA + (size_t)1536 * 384 * 2;
constexpr size_t W_OUT = W_BR + (size_t)4 * 1024 * 512 * 2;
constexpr size_t W_FGU = W_OUT + (size_t)D * D * 2;
constexpr size_t W_FDN = W_FGU + (size_t)NEXP * 2 * FF_E * D * 2;
constexpr size_t W_END = W_FDN + (size_t)NEXP * D * FF_E * 2;
constexpr size_t A_H = al(W_END);
constexpr size_t A_ROPE = A_H + (size_t)TH * D * 2;
constexpr size_t A_Y = A_ROPE + (size_t)TH * 64 * 4;
constexpr size_t A_P = A_Y + (size_t)4 * TH * 512 * 2;
constexpr size_t A_MIX = A_P + (size_t)TH * PW * 2;
constexpr size_t R_RKV = A_MIX;
constexpr size_t R_LOUT = R_RKV + (size_t)TH * 1536 * 2;
constexpr size_t R_O = R_LOUT + (size_t)TH * 1536 * 4;
constexpr size_t R_LIN = R_O + (size_t)TH * 512 * 4;
constexpr size_t R_REC = R_LIN + (size_t)TH * 384 * 2;
constexpr size_t R_END = R_REC + (size_t)BH * 8 * NCH * 61696;
constexpr size_t M_KR = al(R_END);
constexpr size_t M_Q = M_KR + (size_t)TH * 64 * 2;
constexpr size_t M_KV = M_Q + (size_t)TH * 768 * 2;
constexpr size_t M_VT = M_KV + (size_t)TH * 1024 * 2;
constexpr size_t M_END = M_VT + (size_t)TH * 512 * 2;
constexpr size_t G_CH = R_LIN;
constexpr size_t G_O = G_CH + al((size_t)BH * 4 * NCH * 78864);
constexpr size_t G_END = G_O + (size_t)TH * 512 * 4;
constexpr size_t S_ST = al(G_END);
constexpr size_t S_YD = S_ST + (size_t)BH * NCH * 8 * 64 * 128 * 2;
constexpr size_t S_C = S_YD + (size_t)TH * 512 * 4;
constexpr size_t S_AC = S_C + (size_t)BH * NCH * 2 * 17408;
constexpr size_t S_YO = S_AC + (size_t)TH * 8 * 4;
constexpr size_t S_END = S_YO + (size_t)TH * 512 * 4;
constexpr size_t A_Z = A_P;
constexpr size_t A_MG = A_MIX;
constexpr size_t F_ACT = A_P;
constexpr size_t F_GA = F_ACT + (size_t)MOE_ROWS * FF_E * 2;
constexpr size_t F_YE = F_GA + (size_t)MOE_ROWS * D * 2;
constexpr size_t F_TOPE = F_YE + (size_t)MOE_ROWS * D * 4;
constexpr size_t F_TOPW = F_TOPE + (size_t)TH * 2 * 4;
constexpr size_t F_SLOT = F_TOPW + (size_t)TH * 2 * 4;
constexpr size_t F_END = F_SLOT + (size_t)TH * 2 * 4;
constexpr size_t cmax(size_t a, size_t b) { return a > b ? a : b; }
constexpr size_t WS_NEED = cmax(cmax(cmax(M_END, R_END), cmax(G_END, S_END)), F_END);
#ifndef EMU
static_assert(WS_NEED <= (size_t)896 * MiB, "workspace");
#endif
constexpr int CW_BAR = 4096;
constexpr int CW_CNT = 16384;
constexpr int CW_WGC = 32768;

#ifdef EMU
#define WAVE_SYNC() emu_wave_sync()
#else
#define WAVE_SYNC() do { asm volatile("s_waitcnt lgkmcnt(0)" ::: "memory"); } while (0)
#endif
struct Frame {
    LAS unsigned char* lds; int tid, lane, wave, G, gw, NGW, bid;
    GAS float* out; GAS unsigned char* ws; GAS unsigned* ctl;
};
struct Args { const float* in[39]; float* out; unsigned char* ws; int lo, hi; };
#define WSP(type, off) ((type*)(F.ws + (off)))
#define AIN(A_, k) ((const float*)(const GAS float*)(A_).in[k])

template <class FN>
__device__ __forceinline__ void cvt_matrix(const Frame& F, const float* W, int ldw, int K, bf16* WT, int Ndst, const float* kscale, FN srccol) {
    LAS float* scr = (LAS float*)(F.lds + F.wave * 16384);
    const int nblk = Ndst / 32, nitems = (K / 64) * nblk, lane = F.lane;
    for (int item = F.gw; item < nitems; item += F.NGW) {
        const int kb = item / nblk, nb = item % nblk, k0 = 64 * kb, n0 = 32 * nb;
        const int sc = srccol(n0 + (lane & 31));
        float wv[32];
#pragma unroll
        for (int i = 0; i < 32; ++i) { const int kk = 2 * i + (lane >> 5); wv[i] = sc >= 0 ? W[(size_t)(k0 + kk) * ldw + sc] : 0.f; }
#pragma unroll
        for (int i = 0; i < 32; ++i) { const int kk = 2 * i + (lane >> 5); float v = wv[i]; if (kscale) v *= kscale[k0 + kk]; scr[kk * 33 + (lane & 31)] = v; }
        WAVE_SYNC();
        const int c = lane & 7;
#pragma unroll
        for (int j = 0; j < 4; ++j) { const int n = (lane >> 3) + 8 * j; const LAS float* s = scr + (8 * c) * 33 + n;
            u32x4 o; o.x = pk2(s[0 * 33], s[1 * 33]); o.y = pk2(s[2 * 33], s[3 * 33]); o.z = pk2(s[4 * 33], s[5 * 33]); o.w = pk2(s[6 * 33], s[7 * 33]);
            *(u32x4*)(WT + (size_t)(n0 + n) * K + k0 + 8 * c) = o; }
        WAVE_SYNC();
    }
}
__device__ __forceinline__ void phase_convert(const Frame& F, const Args& A, int layer) {
    const float* w_in = AIN(A, 3) + (size_t)layer * D * IN_COLS;
    cvt_matrix(F, w_in, IN_COLS, D, WSP(bf16, W_IN), PW, nullptr, [](int n) { return n < C_GATE ? n : -1; });
    cvt_matrix(F, w_in, IN_COLS, D, WSP(bf16, W_GATE), 4096, nullptr, [](int n) {
        const int pn = n >> 8, c = n & 255, bj = c >> 7, wc = (c >> 5) & 3, nn = (c >> 4) & 1, r = c & 15; return C_GATE + (2 * bj + nn) * D + 64 * pn + 16 * wc + r; });
    cvt_matrix(F, AIN(A, 6) + (size_t)layer * 384 * 768, 768, 384, WSP(bf16, W_UQ), 768, AIN(A, 4) + layer * 384, [](int n) { return n; });
    cvt_matrix(F, AIN(A, 7) + (size_t)layer * 256 * 1024, 1024, 256, WSP(bf16, W_UKV), 1024, AIN(A, 5) + layer * 256, [](int n) { return n; });
    for (int i = 0; i < 4; ++i) cvt_matrix(F, AIN(A, 30) + ((size_t)layer * 4 + i) * 512 * D, D, 512, WSP(bf16, W_BR) + (size_t)i * D * 512, D, nullptr, [](int n) { return n; });
    cvt_matrix(F, AIN(A, 31) + (size_t)layer * D * D, D, D, WSP(bf16, W_OUT), D, nullptr, [](int n) { return n; });
    if (layer == 0) {
        cvt_matrix(F, AIN(A, 33), 2 * FF_D, D, WSP(bf16, W_FGU), 2 * FF_D, nullptr, [](int n) { const int pn = n >> 8, c = n & 255; return c < 128 ? 128 * pn + c : FF_D + 128 * pn + (c - 128); });
        cvt_matrix(F, AIN(A, 34), D, FF_D, WSP(bf16, W_FDN), D, nullptr, [](int n) { return n; });
    } else {
        for (int e = 0; e < NEXP; ++e) {
            cvt_matrix(F, AIN(A, 36) + (size_t)e * D * 2 * FF_E, 2 * FF_E, D, WSP(bf16, W_FGU) + (size_t)e * 2 * FF_E * D, 2 * FF_E, nullptr, [](int n) { const int pn = n >> 8, c = n & 255; return c < 128 ? 128 * pn + c : FF_E + 128 * pn + (c - 128); });
            cvt_matrix(F, AIN(A, 37) + (size_t)e * FF_E * D, D, FF_E, WSP(bf16, W_FDN) + (size_t)e * D * FF_E, D, nullptr, [](int n) { return n; });
        }
    }
    { const float* w2 = AIN(A, 10) + (size_t)layer * 64 * 512; const float* a2 = AIN(A, 12) + (size_t)layer * 64 * 512; const float* g2 = AIN(A, 13) + (size_t)layer * 160 * 512;
      bf16* L = WSP(bf16, W_LORA);
      for (int idx = F.bid * 512 + F.tid; idx < 1536 * 384; idx += F.G * 512) { const int n = idx / 384, k = idx % 384; float v = 0.f;
          if (n < 512) { if (k < 64) v = w2[k * 512 + n]; } else if (n < 1024) { if (k >= 64 && k < 128) v = a2[(k - 64) * 512 + (n - 512)]; } else { if (k >= 128 && k < 288) v = g2[(k - 128) * 512 + (n - 1024)]; }
          L[idx] = (bf16)f2bf(v); } }
}

template <bool ROUTER>
__device__ __forceinline__ void phase_norm(const Frame& F, const Args& A, const float* xin, const float* gain, bf16* H, const float* router, int* tope, float* topw, unsigned* cnt) {
    const int lane = F.lane;
    LAS unsigned* lcnt = (LAS unsigned*)F.lds;
    if (ROUTER) { __syncthreads(); if (F.tid < 8) lcnt[F.tid] = 0u; __syncthreads(); }
    f32x4 gv[4];
#pragma unroll
    for (int j = 0; j < 4; ++j) gv[j] = *(const f32x4*)(gain + 4 * lane + 256 * j);
    for (int m = F.gw; m < TH; m += F.NGW) {
        const float* xr = xin + (size_t)m * D; f32x4 v[4]; float ss = 0.f;
#pragma unroll
        for (int j = 0; j < 4; ++j) { v[j] = *(const f32x4*)(xr + 4 * lane + 256 * j); ss += (v[j].x * v[j].x + v[j].y * v[j].y) + (v[j].z * v[j].z + v[j].w * v[j].w); }
        const float rstd = RSQRT(wave_sum(ss) * (1.0f / D) + EPS);
#pragma unroll
        for (int j = 0; j < 4; ++j) { v[j] = v[j] * rstd * gv[j]; st_bf16x4(H + (size_t)m * D + 4 * lane + 256 * j, v[j]); }
        if (ROUTER) {
            float lg[8];
#pragma unroll
            for (int e = 0; e < 8; ++e) lg[e] = 0.f;
#pragma unroll
            for (int j = 0; j < 4; ++j)
#pragma unroll
                for (int q = 0; q < 4; ++q) { const float* rp = router + (size_t)(4 * lane + 256 * j + q) * 8; const f32x4 r0 = *(const f32x4*)rp, r1 = *(const f32x4*)(rp + 4); const float hv = v[j][q];
                    lg[0] += hv * r0.x; lg[1] += hv * r0.y; lg[2] += hv * r0.z; lg[3] += hv * r0.w; lg[4] += hv * r1.x; lg[5] += hv * r1.y; lg[6] += hv * r1.z; lg[7] += hv * r1.w; }
#pragma unroll
            for (int e = 0; e < 8; ++e) lg[e] = wave_sum(lg[e]);
            if (lane == 0) {
                int e1 = 0; float l1 = lg[0];
#pragma unroll
                for (int e = 1; e < 8; ++e) if (lg[e] > l1) { l1 = lg[e]; e1 = e; }
                int e2 = -1; float l2 = -3.0e38f;
#pragma unroll
                for (int e = 0; e < 8; ++e) if (e != e1 && lg[e] > l2) { l2 = lg[e]; e2 = e; }
                const float w1 = 1.0f / (1.0f + expf(l2 - l1));
                tope[2 * m] = e1; tope[2 * m + 1] = e2; topw[2 * m] = w1; topw[2 * m + 1] = 1.0f - w1;
                ATOMIC_ADD_LDS(lcnt + e1, 1u); ATOMIC_ADD_LDS(lcnt + e2, 1u);
            }
        }
    }
    if (ROUTER) { __syncthreads(); if (F.tid < 8) cnt[F.bid * 8 + F.tid] = lcnt[F.tid]; __syncthreads(); }
}
__device__ __forceinline__ void phase_rope_table(const Frame& F, const Args& A, const int* pos, float* rope) {
    for (int idx = F.bid * 512 + F.tid; idx < TH * 32; idx += F.G * 512) { const int t = idx >> 5, i = idx & 31;
        const float inv = powf(10000.0f, -(float)i / 32.0f);
        const float ang = (float)pos[t] * inv; float sn, cs; sincosf(ang, &sn, &cs);
        rope[(size_t)t * 64 + i] = cs; rope[(size_t)t * 64 + 32 + i] = sn; }
}
__device__ __forceinline__ void phase_final_norm(const Frame& F, const Args& A, float* x, const float* gain) {
    const int lane = F.lane;
    for (int m = F.gw; m < T; m += F.NGW) {
        float* xr = x + (size_t)m * D; f32x4 v[4]; float ss = 0.f;
#pragma unroll
        for (int j = 0; j < 4; ++j) { v[j] = *(const f32x4*)(xr + 4 * lane + 256 * j); ss += (v[j].x * v[j].x + v[j].y * v[j].y) + (v[j].z * v[j].z + v[j].w * v[j].w); }
        const float rstd = RSQRT(wave_sum(ss) * (1.0f / D) + EPS);
#pragma unroll
        for (int j = 0; j < 4; ++j) *(f32x4*)(xr + 4 * lane + 256 * j) = v[j] * rstd * *(const f32x4*)(gain + 4 * lane + 256 * j);
    }
}

__device__ __forceinline__ void phase_mla_prep(const Frame& F, const Args& A) {
    bf16* P = WSP(bf16, A_P); bf16* kr = WSP(bf16, M_KR); const float* rope = WSP(float, A_ROPE);
    const int lane = F.lane;
    for (int m = F.gw; m < TH; m += F.NGW) {
        bf16* pr = P + (size_t)m * PW; float sq = 0.f, skv = 0.f; f32x4 v[3];
#pragma unroll
        for (int j = 0; j < 3; ++j) { const int c = 4 * lane + 256 * j; v[j] = ld_bf16x4(pr + c); const float s = (v[j].x * v[j].x + v[j].y * v[j].y) + (v[j].z * v[j].z + v[j].w * v[j].w);
            if (c < 384) sq += s; else if (c < 640) skv += s; }
        sq = wave_sum(sq); skv = wave_sum(skv);
        const float rq = RSQRT(sq * (1.0f / 384.0f) + EPS), rkv = RSQRT(skv * (1.0f / 256.0f) + EPS);
#pragma unroll
        for (int j = 0; j < 3; ++j) { const int c = 4 * lane + 256 * j; if (c < 640) st_bf16x4(pr + c, v[j] * (c < 384 ? rq : rkv)); }
        if (lane < 32) { const float x1 = bf2f(pr[640 + lane]), x2 = bf2f(pr[672 + lane]), c = rope[(size_t)m * 64 + lane], s = rope[(size_t)m * 64 + 32 + lane];
            kr[(size_t)m * 64 + lane] = (bf16)f2bf(x1 * c - x2 * s); kr[(size_t)m * 64 + 32 + lane] = (bf16)f2bf(x2 * c + x1 * s); }
    }
}
__device__ __forceinline__ void phase_mla_q(const Frame& F, const Args& A) {
    pg8::Gemm g{WSP(bf16, A_P) + 0, WSP(bf16, W_UQ), PW, 384}; pg8::StaticOrder S; S.init(TH, 768, F.G, F.bid);
    EpiBf16 E{WSP(bf16, M_Q), 768, nullptr, 0}; pg8::gemm_phase(F.lds, g, S, E, F.tid);
}
struct EpiKV {
    static constexpr bool PERM = true, AFTER_DRAIN = false;
    bf16* KV; bf16* VT;
    __device__ __forceinline__ void operator()(const f32x4 (&acc)[2][2][4][2], const Unit& u, int wr, int wc, int fr, int fq) const {
        const int row0 = u.pm * 256 + wr * 64 + fr, col0 = wc * 32 + 8 * fq;
#pragma unroll
        for (int ai = 0; ai < 2; ++ai)
#pragma unroll
            for (int m = 0; m < 4; ++m) { const int row = row0 + ai * HALFT + m * 16;
                { const f32x4 v0 = acc[ai][0][m][0], v1 = acc[ai][0][m][1]; u32x4 w; w.x = pk2(v0[0], v0[1]); w.y = pk2(v0[2], v0[3]); w.z = pk2(v1[0], v1[1]); w.w = pk2(v1[2], v1[3]);
                  *(u32x4*)(KV + (size_t)row * 1024 + u.pn * 256 + col0) = w; }
                const int b = row / SEQ, t = row % SEQ; bf16* vt = VT + ((size_t)(b * 4 + u.pn) * 128 + col0) * SEQ + t;
#pragma unroll
                for (int n = 0; n < 2; ++n)
#pragma unroll
                    for (int j = 0; j < 4; ++j) vt[(size_t)(4 * n + j) * SEQ] = (bf16)f2bf(acc[ai][1][m][n][j]); }
    }
};
__device__ __forceinline__ void phase_mla_kv(const Frame& F, const Args& A) {
    pg8::Gemm g{WSP(bf16, A_P) + 384, WSP(bf16, W_UKV), PW, 256}; pg8::StaticOrder S; S.init(TH, 1024, F.G, F.bid);
    EpiKV E{WSP(bf16, M_KV), WSP(bf16, M_VT)}; pg8::gemm_phase(F.lds, g, S, E, F.tid);
}
constexpr int AT_KS = 200, AT_VS = 72;
constexpr int AT_KBYTES = 64 * AT_KS * 2, AT_VBYTES = 128 * AT_VS * 2;
__device__ __forceinline__ void phase_attention(const Frame& F, const Args& A) {
    const bf16* Q = WSP(bf16, M_Q); const bf16* KV = WSP(bf16, M_KV); const bf16* KR = WSP(bf16, M_KR); const bf16* VTg = WSP(bf16, M_VT); const float* rope = WSP(float, A_ROPE); bf16* Y = WSP(bf16, A_Y);
    const int lane = F.lane, w = F.wave, l15 = lane & 15, q4 = lane >> 4, tid = F.tid, grp = w >> 2, wq = w & 3;
    const int NQB = SEQ / 128, nunits = BH * 4 * NQB;
    const float sc2 = 0.07216878364870322f * 1.4426950408889634f;
    for (int unit = F.bid; unit < nunits; unit += F.G) {
        const int qb = NQB - 1 - (unit / (BH * 4)), bh = unit % (BH * 4), h = bh & 3, b = bh >> 2;
        const size_t t0 = (size_t)b * SEQ;
        bf16x8 qf[2][6];
#pragma unroll
        for (int f = 0; f < 2; ++f) { const size_t tq = t0 + qb * 128 + wq * 32 + 16 * f + l15;
#pragma unroll
            for (int ks = 0; ks < 6; ++ks) qf[f][ks] = *(const bf16x8*)(Q + tq * 768 + h * 192 + 32 * ks + 8 * q4);
            const bf16x8 a = qf[f][4], c2 = qf[f][5];
#pragma unroll
            for (int j = 0; j < 8; ++j) { const float x1 = bf2f((unsigned short)a[j]), x2 = bf2f((unsigned short)c2[j]), c = rope[tq * 64 + 8 * q4 + j], sn = rope[tq * 64 + 32 + 8 * q4 + j];
                qf[f][4][j] = (short)f2bf(x1 * c - x2 * sn); qf[f][5][j] = (short)f2bf(x2 * c + x1 * sn); } }
        f32x4 o[2][8];
#pragma unroll
        for (int f = 0; f < 2; ++f)
#pragma unroll
            for (int mb = 0; mb < 8; ++mb) o[f][mb] = (f32x4){0.f, 0.f, 0.f, 0.f};
        float mrow[2] = {-3.0e38f, -3.0e38f}, lrow[2] = {0.f, 0.f};
        const int qchunk = 2 * qb + (wq >> 1), ntile = 2 * qb + 2;
        u32x4 pk_[3], pv_[2];
        const int skey = tid >> 3, c8 = tid & 7;
        const int okv = skey * 1024 + 8 * c8, okr = skey * 64 + 8 * c8, ovt = skey * SEQ + 8 * c8;
        const bf16* kvb = KV + t0 * 1024 + h * 256; const bf16* krb = KR + t0 * 64; const bf16* vtb = VTg + (size_t)(b * 4 + h) * 128 * SEQ;
#define AT_LOAD(kt) do { const bf16* kv_ = kvb + (size_t)(kt) * 65536; const bf16* kr_ = krb + (size_t)(kt) * 4096; const bf16* vt_ = vtb + (size_t)(kt) * 64; \
            pk_[0] = *(const u32x4*)(kv_ + okv); pk_[1] = *(const u32x4*)(kv_ + okv + 64); pk_[2] = *(const u32x4*)(kr_ + okr); \
            pv_[0] = *(const u32x4*)(vt_ + ovt); pv_[1] = *(const u32x4*)(vt_ + ovt + 64 * SEQ); } while (0)
#define AT_STORE(bufi) do { LAS bf16* Ks_ = (LAS bf16*)(F.lds + (bufi) * (AT_KBYTES + AT_VBYTES)); LAS bf16* Vt_ = (LAS bf16*)((LAS unsigned char*)Ks_ + AT_KBYTES); \
            *(LAS u32x4*)(Ks_ + skey * AT_KS + 8 * c8) = pk_[0]; *(LAS u32x4*)(Ks_ + skey * AT_KS + 8 * c8 + 64) = pk_[1]; *(LAS u32x4*)(Ks_ + skey * AT_KS + 8 * c8 + 128) = pk_[2]; \
            *(LAS u32x4*)(Vt_ + skey * AT_VS + 8 * c8) = pv_[0]; *(LAS u32x4*)(Vt_ + (skey + 64) * AT_VS + 8 * c8) = pv_[1]; } while (0)
        __syncthreads();
        AT_LOAD(0); AT_STORE(0);
        __syncthreads();
        for (int kt = 0; kt < ntile; ++kt) {
            if (kt + 1 < ntile) AT_LOAD(kt + 1);
            if (kt <= qchunk) {
                const LAS bf16* Ks = (const LAS bf16*)(F.lds + (kt & 1) * (AT_KBYTES + AT_VBYTES)); const LAS bf16* Vt = (const LAS bf16*)((const LAS unsigned char*)Ks + AT_KBYTES);
                f32x4 st[2][2];
#pragma unroll
                for (int kb = 0; kb < 2; ++kb) { st[0][kb] = (f32x4){0.f, 0.f, 0.f, 0.f}; st[1][kb] = (f32x4){0.f, 0.f, 0.f, 0.f};
#pragma unroll
                    for (int ks = 0; ks < 6; ++ks) { const bf16x8 kf = *(const LAS bf16x8*)(Ks + (32 * grp + 16 * kb + l15) * AT_KS + 32 * ks + 8 * q4);
                        st[0][kb] = MFMA_BF16(kf, qf[0][ks], st[0][kb]); st[1][kb] = MFMA_BF16(kf, qf[1][ks], st[1][kb]); } }
                bf16x8 pb[2];
#pragma unroll
                for (int f = 0; f < 2; ++f) {
                    float mx = -3.0e38f;
#pragma unroll
                    for (int kb = 0; kb < 2; ++kb) { st[f][kb] = st[f][kb] * sc2; mx = fmaxf(mx, fmaxf(fmaxf(st[f][kb].x, st[f][kb].y), fmaxf(st[f][kb].z, st[f][kb].w))); }
                    mx = fmaxf(mx, __shfl_xor(mx, 16)); mx = fmaxf(mx, __shfl_xor(mx, 32));
                    const float mnew = fmaxf(mrow[f], mx), alpha = exp2f(mrow[f] - mnew); mrow[f] = mnew;
                    float ps = 0.f;
#pragma unroll
                    for (int kb = 0; kb < 2; ++kb)
#pragma unroll
                        for (int r = 0; r < 4; ++r) { const float p = exp2f(st[f][kb][r] - mnew); ps += p; pb[f][4 * kb + r] = (short)f2bf(p); }
                    lrow[f] = lrow[f] * alpha + ps;
#pragma unroll
                    for (int mb = 0; mb < 8; ++mb) o[f][mb] = o[f][mb] * alpha;
                }
#pragma unroll
                for (int mb = 0; mb < 8; ++mb) { const LAS bf16* vp = Vt + (16 * mb + l15) * AT_VS + 32 * grp + 4 * q4;
                    const bf16x4 v0 = *(const LAS bf16x4*)vp, v1 = *(const LAS bf16x4*)(vp + 16);
                    bf16x8 vf; vf[0] = v0[0]; vf[1] = v0[1]; vf[2] = v0[2]; vf[3] = v0[3]; vf[4] = v1[0]; vf[5] = v1[1]; vf[6] = v1[2]; vf[7] = v1[3];
                    o[0][mb] = MFMA_BF16(vf, pb[0], o[0][mb]); o[1][mb] = MFMA_BF16(vf, pb[1], o[1][mb]); }
            }
            if (kt + 1 < ntile) AT_STORE((kt + 1) & 1);
            __syncthreads();
        }
#undef AT_LOAD
#undef AT_STORE
#pragma unroll
        for (int f = 0; f < 2; ++f) { lrow[f] += __shfl_xor(lrow[f], 16); lrow[f] += __shfl_xor(lrow[f], 32); }
        LAS float* xo = (LAS float*)F.lds + (size_t)wq * (2 * 8 * 4 * 64 + 4 * 64);
        if (grp == 1) {
#pragma unroll
            for (int f = 0; f < 2; ++f) {
#pragma unroll
                for (int mb = 0; mb < 8; ++mb)
#pragma unroll
                    for (int r = 0; r < 4; ++r) xo[((f * 8 + mb) * 4 + r) * 64 + lane] = o[f][mb][r];
                xo[2 * 8 * 4 * 64 + f * 64 + lane] = mrow[f]; xo[2 * 8 * 4 * 64 + 128 + f * 64 + lane] = lrow[f]; } }
        __syncthreads();
        if (grp == 0) {
#pragma unroll
            for (int f = 0; f < 2; ++f) { const float m1 = xo[2 * 8 * 4 * 64 + f * 64 + lane], l1 = xo[2 * 8 * 4 * 64 + 128 + f * 64 + lane];
                const float m = fmaxf(mrow[f], m1), a0 = exp2f(mrow[f] - m), a1 = exp2f(m1 - m), inv = 1.0f / (lrow[f] * a0 + l1 * a1);
                const size_t tq = t0 + qb * 128 + wq * 32 + 16 * f + l15;
#pragma unroll
                for (int mb = 0; mb < 8; ++mb) { f32x4 v;
#pragma unroll
                    for (int r = 0; r < 4; ++r) v[r] = (o[f][mb][r] * a0 + xo[((f * 8 + mb) * 4 + r) * 64 + lane] * a1) * inv;
                    st_bf16x4(Y + tq * 512 + h * 128 + 16 * mb + 4 * q4, v); } } }
    }
    __syncthreads();
}

__device__ __forceinline__ f32x4 tile_bf(const LAS bf16* a, int lda, const LAS bf16* bt, int ldb, int K, f32x4 acc, int l15, int q4) {
    const LAS bf16* ap = a + l15 * lda + 8 * q4; const LAS bf16* bp = bt + l15 * ldb + 8 * q4;
#pragma unroll 4
    for (int ks = 0; ks < K / 32; ++ks) acc = MFMA_BF16(*(const LAS bf16x8*)(ap + 32 * ks), *(const LAS bf16x8*)(bp + 32 * ks), acc);
    return acc;
}
__device__ __forceinline__ f32x4 tile_mm(const LAS float* a, int lda, int ska, const LAS float* b, int ldb, int scb, int K, f32x4 acc, int l15, int q4);


__device__ __forceinline__ void diag_solve16(const LAS float* Lblk  , int ldl, LAS float* xcol  , int ldx) {
    float x[16];
#pragma unroll
    for (int i = 0; i < 16; ++i) x[i] = xcol[i * ldx];
#pragma unroll
    for (int g = 0; g < 4; ++g) {
        f32x4 av[4][4];
#pragma unroll
        for (int ii = 0; ii < 4; ++ii)
#pragma unroll
            for (int c4 = 0; c4 <= g; ++c4) av[ii][c4] = *(const LAS f32x4*)(Lblk + (4 * g + ii) * ldl + 4 * c4);
#pragma unroll
        for (int ii = 0; ii < 4; ++ii) { const int i = 4 * g + ii; float sacc = x[i];
#pragma unroll
            for (int jj = 0; jj < i; ++jj) sacc -= av[ii][jj >> 2][jj & 3] * x[jj];
            x[i] = sacc; }
    }
#pragma unroll
    for (int i = 1; i < 16; ++i) xcol[i * ldx] = x[i];
}
__device__ __forceinline__ void tri_solve64(const LAS float* L, int ldl, LAS float* X, int ldx, int nct, LAS float* scr, int w, int l15, int q4) {
    LAS float* DI = scr;
    if (w < 4) { LAS float* T = DI + w * 320; LAS float* S = scr + 4 * 320 + w * 320; const LAS float* N = L + 16 * w * ldl + 16 * w;
#pragma unroll
        for (int r = 0; r < 4; ++r) { const int i = 4 * q4 + r; T[i * 20 + l15] = (i == l15 ? 1.0f : 0.0f) - (l15 < i ? N[i * ldl + l15] : 0.0f); }
        { const f32x4 a = tile_mm(N, ldl, 1, N, ldl, 1, 16, (f32x4){0.f, 0.f, 0.f, 0.f}, l15, q4);
#pragma unroll
          for (int r = 0; r < 4; ++r) S[(4 * q4 + r) * 20 + l15] = a[r]; }
        WAVE_SYNC();
#pragma unroll
        for (int it = 0; it < 3; ++it) {
            { const f32x4 a = tile_mm(T, 20, 1, S, 20, 1, 16, (f32x4){0.f, 0.f, 0.f, 0.f}, l15, q4);
#pragma unroll
              for (int r = 0; r < 4; ++r) T[(4 * q4 + r) * 20 + l15] += a[r]; }
            if (it < 2) { const f32x4 a = tile_mm(S, 20, 1, S, 20, 1, 16, (f32x4){0.f, 0.f, 0.f, 0.f}, l15, q4);
#pragma unroll
                for (int r = 0; r < 4; ++r) S[(4 * q4 + r) * 20 + l15] = a[r]; }
            WAVE_SYNC();
        } }
    __syncthreads();
    for (int ct = w; ct < nct; ct += 8) { LAS float* Xc = X + 16 * ct;
#pragma unroll
        for (int rb = 0; rb < 4; ++rb) {
            if (rb > 0) { const f32x4 a = tile_mm(L + 16 * rb * ldl, ldl, 1, Xc, ldx, 1, 16 * rb, (f32x4){0.f, 0.f, 0.f, 0.f}, l15, q4);
#pragma unroll
                for (int r = 0; r < 4; ++r) Xc[(16 * rb + 4 * q4 + r) * ldx + l15] -= a[r];
                WAVE_SYNC(); }
            const f32x4 y = tile_mm(DI + rb * 320, 20, 1, Xc + 16 * rb * ldx, ldx, 1, 16, (f32x4){0.f, 0.f, 0.f, 0.f}, l15, q4);
#pragma unroll
            for (int r = 0; r < 4; ++r) Xc[(16 * rb + 4 * q4 + r) * ldx + l15] = y[r];
            WAVE_SYNC();
        } }
}
__device__ __forceinline__ void phase_rwkv_prep(const Frame& F, const Args& A, int layer) {
    const bf16* P = WSP(bf16, A_P); bf16* RKV = WSP(bf16, R_RKV); bf16* LIN = WSP(bf16, R_LIN); const float* mu = AIN(A, 8) + (size_t)layer * 1824;
    const int lane = F.lane;
    for (int m = F.gw; m < TH; m += F.NGW) {
        const bool first = (m % SEQ) == 0; const bf16* pr = P + (size_t)m * PW + C_RWKV;
#pragma unroll
        for (int j = 0; j < 8; ++j) { const int c = 4 * lane + 256 * j;
            if (c < 1824) { const f32x4 p = ld_bf16x4(pr + c); const f32x4 pv = first ? (f32x4){0.f, 0.f, 0.f, 0.f} : ld_bf16x4(pr - PW + c); const f32x4 muv = *(const f32x4*)(mu + c);
                f32x4 x = p + (pv - p) * muv;
                if (c < 1536) st_bf16x4(RKV + (size_t)m * 1536 + c, x);
                else { if (c < 1600) { x.x = tanhf_(x.x); x.y = tanhf_(x.y); x.z = tanhf_(x.z); x.w = tanhf_(x.w); }
                       else if (c >= 1664) { x.x = sigmoidf_(x.x); x.y = sigmoidf_(x.y); x.z = sigmoidf_(x.z); x.w = sigmoidf_(x.w); }
                       st_bf16x4(LIN + (size_t)m * 384 + (c - 1536), x); } } }
        if (lane < 24) st_bf16x4(LIN + (size_t)m * 384 + 288 + 4 * lane, (f32x4){0.f, 0.f, 0.f, 0.f});
    }
}
__device__ __forceinline__ void phase_rwkv_lora(const Frame& F, const Args& A) {
    pg8::Gemm g{WSP(bf16, R_LIN), WSP(bf16, W_LORA), 384, 384}; pg8::StaticOrder S; S.init(TH, 1536, F.G, (F.bid + F.G / 2) % F.G);
    EpiF32 E{WSP(float, R_LOUT), 1536}; pg8::gemm_phase(F.lds, g, S, E, F.tid);
}
constexpr int RS = 72;
constexpr int RREC_COMMON = 4 * 64 * RS * 2 + 256;
constexpr int RREC_T = 64 * 64 * 2;
constexpr int RREC_BYTES = RREC_COMMON + 3 * RREC_T;
static_assert(RREC_BYTES == 61696, "record size (see R_REC in the workspace map)");
static_assert(RREC_COMMON % 16 == 0, "record alignment");
__device__ __forceinline__ void phase_rwkv_r1(const Frame& F, const Args& A, int layer) {
    const bf16* RKV = WSP(bf16, R_RKV); const float* LOUT = WSP(float, R_LOUT); unsigned char* REC = WSP(unsigned char, R_REC);
    const float* w0 = AIN(A, 9) + layer * 512; const float* a0 = AIN(A, 11) + layer * 512; const float* k_k = AIN(A, 14) + layer * 512; const float* k_a = AIN(A, 15) + layer * 512;
    LAS bf16* kbar = (LAS bf16*)F.lds; LAS bf16* atil = kbar + 64 * RS; LAS bf16* khat = atil + 64 * RS; LAS bf16* rbar = khat + 64 * RS;
    LAS bf16* atT = rbar + 64 * RS; LAS bf16* khT = atT + 64 * RS; LAS bf16* vT = khT + 64 * RS; LAS bf16* Bm = vT + 64 * RS; LAS bf16* Em = Bm + 64 * RS;
    LAS float* Am = (LAS float*)(Em + 64 * RS);
    LAS float* X = Am + 64 * 68;
    LAS float* lam = Am;
    const int w = F.wave;
    const int nunits = BH * 8 * NCH;
    for (int unit = F.bid; unit < nunits; unit += F.G) {
        int tid = F.tid; OPAQUE_V(tid); const int lane = tid & 63, l15 = lane & 15, q4 = lane >> 4;
        const int c = unit % NCH, h = (unit / NCH) & 7, b = unit / (NCH * 8);
        const size_t tok0 = (size_t)b * SEQ + (size_t)c * 64;
        const int j = lane, cj = h * 64 + j;
        __syncthreads();
        float r_[8], km_[8], kk_[8], ka_[8], v_[8], L_[8];
        { const float w0c = w0[cj], a0c = a0[cj], kkc = k_k[cj], kac = k_a[cj]; float run = 0.f;
#pragma unroll
          for (int q = 0; q < 8; ++q) { const int t = 8 * w + q; const size_t tok = tok0 + t;
              const float r = bf2f(RKV[tok * 1536 + cj]), k = bf2f(RKV[tok * 1536 + 512 + cj]); v_[q] = bf2f(RKV[tok * 1536 + 1024 + cj]);
              const float wpre = LOUT[tok * 1536 + cj], apre = LOUT[tok * 1536 + 512 + cj];
              const float wl = -softplusf_(-(w0c + wpre)) - 0.5f, a = sigmoidf_(a0c + apre);
              const float kr = k * kkc, ss = wave_sum(kr * kr), kk = kr * RSQRT(ss + EPS);
              r_[q] = r; km_[q] = k * (1.0f + (a - 1.0f) * kac); kk_[q] = kk; ka_[q] = kk * a;
              run += -expf(wl); L_[q] = run; }
          lam[w * 64 + j] = run; }
        __syncthreads();
        { float base = 0.f, Lend = 0.f;
#pragma unroll
          for (int ww = 0; ww < 8; ++ww) { const float tw = lam[ww * 64 + j]; if (ww < w) base += tw; Lend += tw; }
#pragma unroll
          for (int q = 0; q < 8; ++q) { const int t = 8 * w + q; const float L = base + L_[q], Lm1 = q ? base + L_[q - 1] : base;
              const float eG = expf(L), eGi = expf(-L), eGm1 = expf(Lm1), eT = expf(Lend - L);
              const float kb = kk_[q] * eGm1;
              kbar[t * RS + j] = (bf16)f2bf(kb); X[t * 132 + j] = kb;
              atil[t * RS + j] = (bf16)f2bf(ka_[q] * eGi); khat[t * RS + j] = (bf16)f2bf(km_[q] * eGi); rbar[t * RS + j] = (bf16)f2bf(r_[q] * eG);
              atT[j * RS + t] = (bf16)f2bf(-ka_[q] * eT); khT[j * RS + t] = (bf16)f2bf(km_[q] * eT); vT[j * RS + t] = (bf16)f2bf(v_[q]); }
          if (w == 0) { float* gc = (float*)(REC + (size_t)unit * RREC_BYTES + 4 * 64 * RS * 2); gc[j] = expf(Lend); } }
        __syncthreads();
        unsigned char* rec = REC + (size_t)unit * RREC_BYTES;
        { const int which = w >> 1, tib = 2 * (w & 1);
          const LAS bf16* Aop = (which & 2) ? rbar : kbar; const LAS bf16* Bop = (which & 1) ? khat : atil;
          bf16x8 aF[2][2], bF[4][2];
#pragma unroll
          for (int t = 0; t < 2; ++t)
#pragma unroll
              for (int ks = 0; ks < 2; ++ks) aF[t][ks] = *(const LAS bf16x8*)(Aop + (16 * (tib + t) + l15) * RS + 8 * q4 + 32 * ks);
#pragma unroll
          for (int tj = 0; tj < 4; ++tj)
#pragma unroll
              for (int ks = 0; ks < 2; ++ks) bF[tj][ks] = *(const LAS bf16x8*)(Bop + (16 * tj + l15) * RS + 8 * q4 + 32 * ks);
          f32x4 acc[2][4];
#pragma unroll
          for (int t = 0; t < 2; ++t)
#pragma unroll
              for (int tj = 0; tj < 4; ++tj) { acc[t][tj] = MFMA_BF16(aF[t][0], bF[tj][0], ((f32x4){0.f, 0.f, 0.f, 0.f})); acc[t][tj] = MFMA_BF16(aF[t][1], bF[tj][1], acc[t][tj]); }
#pragma unroll
          for (int t = 0; t < 2; ++t)
#pragma unroll
              for (int tj = 0; tj < 4; ++tj)
#pragma unroll
                  for (int r = 0; r < 4; ++r) { const int i = 16 * (tib + t) + 4 * q4 + r, jj = 16 * tj + l15; const bool keep = (which & 2) ? (jj <= i) : (jj < i); const float v = keep ? acc[t][tj][r] : 0.f;
                      if (which == 0) Am[i * 68 + jj] = v; else if (which == 1) Bm[i * RS + jj] = (bf16)f2bf(v); else if (which == 3) Em[i * RS + jj] = (bf16)f2bf(v);
                      else ((bf16*)(rec + 2 * 64 * RS * 2))[i * RS + jj] = (bf16)f2bf(-v); } }
        __syncthreads();
        { const int tj = w & 3, pb = 6 * (w >> 2);
          bf16x8 bF[2]; f32x4 acc[6];
#pragma unroll
          for (int ks = 0; ks < 2; ++ks) bF[ks] = *(const LAS bf16x8*)(vT + (16 * tj + l15) * RS + 8 * q4 + 32 * ks);
#pragma unroll
          for (int pq = 0; pq < 6; ++pq) { const int pair = pb + pq, which = pair >> 2, ti = pair & 3; const LAS bf16* aop = which == 0 ? Bm : which == 1 ? Em : khT;
              const bf16x8 a0 = *(const LAS bf16x8*)(aop + (16 * ti + l15) * RS + 8 * q4), a1 = *(const LAS bf16x8*)(aop + (16 * ti + l15) * RS + 8 * q4 + 32);
              acc[pq] = MFMA_BF16(a0, bF[0], ((f32x4){0.f, 0.f, 0.f, 0.f})); acc[pq] = MFMA_BF16(a1, bF[1], acc[pq]); }
#pragma unroll
          for (int pq = 0; pq < 6; ++pq) { const int pair = pb + pq, which = pair >> 2, ti = pair & 3;
              if (which == 0) {
#pragma unroll
                  for (int r = 0; r < 4; ++r) X[(16 * ti + 4 * q4 + r) * 132 + 64 + 16 * tj + l15] = acc[pq][r]; }
              else st_bf16x4((bf16*)(rec + RREC_COMMON + which * RREC_T) + (16 * tj + l15) * 64 + 16 * ti + 4 * q4, acc[pq]); } }
        __syncthreads();
        tri_solve64(Am, 68, X, 132, 8, X + 64 * 132, w, l15, q4);
        __syncthreads();
        { const int t = tid >> 3, j0 = 8 * (tid & 7); float v[8];
#pragma unroll
          for (int q = 0; q < 8; ++q) v[q] = X[t * 132 + j0 + q];
          *(u32x4*)((bf16*)rec + t * RS + j0) = pack8(v);
          const int vv = tid >> 3, t0 = 8 * (tid & 7);
#pragma unroll
          for (int q = 0; q < 8; ++q) v[q] = X[(t0 + q) * 132 + 64 + vv];
          *(u32x4*)((bf16*)(rec + RREC_COMMON) + vv * 64 + t0) = pack8(v); }
        for (int e = tid; e < 64 * RS / 8; e += 512) { ((u32x4*)(rec + 64 * RS * 2))[e] = ((const LAS u32x4*)rbar)[e]; ((u32x4*)(rec + 3 * 64 * RS * 2))[e] = ((const LAS u32x4*)atT)[e]; }
    }
    __syncthreads();
}
constexpr int R2_BUF = RREC_COMMON;
__device__ __forceinline__ void phase_rwkv_r2(const Frame& F, const Args& A) {
    const unsigned char* REC = WSP(unsigned char, R_REC); float* RO = WSP(float, R_O);
    LAS unsigned char* buf0 = F.lds; LAS bf16* HT = (LAS bf16*)(F.lds + 2 * R2_BUF); LAS bf16* UT = HT + 2 * 64 * RS;
    const int tid = F.tid, lane = F.lane, w = F.wave, l15 = lane & 15, q4 = lane >> 4, ti = w >> 1;
    const int nunits = BH * 8;
    constexpr int NCHK = R2_BUF / 16;
    for (int unit = F.bid; unit < nunits; unit += F.G) {
        const int h = unit & 7, b = unit >> 3;
        __syncthreads();
        for (int e = tid; e < 2 * 64 * RS / 2; e += 512) ((LAS unsigned*)HT)[e] = 0u;
        f32x4 Hreg[2] = {(f32x4){0.f, 0.f, 0.f, 0.f}, (f32x4){0.f, 0.f, 0.f, 0.f}};
        u32x4 preA[5], preB[5]; u32x2 iniA[3][2], iniB[3][2], cur[3][2];
        const unsigned char* rec0 = REC + (size_t)((b * 8 + h) * NCH) * RREC_BYTES;
        const int tofs = ((16 * (2 * (w & 1)) + l15) * 64 + 16 * ti + 4 * q4) * 2;
#define R2_LOAD(S, recp) do { _Pragma("unroll") for (int q = 0; q < 5; ++q) { const int e = tid + 512 * q; if (e < NCHK) pre##S[q] = *(const u32x4*)((recp) + (size_t)e * 16); } \
            _Pragma("unroll") for (int mq = 0; mq < 3; ++mq) { ini##S[mq][0] = *(const u32x2*)((recp) + RREC_COMMON + mq * RREC_T + tofs); ini##S[mq][1] = *(const u32x2*)((recp) + RREC_COMMON + mq * RREC_T + tofs + 16 * 64 * 2); } } while (0)
#define R2_STORE(S, dst) do { _Pragma("unroll") for (int q = 0; q < 5; ++q) { const int e = tid + 512 * q; if (e < NCHK) *(LAS u32x4*)((dst) + (size_t)e * 16) = pre##S[q]; } } while (0)
#define R2_TAKE(S) do { _Pragma("unroll") for (int mq = 0; mq < 3; ++mq) { cur[mq][0] = ini##S[mq][0]; cur[mq][1] = ini##S[mq][1]; } } while (0)
        R2_LOAD(A, rec0); R2_STORE(A, buf0); R2_TAKE(A);
        if (NCH > 1) R2_LOAD(A, rec0 + (size_t)RREC_BYTES);
        __syncthreads();
#define R2_STEP(c, LS, SS) do { \
            LAS unsigned char* buf = buf0 + ((c) & 1) * R2_BUF; LAS unsigned char* nbuf = buf0 + (((c) + 1) & 1) * R2_BUF; \
            if ((c) + 2 < NCH) R2_LOAD(LS, rec0 + (size_t)((c) + 2) * RREC_BYTES); \
            const LAS bf16* KB = (const LAS bf16*)buf; const LAS bf16* RB = KB + 64 * RS; const LAS bf16* FMn = RB + 64 * RS; const LAS bf16* ATn = FMn + 64 * RS; \
            const LAS float* GC = (const LAS float*)(buf + 4 * 64 * RS * 2); \
            const LAS bf16* H0 = HT + ((c) & 1) * 64 * RS; LAS bf16* H1 = HT + (((c) + 1) & 1) * 64 * RS; \
              \
            bf16x8 hf[2][2], uf[2][2], af[2]; \
            _Pragma("unroll") for (int t2 = 0; t2 < 2; ++t2) _Pragma("unroll") for (int ks = 0; ks < 2; ++ks) hf[t2][ks] = *(const LAS bf16x8*)(H0 + (16 * (2 * (w & 1) + t2) + l15) * RS + 8 * q4 + 32 * ks); \
            _Pragma("unroll") for (int ks = 0; ks < 2; ++ks) af[ks] = *(const LAS bf16x8*)(KB + (16 * ti + l15) * RS + 8 * q4 + 32 * ks); \
            _Pragma("unroll") for (int t2 = 0; t2 < 2; ++t2) { const int tj = 2 * (w & 1) + t2; \
                f32x4 u = (f32x4){bf2f(cur[0][t2].x & 0xffffu), bf2f(cur[0][t2].x >> 16), bf2f(cur[0][t2].y & 0xffffu), bf2f(cur[0][t2].y >> 16)}; \
                u = MFMA_BF16(af[0], hf[t2][0], u); u = MFMA_BF16(af[1], hf[t2][1], u); \
                u32x2 pk; pk.x = pk2(u[0], u[1]); pk.y = pk2(u[2], u[3]); *(LAS u32x2*)(UT + (16 * tj + l15) * RS + 16 * ti + 4 * q4) = pk; } \
            __syncthreads(); \
            _Pragma("unroll") for (int t2 = 0; t2 < 2; ++t2) _Pragma("unroll") for (int ks = 0; ks < 2; ++ks) uf[t2][ks] = *(const LAS bf16x8*)(UT + (16 * (2 * (w & 1) + t2) + l15) * RS + 8 * q4 + 32 * ks); \
            { bf16x8 rf[2], ff[2], tf[2]; \
              _Pragma("unroll") for (int ks = 0; ks < 2; ++ks) { rf[ks] = *(const LAS bf16x8*)(RB + (16 * ti + l15) * RS + 8 * q4 + 32 * ks); ff[ks] = *(const LAS bf16x8*)(FMn + (16 * ti + l15) * RS + 8 * q4 + 32 * ks); tf[ks] = *(const LAS bf16x8*)(ATn + (16 * ti + l15) * RS + 8 * q4 + 32 * ks); } \
              _Pragma("unroll") for (int t2 = 0; t2 < 2; ++t2) { const int tj = 2 * (w & 1) + t2; \
                f32x4 o = (f32x4){bf2f(cur[1][t2].x & 0xffffu), bf2f(cur[1][t2].x >> 16), bf2f(cur[1][t2].y & 0xffffu), bf2f(cur[1][t2].y >> 16)}; \
                o = MFMA_BF16(rf[0], hf[t2][0], o); o = MFMA_BF16(rf[1], hf[t2][1], o); o = MFMA_BF16(ff[0], uf[t2][0], o); o = MFMA_BF16(ff[1], uf[t2][1], o); \
                _Pragma("unroll") for (int r = 0; r < 4; ++r) RO[((size_t)b * SEQ + (size_t)(c) * 64 + 16 * ti + 4 * q4 + r) * 512 + h * 64 + 16 * tj + l15] = o[r]; \
                const f32x4 kv = (f32x4){bf2f(cur[2][t2].x & 0xffffu), bf2f(cur[2][t2].x >> 16), bf2f(cur[2][t2].y & 0xffffu), bf2f(cur[2][t2].y >> 16)}; \
                _Pragma("unroll") for (int r = 0; r < 4; ++r) Hreg[t2][r] = Hreg[t2][r] * GC[16 * ti + 4 * q4 + r] + kv[r]; \
                Hreg[t2] = MFMA_BF16(tf[0], uf[t2][0], Hreg[t2]); Hreg[t2] = MFMA_BF16(tf[1], uf[t2][1], Hreg[t2]); \
                u32x2 pk; pk.x = pk2(Hreg[t2][0], Hreg[t2][1]); pk.y = pk2(Hreg[t2][2], Hreg[t2][3]); *(LAS u32x2*)(H1 + (16 * tj + l15) * RS + 16 * ti + 4 * q4) = pk; } } \
            if ((c) + 1 < NCH) { R2_STORE(SS, nbuf); R2_TAKE(SS); } \
            __syncthreads(); } while (0)
        for (int c = 0; c < NCH; c += 2) { R2_STEP(c, B, A); R2_STEP(c + 1, A, B); }
#undef R2_STEP
#undef R2_STORE
#undef R2_TAKE
#undef R2_LOAD
    }
    __syncthreads();
}
__device__ __forceinline__ void phase_rwkv_post(const Frame& F, const Args& A, int layer) {
    const bf16* RKV = WSP(bf16, R_RKV); const float* LOUT = WSP(float, R_LOUT); const float* RO = WSP(float, R_O); bf16* Y = WSP(bf16, A_Y) + (size_t)1 * TH * 512;
    const float* a0 = AIN(A, 11) + layer * 512; const float* k_a = AIN(A, 15) + layer * 512; const float* r_k = AIN(A, 16) + layer * 512; const float* ln_w = AIN(A, 17) + layer * 512; const float* ln_b = AIN(A, 18) + layer * 512;
    const int lane = F.lane, c0 = 8 * lane;
    for (int m = F.gw; m < TH; m += F.NGW) {
        float o[8], r[8], k[8], v[8], ap[8], g[8];
        { const f32x4 a = *(const f32x4*)(RO + (size_t)m * 512 + c0), b2 = *(const f32x4*)(RO + (size_t)m * 512 + c0 + 4); o[0] = a.x; o[1] = a.y; o[2] = a.z; o[3] = a.w; o[4] = b2.x; o[5] = b2.y; o[6] = b2.z; o[7] = b2.w; }
#pragma unroll
        for (int hh = 0; hh < 2; ++hh) { const f32x4 rv = ld_bf16x4(RKV + (size_t)m * 1536 + c0 + 4 * hh), kv = ld_bf16x4(RKV + (size_t)m * 1536 + 512 + c0 + 4 * hh), vv = ld_bf16x4(RKV + (size_t)m * 1536 + 1024 + c0 + 4 * hh);
            const f32x4 av = *(const f32x4*)(LOUT + (size_t)m * 1536 + 512 + c0 + 4 * hh), gv = *(const f32x4*)(LOUT + (size_t)m * 1536 + 1024 + c0 + 4 * hh);
#pragma unroll
            for (int q = 0; q < 4; ++q) { r[4 * hh + q] = rv[q]; k[4 * hh + q] = kv[q]; v[4 * hh + q] = vv[q]; ap[4 * hh + q] = av[q]; g[4 * hh + q] = gv[q]; } }
        float bon = 0.f, sm = 0.f;
#pragma unroll
        for (int q = 0; q < 8; ++q) { const float a = sigmoidf_(a0[c0 + q] + ap[q]); const float km = k[q] * (1.0f + (a - 1.0f) * k_a[c0 + q]); bon += r[q] * km * r_k[c0 + q]; sm += o[q]; }
        bon += __shfl_xor(bon, 1); bon += __shfl_xor(bon, 2); bon += __shfl_xor(bon, 4);
        sm += __shfl_xor(sm, 1); sm += __shfl_xor(sm, 2); sm += __shfl_xor(sm, 4);
        const float mean = sm * (1.0f / 64.0f); float vs = 0.f;
#pragma unroll
        for (int q = 0; q < 8; ++q) { const float d = o[q] - mean; vs += d * d; }
        vs += __shfl_xor(vs, 1); vs += __shfl_xor(vs, 2); vs += __shfl_xor(vs, 4);
        const float rstd = RSQRT(vs * (1.0f / 64.0f) + 64e-5f);
        float y[8];
#pragma unroll
        for (int q = 0; q < 8; ++q) y[q] = ((o[q] - mean) * rstd * ln_w[c0 + q] + ln_b[c0 + q] + bon * v[q]) * g[q];
        u32x4 wv; wv.x = pk2(y[0], y[1]); wv.y = pk2(y[2], y[3]); wv.z = pk2(y[4], y[5]); wv.w = pk2(y[6], y[7]);
        *(u32x4*)(Y + (size_t)m * 512 + c0) = wv;
    }
}

__device__ __forceinline__ void conv8x8(const bf16* src, int tl0  , const float* w  , int wld, const float* bias, float (&out)[8][8]) {
    float x[11][8];
#pragma unroll
    for (int i = 0; i < 11; ++i) { const int tl = tl0 - 3 + i;
        if (tl >= 0) { const u32x4 v = *(const u32x4*)(src + (ptrdiff_t)(i - 3) * PW);
            x[i][0] = bf2f(v.x & 0xffffu); x[i][1] = bf2f(v.x >> 16); x[i][2] = bf2f(v.y & 0xffffu); x[i][3] = bf2f(v.y >> 16); x[i][4] = bf2f(v.z & 0xffffu); x[i][5] = bf2f(v.z >> 16); x[i][6] = bf2f(v.w & 0xffffu); x[i][7] = bf2f(v.w >> 16); }
        else {
#pragma unroll
            for (int ch = 0; ch < 8; ++ch) x[i][ch] = 0.f; } }
    float wv[4][8], bv[8];
#pragma unroll
    for (int j = 0; j < 4; ++j) { const f32x4 a = *(const f32x4*)(w + j * wld), b = *(const f32x4*)(w + j * wld + 4); wv[j][0] = a.x; wv[j][1] = a.y; wv[j][2] = a.z; wv[j][3] = a.w; wv[j][4] = b.x; wv[j][5] = b.y; wv[j][6] = b.z; wv[j][7] = b.w; }
    if (bias) { const f32x4 a = *(const f32x4*)bias, b = *(const f32x4*)(bias + 4); bv[0] = a.x; bv[1] = a.y; bv[2] = a.z; bv[3] = a.w; bv[4] = b.x; bv[5] = b.y; bv[6] = b.z; bv[7] = b.w; }
    else {
#pragma unroll
        for (int ch = 0; ch < 8; ++ch) bv[ch] = 0.f; }
#pragma unroll
    for (int i = 0; i < 8; ++i)
#pragma unroll
        for (int ch = 0; ch < 8; ++ch) { const float a = bv[ch] + wv[0][ch] * x[i][ch] + wv[1][ch] * x[i + 1][ch] + wv[2][ch] * x[i + 2][ch] + wv[3][ch] * x[i + 3][ch]; out[i][ch] = a * fast_rcp(1.0f + fast_exp(-a)); }
}
constexpr int SB = 136;
constexpr int SC_IMG = 64 * SB * 2;
__device__ __forceinline__ void phase_ssd_s1(const Frame& F, const Args& A, int layer) {
    const bf16* P = WSP(bf16, A_P); bf16* ST = WSP(bf16, S_ST); float* YD = WSP(float, S_YD); unsigned char* SCB = WSP(unsigned char, S_C); float* AC = WSP(float, S_AC);
    const float* cw = AIN(A, 23) + (size_t)layer * 4 * 1024; const float* cb = AIN(A, 24) + layer * 1024; const float* dtb = AIN(A, 25) + layer * 8; const float* a_log = AIN(A, 26) + layer * 8; const float* dsk = AIN(A, 27) + layer * 8;
    LAS bf16* Bt_ = (LAS bf16*)F.lds; LAS bf16* Ct_ = Bt_ + 64 * SB; LAS bf16* BT = Ct_ + 64 * SB; LAS bf16* xT = BT + 128 * RS;
    LAS bf16* Mb = xT + 4 * 64 * RS; LAS bf16* xdT = Mb + 2 * 64 * RS; LAS float* dt = (LAS float*)(xdT + 2 * 64 * RS); LAS float* ac = dt + 256;
    const int tid = F.tid, lane = F.lane, w = F.wave, l15 = lane & 15, q4 = lane >> 4;
    const int nunits = BH * NCH * 2;
    for (int unit = F.bid; unit < nunits; unit += F.G) {
        const int g = unit & 1, c = (unit >> 1) % NCH, b = unit / (2 * NCH);
        const size_t tok0 = (size_t)b * SEQ + (size_t)c * 64;
        __syncthreads();
        {
            const int cg = tid & 63, rb = tid >> 6;
            const int cidx = cg < 32 ? g * 256 + 8 * cg : cg < 48 ? 512 + g * 128 + 8 * (cg - 32) : 768 + g * 128 + 8 * (cg - 48);
            float o[8][8];
            conv8x8(P + (tok0 + 8 * rb) * PW + C_SSD + 512 + cidx, c * 64 + 8 * rb, cw + cidx, 1024, cb + cidx, o);
            if (cg < 32) {
                const int hh = cg >> 3, p0 = 8 * (cg & 7);
#pragma unroll
                for (int ch = 0; ch < 8; ++ch) { float col[8];
#pragma unroll
                    for (int i = 0; i < 8; ++i) col[i] = o[i][ch];
                    *(LAS u32x4*)(xT + (hh * 64 + p0 + ch) * RS + 8 * rb) = pack8(col); }
            } else if (cg < 48) {
                const int n0 = 8 * (cg - 32);
#pragma unroll
                for (int i = 0; i < 8; ++i) *(LAS u32x4*)(Bt_ + (8 * rb + i) * SB + n0) = pack8(o[i]);
#pragma unroll
                for (int ch = 0; ch < 8; ++ch) { float col[8];
#pragma unroll
                    for (int i = 0; i < 8; ++i) col[i] = o[i][ch];
                    *(LAS u32x4*)(BT + (n0 + ch) * RS + 8 * rb) = pack8(col); }
            } else { const int n0 = 8 * (cg - 48);
#pragma unroll
                for (int i = 0; i < 8; ++i) *(LAS u32x4*)(Ct_ + (8 * rb + i) * SB + n0) = pack8(o[i]); }
        }
        if (tid < 256) { const int hh = tid >> 6, h = 4 * g + hh; const float d = softplusf_(bf2f(P[(tok0 + lane) * PW + C_SSD + 1536 + h]) + dtb[h]); float a = -expf(a_log[h]) * d;
#pragma unroll
            for (int o = 1; o < 64; o <<= 1) { const float t = __shfl_up(a, o); if (lane >= o) a += t; }
            dt[tid] = d; ac[tid] = a; AC[(tok0 + lane) * 8 + h] = a; }
        __syncthreads();
        { unsigned char* dst = SCB + (size_t)unit * SC_IMG; for (int e = tid; e < SC_IMG / 16; e += 512) ((u32x4*)dst)[e] = ((const LAS u32x4*)Ct_)[e]; }
        f32x4 cbt[2];
#pragma unroll
        for (int tt = 0; tt < 2; ++tt) { const int tile = w * 2 + tt, ti = tile >> 2, tj = tile & 3; cbt[tt] = (f32x4){0.f, 0.f, 0.f, 0.f};
            if (tj <= ti) cbt[tt] = tile_bf(Ct_ + 16 * ti * SB, SB, Bt_ + 16 * tj * SB, SB, 128, cbt[tt], l15, q4); }
        for (int hh = 0; hh < 4; ++hh) { const int h = 4 * g + hh; LAS bf16* M = Mb + (hh & 1) * 64 * RS; LAS bf16* xd = xdT + (hh & 1) * 64 * RS; const LAS float* dth = dt + hh * 64; const LAS float* ach = ac + hh * 64;
#pragma unroll
            for (int tt = 0; tt < 2; ++tt) { const int tile = w * 2 + tt, ti = tile >> 2, tj = tile & 3;
#pragma unroll
                for (int r = 0; r < 4; ++r) { const int l = 16 * ti + 4 * q4 + r, s = 16 * tj + l15; M[l * RS + s] = (bf16)f2bf((s <= l) ? cbt[tt][r] * expf(ach[l] - ach[s]) * dth[s] : 0.f); } }
            { const int p = tid >> 3, l0 = 8 * (tid & 7); const u32x4 v = *(const LAS u32x4*)(xT + (hh * 64 + p) * RS + l0); const float a63 = ach[63]; float xv[8] = {bf2f(v.x & 0xffffu), bf2f(v.x >> 16), bf2f(v.y & 0xffffu), bf2f(v.y >> 16), bf2f(v.z & 0xffffu), bf2f(v.z >> 16), bf2f(v.w & 0xffffu), bf2f(v.w >> 16)};
#pragma unroll
              for (int i = 0; i < 8; ++i) xv[i] *= dth[l0 + i] * expf(a63 - ach[l0 + i]);
              *(LAS u32x4*)(xd + p * RS + l0) = pack8(xv); }
            __syncthreads();
#pragma unroll
            for (int tt = 0; tt < 2; ++tt) { const int tile = w * 2 + tt, ti = tile >> 2, tj = tile & 3;
                const f32x4 acc = tile_bf(M + 16 * ti * RS, RS, xT + (hh * 64 + 16 * tj) * RS, RS, 64, (f32x4){0.f, 0.f, 0.f, 0.f}, l15, q4);
                const f32x4 xs = ld_bf16x4((const bf16*)(xT + (hh * 64 + 16 * tj + l15) * RS + 16 * ti + 4 * q4));
#pragma unroll
                for (int r = 0; r < 4; ++r) YD[(tok0 + 16 * ti + 4 * q4 + r) * 512 + h * 64 + 16 * tj + l15] = acc[r] + dsk[h] * xs[r]; }
            bf16* st = ST + ((size_t)((b * NCH + c) * 8 + h)) * 64 * 128;
#pragma unroll
            for (int tt = 0; tt < 4; ++tt) { const int tile = w * 4 + tt, ti = tile >> 2, tj = tile & 3;
                const f32x4 acc = tile_bf(BT + 16 * ti * RS, RS, xd + 16 * tj * RS, RS, 64, (f32x4){0.f, 0.f, 0.f, 0.f}, l15, q4);
                st_bf16x4(st + (16 * tj + l15) * 128 + 16 * ti + 4 * q4, acc); }
        }
    }
    __syncthreads();
}
__device__ __forceinline__ void phase_ssd_s23(const Frame& F, const Args& A) {
    const bf16* ST = WSP(bf16, S_ST); float* YO = WSP(float, S_YO); const unsigned char* SCB = WSP(unsigned char, S_C); const float* AC = WSP(float, S_AC);
    LAS bf16* Cimg = (LAS bf16*)F.lds; LAS bf16* Hb = Cimg + 2 * 64 * SB;
    const int tid = F.tid, lane = F.lane, w = F.wave, l15 = lane & 15, q4 = lane >> 4;
    const int nunits = BH * 8 * 4, hp = tid >> 5, hn = 4 * (tid & 31);
    constexpr int NCK = SC_IMG / 16;
    for (int unit = F.bid; unit < nunits; unit += F.G) {
        const int ps = unit & 3, h = (unit >> 2) & 7, b = unit >> 5, g = h >> 2;
        __syncthreads();
        f32x4 Hr = (f32x4){0.f, 0.f, 0.f, 0.f};
        u32x4 preA[3], preB[3]; u32x2 pstA, pstB, stc; float eaA[5], eaB[5], eac[5];
        const size_t tokb = (size_t)b * SEQ;
#define S23_LOAD(S, cc) do { const unsigned char* src_ = SCB + (size_t)((b * NCH + (cc)) * 2 + g) * SC_IMG; \
            _Pragma("unroll") for (int q = 0; q < 3; ++q) { const int e = tid + 512 * q; if (e < NCK) pre##S[q] = *(const u32x4*)(src_ + (size_t)e * 16); } \
            pst##S = *(const u32x2*)(ST + ((size_t)((b * NCH + (cc)) * 8 + h)) * 8192 + (16 * ps + hp) * 128 + hn); \
            _Pragma("unroll") for (int r = 0; r < 4; ++r) ea##S[r] = AC[(tokb + (size_t)(cc) * 64 + 16 * (w & 3) + 4 * q4 + r) * 8 + h]; \
            ea##S[4] = AC[(tokb + (size_t)(cc) * 64 + 63) * 8 + h]; } while (0)
#define S23_STORE(S, dst) do { _Pragma("unroll") for (int q = 0; q < 3; ++q) { const int e = tid + 512 * q; if (e < NCK) ((LAS u32x4*)(dst))[e] = pre##S[q]; } } while (0)
#define S23_TAKE(S) do { stc = pst##S; _Pragma("unroll") for (int r = 0; r < 5; ++r) eac[r] = ea##S[r]; } while (0)
        S23_LOAD(A, 0); S23_STORE(A, Cimg); S23_TAKE(A);
        if (NCH > 1) S23_LOAD(A, 1);
#define S23_STEP(c, LS, SS) do { \
            const size_t tok0 = tokb + (size_t)(c) * 64; \
            if ((c) + 2 < NCH) S23_LOAD(LS, (c) + 2); \
            st_bf16x4((bf16*)(Hb + hp * SB + hn), Hr); \
            __syncthreads(); \
            if (w < 4) { const LAS bf16* Ci = Cimg + ((c) & 1) * 64 * SB; \
                const f32x4 acc = tile_bf(Ci + 16 * w * SB, SB, Hb, SB, 128, (f32x4){0.f, 0.f, 0.f, 0.f}, l15, q4); \
                _Pragma("unroll") for (int r = 0; r < 4; ++r) { const size_t tok = tok0 + 16 * w + 4 * q4 + r; YO[tok * 512 + h * 64 + 16 * ps + l15] = acc[r] * expf(eac[r]); } } \
            { const float dec = expf(eac[4]); Hr.x = dec * Hr.x + bf2f(stc.x & 0xffffu); Hr.y = dec * Hr.y + bf2f(stc.x >> 16); Hr.z = dec * Hr.z + bf2f(stc.y & 0xffffu); Hr.w = dec * Hr.w + bf2f(stc.y >> 16); } \
            if ((c) + 1 < NCH) { S23_STORE(SS, Cimg + (((c) + 1) & 1) * 64 * SB); S23_TAKE(SS); } \
            __syncthreads(); } while (0)
        for (int c = 0; c < NCH; c += 2) { S23_STEP(c, B, A); S23_STEP(c + 1, A, B); }
#undef S23_STEP
#undef S23_TAKE
#undef S23_STORE
#undef S23_LOAD
    }
    __syncthreads();
}
__device__ __forceinline__ void phase_ssd_s4(const Frame& F, const Args& A, int layer) {
    const float* YD = WSP(float, S_YD); const float* YO = WSP(float, S_YO); const bf16* P = WSP(bf16, A_P); bf16* Y = WSP(bf16, A_Y) + (size_t)3 * TH * 512; const float* nw = AIN(A, 28) + layer * 512;
    const int lane = F.lane, c0 = 8 * lane;
    for (int m = F.gw; m < TH; m += F.NGW) {
        const f32x4 a = *(const f32x4*)(YD + (size_t)m * 512 + c0) + *(const f32x4*)(YO + (size_t)m * 512 + c0), b2 = *(const f32x4*)(YD + (size_t)m * 512 + c0 + 4) + *(const f32x4*)(YO + (size_t)m * 512 + c0 + 4);
        const f32x4 z0 = ld_bf16x4(P + (size_t)m * PW + C_SSD + c0), z1 = ld_bf16x4(P + (size_t)m * PW + C_SSD + c0 + 4);
        float y[8] = {a.x * siluf_(z0.x), a.y * siluf_(z0.y), a.z * siluf_(z0.z), a.w * siluf_(z0.w), b2.x * siluf_(z1.x), b2.y * siluf_(z1.y), b2.z * siluf_(z1.z), b2.w * siluf_(z1.w)};
        float ss = 0.f;
#pragma unroll
        for (int q = 0; q < 8; ++q) ss += y[q] * y[q];
        ss += __shfl_xor(ss, 1); ss += __shfl_xor(ss, 2); ss += __shfl_xor(ss, 4); ss += __shfl_xor(ss, 8); ss += __shfl_xor(ss, 16);
        const float rstd = RSQRT(ss * (1.0f / 256.0f) + EPS);
#pragma unroll
        for (int q = 0; q < 8; ++q) y[q] = y[q] * rstd * nw[c0 + q];
        u32x4 wv; wv.x = pk2(y[0], y[1]); wv.y = pk2(y[2], y[3]); wv.z = pk2(y[4], y[5]); wv.w = pk2(y[6], y[7]);
        *(u32x4*)(Y + (size_t)m * 512 + c0) = wv;
    }
}

__device__ __forceinline__ f32x4 tile_mm(const LAS float* a, int lda, int ska, const LAS float* b, int ldb, int scb, int K, f32x4 acc, int l15, int q4) {
    const LAS float* ap = a + l15 * lda + q4 * ska; const LAS float* bp = b + q4 * ldb + l15 * scb;
#pragma unroll 8
    for (int ks = 0; ks < K / 4; ++ks) acc = MFMA_F32(ap[ks * 4 * ska], bp[ks * 4 * ldb], acc);
    return acc;
}
constexpr int GS = 132, GS2 = 68;
constexpr int GR_W = 0, GR_QH = 64 * 136 * 2, GR_KT = 2 * 64 * 136 * 2, GR_QK = GR_KT + 128 * 72 * 2, GR_GL = GR_QK + 64 * 72 * 2, GR_COMMON = GR_GL + 16, GR_UT = 128 * 64 * 2, GR_BYTES = GR_COMMON + GR_UT;
static_assert(GR_BYTES == 78864 && GR_COMMON % 16 == 0, "GDN record");
constexpr int GX = 264;
__device__ __forceinline__ void phase_gdn_g1(const Frame& F, const Args& A, int layer) {
    const bf16* P = WSP(bf16, A_P); unsigned char* CHR = WSP(unsigned char, G_CH);
    const float* convw = AIN(A, 19) + (size_t)layer * 4 * 1536; const float* a_log = AIN(A, 20) + layer * 4; const float* dtb = AIN(A, 21) + layer * 4;
    LAS bf16* qb = (LAS bf16*)F.lds; LAS bf16* kb = qb + 64 * SB; LAS bf16* qkimg = kb + 64 * SB;
    LAS float* X = (LAS float*)(qkimg + 64 * RS); LAS float* Lm = X + 64 * GX; LAS float* ssq = Lm + 64 * GS2;
    LAS float* beta = ssq + 2 * 64 * 16; LAS float* gc = beta + 64; LAS float* egc = gc + 64; LAS float* inorm = egc + 64;
    const int w = F.wave;
    const int nunits = BH * 4 * NCH;
    for (int unit = F.bid; unit < nunits; unit += F.G) {
        int tid = F.tid; OPAQUE_V(tid); const int lane = tid & 63, l15 = lane & 15, q4 = lane >> 4;
        const int c = unit % NCH, h = (unit / NCH) & 3, b = unit / (NCH * 4);
        const size_t tok0 = (size_t)b * SEQ + (size_t)c * 64;
        unsigned char* rec = CHR + (size_t)unit * GR_BYTES;
        __syncthreads();
        const int rb = tid / 48, pc = tid % 48, part = pc >> 4, cgl = pc & 15;
        float o[8][8];
        if (tid < 384) { const int col = part * 512 + h * 128 + 8 * cgl;
            conv8x8(P + (tok0 + 8 * rb) * PW + C_GDN + col, c * 64 + 8 * rb, convw + col, 1536, nullptr, o);
            if (part < 2) {
#pragma unroll
                for (int i = 0; i < 8; ++i) { float sacc = 0.f;
#pragma unroll
                    for (int ch = 0; ch < 8; ++ch) sacc += o[i][ch] * o[i][ch];
                    ssq[(part * 64 + 8 * rb + i) * 16 + cgl] = sacc; } } }
        if (w == 7) { const size_t tok = tok0 + lane; beta[lane] = sigmoidf_(bf2f(P[tok * PW + C_GDN + 1536 + h]));
            float g = -expf(a_log[h]) * softplusf_(bf2f(P[tok * PW + C_GDN + 1540 + h]) + dtb[h]);
#pragma unroll
            for (int o2 = 1; o2 < 64; o2 <<= 1) { const float t = __shfl_up(g, o2); if (lane >= o2) g += t; }
            gc[lane] = g; egc[lane] = expf(g); }
        __syncthreads();
        if (tid < 128) { float sacc = 0.f;
#pragma unroll
            for (int i = 0; i < 16; ++i) sacc += ssq[tid * 16 + i];
            inorm[tid] = (tid < 64 ? 0.08838834764831845f : 1.0f) * RSQRT(sacc + EPS); }
        __syncthreads();
        if (tid < 384) {
#pragma unroll
            for (int i = 0; i < 8; ++i) { const int l = 8 * rb + i;
                if (part < 2) { const float sc = inorm[part * 64 + l]; float v[8];
#pragma unroll
                    for (int ch = 0; ch < 8; ++ch) v[ch] = o[i][ch] * sc;
                    *(LAS u32x4*)((part ? kb : qb) + l * SB + 8 * cgl) = pack8(v); }
                else { const float bl = beta[l]; *(LAS f32x4*)(X + l * GX + 8 * cgl) = (f32x4){o[i][0] * bl, o[i][1] * bl, o[i][2] * bl, o[i][3] * bl}; *(LAS f32x4*)(X + l * GX + 8 * cgl + 4) = (f32x4){o[i][4] * bl, o[i][5] * bl, o[i][6] * bl, o[i][7] * bl}; } } }
        __syncthreads();
        for (int tt = 0; tt < 4; ++tt) { const int tile = w * 4 + tt, which = tile >> 4, ti = (tile >> 2) & 3, tj = tile & 3;
            f32x4 acc = (f32x4){0.f, 0.f, 0.f, 0.f};
            if (tj <= ti) acc = tile_bf((which ? qb : kb) + 16 * ti * SB, SB, kb + 16 * tj * SB, SB, 128, acc, l15, q4);
#pragma unroll
            for (int r = 0; r < 4; ++r) { const int i = 16 * ti + 4 * q4 + r, j = 16 * tj + l15; float v = 0.f;
                if (which ? (j <= i) : (j < i)) v = acc[r] * expf(gc[i] - gc[j]) * (which ? 1.0f : beta[i]);
                if (which) qkimg[i * RS + j] = (bf16)f2bf(v); else Lm[i * GS2 + j] = v; } }
        { const float glast = gc[63];
          for (int e = tid; e < 64 * 16; e += 512) { const int l = e >> 4, d0 = 8 * (e & 15); const u32x4 kv = *(const LAS u32x4*)(kb + l * SB + d0), qv = *(const LAS u32x4*)(qb + l * SB + d0);
              const float kf[8] = {bf2f(kv.x & 0xffffu), bf2f(kv.x >> 16), bf2f(kv.y & 0xffffu), bf2f(kv.y >> 16), bf2f(kv.z & 0xffffu), bf2f(kv.z >> 16), bf2f(kv.w & 0xffffu), bf2f(kv.w >> 16)};
              float qf[8] = {bf2f(qv.x & 0xffffu), bf2f(qv.x >> 16), bf2f(qv.y & 0xffffu), bf2f(qv.y >> 16), bf2f(qv.z & 0xffffu), bf2f(qv.z >> 16), bf2f(qv.w & 0xffffu), bf2f(qv.w >> 16)};
              const float sc = beta[l] * egc[l], eg = egc[l];
              *(LAS f32x4*)(X + l * GX + 128 + d0) = (f32x4){kf[0] * sc, kf[1] * sc, kf[2] * sc, kf[3] * sc}; *(LAS f32x4*)(X + l * GX + 132 + d0) = (f32x4){kf[4] * sc, kf[5] * sc, kf[6] * sc, kf[7] * sc};
#pragma unroll
              for (int q = 0; q < 8; ++q) qf[q] *= eg;
              *(u32x4*)(rec + GR_QH + (size_t)(l * SB + d0) * 2) = pack8(qf); }
          for (int e = tid; e < 128 * 8; e += 512) { const int d = e >> 3, l0 = 8 * (e & 7); float kt[8];
#pragma unroll
              for (int q = 0; q < 8; ++q) kt[q] = bf2f(kb[(l0 + q) * SB + d]) * expf(glast - gc[l0 + q]);
              *(u32x4*)(rec + GR_KT + (size_t)(d * RS + l0) * 2) = pack8(kt); }
          if (tid == 0) *(float*)(rec + GR_GL) = expf(glast); }
        __syncthreads();
        for (int e = tid; e < 64 * RS / 8; e += 512) ((u32x4*)(rec + GR_QK))[e] = ((const LAS u32x4*)qkimg)[e];
        tri_solve64(Lm, GS2, X, GX, 16, ssq, w, l15, q4);
        __syncthreads();
        for (int e = tid; e < 64 * 16; e += 512) { const int l = e >> 4, d0 = 8 * (e & 15); const f32x4 a = *(const LAS f32x4*)(X + l * GX + 128 + d0), b2 = *(const LAS f32x4*)(X + l * GX + 132 + d0);
            const float v[8] = {a.x, a.y, a.z, a.w, b2.x, b2.y, b2.z, b2.w}; *(u32x4*)(rec + GR_W + (size_t)(l * SB + d0) * 2) = pack8(v); }
        for (int e = tid; e < 128 * 8; e += 512) { const int vv = e >> 3, t0 = 8 * (e & 7); float v[8];
#pragma unroll
            for (int q = 0; q < 8; ++q) v[q] = X[(t0 + q) * GX + vv];
            *(u32x4*)((bf16*)(rec + GR_COMMON) + vv * 64 + t0) = pack8(v); }
    }
    __syncthreads();
}
constexpr int G2_STAGE = GR_COMMON;
__device__ __forceinline__ void phase_gdn_g2(const Frame& F, const Args& A) {
    const unsigned char* CHR = WSP(unsigned char, G_CH); float* GO = WSP(float, G_O);
    LAS unsigned char* buf0 = F.lds; LAS bf16* STt = (LAS bf16*)(F.lds + 2 * G2_STAGE); LAS bf16* vnT = STt + 2 * 32 * SB;
    const int tid = F.tid, lane = F.lane, w = F.wave, l15 = lane & 15, q4 = lane >> 4, ti = w >> 1, tj = w & 1;
    const int nunits = BH * 4 * 4;
    constexpr int NCK = G2_STAGE / 16;
    for (int unit = F.bid; unit < nunits; unit += F.G) {
        const int vs = unit & 3, h = (unit >> 2) & 3, b = unit >> 4;
        __syncthreads();
        for (int e = tid; e < 2 * 32 * SB / 2; e += 512) ((LAS unsigned*)STt)[e] = 0u;
        f32x4 Sreg[2] = {(f32x4){0.f, 0.f, 0.f, 0.f}, (f32x4){0.f, 0.f, 0.f, 0.f}};
        u32x4 preA[8], preB[8]; u32x2 uiniA, uiniB, ucur;
        const unsigned char* rec0 = CHR + (size_t)((b * 4 + h) * NCH) * GR_BYTES;
        const int uofs = GR_COMMON + ((32 * vs + 16 * tj + l15) * 64 + 16 * ti + 4 * q4) * 2;
#define G2_LOAD(S, recp) do { _Pragma("unroll") for (int q = 0; q < 8; ++q) { const int e = tid + 512 * q; if (e < NCK) pre##S[q] = *(const u32x4*)((recp) + (size_t)e * 16); } uini##S = *(const u32x2*)((recp) + uofs); } while (0)
#define G2_STORE(S, dst) do { _Pragma("unroll") for (int q = 0; q < 8; ++q) { const int e = tid + 512 * q; if (e < NCK) *(LAS u32x4*)((dst) + (size_t)e * 16) = pre##S[q]; } } while (0)
        G2_LOAD(A, rec0); G2_STORE(A, buf0); ucur = uiniA;
        if (NCH > 1) G2_LOAD(A, rec0 + (size_t)GR_BYTES);
        __syncthreads();
#define G2_STEP(c, LS, SS) do { \
            LAS unsigned char* buf = buf0 + ((c) & 1) * G2_STAGE; LAS unsigned char* nbuf = buf0 + (((c) + 1) & 1) * G2_STAGE; \
            if ((c) + 2 < NCH) G2_LOAD(LS, rec0 + (size_t)((c) + 2) * GR_BYTES); \
            const LAS bf16* Wi = (const LAS bf16*)(buf + GR_W); const LAS bf16* QH = (const LAS bf16*)(buf + GR_QH); const LAS bf16* KT = (const LAS bf16*)(buf + GR_KT); const LAS bf16* QK = (const LAS bf16*)(buf + GR_QK); \
            const float egl = *(const LAS float*)(buf + GR_GL); \
            const LAS bf16* S0 = STt + ((c) & 1) * 32 * SB; LAS bf16* S1 = STt + (((c) + 1) & 1) * 32 * SB; \
            { const f32x4 acc = tile_bf(Wi + 16 * ti * SB, SB, S0 + 16 * tj * SB, SB, 128, (f32x4){0.f, 0.f, 0.f, 0.f}, l15, q4); \
              const f32x4 vn = (f32x4){bf2f(ucur.x & 0xffffu), bf2f(ucur.x >> 16), bf2f(ucur.y & 0xffffu), bf2f(ucur.y >> 16)} - acc; \
              u32x2 pk; pk.x = pk2(vn[0], vn[1]); pk.y = pk2(vn[2], vn[3]); *(LAS u32x2*)(vnT + (16 * tj + l15) * RS + 16 * ti + 4 * q4) = pk; } \
            __syncthreads(); \
            { f32x4 acc = tile_bf(QH + 16 * ti * SB, SB, S0 + 16 * tj * SB, SB, 128, (f32x4){0.f, 0.f, 0.f, 0.f}, l15, q4); \
              acc = tile_bf(QK + 16 * ti * RS, RS, vnT + 16 * tj * RS, RS, 64, acc, l15, q4); \
              _Pragma("unroll") for (int r = 0; r < 4; ++r) GO[((size_t)b * SEQ + (size_t)(c) * 64 + 16 * ti + 4 * q4 + r) * 512 + h * 128 + 32 * vs + 16 * tj + l15] = acc[r]; } \
            _Pragma("unroll") for (int t2 = 0; t2 < 2; ++t2) { Sreg[t2] = Sreg[t2] * egl; \
                Sreg[t2] = tile_bf(KT + 16 * w * RS, RS, vnT + 16 * t2 * RS, RS, 64, Sreg[t2], l15, q4); \
                u32x2 pk; pk.x = pk2(Sreg[t2][0], Sreg[t2][1]); pk.y = pk2(Sreg[t2][2], Sreg[t2][3]); *(LAS u32x2*)(S1 + (16 * t2 + l15) * SB + 16 * w + 4 * q4) = pk; } \
            if ((c) + 1 < NCH) { G2_STORE(SS, nbuf); ucur = uini##SS; } \
            __syncthreads(); } while (0)
        for (int c = 0; c < NCH; c += 2) { G2_STEP(c, B, A); G2_STEP(c + 1, A, B); }
#undef G2_STEP
#undef G2_STORE
#undef G2_LOAD
    }
    __syncthreads();
}
__device__ __forceinline__ void phase_gdn_g3(const Frame& F, const Args& A, int layer) {
    const float* GO = WSP(float, G_O); const bf16* P = WSP(bf16, A_P); bf16* Y = WSP(bf16, A_Y) + (size_t)2 * TH * 512; const float* nw = AIN(A, 22) + layer * 128;
    const int lane = F.lane, c0 = 8 * lane;
    for (int m = F.gw; m < TH; m += F.NGW) {
        const f32x4 a = *(const f32x4*)(GO + (size_t)m * 512 + c0), b2 = *(const f32x4*)(GO + (size_t)m * 512 + c0 + 4);
        float o[8] = {a.x, a.y, a.z, a.w, b2.x, b2.y, b2.z, b2.w}; float ss = 0.f;
#pragma unroll
        for (int q = 0; q < 8; ++q) ss += o[q] * o[q];
        ss += __shfl_xor(ss, 1); ss += __shfl_xor(ss, 2); ss += __shfl_xor(ss, 4); ss += __shfl_xor(ss, 8);
        const float rstd = RSQRT(ss * (1.0f / 128.0f) + EPS);
        const f32x4 z0 = ld_bf16x4(P + (size_t)m * PW + C_GDN + 1544 + c0), z1 = ld_bf16x4(P + (size_t)m * PW + C_GDN + 1544 + c0 + 4);
        const float z[8] = {z0.x, z0.y, z0.z, z0.w, z1.x, z1.y, z1.z, z1.w}; float y[8];
#pragma unroll
        for (int q = 0; q < 8; ++q) y[q] = o[q] * rstd * nw[(c0 + q) & 127] * siluf_(z[q]);
        u32x4 wv; wv.x = pk2(y[0], y[1]); wv.y = pk2(y[2], y[3]); wv.z = pk2(y[4], y[5]); wv.w = pk2(y[6], y[7]);
        *(u32x4*)(Y + (size_t)m * 512 + c0) = wv;
    }
}

__device__ __forceinline__ void phase_merge_z(const Frame& F, const Args& A) {
    pg8::Gemm g{WSP(bf16, A_Y), WSP(bf16, W_BR), 512, 512}; BranchOrder S; S.nP = TH / 256; S.G = F.G; S.c = F.bid;
    EpiZ E{WSP(bf16, A_Z)}; pg8::gemm_phase(F.lds, g, S, E, F.tid);
}
__device__ __forceinline__ void phase_merge_gate(const Frame& F, const Args& A, int layer) {
    pg8::Gemm g{WSP(bf16, A_H), WSP(bf16, W_GATE), D, D}; pg8::StaticOrder S; S.init(TH, 4096, F.G, F.bid);
    EpiMerge E{WSP(bf16, A_Z), AIN(A, 29) + (size_t)layer * 4 * D, WSP(bf16, A_MG)}; pg8::gemm_phase(F.lds, g, S, E, F.tid);
}
__device__ __forceinline__ void phase_merge_out(const Frame& F, const Args& A, const float* xin, float* xout) {
    pg8::Gemm g{WSP(bf16, A_MG), WSP(bf16, W_OUT), D, D}; pg8::StaticOrder S; S.init(TH, D, F.G, F.bid);
    EpiResidual E{xin, xout}; pg8::gemm_phase(F.lds, g, S, E, F.tid);
}
__device__ __forceinline__ void phase_ffn_gu(const Frame& F, const Args& A) {
    pg8::Gemm g{WSP(bf16, A_H), WSP(bf16, W_FGU), D, D}; pg8::StaticOrder S; S.init(TH, 2 * FF_D, F.G, F.bid);
    EpiSwiGLU E{WSP(bf16, F_ACT), FF_D, 1 << 20}; pg8::gemm_phase(F.lds, g, S, E, F.tid);
}
__device__ __forceinline__ void phase_ffn_down(const Frame& F, const Args& A, float* x) {
    pg8::Gemm g{WSP(bf16, F_ACT), WSP(bf16, W_FDN), FF_D, FF_D}; pg8::StaticOrder S; S.init(TH, D, F.G, F.bid);
    EpiResidual E{x, x}; pg8::gemm_phase(F.lds, g, S, E, F.tid);
}
struct MoeLayout { int pstart[NEXP + 1]; };
__device__ __forceinline__ MoeLayout moe_layout(const unsigned* cnt) {
    MoeLayout L; int s = 0;
#pragma unroll
    for (int e = 0; e < NEXP; ++e) { L.pstart[e] = s; s += ((int)cnt[e] + 255) & ~255; }
    L.pstart[NEXP] = s; return L;
}
struct MoeOrder {
    int np, nN, G, c; MoeLayout L;
    __device__ bool next(int i, Unit& u) const {
        const long Lx = (long)i * G + c; if (Lx >= (long)np * nN) return false;
        const int pm = (int)(Lx / nN), pn = (int)(Lx % nN); int e = 0;
#pragma unroll
        for (int k = 1; k < NEXP; ++k) if (pm * 256 >= L.pstart[k]) e = k;
        u.pm = pm; u.pn = e * nN + pn; return true;
    }
    __device__ __forceinline__ void a_ready(const Unit&) const {}
    __device__ __forceinline__ void done(const Unit&) const {}
};
__device__ __forceinline__ void phase_moe_route(const Frame& F, const Args& A, int half) {
    const unsigned* wgc = (const unsigned*)(F.ctl + CW_WGC + half * 8192); unsigned* cnt = (unsigned*)(F.ctl + CW_CNT + half * 16);
    LAS unsigned* tab = (LAS unsigned*)F.lds; LAS unsigned* tot = tab + 8192; LAS unsigned* bef = tot + 8; LAS unsigned* cur = bef + 8;
    __syncthreads();
    for (int e = F.tid; e < F.G * 8; e += 512) tab[e] = wgc[e];
    __syncthreads();
    if (F.tid < 8) { unsigned t = 0, bsum = 0; for (int g = 0; g < F.G; ++g) { const unsigned v = tab[g * 8 + F.tid]; if (g < F.bid) bsum += v; t += v; } tot[F.tid] = t; bef[F.tid] = bsum; cur[F.tid] = 0u; if (F.bid == 0) cnt[F.tid] = t; }
    __syncthreads();
    unsigned totr[8];
#pragma unroll
    for (int e = 0; e < 8; ++e) totr[e] = tot[e];
    const MoeLayout L = moe_layout(totr);
    const bf16* H = WSP(bf16, A_H); bf16* GA = WSP(bf16, F_GA); const int* tope = WSP(int, F_TOPE); int* slot = WSP(int, F_SLOT);
    const int lane = F.lane;
    for (int m = F.gw; m < TH; m += F.NGW) {
        const u32x4 v0 = *(const u32x4*)(H + (size_t)m * D + 8 * lane), v1 = *(const u32x4*)(H + (size_t)m * D + 512 + 8 * lane);
#pragma unroll
        for (int k = 0; k < 2; ++k) { const int e = tope[2 * m + k]; int s = 0;
            int ps = 0;
#pragma unroll
            for (int q = 0; q < NEXP; ++q) ps = (e == q) ? L.pstart[q] : ps;
            if (lane == 0) s = ps + (int)bef[e] + (int)ATOMIC_ADD_LDS(cur + e, 1u);
            s = __shfl(s, 0);
            if (lane == 0) slot[2 * m + k] = s;
            *(u32x4*)(GA + (size_t)s * D + 8 * lane) = v0; *(u32x4*)(GA + (size_t)s * D + 512 + 8 * lane) = v1; }
    }
#pragma unroll
    for (int e = 0; e < NEXP; ++e) { const int r0 = L.pstart[e] + (int)totr[e], r1 = L.pstart[e + 1];
        for (int r = r0 + F.gw; r < r1; r += F.NGW) { *(u32x4*)(GA + (size_t)r * D + 8 * lane) = (u32x4){0u, 0u, 0u, 0u}; *(u32x4*)(GA + (size_t)r * D + 512 + 8 * lane) = (u32x4){0u, 0u, 0u, 0u}; } }
    __syncthreads();
}
__device__ __forceinline__ void phase_moe_gu(const Frame& F, const Args& A, int half) {
    MoeOrder S; S.L = moe_layout((const unsigned*)(F.ctl + CW_CNT + half * 16)); S.np = S.L.pstart[NEXP] / 256; S.nN = 2 * FF_E / 256; S.G = F.G; S.c = F.bid;
    pg8::Gemm g{WSP(bf16, F_GA), WSP(bf16, W_FGU), D, D}; EpiSwiGLU E{WSP(bf16, F_ACT), FF_E, 2 * FF_E / 256}; pg8::gemm_phase(F.lds, g, S, E, F.tid);
}
struct EpiF32Mod {
    static constexpr bool PERM = false, AFTER_DRAIN = false;
    float* C;
    __device__ __forceinline__ void operator()(const f32x4 (&acc)[2][2][4][2], const Unit& u, int wr, int wc, int fr, int fq) const {
        const int row0 = u.pm * 256 + wr * 64 + fr, col0 = (u.pn & 3) * 256 + wc * 32 + 4 * fq;
#pragma unroll
        for (int ai = 0; ai < 2; ++ai)
#pragma unroll
            for (int m = 0; m < 4; ++m) { float* rowp = C + (size_t)(row0 + ai * HALFT + m * 16) * D + col0;
#pragma unroll
                for (int bj = 0; bj < 2; ++bj)
#pragma unroll
                    for (int n = 0; n < 2; ++n) *(f32x4*)(rowp + bj * HALFT + n * 16) = acc[ai][bj][m][n]; }
    }
};
__device__ __forceinline__ void phase_moe_down(const Frame& F, const Args& A, int half) {
    MoeOrder S; S.L = moe_layout((const unsigned*)(F.ctl + CW_CNT + half * 16)); S.np = S.L.pstart[NEXP] / 256; S.nN = D / 256; S.G = F.G; S.c = F.bid;
    pg8::Gemm g{WSP(bf16, F_ACT), WSP(bf16, W_FDN), FF_E, FF_E}; EpiF32Mod E{WSP(float, F_YE)}; pg8::gemm_phase(F.lds, g, S, E, F.tid);
}
__device__ __forceinline__ void phase_moe_combine(const Frame& F, const Args& A, float* x, const float* fgain) {
    const float* YE = WSP(float, F_YE); const int* slot = WSP(int, F_SLOT); const float* topw = WSP(float, F_TOPW); const int lane = F.lane;
    for (int m = F.gw; m < TH; m += F.NGW) { const int s0 = slot[2 * m], s1 = slot[2 * m + 1]; const float w0 = topw[2 * m], w1 = topw[2 * m + 1];
        f32x4 v[4]; float ss = 0.f;
#pragma unroll
        for (int j = 0; j < 4; ++j) { const int c = 4 * lane + 256 * j;
            v[j] = *(const f32x4*)(x + (size_t)m * D + c) + *(const f32x4*)(YE + (size_t)s0 * D + c) * w0 + *(const f32x4*)(YE + (size_t)s1 * D + c) * w1;
            ss += (v[j].x * v[j].x + v[j].y * v[j].y) + (v[j].z * v[j].z + v[j].w * v[j].w); }
        if (fgain) { const float rstd = RSQRT(wave_sum(ss) * (1.0f / D) + EPS);
#pragma unroll
            for (int j = 0; j < 4; ++j) v[j] = v[j] * rstd * *(const f32x4*)(fgain + 4 * lane + 256 * j); }
#pragma unroll
        for (int j = 0; j < 4; ++j) *(f32x4*)(x + (size_t)m * D + 4 * lane + 256 * j) = v[j]; }
}

#ifndef EMU
#define XB_TMO      128
#define XB_XCNT(j)  (256  + 64 * (j))
#define XB_XSUB(j)  (1280 + 64 * (j))
#define XB_XGEN(j)  (2304 + 64 * (j))
#define XB_TOP      3328
#define XB_TOPGEN   3392
#define XCD_BAR_WORDS 3456
#define XB_SPIN_CAP (1u << 22)
__device__ __forceinline__ unsigned xb_ld(unsigned* p)              { return __hip_atomic_load(p, __ATOMIC_RELAXED, __HIP_MEMORY_SCOPE_AGENT); }
__device__ __forceinline__ unsigned xb_add(unsigned* p, unsigned v) { return __hip_atomic_fetch_add(p, v, __ATOMIC_RELAXED, __HIP_MEMORY_SCOPE_AGENT); }
__device__ __forceinline__ unsigned xb_xcc_id() { return (unsigned)__builtin_amdgcn_s_getreg((3 << 11) | 20) & 0xFu; }
#define XB_SPIN(cond, bar) do { unsigned _sp = 0; while (cond) { __builtin_amdgcn_s_sleep(1); \
    if ((++_sp & 255u) == 0u) { if (xb_ld(&(bar)[XB_TMO])) break; if (_sp > XB_SPIN_CAP) { atomicAdd(&(bar)[XB_TMO], 1u); break; } } } } while (0)
struct XcdBarrier { unsigned* bar; unsigned x; volatile LAS unsigned* st; };
__device__ __forceinline__ XcdBarrier xcd_barrier_post(unsigned* bar, volatile LAS unsigned* st) {
    XcdBarrier b; b.bar = bar; b.x = xb_xcc_id(); b.st = st;
    if (threadIdx.x == 0) (void)xb_add(&bar[XB_XCNT(b.x)], 1u);
    return b;
}
__device__ __forceinline__ void xcd_barrier_complete(unsigned* bar, unsigned x, unsigned& nloc, unsigned& nx) {
    const unsigned G = gridDim.x * gridDim.y * gridDim.z;
    unsigned sum, cnt, mine, sp = 0u;
    for (;;) {
        sum = 0u; cnt = 0u; mine = 0u;
#pragma unroll
        for (unsigned j = 0; j < 16; ++j) { const unsigned c = xb_ld(&bar[XB_XCNT(j)]); sum += c; cnt += (c > 0u) ? 1u : 0u; mine = (j == x) ? c : mine; }
        if (sum == G) break;
        __builtin_amdgcn_s_sleep(1);
        if ((++sp & 255u) == 0u) { if (xb_ld(&bar[XB_TMO])) break; if (sp > XB_SPIN_CAP) { atomicAdd(&bar[XB_TMO], 1u); break; } }
    }
    nloc = mine > 0u ? mine : 1u; nx = cnt > 0u ? cnt : 1u;
}
__device__ __forceinline__ void xcd_barrier(const XcdBarrier& b) {
    asm volatile("s_waitcnt vmcnt(0)" ::: "memory");
    __syncthreads();
    if (threadIdx.x == 0) {
        unsigned* bar = b.bar;
        __builtin_amdgcn_s_waitcnt(0);
        unsigned nloc = b.st[0], nx = b.st[1];
        if (nloc == 0u) { xcd_barrier_complete(bar, b.x, nloc, nx); b.st[0] = nloc; b.st[1] = nx; }
        const unsigned old = xb_add(&bar[XB_XSUB(b.x)], 1u);
        const unsigned gen = old / nloc;
        if (old + 1u == (gen + 1u) * nloc) {
            __builtin_amdgcn_fence(__ATOMIC_RELEASE, "agent");
            asm volatile("s_waitcnt vmcnt(0)" ::: "memory");
            const unsigned og = xb_add(&bar[XB_TOP], 1u);
            const unsigned tg = og / nx;
            if (og + 1u == (tg + 1u) * nx) xb_add(&bar[XB_TOPGEN], 1u);
            else XB_SPIN(xb_ld(&bar[XB_TOPGEN]) == tg, bar);
            __builtin_amdgcn_fence(__ATOMIC_ACQUIRE, "agent");
            xb_add(&bar[XB_XGEN(b.x)], 1u);
            asm volatile("s_waitcnt vmcnt(0)" ::: "memory");
        } else {
            XB_SPIN(xb_ld(&bar[XB_XGEN(b.x)]) == gen, bar);
            __builtin_amdgcn_fence(__ATOMIC_ACQUIRE, "agent");
            asm volatile("s_waitcnt vmcnt(0)" ::: "memory");
        }
    }
    __syncthreads();
}
#endif

constexpr int NPHASES = DEPTH + NHALF * (14 + 16);
constexpr int LDS_BYTES = 155648, MISC_OFF = 154624;

__global__ void __launch_bounds__(512, 2) fwd_kernel(Args args_k) {
#ifdef EMU
    unsigned char* lds = emu_lds_ptr;
#else
    extern __shared__ __attribute__((aligned(16))) unsigned char lds[];
#endif
    Frame F0;
    F0.lds = (LAS unsigned char*)lds; F0.tid = threadIdx.x; F0.lane = F0.tid & 63; F0.wave = RFL(F0.tid >> 6); F0.G = gridDim.x; F0.bid = blockIdx.x;
    F0.gw = F0.bid * 8 + F0.wave; F0.NGW = F0.G * 8;
    F0.out = (GAS float*)args_k.out; F0.ws = (GAS unsigned char*)args_k.ws; F0.ctl = (GAS unsigned*)(F0.ws + WS_CTL);
    const int lo = args_k.lo, hi = args_k.hi;
#ifndef EMU
    volatile LAS unsigned* misc = (volatile LAS unsigned*)(F0.lds + MISC_OFF);
    if (F0.tid < 4) misc[F0.tid] = 0u;
    __syncthreads();
    XcdBarrier bar; bar.bar = (unsigned*)(F0.ctl + CW_BAR); bar.x = 0; bar.st = misc;
    if (hi - lo > 1) bar = xcd_barrier_post((unsigned*)(F0.ctl + CW_BAR), misc);
#define GRID_BAR() do { XcdBarrier bq = bar; asm volatile("" : "+s"(bq.bar), "+s"(bq.x)); xcd_barrier(bq); } while (0)
#else
#define GRID_BAR() do { } while (0)
#endif
    int ph = 0;
#ifndef PH_MASK
#define PH_MASK 0xFFFFFFFFFFFFFFFFull
#endif
#define PHASE(...) PHASE_I(31, __VA_ARGS__)
#ifdef EMU
#define LAUNDER(Fq) do { } while (0)
#else
#define LAUNDER(Fq) do { unsigned mq_ = ~0u; asm volatile("" : "+s"(Fq.G), "+s"(Fq.bid), "+s"(Fq.wave), "+s"(Fq.ws), "+s"(Fq.out), "+s"(Fq.ctl), "+s"(mq_)); Fq.lane = (int)__builtin_amdgcn_mbcnt_hi(mq_, __builtin_amdgcn_mbcnt_lo(mq_, 0u)); Fq.tid = Fq.wave * 64 + Fq.lane; Fq.gw = Fq.bid * 8 + Fq.wave; Fq.NGW = Fq.G * 8; } while (0)
#endif
#ifdef EMU
#define ARGS_Q() const Args& args_q = args_k
#else
#define ARGS_Q() const __attribute__((address_space(4))) Args* aq_ = (const __attribute__((address_space(4))) Args*)__builtin_amdgcn_kernarg_segment_ptr(); asm volatile("" : "+s"(aq_)); const Args& args_q = *(const Args*)aq_
#endif
#define PHASE_I(kind, ...) do { if (ph >= lo && ph < hi) { constexpr int reps_ = (((REPEAT_MASK) >> (kind)) & 1u) ? 2 : 1; for (int rr_ = 0; rr_ < reps_; ++rr_) { { Frame Fq = F0; LAUNDER(Fq); const Frame& F = Fq; ARGS_Q(); const Args& args = args_q; __VA_ARGS__; } if (rr_ + 1 < reps_ || ph + 1 < hi) { GRID_BAR(); if (((REPEAT_MASK) >> 26) & 1u) GRID_BAR(); } } } ++ph; } while (0)
#define PHASEK(kind, ...) PHASE_I(kind, __VA_ARGS__)
#define NORM1(layer, half) do { const size_t rn_ = (size_t)(half) * TH; const float* xn_ = ((layer) == 0 ? AIN(args, 0) : (const float*)F.out) + rn_ * D; \
            phase_norm<false>(F, args, xn_, AIN(args, 2) + (layer) * D, WSP(bf16, A_H), nullptr, nullptr, nullptr, nullptr); phase_rope_table(F, args, (const int*)AIN(args, 1) + rn_, WSP(float, A_ROPE)); } while (0)
#define SEGMENT(layer, half) do { \
            const size_t r0 = (size_t)(half) * TH; \
            const float* xin = ((layer) == 0 ? AIN(args_k, 0) : (const float*)F0.out) + r0 * D; float* xo = (float*)F0.out + r0 * D; \
            PHASEK(1, { pg8::Gemm g{WSP(bf16, A_H), WSP(bf16, W_IN), D, D}; pg8::StaticOrder S; S.init(TH, PW, F.G, F.bid); EpiBf16 E{WSP(bf16, A_P), PW, nullptr, 0}; pg8::gemm_phase(F.lds, g, S, E, F.tid); }); \
            PHASEK(2, phase_mla_prep(F, args); phase_rwkv_prep(F, args, layer)); \
            PHASEK(3, phase_mla_q(F, args); __syncthreads(); phase_mla_kv(F, args); __syncthreads(); phase_rwkv_lora(F, args)); \
            PHASEK(8, phase_rwkv_r1(F, args, layer)); \
            PHASEK(5, { const int ns_ = F.G >= 128 ? 64 : (F.G >= 4 ? F.G / 4 : 0); Frame Fa = F;       \
                        if (F.bid < ns_) { Fa.G = ns_; Fa.NGW = ns_ * 8; phase_rwkv_r2(Fa, args); } else { Fa.bid = F.bid - ns_; Fa.G = F.G - ns_; Fa.gw = Fa.bid * 8 + Fa.wave; Fa.NGW = Fa.G * 8; phase_attention(Fa, args); if (ns_ == 0) phase_rwkv_r2(F, args); } }); \
            PHASEK(9, phase_rwkv_post(F, args, layer); phase_gdn_g1(F, args, layer); phase_ssd_s1(F, args, layer)); \
            PHASEK(11, { const int ns_ = F.G >= 4 ? F.G / 2 : 0; Frame Fa = F;                               \
                        if (F.bid < ns_) { Fa.G = ns_; Fa.NGW = ns_ * 8; phase_gdn_g2(Fa, args); } else { Fa.bid = F.bid - ns_; Fa.G = F.G - ns_; Fa.gw = Fa.bid * 8 + Fa.wave; Fa.NGW = Fa.G * 8; phase_ssd_s23(Fa, args); if (ns_ == 0) phase_gdn_g2(F, args); } }); \
            PHASEK(12, phase_gdn_g3(F, args, layer); phase_ssd_s4(F, args, layer)); \
            PHASEK(17, phase_merge_z(F, args)); \
            PHASEK(18, phase_merge_gate(F, args, layer)); \
            PHASEK(19, phase_merge_out(F, args, xin, xo)); \
            if ((layer) == 0) { \
                PHASEK(20, phase_norm<false>(F, args, xo, AIN(args, 32) + (layer) * D, WSP(bf16, A_H), nullptr, nullptr, nullptr, nullptr)); \
                PHASEK(21, phase_ffn_gu(F, args)); \
                PHASE(phase_ffn_down(F, args, xo); if ((half) == 0 && NHALF == 2) NORM1(layer, 1)); \
            } else { \
                PHASE(phase_norm<true>(F, args, xo, AIN(args, 32) + (layer) * D, WSP(bf16, A_H), AIN(args, 35), WSP(int, F_TOPE), WSP(float, F_TOPW), (unsigned*)(F.ctl + CW_WGC + (half) * 8192))); \
                PHASE(phase_moe_route(F, args, half)); \
                PHASEK(22, phase_moe_gu(F, args, half)); \
                PHASEK(23, phase_moe_down(F, args, half)); \
                PHASE(phase_moe_combine(F, args, xo, (layer) == DEPTH - 1 ? AIN(args, 38) : nullptr); if ((half) == 0 && NHALF == 2) NORM1(layer, 1)); \
            } } while (0)
    static_assert(DEPTH == 2 && NHALF <= 2, "segment program");
    PHASEK(27, phase_convert(F, args, 0); NORM1(0, 0));
    SEGMENT(0, 0);
    if (NHALF == 2) SEGMENT(0, 1);
    PHASEK(27, phase_convert(F, args, 1); NORM1(1, 0));
    SEGMENT(1, 0);
    if (NHALF == 2) SEGMENT(1, 1);
#undef SEGMENT
#undef PHASE
}

#ifndef ONE_LAUNCH
#define ONE_LAUNCH 1
#endif
extern "C" void kernel_launch(void* const* d_in, const int* in_sizes, int n_in, void* d_out, int out_size, void* d_ws, size_t ws_size, hipStream_t stream) {
    static int grid = 0;
    if (grid == 0) {
#ifdef EMU
        grid = EMU_GRID;
#else
        if (n_in != 39 || out_size != T * D || ws_size < WS_NEED) { fprintf(stderr, "kernel_launch: unexpected problem (n_in %d out %d ws %zu need %zu)\n", n_in, out_size, ws_size, (size_t)WS_NEED); grid = -1; return; }
        int dev = 0, cus = 0;
        if (hipGetDevice(&dev) != hipSuccess || hipDeviceGetAttribute(&cus, hipDeviceAttributeMultiprocessorCount, dev) != hipSuccess) { grid = -1; return; }
        if (hipFuncSetAttribute((const void*)fwd_kernel, hipFuncAttributeMaxDynamicSharedMemorySize, LDS_BYTES) != hipSuccess) { fprintf(stderr, "kernel_launch: hipFuncSetAttribute failed\n"); grid = -1; return; }
        int per_cu = 0;
        if (hipOccupancyMaxActiveBlocksPerMultiprocessor(&per_cu, (const void*)fwd_kernel, 512, LDS_BYTES) != hipSuccess || per_cu < 1) fprintf(stderr, "kernel_launch: occupancy query reports %d\n", per_cu);
        (void)hipGetLastError();
        grid = cus;
#endif
    }
    if (grid < 0) return;
    (void)hipMemsetAsync((char*)d_ws + WS_CTL, 0, CTL_BYTES, stream);
    Args a{};
    for (int i = 0; i < 39; ++i) a.in[i] = (const float*)d_in[i];
    a.out = (float*)d_out; a.ws = (unsigned char*)d_ws;
#ifdef EMU
    for (int p = EMU_PH_LO; p < EMU_PH_HI && p < NPHASES; ++p) { a.lo = p; a.hi = p + 1; emu_launch(fwd_kernel, grid, 512, a); emu_after_phase(p); }
#else
#if ONE_LAUNCH
    a.lo = 0; a.hi = NPHASES;
    hipLaunchKernelGGL(fwd_kernel, dim3(grid), dim3(512), LDS_BYTES, stream, a);
#else
    for (int p = 0; p < NPHASES; ++p) { a.lo = p; a.hi = p + 1; hipLaunchKernelGGL(fwd_kernel, dim3(grid), dim3(512), LDS_BYTES, stream, a); }
#endif
#endif
}
```

```cpp
#ifndef EMU
#include <hip/hip_runtime.h>
#include <cstdio>
#include <cstdint>
#endif

#ifndef REPEAT_MASK
#define REPEAT_MASK 0u
#endif
#ifdef EMU
constexpr int BATCH = EMU_B, SEQ = EMU_S, NHALF = EMU_NHALF;
#else
constexpr int BATCH = 16, SEQ = 2048, NHALF = 2;
#endif
constexpr int D = 1024, DEPTH = 2, CH = 64;
constexpr int T = BATCH * SEQ, TH = T / NHALF, BH = BATCH / NHALF, NCH = SEQ / CH;
constexpr int C_MLA = 0, C_RWKV = 704, C_GDN = 2528, C_SSD = 4584, C_GATE = 6128, IN_COLS = 10224, PW = 6144;
constexpr int FF_D = 2816, FF_E = 3584, NEXP = 8;
constexpr int MOE_ROWS = ((TH * 2 + NEXP * 255) / 256) * 256;
constexpr float EPS = 1e-6f;
static_assert(TH % 256 == 0 && SEQ % 128 == 0 && BATCH % NHALF == 0 && (SEQ / 64) % 2 == 0, "shape");

typedef unsigned short bf16;
typedef float f32x4 __attribute__((ext_vector_type(4)));
typedef float f32x2 __attribute__((ext_vector_type(2)));
typedef short bf16x8 __attribute__((ext_vector_type(8)));
typedef short bf16x4 __attribute__((ext_vector_type(4)));
typedef unsigned u32x4 __attribute__((ext_vector_type(4)));
typedef unsigned u32x2 __attribute__((ext_vector_type(2)));
#ifdef EMU
#define LAS
#define GAS
#define MFMA_F32(a, b, c) emu_mfma_16x16x4f32(a, b, c)
#define MFMA_BF16(a, b, c) emu_mfma_16x16x32bf16(a, b, c)
#define ATOMIC_ADD_U32(p, v) emu_atomic_add_u32(p, v)
#define ATOMIC_ADD_LDS(p, v) emu_atomic_add_u32((unsigned*)(p), v)
#define RFL(x) (x)
#define OPAQUE_V(x) do { } while (0)
#define LDS_WAIT()
#define VM_WAIT()
__device__ __forceinline__ float fast_exp(float x) { return expf(x); }
__device__ __forceinline__ float fast_rcp(float x) { return 1.0f / x; }
__device__ __forceinline__ float fast_rsqrt(float x) { return 1.0f / sqrtf(x); }
#else
#define LAS __attribute__((address_space(3)))
#define GAS __attribute__((address_space(1)))
#define MFMA_F32(a, b, c) __builtin_amdgcn_mfma_f32_16x16x4f32(a, b, c, 0, 0, 0)
#define MFMA_BF16(a, b, c) __builtin_amdgcn_mfma_f32_16x16x32_bf16(a, b, c, 0, 0, 0)
#define ATOMIC_ADD_U32(p, v) __hip_atomic_fetch_add(p, v, __ATOMIC_RELAXED, __HIP_MEMORY_SCOPE_AGENT)
#define ATOMIC_ADD_LDS(p, v) __hip_atomic_fetch_add((LAS unsigned*)(p), v, __ATOMIC_RELAXED, __HIP_MEMORY_SCOPE_WORKGROUP)
#define RFL(x) __builtin_amdgcn_readfirstlane(x)
#define OPAQUE_V(x) asm volatile("" : "+v"(x))
#define LDS_WAIT() asm volatile("s_waitcnt lgkmcnt(0)" ::: "memory")
#define VM_WAIT() asm volatile("s_waitcnt vmcnt(0)" ::: "memory")
__device__ __forceinline__ float fast_exp(float x) { return __expf(x); }
__device__ __forceinline__ float fast_rcp(float x) { return __builtin_amdgcn_rcpf(x); }
__device__ __forceinline__ float fast_rsqrt(float x) { return __builtin_amdgcn_rsqf(x); }
#endif
__device__ __forceinline__ unsigned f2u(float f) { return __builtin_bit_cast(unsigned, f); }
__device__ __forceinline__ float u2f(unsigned u) { return __builtin_bit_cast(float, u); }
__device__ __forceinline__ unsigned f2bf(float f) { unsigned u = f2u(f); return (u + 0x7fffu + ((u >> 16) & 1u)) >> 16; }
__device__ __forceinline__ float bf2f(unsigned h) { return u2f(h << 16); }
__device__ __forceinline__ unsigned pk2(float lo, float hi) { return f2bf(lo) | (f2bf(hi) << 16); }
#ifndef EMU
#define expf(x) __expf(x)
#define exp2f(x) __builtin_amdgcn_exp2f(x)
#define FDIV(a, b) ((a) * __builtin_amdgcn_rcpf(b))
#define RSQRT(x) __builtin_amdgcn_rsqf(x)
__device__ __forceinline__ float softplusf_(float x) { return x > 20.f ? x : __logf(1.0f + __expf(x)); }
#else
#define FDIV(a, b) ((a) / (b))
#define RSQRT(x) (1.0f / sqrtf(x))
__device__ __forceinline__ float softplusf_(float x) { return x > 20.f ? x : log1pf(expf(x)); }
#endif
__device__ __forceinline__ float sigmoidf_(float x) { return FDIV(1.0f, 1.0f + expf(-x)); }
__device__ __forceinline__ float siluf_(float x) { return FDIV(x, 1.0f + expf(-x)); }
__device__ __forceinline__ float tanhf_(float x) { const float e = expf(2.0f * fminf(x, 15.0f)); return FDIV(e - 1.0f, e + 1.0f); }
__device__ __forceinline__ float wave_sum(float v) {
#pragma unroll
    for (int o = 1; o < 64; o <<= 1) v += __shfl_xor(v, o);
    return v;
}
__device__ __forceinline__ float wave_max(float v) {
#pragma unroll
    for (int o = 1; o < 64; o <<= 1) v = fmaxf(v, __shfl_xor(v, o));
    return v;
}
__device__ __forceinline__ f32x4 ld_bf16x4(const bf16* p) { const u32x2 w = *(const u32x2*)p; return (f32x4){bf2f(w.x & 0xffffu), bf2f(w.x >> 16), bf2f(w.y & 0xffffu), bf2f(w.y >> 16)}; }
__device__ __forceinline__ void st_bf16x4(bf16* p, f32x4 v) { u32x2 w; w.x = pk2(v.x, v.y); w.y = pk2(v.z, v.w); *(u32x2*)p = w; }
__device__ __forceinline__ u32x4 pack8(const float* v) { u32x4 o; o.x = pk2(v[0], v[1]); o.y = pk2(v[2], v[3]); o.z = pk2(v[4], v[5]); o.w = pk2(v[6], v[7]); return o; }

#ifdef EMU
__device__ __forceinline__ float rows_max(float v) { v = fmaxf(v, __shfl_xor(v, 16)); return fmaxf(v, __shfl_xor(v, 32)); }
__device__ __forceinline__ float rows_sum(float v) { v += __shfl_xor(v, 16); return v + __shfl_xor(v, 32); }
#else
typedef unsigned u32x2v __attribute__((ext_vector_type(2)));
__device__ __forceinline__ float rows_max(float v) {
    { const auto r = __builtin_amdgcn_permlane16_swap(f2u(v), f2u(v), false, false); v = fmaxf(u2f(r[0]), u2f(r[1])); }
    { const auto r = __builtin_amdgcn_permlane32_swap(f2u(v), f2u(v), false, false); v = fmaxf(u2f(r[0]), u2f(r[1])); }
    return v; }
__device__ __forceinline__ float rows_sum(float v) {
    { const auto r = __builtin_amdgcn_permlane16_swap(f2u(v), f2u(v), false, false); v = u2f(r[0]) + u2f(r[1]); }
    { const auto r = __builtin_amdgcn_permlane32_swap(f2u(v), f2u(v), false, false); v = u2f(r[0]) + u2f(r[1]); }
    return v; }
#endif

namespace pg8 {
#define PG8_LAS LAS
typedef unsigned short bf16_t;
constexpr int BM = 256, BK = 64, HALF = 128, HTB = HALF * BK * 2, STAGE_BYTES = 8 * HTB, NXCD = 8, WGM = 8;
__host__ __device__ __forceinline__ int lds_byte(int r, int c) { const int st = (r >> 4) * 2 + (c >> 5), rr = r & 15, cc = c & 31, ob = rr * 64 + cc * 2; return st * 1024 + (ob ^ (((ob >> 9) & 1) << 5)); }
__host__ __device__ __forceinline__ void stage_rc(int b, int& R, int& C) { const int st = b / 1024, sb = b % 1024, swz = sb ^ (((sb >> 9) & 1) << 5); R = (st >> 1) * 16 + swz / 64; C = (st & 1) * 32 + (swz % 64) / 2; }
__host__ __device__ __forceinline__ int perm32(int rho) { const int n = rho >> 4, i = rho & 15; return 8 * (i >> 2) + 4 * n + (i & 3); }
struct Unit { int pm, pn; };
struct Gemm { const bf16_t* A; const bf16_t* Bt; int lda, K; };
struct StaticOrder {
    int nM, nN, nwg, G, c;
    __host__ __device__ void init(int M, int N, int G_, int c_) { nM = M / BM; nN = N / BM; nwg = nM * nN; G = G_; c = c_; }
    __host__ __device__ bool next(int i, Unit& u) const {
        const long L = (long)i * G + c; if (L >= nwg) return false;
        int wgid = (int)L; { const int q = nwg / NXCD, r = nwg % NXCD, xcd = wgid % NXCD, off = wgid / NXCD; wgid = (xcd < r ? xcd * (q + 1) : r * (q + 1) + (xcd - r) * q) + off; }
        const int nig = WGM * nN, gid = wgid / nig, fm = gid * WGM, gsz = (nM - fm) < WGM ? (nM - fm) : WGM;
        u.pm = fm + ((wgid % nig) % gsz); u.pn = (wgid % nig) / gsz; return true;
    }
    __device__ __forceinline__ void a_ready(const Unit&) const {}
    __device__ __forceinline__ void done(const Unit&) const {}
};
#ifndef EMU
template <class Epi, class Sched>
__device__ __forceinline__ void gemm_phase(PG8_LAS unsigned char* lds, const Gemm g, const Sched& S, const Epi& E, const int tid) {
    const int wid = __builtin_amdgcn_readfirstlane(tid >> 6), lane = tid & 63, wr = wid >> 2, wc = wid & 3, fr = lane & 15, fq = lane >> 4;
    int Kq = g.K; asm volatile("" : "+s"(Kq));
    const int K = Kq, nt = K / BK, lda = g.lda;
    unsigned voffA[2], voffB[2];
#pragma unroll
    for (int i = 0; i < 2; ++i) { int R, C; stage_rc(tid * 16 + i * 8192, R, C); const int Rb = Epi::PERM ? ((R & ~31) + perm32(R & 31)) : R;
        voffA[i] = (unsigned)(R * lda + C) * 2u; voffB[i] = (unsigned)(Rb * K + C) * 2u; }
    const size_t kstep = (size_t)(BK * 2);
    const size_t hstep = (size_t)HALF * K * 2, hstepA = (size_t)HALF * lda * 2;
    const size_t tstep = 2 * hstep, tstepA = 2 * hstepA;
    const unsigned ldsw = (unsigned)wid * 1024u;
    const int aoff = lds_byte(wr * 64 + fr, fq * 8), boff = lds_byte(wc * 32 + fr, fq * 8);
#define PG8_SA(b, h) (((b) * 2 + (h)) * HTB)
#define PG8_SB(b, h) ((4 + (b) * 2 + (h)) * HTB)
#define PG8_STAGE(bufoff, gbase, voff) do { _Pragma("unroll") for (int _i = 0; _i < 2; ++_i) \
        __builtin_amdgcn_global_load_lds((const unsigned*)((const char*)(gbase) + (voff)[_i]), (PG8_LAS unsigned*)(lds + (bufoff) + ldsw + _i * 8192), 16, 0, 0); } while (0)
#define PG8_LDA(dst, b, h) do { _Pragma("unroll") for (int m = 0; m < 4; ++m) _Pragma("unroll") for (int k = 0; k < 2; ++k) dst[m][k] = *(const PG8_LAS bf16x8*)(lds + PG8_SA(b, h) + aoff + m * 2048 + k * 1024); } while (0)
#define PG8_LDB(dst, b, h) do { _Pragma("unroll") for (int n = 0; n < 2; ++n) _Pragma("unroll") for (int k = 0; k < 2; ++k) dst[n][k] = *(const PG8_LAS bf16x8*)(lds + PG8_SB(b, h) + boff + n * 2048 + k * 1024); } while (0)
#define PG8_MMA(ai, bj, At, Bt) do { __builtin_amdgcn_s_setprio(1); _Pragma("unroll") for (int m = 0; m < 4; ++m) _Pragma("unroll") for (int n = 0; n < 2; ++n) _Pragma("unroll") for (int k = 0; k < 2; ++k) \
        acc[ai][bj][m][n] = __builtin_amdgcn_mfma_f32_16x16x32_bf16(Bt[n][k], At[m][k], acc[ai][bj][m][n], 0, 0, 0); __builtin_amdgcn_s_setprio(0); } while (0)
#define PG8_WAIT_V(n) asm volatile("s_waitcnt vmcnt(" #n ")" ::: "memory")
#define PG8_WAIT_L(n) asm volatile("s_waitcnt lgkmcnt(" #n ")" ::: "memory")
#define PG8_BAR __builtin_amdgcn_s_barrier()
#define PG8_SCHED __builtin_amdgcn_sched_barrier(0)
    Unit cur, nxt; int ui = 0;
    if (!S.next(0, cur)) return;
    f32x4 acc[2][2][4][2];
#pragma unroll
    for (int a = 0; a < 2; ++a)
#pragma unroll
        for (int b = 0; b < 2; ++b)
#pragma unroll
            for (int m = 0; m < 4; ++m)
#pragma unroll
                for (int n = 0; n < 2; ++n) acc[a][b][m][n] = (f32x4){0.f, 0.f, 0.f, 0.f};
    bf16x8 At[4][2], B0[2][2], B1[2][2];
    const char* cA = (const char*)g.A + (size_t)cur.pm * tstepA; const char* cB = (const char*)g.Bt + (size_t)cur.pn * tstep;
    S.a_ready(cur);
    PG8_STAGE(PG8_SB(0, 0), cB, voffB); PG8_STAGE(PG8_SA(0, 0), cA, voffA); PG8_STAGE(PG8_SB(0, 1), cB + hstep, voffB); PG8_STAGE(PG8_SA(0, 1), cA + hstepA, voffA);
    if (wr == 1) PG8_BAR;
    PG8_WAIT_V(4); PG8_BAR;
    PG8_STAGE(PG8_SB(1, 0), cB + kstep, voffB); PG8_STAGE(PG8_SA(1, 0), cA + kstep, voffA); PG8_STAGE(PG8_SB(1, 1), cB + hstep + kstep, voffB);
    PG8_WAIT_V(6); PG8_BAR;
    for (;;) {
        const bool has_next = S.next(ui + 1, nxt);
        const char* nA = has_next ? (const char*)g.A + (size_t)nxt.pm * tstepA : cA; const char* nB = has_next ? (const char*)g.Bt + (size_t)nxt.pn * tstep : cB;
        for (int t = 0; t < nt; t += 2) {
            const bool last = (t == nt - 2);
            const char* a1 = cA + (size_t)(t + 1) * kstep;
            const char* a2 = last ? nA : cA + (size_t)(t + 2) * kstep; const char* b2 = last ? nB : cB + (size_t)(t + 2) * kstep;
            const char* a3 = a2 + kstep; const char* b3 = b2 + kstep;
            if (last && has_next) S.a_ready(nxt);
            PG8_LDB(B0, 0, 0); PG8_SCHED; PG8_LDA(At, 0, 0); PG8_STAGE(PG8_SA(1, 1), a1 + hstepA, voffA);
            PG8_WAIT_L(8); PG8_BAR; PG8_WAIT_L(0); PG8_MMA(0, 0, At, B0); PG8_BAR; PG8_SCHED;
            PG8_LDB(B1, 0, 1); PG8_STAGE(PG8_SB(0, 0), b2, voffB);
            PG8_BAR; PG8_WAIT_L(0); PG8_MMA(0, 1, At, B1); PG8_BAR;
            PG8_LDA(At, 0, 1); PG8_STAGE(PG8_SA(0, 0), a2, voffA);
            PG8_BAR; PG8_WAIT_L(0); PG8_MMA(1, 0, At, B0); PG8_BAR; PG8_SCHED;
            PG8_STAGE(PG8_SB(0, 1), b2 + hstep, voffB);
            PG8_WAIT_V(6); PG8_BAR; PG8_MMA(1, 1, At, B1); PG8_BAR;
            PG8_LDB(B0, 1, 0); PG8_SCHED; PG8_LDA(At, 1, 0); PG8_STAGE(PG8_SA(0, 1), a2 + hstepA, voffA);
            PG8_WAIT_L(8); PG8_BAR; PG8_WAIT_L(0); PG8_MMA(0, 0, At, B0); PG8_BAR; PG8_SCHED;
            PG8_LDB(B1, 1, 1); PG8_STAGE(PG8_SB(1, 0), b3, voffB);
            PG8_BAR; PG8_WAIT_L(0); PG8_MMA(0, 1, At, B1); PG8_BAR;
            PG8_LDA(At, 1, 1); PG8_STAGE(PG8_SA(1, 0), a3, voffA);
            PG8_BAR; PG8_WAIT_L(0); PG8_MMA(1, 0, At, B0); PG8_BAR; PG8_SCHED;
            PG8_STAGE(PG8_SB(1, 1), b3 + hstep, voffB);
            PG8_WAIT_V(6); PG8_BAR; PG8_MMA(1, 1, At, B1); PG8_BAR;
        }
        if constexpr (!Epi::AFTER_DRAIN) { E(acc, cur, wr, wc, fr, fq); S.done(cur); }
        if (!has_next) break;
#pragma unroll
        for (int a = 0; a < 2; ++a)
#pragma unroll
            for (int b = 0; b < 2; ++b)
#pragma unroll
                for (int m = 0; m < 4; ++m)
#pragma unroll
                    for (int n = 0; n < 2; ++n) acc[a][b][m][n] = (f32x4){0.f, 0.f, 0.f, 0.f};
        cur = nxt; cA = nA; cB = nB; ++ui;
    }
    PG8_WAIT_V(0);
    if (wr == 0) PG8_BAR;
    PG8_BAR;
    if constexpr (Epi::AFTER_DRAIN) { E.fused(acc, cur, wr, wc, fr, fq, lds, wid, lane); S.done(cur); }
#undef PG8_SA
#undef PG8_SB
#undef PG8_STAGE
#undef PG8_LDA
#undef PG8_LDB
#undef PG8_MMA
#undef PG8_WAIT_V
#undef PG8_WAIT_L
#undef PG8_BAR
#undef PG8_SCHED
}
#else
template <class Epi, class Sched>
__device__ __forceinline__ void gemm_phase(PG8_LAS unsigned char* lds, const Gemm g, const Sched& S, const Epi& E, const int tid) {
    const int wid = tid >> 6, lane = tid & 63, wr = wid >> 2, wc = wid & 3, fr = lane & 15, fq = lane >> 4;
    Unit cur;
    for (int ui = 0; S.next(ui, cur); ++ui) {
        f32x4 acc[2][2][4][2];
        for (int ai = 0; ai < 2; ++ai) for (int m = 0; m < 4; ++m) {
            const size_t row = (size_t)cur.pm * 256 + ai * 128 + wr * 64 + m * 16 + fr;
            const bf16_t* ap = g.A + row * g.lda;
            for (int bj = 0; bj < 2; ++bj) for (int n = 0; n < 2; ++n) for (int j = 0; j < 4; ++j) {
                const size_t col = (size_t)cur.pn * 256 + bj * 128 + wc * 32 + (Epi::PERM ? 8 * fq + 4 * n : 16 * n + 4 * fq) + j;
                const bf16_t* bp = g.Bt + col * g.K; float s = 0.f;
                for (int k = 0; k < g.K; ++k) s += bf2f(ap[k]) * bf2f(bp[k]);
                acc[ai][bj][m][n][j] = s; } }
        E(acc, cur, wr, wc, fr, fq);
    }
    __syncthreads();
}
#endif
}

using pg8::Unit;
constexpr int HALFT = 128;
struct EpiF32 {
    static constexpr bool PERM = false, AFTER_DRAIN = false;
    float* C; int ldc;
    __device__ __forceinline__ void operator()(const f32x4 (&acc)[2][2][4][2], const Unit& u, int wr, int wc, int fr, int fq) const {
        const int row0 = u.pm * 256 + wr * 64 + fr, col0 = u.pn * 256 + wc * 32 + 4 * fq;
#pragma unroll
        for (int ai = 0; ai < 2; ++ai)
#pragma unroll
            for (int m = 0; m < 4; ++m) { float* rowp = C + (size_t)(row0 + ai * HALFT + m * 16) * ldc + col0;
#pragma unroll
                for (int bj = 0; bj < 2; ++bj)
#pragma unroll
                    for (int n = 0; n < 2; ++n) *(f32x4*)(rowp + bj * HALFT + n * 16) = acc[ai][bj][m][n]; }
    }
};
struct EpiResidual {
    static constexpr bool PERM = false, AFTER_DRAIN = false;
    const float* res; float* out;
    __device__ __forceinline__ void operator()(const f32x4 (&acc)[2][2][4][2], const Unit& u, int wr, int wc, int fr, int fq) const {
        const int row0 = u.pm * 256 + wr * 64 + fr, col0 = u.pn * 256 + wc * 32 + 4 * fq;
#pragma unroll
        for (int ai = 0; ai < 2; ++ai) {
            f32x4 rv[4][2][2];
#pragma unroll
            for (int m = 0; m < 4; ++m) { const size_t o = (size_t)(row0 + ai * HALFT + m * 16) * D + col0;
#pragma unroll
                for (int bj = 0; bj < 2; ++bj)
#pragma unroll
                    for (int n = 0; n < 2; ++n) rv[m][bj][n] = *(const GAS f32x4*)(res + o + bj * HALFT + n * 16); }
#pragma unroll
            for (int m = 0; m < 4; ++m) { const size_t o = (size_t)(row0 + ai * HALFT + m * 16) * D + col0;
#pragma unroll
                for (int bj = 0; bj < 2; ++bj)
#pragma unroll
                    for (int n = 0; n < 2; ++n) *(GAS f32x4*)(out + o + bj * HALFT + n * 16) = rv[m][bj][n] + acc[ai][bj][m][n]; }
        }
    }
};
struct EpiBf16 {
    static constexpr bool PERM = true, AFTER_DRAIN = false;
    bf16* O; int ldc; const float* rowscale; int rs_stride;
    __device__ __forceinline__ void operator()(const f32x4 (&acc)[2][2][4][2], const Unit& u, int wr, int wc, int fr, int fq) const {
        const int row0 = u.pm * 256 + wr * 64 + fr, col0 = u.pn * 256 + wc * 32 + 8 * fq;
#pragma unroll
        for (int ai = 0; ai < 2; ++ai)
#pragma unroll
            for (int m = 0; m < 4; ++m) { const int row = row0 + ai * HALFT + m * 16; bf16* rowp = O + (size_t)row * ldc + col0;
                const float sc = rowscale ? rowscale[(size_t)row * rs_stride] : 1.0f;
#pragma unroll
                for (int bj = 0; bj < 2; ++bj) { const f32x4 v0 = acc[ai][bj][m][0] * sc, v1 = acc[ai][bj][m][1] * sc;
                    u32x4 w; w.x = pk2(v0[0], v0[1]); w.y = pk2(v0[2], v0[3]); w.z = pk2(v1[0], v1[1]); w.w = pk2(v1[2], v1[3]);
                    *(u32x4*)(rowp + bj * HALFT) = w; } }
    }
};
struct EpiSwiGLU {
    static constexpr bool PERM = true, AFTER_DRAIN = false;
    bf16* O; int ldc; int ntile;
    __device__ __forceinline__ void operator()(const f32x4 (&acc)[2][2][4][2], const Unit& u, int wr, int wc, int fr, int fq) const {
        const int row0 = u.pm * 256 + wr * 64 + fr, col0 = (u.pn % ntile) * 128 + wc * 32 + 8 * fq;
#pragma unroll
        for (int ai = 0; ai < 2; ++ai)
#pragma unroll
            for (int m = 0; m < 4; ++m) { bf16* rowp = O + (size_t)(row0 + ai * HALFT + m * 16) * ldc + col0;
                float a[8];
#pragma unroll
                for (int n = 0; n < 2; ++n)
#pragma unroll
                    for (int j = 0; j < 4; ++j) { const float g = acc[ai][0][m][n][j], up = acc[ai][1][m][n][j]; a[4 * n + j] = g * fast_rcp(1.0f + fast_exp(-g)) * up; }
                u32x4 w; w.x = pk2(a[0], a[1]); w.y = pk2(a[2], a[3]); w.z = pk2(a[4], a[5]); w.w = pk2(a[6], a[7]);
                *(u32x4*)rowp = w; }
    }
};
struct EpiZ {
    static constexpr bool PERM = true, AFTER_DRAIN = false;
    bf16* Z;
    __device__ __forceinline__ void operator()(const f32x4 (&acc)[2][2][4][2], const Unit& u, int wr, int wc, int fr, int fq) const {
        const int i = u.pn >> 2, pnl = u.pn & 3, pml = u.pm - i * (TH / 256);
        const int row0 = pml * 256 + wr * 64 + fr, col0 = i * D + pnl * 256 + wc * 32 + 8 * fq;
#pragma unroll
        for (int ai = 0; ai < 2; ++ai)
#pragma unroll
            for (int m = 0; m < 4; ++m) { bf16* rowp = Z + (size_t)(row0 + ai * HALFT + m * 16) * 4096 + col0;
#pragma unroll
                for (int bj = 0; bj < 2; ++bj) { const f32x4 v0 = acc[ai][bj][m][0], v1 = acc[ai][bj][m][1];
                    u32x4 w; w.x = pk2(v0[0], v0[1]); w.y = pk2(v0[2], v0[3]); w.z = pk2(v1[0], v1[1]); w.w = pk2(v1[2], v1[3]);
                    *(GAS u32x4*)(rowp + bj * HALFT) = w; } }
    }
};
struct BranchOrder {
    int nP, G, c;
    __device__ bool next(int i, Unit& u) const {
        const long L = (long)i * G + c; if (L >= (long)16 * nP) return false;
        const int br = (int)(L / (4 * nP)), r = (int)(L % (4 * nP)); u.pm = br * nP + (r >> 2); u.pn = br * 4 + (r & 3); return true;
    }
    __device__ __forceinline__ void a_ready(const Unit&) const {}
    __device__ __forceinline__ void done(const Unit&) const {}
};
struct EpiMerge {
    static constexpr bool PERM = false, AFTER_DRAIN = false;
    const bf16* Z; const float* gate_b; bf16* MG;
    __device__ __forceinline__ void operator()(const f32x4 (&acc)[2][2][4][2], const Unit& u, int wr, int wc, int fr, int fq) const {
        const int row0 = u.pm * 256 + wr * 64 + fr, col = u.pn * 64 + wc * 16 + 4 * fq;
        f32x4 gb[4];
#pragma unroll
        for (int i = 0; i < 4; ++i) gb[i] = *(const GAS f32x4*)(gate_b + i * D + col);
#pragma unroll
        for (int ai = 0; ai < 2; ++ai) {
            u32x2 zv[4][4];
#pragma unroll
            for (int m = 0; m < 4; ++m)
#pragma unroll
                for (int i = 0; i < 4; ++i) zv[m][i] = *(const GAS u32x2*)(Z + (size_t)(row0 + ai * HALFT + m * 16) * 4096 + i * D + col);
#pragma unroll
            for (int m = 0; m < 4; ++m) { const size_t row = (size_t)(row0 + ai * HALFT + m * 16);
                f32x4 s = (f32x4){0.f, 0.f, 0.f, 0.f};
#pragma unroll
                for (int bj = 0; bj < 2; ++bj)
#pragma unroll
                    for (int n = 0; n < 2; ++n) { const int i = 2 * bj + n; const unsigned z01 = zv[m][i].x, z23 = zv[m][i].y;
                        const f32x4 z = (f32x4){bf2f(z01 & 0xffffu), bf2f(z01 >> 16), bf2f(z23 & 0xffffu), bf2f(z23 >> 16)}; const f32x4 a = acc[ai][bj][m][n] + gb[i];
#pragma unroll
                        for (int j = 0; j < 4; ++j) s[j] += z[j] * fast_rcp(1.0f + fast_exp(-a[j])); }
                u32x2 w; w.x = pk2(s.x, s.y); w.y = pk2(s.z, s.w); *(GAS u32x2*)(MG + row * D + col) = w; }
        }
    }
};

constexpr size_t MiB = 1u << 20;
constexpr size_t al(size_t x) { return (x + 255) & ~(size_t)255; }
constexpr size_t WS_CTL = 0, CTL_BYTES = 1 * MiB;
constexpr size_t W_IN = 1 * MiB;
constexpr size_t W_GATE = W_IN + (size_t)PW * D * 2;
constexpr size_t W_UQ = W_GATE + (size_t)4096 * D * 2;
constexpr size_t W_UKV = W_UQ + (size_t)768 * 384 * 2;
constexpr size_t W_LORA = W_UKV + (size_t)1024 * 256 * 2;
constexpr size_t W_BR = W_LORA + (size_t)1536 * 384 * 2;
constexpr size_t W_OUT = W_BR + (size_t)4 * 1024 * 512 * 2;
constexpr size_t W_FGU = W_OUT + (size_t)D * D * 2;
constexpr size_t W_FDN = W_FGU + (size_t)NEXP * 2 * FF_E * D * 2;
constexpr size_t W_END = W_FDN + (size_t)NEXP * D * FF_E * 2;
constexpr size_t A_H = al(W_END);
constexpr size_t A_ROPE = A_H + (size_t)TH * D * 2;
constexpr size_t A_Y = A_ROPE + (size_t)TH * 64 * 4;
constexpr size_t A_P = A_Y + (size_t)4 * TH * 512 * 2;
constexpr size_t A_MIX = A_P + (size_t)TH * PW * 2;
constexpr size_t R_RKV = A_MIX;
constexpr size_t R_LOUT = R_RKV + (size_t)TH * 1536 * 2;
constexpr size_t R_O = R_LOUT + (size_t)TH * 1536 * 4;
constexpr size_t R_LIN = R_O + (size_t)TH * 512 * 4;
constexpr size_t R_REC = R_LIN + (size_t)TH * 384 * 2;
constexpr size_t R_END = R_REC + (size_t)BH * 8 * NCH * 61696;
constexpr size_t M_KR = al(R_END);
constexpr size_t M_Q = M_KR + (size_t)TH * 64 * 2;
constexpr size_t M_KV = M_Q + (size_t)TH * 768 * 2;
constexpr size_t M_VT = M_KV + (size_t)TH * 1024 * 2;
constexpr size_t M_END = M_VT + (size_t)TH * 512 * 2;
constexpr size_t G_CH = R_LIN;
constexpr size_t G_O = G_CH + al((size_t)BH * 4 * NCH * 78864);
constexpr size_t G_END = G_O + (size_t)TH * 512 * 4;
constexpr size_t S_ST = al(G_END);
constexpr size_t S_YD = S_ST + (size_t)BH * NCH * 8 * 64 * 128 * 2;
constexpr size_t S_C = S_YD + (size_t)TH * 512 * 4;
constexpr size_t S_AC = S_C + (size_t)BH * NCH * 2 * 17408;
constexpr size_t S_YO = S_AC + (size_t)TH * 8 * 4;
constexpr size_t S_END = S_YO + (size_t)TH * 512 * 4;
constexpr size_t A_Z = A_P;
constexpr size_t A_MG = A_MIX;
constexpr size_t F_ACT = A_P;
constexpr size_t F_GA = F_ACT + (size_t)MOE_ROWS * FF_E * 2;
constexpr size_t F_YE = F_GA + (size_t)MOE_ROWS * D * 2;
constexpr size_t F_TOPE = F_YE + (size_t)MOE_ROWS * D * 4;
constexpr size_t F_TOPW = F_TOPE + (size_t)TH * 2 * 4;
constexpr size_t F_SLOT = F_TOPW + (size_t)TH * 2 * 4;
constexpr size_t F_END = F_SLOT + (size_t)TH * 2 * 4;
constexpr size_t cmax(size_t a, size_t b) { return a > b ? a : b; }
constexpr size_t WS_NEED = cmax(cmax(cmax(M_END, R_END), cmax(G_END, S_END)), F_END);
#ifndef EMU
static_assert(WS_NEED <= (size_t)896 * MiB, "workspace");
#endif
constexpr int CW_BAR = 4096;
constexpr int CW_CNT = 16384;
constexpr int CW_WGC = 32768;

#ifdef EMU
#define WAVE_SYNC() emu_wave_sync()
#else
#define WAVE_SYNC() do { asm volatile("s_waitcnt lgkmcnt(0)" ::: "memory"); } while (0)
#endif
struct Frame {
    LAS unsigned char* lds; int tid, lane, wave, G, gw, NGW, bid;
    GAS float* out; GAS unsigned char* ws; GAS unsigned* ctl;
};
struct Args { const float* in[39]; float* out; unsigned char* ws; int lo, hi; };
#define WSP(type, off) ((type*)(F.ws + (off)))
#define AIN(A_, k) ((const float*)(const GAS float*)(A_).in[k])

template <class FN>
__device__ __forceinline__ void cvt_matrix(const Frame& F, const float* W, int ldw, int K, bf16* WT, int Ndst, const float* kscale, FN srccol) {
    LAS float* scr = (LAS float*)(F.lds + F.wave * 16384);
    const int nblk = Ndst / 32, nitems = (K / 64) * nblk, lane = F.lane;
    for (int item = F.gw; item < nitems; item += F.NGW) {
        const int kb = item / nblk, nb = item % nblk, k0 = 64 * kb, n0 = 32 * nb;
        const int sc = srccol(n0 + (lane & 31));
        float wv[32];
#pragma unroll
        for (int i = 0; i < 32; ++i) { const int kk = 2 * i + (lane >> 5); wv[i] = sc >= 0 ? W[(size_t)(k0 + kk) * ldw + sc] : 0.f; }
#pragma unroll
        for (int i = 0; i < 32; ++i) { const int kk = 2 * i + (lane >> 5); float v = wv[i]; if (kscale) v *= kscale[k0 + kk]; scr[kk * 33 + (lane & 31)] = v; }
        WAVE_SYNC();
        const int c = lane & 7;
#pragma unroll
        for (int j = 0; j < 4; ++j) { const int n = (lane >> 3) + 8 * j; const LAS float* s = scr + (8 * c) * 33 + n;
            u32x4 o; o.x = pk2(s[0 * 33], s[1 * 33]); o.y = pk2(s[2 * 33], s[3 * 33]); o.z = pk2(s[4 * 33], s[5 * 33]); o.w = pk2(s[6 * 33], s[7 * 33]);
            *(u32x4*)(WT + (size_t)(n0 + n) * K + k0 + 8 * c) = o; }
        WAVE_SYNC();
    }
}
__device__ __forceinline__ void phase_convert(const Frame& F, const Args& A, int layer) {
    const float* w_in = AIN(A, 3) + (size_t)layer * D * IN_COLS;
    cvt_matrix(F, w_in, IN_COLS, D, WSP(bf16, W_IN), PW, nullptr, [](int n) { return n < C_GATE ? n : -1; });
    cvt_matrix(F, w_in, IN_COLS, D, WSP(bf16, W_GATE), 4096, nullptr, [](int n) {
        const int pn = n >> 8, c = n & 255, bj = c >> 7, wc = (c >> 5) & 3, nn = (c >> 4) & 1, r = c & 15; return C_GATE + (2 * bj + nn) * D + 64 * pn + 16 * wc + r; });
    cvt_matrix(F, AIN(A, 6) + (size_t)layer * 384 * 768, 768, 384, WSP(bf16, W_UQ), 768, AIN(A, 4) + layer * 384, [](int n) { return n; });
    cvt_matrix(F, AIN(A, 7) + (size_t)layer * 256 * 1024, 1024, 256, WSP(bf16, W_UKV), 1024, AIN(A, 5) + layer * 256, [](int n) { return n; });
    for (int i = 0; i < 4; ++i) cvt_matrix(F, AIN(A, 30) + ((size_t)layer * 4 + i) * 512 * D, D, 512, WSP(bf16, W_BR) + (size_t)i * D * 512, D, nullptr, [](int n) { return n; });
    cvt_matrix(F, AIN(A, 31) + (size_t)layer * D * D, D, D, WSP(bf16, W_OUT), D, nullptr, [](int n) { return n; });
    if (layer == 0) {
        cvt_matrix(F, AIN(A, 33), 2 * FF_D, D, WSP(bf16, W_FGU), 2 * FF_D, nullptr, [](int n) { const int pn = n >> 8, c = n & 255; return c < 128 ? 128 * pn + c : FF_D + 128 * pn + (c - 128); });
        cvt_matrix(F, AIN(A, 34), D, FF_D, WSP(bf16, W_FDN), D, nullptr, [](int n) { return n; });
    } else {
        for (int e = 0; e < NEXP; ++e) {
            cvt_matrix(F, AIN(A, 36) + (size_t)e * D * 2 * FF_E, 2 * FF_E, D, WSP(bf16, W_FGU) + (size_t)e * 2 * FF_E * D, 2 * FF_E, nullptr, [](int n) { const int pn = n >> 8, c = n & 255; return c < 128 ? 128 * pn + c : FF_E + 128 * pn + (c - 128); });
            cvt_matrix(F, AIN(A, 37) + (size_t)e * FF_E * D, D, FF_E, WSP(bf16, W_FDN) + (size_t)e * D * FF_E, D, nullptr, [](int n) { return n; });
        }
    }
    { const float* w2 = AIN(A, 10) + (size_t)layer * 64 * 512; const float* a2 = AIN(A, 12) + (size_t)layer * 64 * 512; const float* g2 = AIN(A, 13) + (size_t)layer * 160 * 512;
      bf16* L = WSP(bf16, W_LORA);
      for (int idx = F.bid * 512 + F.tid; idx < 1536 * 384; idx += F.G * 512) { const int n = idx / 384, k = idx % 384; float v = 0.f;
          if (n < 512) { if (k < 64) v = w2[k * 512 + n]; } else if (n < 1024) { if (k >= 64 && k < 128) v = a2[(k - 64) * 512 + (n - 512)]; } else { if (k >= 128 && k < 288) v = g2[(k - 128) * 512 + (n - 1024)]; }
          L[idx] = (bf16)f2bf(v); } }
}

template <bool ROUTER>
__device__ __forceinline__ void phase_norm(const Frame& F, const Args& A, const float* xin, const float* gain, bf16* H, const float* router, int* tope, float* topw, unsigned* cnt) {
    const int lane = F.lane;
    LAS unsigned* lcnt = (LAS unsigned*)F.lds;
    if (ROUTER) { __syncthreads(); if (F.tid < 8) lcnt[F.tid] = 0u; __syncthreads(); }
    f32x4 gv[4];
#pragma unroll
    for (int j = 0; j < 4; ++j) gv[j] = *(const f32x4*)(gain + 4 * lane + 256 * j);
    for (int m = F.gw; m < TH; m += F.NGW) {
        const float* xr = xin + (size_t)m * D; f32x4 v[4]; float ss = 0.f;
#pragma unroll
        for (int j = 0; j < 4; ++j) { v[j] = *(const f32x4*)(xr + 4 * lane + 256 * j); ss += (v[j].x * v[j].x + v[j].y * v[j].y) + (v[j].z * v[j].z + v[j].w * v[j].w); }
        const float rstd = RSQRT(wave_sum(ss) * (1.0f / D) + EPS);
#pragma unroll
        for (int j = 0; j < 4; ++j) { v[j] = v[j] * rstd * gv[j]; st_bf16x4(H + (size_t)m * D + 4 * lane + 256 * j, v[j]); }
        if (ROUTER) {
            float lg[8];
#pragma unroll
            for (int e = 0; e < 8; ++e) lg[e] = 0.f;
#pragma unroll
            for (int j = 0; j < 4; ++j)
#pragma unroll
                for (int q = 0; q < 4; ++q) { const float* rp = router + (size_t)(4 * lane + 256 * j + q) * 8; const f32x4 r0 = *(const f32x4*)rp, r1 = *(const f32x4*)(rp + 4); const float hv = v[j][q];
                    lg[0] += hv * r0.x; lg[1] += hv * r0.y; lg[2] += hv * r0.z; lg[3] += hv * r0.w; lg[4] += hv * r1.x; lg[5] += hv * r1.y; lg[6] += hv * r1.z; lg[7] += hv * r1.w; }
#pragma unroll
            for (int e = 0; e < 8; ++e) lg[e] = wave_sum(lg[e]);
            if (lane == 0) {
                int e1 = 0; float l1 = lg[0];
#pragma unroll
                for (int e = 1; e < 8; ++e) if (lg[e] > l1) { l1 = lg[e]; e1 = e; }
                int e2 = -1; float l2 = -3.0e38f;
#pragma unroll
                for (int e = 0; e < 8; ++e) if (e != e1 && lg[e] > l2) { l2 = lg[e]; e2 = e; }
                const float w1 = 1.0f / (1.0f + expf(l2 - l1));
                tope[2 * m] = e1; tope[2 * m + 1] = e2; topw[2 * m] = w1; topw[2 * m + 1] = 1.0f - w1;
                ATOMIC_ADD_LDS(lcnt + e1, 1u); ATOMIC_ADD_LDS(lcnt + e2, 1u);
            }
        }
    }
    if (ROUTER) { __syncthreads(); if (F.tid < 8) cnt[F.bid * 8 + F.tid] = lcnt[F.tid]; __syncthreads(); }
}
__device__ __forceinline__ void phase_rope_table(const Frame& F, const Args& A, const int* pos, float* rope) {
    for (int idx = F.bid * 512 + F.tid; idx < TH * 32; idx += F.G * 512) { const int t = idx >> 5, i = idx & 31;
        const float inv = powf(10000.0f, -(float)i / 32.0f);
        const float ang = (float)pos[t] * inv; float sn, cs; sincosf(ang, &sn, &cs);
        rope[(size_t)t * 64 + i] = cs; rope[(size_t)t * 64 + 32 + i] = sn; }
}
__device__ __forceinline__ void phase_final_norm(const Frame& F, const Args& A, float* x, const float* gain) {
    const int lane = F.lane;
    for (int m = F.gw; m < T; m += F.NGW) {
        float* xr = x + (size_t)m * D; f32x4 v[4]; float ss = 0.f;
#pragma unroll
        for (int j = 0; j < 4; ++j) { v[j] = *(const f32x4*)(xr + 4 * lane + 256 * j); ss += (v[j].x * v[j].x + v[j].y * v[j].y) + (v[j].z * v[j].z + v[j].w * v[j].w); }
        const float rstd = RSQRT(wave_sum(ss) * (1.0f / D) + EPS);
#pragma unroll
        for (int j = 0; j < 4; ++j) *(f32x4*)(xr + 4 * lane + 256 * j) = v[j] * rstd * *(const f32x4*)(gain + 4 * lane + 256 * j);
    }
}

__device__ __forceinline__ void phase_mla_prep(const Frame& F, const Args& A) {
    bf16* P = WSP(bf16, A_P); bf16* kr = WSP(bf16, M_KR); const float* rope = WSP(float, A_ROPE);
    const int lane = F.lane;
    for (int m = F.gw; m < TH; m += F.NGW) {
        bf16* pr = P + (size_t)m * PW; float sq = 0.f, skv = 0.f; f32x4 v[3];
#pragma unroll
        for (int j = 0; j < 3; ++j) { const int c = 4 * lane + 256 * j; v[j] = ld_bf16x4(pr + c); const float s = (v[j].x * v[j].x + v[j].y * v[j].y) + (v[j].z * v[j].z + v[j].w * v[j].w);
            if (c < 384) sq += s; else if (c < 640) skv += s; }
        sq = wave_sum(sq); skv = wave_sum(skv);
        const float rq = RSQRT(sq * (1.0f / 384.0f) + EPS), rkv = RSQRT(skv * (1.0f / 256.0f) + EPS);
#pragma unroll
        for (int j = 0; j < 3; ++j) { const int c = 4 * lane + 256 * j; if (c < 640) st_bf16x4(pr + c, v[j] * (c < 384 ? rq : rkv)); }
        if (lane < 32) { const float x1 = bf2f(pr[640 + lane]), x2 = bf2f(pr[672 + lane]), c = rope[(size_t)m * 64 + lane], s = rope[(size_t)m * 64 + 32 + lane];
            kr[(size_t)m * 64 + lane] = (bf16)f2bf(x1 * c - x2 * s); kr[(size_t)m * 64 + 32 + lane] = (bf16)f2bf(x2 * c + x1 * s); }
    }
}
__device__ __forceinline__ void phase_mla_q(const Frame& F, const Args& A) {
    pg8::Gemm g{WSP(bf16, A_P) + 0, WSP(bf16, W_UQ), PW, 384}; pg8::StaticOrder S; S.init(TH, 768, F.G, F.bid);
    EpiBf16 E{WSP(bf16, M_Q), 768, nullptr, 0}; pg8::gemm_phase(F.lds, g, S, E, F.tid);
}
struct EpiKV {
    static constexpr bool PERM = true, AFTER_DRAIN = false;
    bf16* KV; bf16* VT;
    __device__ __forceinline__ void operator()(const f32x4 (&acc)[2][2][4][2], const Unit& u, int wr, int wc, int fr, int fq) const {
        const int row0 = u.pm * 256 + wr * 64 + fr, col0 = wc * 32 + 8 * fq;
#pragma unroll
        for (int ai = 0; ai < 2; ++ai)
#pragma unroll
            for (int m = 0; m < 4; ++m) { const int row = row0 + ai * HALFT + m * 16;
                { const f32x4 v0 = acc[ai][0][m][0], v1 = acc[ai][0][m][1]; u32x4 w; w.x = pk2(v0[0], v0[1]); w.y = pk2(v0[2], v0[3]); w.z = pk2(v1[0], v1[1]); w.w = pk2(v1[2], v1[3]);
                  *(u32x4*)(KV + (size_t)row * 1024 + u.pn * 256 + col0) = w; }
                const int b = row / SEQ, t = row % SEQ; bf16* vt = VT + ((size_t)(b * 4 + u.pn) * 128 + col0) * SEQ + t;
#pragma unroll
                for (int n = 0; n < 2; ++n)
#pragma unroll
                    for (int j = 0; j < 4; ++j) vt[(size_t)(4 * n + j) * SEQ] = (bf16)f2bf(acc[ai][1][m][n][j]); }
    }
};
__device__ __forceinline__ void phase_mla_kv(const Frame& F, const Args& A) {
    pg8::Gemm g{WSP(bf16, A_P) + 384, WSP(bf16, W_UKV), PW, 256}; pg8::StaticOrder S; S.init(TH, 1024, F.G, F.bid);
    EpiKV E{WSP(bf16, M_KV), WSP(bf16, M_VT)}; pg8::gemm_phase(F.lds, g, S, E, F.tid);
}
constexpr int AT_KS = 200, AT_VS = 72;
constexpr int AT_KBYTES = 64 * AT_KS * 2, AT_VBYTES = 128 * AT_VS * 2;
__device__ __forceinline__ void phase_attention(const Frame& F, const Args& A) {
    const bf16* Q = WSP(bf16, M_Q); const bf16* KV = WSP(bf16, M_KV); const bf16* KR = WSP(bf16, M_KR); const bf16* VTg = WSP(bf16, M_VT); const float* rope = WSP(float, A_ROPE); bf16* Y = WSP(bf16, A_Y);
    const int lane = F.lane, w = F.wave, l15 = lane & 15, q4 = lane >> 4, tid = F.tid, grp = w >> 2, wq = w & 3;
    const int NQB = SEQ / 128, nunits = BH * 4 * NQB;
    const float sc2 = 0.07216878364870322f * 1.4426950408889634f;
    for (int unit = F.bid; unit < nunits; unit += F.G) {
        const int qb = NQB - 1 - (unit / (BH * 4)), bh = unit % (BH * 4), h = bh & 3, b = bh >> 2;
        const size_t t0 = (size_t)b * SEQ;
        bf16x8 qf[2][6];
#pragma unroll
        for (int f = 0; f < 2; ++f) { const size_t tq = t0 + qb * 128 + wq * 32 + 16 * f + l15;
#pragma unroll
            for (int ks = 0; ks < 6; ++ks) qf[f][ks] = *(const bf16x8*)(Q + tq * 768 + h * 192 + 32 * ks + 8 * q4);
            const bf16x8 a = qf[f][4], c2 = qf[f][5];
#pragma unroll
            for (int j = 0; j < 8; ++j) { const float x1 = bf2f((unsigned short)a[j]), x2 = bf2f((unsigned short)c2[j]), c = rope[tq * 64 + 8 * q4 + j], sn = rope[tq * 64 + 32 + 8 * q4 + j];
                qf[f][4][j] = (short)f2bf(x1 * c - x2 * sn); qf[f][5][j] = (short)f2bf(x2 * c + x1 * sn); } }
        f32x4 o[2][8];
#pragma unroll
        for (int f = 0; f < 2; ++f)
#pragma unroll
            for (int mb = 0; mb < 8; ++mb) o[f][mb] = (f32x4){0.f, 0.f, 0.f, 0.f};
        float mrow[2] = {-3.0e38f, -3.0e38f}, lrow[2] = {0.f, 0.f};
        const int qchunk = 2 * qb + (wq >> 1), ntile = 2 * qb + 2;
        u32x4 pk_[3], pv_[2];
        const int skey = tid >> 3, c8 = tid & 7;
        const int okv = skey * 1024 + 8 * c8, okr = skey * 64 + 8 * c8, ovt = skey * SEQ + 8 * c8;
        const bf16* kvb = KV + t0 * 1024 + h * 256; const bf16* krb = KR + t0 * 64; const bf16* vtb = VTg + (size_t)(b * 4 + h) * 128 * SEQ;
#define AT_LOAD(kt) do { const bf16* kv_ = kvb + (size_t)(kt) * 65536; const bf16* kr_ = krb + (size_t)(kt) * 4096; const bf16* vt_ = vtb + (size_t)(kt) * 64; \
            pk_[0] = *(const u32x4*)(kv_ + okv); pk_[1] = *(const u32x4*)(kv_ + okv + 64); pk_[2] = *(const u32x4*)(kr_ + okr); \
            pv_[0] = *(const u32x4*)(vt_ + ovt); pv_[1] = *(const u32x4*)(vt_ + ovt + 64 * SEQ); } while (0)
#define AT_STORE(bufi) do { LAS bf16* Ks_ = (LAS bf16*)(F.lds + (bufi) * (AT_KBYTES + AT_VBYTES)); LAS bf16* Vt_ = (LAS bf16*)((LAS unsigned char*)Ks_ + AT_KBYTES); \
            *(LAS u32x4*)(Ks_ + skey * AT_KS + 8 * c8) = pk_[0]; *(LAS u32x4*)(Ks_ + skey * AT_KS + 8 * c8 + 64) = pk_[1]; *(LAS u32x4*)(Ks_ + skey * AT_KS + 8 * c8 + 128) = pk_[2]; \
            *(LAS u32x4*)(Vt_ + skey * AT_VS + 8 * c8) = pv_[0]; *(LAS u32x4*)(Vt_ + (skey + 64) * AT_VS + 8 * c8) = pv_[1]; } while (0)
        __syncthreads();
        AT_LOAD(0); AT_STORE(0);
        __syncthreads();
        for (int kt = 0; kt < ntile; ++kt) {
            if (kt + 1 < ntile) AT_LOAD(kt + 1);
            if (kt <= qchunk) {
                const LAS bf16* Ks = (const LAS bf16*)(F.lds + (kt & 1) * (AT_KBYTES + AT_VBYTES)); const LAS bf16* Vt = (const LAS bf16*)((const LAS unsigned char*)Ks + AT_KBYTES);
                f32x4 st[2][2];
#pragma unroll
                for (int kb = 0; kb < 2; ++kb) { st[0][kb] = (f32x4){0.f, 0.f, 0.f, 0.f}; st[1][kb] = (f32x4){0.f, 0.f, 0.f, 0.f};
#pragma unroll
                    for (int ks = 0; ks < 6; ++ks) { const bf16x8 kf = *(const LAS bf16x8*)(Ks + (32 * grp + 16 * kb + l15) * AT_KS + 32 * ks + 8 * q4);
                        st[0][kb] = MFMA_BF16(kf, qf[0][ks], st[0][kb]); st[1][kb] = MFMA_BF16(kf, qf[1][ks], st[1][kb]); } }
                bf16x8 pb[2];
#pragma unroll
                for (int f = 0; f < 2; ++f) {
                    float mx = -3.0e38f;
#pragma unroll
                    for (int kb = 0; kb < 2; ++kb) { st[f][kb] = st[f][kb] * sc2; mx = fmaxf(mx, fmaxf(fmaxf(st[f][kb].x, st[f][kb].y), fmaxf(st[f][kb].z, st[f][kb].w))); }
                    mx = rows_max(mx);
                    const float mnew = fmaxf(mrow[f], mx), alpha = exp2f(mrow[f] - mnew); mrow[f] = mnew;
                    float ps = 0.f;
#pragma unroll
                    for (int kb = 0; kb < 2; ++kb)
#pragma unroll
                        for (int r = 0; r < 4; ++r) { const float p = exp2f(st[f][kb][r] - mnew); ps += p; pb[f][4 * kb + r] = (short)f2bf(p); }
                    lrow[f] = lrow[f] * alpha + ps;
#pragma unroll
                    for (int mb = 0; mb < 8; ++mb) o[f][mb] = o[f][mb] * alpha;
                }
#pragma unroll
                for (int mb = 0; mb < 8; ++mb) { const LAS bf16* vp = Vt + (16 * mb + l15) * AT_VS + 32 * grp + 4 * q4;
                    const bf16x4 v0 = *(const LAS bf16x4*)vp, v1 = *(const LAS bf16x4*)(vp + 16);
                    bf16x8 vf; vf[0] = v0[0]; vf[1] = v0[1]; vf[2] = v0[2]; vf[3] = v0[3]; vf[4] = v1[0]; vf[5] = v1[1]; vf[6] = v1[2]; vf[7] = v1[3];
                    o[0][mb] = MFMA_BF16(vf, pb[0], o[0][mb]); o[1][mb] = MFMA_BF16(vf, pb[1], o[1][mb]); }
            }
            if (kt + 1 < ntile) AT_STORE((kt + 1) & 1);
            __syncthreads();
        }
#undef AT_LOAD
#undef AT_STORE
#pragma unroll
        for (int f = 0; f < 2; ++f) lrow[f] = rows_sum(lrow[f]);
        LAS float* xo = (LAS float*)F.lds + (size_t)wq * (2 * 8 * 4 * 64 + 4 * 64);
        if (grp == 1) {
#pragma unroll
            for (int f = 0; f < 2; ++f) {
#pragma unroll
                for (int mb = 0; mb < 8; ++mb)
#pragma unroll
                    for (int r = 0; r < 4; ++r) xo[((f * 8 + mb) * 4 + r) * 64 + lane] = o[f][mb][r];
                xo[2 * 8 * 4 * 64 + f * 64 + lane] = mrow[f]; xo[2 * 8 * 4 * 64 + 128 + f * 64 + lane] = lrow[f]; } }
        __syncthreads();
        if (grp == 0) {
#pragma unroll
            for (int f = 0; f < 2; ++f) { const float m1 = xo[2 * 8 * 4 * 64 + f * 64 + lane], l1 = xo[2 * 8 * 4 * 64 + 128 + f * 64 + lane];
                const float m = fmaxf(mrow[f], m1), a0 = exp2f(mrow[f] - m), a1 = exp2f(m1 - m), inv = 1.0f / (lrow[f] * a0 + l1 * a1);
                const size_t tq = t0 + qb * 128 + wq * 32 + 16 * f + l15;
#pragma unroll
                for (int mb = 0; mb < 8; ++mb) { f32x4 v;
#pragma unroll
                    for (int r = 0; r < 4; ++r) v[r] = (o[f][mb][r] * a0 + xo[((f * 8 + mb) * 4 + r) * 64 + lane] * a1) * inv;
                    st_bf16x4(Y + tq * 512 + h * 128 + 16 * mb + 4 * q4, v); } } }
    }
    __syncthreads();
}

__device__ __forceinline__ f32x4 tile_bf(const LAS bf16* a, int lda, const LAS bf16* bt, int ldb, int K, f32x4 acc, int l15, int q4) {
    const LAS bf16* ap = a + l15 * lda + 8 * q4; const LAS bf16* bp = bt + l15 * ldb + 8 * q4;
#pragma unroll 4
    for (int ks = 0; ks < K / 32; ++ks) acc = MFMA_BF16(*(const LAS bf16x8*)(ap + 32 * ks), *(const LAS bf16x8*)(bp + 32 * ks), acc);
    return acc;
}
__device__ __forceinline__ f32x4 tile_mm(const LAS float* a, int lda, int ska, const LAS float* b, int ldb, int scb, int K, f32x4 acc, int l15, int q4);


__device__ __forceinline__ void diag_solve16(const LAS float* Lblk  , int ldl, LAS float* xcol  , int ldx) {
    float x[16];
#pragma unroll
    for (int i = 0; i < 16; ++i) x[i] = xcol[i * ldx];
#pragma unroll
    for (int g = 0; g < 4; ++g) {
        f32x4 av[4][4];
#pragma unroll
        for (int ii = 0; ii < 4; ++ii)
#pragma unroll
            for (int c4 = 0; c4 <= g; ++c4) av[ii][c4] = *(const LAS f32x4*)(Lblk + (4 * g + ii) * ldl + 4 * c4);
#pragma unroll
        for (int ii = 0; ii < 4; ++ii) { const int i = 4 * g + ii; float sacc = x[i];
#pragma unroll
            for (int jj = 0; jj < i; ++jj) sacc -= av[ii][jj >> 2][jj & 3] * x[jj];
            x[i] = sacc; }
    }
#pragma unroll
    for (int i = 1; i < 16; ++i) xcol[i * ldx] = x[i];
}
__device__ __forceinline__ void tri_solve64(const LAS float* L, int ldl, LAS float* X, int ldx, int nct, LAS float* scr, int w, int l15, int q4) {
    LAS float* DI = scr;
    if (w < 4) { LAS float* T = DI + w * 320; LAS float* S = scr + 4 * 320 + w * 320; const LAS float* N = L + 16 * w * ldl + 16 * w;
#pragma unroll
        for (int r = 0; r < 4; ++r) { const int i = 4 * q4 + r; T[i * 20 + l15] = (i == l15 ? 1.0f : 0.0f) - (l15 < i ? N[i * ldl + l15] : 0.0f); }
        { const f32x4 a = tile_mm(N, ldl, 1, N, ldl, 1, 16, (f32x4){0.f, 0.f, 0.f, 0.f}, l15, q4);
#pragma unroll
          for (int r = 0; r < 4; ++r) S[(4 * q4 + r) * 20 + l15] = a[r]; }
        WAVE_SYNC();
#pragma unroll
        for (int it = 0; it < 3; ++it) {
            { const f32x4 a = tile_mm(T, 20, 1, S, 20, 1, 16, (f32x4){0.f, 0.f, 0.f, 0.f}, l15, q4);
#pragma unroll
              for (int r = 0; r < 4; ++r) T[(4 * q4 + r) * 20 + l15] += a[r]; }
            if (it < 2) { const f32x4 a = tile_mm(S, 20, 1, S, 20, 1, 16, (f32x4){0.f, 0.f, 0.f, 0.f}, l15, q4);
#pragma unroll
                for (int r = 0; r < 4; ++r) S[(4 * q4 + r) * 20 + l15] = a[r]; }
            WAVE_SYNC();
        } }
    __syncthreads();
    for (int ct = w; ct < nct; ct += 8) { LAS float* Xc = X + 16 * ct;
#pragma unroll
        for (int rb = 0; rb < 4; ++rb) {
            if (rb > 0) { const f32x4 a = tile_mm(L + 16 * rb * ldl, ldl, 1, Xc, ldx, 1, 16 * rb, (f32x4){0.f, 0.f, 0.f, 0.f}, l15, q4);
#pragma unroll
                for (int r = 0; r < 4; ++r) Xc[(16 * rb + 4 * q4 + r) * ldx + l15] -= a[r];
                WAVE_SYNC(); }
            const f32x4 y = tile_mm(DI + rb * 320, 20, 1, Xc + 16 * rb * ldx, ldx, 1, 16, (f32x4){0.f, 0.f, 0.f, 0.f}, l15, q4);
#pragma unroll
            for (int r = 0; r < 4; ++r) Xc[(16 * rb + 4 * q4 + r) * ldx + l15] = y[r];
            WAVE_SYNC();
        } }
}
__device__ __forceinline__ void phase_rwkv_prep(const Frame& F, const Args& A, int layer) {
    const bf16* P = WSP(bf16, A_P); bf16* RKV = WSP(bf16, R_RKV); bf16* LIN = WSP(bf16, R_LIN); const float* mu = AIN(A, 8) + (size_t)layer * 1824;
    const int lane = F.lane;
    for (int m = F.gw; m < TH; m += F.NGW) {
        const bool first = (m % SEQ) == 0; const bf16* pr = P + (size_t)m * PW + C_RWKV;
#pragma unroll
        for (int j = 0; j < 8; ++j) { const int c = 4 * lane + 256 * j;
            if (c < 1824) { const f32x4 p = ld_bf16x4(pr + c); const f32x4 pv = first ? (f32x4){0.f, 0.f, 0.f, 0.f} : ld_bf16x4(pr - PW + c); const f32x4 muv = *(const f32x4*)(mu + c);
                f32x4 x = p + (pv - p) * muv;
                if (c < 1536) st_bf16x4(RKV + (size_t)m * 1536 + c, x);
                else { if (c < 1600) { x.x = tanhf_(x.x); x.y = tanhf_(x.y); x.z = tanhf_(x.z); x.w = tanhf_(x.w); }
                       else if (c >= 1664) { x.x = sigmoidf_(x.x); x.y = sigmoidf_(x.y); x.z = sigmoidf_(x.z); x.w = sigmoidf_(x.w); }
                       st_bf16x4(LIN + (size_t)m * 384 + (c - 1536), x); } } }
        if (lane < 24) st_bf16x4(LIN + (size_t)m * 384 + 288 + 4 * lane, (f32x4){0.f, 0.f, 0.f, 0.f});
    }
}
__device__ __forceinline__ void phase_rwkv_lora(const Frame& F, const Args& A) {
    pg8::Gemm g{WSP(bf16, R_LIN), WSP(bf16, W_LORA), 384, 384}; pg8::StaticOrder S; S.init(TH, 1536, F.G, (F.bid + F.G / 2) % F.G);
    EpiF32 E{WSP(float, R_LOUT), 1536}; pg8::gemm_phase(F.lds, g, S, E, F.tid);
}
constexpr int RS = 72;
constexpr int RREC_COMMON = 4 * 64 * RS * 2 + 256;
constexpr int RREC_T = 64 * 64 * 2;
constexpr int RREC_BYTES = RREC_COMMON + 3 * RREC_T;
static_assert(RREC_BYTES == 61696, "record size (see R_REC in the workspace map)");
static_assert(RREC_COMMON % 16 == 0, "record alignment");
__device__ __forceinline__ void phase_rwkv_r1(const Frame& F, const Args& A, int layer) {
    const bf16* RKV = WSP(bf16, R_RKV); const float* LOUT = WSP(float, R_LOUT); unsigned char* REC = WSP(unsigned char, R_REC);
    const float* w0 = AIN(A, 9) + layer * 512; const float* a0 = AIN(A, 11) + layer * 512; const float* k_k = AIN(A, 14) + layer * 512; const float* k_a = AIN(A, 15) + layer * 512;
    LAS bf16* kbar = (LAS bf16*)F.lds; LAS bf16* atil = kbar + 64 * RS; LAS bf16* khat = atil + 64 * RS; LAS bf16* rbar = khat + 64 * RS;
    LAS bf16* atT = rbar + 64 * RS; LAS bf16* khT = atT + 64 * RS; LAS bf16* vT = khT + 64 * RS; LAS bf16* Bm = vT + 64 * RS; LAS bf16* Em = Bm + 64 * RS;
    LAS float* Am = (LAS float*)(Em + 64 * RS);
    LAS float* X = Am + 64 * 68;
    LAS float* lam = Am;
    const int w = F.wave;
    const int nunits = BH * 8 * NCH;
    for (int unit = F.bid; unit < nunits; unit += F.G) {
        int tid = F.tid; OPAQUE_V(tid); const int lane = tid & 63, l15 = lane & 15, q4 = lane >> 4;
        const int c = unit % NCH, h = (unit / NCH) & 7, b = unit / (NCH * 8);
        const size_t tok0 = (size_t)b * SEQ + (size_t)c * 64;
        const int j = lane, cj = h * 64 + j;
        __syncthreads();
        float r_[8], km_[8], kk_[8], ka_[8], v_[8], L_[8];
        { const float w0c = w0[cj], a0c = a0[cj], kkc = k_k[cj], kac = k_a[cj]; float run = 0.f;
#pragma unroll
          for (int q = 0; q < 8; ++q) { const int t = 8 * w + q; const size_t tok = tok0 + t;
              const float r = bf2f(RKV[tok * 1536 + cj]), k = bf2f(RKV[tok * 1536 + 512 + cj]); v_[q] = bf2f(RKV[tok * 1536 + 1024 + cj]);
              const float wpre = LOUT[tok * 1536 + cj], apre = LOUT[tok * 1536 + 512 + cj];
              const float wl = -softplusf_(-(w0c + wpre)) - 0.5f, a = sigmoidf_(a0c + apre);
              const float kr = k * kkc, ss = wave_sum(kr * kr), kk = kr * RSQRT(ss + EPS);
              r_[q] = r; km_[q] = k * (1.0f + (a - 1.0f) * kac); kk_[q] = kk; ka_[q] = kk * a;
              run += -expf(wl); L_[q] = run; }
          lam[w * 64 + j] = run; }
        __syncthreads();
        { float base = 0.f, Lend = 0.f;
#pragma unroll
          for (int ww = 0; ww < 8; ++ww) { const float tw = lam[ww * 64 + j]; if (ww < w) base += tw; Lend += tw; }
#pragma unroll
          for (int q = 0; q < 8; ++q) { const int t = 8 * w + q; const float L = base + L_[q], Lm1 = q ? base + L_[q - 1] : base;
              const float eG = expf(L), eGi = expf(-L), eGm1 = expf(Lm1), eT = expf(Lend - L);
              const float kb = kk_[q] * eGm1;
              kbar[t * RS + j] = (bf16)f2bf(kb); X[t * 132 + j] = kb;
              atil[t * RS + j] = (bf16)f2bf(ka_[q] * eGi); khat[t * RS + j] = (bf16)f2bf(km_[q] * eGi); rbar[t * RS + j] = (bf16)f2bf(r_[q] * eG);
              atT[j * RS + t] = (bf16)f2bf(-ka_[q] * eT); khT[j * RS + t] = (bf16)f2bf(km_[q] * eT); vT[j * RS + t] = (bf16)f2bf(v_[q]); }
          if (w == 0) { float* gc = (float*)(REC + (size_t)unit * RREC_BYTES + 4 * 64 * RS * 2); gc[j] = expf(Lend); } }
        __syncthreads();
        unsigned char* rec = REC + (size_t)unit * RREC_BYTES;
        { const int which = w >> 1, tib = 2 * (w & 1);
          const LAS bf16* Aop = (which & 2) ? rbar : kbar; const LAS bf16* Bop = (which & 1) ? khat : atil;
          bf16x8 aF[2][2], bF[4][2];
#pragma unroll
          for (int t = 0; t < 2; ++t)
#pragma unroll
              for (int ks = 0; ks < 2; ++ks) aF[t][ks] = *(const LAS bf16x8*)(Aop + (16 * (tib + t) + l15) * RS + 8 * q4 + 32 * ks);
#pragma unroll
          for (int tj = 0; tj < 4; ++tj)
#pragma unroll
              for (int ks = 0; ks < 2; ++ks) bF[tj][ks] = *(const LAS bf16x8*)(Bop + (16 * tj + l15) * RS + 8 * q4 + 32 * ks);
          f32x4 acc[2][4];
#pragma unroll
          for (int t = 0; t < 2; ++t)
#pragma unroll
              for (int tj = 0; tj < 4; ++tj) { acc[t][tj] = MFMA_BF16(aF[t][0], bF[tj][0], ((f32x4){0.f, 0.f, 0.f, 0.f})); acc[t][tj] = MFMA_BF16(aF[t][1], bF[tj][1], acc[t][tj]); }
#pragma unroll
          for (int t = 0; t < 2; ++t)
#pragma unroll
              for (int tj = 0; tj < 4; ++tj)
#pragma unroll
                  for (int r = 0; r < 4; ++r) { const int i = 16 * (tib + t) + 4 * q4 + r, jj = 16 * tj + l15; const bool keep = (which & 2) ? (jj <= i) : (jj < i); const float v = keep ? acc[t][tj][r] : 0.f;
                      if (which == 0) Am[i * 68 + jj] = v; else if (which == 1) Bm[i * RS + jj] = (bf16)f2bf(v); else if (which == 3) Em[i * RS + jj] = (bf16)f2bf(v);
                      else ((bf16*)(rec + 2 * 64 * RS * 2))[i * RS + jj] = (bf16)f2bf(-v); } }
        __syncthreads();
        { const int tj = w & 3, pb = 6 * (w >> 2);
          bf16x8 bF[2]; f32x4 acc[6];
#pragma unroll
          for (int ks = 0; ks < 2; ++ks) bF[ks] = *(const LAS bf16x8*)(vT + (16 * tj + l15) * RS + 8 * q4 + 32 * ks);
#pragma unroll
          for (int pq = 0; pq < 6; ++pq) { const int pair = pb + pq, which = pair >> 2, ti = pair & 3; const LAS bf16* aop = which == 0 ? Bm : which == 1 ? Em : khT;
              const bf16x8 a0 = *(const LAS bf16x8*)(aop + (16 * ti + l15) * RS + 8 * q4), a1 = *(const LAS bf16x8*)(aop + (16 * ti + l15) * RS + 8 * q4 + 32);
              acc[pq] = MFMA_BF16(a0, bF[0], ((f32x4){0.f, 0.f, 0.f, 0.f})); acc[pq] = MFMA_BF16(a1, bF[1], acc[pq]); }
#pragma unroll
          for (int pq = 0; pq < 6; ++pq) { const int pair = pb + pq, which = pair >> 2, ti = pair & 3;
              if (which == 0) {
#pragma unroll
                  for (int r = 0; r < 4; ++r) X[(16 * ti + 4 * q4 + r) * 132 + 64 + 16 * tj + l15] = acc[pq][r]; }
              else st_bf16x4((bf16*)(rec + RREC_COMMON + which * RREC_T) + (16 * tj + l15) * 64 + 16 * ti + 4 * q4, acc[pq]); } }
        __syncthreads();
        tri_solve64(Am, 68, X, 132, 8, X + 64 * 132, w, l15, q4);
        __syncthreads();
        { const int t = tid >> 3, j0 = 8 * (tid & 7); float v[8];
#pragma unroll
          for (int q = 0; q < 8; ++q) v[q] = X[t * 132 + j0 + q];
          *(u32x4*)((bf16*)rec + t * RS + j0) = pack8(v);
          const int vv = tid >> 3, t0 = 8 * (tid & 7);
#pragma unroll
          for (int q = 0; q < 8; ++q) v[q] = X[(t0 + q) * 132 + 64 + vv];
          *(u32x4*)((bf16*)(rec + RREC_COMMON) + vv * 64 + t0) = pack8(v); }
        for (int e = tid; e < 64 * RS / 8; e += 512) { ((u32x4*)(rec + 64 * RS * 2))[e] = ((const LAS u32x4*)rbar)[e]; ((u32x4*)(rec + 3 * 64 * RS * 2))[e] = ((const LAS u32x4*)atT)[e]; }
    }
    __syncthreads();
}
constexpr int R2_BUF = RREC_COMMON;
__device__ __forceinline__ void phase_rwkv_r2(const Frame& F, const Args& A) {
    const unsigned char* REC = WSP(unsigned char, R_REC); float* RO = WSP(float, R_O);
    LAS unsigned char* buf0 = F.lds; LAS bf16* HT = (LAS bf16*)(F.lds + 2 * R2_BUF); LAS bf16* UT = HT + 2 * 64 * RS;
    const int tid = F.tid, lane = F.lane, w = F.wave, l15 = lane & 15, q4 = lane >> 4, ti = w >> 1;
    const int nunits = BH * 8;
    constexpr int NCHK = R2_BUF / 16;
    for (int unit = F.bid; unit < nunits; unit += F.G) {
        const int h = unit & 7, b = unit >> 3;
        __syncthreads();
        for (int e = tid; e < 2 * 64 * RS / 2; e += 512) ((LAS unsigned*)HT)[e] = 0u;
        f32x4 Hreg[2] = {(f32x4){0.f, 0.f, 0.f, 0.f}, (f32x4){0.f, 0.f, 0.f, 0.f}};
        u32x4 preA[5], preB[5]; u32x2 iniA[3][2], iniB[3][2], cur[3][2];
        const unsigned char* rec0 = REC + (size_t)((b * 8 + h) * NCH) * RREC_BYTES;
        const int tofs = ((16 * (2 * (w & 1)) + l15) * 64 + 16 * ti + 4 * q4) * 2;
#define R2_LOAD(S, recp) do { _Pragma("unroll") for (int q = 0; q < 5; ++q) { const int e = tid + 512 * q; if (e < NCHK) pre##S[q] = *(const u32x4*)((recp) + (size_t)e * 16); } \
            _Pragma("unroll") for (int mq = 0; mq < 3; ++mq) { ini##S[mq][0] = *(const u32x2*)((recp) + RREC_COMMON + mq * RREC_T + tofs); ini##S[mq][1] = *(const u32x2*)((recp) + RREC_COMMON + mq * RREC_T + tofs + 16 * 64 * 2); } } while (0)
#define R2_STORE(S, dst) do { _Pragma("unroll") for (int q = 0; q < 5; ++q) { const int e = tid + 512 * q; if (e < NCHK) *(LAS u32x4*)((dst) + (size_t)e * 16) = pre##S[q]; } } while (0)
#define R2_TAKE(S) do { _Pragma("unroll") for (int mq = 0; mq < 3; ++mq) { cur[mq][0] = ini##S[mq][0]; cur[mq][1] = ini##S[mq][1]; } } while (0)
        R2_LOAD(A, rec0); R2_STORE(A, buf0); R2_TAKE(A);
        if (NCH > 1) R2_LOAD(A, rec0 + (size_t)RREC_BYTES);
        __syncthreads();
#define R2_STEP(c, LS, SS) do { \
            LAS unsigned char* buf = buf0 + ((c) & 1) * R2_BUF; LAS unsigned char* nbuf = buf0 + (((c) + 1) & 1) * R2_BUF; \
            if ((c) + 2 < NCH) R2_LOAD(LS, rec0 + (size_t)((c) + 2) * RREC_BYTES); \
            const LAS bf16* KB = (const LAS bf16*)buf; const LAS bf16* RB = KB + 64 * RS; const LAS bf16* FMn = RB + 64 * RS; const LAS bf16* ATn = FMn + 64 * RS; \
            const LAS float* GC = (const LAS float*)(buf + 4 * 64 * RS * 2); \
            const LAS bf16* H0 = HT + ((c) & 1) * 64 * RS; LAS bf16* H1 = HT + (((c) + 1) & 1) * 64 * RS; \
              \
            bf16x8 hf[2][2], uf[2][2], af[2]; \
            _Pragma("unroll") for (int t2 = 0; t2 < 2; ++t2) _Pragma("unroll") for (int ks = 0; ks < 2; ++ks) hf[t2][ks] = *(const LAS bf16x8*)(H0 + (16 * (2 * (w & 1) + t2) + l15) * RS + 8 * q4 + 32 * ks); \
            _Pragma("unroll") for (int ks = 0; ks < 2; ++ks) af[ks] = *(const LAS bf16x8*)(KB + (16 * ti + l15) * RS + 8 * q4 + 32 * ks); \
            _Pragma("unroll") for (int t2 = 0; t2 < 2; ++t2) { const int tj = 2 * (w & 1) + t2; \
                f32x4 u = (f32x4){bf2f(cur[0][t2].x & 0xffffu), bf2f(cur[0][t2].x >> 16), bf2f(cur[0][t2].y & 0xffffu), bf2f(cur[0][t2].y >> 16)}; \
                u = MFMA_BF16(af[0], hf[t2][0], u); u = MFMA_BF16(af[1], hf[t2][1], u); \
                u32x2 pk; pk.x = pk2(u[0], u[1]); pk.y = pk2(u[2], u[3]); *(LAS u32x2*)(UT + (16 * tj + l15) * RS + 16 * ti + 4 * q4) = pk; } \
            __syncthreads(); \
            _Pragma("unroll") for (int t2 = 0; t2 < 2; ++t2) _Pragma("unroll") for (int ks = 0; ks < 2; ++ks) uf[t2][ks] = *(const LAS bf16x8*)(UT + (16 * (2 * (w & 1) + t2) + l15) * RS + 8 * q4 + 32 * ks); \
            { bf16x8 rf[2], ff[2], tf[2]; \
              _Pragma("unroll") for (int ks = 0; ks < 2; ++ks) { rf[ks] = *(const LAS bf16x8*)(RB + (16 * ti + l15) * RS + 8 * q4 + 32 * ks); ff[ks] = *(const LAS bf16x8*)(FMn + (16 * ti + l15) * RS + 8 * q4 + 32 * ks); tf[ks] = *(const LAS bf16x8*)(ATn + (16 * ti + l15) * RS + 8 * q4 + 32 * ks); } \
              _Pragma("unroll") for (int t2 = 0; t2 < 2; ++t2) { const int tj = 2 * (w & 1) + t2; \
                f32x4 o = (f32x4){bf2f(cur[1][t2].x & 0xffffu), bf2f(cur[1][t2].x >> 16), bf2f(cur[1][t2].y & 0xffffu), bf2f(cur[1][t2].y >> 16)}; \
                o = MFMA_BF16(rf[0], hf[t2][0], o); o = MFMA_BF16(rf[1], hf[t2][1], o); o = MFMA_BF16(ff[0], uf[t2][0], o); o = MFMA_BF16(ff[1], uf[t2][1], o); \
                _Pragma("unroll") for (int r = 0; r < 4; ++r) RO[((size_t)b * SEQ + (size_t)(c) * 64 + 16 * ti + 4 * q4 + r) * 512 + h * 64 + 16 * tj + l15] = o[r]; \
                const f32x4 kv = (f32x4){bf2f(cur[2][t2].x & 0xffffu), bf2f(cur[2][t2].x >> 16), bf2f(cur[2][t2].y & 0xffffu), bf2f(cur[2][t2].y >> 16)}; \
                _Pragma("unroll") for (int r = 0; r < 4; ++r) Hreg[t2][r] = Hreg[t2][r] * GC[16 * ti + 4 * q4 + r] + kv[r]; \
                Hreg[t2] = MFMA_BF16(tf[0], uf[t2][0], Hreg[t2]); Hreg[t2] = MFMA_BF16(tf[1], uf[t2][1], Hreg[t2]); \
                u32x2 pk; pk.x = pk2(Hreg[t2][0], Hreg[t2][1]); pk.y = pk2(Hreg[t2][2], Hreg[t2][3]); *(LAS u32x2*)(H1 + (16 * tj + l15) * RS + 16 * ti + 4 * q4) = pk; } } \
            if ((c) + 1 < NCH) { R2_STORE(SS, nbuf); R2_TAKE(SS); } \
            __syncthreads(); } while (0)
        for (int c = 0; c < NCH; c += 2) { R2_STEP(c, B, A); R2_STEP(c + 1, A, B); }
#undef R2_STEP
#undef R2_STORE
#undef R2_TAKE
#undef R2_LOAD
    }
    __syncthreads();
}
__device__ __forceinline__ void phase_rwkv_post(const Frame& F, const Args& A, int layer) {
    const bf16* RKV = WSP(bf16, R_RKV); const float* LOUT = WSP(float, R_LOUT); const float* RO = WSP(float, R_O); bf16* Y = WSP(bf16, A_Y) + (size_t)1 * TH * 512;
    const float* a0 = AIN(A, 11) + layer * 512; const float* k_a = AIN(A, 15) + layer * 512; const float* r_k = AIN(A, 16) + layer * 512; const float* ln_w = AIN(A, 17) + layer * 512; const float* ln_b = AIN(A, 18) + layer * 512;
    const int lane = F.lane, c0 = 8 * lane;
    for (int m = F.gw; m < TH; m += F.NGW) {
        float o[8], r[8], k[8], v[8], ap[8], g[8];
        { const f32x4 a = *(const f32x4*)(RO + (size_t)m * 512 + c0), b2 = *(const f32x4*)(RO + (size_t)m * 512 + c0 + 4); o[0] = a.x; o[1] = a.y; o[2] = a.z; o[3] = a.w; o[4] = b2.x; o[5] = b2.y; o[6] = b2.z; o[7] = b2.w; }
#pragma unroll
        for (int hh = 0; hh < 2; ++hh) { const f32x4 rv = ld_bf16x4(RKV + (size_t)m * 1536 + c0 + 4 * hh), kv = ld_bf16x4(RKV + (size_t)m * 1536 + 512 + c0 + 4 * hh), vv = ld_bf16x4(RKV + (size_t)m * 1536 + 1024 + c0 + 4 * hh);
            const f32x4 av = *(const f32x4*)(LOUT + (size_t)m * 1536 + 512 + c0 + 4 * hh), gv = *(const f32x4*)(LOUT + (size_t)m * 1536 + 1024 + c0 + 4 * hh);
#pragma unroll
            for (int q = 0; q < 4; ++q) { r[4 * hh + q] = rv[q]; k[4 * hh + q] = kv[q]; v[4 * hh + q] = vv[q]; ap[4 * hh + q] = av[q]; g[4 * hh + q] = gv[q]; } }
        float bon = 0.f, sm = 0.f;
#pragma unroll
        for (int q = 0; q < 8; ++q) { const float a = sigmoidf_(a0[c0 + q] + ap[q]); const float km = k[q] * (1.0f + (a - 1.0f) * k_a[c0 + q]); bon += r[q] * km * r_k[c0 + q]; sm += o[q]; }
        bon += __shfl_xor(bon, 1); bon += __shfl_xor(bon, 2); bon += __shfl_xor(bon, 4);
        sm += __shfl_xor(sm, 1); sm += __shfl_xor(sm, 2); sm += __shfl_xor(sm, 4);
        const float mean = sm * (1.0f / 64.0f); float vs = 0.f;
#pragma unroll
        for (int q = 0; q < 8; ++q) { const float d = o[q] - mean; vs += d * d; }
        vs += __shfl_xor(vs, 1); vs += __shfl_xor(vs, 2); vs += __shfl_xor(vs, 4);
        const float rstd = RSQRT(vs * (1.0f / 64.0f) + 64e-5f);
        float y[8];
#pragma unroll
        for (int q = 0; q < 8; ++q) y[q] = ((o[q] - mean) * rstd * ln_w[c0 + q] + ln_b[c0 + q] + bon * v[q]) * g[q];
        u32x4 wv; wv.x = pk2(y[0], y[1]); wv.y = pk2(y[2], y[3]); wv.z = pk2(y[4], y[5]); wv.w = pk2(y[6], y[7]);
        *(u32x4*)(Y + (size_t)m * 512 + c0) = wv;
    }
}

__device__ __forceinline__ void conv8x8(const bf16* src, int tl0  , const float* w  , int wld, const float* bias, float (&out)[8][8]) {
    float x[11][8];
#pragma unroll
    for (int i = 0; i < 11; ++i) { const int tl = tl0 - 3 + i;
        if (tl >= 0) { const u32x4 v = *(const u32x4*)(src + (ptrdiff_t)(i - 3) * PW);
            x[i][0] = bf2f(v.x & 0xffffu); x[i][1] = bf2f(v.x >> 16); x[i][2] = bf2f(v.y & 0xffffu); x[i][3] = bf2f(v.y >> 16); x[i][4] = bf2f(v.z & 0xffffu); x[i][5] = bf2f(v.z >> 16); x[i][6] = bf2f(v.w & 0xffffu); x[i][7] = bf2f(v.w >> 16); }
        else {
#pragma unroll
            for (int ch = 0; ch < 8; ++ch) x[i][ch] = 0.f; } }
    float wv[4][8], bv[8];
#pragma unroll
    for (int j = 0; j < 4; ++j) { const f32x4 a = *(const f32x4*)(w + j * wld), b = *(const f32x4*)(w + j * wld + 4); wv[j][0] = a.x; wv[j][1] = a.y; wv[j][2] = a.z; wv[j][3] = a.w; wv[j][4] = b.x; wv[j][5] = b.y; wv[j][6] = b.z; wv[j][7] = b.w; }
    if (bias) { const f32x4 a = *(const f32x4*)bias, b = *(const f32x4*)(bias + 4); bv[0] = a.x; bv[1] = a.y; bv[2] = a.z; bv[3] = a.w; bv[4] = b.x; bv[5] = b.y; bv[6] = b.z; bv[7] = b.w; }
    else {
#pragma unroll
        for (int ch = 0; ch < 8; ++ch) bv[ch] = 0.f; }
#pragma unroll
    for (int i = 0; i < 8; ++i)
#pragma unroll
        for (int ch = 0; ch < 8; ++ch) { const float a = bv[ch] + wv[0][ch] * x[i][ch] + wv[1][ch] * x[i + 1][ch] + wv[2][ch] * x[i + 2][ch] + wv[3][ch] * x[i + 3][ch]; out[i][ch] = a * fast_rcp(1.0f + fast_exp(-a)); }
}
constexpr int SB = 136;
constexpr int SC_IMG = 64 * SB * 2;
__device__ __forceinline__ void phase_ssd_s1(const Frame& F, const Args& A, int layer) {
    const bf16* P = WSP(bf16, A_P); bf16* ST = WSP(bf16, S_ST); float* YD = WSP(float, S_YD); unsigned char* SCB = WSP(unsigned char, S_C); float* AC = WSP(float, S_AC);
    const float* cw = AIN(A, 23) + (size_t)layer * 4 * 1024; const float* cb = AIN(A, 24) + layer * 1024; const float* dtb = AIN(A, 25) + layer * 8; const float* a_log = AIN(A, 26) + layer * 8; const float* dsk = AIN(A, 27) + layer * 8;
    LAS bf16* Bt_ = (LAS bf16*)F.lds; LAS bf16* Ct_ = Bt_ + 64 * SB; LAS bf16* BT = Ct_ + 64 * SB; LAS bf16* xT = BT + 128 * RS;
    LAS bf16* Mb = xT + 4 * 64 * RS; LAS bf16* xdT = Mb + 2 * 64 * RS; LAS float* dt = (LAS float*)(xdT + 2 * 64 * RS); LAS float* ac = dt + 256;
    const int tid = F.tid, lane = F.lane, w = F.wave, l15 = lane & 15, q4 = lane >> 4;
    const int nunits = BH * NCH * 2;
    for (int unit = F.bid; unit < nunits; unit += F.G) {
        const int g = unit & 1, c = (unit >> 1) % NCH, b = unit / (2 * NCH);
        const size_t tok0 = (size_t)b * SEQ + (size_t)c * 64;
        __syncthreads();
        {
            const int cg = tid & 63, rb = tid >> 6;
            const int cidx = cg < 32 ? g * 256 + 8 * cg : cg < 48 ? 512 + g * 128 + 8 * (cg - 32) : 768 + g * 128 + 8 * (cg - 48);
            float o[8][8];
            conv8x8(P + (tok0 + 8 * rb) * PW + C_SSD + 512 + cidx, c * 64 + 8 * rb, cw + cidx, 1024, cb + cidx, o);
            if (cg < 32) {
                const int hh = cg >> 3, p0 = 8 * (cg & 7);
#pragma unroll
                for (int ch = 0; ch < 8; ++ch) { float col[8];
#pragma unroll
                    for (int i = 0; i < 8; ++i) col[i] = o[i][ch];
                    *(LAS u32x4*)(xT + (hh * 64 + p0 + ch) * RS + 8 * rb) = pack8(col); }
            } else if (cg < 48) {
                const int n0 = 8 * (cg - 32);
#pragma unroll
                for (int i = 0; i < 8; ++i) *(LAS u32x4*)(Bt_ + (8 * rb + i) * SB + n0) = pack8(o[i]);
#pragma unroll
                for (int ch = 0; ch < 8; ++ch) { float col[8];
#pragma unroll
                    for (int i = 0; i < 8; ++i) col[i] = o[i][ch];
                    *(LAS u32x4*)(BT + (n0 + ch) * RS + 8 * rb) = pack8(col); }
            } else { const int n0 = 8 * (cg - 48);
#pragma unroll
                for (int i = 0; i < 8; ++i) *(LAS u32x4*)(Ct_ + (8 * rb + i) * SB + n0) = pack8(o[i]); }
        }
        if (tid < 256) { const int hh = tid >> 6, h = 4 * g + hh; const float d = softplusf_(bf2f(P[(tok0 + lane) * PW + C_SSD + 1536 + h]) + dtb[h]); float a = -expf(a_log[h]) * d;
#pragma unroll
            for (int o = 1; o < 64; o <<= 1) { const float t = __shfl_up(a, o); if (lane >= o) a += t; }
            dt[tid] = d; ac[tid] = a; AC[(tok0 + lane) * 8 + h] = a; }
        __syncthreads();
        { unsigned char* dst = SCB + (size_t)unit * SC_IMG; for (int e = tid; e < SC_IMG / 16; e += 512) ((u32x4*)dst)[e] = ((const LAS u32x4*)Ct_)[e]; }
        f32x4 cbt[2];
#pragma unroll
        for (int tt = 0; tt < 2; ++tt) { const int tile = w * 2 + tt, ti = tile >> 2, tj = tile & 3; cbt[tt] = (f32x4){0.f, 0.f, 0.f, 0.f};
            if (tj <= ti) cbt[tt] = tile_bf(Ct_ + 16 * ti * SB, SB, Bt_ + 16 * tj * SB, SB, 128, cbt[tt], l15, q4); }
        for (int hh = 0; hh < 4; ++hh) { const int h = 4 * g + hh; LAS bf16* M = Mb + (hh & 1) * 64 * RS; LAS bf16* xd = xdT + (hh & 1) * 64 * RS; const LAS float* dth = dt + hh * 64; const LAS float* ach = ac + hh * 64;
#pragma unroll
            for (int tt = 0; tt < 2; ++tt) { const int tile = w * 2 + tt, ti = tile >> 2, tj = tile & 3;
#pragma unroll
                for (int r = 0; r < 4; ++r) { const int l = 16 * ti + 4 * q4 + r, s = 16 * tj + l15; M[l * RS + s] = (bf16)f2bf((s <= l) ? cbt[tt][r] * expf(ach[l] - ach[s]) * dth[s] : 0.f); } }
            { const int p = tid >> 3, l0 = 8 * (tid & 7); const u32x4 v = *(const LAS u32x4*)(xT + (hh * 64 + p) * RS + l0); const float a63 = ach[63]; float xv[8] = {bf2f(v.x & 0xffffu), bf2f(v.x >> 16), bf2f(v.y & 0xffffu), bf2f(v.y >> 16), bf2f(v.z & 0xffffu), bf2f(v.z >> 16), bf2f(v.w & 0xffffu), bf2f(v.w >> 16)};
#pragma unroll
              for (int i = 0; i < 8; ++i) xv[i] *= dth[l0 + i] * expf(a63 - ach[l0 + i]);
              *(LAS u32x4*)(xd + p * RS + l0) = pack8(xv); }
            __syncthreads();
#pragma unroll
            for (int tt = 0; tt < 2; ++tt) { const int tile = w * 2 + tt, ti = tile >> 2, tj = tile & 3;
                const f32x4 acc = tile_bf(M + 16 * ti * RS, RS, xT + (hh * 64 + 16 * tj) * RS, RS, 64, (f32x4){0.f, 0.f, 0.f, 0.f}, l15, q4);
                const f32x4 xs = ld_bf16x4((const bf16*)(xT + (hh * 64 + 16 * tj + l15) * RS + 16 * ti + 4 * q4));
#pragma unroll
                for (int r = 0; r < 4; ++r) YD[(tok0 + 16 * ti + 4 * q4 + r) * 512 + h * 64 + 16 * tj + l15] = acc[r] + dsk[h] * xs[r]; }
            bf16* st = ST + ((size_t)((b * NCH + c) * 8 + h)) * 64 * 128;
#pragma unroll
            for (int tt = 0; tt < 4; ++tt) { const int tile = w * 4 + tt, ti = tile >> 2, tj = tile & 3;
                const f32x4 acc = tile_bf(BT + 16 * ti * RS, RS, xd + 16 * tj * RS, RS, 64, (f32x4){0.f, 0.f, 0.f, 0.f}, l15, q4);
                st_bf16x4(st + (16 * tj + l15) * 128 + 16 * ti + 4 * q4, acc); }
        }
    }
    __syncthreads();
}
__device__ __forceinline__ void phase_ssd_s23(const Frame& F, const Args& A) {
    const bf16* ST = WSP(bf16, S_ST); float* YO = WSP(float, S_YO); const unsigned char* SCB = WSP(unsigned char, S_C); const float* AC = WSP(float, S_AC);
    LAS bf16* Cimg = (LAS bf16*)F.lds; LAS bf16* Hb = Cimg + 2 * 64 * SB;
    const int tid = F.tid, lane = F.lane, w = F.wave, l15 = lane & 15, q4 = lane >> 4;
    const int nunits = BH * 8 * 4, hp = tid >> 5, hn = 4 * (tid & 31);
    constexpr int NCK = SC_IMG / 16;
    for (int unit = F.bid; unit < nunits; unit += F.G) {
        const int ps = unit & 3, h = (unit >> 2) & 7, b = unit >> 5, g = h >> 2;
        __syncthreads();
        f32x4 Hr = (f32x4){0.f, 0.f, 0.f, 0.f};
        u32x4 preA[3], preB[3]; u32x2 pstA, pstB, stc; float eaA[5], eaB[5], eac[5];
        const size_t tokb = (size_t)b * SEQ;
#define S23_LOAD(S, cc) do { const unsigned char* src_ = SCB + (size_t)((b * NCH + (cc)) * 2 + g) * SC_IMG; \
            _Pragma("unroll") for (int q = 0; q < 3; ++q) { const int e = tid + 512 * q; if (e < NCK) pre##S[q] = *(const u32x4*)(src_ + (size_t)e * 16); } \
            pst##S = *(const u32x2*)(ST + ((size_t)((b * NCH + (cc)) * 8 + h)) * 8192 + (16 * ps + hp) * 128 + hn); \
            _Pragma("unroll") for (int r = 0; r < 4; ++r) ea##S[r] = AC[(tokb + (size_t)(cc) * 64 + 16 * (w & 3) + 4 * q4 + r) * 8 + h]; \
            ea##S[4] = AC[(tokb + (size_t)(cc) * 64 + 63) * 8 + h]; } while (0)
#define S23_STORE(S, dst) do { _Pragma("unroll") for (int q = 0; q < 3; ++q) { const int e = tid + 512 * q; if (e < NCK) ((LAS u32x4*)(dst))[e] = pre##S[q]; } } while (0)
#define S23_TAKE(S) do { stc = pst##S; _Pragma("unroll") for (int r = 0; r < 5; ++r) eac[r] = ea##S[r]; } while (0)
        S23_LOAD(A, 0); S23_STORE(A, Cimg); S23_TAKE(A);
        if (NCH > 1) S23_LOAD(A, 1);
#define S23_STEP(c, LS, SS) do { \
            const size_t tok0 = tokb + (size_t)(c) * 64; \
            if ((c) + 2 < NCH) S23_LOAD(LS, (c) + 2); \
            st_bf16x4((bf16*)(Hb + hp * SB + hn), Hr); \
            __syncthreads(); \
            if (w < 4) { const LAS bf16* Ci = Cimg + ((c) & 1) * 64 * SB; \
                const f32x4 acc = tile_bf(Ci + 16 * w * SB, SB, Hb, SB, 128, (f32x4){0.f, 0.f, 0.f, 0.f}, l15, q4); \
                _Pragma("unroll") for (int r = 0; r < 4; ++r) { const size_t tok = tok0 + 16 * w + 4 * q4 + r; YO[tok * 512 + h * 64 + 16 * ps + l15] = acc[r] * expf(eac[r]); } } \
            { const float dec = expf(eac[4]); Hr.x = dec * Hr.x + bf2f(stc.x & 0xffffu); Hr.y = dec * Hr.y + bf2f(stc.x >> 16); Hr.z = dec * Hr.z + bf2f(stc.y & 0xffffu); Hr.w = dec * Hr.w + bf2f(stc.y >> 16); } \
            if ((c) + 1 < NCH) { S23_STORE(SS, Cimg + (((c) + 1) & 1) * 64 * SB); S23_TAKE(SS); } \
            __syncthreads(); } while (0)
        for (int c = 0; c < NCH; c += 2) { S23_STEP(c, B, A); S23_STEP(c + 1, A, B); }
#undef S23_STEP
#undef S23_TAKE
#undef S23_STORE
#undef S23_LOAD
    }
    __syncthreads();
}
__device__ __forceinline__ void phase_ssd_s4(const Frame& F, const Args& A, int layer) {
    const float* YD = WSP(float, S_YD); const float* YO = WSP(float, S_YO); const bf16* P = WSP(bf16, A_P); bf16* Y = WSP(bf16, A_Y) + (size_t)3 * TH * 512; const float* nw = AIN(A, 28) + layer * 512;
    const int lane = F.lane, c0 = 8 * lane;
    for (int m = F.gw; m < TH; m += F.NGW) {
        const f32x4 a = *(const f32x4*)(YD + (size_t)m * 512 + c0) + *(const f32x4*)(YO + (size_t)m * 512 + c0), b2 = *(const f32x4*)(YD + (size_t)m * 512 + c0 + 4) + *(const f32x4*)(YO + (size_t)m * 512 + c0 + 4);
        const f32x4 z0 = ld_bf16x4(P + (size_t)m * PW + C_SSD + c0), z1 = ld_bf16x4(P + (size_t)m * PW + C_SSD + c0 + 4);
        float y[8] = {a.x * siluf_(z0.x), a.y * siluf_(z0.y), a.z * siluf_(z0.z), a.w * siluf_(z0.w), b2.x * siluf_(z1.x), b2.y * siluf_(z1.y), b2.z * siluf_(z1.z), b2.w * siluf_(z1.w)};
        float ss = 0.f;
#pragma unroll
        for (int q = 0; q < 8; ++q) ss += y[q] * y[q];
        ss += __shfl_xor(ss, 1); ss += __shfl_xor(ss, 2); ss += __shfl_xor(ss, 4); ss += __shfl_xor(ss, 8); ss += __shfl_xor(ss, 16);
        const float rstd = RSQRT(ss * (1.0f / 256.0f) + EPS);
#pragma unroll
        for (int q = 0; q < 8; ++q) y[q] = y[q] * rstd * nw[c0 + q];
        u32x4 wv; wv.x = pk2(y[0], y[1]); wv.y = pk2(y[2], y[3]); wv.z = pk2(y[4], y[5]); wv.w = pk2(y[6], y[7]);
        *(u32x4*)(Y + (size_t)m * 512 + c0) = wv;
    }
}

__device__ __forceinline__ f32x4 tile_mm(const LAS float* a, int lda, int ska, const LAS float* b, int ldb, int scb, int K, f32x4 acc, int l15, int q4) {
    const LAS float* ap = a + l15 * lda + q4 * ska; const LAS float* bp = b + q4 * ldb + l15 * scb;
#pragma unroll 8
    for (int ks = 0; ks < K / 4; ++ks) acc = MFMA_F32(ap[ks * 4 * ska], bp[ks * 4 * ldb], acc);
    return acc;
}
constexpr int GS = 132, GS2 = 68;
constexpr int GR_W = 0, GR_QH = 64 * 136 * 2, GR_KT = 2 * 64 * 136 * 2, GR_QK = GR_KT + 128 * 72 * 2, GR_GL = GR_QK + 64 * 72 * 2, GR_COMMON = GR_GL + 16, GR_UT = 128 * 64 * 2, GR_BYTES = GR_COMMON + GR_UT;
static_assert(GR_BYTES == 78864 && GR_COMMON % 16 == 0, "GDN record");
constexpr int GX = 264;
__device__ __forceinline__ void phase_gdn_g1(const Frame& F, const Args& A, int layer) {
    const bf16* P = WSP(bf16, A_P); unsigned char* CHR = WSP(unsigned char, G_CH);
    const float* convw = AIN(A, 19) + (size_t)layer * 4 * 1536; const float* a_log = AIN(A, 20) + layer * 4; const float* dtb = AIN(A, 21) + layer * 4;
    LAS bf16* qb = (LAS bf16*)F.lds; LAS bf16* kb = qb + 64 * SB; LAS bf16* qkimg = kb + 64 * SB;
    LAS float* X = (LAS float*)(qkimg + 64 * RS); LAS float* Lm = X + 64 * GX; LAS float* ssq = Lm + 64 * GS2;
    LAS float* beta = ssq + 2 * 64 * 16; LAS float* gc = beta + 64; LAS float* egc = gc + 64; LAS float* inorm = egc + 64;
    const int w = F.wave;
    const int nunits = BH * 4 * NCH;
    for (int unit = F.bid; unit < nunits; unit += F.G) {
        int tid = F.tid; OPAQUE_V(tid); const int lane = tid & 63, l15 = lane & 15, q4 = lane >> 4;
        const int c = unit % NCH, h = (unit / NCH) & 3, b = unit / (NCH * 4);
        const size_t tok0 = (size_t)b * SEQ + (size_t)c * 64;
        unsigned char* rec = CHR + (size_t)unit * GR_BYTES;
        __syncthreads();
        const int rb = tid / 48, pc = tid % 48, part = pc >> 4, cgl = pc & 15;
        float o[8][8];
        if (tid < 384) { const int col = part * 512 + h * 128 + 8 * cgl;
            conv8x8(P + (tok0 + 8 * rb) * PW + C_GDN + col, c * 64 + 8 * rb, convw + col, 1536, nullptr, o);
            if (part < 2) {
#pragma unroll
                for (int i = 0; i < 8; ++i) { float sacc = 0.f;
#pragma unroll
                    for (int ch = 0; ch < 8; ++ch) sacc += o[i][ch] * o[i][ch];
                    ssq[(part * 64 + 8 * rb + i) * 16 + cgl] = sacc; } } }
        if (w == 7) { const size_t tok = tok0 + lane; beta[lane] = sigmoidf_(bf2f(P[tok * PW + C_GDN + 1536 + h]));
            float g = -expf(a_log[h]) * softplusf_(bf2f(P[tok * PW + C_GDN + 1540 + h]) + dtb[h]);
#pragma unroll
            for (int o2 = 1; o2 < 64; o2 <<= 1) { const float t = __shfl_up(g, o2); if (lane >= o2) g += t; }
            gc[lane] = g; egc[lane] = expf(g); }
        __syncthreads();
        if (tid < 128) { float sacc = 0.f;
#pragma unroll
            for (int i = 0; i < 16; ++i) sacc += ssq[tid * 16 + i];
            inorm[tid] = (tid < 64 ? 0.08838834764831845f : 1.0f) * RSQRT(sacc + EPS); }
        __syncthreads();
        if (tid < 384) {
#pragma unroll
            for (int i = 0; i < 8; ++i) { const int l = 8 * rb + i;
                if (part < 2) { const float sc = inorm[part * 64 + l]; float v[8];
#pragma unroll
                    for (int ch = 0; ch < 8; ++ch) v[ch] = o[i][ch] * sc;
                    *(LAS u32x4*)((part ? kb : qb) + l * SB + 8 * cgl) = pack8(v); }
                else { const float bl = beta[l]; *(LAS f32x4*)(X + l * GX + 8 * cgl) = (f32x4){o[i][0] * bl, o[i][1] * bl, o[i][2] * bl, o[i][3] * bl}; *(LAS f32x4*)(X + l * GX + 8 * cgl + 4) = (f32x4){o[i][4] * bl, o[i][5] * bl, o[i][6] * bl, o[i][7] * bl}; } } }
        __syncthreads();
        for (int tt = 0; tt < 4; ++tt) { const int tile = w * 4 + tt, which = tile >> 4, ti = (tile >> 2) & 3, tj = tile & 3;
            f32x4 acc = (f32x4){0.f, 0.f, 0.f, 0.f};
            if (tj <= ti) acc = tile_bf((which ? qb : kb) + 16 * ti * SB, SB, kb + 16 * tj * SB, SB, 128, acc, l15, q4);
#pragma unroll
            for (int r = 0; r < 4; ++r) { const int i = 16 * ti + 4 * q4 + r, j = 16 * tj + l15; float v = 0.f;
                if (which ? (j <= i) : (j < i)) v = acc[r] * expf(gc[i] - gc[j]) * (which ? 1.0f : beta[i]);
                if (which) qkimg[i * RS + j] = (bf16)f2bf(v); else Lm[i * GS2 + j] = v; } }
        { const float glast = gc[63];
          for (int e = tid; e < 64 * 16; e += 512) { const int l = e >> 4, d0 = 8 * (e & 15); const u32x4 kv = *(const LAS u32x4*)(kb + l * SB + d0), qv = *(const LAS u32x4*)(qb + l * SB + d0);
              const float kf[8] = {bf2f(kv.x & 0xffffu), bf2f(kv.x >> 16), bf2f(kv.y & 0xffffu), bf2f(kv.y >> 16), bf2f(kv.z & 0xffffu), bf2f(kv.z >> 16), bf2f(kv.w & 0xffffu), bf2f(kv.w >> 16)};
              float qf[8] = {bf2f(qv.x & 0xffffu), bf2f(qv.x >> 16), bf2f(qv.y & 0xffffu), bf2f(qv.y >> 16), bf2f(qv.z & 0xffffu), bf2f(qv.z >> 16), bf2f(qv.w & 0xffffu), bf2f(qv.w >> 16)};
              const float sc = beta[l] * egc[l], eg = egc[l];
              *(LAS f32x4*)(X + l * GX + 128 + d0) = (f32x4){kf[0] * sc, kf[1] * sc, kf[2] * sc, kf[3] * sc}; *(LAS f32x4*)(X + l * GX + 132 + d0) = (f32x4){kf[4] * sc, kf[5] * sc, kf[6] * sc, kf[7] * sc};
#pragma unroll
              for (int q = 0; q < 8; ++q) qf[q] *= eg;
              *(u32x4*)(rec + GR_QH + (size_t)(l * SB + d0) * 2) = pack8(qf); }
          for (int e = tid; e < 128 * 8; e += 512) { const int d = e >> 3, l0 = 8 * (e & 7); float kt[8];
#pragma unroll
              for (int q = 0; q < 8; ++q) kt[q] = bf2f(kb[(l0 + q) * SB + d]) * expf(glast - gc[l0 + q]);
              *(u32x4*)(rec + GR_KT + (size_t)(d * RS + l0) * 2) = pack8(kt); }
          if (tid == 0) *(float*)(rec + GR_GL) = expf(glast); }
        __syncthreads();
        for (int e = tid; e < 64 * RS / 8; e += 512) ((u32x4*)(rec + GR_QK))[e] = ((const LAS u32x4*)qkimg)[e];
        tri_solve64(Lm, GS2, X, GX, 16, ssq, w, l15, q4);
        __syncthreads();
        for (int e = tid; e < 64 * 16; e += 512) { const int l = e >> 4, d0 = 8 * (e & 15); const f32x4 a = *(const LAS f32x4*)(X + l * GX + 128 + d0), b2 = *(const LAS f32x4*)(X + l * GX + 132 + d0);
            const float v[8] = {a.x, a.y, a.z, a.w, b2.x, b2.y, b2.z, b2.w}; *(u32x4*)(rec + GR_W + (size_t)(l * SB + d0) * 2) = pack8(v); }
        for (int e = tid; e < 128 * 8; e += 512) { const int vv = e >> 3, t0 = 8 * (e & 7); float v[8];
#pragma unroll
            for (int q = 0; q < 8; ++q) v[q] = X[(t0 + q) * GX + vv];
            *(u32x4*)((bf16*)(rec + GR_COMMON) + vv * 64 + t0) = pack8(v); }
    }
    __syncthreads();
}
constexpr int G2_STAGE = GR_COMMON;
__device__ __forceinline__ void phase_gdn_g2(const Frame& F, const Args& A) {
    const unsigned char* CHR = WSP(unsigned char, G_CH); float* GO = WSP(float, G_O);
    LAS unsigned char* buf0 = F.lds; LAS bf16* STt = (LAS bf16*)(F.lds + 2 * G2_STAGE); LAS bf16* vnT = STt + 2 * 32 * SB;
    const int tid = F.tid, lane = F.lane, w = F.wave, l15 = lane & 15, q4 = lane >> 4, ti = w >> 1, tj = w & 1;
    const int nunits = BH * 4 * 4;
    constexpr int NCK = G2_STAGE / 16;
    for (int unit = F.bid; unit < nunits; unit += F.G) {
        const int vs = unit & 3, h = (unit >> 2) & 3, b = unit >> 4;
        __syncthreads();
        for (int e = tid; e < 2 * 32 * SB / 2; e += 512) ((LAS unsigned*)STt)[e] = 0u;
        f32x4 Sreg[2] = {(f32x4){0.f, 0.f, 0.f, 0.f}, (f32x4){0.f, 0.f, 0.f, 0.f}};
        u32x4 preA[8], preB[8]; u32x2 uiniA, uiniB, ucur;
        const unsigned char* rec0 = CHR + (size_t)((b * 4 + h) * NCH) * GR_BYTES;
        const int uofs = GR_COMMON + ((32 * vs + 16 * tj + l15) * 64 + 16 * ti + 4 * q4) * 2;
#define G2_LOAD(S, recp) do { _Pragma("unroll") for (int q = 0; q < 8; ++q) { const int e = tid + 512 * q; if (e < NCK) pre##S[q] = *(const u32x4*)((recp) + (size_t)e * 16); } uini##S = *(const u32x2*)((recp) + uofs); } while (0)
#define G2_STORE(S, dst) do { _Pragma("unroll") for (int q = 0; q < 8; ++q) { const int e = tid + 512 * q; if (e < NCK) *(LAS u32x4*)((dst) + (size_t)e * 16) = pre##S[q]; } } while (0)
        G2_LOAD(A, rec0); G2_STORE(A, buf0); ucur = uiniA;
        if (NCH > 1) G2_LOAD(A, rec0 + (size_t)GR_BYTES);
        __syncthreads();
#define G2_STEP(c, LS, SS) do { \
            LAS unsigned char* buf = buf0 + ((c) & 1) * G2_STAGE; LAS unsigned char* nbuf = buf0 + (((c) + 1) & 1) * G2_STAGE; \
            if ((c) + 2 < NCH) G2_LOAD(LS, rec0 + (size_t)((c) + 2) * GR_BYTES); \
            const LAS bf16* Wi = (const LAS bf16*)(buf + GR_W); const LAS bf16* QH = (const LAS bf16*)(buf + GR_QH); const LAS bf16* KT = (const LAS bf16*)(buf + GR_KT); const LAS bf16* QK = (const LAS bf16*)(buf + GR_QK); \
            const float egl = *(const LAS float*)(buf + GR_GL); \
            const LAS bf16* S0 = STt + ((c) & 1) * 32 * SB; LAS bf16* S1 = STt + (((c) + 1) & 1) * 32 * SB; \
            { const f32x4 acc = tile_bf(Wi + 16 * ti * SB, SB, S0 + 16 * tj * SB, SB, 128, (f32x4){0.f, 0.f, 0.f, 0.f}, l15, q4); \
              const f32x4 vn = (f32x4){bf2f(ucur.x & 0xffffu), bf2f(ucur.x >> 16), bf2f(ucur.y & 0xffffu), bf2f(ucur.y >> 16)} - acc; \
              u32x2 pk; pk.x = pk2(vn[0], vn[1]); pk.y = pk2(vn[2], vn[3]); *(LAS u32x2*)(vnT + (16 * tj + l15) * RS + 16 * ti + 4 * q4) = pk; } \
            __syncthreads(); \
            { f32x4 acc = tile_bf(QH + 16 * ti * SB, SB, S0 + 16 * tj * SB, SB, 128, (f32x4){0.f, 0.f, 0.f, 0.f}, l15, q4); \
              acc = tile_bf(QK + 16 * ti * RS, RS, vnT + 16 * tj * RS, RS, 64, acc, l15, q4); \
              _Pragma("unroll") for (int r = 0; r < 4; ++r) GO[((size_t)b * SEQ + (size_t)(c) * 64 + 16 * ti + 4 * q4 + r) * 512 + h * 128 + 32 * vs + 16 * tj + l15] = acc[r]; } \
            _Pragma("unroll") for (int t2 = 0; t2 < 2; ++t2) { Sreg[t2] = Sreg[t2] * egl; \
                Sreg[t2] = tile_bf(KT + 16 * w * RS, RS, vnT + 16 * t2 * RS, RS, 64, Sreg[t2], l15, q4); \
                u32x2 pk; pk.x = pk2(Sreg[t2][0], Sreg[t2][1]); pk.y = pk2(Sreg[t2][2], Sreg[t2][3]); *(LAS u32x2*)(S1 + (16 * t2 + l15) * SB + 16 * w + 4 * q4) = pk; } \
            if ((c) + 1 < NCH) { G2_STORE(SS, nbuf); ucur = uini##SS; } \
            __syncthreads(); } while (0)
        for (int c = 0; c < NCH; c += 2) { G2_STEP(c, B, A); G2_STEP(c + 1, A, B); }
#undef G2_STEP
#undef G2_STORE
#undef G2_LOAD
    }
    __syncthreads();
}
__device__ __forceinline__ void phase_gdn_g3(const Frame& F, const Args& A, int layer) {
    const float* GO = WSP(float, G_O); const bf16* P = WSP(bf16, A_P); bf16* Y = WSP(bf16, A_Y) + (size_t)2 * TH * 512; const float* nw = AIN(A, 22) + layer * 128;
    const int lane = F.lane, c0 = 8 * lane;
    for (int m = F.gw; m < TH; m += F.NGW) {
        const f32x4 a = *(const f32x4*)(GO + (size_t)m * 512 + c0), b2 = *(const f32x4*)(GO + (size_t)m * 512 + c0 + 4);
        float o[8] = {a.x, a.y, a.z, a.w, b2.x, b2.y, b2.z, b2.w}; float ss = 0.f;
#pragma unroll
        for (int q = 0; q < 8; ++q) ss += o[q] * o[q];
        ss += __shfl_xor(ss, 1); ss += __shfl_xor(ss, 2); ss += __shfl_xor(ss, 4); ss += __shfl_xor(ss, 8);
        const float rstd = RSQRT(ss * (1.0f / 128.0f) + EPS);
        const f32x4 z0 = ld_bf16x4(P + (size_t)m * PW + C_GDN + 1544 + c0), z1 = ld_bf16x4(P + (size_t)m * PW + C_GDN + 1544 + c0 + 4);
        const float z[8] = {z0.x, z0.y, z0.z, z0.w, z1.x, z1.y, z1.z, z1.w}; float y[8];
#pragma unroll
        for (int q = 0; q < 8; ++q) y[q] = o[q] * rstd * nw[(c0 + q) & 127] * siluf_(z[q]);
        u32x4 wv; wv.x = pk2(y[0], y[1]); wv.y = pk2(y[2], y[3]); wv.z = pk2(y[4], y[5]); wv.w = pk2(y[6], y[7]);
        *(u32x4*)(Y + (size_t)m * 512 + c0) = wv;
    }
}

__device__ __forceinline__ void phase_merge_z(const Frame& F, const Args& A) {
    pg8::Gemm g{WSP(bf16, A_Y), WSP(bf16, W_BR), 512, 512}; BranchOrder S; S.nP = TH / 256; S.G = F.G; S.c = F.bid;
    EpiZ E{WSP(bf16, A_Z)}; pg8::gemm_phase(F.lds, g, S, E, F.tid);
}
__device__ __forceinline__ void phase_merge_gate(const Frame& F, const Args& A, int layer) {
    pg8::Gemm g{WSP(bf16, A_H), WSP(bf16, W_GATE), D, D}; pg8::StaticOrder S; S.init(TH, 4096, F.G, F.bid);
    EpiMerge E{WSP(bf16, A_Z), AIN(A, 29) + (size_t)layer * 4 * D, WSP(bf16, A_MG)}; pg8::gemm_phase(F.lds, g, S, E, F.tid);
}
__device__ __forceinline__ void phase_merge_out(const Frame& F, const Args& A, const float* xin, float* xout) {
    pg8::Gemm g{WSP(bf16, A_MG), WSP(bf16, W_OUT), D, D}; pg8::StaticOrder S; S.init(TH, D, F.G, F.bid);
    EpiResidual E{xin, xout}; pg8::gemm_phase(F.lds, g, S, E, F.tid);
}
__device__ __forceinline__ void phase_ffn_gu(const Frame& F, const Args& A) {
    pg8::Gemm g{WSP(bf16, A_H), WSP(bf16, W_FGU), D, D}; pg8::StaticOrder S; S.init(TH, 2 * FF_D, F.G, F.bid);
    EpiSwiGLU E{WSP(bf16, F_ACT), FF_D, 1 << 20}; pg8::gemm_phase(F.lds, g, S, E, F.tid);
}
__device__ __forceinline__ void phase_ffn_down(const Frame& F, const Args& A, float* x) {
    pg8::Gemm g{WSP(bf16, F_ACT), WSP(bf16, W_FDN), FF_D, FF_D}; pg8::StaticOrder S; S.init(TH, D, F.G, F.bid);
    EpiResidual E{x, x}; pg8::gemm_phase(F.lds, g, S, E, F.tid);
}
struct MoeLayout { int pstart[NEXP + 1]; };
__device__ __forceinline__ MoeLayout moe_layout(const unsigned* cnt) {
    MoeLayout L; int s = 0;
#pragma unroll
    for (int e = 0; e < NEXP; ++e) { L.pstart[e] = s; s += ((int)cnt[e] + 255) & ~255; }
    L.pstart[NEXP] = s; return L;
}
struct MoeOrder {
    int np, nN, G, c; MoeLayout L;
    __device__ bool next(int i, Unit& u) const {
        const long Lx = (long)i * G + c; if (Lx >= (long)np * nN) return false;
        const int pm = (int)(Lx / nN), pn = (int)(Lx % nN); int e = 0;
#pragma unroll
        for (int k = 1; k < NEXP; ++k) if (pm * 256 >= L.pstart[k]) e = k;
        u.pm = pm; u.pn = e * nN + pn; return true;
    }
    __device__ __forceinline__ void a_ready(const Unit&) const {}
    __device__ __forceinline__ void done(const Unit&) const {}
};
__device__ __forceinline__ void phase_moe_route(const Frame& F, const Args& A, int half) {
    const unsigned* wgc = (const unsigned*)(F.ctl + CW_WGC + half * 8192); unsigned* cnt = (unsigned*)(F.ctl + CW_CNT + half * 16);
    LAS unsigned* tab = (LAS unsigned*)F.lds; LAS unsigned* tot = tab + 8192; LAS unsigned* bef = tot + 8; LAS unsigned* cur = bef + 8;
    __syncthreads();
    for (int e = F.tid; e < F.G * 8; e += 512) tab[e] = wgc[e];
    __syncthreads();
    if (F.tid < 8) { unsigned t = 0, bsum = 0; for (int g = 0; g < F.G; ++g) { const unsigned v = tab[g * 8 + F.tid]; if (g < F.bid) bsum += v; t += v; } tot[F.tid] = t; bef[F.tid] = bsum; cur[F.tid] = 0u; if (F.bid == 0) cnt[F.tid] = t; }
    __syncthreads();
    unsigned totr[8];
#pragma unroll
    for (int e = 0; e < 8; ++e) totr[e] = tot[e];
    const MoeLayout L = moe_layout(totr);
    const bf16* H = WSP(bf16, A_H); bf16* GA = WSP(bf16, F_GA); const int* tope = WSP(int, F_TOPE); int* slot = WSP(int, F_SLOT);
    const int lane = F.lane;
    for (int m = F.gw; m < TH; m += F.NGW) {
        const u32x4 v0 = *(const u32x4*)(H + (size_t)m * D + 8 * lane), v1 = *(const u32x4*)(H + (size_t)m * D + 512 + 8 * lane);
#pragma unroll
        for (int k = 0; k < 2; ++k) { const int e = tope[2 * m + k]; int s = 0;
            int ps = 0;
#pragma unroll
            for (int q = 0; q < NEXP; ++q) ps = (e == q) ? L.pstart[q] : ps;
            if (lane == 0) s = ps + (int)bef[e] + (int)ATOMIC_ADD_LDS(cur + e, 1u);
            s = __shfl(s, 0);
            if (lane == 0) slot[2 * m + k] = s;
            *(u32x4*)(GA + (size_t)s * D + 8 * lane) = v0; *(u32x4*)(GA + (size_t)s * D + 512 + 8 * lane) = v1; }
    }
#pragma unroll
    for (int e = 0; e < NEXP; ++e) { const int r0 = L.pstart[e] + (int)totr[e], r1 = L.pstart[e + 1];
        for (int r = r0 + F.gw; r < r1; r += F.NGW) { *(u32x4*)(GA + (size_t)r * D + 8 * lane) = (u32x4){0u, 0u, 0u, 0u}; *(u32x4*)(GA + (size_t)r * D + 512 + 8 * lane) = (u32x4){0u, 0u, 0u, 0u}; } }
    __syncthreads();
}
__device__ __forceinline__ void phase_moe_gu(const Frame& F, const Args& A, int half) {
    MoeOrder S; S.L = moe_layout((const unsigned*)(F.ctl + CW_CNT + half * 16)); S.np = S.L.pstart[NEXP] / 256; S.nN = 2 * FF_E / 256; S.G = F.G; S.c = F.bid;
    pg8::Gemm g{WSP(bf16, F_GA), WSP(bf16, W_FGU), D, D}; EpiSwiGLU E{WSP(bf16, F_ACT), FF_E, 2 * FF_E / 256}; pg8::gemm_phase(F.lds, g, S, E, F.tid);
}
struct EpiF32Mod {
    static constexpr bool PERM = false, AFTER_DRAIN = false;
    float* C;
    __device__ __forceinline__ void operator()(const f32x4 (&acc)[2][2][4][2], const Unit& u, int wr, int wc, int fr, int fq) const {
        const int row0 = u.pm * 256 + wr * 64 + fr, col0 = (u.pn & 3) * 256 + wc * 32 + 4 * fq;
#pragma unroll
        for (int ai = 0; ai < 2; ++ai)
#pragma unroll
            for (int m = 0; m < 4; ++m) { float* rowp = C + (size_t)(row0 + ai * HALFT + m * 16) * D + col0;
#pragma unroll
                for (int bj = 0; bj < 2; ++bj)
#pragma unroll
                    for (int n = 0; n < 2; ++n) *(f32x4*)(rowp + bj * HALFT + n * 16) = acc[ai][bj][m][n]; }
    }
};
__device__ __forceinline__ void phase_moe_down(const Frame& F, const Args& A, int half) {
    MoeOrder S; S.L = moe_layout((const unsigned*)(F.ctl + CW_CNT + half * 16)); S.np = S.L.pstart[NEXP] / 256; S.nN = D / 256; S.G = F.G; S.c = F.bid;
    pg8::Gemm g{WSP(bf16, F_ACT), WSP(bf16, W_FDN), FF_E, FF_E}; EpiF32Mod E{WSP(float, F_YE)}; pg8::gemm_phase(F.lds, g, S, E, F.tid);
}
__device__ __forceinline__ void phase_moe_combine(const Frame& F, const Args& A, float* x, const float* fgain) {
    const float* YE = WSP(float, F_YE); const int* slot = WSP(int, F_SLOT); const float* topw = WSP(float, F_TOPW); const int lane = F.lane;
    for (int m = F.gw; m < TH; m += F.NGW) { const int s0 = slot[2 * m], s1 = slot[2 * m + 1]; const float w0 = topw[2 * m], w1 = topw[2 * m + 1];
        f32x4 v[4]; float ss = 0.f;
#pragma unroll
        for (int j = 0; j < 4; ++j) { const int c = 4 * lane + 256 * j;
            v[j] = *(const f32x4*)(x + (size_t)m * D + c) + *(const f32x4*)(YE + (size_t)s0 * D + c) * w0 + *(const f32x4*)(YE + (size_t)s1 * D + c) * w1;
            ss += (v[j].x * v[j].x + v[j].y * v[j].y) + (v[j].z * v[j].z + v[j].w * v[j].w); }
        if (fgain) { const float rstd = RSQRT(wave_sum(ss) * (1.0f / D) + EPS);
#pragma unroll
            for (int j = 0; j < 4; ++j) v[j] = v[j] * rstd * *(const f32x4*)(fgain + 4 * lane + 256 * j); }
#pragma unroll
        for (int j = 0; j < 4; ++j) *(f32x4*)(x + (size_t)m * D + 4 * lane + 256 * j) = v[j]; }
}

#ifndef EMU
#define XB_TMO      128
#define XB_XCNT(j)  (256  + 64 * (j))
#define XB_XSUB(j)  (1280 + 64 * (j))
#define XB_XGEN(j)  (2304 + 64 * (j))
#define XB_TOP      3328
#define XB_TOPGEN   3392
#define XCD_BAR_WORDS 3456
#define XB_SPIN_CAP (1u << 22)
__device__ __forceinline__ unsigned xb_ld(unsigned* p)              { return __hip_atomic_load(p, __ATOMIC_RELAXED, __HIP_MEMORY_SCOPE_AGENT); }
__device__ __forceinline__ unsigned xb_add(unsigned* p, unsigned v) { return __hip_atomic_fetch_add(p, v, __ATOMIC_RELAXED, __HIP_MEMORY_SCOPE_AGENT); }
__device__ __forceinline__ unsigned xb_xcc_id() { return (unsigned)__builtin_amdgcn_s_getreg((3 << 11) | 20) & 0xFu; }
#define XB_SPIN(cond, bar) do { unsigned _sp = 0; while (cond) { __builtin_amdgcn_s_sleep(1); \
    if ((++_sp & 255u) == 0u) { if (xb_ld(&(bar)[XB_TMO])) break; if (_sp > XB_SPIN_CAP) { atomicAdd(&(bar)[XB_TMO], 1u); break; } } } } while (0)
struct XcdBarrier { unsigned* bar; unsigned x; volatile LAS unsigned* st; };
__device__ __forceinline__ XcdBarrier xcd_barrier_post(unsigned* bar, volatile LAS unsigned* st) {
    XcdBarrier b; b.bar = bar; b.x = xb_xcc_id(); b.st = st;
    if (threadIdx.x == 0) (void)xb_add(&bar[XB_XCNT(b.x)], 1u);
    return b;
}
__device__ __forceinline__ void xcd_barrier_complete(unsigned* bar, unsigned x, unsigned& nloc, unsigned& nx) {
    const unsigned G = gridDim.x * gridDim.y * gridDim.z;
    unsigned sum, cnt, mine, sp = 0u;
    for (;;) {
        sum = 0u; cnt = 0u; mine = 0u;
#pragma unroll
        for (unsigned j = 0; j < 16; ++j) { const unsigned c = xb_ld(&bar[XB_XCNT(j)]); sum += c; cnt += (c > 0u) ? 1u : 0u; mine = (j == x) ? c : mine; }
        if (sum == G) break;
        __builtin_amdgcn_s_sleep(1);
        if ((++sp & 255u) == 0u) { if (xb_ld(&bar[XB_TMO])) break; if (sp > XB_SPIN_CAP) { atomicAdd(&bar[XB_TMO], 1u); break; } }
    }
    nloc = mine > 0u ? mine : 1u; nx = cnt > 0u ? cnt : 1u;
}
__device__ __forceinline__ void xcd_barrier(const XcdBarrier& b) {
    asm volatile("s_waitcnt vmcnt(0)" ::: "memory");
    __syncthreads();
    if (threadIdx.x == 0) {
        unsigned* bar = b.bar;
        __builtin_amdgcn_s_waitcnt(0);
        unsigned nloc = b.st[0], nx = b.st[1];
        if (nloc == 0u) { xcd_barrier_complete(bar, b.x, nloc, nx); b.st[0] = nloc; b.st[1] = nx; }
        const unsigned old = xb_add(&bar[XB_XSUB(b.x)], 1u);
        const unsigned gen = old / nloc;
        if (old + 1u == (gen + 1u) * nloc) {
            __builtin_amdgcn_fence(__ATOMIC_RELEASE, "agent");
            asm volatile("s_waitcnt vmcnt(0)" ::: "memory");
            const unsigned og = xb_add(&bar[XB_TOP], 1u);
            const unsigned tg = og / nx;
            if (og + 1u == (tg + 1u) * nx) xb_add(&bar[XB_TOPGEN], 1u);
            else XB_SPIN(xb_ld(&bar[XB_TOPGEN]) == tg, bar);
            __builtin_amdgcn_fence(__ATOMIC_ACQUIRE, "agent");
            xb_add(&bar[XB_XGEN(b.x)], 1u);
            asm volatile("s_waitcnt vmcnt(0)" ::: "memory");
        } else {
            XB_SPIN(xb_ld(&bar[XB_XGEN(b.x)]) == gen, bar);
            __builtin_amdgcn_fence(__ATOMIC_ACQUIRE, "agent");
            asm volatile("s_waitcnt vmcnt(0)" ::: "memory");
        }
    }
    __syncthreads();
}
#endif

constexpr int NPHASES = DEPTH + NHALF * (14 + 16);
constexpr int LDS_BYTES = 155648, MISC_OFF = 154624;

__global__ void __launch_bounds__(512, 2) fwd_kernel(Args args_k) {
#ifdef EMU
    unsigned char* lds = emu_lds_ptr;
#else
    extern __shared__ __attribute__((aligned(16))) unsigned char lds[];
#endif
    Frame F0;
    F0.lds = (LAS unsigned char*)lds; F0.tid = threadIdx.x; F0.lane = F0.tid & 63; F0.wave = RFL(F0.tid >> 6); F0.G = gridDim.x; F0.bid = blockIdx.x;
    F0.gw = F0.bid * 8 + F0.wave; F0.NGW = F0.G * 8;
    F0.out = (GAS float*)args_k.out; F0.ws = (GAS unsigned char*)args_k.ws; F0.ctl = (GAS unsigned*)(F0.ws + WS_CTL);
    const int lo = args_k.lo, hi = args_k.hi;
#ifndef EMU
    volatile LAS unsigned* misc = (volatile LAS unsigned*)(F0.lds + MISC_OFF);
    if (F0.tid < 4) misc[F0.tid] = 0u;
    __syncthreads();
    XcdBarrier bar; bar.bar = (unsigned*)(F0.ctl + CW_BAR); bar.x = 0; bar.st = misc;
    if (hi - lo > 1) bar = xcd_barrier_post((unsigned*)(F0.ctl + CW_BAR), misc);
#define GRID_BAR() do { XcdBarrier bq = bar; asm volatile("" : "+s"(bq.bar), "+s"(bq.x)); xcd_barrier(bq); } while (0)
#else
#define GRID_BAR() do { } while (0)
#endif
    int ph = 0;
#ifndef PH_MASK
#define PH_MASK 0xFFFFFFFFFFFFFFFFull
#endif
#define PHASE(...) PHASE_I(31, __VA_ARGS__)
#ifdef EMU
#define LAUNDER(Fq) do { } while (0)
#else
#define LAUNDER(Fq) do { unsigned mq_ = ~0u; asm volatile("" : "+s"(Fq.G), "+s"(Fq.bid), "+s"(Fq.wave), "+s"(Fq.ws), "+s"(Fq.out), "+s"(Fq.ctl), "+s"(mq_)); Fq.lane = (int)__builtin_amdgcn_mbcnt_hi(mq_, __builtin_amdgcn_mbcnt_lo(mq_, 0u)); Fq.tid = Fq.wave * 64 + Fq.lane; Fq.gw = Fq.bid * 8 + Fq.wave; Fq.NGW = Fq.G * 8; } while (0)
#endif
#ifdef EMU
#define ARGS_Q() const Args& args_q = args_k
#else
#define ARGS_Q() const __attribute__((address_space(4))) Args* aq_ = (const __attribute__((address_space(4))) Args*)__builtin_amdgcn_kernarg_segment_ptr(); asm volatile("" : "+s"(aq_)); const Args& args_q = *(const Args*)aq_
#endif
#define PHASE_I(kind, ...) do { if (ph >= lo && ph < hi) { constexpr int reps_ = (((REPEAT_MASK) >> (kind)) & 1u) ? 2 : 1; for (int rr_ = 0; rr_ < reps_; ++rr_) { { Frame Fq = F0; LAUNDER(Fq); const Frame& F = Fq; ARGS_Q(); const Args& args = args_q; __VA_ARGS__; } if (rr_ + 1 < reps_ || ph + 1 < hi) { GRID_BAR(); if (((REPEAT_MASK) >> 26) & 1u) GRID_BAR(); } } } ++ph; } while (0)
#define PHASEK(kind, ...) PHASE_I(kind, __VA_ARGS__)
#define NORM1(layer, half) do { const size_t rn_ = (size_t)(half) * TH; const float* xn_ = ((layer) == 0 ? AIN(args, 0) : (const float*)F.out) + rn_ * D; \
            phase_norm<false>(F, args, xn_, AIN(args, 2) + (layer) * D, WSP(bf16, A_H), nullptr, nullptr, nullptr, nullptr); phase_rope_table(F, args, (const int*)AIN(args, 1) + rn_, WSP(float, A_ROPE)); } while (0)
#define SEGMENT(layer, half) do { \
            const size_t r0 = (size_t)(half) * TH; \
            const float* xin = ((layer) == 0 ? AIN(args_k, 0) : (const float*)F0.out) + r0 * D; float* xo = (float*)F0.out + r0 * D; \
            PHASEK(1, { pg8::Gemm g{WSP(bf16, A_H), WSP(bf16, W_IN), D, D}; pg8::StaticOrder S; S.init(TH, PW, F.G, F.bid); EpiBf16 E{WSP(bf16, A_P), PW, nullptr, 0}; pg8::gemm_phase(F.lds, g, S, E, F.tid); }); \
            PHASEK(2, phase_mla_prep(F, args); phase_rwkv_prep(F, args, layer)); \
            PHASEK(3, phase_mla_q(F, args); __syncthreads(); phase_mla_kv(F, args); __syncthreads(); phase_rwkv_lora(F, args)); \
            PHASEK(8, phase_rwkv_r1(F, args, layer)); \
            PHASEK(5, { const int ns_ = F.G >= 128 ? 64 : (F.G >= 4 ? F.G / 4 : 0); Frame Fa = F;       \
                        if (F.bid < ns_) { Fa.G = ns_; Fa.NGW = ns_ * 8; phase_rwkv_r2(Fa, args); } else { Fa.bid = F.bid - ns_; Fa.G = F.G - ns_; Fa.gw = Fa.bid * 8 + Fa.wave; Fa.NGW = Fa.G * 8; phase_attention(Fa, args); if (ns_ == 0) phase_rwkv_r2(F, args); } }); \
            PHASEK(9, phase_rwkv_post(F, args, layer); phase_gdn_g1(F, args, layer); phase_ssd_s1(F, args, layer)); \
            PHASEK(11, { const int ns_ = F.G >= 4 ? F.G / 2 : 0; Frame Fa = F;                               \
                        if (F.bid < ns_) { Fa.G = ns_; Fa.NGW = ns_ * 8; phase_gdn_g2(Fa, args); } else { Fa.bid = F.bid - ns_; Fa.G = F.G - ns_; Fa.gw = Fa.bid * 8 + Fa.wave; Fa.NGW = Fa.G * 8; phase_ssd_s23(Fa, args); if (ns_ == 0) phase_gdn_g2(F, args); } }); \
            PHASEK(12, phase_gdn_g3(F, args, layer); phase_ssd_s4(F, args, layer)); \
            PHASEK(17, phase_merge_z(F, args)); \
            PHASEK(18, phase_merge_gate(F, args, layer)); \
            PHASEK(19, phase_merge_out(F, args, xin, xo)); \
            if ((layer) == 0) { \
                PHASEK(20, phase_norm<false>(F, args, xo, AIN(args, 32) + (layer) * D, WSP(bf16, A_H), nullptr, nullptr, nullptr, nullptr)); \
                PHASEK(21, phase_ffn_gu(F, args)); \
                PHASE(phase_ffn_down(F, args, xo); if ((half) == 0 && NHALF == 2) NORM1(layer, 1)); \
            } else { \
                PHASE(phase_norm<true>(F, args, xo, AIN(args, 32) + (layer) * D, WSP(bf16, A_H), AIN(args, 35), WSP(int, F_TOPE), WSP(float, F_TOPW), (unsigned*)(F.ctl + CW_WGC + (half) * 8192))); \
                PHASE(phase_moe_route(F, args, half)); \
                PHASEK(22, phase_moe_gu(F, args, half)); \
                PHASEK(23, phase_moe_down(F, args, half)); \
                PHASE(phase_moe_combine(F, args, xo, (layer) == DEPTH - 1 ? AIN(args, 38) : nullptr); if ((half) == 0 && NHALF == 2) NORM1(layer, 1)); \
            } } while (0)
    static_assert(DEPTH == 2 && NHALF <= 2, "segment program");
    PHASEK(27, phase_convert(F, args, 0); NORM1(0, 0));
    SEGMENT(0, 0);
    if (NHALF == 2) SEGMENT(0, 1);
    PHASEK(27, phase_convert(F, args, 1); NORM1(1, 0));
    SEGMENT(1, 0);
    if (NHALF == 2) SEGMENT(1, 1);
#undef SEGMENT
#undef PHASE
}

#ifndef ONE_LAUNCH
#define ONE_LAUNCH 1
#endif
extern "C" void kernel_launch(void* const* d_in, const int* in_sizes, int n_in, void* d_out, int out_size, void* d_ws, size_t ws_size, hipStream_t stream) {
    static int grid = 0;
    if (grid == 0) {
#ifdef EMU
        grid = EMU_GRID;
#else
        if (n_in != 39 || out_size != T * D || ws_size < WS_NEED) { fprintf(stderr, "kernel_launch: unexpected problem (n_in %d out %d ws %zu need %zu)\n", n_in, out_size, ws_size, (size_t)WS_NEED); grid = -1; return; }
        int dev = 0, cus = 0;
        if (hipGetDevice(&dev) != hipSuccess || hipDeviceGetAttribute(&cus, hipDeviceAttributeMultiprocessorCount, dev) != hipSuccess) { grid = -1; return; }
        if (hipFuncSetAttribute((const void*)fwd_kernel, hipFuncAttributeMaxDynamicSharedMemorySize, LDS_BYTES) != hipSuccess) { fprintf(stderr, "kernel_launch: hipFuncSetAttribute failed\n"); grid = -1; return; }
        int per_cu = 0;
        if (hipOccupancyMaxActiveBlocksPerMultiprocessor(&per_cu, (const void*)fwd_kernel, 512, LDS_BYTES) != hipSuccess || per_cu < 1) fprintf(stderr, "kernel_launch: occupancy query reports %d\n", per_cu);
        (void)hipGetLastError();
        grid = cus;
#endif
    }
    if (grid < 0) return;
    (void)hipMemsetAsync((char*)d_ws + WS_CTL, 0, CTL_BYTES, stream);
    Args a{};
    for (int i = 0; i < 39; ++i) a.in[i] = (const float*)d_in[i];
    a.out = (float*)d_out; a.ws = (unsigned char*)d_ws;
#ifdef EMU
    for (int p = EMU_PH_LO; p < EMU_PH_HI && p < NPHASES; ++p) { a.lo = p; a.hi = p + 1; emu_launch(fwd_kernel, grid, 512, a); emu_after_phase(p); }
#else
#if ONE_LAUNCH
    a.lo = 0; a.hi = NPHASES;
    hipLaunchKernelGGL(fwd_kernel, dim3(grid), dim3(512), LDS_BYTES, stream, a);
#else
    for (int p = 0; p < NPHASES; ++p) { a.lo = p; a.hi = p + 1; hipLaunchKernelGGL(fwd_kernel, dim3(grid), dim3(512), LDS_BYTES, stream, a); }
#endif
#endif
}
```

```cpp
#ifndef EMU
#include <hip/hip_runtime.h>
#include <cstdio>
#include <cstdint>
#endif

#ifndef REPEAT_MASK
#define REPEAT_MASK 0u
#endif
#ifdef EMU
constexpr int BATCH = EMU_B, SEQ = EMU_S, NHALF = EMU_NHALF;
#else
constexpr int BATCH = 16, SEQ = 2048, NHALF = 2;
#endif
constexpr int D = 1024, DEPTH = 2, CH = 64;
constexpr int T = BATCH * SEQ, TH = T / NHALF, BH = BATCH / NHALF, NCH = SEQ / CH;
constexpr int C_MLA = 0, C_RWKV = 704, C_GDN = 2528, C_SSD = 4584, C_GATE = 6128, IN_COLS = 10224, PW = 6144;
constexpr int FF_D = 2816, FF_E = 3584, NEXP = 8;
constexpr int MOE_ROWS = ((TH * 2 + NEXP * 255) / 256) * 256;
constexpr float EPS = 1e-6f;
static_assert(TH % 256 == 0 && SEQ % 128 == 0 && BATCH % NHALF == 0 && (SEQ / 64) % 2 == 0, "shape");

typedef unsigned short bf16;
typedef float f32x4 __attribute__((ext_vector_type(4)));
typedef float f32x2 __attribute__((ext_vector_type(2)));
typedef short bf16x8 __attribute__((ext_vector_type(8)));
typedef short bf16x4 __attribute__((ext_vector_type(4)));
typedef unsigned u32x4 __attribute__((ext_vector_type(4)));
typedef unsigned u32x2 __attribute__((ext_vector_type(2)));
#ifdef EMU
#define LAS
#define GAS
#define MFMA_F32(a, b, c) emu_mfma_16x16x4f32(a, b, c)
#define MFMA_BF16(a, b, c) emu_mfma_16x16x32bf16(a, b, c)
#define ATOMIC_ADD_U32(p, v) emu_atomic_add_u32(p, v)
#define ATOMIC_ADD_LDS(p, v) emu_atomic_add_u32((unsigned*)(p), v)
#define RFL(x) (x)
#define OPAQUE_V(x) do { } while (0)
#define LDS_WAIT()
#define VM_WAIT()
__device__ __forceinline__ float fast_exp(float x) { return expf(x); }
__device__ __forceinline__ float fast_rcp(float x) { return 1.0f / x; }
__device__ __forceinline__ float fast_rsqrt(float x) { return 1.0f / sqrtf(x); }
#else
#define LAS __attribute__((address_space(3)))
#define GAS __attribute__((address_space(1)))
#define MFMA_F32(a, b, c) __builtin_amdgcn_mfma_f32_16x16x4f32(a, b, c, 0, 0, 0)
#define MFMA_BF16(a, b, c) __builtin_amdgcn_mfma_f32_16x16x32_bf16(a, b, c, 0, 0, 0)
#define ATOMIC_ADD_U32(p, v) __hip_atomic_fetch_add(p, v, __ATOMIC_RELAXED, __HIP_MEMORY_SCOPE_AGENT)
#define ATOMIC_ADD_LDS(p, v) __hip_atomic_fetch_add((LAS unsigned*)(p), v, __ATOMIC_RELAXED, __HIP_MEMORY_SCOPE_WORKGROUP)
#define RFL(x) __builtin_amdgcn_readfirstlane(x)
#define OPAQUE_V(x) asm volatile("" : "+v"(x))
#define LDS_WAIT() asm volatile("s_waitcnt lgkmcnt(0)" ::: "memory")
#define VM_WAIT() asm volatile("s_waitcnt vmcnt(0)" ::: "memory")
__device__ __forceinline__ float fast_exp(float x) { return __expf(x); }
__device__ __forceinline__ float fast_rcp(float x) { return __builtin_amdgcn_rcpf(x); }
__device__ __forceinline__ float fast_rsqrt(float x) { return __builtin_amdgcn_rsqf(x); }
#endif
__device__ __forceinline__ unsigned f2u(float f) { return __builtin_bit_cast(unsigned, f); }
__device__ __forceinline__ float u2f(unsigned u) { return __builtin_bit_cast(float, u); }
__device__ __forceinline__ unsigned f2bf(float f) { unsigned u = f2u(f); return (u + 0x7fffu + ((u >> 16) & 1u)) >> 16; }
__device__ __forceinline__ float bf2f(unsigned h) { return u2f(h << 16); }
__device__ __forceinline__ unsigned pk2(float lo, float hi) { return f2bf(lo) | (f2bf(hi) << 16); }
#ifndef EMU
#define expf(x) __expf(x)
#define exp2f(x) __builtin_amdgcn_exp2f(x)
#define FDIV(a, b) ((a) * __builtin_amdgcn_rcpf(b))
#define RSQRT(x) __builtin_amdgcn_rsqf(x)
__device__ __forceinline__ float softplusf_(float x) { return x > 20.f ? x : __logf(1.0f + __expf(x)); }
#else
#define FDIV(a, b) ((a) / (b))
#define RSQRT(x) (1.0f / sqrtf(x))
__device__ __forceinline__ float softplusf_(float x) { return x > 20.f ? x : log1pf(expf(x)); }
#endif
__device__ __forceinline__ float sigmoidf_(float x) { return FDIV(1.0f, 1.0f + expf(-x)); }
__device__ __forceinline__ float siluf_(float x) { return FDIV(x, 1.0f + expf(-x)); }
__device__ __forceinline__ float tanhf_(float x) { const float e = expf(2.0f * fminf(x, 15.0f)); return FDIV(e - 1.0f, e + 1.0f); }
__device__ __forceinline__ float wave_sum(float v) {
#pragma unroll
    for (int o = 1; o < 64; o <<= 1) v += __shfl_xor(v, o);
    return v;
}
__device__ __forceinline__ float wave_max(float v) {
#pragma unroll
    for (int o = 1; o < 64; o <<= 1) v = fmaxf(v, __shfl_xor(v, o));
    return v;
}
__device__ __forceinline__ f32x4 ld_bf16x4(const bf16* p) { const u32x2 w = *(const u32x2*)p; return (f32x4){bf2f(w.x & 0xffffu), bf2f(w.x >> 16), bf2f(w.y & 0xffffu), bf2f(w.y >> 16)}; }
__device__ __forceinline__ void st_bf16x4(bf16* p, f32x4 v) { u32x2 w; w.x = pk2(v.x, v.y); w.y = pk2(v.z, v.w); *(u32x2*)p = w; }
__device__ __forceinline__ u32x4 pack8(const float* v) { u32x4 o; o.x = pk2(v[0], v[1]); o.y = pk2(v[2], v[3]); o.z = pk2(v[4], v[5]); o.w = pk2(v[6], v[7]); return o; }

#ifdef EMU
__device__ __forceinline__ float rows_max(float v) { v = fmaxf(v, __shfl_xor(v, 16)); return fmaxf(v, __shfl_xor(v, 32)); }
__device__ __forceinline__ float rows_sum(float v) { v += __shfl_xor(v, 16); return v + __shfl_xor(v, 32); }
#else
typedef unsigned u32x2v __attribute__((ext_vector_type(2)));
__device__ __forceinline__ float rows_max(float v) {
    { const auto r = __builtin_amdgcn_permlane16_swap(f2u(v), f2u(v), false, false); v = fmaxf(u2f(r[0]), u2f(r[1])); }
    { const auto r = __builtin_amdgcn_permlane32_swap(f2u(v), f2u(v), false, false); v = fmaxf(u2f(r[0]), u2f(r[1])); }
    return v; }
__device__ __forceinline__ float rows_sum(float v) {
    { const auto r = __builtin_amdgcn_permlane16_swap(f2u(v), f2u(v), false, false); v = u2f(r[0]) + u2f(r[1]); }
    { const auto r = __builtin_amdgcn_permlane32_swap(f2u(v), f2u(v), false, false); v = u2f(r[0]) + u2f(r[1]); }
    return v; }
#endif

namespace pg8 {
#define PG8_LAS LAS
typedef unsigned short bf16_t;
constexpr int BM = 256, BK = 64, HALF = 128, HTB = HALF * BK * 2, STAGE_BYTES = 8 * HTB, NXCD = 8, WGM = 8;
__host__ __device__ __forceinline__ int lds_byte(int r, int c) { const int st = (r >> 4) * 2 + (c >> 5), rr = r & 15, cc = c & 31, ob = rr * 64 + cc * 2; return st * 1024 + (ob ^ (((ob >> 9) & 1) << 5)); }
__host__ __device__ __forceinline__ void stage_rc(int b, int& R, int& C) { const int st = b / 1024, sb = b % 1024, swz = sb ^ (((sb >> 9) & 1) << 5); R = (st >> 1) * 16 + swz / 64; C = (st & 1) * 32 + (swz % 64) / 2; }
__host__ __device__ __forceinline__ int perm32(int rho) { const int n = rho >> 4, i = rho & 15; return 8 * (i >> 2) + 4 * n + (i & 3); }
struct Unit { int pm, pn; };
struct Gemm { const bf16_t* A; const bf16_t* Bt; int lda, K; };
struct StaticOrder {
    int nM, nN, nwg, G, c;
    __host__ __device__ void init(int M, int N, int G_, int c_) { nM = M / BM; nN = N / BM; nwg = nM * nN; G = G_; c = c_; }
    __host__ __device__ bool next(int i, Unit& u) const {
        const long L = (long)i * G + c; if (L >= nwg) return false;
        int wgid = (int)L; { const int q = nwg / NXCD, r = nwg % NXCD, xcd = wgid % NXCD, off = wgid / NXCD; wgid = (xcd < r ? xcd * (q + 1) : r * (q + 1) + (xcd - r) * q) + off; }
        const int nig = WGM * nN, gid = wgid / nig, fm = gid * WGM, gsz = (nM - fm) < WGM ? (nM - fm) : WGM;
        u.pm = fm + ((wgid % nig) % gsz); u.pn = (wgid % nig) / gsz; return true;
    }
    __device__ __forceinline__ void a_ready(const Unit&) const {}
    __device__ __forceinline__ void done(const Unit&) const {}
};
#ifndef EMU
template <class Epi, class Sched>
__device__ __forceinline__ void gemm_phase(PG8_LAS unsigned char* lds, const Gemm g, const Sched& S, const Epi& E, const int tid) {
    const int wid = __builtin_amdgcn_readfirstlane(tid >> 6), lane = tid & 63, wr = wid >> 2, wc = wid & 3, fr = lane & 15, fq = lane >> 4;
    int Kq = g.K; asm volatile("" : "+s"(Kq));
    const int K = Kq, nt = K / BK, lda = g.lda;
    unsigned voffA[2], voffB[2];
#pragma unroll
    for (int i = 0; i < 2; ++i) { int R, C; stage_rc(tid * 16 + i * 8192, R, C); const int Rb = Epi::PERM ? ((R & ~31) + perm32(R & 31)) : R;
        voffA[i] = (unsigned)(R * lda + C) * 2u; voffB[i] = (unsigned)(Rb * K + C) * 2u; }
    const size_t kstep = (size_t)(BK * 2);
    const size_t hstep = (size_t)HALF * K * 2, hstepA = (size_t)HALF * lda * 2;
    const size_t tstep = 2 * hstep, tstepA = 2 * hstepA;
    const unsigned ldsw = (unsigned)wid * 1024u;
    const int aoff = lds_byte(wr * 64 + fr, fq * 8), boff = lds_byte(wc * 32 + fr, fq * 8);
#define PG8_SA(b, h) (((b) * 2 + (h)) * HTB)
#define PG8_SB(b, h) ((4 + (b) * 2 + (h)) * HTB)
#define PG8_STAGE(bufoff, gbase, voff) do { _Pragma("unroll") for (int _i = 0; _i < 2; ++_i) \
        __builtin_amdgcn_global_load_lds((const unsigned*)((const char*)(gbase) + (voff)[_i]), (PG8_LAS unsigned*)(lds + (bufoff) + ldsw + _i * 8192), 16, 0, 0); } while (0)
#define PG8_LDA(dst, b, h) do { _Pragma("unroll") for (int m = 0; m < 4; ++m) _Pragma("unroll") for (int k = 0; k < 2; ++k) dst[m][k] = *(const PG8_LAS bf16x8*)(lds + PG8_SA(b, h) + aoff + m * 2048 + k * 1024); } while (0)
#define PG8_LDB(dst, b, h) do { _Pragma("unroll") for (int n = 0; n < 2; ++n) _Pragma("unroll") for (int k = 0; k < 2; ++k) dst[n][k] = *(const PG8_LAS bf16x8*)(lds + PG8_SB(b, h) + boff + n * 2048 + k * 1024); } while (0)
#define PG8_MMA(ai, bj, At, Bt) do { __builtin_amdgcn_s_setprio(1); _Pragma("unroll") for (int m = 0; m < 4; ++m) _Pragma("unroll") for (int n = 0; n < 2; ++n) _Pragma("unroll") for (int k = 0; k < 2; ++k) \
        acc[ai][bj][m][n] = __builtin_amdgcn_mfma_f32_16x16x32_bf16(Bt[n][k], At[m][k], acc[ai][bj][m][n], 0, 0, 0); __builtin_amdgcn_s_setprio(0); } while (0)
#define PG8_WAIT_V(n) asm volatile("s_waitcnt vmcnt(" #n ")" ::: "memory")
#define PG8_WAIT_L(n) asm volatile("s_waitcnt lgkmcnt(" #n ")" ::: "memory")
#define PG8_BAR __builtin_amdgcn_s_barrier()
#define PG8_SCHED __builtin_amdgcn_sched_barrier(0)
    Unit cur, nxt; int ui = 0;
    if (!S.next(0, cur)) return;
    f32x4 acc[2][2][4][2];
#pragma unroll
    for (int a = 0; a < 2; ++a)
#pragma unroll
        for (int b = 0; b < 2; ++b)
#pragma unroll
            for (int m = 0; m < 4; ++m)
#pragma unroll
                for (int n = 0; n < 2; ++n) acc[a][b][m][n] = (f32x4){0.f, 0.f, 0.f, 0.f};
    bf16x8 At[4][2], B0[2][2], B1[2][2];
    const char* cA = (const char*)g.A + (size_t)cur.pm * tstepA; const char* cB = (const char*)g.Bt + (size_t)cur.pn * tstep;
    S.a_ready(cur);
    PG8_STAGE(PG8_SB(0, 0), cB, voffB); PG8_STAGE(PG8_SA(0, 0), cA, voffA); PG8_STAGE(PG8_SB(0, 1), cB + hstep, voffB); PG8_STAGE(PG8_SA(0, 1), cA + hstepA, voffA);
    if (wr == 1) PG8_BAR;
    PG8_WAIT_V(4); PG8_BAR;
    PG8_STAGE(PG8_SB(1, 0), cB + kstep, voffB); PG8_STAGE(PG8_SA(1, 0), cA + kstep, voffA); PG8_STAGE(PG8_SB(1, 1), cB + hstep + kstep, voffB);
    PG8_WAIT_V(6); PG8_BAR;
    for (;;) {
        const bool has_next = S.next(ui + 1, nxt);
        const char* nA = has_next ? (const char*)g.A + (size_t)nxt.pm * tstepA : cA; const char* nB = has_next ? (const char*)g.Bt + (size_t)nxt.pn * tstep : cB;
        for (int t = 0; t < nt; t += 2) {
            const bool last = (t == nt - 2);
            const char* a1 = cA + (size_t)(t + 1) * kstep;
            const char* a2 = last ? nA : cA + (size_t)(t + 2) * kstep; const char* b2 = last ? nB : cB + (size_t)(t + 2) * kstep;
            const char* a3 = a2 + kstep; const char* b3 = b2 + kstep;
            if (last && has_next) S.a_ready(nxt);
            PG8_LDB(B0, 0, 0); PG8_SCHED; PG8_LDA(At, 0, 0); PG8_STAGE(PG8_SA(1, 1), a1 + hstepA, voffA);
            PG8_WAIT_L(8); PG8_BAR; PG8_WAIT_L(0); PG8_MMA(0, 0, At, B0); PG8_BAR; PG8_SCHED;
            PG8_LDB(B1, 0, 1); PG8_STAGE(PG8_SB(0, 0), b2, voffB);
            PG8_BAR; PG8_WAIT_L(0); PG8_MMA(0, 1, At, B1); PG8_BAR;
            PG8_LDA(At, 0, 1); PG8_STAGE(PG8_SA(0, 0), a2, voffA);
            PG8_BAR; PG8_WAIT_L(0); PG8_MMA(1, 0, At, B0); PG8_BAR; PG8_SCHED;
            PG8_STAGE(PG8_SB(0, 1), b2 + hstep, voffB);
            PG8_WAIT_V(6); PG8_BAR; PG8_MMA(1, 1, At, B1); PG8_BAR;
            PG8_LDB(B0, 1, 0); PG8_SCHED; PG8_LDA(At, 1, 0); PG8_STAGE(PG8_SA(0, 1), a2 + hstepA, voffA);
            PG8_WAIT_L(8); PG8_BAR; PG8_WAIT_L(0); PG8_MMA(0, 0, At, B0); PG8_BAR; PG8_SCHED;
            PG8_LDB(B1, 1, 1); PG8_STAGE(PG8_SB(1, 0), b3, voffB);
            PG8_BAR; PG8_WAIT_L(0); PG8_MMA(0, 1, At, B1); PG8_BAR;
            PG8_LDA(At, 1, 1); PG8_STAGE(PG8_SA(1, 0), a3, voffA);
            PG8_BAR; PG8_WAIT_L(0); PG8_MMA(1, 0, At, B0); PG8_BAR; PG8_SCHED;
            PG8_STAGE(PG8_SB(1, 1), b3 + hstep, voffB);
            PG8_WAIT_V(6); PG8_BAR; PG8_MMA(1, 1, At, B1); PG8_BAR;
        }
        if constexpr (!Epi::AFTER_DRAIN) { E(acc, cur, wr, wc, fr, fq); S.done(cur); }
        if (!has_next) break;
#pragma unroll
        for (int a = 0; a < 2; ++a)
#pragma unroll
            for (int b = 0; b < 2; ++b)
#pragma unroll
                for (int m = 0; m < 4; ++m)
#pragma unroll
                    for (int n = 0; n < 2; ++n) acc[a][b][m][n] = (f32x4){0.f, 0.f, 0.f, 0.f};
        cur = nxt; cA = nA; cB = nB; ++ui;
    }
    PG8_WAIT_V(0);
    if (wr == 0) PG8_BAR;
    PG8_BAR;
    if constexpr (Epi::AFTER_DRAIN) { E.fused(acc, cur, wr, wc, fr, fq, lds, wid, lane); S.done(cur); }
#undef PG8_SA
#undef PG8_SB
#undef PG8_STAGE
#undef PG8_LDA
#undef PG8_LDB
#undef PG8_MMA
#undef PG8_WAIT_V
#undef PG8_WAIT_L
#undef PG8_BAR
#undef PG8_SCHED
}
#else
template <class Epi, class Sched>
__device__ __forceinline__ void gemm_phase(PG8_LAS unsigned char* lds, const Gemm g, const Sched& S, const Epi& E, const int tid) {
    const int wid = tid >> 6, lane = tid & 63, wr = wid >> 2, wc = wid & 3, fr = lane & 15, fq = lane >> 4;
    Unit cur;
    for (int ui = 0; S.next(ui, cur); ++ui) {
        f32x4 acc[2][2][4][2];
        for (int ai = 0; ai < 2; ++ai) for (int m = 0; m < 4; ++m) {
            const size_t row = (size_t)cur.pm * 256 + ai * 128 + wr * 64 + m * 16 + fr;
            const bf16_t* ap = g.A + row * g.lda;
            for (int bj = 0; bj < 2; ++bj) for (int n = 0; n < 2; ++n) for (int j = 0; j < 4; ++j) {
                const size_t col = (size_t)cur.pn * 256 + bj * 128 + wc * 32 + (Epi::PERM ? 8 * fq + 4 * n : 16 * n + 4 * fq) + j;
                const bf16_t* bp = g.Bt + col * g.K; float s = 0.f;
                for (int k = 0; k < g.K; ++k) s += bf2f(ap[k]) * bf2f(bp[k]);
                acc[ai][bj][m][n][j] = s; } }
        E(acc, cur, wr, wc, fr, fq);
    }
    __syncthreads();
}
#endif
}

using pg8::Unit;
constexpr int HALFT = 128;
struct EpiF32 {
    static constexpr bool PERM = false, AFTER_DRAIN = false;
    float* C; int ldc;
    __device__ __forceinline__ void operator()(const f32x4 (&acc)[2][2][4][2], const Unit& u, int wr, int wc, int fr, int fq) const {
        const int row0 = u.pm * 256 + wr * 64 + fr, col0 = u.pn * 256 + wc * 32 + 4 * fq;
#pragma unroll
        for (int ai = 0; ai < 2; ++ai)
#pragma unroll
            for (int m = 0; m < 4; ++m) { float* rowp = C + (size_t)(row0 + ai * HALFT + m * 16) * ldc + col0;
#pragma unroll
                for (int bj = 0; bj < 2; ++bj)
#pragma unroll
                    for (int n = 0; n < 2; ++n) *(f32x4*)(rowp + bj * HALFT + n * 16) = acc[ai][bj][m][n]; }
    }
};
struct EpiResidual {
    static constexpr bool PERM = false, AFTER_DRAIN = false;
    const float* res; float* out;
    __device__ __forceinline__ void operator()(const f32x4 (&acc)[2][2][4][2], const Unit& u, int wr, int wc, int fr, int fq) const {
        const int row0 = u.pm * 256 + wr * 64 + fr, col0 = u.pn * 256 + wc * 32 + 4 * fq;
#pragma unroll
        for (int ai = 0; ai < 2; ++ai) {
            f32x4 rv[4][2][2];
#pragma unroll
            for (int m = 0; m < 4; ++m) { const size_t o = (size_t)(row0 + ai * HALFT + m * 16) * D + col0;
#pragma unroll
                for (int bj = 0; bj < 2; ++bj)
#pragma unroll
                    for (int n = 0; n < 2; ++n) rv[m][bj][n] = *(const GAS f32x4*)(res + o + bj * HALFT + n * 16); }
#pragma unroll
            for (int m = 0; m < 4; ++m) { const size_t o = (size_t)(row0 + ai * HALFT + m * 16) * D + col0;
#pragma unroll
                for (int bj = 0; bj < 2; ++bj)
#pragma unroll
                    for (int n = 0; n < 2; ++n) *(GAS f32x4*)(out + o + bj * HALFT + n * 16) = rv[m][bj][n] + acc[ai][bj][m][n]; }
        }
    }
};
struct EpiBf16 {
    static constexpr bool PERM = true, AFTER_DRAIN = false;
    bf16* O; int ldc; const float* rowscale; int rs_stride;
    __device__ __forceinline__ void operator()(const f32x4 (&acc)[2][2][4][2], const Unit& u, int wr, int wc, int fr, int fq) const {
        const int row0 = u.pm * 256 + wr * 64 + fr, col0 = u.pn * 256 + wc * 32 + 8 * fq;
#pragma unroll
        for (int ai = 0; ai < 2; ++ai)
#pragma unroll
            for (int m = 0; m < 4; ++m) { const int row = row0 + ai * HALFT + m * 16; bf16* rowp = O + (size_t)row * ldc + col0;
                const float sc = rowscale ? rowscale[(size_t)row * rs_stride] : 1.0f;
#pragma unroll
                for (int bj = 0; bj < 2; ++bj) { const f32x4 v0 = acc[ai][bj][m][0] * sc, v1 = acc[ai][bj][m][1] * sc;
                    u32x4 w; w.x = pk2(v0[0], v0[1]); w.y = pk2(v0[2], v0[3]); w.z = pk2(v1[0], v1[1]); w.w = pk2(v1[2], v1[3]);
                    *(u32x4*)(rowp + bj * HALFT) = w; } }
    }
};
struct EpiSwiGLU {
    static constexpr bool PERM = true, AFTER_DRAIN = false;
    bf16* O; int ldc; int ntile;
    __device__ __forceinline__ void operator()(const f32x4 (&acc)[2][2][4][2], const Unit& u, int wr, int wc, int fr, int fq) const {
        const int row0 = u.pm * 256 + wr * 64 + fr, col0 = (u.pn % ntile) * 128 + wc * 32 + 8 * fq;
#pragma unroll
        for (int ai = 0; ai < 2; ++ai)
#pragma unroll
            for (int m = 0; m < 4; ++m) { bf16* rowp = O + (size_t)(row0 + ai * HALFT + m * 16) * ldc + col0;
                float a[8];
#pragma unroll
                for (int n = 0; n < 2; ++n)
#pragma unroll
                    for (int j = 0; j < 4; ++j) { const float g = acc[ai][0][m][n][j], up = acc[ai][1][m][n][j]; a[4 * n + j] = g * fast_rcp(1.0f + fast_exp(-g)) * up; }
                u32x4 w; w.x = pk2(a[0], a[1]); w.y = pk2(a[2], a[3]); w.z = pk2(a[4], a[5]); w.w = pk2(a[6], a[7]);
                *(u32x4*)rowp = w; }
    }
};
struct EpiZ {
    static constexpr bool PERM = true, AFTER_DRAIN = false;
    bf16* Z;
    __device__ __forceinline__ void operator()(const f32x4 (&acc)[2][2][4][2], const Unit& u, int wr, int wc, int fr, int fq) const {
        const int i = u.pn >> 2, pnl = u.pn & 3, pml = u.pm - i * (TH / 256);
        const int row0 = pml * 256 + wr * 64 + fr, col0 = i * D + pnl * 256 + wc * 32 + 8 * fq;
#pragma unroll
        for (int ai = 0; ai < 2; ++ai)
#pragma unroll
            for (int m = 0; m < 4; ++m) { bf16* rowp = Z + (size_t)(row0 + ai * HALFT + m * 16) * 4096 + col0;
#pragma unroll
                for (int bj = 0; bj < 2; ++bj) { const f32x4 v0 = acc[ai][bj][m][0], v1 = acc[ai][bj][m][1];
                    u32x4 w; w.x = pk2(v0[0], v0[1]); w.y = pk2(v0[2], v0[3]); w.z = pk2(v1[0], v1[1]); w.w = pk2(v1[2], v1[3]);
                    *(GAS u32x4*)(rowp + bj * HALFT) = w; } }
    }
};
struct BranchOrder {
    int nP, G, c;
    __device__ bool next(int i, Unit& u) const {
        const long L = (long)i * G + c; if (L >= (long)16 * nP) return false;
        const int br = (int)(L / (4 * nP)), r = (int)(L % (4 * nP)); u.pm = br * nP + (r >> 2); u.pn = br * 4 + (r & 3); return true;
    }
    __device__ __forceinline__ void a_ready(const Unit&) const {}
    __device__ __forceinline__ void done(const Unit&) const {}
};
struct EpiMerge {
    static constexpr bool PERM = false, AFTER_DRAIN = false;
    const bf16* Z; const float* gate_b; bf16* MG;
    __device__ __forceinline__ void operator()(const f32x4 (&acc)[2][2][4][2], const Unit& u, int wr, int wc, int fr, int fq) const {
        const int row0 = u.pm * 256 + wr * 64 + fr, col = u.pn * 64 + wc * 16 + 4 * fq;
        f32x4 gb[4];
#pragma unroll
        for (int i = 0; i < 4; ++i) gb[i] = *(const GAS f32x4*)(gate_b + i * D + col);
#pragma unroll
        for (int ai = 0; ai < 2; ++ai) {
            u32x2 zv[4][4];
#pragma unroll
            for (int m = 0; m < 4; ++m)
#pragma unroll
                for (int i = 0; i < 4; ++i) zv[m][i] = *(const GAS u32x2*)(Z + (size_t)(row0 + ai * HALFT + m * 16) * 4096 + i * D + col);
#pragma unroll
            for (int m = 0; m < 4; ++m) { const size_t row = (size_t)(row0 + ai * HALFT + m * 16);
                f32x4 s = (f32x4){0.f, 0.f, 0.f, 0.f};
#pragma unroll
                for (int bj = 0; bj < 2; ++bj)
#pragma unroll
                    for (int n = 0; n < 2; ++n) { const int i = 2 * bj + n; const unsigned z01 = zv[m][i].x, z23 = zv[m][i].y;
                        const f32x4 z = (f32x4){bf2f(z01 & 0xffffu), bf2f(z01 >> 16), bf2f(z23 & 0xffffu), bf2f(z23 >> 16)}; const f32x4 a = acc[ai][bj][m][n] + gb[i];
#pragma unroll
                        for (int j = 0; j < 4; ++j) s[j] += z[j] * fast_rcp(1.0f + fast_exp(-a[j])); }
                u32x2 w; w.x = pk2(s.x, s.y); w.y = pk2(s.z, s.w); *(GAS u32x2*)(MG + row * D + col) = w; }
        }
    }
};

constexpr size_t MiB = 1u << 20;
constexpr size_t al(size_t x) { return (x + 255) & ~(size_t)255; }
constexpr size_t WS_CTL = 0, CTL_BYTES = 1 * MiB;
constexpr size_t W_IN = 1 * MiB;
constexpr size_t W_GATE = W_IN + (size_t)PW * D * 2;
constexpr size_t W_UQ = W_GATE + (size_t)4096 * D * 2;
constexpr size_t W_UKV = W_UQ + (size_t)768 * 384 * 2;
constexpr size_t W_LORA = W_UKV + (size_t)1024 * 256 * 2;
constexpr size_t W_BR = W_LORA + (size_t)1536 * 384 * 2;
constexpr size_t W_OUT = W_BR + (size_t)4 * 1024 * 512 * 2;
constexpr size_t W_FGU = W_OUT + (size_t)D * D * 2;
constexpr size_t W_FDN = W_FGU + (size_t)NEXP * 2 * FF_E * D * 2;
constexpr size_t W_END = W_FDN + (size_t)NEXP * D * FF_E * 2;
constexpr size_t A_H = al(W_END);
constexpr size_t A_ROPE = A_H + (size_t)TH * D * 2;
constexpr size_t A_Y = A_ROPE + (size_t)TH * 64 * 4;
constexpr size_t A_P = A_Y + (size_t)4 * TH * 512 * 2;
constexpr size_t A_MIX = A_P + (size_t)TH * PW * 2;
constexpr size_t R_RKV = A_MIX;
constexpr size_t R_LOUT = R_RKV + (size_t)TH * 1536 * 2;
constexpr size_t R_O = R_LOUT + (size_t)TH * 1536 * 4;
constexpr size_t R_LIN = R_O + (size_t)TH * 512 * 4;
constexpr size_t R_REC = R_LIN + (size_t)TH * 384 * 2;
constexpr size_t R_END = R_REC + (size_t)BH * 8 * NCH * 61696;
constexpr size_t M_KR = al(R_END);
constexpr size_t M_Q = M_KR + (size_t)TH * 64 * 2;
constexpr size_t M_KV = M_Q + (size_t)TH * 768 * 2;
constexpr size_t M_VT = M_KV + (size_t)TH * 1024 * 2;
constexpr size_t M_END = M_VT + (size_t)TH * 512 * 2;
constexpr size_t G_CH = R_LIN;
constexpr size_t G_O = G_CH + al((size_t)BH * 4 * NCH * 78864);
constexpr size_t G_END = G_O + (size_t)TH * 512 * 4;
constexpr size_t S_ST = al(G_END);
constexpr size_t S_YD = S_ST + (size_t)BH * NCH * 8 * 64 * 128 * 2;
constexpr size_t S_C = S_YD + (size_t)TH * 512 * 4;
constexpr size_t S_AC = S_C + (size_t)BH * NCH * 2 * 17408;
constexpr size_t S_YO = S_AC + (size_t)TH * 8 * 4;
constexpr size_t S_END = S_YO + (size_t)TH * 512 * 4;
constexpr size_t A_Z = A_P;
constexpr size_t A_MG = A_MIX;
constexpr size_t F_ACT = A_P;
constexpr size_t F_GA = F_ACT + (size_t)MOE_ROWS * FF_E * 2;
constexpr size_t F_YE = F_GA + (size_t)MOE_ROWS * D * 2;
constexpr size_t F_TOPE = F_YE + (size_t)MOE_ROWS * D * 4;
constexpr size_t F_TOPW = F_TOPE + (size_t)TH * 2 * 4;
constexpr size_t F_SLOT = F_TOPW + (size_t)TH * 2 * 4;
constexpr size_t F_END = F_SLOT + (size_t)TH * 2 * 4;
constexpr size_t cmax(size_t a, size_t b) { return a > b ? a : b; }
constexpr size_t WS_NEED = cmax(cmax(cmax(M_END, R_END), cmax(G_END, S_END)), F_END);
#ifndef EMU
static_assert(WS_NEED <= (size_t)896 * MiB, "workspace");
#endif
constexpr int CW_BAR = 4096;
constexpr int CW_CNT = 16384;
constexpr int CW_WGC = 32768;

#ifdef EMU
#define WAVE_SYNC() emu_wave_sync()
#else
#define WAVE_SYNC() do { asm volatile("s_waitcnt lgkmcnt(0)" ::: "memory"); } while (0)
#endif
struct Frame {
    LAS unsigned char* lds; int tid, lane, wave, G, gw, NGW, bid;
    GAS float* out; GAS unsigned char* ws; GAS unsigned* ctl;
};
struct Args { const float* in[39]; float* out; unsigned char* ws; int lo, hi; };
#define WSP(type, off) ((type*)(F.ws + (off)))
#define AIN(A_, k) ((const float*)(const GAS float*)(A_).in[k])

template <class FN>
__device__ __forceinline__ void cvt_matrix(const Frame& F, const float* W, int ldw, int K, bf16* WT, int Ndst, const float* kscale, FN srccol) {
    LAS float* scr = (LAS float*)(F.lds + F.wave * 16384);
    const int nblk = Ndst / 32, nitems = (K / 64) * nblk, lane = F.lane;
    for (int item = F.gw; item < nitems; item += F.NGW) {
        const int kb = item / nblk, nb = item % nblk, k0 = 64 * kb, n0 = 32 * nb;
        const int sc = srccol(n0 + (lane & 31));
        float wv[32];
#pragma unroll
        for (int i = 0; i < 32; ++i) { const int kk = 2 * i + (lane >> 5); wv[i] = sc >= 0 ? W[(size_t)(k0 + kk) * ldw + sc] : 0.f; }
#pragma unroll
        for (int i = 0; i < 32; ++i) { const int kk = 2 * i + (lane >> 5); float v = wv[i]; if (kscale) v *= kscale[k0 + kk]; scr[kk * 33 + (lane & 31)] = v; }
        WAVE_SYNC();
        const int c = lane & 7;
#pragma unroll
        for (int j = 0; j < 4; ++j) { const int n = (lane >> 3) + 8 * j; const LAS float* s = scr + (8 * c) * 33 + n;
            u32x4 o; o.x = pk2(s[0 * 33], s[1 * 33]); o.y = pk2(s[2 * 33], s[3 * 33]); o.z = pk2(s[4 * 33], s[5 * 33]); o.w = pk2(s[6 * 33], s[7 * 33]);
            *(u32x4*)(WT + (size_t)(n0 + n) * K + k0 + 8 * c) = o; }
        WAVE_SYNC();
    }
}
__device__ __forceinline__ void phase_convert(const Frame& F, const Args& A, int layer) {
    const float* w_in = AIN(A, 3) + (size_t)layer * D * IN_COLS;
    cvt_matrix(F, w_in, IN_COLS, D, WSP(bf16, W_IN), PW, nullptr, [](int n) { return n < C_GATE ? n : -1; });
    cvt_matrix(F, w_in, IN_COLS, D, WSP(bf16, W_GATE), 4096, nullptr, [](int n) {
        const int pn = n >> 8, c = n & 255, bj = c >> 7, wc = (c >> 5) & 3, nn = (c >> 4) & 1, r = c & 15; return C_GATE + (2 * bj + nn) * D + 64 * pn + 16 * wc + r; });
    cvt_matrix(F, AIN(A, 6) + (size_t)layer * 384 * 768, 768, 384, WSP(bf16, W_UQ), 768, AIN(A, 4) + layer * 384, [](int n) { return n; });
    cvt_matrix(F, AIN(A, 7) + (size_t)layer * 256 * 1024, 1024, 256, WSP(bf16, W_UKV), 1024, AIN(A, 5) + layer * 256, [](int n) { return n; });
    for (int i = 0; i < 4; ++i) cvt_matrix(F, AIN(A, 30) + ((size_t)layer * 4 + i) * 512 * D, D, 512, WSP(bf16, W_BR) + (size_t)i * D * 512, D, nullptr, [](int n) { return n; });
    cvt_matrix(F, AIN(A, 31) + (size_t)layer * D * D, D, D, WSP(bf16, W_OUT), D, nullptr, [](int n) { return n; });
    if (layer == 0) {
        cvt_matrix(F, AIN(A, 33), 2 * FF_D, D, WSP(bf16, W_FGU), 2 * FF_D, nullptr, [](int n) { const int pn = n >> 8, c = n & 255; return c < 128 ? 128 * pn + c : FF_D + 128 * pn + (c - 128); });
        cvt_matrix(F, AIN(A, 34), D, FF_D, WSP(bf16, W_FDN), D, nullptr, [](int n) { return n; });
    } else {
        for (int e = 0; e < NEXP; ++e) {
            cvt_matrix(F, AIN(A, 36) + (size_t)e * D * 2 * FF_E, 2 * FF_E, D, WSP(bf16, W_FGU) + (size_t)e * 2 * FF_E * D, 2 * FF_E, nullptr, [](int n) { const int pn = n >> 8, c = n & 255; return c < 128 ? 128 * pn + c : FF_E + 128 * pn + (c - 128); });
            cvt_matrix(F, AIN(A, 37) + (size_t)e * FF_E * D, D, FF_E, WSP(bf16, W_FDN) + (size_t)e * D * FF_E, D, nullptr, [](int n) { return n; });
        }
    }
    { const float* w2 = AIN(A, 10) + (size_t)layer * 64 * 512; const float* a2 = AIN(A, 12) + (size_t)layer * 64 * 512; const float* g2 = AIN(A, 13) + (size_t)layer * 160 * 512;
      bf16* L = WSP(bf16, W_LORA);
      for (int idx = F.bid * 512 + F.tid; idx < 1536 * 384; idx += F.G * 512) { const int n = idx / 384, k = idx % 384; float v = 0.f;
          if (n < 512) { if (k < 64) v = w2[k * 512 + n]; } else if (n < 1024) { if (k >= 64 && k < 128) v = a2[(k - 64) * 512 + (n - 512)]; } else { if (k >= 128 && k < 288) v = g2[(k - 128) * 512 + (n - 1024)]; }
          L[idx] = (bf16)f2bf(v); } }
}

template <bool ROUTER>
__device__ __forceinline__ void phase_norm(const Frame& F, const Args& A, const float* xin, const float* gain, bf16* H, const float* router, int* tope, float* topw, unsigned* cnt) {
    const int lane = F.lane;
    LAS unsigned* lcnt = (LAS unsigned*)F.lds;
    if (ROUTER) { __syncthreads(); if (F.tid < 8) lcnt[F.tid] = 0u; __syncthreads(); }
    f32x4 gv[4];
#pragma unroll
    for (int j = 0; j < 4; ++j) gv[j] = *(const f32x4*)(gain + 4 * lane + 256 * j);
    for (int m = F.gw; m < TH; m += F.NGW) {
        const float* xr = xin + (size_t)m * D; f32x4 v[4]; float ss = 0.f;
#pragma unroll
        for (int j = 0; j < 4; ++j) { v[j] = *(const f32x4*)(xr + 4 * lane + 256 * j); ss += (v[j].x * v[j].x + v[j].y * v[j].y) + (v[j].z * v[j].z + v[j].w * v[j].w); }
        const float rstd = RSQRT(wave_sum(ss) * (1.0f / D) + EPS);
#pragma unroll
        for (int j = 0; j < 4; ++j) { v[j] = v[j] * rstd * gv[j]; st_bf16x4(H + (size_t)m * D + 4 * lane + 256 * j, v[j]); }
        if (ROUTER) {
            float lg[8];
#pragma unroll
            for (int e = 0; e < 8; ++e) lg[e] = 0.f;
#pragma unroll
            for (int j = 0; j < 4; ++j)
#pragma unroll
                for (int q = 0; q < 4; ++q) { const float* rp = router + (size_t)(4 * lane + 256 * j + q) * 8; const f32x4 r0 = *(const f32x4*)rp, r1 = *(const f32x4*)(rp + 4); const float hv = v[j][q];
                    lg[0] += hv * r0.x; lg[1] += hv * r0.y; lg[2] += hv * r0.z; lg[3] += hv * r0.w; lg[4] += hv * r1.x; lg[5] += hv * r1.y; lg[6] += hv * r1.z; lg[7] += hv * r1.w; }
#pragma unroll
            for (int e = 0; e < 8; ++e) lg[e] = wave_sum(lg[e]);
            if (lane == 0) {
                int e1 = 0; float l1 = lg[0];
#pragma unroll
                for (int e = 1; e < 8; ++e) if (lg[e] > l1) { l1 = lg[e]; e1 = e; }
                int e2 = -1; float l2 = -3.0e38f;
#pragma unroll
                for (int e = 0; e < 8; ++e) if (e != e1 && lg[e] > l2) { l2 = lg[e]; e2 = e; }
                const float w1 = 1.0f / (1.0f + expf(l2 - l1));
                tope[2 * m] = e1; tope[2 * m + 1] = e2; topw[2 * m] = w1; topw[2 * m + 1] = 1.0f - w1;
                ATOMIC_ADD_LDS(lcnt + e1, 1u); ATOMIC_ADD_LDS(lcnt + e2, 1u);
            }
        }
    }
    if (ROUTER) { __syncthreads(); if (F.tid < 8) cnt[F.bid * 8 + F.tid] = lcnt[F.tid]; __syncthreads(); }
}
__device__ __forceinline__ void phase_rope_table(const Frame& F, const Args& A, const int* pos, float* rope) {
    for (int idx = F.bid * 512 + F.tid; idx < TH * 32; idx += F.G * 512) { const int t = idx >> 5, i = idx & 31;
        const float inv = powf(10000.0f, -(float)i / 32.0f);
        const float ang = (float)pos[t] * inv; float sn, cs; sincosf(ang, &sn, &cs);
        rope[(size_t)t * 64 + i] = cs; rope[(size_t)t * 64 + 32 + i] = sn; }
}
__device__ __forceinline__ void phase_final_norm(const Frame& F, const Args& A, float* x, const float* gain) {
    const int lane = F.lane;
    for (int m = F.gw; m < T; m += F.NGW) {
        float* xr = x + (size_t)m * D; f32x4 v[4]; float ss = 0.f;
#pragma unroll
        for (int j = 0; j < 4; ++j) { v[j] = *(const f32x4*)(xr + 4 * lane + 256 * j); ss += (v[j].x * v[j].x + v[j].y * v[j].y) + (v[j].z * v[j].z + v[j].w * v[j].w); }
        const float rstd = RSQRT(wave_sum(ss) * (1.0f / D) + EPS);
#pragma unroll
        for (int j = 0; j < 4; ++j) *(f32x4*)(xr + 4 * lane + 256 * j) = v[j] * rstd * *(const f32x4*)(gain + 4 * lane + 256 * j);
    }
}

__device__ __forceinline__ void phase_mla_prep(const Frame& F, const Args& A) {
    bf16* P = WSP(bf16, A_P); bf16* kr = WSP(bf16, M_KR); const float* rope = WSP(float, A_ROPE);
    const int lane = F.lane;
    for (int m = F.gw; m < TH; m += F.NGW) {
        bf16* pr = P + (size_t)m * PW; float sq = 0.f, skv = 0.f; f32x4 v[3];
#pragma unroll
        for (int j = 0; j < 3; ++j) { const int c = 4 * lane + 256 * j; v[j] = ld_bf16x4(pr + c); const float s = (v[j].x * v[j].x + v[j].y * v[j].y) + (v[j].z * v[j].z + v[j].w * v[j].w);
            if (c < 384) sq += s; else if (c < 640) skv += s; }
        sq = wave_sum(sq); skv = wave_sum(skv);
        const float rq = RSQRT(sq * (1.0f / 384.0f) + EPS), rkv = RSQRT(skv * (1.0f / 256.0f) + EPS);
#pragma unroll
        for (int j = 0; j < 3; ++j) { const int c = 4 * lane + 256 * j; if (c < 640) st_bf16x4(pr + c, v[j] * (c < 384 ? rq : rkv)); }
        if (lane < 32) { const float x1 = bf2f(pr[640 + lane]), x2 = bf2f(pr[672 + lane]), c = rope[(size_t)m * 64 + lane], s = rope[(size_t)m * 64 + 32 + lane];
            kr[(size_t)m * 64 + lane] = (bf16)f2bf(x1 * c - x2 * s); kr[(size_t)m * 64 + 32 + lane] = (bf16)f2bf(x2 * c + x1 * s); }
    }
}
__device__ __forceinline__ void phase_mla_q(const Frame& F, const Args& A) {
    pg8::Gemm g{WSP(bf16, A_P) + 0, WSP(bf16, W_UQ), PW, 384}; pg8::StaticOrder S; S.init(TH, 768, F.G, F.bid);
    EpiBf16 E{WSP(bf16, M_Q), 768, nullptr, 0}; pg8::gemm_phase(F.lds, g, S, E, F.tid);
}
struct EpiKV {
    static constexpr bool PERM = true, AFTER_DRAIN = false;
    bf16* KV; bf16* VT;
    __device__ __forceinline__ void operator()(const f32x4 (&acc)[2][2][4][2], const Unit& u, int wr, int wc, int fr, int fq) const {
        const int row0 = u.pm * 256 + wr * 64 + fr, col0 = wc * 32 + 8 * fq;
#pragma unroll
        for (int ai = 0; ai < 2; ++ai)
#pragma unroll
            for (int m = 0; m < 4; ++m) { const int row = row0 + ai * HALFT + m * 16;
                { const f32x4 v0 = acc[ai][0][m][0], v1 = acc[ai][0][m][1]; u32x4 w; w.x = pk2(v0[0], v0[1]); w.y = pk2(v0[2], v0[3]); w.z = pk2(v1[0], v1[1]); w.w = pk2(v1[2], v1[3]);
                  *(u32x4*)(KV + (size_t)row * 1024 + u.pn * 256 + col0) = w; }
                const int b = row / SEQ, t = row % SEQ; bf16* vt = VT + ((size_t)(b * 4 + u.pn) * 128 + col0) * SEQ + t;
#pragma unroll
                for (int n = 0; n < 2; ++n)
#pragma unroll
                    for (int j = 0; j < 4; ++j) vt[(size_t)(4 * n + j) * SEQ] = (bf16)f2bf(acc[ai][1][m][n][j]); }
    }
};
__device__ __forceinline__ void phase_mla_kv(const Frame& F, const Args& A) {
    pg8::Gemm g{WSP(bf16, A_P) + 384, WSP(bf16, W_UKV), PW, 256}; pg8::StaticOrder S; S.init(TH, 1024, F.G, F.bid);
    EpiKV E{WSP(bf16, M_KV), WSP(bf16, M_VT)}; pg8::gemm_phase(F.lds, g, S, E, F.tid);
}
constexpr int AT_KS = 200, AT_VS = 72;
constexpr int AT_KBYTES = 64 * AT_KS * 2, AT_VBYTES = 128 * AT_VS * 2;
__device__ __forceinline__ void phase_attention(const Frame& F, const Args& A) {
    const bf16* Q = WSP(bf16, M_Q); const bf16* KV = WSP(bf16, M_KV); const bf16* KR = WSP(bf16, M_KR); const bf16* VTg = WSP(bf16, M_VT); const float* rope = WSP(float, A_ROPE); bf16* Y = WSP(bf16, A_Y);
    const int lane = F.lane, w = F.wave, l15 = lane & 15, q4 = lane >> 4, tid = F.tid, grp = w >> 2, wq = w & 3;
    const int NQB = SEQ / 128, nunits = BH * 4 * NQB;
    const float sc2 = 0.07216878364870322f * 1.4426950408889634f;
    for (int unit = F.bid; unit < nunits; unit += F.G) {
        const int qb = NQB - 1 - (unit / (BH * 4)), bh = unit % (BH * 4), h = bh & 3, b = bh >> 2;
        const size_t t0 = (size_t)b * SEQ;
        bf16x8 qf[2][6];
#pragma unroll
        for (int f = 0; f < 2; ++f) { const size_t tq = t0 + qb * 128 + wq * 32 + 16 * f + l15;
#pragma unroll
            for (int ks = 0; ks < 6; ++ks) qf[f][ks] = *(const bf16x8*)(Q + tq * 768 + h * 192 + 32 * ks + 8 * q4);
            const bf16x8 a = qf[f][4], c2 = qf[f][5];
#pragma unroll
            for (int j = 0; j < 8; ++j) { const float x1 = bf2f((unsigned short)a[j]), x2 = bf2f((unsigned short)c2[j]), c = rope[tq * 64 + 8 * q4 + j], sn = rope[tq * 64 + 32 + 8 * q4 + j];
                qf[f][4][j] = (short)f2bf(x1 * c - x2 * sn); qf[f][5][j] = (short)f2bf(x2 * c + x1 * sn); } }
        f32x4 o[2][8];
#pragma unroll
        for (int f = 0; f < 2; ++f)
#pragma unroll
            for (int mb = 0; mb < 8; ++mb) o[f][mb] = (f32x4){0.f, 0.f, 0.f, 0.f};
        float mrow[2] = {-3.0e38f, -3.0e38f}, lrow[2] = {0.f, 0.f};
        const int qchunk = 2 * qb + (wq >> 1), ntile = 2 * qb + 2;
        u32x4 pk_[3], pv_[2];
        const int skey = tid >> 3, c8 = tid & 7;
        const int okv = skey * 1024 + 8 * c8, okr = skey * 64 + 8 * c8, ovt = skey * SEQ + 8 * c8;
        const bf16* kvb = KV + t0 * 1024 + h * 256; const bf16* krb = KR + t0 * 64; const bf16* vtb = VTg + (size_t)(b * 4 + h) * 128 * SEQ;
#define AT_LOAD(kt) do { const bf16* kv_ = kvb + (size_t)(kt) * 65536; const bf16* kr_ = krb + (size_t)(kt) * 4096; const bf16* vt_ = vtb + (size_t)(kt) * 64; \
            pk_[0] = *(const u32x4*)(kv_ + okv); pk_[1] = *(const u32x4*)(kv_ + okv + 64); pk_[2] = *(const u32x4*)(kr_ + okr); \
            pv_[0] = *(const u32x4*)(vt_ + ovt); pv_[1] = *(const u32x4*)(vt_ + ovt + 64 * SEQ); } while (0)
#define AT_STORE(bufi) do { LAS bf16* Ks_ = (LAS bf16*)(F.lds + (bufi) * (AT_KBYTES + AT_VBYTES)); LAS bf16* Vt_ = (LAS bf16*)((LAS unsigned char*)Ks_ + AT_KBYTES); \
            *(LAS u32x4*)(Ks_ + skey * AT_KS + 8 * c8) = pk_[0]; *(LAS u32x4*)(Ks_ + skey * AT_KS + 8 * c8 + 64) = pk_[1]; *(LAS u32x4*)(Ks_ + skey * AT_KS + 8 * c8 + 128) = pk_[2]; \
            *(LAS u32x4*)(Vt_ + skey * AT_VS + 8 * c8) = pv_[0]; *(LAS u32x4*)(Vt_ + (skey + 64) * AT_VS + 8 * c8) = pv_[1]; } while (0)
        __syncthreads();
        AT_LOAD(0); AT_STORE(0);
        __syncthreads();
        for (int kt = 0; kt < ntile; ++kt) {
            if (kt + 1 < ntile) AT_LOAD(kt + 1);
            if (kt <= qchunk) {
                const LAS bf16* Ks = (const LAS bf16*)(F.lds + (kt & 1) * (AT_KBYTES + AT_VBYTES)); const LAS bf16* Vt = (const LAS bf16*)((const LAS unsigned char*)Ks + AT_KBYTES);
                f32x4 st[2][2];
#pragma unroll
                for (int kb = 0; kb < 2; ++kb) { st[0][kb] = (f32x4){0.f, 0.f, 0.f, 0.f}; st[1][kb] = (f32x4){0.f, 0.f, 0.f, 0.f};
#pragma unroll
                    for (int ks = 0; ks < 6; ++ks) { const bf16x8 kf = *(const LAS bf16x8*)(Ks + (32 * grp + 16 * kb + l15) * AT_KS + 32 * ks + 8 * q4);
                        st[0][kb] = MFMA_BF16(kf, qf[0][ks], st[0][kb]); st[1][kb] = MFMA_BF16(kf, qf[1][ks], st[1][kb]); } }
                bf16x8 pb[2];
#pragma unroll
                for (int f = 0; f < 2; ++f) {
                    float mx = -3.0e38f;
#pragma unroll
                    for (int kb = 0; kb < 2; ++kb) { st[f][kb] = st[f][kb] * sc2; mx = fmaxf(mx, fmaxf(fmaxf(st[f][kb].x, st[f][kb].y), fmaxf(st[f][kb].z, st[f][kb].w))); }
                    mx = rows_max(mx);
                    const float mnew = fmaxf(mrow[f], mx), alpha = exp2f(mrow[f] - mnew); mrow[f] = mnew;
                    float ps = 0.f;
#pragma unroll
                    for (int kb = 0; kb < 2; ++kb)
#pragma unroll
                        for (int r = 0; r < 4; ++r) { const float p = exp2f(st[f][kb][r] - mnew); ps += p; pb[f][4 * kb + r] = (short)f2bf(p); }
                    lrow[f] = lrow[f] * alpha + ps;
#pragma unroll
                    for (int mb = 0; mb < 8; ++mb) o[f][mb] = o[f][mb] * alpha;
                }
#pragma unroll
                for (int mb = 0; mb < 8; ++mb) { const LAS bf16* vp = Vt + (16 * mb + l15) * AT_VS + 32 * grp + 4 * q4;
                    const bf16x4 v0 = *(const LAS bf16x4*)vp, v1 = *(const LAS bf16x4*)(vp + 16);
                    bf16x8 vf; vf[0] = v0[0]; vf[1] = v0[1]; vf[2] = v0[2]; vf[3] = v0[3]; vf[4] = v1[0]; vf[5] = v1[1]; vf[6] = v1[2]; vf[7] = v1[3];
                    o[0][mb] = MFMA_BF16(vf, pb[0], o[0][mb]); o[1][mb] = MFMA_BF16(vf, pb[1], o[1][mb]); }
            }
            if (kt + 1 < ntile) AT_STORE((kt + 1) & 1);
            __syncthreads();
        }
#undef AT_LOAD
#undef AT_STORE
#pragma unroll
        for (int f = 0; f < 2; ++f) lrow[f] = rows_sum(lrow[f]);
        LAS float* xo = (LAS float*)F.lds + (size_t)wq * (2 * 8 * 4 * 64 + 4 * 64);
        if (grp == 1) {
#pragma unroll
            for (int f = 0; f < 2; ++f) {
#pragma unroll
                for (int mb = 0; mb < 8; ++mb)
#pragma unroll
                    for (int r = 0; r < 4; ++r) xo[((f * 8 + mb) * 4 + r) * 64 + lane] = o[f][mb][r];
                xo[2 * 8 * 4 * 64 + f * 64 + lane] = mrow[f]; xo[2 * 8 * 4 * 64 + 128 + f * 64 + lane] = lrow[f]; } }
        __syncthreads();
        if (grp == 0) {
#pragma unroll
            for (int f = 0; f < 2; ++f) { const float m1 = xo[2 * 8 * 4 * 64 + f * 64 + lane], l1 = xo[2 * 8 * 4 * 64 + 128 + f * 64 + lane];
                const float m = fmaxf(mrow[f], m1), a0 = exp2f(mrow[f] - m), a1 = exp2f(m1 - m), inv = 1.0f / (lrow[f] * a0 + l1 * a1);
                const size_t tq = t0 + qb * 128 + wq * 32 + 16 * f + l15;
#pragma unroll
                for (int mb = 0; mb < 8; ++mb) { f32x4 v;
#pragma unroll
                    for (int r = 0; r < 4; ++r) v[r] = (o[f][mb][r] * a0 + xo[((f * 8 + mb) * 4 + r) * 64 + lane] * a1) * inv;
                    st_bf16x4(Y + tq * 512 + h * 128 + 16 * mb + 4 * q4, v); } } }
    }
    __syncthreads();
}

__device__ __forceinline__ f32x4 tile_bf(const LAS bf16* a, int lda, const LAS bf16* bt, int ldb, int K, f32x4 acc, int l15, int q4) {
    const LAS bf16* ap = a + l15 * lda + 8 * q4; const LAS bf16* bp = bt + l15 * ldb + 8 * q4;
#pragma unroll 4
    for (int ks = 0; ks < K / 32; ++ks) acc = MFMA_BF16(*(const LAS bf16x8*)(ap + 32 * ks), *(const LAS bf16x8*)(bp + 32 * ks), acc);
    return acc;
}
__device__ __forceinline__ f32x4 tile_mm(const LAS float* a, int lda, int ska, const LAS float* b, int ldb, int scb, int K, f32x4 acc, int l15, int q4);


__device__ __forceinline__ void diag_solve16(const LAS float* Lblk  , int ldl, LAS float* xcol  , int ldx) {
    float x[16];
#pragma unroll
    for (int i = 0; i < 16; ++i) x[i] = xcol[i * ldx];
#pragma unroll
    for (int g = 0; g < 4; ++g) {
        f32x4 av[4][4];
#pragma unroll
        for (int ii = 0; ii < 4; ++ii)
#pragma unroll
            for (int c4 = 0; c4 <= g; ++c4) av[ii][c4] = *(const LAS f32x4*)(Lblk + (4 * g + ii) * ldl + 4 * c4);
#pragma unroll
        for (int ii = 0; ii < 4; ++ii) { const int i = 4 * g + ii; float sacc = x[i];
#pragma unroll
            for (int jj = 0; jj < i; ++jj) sacc -= av[ii][jj >> 2][jj & 3] * x[jj];
            x[i] = sacc; }
    }
#pragma unroll
    for (int i = 1; i < 16; ++i) xcol[i * ldx] = x[i];
}
__device__ __forceinline__ void tri_solve64(const LAS float* L, int ldl, LAS float* X, int ldx, int nct, LAS float* scr, int w, int l15, int q4) {
    LAS float* DI = scr;
    if (w < 4) { LAS float* T = DI + w * 320; LAS float* S = scr + 4 * 320 + w * 320; const LAS float* N = L + 16 * w * ldl + 16 * w;
#pragma unroll
        for (int r = 0; r < 4; ++r) { const int i = 4 * q4 + r; T[i * 20 + l15] = (i == l15 ? 1.0f : 0.0f) - (l15 < i ? N[i * ldl + l15] : 0.0f); }
        { const f32x4 a = tile_mm(N, ldl, 1, N, ldl, 1, 16, (f32x4){0.f, 0.f, 0.f, 0.f}, l15, q4);
#pragma unroll
          for (int r = 0; r < 4; ++r) S[(4 * q4 + r) * 20 + l15] = a[r]; }
        WAVE_SYNC();
#pragma unroll
        for (int it = 0; it < 3; ++it) {
            { const f32x4 a = tile_mm(T, 20, 1, S, 20, 1, 16, (f32x4){0.f, 0.f, 0.f, 0.f}, l15, q4);
#pragma unroll
              for (int r = 0; r < 4; ++r) T[(4 * q4 + r) * 20 + l15] += a[r]; }
            if (it < 2) { const f32x4 a = tile_mm(S, 20, 1, S, 20, 1, 16, (f32x4){0.f, 0.f, 0.f, 0.f}, l15, q4);
#pragma unroll
                for (int r = 0; r < 4; ++r) S[(4 * q4 + r) * 20 + l15] = a[r]; }
            WAVE_SYNC();
        } }
    __syncthreads();
    for (int ct = w; ct < nct; ct += 8) { LAS float* Xc = X + 16 * ct;
#pragma unroll
        for (int rb = 0; rb < 4; ++rb) {
            if (rb > 0) { const f32x4 a = tile_mm(L + 16 * rb * ldl, ldl, 1, Xc, ldx, 1, 16 * rb, (f32x4){0.f, 0.f, 0.f, 0.f}, l15, q4);
#pragma unroll
                for (int r = 0; r < 4; ++r) Xc[(16 * rb + 4 * q4 + r) * ldx + l15] -= a[r];
                WAVE_SYNC(); }
            const f32x4 y = tile_mm(DI + rb * 320, 20, 1, Xc + 16 * rb * ldx, ldx, 1, 16, (f32x4){0.f, 0.f, 0.f, 0.f}, l15, q4);
#pragma unroll
            for (int r = 0; r < 4; ++r) Xc[(16 * rb + 4 * q4 + r) * ldx + l15] = y[r];
            WAVE_SYNC();
        } }
}
__device__ __forceinline__ void phase_rwkv_prep(const Frame& F, const Args& A, int layer) {
    const bf16* P = WSP(bf16, A_P); bf16* RKV = WSP(bf16, R_RKV); bf16* LIN = WSP(bf16, R_LIN); const float* mu = AIN(A, 8) + (size_t)layer * 1824;
    const int lane = F.lane;
    for (int m = F.gw; m < TH; m += F.NGW) {
        const bool first = (m % SEQ) == 0; const bf16* pr = P + (size_t)m * PW + C_RWKV;
#pragma unroll
        for (int j = 0; j < 8; ++j) { const int c = 4 * lane + 256 * j;
            if (c < 1824) { const f32x4 p = ld_bf16x4(pr + c); const f32x4 pv = first ? (f32x4){0.f, 0.f, 0.f, 0.f} : ld_bf16x4(pr - PW + c); const f32x4 muv = *(const f32x4*)(mu + c);
                f32x4 x = p + (pv - p) * muv;
                if (c < 1536) st_bf16x4(RKV + (size_t)m * 1536 + c, x);
                else { if (c < 1600) { x.x = tanhf_(x.x); x.y = tanhf_(x.y); x.z = tanhf_(x.z); x.w = tanhf_(x.w); }
                       else if (c >= 1664) { x.x = sigmoidf_(x.x); x.y = sigmoidf_(x.y); x.z = sigmoidf_(x.z); x.w = sigmoidf_(x.w); }
                       st_bf16x4(LIN + (size_t)m * 384 + (c - 1536), x); } } }
        if (lane < 24) st_bf16x4(LIN + (size_t)m * 384 + 288 + 4 * lane, (f32x4){0.f, 0.f, 0.f, 0.f});
    }
}
__device__ __forceinline__ void phase_rwkv_lora(const Frame& F, const Args& A) {
    pg8::Gemm g{WSP(bf16, R_LIN), WSP(bf16, W_LORA), 384, 384}; pg8::StaticOrder S; S.init(TH, 1536, F.G, (F.bid + F.G / 2) % F.G);
    EpiF32 E{WSP(float, R_LOUT), 1536}; pg8::gemm_phase(F.lds, g, S, E, F.tid);
}
constexpr int RS = 72;
constexpr int RREC_COMMON = 4 * 64 * RS * 2 + 256;
constexpr int RREC_T = 64 * 64 * 2;
constexpr int RREC_BYTES = RREC_COMMON + 3 * RREC_T;
static_assert(RREC_BYTES == 61696, "record size (see R_REC in the workspace map)");
static_assert(RREC_COMMON % 16 == 0, "record alignment");
__device__ __forceinline__ void phase_rwkv_r1(const Frame& F, const Args& A, int layer) {
    const bf16* RKV = WSP(bf16, R_RKV); const float* LOUT = WSP(float, R_LOUT); unsigned char* REC = WSP(unsigned char, R_REC);
    const float* w0 = AIN(A, 9) + layer * 512; const float* a0 = AIN(A, 11) + layer * 512; const float* k_k = AIN(A, 14) + layer * 512; const float* k_a = AIN(A, 15) + layer * 512;
    LAS bf16* kbar = (LAS bf16*)F.lds; LAS bf16* atil = kbar + 64 * RS; LAS bf16* khat = atil + 64 * RS; LAS bf16* rbar = khat + 64 * RS;
    LAS bf16* atT = rbar + 64 * RS; LAS bf16* khT = atT + 64 * RS; LAS bf16* vT = khT + 64 * RS; LAS bf16* Bm = vT + 64 * RS; LAS bf16* Em = Bm + 64 * RS;
    LAS float* Am = (LAS float*)(Em + 64 * RS);
    LAS float* X = Am + 64 * 68;
    LAS float* lam = Am;
    const int w = F.wave;
    const int nunits = BH * 8 * NCH;
    for (int unit = F.bid; unit < nunits; unit += F.G) {
        int tid = F.tid; OPAQUE_V(tid); const int lane = tid & 63, l15 = lane & 15, q4 = lane >> 4;
        const int c = unit % NCH, h = (unit / NCH) & 7, b = unit / (NCH * 8);
        const size_t tok0 = (size_t)b * SEQ + (size_t)c * 64;
        const int j = lane, cj = h * 64 + j;
        __syncthreads();
        float r_[8], km_[8], kk_[8], ka_[8], v_[8], L_[8];
        { const float w0c = w0[cj], a0c = a0[cj], kkc = k_k[cj], kac = k_a[cj]; float run = 0.f;
#pragma unroll
          for (int q = 0; q < 8; ++q) { const int t = 8 * w + q; const size_t tok = tok0 + t;
              const float r = bf2f(RKV[tok * 1536 + cj]), k = bf2f(RKV[tok * 1536 + 512 + cj]); v_[q] = bf2f(RKV[tok * 1536 + 1024 + cj]);
              const float wpre = LOUT[tok * 1536 + cj], apre = LOUT[tok * 1536 + 512 + cj];
              const float wl = -softplusf_(-(w0c + wpre)) - 0.5f, a = sigmoidf_(a0c + apre);
              const float kr = k * kkc, ss = wave_sum(kr * kr), kk = kr * RSQRT(ss + EPS);
              r_[q] = r; km_[q] = k * (1.0f + (a - 1.0f) * kac); kk_[q] = kk; ka_[q] = kk * a;
              run += -expf(wl); L_[q] = run; }
          lam[w * 64 + j] = run; }
        __syncthreads();
        { float base = 0.f, Lend = 0.f;
#pragma unroll
          for (int ww = 0; ww < 8; ++ww) { const float tw = lam[ww * 64 + j]; if (ww < w) base += tw; Lend += tw; }
#pragma unroll
          for (int q = 0; q < 8; ++q) { const int t = 8 * w + q; const float L = base + L_[q], Lm1 = q ? base + L_[q - 1] : base;
              const float eG = expf(L), eGi = expf(-L), eGm1 = expf(Lm1), eT = expf(Lend - L);
              const float kb = kk_[q] * eGm1;
              kbar[t * RS + j] = (bf16)f2bf(kb); X[t * 132 + j] = kb;
              atil[t * RS + j] = (bf16)f2bf(ka_[q] * eGi); khat[t * RS + j] = (bf16)f2bf(km_[q] * eGi); rbar[t * RS + j] = (bf16)f2bf(r_[q] * eG);
              atT[j * RS + t] = (bf16)f2bf(-ka_[q] * eT); khT[j * RS + t] = (bf16)f2bf(km_[q] * eT); vT[j * RS + t] = (bf16)f2bf(v_[q]); }
          if (w == 0) { float* gc = (float*)(REC + (size_t)unit * RREC_BYTES + 4 * 64 * RS * 2); gc[j] = expf(Lend); } }
        __syncthreads();
        unsigned char* rec = REC + (size_t)unit * RREC_BYTES;
        { const int which = w >> 1, tib = 2 * (w & 1);
          const LAS bf16* Aop = (which & 2) ? rbar : kbar; const LAS bf16* Bop = (which & 1) ? khat : atil;
          bf16x8 aF[2][2], bF[4][2];
#pragma unroll
          for (int t = 0; t < 2; ++t)
#pragma unroll
              for (int ks = 0; ks < 2; ++ks) aF[t][ks] = *(const LAS bf16x8*)(Aop + (16 * (tib + t) + l15) * RS + 8 * q4 + 32 * ks);
#pragma unroll
          for (int tj = 0; tj < 4; ++tj)
#pragma unroll
              for (int ks = 0; ks < 2; ++ks) bF[tj][ks] = *(const LAS bf16x8*)(Bop + (16 * tj + l15) * RS + 8 * q4 + 32 * ks);
          f32x4 acc[2][4];
#pragma unroll
          for (int t = 0; t < 2; ++t)
#pragma unroll
              for (int tj = 0; tj < 4; ++tj) { acc[t][tj] = MFMA_BF16(aF[t][0], bF[tj][0], ((f32x4){0.f, 0.f, 0.f, 0.f})); acc[t][tj] = MFMA_BF16(aF[t][1], bF[tj][1], acc[t][tj]); }
#pragma unroll
          for (int t = 0; t < 2; ++t)
#pragma unroll
              for (int tj = 0; tj < 4; ++tj)
#pragma unroll
                  for (int r = 0; r < 4; ++r) { const int i = 16 * (tib + t) + 4 * q4 + r, jj = 16 * tj + l15; const bool keep = (which & 2) ? (jj <= i) : (jj < i); const float v = keep ? acc[t][tj][r] : 0.f;
                      if (which == 0) Am[i * 68 + jj] = v; else if (which == 1) Bm[i * RS + jj] = (bf16)f2bf(v); else if (which == 3) Em[i * RS + jj] = (bf16)f2bf(v);
                      else ((bf16*)(rec + 2 * 64 * RS * 2))[i * RS + jj] = (bf16)f2bf(-v); } }
        __syncthreads();
        { const int tj = w & 3, pb = 6 * (w >> 2);
          bf16x8 bF[2]; f32x4 acc[6];
#pragma unroll
          for (int ks = 0; ks < 2; ++ks) bF[ks] = *(const LAS bf16x8*)(vT + (16 * tj + l15) * RS + 8 * q4 + 32 * ks);
#pragma unroll
          for (int pq = 0; pq < 6; ++pq) { const int pair = pb + pq, which = pair >> 2, ti = pair & 3; const LAS bf16* aop = which == 0 ? Bm : which == 1 ? Em : khT;
              const bf16x8 a0 = *(const LAS bf16x8*)(aop + (16 * ti + l15) * RS + 8 * q4), a1 = *(const LAS bf16x8*)(aop + (16 * ti + l15) * RS + 8 * q4 + 32);
              acc[pq] = MFMA_BF16(a0, bF[0], ((f32x4){0.f, 0.f, 0.f, 0.f})); acc[pq] = MFMA_BF16(a1, bF[1], acc[pq]); }
#pragma unroll
          for (int pq = 0; pq < 6; ++pq) { const int pair = pb + pq, which = pair >> 2, ti = pair & 3;
              if (which == 0) {
#pragma unroll
                  for (int r = 0; r < 4; ++r) X[(16 * ti + 4 * q4 + r) * 132 + 64 + 16 * tj + l15] = acc[pq][r]; }
              else st_bf16x4((bf16*)(rec + RREC_COMMON + which * RREC_T) + (16 * tj + l15) * 64 + 16 * ti + 4 * q4, acc[pq]); } }
        __syncthreads();
        tri_solve64(Am, 68, X, 132, 8, X + 64 * 132, w, l15, q4);
        __syncthreads();
        { const int t = tid >> 3, j0 = 8 * (tid & 7); float v[8];
#pragma unroll
          for (int q = 0; q < 8; ++q) v[q] = X[t * 132 + j0 + q];
          *(u32x4*)((bf16*)rec + t * RS + j0) = pack8(v);
          const int vv = tid >> 3, t0 = 8 * (tid & 7);
#pragma unroll
          for (int q = 0; q < 8; ++q) v[q] = X[(t0 + q) * 132 + 64 + vv];
          *(u32x4*)((bf16*)(rec + RREC_COMMON) + vv * 64 + t0) = pack8(v); }
        for (int e = tid; e < 64 * RS / 8; e += 512) { ((u32x4*)(rec + 64 * RS * 2))[e] = ((const LAS u32x4*)rbar)[e]; ((u32x4*)(rec + 3 * 64 * RS * 2))[e] = ((const LAS u32x4*)atT)[e]; }
    }
    __syncthreads();
}
constexpr int R2_BUF = RREC_COMMON;
__device__ __forceinline__ void phase_rwkv_r2(const Frame& F, const Args& A) {
    const unsigned char* REC = WSP(unsigned char, R_REC); float* RO = WSP(float, R_O);
    LAS unsigned char* buf0 = F.lds; LAS bf16* HT = (LAS bf16*)(F.lds + 2 * R2_BUF); LAS bf16* UT = HT + 2 * 64 * RS;
    const int tid = F.tid, lane = F.lane, w = F.wave, l15 = lane & 15, q4 = lane >> 4, ti = w >> 1;
    const int nunits = BH * 8;
    constexpr int NCHK = R2_BUF / 16;
    for (int unit = F.bid; unit < nunits; unit += F.G) {
        const int h = unit & 7, b = unit >> 3;
        __syncthreads();
        for (int e = tid; e < 2 * 64 * RS / 2; e += 512) ((LAS unsigned*)HT)[e] = 0u;
        f32x4 Hreg[2] = {(f32x4){0.f, 0.f, 0.f, 0.f}, (f32x4){0.f, 0.f, 0.f, 0.f}};
        u32x4 preA[5], preB[5]; u32x2 iniA[3][2], iniB[3][2], cur[3][2];
        const unsigned char* rec0 = REC + (size_t)((b * 8 + h) * NCH) * RREC_BYTES;
        const int tofs = ((16 * (2 * (w & 1)) + l15) * 64 + 16 * ti + 4 * q4) * 2;
#define R2_LOAD(S, recp) do { _Pragma("unroll") for (int q = 0; q < 5; ++q) { const int e = tid + 512 * q; if (e < NCHK) pre##S[q] = *(const u32x4*)((recp) + (size_t)e * 16); } \
            _Pragma("unroll") for (int mq = 0; mq < 3; ++mq) { ini##S[mq][0] = *(const u32x2*)((recp) + RREC_COMMON + mq * RREC_T + tofs); ini##S[mq][1] = *(const u32x2*)((recp) + RREC_COMMON + mq * RREC_T + tofs + 16 * 64 * 2); } } while (0)
#define R2_STORE(S, dst) do { _Pragma("unroll") for (int q = 0; q < 5; ++q) { const int e = tid + 512 * q; if (e < NCHK) *(LAS u32x4*)((dst) + (size_t)e * 16) = pre##S[q]; } } while (0)
#define R2_TAKE(S) do { _Pragma("unroll") for (int mq = 0; mq < 3; ++mq) { cur[mq][0] = ini##S[mq][0]; cur[mq][1] = ini##S[mq][1]; } } while (0)
        R2_LOAD(A, rec0); R2_STORE(A, buf0); R2_TAKE(A);
        if (NCH > 1) R2_LOAD(A, rec0 + (size_t)RREC_BYTES);
        __syncthreads();
#define R2_STEP(c, LS, SS) do { \
            LAS unsigned char* buf = buf0 + ((c) & 1) * R2_BUF; LAS unsigned char* nbuf = buf0 + (((c) + 1) & 1) * R2_BUF; \
            if ((c) + 2 < NCH) R2_LOAD(LS, rec0 + (size_t)((c) + 2) * RREC_BYTES); \
            const LAS bf16* KB = (const LAS bf16*)buf; const LAS bf16* RB = KB + 64 * RS; const LAS bf16* FMn = RB + 64 * RS; const LAS bf16* ATn = FMn + 64 * RS; \
            const LAS float* GC = (const LAS float*)(buf + 4 * 64 * RS * 2); \
            const LAS bf16* H0 = HT + ((c) & 1) * 64 * RS; LAS bf16* H1 = HT + (((c) + 1) & 1) * 64 * RS; \
              \
            bf16x8 hf[2][2], uf[2][2], af[2]; \
            _Pragma("unroll") for (int t2 = 0; t2 < 2; ++t2) _Pragma("unroll") for (int ks = 0; ks < 2; ++ks) hf[t2][ks] = *(const LAS bf16x8*)(H0 + (16 * (2 * (w & 1) + t2) + l15) * RS + 8 * q4 + 32 * ks); \
            _Pragma("unroll") for (int ks = 0; ks < 2; ++ks) af[ks] = *(const LAS bf16x8*)(KB + (16 * ti + l15) * RS + 8 * q4 + 32 * ks); \
            _Pragma("unroll") for (int t2 = 0; t2 < 2; ++t2) { const int tj = 2 * (w & 1) + t2; \
                f32x4 u = (f32x4){bf2f(cur[0][t2].x & 0xffffu), bf2f(cur[0][t2].x >> 16), bf2f(cur[0][t2].y & 0xffffu), bf2f(cur[0][t2].y >> 16)}; \
                u = MFMA_BF16(af[0], hf[t2][0], u); u = MFMA_BF16(af[1], hf[t2][1], u); \
                u32x2 pk; pk.x = pk2(u[0], u[1]); pk.y = pk2(u[2], u[3]); *(LAS u32x2*)(UT + (16 * tj + l15) * RS + 16 * ti + 4 * q4) = pk; } \
            __syncthreads(); \
            _Pragma("unroll") for (int t2 = 0; t2 < 2; ++t2) _Pragma("unroll") for (int ks = 0; ks < 2; ++ks) uf[t2][ks] = *(const LAS bf16x8*)(UT + (16 * (2 * (w & 1) + t2) + l15) * RS + 8 * q4 + 32 * ks); \
            { bf16x8 rf[2], ff[2], tf[2]; \
              _Pragma("unroll") for (int ks = 0; ks < 2; ++ks) { rf[ks] = *(const LAS bf16x8*)(RB + (16 * ti + l15) * RS + 8 * q4 + 32 * ks); ff[ks] = *(const LAS bf16x8*)(FMn + (16 * ti + l15) * RS + 8 * q4 + 32 * ks); tf[ks] = *(const LAS bf16x8*)(ATn + (16 * ti + l15) * RS + 8 * q4 + 32 * ks); } \
              _Pragma("unroll") for (int t2 = 0; t2 < 2; ++t2) { const int tj = 2 * (w & 1) + t2; \
                f32x4 o = (f32x4){bf2f(cur[1][t2].x & 0xffffu), bf2f(cur[1][t2].x >> 16), bf2f(cur[1][t2].y & 0xffffu), bf2f(cur[1][t2].y >> 16)}; \
                o = MFMA_BF16(rf[0], hf[t2][0], o); o = MFMA_BF16(rf[1], hf[t2][1], o); o = MFMA_BF16(ff[0], uf[t2][0], o); o = MFMA_BF16(ff[1], uf[t2][1], o); \
                _Pragma("unroll") for (int r = 0; r < 4; ++r) RO[((size_t)b * SEQ + (size_t)(c) * 64 + 16 * ti + 4 * q4 + r) * 512 + h * 64 + 16 * tj + l15] = o[r]; \
                const f32x4 kv = (f32x4){bf2f(cur[2][t2].x & 0xffffu), bf2f(cur[2][t2].x >> 16), bf2f(cur[2][t2].y & 0xffffu), bf2f(cur[2][t2].y >> 16)}; \
                _Pragma("unroll") for (int r = 0; r < 4; ++r) Hreg[t2][r] = Hreg[t2][r] * GC[16 * ti + 4 * q4 + r] + kv[r]; \
                Hreg[t2] = MFMA_BF16(tf[0], uf[t2][0], Hreg[t2]); Hreg[t2] = MFMA_BF16(tf[1], uf[t2][1], Hreg[t2]); \
                u32x2 pk; pk.x = pk2(Hreg[t2][0], Hreg[t2][1]); pk.y = pk2(Hreg[t2][2], Hreg[t2][3]); *(LAS u32x2*)(H1 + (16 * tj + l15) * RS + 16 * ti + 4 * q4) = pk; } } \
            if ((c) + 1 < NCH) { R2_STORE(SS, nbuf); R2_TAKE(SS); } \
            __syncthreads(); } while (0)
        for (int c = 0; c < NCH; c += 2) { R2_STEP(c, B, A); R2_STEP(c + 1, A, B); }
#undef R2_STEP
#undef R2_STORE
#undef R2_TAKE
#undef R2_LOAD
    }
    __syncthreads();
}
__device__ __forceinline__ void phase_rwkv_post(const Frame& F, const Args& A, int layer) {
    const bf16* RKV = WSP(bf16, R_RKV); const float* LOUT = WSP(float, R_LOUT); const float* RO = WSP(float, R_O); bf16* Y = WSP(bf16, A_Y) + (size_t)1 * TH * 512;
    const float* a0 = AIN(A, 11) + layer * 512; const float* k_a = AIN(A, 15) + layer * 512; const float* r_k = AIN(A, 16) + layer * 512; const float* ln_w = AIN(A, 17) + layer * 512; const float* ln_b = AIN(A, 18) + layer * 512;
    const int lane = F.lane, c0 = 8 * lane;
    for (int m = F.gw; m < TH; m += F.NGW) {
        float o[8], r[8], k[8], v[8], ap[8], g[8];
        { const f32x4 a = *(const f32x4*)(RO + (size_t)m * 512 + c0), b2 = *(const f32x4*)(RO + (size_t)m * 512 + c0 + 4); o[0] = a.x; o[1] = a.y; o[2] = a.z; o[3] = a.w; o[4] = b2.x; o[5] = b2.y; o[6] = b2.z; o[7] = b2.w; }
#pragma unroll
        for (int hh = 0; hh < 2; ++hh) { const f32x4 rv = ld_bf16x4(RKV + (size_t)m * 1536 + c0 + 4 * hh), kv = ld_bf16x4(RKV + (size_t)m * 1536 + 512 + c0 + 4 * hh), vv = ld_bf16x4(RKV + (size_t)m * 1536 + 1024 + c0 + 4 * hh);
            const f32x4 av = *(const f32x4*)(LOUT + (size_t)m * 1536 + 512 + c0 + 4 * hh), gv = *(const f32x4*)(LOUT + (size_t)m * 1536 + 1024 + c0 + 4 * hh);
#pragma unroll
            for (int q = 0; q < 4; ++q) { r[4 * hh + q] = rv[q]; k[4 * hh + q] = kv[q]; v[4 * hh + q] = vv[q]; ap[4 * hh + q] = av[q]; g[4 * hh + q] = gv[q]; } }
        float bon = 0.f, sm = 0.f;
#pragma unroll
        for (int q = 0; q < 8; ++q) { const float a = sigmoidf_(a0[c0 + q] + ap[q]); const float km = k[q] * (1.0f + (a - 1.0f) * k_a[c0 + q]); bon += r[q] * km * r_k[c0 + q]; sm += o[q]; }
        bon += __shfl_xor(bon, 1); bon += __shfl_xor(bon, 2); bon += __shfl_xor(bon, 4);
        sm += __shfl_xor(sm, 1); sm += __shfl_xor(sm, 2); sm += __shfl_xor(sm, 4);
        const float mean = sm * (1.0f / 64.0f); float vs = 0.f;
#pragma unroll
        for (int q = 0; q < 8; ++q) { const float d = o[q] - mean; vs += d * d; }
        vs += __shfl_xor(vs, 1); vs += __shfl_xor(vs, 2); vs += __shfl_xor(vs, 4);
        const float rstd = RSQRT(vs * (1.0f / 64.0f) + 64e-5f);
        float y[8];
#pragma unroll
        for (int q = 0; q < 8; ++q) y[q] = ((o[q] - mean) * rstd * ln_w[c0 + q] + ln_b[c0 + q] + bon * v[q]) * g[q];
        u32x4 wv; wv.x = pk2(y[0], y[1]); wv.y = pk2(y[2], y[3]); wv.z = pk2(y[4], y[5]); wv.w = pk2(y[6], y[7]);
        *(u32x4*)(Y + (size_t)m * 512 + c0) = wv;
    }
}

__device__ __forceinline__ void conv8x8(const bf16* src, int tl0  , const float* w  , int wld, const float* bias, float (&out)[8][8]) {
    float x[11][8];
#pragma unroll
    for (int i = 0; i < 11; ++i) { const int tl = tl0 - 3 + i;
        if (tl >= 0) { const u32x4 v = *(const u32x4*)(src + (ptrdiff_t)(i - 3) * PW);
            x[i][0] = bf2f(v.x & 0xffffu); x[i][1] = bf2f(v.x >> 16); x[i][2] = bf2f(v.y & 0xffffu); x[i][3] = bf2f(v.y >> 16); x[i][4] = bf2f(v.z & 0xffffu); x[i][5] = bf2f(v.z >> 16); x[i][6] = bf2f(v.w & 0xffffu); x[i][7] = bf2f(v.w >> 16); }
        else {
#pragma unroll
            for (int ch = 0; ch < 8; ++ch) x[i][ch] = 0.f; } }
    float wv[4][8], bv[8];
#pragma unroll
    for (int j = 0; j < 4; ++j) { const f32x4 a = *(const f32x4*)(w + j * wld), b = *(const f32x4*)(w + j * wld + 4); wv[j][0] = a.x; wv[j][1] = a.y; wv[j][2] = a.z; wv[j][3] = a.w; wv[j][4] = b.x; wv[j][5] = b.y; wv[j][6] = b.z; wv[j][7] = b.w; }
    if (bias) { const f32x4 a = *(const f32x4*)bias, b = *(const f32x4*)(bias + 4); bv[0] = a.x; bv[1] = a.y; bv[2] = a.z; bv[3] = a.w; bv[4] = b.x; bv[5] = b.y; bv[6] = b.z; bv[7] = b.w; }
    else {
#pragma unroll
        for (int ch = 0; ch < 8; ++ch) bv[ch] = 0.f; }
#pragma unroll
    for (int i = 0; i < 8; ++i)
#pragma unroll
        for (int ch = 0; ch < 8; ++ch) { const float a = bv[ch] + wv[0][ch] * x[i][ch] + wv[1][ch] * x[i + 1][ch] + wv[2][ch] * x[i + 2][ch] + wv[3][ch] * x[i + 3][ch]; out[i][ch] = a * fast_rcp(1.0f + fast_exp(-a)); }
}
constexpr int SB = 136;
constexpr int SC_IMG = 64 * SB * 2;
__device__ __forceinline__ void phase_ssd_s1(const Frame& F, const Args& A, int layer) {
    const bf16* P = WSP(bf16, A_P); bf16* ST = WSP(bf16, S_ST); float* YD = WSP(float, S_YD); unsigned char* SCB = WSP(unsigned char, S_C); float* AC = WSP(float, S_AC);
    const float* cw = AIN(A, 23) + (size_t)layer * 4 * 1024; const float* cb = AIN(A, 24) + layer * 1024; const float* dtb = AIN(A, 25) + layer * 8; const float* a_log = AIN(A, 26) + layer * 8; const float* dsk = AIN(A, 27) + layer * 8;
    LAS bf16* Bt_ = (LAS bf16*)F.lds; LAS bf16* Ct_ = Bt_ + 64 * SB; LAS bf16* BT = Ct_ + 64 * SB; LAS bf16* xT = BT + 128 * RS;
    LAS bf16* Mb = xT + 4 * 64 * RS; LAS bf16* xdT = Mb + 2 * 64 * RS; LAS float* dt = (LAS float*)(xdT + 2 * 64 * RS); LAS float* ac = dt + 256;
    const int tid = F.tid, lane = F.lane, w = F.wave, l15 = lane & 15, q4 = lane >> 4;
    const int nunits = BH * NCH * 2;
    for (int unit = F.bid; unit < nunits; unit += F.G) {
        const int g = unit & 1, c = (unit >> 1) % NCH, b = unit / (2 * NCH);
        const size_t tok0 = (size_t)b * SEQ + (size_t)c * 64;
        __syncthreads();
        {
            const int cg = tid & 63, rb = tid >> 6;
            const int cidx = cg < 32 ? g * 256 + 8 * cg : cg < 48 ? 512 + g * 128 + 8 * (cg - 32) : 768 + g * 128 + 8 * (cg - 48);
            float o[8][8];
            conv8x8(P + (tok0 + 8 * rb) * PW + C_SSD + 512 + cidx, c * 64 + 8 * rb, cw + cidx, 1024, cb + cidx, o);
            if (cg < 32) {
                const int hh = cg >> 3, p0 = 8 * (cg & 7);
#pragma unroll
                for (int ch = 0; ch < 8; ++ch) { float col[8];
#pragma unroll
                    for (int i = 0; i < 8; ++i) col[i] = o[i][ch];
                    *(LAS u32x4*)(xT + (hh * 64 + p0 + ch) * RS + 8 * rb) = pack8(col); }
            } else if (cg < 48) {
                const int n0 = 8 * (cg - 32);
#pragma unroll
                for (int i = 0; i < 8; ++i) *(LAS u32x4*)(Bt_ + (8 * rb + i) * SB + n0) = pack8(o[i]);
#pragma unroll
                for (int ch = 0; ch < 8; ++ch) { float col[8];
#pragma unroll
                    for (int i = 0; i < 8; ++i) col[i] = o[i][ch];
                    *(LAS u32x4*)(BT + (n0 + ch) * RS + 8 * rb) = pack8(col); }
            } else { const int n0 = 8 * (cg - 48);
#pragma unroll
                for (int i = 0; i < 8; ++i) *(LAS u32x4*)(Ct_ + (8 * rb + i) * SB + n0) = pack8(o[i]); }
        }
        if (tid < 256) { const int hh = tid >> 6, h = 4 * g + hh; const float d = softplusf_(bf2f(P[(tok0 + lane) * PW + C_SSD + 1536 + h]) + dtb[h]); float a = -expf(a_log[h]) * d;
#pragma unroll
            for (int o = 1; o < 64; o <<= 1) { const float t = __shfl_up(a, o); if (lane >= o) a += t; }
            dt[tid] = d; ac[tid] = a; AC[(tok0 + lane) * 8 + h] = a; }
        __syncthreads();
        { unsigned char* dst = SCB + (size_t)unit * SC_IMG; for (int e = tid; e < SC_IMG / 16; e += 512) ((u32x4*)dst)[e] = ((const LAS u32x4*)Ct_)[e]; }
        f32x4 cbt[2];
#pragma unroll
        for (int tt = 0; tt < 2; ++tt) { const int tile = w * 2 + tt, ti = tile >> 2, tj = tile & 3; cbt[tt] = (f32x4){0.f, 0.f, 0.f, 0.f};
            if (tj <= ti) cbt[tt] = tile_bf(Ct_ + 16 * ti * SB, SB, Bt_ + 16 * tj * SB, SB, 128, cbt[tt], l15, q4); }
        for (int hh = 0; hh < 4; ++hh) { const int h = 4 * g + hh; LAS bf16* M = Mb + (hh & 1) * 64 * RS; LAS bf16* xd = xdT + (hh & 1) * 64 * RS; const LAS float* dth = dt + hh * 64; const LAS float* ach = ac + hh * 64;
#pragma unroll
            for (int tt = 0; tt < 2; ++tt) { const int tile = w * 2 + tt, ti = tile >> 2, tj = tile & 3;
#pragma unroll
                for (int r = 0; r < 4; ++r) { const int l = 16 * ti + 4 * q4 + r, s = 16 * tj + l15; M[l * RS + s] = (bf16)f2bf((s <= l) ? cbt[tt][r] * expf(ach[l] - ach[s]) * dth[s] : 0.f); } }
            { const int p = tid >> 3, l0 = 8 * (tid & 7); const u32x4 v = *(const LAS u32x4*)(xT + (hh * 64 + p) * RS + l0); const float a63 = ach[63]; float xv[8] = {bf2f(v.x & 0xffffu), bf2f(v.x >> 16), bf2f(v.y & 0xffffu), bf2f(v.y >> 16), bf2f(v.z & 0xffffu), bf2f(v.z >> 16), bf2f(v.w & 0xffffu), bf2f(v.w >> 16)};
#pragma unroll
              for (int i = 0; i < 8; ++i) xv[i] *= dth[l0 + i] * expf(a63 - ach[l0 + i]);
              *(LAS u32x4*)(xd + p * RS + l0) = pack8(xv); }
            __syncthreads();
#pragma unroll
            for (int tt = 0; tt < 2; ++tt) { const int tile = w * 2 + tt, ti = tile >> 2, tj = tile & 3;
                const f32x4 acc = tile_bf(M + 16 * ti * RS, RS, xT + (hh * 64 + 16 * tj) * RS, RS, 64, (f32x4){0.f, 0.f, 0.f, 0.f}, l15, q4);
                const f32x4 xs = ld_bf16x4((const bf16*)(xT + (hh * 64 + 16 * tj + l15) * RS + 16 * ti + 4 * q4));
#pragma unroll
                for (int r = 0; r < 4; ++r) YD[(tok0 + 16 * ti + 4 * q4 + r) * 512 + h * 64 + 16 * tj + l15] = acc[r] + dsk[h] * xs[r]; }
            bf16* st = ST + ((size_t)((b * NCH + c) * 8 + h)) * 64 * 128;
#pragma unroll
            for (int tt = 0; tt < 4; ++tt) { const int tile = w * 4 + tt, ti = tile >> 2, tj = tile & 3;
                const f32x4 acc = tile_bf(BT + 16 * ti * RS, RS, xd + 16 * tj * RS, RS, 64, (f32x4){0.f, 0.f, 0.f, 0.f}, l15, q4);
                st_bf16x4(st + (16 * tj + l15) * 128 + 16 * ti + 4 * q4, acc); }
        }
    }
    __syncthreads();
}
__device__ __forceinline__ void phase_ssd_s23(const Frame& F, const Args& A) {
    const bf16* ST = WSP(bf16, S_ST); float* YO = WSP(float, S_YO); const unsigned char* SCB = WSP(unsigned char, S_C); const float* AC = WSP(float, S_AC);
    LAS bf16* Cimg = (LAS bf16*)F.lds; LAS bf16* Hb = Cimg + 2 * 64 * SB;
    const int tid = F.tid, lane = F.lane, w = F.wave, l15 = lane & 15, q4 = lane >> 4;
    const int nunits = BH * 8 * 4, hp = tid >> 5, hn = 4 * (tid & 31);
    constexpr int NCK = SC_IMG / 16;
    for (int unit = F.bid; unit < nunits; unit += F.G) {
        const int ps = unit & 3, h = (unit >> 2) & 7, b = unit >> 5, g = h >> 2;
        __syncthreads();
        f32x4 Hr = (f32x4){0.f, 0.f, 0.f, 0.f};
        u32x4 preA[3], preB[3]; u32x2 pstA, pstB, stc; float eaA[5], eaB[5], eac[5];
        const size_t tokb = (size_t)b * SEQ;
#define S23_LOAD(S, cc) do { const unsigned char* src_ = SCB + (size_t)((b * NCH + (cc)) * 2 + g) * SC_IMG; \
            _Pragma("unroll") for (int q = 0; q < 3; ++q) { const int e = tid + 512 * q; if (e < NCK) pre##S[q] = *(const u32x4*)(src_ + (size_t)e * 16); } \
            pst##S = *(const u32x2*)(ST + ((size_t)((b * NCH + (cc)) * 8 + h)) * 8192 + (16 * ps + hp) * 128 + hn); \
            _Pragma("unroll") for (int r = 0; r < 4; ++r) ea##S[r] = AC[(tokb + (size_t)(cc) * 64 + 16 * (w & 3) + 4 * q4 + r) * 8 + h]; \
            ea##S[4] = AC[(tokb + (size_t)(cc) * 64 + 63) * 8 + h]; } while (0)
#define S23_STORE(S, dst) do { _Pragma("unroll") for (int q = 0; q < 3; ++q) { const int e = tid + 512 * q; if (e < NCK) ((LAS u32x4*)(dst))[e] = pre##S[q]; } } while (0)
#define S23_TAKE(S) do { stc = pst##S; _Pragma("unroll") for (int r = 0; r < 5; ++r) eac[r] = ea##S[r]; } while (0)
        S23_LOAD(A, 0); S23_STORE(A, Cimg); S23_TAKE(A);
        if (NCH > 1) S23_LOAD(A, 1);
#define S23_STEP(c, LS, SS) do { \
            const size_t tok0 = tokb + (size_t)(c) * 64; \
            if ((c) + 2 < NCH) S23_LOAD(LS, (c) + 2); \
            st_bf16x4((bf16*)(Hb + hp * SB + hn), Hr); \
            __syncthreads(); \
            if (w < 4) { const LAS bf16* Ci = Cimg + ((c) & 1) * 64 * SB; \
                const f32x4 acc = tile_bf(Ci + 16 * w * SB, SB, Hb, SB, 128, (f32x4){0.f, 0.f, 0.f, 0.f}, l15, q4); \
                _Pragma("unroll") for (int r = 0; r < 4; ++r) { const size_t tok = tok0 + 16 * w + 4 * q4 + r; YO[tok * 512 + h * 64 + 16 * ps + l15] = acc[r] * expf(eac[r]); } } \
            { const float dec = expf(eac[4]); Hr.x = dec * Hr.x + bf2f(stc.x & 0xffffu); Hr.y = dec * Hr.y + bf2f(stc.x >> 16); Hr.z = dec * Hr.z + bf2f(stc.y & 0xffffu); Hr.w = dec * Hr.w + bf2f(stc.y >> 16); } \
            if ((c) + 1 < NCH) { S23_STORE(SS, Cimg + (((c) + 1) & 1) * 64 * SB); S23_TAKE(SS); } \
            __syncthreads(); } while (0)
        for (int c = 0; c < NCH; c += 2) { S23_STEP(c, B, A); S23_STEP(c + 1, A, B); }
#undef S23_STEP
#undef S23_TAKE
#undef S23_STORE
#undef S23_LOAD
    }
    __syncthreads();
}
__device__ __forceinline__ void phase_ssd_s4(const Frame& F, const Args& A, int layer) {
    const float* YD = WSP(float, S_YD); const float* YO = WSP(float, S_YO); const bf16* P = WSP(bf16, A_P); bf16* Y = WSP(bf16, A_Y) + (size_t)3 * TH * 512; const float* nw = AIN(A, 28) + layer * 512;
    const int lane = F.lane, c0 = 8 * lane;
    for (int m = F.gw; m < TH; m += F.NGW) {
        const f32x4 a = *(const f32x4*)(YD + (size_t)m * 512 + c0) + *(const f32x4*)(YO + (size_t)m * 512 + c0), b2 = *(const f32x4*)(YD + (size_t)m * 512 + c0 + 4) + *(const f32x4*)(YO + (size_t)m * 512 + c0 + 4);
        const f32x4 z0 = ld_bf16x4(P + (size_t)m * PW + C_SSD + c0), z1 = ld_bf16x4(P + (size_t)m * PW + C_SSD + c0 + 4);
        float y[8] = {a.x * siluf_(z0.x), a.y * siluf_(z0.y), a.z * siluf_(z0.z), a.w * siluf_(z0.w), b2.x * siluf_(z1.x), b2.y * siluf_(z1.y), b2.z * siluf_(z1.z), b2.w * siluf_(z1.w)};
        float ss = 0.f;
#pragma unroll
        for (int q = 0; q < 8; ++q) ss += y[q] * y[q];
        ss += __shfl_xor(ss, 1); ss += __shfl_xor(ss, 2); ss += __shfl_xor(ss, 4); ss += __shfl_xor(ss, 8); ss += __shfl_xor(ss, 16);
        const float rstd = RSQRT(ss * (1.0f / 256.0f) + EPS);
#pragma unroll
        for (int q = 0; q < 8; ++q) y[q] = y[q] * rstd * nw[c0 + q];
        u32x4 wv; wv.x = pk2(y[0], y[1]); wv.y = pk2(y[2], y[3]); wv.z = pk2(y[4], y[5]); wv.w = pk2(y[6], y[7]);
        *(u32x4*)(Y + (size_t)m * 512 + c0) = wv;
    }
}

__device__ __forceinline__ f32x4 tile_mm(const LAS float* a, int lda, int ska, const LAS float* b, int ldb, int scb, int K, f32x4 acc, int l15, int q4) {
    const LAS float* ap = a + l15 * lda + q4 * ska; const LAS float* bp = b + q4 * ldb + l15 * scb;
#pragma unroll 8
    for (int ks = 0; ks < K / 4; ++ks) acc = MFMA_F32(ap[ks * 4 * ska], bp[ks * 4 * ldb], acc);
    return acc;
}
constexpr int GS = 132, GS2 = 68;
constexpr int GR_W = 0, GR_QH = 64 * 136 * 2, GR_KT = 2 * 64 * 136 * 2, GR_QK = GR_KT + 128 * 72 * 2, GR_GL = GR_QK + 64 * 72 * 2, GR_COMMON = GR_GL + 16, GR_UT = 128 * 64 * 2, GR_BYTES = GR_COMMON + GR_UT;
static_assert(GR_BYTES == 78864 && GR_COMMON % 16 == 0, "GDN record");
constexpr int GX = 264;
__device__ __forceinline__ void phase_gdn_g1(const Frame& F, const Args& A, int layer) {
    const bf16* P = WSP(bf16, A_P); unsigned char* CHR = WSP(unsigned char, G_CH);
    const float* convw = AIN(A, 19) + (size_t)layer * 4 * 1536; const float* a_log = AIN(A, 20) + layer * 4; const float* dtb = AIN(A, 21) + layer * 4;
    LAS bf16* qb = (LAS bf16*)F.lds; LAS bf16* kb = qb + 64 * SB; LAS bf16* qkimg = kb + 64 * SB;
    LAS float* X = (LAS float*)(qkimg + 64 * RS); LAS float* Lm = X + 64 * GX; LAS float* ssq = Lm + 64 * GS2;
    LAS float* beta = ssq + 2 * 64 * 16; LAS float* gc = beta + 64; LAS float* egc = gc + 64; LAS float* inorm = egc + 64;
    const int w = F.wave;
    const int nunits = BH * 4 * NCH;
    for (int unit = F.bid; unit < nunits; unit += F.G) {
        int tid = F.tid; OPAQUE_V(tid); const int lane = tid & 63, l15 = lane & 15, q4 = lane >> 4;
        const int c = unit % NCH, h = (unit / NCH) & 3, b = unit / (NCH * 4);
        const size_t tok0 = (size_t)b * SEQ + (size_t)c * 64;
        unsigned char* rec = CHR + (size_t)unit * GR_BYTES;
        __syncthreads();
        const int rb = tid / 48, pc = tid % 48, part = pc >> 4, cgl = pc & 15;
        float o[8][8];
        if (tid < 384) { const int col = part * 512 + h * 128 + 8 * cgl;
            conv8x8(P + (tok0 + 8 * rb) * PW + C_GDN + col, c * 64 + 8 * rb, convw + col, 1536, nullptr, o);
            if (part < 2) {
#pragma unroll
                for (int i = 0; i < 8; ++i) { float sacc = 0.f;
#pragma unroll
                    for (int ch = 0; ch < 8; ++ch) sacc += o[i][ch] * o[i][ch];
                    ssq[(part * 64 + 8 * rb + i) * 16 + cgl] = sacc; } } }
        if (w == 7) { const size_t tok = tok0 + lane; beta[lane] = sigmoidf_(bf2f(P[tok * PW + C_GDN + 1536 + h]));
            float g = -expf(a_log[h]) * softplusf_(bf2f(P[tok * PW + C_GDN + 1540 + h]) + dtb[h]);
#pragma unroll
            for (int o2 = 1; o2 < 64; o2 <<= 1) { const float t = __shfl_up(g, o2); if (lane >= o2) g += t; }
            gc[lane] = g; egc[lane] = expf(g); }
        __syncthreads();
        if (tid < 128) { float sacc = 0.f;
#pragma unroll
            for (int i = 0; i < 16; ++i) sacc += ssq[tid * 16 + i];
            inorm[tid] = (tid < 64 ? 0.08838834764831845f : 1.0f) * RSQRT(sacc + EPS); }
        __syncthreads();
        if (tid < 384) {
#pragma unroll
            for (int i = 0; i < 8; ++i) { const int l = 8 * rb + i;
                if (part < 2) { const float sc = inorm[part * 64 + l]; float v[8];
#pragma unroll
                    for (int ch = 0; ch < 8; ++ch) v[ch] = o[i][ch] * sc;
                    *(LAS u32x4*)((part ? kb : qb) + l * SB + 8 * cgl) = pack8(v); }
                else { const float bl = beta[l]; *(LAS f32x4*)(X + l * GX + 8 * cgl) = (f32x4){o[i][0] * bl, o[i][1] * bl, o[i][2] * bl, o[i][3] * bl}; *(LAS f32x4*)(X + l * GX + 8 * cgl + 4) = (f32x4){o[i][4] * bl, o[i][5] * bl, o[i][6] * bl, o[i][7] * bl}; } } }
        __syncthreads();
        { const int which = w >> 2, ti = w & 3; const LAS bf16* Aop = which ? qb : kb;
          bf16x8 aF[4]; f32x4 acc[4];
#pragma unroll
          for (int ks = 0; ks < 4; ++ks) aF[ks] = *(const LAS bf16x8*)(Aop + (16 * ti + l15) * SB + 8 * q4 + 32 * ks);
#pragma unroll
          for (int tj = 0; tj < 4; ++tj) { acc[tj] = (f32x4){0.f, 0.f, 0.f, 0.f};
#pragma unroll
              for (int ks = 0; ks < 4; ++ks) acc[tj] = MFMA_BF16(aF[ks], *(const LAS bf16x8*)(kb + (16 * tj + l15) * SB + 8 * q4 + 32 * ks), acc[tj]); }
#pragma unroll
          for (int tj = 0; tj < 4; ++tj)
#pragma unroll
              for (int r = 0; r < 4; ++r) { const int i = 16 * ti + 4 * q4 + r, j = 16 * tj + l15; float v = 0.f;
                  if (which ? (j <= i) : (j < i)) v = acc[tj][r] * expf(gc[i] - gc[j]) * (which ? 1.0f : beta[i]);
                  if (which) qkimg[i * RS + j] = (bf16)f2bf(v); else Lm[i * GS2 + j] = v; } }
        { const float glast = gc[63];
          for (int e = tid; e < 64 * 16; e += 512) { const int l = e >> 4, d0 = 8 * (e & 15); const u32x4 kv = *(const LAS u32x4*)(kb + l * SB + d0), qv = *(const LAS u32x4*)(qb + l * SB + d0);
              const float kf[8] = {bf2f(kv.x & 0xffffu), bf2f(kv.x >> 16), bf2f(kv.y & 0xffffu), bf2f(kv.y >> 16), bf2f(kv.z & 0xffffu), bf2f(kv.z >> 16), bf2f(kv.w & 0xffffu), bf2f(kv.w >> 16)};
              float qf[8] = {bf2f(qv.x & 0xffffu), bf2f(qv.x >> 16), bf2f(qv.y & 0xffffu), bf2f(qv.y >> 16), bf2f(qv.z & 0xffffu), bf2f(qv.z >> 16), bf2f(qv.w & 0xffffu), bf2f(qv.w >> 16)};
              const float sc = beta[l] * egc[l], eg = egc[l];
              *(LAS f32x4*)(X + l * GX + 128 + d0) = (f32x4){kf[0] * sc, kf[1] * sc, kf[2] * sc, kf[3] * sc}; *(LAS f32x4*)(X + l * GX + 132 + d0) = (f32x4){kf[4] * sc, kf[5] * sc, kf[6] * sc, kf[7] * sc};
#pragma unroll
              for (int q = 0; q < 8; ++q) qf[q] *= eg;
              *(u32x4*)(rec + GR_QH + (size_t)(l * SB + d0) * 2) = pack8(qf); }
          for (int e = tid; e < 128 * 8; e += 512) { const int d = e >> 3, l0 = 8 * (e & 7); float kt[8];
#pragma unroll
              for (int q = 0; q < 8; ++q) kt[q] = bf2f(kb[(l0 + q) * SB + d]) * expf(glast - gc[l0 + q]);
              *(u32x4*)(rec + GR_KT + (size_t)(d * RS + l0) * 2) = pack8(kt); }
          if (tid == 0) *(float*)(rec + GR_GL) = expf(glast); }
        __syncthreads();
        for (int e = tid; e < 64 * RS / 8; e += 512) ((u32x4*)(rec + GR_QK))[e] = ((const LAS u32x4*)qkimg)[e];
        tri_solve64(Lm, GS2, X, GX, 16, ssq, w, l15, q4);
        __syncthreads();
        for (int e = tid; e < 64 * 16; e += 512) { const int l = e >> 4, d0 = 8 * (e & 15); const f32x4 a = *(const LAS f32x4*)(X + l * GX + 128 + d0), b2 = *(const LAS f32x4*)(X + l * GX + 132 + d0);
            const float v[8] = {a.x, a.y, a.z, a.w, b2.x, b2.y, b2.z, b2.w}; *(u32x4*)(rec + GR_W + (size_t)(l * SB + d0) * 2) = pack8(v); }
        for (int e = tid; e < 128 * 8; e += 512) { const int vv = e >> 3, t0 = 8 * (e & 7); float v[8];
#pragma unroll
            for (int q = 0; q < 8; ++q) v[q] = X[(t0 + q) * GX + vv];
            *(u32x4*)((bf16*)(rec + GR_COMMON) + vv * 64 + t0) = pack8(v); }
    }
    __syncthreads();
}
constexpr int G2_STAGE = GR_COMMON;
__device__ __forceinline__ void phase_gdn_g2(const Frame& F, const Args& A) {
    const unsigned char* CHR = WSP(unsigned char, G_CH); float* GO = WSP(float, G_O);
    LAS unsigned char* buf0 = F.lds; LAS bf16* STt = (LAS bf16*)(F.lds + 2 * G2_STAGE); LAS bf16* vnT = STt + 2 * 32 * SB;
    const int tid = F.tid, lane = F.lane, w = F.wave, l15 = lane & 15, q4 = lane >> 4, ti = w >> 1, tj = w & 1;
    const int nunits = BH * 4 * 4;
    constexpr int NCK = G2_STAGE / 16;
    for (int unit = F.bid; unit < nunits; unit += F.G) {
        const int vs = unit & 3, h = (unit >> 2) & 3, b = unit >> 4;
        __syncthreads();
        for (int e = tid; e < 2 * 32 * SB / 2; e += 512) ((LAS unsigned*)STt)[e] = 0u;
        f32x4 Sreg[2] = {(f32x4){0.f, 0.f, 0.f, 0.f}, (f32x4){0.f, 0.f, 0.f, 0.f}};
        u32x4 preA[8], preB[8]; u32x2 uiniA, uiniB, ucur;
        const unsigned char* rec0 = CHR + (size_t)((b * 4 + h) * NCH) * GR_BYTES;
        const int uofs = GR_COMMON + ((32 * vs + 16 * tj + l15) * 64 + 16 * ti + 4 * q4) * 2;
#define G2_LOAD(S, recp) do { _Pragma("unroll") for (int q = 0; q < 8; ++q) { const int e = tid + 512 * q; if (e < NCK) pre##S[q] = *(const u32x4*)((recp) + (size_t)e * 16); } uini##S = *(const u32x2*)((recp) + uofs); } while (0)
#define G2_STORE(S, dst) do { _Pragma("unroll") for (int q = 0; q < 8; ++q) { const int e = tid + 512 * q; if (e < NCK) *(LAS u32x4*)((dst) + (size_t)e * 16) = pre##S[q]; } } while (0)
        G2_LOAD(A, rec0); G2_STORE(A, buf0); ucur = uiniA;
        if (NCH > 1) G2_LOAD(A, rec0 + (size_t)GR_BYTES);
        __syncthreads();
#define G2_STEP(c, LS, SS) do { \
            LAS unsigned char* buf = buf0 + ((c) & 1) * G2_STAGE; LAS unsigned char* nbuf = buf0 + (((c) + 1) & 1) * G2_STAGE; \
            if ((c) + 2 < NCH) G2_LOAD(LS, rec0 + (size_t)((c) + 2) * GR_BYTES); \
            const LAS bf16* Wi = (const LAS bf16*)(buf + GR_W); const LAS bf16* QH = (const LAS bf16*)(buf + GR_QH); const LAS bf16* KT = (const LAS bf16*)(buf + GR_KT); const LAS bf16* QK = (const LAS bf16*)(buf + GR_QK); \
            const float egl = *(const LAS float*)(buf + GR_GL); \
            const LAS bf16* S0 = STt + ((c) & 1) * 32 * SB; LAS bf16* S1 = STt + (((c) + 1) & 1) * 32 * SB; \
            { const f32x4 acc = tile_bf(Wi + 16 * ti * SB, SB, S0 + 16 * tj * SB, SB, 128, (f32x4){0.f, 0.f, 0.f, 0.f}, l15, q4); \
              const f32x4 vn = (f32x4){bf2f(ucur.x & 0xffffu), bf2f(ucur.x >> 16), bf2f(ucur.y & 0xffffu), bf2f(ucur.y >> 16)} - acc; \
              u32x2 pk; pk.x = pk2(vn[0], vn[1]); pk.y = pk2(vn[2], vn[3]); *(LAS u32x2*)(vnT + (16 * tj + l15) * RS + 16 * ti + 4 * q4) = pk; } \
            __syncthreads(); \
            { f32x4 acc = tile_bf(QH + 16 * ti * SB, SB, S0 + 16 * tj * SB, SB, 128, (f32x4){0.f, 0.f, 0.f, 0.f}, l15, q4); \
              acc = tile_bf(QK + 16 * ti * RS, RS, vnT + 16 * tj * RS, RS, 64, acc, l15, q4); \
              _Pragma("unroll") for (int r = 0; r < 4; ++r) GO[((size_t)b * SEQ + (size_t)(c) * 64 + 16 * ti + 4 * q4 + r) * 512 + h * 128 + 32 * vs + 16 * tj + l15] = acc[r]; } \
            _Pragma("unroll") for (int t2 = 0; t2 < 2; ++t2) { Sreg[t2] = Sreg[t2] * egl; \
                Sreg[t2] = tile_bf(KT + 16 * w * RS, RS, vnT + 16 * t2 * RS, RS, 64, Sreg[t2], l15, q4); \
                u32x2 pk; pk.x = pk2(Sreg[t2][0], Sreg[t2][1]); pk.y = pk2(Sreg[t2][2], Sreg[t2][3]); *(LAS u32x2*)(S1 + (16 * t2 + l15) * SB + 16 * w + 4 * q4) = pk; } \
            if ((c) + 1 < NCH) { G2_STORE(SS, nbuf); ucur = uini##SS; } \
            __syncthreads(); } while (0)
        for (int c = 0; c < NCH; c += 2) { G2_STEP(c, B, A); G2_STEP(c + 1, A, B); }
#undef G2_STEP
#undef G2_STORE
#undef G2_LOAD
    }
    __syncthreads();
}
__device__ __forceinline__ void phase_gdn_g3(const Frame& F, const Args& A, int layer) {
    const float* GO = WSP(float, G_O); const bf16* P = WSP(bf16, A_P); bf16* Y = WSP(bf16, A_Y) + (size_t)2 * TH * 512; const float* nw = AIN(A, 22) + layer * 128;
    const int lane = F.lane, c0 = 8 * lane;
    for (int m = F.gw; m < TH; m += F.NGW) {
        const f32x4 a = *(const f32x4*)(GO + (size_t)m * 512 + c0), b2 = *(const f32x4*)(GO + (size_t)m * 512 + c0 + 4);
        float o[8] = {a.x, a.y, a.z, a.w, b2.x, b2.y, b2.z, b2.w}; float ss = 0.f;
#pragma unroll
        for (int q = 0; q < 8; ++q) ss += o[q] * o[q];
        ss += __shfl_xor(ss, 1); ss += __shfl_xor(ss, 2); ss += __shfl_xor(ss, 4); ss += __shfl_xor(ss, 8);
        const float rstd = RSQRT(ss * (1.0f / 128.0f) + EPS);
        const f32x4 z0 = ld_bf16x4(P + (size_t)m * PW + C_GDN + 1544 + c0), z1 = ld_bf16x4(P + (size_t)m * PW + C_GDN + 1544 + c0 + 4);
        const float z[8] = {z0.x, z0.y, z0.z, z0.w, z1.x, z1.y, z1.z, z1.w}; float y[8];
#pragma unroll
        for (int q = 0; q < 8; ++q) y[q] = o[q] * rstd * nw[(c0 + q) & 127] * siluf_(z[q]);
        u32x4 wv; wv.x = pk2(y[0], y[1]); wv.y = pk2(y[2], y[3]); wv.z = pk2(y[4], y[5]); wv.w = pk2(y[6], y[7]);
        *(u32x4*)(Y + (size_t)m * 512 + c0) = wv;
    }
}

__device__ __forceinline__ void phase_merge_z(const Frame& F, const Args& A) {
    pg8::Gemm g{WSP(bf16, A_Y), WSP(bf16, W_BR), 512, 512}; BranchOrder S; S.nP = TH / 256; S.G = F.G; S.c = F.bid;
    EpiZ E{WSP(bf16, A_Z)}; pg8::gemm_phase(F.lds, g, S, E, F.tid);
}
__device__ __forceinline__ void phase_merge_gate(const Frame& F, const Args& A, int layer) {
    pg8::Gemm g{WSP(bf16, A_H), WSP(bf16, W_GATE), D, D}; pg8::StaticOrder S; S.init(TH, 4096, F.G, F.bid);
    EpiMerge E{WSP(bf16, A_Z), AIN(A, 29) + (size_t)layer * 4 * D, WSP(bf16, A_MG)}; pg8::gemm_phase(F.lds, g, S, E, F.tid);
}
__device__ __forceinline__ void phase_merge_out(const Frame& F, const Args& A, const float* xin, float* xout) {
    pg8::Gemm g{WSP(bf16, A_MG), WSP(bf16, W_OUT), D, D}; pg8::StaticOrder S; S.init(TH, D, F.G, F.bid);
    EpiResidual E{xin, xout}; pg8::gemm_phase(F.lds, g, S, E, F.tid);
}
__device__ __forceinline__ void phase_ffn_gu(const Frame& F, const Args& A) {
    pg8::Gemm g{WSP(bf16, A_H), WSP(bf16, W_FGU), D, D}; pg8::StaticOrder S; S.init(TH, 2 * FF_D, F.G, F.bid);
    EpiSwiGLU E{WSP(bf16, F_ACT), FF_D, 1 << 20}; pg8::gemm_phase(F.lds, g, S, E, F.tid);
}
__device__ __forceinline__ void phase_ffn_down(const Frame& F, const Args& A, float* x) {
    pg8::Gemm g{WSP(bf16, F_ACT), WSP(bf16, W_FDN), FF_D, FF_D}; pg8::StaticOrder S; S.init(TH, D, F.G, F.bid);
    EpiResidual E{x, x}; pg8::gemm_phase(F.lds, g, S, E, F.tid);
}
struct MoeLayout { int pstart[NEXP + 1]; };
__device__ __forceinline__ MoeLayout moe_layout(const unsigned* cnt) {
    MoeLayout L; int s = 0;
#pragma unroll
    for (int e = 0; e < NEXP; ++e) { L.pstart[e] = s; s += ((int)cnt[e] + 255) & ~255; }
    L.pstart[NEXP] = s; return L;
}
struct MoeOrder {
    int np, nN, G, c; MoeLayout L;
    __device__ bool next(int i, Unit& u) const {
        const long Lx = (long)i * G + c; if (Lx >= (long)np * nN) return false;
        const int pm = (int)(Lx / nN), pn = (int)(Lx % nN); int e = 0;
#pragma unroll
        for (int k = 1; k < NEXP; ++k) if (pm * 256 >= L.pstart[k]) e = k;
        u.pm = pm; u.pn = e * nN + pn; return true;
    }
    __device__ __forceinline__ void a_ready(const Unit&) const {}
    __device__ __forceinline__ void done(const Unit&) const {}
};
__device__ __forceinline__ void phase_moe_route(const Frame& F, const Args& A, int half) {
    const unsigned* wgc = (const unsigned*)(F.ctl + CW_WGC + half * 8192); unsigned* cnt = (unsigned*)(F.ctl + CW_CNT + half * 16);
    LAS unsigned* tab = (LAS unsigned*)F.lds; LAS unsigned* tot = tab + 8192; LAS unsigned* bef = tot + 8; LAS unsigned* cur = bef + 8;
    __syncthreads();
    for (int e = F.tid; e < F.G * 8; e += 512) tab[e] = wgc[e];
    __syncthreads();
    if (F.tid < 8) { unsigned t = 0, bsum = 0; for (int g = 0; g < F.G; ++g) { const unsigned v = tab[g * 8 + F.tid]; if (g < F.bid) bsum += v; t += v; } tot[F.tid] = t; bef[F.tid] = bsum; cur[F.tid] = 0u; if (F.bid == 0) cnt[F.tid] = t; }
    __syncthreads();
    unsigned totr[8];
#pragma unroll
    for (int e = 0; e < 8; ++e) totr[e] = tot[e];
    const MoeLayout L = moe_layout(totr);
    const bf16* H = WSP(bf16, A_H); bf16* GA = WSP(bf16, F_GA); const int* tope = WSP(int, F_TOPE); int* slot = WSP(int, F_SLOT);
    const int lane = F.lane;
    for (int m = F.gw; m < TH; m += F.NGW) {
        const u32x4 v0 = *(const u32x4*)(H + (size_t)m * D + 8 * lane), v1 = *(const u32x4*)(H + (size_t)m * D + 512 + 8 * lane);
#pragma unroll
        for (int k = 0; k < 2; ++k) { const int e = tope[2 * m + k]; int s = 0;
            int ps = 0;
#pragma unroll
            for (int q = 0; q < NEXP; ++q) ps = (e == q) ? L.pstart[q] : ps;
            if (lane == 0) s = ps + (int)bef[e] + (int)ATOMIC_ADD_LDS(cur + e, 1u);
            s = __shfl(s, 0);
            if (lane == 0) slot[2 * m + k] = s;
            *(u32x4*)(GA + (size_t)s * D + 8 * lane) = v0; *(u32x4*)(GA + (size_t)s * D + 512 + 8 * lane) = v1; }
    }
#pragma unroll
    for (int e = 0; e < NEXP; ++e) { const int r0 = L.pstart[e] + (int)totr[e], r1 = L.pstart[e + 1];
        for (int r = r0 + F.gw; r < r1; r += F.NGW) { *(u32x4*)(GA + (size_t)r * D + 8 * lane) = (u32x4){0u, 0u, 0u, 0u}; *(u32x4*)(GA + (size_t)r * D + 512 + 8 * lane) = (u32x4){0u, 0u, 0u, 0u}; } }
    __syncthreads();
}
__device__ __forceinline__ void phase_moe_gu(const Frame& F, const Args& A, int half) {
    MoeOrder S; S.L = moe_layout((const unsigned*)(F.ctl + CW_CNT + half * 16)); S.np = S.L.pstart[NEXP] / 256; S.nN = 2 * FF_E / 256; S.G = F.G; S.c = F.bid;
    pg8::Gemm g{WSP(bf16, F_GA), WSP(bf16, W_FGU), D, D}; EpiSwiGLU E{WSP(bf16, F_ACT), FF_E, 2 * FF_E / 256}; pg8::gemm_phase(F.lds, g, S, E, F.tid);
}
struct EpiF32Mod {
    static constexpr bool PERM = false, AFTER_DRAIN = false;
    float* C;
    __device__ __forceinline__ void operator()(const f32x4 (&acc)[2][2][4][2], const Unit& u, int wr, int wc, int fr, int fq) const {
        const int row0 = u.pm * 256 + wr * 64 + fr, col0 = (u.pn & 3) * 256 + wc * 32 + 4 * fq;
#pragma unroll
        for (int ai = 0; ai < 2; ++ai)
#pragma unroll
            for (int m = 0; m < 4; ++m) { float* rowp = C + (size_t)(row0 + ai * HALFT + m * 16) * D + col0;
#pragma unroll
                for (int bj = 0; bj < 2; ++bj)
#pragma unroll
                    for (int n = 0; n < 2; ++n) *(f32x4*)(rowp + bj * HALFT + n * 16) = acc[ai][bj][m][n]; }
    }
};
__device__ __forceinline__ void phase_moe_down(const Frame& F, const Args& A, int half) {
    MoeOrder S; S.L = moe_layout((const unsigned*)(F.ctl + CW_CNT + half * 16)); S.np = S.L.pstart[NEXP] / 256; S.nN = D / 256; S.G = F.G; S.c = F.bid;
    pg8::Gemm g{WSP(bf16, F_ACT), WSP(bf16, W_FDN), FF_E, FF_E}; EpiF32Mod E{WSP(float, F_YE)}; pg8::gemm_phase(F.lds, g, S, E, F.tid);
}
__device__ __forceinline__ void phase_moe_combine(const Frame& F, const Args& A, float* x, const float* fgain) {
    const float* YE = WSP(float, F_YE); const int* slot = WSP(int, F_SLOT); const float* topw = WSP(float, F_TOPW); const int lane = F.lane;
    for (int m = F.gw; m < TH; m += F.NGW) { const int s0 = slot[2 * m], s1 = slot[2 * m + 1]; const float w0 = topw[2 * m], w1 = topw[2 * m + 1];
        f32x4 v[4]; float ss = 0.f;
#pragma unroll
        for (int j = 0; j < 4; ++j) { const int c = 4 * lane + 256 * j;
            v[j] = *(const f32x4*)(x + (size_t)m * D + c) + *(const f32x4*)(YE + (size_t)s0 * D + c) * w0 + *(const f32x4*)(YE + (size_t)s1 * D + c) * w1;
            ss += (v[j].x * v[j].x + v[j].y * v[j].y) + (v[j].z * v[j].z + v[j].w * v[j].w); }
        if (fgain) { const float rstd = RSQRT(wave_sum(ss) * (1.0f / D) + EPS);
#pragma unroll
            for (int j = 0; j < 4; ++j) v[j] = v[j] * rstd * *(const f32x4*)(fgain + 4 * lane + 256 * j); }
#pragma unroll
        for (int j = 0; j < 4; ++j) *(f32x4*)(x + (size_t)m * D + 4 * lane + 256 * j) = v[j]; }
}

#ifndef EMU
#define XB_TMO      128
#define XB_XCNT(j)  (256  + 64 * (j))
#define XB_XSUB(j)  (1280 + 64 * (j))
#define XB_XGEN(j)  (2304 + 64 * (j))
#define XB_TOP      3328
#define XB_TOPGEN   3392
#define XCD_BAR_WORDS 3456
#define XB_SPIN_CAP (1u << 22)
__device__ __forceinline__ unsigned xb_ld(unsigned* p)              { return __hip_atomic_load(p, __ATOMIC_RELAXED, __HIP_MEMORY_SCOPE_AGENT); }
__device__ __forceinline__ unsigned xb_add(unsigned* p, unsigned v) { return __hip_atomic_fetch_add(p, v, __ATOMIC_RELAXED, __HIP_MEMORY_SCOPE_AGENT); }
__device__ __forceinline__ unsigned xb_xcc_id() { return (unsigned)__builtin_amdgcn_s_getreg((3 << 11) | 20) & 0xFu; }
#define XB_SPIN(cond, bar) do { unsigned _sp = 0; while (cond) { __builtin_amdgcn_s_sleep(1); \
    if ((++_sp & 255u) == 0u) { if (xb_ld(&(bar)[XB_TMO])) break; if (_sp > XB_SPIN_CAP) { atomicAdd(&(bar)[XB_TMO], 1u); break; } } } } while (0)
struct XcdBarrier { unsigned* bar; unsigned x; volatile LAS unsigned* st; };
__device__ __forceinline__ XcdBarrier xcd_barrier_post(unsigned* bar, volatile LAS unsigned* st) {
    XcdBarrier b; b.bar = bar; b.x = xb_xcc_id(); b.st = st;
    if (threadIdx.x == 0) (void)xb_add(&bar[XB_XCNT(b.x)], 1u);
    return b;
}
__device__ __forceinline__ void xcd_barrier_complete(unsigned* bar, unsigned x, unsigned& nloc, unsigned& nx) {
    const unsigned G = gridDim.x * gridDim.y * gridDim.z;
    unsigned sum, cnt, mine, sp = 0u;
    for (;;) {
        sum = 0u; cnt = 0u; mine = 0u;
#pragma unroll
        for (unsigned j = 0; j < 16; ++j) { const unsigned c = xb_ld(&bar[XB_XCNT(j)]); sum += c; cnt += (c > 0u) ? 1u : 0u; mine = (j == x) ? c : mine; }
        if (sum == G) break;
        __builtin_amdgcn_s_sleep(1);
        if ((++sp & 255u) == 0u) { if (xb_ld(&bar[XB_TMO])) break; if (sp > XB_SPIN_CAP) { atomicAdd(&bar[XB_TMO], 1u); break; } }
    }
    nloc = mine > 0u ? mine : 1u; nx = cnt > 0u ? cnt : 1u;
}
__device__ __forceinline__ void xcd_barrier(const XcdBarrier& b) {
    asm volatile("s_waitcnt vmcnt(0)" ::: "memory");
    __syncthreads();
    if (threadIdx.x == 0) {
        unsigned* bar = b.bar;
        __builtin_amdgcn_s_waitcnt(0);
        unsigned nloc = b.st[0], nx = b.st[1];
        if (nloc == 0u) { xcd_barrier_complete(bar, b.x, nloc, nx); b.st[0] = nloc; b.st[1] = nx; }
        const unsigned old = xb_add(&bar[XB_XSUB(b.x)], 1u);
        const unsigned gen = old / nloc;
        if (old + 1u == (gen + 1u) * nloc) {
            __builtin_amdgcn_fence(__ATOMIC_RELEASE, "agent");
            asm volatile("s_waitcnt vmcnt(0)" ::: "memory");
            const unsigned og = xb_add(&bar[XB_TOP], 1u);
            const unsigned tg = og / nx;
            if (og + 1u == (tg + 1u) * nx) xb_add(&bar[XB_TOPGEN], 1u);
            else XB_SPIN(xb_ld(&bar[XB_TOPGEN]) == tg, bar);
            __builtin_amdgcn_fence(__ATOMIC_ACQUIRE, "agent");
            xb_add(&bar[XB_XGEN(b.x)], 1u);
            asm volatile("s_waitcnt vmcnt(0)" ::: "memory");
        } else {
            XB_SPIN(xb_ld(&bar[XB_XGEN(b.x)]) == gen, bar);
            __builtin_amdgcn_fence(__ATOMIC_ACQUIRE, "agent");
            asm volatile("s_waitcnt vmcnt(0)" ::: "memory");
        }
    }
    __syncthreads();
}
#endif

constexpr int NPHASES = DEPTH + NHALF * (14 + 16);
constexpr int LDS_BYTES = 155648, MISC_OFF = 154624;

__global__ void __launch_bounds__(512, 2) fwd_kernel(Args args_k) {
#ifdef EMU
    unsigned char* lds = emu_lds_ptr;
#else
    extern __shared__ __attribute__((aligned(16))) unsigned char lds[];
#endif
    Frame F0;
    F0.lds = (LAS unsigned char*)lds; F0.tid = threadIdx.x; F0.lane = F0.tid & 63; F0.wave = RFL(F0.tid >> 6); F0.G = gridDim.x; F0.bid = blockIdx.x;
    F0.gw = F0.bid * 8 + F0.wave; F0.NGW = F0.G * 8;
    F0.out = (GAS float*)args_k.out; F0.ws = (GAS unsigned char*)args_k.ws; F0.ctl = (GAS unsigned*)(F0.ws + WS_CTL);
    const int lo = args_k.lo, hi = args_k.hi;
#ifndef EMU
    volatile LAS unsigned* misc = (volatile LAS unsigned*)(F0.lds + MISC_OFF);
    if (F0.tid < 4) misc[F0.tid] = 0u;
    __syncthreads();
    XcdBarrier bar; bar.bar = (unsigned*)(F0.ctl + CW_BAR); bar.x = 0; bar.st = misc;
    if (hi - lo > 1) bar = xcd_barrier_post((unsigned*)(F0.ctl + CW_BAR), misc);
#define GRID_BAR() do { XcdBarrier bq = bar; asm volatile("" : "+s"(bq.bar), "+s"(bq.x)); xcd_barrier(bq); } while (0)
#else
#define GRID_BAR() do { } while (0)
#endif
    int ph = 0;
#ifndef PH_MASK
#define PH_MASK 0xFFFFFFFFFFFFFFFFull
#endif
#define PHASE(...) PHASE_I(31, __VA_ARGS__)
#ifdef EMU
#define LAUNDER(Fq) do { } while (0)
#else
#define LAUNDER(Fq) do { unsigned mq_ = ~0u; asm volatile("" : "+s"(Fq.G), "+s"(Fq.bid), "+s"(Fq.wave), "+s"(Fq.ws), "+s"(Fq.out), "+s"(Fq.ctl), "+s"(mq_)); Fq.lane = (int)__builtin_amdgcn_mbcnt_hi(mq_, __builtin_amdgcn_mbcnt_lo(mq_, 0u)); Fq.tid = Fq.wave * 64 + Fq.lane; Fq.gw = Fq.bid * 8 + Fq.wave; Fq.NGW = Fq.G * 8; } while (0)
#endif
#ifdef EMU
#define ARGS_Q() const Args& args_q = args_k
#else
#define ARGS_Q() const __attribute__((address_space(4))) Args* aq_ = (const __attribute__((address_space(4))) Args*)__builtin_amdgcn_kernarg_segment_ptr(); asm volatile("" : "+s"(aq_)); const Args& args_q = *(const Args*)aq_
#endif
#define PHASE_I(kind, ...) do { if (ph >= lo && ph < hi) { constexpr int reps_ = (((REPEAT_MASK) >> (kind)) & 1u) ? 2 : 1; for (int rr_ = 0; rr_ < reps_; ++rr_) { { Frame Fq = F0; LAUNDER(Fq); const Frame& F = Fq; ARGS_Q(); const Args& args = args_q; __VA_ARGS__; } if (rr_ + 1 < reps_ || ph + 1 < hi) { GRID_BAR(); if (((REPEAT_MASK) >> 26) & 1u) GRID_BAR(); } } } ++ph; } while (0)
#define PHASEK(kind, ...) PHASE_I(kind, __VA_ARGS__)
#define NORM1(layer, half) do { const size_t rn_ = (size_t)(half) * TH; const float* xn_ = ((layer) == 0 ? AIN(args, 0) : (const float*)F.out) + rn_ * D; \
            phase_norm<false>(F, args, xn_, AIN(args, 2) + (layer) * D, WSP(bf16, A_H), nullptr, nullptr, nullptr, nullptr); phase_rope_table(F, args, (const int*)AIN(args, 1) + rn_, WSP(float, A_ROPE)); } while (0)
#define SEGMENT(layer, half) do { \
            const size_t r0 = (size_t)(half) * TH; \
            const float* xin = ((layer) == 0 ? AIN(args_k, 0) : (const float*)F0.out) + r0 * D; float* xo = (float*)F0.out + r0 * D; \
            PHASEK(1, { pg8::Gemm g{WSP(bf16, A_H), WSP(bf16, W_IN), D, D}; pg8::StaticOrder S; S.init(TH, PW, F.G, F.bid); EpiBf16 E{WSP(bf16, A_P), PW, nullptr, 0}; pg8::gemm_phase(F.lds, g, S, E, F.tid); }); \
            PHASEK(2, phase_mla_prep(F, args); phase_rwkv_prep(F, args, layer)); \
            PHASEK(3, phase_mla_q(F, args); __syncthreads(); phase_mla_kv(F, args); __syncthreads(); phase_rwkv_lora(F, args)); \
            PHASEK(8, phase_rwkv_r1(F, args, layer)); \
            PHASEK(5, { const int ns_ = F.G >= 128 ? 64 : (F.G >= 4 ? F.G / 4 : 0); Frame Fa = F;       \
                        if (F.bid < ns_) { Fa.G = ns_; Fa.NGW = ns_ * 8; phase_rwkv_r2(Fa, args); } else { Fa.bid = F.bid - ns_; Fa.G = F.G - ns_; Fa.gw = Fa.bid * 8 + Fa.wave; Fa.NGW = Fa.G * 8; phase_attention(Fa, args); if (ns_ == 0) phase_rwkv_r2(F, args); } }); \
            PHASEK(9, phase_rwkv_post(F, args, layer); phase_gdn_g1(F, args, layer); phase_ssd_s1(F, args, layer)); \
            PHASEK(11, { const int ns_ = F.G >= 4 ? F.G / 2 : 0; Frame Fa = F;                               \
                        if (F.bid < ns_) { Fa.G = ns_; Fa.NGW = ns_ * 8; phase_gdn_g2(Fa, args); } else { Fa.bid = F.bid - ns_; Fa.G = F.G - ns_; Fa.gw = Fa.bid * 8 + Fa.wave; Fa.NGW = Fa.G * 8; phase_ssd_s23(Fa, args); if (ns_ == 0) phase_gdn_g2(F, args); } }); \
            PHASEK(12, phase_gdn_g3(F, args, layer); phase_ssd_s4(F, args, layer)); \
            PHASEK(17, phase_merge_z(F, args)); \
            PHASEK(18, phase_merge_gate(F, args, layer)); \
            PHASEK(19, phase_merge_out(F, args, xin, xo)); \
            if ((layer) == 0) { \
                PHASEK(20, phase_norm<false>(F, args, xo, AIN(args, 32) + (layer) * D, WSP(bf16, A_H), nullptr, nullptr, nullptr, nullptr)); \
                PHASEK(21, phase_ffn_gu(F, args)); \
                PHASE(phase_ffn_down(F, args, xo); if ((half) == 0 && NHALF == 2) NORM1(layer, 1)); \
            } else { \
                PHASE(phase_norm<true>(F, args, xo, AIN(args, 32) + (layer) * D, WSP(bf16, A_H), AIN(args, 35), WSP(int, F_TOPE), WSP(float, F_TOPW), (unsigned*)(F.ctl + CW_WGC + (half) * 8192))); \
                PHASE(phase_moe_route(F, args, half)); \
                PHASEK(22, phase_moe_gu(F, args, half)); \
                PHASEK(23, phase_moe_down(F, args, half)); \
                PHASE(phase_moe_combine(F, args, xo, (layer) == DEPTH - 1 ? AIN(args, 38) : nullptr); if ((half) == 0 && NHALF == 2) NORM1(layer, 1)); \
            } } while (0)
    static_assert(DEPTH == 2 && NHALF <= 2, "segment program");
    PHASEK(27, phase_convert(F, args, 0); NORM1(0, 0));
    SEGMENT(0, 0);
    if (NHALF == 2) SEGMENT(0, 1);
    PHASEK(27, phase_convert(F, args, 1); NORM1(1, 0));
    SEGMENT(1, 0);
    if (NHALF == 2) SEGMENT(1, 1);
#undef SEGMENT
#undef PHASE
}

#ifndef ONE_LAUNCH
#define ONE_LAUNCH 1
#endif
extern "C" void kernel_launch(void* const* d_in, const int* in_sizes, int n_in, void* d_out, int out_size, void* d_ws, size_t ws_size, hipStream_t stream) {
    static int grid = 0;
    if (grid == 0) {
#ifdef EMU
        grid = EMU_GRID;
#else
        if (n_in != 39 || out_size != T * D || ws_size < WS_NEED) { fprintf(stderr, "kernel_launch: unexpected problem (n_in %d out %d ws %zu need %zu)\n", n_in, out_size, ws_size, (size_t)WS_NEED); grid = -1; return; }
        int dev = 0, cus = 0;
        if (hipGetDevice(&dev) != hipSuccess || hipDeviceGetAttribute(&cus, hipDeviceAttributeMultiprocessorCount, dev) != hipSuccess) { grid = -1; return; }
        if (hipFuncSetAttribute((const void*)fwd_kernel, hipFuncAttributeMaxDynamicSharedMemorySize, LDS_BYTES) != hipSuccess) { fprintf(stderr, "kernel_launch: hipFuncSetAttribute failed\n"); grid = -1; return; }
        int per_cu = 0;
        if (hipOccupancyMaxActiveBlocksPerMultiprocessor(&per_cu, (const void*)fwd_kernel, 512, LDS_BYTES) != hipSuccess || per_cu < 1) fprintf(stderr, "kernel_launch: occupancy query reports %d\n", per_cu);
        (void)hipGetLastError();
        grid = cus;
#endif
    }
    if (grid < 0) return;
    (void)hipMemsetAsync((char*)d_ws + WS_CTL, 0, CTL_BYTES, stream);
    Args a{};
    for (int i = 0; i < 39; ++i) a.in[i] = (const float*)d_in[i];
    a.out = (float*)d_out; a.ws = (unsigned char*)d_ws;
#ifdef EMU
    for (int p = EMU_PH_LO; p < EMU_PH_HI && p < NPHASES; ++p) { a.lo = p; a.hi = p + 1; emu_launch(fwd_kernel, grid, 512, a); emu_after_phase(p); }
#else
#if ONE_LAUNCH
    a.lo = 0; a.hi = NPHASES;
    hipLaunchKernelGGL(fwd_kernel, dim3(grid), dim3(512), LDS_BYTES, stream, a);
#else
    for (int p = 0; p < NPHASES; ++p) { a.lo = p; a.hi = p + 1; hipLaunchKernelGGL(fwd_kernel, dim3(grid), dim3(512), LDS_BYTES, stream, a); }
#endif
#endif
}
```

```cpp
#ifndef EMU
#include <hip/hip_runtime.h>
#include <cstdio>
#include <cstdint>
#endif

#ifndef REPEAT_MASK
#define REPEAT_MASK 0u
#endif
#ifdef EMU
constexpr int BATCH = EMU_B, SEQ = EMU_S, NHALF = EMU_NHALF;
#else
constexpr int BATCH = 16, SEQ = 2048, NHALF = 2;
#endif
constexpr int D = 1024, DEPTH = 2, CH = 64;
constexpr int T = BATCH * SEQ, TH = T / NHALF, BH = BATCH / NHALF, NCH = SEQ / CH;
constexpr int C_MLA = 0, C_RWKV = 704, C_GDN = 2528, C_SSD = 4584, C_GATE = 6128, IN_COLS = 10224, PW = 6144;
constexpr int FF_D = 2816, FF_E = 3584, NEXP = 8;
constexpr int MOE_ROWS = ((TH * 2 + NEXP * 255) / 256) * 256;
constexpr float EPS = 1e-6f;
static_assert(TH % 256 == 0 && SEQ % 128 == 0 && BATCH % NHALF == 0 && (SEQ / 64) % 2 == 0, "shape");

typedef unsigned short bf16;
typedef float f32x4 __attribute__((ext_vector_type(4)));
typedef float f32x2 __attribute__((ext_vector_type(2)));
typedef short bf16x8 __attribute__((ext_vector_type(8)));
typedef short bf16x4 __attribute__((ext_vector_type(4)));
typedef unsigned u32x4 __attribute__((ext_vector_type(4)));
typedef unsigned u32x2 __attribute__((ext_vector_type(2)));
#ifdef EMU
#define LAS
#define GAS
#define MFMA_F32(a, b, c) emu_mfma_16x16x4f32(a, b, c)
#define MFMA_BF16(a, b, c) emu_mfma_16x16x32bf16(a, b, c)
#define ATOMIC_ADD_U32(p, v) emu_atomic_add_u32(p, v)
#define ATOMIC_ADD_LDS(p, v) emu_atomic_add_u32((unsigned*)(p), v)
#define RFL(x) (x)
#define OPAQUE_V(x) do { } while (0)
#define LDS_WAIT()
#define VM_WAIT()
__device__ __forceinline__ float fast_exp(float x) { return expf(x); }
__device__ __forceinline__ float fast_rcp(float x) { return 1.0f / x; }
__device__ __forceinline__ float fast_rsqrt(float x) { return 1.0f / sqrtf(x); }
#else
#define LAS __attribute__((address_space(3)))
#define GAS __attribute__((address_space(1)))
#define MFMA_F32(a, b, c) __builtin_amdgcn_mfma_f32_16x16x4f32(a, b, c, 0, 0, 0)
#define MFMA_BF16(a, b, c) __builtin_amdgcn_mfma_f32_16x16x32_bf16(a, b, c, 0, 0, 0)
#define ATOMIC_ADD_U32(p, v) __hip_atomic_fetch_add(p, v, __ATOMIC_RELAXED, __HIP_MEMORY_SCOPE_AGENT)
#define ATOMIC_ADD_LDS(p, v) __hip_atomic_fetch_add((LAS unsigned*)(p), v, __ATOMIC_RELAXED, __HIP_MEMORY_SCOPE_WORKGROUP)
#define RFL(x) __builtin_amdgcn_readfirstlane(x)
#define OPAQUE_V(x) asm volatile("" : "+v"(x))
#define LDS_WAIT() asm volatile("s_waitcnt lgkmcnt(0)" ::: "memory")
#define VM_WAIT() asm volatile("s_waitcnt vmcnt(0)" ::: "memory")
__device__ __forceinline__ float fast_exp(float x) { return __expf(x); }
__device__ __forceinline__ float fast_rcp(float x) { return __builtin_amdgcn_rcpf(x); }
__device__ __forceinline__ float fast_rsqrt(float x) { return __builtin_amdgcn_rsqf(x); }
#endif
__device__ __forceinline__ unsigned f2u(float f) { return __builtin_bit_cast(unsigned, f); }
__device__ __forceinline__ float u2f(unsigned u) { return __builtin_bit_cast(float, u); }
#ifdef EMU
__device__ __forceinline__ unsigned f2bf(float f) { unsigned u = f2u(f); return (u + 0x7fffu + ((u >> 16) & 1u)) >> 16; }
__device__ __forceinline__ unsigned pk2(float lo, float hi) { return f2bf(lo) | (f2bf(hi) << 16); }
#else
typedef __bf16 bf16v2_ __attribute__((ext_vector_type(2)));
__device__ __forceinline__ unsigned pk2(float lo, float hi) { const f32x2 v = {lo, hi}; return __builtin_bit_cast(unsigned, __builtin_convertvector(v, bf16v2_)); }
__device__ __forceinline__ unsigned f2bf(float f) { return pk2(f, f) & 0xffffu; }
#endif
__device__ __forceinline__ float bf2f(unsigned h) { return u2f(h << 16); }
#ifndef EMU
#define expf(x) __expf(x)
#define exp2f(x) __builtin_amdgcn_exp2f(x)
#define FDIV(a, b) ((a) * __builtin_amdgcn_rcpf(b))
#define RSQRT(x) __builtin_amdgcn_rsqf(x)
__device__ __forceinline__ float softplusf_(float x) { return x > 20.f ? x : __logf(1.0f + __expf(x)); }
#else
#define FDIV(a, b) ((a) / (b))
#define RSQRT(x) (1.0f / sqrtf(x))
__device__ __forceinline__ float softplusf_(float x) { return x > 20.f ? x : log1pf(expf(x)); }
#endif
__device__ __forceinline__ float sigmoidf_(float x) { return FDIV(1.0f, 1.0f + expf(-x)); }
__device__ __forceinline__ float siluf_(float x) { return FDIV(x, 1.0f + expf(-x)); }
__device__ __forceinline__ float tanhf_(float x) { const float e = expf(2.0f * fminf(x, 15.0f)); return FDIV(e - 1.0f, e + 1.0f); }
#ifdef EMU
template <int N> __device__ __forceinline__ float red_sum(float v) {
#pragma unroll
    for (int o = 1; o < N; o <<= 1) v += __shfl_xor(v, o);
    return v; }
template <int N> __device__ __forceinline__ float red_max(float v) {
#pragma unroll
    for (int o = 1; o < N; o <<= 1) v = fmaxf(v, __shfl_xor(v, o));
    return v; }
__device__ __forceinline__ int bcast0(int v) { return __shfl(v, 0); }
#else
template <int CTRL> __device__ __forceinline__ float dpp_mov(float v) { return u2f((unsigned)__builtin_amdgcn_mov_dpp((int)f2u(v), CTRL, 0xF, 0xF, true)); }
template <int N> __device__ __forceinline__ float red_sum(float v) {
    v += dpp_mov<0xB1>(v);
    v += dpp_mov<0x4E>(v);
    v += dpp_mov<0x141>(v);
    if (N >= 16) v += dpp_mov<0x140>(v);
    if (N >= 32) { const auto r = __builtin_amdgcn_permlane16_swap(f2u(v), f2u(v), false, false); v = u2f(r[0]) + u2f(r[1]); }
    if (N >= 64) { const auto r = __builtin_amdgcn_permlane32_swap(f2u(v), f2u(v), false, false); v = u2f(r[0]) + u2f(r[1]); }
    return v; }
template <int N> __device__ __forceinline__ float red_max(float v) {
    v = fmaxf(v, dpp_mov<0xB1>(v)); v = fmaxf(v, dpp_mov<0x4E>(v)); v = fmaxf(v, dpp_mov<0x141>(v));
    if (N >= 16) v = fmaxf(v, dpp_mov<0x140>(v));
    if (N >= 32) { const auto r = __builtin_amdgcn_permlane16_swap(f2u(v), f2u(v), false, false); v = fmaxf(u2f(r[0]), u2f(r[1])); }
    if (N >= 64) { const auto r = __builtin_amdgcn_permlane32_swap(f2u(v), f2u(v), false, false); v = fmaxf(u2f(r[0]), u2f(r[1])); }
    return v; }
__device__ __forceinline__ int bcast0(int v) { return __builtin_amdgcn_readfirstlane(v); }
#endif
__device__ __forceinline__ float wave_sum(float v) { return red_sum<64>(v); }
__device__ __forceinline__ float wave_max(float v) { return red_max<64>(v); }
__device__ __forceinline__ f32x4 ld_bf16x4(const bf16* p) { const u32x2 w = *(const u32x2*)p; return (f32x4){bf2f(w.x & 0xffffu), bf2f(w.x >> 16), bf2f(w.y & 0xffffu), bf2f(w.y >> 16)}; }
__device__ __forceinline__ void st_bf16x4(bf16* p, f32x4 v) { u32x2 w; w.x = pk2(v.x, v.y); w.y = pk2(v.z, v.w); *(u32x2*)p = w; }
__device__ __forceinline__ u32x4 pack8(const float* v) { u32x4 o; o.x = pk2(v[0], v[1]); o.y = pk2(v[2], v[3]); o.z = pk2(v[4], v[5]); o.w = pk2(v[6], v[7]); return o; }

#ifdef EMU
__device__ __forceinline__ float rows_max(float v) { v = fmaxf(v, __shfl_xor(v, 16)); return fmaxf(v, __shfl_xor(v, 32)); }
__device__ __forceinline__ float rows_sum(float v) { v += __shfl_xor(v, 16); return v + __shfl_xor(v, 32); }
#else
typedef unsigned u32x2v __attribute__((ext_vector_type(2)));
__device__ __forceinline__ float rows_max(float v) {
    { const auto r = __builtin_amdgcn_permlane16_swap(f2u(v), f2u(v), false, false); v = fmaxf(u2f(r[0]), u2f(r[1])); }
    { const auto r = __builtin_amdgcn_permlane32_swap(f2u(v), f2u(v), false, false); v = fmaxf(u2f(r[0]), u2f(r[1])); }
    return v; }
__device__ __forceinline__ float rows_sum(float v) {
    { const auto r = __builtin_amdgcn_permlane16_swap(f2u(v), f2u(v), false, false); v = u2f(r[0]) + u2f(r[1]); }
    { const auto r = __builtin_amdgcn_permlane32_swap(f2u(v), f2u(v), false, false); v = u2f(r[0]) + u2f(r[1]); }
    return v; }
#endif

namespace pg8 {
#define PG8_LAS LAS
typedef unsigned short bf16_t;
constexpr int BM = 256, BK = 64, HALF = 128, HTB = HALF * BK * 2, STAGE_BYTES = 8 * HTB, NXCD = 8, WGM = 8;
__host__ __device__ __forceinline__ int lds_byte(int r, int c) { const int st = (r >> 4) * 2 + (c >> 5), rr = r & 15, cc = c & 31, ob = rr * 64 + cc * 2; return st * 1024 + (ob ^ (((ob >> 9) & 1) << 5)); }
__host__ __device__ __forceinline__ void stage_rc(int b, int& R, int& C) { const int st = b / 1024, sb = b % 1024, swz = sb ^ (((sb >> 9) & 1) << 5); R = (st >> 1) * 16 + swz / 64; C = (st & 1) * 32 + (swz % 64) / 2; }
__host__ __device__ __forceinline__ int perm32(int rho) { const int n = rho >> 4, i = rho & 15; return 8 * (i >> 2) + 4 * n + (i & 3); }
struct Unit { int pm, pn; };
struct Gemm { const bf16_t* A; const bf16_t* Bt; int lda, K; };
struct StaticOrder {
    int nM, nN, nwg, G, c;
    __host__ __device__ void init(int M, int N, int G_, int c_) { nM = M / BM; nN = N / BM; nwg = nM * nN; G = G_; c = c_; }
    __host__ __device__ bool next(int i, Unit& u) const {
        const long L = (long)i * G + c; if (L >= nwg) return false;
        int wgid = (int)L; { const int q = nwg / NXCD, r = nwg % NXCD, xcd = wgid % NXCD, off = wgid / NXCD; wgid = (xcd < r ? xcd * (q + 1) : r * (q + 1) + (xcd - r) * q) + off; }
        const int nig = WGM * nN, gid = wgid / nig, fm = gid * WGM, gsz = (nM - fm) < WGM ? (nM - fm) : WGM;
        u.pm = fm + ((wgid % nig) % gsz); u.pn = (wgid % nig) / gsz; return true;
    }
    __device__ __forceinline__ void a_ready(const Unit&) const {}
    __device__ __forceinline__ void done(const Unit&) const {}
};
#ifndef EMU
template <class Epi, class Sched>
__device__ __forceinline__ void gemm_phase(PG8_LAS unsigned char* lds, const Gemm g, const Sched& S, const Epi& E, const int tid) {
    const int wid = __builtin_amdgcn_readfirstlane(tid >> 6), lane = tid & 63, wr = wid >> 2, wc = wid & 3, fr = lane & 15, fq = lane >> 4;
    int Kq = g.K; asm volatile("" : "+s"(Kq));
    const int K = Kq, nt = K / BK, lda = g.lda;
    unsigned voffA[2], voffB[2];
#pragma unroll
    for (int i = 0; i < 2; ++i) { int R, C; stage_rc(tid * 16 + i * 8192, R, C); const int Rb = Epi::PERM ? ((R & ~31) + perm32(R & 31)) : R;
        voffA[i] = (unsigned)(R * lda + C) * 2u; voffB[i] = (unsigned)(Rb * K + C) * 2u; }
    const size_t kstep = (size_t)(BK * 2);
    const size_t hstep = (size_t)HALF * K * 2, hstepA = (size_t)HALF * lda * 2;
    const size_t tstep = 2 * hstep, tstepA = 2 * hstepA;
    const unsigned ldsw = (unsigned)wid * 1024u;
    const int aoff = lds_byte(wr * 64 + fr, fq * 8), boff = lds_byte(wc * 32 + fr, fq * 8);
#define PG8_SA(b, h) (((b) * 2 + (h)) * HTB)
#define PG8_SB(b, h) ((4 + (b) * 2 + (h)) * HTB)
#define PG8_STAGE(bufoff, gbase, voff) do { _Pragma("unroll") for (int _i = 0; _i < 2; ++_i) \
        __builtin_amdgcn_global_load_lds((const unsigned*)((const char*)(gbase) + (voff)[_i]), (PG8_LAS unsigned*)(lds + (bufoff) + ldsw + _i * 8192), 16, 0, 0); } while (0)
#define PG8_LDA(dst, b, h) do { _Pragma("unroll") for (int m = 0; m < 4; ++m) _Pragma("unroll") for (int k = 0; k < 2; ++k) dst[m][k] = *(const PG8_LAS bf16x8*)(lds + PG8_SA(b, h) + aoff + m * 2048 + k * 1024); } while (0)
#define PG8_LDB(dst, b, h) do { _Pragma("unroll") for (int n = 0; n < 2; ++n) _Pragma("unroll") for (int k = 0; k < 2; ++k) dst[n][k] = *(const PG8_LAS bf16x8*)(lds + PG8_SB(b, h) + boff + n * 2048 + k * 1024); } while (0)
#define PG8_MMA(ai, bj, At, Bt) do { __builtin_amdgcn_s_setprio(1); _Pragma("unroll") for (int m = 0; m < 4; ++m) _Pragma("unroll") for (int n = 0; n < 2; ++n) _Pragma("unroll") for (int k = 0; k < 2; ++k) \
        acc[ai][bj][m][n] = __builtin_amdgcn_mfma_f32_16x16x32_bf16(Bt[n][k], At[m][k], acc[ai][bj][m][n], 0, 0, 0); __builtin_amdgcn_s_setprio(0); } while (0)
#define PG8_WAIT_V(n) asm volatile("s_waitcnt vmcnt(" #n ")" ::: "memory")
#define PG8_WAIT_L(n) asm volatile("s_waitcnt lgkmcnt(" #n ")" ::: "memory")
#define PG8_BAR __builtin_amdgcn_s_barrier()
#define PG8_SCHED __builtin_amdgcn_sched_barrier(0)
    Unit cur, nxt; int ui = 0;
    if (!S.next(0, cur)) return;
    f32x4 acc[2][2][4][2];
#pragma unroll
    for (int a = 0; a < 2; ++a)
#pragma unroll
        for (int b = 0; b < 2; ++b)
#pragma unroll
            for (int m = 0; m < 4; ++m)
#pragma unroll
                for (int n = 0; n < 2; ++n) acc[a][b][m][n] = (f32x4){0.f, 0.f, 0.f, 0.f};
    bf16x8 At[4][2], B0[2][2], B1[2][2];
    const char* cA = (const char*)g.A + (size_t)cur.pm * tstepA; const char* cB = (const char*)g.Bt + (size_t)cur.pn * tstep;
    S.a_ready(cur);
    PG8_STAGE(PG8_SB(0, 0), cB, voffB); PG8_STAGE(PG8_SA(0, 0), cA, voffA); PG8_STAGE(PG8_SB(0, 1), cB + hstep, voffB); PG8_STAGE(PG8_SA(0, 1), cA + hstepA, voffA);
    if (wr == 1) PG8_BAR;
    PG8_WAIT_V(4); PG8_BAR;
    PG8_STAGE(PG8_SB(1, 0), cB + kstep, voffB); PG8_STAGE(PG8_SA(1, 0), cA + kstep, voffA); PG8_STAGE(PG8_SB(1, 1), cB + hstep + kstep, voffB);
    PG8_WAIT_V(6); PG8_BAR;
    for (;;) {
        const bool has_next = S.next(ui + 1, nxt);
        const char* nA = has_next ? (const char*)g.A + (size_t)nxt.pm * tstepA : cA; const char* nB = has_next ? (const char*)g.Bt + (size_t)nxt.pn * tstep : cB;
        for (int t = 0; t < nt; t += 2) {
            const bool last = (t == nt - 2);
            const char* a1 = cA + (size_t)(t + 1) * kstep;
            const char* a2 = last ? nA : cA + (size_t)(t + 2) * kstep; const char* b2 = last ? nB : cB + (size_t)(t + 2) * kstep;
            const char* a3 = a2 + kstep; const char* b3 = b2 + kstep;
            if (last && has_next) S.a_ready(nxt);
            PG8_LDB(B0, 0, 0); PG8_SCHED; PG8_LDA(At, 0, 0); PG8_STAGE(PG8_SA(1, 1), a1 + hstepA, voffA);
            PG8_WAIT_L(8); PG8_BAR; PG8_WAIT_L(0); PG8_MMA(0, 0, At, B0); PG8_BAR; PG8_SCHED;
            PG8_LDB(B1, 0, 1); PG8_STAGE(PG8_SB(0, 0), b2, voffB);
            PG8_BAR; PG8_WAIT_L(0); PG8_MMA(0, 1, At, B1); PG8_BAR;
            PG8_LDA(At, 0, 1); PG8_STAGE(PG8_SA(0, 0), a2, voffA);
            PG8_BAR; PG8_WAIT_L(0); PG8_MMA(1, 0, At, B0); PG8_BAR; PG8_SCHED;
            PG8_STAGE(PG8_SB(0, 1), b2 + hstep, voffB);
            PG8_WAIT_V(6); PG8_BAR; PG8_MMA(1, 1, At, B1); PG8_BAR;
            PG8_LDB(B0, 1, 0); PG8_SCHED; PG8_LDA(At, 1, 0); PG8_STAGE(PG8_SA(0, 1), a2 + hstepA, voffA);
            PG8_WAIT_L(8); PG8_BAR; PG8_WAIT_L(0); PG8_MMA(0, 0, At, B0); PG8_BAR; PG8_SCHED;
            PG8_LDB(B1, 1, 1); PG8_STAGE(PG8_SB(1, 0), b3, voffB);
            PG8_BAR; PG8_WAIT_L(0); PG8_MMA(0, 1, At, B1); PG8_BAR;
            PG8_LDA(At, 1, 1); PG8_STAGE(PG8_SA(1, 0), a3, voffA);
            PG8_BAR; PG8_WAIT_L(0); PG8_MMA(1, 0, At, B0); PG8_BAR; PG8_SCHED;
            PG8_STAGE(PG8_SB(1, 1), b3 + hstep, voffB);
            PG8_WAIT_V(6); PG8_BAR; PG8_MMA(1, 1, At, B1); PG8_BAR;
        }
        if constexpr (!Epi::AFTER_DRAIN) { E(acc, cur, wr, wc, fr, fq); S.done(cur); }
        if (!has_next) break;
#pragma unroll
        for (int a = 0; a < 2; ++a)
#pragma unroll
            for (int b = 0; b < 2; ++b)
#pragma unroll
                for (int m = 0; m < 4; ++m)
#pragma unroll
                    for (int n = 0; n < 2; ++n) acc[a][b][m][n] = (f32x4){0.f, 0.f, 0.f, 0.f};
        cur = nxt; cA = nA; cB = nB; ++ui;
    }
    PG8_WAIT_V(0);
    if (wr == 0) PG8_BAR;
    PG8_BAR;
    if constexpr (Epi::AFTER_DRAIN) { E.fused(acc, cur, wr, wc, fr, fq, lds, wid, lane); S.done(cur); }
#undef PG8_SA
#undef PG8_SB
#undef PG8_STAGE
#undef PG8_LDA
#undef PG8_LDB
#undef PG8_MMA
#undef PG8_WAIT_V
#undef PG8_WAIT_L
#undef PG8_BAR
#undef PG8_SCHED
}
#else
template <class Epi, class Sched>
__device__ __forceinline__ void gemm_phase(PG8_LAS unsigned char* lds, const Gemm g, const Sched& S, const Epi& E, const int tid) {
    const int wid = tid >> 6, lane = tid & 63, wr = wid >> 2, wc = wid & 3, fr = lane & 15, fq = lane >> 4;
    Unit cur;
    for (int ui = 0; S.next(ui, cur); ++ui) {
        f32x4 acc[2][2][4][2];
        for (int ai = 0; ai < 2; ++ai) for (int m = 0; m < 4; ++m) {
            const size_t row = (size_t)cur.pm * 256 + ai * 128 + wr * 64 + m * 16 + fr;
            const bf16_t* ap = g.A + row * g.lda;
            for (int bj = 0; bj < 2; ++bj) for (int n = 0; n < 2; ++n) for (int j = 0; j < 4; ++j) {
                const size_t col = (size_t)cur.pn * 256 + bj * 128 + wc * 32 + (Epi::PERM ? 8 * fq + 4 * n : 16 * n + 4 * fq) + j;
                const bf16_t* bp = g.Bt + col * g.K; float s = 0.f;
                for (int k = 0; k < g.K; ++k) s += bf2f(ap[k]) * bf2f(bp[k]);
                acc[ai][bj][m][n][j] = s; } }
        E(acc, cur, wr, wc, fr, fq);
    }
    __syncthreads();
}
#endif
}

using pg8::Unit;
constexpr int HALFT = 128;
struct EpiF32 {
    static constexpr bool PERM = false, AFTER_DRAIN = false;
    float* C; int ldc;
    __device__ __forceinline__ void operator()(const f32x4 (&acc)[2][2][4][2], const Unit& u, int wr, int wc, int fr, int fq) const {
        const int row0 = u.pm * 256 + wr * 64 + fr, col0 = u.pn * 256 + wc * 32 + 4 * fq;
#pragma unroll
        for (int ai = 0; ai < 2; ++ai)
#pragma unroll
            for (int m = 0; m < 4; ++m) { float* rowp = C + (size_t)(row0 + ai * HALFT + m * 16) * ldc + col0;
#pragma unroll
                for (int bj = 0; bj < 2; ++bj)
#pragma unroll
                    for (int n = 0; n < 2; ++n) *(f32x4*)(rowp + bj * HALFT + n * 16) = acc[ai][bj][m][n]; }
    }
};
struct EpiResidual {
    static constexpr bool PERM = false, AFTER_DRAIN = false;
    const float* res; float* out;
    __device__ __forceinline__ void operator()(const f32x4 (&acc)[2][2][4][2], const Unit& u, int wr, int wc, int fr, int fq) const {
        const int row0 = u.pm * 256 + wr * 64 + fr, col0 = u.pn * 256 + wc * 32 + 4 * fq;
#pragma unroll
        for (int ai = 0; ai < 2; ++ai) {
            f32x4 rv[4][2][2];
#pragma unroll
            for (int m = 0; m < 4; ++m) { const size_t o = (size_t)(row0 + ai * HALFT + m * 16) * D + col0;
#pragma unroll
                for (int bj = 0; bj < 2; ++bj)
#pragma unroll
                    for (int n = 0; n < 2; ++n) rv[m][bj][n] = *(const GAS f32x4*)(res + o + bj * HALFT + n * 16); }
#pragma unroll
            for (int m = 0; m < 4; ++m) { const size_t o = (size_t)(row0 + ai * HALFT + m * 16) * D + col0;
#pragma unroll
                for (int bj = 0; bj < 2; ++bj)
#pragma unroll
                    for (int n = 0; n < 2; ++n) *(GAS f32x4*)(out + o + bj * HALFT + n * 16) = rv[m][bj][n] + acc[ai][bj][m][n]; }
        }
    }
};
struct EpiBf16 {
    static constexpr bool PERM = true, AFTER_DRAIN = false;
    bf16* O; int ldc; const float* rowscale; int rs_stride;
    __device__ __forceinline__ void operator()(const f32x4 (&acc)[2][2][4][2], const Unit& u, int wr, int wc, int fr, int fq) const {
        const int row0 = u.pm * 256 + wr * 64 + fr, col0 = u.pn * 256 + wc * 32 + 8 * fq;
#pragma unroll
        for (int ai = 0; ai < 2; ++ai)
#pragma unroll
            for (int m = 0; m < 4; ++m) { const int row = row0 + ai * HALFT + m * 16; bf16* rowp = O + (size_t)row * ldc + col0;
                const float sc = rowscale ? rowscale[(size_t)row * rs_stride] : 1.0f;
#pragma unroll
                for (int bj = 0; bj < 2; ++bj) { const f32x4 v0 = acc[ai][bj][m][0] * sc, v1 = acc[ai][bj][m][1] * sc;
                    u32x4 w; w.x = pk2(v0[0], v0[1]); w.y = pk2(v0[2], v0[3]); w.z = pk2(v1[0], v1[1]); w.w = pk2(v1[2], v1[3]);
                    *(u32x4*)(rowp + bj * HALFT) = w; } }
    }
};
struct EpiSwiGLU {
    static constexpr bool PERM = true, AFTER_DRAIN = false;
    bf16* O; int ldc; int ntile;
    __device__ __forceinline__ void operator()(const f32x4 (&acc)[2][2][4][2], const Unit& u, int wr, int wc, int fr, int fq) const {
        const int row0 = u.pm * 256 + wr * 64 + fr, col0 = (u.pn % ntile) * 128 + wc * 32 + 8 * fq;
#pragma unroll
        for (int ai = 0; ai < 2; ++ai)
#pragma unroll
            for (int m = 0; m < 4; ++m) { bf16* rowp = O + (size_t)(row0 + ai * HALFT + m * 16) * ldc + col0;
                float a[8];
#pragma unroll
                for (int n = 0; n < 2; ++n)
#pragma unroll
                    for (int j = 0; j < 4; ++j) { const float g = acc[ai][0][m][n][j], up = acc[ai][1][m][n][j]; a[4 * n + j] = g * fast_rcp(1.0f + fast_exp(-g)) * up; }
                u32x4 w; w.x = pk2(a[0], a[1]); w.y = pk2(a[2], a[3]); w.z = pk2(a[4], a[5]); w.w = pk2(a[6], a[7]);
                *(u32x4*)rowp = w; }
    }
};
struct EpiZ {
    static constexpr bool PERM = true, AFTER_DRAIN = false;
    bf16* Z;
    __device__ __forceinline__ void operator()(const f32x4 (&acc)[2][2][4][2], const Unit& u, int wr, int wc, int fr, int fq) const {
        const int i = u.pn >> 2, pnl = u.pn & 3, pml = u.pm - i * (TH / 256);
        const int row0 = pml * 256 + wr * 64 + fr, col0 = i * D + pnl * 256 + wc * 32 + 8 * fq;
#pragma unroll
        for (int ai = 0; ai < 2; ++ai)
#pragma unroll
            for (int m = 0; m < 4; ++m) { bf16* rowp = Z + (size_t)(row0 + ai * HALFT + m * 16) * 4096 + col0;
#pragma unroll
                for (int bj = 0; bj < 2; ++bj) { const f32x4 v0 = acc[ai][bj][m][0], v1 = acc[ai][bj][m][1];
                    u32x4 w; w.x = pk2(v0[0], v0[1]); w.y = pk2(v0[2], v0[3]); w.z = pk2(v1[0], v1[1]); w.w = pk2(v1[2], v1[3]);
                    *(GAS u32x4*)(rowp + bj * HALFT) = w; } }
    }
};
struct BranchOrder {
    int nP, G, c;
    __device__ bool next(int i, Unit& u) const {
        const long L = (long)i * G + c; if (L >= (long)16 * nP) return false;
        const int br = (int)(L / (4 * nP)), r = (int)(L % (4 * nP)); u.pm = br * nP + (r >> 2); u.pn = br * 4 + (r & 3); return true;
    }
    __device__ __forceinline__ void a_ready(const Unit&) const {}
    __device__ __forceinline__ void done(const Unit&) const {}
};
struct EpiMerge {
    static constexpr bool PERM = false, AFTER_DRAIN = false;
    const bf16* Z; const float* gate_b; bf16* MG;
    __device__ __forceinline__ void operator()(const f32x4 (&acc)[2][2][4][2], const Unit& u, int wr, int wc, int fr, int fq) const {
        const int row0 = u.pm * 256 + wr * 64 + fr, col = u.pn * 64 + wc * 16 + 4 * fq;
        f32x4 gb[4];
#pragma unroll
        for (int i = 0; i < 4; ++i) gb[i] = *(const GAS f32x4*)(gate_b + i * D + col);
#pragma unroll
        for (int ai = 0; ai < 2; ++ai) {
            u32x2 zv[4][4];
#pragma unroll
            for (int m = 0; m < 4; ++m)
#pragma unroll
                for (int i = 0; i < 4; ++i) zv[m][i] = *(const GAS u32x2*)(Z + (size_t)(row0 + ai * HALFT + m * 16) * 4096 + i * D + col);
#pragma unroll
            for (int m = 0; m < 4; ++m) { const size_t row = (size_t)(row0 + ai * HALFT + m * 16);
                f32x4 s = (f32x4){0.f, 0.f, 0.f, 0.f};
#pragma unroll
                for (int bj = 0; bj < 2; ++bj)
#pragma unroll
                    for (int n = 0; n < 2; ++n) { const int i = 2 * bj + n; const unsigned z01 = zv[m][i].x, z23 = zv[m][i].y;
                        const f32x4 z = (f32x4){bf2f(z01 & 0xffffu), bf2f(z01 >> 16), bf2f(z23 & 0xffffu), bf2f(z23 >> 16)}; const f32x4 a = acc[ai][bj][m][n] + gb[i];
#pragma unroll
                        for (int j = 0; j < 4; ++j) s[j] += z[j] * fast_rcp(1.0f + fast_exp(-a[j])); }
                u32x2 w; w.x = pk2(s.x, s.y); w.y = pk2(s.z, s.w); *(GAS u32x2*)(MG + row * D + col) = w; }
        }
    }
};

constexpr size_t MiB = 1u << 20;
constexpr size_t al(size_t x) { return (x + 255) & ~(size_t)255; }
constexpr size_t WS_CTL = 0, CTL_BYTES = 1 * MiB;
constexpr size_t W_IN = 1 * MiB;
constexpr size_t W_GATE = W_IN + (size_t)PW * D * 2;
constexpr size_t W_UQ = W_GATE + (size_t)4096 * D * 2;
constexpr size_t W_UKV = W_UQ + (size_t)768 * 384 * 2;
constexpr size_t W_LORA = W_UKV + (size_t)1024 * 256 * 2;
constexpr size_t W_BR = W_LORA + (size_t)1536 * 384 * 2;
constexpr size_t W_OUT = W_BR + (size_t)4 * 1024 * 512 * 2;
constexpr size_t W_FGU = W_OUT + (size_t)D * D * 2;
constexpr size_t W_FDN = W_FGU + (size_t)NEXP * 2 * FF_E * D * 2;
constexpr size_t W_END = W_FDN + (size_t)NEXP * D * FF_E * 2;
constexpr size_t A_H = al(W_END);
constexpr size_t A_ROPE = A_H + (size_t)TH * D * 2;
constexpr size_t A_Y = A_ROPE + (size_t)TH * 64 * 4;
constexpr size_t A_P = A_Y + (size_t)4 * TH * 512 * 2;
constexpr size_t A_MIX = A_P + (size_t)TH * PW * 2;
constexpr size_t R_RKV = A_MIX;
constexpr size_t R_LOUT = R_RKV + (size_t)TH * 1536 * 2;
constexpr size_t R_O = R_LOUT + (size_t)TH * 1536 * 4;
constexpr size_t R_LIN = R_O + (size_t)TH * 512 * 4;
constexpr size_t R_REC = R_LIN + (size_t)TH * 384 * 2;
constexpr size_t R_END = R_REC + (size_t)BH * 8 * NCH * 61696;
constexpr size_t M_KR = al(R_END);
constexpr size_t M_Q = M_KR + (size_t)TH * 64 * 2;
constexpr size_t M_KV = M_Q + (size_t)TH * 768 * 2;
constexpr size_t M_VT = M_KV + (size_t)TH * 1024 * 2;
constexpr size_t M_END = M_VT + (size_t)TH * 512 * 2;
constexpr size_t G_CH = R_LIN;
constexpr size_t G_O = G_CH + al((size_t)BH * 4 * NCH * 78864);
constexpr size_t G_END = G_O + (size_t)TH * 512 * 4;
constexpr size_t S_ST = al(G_END);
constexpr size_t S_YD = S_ST + (size_t)BH * NCH * 8 * 64 * 128 * 2;
constexpr size_t S_C = S_YD + (size_t)TH * 512 * 4;
constexpr size_t S_AC = S_C + (size_t)BH * NCH * 2 * 17408;
constexpr size_t S_YO = S_AC + (size_t)TH * 8 * 4;
constexpr size_t S_END = S_YO + (size_t)TH * 512 * 4;
constexpr size_t A_Z = A_P;
constexpr size_t A_MG = A_MIX;
constexpr size_t F_ACT = A_P;
constexpr size_t F_GA = F_ACT + (size_t)MOE_ROWS * FF_E * 2;
constexpr size_t F_YE = F_GA + (size_t)MOE_ROWS * D * 2;
constexpr size_t F_TOPE = F_YE + (size_t)MOE_ROWS * D * 4;
constexpr size_t F_TOPW = F_TOPE + (size_t)TH * 2 * 4;
constexpr size_t F_SLOT = F_TOPW + (size_t)TH * 2 * 4;
constexpr size_t F_END = F_SLOT + (size_t)TH * 2 * 4;
constexpr size_t cmax(size_t a, size_t b) { return a > b ? a : b; }
constexpr size_t WS_NEED = cmax(cmax(cmax(M_END, R_END), cmax(G_END, S_END)), F_END);
#ifndef EMU
static_assert(WS_NEED <= (size_t)896 * MiB, "workspace");
#endif
constexpr int CW_BAR = 4096;
constexpr int CW_CNT = 16384;
constexpr int CW_WGC = 32768;

#ifdef EMU
#define WAVE_SYNC() emu_wave_sync()
#else
#define WAVE_SYNC() do { asm volatile("s_waitcnt lgkmcnt(0)" ::: "memory"); } while (0)
#endif
struct Frame {
    LAS unsigned char* lds; int tid, lane, wave, G, gw, NGW, bid;
    GAS float* out; GAS unsigned char* ws; GAS unsigned* ctl;
};
struct Args { const float* in[39]; float* out; unsigned char* ws; int lo, hi; };
#define WSP(type, off) ((type*)(F.ws + (off)))
#define AIN(A_, k) ((const float*)(const GAS float*)(A_).in[k])

template <class FN>
__device__ __forceinline__ void cvt_matrix(const Frame& F, const float* W, int ldw, int K, bf16* WT, int Ndst, const float* kscale, FN srccol) {
    LAS float* scr = (LAS float*)(F.lds + F.wave * 16384);
    const int nblk = Ndst / 32, nitems = (K / 64) * nblk, lane = F.lane;
    for (int item = F.gw; item < nitems; item += F.NGW) {
        const int kb = item / nblk, nb = item % nblk, k0 = 64 * kb, n0 = 32 * nb;
        const int sc = srccol(n0 + (lane & 31));
        float wv[32];
#pragma unroll
        for (int i = 0; i < 32; ++i) { const int kk = 2 * i + (lane >> 5); wv[i] = sc >= 0 ? W[(size_t)(k0 + kk) * ldw + sc] : 0.f; }
#pragma unroll
        for (int i = 0; i < 32; ++i) { const int kk = 2 * i + (lane >> 5); float v = wv[i]; if (kscale) v *= kscale[k0 + kk]; scr[kk * 33 + (lane & 31)] = v; }
        WAVE_SYNC();
        const int c = lane & 7;
#pragma unroll
        for (int j = 0; j < 4; ++j) { const int n = (lane >> 3) + 8 * j; const LAS float* s = scr + (8 * c) * 33 + n;
            u32x4 o; o.x = pk2(s[0 * 33], s[1 * 33]); o.y = pk2(s[2 * 33], s[3 * 33]); o.z = pk2(s[4 * 33], s[5 * 33]); o.w = pk2(s[6 * 33], s[7 * 33]);
            *(u32x4*)(WT + (size_t)(n0 + n) * K + k0 + 8 * c) = o; }
        WAVE_SYNC();
    }
}
__device__ __forceinline__ void phase_convert(const Frame& F, const Args& A, int layer) {
    const float* w_in = AIN(A, 3) + (size_t)layer * D * IN_COLS;
    cvt_matrix(F, w_in, IN_COLS, D, WSP(bf16, W_IN), PW, nullptr, [](int n) { return n < C_GATE ? n : -1; });
    cvt_matrix(F, w_in, IN_COLS, D, WSP(bf16, W_GATE), 4096, nullptr, [](int n) {
        const int pn = n >> 8, c = n & 255, bj = c >> 7, wc = (c >> 5) & 3, nn = (c >> 4) & 1, r = c & 15; return C_GATE + (2 * bj + nn) * D + 64 * pn + 16 * wc + r; });
    cvt_matrix(F, AIN(A, 6) + (size_t)layer * 384 * 768, 768, 384, WSP(bf16, W_UQ), 768, AIN(A, 4) + layer * 384, [](int n) { return n; });
    cvt_matrix(F, AIN(A, 7) + (size_t)layer * 256 * 1024, 1024, 256, WSP(bf16, W_UKV), 1024, AIN(A, 5) + layer * 256, [](int n) { return n; });
    for (int i = 0; i < 4; ++i) cvt_matrix(F, AIN(A, 30) + ((size_t)layer * 4 + i) * 512 * D, D, 512, WSP(bf16, W_BR) + (size_t)i * D * 512, D, nullptr, [](int n) { return n; });
    cvt_matrix(F, AIN(A, 31) + (size_t)layer * D * D, D, D, WSP(bf16, W_OUT), D, nullptr, [](int n) { return n; });
    if (layer == 0) {
        cvt_matrix(F, AIN(A, 33), 2 * FF_D, D, WSP(bf16, W_FGU), 2 * FF_D, nullptr, [](int n) { const int pn = n >> 8, c = n & 255; return c < 128 ? 128 * pn + c : FF_D + 128 * pn + (c - 128); });
        cvt_matrix(F, AIN(A, 34), D, FF_D, WSP(bf16, W_FDN), D, nullptr, [](int n) { return n; });
    } else {
        for (int e = 0; e < NEXP; ++e) {
            cvt_matrix(F, AIN(A, 36) + (size_t)e * D * 2 * FF_E, 2 * FF_E, D, WSP(bf16, W_FGU) + (size_t)e * 2 * FF_E * D, 2 * FF_E, nullptr, [](int n) { const int pn = n >> 8, c = n & 255; return c < 128 ? 128 * pn + c : FF_E + 128 * pn + (c - 128); });
            cvt_matrix(F, AIN(A, 37) + (size_t)e * FF_E * D, D, FF_E, WSP(bf16, W_FDN) + (size_t)e * D * FF_E, D, nullptr, [](int n) { return n; });
        }
    }
    { const float* w2 = AIN(A, 10) + (size_t)layer * 64 * 512; const float* a2 = AIN(A, 12) + (size_t)layer * 64 * 512; const float* g2 = AIN(A, 13) + (size_t)layer * 160 * 512;
      bf16* L = WSP(bf16, W_LORA);
      for (int idx = F.bid * 512 + F.tid; idx < 1536 * 384; idx += F.G * 512) { const int n = idx / 384, k = idx % 384; float v = 0.f;
          if (n < 512) { if (k < 64) v = w2[k * 512 + n]; } else if (n < 1024) { if (k >= 64 && k < 128) v = a2[(k - 64) * 512 + (n - 512)]; } else { if (k >= 128 && k < 288) v = g2[(k - 128) * 512 + (n - 1024)]; }
          L[idx] = (bf16)f2bf(v); } }
}

template <bool ROUTER>
__device__ __forceinline__ void phase_norm(const Frame& F, const Args& A, const float* xin, const float* gain, bf16* H, const float* router, int* tope, float* topw, unsigned* cnt) {
    const int lane = F.lane;
    LAS unsigned* lcnt = (LAS unsigned*)F.lds;
    if (ROUTER) { __syncthreads(); if (F.tid < 8) lcnt[F.tid] = 0u; __syncthreads(); }
    f32x4 gv[4];
#pragma unroll
    for (int j = 0; j < 4; ++j) gv[j] = *(const f32x4*)(gain + 4 * lane + 256 * j);
    for (int m = F.gw; m < TH; m += F.NGW) {
        const float* xr = xin + (size_t)m * D; f32x4 v[4]; float ss = 0.f;
#pragma unroll
        for (int j = 0; j < 4; ++j) { v[j] = *(const f32x4*)(xr + 4 * lane + 256 * j); ss += (v[j].x * v[j].x + v[j].y * v[j].y) + (v[j].z * v[j].z + v[j].w * v[j].w); }
        const float rstd = RSQRT(wave_sum(ss) * (1.0f / D) + EPS);
#pragma unroll
        for (int j = 0; j < 4; ++j) { v[j] = v[j] * rstd * gv[j]; st_bf16x4(H + (size_t)m * D + 4 * lane + 256 * j, v[j]); }
        if (ROUTER) {
            float lg[8];
#pragma unroll
            for (int e = 0; e < 8; ++e) lg[e] = 0.f;
#pragma unroll
            for (int j = 0; j < 4; ++j)
#pragma unroll
                for (int q = 0; q < 4; ++q) { const float* rp = router + (size_t)(4 * lane + 256 * j + q) * 8; const f32x4 r0 = *(const f32x4*)rp, r1 = *(const f32x4*)(rp + 4); const float hv = v[j][q];
                    lg[0] += hv * r0.x; lg[1] += hv * r0.y; lg[2] += hv * r0.z; lg[3] += hv * r0.w; lg[4] += hv * r1.x; lg[5] += hv * r1.y; lg[6] += hv * r1.z; lg[7] += hv * r1.w; }
#pragma unroll
            for (int e = 0; e < 8; ++e) lg[e] = wave_sum(lg[e]);
            if (lane == 0) {
                int e1 = 0; float l1 = lg[0];
#pragma unroll
                for (int e = 1; e < 8; ++e) if (lg[e] > l1) { l1 = lg[e]; e1 = e; }
                int e2 = -1; float l2 = -3.0e38f;
#pragma unroll
                for (int e = 0; e < 8; ++e) if (e != e1 && lg[e] > l2) { l2 = lg[e]; e2 = e; }
                const float w1 = 1.0f / (1.0f + expf(l2 - l1));
                tope[2 * m] = e1; tope[2 * m + 1] = e2; topw[2 * m] = w1; topw[2 * m + 1] = 1.0f - w1;
                ATOMIC_ADD_LDS(lcnt + e1, 1u); ATOMIC_ADD_LDS(lcnt + e2, 1u);
            }
        }
    }
    if (ROUTER) { __syncthreads(); if (F.tid < 8) cnt[F.bid * 8 + F.tid] = lcnt[F.tid]; __syncthreads(); }
}
__device__ __forceinline__ void phase_rope_table(const Frame& F, const Args& A, const int* pos, float* rope) {
    for (int idx = F.bid * 512 + F.tid; idx < TH * 32; idx += F.G * 512) { const int t = idx >> 5, i = idx & 31;
        const float inv = powf(10000.0f, -(float)i / 32.0f);
        const float ang = (float)pos[t] * inv; float sn, cs; sincosf(ang, &sn, &cs);
        rope[(size_t)t * 64 + i] = cs; rope[(size_t)t * 64 + 32 + i] = sn; }
}
__device__ __forceinline__ void phase_final_norm(const Frame& F, const Args& A, float* x, const float* gain) {
    const int lane = F.lane;
    for (int m = F.gw; m < T; m += F.NGW) {
        float* xr = x + (size_t)m * D; f32x4 v[4]; float ss = 0.f;
#pragma unroll
        for (int j = 0; j < 4; ++j) { v[j] = *(const f32x4*)(xr + 4 * lane + 256 * j); ss += (v[j].x * v[j].x + v[j].y * v[j].y) + (v[j].z * v[j].z + v[j].w * v[j].w); }
        const float rstd = RSQRT(wave_sum(ss) * (1.0f / D) + EPS);
#pragma unroll
        for (int j = 0; j < 4; ++j) *(f32x4*)(xr + 4 * lane + 256 * j) = v[j] * rstd * *(const f32x4*)(gain + 4 * lane + 256 * j);
    }
}

__device__ __forceinline__ void phase_mla_prep(const Frame& F, const Args& A) {
    bf16* P = WSP(bf16, A_P); bf16* kr = WSP(bf16, M_KR); const float* rope = WSP(float, A_ROPE);
    const int lane = F.lane;
    for (int m = F.gw; m < TH; m += F.NGW) {
        bf16* pr = P + (size_t)m * PW; float sq = 0.f, skv = 0.f; f32x4 v[3];
#pragma unroll
        for (int j = 0; j < 3; ++j) { const int c = 4 * lane + 256 * j; v[j] = ld_bf16x4(pr + c); const float s = (v[j].x * v[j].x + v[j].y * v[j].y) + (v[j].z * v[j].z + v[j].w * v[j].w);
            if (c < 384) sq += s; else if (c < 640) skv += s; }
        sq = wave_sum(sq); skv = wave_sum(skv);
        const float rq = RSQRT(sq * (1.0f / 384.0f) + EPS), rkv = RSQRT(skv * (1.0f / 256.0f) + EPS);
#pragma unroll
        for (int j = 0; j < 3; ++j) { const int c = 4 * lane + 256 * j; if (c < 640) st_bf16x4(pr + c, v[j] * (c < 384 ? rq : rkv)); }
        if (lane < 32) { const float x1 = bf2f(pr[640 + lane]), x2 = bf2f(pr[672 + lane]), c = rope[(size_t)m * 64 + lane], s = rope[(size_t)m * 64 + 32 + lane];
            kr[(size_t)m * 64 + lane] = (bf16)f2bf(x1 * c - x2 * s); kr[(size_t)m * 64 + 32 + lane] = (bf16)f2bf(x2 * c + x1 * s); }
    }
}
__device__ __forceinline__ void phase_mla_q(const Frame& F, const Args& A) {
    pg8::Gemm g{WSP(bf16, A_P) + 0, WSP(bf16, W_UQ), PW, 384}; pg8::StaticOrder S; S.init(TH, 768, F.G, F.bid);
    EpiBf16 E{WSP(bf16, M_Q), 768, nullptr, 0}; pg8::gemm_phase(F.lds, g, S, E, F.tid);
}
struct EpiKV {
    static constexpr bool PERM = true, AFTER_DRAIN = false;
    bf16* KV; bf16* VT;
    __device__ __forceinline__ void operator()(const f32x4 (&acc)[2][2][4][2], const Unit& u, int wr, int wc, int fr, int fq) const {
        const int row0 = u.pm * 256 + wr * 64 + fr, col0 = wc * 32 + 8 * fq;
#pragma unroll
        for (int ai = 0; ai < 2; ++ai)
#pragma unroll
            for (int m = 0; m < 4; ++m) { const int row = row0 + ai * HALFT + m * 16;
                { const f32x4 v0 = acc[ai][0][m][0], v1 = acc[ai][0][m][1]; u32x4 w; w.x = pk2(v0[0], v0[1]); w.y = pk2(v0[2], v0[3]); w.z = pk2(v1[0], v1[1]); w.w = pk2(v1[2], v1[3]);
                  *(u32x4*)(KV + (size_t)row * 1024 + u.pn * 256 + col0) = w; }
                const int b = row / SEQ, t = row % SEQ; bf16* vt = VT + ((size_t)(b * 4 + u.pn) * 128 + col0) * SEQ + t;
#pragma unroll
                for (int n = 0; n < 2; ++n)
#pragma unroll
                    for (int j = 0; j < 4; ++j) vt[(size_t)(4 * n + j) * SEQ] = (bf16)f2bf(acc[ai][1][m][n][j]); }
    }
};
__device__ __forceinline__ void phase_mla_kv(const Frame& F, const Args& A) {
    pg8::Gemm g{WSP(bf16, A_P) + 384, WSP(bf16, W_UKV), PW, 256}; pg8::StaticOrder S; S.init(TH, 1024, F.G, F.bid);
    EpiKV E{WSP(bf16, M_KV), WSP(bf16, M_VT)}; pg8::gemm_phase(F.lds, g, S, E, F.tid);
}
constexpr int AT_KS = 200, AT_VS = 72;
constexpr int AT_KBYTES = 64 * AT_KS * 2, AT_VBYTES = 128 * AT_VS * 2;
__device__ __forceinline__ void phase_attention(const Frame& F, const Args& A) {
    const bf16* Q = WSP(bf16, M_Q); const bf16* KV = WSP(bf16, M_KV); const bf16* KR = WSP(bf16, M_KR); const bf16* VTg = WSP(bf16, M_VT); const float* rope = WSP(float, A_ROPE); bf16* Y = WSP(bf16, A_Y);
    const int lane = F.lane, w = F.wave, l15 = lane & 15, q4 = lane >> 4, tid = F.tid, grp = w >> 2, wq = w & 3;
    const int NQB = SEQ / 128, nunits = BH * 4 * NQB;
    const float sc2 = 0.07216878364870322f * 1.4426950408889634f;
    for (int unit = F.bid; unit < nunits; unit += F.G) {
        const int qb = NQB - 1 - (unit / (BH * 4)), bh = unit % (BH * 4), h = bh & 3, b = bh >> 2;
        const size_t t0 = (size_t)b * SEQ;
        bf16x8 qf[2][6];
#pragma unroll
        for (int f = 0; f < 2; ++f) { const size_t tq = t0 + qb * 128 + wq * 32 + 16 * f + l15;
#pragma unroll
            for (int ks = 0; ks < 6; ++ks) qf[f][ks] = *(const bf16x8*)(Q + tq * 768 + h * 192 + 32 * ks + 8 * q4);
            const bf16x8 a = qf[f][4], c2 = qf[f][5];
#pragma unroll
            for (int j = 0; j < 8; ++j) { const float x1 = bf2f((unsigned short)a[j]), x2 = bf2f((unsigned short)c2[j]), c = rope[tq * 64 + 8 * q4 + j], sn = rope[tq * 64 + 32 + 8 * q4 + j];
                qf[f][4][j] = (short)f2bf(x1 * c - x2 * sn); qf[f][5][j] = (short)f2bf(x2 * c + x1 * sn); } }
        f32x4 o[2][8];
#pragma unroll
        for (int f = 0; f < 2; ++f)
#pragma unroll
            for (int mb = 0; mb < 8; ++mb) o[f][mb] = (f32x4){0.f, 0.f, 0.f, 0.f};
        float mrow[2] = {-3.0e38f, -3.0e38f}, lrow[2] = {0.f, 0.f};
        const int qchunk = 2 * qb + (wq >> 1), ntile = 2 * qb + 2;
        u32x4 pk_[3], pv_[2];
        const int skey = tid >> 3, c8 = tid & 7;
        const int okv = skey * 1024 + 8 * c8, okr = skey * 64 + 8 * c8, ovt = skey * SEQ + 8 * c8;
        const bf16* kvb = KV + t0 * 1024 + h * 256; const bf16* krb = KR + t0 * 64; const bf16* vtb = VTg + (size_t)(b * 4 + h) * 128 * SEQ;
#define AT_LOAD(kt) do { const bf16* kv_ = kvb + (size_t)(kt) * 65536; const bf16* kr_ = krb + (size_t)(kt) * 4096; const bf16* vt_ = vtb + (size_t)(kt) * 64; \
            pk_[0] = *(const u32x4*)(kv_ + okv); pk_[1] = *(const u32x4*)(kv_ + okv + 64); pk_[2] = *(const u32x4*)(kr_ + okr); \
            pv_[0] = *(const u32x4*)(vt_ + ovt); pv_[1] = *(const u32x4*)(vt_ + ovt + 64 * SEQ); } while (0)
#define AT_STORE(bufi) do { LAS bf16* Ks_ = (LAS bf16*)(F.lds + (bufi) * (AT_KBYTES + AT_VBYTES)); LAS bf16* Vt_ = (LAS bf16*)((LAS unsigned char*)Ks_ + AT_KBYTES); \
            *(LAS u32x4*)(Ks_ + skey * AT_KS + 8 * c8) = pk_[0]; *(LAS u32x4*)(Ks_ + skey * AT_KS + 8 * c8 + 64) = pk_[1]; *(LAS u32x4*)(Ks_ + skey * AT_KS + 8 * c8 + 128) = pk_[2]; \
            *(LAS u32x4*)(Vt_ + skey * AT_VS + 8 * c8) = pv_[0]; *(LAS u32x4*)(Vt_ + (skey + 64) * AT_VS + 8 * c8) = pv_[1]; } while (0)
        __syncthreads();
        AT_LOAD(0); AT_STORE(0);
        __syncthreads();
        for (int kt = 0; kt < ntile; ++kt) {
            if (kt + 1 < ntile) AT_LOAD(kt + 1);
            if (kt <= qchunk) {
                const LAS bf16* Ks = (const LAS bf16*)(F.lds + (kt & 1) * (AT_KBYTES + AT_VBYTES)); const LAS bf16* Vt = (const LAS bf16*)((const LAS unsigned char*)Ks + AT_KBYTES);
                f32x4 st[2][2];
#pragma unroll
                for (int kb = 0; kb < 2; ++kb) { st[0][kb] = (f32x4){0.f, 0.f, 0.f, 0.f}; st[1][kb] = (f32x4){0.f, 0.f, 0.f, 0.f};
#pragma unroll
                    for (int ks = 0; ks < 6; ++ks) { const bf16x8 kf = *(const LAS bf16x8*)(Ks + (32 * grp + 16 * kb + l15) * AT_KS + 32 * ks + 8 * q4);
                        st[0][kb] = MFMA_BF16(kf, qf[0][ks], st[0][kb]); st[1][kb] = MFMA_BF16(kf, qf[1][ks], st[1][kb]); } }
                bf16x8 pb[2];
#pragma unroll
                for (int f = 0; f < 2; ++f) {
                    float mx = -3.0e38f;
#pragma unroll
                    for (int kb = 0; kb < 2; ++kb) { st[f][kb] = st[f][kb] * sc2; mx = fmaxf(mx, fmaxf(fmaxf(st[f][kb].x, st[f][kb].y), fmaxf(st[f][kb].z, st[f][kb].w))); }
                    mx = rows_max(mx);
                    const float mnew = fmaxf(mrow[f], mx), alpha = exp2f(mrow[f] - mnew); mrow[f] = mnew;
                    float ps = 0.f;
#pragma unroll
                    for (int kb = 0; kb < 2; ++kb)
#pragma unroll
                        for (int r = 0; r < 4; ++r) { const float p = exp2f(st[f][kb][r] - mnew); ps += p; pb[f][4 * kb + r] = (short)f2bf(p); }
                    lrow[f] = lrow[f] * alpha + ps;
#pragma unroll
                    for (int mb = 0; mb < 8; ++mb) o[f][mb] = o[f][mb] * alpha;
                }
#pragma unroll
                for (int mb = 0; mb < 8; ++mb) { const LAS bf16* vp = Vt + (16 * mb + l15) * AT_VS + 32 * grp + 4 * q4;
                    const bf16x4 v0 = *(const LAS bf16x4*)vp, v1 = *(const LAS bf16x4*)(vp + 16);
                    bf16x8 vf; vf[0] = v0[0]; vf[1] = v0[1]; vf[2] = v0[2]; vf[3] = v0[3]; vf[4] = v1[0]; vf[5] = v1[1]; vf[6] = v1[2]; vf[7] = v1[3];
                    o[0][mb] = MFMA_BF16(vf, pb[0], o[0][mb]); o[1][mb] = MFMA_BF16(vf, pb[1], o[1][mb]); }
            }
            if (kt + 1 < ntile) AT_STORE((kt + 1) & 1);
            __syncthreads();
        }
#undef AT_LOAD
#undef AT_STORE
#pragma unroll
        for (int f = 0; f < 2; ++f) lrow[f] = rows_sum(lrow[f]);
        LAS float* xo = (LAS float*)F.lds + (size_t)wq * (2 * 8 * 4 * 64 + 4 * 64);
        if (grp == 1) {
#pragma unroll
            for (int f = 0; f < 2; ++f) {
#pragma unroll
                for (int mb = 0; mb < 8; ++mb)
#pragma unroll
                    for (int r = 0; r < 4; ++r) xo[((f * 8 + mb) * 4 + r) * 64 + lane] = o[f][mb][r];
                xo[2 * 8 * 4 * 64 + f * 64 + lane] = mrow[f]; xo[2 * 8 * 4 * 64 + 128 + f * 64 + lane] = lrow[f]; } }
        __syncthreads();
        if (grp == 0) {
#pragma unroll
            for (int f = 0; f < 2; ++f) { const float m1 = xo[2 * 8 * 4 * 64 + f * 64 + lane], l1 = xo[2 * 8 * 4 * 64 + 128 + f * 64 + lane];
                const float m = fmaxf(mrow[f], m1), a0 = exp2f(mrow[f] - m), a1 = exp2f(m1 - m), inv = 1.0f / (lrow[f] * a0 + l1 * a1);
                const size_t tq = t0 + qb * 128 + wq * 32 + 16 * f + l15;
#pragma unroll
                for (int mb = 0; mb < 8; ++mb) { f32x4 v;
#pragma unroll
                    for (int r = 0; r < 4; ++r) v[r] = (o[f][mb][r] * a0 + xo[((f * 8 + mb) * 4 + r) * 64 + lane] * a1) * inv;
                    st_bf16x4(Y + tq * 512 + h * 128 + 16 * mb + 4 * q4, v); } } }
    }
    __syncthreads();
}

__device__ __forceinline__ f32x4 tile_bf(const LAS bf16* a, int lda, const LAS bf16* bt, int ldb, int K, f32x4 acc, int l15, int q4) {
    const LAS bf16* ap = a + l15 * lda + 8 * q4; const LAS bf16* bp = bt + l15 * ldb + 8 * q4;
#pragma unroll 4
    for (int ks = 0; ks < K / 32; ++ks) acc = MFMA_BF16(*(const LAS bf16x8*)(ap + 32 * ks), *(const LAS bf16x8*)(bp + 32 * ks), acc);
    return acc;
}
__device__ __forceinline__ f32x4 tile_mm(const LAS float* a, int lda, int ska, const LAS float* b, int ldb, int scb, int K, f32x4 acc, int l15, int q4);


__device__ __forceinline__ void diag_solve16(const LAS float* Lblk  , int ldl, LAS float* xcol  , int ldx) {
    float x[16];
#pragma unroll
    for (int i = 0; i < 16; ++i) x[i] = xcol[i * ldx];
#pragma unroll
    for (int g = 0; g < 4; ++g) {
        f32x4 av[4][4];
#pragma unroll
        for (int ii = 0; ii < 4; ++ii)
#pragma unroll
            for (int c4 = 0; c4 <= g; ++c4) av[ii][c4] = *(const LAS f32x4*)(Lblk + (4 * g + ii) * ldl + 4 * c4);
#pragma unroll
        for (int ii = 0; ii < 4; ++ii) { const int i = 4 * g + ii; float sacc = x[i];
#pragma unroll
            for (int jj = 0; jj < i; ++jj) sacc -= av[ii][jj >> 2][jj & 3] * x[jj];
            x[i] = sacc; }
    }
#pragma unroll
    for (int i = 1; i < 16; ++i) xcol[i * ldx] = x[i];
}
__device__ __forceinline__ void tri_solve64(const LAS float* L, int ldl, LAS float* X, int ldx, int nct, LAS float* scr, int w, int l15, int q4) {
    LAS float* DI = scr;
    if (w < 4) { LAS float* T = DI + w * 320; LAS float* S = scr + 4 * 320 + w * 320; const LAS float* N = L + 16 * w * ldl + 16 * w;
#pragma unroll
        for (int r = 0; r < 4; ++r) { const int i = 4 * q4 + r; T[i * 20 + l15] = (i == l15 ? 1.0f : 0.0f) - (l15 < i ? N[i * ldl + l15] : 0.0f); }
        { const f32x4 a = tile_mm(N, ldl, 1, N, ldl, 1, 16, (f32x4){0.f, 0.f, 0.f, 0.f}, l15, q4);
#pragma unroll
          for (int r = 0; r < 4; ++r) S[(4 * q4 + r) * 20 + l15] = a[r]; }
        WAVE_SYNC();
#pragma unroll
        for (int it = 0; it < 3; ++it) {
            { const f32x4 a = tile_mm(T, 20, 1, S, 20, 1, 16, (f32x4){0.f, 0.f, 0.f, 0.f}, l15, q4);
#pragma unroll
              for (int r = 0; r < 4; ++r) T[(4 * q4 + r) * 20 + l15] += a[r]; }
            if (it < 2) { const f32x4 a = tile_mm(S, 20, 1, S, 20, 1, 16, (f32x4){0.f, 0.f, 0.f, 0.f}, l15, q4);
#pragma unroll
                for (int r = 0; r < 4; ++r) S[(4 * q4 + r) * 20 + l15] = a[r]; }
            WAVE_SYNC();
        } }
    __syncthreads();
    for (int ct = w; ct < nct; ct += 8) { LAS float* Xc = X + 16 * ct;
#pragma unroll
        for (int rb = 0; rb < 4; ++rb) {
            if (rb > 0) { const f32x4 a = tile_mm(L + 16 * rb * ldl, ldl, 1, Xc, ldx, 1, 16 * rb, (f32x4){0.f, 0.f, 0.f, 0.f}, l15, q4);
#pragma unroll
                for (int r = 0; r < 4; ++r) Xc[(16 * rb + 4 * q4 + r) * ldx + l15] -= a[r];
                WAVE_SYNC(); }
            const f32x4 y = tile_mm(DI + rb * 320, 20, 1, Xc + 16 * rb * ldx, ldx, 1, 16, (f32x4){0.f, 0.f, 0.f, 0.f}, l15, q4);
#pragma unroll
            for (int r = 0; r < 4; ++r) Xc[(16 * rb + 4 * q4 + r) * ldx + l15] = y[r];
            WAVE_SYNC();
        } }
}
__device__ __forceinline__ void phase_rwkv_prep(const Frame& F, const Args& A, int layer) {
    const bf16* P = WSP(bf16, A_P); bf16* RKV = WSP(bf16, R_RKV); bf16* LIN = WSP(bf16, R_LIN); const float* mu = AIN(A, 8) + (size_t)layer * 1824;
    const int lane = F.lane;
    for (int m = F.gw; m < TH; m += F.NGW) {
        const bool first = (m % SEQ) == 0; const bf16* pr = P + (size_t)m * PW + C_RWKV;
#pragma unroll
        for (int j = 0; j < 8; ++j) { const int c = 4 * lane + 256 * j;
            if (c < 1824) { const f32x4 p = ld_bf16x4(pr + c); const f32x4 pv = first ? (f32x4){0.f, 0.f, 0.f, 0.f} : ld_bf16x4(pr - PW + c); const f32x4 muv = *(const f32x4*)(mu + c);
                f32x4 x = p + (pv - p) * muv;
                if (c < 1536) st_bf16x4(RKV + (size_t)m * 1536 + c, x);
                else { if (c < 1600) { x.x = tanhf_(x.x); x.y = tanhf_(x.y); x.z = tanhf_(x.z); x.w = tanhf_(x.w); }
                       else if (c >= 1664) { x.x = sigmoidf_(x.x); x.y = sigmoidf_(x.y); x.z = sigmoidf_(x.z); x.w = sigmoidf_(x.w); }
                       st_bf16x4(LIN + (size_t)m * 384 + (c - 1536), x); } } }
        if (lane < 24) st_bf16x4(LIN + (size_t)m * 384 + 288 + 4 * lane, (f32x4){0.f, 0.f, 0.f, 0.f});
    }
}
__device__ __forceinline__ void phase_rwkv_lora(const Frame& F, const Args& A) {
    pg8::Gemm g{WSP(bf16, R_LIN), WSP(bf16, W_LORA), 384, 384}; pg8::StaticOrder S; S.init(TH, 1536, F.G, (F.bid + F.G / 2) % F.G);
    EpiF32 E{WSP(float, R_LOUT), 1536}; pg8::gemm_phase(F.lds, g, S, E, F.tid);
}
constexpr int RS = 72;
constexpr int RREC_COMMON = 4 * 64 * RS * 2 + 256;
constexpr int RREC_T = 64 * 64 * 2;
constexpr int RREC_BYTES = RREC_COMMON + 3 * RREC_T;
static_assert(RREC_BYTES == 61696, "record size (see R_REC in the workspace map)");
static_assert(RREC_COMMON % 16 == 0, "record alignment");
__device__ __forceinline__ void phase_rwkv_r1(const Frame& F, const Args& A, int layer) {
    const bf16* RKV = WSP(bf16, R_RKV); const float* LOUT = WSP(float, R_LOUT); unsigned char* REC = WSP(unsigned char, R_REC);
    const float* w0 = AIN(A, 9) + layer * 512; const float* a0 = AIN(A, 11) + layer * 512; const float* k_k = AIN(A, 14) + layer * 512; const float* k_a = AIN(A, 15) + layer * 512;
    LAS bf16* kbar = (LAS bf16*)F.lds; LAS bf16* atil = kbar + 64 * RS; LAS bf16* khat = atil + 64 * RS; LAS bf16* rbar = khat + 64 * RS;
    LAS bf16* atT = rbar + 64 * RS; LAS bf16* khT = atT + 64 * RS; LAS bf16* vT = khT + 64 * RS; LAS bf16* Bm = vT + 64 * RS; LAS bf16* Em = Bm + 64 * RS;
    LAS float* Am = (LAS float*)(Em + 64 * RS);
    LAS float* X = Am + 64 * 68;
    LAS float* lam = Am;
    const int w = F.wave;
    const int nunits = BH * 8 * NCH;
    for (int unit = F.bid; unit < nunits; unit += F.G) {
        int tid = F.tid; OPAQUE_V(tid); const int lane = tid & 63, l15 = lane & 15, q4 = lane >> 4;
        const int c = unit % NCH, h = (unit / NCH) & 7, b = unit / (NCH * 8);
        const size_t tok0 = (size_t)b * SEQ + (size_t)c * 64;
        const int j = lane, cj = h * 64 + j;
        __syncthreads();
        float r_[8], km_[8], kk_[8], ka_[8], v_[8], L_[8];
        { const float w0c = w0[cj], a0c = a0[cj], kkc = k_k[cj], kac = k_a[cj]; float run = 0.f;
#pragma unroll
          for (int q = 0; q < 8; ++q) { const int t = 8 * w + q; const size_t tok = tok0 + t;
              const float r = bf2f(RKV[tok * 1536 + cj]), k = bf2f(RKV[tok * 1536 + 512 + cj]); v_[q] = bf2f(RKV[tok * 1536 + 1024 + cj]);
              const float wpre = LOUT[tok * 1536 + cj], apre = LOUT[tok * 1536 + 512 + cj];
              const float wl = -softplusf_(-(w0c + wpre)) - 0.5f, a = sigmoidf_(a0c + apre);
              const float kr = k * kkc, ss = wave_sum(kr * kr), kk = kr * RSQRT(ss + EPS);
              r_[q] = r; km_[q] = k * (1.0f + (a - 1.0f) * kac); kk_[q] = kk; ka_[q] = kk * a;
              run += -expf(wl); L_[q] = run; }
          lam[w * 64 + j] = run; }
        __syncthreads();
        { float base = 0.f, Lend = 0.f;
#pragma unroll
          for (int ww = 0; ww < 8; ++ww) { const float tw = lam[ww * 64 + j]; if (ww < w) base += tw; Lend += tw; }
#pragma unroll
          for (int q = 0; q < 8; ++q) { const int t = 8 * w + q; const float L = base + L_[q], Lm1 = q ? base + L_[q - 1] : base;
              const float eG = expf(L), eGi = expf(-L), eGm1 = expf(Lm1), eT = expf(Lend - L);
              const float kb = kk_[q] * eGm1;
              kbar[t * RS + j] = (bf16)f2bf(kb); X[t * 132 + j] = kb;
              atil[t * RS + j] = (bf16)f2bf(ka_[q] * eGi); khat[t * RS + j] = (bf16)f2bf(km_[q] * eGi); rbar[t * RS + j] = (bf16)f2bf(r_[q] * eG);
              atT[j * RS + t] = (bf16)f2bf(-ka_[q] * eT); khT[j * RS + t] = (bf16)f2bf(km_[q] * eT); vT[j * RS + t] = (bf16)f2bf(v_[q]); }
          if (w == 0) { float* gc = (float*)(REC + (size_t)unit * RREC_BYTES + 4 * 64 * RS * 2); gc[j] = expf(Lend); } }
        __syncthreads();
        unsigned char* rec = REC + (size_t)unit * RREC_BYTES;
        { const int which = w >> 1, tib = 2 * (w & 1);
          const LAS bf16* Aop = (which & 2) ? rbar : kbar; const LAS bf16* Bop = (which & 1) ? khat : atil;
          bf16x8 aF[2][2], bF[4][2];
#pragma unroll
          for (int t = 0; t < 2; ++t)
#pragma unroll
              for (int ks = 0; ks < 2; ++ks) aF[t][ks] = *(const LAS bf16x8*)(Aop + (16 * (tib + t) + l15) * RS + 8 * q4 + 32 * ks);
#pragma unroll
          for (int tj = 0; tj < 4; ++tj)
#pragma unroll
              for (int ks = 0; ks < 2; ++ks) bF[tj][ks] = *(const LAS bf16x8*)(Bop + (16 * tj + l15) * RS + 8 * q4 + 32 * ks);
          f32x4 acc[2][4];
#pragma unroll
          for (int t = 0; t < 2; ++t)
#pragma unroll
              for (int tj = 0; tj < 4; ++tj) { acc[t][tj] = MFMA_BF16(aF[t][0], bF[tj][0], ((f32x4){0.f, 0.f, 0.f, 0.f})); acc[t][tj] = MFMA_BF16(aF[t][1], bF[tj][1], acc[t][tj]); }
#pragma unroll
          for (int t = 0; t < 2; ++t)
#pragma unroll
              for (int tj = 0; tj < 4; ++tj)
#pragma unroll
                  for (int r = 0; r < 4; ++r) { const int i = 16 * (tib + t) + 4 * q4 + r, jj = 16 * tj + l15; const bool keep = (which & 2) ? (jj <= i) : (jj < i); const float v = keep ? acc[t][tj][r] : 0.f;
                      if (which == 0) Am[i * 68 + jj] = v; else if (which == 1) Bm[i * RS + jj] = (bf16)f2bf(v); else if (which == 3) Em[i * RS + jj] = (bf16)f2bf(v);
                      else ((bf16*)(rec + 2 * 64 * RS * 2))[i * RS + jj] = (bf16)f2bf(-v); } }
        __syncthreads();
        { const int tj = w & 3, pb = 6 * (w >> 2);
          bf16x8 bF[2]; f32x4 acc[6];
#pragma unroll
          for (int ks = 0; ks < 2; ++ks) bF[ks] = *(const LAS bf16x8*)(vT + (16 * tj + l15) * RS + 8 * q4 + 32 * ks);
#pragma unroll
          for (int pq = 0; pq < 6; ++pq) { const int pair = pb + pq, which = pair >> 2, ti = pair & 3; const LAS bf16* aop = which == 0 ? Bm : which == 1 ? Em : khT;
              const bf16x8 a0 = *(const LAS bf16x8*)(aop + (16 * ti + l15) * RS + 8 * q4), a1 = *(const LAS bf16x8*)(aop + (16 * ti + l15) * RS + 8 * q4 + 32);
              acc[pq] = MFMA_BF16(a0, bF[0], ((f32x4){0.f, 0.f, 0.f, 0.f})); acc[pq] = MFMA_BF16(a1, bF[1], acc[pq]); }
#pragma unroll
          for (int pq = 0; pq < 6; ++pq) { const int pair = pb + pq, which = pair >> 2, ti = pair & 3;
              if (which == 0) {
#pragma unroll
                  for (int r = 0; r < 4; ++r) X[(16 * ti + 4 * q4 + r) * 132 + 64 + 16 * tj + l15] = acc[pq][r]; }
              else st_bf16x4((bf16*)(rec + RREC_COMMON + which * RREC_T) + (16 * tj + l15) * 64 + 16 * ti + 4 * q4, acc[pq]); } }
        __syncthreads();
        tri_solve64(Am, 68, X, 132, 8, X + 64 * 132, w, l15, q4);
        __syncthreads();
        { const int t = tid >> 3, j0 = 8 * (tid & 7); float v[8];
#pragma unroll
          for (int q = 0; q < 8; ++q) v[q] = X[t * 132 + j0 + q];
          *(u32x4*)((bf16*)rec + t * RS + j0) = pack8(v);
          const int vv = tid >> 3, t0 = 8 * (tid & 7);
#pragma unroll
          for (int q = 0; q < 8; ++q) v[q] = X[(t0 + q) * 132 + 64 + vv];
          *(u32x4*)((bf16*)(rec + RREC_COMMON) + vv * 64 + t0) = pack8(v); }
        for (int e = tid; e < 64 * RS / 8; e += 512) { ((u32x4*)(rec + 64 * RS * 2))[e] = ((const LAS u32x4*)rbar)[e]; ((u32x4*)(rec + 3 * 64 * RS * 2))[e] = ((const LAS u32x4*)atT)[e]; }
    }
    __syncthreads();
}
constexpr int R2_BUF = RREC_COMMON;
__device__ __forceinline__ void phase_rwkv_r2(const Frame& F, const Args& A) {
    const unsigned char* REC = WSP(unsigned char, R_REC); float* RO = WSP(float, R_O);
    LAS unsigned char* buf0 = F.lds; LAS bf16* HT = (LAS bf16*)(F.lds + 2 * R2_BUF); LAS bf16* UT = HT + 2 * 64 * RS;
    const int w = F.wave, ti = w >> 1;
    const int nunits = BH * 8;
    constexpr int NCHK = R2_BUF / 16;
    for (int unit = F.bid; unit < nunits; unit += F.G) {
        int tid = F.tid; OPAQUE_V(tid); const int lane = tid & 63, l15 = lane & 15, q4 = lane >> 4;
        const int h = unit & 7, b = unit >> 3;
        __syncthreads();
        for (int e = tid; e < 2 * 64 * RS / 2; e += 512) ((LAS unsigned*)HT)[e] = 0u;
        f32x4 Hreg[2] = {(f32x4){0.f, 0.f, 0.f, 0.f}, (f32x4){0.f, 0.f, 0.f, 0.f}};
        u32x4 preA[5], preB[5]; u32x2 iniA[3][2], iniB[3][2], cur[3][2];
        const unsigned char* rec0 = REC + (size_t)((b * 8 + h) * NCH) * RREC_BYTES;
        const int tofs = ((16 * (2 * (w & 1)) + l15) * 64 + 16 * ti + 4 * q4) * 2;
#define R2_LOAD(S, recp) do { _Pragma("unroll") for (int q = 0; q < 5; ++q) { const int e = tid + 512 * q; if (e < NCHK) pre##S[q] = *(const u32x4*)((recp) + (size_t)e * 16); } \
            _Pragma("unroll") for (int mq = 0; mq < 3; ++mq) { ini##S[mq][0] = *(const u32x2*)((recp) + RREC_COMMON + mq * RREC_T + tofs); ini##S[mq][1] = *(const u32x2*)((recp) + RREC_COMMON + mq * RREC_T + tofs + 16 * 64 * 2); } } while (0)
#define R2_STORE(S, dst) do { _Pragma("unroll") for (int q = 0; q < 5; ++q) { const int e = tid + 512 * q; if (e < NCHK) *(LAS u32x4*)((dst) + (size_t)e * 16) = pre##S[q]; } } while (0)
#define R2_TAKE(S) do { _Pragma("unroll") for (int mq = 0; mq < 3; ++mq) { cur[mq][0] = ini##S[mq][0]; cur[mq][1] = ini##S[mq][1]; } } while (0)
        R2_LOAD(A, rec0); R2_STORE(A, buf0); R2_TAKE(A);
        if (NCH > 1) R2_LOAD(A, rec0 + (size_t)RREC_BYTES);
        __syncthreads();
#define R2_STEP(c, LS, SS) do { \
            LAS unsigned char* buf = buf0 + ((c) & 1) * R2_BUF; LAS unsigned char* nbuf = buf0 + (((c) + 1) & 1) * R2_BUF; \
            if ((c) + 2 < NCH) R2_LOAD(LS, rec0 + (size_t)((c) + 2) * RREC_BYTES); \
            const LAS bf16* KB = (const LAS bf16*)buf; const LAS bf16* RB = KB + 64 * RS; const LAS bf16* FMn = RB + 64 * RS; const LAS bf16* ATn = FMn + 64 * RS; \
            const LAS float* GC = (const LAS float*)(buf + 4 * 64 * RS * 2); \
            const LAS bf16* H0 = HT + ((c) & 1) * 64 * RS; LAS bf16* H1 = HT + (((c) + 1) & 1) * 64 * RS; \
              \
            bf16x8 hf[2][2], uf[2][2], af[2]; \
            _Pragma("unroll") for (int t2 = 0; t2 < 2; ++t2) _Pragma("unroll") for (int ks = 0; ks < 2; ++ks) hf[t2][ks] = *(const LAS bf16x8*)(H0 + (16 * (2 * (w & 1) + t2) + l15) * RS + 8 * q4 + 32 * ks); \
            _Pragma("unroll") for (int ks = 0; ks < 2; ++ks) af[ks] = *(const LAS bf16x8*)(KB + (16 * ti + l15) * RS + 8 * q4 + 32 * ks); \
            _Pragma("unroll") for (int t2 = 0; t2 < 2; ++t2) { const int tj = 2 * (w & 1) + t2; \
                f32x4 u = (f32x4){bf2f(cur[0][t2].x & 0xffffu), bf2f(cur[0][t2].x >> 16), bf2f(cur[0][t2].y & 0xffffu), bf2f(cur[0][t2].y >> 16)}; \
                u = MFMA_BF16(af[0], hf[t2][0], u); u = MFMA_BF16(af[1], hf[t2][1], u); \
                u32x2 pk; pk.x = pk2(u[0], u[1]); pk.y = pk2(u[2], u[3]); *(LAS u32x2*)(UT + (16 * tj + l15) * RS + 16 * ti + 4 * q4) = pk; } \
            __syncthreads(); \
            _Pragma("unroll") for (int t2 = 0; t2 < 2; ++t2) _Pragma("unroll") for (int ks = 0; ks < 2; ++ks) uf[t2][ks] = *(const LAS bf16x8*)(UT + (16 * (2 * (w & 1) + t2) + l15) * RS + 8 * q4 + 32 * ks); \
            { bf16x8 rf[2], ff[2], tf[2]; \
              _Pragma("unroll") for (int ks = 0; ks < 2; ++ks) { rf[ks] = *(const LAS bf16x8*)(RB + (16 * ti + l15) * RS + 8 * q4 + 32 * ks); ff[ks] = *(const LAS bf16x8*)(FMn + (16 * ti + l15) * RS + 8 * q4 + 32 * ks); tf[ks] = *(const LAS bf16x8*)(ATn + (16 * ti + l15) * RS + 8 * q4 + 32 * ks); } \
              _Pragma("unroll") for (int t2 = 0; t2 < 2; ++t2) { const int tj = 2 * (w & 1) + t2; \
                f32x4 o = (f32x4){bf2f(cur[1][t2].x & 0xffffu), bf2f(cur[1][t2].x >> 16), bf2f(cur[1][t2].y & 0xffffu), bf2f(cur[1][t2].y >> 16)}; \
                o = MFMA_BF16(rf[0], hf[t2][0], o); o = MFMA_BF16(rf[1], hf[t2][1], o); o = MFMA_BF16(ff[0], uf[t2][0], o); o = MFMA_BF16(ff[1], uf[t2][1], o); \
                _Pragma("unroll") for (int r = 0; r < 4; ++r) RO[((size_t)b * SEQ + (size_t)(c) * 64 + 16 * ti + 4 * q4 + r) * 512 + h * 64 + 16 * tj + l15] = o[r]; \
                const f32x4 kv = (f32x4){bf2f(cur[2][t2].x & 0xffffu), bf2f(cur[2][t2].x >> 16), bf2f(cur[2][t2].y & 0xffffu), bf2f(cur[2][t2].y >> 16)}; \
                _Pragma("unroll") for (int r = 0; r < 4; ++r) Hreg[t2][r] = Hreg[t2][r] * GC[16 * ti + 4 * q4 + r] + kv[r]; \
                Hreg[t2] = MFMA_BF16(tf[0], uf[t2][0], Hreg[t2]); Hreg[t2] = MFMA_BF16(tf[1], uf[t2][1], Hreg[t2]); \
                u32x2 pk; pk.x = pk2(Hreg[t2][0], Hreg[t2][1]); pk.y = pk2(Hreg[t2][2], Hreg[t2][3]); *(LAS u32x2*)(H1 + (16 * tj + l15) * RS + 16 * ti + 4 * q4) = pk; } } \
            if ((c) + 1 < NCH) { R2_STORE(SS, nbuf); R2_TAKE(SS); } \
            __syncthreads(); } while (0)
        for (int c = 0; c < NCH; c += 2) { R2_STEP(c, B, A); R2_STEP(c + 1, A, B); }
#undef R2_STEP
#undef R2_STORE
#undef R2_TAKE
#undef R2_LOAD
    }
    __syncthreads();
}
__device__ __forceinline__ void phase_rwkv_post(const Frame& F, const Args& A, int layer) {
    const bf16* RKV = WSP(bf16, R_RKV); const float* LOUT = WSP(float, R_LOUT); const float* RO = WSP(float, R_O); bf16* Y = WSP(bf16, A_Y) + (size_t)1 * TH * 512;
    const float* a0 = AIN(A, 11) + layer * 512; const float* k_a = AIN(A, 15) + layer * 512; const float* r_k = AIN(A, 16) + layer * 512; const float* ln_w = AIN(A, 17) + layer * 512; const float* ln_b = AIN(A, 18) + layer * 512;
    const int lane = F.lane, c0 = 8 * lane;
    for (int m = F.gw; m < TH; m += F.NGW) {
        float o[8], r[8], k[8], v[8], ap[8], g[8];
        { const f32x4 a = *(const f32x4*)(RO + (size_t)m * 512 + c0), b2 = *(const f32x4*)(RO + (size_t)m * 512 + c0 + 4); o[0] = a.x; o[1] = a.y; o[2] = a.z; o[3] = a.w; o[4] = b2.x; o[5] = b2.y; o[6] = b2.z; o[7] = b2.w; }
#pragma unroll
        for (int hh = 0; hh < 2; ++hh) { const f32x4 rv = ld_bf16x4(RKV + (size_t)m * 1536 + c0 + 4 * hh), kv = ld_bf16x4(RKV + (size_t)m * 1536 + 512 + c0 + 4 * hh), vv = ld_bf16x4(RKV + (size_t)m * 1536 + 1024 + c0 + 4 * hh);
            const f32x4 av = *(const f32x4*)(LOUT + (size_t)m * 1536 + 512 + c0 + 4 * hh), gv = *(const f32x4*)(LOUT + (size_t)m * 1536 + 1024 + c0 + 4 * hh);
#pragma unroll
            for (int q = 0; q < 4; ++q) { r[4 * hh + q] = rv[q]; k[4 * hh + q] = kv[q]; v[4 * hh + q] = vv[q]; ap[4 * hh + q] = av[q]; g[4 * hh + q] = gv[q]; } }
        float bon = 0.f, sm = 0.f;
#pragma unroll
        for (int q = 0; q < 8; ++q) { const float a = sigmoidf_(a0[c0 + q] + ap[q]); const float km = k[q] * (1.0f + (a - 1.0f) * k_a[c0 + q]); bon += r[q] * km * r_k[c0 + q]; sm += o[q]; }
        bon = red_sum<8>(bon); sm = red_sum<8>(sm);
        const float mean = sm * (1.0f / 64.0f); float vs = 0.f;
#pragma unroll
        for (int q = 0; q < 8; ++q) { const float d = o[q] - mean; vs += d * d; }
        vs = red_sum<8>(vs);
        const float rstd = RSQRT(vs * (1.0f / 64.0f) + 64e-5f);
        float y[8];
#pragma unroll
        for (int q = 0; q < 8; ++q) y[q] = ((o[q] - mean) * rstd * ln_w[c0 + q] + ln_b[c0 + q] + bon * v[q]) * g[q];
        u32x4 wv; wv.x = pk2(y[0], y[1]); wv.y = pk2(y[2], y[3]); wv.z = pk2(y[4], y[5]); wv.w = pk2(y[6], y[7]);
        *(u32x4*)(Y + (size_t)m * 512 + c0) = wv;
    }
}

__device__ __forceinline__ void conv8x8(const bf16* src, int tl0  , const float* w  , int wld, const float* bias, float (&out)[8][8]) {
    float x[11][8];
#pragma unroll
    for (int i = 0; i < 11; ++i) { const int tl = tl0 - 3 + i;
        if (tl >= 0) { const u32x4 v = *(const u32x4*)(src + (ptrdiff_t)(i - 3) * PW);
            x[i][0] = bf2f(v.x & 0xffffu); x[i][1] = bf2f(v.x >> 16); x[i][2] = bf2f(v.y & 0xffffu); x[i][3] = bf2f(v.y >> 16); x[i][4] = bf2f(v.z & 0xffffu); x[i][5] = bf2f(v.z >> 16); x[i][6] = bf2f(v.w & 0xffffu); x[i][7] = bf2f(v.w >> 16); }
        else {
#pragma unroll
            for (int ch = 0; ch < 8; ++ch) x[i][ch] = 0.f; } }
    float wv[4][8], bv[8];
#pragma unroll
    for (int j = 0; j < 4; ++j) { const f32x4 a = *(const f32x4*)(w + j * wld), b = *(const f32x4*)(w + j * wld + 4); wv[j][0] = a.x; wv[j][1] = a.y; wv[j][2] = a.z; wv[j][3] = a.w; wv[j][4] = b.x; wv[j][5] = b.y; wv[j][6] = b.z; wv[j][7] = b.w; }
    if (bias) { const f32x4 a = *(const f32x4*)bias, b = *(const f32x4*)(bias + 4); bv[0] = a.x; bv[1] = a.y; bv[2] = a.z; bv[3] = a.w; bv[4] = b.x; bv[5] = b.y; bv[6] = b.z; bv[7] = b.w; }
    else {
#pragma unroll
        for (int ch = 0; ch < 8; ++ch) bv[ch] = 0.f; }
#pragma unroll
    for (int i = 0; i < 8; ++i)
#pragma unroll
        for (int ch = 0; ch < 8; ++ch) { const float a = bv[ch] + wv[0][ch] * x[i][ch] + wv[1][ch] * x[i + 1][ch] + wv[2][ch] * x[i + 2][ch] + wv[3][ch] * x[i + 3][ch]; out[i][ch] = a * fast_rcp(1.0f + fast_exp(-a)); }
}
constexpr int SB = 136;
constexpr int SC_IMG = 64 * SB * 2;
__device__ __forceinline__ void phase_ssd_s1(const Frame& F, const Args& A, int layer) {
    const bf16* P = WSP(bf16, A_P); bf16* ST = WSP(bf16, S_ST); float* YD = WSP(float, S_YD); unsigned char* SCB = WSP(unsigned char, S_C); float* AC = WSP(float, S_AC);
    const float* cw = AIN(A, 23) + (size_t)layer * 4 * 1024; const float* cb = AIN(A, 24) + layer * 1024; const float* dtb = AIN(A, 25) + layer * 8; const float* a_log = AIN(A, 26) + layer * 8; const float* dsk = AIN(A, 27) + layer * 8;
    LAS bf16* Bt_ = (LAS bf16*)F.lds; LAS bf16* Ct_ = Bt_ + 64 * SB; LAS bf16* BT = Ct_ + 64 * SB; LAS bf16* xT = BT + 128 * RS;
    LAS bf16* Mb = xT + 4 * 64 * RS; LAS bf16* xdT = Mb + 2 * 64 * RS; LAS float* dt = (LAS float*)(xdT + 2 * 64 * RS); LAS float* ac = dt + 256;
    const int w = F.wave;
    const int nunits = BH * NCH * 2;
    for (int unit = F.bid; unit < nunits; unit += F.G) {
        int tid = F.tid; OPAQUE_V(tid); const int lane = tid & 63, l15 = lane & 15, q4 = lane >> 4;
        const int g = unit & 1, c = (unit >> 1) % NCH, b = unit / (2 * NCH);
        const size_t tok0 = (size_t)b * SEQ + (size_t)c * 64;
        __syncthreads();
        {
            const int cg = tid & 63, rb = tid >> 6;
            const int cidx = cg < 32 ? g * 256 + 8 * cg : cg < 48 ? 512 + g * 128 + 8 * (cg - 32) : 768 + g * 128 + 8 * (cg - 48);
            float o[8][8];
            conv8x8(P + (tok0 + 8 * rb) * PW + C_SSD + 512 + cidx, c * 64 + 8 * rb, cw + cidx, 1024, cb + cidx, o);
            if (cg < 32) {
                const int hh = cg >> 3, p0 = 8 * (cg & 7);
#pragma unroll
                for (int ch = 0; ch < 8; ++ch) { float col[8];
#pragma unroll
                    for (int i = 0; i < 8; ++i) col[i] = o[i][ch];
                    *(LAS u32x4*)(xT + (hh * 64 + p0 + ch) * RS + 8 * rb) = pack8(col); }
            } else if (cg < 48) {
                const int n0 = 8 * (cg - 32);
#pragma unroll
                for (int i = 0; i < 8; ++i) *(LAS u32x4*)(Bt_ + (8 * rb + i) * SB + n0) = pack8(o[i]);
#pragma unroll
                for (int ch = 0; ch < 8; ++ch) { float col[8];
#pragma unroll
                    for (int i = 0; i < 8; ++i) col[i] = o[i][ch];
                    *(LAS u32x4*)(BT + (n0 + ch) * RS + 8 * rb) = pack8(col); }
            } else { const int n0 = 8 * (cg - 48);
#pragma unroll
                for (int i = 0; i < 8; ++i) *(LAS u32x4*)(Ct_ + (8 * rb + i) * SB + n0) = pack8(o[i]); }
        }
        if (tid < 256) { const int hh = tid >> 6, h = 4 * g + hh; const float d = softplusf_(bf2f(P[(tok0 + lane) * PW + C_SSD + 1536 + h]) + dtb[h]); float a = -expf(a_log[h]) * d;
#pragma unroll
            for (int o = 1; o < 64; o <<= 1) { const float t = __shfl_up(a, o); if (lane >= o) a += t; }
            dt[tid] = d; ac[tid] = a; AC[(tok0 + lane) * 8 + h] = a; }
        __syncthreads();
        { unsigned char* dst = SCB + (size_t)unit * SC_IMG; for (int e = tid; e < SC_IMG / 16; e += 512) ((u32x4*)dst)[e] = ((const LAS u32x4*)Ct_)[e]; }
        f32x4 cbt[2];
#pragma unroll
        for (int tt = 0; tt < 2; ++tt) { const int tile = w * 2 + tt, ti = tile >> 2, tj = tile & 3; cbt[tt] = (f32x4){0.f, 0.f, 0.f, 0.f};
            if (tj <= ti) cbt[tt] = tile_bf(Ct_ + 16 * ti * SB, SB, Bt_ + 16 * tj * SB, SB, 128, cbt[tt], l15, q4); }
        for (int hh = 0; hh < 4; ++hh) { const int h = 4 * g + hh; LAS bf16* M = Mb + (hh & 1) * 64 * RS; LAS bf16* xd = xdT + (hh & 1) * 64 * RS; const LAS float* dth = dt + hh * 64; const LAS float* ach = ac + hh * 64;
#pragma unroll
            for (int tt = 0; tt < 2; ++tt) { const int tile = w * 2 + tt, ti = tile >> 2, tj = tile & 3;
#pragma unroll
                for (int r = 0; r < 4; ++r) { const int l = 16 * ti + 4 * q4 + r, s = 16 * tj + l15; M[l * RS + s] = (bf16)f2bf((s <= l) ? cbt[tt][r] * expf(ach[l] - ach[s]) * dth[s] : 0.f); } }
            { const int p = tid >> 3, l0 = 8 * (tid & 7); const u32x4 v = *(const LAS u32x4*)(xT + (hh * 64 + p) * RS + l0); const float a63 = ach[63]; float xv[8] = {bf2f(v.x & 0xffffu), bf2f(v.x >> 16), bf2f(v.y & 0xffffu), bf2f(v.y >> 16), bf2f(v.z & 0xffffu), bf2f(v.z >> 16), bf2f(v.w & 0xffffu), bf2f(v.w >> 16)};
#pragma unroll
              for (int i = 0; i < 8; ++i) xv[i] *= dth[l0 + i] * expf(a63 - ach[l0 + i]);
              *(LAS u32x4*)(xd + p * RS + l0) = pack8(xv); }
            __syncthreads();
#pragma unroll
            for (int tt = 0; tt < 2; ++tt) { const int tile = w * 2 + tt, ti = tile >> 2, tj = tile & 3;
                const f32x4 acc = tile_bf(M + 16 * ti * RS, RS, xT + (hh * 64 + 16 * tj) * RS, RS, 64, (f32x4){0.f, 0.f, 0.f, 0.f}, l15, q4);
                const f32x4 xs = ld_bf16x4((const bf16*)(xT + (hh * 64 + 16 * tj + l15) * RS + 16 * ti + 4 * q4));
#pragma unroll
                for (int r = 0; r < 4; ++r) YD[(tok0 + 16 * ti + 4 * q4 + r) * 512 + h * 64 + 16 * tj + l15] = acc[r] + dsk[h] * xs[r]; }
            bf16* st = ST + ((size_t)((b * NCH + c) * 8 + h)) * 64 * 128;
#pragma unroll
            for (int tt = 0; tt < 4; ++tt) { const int tile = w * 4 + tt, ti = tile >> 2, tj = tile & 3;
                const f32x4 acc = tile_bf(BT + 16 * ti * RS, RS, xd + 16 * tj * RS, RS, 64, (f32x4){0.f, 0.f, 0.f, 0.f}, l15, q4);
                st_bf16x4(st + (16 * tj + l15) * 128 + 16 * ti + 4 * q4, acc); }
        }
    }
    __syncthreads();
}
__device__ __forceinline__ void phase_ssd_s23(const Frame& F, const Args& A) {
    const bf16* ST = WSP(bf16, S_ST); float* YO = WSP(float, S_YO); const unsigned char* SCB = WSP(unsigned char, S_C); const float* AC = WSP(float, S_AC);
    LAS bf16* Cimg = (LAS bf16*)F.lds; LAS bf16* Hb = Cimg + 2 * 64 * SB;
    const int w = F.wave;
    const int nunits = BH * 8 * 4;
    constexpr int NCK = SC_IMG / 16;
    for (int unit = F.bid; unit < nunits; unit += F.G) {
        int tid = F.tid; OPAQUE_V(tid); const int lane = tid & 63, l15 = lane & 15, q4 = lane >> 4, hp = tid >> 5, hn = 4 * (tid & 31);
        const int ps = unit & 3, h = (unit >> 2) & 7, b = unit >> 5, g = h >> 2;
        __syncthreads();
        f32x4 Hr = (f32x4){0.f, 0.f, 0.f, 0.f};
        u32x4 preA[3], preB[3]; u32x2 pstA, pstB, stc; float eaA[5], eaB[5], eac[5];
        const size_t tokb = (size_t)b * SEQ;
#define S23_LOAD(S, cc) do { const unsigned char* src_ = SCB + (size_t)((b * NCH + (cc)) * 2 + g) * SC_IMG; \
            _Pragma("unroll") for (int q = 0; q < 3; ++q) { const int e = tid + 512 * q; if (e < NCK) pre##S[q] = *(const u32x4*)(src_ + (size_t)e * 16); } \
            pst##S = *(const u32x2*)(ST + ((size_t)((b * NCH + (cc)) * 8 + h)) * 8192 + (16 * ps + hp) * 128 + hn); \
            _Pragma("unroll") for (int r = 0; r < 4; ++r) ea##S[r] = AC[(tokb + (size_t)(cc) * 64 + 16 * (w & 3) + 4 * q4 + r) * 8 + h]; \
            ea##S[4] = AC[(tokb + (size_t)(cc) * 64 + 63) * 8 + h]; } while (0)
#define S23_STORE(S, dst) do { _Pragma("unroll") for (int q = 0; q < 3; ++q) { const int e = tid + 512 * q; if (e < NCK) ((LAS u32x4*)(dst))[e] = pre##S[q]; } } while (0)
#define S23_TAKE(S) do { stc = pst##S; _Pragma("unroll") for (int r = 0; r < 5; ++r) eac[r] = ea##S[r]; } while (0)
        S23_LOAD(A, 0); S23_STORE(A, Cimg); S23_TAKE(A);
        if (NCH > 1) S23_LOAD(A, 1);
#define S23_STEP(c, LS, SS) do { \
            const size_t tok0 = tokb + (size_t)(c) * 64; \
            if ((c) + 2 < NCH) S23_LOAD(LS, (c) + 2); \
            st_bf16x4((bf16*)(Hb + hp * SB + hn), Hr); \
            __syncthreads(); \
            if (w < 4) { const LAS bf16* Ci = Cimg + ((c) & 1) * 64 * SB; \
                const f32x4 acc = tile_bf(Ci + 16 * w * SB, SB, Hb, SB, 128, (f32x4){0.f, 0.f, 0.f, 0.f}, l15, q4); \
                _Pragma("unroll") for (int r = 0; r < 4; ++r) { const size_t tok = tok0 + 16 * w + 4 * q4 + r; YO[tok * 512 + h * 64 + 16 * ps + l15] = acc[r] * expf(eac[r]); } } \
            { const float dec = expf(eac[4]); Hr.x = dec * Hr.x + bf2f(stc.x & 0xffffu); Hr.y = dec * Hr.y + bf2f(stc.x >> 16); Hr.z = dec * Hr.z + bf2f(stc.y & 0xffffu); Hr.w = dec * Hr.w + bf2f(stc.y >> 16); } \
            if ((c) + 1 < NCH) { S23_STORE(SS, Cimg + (((c) + 1) & 1) * 64 * SB); S23_TAKE(SS); } \
            __syncthreads(); } while (0)
        for (int c = 0; c < NCH; c += 2) { S23_STEP(c, B, A); S23_STEP(c + 1, A, B); }
#undef S23_STEP
#undef S23_TAKE
#undef S23_STORE
#undef S23_LOAD
    }
    __syncthreads();
}
__device__ __forceinline__ void phase_ssd_s4(const Frame& F, const Args& A, int layer) {
    const float* YD = WSP(float, S_YD); const float* YO = WSP(float, S_YO); const bf16* P = WSP(bf16, A_P); bf16* Y = WSP(bf16, A_Y) + (size_t)3 * TH * 512; const float* nw = AIN(A, 28) + layer * 512;
    const int lane = F.lane, c0 = 8 * lane;
    for (int m = F.gw; m < TH; m += F.NGW) {
        const f32x4 a = *(const f32x4*)(YD + (size_t)m * 512 + c0) + *(const f32x4*)(YO + (size_t)m * 512 + c0), b2 = *(const f32x4*)(YD + (size_t)m * 512 + c0 + 4) + *(const f32x4*)(YO + (size_t)m * 512 + c0 + 4);
        const f32x4 z0 = ld_bf16x4(P + (size_t)m * PW + C_SSD + c0), z1 = ld_bf16x4(P + (size_t)m * PW + C_SSD + c0 + 4);
        float y[8] = {a.x * siluf_(z0.x), a.y * siluf_(z0.y), a.z * siluf_(z0.z), a.w * siluf_(z0.w), b2.x * siluf_(z1.x), b2.y * siluf_(z1.y), b2.z * siluf_(z1.z), b2.w * siluf_(z1.w)};
        float ss = 0.f;
#pragma unroll
        for (int q = 0; q < 8; ++q) ss += y[q] * y[q];
        ss = red_sum<32>(ss);
        const float rstd = RSQRT(ss * (1.0f / 256.0f) + EPS);
#pragma unroll
        for (int q = 0; q < 8; ++q) y[q] = y[q] * rstd * nw[c0 + q];
        u32x4 wv; wv.x = pk2(y[0], y[1]); wv.y = pk2(y[2], y[3]); wv.z = pk2(y[4], y[5]); wv.w = pk2(y[6], y[7]);
        *(u32x4*)(Y + (size_t)m * 512 + c0) = wv;
    }
}

__device__ __forceinline__ f32x4 tile_mm(const LAS float* a, int lda, int ska, const LAS float* b, int ldb, int scb, int K, f32x4 acc, int l15, int q4) {
    const LAS float* ap = a + l15 * lda + q4 * ska; const LAS float* bp = b + q4 * ldb + l15 * scb;
#pragma unroll 8
    for (int ks = 0; ks < K / 4; ++ks) acc = MFMA_F32(ap[ks * 4 * ska], bp[ks * 4 * ldb], acc);
    return acc;
}
constexpr int GS = 132, GS2 = 68;
constexpr int GR_W = 0, GR_QH = 64 * 136 * 2, GR_KT = 2 * 64 * 136 * 2, GR_QK = GR_KT + 128 * 72 * 2, GR_GL = GR_QK + 64 * 72 * 2, GR_COMMON = GR_GL + 16, GR_UT = 128 * 64 * 2, GR_BYTES = GR_COMMON + GR_UT;
static_assert(GR_BYTES == 78864 && GR_COMMON % 16 == 0, "GDN record");
constexpr int GX = 264;
__device__ __forceinline__ void phase_gdn_g1(const Frame& F, const Args& A, int layer) {
    const bf16* P = WSP(bf16, A_P); unsigned char* CHR = WSP(unsigned char, G_CH);
    const float* convw = AIN(A, 19) + (size_t)layer * 4 * 1536; const float* a_log = AIN(A, 20) + layer * 4; const float* dtb = AIN(A, 21) + layer * 4;
    LAS bf16* qb = (LAS bf16*)F.lds; LAS bf16* kb = qb + 64 * SB; LAS bf16* qkimg = kb + 64 * SB;
    LAS float* X = (LAS float*)(qkimg + 64 * RS); LAS float* Lm = X + 64 * GX; LAS float* ssq = Lm + 64 * GS2;
    LAS float* beta = ssq + 2 * 64 * 16; LAS float* gc = beta + 64; LAS float* egc = gc + 64; LAS float* inorm = egc + 64;
    const int w = F.wave;
    const int nunits = BH * 4 * NCH;
    for (int unit = F.bid; unit < nunits; unit += F.G) {
        int tid = F.tid; OPAQUE_V(tid); const int lane = tid & 63, l15 = lane & 15, q4 = lane >> 4;
        const int c = unit % NCH, h = (unit / NCH) & 3, b = unit / (NCH * 4);
        const size_t tok0 = (size_t)b * SEQ + (size_t)c * 64;
        unsigned char* rec = CHR + (size_t)unit * GR_BYTES;
        __syncthreads();
        const int rb = tid / 48, pc = tid % 48, part = pc >> 4, cgl = pc & 15;
        float o[8][8];
        if (tid < 384) { const int col = part * 512 + h * 128 + 8 * cgl;
            conv8x8(P + (tok0 + 8 * rb) * PW + C_GDN + col, c * 64 + 8 * rb, convw + col, 1536, nullptr, o);
            if (part < 2) {
#pragma unroll
                for (int i = 0; i < 8; ++i) { float sacc = 0.f;
#pragma unroll
                    for (int ch = 0; ch < 8; ++ch) sacc += o[i][ch] * o[i][ch];
                    ssq[(part * 64 + 8 * rb + i) * 16 + cgl] = sacc; } } }
        if (w == 7) { const size_t tok = tok0 + lane; beta[lane] = sigmoidf_(bf2f(P[tok * PW + C_GDN + 1536 + h]));
            float g = -expf(a_log[h]) * softplusf_(bf2f(P[tok * PW + C_GDN + 1540 + h]) + dtb[h]);
#pragma unroll
            for (int o2 = 1; o2 < 64; o2 <<= 1) { const float t = __shfl_up(g, o2); if (lane >= o2) g += t; }
            gc[lane] = g; egc[lane] = expf(g); }
        __syncthreads();
        if (tid < 128) { float sacc = 0.f;
#pragma unroll
            for (int i = 0; i < 16; ++i) sacc += ssq[tid * 16 + i];
            inorm[tid] = (tid < 64 ? 0.08838834764831845f : 1.0f) * RSQRT(sacc + EPS); }
        __syncthreads();
        if (tid < 384) {
#pragma unroll
            for (int i = 0; i < 8; ++i) { const int l = 8 * rb + i;
                if (part < 2) { const float sc = inorm[part * 64 + l]; float v[8];
#pragma unroll
                    for (int ch = 0; ch < 8; ++ch) v[ch] = o[i][ch] * sc;
                    *(LAS u32x4*)((part ? kb : qb) + l * SB + 8 * cgl) = pack8(v); }
                else { const float bl = beta[l]; *(LAS f32x4*)(X + l * GX + 8 * cgl) = (f32x4){o[i][0] * bl, o[i][1] * bl, o[i][2] * bl, o[i][3] * bl}; *(LAS f32x4*)(X + l * GX + 8 * cgl + 4) = (f32x4){o[i][4] * bl, o[i][5] * bl, o[i][6] * bl, o[i][7] * bl}; } } }
        __syncthreads();
        { const int which = w >> 2, ti = w & 3; const LAS bf16* Aop = which ? qb : kb;
          bf16x8 aF[4]; f32x4 acc[4];
#pragma unroll
          for (int ks = 0; ks < 4; ++ks) aF[ks] = *(const LAS bf16x8*)(Aop + (16 * ti + l15) * SB + 8 * q4 + 32 * ks);
#pragma unroll
          for (int tj = 0; tj < 4; ++tj) { acc[tj] = (f32x4){0.f, 0.f, 0.f, 0.f};
#pragma unroll
              for (int ks = 0; ks < 4; ++ks) acc[tj] = MFMA_BF16(aF[ks], *(const LAS bf16x8*)(kb + (16 * tj + l15) * SB + 8 * q4 + 32 * ks), acc[tj]); }
#pragma unroll
          for (int tj = 0; tj < 4; ++tj)
#pragma unroll
              for (int r = 0; r < 4; ++r) { const int i = 16 * ti + 4 * q4 + r, j = 16 * tj + l15; float v = 0.f;
                  if (which ? (j <= i) : (j < i)) v = acc[tj][r] * expf(gc[i] - gc[j]) * (which ? 1.0f : beta[i]);
                  if (which) qkimg[i * RS + j] = (bf16)f2bf(v); else Lm[i * GS2 + j] = v; } }
        { const float glast = gc[63];
          for (int e = tid; e < 64 * 16; e += 512) { const int l = e >> 4, d0 = 8 * (e & 15); const u32x4 kv = *(const LAS u32x4*)(kb + l * SB + d0), qv = *(const LAS u32x4*)(qb + l * SB + d0);
              const float kf[8] = {bf2f(kv.x & 0xffffu), bf2f(kv.x >> 16), bf2f(kv.y & 0xffffu), bf2f(kv.y >> 16), bf2f(kv.z & 0xffffu), bf2f(kv.z >> 16), bf2f(kv.w & 0xffffu), bf2f(kv.w >> 16)};
              float qf[8] = {bf2f(qv.x & 0xffffu), bf2f(qv.x >> 16), bf2f(qv.y & 0xffffu), bf2f(qv.y >> 16), bf2f(qv.z & 0xffffu), bf2f(qv.z >> 16), bf2f(qv.w & 0xffffu), bf2f(qv.w >> 16)};
              const float sc = beta[l] * egc[l], eg = egc[l];
              *(LAS f32x4*)(X + l * GX + 128 + d0) = (f32x4){kf[0] * sc, kf[1] * sc, kf[2] * sc, kf[3] * sc}; *(LAS f32x4*)(X + l * GX + 132 + d0) = (f32x4){kf[4] * sc, kf[5] * sc, kf[6] * sc, kf[7] * sc};
#pragma unroll
              for (int q = 0; q < 8; ++q) qf[q] *= eg;
              *(u32x4*)(rec + GR_QH + (size_t)(l * SB + d0) * 2) = pack8(qf); }
          for (int e = tid; e < 128 * 8; e += 512) { const int d = e >> 3, l0 = 8 * (e & 7); float kt[8];
#pragma unroll
              for (int q = 0; q < 8; ++q) kt[q] = bf2f(kb[(l0 + q) * SB + d]) * expf(glast - gc[l0 + q]);
              *(u32x4*)(rec + GR_KT + (size_t)(d * RS + l0) * 2) = pack8(kt); }
          if (tid == 0) *(float*)(rec + GR_GL) = expf(glast); }
        __syncthreads();
        for (int e = tid; e < 64 * RS / 8; e += 512) ((u32x4*)(rec + GR_QK))[e] = ((const LAS u32x4*)qkimg)[e];
        tri_solve64(Lm, GS2, X, GX, 16, ssq, w, l15, q4);
        __syncthreads();
        for (int e = tid; e < 64 * 16; e += 512) { const int l = e >> 4, d0 = 8 * (e & 15); const f32x4 a = *(const LAS f32x4*)(X + l * GX + 128 + d0), b2 = *(const LAS f32x4*)(X + l * GX + 132 + d0);
            const float v[8] = {a.x, a.y, a.z, a.w, b2.x, b2.y, b2.z, b2.w}; *(u32x4*)(rec + GR_W + (size_t)(l * SB + d0) * 2) = pack8(v); }
        for (int e = tid; e < 128 * 8; e += 512) { const int vv = e >> 3, t0 = 8 * (e & 7); float v[8];
#pragma unroll
            for (int q = 0; q < 8; ++q) v[q] = X[(t0 + q) * GX + vv];
            *(u32x4*)((bf16*)(rec + GR_COMMON) + vv * 64 + t0) = pack8(v); }
    }
    __syncthreads();
}
constexpr int G2_STAGE = GR_COMMON;
__device__ __forceinline__ void phase_gdn_g2(const Frame& F, const Args& A) {
    const unsigned char* CHR = WSP(unsigned char, G_CH); float* GO = WSP(float, G_O);
    LAS unsigned char* buf0 = F.lds; LAS bf16* STt = (LAS bf16*)(F.lds + 2 * G2_STAGE); LAS bf16* vnT = STt + 2 * 32 * SB;
    const int w = F.wave, ti = w >> 1, tj = w & 1;
    const int nunits = BH * 4 * 4;
    constexpr int NCK = G2_STAGE / 16;
    for (int unit = F.bid; unit < nunits; unit += F.G) {
        int tid = F.tid; OPAQUE_V(tid); const int lane = tid & 63, l15 = lane & 15, q4 = lane >> 4;
        const int vs = unit & 3, h = (unit >> 2) & 3, b = unit >> 4;
        __syncthreads();
        for (int e = tid; e < 2 * 32 * SB / 2; e += 512) ((LAS unsigned*)STt)[e] = 0u;
        f32x4 Sreg[2] = {(f32x4){0.f, 0.f, 0.f, 0.f}, (f32x4){0.f, 0.f, 0.f, 0.f}};
        u32x4 preA[8], preB[8]; u32x2 uiniA, uiniB, ucur;
        const unsigned char* rec0 = CHR + (size_t)((b * 4 + h) * NCH) * GR_BYTES;
        const int uofs = GR_COMMON + ((32 * vs + 16 * tj + l15) * 64 + 16 * ti + 4 * q4) * 2;
#define G2_LOAD(S, recp) do { _Pragma("unroll") for (int q = 0; q < 8; ++q) { const int e = tid + 512 * q; if (e < NCK) pre##S[q] = *(const u32x4*)((recp) + (size_t)e * 16); } uini##S = *(const u32x2*)((recp) + uofs); } while (0)
#define G2_STORE(S, dst) do { _Pragma("unroll") for (int q = 0; q < 8; ++q) { const int e = tid + 512 * q; if (e < NCK) *(LAS u32x4*)((dst) + (size_t)e * 16) = pre##S[q]; } } while (0)
        G2_LOAD(A, rec0); G2_STORE(A, buf0); ucur = uiniA;
        if (NCH > 1) G2_LOAD(A, rec0 + (size_t)GR_BYTES);
        __syncthreads();
#define G2_STEP(c, LS, SS) do { \
            LAS unsigned char* buf = buf0 + ((c) & 1) * G2_STAGE; LAS unsigned char* nbuf = buf0 + (((c) + 1) & 1) * G2_STAGE; \
            if ((c) + 2 < NCH) G2_LOAD(LS, rec0 + (size_t)((c) + 2) * GR_BYTES); \
            const LAS bf16* Wi = (const LAS bf16*)(buf + GR_W); const LAS bf16* QH = (const LAS bf16*)(buf + GR_QH); const LAS bf16* KT = (const LAS bf16*)(buf + GR_KT); const LAS bf16* QK = (const LAS bf16*)(buf + GR_QK); \
            const float egl = *(const LAS float*)(buf + GR_GL); \
            const LAS bf16* S0 = STt + ((c) & 1) * 32 * SB; LAS bf16* S1 = STt + (((c) + 1) & 1) * 32 * SB; \
            { const f32x4 acc = tile_bf(Wi + 16 * ti * SB, SB, S0 + 16 * tj * SB, SB, 128, (f32x4){0.f, 0.f, 0.f, 0.f}, l15, q4); \
              const f32x4 vn = (f32x4){bf2f(ucur.x & 0xffffu), bf2f(ucur.x >> 16), bf2f(ucur.y & 0xffffu), bf2f(ucur.y >> 16)} - acc; \
              u32x2 pk; pk.x = pk2(vn[0], vn[1]); pk.y = pk2(vn[2], vn[3]); *(LAS u32x2*)(vnT + (16 * tj + l15) * RS + 16 * ti + 4 * q4) = pk; } \
            __syncthreads(); \
            { f32x4 acc = tile_bf(QH + 16 * ti * SB, SB, S0 + 16 * tj * SB, SB, 128, (f32x4){0.f, 0.f, 0.f, 0.f}, l15, q4); \
              acc = tile_bf(QK + 16 * ti * RS, RS, vnT + 16 * tj * RS, RS, 64, acc, l15, q4); \
              _Pragma("unroll") for (int r = 0; r < 4; ++r) GO[((size_t)b * SEQ + (size_t)(c) * 64 + 16 * ti + 4 * q4 + r) * 512 + h * 128 + 32 * vs + 16 * tj + l15] = acc[r]; } \
            _Pragma("unroll") for (int t2 = 0; t2 < 2; ++t2) { Sreg[t2] = Sreg[t2] * egl; \
                Sreg[t2] = tile_bf(KT + 16 * w * RS, RS, vnT + 16 * t2 * RS, RS, 64, Sreg[t2], l15, q4); \
                u32x2 pk; pk.x = pk2(Sreg[t2][0], Sreg[t2][1]); pk.y = pk2(Sreg[t2][2], Sreg[t2][3]); *(LAS u32x2*)(S1 + (16 * t2 + l15) * SB + 16 * w + 4 * q4) = pk; } \
            if ((c) + 1 < NCH) { G2_STORE(SS, nbuf); ucur = uini##SS; } \
            __syncthreads(); } while (0)
        for (int c = 0; c < NCH; c += 2) { G2_STEP(c, B, A); G2_STEP(c + 1, A, B); }
#undef G2_STEP
#undef G2_STORE
#undef G2_LOAD
    }
    __syncthreads();
}
__device__ __forceinline__ void phase_gdn_g3(const Frame& F, const Args& A, int layer) {
    const float* GO = WSP(float, G_O); const bf16* P = WSP(bf16, A_P); bf16* Y = WSP(bf16, A_Y) + (size_t)2 * TH * 512; const float* nw = AIN(A, 22) + layer * 128;
    const int lane = F.lane, c0 = 8 * lane;
    for (int m = F.gw; m < TH; m += F.NGW) {
        const f32x4 a = *(const f32x4*)(GO + (size_t)m * 512 + c0), b2 = *(const f32x4*)(GO + (size_t)m * 512 + c0 + 4);
        float o[8] = {a.x, a.y, a.z, a.w, b2.x, b2.y, b2.z, b2.w}; float ss = 0.f;
#pragma unroll
        for (int q = 0; q < 8; ++q) ss += o[q] * o[q];
        ss = red_sum<16>(ss);
        const float rstd = RSQRT(ss * (1.0f / 128.0f) + EPS);
        const f32x4 z0 = ld_bf16x4(P + (size_t)m * PW + C_GDN + 1544 + c0), z1 = ld_bf16x4(P + (size_t)m * PW + C_GDN + 1544 + c0 + 4);
        const float z[8] = {z0.x, z0.y, z0.z, z0.w, z1.x, z1.y, z1.z, z1.w}; float y[8];
#pragma unroll
        for (int q = 0; q < 8; ++q) y[q] = o[q] * rstd * nw[(c0 + q) & 127] * siluf_(z[q]);
        u32x4 wv; wv.x = pk2(y[0], y[1]); wv.y = pk2(y[2], y[3]); wv.z = pk2(y[4], y[5]); wv.w = pk2(y[6], y[7]);
        *(u32x4*)(Y + (size_t)m * 512 + c0) = wv;
    }
}

__device__ __forceinline__ void phase_merge_z(const Frame& F, const Args& A) {
    pg8::Gemm g{WSP(bf16, A_Y), WSP(bf16, W_BR), 512, 512}; BranchOrder S; S.nP = TH / 256; S.G = F.G; S.c = F.bid;
    EpiZ E{WSP(bf16, A_Z)}; pg8::gemm_phase(F.lds, g, S, E, F.tid);
}
__device__ __forceinline__ void phase_merge_gate(const Frame& F, const Args& A, int layer) {
    pg8::Gemm g{WSP(bf16, A_H), WSP(bf16, W_GATE), D, D}; pg8::StaticOrder S; S.init(TH, 4096, F.G, F.bid);
    EpiMerge E{WSP(bf16, A_Z), AIN(A, 29) + (size_t)layer * 4 * D, WSP(bf16, A_MG)}; pg8::gemm_phase(F.lds, g, S, E, F.tid);
}
__device__ __forceinline__ void phase_merge_out(const Frame& F, const Args& A, const float* xin, float* xout) {
    pg8::Gemm g{WSP(bf16, A_MG), WSP(bf16, W_OUT), D, D}; pg8::StaticOrder S; S.init(TH, D, F.G, F.bid);
    EpiResidual E{xin, xout}; pg8::gemm_phase(F.lds, g, S, E, F.tid);
}
__device__ __forceinline__ void phase_ffn_gu(const Frame& F, const Args& A) {
    pg8::Gemm g{WSP(bf16, A_H), WSP(bf16, W_FGU), D, D}; pg8::StaticOrder S; S.init(TH, 2 * FF_D, F.G, F.bid);
    EpiSwiGLU E{WSP(bf16, F_ACT), FF_D, 1 << 20}; pg8::gemm_phase(F.lds, g, S, E, F.tid);
}
__device__ __forceinline__ void phase_ffn_down(const Frame& F, const Args& A, float* x) {
    pg8::Gemm g{WSP(bf16, F_ACT), WSP(bf16, W_FDN), FF_D, FF_D}; pg8::StaticOrder S; S.init(TH, D, F.G, F.bid);
    EpiResidual E{x, x}; pg8::gemm_phase(F.lds, g, S, E, F.tid);
}
struct MoeLayout { int pstart[NEXP + 1]; };
__device__ __forceinline__ MoeLayout moe_layout(const unsigned* cnt) {
    MoeLayout L; int s = 0;
#pragma unroll
    for (int e = 0; e < NEXP; ++e) { L.pstart[e] = s; s += ((int)cnt[e] + 255) & ~255; }
    L.pstart[NEXP] = s; return L;
}
struct MoeOrder {
    int np, nN, G, c; MoeLayout L;
    __device__ bool next(int i, Unit& u) const {
        const long Lx = (long)i * G + c; if (Lx >= (long)np * nN) return false;
        const int pm = (int)(Lx / nN), pn = (int)(Lx % nN); int e = 0;
#pragma unroll
        for (int k = 1; k < NEXP; ++k) if (pm * 256 >= L.pstart[k]) e = k;
        u.pm = pm; u.pn = e * nN + pn; return true;
    }
    __device__ __forceinline__ void a_ready(const Unit&) const {}
    __device__ __forceinline__ void done(const Unit&) const {}
};
__device__ __forceinline__ void phase_moe_route(const Frame& F, const Args& A, int half) {
    const unsigned* wgc = (const unsigned*)(F.ctl + CW_WGC + half * 8192); unsigned* cnt = (unsigned*)(F.ctl + CW_CNT + half * 16);
    LAS unsigned* tab = (LAS unsigned*)F.lds; LAS unsigned* tot = tab + 8192; LAS unsigned* bef = tot + 8; LAS unsigned* cur = bef + 8;
    __syncthreads();
    for (int e = F.tid; e < F.G * 8; e += 512) tab[e] = wgc[e];
    __syncthreads();
    if (F.tid < 8) { unsigned t = 0, bsum = 0; for (int g = 0; g < F.G; ++g) { const unsigned v = tab[g * 8 + F.tid]; if (g < F.bid) bsum += v; t += v; } tot[F.tid] = t; bef[F.tid] = bsum; cur[F.tid] = 0u; if (F.bid == 0) cnt[F.tid] = t; }
    __syncthreads();
    unsigned totr[8];
#pragma unroll
    for (int e = 0; e < 8; ++e) totr[e] = tot[e];
    const MoeLayout L = moe_layout(totr);
    const bf16* H = WSP(bf16, A_H); bf16* GA = WSP(bf16, F_GA); const int* tope = WSP(int, F_TOPE); int* slot = WSP(int, F_SLOT);
    const int lane = F.lane;
    for (int m = F.gw; m < TH; m += F.NGW) {
        const u32x4 v0 = *(const u32x4*)(H + (size_t)m * D + 8 * lane), v1 = *(const u32x4*)(H + (size_t)m * D + 512 + 8 * lane);
#pragma unroll
        for (int k = 0; k < 2; ++k) { const int e = tope[2 * m + k]; int s = 0;
            int ps = 0;
#pragma unroll
            for (int q = 0; q < NEXP; ++q) ps = (e == q) ? L.pstart[q] : ps;
            if (lane == 0) s = ps + (int)bef[e] + (int)ATOMIC_ADD_LDS(cur + e, 1u);
            s = bcast0(s);
            if (lane == 0) slot[2 * m + k] = s;
            *(u32x4*)(GA + (size_t)s * D + 8 * lane) = v0; *(u32x4*)(GA + (size_t)s * D + 512 + 8 * lane) = v1; }
    }
#pragma unroll
    for (int e = 0; e < NEXP; ++e) { const int r0 = L.pstart[e] + (int)totr[e], r1 = L.pstart[e + 1];
        for (int r = r0 + F.gw; r < r1; r += F.NGW) { *(u32x4*)(GA + (size_t)r * D + 8 * lane) = (u32x4){0u, 0u, 0u, 0u}; *(u32x4*)(GA + (size_t)r * D + 512 + 8 * lane) = (u32x4){0u, 0u, 0u, 0u}; } }
    __syncthreads();
}
__device__ __forceinline__ void phase_moe_gu(const Frame& F, const Args& A, int half) {
    MoeOrder S; S.L = moe_layout((const unsigned*)(F.ctl + CW_CNT + half * 16)); S.np = S.L.pstart[NEXP] / 256; S.nN = 2 * FF_E / 256; S.G = F.G; S.c = F.bid;
    pg8::Gemm g{WSP(bf16, F_GA), WSP(bf16, W_FGU), D, D}; EpiSwiGLU E{WSP(bf16, F_ACT), FF_E, 2 * FF_E / 256}; pg8::gemm_phase(F.lds, g, S, E, F.tid);
}
struct EpiF32Mod {
    static constexpr bool PERM = false, AFTER_DRAIN = false;
    float* C;
    __device__ __forceinline__ void operator()(const f32x4 (&acc)[2][2][4][2], const Unit& u, int wr, int wc, int fr, int fq) const {
        const int row0 = u.pm * 256 + wr * 64 + fr, col0 = (u.pn & 3) * 256 + wc * 32 + 4 * fq;
#pragma unroll
        for (int ai = 0; ai < 2; ++ai)
#pragma unroll
            for (int m = 0; m < 4; ++m) { float* rowp = C + (size_t)(row0 + ai * HALFT + m * 16) * D + col0;
#pragma unroll
                for (int bj = 0; bj < 2; ++bj)
#pragma unroll
                    for (int n = 0; n < 2; ++n) *(f32x4*)(rowp + bj * HALFT + n * 16) = acc[ai][bj][m][n]; }
    }
};
__device__ __forceinline__ void phase_moe_down(const Frame& F, const Args& A, int half) {
    MoeOrder S; S.L = moe_layout((const unsigned*)(F.ctl + CW_CNT + half * 16)); S.np = S.L.pstart[NEXP] / 256; S.nN = D / 256; S.G = F.G; S.c = F.bid;
    pg8::Gemm g{WSP(bf16, F_ACT), WSP(bf16, W_FDN), FF_E, FF_E}; EpiF32Mod E{WSP(float, F_YE)}; pg8::gemm_phase(F.lds, g, S, E, F.tid);
}
__device__ __forceinline__ void phase_moe_combine(const Frame& F, const Args& A, float* x, const float* fgain) {
    const float* YE = WSP(float, F_YE); const int* slot = WSP(int, F_SLOT); const float* topw = WSP(float, F_TOPW); const int lane = F.lane;
    for (int m = F.gw; m < TH; m += F.NGW) { const int s0 = slot[2 * m], s1 = slot[2 * m + 1]; const float w0 = topw[2 * m], w1 = topw[2 * m + 1];
        f32x4 v[4]; float ss = 0.f;
#pragma unroll
        for (int j = 0; j < 4; ++j) { const int c = 4 * lane + 256 * j;
            v[j] = *(const f32x4*)(x + (size_t)m * D + c) + *(const f32x4*)(YE + (size_t)s0 * D + c) * w0 + *(const f32x4*)(YE + (size_t)s1 * D + c) * w1;
            ss += (v[j].x * v[j].x + v[j].y * v[j].y) + (v[j].z * v[j].z + v[j].w * v[j].w); }
        if (fgain) { const float rstd = RSQRT(wave_sum(ss) * (1.0f / D) + EPS);
#pragma unroll
            for (int j = 0; j < 4; ++j) v[j] = v[j] * rstd * *(const f32x4*)(fgain + 4 * lane + 256 * j); }
#pragma unroll
        for (int j = 0; j < 4; ++j) *(f32x4*)(x + (size_t)m * D + 4 * lane + 256 * j) = v[j]; }
}

#ifndef EMU
#define XB_TMO      128
#define XB_XCNT(j)  (256  + 64 * (j))
#define XB_XSUB(j)  (1280 + 64 * (j))
#define XB_XGEN(j)  (2304 + 64 * (j))
#define XB_TOP      3328
#define XB_TOPGEN   3392
#define XCD_BAR_WORDS 3456
#define XB_SPIN_CAP (1u << 22)
__device__ __forceinline__ unsigned xb_ld(unsigned* p)              { return __hip_atomic_load(p, __ATOMIC_RELAXED, __HIP_MEMORY_SCOPE_AGENT); }
__device__ __forceinline__ unsigned xb_add(unsigned* p, unsigned v) { return __hip_atomic_fetch_add(p, v, __ATOMIC_RELAXED, __HIP_MEMORY_SCOPE_AGENT); }
__device__ __forceinline__ unsigned xb_xcc_id() { return (unsigned)__builtin_amdgcn_s_getreg((3 << 11) | 20) & 0xFu; }
#define XB_SPIN(cond, bar) do { unsigned _sp = 0; while (cond) { __builtin_amdgcn_s_sleep(1); \
    if ((++_sp & 255u) == 0u) { if (xb_ld(&(bar)[XB_TMO])) break; if (_sp > XB_SPIN_CAP) { atomicAdd(&(bar)[XB_TMO], 1u); break; } } } } while (0)
struct XcdBarrier { unsigned* bar; unsigned x; volatile LAS unsigned* st; };
__device__ __forceinline__ XcdBarrier xcd_barrier_post(unsigned* bar, volatile LAS unsigned* st) {
    XcdBarrier b; b.bar = bar; b.x = xb_xcc_id(); b.st = st;
    if (threadIdx.x == 0) (void)xb_add(&bar[XB_XCNT(b.x)], 1u);
    return b;
}
__device__ __forceinline__ void xcd_barrier_complete(unsigned* bar, unsigned x, unsigned& nloc, unsigned& nx) {
    const unsigned G = gridDim.x * gridDim.y * gridDim.z;
    unsigned sum, cnt, mine, sp = 0u;
    for (;;) {
        sum = 0u; cnt = 0u; mine = 0u;
#pragma unroll
        for (unsigned j = 0; j < 16; ++j) { const unsigned c = xb_ld(&bar[XB_XCNT(j)]); sum += c; cnt += (c > 0u) ? 1u : 0u; mine = (j == x) ? c : mine; }
        if (sum == G) break;
        __builtin_amdgcn_s_sleep(1);
        if ((++sp & 255u) == 0u) { if (xb_ld(&bar[XB_TMO])) break; if (sp > XB_SPIN_CAP) { atomicAdd(&bar[XB_TMO], 1u); break; } }
    }
    nloc = mine > 0u ? mine : 1u; nx = cnt > 0u ? cnt : 1u;
}
__device__ __forceinline__ void xcd_barrier(const XcdBarrier& b) {
    asm volatile("s_waitcnt vmcnt(0)" ::: "memory");
    __syncthreads();
    if (threadIdx.x == 0) {
        unsigned* bar = b.bar;
        __builtin_amdgcn_s_waitcnt(0);
        unsigned nloc = b.st[0], nx = b.st[1];
        if (nloc == 0u) { xcd_barrier_complete(bar, b.x, nloc, nx); b.st[0] = nloc; b.st[1] = nx; }
        const unsigned old = xb_add(&bar[XB_XSUB(b.x)], 1u);
        const unsigned gen = old / nloc;
        if (old + 1u == (gen + 1u) * nloc) {
            __builtin_amdgcn_fence(__ATOMIC_RELEASE, "agent");
            asm volatile("s_waitcnt vmcnt(0)" ::: "memory");
            const unsigned og = xb_add(&bar[XB_TOP], 1u);
            const unsigned tg = og / nx;
            if (og + 1u == (tg + 1u) * nx) xb_add(&bar[XB_TOPGEN], 1u);
            else XB_SPIN(xb_ld(&bar[XB_TOPGEN]) == tg, bar);
            __builtin_amdgcn_fence(__ATOMIC_ACQUIRE, "agent");
            xb_add(&bar[XB_XGEN(b.x)], 1u);
            asm volatile("s_waitcnt vmcnt(0)" ::: "memory");
        } else {
            XB_SPIN(xb_ld(&bar[XB_XGEN(b.x)]) == gen, bar);
            __builtin_amdgcn_fence(__ATOMIC_ACQUIRE, "agent");
            asm volatile("s_waitcnt vmcnt(0)" ::: "memory");
        }
    }
    __syncthreads();
}
#endif

constexpr int NPHASES = DEPTH + NHALF * (14 + 16);
constexpr int LDS_BYTES = 155648, MISC_OFF = 154624;

__global__ void __launch_bounds__(512, 2) fwd_kernel(Args args_k) {
#ifdef EMU
    unsigned char* lds = emu_lds_ptr;
#else
    extern __shared__ __attribute__((aligned(16))) unsigned char lds[];
#endif
    Frame F0;
    F0.lds = (LAS unsigned char*)lds; F0.tid = threadIdx.x; F0.lane = F0.tid & 63; F0.wave = RFL(F0.tid >> 6); F0.G = gridDim.x; F0.bid = blockIdx.x;
    F0.gw = F0.bid * 8 + F0.wave; F0.NGW = F0.G * 8;
    F0.out = (GAS float*)args_k.out; F0.ws = (GAS unsigned char*)args_k.ws; F0.ctl = (GAS unsigned*)(F0.ws + WS_CTL);
    const int lo = args_k.lo, hi = args_k.hi;
#ifndef EMU
    volatile LAS unsigned* misc = (volatile LAS unsigned*)(F0.lds + MISC_OFF);
    if (F0.tid < 4) misc[F0.tid] = 0u;
    __syncthreads();
    XcdBarrier bar; bar.bar = (unsigned*)(F0.ctl + CW_BAR); bar.x = 0; bar.st = misc;
    if (hi - lo > 1) bar = xcd_barrier_post((unsigned*)(F0.ctl + CW_BAR), misc);
#define GRID_BAR() do { XcdBarrier bq = bar; asm volatile("" : "+s"(bq.bar), "+s"(bq.x)); xcd_barrier(bq); } while (0)
#else
#define GRID_BAR() do { } while (0)
#endif
    int ph = 0;
#ifndef PH_MASK
#define PH_MASK 0xFFFFFFFFFFFFFFFFull
#endif
#define PHASE(...) PHASE_I(31, __VA_ARGS__)
#ifdef EMU
#define LAUNDER(Fq) do { } while (0)
#else
#define LAUNDER(Fq) do { unsigned mq_ = ~0u; asm volatile("" : "+s"(Fq.G), "+s"(Fq.bid), "+s"(Fq.wave), "+s"(Fq.ws), "+s"(Fq.out), "+s"(Fq.ctl), "+s"(mq_)); Fq.lane = (int)__builtin_amdgcn_mbcnt_hi(mq_, __builtin_amdgcn_mbcnt_lo(mq_, 0u)); Fq.tid = Fq.wave * 64 + Fq.lane; Fq.gw = Fq.bid * 8 + Fq.wave; Fq.NGW = Fq.G * 8; } while (0)
#endif
#ifdef EMU
#define ARGS_Q() const Args& args_q = args_k
#else
#define ARGS_Q() const __attribute__((address_space(4))) Args* aq_ = (const __attribute__((address_space(4))) Args*)__builtin_amdgcn_kernarg_segment_ptr(); asm volatile("" : "+s"(aq_)); const Args& args_q = *(const Args*)aq_
#endif
#define PHASE_I(kind, ...) do { if (ph >= lo && ph < hi) { constexpr int reps_ = (((REPEAT_MASK) >> (kind)) & 1u) ? 2 : 1; for (int rr_ = 0; rr_ < reps_; ++rr_) { { Frame Fq = F0; LAUNDER(Fq); const Frame& F = Fq; ARGS_Q(); const Args& args = args_q; __VA_ARGS__; } if (rr_ + 1 < reps_ || ph + 1 < hi) { GRID_BAR(); if (((REPEAT_MASK) >> 26) & 1u) GRID_BAR(); } } } ++ph; } while (0)
#define PHASEK(kind, ...) PHASE_I(kind, __VA_ARGS__)
#define NORM1(layer, half) do { const size_t rn_ = (size_t)(half) * TH; const float* xn_ = ((layer) == 0 ? AIN(args, 0) : (const float*)F.out) + rn_ * D; \
            phase_norm<false>(F, args, xn_, AIN(args, 2) + (layer) * D, WSP(bf16, A_H), nullptr, nullptr, nullptr, nullptr); phase_rope_table(F, args, (const int*)AIN(args, 1) + rn_, WSP(float, A_ROPE)); } while (0)
#define SEGMENT(layer, half) do { \
            const size_t r0 = (size_t)(half) * TH; \
            const float* xin = ((layer) == 0 ? AIN(args_k, 0) : (const float*)F0.out) + r0 * D; float* xo = (float*)F0.out + r0 * D; \
            PHASEK(1, { pg8::Gemm g{WSP(bf16, A_H), WSP(bf16, W_IN), D, D}; pg8::StaticOrder S; S.init(TH, PW, F.G, F.bid); EpiBf16 E{WSP(bf16, A_P), PW, nullptr, 0}; pg8::gemm_phase(F.lds, g, S, E, F.tid); }); \
            PHASEK(2, phase_mla_prep(F, args); phase_rwkv_prep(F, args, layer)); \
            PHASEK(3, phase_mla_q(F, args); __syncthreads(); phase_mla_kv(F, args); __syncthreads(); phase_rwkv_lora(F, args)); \
            PHASEK(8, phase_rwkv_r1(F, args, layer)); \
            PHASEK(5, { const int ns_ = F.G >= 128 ? 64 : (F.G >= 4 ? F.G / 4 : 0); Frame Fa = F;       \
                        if (F.bid < ns_) { Fa.G = ns_; Fa.NGW = ns_ * 8; phase_rwkv_r2(Fa, args); } else { Fa.bid = F.bid - ns_; Fa.G = F.G - ns_; Fa.gw = Fa.bid * 8 + Fa.wave; Fa.NGW = Fa.G * 8; phase_attention(Fa, args); if (ns_ == 0) phase_rwkv_r2(F, args); } }); \
            PHASEK(9, phase_rwkv_post(F, args, layer); phase_gdn_g1(F, args, layer); phase_ssd_s1(F, args, layer)); \
            PHASEK(11, { const int ns_ = F.G >= 4 ? F.G / 2 : 0; Frame Fa = F;                               \
                        if (F.bid < ns_) { Fa.G = ns_; Fa.NGW = ns_ * 8; phase_gdn_g2(Fa, args); } else { Fa.bid = F.bid - ns_; Fa.G = F.G - ns_; Fa.gw = Fa.bid * 8 + Fa.wave; Fa.NGW = Fa.G * 8; phase_ssd_s23(Fa, args); if (ns_ == 0) phase_gdn_g2(F, args); } }); \
            PHASEK(12, phase_gdn_g3(F, args, layer); phase_ssd_s4(F, args, layer)); \
            PHASEK(17, phase_merge_z(F, args)); \
            PHASEK(18, phase_merge_gate(F, args, layer)); \
            PHASEK(19, phase_merge_out(F, args, xin, xo)); \
            if ((layer) == 0) { \
                PHASEK(20, phase_norm<false>(F, args, xo, AIN(args, 32) + (layer) * D, WSP(bf16, A_H), nullptr, nullptr, nullptr, nullptr)); \
                PHASEK(21, phase_ffn_gu(F, args)); \
                PHASE(phase_ffn_down(F, args, xo); if ((half) == 0 && NHALF == 2) NORM1(layer, 1)); \
            } else { \
                PHASE(phase_norm<true>(F, args, xo, AIN(args, 32) + (layer) * D, WSP(bf16, A_H), AIN(args, 35), WSP(int, F_TOPE), WSP(float, F_TOPW), (unsigned*)(F.ctl + CW_WGC + (half) * 8192))); \
                PHASE(phase_moe_route(F, args, half)); \
                PHASEK(22, phase_moe_gu(F, args, half)); \
                PHASEK(23, phase_moe_down(F, args, half)); \
                PHASE(phase_moe_combine(F, args, xo, (layer) == DEPTH - 1 ? AIN(args, 38) : nullptr); if ((half) == 0 && NHALF == 2) NORM1(layer, 1)); \
            } } while (0)
    static_assert(DEPTH == 2 && NHALF <= 2, "segment program");
    PHASEK(27, phase_convert(F, args, 0); NORM1(0, 0));
    SEGMENT(0, 0);
    if (NHALF == 2) SEGMENT(0, 1);
    PHASEK(27, phase_convert(F, args, 1); NORM1(1, 0));
    SEGMENT(1, 0);
    if (NHALF == 2) SEGMENT(1, 1);
#undef SEGMENT
#undef PHASE
}

#ifndef ONE_LAUNCH
#define ONE_LAUNCH 1
#endif
extern "C" void kernel_launch(void* const* d_in, const int* in_sizes, int n_in, void* d_out, int out_size, void* d_ws, size_t ws_size, hipStream_t stream) {
    static int grid = 0;
    if (grid == 0) {
#ifdef EMU
        grid = EMU_GRID;
#else
        if (n_in != 39 || out_size != T * D || ws_size < WS_NEED) { fprintf(stderr, "kernel_launch: unexpected problem (n_in %d out %d ws %zu need %zu)\n", n_in, out_size, ws_size, (size_t)WS_NEED); grid = -1; return; }
        int dev = 0, cus = 0;
        if (hipGetDevice(&dev) != hipSuccess || hipDeviceGetAttribute(&cus, hipDeviceAttributeMultiprocessorCount, dev) != hipSuccess) { grid = -1; return; }
        if (hipFuncSetAttribute((const void*)fwd_kernel, hipFuncAttributeMaxDynamicSharedMemorySize, LDS_BYTES) != hipSuccess) { fprintf(stderr, "kernel_launch: hipFuncSetAttribute failed\n"); grid = -1; return; }
        int per_cu = 0;
        if (hipOccupancyMaxActiveBlocksPerMultiprocessor(&per_cu, (const void*)fwd_kernel, 512, LDS_BYTES) != hipSuccess || per_cu < 1) fprintf(stderr, "kernel_launch: occupancy query reports %d\n", per_cu);
        (void)hipGetLastError();
        grid = cus;
#endif
    }
    if (grid < 0) return;
    (void)hipMemsetAsync((char*)d_ws + WS_CTL, 0, CTL_BYTES, stream);
    Args a{};
    for (int i = 0; i < 39; ++i) a.in[i] = (const float*)d_in[i];
    a.out = (float*)d_out; a.ws = (unsigned char*)d_ws;
#ifdef EMU
    for (int p = EMU_PH_LO; p < EMU_PH_HI && p < NPHASES; ++p) { a.lo = p; a.hi = p + 1; emu_launch(fwd_kernel, grid, 512, a); emu_after_phase(p); }
#else
#if ONE_LAUNCH
    a.lo = 0; a.hi = NPHASES;
    hipLaunchKernelGGL(fwd_kernel, dim3(grid), dim3(512), LDS_BYTES, stream, a);
#else
    for (int p = 0; p < NPHASES; ++p) { a.lo = p; a.hi = p + 1; hipLaunchKernelGGL(fwd_kernel, dim3(grid), dim3(512), LDS_BYTES, stream, a); }
#endif
#endif
}
```

```cpp
#ifndef EMU
#include <hip/hip_runtime.h>
#include <cstdio>
#include <cstdint>
#endif

#ifdef EMU
#define FLAG_SET(p) __atomic_store_n((p), 1u, __ATOMIC_RELEASE)
#define FLAG_WAIT(p) do { while (__atomic_load_n((p), __ATOMIC_ACQUIRE) == 0u) { } } while (0)
#else
#define FLAG_SET(p) do { __atomic_thread_fence(__ATOMIC_RELEASE); __hip_atomic_store((p), 1u, __ATOMIC_RELEASE, __HIP_MEMORY_SCOPE_AGENT); } while (0)
#define FLAG_WAIT(p) do { while (__hip_atomic_load((p), __ATOMIC_ACQUIRE, __HIP_MEMORY_SCOPE_AGENT) == 0u) __builtin_amdgcn_s_sleep(8); __atomic_thread_fence(__ATOMIC_ACQUIRE); } while (0)
#endif
constexpr int PQ_SLOT_OFF = 154624 + 512;
#ifndef REPEAT_MASK
#define REPEAT_MASK 0u
#endif
#ifdef EMU
constexpr int BATCH = EMU_B, SEQ = EMU_S, NHALF = EMU_NHALF;
#else
constexpr int BATCH = 16, SEQ = 2048, NHALF = 2;
#endif
constexpr int D = 1024, DEPTH = 2, CH = 64;
constexpr int T = BATCH * SEQ, TH = T / NHALF, BH = BATCH / NHALF, NCH = SEQ / CH;
constexpr int C_MLA = 0, C_RWKV = 704, C_GDN = 2528, C_SSD = 4584, C_GATE = 6128, IN_COLS = 10224, PW = 6144;
constexpr int FF_D = 2816, FF_E = 3584, NEXP = 8;
constexpr int MOE_KSPLIT = 7, MOE_MAINP = TH * 2 / 256;
constexpr int MOE_ROWS = ((TH * 2 + NEXP * 255) / 256) * 256;
constexpr float EPS = 1e-6f;
static_assert(TH % 256 == 0 && SEQ % 128 == 0 && BATCH % NHALF == 0 && (SEQ / 64) % 2 == 0, "shape");

typedef unsigned short bf16;
typedef float f32x4 __attribute__((ext_vector_type(4)));
typedef float f32x2 __attribute__((ext_vector_type(2)));
typedef short bf16x8 __attribute__((ext_vector_type(8)));
typedef short bf16x4 __attribute__((ext_vector_type(4)));
typedef unsigned u32x4 __attribute__((ext_vector_type(4)));
typedef unsigned u32x2 __attribute__((ext_vector_type(2)));
#ifdef EMU
#define LAS
#define GAS
#define MFMA_F32(a, b, c) emu_mfma_16x16x4f32(a, b, c)
#define MFMA_BF16(a, b, c) emu_mfma_16x16x32bf16(a, b, c)
#define ATOMIC_ADD_U32(p, v) emu_atomic_add_u32(p, v)
#define ATOMIC_ADD_LDS(p, v) emu_atomic_add_u32((unsigned*)(p), v)
#define RFL(x) (x)
#define OPAQUE_V(x) do { } while (0)
#define ASSUME(c) do { } while (0)
#define LDS_WAIT()
#define VM_WAIT()
__device__ __forceinline__ float fast_exp(float x) { return expf(x); }
__device__ __forceinline__ float fast_rcp(float x) { return 1.0f / x; }
__device__ __forceinline__ float fast_rsqrt(float x) { return 1.0f / sqrtf(x); }
#else
#define LAS __attribute__((address_space(3)))
#define GAS __attribute__((address_space(1)))
#define MFMA_F32(a, b, c) __builtin_amdgcn_mfma_f32_16x16x4f32(a, b, c, 0, 0, 0)
#define MFMA_BF16(a, b, c) __builtin_amdgcn_mfma_f32_16x16x32_bf16(a, b, c, 0, 0, 0)
#define ATOMIC_ADD_U32(p, v) __hip_atomic_fetch_add(p, v, __ATOMIC_RELAXED, __HIP_MEMORY_SCOPE_AGENT)
#define ATOMIC_ADD_LDS(p, v) __hip_atomic_fetch_add((LAS unsigned*)(p), v, __ATOMIC_RELAXED, __HIP_MEMORY_SCOPE_WORKGROUP)
#define RFL(x) __builtin_amdgcn_readfirstlane(x)
#define ASSUME(c) __builtin_assume(c)
#define OPAQUE_V(x) asm volatile("" : "+v"(x))
#define LDS_WAIT() asm volatile("s_waitcnt lgkmcnt(0)" ::: "memory")
#define VM_WAIT() asm volatile("s_waitcnt vmcnt(0)" ::: "memory")
__device__ __forceinline__ float fast_exp(float x) { return __expf(x); }
__device__ __forceinline__ float fast_rcp(float x) { return __builtin_amdgcn_rcpf(x); }
__device__ __forceinline__ float fast_rsqrt(float x) { return __builtin_amdgcn_rsqf(x); }
#endif
__device__ __forceinline__ unsigned f2u(float f) { return __builtin_bit_cast(unsigned, f); }
__device__ __forceinline__ float u2f(unsigned u) { return __builtin_bit_cast(float, u); }
#ifdef EMU
__device__ __forceinline__ unsigned f2bf(float f) { unsigned u = f2u(f); return (u + 0x7fffu + ((u >> 16) & 1u)) >> 16; }
__device__ __forceinline__ unsigned pk2(float lo, float hi) { return f2bf(lo) | (f2bf(hi) << 16); }
#else
typedef __bf16 bf16v2_ __attribute__((ext_vector_type(2)));
__device__ __forceinline__ unsigned pk2(float lo, float hi) { const f32x2 v = {lo, hi}; return __builtin_bit_cast(unsigned, __builtin_convertvector(v, bf16v2_)); }
__device__ __forceinline__ unsigned f2bf(float f) { return pk2(f, f) & 0xffffu; }
#endif
__device__ __forceinline__ float bf2f(unsigned h) { return u2f(h << 16); }
#ifndef EMU
#define expf(x) __expf(x)
#define exp2f(x) __builtin_amdgcn_exp2f(x)
#define FDIV(a, b) ((a) * __builtin_amdgcn_rcpf(b))
#define RSQRT(x) __builtin_amdgcn_rsqf(x)
__device__ __forceinline__ float softplusf_(float x) { return x > 20.f ? x : __logf(1.0f + __expf(x)); }
#else
#define FDIV(a, b) ((a) / (b))
#define RSQRT(x) (1.0f / sqrtf(x))
__device__ __forceinline__ float softplusf_(float x) { return x > 20.f ? x : log1pf(expf(x)); }
#endif
__device__ __forceinline__ float sigmoidf_(float x) { return FDIV(1.0f, 1.0f + expf(-x)); }
__device__ __forceinline__ float siluf_(float x) { return FDIV(x, 1.0f + expf(-x)); }
__device__ __forceinline__ float tanhf_(float x) { const float e = expf(2.0f * fminf(x, 15.0f)); return FDIV(e - 1.0f, e + 1.0f); }
#ifdef EMU
template <int N> __device__ __forceinline__ float red_sum(float v) {
#pragma unroll
    for (int o = 1; o < N; o <<= 1) v += __shfl_xor(v, o);
    return v; }
template <int N> __device__ __forceinline__ float red_max(float v) {
#pragma unroll
    for (int o = 1; o < N; o <<= 1) v = fmaxf(v, __shfl_xor(v, o));
    return v; }
__device__ __forceinline__ int bcast0(int v) { return __shfl(v, 0); }
#else
template <int CTRL> __device__ __forceinline__ float dpp_mov(float v) { return u2f((unsigned)__builtin_amdgcn_mov_dpp((int)f2u(v), CTRL, 0xF, 0xF, true)); }
template <int N> __device__ __forceinline__ float red_sum(float v) {
    v += dpp_mov<0xB1>(v);
    v += dpp_mov<0x4E>(v);
    v += dpp_mov<0x141>(v);
    if (N >= 16) v += dpp_mov<0x140>(v);
    if (N >= 32) { const auto r = __builtin_amdgcn_permlane16_swap(f2u(v), f2u(v), false, false); v = u2f(r[0]) + u2f(r[1]); }
    if (N >= 64) { const auto r = __builtin_amdgcn_permlane32_swap(f2u(v), f2u(v), false, false); v = u2f(r[0]) + u2f(r[1]); }
    return v; }
template <int N> __device__ __forceinline__ float red_max(float v) {
    v = fmaxf(v, dpp_mov<0xB1>(v)); v = fmaxf(v, dpp_mov<0x4E>(v)); v = fmaxf(v, dpp_mov<0x141>(v));
    if (N >= 16) v = fmaxf(v, dpp_mov<0x140>(v));
    if (N >= 32) { const auto r = __builtin_amdgcn_permlane16_swap(f2u(v), f2u(v), false, false); v = fmaxf(u2f(r[0]), u2f(r[1])); }
    if (N >= 64) { const auto r = __builtin_amdgcn_permlane32_swap(f2u(v), f2u(v), false, false); v = fmaxf(u2f(r[0]), u2f(r[1])); }
    return v; }
__device__ __forceinline__ int bcast0(int v) { return __builtin_amdgcn_readfirstlane(v); }
#endif
__device__ __forceinline__ float wave_sum(float v) { return red_sum<64>(v); }
__device__ __forceinline__ float wave_max(float v) { return red_max<64>(v); }
__device__ __forceinline__ f32x4 ld_bf16x4(const bf16* p) { const u32x2 w = *(const u32x2*)p; return (f32x4){bf2f(w.x & 0xffffu), bf2f(w.x >> 16), bf2f(w.y & 0xffffu), bf2f(w.y >> 16)}; }
__device__ __forceinline__ void st_bf16x4(bf16* p, f32x4 v) { u32x2 w; w.x = pk2(v.x, v.y); w.y = pk2(v.z, v.w); *(u32x2*)p = w; }
__device__ __forceinline__ u32x4 pack8(const float* v) { u32x4 o; o.x = pk2(v[0], v[1]); o.y = pk2(v[2], v[3]); o.z = pk2(v[4], v[5]); o.w = pk2(v[6], v[7]); return o; }

#ifdef EMU
__device__ __forceinline__ float rows_max(float v) { v = fmaxf(v, __shfl_xor(v, 16)); return fmaxf(v, __shfl_xor(v, 32)); }
__device__ __forceinline__ float rows_sum(float v) { v += __shfl_xor(v, 16); return v + __shfl_xor(v, 32); }
#else
typedef unsigned u32x2v __attribute__((ext_vector_type(2)));
__device__ __forceinline__ float rows_max(float v) {
    { const auto r = __builtin_amdgcn_permlane16_swap(f2u(v), f2u(v), false, false); v = fmaxf(u2f(r[0]), u2f(r[1])); }
    { const auto r = __builtin_amdgcn_permlane32_swap(f2u(v), f2u(v), false, false); v = fmaxf(u2f(r[0]), u2f(r[1])); }
    return v; }
__device__ __forceinline__ float rows_sum(float v) {
    { const auto r = __builtin_amdgcn_permlane16_swap(f2u(v), f2u(v), false, false); v = u2f(r[0]) + u2f(r[1]); }
    { const auto r = __builtin_amdgcn_permlane32_swap(f2u(v), f2u(v), false, false); v = u2f(r[0]) + u2f(r[1]); }
    return v; }
#endif

namespace pg8 {
#define PG8_LAS LAS
typedef unsigned short bf16_t;
constexpr int BM = 256, BK = 64, HALF = 128, HTB = HALF * BK * 2, STAGE_BYTES = 8 * HTB, NXCD = 8, WGM = 8;
__host__ __device__ __forceinline__ int lds_byte(int r, int c) { const int st = (r >> 4) * 2 + (c >> 5), rr = r & 15, cc = c & 31, ob = rr * 64 + cc * 2; return st * 1024 + (ob ^ (((ob >> 9) & 1) << 5)); }
__host__ __device__ __forceinline__ void stage_rc(int b, int& R, int& C) { const int st = b / 1024, sb = b % 1024, swz = sb ^ (((sb >> 9) & 1) << 5); R = (st >> 1) * 16 + swz / 64; C = (st & 1) * 32 + (swz % 64) / 2; }
__host__ __device__ __forceinline__ int perm32(int rho) { const int n = rho >> 4, i = rho & 15; return 8 * (i >> 2) + 4 * n + (i & 3); }
struct Unit { int pm, pn, kb = 0; };
struct Gemm { const bf16_t* A; const bf16_t* Bt; int lda, K, ldb = 0; };
struct StaticOrder {
    int nM, nN, nwg, G, c;
    __host__ __device__ void init(int M, int N, int G_, int c_) { nM = M / BM; nN = N / BM; nwg = nM * nN; G = G_; c = c_; }
    __host__ __device__ bool next(int i, Unit& u) const {
        const long L = (long)i * G + c; if (L >= nwg) return false;
        int wgid = (int)L; { const int q = nwg / NXCD, r = nwg % NXCD, xcd = wgid % NXCD, off = wgid / NXCD; wgid = (xcd < r ? xcd * (q + 1) : r * (q + 1) + (xcd - r) * q) + off; }
        const int nig = WGM * nN, gid = wgid / nig, fm = gid * WGM, gsz = (nM - fm) < WGM ? (nM - fm) : WGM;
        u.pm = fm + ((wgid % nig) % gsz); u.pn = (wgid % nig) / gsz; return true;
    }
    __device__ __forceinline__ void a_ready(const Unit&) const {}
    __device__ __forceinline__ void done(const Unit&) const {}
};
#ifndef EMU
template <class Epi, class Sched>
__device__ __forceinline__ void gemm_phase(PG8_LAS unsigned char* lds, const Gemm g, const Sched& S, const Epi& E, const int tid) {
    const int wid = __builtin_amdgcn_readfirstlane(tid >> 6), lane = tid & 63, wr = wid >> 2, wc = wid & 3, fr = lane & 15, fq = lane >> 4;
    int Kq = g.K; asm volatile("" : "+s"(Kq));
    const int K = Kq, nt = K / BK, lda = g.lda, ldb = g.ldb > 0 ? g.ldb : K;
    unsigned voffA[2], voffB[2];
#pragma unroll
    for (int i = 0; i < 2; ++i) { int R, C; stage_rc(tid * 16 + i * 8192, R, C); const int Rb = Epi::PERM ? ((R & ~31) + perm32(R & 31)) : R;
        voffA[i] = (unsigned)(R * lda + C) * 2u; voffB[i] = (unsigned)(Rb * ldb + C) * 2u; }
    const size_t kstep = (size_t)(BK * 2);
    const size_t hstep = (size_t)HALF * ldb * 2, hstepA = (size_t)HALF * lda * 2;
    const size_t tstep = 2 * hstep, tstepA = 2 * hstepA;
    const unsigned ldsw = (unsigned)wid * 1024u;
    const int aoff = lds_byte(wr * 64 + fr, fq * 8), boff = lds_byte(wc * 32 + fr, fq * 8);
#define PG8_SA(b, h) (((b) * 2 + (h)) * HTB)
#define PG8_SB(b, h) ((4 + (b) * 2 + (h)) * HTB)
#define PG8_STAGE(bufoff, gbase, voff) do { _Pragma("unroll") for (int _i = 0; _i < 2; ++_i) \
        __builtin_amdgcn_global_load_lds((const unsigned*)((const char*)(gbase) + (voff)[_i]), (PG8_LAS unsigned*)(lds + (bufoff) + ldsw + _i * 8192), 16, 0, 0); } while (0)
#define PG8_LDA(dst, b, h) do { _Pragma("unroll") for (int m = 0; m < 4; ++m) _Pragma("unroll") for (int k = 0; k < 2; ++k) dst[m][k] = *(const PG8_LAS bf16x8*)(lds + PG8_SA(b, h) + aoff + m * 2048 + k * 1024); } while (0)
#define PG8_LDB(dst, b, h) do { _Pragma("unroll") for (int n = 0; n < 2; ++n) _Pragma("unroll") for (int k = 0; k < 2; ++k) dst[n][k] = *(const PG8_LAS bf16x8*)(lds + PG8_SB(b, h) + boff + n * 2048 + k * 1024); } while (0)
#define PG8_MMA(ai, bj, At, Bt) do { __builtin_amdgcn_s_setprio(1); _Pragma("unroll") for (int m = 0; m < 4; ++m) _Pragma("unroll") for (int n = 0; n < 2; ++n) _Pragma("unroll") for (int k = 0; k < 2; ++k) \
        acc[ai][bj][m][n] = __builtin_amdgcn_mfma_f32_16x16x32_bf16(Bt[n][k], At[m][k], acc[ai][bj][m][n], 0, 0, 0); __builtin_amdgcn_s_setprio(0); } while (0)
#define PG8_WAIT_V(n) asm volatile("s_waitcnt vmcnt(" #n ")" ::: "memory")
#define PG8_WAIT_L(n) asm volatile("s_waitcnt lgkmcnt(" #n ")" ::: "memory")
#define PG8_BAR __builtin_amdgcn_s_barrier()
#define PG8_SCHED __builtin_amdgcn_sched_barrier(0)
    Unit cur, nxt; int ui = 0;
    if (!S.next(0, cur)) return;
    f32x4 acc[2][2][4][2];
#pragma unroll
    for (int a = 0; a < 2; ++a)
#pragma unroll
        for (int b = 0; b < 2; ++b)
#pragma unroll
            for (int m = 0; m < 4; ++m)
#pragma unroll
                for (int n = 0; n < 2; ++n) acc[a][b][m][n] = (f32x4){0.f, 0.f, 0.f, 0.f};
    bf16x8 At[4][2], B0[2][2], B1[2][2];
    const char* cA = (const char*)g.A + (size_t)cur.pm * tstepA + cur.kb; const char* cB = (const char*)g.Bt + (size_t)cur.pn * tstep + cur.kb;
    S.a_ready(cur);
    PG8_STAGE(PG8_SB(0, 0), cB, voffB); PG8_STAGE(PG8_SA(0, 0), cA, voffA); PG8_STAGE(PG8_SB(0, 1), cB + hstep, voffB); PG8_STAGE(PG8_SA(0, 1), cA + hstepA, voffA);
    if (wr == 1) PG8_BAR;
    PG8_WAIT_V(4); PG8_BAR;
    PG8_STAGE(PG8_SB(1, 0), cB + kstep, voffB); PG8_STAGE(PG8_SA(1, 0), cA + kstep, voffA); PG8_STAGE(PG8_SB(1, 1), cB + hstep + kstep, voffB);
    PG8_WAIT_V(6); PG8_BAR;
    for (;;) {
        const bool has_next = S.next(ui + 1, nxt);
        const char* nA = has_next ? (const char*)g.A + (size_t)nxt.pm * tstepA + nxt.kb : cA; const char* nB = has_next ? (const char*)g.Bt + (size_t)nxt.pn * tstep + nxt.kb : cB;
        for (int t = 0; t < nt; t += 2) {
            const bool last = (t == nt - 2);
            const char* a1 = cA + (size_t)(t + 1) * kstep;
            const char* a2 = last ? nA : cA + (size_t)(t + 2) * kstep; const char* b2 = last ? nB : cB + (size_t)(t + 2) * kstep;
            const char* a3 = a2 + kstep; const char* b3 = b2 + kstep;
            if (last && has_next) S.a_ready(nxt);
            PG8_LDB(B0, 0, 0); PG8_SCHED; PG8_LDA(At, 0, 0); PG8_STAGE(PG8_SA(1, 1), a1 + hstepA, voffA);
            PG8_WAIT_L(8); PG8_BAR; PG8_WAIT_L(0); PG8_MMA(0, 0, At, B0); PG8_BAR; PG8_SCHED;
            PG8_LDB(B1, 0, 1); PG8_STAGE(PG8_SB(0, 0), b2, voffB);
            PG8_BAR; PG8_WAIT_L(0); PG8_MMA(0, 1, At, B1); PG8_BAR;
            PG8_LDA(At, 0, 1); PG8_STAGE(PG8_SA(0, 0), a2, voffA);
            PG8_BAR; PG8_WAIT_L(0); PG8_MMA(1, 0, At, B0); PG8_BAR; PG8_SCHED;
            PG8_STAGE(PG8_SB(0, 1), b2 + hstep, voffB);
            PG8_WAIT_V(6); PG8_BAR; PG8_MMA(1, 1, At, B1); PG8_BAR;
            PG8_LDB(B0, 1, 0); PG8_SCHED; PG8_LDA(At, 1, 0); PG8_STAGE(PG8_SA(0, 1), a2 + hstepA, voffA);
            PG8_WAIT_L(8); PG8_BAR; PG8_WAIT_L(0); PG8_MMA(0, 0, At, B0); PG8_BAR; PG8_SCHED;
            PG8_LDB(B1, 1, 1); PG8_STAGE(PG8_SB(1, 0), b3, voffB);
            PG8_BAR; PG8_WAIT_L(0); PG8_MMA(0, 1, At, B1); PG8_BAR;
            PG8_LDA(At, 1, 1); PG8_STAGE(PG8_SA(1, 0), a3, voffA);
            PG8_BAR; PG8_WAIT_L(0); PG8_MMA(1, 0, At, B0); PG8_BAR; PG8_SCHED;
            PG8_STAGE(PG8_SB(1, 1), b3 + hstep, voffB);
            PG8_WAIT_V(6); PG8_BAR; PG8_MMA(1, 1, At, B1); PG8_BAR;
        }
        if constexpr (!Epi::AFTER_DRAIN) { E(acc, cur, wr, wc, fr, fq); S.done(cur); }
        if (!has_next) break;
#pragma unroll
        for (int a = 0; a < 2; ++a)
#pragma unroll
            for (int b = 0; b < 2; ++b)
#pragma unroll
                for (int m = 0; m < 4; ++m)
#pragma unroll
                    for (int n = 0; n < 2; ++n) acc[a][b][m][n] = (f32x4){0.f, 0.f, 0.f, 0.f};
        cur = nxt; cA = nA; cB = nB; ++ui;
    }
    PG8_WAIT_V(0);
    if (wr == 0) PG8_BAR;
    PG8_BAR;
    if constexpr (Epi::AFTER_DRAIN) { E.fused(acc, cur, wr, wc, fr, fq, lds, wid, lane); S.done(cur); }
#undef PG8_SA
#undef PG8_SB
#undef PG8_STAGE
#undef PG8_LDA
#undef PG8_LDB
#undef PG8_MMA
#undef PG8_WAIT_V
#undef PG8_WAIT_L
#undef PG8_BAR
#undef PG8_SCHED
}
#else
template <class Epi, class Sched>
__device__ __forceinline__ void gemm_phase(PG8_LAS unsigned char* lds, const Gemm g, const Sched& S, const Epi& E, const int tid) {
    const int wid = tid >> 6, lane = tid & 63, wr = wid >> 2, wc = wid & 3, fr = lane & 15, fq = lane >> 4;
    Unit cur;
    for (int ui = 0; S.next(ui, cur); ++ui) {
        f32x4 acc[2][2][4][2];
        for (int ai = 0; ai < 2; ++ai) for (int m = 0; m < 4; ++m) {
            const size_t row = (size_t)cur.pm * 256 + ai * 128 + wr * 64 + m * 16 + fr;
            const bf16_t* ap = g.A + row * g.lda + cur.kb / 2;
            for (int bj = 0; bj < 2; ++bj) for (int n = 0; n < 2; ++n) for (int j = 0; j < 4; ++j) {
                const size_t col = (size_t)cur.pn * 256 + bj * 128 + wc * 32 + (Epi::PERM ? 8 * fq + 4 * n : 16 * n + 4 * fq) + j;
                const bf16_t* bp = g.Bt + col * (g.ldb > 0 ? g.ldb : g.K) + cur.kb / 2; float s = 0.f;
                for (int k = 0; k < g.K; ++k) s += bf2f(ap[k]) * bf2f(bp[k]);
                acc[ai][bj][m][n][j] = s; } }
        E(acc, cur, wr, wc, fr, fq);
    }
    __syncthreads();
}
#endif
}

using pg8::Unit;
constexpr int HALFT = 128;
struct EpiF32 {
    static constexpr bool PERM = false, AFTER_DRAIN = false;
    float* C; int ldc;
    __device__ __forceinline__ void operator()(const f32x4 (&acc)[2][2][4][2], const Unit& u, int wr, int wc, int fr, int fq) const {
        const int row0 = u.pm * 256 + wr * 64 + fr, col0 = u.pn * 256 + wc * 32 + 4 * fq;
#pragma unroll
        for (int ai = 0; ai < 2; ++ai)
#pragma unroll
            for (int m = 0; m < 4; ++m) { float* rowp = C + (size_t)(row0 + ai * HALFT + m * 16) * ldc + col0;
#pragma unroll
                for (int bj = 0; bj < 2; ++bj)
#pragma unroll
                    for (int n = 0; n < 2; ++n) *(f32x4*)(rowp + bj * HALFT + n * 16) = acc[ai][bj][m][n]; }
    }
};
struct EpiLora {
    static constexpr bool PERM = true, AFTER_DRAIN = false;
    float* W; bf16* AG;
    __device__ __forceinline__ void operator()(const f32x4 (&acc)[2][2][4][2], const Unit& u, int wr, int wc, int fr, int fq) const {
        const int row0 = u.pm * 256 + wr * 64 + fr, colt = wc * 32 + 8 * fq;
        if (u.pn < 2) {
#pragma unroll
            for (int ai = 0; ai < 2; ++ai)
#pragma unroll
                for (int m = 0; m < 4; ++m) { float* rowp = W + (size_t)(row0 + ai * HALFT + m * 16) * 512 + u.pn * 256 + colt;
#pragma unroll
                    for (int bj = 0; bj < 2; ++bj) { *(f32x4*)(rowp + bj * HALFT) = acc[ai][bj][m][0]; *(f32x4*)(rowp + bj * HALFT + 4) = acc[ai][bj][m][1]; } }
        } else {
#pragma unroll
            for (int ai = 0; ai < 2; ++ai)
#pragma unroll
                for (int m = 0; m < 4; ++m) { bf16* rowp = AG + (size_t)(row0 + ai * HALFT + m * 16) * 1024 + (u.pn - 2) * 256 + colt;
#pragma unroll
                    for (int bj = 0; bj < 2; ++bj) { const f32x4 v0 = acc[ai][bj][m][0], v1 = acc[ai][bj][m][1];
                        u32x4 w; w.x = pk2(v0[0], v0[1]); w.y = pk2(v0[2], v0[3]); w.z = pk2(v1[0], v1[1]); w.w = pk2(v1[2], v1[3]);
                        *(u32x4*)(rowp + bj * HALFT) = w; } }
        }
    }
};
struct EpiResidual {
    static constexpr bool PERM = false, AFTER_DRAIN = false;
    const float* res; float* out;
    __device__ __forceinline__ void operator()(const f32x4 (&acc)[2][2][4][2], const Unit& u, int wr, int wc, int fr, int fq) const {
        const int row0 = u.pm * 256 + wr * 64 + fr, col0 = u.pn * 256 + wc * 32 + 4 * fq;
#pragma unroll
        for (int ai = 0; ai < 2; ++ai) {
            f32x4 rv[4][2][2];
#pragma unroll
            for (int m = 0; m < 4; ++m) { const size_t o = (size_t)(row0 + ai * HALFT + m * 16) * D + col0;
#pragma unroll
                for (int bj = 0; bj < 2; ++bj)
#pragma unroll
                    for (int n = 0; n < 2; ++n) rv[m][bj][n] = *(const GAS f32x4*)(res + o + bj * HALFT + n * 16); }
#pragma unroll
            for (int m = 0; m < 4; ++m) { const size_t o = (size_t)(row0 + ai * HALFT + m * 16) * D + col0;
#pragma unroll
                for (int bj = 0; bj < 2; ++bj)
#pragma unroll
                    for (int n = 0; n < 2; ++n) *(GAS f32x4*)(out + o + bj * HALFT + n * 16) = rv[m][bj][n] + acc[ai][bj][m][n]; }
        }
    }
};
struct EpiBf16 {
    static constexpr bool PERM = true, AFTER_DRAIN = false;
    bf16* O; int ldc; const float* rowscale; int rs_stride;
    __device__ __forceinline__ void operator()(const f32x4 (&acc)[2][2][4][2], const Unit& u, int wr, int wc, int fr, int fq) const {
        const int row0 = u.pm * 256 + wr * 64 + fr, col0 = u.pn * 256 + wc * 32 + 8 * fq;
#pragma unroll
        for (int ai = 0; ai < 2; ++ai)
#pragma unroll
            for (int m = 0; m < 4; ++m) { const int row = row0 + ai * HALFT + m * 16; bf16* rowp = O + (size_t)row * ldc + col0;
                const float sc = rowscale ? rowscale[(size_t)row * rs_stride] : 1.0f;
#pragma unroll
                for (int bj = 0; bj < 2; ++bj) { const f32x4 v0 = acc[ai][bj][m][0] * sc, v1 = acc[ai][bj][m][1] * sc;
                    u32x4 w; w.x = pk2(v0[0], v0[1]); w.y = pk2(v0[2], v0[3]); w.z = pk2(v1[0], v1[1]); w.w = pk2(v1[2], v1[3]);
                    *(u32x4*)(rowp + bj * HALFT) = w; } }
    }
};
struct EpiSwiGLU {
    static constexpr bool PERM = true, AFTER_DRAIN = false;
    bf16* O; int ldc; int ntile;
    __device__ __forceinline__ void operator()(const f32x4 (&acc)[2][2][4][2], const Unit& u, int wr, int wc, int fr, int fq) const {
        const int row0 = u.pm * 256 + wr * 64 + fr, col0 = (u.pn % ntile) * 128 + wc * 32 + 8 * fq;
#pragma unroll
        for (int ai = 0; ai < 2; ++ai)
#pragma unroll
            for (int m = 0; m < 4; ++m) { bf16* rowp = O + (size_t)(row0 + ai * HALFT + m * 16) * ldc + col0;
                float a[8];
#pragma unroll
                for (int n = 0; n < 2; ++n)
#pragma unroll
                    for (int j = 0; j < 4; ++j) { const float g = acc[ai][0][m][n][j], up = acc[ai][1][m][n][j]; a[4 * n + j] = g * fast_rcp(1.0f + fast_exp(-g)) * up; }
                u32x4 w; w.x = pk2(a[0], a[1]); w.y = pk2(a[2], a[3]); w.z = pk2(a[4], a[5]); w.w = pk2(a[6], a[7]);
                *(u32x4*)rowp = w; }
    }
};
struct EpiZ {
    static constexpr bool PERM = true, AFTER_DRAIN = false;
    bf16* Z;
    __device__ __forceinline__ void operator()(const f32x4 (&acc)[2][2][4][2], const Unit& u, int wr, int wc, int fr, int fq) const {
        const int i = u.pn >> 2, pnl = u.pn & 3, pml = u.pm - i * (TH / 256);
        const int row0 = pml * 256 + wr * 64 + fr, col0 = i * D + pnl * 256 + wc * 32 + 8 * fq;
#pragma unroll
        for (int ai = 0; ai < 2; ++ai)
#pragma unroll
            for (int m = 0; m < 4; ++m) { bf16* rowp = Z + (size_t)(row0 + ai * HALFT + m * 16) * 4096 + col0;
#pragma unroll
                for (int bj = 0; bj < 2; ++bj) { const f32x4 v0 = acc[ai][bj][m][0], v1 = acc[ai][bj][m][1];
                    u32x4 w; w.x = pk2(v0[0], v0[1]); w.y = pk2(v0[2], v0[3]); w.z = pk2(v1[0], v1[1]); w.w = pk2(v1[2], v1[3]);
                    *(GAS u32x4*)(rowp + bj * HALFT) = w; } }
    }
};
struct BranchOrder {
    int nP, G, c;
    __device__ bool next(int i, Unit& u) const {
        const long L = (long)i * G + c; if (L >= (long)16 * nP) return false;
        const int br = (int)(L / (4 * nP)), r = (int)(L % (4 * nP)); u.pm = br * nP + (r >> 2); u.pn = br * 4 + (r & 3); return true;
    }
    __device__ __forceinline__ void a_ready(const Unit&) const {}
    __device__ __forceinline__ void done(const Unit&) const {}
};
struct EpiMerge {
    static constexpr bool PERM = false, AFTER_DRAIN = false;
    const bf16* Z; const float* gate_b; bf16* MG;
    __device__ __forceinline__ void operator()(const f32x4 (&acc)[2][2][4][2], const Unit& u, int wr, int wc, int fr, int fq) const {
        const int row0 = u.pm * 256 + wr * 64 + fr, col = u.pn * 64 + wc * 16 + 4 * fq;
        f32x4 gb[4];
#pragma unroll
        for (int i = 0; i < 4; ++i) gb[i] = *(const GAS f32x4*)(gate_b + i * D + col);
#pragma unroll
        for (int ai = 0; ai < 2; ++ai) {
            u32x2 zv[4][4];
#pragma unroll
            for (int m = 0; m < 4; ++m)
#pragma unroll
                for (int i = 0; i < 4; ++i) zv[m][i] = *(const GAS u32x2*)(Z + (size_t)(row0 + ai * HALFT + m * 16) * 4096 + i * D + col);
#pragma unroll
            for (int m = 0; m < 4; ++m) { const size_t row = (size_t)(row0 + ai * HALFT + m * 16);
                f32x4 s = (f32x4){0.f, 0.f, 0.f, 0.f};
#pragma unroll
                for (int bj = 0; bj < 2; ++bj)
#pragma unroll
                    for (int n = 0; n < 2; ++n) { const int i = 2 * bj + n; const unsigned z01 = zv[m][i].x, z23 = zv[m][i].y;
                        const f32x4 z = (f32x4){bf2f(z01 & 0xffffu), bf2f(z01 >> 16), bf2f(z23 & 0xffffu), bf2f(z23 >> 16)}; const f32x4 a = acc[ai][bj][m][n] + gb[i];
#pragma unroll
                        for (int j = 0; j < 4; ++j) s[j] += z[j] * fast_rcp(1.0f + fast_exp(-a[j])); }
                u32x2 w; w.x = pk2(s.x, s.y); w.y = pk2(s.z, s.w); *(GAS u32x2*)(MG + row * D + col) = w; }
        }
    }
};

constexpr size_t MiB = 1u << 20;
constexpr size_t al(size_t x) { return (x + 255) & ~(size_t)255; }
constexpr size_t WS_CTL = 0, CTL_BYTES = 1 * MiB;
constexpr size_t W_IN = 1 * MiB;
constexpr size_t W_GATE = W_IN + (size_t)PW * D * 2;
constexpr size_t W_UQ = W_GATE + (size_t)4096 * D * 2;
constexpr size_t W_UKV = W_UQ + (size_t)768 * 384 * 2;
constexpr size_t W_LORA = W_UKV + (size_t)1024 * 256 * 2;
constexpr size_t W_BR = W_LORA + (size_t)1536 * 384 * 2;
constexpr size_t W_OUT = W_BR + (size_t)4 * 1024 * 512 * 2;
constexpr size_t W_FGU = W_OUT + (size_t)D * D * 2;
constexpr size_t W_FDN = W_FGU + (size_t)NEXP * 2 * FF_E * D * 2;
constexpr size_t W_END = W_FDN + (size_t)NEXP * D * FF_E * 2;
constexpr size_t A_H = al(W_END);
constexpr size_t A_ROPE = A_H + (size_t)TH * D * 2;
constexpr size_t A_Y = A_ROPE + (size_t)TH * 64 * 4;
constexpr size_t A_P = A_Y + (size_t)4 * TH * 512 * 2;
constexpr size_t A_MIX = A_P + (size_t)TH * PW * 2;
constexpr size_t R_RKV = A_MIX;
constexpr size_t R_LOUT = R_RKV + (size_t)TH * 1536 * 2;
constexpr size_t R_O = R_LOUT + (size_t)TH * 1536 * 4;
constexpr size_t R_LIN = R_O + (size_t)TH * 512 * 4;
constexpr size_t R_REC = R_LIN + (size_t)TH * 384 * 2;
constexpr size_t R_END = R_REC + (size_t)BH * 8 * NCH * 61696;
constexpr size_t M_KR = al(R_END);
constexpr size_t M_Q = M_KR + (size_t)TH * 64 * 2;
constexpr size_t M_KV = M_Q + (size_t)TH * 768 * 2;
constexpr size_t M_VT = M_KV + (size_t)TH * 1024 * 2;
constexpr size_t M_END = M_VT + (size_t)TH * 512 * 2;
constexpr size_t G_CH = R_LIN;
constexpr size_t G_O = G_CH + al((size_t)BH * 4 * NCH * 78864);
constexpr size_t G_END = G_O + (size_t)TH * 512 * 4;
constexpr size_t S_ST = al(G_END);
constexpr size_t S_YD = S_ST + (size_t)BH * NCH * 8 * 64 * 128 * 2;
constexpr size_t S_C = S_YD + (size_t)TH * 512 * 4;
constexpr size_t S_AC = S_C + (size_t)BH * NCH * 2 * 17408;
constexpr size_t S_YO = S_AC + (size_t)TH * 8 * 4;
constexpr size_t S_END = S_YO + (size_t)TH * 512 * 4;
constexpr size_t A_Z = A_P;
constexpr size_t A_MG = A_MIX;
constexpr size_t F_ACT = A_P;
constexpr size_t F_GA = F_ACT + (size_t)MOE_ROWS * FF_E * 2;
constexpr size_t F_YE = F_GA + (size_t)MOE_ROWS * D * 2;
constexpr size_t F_TOPE = F_YE + (size_t)MOE_ROWS * D * 4;
constexpr size_t F_TOPW = F_TOPE + (size_t)TH * 2 * 4;
constexpr size_t F_SLOT = F_TOPW + (size_t)TH * 2 * 4;
constexpr size_t F_PART = al(F_SLOT + (size_t)TH * 2 * 4);
constexpr size_t F_END = F_PART + (size_t)MOE_KSPLIT * (MOE_ROWS - 2 * TH) * D * 4;
constexpr size_t cmax(size_t a, size_t b) { return a > b ? a : b; }
constexpr size_t WS_NEED = cmax(cmax(cmax(M_END, R_END), cmax(G_END, S_END)), F_END);
#ifndef EMU
static_assert(WS_NEED <= (size_t)896 * MiB, "workspace");
#endif
constexpr int CW_BAR = 4096;
constexpr int CW_ATQ = 12288;
constexpr int CW_RFLAG = 12288;
constexpr int CW_CNT = 16384;
constexpr int CW_WGC = 32768;

#ifdef EMU
#define WAVE_SYNC() emu_wave_sync()
#else
#define WAVE_SYNC() do { asm volatile("s_waitcnt lgkmcnt(0)" ::: "memory"); } while (0)
#endif
struct Frame {
    LAS unsigned char* lds; int tid, lane, wave, G, gw, NGW, bid;
    GAS float* out; GAS unsigned char* ws; GAS unsigned* ctl;
};
struct Args { const float* in[39]; float* out; unsigned char* ws; int lo, hi; };
#define WSP(type, off) ((type*)(F.ws + (off)))
#define AIN(A_, k) ((const float*)(const GAS float*)(A_).in[k])

template <class FN>
__device__ __forceinline__ void cvt_matrix(const Frame& F, const float* W, int ldw, int K, bf16* WT, int Ndst, const float* kscale, FN srccol) {
    LAS float* scr = (LAS float*)(F.lds + F.wave * 16384);
    const int nblk = Ndst / 32, nitems = (K / 64) * nblk, lane = F.lane;
    for (int item = F.gw; item < nitems; item += F.NGW) {
        const int kb = item / nblk, nb = item % nblk, k0 = 64 * kb, n0 = 32 * nb;
        const int sc = srccol(n0 + (lane & 31));
        float wv[32];
#pragma unroll
        for (int i = 0; i < 32; ++i) { const int kk = 2 * i + (lane >> 5); wv[i] = sc >= 0 ? W[(size_t)(k0 + kk) * ldw + sc] : 0.f; }
#pragma unroll
        for (int i = 0; i < 32; ++i) { const int kk = 2 * i + (lane >> 5); float v = wv[i]; if (kscale) v *= kscale[k0 + kk]; scr[kk * 33 + (lane & 31)] = v; }
        WAVE_SYNC();
        const int c = lane & 7;
#pragma unroll
        for (int j = 0; j < 4; ++j) { const int n = (lane >> 3) + 8 * j; const LAS float* s = scr + (8 * c) * 33 + n;
            u32x4 o; o.x = pk2(s[0 * 33], s[1 * 33]); o.y = pk2(s[2 * 33], s[3 * 33]); o.z = pk2(s[4 * 33], s[5 * 33]); o.w = pk2(s[6 * 33], s[7 * 33]);
            *(u32x4*)(WT + (size_t)(n0 + n) * K + k0 + 8 * c) = o; }
        WAVE_SYNC();
    }
}
__device__ __forceinline__ void phase_convert(const Frame& F, const Args& A, int layer) {
    const float* w_in = AIN(A, 3) + (size_t)layer * D * IN_COLS;
    cvt_matrix(F, w_in, IN_COLS, D, WSP(bf16, W_IN), PW, nullptr, [](int n) { return n < C_GATE ? n : -1; });
    cvt_matrix(F, w_in, IN_COLS, D, WSP(bf16, W_GATE), 4096, nullptr, [](int n) {
        const int pn = n >> 8, c = n & 255, bj = c >> 7, wc = (c >> 5) & 3, nn = (c >> 4) & 1, r = c & 15; return C_GATE + (2 * bj + nn) * D + 64 * pn + 16 * wc + r; });
    cvt_matrix(F, AIN(A, 6) + (size_t)layer * 384 * 768, 768, 384, WSP(bf16, W_UQ), 768, AIN(A, 4) + layer * 384, [](int n) { return n; });
    cvt_matrix(F, AIN(A, 7) + (size_t)layer * 256 * 1024, 1024, 256, WSP(bf16, W_UKV), 1024, AIN(A, 5) + layer * 256, [](int n) { return n; });
    for (int i = 0; i < 4; ++i) cvt_matrix(F, AIN(A, 30) + ((size_t)layer * 4 + i) * 512 * D, D, 512, WSP(bf16, W_BR) + (size_t)i * D * 512, D, nullptr, [](int n) { return n; });
    cvt_matrix(F, AIN(A, 31) + (size_t)layer * D * D, D, D, WSP(bf16, W_OUT), D, nullptr, [](int n) { return n; });
    if (layer == 0) {
        cvt_matrix(F, AIN(A, 33), 2 * FF_D, D, WSP(bf16, W_FGU), 2 * FF_D, nullptr, [](int n) { const int pn = n >> 8, c = n & 255; return c < 128 ? 128 * pn + c : FF_D + 128 * pn + (c - 128); });
        cvt_matrix(F, AIN(A, 34), D, FF_D, WSP(bf16, W_FDN), D, nullptr, [](int n) { return n; });
    } else {
        for (int e = 0; e < NEXP; ++e) {
            cvt_matrix(F, AIN(A, 36) + (size_t)e * D * 2 * FF_E, 2 * FF_E, D, WSP(bf16, W_FGU) + (size_t)e * 2 * FF_E * D, 2 * FF_E, nullptr, [](int n) { const int pn = n >> 8, c = n & 255; return c < 128 ? 128 * pn + c : FF_E + 128 * pn + (c - 128); });
            cvt_matrix(F, AIN(A, 37) + (size_t)e * FF_E * D, D, FF_E, WSP(bf16, W_FDN) + (size_t)e * D * FF_E, D, nullptr, [](int n) { return n; });
        }
    }
    { const float* w2 = AIN(A, 10) + (size_t)layer * 64 * 512; const float* a2 = AIN(A, 12) + (size_t)layer * 64 * 512; const float* g2 = AIN(A, 13) + (size_t)layer * 160 * 512;
      bf16* L = WSP(bf16, W_LORA);
      for (int idx = F.bid * 512 + F.tid; idx < 1536 * 384; idx += F.G * 512) { const int n = idx / 384, k = idx % 384; float v = 0.f;
          if (n < 512) { if (k < 64) v = w2[k * 512 + n]; } else if (n < 1024) { if (k >= 64 && k < 128) v = a2[(k - 64) * 512 + (n - 512)]; } else { if (k >= 128 && k < 288) v = g2[(k - 128) * 512 + (n - 1024)]; }
          L[idx] = (bf16)f2bf(v); } }
}

template <bool ROUTER>
__device__ __forceinline__ void phase_norm(const Frame& F, const Args& A, const float* xin, const float* gain, bf16* H, const float* router, int* tope, float* topw, unsigned* cnt) {
    const int lane = F.lane;
    LAS unsigned* lcnt = (LAS unsigned*)F.lds;
    if (ROUTER) { __syncthreads(); if (F.tid < 8) lcnt[F.tid] = 0u; __syncthreads(); }
    f32x4 gv[4];
#pragma unroll
    for (int j = 0; j < 4; ++j) gv[j] = *(const f32x4*)(gain + 4 * lane + 256 * j);
    for (int m = F.gw; m < TH; m += F.NGW) {
        const float* xr = xin + (size_t)m * D; f32x4 v[4]; float ss = 0.f;
#pragma unroll
        for (int j = 0; j < 4; ++j) { v[j] = *(const f32x4*)(xr + 4 * lane + 256 * j); ss += (v[j].x * v[j].x + v[j].y * v[j].y) + (v[j].z * v[j].z + v[j].w * v[j].w); }
        const float rstd = RSQRT(wave_sum(ss) * (1.0f / D) + EPS);
#pragma unroll
        for (int j = 0; j < 4; ++j) { v[j] = v[j] * rstd * gv[j]; st_bf16x4(H + (size_t)m * D + 4 * lane + 256 * j, v[j]); }
        if (ROUTER) {
            float lg[8];
#pragma unroll
            for (int e = 0; e < 8; ++e) lg[e] = 0.f;
#pragma unroll
            for (int j = 0; j < 4; ++j)
#pragma unroll
                for (int q = 0; q < 4; ++q) { const float* rp = router + (size_t)(4 * lane + 256 * j + q) * 8; const f32x4 r0 = *(const f32x4*)rp, r1 = *(const f32x4*)(rp + 4); const float hv = v[j][q];
                    lg[0] += hv * r0.x; lg[1] += hv * r0.y; lg[2] += hv * r0.z; lg[3] += hv * r0.w; lg[4] += hv * r1.x; lg[5] += hv * r1.y; lg[6] += hv * r1.z; lg[7] += hv * r1.w; }
#pragma unroll
            for (int e = 0; e < 8; ++e) lg[e] = wave_sum(lg[e]);
            if (lane == 0) {
                int e1 = 0; float l1 = lg[0];
#pragma unroll
                for (int e = 1; e < 8; ++e) if (lg[e] > l1) { l1 = lg[e]; e1 = e; }
                int e2 = -1; float l2 = -3.0e38f;
#pragma unroll
                for (int e = 0; e < 8; ++e) if (e != e1 && lg[e] > l2) { l2 = lg[e]; e2 = e; }
                const float w1 = 1.0f / (1.0f + expf(l2 - l1));
                tope[2 * m] = e1; tope[2 * m + 1] = e2; topw[2 * m] = w1; topw[2 * m + 1] = 1.0f - w1;
                ATOMIC_ADD_LDS(lcnt + e1, 1u); ATOMIC_ADD_LDS(lcnt + e2, 1u);
            }
        }
    }
    if (ROUTER) { __syncthreads(); if (F.tid < 8) cnt[F.bid * 8 + F.tid] = lcnt[F.tid]; __syncthreads(); }
}
__device__ __forceinline__ void phase_rope_table(const Frame& F, const Args& A, const int* pos, float* rope) {
    for (int idx = F.bid * 512 + F.tid; idx < TH * 32; idx += F.G * 512) { const int t = idx >> 5, i = idx & 31;
        const float inv = powf(10000.0f, -(float)i / 32.0f);
        const float ang = (float)pos[t] * inv; float sn, cs; sincosf(ang, &sn, &cs);
        rope[(size_t)t * 64 + i] = cs; rope[(size_t)t * 64 + 32 + i] = sn; }
}
__device__ __forceinline__ void phase_final_norm(const Frame& F, const Args& A, float* x, const float* gain) {
    const int lane = F.lane;
    for (int m = F.gw; m < T; m += F.NGW) {
        float* xr = x + (size_t)m * D; f32x4 v[4]; float ss = 0.f;
#pragma unroll
        for (int j = 0; j < 4; ++j) { v[j] = *(const f32x4*)(xr + 4 * lane + 256 * j); ss += (v[j].x * v[j].x + v[j].y * v[j].y) + (v[j].z * v[j].z + v[j].w * v[j].w); }
        const float rstd = RSQRT(wave_sum(ss) * (1.0f / D) + EPS);
#pragma unroll
        for (int j = 0; j < 4; ++j) *(f32x4*)(xr + 4 * lane + 256 * j) = v[j] * rstd * *(const f32x4*)(gain + 4 * lane + 256 * j);
    }
}

__device__ __forceinline__ void phase_mla_prep(const Frame& F, const Args& A) {
    bf16* P = WSP(bf16, A_P); bf16* kr = WSP(bf16, M_KR); const float* rope = WSP(float, A_ROPE);
    const int lane = F.lane;
    for (int m = F.gw; m < TH; m += F.NGW) {
        bf16* pr = P + (size_t)m * PW; float sq = 0.f, skv = 0.f; f32x4 v[3];
#pragma unroll
        for (int j = 0; j < 3; ++j) { const int c = 4 * lane + 256 * j; v[j] = ld_bf16x4(pr + c); const float s = (v[j].x * v[j].x + v[j].y * v[j].y) + (v[j].z * v[j].z + v[j].w * v[j].w);
            if (c < 384) sq += s; else if (c < 640) skv += s; }
        sq = wave_sum(sq); skv = wave_sum(skv);
        const float rq = RSQRT(sq * (1.0f / 384.0f) + EPS), rkv = RSQRT(skv * (1.0f / 256.0f) + EPS);
#pragma unroll
        for (int j = 0; j < 3; ++j) { const int c = 4 * lane + 256 * j; if (c < 640) st_bf16x4(pr + c, v[j] * (c < 384 ? rq : rkv)); }
        if (lane < 32) { const float x1 = bf2f(pr[640 + lane]), x2 = bf2f(pr[672 + lane]), c = rope[(size_t)m * 64 + lane], s = rope[(size_t)m * 64 + 32 + lane];
            kr[(size_t)m * 64 + lane] = (bf16)f2bf(x1 * c - x2 * s); kr[(size_t)m * 64 + 32 + lane] = (bf16)f2bf(x2 * c + x1 * s); }
    }
}
__device__ __forceinline__ void phase_mla_q(const Frame& F, const Args& A) {
    pg8::Gemm g{WSP(bf16, A_P) + 0, WSP(bf16, W_UQ), PW, 384}; pg8::StaticOrder S; S.init(TH, 768, F.G, F.bid);
    EpiBf16 E{WSP(bf16, M_Q), 768, nullptr, 0}; pg8::gemm_phase(F.lds, g, S, E, F.tid);
}
struct EpiKV {
    static constexpr bool PERM = true, AFTER_DRAIN = false;
    bf16* KV; bf16* VT;
    __device__ __forceinline__ void operator()(const f32x4 (&acc)[2][2][4][2], const Unit& u, int wr, int wc, int fr, int fq) const {
        const int row0 = u.pm * 256 + wr * 64 + fr, col0 = wc * 32 + 8 * fq;
#pragma unroll
        for (int ai = 0; ai < 2; ++ai)
#pragma unroll
            for (int m = 0; m < 4; ++m) { const int row = row0 + ai * HALFT + m * 16;
                { const f32x4 v0 = acc[ai][0][m][0], v1 = acc[ai][0][m][1]; u32x4 w; w.x = pk2(v0[0], v0[1]); w.y = pk2(v0[2], v0[3]); w.z = pk2(v1[0], v1[1]); w.w = pk2(v1[2], v1[3]);
                  *(u32x4*)(KV + (size_t)row * 1024 + u.pn * 256 + col0) = w; }
                const int b = row / SEQ, t = row % SEQ; bf16* vt = VT + ((size_t)(b * 4 + u.pn) * 128 + col0) * SEQ + t;
#pragma unroll
                for (int n = 0; n < 2; ++n)
#pragma unroll
                    for (int j = 0; j < 4; ++j) vt[(size_t)(4 * n + j) * SEQ] = (bf16)f2bf(acc[ai][1][m][n][j]); }
    }
};
__device__ __forceinline__ void phase_mla_kv(const Frame& F, const Args& A) {
    pg8::Gemm g{WSP(bf16, A_P) + 384, WSP(bf16, W_UKV), PW, 256}; pg8::StaticOrder S; S.init(TH, 1024, F.G, F.bid);
    EpiKV E{WSP(bf16, M_KV), WSP(bf16, M_VT)}; pg8::gemm_phase(F.lds, g, S, E, F.tid);
}
constexpr int AT_KS = 200, AT_VS = 72;
constexpr int AT_KBYTES = 64 * AT_KS * 2, AT_VBYTES = 128 * AT_VS * 2;
__device__ __forceinline__ void phase_attention(const Frame& F, const Args& A) {
    const bf16* Q = WSP(bf16, M_Q); const bf16* KV = WSP(bf16, M_KV); const bf16* KR = WSP(bf16, M_KR); const bf16* VTg = WSP(bf16, M_VT); const float* rope = WSP(float, A_ROPE); bf16* Y = WSP(bf16, A_Y);
    const int lane = F.lane, w = F.wave, l15 = lane & 15, q4 = lane >> 4, tid = F.tid, grp = w >> 2, wq = w & 3;
    const int NQB = SEQ / 128, nunits = BH * 4 * NQB;
    const float sc2 = 0.07216878364870322f * 1.4426950408889634f;
    for (int unit = F.bid; unit < nunits; unit += F.G) {
        const int qb = NQB - 1 - (unit / (BH * 4)), bh = unit % (BH * 4), h = bh & 3, b = bh >> 2;
        const size_t t0 = (size_t)b * SEQ;
        bf16x8 qf[2][6];
#pragma unroll
        for (int f = 0; f < 2; ++f) { const size_t tq = t0 + qb * 128 + wq * 32 + 16 * f + l15;
#pragma unroll
            for (int ks = 0; ks < 6; ++ks) qf[f][ks] = *(const bf16x8*)(Q + tq * 768 + h * 192 + 32 * ks + 8 * q4);
            const bf16x8 a = qf[f][4], c2 = qf[f][5];
#pragma unroll
            for (int j = 0; j < 8; ++j) { const float x1 = bf2f((unsigned short)a[j]), x2 = bf2f((unsigned short)c2[j]), c = rope[tq * 64 + 8 * q4 + j], sn = rope[tq * 64 + 32 + 8 * q4 + j];
                qf[f][4][j] = (short)f2bf(x1 * c - x2 * sn); qf[f][5][j] = (short)f2bf(x2 * c + x1 * sn); } }
        f32x4 o[2][8];
#pragma unroll
        for (int f = 0; f < 2; ++f)
#pragma unroll
            for (int mb = 0; mb < 8; ++mb) o[f][mb] = (f32x4){0.f, 0.f, 0.f, 0.f};
        float mrow[2] = {-3.0e38f, -3.0e38f}, lrow[2] = {0.f, 0.f};
        const int qchunk = 2 * qb + (wq >> 1), ntile = 2 * qb + 2;
        u32x4 pk_[3], pv_[2];
        const int skey = tid >> 3, c8 = tid & 7;
        const int okv = skey * 1024 + 8 * c8, okr = skey * 64 + 8 * c8, ovt = skey * SEQ + 8 * c8;
        const bf16* kvb = KV + t0 * 1024 + h * 256; const bf16* krb = KR + t0 * 64; const bf16* vtb = VTg + (size_t)(b * 4 + h) * 128 * SEQ;
#define AT_LOAD(kt) do { const bf16* kv_ = kvb + (size_t)(kt) * 65536; const bf16* kr_ = krb + (size_t)(kt) * 4096; const bf16* vt_ = vtb + (size_t)(kt) * 64; \
            pk_[0] = *(const u32x4*)(kv_ + okv); pk_[1] = *(const u32x4*)(kv_ + okv + 64); pk_[2] = *(const u32x4*)(kr_ + okr); \
            pv_[0] = *(const u32x4*)(vt_ + ovt); pv_[1] = *(const u32x4*)(vt_ + ovt + 64 * SEQ); } while (0)
#define AT_STORE(bufi) do { LAS bf16* Ks_ = (LAS bf16*)(F.lds + (bufi) * (AT_KBYTES + AT_VBYTES)); LAS bf16* Vt_ = (LAS bf16*)((LAS unsigned char*)Ks_ + AT_KBYTES); \
            *(LAS u32x4*)(Ks_ + skey * AT_KS + 8 * c8) = pk_[0]; *(LAS u32x4*)(Ks_ + skey * AT_KS + 8 * c8 + 64) = pk_[1]; *(LAS u32x4*)(Ks_ + skey * AT_KS + 8 * c8 + 128) = pk_[2]; \
            *(LAS u32x4*)(Vt_ + skey * AT_VS + 8 * c8) = pv_[0]; *(LAS u32x4*)(Vt_ + (skey + 64) * AT_VS + 8 * c8) = pv_[1]; } while (0)
        __syncthreads();
        AT_LOAD(0); AT_STORE(0);
        __syncthreads();
        for (int kt = 0; kt < ntile; ++kt) {
            if (kt + 1 < ntile) AT_LOAD(kt + 1);
            if (kt <= qchunk) {
                const LAS bf16* Ks = (const LAS bf16*)(F.lds + (kt & 1) * (AT_KBYTES + AT_VBYTES)); const LAS bf16* Vt = (const LAS bf16*)((const LAS unsigned char*)Ks + AT_KBYTES);
                f32x4 st[2][2];
#pragma unroll
                for (int kb = 0; kb < 2; ++kb) { st[0][kb] = (f32x4){0.f, 0.f, 0.f, 0.f}; st[1][kb] = (f32x4){0.f, 0.f, 0.f, 0.f};
#pragma unroll
                    for (int ks = 0; ks < 6; ++ks) { const bf16x8 kf = *(const LAS bf16x8*)(Ks + (32 * grp + 16 * kb + l15) * AT_KS + 32 * ks + 8 * q4);
                        st[0][kb] = MFMA_BF16(kf, qf[0][ks], st[0][kb]); st[1][kb] = MFMA_BF16(kf, qf[1][ks], st[1][kb]); } }
                bf16x8 pb[2];
#pragma unroll
                for (int f = 0; f < 2; ++f) {
                    float mx = -3.0e38f;
#pragma unroll
                    for (int kb = 0; kb < 2; ++kb) mx = fmaxf(mx, fmaxf(fmaxf(st[f][kb].x, st[f][kb].y), fmaxf(st[f][kb].z, st[f][kb].w)));
                    mx = rows_max(mx) * sc2;
                    const float mnew = fmaxf(mrow[f], mx), alpha = exp2f(mrow[f] - mnew); mrow[f] = mnew;
                    float ps = 0.f;
#pragma unroll
                    for (int kb = 0; kb < 2; ++kb)
#pragma unroll
                        for (int r = 0; r < 4; ++r) { const float p = exp2f(__builtin_fmaf(st[f][kb][r], sc2, -mnew)); ps += p; pb[f][4 * kb + r] = (short)f2bf(p); }
                    lrow[f] = lrow[f] * alpha + ps;
#pragma unroll
                    for (int mb = 0; mb < 8; ++mb) o[f][mb] = o[f][mb] * alpha;
                }
#pragma unroll
                for (int mb = 0; mb < 8; ++mb) { const LAS bf16* vp = Vt + (16 * mb + l15) * AT_VS + 32 * grp + 4 * q4;
                    const bf16x4 v0 = *(const LAS bf16x4*)vp, v1 = *(const LAS bf16x4*)(vp + 16);
                    bf16x8 vf; vf[0] = v0[0]; vf[1] = v0[1]; vf[2] = v0[2]; vf[3] = v0[3]; vf[4] = v1[0]; vf[5] = v1[1]; vf[6] = v1[2]; vf[7] = v1[3];
                    o[0][mb] = MFMA_BF16(vf, pb[0], o[0][mb]); o[1][mb] = MFMA_BF16(vf, pb[1], o[1][mb]); }
            }
            if (kt + 1 < ntile) AT_STORE((kt + 1) & 1);
            __syncthreads();
        }
#undef AT_LOAD
#undef AT_STORE
#pragma unroll
        for (int f = 0; f < 2; ++f) lrow[f] = rows_sum(lrow[f]);
        LAS float* xo = (LAS float*)F.lds + (size_t)wq * (2 * 8 * 4 * 64 + 4 * 64);
        if (grp == 1) {
#pragma unroll
            for (int f = 0; f < 2; ++f) {
#pragma unroll
                for (int mb = 0; mb < 8; ++mb)
#pragma unroll
                    for (int r = 0; r < 4; ++r) xo[((f * 8 + mb) * 4 + r) * 64 + lane] = o[f][mb][r];
                xo[2 * 8 * 4 * 64 + f * 64 + lane] = mrow[f]; xo[2 * 8 * 4 * 64 + 128 + f * 64 + lane] = lrow[f]; } }
        __syncthreads();
        if (grp == 0) {
#pragma unroll
            for (int f = 0; f < 2; ++f) { const float m1 = xo[2 * 8 * 4 * 64 + f * 64 + lane], l1 = xo[2 * 8 * 4 * 64 + 128 + f * 64 + lane];
                const float m = fmaxf(mrow[f], m1), a0 = exp2f(mrow[f] - m), a1 = exp2f(m1 - m), inv = 1.0f / (lrow[f] * a0 + l1 * a1);
                const size_t tq = t0 + qb * 128 + wq * 32 + 16 * f + l15;
#pragma unroll
                for (int mb = 0; mb < 8; ++mb) { f32x4 v;
#pragma unroll
                    for (int r = 0; r < 4; ++r) v[r] = (o[f][mb][r] * a0 + xo[((f * 8 + mb) * 4 + r) * 64 + lane] * a1) * inv;
                    st_bf16x4(Y + tq * 512 + h * 128 + 16 * mb + 4 * q4, v); } } }
    }
    __syncthreads();
}

__device__ __forceinline__ f32x4 tile_bf(const LAS bf16* a, int lda, const LAS bf16* bt, int ldb, int K, f32x4 acc, int l15, int q4) {
    const LAS bf16* ap = a + l15 * lda + 8 * q4; const LAS bf16* bp = bt + l15 * ldb + 8 * q4;
#pragma unroll 4
    for (int ks = 0; ks < K / 32; ++ks) acc = MFMA_BF16(*(const LAS bf16x8*)(ap + 32 * ks), *(const LAS bf16x8*)(bp + 32 * ks), acc);
    return acc;
}
__device__ __forceinline__ f32x4 tile_mm(const LAS float* a, int lda, int ska, const LAS float* b, int ldb, int scb, int K, f32x4 acc, int l15, int q4);


__device__ __forceinline__ void diag_solve16(const LAS float* Lblk  , int ldl, LAS float* xcol  , int ldx) {
    float x[16];
#pragma unroll
    for (int i = 0; i < 16; ++i) x[i] = xcol[i * ldx];
#pragma unroll
    for (int g = 0; g < 4; ++g) {
        f32x4 av[4][4];
#pragma unroll
        for (int ii = 0; ii < 4; ++ii)
#pragma unroll
            for (int c4 = 0; c4 <= g; ++c4) av[ii][c4] = *(const LAS f32x4*)(Lblk + (4 * g + ii) * ldl + 4 * c4);
#pragma unroll
        for (int ii = 0; ii < 4; ++ii) { const int i = 4 * g + ii; float sacc = x[i];
#pragma unroll
            for (int jj = 0; jj < i; ++jj) sacc -= av[ii][jj >> 2][jj & 3] * x[jj];
            x[i] = sacc; }
    }
#pragma unroll
    for (int i = 1; i < 16; ++i) xcol[i * ldx] = x[i];
}
__device__ __forceinline__ void tri_solve64(const LAS float* L, int ldl, LAS float* X, int ldx, int nct, LAS float* scr, int w, int l15, int q4) {
    LAS float* DI = scr;
    if (w < 4) { LAS float* T = DI + w * 320; LAS float* S = scr + 4 * 320 + w * 320; const LAS float* N = L + 16 * w * ldl + 16 * w;
#pragma unroll
        for (int r = 0; r < 4; ++r) { const int i = 4 * q4 + r; T[i * 20 + l15] = (i == l15 ? 1.0f : 0.0f) - (l15 < i ? N[i * ldl + l15] : 0.0f); }
        { const f32x4 a = tile_mm(N, ldl, 1, N, ldl, 1, 16, (f32x4){0.f, 0.f, 0.f, 0.f}, l15, q4);
#pragma unroll
          for (int r = 0; r < 4; ++r) S[(4 * q4 + r) * 20 + l15] = a[r]; }
        WAVE_SYNC();
#pragma unroll
        for (int it = 0; it < 3; ++it) {
            { const f32x4 a = tile_mm(T, 20, 1, S, 20, 1, 16, (f32x4){0.f, 0.f, 0.f, 0.f}, l15, q4);
#pragma unroll
              for (int r = 0; r < 4; ++r) T[(4 * q4 + r) * 20 + l15] += a[r]; }
            if (it < 2) { const f32x4 a = tile_mm(S, 20, 1, S, 20, 1, 16, (f32x4){0.f, 0.f, 0.f, 0.f}, l15, q4);
#pragma unroll
                for (int r = 0; r < 4; ++r) S[(4 * q4 + r) * 20 + l15] = a[r]; }
            WAVE_SYNC();
        } }
    __syncthreads();
    for (int ct = w; ct < nct; ct += 8) { LAS float* Xc = X + 16 * ct;
#pragma unroll
        for (int rb = 0; rb < 4; ++rb) {
            if (rb > 0) { const f32x4 a = tile_mm(L + 16 * rb * ldl, ldl, 1, Xc, ldx, 1, 16 * rb, (f32x4){0.f, 0.f, 0.f, 0.f}, l15, q4);
#pragma unroll
                for (int r = 0; r < 4; ++r) Xc[(16 * rb + 4 * q4 + r) * ldx + l15] -= a[r];
                WAVE_SYNC(); }
            const f32x4 y = tile_mm(DI + rb * 320, 20, 1, Xc + 16 * rb * ldx, ldx, 1, 16, (f32x4){0.f, 0.f, 0.f, 0.f}, l15, q4);
#pragma unroll
            for (int r = 0; r < 4; ++r) Xc[(16 * rb + 4 * q4 + r) * ldx + l15] = y[r];
            WAVE_SYNC();
        } }
}
__device__ __forceinline__ void phase_rwkv_prep(const Frame& F, const Args& A, int layer) {
    const bf16* P = WSP(bf16, A_P); bf16* RKV = WSP(bf16, R_RKV); bf16* LIN = WSP(bf16, R_LIN); const float* mu = AIN(A, 8) + (size_t)layer * 1824;
    const int lane = F.lane;
    for (int m = F.gw; m < TH; m += F.NGW) {
        const bool first = (m % SEQ) == 0; const bf16* pr = P + (size_t)m * PW + C_RWKV;
#pragma unroll
        for (int j = 0; j < 8; ++j) { const int c = 4 * lane + 256 * j;
            if (c < 1824) { const f32x4 p = ld_bf16x4(pr + c); const f32x4 pv = first ? (f32x4){0.f, 0.f, 0.f, 0.f} : ld_bf16x4(pr - PW + c); const f32x4 muv = *(const f32x4*)(mu + c);
                f32x4 x = p + (pv - p) * muv;
                if (c < 1536) st_bf16x4(RKV + (size_t)m * 1536 + c, x);
                else { if (c < 1600) { x.x = tanhf_(x.x); x.y = tanhf_(x.y); x.z = tanhf_(x.z); x.w = tanhf_(x.w); }
                       else if (c >= 1664) { x.x = sigmoidf_(x.x); x.y = sigmoidf_(x.y); x.z = sigmoidf_(x.z); x.w = sigmoidf_(x.w); }
                       st_bf16x4(LIN + (size_t)m * 384 + (c - 1536), x); } } }
        if (lane < 24) st_bf16x4(LIN + (size_t)m * 384 + 288 + 4 * lane, (f32x4){0.f, 0.f, 0.f, 0.f});
    }
}
__device__ __forceinline__ void phase_rwkv_lora(const Frame& F, const Args& A) {
    pg8::Gemm g{WSP(bf16, R_LIN), WSP(bf16, W_LORA), 384, 384}; pg8::StaticOrder S; S.init(TH, 1536, F.G, (F.bid + F.G / 2) % F.G);
    EpiLora E{WSP(float, R_LOUT), (bf16*)(WSP(float, R_LOUT) + (size_t)TH * 512)}; pg8::gemm_phase(F.lds, g, S, E, F.tid);
}
constexpr int RS = 72;
constexpr int RREC_COMMON = 4 * 64 * RS * 2 + 256;
constexpr int RREC_T = 64 * 64 * 2;
constexpr int RREC_BYTES = RREC_COMMON + 3 * RREC_T;
static_assert(RREC_BYTES == 61696, "record size (see R_REC in the workspace map)");
static_assert(RREC_COMMON % 16 == 0, "record alignment");
__device__ __forceinline__ void phase_rwkv_r1(const Frame& F, const Args& A, int layer) {
    const bf16* RKV = WSP(bf16, R_RKV); const float* LOUT = WSP(float, R_LOUT); unsigned char* REC = WSP(unsigned char, R_REC);
    const float* w0 = AIN(A, 9) + layer * 512; const float* a0 = AIN(A, 11) + layer * 512; const float* k_k = AIN(A, 14) + layer * 512; const float* k_a = AIN(A, 15) + layer * 512;
    LAS bf16* kbar = (LAS bf16*)F.lds; LAS bf16* atil = kbar + 64 * RS; LAS bf16* khat = atil + 64 * RS; LAS bf16* rbar = khat + 64 * RS;
    LAS bf16* atT = rbar + 64 * RS; LAS bf16* khT = atT + 64 * RS; LAS bf16* vT = khT + 64 * RS; LAS bf16* Bm = vT + 64 * RS; LAS bf16* Em = Bm + 64 * RS;
    LAS float* Am = (LAS float*)(Em + 64 * RS);
    LAS float* X = Am + 64 * 68;
    LAS float* lam = Am;
    const int w = F.wave;
    const int nunits = BH * 8 * NCH;
    for (int unit = F.bid; unit < nunits; unit += F.G) {
        int tid = F.tid; OPAQUE_V(tid); ASSUME(tid >= 0 && tid < 512); const int lane = tid & 63, l15 = lane & 15, q4 = lane >> 4;
        const int c = unit % NCH, h = (unit / NCH) & 7, b = unit / (NCH * 8);
        const size_t tok0 = (size_t)b * SEQ + (size_t)c * 64;
        const int j = lane, cj = h * 64 + j;
        __syncthreads();
        float r_[8], km_[8], kk_[8], ka_[8], v_[8], L_[8];
        { const float w0c = w0[cj], a0c = a0[cj], kkc = k_k[cj], kac = k_a[cj]; float run = 0.f;
#pragma unroll
          for (int q = 0; q < 8; ++q) { const int t = 8 * w + q; const size_t tok = tok0 + t;
              const float r = bf2f(RKV[tok * 1536 + cj]), k = bf2f(RKV[tok * 1536 + 512 + cj]); v_[q] = bf2f(RKV[tok * 1536 + 1024 + cj]);
              const float wpre = LOUT[tok * 512 + cj], apre = bf2f(((const bf16*)(LOUT + (size_t)TH * 512))[tok * 1024 + cj]);
              const float wl = -softplusf_(-(w0c + wpre)) - 0.5f, a = sigmoidf_(a0c + apre);
              const float kr = k * kkc, ss = wave_sum(kr * kr), kk = kr * RSQRT(ss + EPS);
              r_[q] = r; km_[q] = k * (1.0f + (a - 1.0f) * kac); kk_[q] = kk; ka_[q] = kk * a;
              run += -expf(wl); L_[q] = run; }
          lam[w * 64 + j] = run; }
        __syncthreads();
        { float base = 0.f, Lend = 0.f;
#pragma unroll
          for (int ww = 0; ww < 8; ++ww) { const float tw = lam[ww * 64 + j]; if (ww < w) base += tw; Lend += tw; }
#pragma unroll
          for (int q = 0; q < 8; ++q) { const int t = 8 * w + q; const float L = base + L_[q], Lm1 = q ? base + L_[q - 1] : base;
              const float eG = expf(L), eGi = expf(-L), eGm1 = expf(Lm1), eT = expf(Lend - L);
              const float kb = kk_[q] * eGm1;
              kbar[t * RS + j] = (bf16)f2bf(kb); X[t * 132 + j] = kb;
              atil[t * RS + j] = (bf16)f2bf(ka_[q] * eGi); khat[t * RS + j] = (bf16)f2bf(km_[q] * eGi); rbar[t * RS + j] = (bf16)f2bf(r_[q] * eG);
              atT[j * RS + t] = (bf16)f2bf(-ka_[q] * eT); khT[j * RS + t] = (bf16)f2bf(km_[q] * eT); vT[j * RS + t] = (bf16)f2bf(v_[q]); }
          if (w == 0) { float* gc = (float*)(REC + (size_t)unit * RREC_BYTES + 4 * 64 * RS * 2); gc[j] = expf(Lend); } }
        __syncthreads();
        unsigned char* rec = REC + (size_t)unit * RREC_BYTES;
        { const int which = w >> 1, tib = 2 * (w & 1);
          const LAS bf16* Aop = (which & 2) ? rbar : kbar; const LAS bf16* Bop = (which & 1) ? khat : atil;
          bf16x8 aF[2][2], bF[4][2];
#pragma unroll
          for (int t = 0; t < 2; ++t)
#pragma unroll
              for (int ks = 0; ks < 2; ++ks) aF[t][ks] = *(const LAS bf16x8*)(Aop + (16 * (tib + t) + l15) * RS + 8 * q4 + 32 * ks);
#pragma unroll
          for (int tj = 0; tj < 4; ++tj)
#pragma unroll
              for (int ks = 0; ks < 2; ++ks) bF[tj][ks] = *(const LAS bf16x8*)(Bop + (16 * tj + l15) * RS + 8 * q4 + 32 * ks);
          f32x4 acc[2][4];
#pragma unroll
          for (int t = 0; t < 2; ++t)
#pragma unroll
              for (int tj = 0; tj < 4; ++tj) { acc[t][tj] = MFMA_BF16(aF[t][0], bF[tj][0], ((f32x4){0.f, 0.f, 0.f, 0.f})); acc[t][tj] = MFMA_BF16(aF[t][1], bF[tj][1], acc[t][tj]); }
#pragma unroll
          for (int t = 0; t < 2; ++t)
#pragma unroll
              for (int tj = 0; tj < 4; ++tj)
#pragma unroll
                  for (int r = 0; r < 4; ++r) { const int i = 16 * (tib + t) + 4 * q4 + r, jj = 16 * tj + l15; const bool keep = (which & 2) ? (jj <= i) : (jj < i); acc[t][tj][r] = keep ? acc[t][tj][r] : 0.f; }
#define R1_EPI(STMT) _Pragma("unroll") for (int t = 0; t < 2; ++t) _Pragma("unroll") for (int tj = 0; tj < 4; ++tj) _Pragma("unroll") for (int r = 0; r < 4; ++r) { const int i = 16 * (tib + t) + 4 * q4 + r, jj = 16 * tj + l15; const float v = acc[t][tj][r]; STMT; }
          if (which == 0) { R1_EPI(Am[i * 68 + jj] = v) }
          else if (which == 1) { R1_EPI(Bm[i * RS + jj] = (bf16)f2bf(v)) }
          else if (which == 3) { R1_EPI(Em[i * RS + jj] = (bf16)f2bf(v)) }
          else { bf16* fm = (bf16*)(rec + 2 * 64 * RS * 2); R1_EPI(fm[i * RS + jj] = (bf16)f2bf(-v)) }
#undef R1_EPI
        }
        __syncthreads();
        { const int tj = w & 3, pb = 6 * (w >> 2);
          bf16x8 bF[2]; f32x4 acc[6];
#pragma unroll
          for (int ks = 0; ks < 2; ++ks) bF[ks] = *(const LAS bf16x8*)(vT + (16 * tj + l15) * RS + 8 * q4 + 32 * ks);
#pragma unroll
          for (int pq = 0; pq < 6; ++pq) { const int pair = pb + pq, which = pair >> 2, ti = pair & 3; const LAS bf16* aop = which == 0 ? Bm : which == 1 ? Em : khT;
              const bf16x8 a0 = *(const LAS bf16x8*)(aop + (16 * ti + l15) * RS + 8 * q4), a1 = *(const LAS bf16x8*)(aop + (16 * ti + l15) * RS + 8 * q4 + 32);
              acc[pq] = MFMA_BF16(a0, bF[0], ((f32x4){0.f, 0.f, 0.f, 0.f})); acc[pq] = MFMA_BF16(a1, bF[1], acc[pq]); }
#pragma unroll
          for (int pq = 0; pq < 6; ++pq) { const int pair = pb + pq, which = pair >> 2, ti = pair & 3;
              if (which == 0) {
#pragma unroll
                  for (int r = 0; r < 4; ++r) X[(16 * ti + 4 * q4 + r) * 132 + 64 + 16 * tj + l15] = acc[pq][r]; }
              else st_bf16x4((bf16*)(rec + RREC_COMMON + which * RREC_T) + (16 * tj + l15) * 64 + 16 * ti + 4 * q4, acc[pq]); } }
        __syncthreads();
        tri_solve64(Am, 68, X, 132, 8, X + 64 * 132, w, l15, q4);
        __syncthreads();
        { const int t = tid >> 3, j0 = 8 * (tid & 7); float v[8];
#pragma unroll
          for (int q = 0; q < 8; ++q) v[q] = X[t * 132 + j0 + q];
          *(u32x4*)((bf16*)rec + t * RS + j0) = pack8(v);
          const int vv = tid >> 3, t0 = 8 * (tid & 7);
#pragma unroll
          for (int q = 0; q < 8; ++q) v[q] = X[(t0 + q) * 132 + 64 + vv];
          *(u32x4*)((bf16*)(rec + RREC_COMMON) + vv * 64 + t0) = pack8(v); }
        for (int e = tid; e < 64 * RS / 8; e += 512) { ((u32x4*)(rec + 64 * RS * 2))[e] = ((const LAS u32x4*)rbar)[e]; ((u32x4*)(rec + 3 * 64 * RS * 2))[e] = ((const LAS u32x4*)atT)[e]; }
    }
    __syncthreads();
}
constexpr int R2_BUF = RREC_COMMON;
__device__ __forceinline__ void phase_rwkv_r2(const Frame& F, const Args& A, unsigned* flags) {
    const unsigned char* REC = WSP(unsigned char, R_REC); bf16* RO = WSP(bf16, R_O);
    LAS unsigned char* buf0 = F.lds; LAS bf16* HT = (LAS bf16*)(F.lds + 2 * R2_BUF); LAS bf16* UT = HT + 2 * 64 * RS;
    const int w = F.wave, ti = w >> 1;
    const int nunits = BH * 8;
    constexpr int NCHK = R2_BUF / 16;
    for (int unit = F.bid; unit < nunits; unit += F.G) {
        int tid = F.tid; OPAQUE_V(tid); ASSUME(tid >= 0 && tid < 512); const int lane = tid & 63, l15 = lane & 15, q4 = lane >> 4;
        const int h = unit & 7, b = unit >> 3;
        __syncthreads();
        for (int e = tid; e < 2 * 64 * RS / 2; e += 512) ((LAS unsigned*)HT)[e] = 0u;
        f32x4 Hreg[2] = {(f32x4){0.f, 0.f, 0.f, 0.f}, (f32x4){0.f, 0.f, 0.f, 0.f}};
        u32x4 preA[5], preB[5]; u32x2 iniA[3][2], iniB[3][2], cur[3][2];
        const unsigned char* rec0 = REC + (size_t)((b * 8 + h) * NCH) * RREC_BYTES;
        const int tofs = ((16 * (2 * (w & 1)) + l15) * 64 + 16 * ti + 4 * q4) * 2;
#define R2_LOAD(S, recp) do { _Pragma("unroll") for (int q = 0; q < 5; ++q) { const int e = tid + 512 * q; if (e < NCHK) pre##S[q] = *(const u32x4*)((recp) + (size_t)e * 16); } \
            _Pragma("unroll") for (int mq = 0; mq < 3; ++mq) { ini##S[mq][0] = *(const u32x2*)((recp) + RREC_COMMON + mq * RREC_T + tofs); ini##S[mq][1] = *(const u32x2*)((recp) + RREC_COMMON + mq * RREC_T + tofs + 16 * 64 * 2); } } while (0)
#define R2_STORE(S, dst) do { _Pragma("unroll") for (int q = 0; q < 5; ++q) { const int e = tid + 512 * q; if (e < NCHK) *(LAS u32x4*)((dst) + (size_t)e * 16) = pre##S[q]; } } while (0)
#define R2_TAKE(S) do { _Pragma("unroll") for (int mq = 0; mq < 3; ++mq) { cur[mq][0] = ini##S[mq][0]; cur[mq][1] = ini##S[mq][1]; } } while (0)
        R2_LOAD(A, rec0); R2_STORE(A, buf0); R2_TAKE(A);
        if (NCH > 1) R2_LOAD(A, rec0 + (size_t)RREC_BYTES);
        __syncthreads();
#define R2_STEP(c, LS, SS) do { \
            LAS unsigned char* buf = buf0 + ((c) & 1) * R2_BUF; LAS unsigned char* nbuf = buf0 + (((c) + 1) & 1) * R2_BUF; \
            if ((c) + 2 < NCH) R2_LOAD(LS, rec0 + (size_t)((c) + 2) * RREC_BYTES); \
            const LAS bf16* KB = (const LAS bf16*)buf; const LAS bf16* RB = KB + 64 * RS; const LAS bf16* FMn = RB + 64 * RS; const LAS bf16* ATn = FMn + 64 * RS; \
            const LAS float* GC = (const LAS float*)(buf + 4 * 64 * RS * 2); \
            const LAS bf16* H0 = HT + ((c) & 1) * 64 * RS; LAS bf16* H1 = HT + (((c) + 1) & 1) * 64 * RS; \
              \
            bf16x8 hf[2][2], uf[2][2], af[2]; \
            _Pragma("unroll") for (int t2 = 0; t2 < 2; ++t2) _Pragma("unroll") for (int ks = 0; ks < 2; ++ks) hf[t2][ks] = *(const LAS bf16x8*)(H0 + (16 * (2 * (w & 1) + t2) + l15) * RS + 8 * q4 + 32 * ks); \
            _Pragma("unroll") for (int ks = 0; ks < 2; ++ks) af[ks] = *(const LAS bf16x8*)(KB + (16 * ti + l15) * RS + 8 * q4 + 32 * ks); \
            _Pragma("unroll") for (int t2 = 0; t2 < 2; ++t2) { const int tj = 2 * (w & 1) + t2; \
                f32x4 u = (f32x4){bf2f(cur[0][t2].x & 0xffffu), bf2f(cur[0][t2].x >> 16), bf2f(cur[0][t2].y & 0xffffu), bf2f(cur[0][t2].y >> 16)}; \
                u = MFMA_BF16(af[0], hf[t2][0], u); u = MFMA_BF16(af[1], hf[t2][1], u); \
                u32x2 pk; pk.x = pk2(u[0], u[1]); pk.y = pk2(u[2], u[3]); *(LAS u32x2*)(UT + (16 * tj + l15) * RS + 16 * ti + 4 * q4) = pk; } \
            __syncthreads(); \
            _Pragma("unroll") for (int t2 = 0; t2 < 2; ++t2) _Pragma("unroll") for (int ks = 0; ks < 2; ++ks) uf[t2][ks] = *(const LAS bf16x8*)(UT + (16 * (2 * (w & 1) + t2) + l15) * RS + 8 * q4 + 32 * ks); \
            { bf16x8 rf[2], ff[2], tf[2]; \
              _Pragma("unroll") for (int ks = 0; ks < 2; ++ks) { rf[ks] = *(const LAS bf16x8*)(RB + (16 * ti + l15) * RS + 8 * q4 + 32 * ks); ff[ks] = *(const LAS bf16x8*)(FMn + (16 * ti + l15) * RS + 8 * q4 + 32 * ks); tf[ks] = *(const LAS bf16x8*)(ATn + (16 * ti + l15) * RS + 8 * q4 + 32 * ks); } \
              _Pragma("unroll") for (int t2 = 0; t2 < 2; ++t2) { const int tj = 2 * (w & 1) + t2; \
                f32x4 o = (f32x4){bf2f(cur[1][t2].x & 0xffffu), bf2f(cur[1][t2].x >> 16), bf2f(cur[1][t2].y & 0xffffu), bf2f(cur[1][t2].y >> 16)}; \
                o = MFMA_BF16(rf[0], hf[t2][0], o); o = MFMA_BF16(rf[1], hf[t2][1], o); o = MFMA_BF16(ff[0], uf[t2][0], o); o = MFMA_BF16(ff[1], uf[t2][1], o); \
                _Pragma("unroll") for (int r = 0; r < 4; ++r) RO[((size_t)b * SEQ + (size_t)(c) * 64 + 16 * ti + 4 * q4 + r) * 512 + h * 64 + 16 * tj + l15] = (bf16)f2bf(o[r]); \
                const f32x4 kv = (f32x4){bf2f(cur[2][t2].x & 0xffffu), bf2f(cur[2][t2].x >> 16), bf2f(cur[2][t2].y & 0xffffu), bf2f(cur[2][t2].y >> 16)}; \
                _Pragma("unroll") for (int r = 0; r < 4; ++r) Hreg[t2][r] = Hreg[t2][r] * GC[16 * ti + 4 * q4 + r] + kv[r]; \
                Hreg[t2] = MFMA_BF16(tf[0], uf[t2][0], Hreg[t2]); Hreg[t2] = MFMA_BF16(tf[1], uf[t2][1], Hreg[t2]); \
                u32x2 pk; pk.x = pk2(Hreg[t2][0], Hreg[t2][1]); pk.y = pk2(Hreg[t2][2], Hreg[t2][3]); *(LAS u32x2*)(H1 + (16 * tj + l15) * RS + 16 * ti + 4 * q4) = pk; } } \
            if ((c) + 1 < NCH) { R2_STORE(SS, nbuf); R2_TAKE(SS); } \
            __syncthreads(); } while (0)
        for (int c = 0; c < NCH; c += 2) { R2_STEP(c, B, A); R2_STEP(c + 1, A, B); }
        if (tid == 0) FLAG_SET(flags + unit);
#undef R2_STEP
#undef R2_STORE
#undef R2_TAKE
#undef R2_LOAD
    }
    __syncthreads();
}
__device__ __forceinline__ void phase_rwkv_post_queue(const Frame& F, const Args& A, int layer, unsigned* flags, unsigned* queue) {
    const bf16* RKV = WSP(bf16, R_RKV); const bf16* LAG = (const bf16*)(WSP(float, R_LOUT) + (size_t)TH * 512); const bf16* RO = WSP(bf16, R_O); bf16* Y = WSP(bf16, A_Y) + (size_t)1 * TH * 512;
    LAS unsigned* slot = (LAS unsigned*)(F.lds + PQ_SLOT_OFF);
    const int tid = F.tid, lane = F.lane, w = F.wave, tl = lane >> 3, nitems = BH * 8 * (SEQ / 256);
    for (;;) {
        __syncthreads();
        if (tid == 0) *slot = ATOMIC_ADD_U32(queue, 1u);
        __syncthreads();
        const int item = RFL((int)*slot);
        if (item >= nitems) break;
        const int unit = item / (SEQ / 256), blk = item % (SEQ / 256), h = unit & 7, b = unit >> 3;
        if (tid == 0) FLAG_WAIT(flags + unit);
        __syncthreads();
        const int c0 = h * 64 + 8 * (lane & 7);
        float pa0[8], pka[8], prk[8], plw[8], plb[8];
        { const float* a0 = AIN(A, 11) + layer * 512 + c0; const float* k_a = AIN(A, 15) + layer * 512 + c0; const float* r_k = AIN(A, 16) + layer * 512 + c0; const float* ln_w = AIN(A, 17) + layer * 512 + c0; const float* ln_b = AIN(A, 18) + layer * 512 + c0;
#pragma unroll
          for (int q = 0; q < 8; ++q) { pa0[q] = a0[q]; pka[q] = k_a[q]; prk[q] = r_k[q]; plw[q] = ln_w[q]; plb[q] = ln_b[q]; } }
#pragma unroll 2
        for (int it = 0; it < 4; ++it) { const size_t m = (size_t)b * SEQ + 256 * blk + 32 * w + 8 * it + tl;
            float o[8], r[8], k[8], v[8], ap[8], g[8];
            { const f32x4 a = ld_bf16x4(RO + m * 512 + c0), b2 = ld_bf16x4(RO + m * 512 + c0 + 4); o[0] = a.x; o[1] = a.y; o[2] = a.z; o[3] = a.w; o[4] = b2.x; o[5] = b2.y; o[6] = b2.z; o[7] = b2.w; }
#pragma unroll
            for (int hh = 0; hh < 2; ++hh) { const f32x4 rv = ld_bf16x4(RKV + m * 1536 + c0 + 4 * hh), kv = ld_bf16x4(RKV + m * 1536 + 512 + c0 + 4 * hh), vv = ld_bf16x4(RKV + m * 1536 + 1024 + c0 + 4 * hh);
                const f32x4 av = ld_bf16x4(LAG + m * 1024 + c0 + 4 * hh), gv = ld_bf16x4(LAG + m * 1024 + 512 + c0 + 4 * hh);
#pragma unroll
                for (int q = 0; q < 4; ++q) { r[4 * hh + q] = rv[q]; k[4 * hh + q] = kv[q]; v[4 * hh + q] = vv[q]; ap[4 * hh + q] = av[q]; g[4 * hh + q] = gv[q]; } }
            float bon = 0.f, sm = 0.f;
#pragma unroll
            for (int q = 0; q < 8; ++q) { const float a = sigmoidf_(pa0[q] + ap[q]); const float km = k[q] * (1.0f + (a - 1.0f) * pka[q]); bon += r[q] * km * prk[q]; sm += o[q]; }
            bon = red_sum<8>(bon); sm = red_sum<8>(sm);
            const float mean = sm * (1.0f / 64.0f); float vs = 0.f;
#pragma unroll
            for (int q = 0; q < 8; ++q) { const float d = o[q] - mean; vs += d * d; }
            vs = red_sum<8>(vs);
            const float rstd = RSQRT(vs * (1.0f / 64.0f) + 64e-5f);
            float y[8];
#pragma unroll
            for (int q = 0; q < 8; ++q) y[q] = ((o[q] - mean) * rstd * plw[q] + plb[q] + bon * v[q]) * g[q];
            u32x4 wv; wv.x = pk2(y[0], y[1]); wv.y = pk2(y[2], y[3]); wv.z = pk2(y[4], y[5]); wv.w = pk2(y[6], y[7]);
            *(u32x4*)(Y + m * 512 + c0) = wv; }
    }
    __syncthreads();
}

__device__ __forceinline__ void conv8x8(const bf16* src, int tl0  , const float* w  , int wld, const float* bias, float (&out)[8][8]) {
    float x[11][8];
#pragma unroll
    for (int i = 0; i < 11; ++i) { const int tl = tl0 - 3 + i;
        if (tl >= 0) { const u32x4 v = *(const u32x4*)(src + (ptrdiff_t)(i - 3) * PW);
            x[i][0] = bf2f(v.x & 0xffffu); x[i][1] = bf2f(v.x >> 16); x[i][2] = bf2f(v.y & 0xffffu); x[i][3] = bf2f(v.y >> 16); x[i][4] = bf2f(v.z & 0xffffu); x[i][5] = bf2f(v.z >> 16); x[i][6] = bf2f(v.w & 0xffffu); x[i][7] = bf2f(v.w >> 16); }
        else {
#pragma unroll
            for (int ch = 0; ch < 8; ++ch) x[i][ch] = 0.f; } }
    float wv[4][8], bv[8];
#pragma unroll
    for (int j = 0; j < 4; ++j) { const f32x4 a = *(const f32x4*)(w + j * wld), b = *(const f32x4*)(w + j * wld + 4); wv[j][0] = a.x; wv[j][1] = a.y; wv[j][2] = a.z; wv[j][3] = a.w; wv[j][4] = b.x; wv[j][5] = b.y; wv[j][6] = b.z; wv[j][7] = b.w; }
    if (bias) { const f32x4 a = *(const f32x4*)bias, b = *(const f32x4*)(bias + 4); bv[0] = a.x; bv[1] = a.y; bv[2] = a.z; bv[3] = a.w; bv[4] = b.x; bv[5] = b.y; bv[6] = b.z; bv[7] = b.w; }
    else {
#pragma unroll
        for (int ch = 0; ch < 8; ++ch) bv[ch] = 0.f; }
#pragma unroll
    for (int i = 0; i < 8; ++i)
#pragma unroll
        for (int ch = 0; ch < 8; ++ch) { const float a = bv[ch] + wv[0][ch] * x[i][ch] + wv[1][ch] * x[i + 1][ch] + wv[2][ch] * x[i + 2][ch] + wv[3][ch] * x[i + 3][ch]; out[i][ch] = a * fast_rcp(1.0f + fast_exp(-a)); }
}
constexpr int SB = 136;
constexpr int SC_IMG = 64 * SB * 2;
__device__ __forceinline__ void phase_ssd_s1(const Frame& F, const Args& A, int layer) {
    const bf16* P = WSP(bf16, A_P); bf16* ST = WSP(bf16, S_ST); bf16* YD = WSP(bf16, S_YD); unsigned char* SCB = WSP(unsigned char, S_C); float* AC = WSP(float, S_AC);
    const float* cw = AIN(A, 23) + (size_t)layer * 4 * 1024; const float* cb = AIN(A, 24) + layer * 1024; const float* dtb = AIN(A, 25) + layer * 8; const float* a_log = AIN(A, 26) + layer * 8; const float* dsk = AIN(A, 27) + layer * 8;
    LAS bf16* Bt_ = (LAS bf16*)F.lds; LAS bf16* Ct_ = Bt_ + 64 * SB; LAS bf16* BT = Ct_ + 64 * SB; LAS bf16* xT = BT + 128 * RS;
    LAS bf16* Mb = xT + 4 * 64 * RS; LAS bf16* xdT = Mb + 2 * 64 * RS; LAS float* dt = (LAS float*)(xdT + 2 * 64 * RS); LAS float* ac = dt + 256;
    const int w = F.wave;
    const int nunits = BH * NCH * 2;
    for (int unit = F.bid; unit < nunits; unit += F.G) {
        int tid = F.tid; OPAQUE_V(tid); ASSUME(tid >= 0 && tid < 512); const int lane = tid & 63, l15 = lane & 15, q4 = lane >> 4;
        const int g = unit & 1, c = (unit >> 1) % NCH, b = unit / (2 * NCH);
        const size_t tok0 = (size_t)b * SEQ + (size_t)c * 64;
        __syncthreads();
        {
            const int cg = tid & 63, rb = tid >> 6;
            const int cidx = cg < 32 ? g * 256 + 8 * cg : cg < 48 ? 512 + g * 128 + 8 * (cg - 32) : 768 + g * 128 + 8 * (cg - 48);
            float o[8][8];
            conv8x8(P + (tok0 + 8 * rb) * PW + C_SSD + 512 + cidx, c * 64 + 8 * rb, cw + cidx, 1024, cb + cidx, o);
            if (cg < 32) {
                const int hh = cg >> 3, p0 = 8 * (cg & 7);
#pragma unroll
                for (int ch = 0; ch < 8; ++ch) { float col[8];
#pragma unroll
                    for (int i = 0; i < 8; ++i) col[i] = o[i][ch];
                    *(LAS u32x4*)(xT + (hh * 64 + p0 + ch) * RS + 8 * rb) = pack8(col); }
            } else if (cg < 48) {
                const int n0 = 8 * (cg - 32);
#pragma unroll
                for (int i = 0; i < 8; ++i) *(LAS u32x4*)(Bt_ + (8 * rb + i) * SB + n0) = pack8(o[i]);
#pragma unroll
                for (int ch = 0; ch < 8; ++ch) { float col[8];
#pragma unroll
                    for (int i = 0; i < 8; ++i) col[i] = o[i][ch];
                    *(LAS u32x4*)(BT + (n0 + ch) * RS + 8 * rb) = pack8(col); }
            } else { const int n0 = 8 * (cg - 48);
#pragma unroll
                for (int i = 0; i < 8; ++i) *(LAS u32x4*)(Ct_ + (8 * rb + i) * SB + n0) = pack8(o[i]); }
        }
        if (tid < 256) { const int hh = tid >> 6, h = 4 * g + hh; const float d = softplusf_(bf2f(P[(tok0 + lane) * PW + C_SSD + 1536 + h]) + dtb[h]); float a = -expf(a_log[h]) * d;
#pragma unroll
            for (int o = 1; o < 64; o <<= 1) { const float t = __shfl_up(a, o); if (lane >= o) a += t; }
            dt[tid] = d; ac[tid] = a; AC[(tok0 + lane) * 8 + h] = a; }
        __syncthreads();
        { unsigned char* dst = SCB + (size_t)unit * SC_IMG; for (int e = tid; e < SC_IMG / 16; e += 512) ((u32x4*)dst)[e] = ((const LAS u32x4*)Ct_)[e]; }
        f32x4 cbt[2];
#pragma unroll
        for (int tt = 0; tt < 2; ++tt) { const int tile = w * 2 + tt, ti = tile >> 2, tj = tile & 3; cbt[tt] = (f32x4){0.f, 0.f, 0.f, 0.f};
            if (tj <= ti) cbt[tt] = tile_bf(Ct_ + 16 * ti * SB, SB, Bt_ + 16 * tj * SB, SB, 128, cbt[tt], l15, q4); }
        for (int hh = 0; hh < 4; ++hh) { const int h = 4 * g + hh; LAS bf16* M = Mb + (hh & 1) * 64 * RS; LAS bf16* xd = xdT + (hh & 1) * 64 * RS; const LAS float* dth = dt + hh * 64; const LAS float* ach = ac + hh * 64;
#pragma unroll
            for (int tt = 0; tt < 2; ++tt) { const int tile = w * 2 + tt, ti = tile >> 2, tj = tile & 3;
#pragma unroll
                for (int r = 0; r < 4; ++r) { const int l = 16 * ti + 4 * q4 + r, s = 16 * tj + l15; M[l * RS + s] = (bf16)f2bf((s <= l) ? cbt[tt][r] * expf(ach[l] - ach[s]) * dth[s] : 0.f); } }
            { const int p = tid >> 3, l0 = 8 * (tid & 7); const u32x4 v = *(const LAS u32x4*)(xT + (hh * 64 + p) * RS + l0); const float a63 = ach[63]; float xv[8] = {bf2f(v.x & 0xffffu), bf2f(v.x >> 16), bf2f(v.y & 0xffffu), bf2f(v.y >> 16), bf2f(v.z & 0xffffu), bf2f(v.z >> 16), bf2f(v.w & 0xffffu), bf2f(v.w >> 16)};
#pragma unroll
              for (int i = 0; i < 8; ++i) xv[i] *= dth[l0 + i] * expf(a63 - ach[l0 + i]);
              *(LAS u32x4*)(xd + p * RS + l0) = pack8(xv); }
            __syncthreads();
#pragma unroll
            for (int tt = 0; tt < 2; ++tt) { const int tile = w * 2 + tt, ti = tile >> 2, tj = tile & 3;
                const f32x4 acc = tile_bf(M + 16 * ti * RS, RS, xT + (hh * 64 + 16 * tj) * RS, RS, 64, (f32x4){0.f, 0.f, 0.f, 0.f}, l15, q4);
                const f32x4 xs = ld_bf16x4((const bf16*)(xT + (hh * 64 + 16 * tj + l15) * RS + 16 * ti + 4 * q4));
#pragma unroll
                for (int r = 0; r < 4; ++r) YD[(tok0 + 16 * ti + 4 * q4 + r) * 512 + h * 64 + 16 * tj + l15] = (bf16)f2bf(acc[r] + dsk[h] * xs[r]); }
            bf16* st = ST + ((size_t)((b * NCH + c) * 8 + h)) * 64 * 128;
#pragma unroll
            for (int tt = 0; tt < 4; ++tt) { const int tile = w * 4 + tt, ti = tile >> 2, tj = tile & 3;
                const f32x4 acc = tile_bf(BT + 16 * ti * RS, RS, xd + 16 * tj * RS, RS, 64, (f32x4){0.f, 0.f, 0.f, 0.f}, l15, q4);
                st_bf16x4(st + (16 * tj + l15) * 128 + 16 * ti + 4 * q4, acc); }
        }
    }
    __syncthreads();
}
__device__ __forceinline__ void phase_ssd_s23(const Frame& F, const Args& A) {
    const bf16* ST = WSP(bf16, S_ST); bf16* YO = WSP(bf16, S_YO); const unsigned char* SCB = WSP(unsigned char, S_C); const float* AC = WSP(float, S_AC);
    LAS bf16* Cimg = (LAS bf16*)F.lds; LAS bf16* Hb = Cimg + 2 * 64 * SB;
    const int w = F.wave;
    const int nunits = BH * 8 * 4;
    constexpr int NCK = SC_IMG / 16;
    for (int unit = F.bid; unit < nunits; unit += F.G) {
        int tid = F.tid; OPAQUE_V(tid); ASSUME(tid >= 0 && tid < 512); const int lane = tid & 63, l15 = lane & 15, q4 = lane >> 4, hp = tid >> 5, hn = 4 * (tid & 31);
        const int ps = unit & 3, h = (unit >> 2) & 7, b = unit >> 5, g = h >> 2;
        __syncthreads();
        f32x4 Hr = (f32x4){0.f, 0.f, 0.f, 0.f};
        u32x4 preA[3], preB[3]; u32x2 pstA, pstB, stc; float eaA[5], eaB[5], eac[5];
        const size_t tokb = (size_t)b * SEQ;
#define S23_LOAD(S, cc) do { const unsigned char* src_ = SCB + (size_t)((b * NCH + (cc)) * 2 + g) * SC_IMG; \
            _Pragma("unroll") for (int q = 0; q < 3; ++q) { const int e = tid + 512 * q; if (e < NCK) pre##S[q] = *(const u32x4*)(src_ + (size_t)e * 16); } \
            pst##S = *(const u32x2*)(ST + ((size_t)((b * NCH + (cc)) * 8 + h)) * 8192 + (16 * ps + hp) * 128 + hn); \
            _Pragma("unroll") for (int r = 0; r < 4; ++r) ea##S[r] = AC[(tokb + (size_t)(cc) * 64 + 16 * (w & 3) + 4 * q4 + r) * 8 + h]; \
            ea##S[4] = AC[(tokb + (size_t)(cc) * 64 + 63) * 8 + h]; } while (0)
#define S23_STORE(S, dst) do { _Pragma("unroll") for (int q = 0; q < 3; ++q) { const int e = tid + 512 * q; if (e < NCK) ((LAS u32x4*)(dst))[e] = pre##S[q]; } } while (0)
#define S23_TAKE(S) do { stc = pst##S; _Pragma("unroll") for (int r = 0; r < 5; ++r) eac[r] = ea##S[r]; } while (0)
        S23_LOAD(A, 0); S23_STORE(A, Cimg); S23_TAKE(A);
        if (NCH > 1) S23_LOAD(A, 1);
#define S23_STEP(c, LS, SS) do { \
            const size_t tok0 = tokb + (size_t)(c) * 64; \
            if ((c) + 2 < NCH) S23_LOAD(LS, (c) + 2); \
            st_bf16x4((bf16*)(Hb + hp * SB + hn), Hr); \
            __syncthreads(); \
            if (w < 4) { const LAS bf16* Ci = Cimg + ((c) & 1) * 64 * SB; \
                const f32x4 acc = tile_bf(Ci + 16 * w * SB, SB, Hb, SB, 128, (f32x4){0.f, 0.f, 0.f, 0.f}, l15, q4); \
                _Pragma("unroll") for (int r = 0; r < 4; ++r) { const size_t tok = tok0 + 16 * w + 4 * q4 + r; YO[tok * 512 + h * 64 + 16 * ps + l15] = (bf16)f2bf(acc[r] * expf(eac[r])); } } \
            { const float dec = expf(eac[4]); Hr.x = dec * Hr.x + bf2f(stc.x & 0xffffu); Hr.y = dec * Hr.y + bf2f(stc.x >> 16); Hr.z = dec * Hr.z + bf2f(stc.y & 0xffffu); Hr.w = dec * Hr.w + bf2f(stc.y >> 16); } \
            if ((c) + 1 < NCH) { S23_STORE(SS, Cimg + (((c) + 1) & 1) * 64 * SB); S23_TAKE(SS); } \
            __syncthreads(); } while (0)
        for (int c = 0; c < NCH; c += 2) { S23_STEP(c, B, A); S23_STEP(c + 1, A, B); }
#undef S23_STEP
#undef S23_TAKE
#undef S23_STORE
#undef S23_LOAD
    }
    __syncthreads();
}
__device__ __forceinline__ void phase_ssd_s4(const Frame& F, const Args& A, int layer) {
    const bf16* YD = WSP(bf16, S_YD); const bf16* YO = WSP(bf16, S_YO); const bf16* P = WSP(bf16, A_P); bf16* Y = WSP(bf16, A_Y) + (size_t)3 * TH * 512; const float* nw = AIN(A, 28) + layer * 512;
    const int lane = F.lane, c0 = 8 * lane;
    for (int m = F.gw; m < TH; m += F.NGW) {
        const f32x4 a = ld_bf16x4(YD + (size_t)m * 512 + c0) + ld_bf16x4(YO + (size_t)m * 512 + c0), b2 = ld_bf16x4(YD + (size_t)m * 512 + c0 + 4) + ld_bf16x4(YO + (size_t)m * 512 + c0 + 4);
        const f32x4 z0 = ld_bf16x4(P + (size_t)m * PW + C_SSD + c0), z1 = ld_bf16x4(P + (size_t)m * PW + C_SSD + c0 + 4);
        float y[8] = {a.x * siluf_(z0.x), a.y * siluf_(z0.y), a.z * siluf_(z0.z), a.w * siluf_(z0.w), b2.x * siluf_(z1.x), b2.y * siluf_(z1.y), b2.z * siluf_(z1.z), b2.w * siluf_(z1.w)};
        float ss = 0.f;
#pragma unroll
        for (int q = 0; q < 8; ++q) ss += y[q] * y[q];
        ss = red_sum<32>(ss);
        const float rstd = RSQRT(ss * (1.0f / 256.0f) + EPS);
#pragma unroll
        for (int q = 0; q < 8; ++q) y[q] = y[q] * rstd * nw[c0 + q];
        u32x4 wv; wv.x = pk2(y[0], y[1]); wv.y = pk2(y[2], y[3]); wv.z = pk2(y[4], y[5]); wv.w = pk2(y[6], y[7]);
        *(u32x4*)(Y + (size_t)m * 512 + c0) = wv;
    }
}

__device__ __forceinline__ f32x4 tile_mm(const LAS float* a, int lda, int ska, const LAS float* b, int ldb, int scb, int K, f32x4 acc, int l15, int q4) {
    const LAS float* ap = a + l15 * lda + q4 * ska; const LAS float* bp = b + q4 * ldb + l15 * scb;
#pragma unroll 8
    for (int ks = 0; ks < K / 4; ++ks) acc = MFMA_F32(ap[ks * 4 * ska], bp[ks * 4 * ldb], acc);
    return acc;
}
constexpr int GS = 132, GS2 = 68;
constexpr int GR_W = 0, GR_QH = 64 * 136 * 2, GR_KT = 2 * 64 * 136 * 2, GR_QK = GR_KT + 128 * 72 * 2, GR_GL = GR_QK + 64 * 72 * 2, GR_COMMON = GR_GL + 16, GR_UT = 128 * 64 * 2, GR_BYTES = GR_COMMON + GR_UT;
static_assert(GR_BYTES == 78864 && GR_COMMON % 16 == 0, "GDN record");
constexpr int GX = 264;
__device__ __forceinline__ void phase_gdn_g1(const Frame& F, const Args& A, int layer) {
    const bf16* P = WSP(bf16, A_P); unsigned char* CHR = WSP(unsigned char, G_CH);
    const float* convw = AIN(A, 19) + (size_t)layer * 4 * 1536; const float* a_log = AIN(A, 20) + layer * 4; const float* dtb = AIN(A, 21) + layer * 4;
    LAS bf16* qb = (LAS bf16*)F.lds; LAS bf16* kb = qb + 64 * SB; LAS bf16* qkimg = kb + 64 * SB;
    LAS float* X = (LAS float*)(qkimg + 64 * RS); LAS float* Lm = X + 64 * GX; LAS float* ssq = Lm + 64 * GS2;
    LAS float* beta = ssq + 2 * 64 * 16; LAS float* gc = beta + 64; LAS float* egc = gc + 64; LAS float* inorm = egc + 64;
    const int w = F.wave;
    const int nunits = BH * 4 * NCH;
    for (int unit = F.bid; unit < nunits; unit += F.G) {
        int tid = F.tid; OPAQUE_V(tid); ASSUME(tid >= 0 && tid < 512); const int lane = tid & 63, l15 = lane & 15, q4 = lane >> 4;
        const int c = unit % NCH, h = (unit / NCH) & 3, b = unit / (NCH * 4);
        const size_t tok0 = (size_t)b * SEQ + (size_t)c * 64;
        unsigned char* rec = CHR + (size_t)unit * GR_BYTES;
        __syncthreads();
        const int rb = tid / 48, pc = tid % 48, part = pc >> 4, cgl = pc & 15;
        float o[8][8];
        if (tid < 384) { const int col = part * 512 + h * 128 + 8 * cgl;
            conv8x8(P + (tok0 + 8 * rb) * PW + C_GDN + col, c * 64 + 8 * rb, convw + col, 1536, nullptr, o);
            if (part < 2) {
#pragma unroll
                for (int i = 0; i < 8; ++i) { float sacc = 0.f;
#pragma unroll
                    for (int ch = 0; ch < 8; ++ch) sacc += o[i][ch] * o[i][ch];
                    ssq[(part * 64 + 8 * rb + i) * 16 + cgl] = sacc; } } }
        if (w == 7) { const size_t tok = tok0 + lane; beta[lane] = sigmoidf_(bf2f(P[tok * PW + C_GDN + 1536 + h]));
            float g = -expf(a_log[h]) * softplusf_(bf2f(P[tok * PW + C_GDN + 1540 + h]) + dtb[h]);
#pragma unroll
            for (int o2 = 1; o2 < 64; o2 <<= 1) { const float t = __shfl_up(g, o2); if (lane >= o2) g += t; }
            gc[lane] = g; egc[lane] = expf(g); }
        __syncthreads();
        if (tid < 128) { float sacc = 0.f;
#pragma unroll
            for (int i = 0; i < 16; ++i) sacc += ssq[tid * 16 + i];
            inorm[tid] = (tid < 64 ? 0.08838834764831845f : 1.0f) * RSQRT(sacc + EPS); }
        __syncthreads();
        if (tid < 384) {
#pragma unroll
            for (int i = 0; i < 8; ++i) { const int l = 8 * rb + i;
                if (part < 2) { const float sc = inorm[part * 64 + l]; float v[8];
#pragma unroll
                    for (int ch = 0; ch < 8; ++ch) v[ch] = o[i][ch] * sc;
                    *(LAS u32x4*)((part ? kb : qb) + l * SB + 8 * cgl) = pack8(v); }
                else { const float bl = beta[l]; *(LAS f32x4*)(X + l * GX + 8 * cgl) = (f32x4){o[i][0] * bl, o[i][1] * bl, o[i][2] * bl, o[i][3] * bl}; *(LAS f32x4*)(X + l * GX + 8 * cgl + 4) = (f32x4){o[i][4] * bl, o[i][5] * bl, o[i][6] * bl, o[i][7] * bl}; } } }
        __syncthreads();
        { const int which = w >> 2, ti = w & 3; const LAS bf16* Aop = which ? qb : kb;
          bf16x8 aF[4]; f32x4 acc[4];
#pragma unroll
          for (int ks = 0; ks < 4; ++ks) aF[ks] = *(const LAS bf16x8*)(Aop + (16 * ti + l15) * SB + 8 * q4 + 32 * ks);
#pragma unroll
          for (int tj = 0; tj < 4; ++tj) { acc[tj] = (f32x4){0.f, 0.f, 0.f, 0.f};
#pragma unroll
              for (int ks = 0; ks < 4; ++ks) acc[tj] = MFMA_BF16(aF[ks], *(const LAS bf16x8*)(kb + (16 * tj + l15) * SB + 8 * q4 + 32 * ks), acc[tj]); }
          if (which) {
#pragma unroll
              for (int tj = 0; tj < 4; ++tj)
#pragma unroll
                  for (int r = 0; r < 4; ++r) { const int i = 16 * ti + 4 * q4 + r, j = 16 * tj + l15; const float v = (j <= i) ? acc[tj][r] * expf(gc[i] - gc[j]) : 0.f; qkimg[i * RS + j] = (bf16)f2bf(v); }
          } else {
#pragma unroll
              for (int tj = 0; tj < 4; ++tj)
#pragma unroll
                  for (int r = 0; r < 4; ++r) { const int i = 16 * ti + 4 * q4 + r, j = 16 * tj + l15; const float v = (j < i) ? acc[tj][r] * expf(gc[i] - gc[j]) * beta[i] : 0.f; Lm[i * GS2 + j] = v; }
          } }
        { const float glast = gc[63];
          for (int e = tid; e < 64 * 16; e += 512) { const int l = e >> 4, d0 = 8 * (e & 15); const u32x4 kv = *(const LAS u32x4*)(kb + l * SB + d0), qv = *(const LAS u32x4*)(qb + l * SB + d0);
              const float kf[8] = {bf2f(kv.x & 0xffffu), bf2f(kv.x >> 16), bf2f(kv.y & 0xffffu), bf2f(kv.y >> 16), bf2f(kv.z & 0xffffu), bf2f(kv.z >> 16), bf2f(kv.w & 0xffffu), bf2f(kv.w >> 16)};
              float qf[8] = {bf2f(qv.x & 0xffffu), bf2f(qv.x >> 16), bf2f(qv.y & 0xffffu), bf2f(qv.y >> 16), bf2f(qv.z & 0xffffu), bf2f(qv.z >> 16), bf2f(qv.w & 0xffffu), bf2f(qv.w >> 16)};
              const float sc = beta[l] * egc[l], eg = egc[l];
              *(LAS f32x4*)(X + l * GX + 128 + d0) = (f32x4){kf[0] * sc, kf[1] * sc, kf[2] * sc, kf[3] * sc}; *(LAS f32x4*)(X + l * GX + 132 + d0) = (f32x4){kf[4] * sc, kf[5] * sc, kf[6] * sc, kf[7] * sc};
#pragma unroll
              for (int q = 0; q < 8; ++q) qf[q] *= eg;
              *(u32x4*)(rec + GR_QH + (size_t)(l * SB + d0) * 2) = pack8(qf); }
          for (int e = tid; e < 128 * 8; e += 512) { const int d = e >> 3, l0 = 8 * (e & 7); float kt[8];
#pragma unroll
              for (int q = 0; q < 8; ++q) kt[q] = bf2f(kb[(l0 + q) * SB + d]) * expf(glast - gc[l0 + q]);
              *(u32x4*)(rec + GR_KT + (size_t)(d * RS + l0) * 2) = pack8(kt); }
          if (tid == 0) *(float*)(rec + GR_GL) = expf(glast); }
        __syncthreads();
        for (int e = tid; e < 64 * RS / 8; e += 512) ((u32x4*)(rec + GR_QK))[e] = ((const LAS u32x4*)qkimg)[e];
        tri_solve64(Lm, GS2, X, GX, 16, ssq, w, l15, q4);
        __syncthreads();
        for (int e = tid; e < 64 * 16; e += 512) { const int l = e >> 4, d0 = 8 * (e & 15); const f32x4 a = *(const LAS f32x4*)(X + l * GX + 128 + d0), b2 = *(const LAS f32x4*)(X + l * GX + 132 + d0);
            const float v[8] = {a.x, a.y, a.z, a.w, b2.x, b2.y, b2.z, b2.w}; *(u32x4*)(rec + GR_W + (size_t)(l * SB + d0) * 2) = pack8(v); }
        for (int e = tid; e < 128 * 8; e += 512) { const int vv = e >> 3, t0 = 8 * (e & 7); float v[8];
#pragma unroll
            for (int q = 0; q < 8; ++q) v[q] = X[(t0 + q) * GX + vv];
            *(u32x4*)((bf16*)(rec + GR_COMMON) + vv * 64 + t0) = pack8(v); }
    }
    __syncthreads();
}
constexpr int G2_STAGE = GR_COMMON;
__device__ __forceinline__ void phase_gdn_g2(const Frame& F, const Args& A) {
    const unsigned char* CHR = WSP(unsigned char, G_CH); bf16* GO = WSP(bf16, G_O);
    LAS unsigned char* buf0 = F.lds; LAS bf16* STt = (LAS bf16*)(F.lds + 2 * G2_STAGE); LAS bf16* vnT = STt + 2 * 32 * SB;
    const int w = F.wave, ti = w >> 1, tj = w & 1;
    const int nunits = BH * 4 * 4;
    constexpr int NCK = G2_STAGE / 16;
    for (int unit = F.bid; unit < nunits; unit += F.G) {
        int tid = F.tid; OPAQUE_V(tid); ASSUME(tid >= 0 && tid < 512); const int lane = tid & 63, l15 = lane & 15, q4 = lane >> 4;
        const int vs = unit & 3, h = (unit >> 2) & 3, b = unit >> 4;
        __syncthreads();
        for (int e = tid; e < 2 * 32 * SB / 2; e += 512) ((LAS unsigned*)STt)[e] = 0u;
        f32x4 Sreg[2] = {(f32x4){0.f, 0.f, 0.f, 0.f}, (f32x4){0.f, 0.f, 0.f, 0.f}};
        u32x4 preA[8], preB[8]; u32x2 uiniA, uiniB, ucur;
        const unsigned char* rec0 = CHR + (size_t)((b * 4 + h) * NCH) * GR_BYTES;
        const int uofs = GR_COMMON + ((32 * vs + 16 * tj + l15) * 64 + 16 * ti + 4 * q4) * 2;
#define G2_LOAD(S, recp) do { _Pragma("unroll") for (int q = 0; q < 8; ++q) { const int e = tid + 512 * q; if (e < NCK) pre##S[q] = *(const u32x4*)((recp) + (size_t)e * 16); } uini##S = *(const u32x2*)((recp) + uofs); } while (0)
#define G2_STORE(S, dst) do { _Pragma("unroll") for (int q = 0; q < 8; ++q) { const int e = tid + 512 * q; if (e < NCK) *(LAS u32x4*)((dst) + (size_t)e * 16) = pre##S[q]; } } while (0)
        G2_LOAD(A, rec0); G2_STORE(A, buf0); ucur = uiniA;
        if (NCH > 1) G2_LOAD(A, rec0 + (size_t)GR_BYTES);
        __syncthreads();
#define G2_STEP(c, LS, SS) do { \
            LAS unsigned char* buf = buf0 + ((c) & 1) * G2_STAGE; LAS unsigned char* nbuf = buf0 + (((c) + 1) & 1) * G2_STAGE; \
            if ((c) + 2 < NCH) G2_LOAD(LS, rec0 + (size_t)((c) + 2) * GR_BYTES); \
            const LAS bf16* Wi = (const LAS bf16*)(buf + GR_W); const LAS bf16* QH = (const LAS bf16*)(buf + GR_QH); const LAS bf16* KT = (const LAS bf16*)(buf + GR_KT); const LAS bf16* QK = (const LAS bf16*)(buf + GR_QK); \
            const float egl = *(const LAS float*)(buf + GR_GL); \
            const LAS bf16* S0 = STt + ((c) & 1) * 32 * SB; LAS bf16* S1 = STt + (((c) + 1) & 1) * 32 * SB; \
            { const f32x4 acc = tile_bf(Wi + 16 * ti * SB, SB, S0 + 16 * tj * SB, SB, 128, (f32x4){0.f, 0.f, 0.f, 0.f}, l15, q4); \
              const f32x4 vn = (f32x4){bf2f(ucur.x & 0xffffu), bf2f(ucur.x >> 16), bf2f(ucur.y & 0xffffu), bf2f(ucur.y >> 16)} - acc; \
              u32x2 pk; pk.x = pk2(vn[0], vn[1]); pk.y = pk2(vn[2], vn[3]); *(LAS u32x2*)(vnT + (16 * tj + l15) * RS + 16 * ti + 4 * q4) = pk; } \
            __syncthreads(); \
            { f32x4 acc = tile_bf(QH + 16 * ti * SB, SB, S0 + 16 * tj * SB, SB, 128, (f32x4){0.f, 0.f, 0.f, 0.f}, l15, q4); \
              acc = tile_bf(QK + 16 * ti * RS, RS, vnT + 16 * tj * RS, RS, 64, acc, l15, q4); \
              _Pragma("unroll") for (int r = 0; r < 4; ++r) GO[((size_t)b * SEQ + (size_t)(c) * 64 + 16 * ti + 4 * q4 + r) * 512 + h * 128 + 32 * vs + 16 * tj + l15] = (bf16)f2bf(acc[r]); } \
            _Pragma("unroll") for (int t2 = 0; t2 < 2; ++t2) { Sreg[t2] = Sreg[t2] * egl; \
                Sreg[t2] = tile_bf(KT + 16 * w * RS, RS, vnT + 16 * t2 * RS, RS, 64, Sreg[t2], l15, q4); \
                u32x2 pk; pk.x = pk2(Sreg[t2][0], Sreg[t2][1]); pk.y = pk2(Sreg[t2][2], Sreg[t2][3]); *(LAS u32x2*)(S1 + (16 * t2 + l15) * SB + 16 * w + 4 * q4) = pk; } \
            if ((c) + 1 < NCH) { G2_STORE(SS, nbuf); ucur = uini##SS; } \
            __syncthreads(); } while (0)
        for (int c = 0; c < NCH; c += 2) { G2_STEP(c, B, A); G2_STEP(c + 1, A, B); }
#undef G2_STEP
#undef G2_STORE
#undef G2_LOAD
    }
    __syncthreads();
}
__device__ __forceinline__ void phase_gdn_g3(const Frame& F, const Args& A, int layer) {
    const bf16* GO = WSP(bf16, G_O); const bf16* P = WSP(bf16, A_P); bf16* Y = WSP(bf16, A_Y) + (size_t)2 * TH * 512; const float* nw = AIN(A, 22) + layer * 128;
    const int lane = F.lane, c0 = 8 * lane;
    for (int m = F.gw; m < TH; m += F.NGW) {
        const f32x4 a = ld_bf16x4(GO + (size_t)m * 512 + c0), b2 = ld_bf16x4(GO + (size_t)m * 512 + c0 + 4);
        float o[8] = {a.x, a.y, a.z, a.w, b2.x, b2.y, b2.z, b2.w}; float ss = 0.f;
#pragma unroll
        for (int q = 0; q < 8; ++q) ss += o[q] * o[q];
        ss = red_sum<16>(ss);
        const float rstd = RSQRT(ss * (1.0f / 128.0f) + EPS);
        const f32x4 z0 = ld_bf16x4(P + (size_t)m * PW + C_GDN + 1544 + c0), z1 = ld_bf16x4(P + (size_t)m * PW + C_GDN + 1544 + c0 + 4);
        const float z[8] = {z0.x, z0.y, z0.z, z0.w, z1.x, z1.y, z1.z, z1.w}; float y[8];
#pragma unroll
        for (int q = 0; q < 8; ++q) y[q] = o[q] * rstd * nw[(c0 + q) & 127] * siluf_(z[q]);
        u32x4 wv; wv.x = pk2(y[0], y[1]); wv.y = pk2(y[2], y[3]); wv.z = pk2(y[4], y[5]); wv.w = pk2(y[6], y[7]);
        *(u32x4*)(Y + (size_t)m * 512 + c0) = wv;
    }
}

__device__ __forceinline__ void phase_merge_z(const Frame& F, const Args& A) {
    pg8::Gemm g{WSP(bf16, A_Y), WSP(bf16, W_BR), 512, 512}; BranchOrder S; S.nP = TH / 256; S.G = F.G; S.c = F.bid;
    EpiZ E{WSP(bf16, A_Z)}; pg8::gemm_phase(F.lds, g, S, E, F.tid);
}
__device__ __forceinline__ void phase_merge_gate(const Frame& F, const Args& A, int layer) {
    pg8::Gemm g{WSP(bf16, A_H), WSP(bf16, W_GATE), D, D}; pg8::StaticOrder S; S.init(TH, 4096, F.G, F.bid);
    EpiMerge E{WSP(bf16, A_Z), AIN(A, 29) + (size_t)layer * 4 * D, WSP(bf16, A_MG)}; pg8::gemm_phase(F.lds, g, S, E, F.tid);
}
__device__ __forceinline__ void phase_merge_out(const Frame& F, const Args& A, const float* xin, float* xout) {
    pg8::Gemm g{WSP(bf16, A_MG), WSP(bf16, W_OUT), D, D}; pg8::StaticOrder S; S.init(TH, D, F.G, F.bid);
    EpiResidual E{xin, xout}; pg8::gemm_phase(F.lds, g, S, E, F.tid);
}
__device__ __forceinline__ void phase_ffn_gu(const Frame& F, const Args& A) {
    pg8::Gemm g{WSP(bf16, A_H), WSP(bf16, W_FGU), D, D}; pg8::StaticOrder S; S.init(TH, 2 * FF_D, F.G, F.bid);
    EpiSwiGLU E{WSP(bf16, F_ACT), FF_D, 1 << 20}; pg8::gemm_phase(F.lds, g, S, E, F.tid);
}
__device__ __forceinline__ void phase_ffn_down(const Frame& F, const Args& A, float* x) {
    pg8::Gemm g{WSP(bf16, F_ACT), WSP(bf16, W_FDN), FF_D, FF_D}; pg8::StaticOrder S; S.init(TH, D, F.G, F.bid);
    EpiResidual E{x, x}; pg8::gemm_phase(F.lds, g, S, E, F.tid);
}
struct MoeLayout { int pstart[NEXP + 1]; };
__device__ __forceinline__ MoeLayout moe_layout(const unsigned* cnt) {
    MoeLayout L; int s = 0;
#pragma unroll
    for (int e = 0; e < NEXP; ++e) { L.pstart[e] = s; s += ((int)cnt[e] + 255) & ~255; }
    L.pstart[NEXP] = s; return L;
}
struct MoeOrder {
    int np, nN, G, c; MoeLayout L;
    __device__ bool next(int i, Unit& u) const {
        const long Lx = (long)i * G + c; if (Lx >= (long)np * nN) return false;
        const int pm = (int)(Lx / nN), pn = (int)(Lx % nN); int e = 0;
#pragma unroll
        for (int k = 1; k < NEXP; ++k) if (pm * 256 >= L.pstart[k]) e = k;
        u.pm = pm; u.pn = e * nN + pn; return true;
    }
    __device__ __forceinline__ void a_ready(const Unit&) const {}
    __device__ __forceinline__ void done(const Unit&) const {}
};
__device__ __forceinline__ void phase_moe_route(const Frame& F, const Args& A, int half) {
    const unsigned* wgc = (const unsigned*)(F.ctl + CW_WGC + half * 8192); unsigned* cnt = (unsigned*)(F.ctl + CW_CNT + half * 16);
    LAS unsigned* tab = (LAS unsigned*)F.lds; LAS unsigned* tot = tab + 8192; LAS unsigned* bef = tot + 8; LAS unsigned* cur = bef + 8;
    __syncthreads();
    for (int e = F.tid; e < F.G * 8; e += 512) tab[e] = wgc[e];
    __syncthreads();
    if (F.tid < 8) { unsigned t = 0, bsum = 0; for (int g = 0; g < F.G; ++g) { const unsigned v = tab[g * 8 + F.tid]; if (g < F.bid) bsum += v; t += v; } tot[F.tid] = t; bef[F.tid] = bsum; cur[F.tid] = 0u; if (F.bid == 0) cnt[F.tid] = t; }
    __syncthreads();
    unsigned totr[8];
#pragma unroll
    for (int e = 0; e < 8; ++e) totr[e] = tot[e];
    const MoeLayout L = moe_layout(totr);
    const bf16* H = WSP(bf16, A_H); bf16* GA = WSP(bf16, F_GA); const int* tope = WSP(int, F_TOPE); int* slot = WSP(int, F_SLOT);
    const int lane = F.lane;
    for (int m = F.gw; m < TH; m += F.NGW) {
        const u32x4 v0 = *(const u32x4*)(H + (size_t)m * D + 8 * lane), v1 = *(const u32x4*)(H + (size_t)m * D + 512 + 8 * lane);
#pragma unroll
        for (int k = 0; k < 2; ++k) { const int e = tope[2 * m + k]; int s = 0;
            int ps = 0;
#pragma unroll
            for (int q = 0; q < NEXP; ++q) ps = (e == q) ? L.pstart[q] : ps;
            if (lane == 0) s = ps + (int)bef[e] + (int)ATOMIC_ADD_LDS(cur + e, 1u);
            s = bcast0(s);
            if (lane == 0) slot[2 * m + k] = s;
            *(u32x4*)(GA + (size_t)s * D + 8 * lane) = v0; *(u32x4*)(GA + (size_t)s * D + 512 + 8 * lane) = v1; }
    }
#pragma unroll
    for (int e = 0; e < NEXP; ++e) { const int r0 = L.pstart[e] + (int)totr[e], r1 = L.pstart[e + 1];
        for (int r = r0 + F.gw; r < r1; r += F.NGW) { *(u32x4*)(GA + (size_t)r * D + 8 * lane) = (u32x4){0u, 0u, 0u, 0u}; *(u32x4*)(GA + (size_t)r * D + 512 + 8 * lane) = (u32x4){0u, 0u, 0u, 0u}; } }
    __syncthreads();
}
__device__ __forceinline__ void phase_moe_gu(const Frame& F, const Args& A, int half) {
    MoeOrder S; S.L = moe_layout((const unsigned*)(F.ctl + CW_CNT + half * 16)); S.np = S.L.pstart[NEXP] / 256; S.nN = 2 * FF_E / 256; S.G = F.G; S.c = F.bid;
    pg8::Gemm g{WSP(bf16, F_GA), WSP(bf16, W_FGU), D, D}; EpiSwiGLU E{WSP(bf16, F_ACT), FF_E, 2 * FF_E / 256}; pg8::gemm_phase(F.lds, g, S, E, F.tid);
}
struct EpiBf16Mod {
    static constexpr bool PERM = true, AFTER_DRAIN = false;
    bf16* C;
    __device__ __forceinline__ void operator()(const f32x4 (&acc)[2][2][4][2], const Unit& u, int wr, int wc, int fr, int fq) const {
        const int row0 = u.pm * 256 + wr * 64 + fr, col0 = (u.pn & 3) * 256 + wc * 32 + 8 * fq;
#pragma unroll
        for (int ai = 0; ai < 2; ++ai)
#pragma unroll
            for (int m = 0; m < 4; ++m) { bf16* rowp = C + (size_t)(row0 + ai * HALFT + m * 16) * D + col0;
#pragma unroll
                for (int bj = 0; bj < 2; ++bj) { const f32x4 v0 = acc[ai][bj][m][0], v1 = acc[ai][bj][m][1];
                    u32x4 w; w.x = pk2(v0[0], v0[1]); w.y = pk2(v0[2], v0[3]); w.z = pk2(v1[0], v1[1]); w.w = pk2(v1[2], v1[3]);
                    *(u32x4*)(rowp + bj * HALFT) = w; } }
    }
};
struct MoeTailOrder {
    int ntail, G, c; MoeLayout L;
    __device__ bool next(int i, Unit& u) const {
        const int j = i * G + c; if (j >= ntail * MOE_KSPLIT) return false;
        const int t = j / MOE_KSPLIT, ch = j % MOE_KSPLIT, pm = MOE_MAINP + (t >> 2); int e = 0;
#pragma unroll
        for (int k = 1; k < NEXP; ++k) if (pm * 256 >= L.pstart[k]) e = k;
        u.pm = pm; u.pn = e * 4 + (t & 3); u.kb = ch * (FF_E / MOE_KSPLIT) * 2; return true;
    }
    __device__ __forceinline__ void a_ready(const Unit&) const {}
    __device__ __forceinline__ void done(const Unit&) const {}
};
struct EpiPart {
    static constexpr bool PERM = false, AFTER_DRAIN = false;
    float* C;
    __device__ __forceinline__ void operator()(const f32x4 (&acc)[2][2][4][2], const Unit& u, int wr, int wc, int fr, int fq) const {
        const int ch = u.kb / ((FF_E / MOE_KSPLIT) * 2);
        const int row0 = ch * (MOE_ROWS - 2 * TH) + (u.pm - MOE_MAINP) * 256 + wr * 64 + fr, col0 = (u.pn & 3) * 256 + wc * 32 + 4 * fq;
#pragma unroll
        for (int ai = 0; ai < 2; ++ai)
#pragma unroll
            for (int m = 0; m < 4; ++m) { float* rowp = C + (size_t)(row0 + ai * HALFT + m * 16) * D + col0;
#pragma unroll
                for (int bj = 0; bj < 2; ++bj)
#pragma unroll
                    for (int n = 0; n < 2; ++n) *(f32x4*)(rowp + bj * HALFT + n * 16) = acc[ai][bj][m][n]; }
    }
};
static_assert(FF_E % (MOE_KSPLIT * 128) == 0, "split-K chunks are an even number of K tiles");
__device__ __forceinline__ void phase_moe_down(const Frame& F, const Args& A, int half) {
    const MoeLayout L = moe_layout((const unsigned*)(F.ctl + CW_CNT + half * 16)); const int np = L.pstart[NEXP] / 256;
    { MoeOrder S; S.L = L; S.np = np < MOE_MAINP ? np : MOE_MAINP; S.nN = D / 256; S.G = F.G; S.c = F.bid;
      pg8::Gemm g{WSP(bf16, F_ACT), WSP(bf16, W_FDN), FF_E, FF_E}; EpiBf16Mod E{WSP(bf16, F_YE)}; pg8::gemm_phase(F.lds, g, S, E, F.tid); }
    __syncthreads();
    { MoeTailOrder S; S.L = L; S.ntail = (np > MOE_MAINP ? np - MOE_MAINP : 0) * 4; S.G = F.G; S.c = F.bid;
      pg8::Gemm g{WSP(bf16, F_ACT), WSP(bf16, W_FDN), FF_E, FF_E / MOE_KSPLIT, FF_E}; EpiPart E{WSP(float, F_PART)}; pg8::gemm_phase(F.lds, g, S, E, F.tid); }
}
__device__ __forceinline__ void phase_moe_combine(const Frame& F, const Args& A, float* x, const float* fgain) {
    const bf16* YE = WSP(bf16, F_YE); const float* PT = WSP(float, F_PART); const int* slot = WSP(int, F_SLOT); const float* topw = WSP(float, F_TOPW); const int lane = F.lane;
    for (int m = F.gw; m < TH; m += F.NGW) { const int s0 = slot[2 * m], s1 = slot[2 * m + 1]; const float w0 = topw[2 * m], w1 = topw[2 * m + 1];
        f32x4 v[4]; float ss = 0.f;
#pragma unroll
        for (int j = 0; j < 4; ++j) { const int c = 4 * lane + 256 * j;
            f32x4 y0, y1;
            if (s0 < 2 * TH) y0 = ld_bf16x4(YE + (size_t)s0 * D + c); else { y0 = (f32x4){0.f, 0.f, 0.f, 0.f};
#pragma unroll
                for (int ch = 0; ch < MOE_KSPLIT; ++ch) y0 = y0 + *(const f32x4*)(PT + ((size_t)ch * (MOE_ROWS - 2 * TH) + (s0 - 2 * TH)) * D + c); }
            if (s1 < 2 * TH) y1 = ld_bf16x4(YE + (size_t)s1 * D + c); else { y1 = (f32x4){0.f, 0.f, 0.f, 0.f};
#pragma unroll
                for (int ch = 0; ch < MOE_KSPLIT; ++ch) y1 = y1 + *(const f32x4*)(PT + ((size_t)ch * (MOE_ROWS - 2 * TH) + (s1 - 2 * TH)) * D + c); }
            v[j] = *(const f32x4*)(x + (size_t)m * D + c) + y0 * w0 + y1 * w1;
            ss += (v[j].x * v[j].x + v[j].y * v[j].y) + (v[j].z * v[j].z + v[j].w * v[j].w); }
        if (fgain) { const float rstd = RSQRT(wave_sum(ss) * (1.0f / D) + EPS);
#pragma unroll
            for (int j = 0; j < 4; ++j) v[j] = v[j] * rstd * *(const f32x4*)(fgain + 4 * lane + 256 * j); }
#pragma unroll
        for (int j = 0; j < 4; ++j) *(f32x4*)(x + (size_t)m * D + 4 * lane + 256 * j) = v[j]; }
}

#ifndef EMU
#define XB_TMO      128
#define XB_XCNT(j)  (256  + 64 * (j))
#define XB_XSUB(j)  (1280 + 64 * (j))
#define XB_XGEN(j)  (2304 + 64 * (j))
#define XB_TOP      3328
#define XB_TOPGEN   3392
#define XCD_BAR_WORDS 3456
#define XB_SPIN_CAP (1u << 22)
__device__ __forceinline__ unsigned xb_ld(unsigned* p)              { return __hip_atomic_load(p, __ATOMIC_RELAXED, __HIP_MEMORY_SCOPE_AGENT); }
__device__ __forceinline__ unsigned xb_add(unsigned* p, unsigned v) { return __hip_atomic_fetch_add(p, v, __ATOMIC_RELAXED, __HIP_MEMORY_SCOPE_AGENT); }
__device__ __forceinline__ unsigned xb_xcc_id() { return (unsigned)__builtin_amdgcn_s_getreg((3 << 11) | 20) & 0xFu; }
#define XB_SPIN(cond, bar) do { unsigned _sp = 0; while (cond) { __builtin_amdgcn_s_sleep(1); \
    if ((++_sp & 255u) == 0u) { if (xb_ld(&(bar)[XB_TMO])) break; if (_sp > XB_SPIN_CAP) { atomicAdd(&(bar)[XB_TMO], 1u); break; } } } } while (0)
struct XcdBarrier { unsigned* bar; unsigned x; volatile LAS unsigned* st; };
__device__ __forceinline__ XcdBarrier xcd_barrier_post(unsigned* bar, volatile LAS unsigned* st) {
    XcdBarrier b; b.bar = bar; b.x = xb_xcc_id(); b.st = st;
    if (threadIdx.x == 0) (void)xb_add(&bar[XB_XCNT(b.x)], 1u);
    return b;
}
__device__ __forceinline__ void xcd_barrier_complete(unsigned* bar, unsigned x, unsigned& nloc, unsigned& nx) {
    const unsigned G = gridDim.x * gridDim.y * gridDim.z;
    unsigned sum, cnt, mine, sp = 0u;
    for (;;) {
        sum = 0u; cnt = 0u; mine = 0u;
#pragma unroll
        for (unsigned j = 0; j < 16; ++j) { const unsigned c = xb_ld(&bar[XB_XCNT(j)]); sum += c; cnt += (c > 0u) ? 1u : 0u; mine = (j == x) ? c : mine; }
        if (sum == G) break;
        __builtin_amdgcn_s_sleep(1);
        if ((++sp & 255u) == 0u) { if (xb_ld(&bar[XB_TMO])) break; if (sp > XB_SPIN_CAP) { atomicAdd(&bar[XB_TMO], 1u); break; } }
    }
    nloc = mine > 0u ? mine : 1u; nx = cnt > 0u ? cnt : 1u;
}
__device__ __forceinline__ void xcd_barrier(const XcdBarrier& b) {
    asm volatile("s_waitcnt vmcnt(0)" ::: "memory");
    __syncthreads();
    if (threadIdx.x == 0) {
        unsigned* bar = b.bar;
        __builtin_amdgcn_s_waitcnt(0);
        unsigned nloc = b.st[0], nx = b.st[1];
        if (nloc == 0u) { xcd_barrier_complete(bar, b.x, nloc, nx); b.st[0] = nloc; b.st[1] = nx; }
        const unsigned old = xb_add(&bar[XB_XSUB(b.x)], 1u);
        const unsigned gen = old / nloc;
        if (old + 1u == (gen + 1u) * nloc) {
            __builtin_amdgcn_fence(__ATOMIC_RELEASE, "agent");
            asm volatile("s_waitcnt vmcnt(0)" ::: "memory");
            const unsigned og = xb_add(&bar[XB_TOP], 1u);
            const unsigned tg = og / nx;
            if (og + 1u == (tg + 1u) * nx) xb_add(&bar[XB_TOPGEN], 1u);
            else XB_SPIN(xb_ld(&bar[XB_TOPGEN]) == tg, bar);
            __builtin_amdgcn_fence(__ATOMIC_ACQUIRE, "agent");
            xb_add(&bar[XB_XGEN(b.x)], 1u);
            asm volatile("s_waitcnt vmcnt(0)" ::: "memory");
        } else {
            XB_SPIN(xb_ld(&bar[XB_XGEN(b.x)]) == gen, bar);
            __builtin_amdgcn_fence(__ATOMIC_ACQUIRE, "agent");
            asm volatile("s_waitcnt vmcnt(0)" ::: "memory");
        }
    }
    __syncthreads();
}
#endif

constexpr int NPHASES = DEPTH + NHALF * (14 + 16);
constexpr int LDS_BYTES = 155648, MISC_OFF = 154624;

__global__ void __launch_bounds__(512, 2) fwd_kernel(Args args_k) {
#ifdef EMU
    unsigned char* lds = emu_lds_ptr;
#else
    extern __shared__ __attribute__((aligned(16))) unsigned char lds[];
#endif
    Frame F0;
    F0.lds = (LAS unsigned char*)lds; F0.tid = threadIdx.x; F0.lane = F0.tid & 63; F0.wave = RFL(F0.tid >> 6); F0.G = gridDim.x; F0.bid = blockIdx.x;
    F0.gw = F0.bid * 8 + F0.wave; F0.NGW = F0.G * 8;
    F0.out = (GAS float*)args_k.out; F0.ws = (GAS unsigned char*)args_k.ws; F0.ctl = (GAS unsigned*)(F0.ws + WS_CTL);
    const int lo = args_k.lo, hi = args_k.hi;
#ifndef EMU
    volatile LAS unsigned* misc = (volatile LAS unsigned*)(F0.lds + MISC_OFF);
    if (F0.tid < 4) misc[F0.tid] = 0u;
    __syncthreads();
    XcdBarrier bar; bar.bar = (unsigned*)(F0.ctl + CW_BAR); bar.x = 0; bar.st = misc;
    if (hi - lo > 1) bar = xcd_barrier_post((unsigned*)(F0.ctl + CW_BAR), misc);
#define GRID_BAR() do { XcdBarrier bq = bar; asm volatile("" : "+s"(bq.bar), "+s"(bq.x)); xcd_barrier(bq); } while (0)
#else
#define GRID_BAR() do { } while (0)
#endif
    int ph = 0;
#ifndef PH_MASK
#define PH_MASK 0xFFFFFFFFFFFFFFFFull
#endif
#define PHASE(...) PHASE_I(31, __VA_ARGS__)
#ifdef EMU
#define LAUNDER(Fq) do { } while (0)
#else
#define LAUNDER(Fq) do { unsigned mq_ = ~0u; asm volatile("" : "+s"(Fq.G), "+s"(Fq.bid), "+s"(Fq.wave), "+s"(Fq.ws), "+s"(Fq.out), "+s"(Fq.ctl), "+s"(mq_)); Fq.lane = (int)__builtin_amdgcn_mbcnt_hi(mq_, __builtin_amdgcn_mbcnt_lo(mq_, 0u)); Fq.tid = Fq.wave * 64 + Fq.lane; Fq.gw = Fq.bid * 8 + Fq.wave; Fq.NGW = Fq.G * 8; } while (0)
#endif
#ifdef EMU
#define ARGS_Q() const Args& args_q = args_k
#else
#define ARGS_Q() const __attribute__((address_space(4))) Args* aq_ = (const __attribute__((address_space(4))) Args*)__builtin_amdgcn_kernarg_segment_ptr(); asm volatile("" : "+s"(aq_)); const Args& args_q = *(const Args*)aq_
#endif
#define PHASE_I(kind, ...) do { if (ph >= lo && ph < hi) { constexpr int reps_ = (((REPEAT_MASK) >> (kind)) & 1u) ? 2 : 1; for (int rr_ = 0; rr_ < reps_; ++rr_) { { Frame Fq = F0; LAUNDER(Fq); const Frame& F = Fq; ARGS_Q(); const Args& args = args_q; __VA_ARGS__; } if (rr_ + 1 < reps_ || ph + 1 < hi) { GRID_BAR(); if (((REPEAT_MASK) >> 26) & 1u) GRID_BAR(); } } } ++ph; } while (0)
#define PHASEK(kind, ...) PHASE_I(kind, __VA_ARGS__)
#define NORM1(layer, half) do { const size_t rn_ = (size_t)(half) * TH; const float* xn_ = ((layer) == 0 ? AIN(args, 0) : (const float*)F.out) + rn_ * D; \
            phase_norm<false>(F, args, xn_, AIN(args, 2) + (layer) * D, WSP(bf16, A_H), nullptr, nullptr, nullptr, nullptr); phase_rope_table(F, args, (const int*)AIN(args, 1) + rn_, WSP(float, A_ROPE)); } while (0)
#define SEGMENT(layer, half) do { \
            const size_t r0 = (size_t)(half) * TH; \
            const float* xin = ((layer) == 0 ? AIN(args_k, 0) : (const float*)F0.out) + r0 * D; float* xo = (float*)F0.out + r0 * D; \
            PHASEK(1, { pg8::Gemm g{WSP(bf16, A_H), WSP(bf16, W_IN), D, D}; pg8::StaticOrder S; S.init(TH, PW, F.G, F.bid); EpiBf16 E{WSP(bf16, A_P), PW, nullptr, 0}; pg8::gemm_phase(F.lds, g, S, E, F.tid); }); \
            PHASEK(2, phase_mla_prep(F, args); phase_rwkv_prep(F, args, layer)); \
            PHASEK(3, phase_mla_q(F, args); __syncthreads(); phase_mla_kv(F, args); __syncthreads(); phase_rwkv_lora(F, args)); \
            PHASEK(8, phase_rwkv_r1(F, args, layer)); \
            PHASEK(5, { const int ns_ = F.G >= 128 ? 64 : (F.G >= 4 ? F.G / 4 : 0); Frame Fa = F;       \
                        unsigned* rfl_ = (unsigned*)(F.ctl + CW_RFLAG + 128 * ((layer) * NHALF + (half))); unsigned* rq_ = (unsigned*)(F.ctl + CW_RFLAG + 2048 + 32 * ((layer) * NHALF + (half))); \
                        if (F.bid < ns_) { Fa.G = ns_; Fa.NGW = ns_ * 8; phase_rwkv_r2(Fa, args, rfl_); } else { Fa.bid = F.bid - ns_; Fa.G = F.G - ns_; Fa.gw = Fa.bid * 8 + Fa.wave; Fa.NGW = Fa.G * 8; phase_attention(Fa, args); if (ns_ == 0) phase_rwkv_r2(F, args, rfl_); } \
                        phase_rwkv_post_queue(F, args, layer, rfl_, rq_); }); \
            PHASEK(9, phase_gdn_g1(F, args, layer); phase_ssd_s1(F, args, layer)); \
            PHASEK(11, { const int ns_ = F.G >= 4 ? F.G / 2 : 0; Frame Fa = F;                               \
                        if (F.bid < ns_) { Fa.G = ns_; Fa.NGW = ns_ * 8; phase_gdn_g2(Fa, args); } else { Fa.bid = F.bid - ns_; Fa.G = F.G - ns_; Fa.gw = Fa.bid * 8 + Fa.wave; Fa.NGW = Fa.G * 8; phase_ssd_s23(Fa, args); if (ns_ == 0) phase_gdn_g2(F, args); } }); \
            PHASEK(12, phase_gdn_g3(F, args, layer); phase_ssd_s4(F, args, layer)); \
            PHASEK(17, phase_merge_z(F, args)); \
            PHASEK(18, phase_merge_gate(F, args, layer)); \
            PHASEK(19, phase_merge_out(F, args, xin, xo)); \
            if ((layer) == 0) { \
                PHASEK(20, phase_norm<false>(F, args, xo, AIN(args, 32) + (layer) * D, WSP(bf16, A_H), nullptr, nullptr, nullptr, nullptr)); \
                PHASEK(21, phase_ffn_gu(F, args)); \
                PHASE(phase_ffn_down(F, args, xo); if ((half) == 0 && NHALF == 2) NORM1(layer, 1)); \
            } else { \
                PHASE(phase_norm<true>(F, args, xo, AIN(args, 32) + (layer) * D, WSP(bf16, A_H), AIN(args, 35), WSP(int, F_TOPE), WSP(float, F_TOPW), (unsigned*)(F.ctl + CW_WGC + (half) * 8192))); \
                PHASE(phase_moe_route(F, args, half)); \
                PHASEK(22, phase_moe_gu(F, args, half)); \
                PHASEK(23, phase_moe_down(F, args, half)); \
                PHASE(phase_moe_combine(F, args, xo, (layer) == DEPTH - 1 ? AIN(args, 38) : nullptr); if ((half) == 0 && NHALF == 2) NORM1(layer, 1)); \
            } } while (0)
    static_assert(DEPTH == 2 && NHALF <= 2, "segment program");
    PHASEK(27, phase_convert(F, args, 0); NORM1(0, 0));
    SEGMENT(0, 0);
    if (NHALF == 2) SEGMENT(0, 1);
    PHASEK(27, phase_convert(F, args, 1); NORM1(1, 0));
    SEGMENT(1, 0);
    if (NHALF == 2) SEGMENT(1, 1);
#undef SEGMENT
#undef PHASE
}

#ifndef ONE_LAUNCH
#define ONE_LAUNCH 1
#endif
extern "C" void kernel_launch(void* const* d_in, const int* in_sizes, int n_in, void* d_out, int out_size, void* d_ws, size_t ws_size, hipStream_t stream) {
    static int grid = 0;
    if (grid == 0) {
#ifdef EMU
        grid = EMU_GRID;
#else
        if (n_in != 39 || out_size != T * D || ws_size < WS_NEED) { fprintf(stderr, "kernel_launch: unexpected problem (n_in %d out %d ws %zu need %zu)\n", n_in, out_size, ws_size, (size_t)WS_NEED); grid = -1; return; }
        int dev = 0, cus = 0;
        if (hipGetDevice(&dev) != hipSuccess || hipDeviceGetAttribute(&cus, hipDeviceAttributeMultiprocessorCount, dev) != hipSuccess) { grid = -1; return; }
        if (hipFuncSetAttribute((const void*)fwd_kernel, hipFuncAttributeMaxDynamicSharedMemorySize, LDS_BYTES) != hipSuccess) { fprintf(stderr, "kernel_launch: hipFuncSetAttribute failed\n"); grid = -1; return; }
        int per_cu = 0;
        if (hipOccupancyMaxActiveBlocksPerMultiprocessor(&per_cu, (const void*)fwd_kernel, 512, LDS_BYTES) != hipSuccess || per_cu < 1) fprintf(stderr, "kernel_launch: occupancy query reports %d\n", per_cu);
        (void)hipGetLastError();
        grid = cus;
#endif
    }
    if (grid < 0) return;
    (void)hipMemsetAsync((char*)d_ws + WS_CTL, 0, CTL_BYTES, stream);
    Args a{};
    for (int i = 0; i < 39; ++i) a.in[i] = (const float*)d_in[i];
    a.out = (float*)d_out; a.ws = (unsigned char*)d_ws;
#ifdef EMU
    for (int p = EMU_PH_LO; p < EMU_PH_HI && p < NPHASES; ++p) { a.lo = p; a.hi = p + 1; emu_launch(fwd_kernel, grid, 512, a); emu_after_phase(p); }
#else
#if ONE_LAUNCH
    a.lo = 0; a.hi = NPHASES;
    hipLaunchKernelGGL(fwd_kernel, dim3(grid), dim3(512), LDS_BYTES, stream, a);
#else
    for (int p = 0; p < NPHASES; ++p) { a.lo = p; a.hi = p + 1; hipLaunchKernelGGL(fwd_kernel, dim3(grid), dim3(512), LDS_BYTES, stream, a); }
#endif
#endif
}
```

```cpp
#ifndef EMU
#include <hip/hip_runtime.h>
#include <cstdio>
#include <cstdint>
#endif

#ifdef EMU
#define FLAG_SET(p) __atomic_store_n((p), 1u, __ATOMIC_RELEASE)
#define FLAG_WAIT(p) do { while (__atomic_load_n((p), __ATOMIC_ACQUIRE) == 0u) { } } while (0)
#else
#define FLAG_SET(p) do { __atomic_thread_fence(__ATOMIC_RELEASE); __hip_atomic_store((p), 1u, __ATOMIC_RELEASE, __HIP_MEMORY_SCOPE_AGENT); } while (0)
#define FLAG_WAIT(p) do { while (__hip_atomic_load((p), __ATOMIC_ACQUIRE, __HIP_MEMORY_SCOPE_AGENT) == 0u) __builtin_amdgcn_s_sleep(8); __atomic_thread_fence(__ATOMIC_ACQUIRE); } while (0)
#endif
constexpr int PQ_SLOT_OFF = 154624 + 512;
#ifndef REPEAT_MASK
#define REPEAT_MASK 0u
#endif
#ifdef EMU
constexpr int BATCH = EMU_B, SEQ = EMU_S, NHALF = EMU_NHALF;
#else
constexpr int BATCH = 16, SEQ = 2048, NHALF = 2;
#endif
constexpr int D = 1024, DEPTH = 2, CH = 64;
constexpr int T = BATCH * SEQ, TH = T / NHALF, BH = BATCH / NHALF, NCH = SEQ / CH;
constexpr int C_MLA = 0, C_RWKV = 704, C_GDN = 2528, C_SSD = 4584, C_GATE = 6128, IN_COLS = 10224, PW = 6144;
constexpr int FF_D = 2816, FF_E = 3584, NEXP = 8;
constexpr int MOE_KSPLIT = 7, MOE_MAINP = TH * 2 / 256;
constexpr int MOE_ROWS = ((TH * 2 + NEXP * 255) / 256) * 256;
constexpr float EPS = 1e-6f;
static_assert(TH % 256 == 0 && SEQ % 128 == 0 && BATCH % NHALF == 0 && (SEQ / 64) % 2 == 0, "shape");

typedef unsigned short bf16;
typedef float f32x4 __attribute__((ext_vector_type(4)));
typedef float f32x2 __attribute__((ext_vector_type(2)));
typedef short bf16x8 __attribute__((ext_vector_type(8)));
typedef short bf16x4 __attribute__((ext_vector_type(4)));
typedef unsigned u32x4 __attribute__((ext_vector_type(4)));
typedef unsigned u32x2 __attribute__((ext_vector_type(2)));
#ifdef EMU
#define LAS
#define GAS
#define MFMA_F32(a, b, c) emu_mfma_16x16x4f32(a, b, c)
#define MFMA_BF16(a, b, c) emu_mfma_16x16x32bf16(a, b, c)
#define ATOMIC_ADD_U32(p, v) emu_atomic_add_u32(p, v)
#define ATOMIC_ADD_LDS(p, v) emu_atomic_add_u32((unsigned*)(p), v)
#define RFL(x) (x)
#define OPAQUE_V(x) do { } while (0)
#define ASSUME(c) do { } while (0)
#define LDS_WAIT()
#define VM_WAIT()
__device__ __forceinline__ float fast_exp(float x) { return expf(x); }
__device__ __forceinline__ float fast_rcp(float x) { return 1.0f / x; }
__device__ __forceinline__ float fast_rsqrt(float x) { return 1.0f / sqrtf(x); }
#else
#define LAS __attribute__((address_space(3)))
#define GAS __attribute__((address_space(1)))
#define MFMA_F32(a, b, c) __builtin_amdgcn_mfma_f32_16x16x4f32(a, b, c, 0, 0, 0)
#define MFMA_BF16(a, b, c) __builtin_amdgcn_mfma_f32_16x16x32_bf16(a, b, c, 0, 0, 0)
#define ATOMIC_ADD_U32(p, v) __hip_atomic_fetch_add(p, v, __ATOMIC_RELAXED, __HIP_MEMORY_SCOPE_AGENT)
#define ATOMIC_ADD_LDS(p, v) __hip_atomic_fetch_add((LAS unsigned*)(p), v, __ATOMIC_RELAXED, __HIP_MEMORY_SCOPE_WORKGROUP)
#define RFL(x) __builtin_amdgcn_readfirstlane(x)
#define ASSUME(c) __builtin_assume(c)
#define OPAQUE_V(x) asm volatile("" : "+v"(x))
#define LDS_WAIT() asm volatile("s_waitcnt lgkmcnt(0)" ::: "memory")
#define VM_WAIT() asm volatile("s_waitcnt vmcnt(0)" ::: "memory")
__device__ __forceinline__ float fast_exp(float x) { return __expf(x); }
__device__ __forceinline__ float fast_rcp(float x) { return __builtin_amdgcn_rcpf(x); }
__device__ __forceinline__ float fast_rsqrt(float x) { return __builtin_amdgcn_rsqf(x); }
#endif
__device__ __forceinline__ unsigned f2u(float f) { return __builtin_bit_cast(unsigned, f); }
__device__ __forceinline__ float u2f(unsigned u) { return __builtin_bit_cast(float, u); }
#ifdef EMU
__device__ __forceinline__ unsigned f2bf(float f) { unsigned u = f2u(f); return (u + 0x7fffu + ((u >> 16) & 1u)) >> 16; }
__device__ __forceinline__ unsigned pk2(float lo, float hi) { return f2bf(lo) | (f2bf(hi) << 16); }
#else
typedef __bf16 bf16v2_ __attribute__((ext_vector_type(2)));
__device__ __forceinline__ unsigned pk2(float lo, float hi) { const f32x2 v = {lo, hi}; return __builtin_bit_cast(unsigned, __builtin_convertvector(v, bf16v2_)); }
__device__ __forceinline__ unsigned f2bf(float f) { return pk2(f, f) & 0xffffu; }
#endif
__device__ __forceinline__ float bf2f(unsigned h) { return u2f(h << 16); }
#ifndef EMU
#define expf(x) __expf(x)
#define exp2f(x) __builtin_amdgcn_exp2f(x)
#define FDIV(a, b) ((a) * __builtin_amdgcn_rcpf(b))
#define RSQRT(x) __builtin_amdgcn_rsqf(x)
__device__ __forceinline__ float softplusf_(float x) { return x > 20.f ? x : __logf(1.0f + __expf(x)); }
#else
#define FDIV(a, b) ((a) / (b))
#define RSQRT(x) (1.0f / sqrtf(x))
__device__ __forceinline__ float softplusf_(float x) { return x > 20.f ? x : log1pf(expf(x)); }
#endif
__device__ __forceinline__ float sigmoidf_(float x) { return FDIV(1.0f, 1.0f + expf(-x)); }
__device__ __forceinline__ float siluf_(float x) { return FDIV(x, 1.0f + expf(-x)); }
__device__ __forceinline__ float tanhf_(float x) { const float e = expf(2.0f * fminf(x, 15.0f)); return FDIV(e - 1.0f, e + 1.0f); }
#ifdef EMU
template <int N> __device__ __forceinline__ float red_sum(float v) {
#pragma unroll
    for (int o = 1; o < N; o <<= 1) v += __shfl_xor(v, o);
    return v; }
template <int N> __device__ __forceinline__ float red_max(float v) {
#pragma unroll
    for (int o = 1; o < N; o <<= 1) v = fmaxf(v, __shfl_xor(v, o));
    return v; }
__device__ __forceinline__ int bcast0(int v) { return __shfl(v, 0); }
#else
template <int CTRL> __device__ __forceinline__ float dpp_mov(float v) { return u2f((unsigned)__builtin_amdgcn_mov_dpp((int)f2u(v), CTRL, 0xF, 0xF, true)); }
template <int N> __device__ __forceinline__ float red_sum(float v) {
    v += dpp_mov<0xB1>(v);
    v += dpp_mov<0x4E>(v);
    v += dpp_mov<0x141>(v);
    if (N >= 16) v += dpp_mov<0x140>(v);
    if (N >= 32) { const auto r = __builtin_amdgcn_permlane16_swap(f2u(v), f2u(v), false, false); v = u2f(r[0]) + u2f(r[1]); }
    if (N >= 64) { const auto r = __builtin_amdgcn_permlane32_swap(f2u(v), f2u(v), false, false); v = u2f(r[0]) + u2f(r[1]); }
    return v; }
template <int N> __device__ __forceinline__ float red_max(float v) {
    v = fmaxf(v, dpp_mov<0xB1>(v)); v = fmaxf(v, dpp_mov<0x4E>(v)); v = fmaxf(v, dpp_mov<0x141>(v));
    if (N >= 16) v = fmaxf(v, dpp_mov<0x140>(v));
    if (N >= 32) { const auto r = __builtin_amdgcn_permlane16_swap(f2u(v), f2u(v), false, false); v = fmaxf(u2f(r[0]), u2f(r[1])); }
    if (N >= 64) { const auto r = __builtin_amdgcn_permlane32_swap(f2u(v), f2u(v), false, false); v = fmaxf(u2f(r[0]), u2f(r[1])); }
    return v; }
__device__ __forceinline__ int bcast0(int v) { return __builtin_amdgcn_readfirstlane(v); }
#endif
__device__ __forceinline__ float wave_sum(float v) { return red_sum<64>(v); }
__device__ __forceinline__ float wave_max(float v) { return red_max<64>(v); }
__device__ __forceinline__ f32x4 ld_bf16x4(const bf16* p) { const u32x2 w = *(const u32x2*)p; return (f32x4){bf2f(w.x & 0xffffu), bf2f(w.x >> 16), bf2f(w.y & 0xffffu), bf2f(w.y >> 16)}; }
__device__ __forceinline__ void st_bf16x4(bf16* p, f32x4 v) { u32x2 w; w.x = pk2(v.x, v.y); w.y = pk2(v.z, v.w); *(u32x2*)p = w; }
__device__ __forceinline__ u32x4 pack8(const float* v) { u32x4 o; o.x = pk2(v[0], v[1]); o.y = pk2(v[2], v[3]); o.z = pk2(v[4], v[5]); o.w = pk2(v[6], v[7]); return o; }

#ifdef EMU
__device__ __forceinline__ float rows_max(float v) { v = fmaxf(v, __shfl_xor(v, 16)); return fmaxf(v, __shfl_xor(v, 32)); }
__device__ __forceinline__ float rows_sum(float v) { v += __shfl_xor(v, 16); return v + __shfl_xor(v, 32); }
#else
typedef unsigned u32x2v __attribute__((ext_vector_type(2)));
__device__ __forceinline__ float rows_max(float v) {
    { const auto r = __builtin_amdgcn_permlane16_swap(f2u(v), f2u(v), false, false); v = fmaxf(u2f(r[0]), u2f(r[1])); }
    { const auto r = __builtin_amdgcn_permlane32_swap(f2u(v), f2u(v), false, false); v = fmaxf(u2f(r[0]), u2f(r[1])); }
    return v; }
__device__ __forceinline__ float rows_sum(float v) {
    { const auto r = __builtin_amdgcn_permlane16_swap(f2u(v), f2u(v), false, false); v = u2f(r[0]) + u2f(r[1]); }
    { const auto r = __builtin_amdgcn_permlane32_swap(f2u(v), f2u(v), false, false); v = u2f(r[0]) + u2f(r[1]); }
    return v; }
#endif

namespace pg8 {
#define PG8_LAS LAS
typedef unsigned short bf16_t;
constexpr int BM = 256, BK = 64, HALF = 128, HTB = HALF * BK * 2, STAGE_BYTES = 8 * HTB, NXCD = 8, WGM = 8;
__host__ __device__ __forceinline__ int lds_byte(int r, int c) { const int st = (r >> 4) * 2 + (c >> 5), rr = r & 15, cc = c & 31, ob = rr * 64 + cc * 2; return st * 1024 + (ob ^ (((ob >> 9) & 1) << 5)); }
__host__ __device__ __forceinline__ void stage_rc(int b, int& R, int& C) { const int st = b / 1024, sb = b % 1024, swz = sb ^ (((sb >> 9) & 1) << 5); R = (st >> 1) * 16 + swz / 64; C = (st & 1) * 32 + (swz % 64) / 2; }
__host__ __device__ __forceinline__ int perm32(int rho) { const int n = rho >> 4, i = rho & 15; return 8 * (i >> 2) + 4 * n + (i & 3); }
struct Unit { int pm, pn, kb = 0; };
struct Gemm { const bf16_t* A; const bf16_t* Bt; int lda, K, ldb = 0; };
struct StaticOrder {
    int nM, nN, nwg, G, c;
    __host__ __device__ void init(int M, int N, int G_, int c_) { nM = M / BM; nN = N / BM; nwg = nM * nN; G = G_; c = c_; }
    __host__ __device__ bool next(int i, Unit& u) const {
        const long L = (long)i * G + c; if (L >= nwg) return false;
        int wgid = (int)L; { const int q = nwg / NXCD, r = nwg % NXCD, xcd = wgid % NXCD, off = wgid / NXCD; wgid = (xcd < r ? xcd * (q + 1) : r * (q + 1) + (xcd - r) * q) + off; }
        const int nig = WGM * nN, gid = wgid / nig, fm = gid * WGM, gsz = (nM - fm) < WGM ? (nM - fm) : WGM;
        u.pm = fm + ((wgid % nig) % gsz); u.pn = (wgid % nig) / gsz; return true;
    }
    __device__ __forceinline__ void a_ready(const Unit&) const {}
    __device__ __forceinline__ void done(const Unit&) const {}
};
#ifndef EMU
template <class Epi, class Sched>
__device__ __forceinline__ void gemm_phase(PG8_LAS unsigned char* lds, const Gemm g, const Sched& S, const Epi& E, const int tid) {
    const int wid = __builtin_amdgcn_readfirstlane(tid >> 6), lane = tid & 63, wr = wid >> 2, wc = wid & 3, fr = lane & 15, fq = lane >> 4;
    int Kq = g.K; asm volatile("" : "+s"(Kq));
    const int K = Kq, nt = K / BK, lda = g.lda, ldb = g.ldb > 0 ? g.ldb : K;
    unsigned voffA[2], voffB[2];
#pragma unroll
    for (int i = 0; i < 2; ++i) { int R, C; stage_rc(tid * 16 + i * 8192, R, C); const int Rb = Epi::PERM ? ((R & ~31) + perm32(R & 31)) : R;
        voffA[i] = (unsigned)(R * lda + C) * 2u; voffB[i] = (unsigned)(Rb * ldb + C) * 2u; }
    const size_t kstep = (size_t)(BK * 2);
    const size_t hstep = (size_t)HALF * ldb * 2, hstepA = (size_t)HALF * lda * 2;
    const size_t tstep = 2 * hstep, tstepA = 2 * hstepA;
    const unsigned ldsw = (unsigned)wid * 1024u;
    const int aoff = lds_byte(wr * 64 + fr, fq * 8), boff = lds_byte(wc * 32 + fr, fq * 8);
#define PG8_SA(b, h) (((b) * 2 + (h)) * HTB)
#define PG8_SB(b, h) ((4 + (b) * 2 + (h)) * HTB)
#define PG8_STAGE(bufoff, gbase, voff) do { _Pragma("unroll") for (int _i = 0; _i < 2; ++_i) \
        __builtin_amdgcn_global_load_lds((const unsigned*)((const char*)(gbase) + (voff)[_i]), (PG8_LAS unsigned*)(lds + (bufoff) + ldsw + _i * 8192), 16, 0, 0); } while (0)
#define PG8_LDA(dst, b, h) do { _Pragma("unroll") for (int m = 0; m < 4; ++m) _Pragma("unroll") for (int k = 0; k < 2; ++k) dst[m][k] = *(const PG8_LAS bf16x8*)(lds + PG8_SA(b, h) + aoff + m * 2048 + k * 1024); } while (0)
#define PG8_LDB(dst, b, h) do { _Pragma("unroll") for (int n = 0; n < 2; ++n) _Pragma("unroll") for (int k = 0; k < 2; ++k) dst[n][k] = *(const PG8_LAS bf16x8*)(lds + PG8_SB(b, h) + boff + n * 2048 + k * 1024); } while (0)
#define PG8_MMA(ai, bj, At, Bt) do { __builtin_amdgcn_s_setprio(1); _Pragma("unroll") for (int m = 0; m < 4; ++m) _Pragma("unroll") for (int n = 0; n < 2; ++n) _Pragma("unroll") for (int k = 0; k < 2; ++k) \
        acc[ai][bj][m][n] = __builtin_amdgcn_mfma_f32_16x16x32_bf16(Bt[n][k], At[m][k], acc[ai][bj][m][n], 0, 0, 0); __builtin_amdgcn_s_setprio(0); } while (0)
#define PG8_WAIT_V(n) asm volatile("s_waitcnt vmcnt(" #n ")" ::: "memory")
#define PG8_WAIT_L(n) asm volatile("s_waitcnt lgkmcnt(" #n ")" ::: "memory")
#define PG8_BAR __builtin_amdgcn_s_barrier()
#define PG8_SCHED __builtin_amdgcn_sched_barrier(0)
    Unit cur, nxt; int ui = 0;
    if (!S.next(0, cur)) return;
    f32x4 acc[2][2][4][2];
#pragma unroll
    for (int a = 0; a < 2; ++a)
#pragma unroll
        for (int b = 0; b < 2; ++b)
#pragma unroll
            for (int m = 0; m < 4; ++m)
#pragma unroll
                for (int n = 0; n < 2; ++n) acc[a][b][m][n] = (f32x4){0.f, 0.f, 0.f, 0.f};
    bf16x8 At[4][2], B0[2][2], B1[2][2];
    const char* cA = (const char*)g.A + (size_t)cur.pm * tstepA + cur.kb; const char* cB = (const char*)g.Bt + (size_t)cur.pn * tstep + cur.kb;
    S.a_ready(cur);
    PG8_STAGE(PG8_SB(0, 0), cB, voffB); PG8_STAGE(PG8_SA(0, 0), cA, voffA); PG8_STAGE(PG8_SB(0, 1), cB + hstep, voffB); PG8_STAGE(PG8_SA(0, 1), cA + hstepA, voffA);
    if (wr == 1) PG8_BAR;
    PG8_WAIT_V(4); PG8_BAR;
    PG8_STAGE(PG8_SB(1, 0), cB + kstep, voffB); PG8_STAGE(PG8_SA(1, 0), cA + kstep, voffA); PG8_STAGE(PG8_SB(1, 1), cB + hstep + kstep, voffB);
    PG8_WAIT_V(6); PG8_BAR;
    for (;;) {
        const bool has_next = S.next(ui + 1, nxt);
        const char* nA = has_next ? (const char*)g.A + (size_t)nxt.pm * tstepA + nxt.kb : cA; const char* nB = has_next ? (const char*)g.Bt + (size_t)nxt.pn * tstep + nxt.kb : cB;
        for (int t = 0; t < nt; t += 2) {
            const bool last = (t == nt - 2);
            const char* a1 = cA + (size_t)(t + 1) * kstep;
            const char* a2 = last ? nA : cA + (size_t)(t + 2) * kstep; const char* b2 = last ? nB : cB + (size_t)(t + 2) * kstep;
            const char* a3 = a2 + kstep; const char* b3 = b2 + kstep;
            if (last && has_next) S.a_ready(nxt);
            PG8_LDB(B0, 0, 0); PG8_SCHED; PG8_LDA(At, 0, 0); PG8_STAGE(PG8_SA(1, 1), a1 + hstepA, voffA);
            PG8_WAIT_L(8); PG8_BAR; PG8_WAIT_L(0); PG8_MMA(0, 0, At, B0); PG8_BAR; PG8_SCHED;
            PG8_LDB(B1, 0, 1); PG8_STAGE(PG8_SB(0, 0), b2, voffB);
            PG8_BAR; PG8_WAIT_L(0); PG8_MMA(0, 1, At, B1); PG8_BAR;
            PG8_LDA(At, 0, 1); PG8_STAGE(PG8_SA(0, 0), a2, voffA);
            PG8_BAR; PG8_WAIT_L(0); PG8_MMA(1, 0, At, B0); PG8_BAR; PG8_SCHED;
            PG8_STAGE(PG8_SB(0, 1), b2 + hstep, voffB);
            PG8_WAIT_V(6); PG8_BAR; PG8_MMA(1, 1, At, B1); PG8_BAR;
            PG8_LDB(B0, 1, 0); PG8_SCHED; PG8_LDA(At, 1, 0); PG8_STAGE(PG8_SA(0, 1), a2 + hstepA, voffA);
            PG8_WAIT_L(8); PG8_BAR; PG8_WAIT_L(0); PG8_MMA(0, 0, At, B0); PG8_BAR; PG8_SCHED;
            PG8_LDB(B1, 1, 1); PG8_STAGE(PG8_SB(1, 0), b3, voffB);
            PG8_BAR; PG8_WAIT_L(0); PG8_MMA(0, 1, At, B1); PG8_BAR;
            PG8_LDA(At, 1, 1); PG8_STAGE(PG8_SA(1, 0), a3, voffA);
            PG8_BAR; PG8_WAIT_L(0); PG8_MMA(1, 0, At, B0); PG8_BAR; PG8_SCHED;
            PG8_STAGE(PG8_SB(1, 1), b3 + hstep, voffB);
            PG8_WAIT_V(6); PG8_BAR; PG8_MMA(1, 1, At, B1); PG8_BAR;
        }
        if constexpr (!Epi::AFTER_DRAIN) { E(acc, cur, wr, wc, fr, fq); S.done(cur); }
        if (!has_next) break;
#pragma unroll
        for (int a = 0; a < 2; ++a)
#pragma unroll
            for (int b = 0; b < 2; ++b)
#pragma unroll
                for (int m = 0; m < 4; ++m)
#pragma unroll
                    for (int n = 0; n < 2; ++n) acc[a][b][m][n] = (f32x4){0.f, 0.f, 0.f, 0.f};
        cur = nxt; cA = nA; cB = nB; ++ui;
    }
    PG8_WAIT_V(0);
    if (wr == 0) PG8_BAR;
    PG8_BAR;
    if constexpr (Epi::AFTER_DRAIN) { E.fused(acc, cur, wr, wc, fr, fq, lds, wid, lane); S.done(cur); }
#undef PG8_SA
#undef PG8_SB
#undef PG8_STAGE
#undef PG8_LDA
#undef PG8_LDB
#undef PG8_MMA
#undef PG8_WAIT_V
#undef PG8_WAIT_L
#undef PG8_BAR
#undef PG8_SCHED
}
#else
template <class Epi, class Sched>
__device__ __forceinline__ void gemm_phase(PG8_LAS unsigned char* lds, const Gemm g, const Sched& S, const Epi& E, const int tid) {
    const int wid = tid >> 6, lane = tid & 63, wr = wid >> 2, wc = wid & 3, fr = lane & 15, fq = lane >> 4;
    Unit cur;
    for (int ui = 0; S.next(ui, cur); ++ui) {
        f32x4 acc[2][2][4][2];
        for (int ai = 0; ai < 2; ++ai) for (int m = 0; m < 4; ++m) {
            const size_t row = (size_t)cur.pm * 256 + ai * 128 + wr * 64 + m * 16 + fr;
            const bf16_t* ap = g.A + row * g.lda + cur.kb / 2;
            for (int bj = 0; bj < 2; ++bj) for (int n = 0; n < 2; ++n) for (int j = 0; j < 4; ++j) {
                const size_t col = (size_t)cur.pn * 256 + bj * 128 + wc * 32 + (Epi::PERM ? 8 * fq + 4 * n : 16 * n + 4 * fq) + j;
                const bf16_t* bp = g.Bt + col * (g.ldb > 0 ? g.ldb : g.K) + cur.kb / 2; float s = 0.f;
                for (int k = 0; k < g.K; ++k) s += bf2f(ap[k]) * bf2f(bp[k]);
                acc[ai][bj][m][n][j] = s; } }
        E(acc, cur, wr, wc, fr, fq);
    }
    __syncthreads();
}
#endif
}

using pg8::Unit;
constexpr int HALFT = 128;
struct EpiF32 {
    static constexpr bool PERM = false, AFTER_DRAIN = false;
    float* C; int ldc;
    __device__ __forceinline__ void operator()(const f32x4 (&acc)[2][2][4][2], const Unit& u, int wr, int wc, int fr, int fq) const {
        const int row0 = u.pm * 256 + wr * 64 + fr, col0 = u.pn * 256 + wc * 32 + 4 * fq;
#pragma unroll
        for (int ai = 0; ai < 2; ++ai)
#pragma unroll
            for (int m = 0; m < 4; ++m) { float* rowp = C + (size_t)(row0 + ai * HALFT + m * 16) * ldc + col0;
#pragma unroll
                for (int bj = 0; bj < 2; ++bj)
#pragma unroll
                    for (int n = 0; n < 2; ++n) *(f32x4*)(rowp + bj * HALFT + n * 16) = acc[ai][bj][m][n]; }
    }
};
struct EpiLora {
    static constexpr bool PERM = true, AFTER_DRAIN = false;
    float* W; bf16* AG;
    __device__ __forceinline__ void operator()(const f32x4 (&acc)[2][2][4][2], const Unit& u, int wr, int wc, int fr, int fq) const {
        const int row0 = u.pm * 256 + wr * 64 + fr, colt = wc * 32 + 8 * fq;
        if (u.pn < 2) {
#pragma unroll
            for (int ai = 0; ai < 2; ++ai)
#pragma unroll
                for (int m = 0; m < 4; ++m) { bf16* rowp = (bf16*)W + (size_t)(row0 + ai * HALFT + m * 16) * 512 + u.pn * 256 + colt;
#pragma unroll
                    for (int bj = 0; bj < 2; ++bj) { const f32x4 v0 = acc[ai][bj][m][0], v1 = acc[ai][bj][m][1];
                        u32x4 w; w.x = pk2(v0[0], v0[1]); w.y = pk2(v0[2], v0[3]); w.z = pk2(v1[0], v1[1]); w.w = pk2(v1[2], v1[3]);
                        *(u32x4*)(rowp + bj * HALFT) = w; } }
        } else {
#pragma unroll
            for (int ai = 0; ai < 2; ++ai)
#pragma unroll
                for (int m = 0; m < 4; ++m) { bf16* rowp = AG + (size_t)(row0 + ai * HALFT + m * 16) * 1024 + (u.pn - 2) * 256 + colt;
#pragma unroll
                    for (int bj = 0; bj < 2; ++bj) { const f32x4 v0 = acc[ai][bj][m][0], v1 = acc[ai][bj][m][1];
                        u32x4 w; w.x = pk2(v0[0], v0[1]); w.y = pk2(v0[2], v0[3]); w.z = pk2(v1[0], v1[1]); w.w = pk2(v1[2], v1[3]);
                        *(u32x4*)(rowp + bj * HALFT) = w; } }
        }
    }
};
struct EpiResidual {
    static constexpr bool PERM = false, AFTER_DRAIN = false;
    const float* res; float* out;
    __device__ __forceinline__ void operator()(const f32x4 (&acc)[2][2][4][2], const Unit& u, int wr, int wc, int fr, int fq) const {
        const int row0 = u.pm * 256 + wr * 64 + fr, col0 = u.pn * 256 + wc * 32 + 4 * fq;
#pragma unroll
        for (int ai = 0; ai < 2; ++ai) {
            f32x4 rv[4][2][2];
#pragma unroll
            for (int m = 0; m < 4; ++m) { const size_t o = (size_t)(row0 + ai * HALFT + m * 16) * D + col0;
#pragma unroll
                for (int bj = 0; bj < 2; ++bj)
#pragma unroll
                    for (int n = 0; n < 2; ++n) rv[m][bj][n] = *(const GAS f32x4*)(res + o + bj * HALFT + n * 16); }
#pragma unroll
            for (int m = 0; m < 4; ++m) { const size_t o = (size_t)(row0 + ai * HALFT + m * 16) * D + col0;
#pragma unroll
                for (int bj = 0; bj < 2; ++bj)
#pragma unroll
                    for (int n = 0; n < 2; ++n) *(GAS f32x4*)(out + o + bj * HALFT + n * 16) = rv[m][bj][n] + acc[ai][bj][m][n]; }
        }
    }
};
struct EpiBf16 {
    static constexpr bool PERM = true, AFTER_DRAIN = false;
    bf16* O; int ldc; const float* rowscale; int rs_stride;
    __device__ __forceinline__ void operator()(const f32x4 (&acc)[2][2][4][2], const Unit& u, int wr, int wc, int fr, int fq) const {
        const int row0 = u.pm * 256 + wr * 64 + fr, col0 = u.pn * 256 + wc * 32 + 8 * fq;
#pragma unroll
        for (int ai = 0; ai < 2; ++ai)
#pragma unroll
            for (int m = 0; m < 4; ++m) { const int row = row0 + ai * HALFT + m * 16; bf16* rowp = O + (size_t)row * ldc + col0;
                const float sc = rowscale ? rowscale[(size_t)row * rs_stride] : 1.0f;
#pragma unroll
                for (int bj = 0; bj < 2; ++bj) { const f32x4 v0 = acc[ai][bj][m][0] * sc, v1 = acc[ai][bj][m][1] * sc;
                    u32x4 w; w.x = pk2(v0[0], v0[1]); w.y = pk2(v0[2], v0[3]); w.z = pk2(v1[0], v1[1]); w.w = pk2(v1[2], v1[3]);
                    *(u32x4*)(rowp + bj * HALFT) = w; } }
    }
};
struct EpiSwiGLU {
    static constexpr bool PERM = true, AFTER_DRAIN = false;
    bf16* O; int ldc; int ntile;
    __device__ __forceinline__ void operator()(const f32x4 (&acc)[2][2][4][2], const Unit& u, int wr, int wc, int fr, int fq) const {
        const int row0 = u.pm * 256 + wr * 64 + fr, col0 = (u.pn % ntile) * 128 + wc * 32 + 8 * fq;
#pragma unroll
        for (int ai = 0; ai < 2; ++ai)
#pragma unroll
            for (int m = 0; m < 4; ++m) { bf16* rowp = O + (size_t)(row0 + ai * HALFT + m * 16) * ldc + col0;
                float a[8];
#pragma unroll
                for (int n = 0; n < 2; ++n)
#pragma unroll
                    for (int j = 0; j < 4; ++j) { const float g = acc[ai][0][m][n][j], up = acc[ai][1][m][n][j]; a[4 * n + j] = g * fast_rcp(1.0f + fast_exp(-g)) * up; }
                u32x4 w; w.x = pk2(a[0], a[1]); w.y = pk2(a[2], a[3]); w.z = pk2(a[4], a[5]); w.w = pk2(a[6], a[7]);
                *(u32x4*)rowp = w; }
    }
};
struct EpiZ {
    static constexpr bool PERM = true, AFTER_DRAIN = false;
    bf16* Z;
    __device__ __forceinline__ void operator()(const f32x4 (&acc)[2][2][4][2], const Unit& u, int wr, int wc, int fr, int fq) const {
        const int i = u.pn >> 2, pnl = u.pn & 3, pml = u.pm - i * (TH / 256);
        const int row0 = pml * 256 + wr * 64 + fr, col0 = i * D + pnl * 256 + wc * 32 + 8 * fq;
#pragma unroll
        for (int ai = 0; ai < 2; ++ai)
#pragma unroll
            for (int m = 0; m < 4; ++m) { bf16* rowp = Z + (size_t)(row0 + ai * HALFT + m * 16) * 4096 + col0;
#pragma unroll
                for (int bj = 0; bj < 2; ++bj) { const f32x4 v0 = acc[ai][bj][m][0], v1 = acc[ai][bj][m][1];
                    u32x4 w; w.x = pk2(v0[0], v0[1]); w.y = pk2(v0[2], v0[3]); w.z = pk2(v1[0], v1[1]); w.w = pk2(v1[2], v1[3]);
                    *(GAS u32x4*)(rowp + bj * HALFT) = w; } }
    }
};
struct BranchOrder {
    int nP, G, c;
    __device__ bool next(int i, Unit& u) const {
        const long L = (long)i * G + c; if (L >= (long)16 * nP) return false;
        const int br = (int)(L / (4 * nP)), r = (int)(L % (4 * nP)); u.pm = br * nP + (r >> 2); u.pn = br * 4 + (r & 3); return true;
    }
    __device__ __forceinline__ void a_ready(const Unit&) const {}
    __device__ __forceinline__ void done(const Unit&) const {}
};
struct EpiMerge {
    static constexpr bool PERM = false, AFTER_DRAIN = false;
    const bf16* Z; const float* gate_b; bf16* MG;
    __device__ __forceinline__ void operator()(const f32x4 (&acc)[2][2][4][2], const Unit& u, int wr, int wc, int fr, int fq) const {
        const int row0 = u.pm * 256 + wr * 64 + fr, col = u.pn * 64 + wc * 16 + 4 * fq;
        f32x4 gb[4];
#pragma unroll
        for (int i = 0; i < 4; ++i) gb[i] = *(const GAS f32x4*)(gate_b + i * D + col);
#pragma unroll
        for (int ai = 0; ai < 2; ++ai) {
            u32x2 zv[4][4];
#pragma unroll
            for (int m = 0; m < 4; ++m)
#pragma unroll
                for (int i = 0; i < 4; ++i) zv[m][i] = *(const GAS u32x2*)(Z + (size_t)(row0 + ai * HALFT + m * 16) * 4096 + i * D + col);
#pragma unroll
            for (int m = 0; m < 4; ++m) { const size_t row = (size_t)(row0 + ai * HALFT + m * 16);
                f32x4 s = (f32x4){0.f, 0.f, 0.f, 0.f};
#pragma unroll
                for (int bj = 0; bj < 2; ++bj)
#pragma unroll
                    for (int n = 0; n < 2; ++n) { const int i = 2 * bj + n; const unsigned z01 = zv[m][i].x, z23 = zv[m][i].y;
                        const f32x4 z = (f32x4){bf2f(z01 & 0xffffu), bf2f(z01 >> 16), bf2f(z23 & 0xffffu), bf2f(z23 >> 16)}; const f32x4 a = acc[ai][bj][m][n] + gb[i];
#pragma unroll
                        for (int j = 0; j < 4; ++j) s[j] += z[j] * fast_rcp(1.0f + fast_exp(-a[j])); }
                u32x2 w; w.x = pk2(s.x, s.y); w.y = pk2(s.z, s.w); *(GAS u32x2*)(MG + row * D + col) = w; }
        }
    }
};

constexpr size_t MiB = 1u << 20;
constexpr size_t al(size_t x) { return (x + 255) & ~(size_t)255; }
constexpr size_t WS_CTL = 0, CTL_BYTES = 1 * MiB;
constexpr size_t W_IN = 1 * MiB;
constexpr size_t W_GATE = W_IN + (size_t)PW * D * 2;
constexpr size_t W_UQ = W_GATE + (size_t)4096 * D * 2;
constexpr size_t W_UKV = W_UQ + (size_t)768 * 384 * 2;
constexpr size_t W_LORA = W_UKV + (size_t)1024 * 256 * 2;
constexpr size_t W_BR = W_LORA + (size_t)1536 * 384 * 2;
constexpr size_t W_OUT = W_BR + (size_t)4 * 1024 * 512 * 2;
constexpr size_t W_FGU = W_OUT + (size_t)D * D * 2;
constexpr size_t W_FDN = W_FGU + (size_t)NEXP * 2 * FF_E * D * 2;
constexpr size_t W_END = W_FDN + (size_t)NEXP * D * FF_E * 2;
constexpr size_t A_H = al(W_END);
constexpr size_t A_ROPE = A_H + (size_t)TH * D * 2;
constexpr size_t A_Y = A_ROPE + (size_t)TH * 64 * 4;
constexpr size_t A_P = A_Y + (size_t)4 * TH * 512 * 2;
constexpr size_t A_MIX = A_P + (size_t)TH * PW * 2;
constexpr size_t R_RKV = A_MIX;
constexpr size_t R_LOUT = R_RKV + (size_t)TH * 1536 * 2;
constexpr size_t R_O = R_LOUT + (size_t)TH * 1536 * 4;
constexpr size_t R_LIN = R_O + (size_t)TH * 512 * 4;
constexpr size_t R_REC = R_LIN + (size_t)TH * 384 * 2;
constexpr size_t R_END = R_REC + (size_t)BH * 8 * NCH * 61696;
constexpr size_t M_KR = al(R_END);
constexpr size_t M_Q = M_KR + (size_t)TH * 64 * 2;
constexpr size_t M_KV = M_Q + (size_t)TH * 768 * 2;
constexpr size_t M_VT = M_KV + (size_t)TH * 1024 * 2;
constexpr size_t M_END = M_VT + (size_t)TH * 512 * 2;
constexpr size_t G_CH = R_LIN;
constexpr size_t G_O = G_CH + al((size_t)BH * 4 * NCH * 78864);
constexpr size_t G_END = G_O + (size_t)TH * 512 * 4;
constexpr size_t S_ST = al(G_END);
constexpr size_t S_YD = S_ST + (size_t)BH * NCH * 8 * 64 * 128 * 2;
constexpr size_t S_C = S_YD + (size_t)TH * 512 * 4;
constexpr size_t S_AC = S_C + (size_t)BH * NCH * 2 * 17408;
constexpr size_t S_YO = S_AC + (size_t)TH * 8 * 4;
constexpr size_t S_END = S_YO + (size_t)TH * 512 * 4;
constexpr size_t A_Z = A_P;
constexpr size_t A_MG = A_MIX;
constexpr size_t F_ACT = A_P;
constexpr size_t F_GA = F_ACT + (size_t)MOE_ROWS * FF_E * 2;
constexpr size_t F_YE = F_GA + (size_t)MOE_ROWS * D * 2;
constexpr size_t F_TOPE = F_YE + (size_t)MOE_ROWS * D * 4;
constexpr size_t F_TOPW = F_TOPE + (size_t)TH * 2 * 4;
constexpr size_t F_SLOT = F_TOPW + (size_t)TH * 2 * 4;
constexpr size_t F_PART = al(F_SLOT + (size_t)TH * 2 * 4);
constexpr size_t F_END = F_PART + (size_t)MOE_KSPLIT * (MOE_ROWS - 2 * TH) * D * 4;
constexpr size_t cmax(size_t a, size_t b) { return a > b ? a : b; }
constexpr size_t WS_NEED = cmax(cmax(cmax(M_END, R_END), cmax(G_END, S_END)), F_END);
#ifndef EMU
static_assert(WS_NEED <= (size_t)896 * MiB, "workspace");
#endif
constexpr int CW_BAR = 4096;
constexpr int CW_ATQ = 12288;
constexpr int CW_RFLAG = 12288;
constexpr int CW_CNT = 16384;
constexpr int CW_WGC = 32768;

#ifdef EMU
#define WAVE_SYNC() emu_wave_sync()
#else
#define WAVE_SYNC() do { asm volatile("s_waitcnt lgkmcnt(0)" ::: "memory"); } while (0)
#endif
struct Frame {
    LAS unsigned char* lds; int tid, lane, wave, G, gw, NGW, bid;
    GAS float* out; GAS unsigned char* ws; GAS unsigned* ctl;
};
struct Args { const float* in[39]; float* out; unsigned char* ws; int lo, hi; };
#define WSP(type, off) ((type*)(F.ws + (off)))
#define AIN(A_, k) ((const float*)(const GAS float*)(A_).in[k])

template <class FN>
__device__ __forceinline__ void cvt_matrix(const Frame& F, const float* W, int ldw, int K, bf16* WT, int Ndst, const float* kscale, FN srccol) {
    LAS float* scr = (LAS float*)(F.lds + F.wave * 16384);
    const int nblk = Ndst / 32, nitems = (K / 64) * nblk, lane = F.lane;
    for (int item = F.gw; item < nitems; item += F.NGW) {
        const int kb = item / nblk, nb = item % nblk, k0 = 64 * kb, n0 = 32 * nb;
        const int sc = srccol(n0 + (lane & 31));
        float wv[32];
#pragma unroll
        for (int i = 0; i < 32; ++i) { const int kk = 2 * i + (lane >> 5); wv[i] = sc >= 0 ? W[(size_t)(k0 + kk) * ldw + sc] : 0.f; }
#pragma unroll
        for (int i = 0; i < 32; ++i) { const int kk = 2 * i + (lane >> 5); float v = wv[i]; if (kscale) v *= kscale[k0 + kk]; scr[kk * 33 + (lane & 31)] = v; }
        WAVE_SYNC();
        const int c = lane & 7;
#pragma unroll
        for (int j = 0; j < 4; ++j) { const int n = (lane >> 3) + 8 * j; const LAS float* s = scr + (8 * c) * 33 + n;
            u32x4 o; o.x = pk2(s[0 * 33], s[1 * 33]); o.y = pk2(s[2 * 33], s[3 * 33]); o.z = pk2(s[4 * 33], s[5 * 33]); o.w = pk2(s[6 * 33], s[7 * 33]);
            *(u32x4*)(WT + (size_t)(n0 + n) * K + k0 + 8 * c) = o; }
        WAVE_SYNC();
    }
}
__device__ __forceinline__ void phase_convert(const Frame& F, const Args& A, int layer) {
    const float* w_in = AIN(A, 3) + (size_t)layer * D * IN_COLS;
    cvt_matrix(F, w_in, IN_COLS, D, WSP(bf16, W_IN), PW, nullptr, [](int n) { return n < C_GATE ? n : -1; });
    cvt_matrix(F, w_in, IN_COLS, D, WSP(bf16, W_GATE), 4096, nullptr, [](int n) {
        const int pn = n >> 8, c = n & 255, bj = c >> 7, wc = (c >> 5) & 3, nn = (c >> 4) & 1, r = c & 15; return C_GATE + (2 * bj + nn) * D + 64 * pn + 16 * wc + r; });
    cvt_matrix(F, AIN(A, 6) + (size_t)layer * 384 * 768, 768, 384, WSP(bf16, W_UQ), 768, AIN(A, 4) + layer * 384, [](int n) { return n; });
    cvt_matrix(F, AIN(A, 7) + (size_t)layer * 256 * 1024, 1024, 256, WSP(bf16, W_UKV), 1024, AIN(A, 5) + layer * 256, [](int n) { return n; });
    for (int i = 0; i < 4; ++i) cvt_matrix(F, AIN(A, 30) + ((size_t)layer * 4 + i) * 512 * D, D, 512, WSP(bf16, W_BR) + (size_t)i * D * 512, D, nullptr, [](int n) { return n; });
    cvt_matrix(F, AIN(A, 31) + (size_t)layer * D * D, D, D, WSP(bf16, W_OUT), D, nullptr, [](int n) { return n; });
    if (layer == 0) {
        cvt_matrix(F, AIN(A, 33), 2 * FF_D, D, WSP(bf16, W_FGU), 2 * FF_D, nullptr, [](int n) { const int pn = n >> 8, c = n & 255; return c < 128 ? 128 * pn + c : FF_D + 128 * pn + (c - 128); });
        cvt_matrix(F, AIN(A, 34), D, FF_D, WSP(bf16, W_FDN), D, nullptr, [](int n) { return n; });
    } else {
        for (int e = 0; e < NEXP; ++e) {
            cvt_matrix(F, AIN(A, 36) + (size_t)e * D * 2 * FF_E, 2 * FF_E, D, WSP(bf16, W_FGU) + (size_t)e * 2 * FF_E * D, 2 * FF_E, nullptr, [](int n) { const int pn = n >> 8, c = n & 255; return c < 128 ? 128 * pn + c : FF_E + 128 * pn + (c - 128); });
            cvt_matrix(F, AIN(A, 37) + (size_t)e * FF_E * D, D, FF_E, WSP(bf16, W_FDN) + (size_t)e * D * FF_E, D, nullptr, [](int n) { return n; });
        }
    }
    { const float* w2 = AIN(A, 10) + (size_t)layer * 64 * 512; const float* a2 = AIN(A, 12) + (size_t)layer * 64 * 512; const float* g2 = AIN(A, 13) + (size_t)layer * 160 * 512;
      bf16* L = WSP(bf16, W_LORA);
      for (int idx = F.bid * 512 + F.tid; idx < 1536 * 384; idx += F.G * 512) { const int n = idx / 384, k = idx % 384; float v = 0.f;
          if (n < 512) { if (k < 64) v = w2[k * 512 + n]; } else if (n < 1024) { if (k >= 64 && k < 128) v = a2[(k - 64) * 512 + (n - 512)]; } else { if (k >= 128 && k < 288) v = g2[(k - 128) * 512 + (n - 1024)]; }
          L[idx] = (bf16)f2bf(v); } }
}

template <bool ROUTER>
__device__ __forceinline__ void phase_norm(const Frame& F, const Args& A, const float* xin, const float* gain, bf16* H, const float* router, int* tope, float* topw, unsigned* cnt) {
    const int lane = F.lane;
    LAS unsigned* lcnt = (LAS unsigned*)F.lds;
    if (ROUTER) { __syncthreads(); if (F.tid < 8) lcnt[F.tid] = 0u; __syncthreads(); }
    f32x4 gv[4];
#pragma unroll
    for (int j = 0; j < 4; ++j) gv[j] = *(const f32x4*)(gain + 4 * lane + 256 * j);
    for (int m = F.gw; m < TH; m += F.NGW) {
        const float* xr = xin + (size_t)m * D; f32x4 v[4]; float ss = 0.f;
#pragma unroll
        for (int j = 0; j < 4; ++j) { v[j] = *(const f32x4*)(xr + 4 * lane + 256 * j); ss += (v[j].x * v[j].x + v[j].y * v[j].y) + (v[j].z * v[j].z + v[j].w * v[j].w); }
        const float rstd = RSQRT(wave_sum(ss) * (1.0f / D) + EPS);
#pragma unroll
        for (int j = 0; j < 4; ++j) { v[j] = v[j] * rstd * gv[j]; st_bf16x4(H + (size_t)m * D + 4 * lane + 256 * j, v[j]); }
        if (ROUTER) {
            float lg[8];
#pragma unroll
            for (int e = 0; e < 8; ++e) lg[e] = 0.f;
#pragma unroll
            for (int j = 0; j < 4; ++j)
#pragma unroll
                for (int q = 0; q < 4; ++q) { const float* rp = router + (size_t)(4 * lane + 256 * j + q) * 8; const f32x4 r0 = *(const f32x4*)rp, r1 = *(const f32x4*)(rp + 4); const float hv = v[j][q];
                    lg[0] += hv * r0.x; lg[1] += hv * r0.y; lg[2] += hv * r0.z; lg[3] += hv * r0.w; lg[4] += hv * r1.x; lg[5] += hv * r1.y; lg[6] += hv * r1.z; lg[7] += hv * r1.w; }
#pragma unroll
            for (int e = 0; e < 8; ++e) lg[e] = wave_sum(lg[e]);
            if (lane == 0) {
                int e1 = 0; float l1 = lg[0];
#pragma unroll
                for (int e = 1; e < 8; ++e) if (lg[e] > l1) { l1 = lg[e]; e1 = e; }
                int e2 = -1; float l2 = -3.0e38f;
#pragma unroll
                for (int e = 0; e < 8; ++e) if (e != e1 && lg[e] > l2) { l2 = lg[e]; e2 = e; }
                const float w1 = 1.0f / (1.0f + expf(l2 - l1));
                tope[2 * m] = e1; tope[2 * m + 1] = e2; topw[2 * m] = w1; topw[2 * m + 1] = 1.0f - w1;
                ATOMIC_ADD_LDS(lcnt + e1, 1u); ATOMIC_ADD_LDS(lcnt + e2, 1u);
            }
        }
    }
    if (ROUTER) { __syncthreads(); if (F.tid < 8) cnt[F.bid * 8 + F.tid] = lcnt[F.tid]; __syncthreads(); }
}
__device__ __forceinline__ void phase_rope_table(const Frame& F, const Args& A, const int* pos, float* rope) {
    for (int idx = F.bid * 512 + F.tid; idx < TH * 32; idx += F.G * 512) { const int t = idx >> 5, i = idx & 31;
        const float inv = powf(10000.0f, -(float)i / 32.0f);
        const float ang = (float)pos[t] * inv; float sn, cs; sincosf(ang, &sn, &cs);
        rope[(size_t)t * 64 + i] = cs; rope[(size_t)t * 64 + 32 + i] = sn; }
}
__device__ __forceinline__ void phase_final_norm(const Frame& F, const Args& A, float* x, const float* gain) {
    const int lane = F.lane;
    for (int m = F.gw; m < T; m += F.NGW) {
        float* xr = x + (size_t)m * D; f32x4 v[4]; float ss = 0.f;
#pragma unroll
        for (int j = 0; j < 4; ++j) { v[j] = *(const f32x4*)(xr + 4 * lane + 256 * j); ss += (v[j].x * v[j].x + v[j].y * v[j].y) + (v[j].z * v[j].z + v[j].w * v[j].w); }
        const float rstd = RSQRT(wave_sum(ss) * (1.0f / D) + EPS);
#pragma unroll
        for (int j = 0; j < 4; ++j) *(f32x4*)(xr + 4 * lane + 256 * j) = v[j] * rstd * *(const f32x4*)(gain + 4 * lane + 256 * j);
    }
}

__device__ __forceinline__ void phase_mla_prep(const Frame& F, const Args& A) {
    bf16* P = WSP(bf16, A_P); bf16* kr = WSP(bf16, M_KR); const float* rope = WSP(float, A_ROPE);
    const int lane = F.lane;
    for (int m = F.gw; m < TH; m += F.NGW) {
        bf16* pr = P + (size_t)m * PW; float sq = 0.f, skv = 0.f; f32x4 v[3];
#pragma unroll
        for (int j = 0; j < 3; ++j) { const int c = 4 * lane + 256 * j; v[j] = ld_bf16x4(pr + c); const float s = (v[j].x * v[j].x + v[j].y * v[j].y) + (v[j].z * v[j].z + v[j].w * v[j].w);
            if (c < 384) sq += s; else if (c < 640) skv += s; }
        sq = wave_sum(sq); skv = wave_sum(skv);
        const float rq = RSQRT(sq * (1.0f / 384.0f) + EPS), rkv = RSQRT(skv * (1.0f / 256.0f) + EPS);
#pragma unroll
        for (int j = 0; j < 3; ++j) { const int c = 4 * lane + 256 * j; if (c < 640) st_bf16x4(pr + c, v[j] * (c < 384 ? rq : rkv)); }
        if (lane < 32) { const float x1 = bf2f(pr[640 + lane]), x2 = bf2f(pr[672 + lane]), c = rope[(size_t)m * 64 + lane], s = rope[(size_t)m * 64 + 32 + lane];
            kr[(size_t)m * 64 + lane] = (bf16)f2bf(x1 * c - x2 * s); kr[(size_t)m * 64 + 32 + lane] = (bf16)f2bf(x2 * c + x1 * s); }
    }
}
__device__ __forceinline__ void phase_mla_q(const Frame& F, const Args& A) {
    pg8::Gemm g{WSP(bf16, A_P) + 0, WSP(bf16, W_UQ), PW, 384}; pg8::StaticOrder S; S.init(TH, 768, F.G, F.bid);
    EpiBf16 E{WSP(bf16, M_Q), 768, nullptr, 0}; pg8::gemm_phase(F.lds, g, S, E, F.tid);
}
struct EpiKV {
    static constexpr bool PERM = true, AFTER_DRAIN = false;
    bf16* KV; bf16* VT;
    __device__ __forceinline__ void operator()(const f32x4 (&acc)[2][2][4][2], const Unit& u, int wr, int wc, int fr, int fq) const {
        const int row0 = u.pm * 256 + wr * 64 + fr, col0 = wc * 32 + 8 * fq;
#pragma unroll
        for (int ai = 0; ai < 2; ++ai)
#pragma unroll
            for (int m = 0; m < 4; ++m) { const int row = row0 + ai * HALFT + m * 16;
                { const f32x4 v0 = acc[ai][0][m][0], v1 = acc[ai][0][m][1]; u32x4 w; w.x = pk2(v0[0], v0[1]); w.y = pk2(v0[2], v0[3]); w.z = pk2(v1[0], v1[1]); w.w = pk2(v1[2], v1[3]);
                  *(u32x4*)(KV + (size_t)row * 1024 + u.pn * 256 + col0) = w; }
                const int b = row / SEQ, t = row % SEQ; bf16* vt = VT + ((size_t)(b * 4 + u.pn) * 128 + col0) * SEQ + t;
#pragma unroll
                for (int n = 0; n < 2; ++n)
#pragma unroll
                    for (int j = 0; j < 4; ++j) vt[(size_t)(4 * n + j) * SEQ] = (bf16)f2bf(acc[ai][1][m][n][j]); }
    }
};
__device__ __forceinline__ void phase_mla_kv(const Frame& F, const Args& A) {
    pg8::Gemm g{WSP(bf16, A_P) + 384, WSP(bf16, W_UKV), PW, 256}; pg8::StaticOrder S; S.init(TH, 1024, F.G, F.bid);
    EpiKV E{WSP(bf16, M_KV), WSP(bf16, M_VT)}; pg8::gemm_phase(F.lds, g, S, E, F.tid);
}
constexpr int AT_KS = 200, AT_VS = 72;
constexpr int AT_KBYTES = 64 * AT_KS * 2, AT_VBYTES = 128 * AT_VS * 2;
__device__ __forceinline__ void phase_attention(const Frame& F, const Args& A) {
    const bf16* Q = WSP(bf16, M_Q); const bf16* KV = WSP(bf16, M_KV); const bf16* KR = WSP(bf16, M_KR); const bf16* VTg = WSP(bf16, M_VT); const float* rope = WSP(float, A_ROPE); bf16* Y = WSP(bf16, A_Y);
    const int lane = F.lane, w = F.wave, l15 = lane & 15, q4 = lane >> 4, tid = F.tid, grp = w >> 2, wq = w & 3;
    const int NQB = SEQ / 128, nunits = BH * 4 * NQB;
    const float sc2 = 0.07216878364870322f * 1.4426950408889634f;
    for (int unit = F.bid; unit < nunits; unit += F.G) {
        const int qb = NQB - 1 - (unit / (BH * 4)), bh = unit % (BH * 4), h = bh & 3, b = bh >> 2;
        const size_t t0 = (size_t)b * SEQ;
        bf16x8 qf[2][6];
#pragma unroll
        for (int f = 0; f < 2; ++f) { const size_t tq = t0 + qb * 128 + wq * 32 + 16 * f + l15;
#pragma unroll
            for (int ks = 0; ks < 6; ++ks) qf[f][ks] = *(const bf16x8*)(Q + tq * 768 + h * 192 + 32 * ks + 8 * q4);
            const bf16x8 a = qf[f][4], c2 = qf[f][5];
#pragma unroll
            for (int j = 0; j < 8; ++j) { const float x1 = bf2f((unsigned short)a[j]), x2 = bf2f((unsigned short)c2[j]), c = rope[tq * 64 + 8 * q4 + j], sn = rope[tq * 64 + 32 + 8 * q4 + j];
                qf[f][4][j] = (short)f2bf(x1 * c - x2 * sn); qf[f][5][j] = (short)f2bf(x2 * c + x1 * sn); } }
        f32x4 o[2][8];
#pragma unroll
        for (int f = 0; f < 2; ++f)
#pragma unroll
            for (int mb = 0; mb < 8; ++mb) o[f][mb] = (f32x4){0.f, 0.f, 0.f, 0.f};
        float mrow[2] = {-3.0e38f, -3.0e38f}, lrow[2] = {0.f, 0.f};
        const int qchunk = 2 * qb + (wq >> 1), ntile = 2 * qb + 2;
        u32x4 pk_[3], pv_[2];
        const int skey = tid >> 3, c8 = tid & 7;
        const int okv = skey * 1024 + 8 * c8, okr = skey * 64 + 8 * c8, ovt = skey * SEQ + 8 * c8;
        const bf16* kvb = KV + t0 * 1024 + h * 256; const bf16* krb = KR + t0 * 64; const bf16* vtb = VTg + (size_t)(b * 4 + h) * 128 * SEQ;
#define AT_LOAD(kt) do { const bf16* kv_ = kvb + (size_t)(kt) * 65536; const bf16* kr_ = krb + (size_t)(kt) * 4096; const bf16* vt_ = vtb + (size_t)(kt) * 64; \
            pk_[0] = *(const u32x4*)(kv_ + okv); pk_[1] = *(const u32x4*)(kv_ + okv + 64); pk_[2] = *(const u32x4*)(kr_ + okr); \
            pv_[0] = *(const u32x4*)(vt_ + ovt); pv_[1] = *(const u32x4*)(vt_ + ovt + 64 * SEQ); } while (0)
#define AT_STORE(bufi) do { LAS bf16* Ks_ = (LAS bf16*)(F.lds + (bufi) * (AT_KBYTES + AT_VBYTES)); LAS bf16* Vt_ = (LAS bf16*)((LAS unsigned char*)Ks_ + AT_KBYTES); \
            *(LAS u32x4*)(Ks_ + skey * AT_KS + 8 * c8) = pk_[0]; *(LAS u32x4*)(Ks_ + skey * AT_KS + 8 * c8 + 64) = pk_[1]; *(LAS u32x4*)(Ks_ + skey * AT_KS + 8 * c8 + 128) = pk_[2]; \
            *(LAS u32x4*)(Vt_ + skey * AT_VS + 8 * c8) = pv_[0]; *(LAS u32x4*)(Vt_ + (skey + 64) * AT_VS + 8 * c8) = pv_[1]; } while (0)
        __syncthreads();
        AT_LOAD(0); AT_STORE(0);
        __syncthreads();
        for (int kt = 0; kt < ntile; ++kt) {
            if (kt + 1 < ntile) AT_LOAD(kt + 1);
            if (kt <= qchunk) {
                const LAS bf16* Ks = (const LAS bf16*)(F.lds + (kt & 1) * (AT_KBYTES + AT_VBYTES)); const LAS bf16* Vt = (const LAS bf16*)((const LAS unsigned char*)Ks + AT_KBYTES);
                f32x4 st[2][2];
#pragma unroll
                for (int kb = 0; kb < 2; ++kb) { st[0][kb] = (f32x4){0.f, 0.f, 0.f, 0.f}; st[1][kb] = (f32x4){0.f, 0.f, 0.f, 0.f};
#pragma unroll
                    for (int ks = 0; ks < 6; ++ks) { const bf16x8 kf = *(const LAS bf16x8*)(Ks + (32 * grp + 16 * kb + l15) * AT_KS + 32 * ks + 8 * q4);
                        st[0][kb] = MFMA_BF16(kf, qf[0][ks], st[0][kb]); st[1][kb] = MFMA_BF16(kf, qf[1][ks], st[1][kb]); } }
                bf16x8 pb[2];
#pragma unroll
                for (int f = 0; f < 2; ++f) {
                    float mx = -3.0e38f;
#pragma unroll
                    for (int kb = 0; kb < 2; ++kb) { st[f][kb] = st[f][kb] * sc2; mx = fmaxf(mx, fmaxf(fmaxf(st[f][kb].x, st[f][kb].y), fmaxf(st[f][kb].z, st[f][kb].w))); }
                    mx = rows_max(mx);
                    const float mnew = fmaxf(mrow[f], mx), alpha = exp2f(mrow[f] - mnew); mrow[f] = mnew;
                    float ps = 0.f;
#pragma unroll
                    for (int kb = 0; kb < 2; ++kb)
#pragma unroll
                        for (int r = 0; r < 4; ++r) { const float p = exp2f(st[f][kb][r] - mnew); ps += p; pb[f][4 * kb + r] = (short)f2bf(p); }
                    lrow[f] = lrow[f] * alpha + ps;
#pragma unroll
                    for (int mb = 0; mb < 8; ++mb) o[f][mb] = o[f][mb] * alpha;
                }
#pragma unroll
                for (int mb = 0; mb < 8; ++mb) { const LAS bf16* vp = Vt + (16 * mb + l15) * AT_VS + 32 * grp + 4 * q4;
                    const bf16x4 v0 = *(const LAS bf16x4*)vp, v1 = *(const LAS bf16x4*)(vp + 16);
                    bf16x8 vf; vf[0] = v0[0]; vf[1] = v0[1]; vf[2] = v0[2]; vf[3] = v0[3]; vf[4] = v1[0]; vf[5] = v1[1]; vf[6] = v1[2]; vf[7] = v1[3];
                    o[0][mb] = MFMA_BF16(vf, pb[0], o[0][mb]); o[1][mb] = MFMA_BF16(vf, pb[1], o[1][mb]); }
            }
            if (kt + 1 < ntile) AT_STORE((kt + 1) & 1);
            __syncthreads();
        }
#undef AT_LOAD
#undef AT_STORE
#pragma unroll
        for (int f = 0; f < 2; ++f) lrow[f] = rows_sum(lrow[f]);
        LAS float* xo = (LAS float*)F.lds + (size_t)wq * (2 * 8 * 4 * 64 + 4 * 64);
        if (grp == 1) {
#pragma unroll
            for (int f = 0; f < 2; ++f) {
#pragma unroll
                for (int mb = 0; mb < 8; ++mb)
#pragma unroll
                    for (int r = 0; r < 4; ++r) xo[((f * 8 + mb) * 4 + r) * 64 + lane] = o[f][mb][r];
                xo[2 * 8 * 4 * 64 + f * 64 + lane] = mrow[f]; xo[2 * 8 * 4 * 64 + 128 + f * 64 + lane] = lrow[f]; } }
        __syncthreads();
        if (grp == 0) {
#pragma unroll
            for (int f = 0; f < 2; ++f) { const float m1 = xo[2 * 8 * 4 * 64 + f * 64 + lane], l1 = xo[2 * 8 * 4 * 64 + 128 + f * 64 + lane];
                const float m = fmaxf(mrow[f], m1), a0 = exp2f(mrow[f] - m), a1 = exp2f(m1 - m), inv = 1.0f / (lrow[f] * a0 + l1 * a1);
                const size_t tq = t0 + qb * 128 + wq * 32 + 16 * f + l15;
#pragma unroll
                for (int mb = 0; mb < 8; ++mb) { f32x4 v;
#pragma unroll
                    for (int r = 0; r < 4; ++r) v[r] = (o[f][mb][r] * a0 + xo[((f * 8 + mb) * 4 + r) * 64 + lane] * a1) * inv;
                    st_bf16x4(Y + tq * 512 + h * 128 + 16 * mb + 4 * q4, v); } } }
    }
    __syncthreads();
}

__device__ __forceinline__ f32x4 tile_bf(const LAS bf16* a, int lda, const LAS bf16* bt, int ldb, int K, f32x4 acc, int l15, int q4) {
    const LAS bf16* ap = a + l15 * lda + 8 * q4; const LAS bf16* bp = bt + l15 * ldb + 8 * q4;
#pragma unroll 4
    for (int ks = 0; ks < K / 32; ++ks) acc = MFMA_BF16(*(const LAS bf16x8*)(ap + 32 * ks), *(const LAS bf16x8*)(bp + 32 * ks), acc);
    return acc;
}
__device__ __forceinline__ f32x4 tile_mm(const LAS float* a, int lda, int ska, const LAS float* b, int ldb, int scb, int K, f32x4 acc, int l15, int q4);


__device__ __forceinline__ void diag_solve16(const LAS float* Lblk  , int ldl, LAS float* xcol  , int ldx) {
    float x[16];
#pragma unroll
    for (int i = 0; i < 16; ++i) x[i] = xcol[i * ldx];
#pragma unroll
    for (int g = 0; g < 4; ++g) {
        f32x4 av[4][4];
#pragma unroll
        for (int ii = 0; ii < 4; ++ii)
#pragma unroll
            for (int c4 = 0; c4 <= g; ++c4) av[ii][c4] = *(const LAS f32x4*)(Lblk + (4 * g + ii) * ldl + 4 * c4);
#pragma unroll
        for (int ii = 0; ii < 4; ++ii) { const int i = 4 * g + ii; float sacc = x[i];
#pragma unroll
            for (int jj = 0; jj < i; ++jj) sacc -= av[ii][jj >> 2][jj & 3] * x[jj];
            x[i] = sacc; }
    }
#pragma unroll
    for (int i = 1; i < 16; ++i) xcol[i * ldx] = x[i];
}
__device__ __forceinline__ void tri_solve64(const LAS float* L, int ldl, LAS float* X, int ldx, int nct, LAS float* scr, int w, int l15, int q4) {
    LAS float* DI = scr;
    if (w < 4) { LAS float* T = DI + w * 320; LAS float* S = scr + 4 * 320 + w * 320; const LAS float* N = L + 16 * w * ldl + 16 * w;
#pragma unroll
        for (int r = 0; r < 4; ++r) { const int i = 4 * q4 + r; T[i * 20 + l15] = (i == l15 ? 1.0f : 0.0f) - (l15 < i ? N[i * ldl + l15] : 0.0f); }
        { const f32x4 a = tile_mm(N, ldl, 1, N, ldl, 1, 16, (f32x4){0.f, 0.f, 0.f, 0.f}, l15, q4);
#pragma unroll
          for (int r = 0; r < 4; ++r) S[(4 * q4 + r) * 20 + l15] = a[r]; }
        WAVE_SYNC();
#pragma unroll
        for (int it = 0; it < 3; ++it) {
            { const f32x4 a = tile_mm(T, 20, 1, S, 20, 1, 16, (f32x4){0.f, 0.f, 0.f, 0.f}, l15, q4);
#pragma unroll
              for (int r = 0; r < 4; ++r) T[(4 * q4 + r) * 20 + l15] += a[r]; }
            if (it < 2) { const f32x4 a = tile_mm(S, 20, 1, S, 20, 1, 16, (f32x4){0.f, 0.f, 0.f, 0.f}, l15, q4);
#pragma unroll
                for (int r = 0; r < 4; ++r) S[(4 * q4 + r) * 20 + l15] = a[r]; }
            WAVE_SYNC();
        } }
    __syncthreads();
    for (int ct = w; ct < nct; ct += 8) { LAS float* Xc = X + 16 * ct;
#pragma unroll
        for (int rb = 0; rb < 4; ++rb) {
            if (rb > 0) { const f32x4 a = tile_mm(L + 16 * rb * ldl, ldl, 1, Xc, ldx, 1, 16 * rb, (f32x4){0.f, 0.f, 0.f, 0.f}, l15, q4);
#pragma unroll
                for (int r = 0; r < 4; ++r) Xc[(16 * rb + 4 * q4 + r) * ldx + l15] -= a[r];
                WAVE_SYNC(); }
            const f32x4 y = tile_mm(DI + rb * 320, 20, 1, Xc + 16 * rb * ldx, ldx, 1, 16, (f32x4){0.f, 0.f, 0.f, 0.f}, l15, q4);
#pragma unroll
            for (int r = 0; r < 4; ++r) Xc[(16 * rb + 4 * q4 + r) * ldx + l15] = y[r];
            WAVE_SYNC();
        } }
}
__device__ __forceinline__ void phase_rwkv_prep(const Frame& F, const Args& A, int layer) {
    const bf16* P = WSP(bf16, A_P); bf16* RKV = WSP(bf16, R_RKV); bf16* LIN = WSP(bf16, R_LIN); const float* mu = AIN(A, 8) + (size_t)layer * 1824;
    const int lane = F.lane;
    for (int m = F.gw; m < TH; m += F.NGW) {
        const bool first = (m % SEQ) == 0; const bf16* pr = P + (size_t)m * PW + C_RWKV;
#pragma unroll
        for (int j = 0; j < 8; ++j) { const int c = 4 * lane + 256 * j;
            if (c < 1824) { const f32x4 p = ld_bf16x4(pr + c); const f32x4 pv = first ? (f32x4){0.f, 0.f, 0.f, 0.f} : ld_bf16x4(pr - PW + c); const f32x4 muv = *(const f32x4*)(mu + c);
                f32x4 x = p + (pv - p) * muv;
                if (c < 1536) st_bf16x4(RKV + (size_t)m * 1536 + c, x);
                else { if (c < 1600) { x.x = tanhf_(x.x); x.y = tanhf_(x.y); x.z = tanhf_(x.z); x.w = tanhf_(x.w); }
                       else if (c >= 1664) { x.x = sigmoidf_(x.x); x.y = sigmoidf_(x.y); x.z = sigmoidf_(x.z); x.w = sigmoidf_(x.w); }
                       st_bf16x4(LIN + (size_t)m * 384 + (c - 1536), x); } } }
        if (lane < 24) st_bf16x4(LIN + (size_t)m * 384 + 288 + 4 * lane, (f32x4){0.f, 0.f, 0.f, 0.f});
    }
}
__device__ __forceinline__ void phase_rwkv_lora(const Frame& F, const Args& A) {
    pg8::Gemm g{WSP(bf16, R_LIN), WSP(bf16, W_LORA), 384, 384}; pg8::StaticOrder S; S.init(TH, 1536, F.G, (F.bid + F.G / 2) % F.G);
    EpiLora E{WSP(float, R_LOUT), (bf16*)(WSP(float, R_LOUT) + (size_t)TH * 512)}; pg8::gemm_phase(F.lds, g, S, E, F.tid);
}
constexpr int RS = 72;
constexpr int RREC_COMMON = 4 * 64 * RS * 2 + 256;
constexpr int RREC_T = 64 * 64 * 2;
constexpr int RREC_BYTES = RREC_COMMON + 3 * RREC_T;
static_assert(RREC_BYTES == 61696, "record size (see R_REC in the workspace map)");
static_assert(RREC_COMMON % 16 == 0, "record alignment");
__device__ __forceinline__ void phase_rwkv_r1(const Frame& F, const Args& A, int layer) {
    const bf16* RKV = WSP(bf16, R_RKV); const float* LOUT = WSP(float, R_LOUT); unsigned char* REC = WSP(unsigned char, R_REC);
    const float* w0 = AIN(A, 9) + layer * 512; const float* a0 = AIN(A, 11) + layer * 512; const float* k_k = AIN(A, 14) + layer * 512; const float* k_a = AIN(A, 15) + layer * 512;
    LAS bf16* kbar = (LAS bf16*)F.lds; LAS bf16* atil = kbar + 64 * RS; LAS bf16* khat = atil + 64 * RS; LAS bf16* rbar = khat + 64 * RS;
    LAS bf16* atT = rbar + 64 * RS; LAS bf16* khT = atT + 64 * RS; LAS bf16* vT = khT + 64 * RS; LAS bf16* Bm = vT + 64 * RS; LAS bf16* Em = Bm + 64 * RS;
    LAS float* Am = (LAS float*)(Em + 64 * RS);
    LAS float* X = Am + 64 * 68;
    LAS float* lam = Am;
    const int w = F.wave;
    const int nunits = BH * 8 * NCH;
    for (int unit = F.bid; unit < nunits; unit += F.G) {
        int tid = F.tid; OPAQUE_V(tid); ASSUME(tid >= 0 && tid < 512); const int lane = tid & 63, l15 = lane & 15, q4 = lane >> 4;
        const int c = unit % NCH, h = (unit / NCH) & 7, b = unit / (NCH * 8);
        const size_t tok0 = (size_t)b * SEQ + (size_t)c * 64;
        const int j = lane, cj = h * 64 + j;
        __syncthreads();
        float r_[8], km_[8], kk_[8], ka_[8], v_[8], L_[8];
        { const float w0c = w0[cj], a0c = a0[cj], kkc = k_k[cj], kac = k_a[cj]; float run = 0.f;
#pragma unroll
          for (int q = 0; q < 8; ++q) { const int t = 8 * w + q; const size_t tok = tok0 + t;
              const float r = bf2f(RKV[tok * 1536 + cj]), k = bf2f(RKV[tok * 1536 + 512 + cj]); v_[q] = bf2f(RKV[tok * 1536 + 1024 + cj]);
              const float wpre = bf2f(((const bf16*)LOUT)[tok * 512 + cj]), apre = bf2f(((const bf16*)(LOUT + (size_t)TH * 512))[tok * 1024 + cj]);
              const float wl = -softplusf_(-(w0c + wpre)) - 0.5f, a = sigmoidf_(a0c + apre);
              const float kr = k * kkc, ss = wave_sum(kr * kr), kk = kr * RSQRT(ss + EPS);
              r_[q] = r; km_[q] = k * (1.0f + (a - 1.0f) * kac); kk_[q] = kk; ka_[q] = kk * a;
              run += -expf(wl); L_[q] = run; }
          lam[w * 64 + j] = run; }
        __syncthreads();
        { float base = 0.f, Lend = 0.f;
#pragma unroll
          for (int ww = 0; ww < 8; ++ww) { const float tw = lam[ww * 64 + j]; if (ww < w) base += tw; Lend += tw; }
#pragma unroll
          for (int q = 0; q < 8; ++q) { const int t = 8 * w + q; const float L = base + L_[q], Lm1 = q ? base + L_[q - 1] : base;
              const float eG = expf(L), eGi = expf(-L), eGm1 = expf(Lm1), eT = expf(Lend - L);
              const float kb = kk_[q] * eGm1;
              kbar[t * RS + j] = (bf16)f2bf(kb); X[t * 132 + j] = kb;
              atil[t * RS + j] = (bf16)f2bf(ka_[q] * eGi); khat[t * RS + j] = (bf16)f2bf(km_[q] * eGi); rbar[t * RS + j] = (bf16)f2bf(r_[q] * eG);
              atT[j * RS + t] = (bf16)f2bf(-ka_[q] * eT); khT[j * RS + t] = (bf16)f2bf(km_[q] * eT); vT[j * RS + t] = (bf16)f2bf(v_[q]); }
          if (w == 0) { float* gc = (float*)(REC + (size_t)unit * RREC_BYTES + 4 * 64 * RS * 2); gc[j] = expf(Lend); } }
        __syncthreads();
        unsigned char* rec = REC + (size_t)unit * RREC_BYTES;
        { const int which = w >> 1, tib = 2 * (w & 1);
          const LAS bf16* Aop = (which & 2) ? rbar : kbar; const LAS bf16* Bop = (which & 1) ? khat : atil;
          bf16x8 aF[2][2], bF[4][2];
#pragma unroll
          for (int t = 0; t < 2; ++t)
#pragma unroll
              for (int ks = 0; ks < 2; ++ks) aF[t][ks] = *(const LAS bf16x8*)(Aop + (16 * (tib + t) + l15) * RS + 8 * q4 + 32 * ks);
#pragma unroll
          for (int tj = 0; tj < 4; ++tj)
#pragma unroll
              for (int ks = 0; ks < 2; ++ks) bF[tj][ks] = *(const LAS bf16x8*)(Bop + (16 * tj + l15) * RS + 8 * q4 + 32 * ks);
          f32x4 acc[2][4];
#pragma unroll
          for (int t = 0; t < 2; ++t)
#pragma unroll
              for (int tj = 0; tj < 4; ++tj) { acc[t][tj] = MFMA_BF16(aF[t][0], bF[tj][0], ((f32x4){0.f, 0.f, 0.f, 0.f})); acc[t][tj] = MFMA_BF16(aF[t][1], bF[tj][1], acc[t][tj]); }
#pragma unroll
          for (int t = 0; t < 2; ++t)
#pragma unroll
              for (int tj = 0; tj < 4; ++tj)
#pragma unroll
                  for (int r = 0; r < 4; ++r) { const int i = 16 * (tib + t) + 4 * q4 + r, jj = 16 * tj + l15; const bool keep = (which & 2) ? (jj <= i) : (jj < i); acc[t][tj][r] = keep ? acc[t][tj][r] : 0.f; }
#define R1_EPI(STMT) _Pragma("unroll") for (int t = 0; t < 2; ++t) _Pragma("unroll") for (int tj = 0; tj < 4; ++tj) _Pragma("unroll") for (int r = 0; r < 4; ++r) { const int i = 16 * (tib + t) + 4 * q4 + r, jj = 16 * tj + l15; const float v = acc[t][tj][r]; STMT; }
          if (which == 0) { R1_EPI(Am[i * 68 + jj] = v) }
          else if (which == 1) { R1_EPI(Bm[i * RS + jj] = (bf16)f2bf(v)) }
          else if (which == 3) { R1_EPI(Em[i * RS + jj] = (bf16)f2bf(v)) }
          else { bf16* fm = (bf16*)(rec + 2 * 64 * RS * 2); R1_EPI(fm[i * RS + jj] = (bf16)f2bf(-v)) }
#undef R1_EPI
        }
        __syncthreads();
        { const int tj = w & 3, pb = 6 * (w >> 2);
          bf16x8 bF[2]; f32x4 acc[6];
#pragma unroll
          for (int ks = 0; ks < 2; ++ks) bF[ks] = *(const LAS bf16x8*)(vT + (16 * tj + l15) * RS + 8 * q4 + 32 * ks);
#pragma unroll
          for (int pq = 0; pq < 6; ++pq) { const int pair = pb + pq, which = pair >> 2, ti = pair & 3; const LAS bf16* aop = which == 0 ? Bm : which == 1 ? Em : khT;
              const bf16x8 a0 = *(const LAS bf16x8*)(aop + (16 * ti + l15) * RS + 8 * q4), a1 = *(const LAS bf16x8*)(aop + (16 * ti + l15) * RS + 8 * q4 + 32);
              acc[pq] = MFMA_BF16(a0, bF[0], ((f32x4){0.f, 0.f, 0.f, 0.f})); acc[pq] = MFMA_BF16(a1, bF[1], acc[pq]); }
#pragma unroll
          for (int pq = 0; pq < 6; ++pq) { const int pair = pb + pq, which = pair >> 2, ti = pair & 3;
              if (which == 0) {
#pragma unroll
                  for (int r = 0; r < 4; ++r) X[(16 * ti + 4 * q4 + r) * 132 + 64 + 16 * tj + l15] = acc[pq][r]; }
              else st_bf16x4((bf16*)(rec + RREC_COMMON + which * RREC_T) + (16 * tj + l15) * 64 + 16 * ti + 4 * q4, acc[pq]); } }
        __syncthreads();
        tri_solve64(Am, 68, X, 132, 8, X + 64 * 132, w, l15, q4);
        __syncthreads();
        { const int t = tid >> 3, j0 = 8 * (tid & 7); float v[8];
#pragma unroll
          for (int q = 0; q < 8; ++q) v[q] = X[t * 132 + j0 + q];
          *(u32x4*)((bf16*)rec + t * RS + j0) = pack8(v);
          const int vv = tid >> 3, t0 = 8 * (tid & 7);
#pragma unroll
          for (int q = 0; q < 8; ++q) v[q] = X[(t0 + q) * 132 + 64 + vv];
          *(u32x4*)((bf16*)(rec + RREC_COMMON) + vv * 64 + t0) = pack8(v); }
        for (int e = tid; e < 64 * RS / 8; e += 512) { ((u32x4*)(rec + 64 * RS * 2))[e] = ((const LAS u32x4*)rbar)[e]; ((u32x4*)(rec + 3 * 64 * RS * 2))[e] = ((const LAS u32x4*)atT)[e]; }
    }
    __syncthreads();
}
constexpr int R2_BUF = RREC_COMMON;
__device__ __forceinline__ void phase_rwkv_r2(const Frame& F, const Args& A, unsigned* flags) {
    const unsigned char* REC = WSP(unsigned char, R_REC); bf16* RO = WSP(bf16, R_O);
    LAS unsigned char* buf0 = F.lds; LAS bf16* HT = (LAS bf16*)(F.lds + 2 * R2_BUF); LAS bf16* UT = HT + 2 * 64 * RS;
    const int w = F.wave, ti = w >> 1;
    const int nunits = BH * 8;
    constexpr int NCHK = R2_BUF / 16;
    for (int unit = F.bid; unit < nunits; unit += F.G) {
        int tid = F.tid; OPAQUE_V(tid); ASSUME(tid >= 0 && tid < 512); const int lane = tid & 63, l15 = lane & 15, q4 = lane >> 4;
        const int h = unit & 7, b = unit >> 3;
        __syncthreads();
        for (int e = tid; e < 2 * 64 * RS / 2; e += 512) ((LAS unsigned*)HT)[e] = 0u;
        f32x4 Hreg[2] = {(f32x4){0.f, 0.f, 0.f, 0.f}, (f32x4){0.f, 0.f, 0.f, 0.f}};
        u32x4 preA[5], preB[5]; u32x2 iniA[3][2], iniB[3][2], cur[3][2];
        const unsigned char* rec0 = REC + (size_t)((b * 8 + h) * NCH) * RREC_BYTES;
        const int tofs = ((16 * (2 * (w & 1)) + l15) * 64 + 16 * ti + 4 * q4) * 2;
#define R2_LOAD(S, recp) do { _Pragma("unroll") for (int q = 0; q < 5; ++q) { const int e = tid + 512 * q; if (e < NCHK) pre##S[q] = *(const u32x4*)((recp) + (size_t)e * 16); } \
            _Pragma("unroll") for (int mq = 0; mq < 3; ++mq) { ini##S[mq][0] = *(const u32x2*)((recp) + RREC_COMMON + mq * RREC_T + tofs); ini##S[mq][1] = *(const u32x2*)((recp) + RREC_COMMON + mq * RREC_T + tofs + 16 * 64 * 2); } } while (0)
#define R2_STORE(S, dst) do { _Pragma("unroll") for (int q = 0; q < 5; ++q) { const int e = tid + 512 * q; if (e < NCHK) *(LAS u32x4*)((dst) + (size_t)e * 16) = pre##S[q]; } } while (0)
#define R2_TAKE(S) do { _Pragma("unroll") for (int mq = 0; mq < 3; ++mq) { cur[mq][0] = ini##S[mq][0]; cur[mq][1] = ini##S[mq][1]; } } while (0)
        R2_LOAD(A, rec0); R2_STORE(A, buf0); R2_TAKE(A);
        if (NCH > 1) R2_LOAD(A, rec0 + (size_t)RREC_BYTES);
        __syncthreads();
#define R2_STEP(c, LS, SS) do { \
            LAS unsigned char* buf = buf0 + ((c) & 1) * R2_BUF; LAS unsigned char* nbuf = buf0 + (((c) + 1) & 1) * R2_BUF; \
            if ((c) + 2 < NCH) R2_LOAD(LS, rec0 + (size_t)((c) + 2) * RREC_BYTES); \
            const LAS bf16* KB = (const LAS bf16*)buf; const LAS bf16* RB = KB + 64 * RS; const LAS bf16* FMn = RB + 64 * RS; const LAS bf16* ATn = FMn + 64 * RS; \
            const LAS float* GC = (const LAS float*)(buf + 4 * 64 * RS * 2); \
            const LAS bf16* H0 = HT + ((c) & 1) * 64 * RS; LAS bf16* H1 = HT + (((c) + 1) & 1) * 64 * RS; \
              \
            bf16x8 hf[2][2], uf[2][2], af[2]; \
            _Pragma("unroll") for (int t2 = 0; t2 < 2; ++t2) _Pragma("unroll") for (int ks = 0; ks < 2; ++ks) hf[t2][ks] = *(const LAS bf16x8*)(H0 + (16 * (2 * (w & 1) + t2) + l15) * RS + 8 * q4 + 32 * ks); \
            _Pragma("unroll") for (int ks = 0; ks < 2; ++ks) af[ks] = *(const LAS bf16x8*)(KB + (16 * ti + l15) * RS + 8 * q4 + 32 * ks); \
            _Pragma("unroll") for (int t2 = 0; t2 < 2; ++t2) { const int tj = 2 * (w & 1) + t2; \
                f32x4 u = (f32x4){bf2f(cur[0][t2].x & 0xffffu), bf2f(cur[0][t2].x >> 16), bf2f(cur[0][t2].y & 0xffffu), bf2f(cur[0][t2].y >> 16)}; \
                u = MFMA_BF16(af[0], hf[t2][0], u); u = MFMA_BF16(af[1], hf[t2][1], u); \
                u32x2 pk; pk.x = pk2(u[0], u[1]); pk.y = pk2(u[2], u[3]); *(LAS u32x2*)(UT + (16 * tj + l15) * RS + 16 * ti + 4 * q4) = pk; } \
            __syncthreads(); \
            _Pragma("unroll") for (int t2 = 0; t2 < 2; ++t2) _Pragma("unroll") for (int ks = 0; ks < 2; ++ks) uf[t2][ks] = *(const LAS bf16x8*)(UT + (16 * (2 * (w & 1) + t2) + l15) * RS + 8 * q4 + 32 * ks); \
            { bf16x8 rf[2], ff[2], tf[2]; \
              _Pragma("unroll") for (int ks = 0; ks < 2; ++ks) { rf[ks] = *(const LAS bf16x8*)(RB + (16 * ti + l15) * RS + 8 * q4 + 32 * ks); ff[ks] = *(const LAS bf16x8*)(FMn + (16 * ti + l15) * RS + 8 * q4 + 32 * ks); tf[ks] = *(const LAS bf16x8*)(ATn + (16 * ti + l15) * RS + 8 * q4 + 32 * ks); } \
              _Pragma("unroll") for (int t2 = 0; t2 < 2; ++t2) { const int tj = 2 * (w & 1) + t2; \
                f32x4 o = (f32x4){bf2f(cur[1][t2].x & 0xffffu), bf2f(cur[1][t2].x >> 16), bf2f(cur[1][t2].y & 0xffffu), bf2f(cur[1][t2].y >> 16)}; \
                o = MFMA_BF16(rf[0], hf[t2][0], o); o = MFMA_BF16(rf[1], hf[t2][1], o); o = MFMA_BF16(ff[0], uf[t2][0], o); o = MFMA_BF16(ff[1], uf[t2][1], o); \
                _Pragma("unroll") for (int r = 0; r < 4; ++r) RO[((size_t)b * SEQ + (size_t)(c) * 64 + 16 * ti + 4 * q4 + r) * 512 + h * 64 + 16 * tj + l15] = (bf16)f2bf(o[r]); \
                const f32x4 kv = (f32x4){bf2f(cur[2][t2].x & 0xffffu), bf2f(cur[2][t2].x >> 16), bf2f(cur[2][t2].y & 0xffffu), bf2f(cur[2][t2].y >> 16)}; \
                _Pragma("unroll") for (int r = 0; r < 4; ++r) Hreg[t2][r] = Hreg[t2][r] * GC[16 * ti + 4 * q4 + r] + kv[r]; \
                Hreg[t2] = MFMA_BF16(tf[0], uf[t2][0], Hreg[t2]); Hreg[t2] = MFMA_BF16(tf[1], uf[t2][1], Hreg[t2]); \
                u32x2 pk; pk.x = pk2(Hreg[t2][0], Hreg[t2][1]); pk.y = pk2(Hreg[t2][2], Hreg[t2][3]); *(LAS u32x2*)(H1 + (16 * tj + l15) * RS + 16 * ti + 4 * q4) = pk; } } \
            if ((c) + 1 < NCH) { R2_STORE(SS, nbuf); R2_TAKE(SS); } \
            __syncthreads(); } while (0)
        for (int c = 0; c < NCH; c += 2) { R2_STEP(c, B, A); R2_STEP(c + 1, A, B); }
        if (tid == 0) FLAG_SET(flags + unit);
#undef R2_STEP
#undef R2_STORE
#undef R2_TAKE
#undef R2_LOAD
    }
    __syncthreads();
}
__device__ __forceinline__ void phase_rwkv_post_queue(const Frame& F, const Args& A, int layer, unsigned* flags, unsigned* queue) {
    const bf16* RKV = WSP(bf16, R_RKV); const bf16* LAG = (const bf16*)(WSP(float, R_LOUT) + (size_t)TH * 512); const bf16* RO = WSP(bf16, R_O); bf16* Y = WSP(bf16, A_Y) + (size_t)1 * TH * 512;
    LAS unsigned* slot = (LAS unsigned*)(F.lds + PQ_SLOT_OFF);
    const int tid = F.tid, lane = F.lane, w = F.wave, tl = lane >> 3, nitems = BH * 8 * (SEQ / 256);
    for (;;) {
        __syncthreads();
        if (tid == 0) *slot = ATOMIC_ADD_U32(queue, 1u);
        __syncthreads();
        const int item = RFL((int)*slot);
        if (item >= nitems) break;
        const int unit = item / (SEQ / 256), blk = item % (SEQ / 256), h = unit & 7, b = unit >> 3;
        if (tid == 0) FLAG_WAIT(flags + unit);
        __syncthreads();
        const int c0 = h * 64 + 8 * (lane & 7);
        float pa0[8], pka[8], prk[8], plw[8], plb[8];
        { const float* a0 = AIN(A, 11) + layer * 512 + c0; const float* k_a = AIN(A, 15) + layer * 512 + c0; const float* r_k = AIN(A, 16) + layer * 512 + c0; const float* ln_w = AIN(A, 17) + layer * 512 + c0; const float* ln_b = AIN(A, 18) + layer * 512 + c0;
#pragma unroll
          for (int q = 0; q < 8; ++q) { pa0[q] = a0[q]; pka[q] = k_a[q]; prk[q] = r_k[q]; plw[q] = ln_w[q]; plb[q] = ln_b[q]; } }
#pragma unroll 2
        for (int it = 0; it < 4; ++it) { const size_t m = (size_t)b * SEQ + 256 * blk + 32 * w + 8 * it + tl;
            float o[8], r[8], k[8], v[8], ap[8], g[8];
            { const f32x4 a = ld_bf16x4(RO + m * 512 + c0), b2 = ld_bf16x4(RO + m * 512 + c0 + 4); o[0] = a.x; o[1] = a.y; o[2] = a.z; o[3] = a.w; o[4] = b2.x; o[5] = b2.y; o[6] = b2.z; o[7] = b2.w; }
#pragma unroll
            for (int hh = 0; hh < 2; ++hh) { const f32x4 rv = ld_bf16x4(RKV + m * 1536 + c0 + 4 * hh), kv = ld_bf16x4(RKV + m * 1536 + 512 + c0 + 4 * hh), vv = ld_bf16x4(RKV + m * 1536 + 1024 + c0 + 4 * hh);
                const f32x4 av = ld_bf16x4(LAG + m * 1024 + c0 + 4 * hh), gv = ld_bf16x4(LAG + m * 1024 + 512 + c0 + 4 * hh);
#pragma unroll
                for (int q = 0; q < 4; ++q) { r[4 * hh + q] = rv[q]; k[4 * hh + q] = kv[q]; v[4 * hh + q] = vv[q]; ap[4 * hh + q] = av[q]; g[4 * hh + q] = gv[q]; } }
            float bon = 0.f, sm = 0.f;
#pragma unroll
            for (int q = 0; q < 8; ++q) { const float a = sigmoidf_(pa0[q] + ap[q]); const float km = k[q] * (1.0f + (a - 1.0f) * pka[q]); bon += r[q] * km * prk[q]; sm += o[q]; }
            bon = red_sum<8>(bon); sm = red_sum<8>(sm);
            const float mean = sm * (1.0f / 64.0f); float vs = 0.f;
#pragma unroll
            for (int q = 0; q < 8; ++q) { const float d = o[q] - mean; vs += d * d; }
            vs = red_sum<8>(vs);
            const float rstd = RSQRT(vs * (1.0f / 64.0f) + 64e-5f);
            float y[8];
#pragma unroll
            for (int q = 0; q < 8; ++q) y[q] = ((o[q] - mean) * rstd * plw[q] + plb[q] + bon * v[q]) * g[q];
            u32x4 wv; wv.x = pk2(y[0], y[1]); wv.y = pk2(y[2], y[3]); wv.z = pk2(y[4], y[5]); wv.w = pk2(y[6], y[7]);
            *(u32x4*)(Y + m * 512 + c0) = wv; }
    }
    __syncthreads();
}

__device__ __forceinline__ void conv8x8(const bf16* src, int tl0  , const float* w  , int wld, const float* bias, float (&out)[8][8]) {
    float x[11][8];
#pragma unroll
    for (int i = 0; i < 11; ++i) { const int tl = tl0 - 3 + i;
        if (tl >= 0) { const u32x4 v = *(const u32x4*)(src + (ptrdiff_t)(i - 3) * PW);
            x[i][0] = bf2f(v.x & 0xffffu); x[i][1] = bf2f(v.x >> 16); x[i][2] = bf2f(v.y & 0xffffu); x[i][3] = bf2f(v.y >> 16); x[i][4] = bf2f(v.z & 0xffffu); x[i][5] = bf2f(v.z >> 16); x[i][6] = bf2f(v.w & 0xffffu); x[i][7] = bf2f(v.w >> 16); }
        else {
#pragma unroll
            for (int ch = 0; ch < 8; ++ch) x[i][ch] = 0.f; } }
    float wv[4][8], bv[8];
#pragma unroll
    for (int j = 0; j < 4; ++j) { const f32x4 a = *(const f32x4*)(w + j * wld), b = *(const f32x4*)(w + j * wld + 4); wv[j][0] = a.x; wv[j][1] = a.y; wv[j][2] = a.z; wv[j][3] = a.w; wv[j][4] = b.x; wv[j][5] = b.y; wv[j][6] = b.z; wv[j][7] = b.w; }
    if (bias) { const f32x4 a = *(const f32x4*)bias, b = *(const f32x4*)(bias + 4); bv[0] = a.x; bv[1] = a.y; bv[2] = a.z; bv[3] = a.w; bv[4] = b.x; bv[5] = b.y; bv[6] = b.z; bv[7] = b.w; }
    else {
#pragma unroll
        for (int ch = 0; ch < 8; ++ch) bv[ch] = 0.f; }
#pragma unroll
    for (int i = 0; i < 8; ++i)
#pragma unroll
        for (int ch = 0; ch < 8; ++ch) { const float a = bv[ch] + wv[0][ch] * x[i][ch] + wv[1][ch] * x[i + 1][ch] + wv[2][ch] * x[i + 2][ch] + wv[3][ch] * x[i + 3][ch]; out[i][ch] = a * fast_rcp(1.0f + fast_exp(-a)); }
}
constexpr int SB = 136;
constexpr int SC_IMG = 64 * SB * 2;
__device__ __forceinline__ void phase_ssd_s1(const Frame& F, const Args& A, int layer) {
    const bf16* P = WSP(bf16, A_P); bf16* ST = WSP(bf16, S_ST); bf16* YD = WSP(bf16, S_YD); unsigned char* SCB = WSP(unsigned char, S_C); float* AC = WSP(float, S_AC);
    const float* cw = AIN(A, 23) + (size_t)layer * 4 * 1024; const float* cb = AIN(A, 24) + layer * 1024; const float* dtb = AIN(A, 25) + layer * 8; const float* a_log = AIN(A, 26) + layer * 8; const float* dsk = AIN(A, 27) + layer * 8;
    LAS bf16* Bt_ = (LAS bf16*)F.lds; LAS bf16* Ct_ = Bt_ + 64 * SB; LAS bf16* BT = Ct_ + 64 * SB; LAS bf16* xT = BT + 128 * RS;
    LAS bf16* Mb = xT + 4 * 64 * RS; LAS bf16* xdT = Mb + 2 * 64 * RS; LAS float* dt = (LAS float*)(xdT + 2 * 64 * RS); LAS float* ac = dt + 256;
    const int w = F.wave;
    const int nunits = BH * NCH * 2;
    for (int unit = F.bid; unit < nunits; unit += F.G) {
        int tid = F.tid; OPAQUE_V(tid); ASSUME(tid >= 0 && tid < 512); const int lane = tid & 63, l15 = lane & 15, q4 = lane >> 4;
        const int g = unit & 1, c = (unit >> 1) % NCH, b = unit / (2 * NCH);
        const size_t tok0 = (size_t)b * SEQ + (size_t)c * 64;
        __syncthreads();
        {
            const int cg = tid & 63, rb = tid >> 6;
            const int cidx = cg < 32 ? g * 256 + 8 * cg : cg < 48 ? 512 + g * 128 + 8 * (cg - 32) : 768 + g * 128 + 8 * (cg - 48);
            float o[8][8];
            conv8x8(P + (tok0 + 8 * rb) * PW + C_SSD + 512 + cidx, c * 64 + 8 * rb, cw + cidx, 1024, cb + cidx, o);
            if (cg < 32) {
                const int hh = cg >> 3, p0 = 8 * (cg & 7);
#pragma unroll
                for (int ch = 0; ch < 8; ++ch) { float col[8];
#pragma unroll
                    for (int i = 0; i < 8; ++i) col[i] = o[i][ch];
                    *(LAS u32x4*)(xT + (hh * 64 + p0 + ch) * RS + 8 * rb) = pack8(col); }
            } else if (cg < 48) {
                const int n0 = 8 * (cg - 32);
#pragma unroll
                for (int i = 0; i < 8; ++i) *(LAS u32x4*)(Bt_ + (8 * rb + i) * SB + n0) = pack8(o[i]);
#pragma unroll
                for (int ch = 0; ch < 8; ++ch) { float col[8];
#pragma unroll
                    for (int i = 0; i < 8; ++i) col[i] = o[i][ch];
                    *(LAS u32x4*)(BT + (n0 + ch) * RS + 8 * rb) = pack8(col); }
            } else { const int n0 = 8 * (cg - 48);
#pragma unroll
                for (int i = 0; i < 8; ++i) *(LAS u32x4*)(Ct_ + (8 * rb + i) * SB + n0) = pack8(o[i]); }
        }
        if (tid < 256) { const int hh = tid >> 6, h = 4 * g + hh; const float d = softplusf_(bf2f(P[(tok0 + lane) * PW + C_SSD + 1536 + h]) + dtb[h]); float a = -expf(a_log[h]) * d;
#pragma unroll
            for (int o = 1; o < 64; o <<= 1) { const float t = __shfl_up(a, o); if (lane >= o) a += t; }
            dt[tid] = d; ac[tid] = a; AC[(tok0 + lane) * 8 + h] = a; }
        __syncthreads();
        { unsigned char* dst = SCB + (size_t)unit * SC_IMG; for (int e = tid; e < SC_IMG / 16; e += 512) ((u32x4*)dst)[e] = ((const LAS u32x4*)Ct_)[e]; }
        f32x4 cbt[2];
#pragma unroll
        for (int tt = 0; tt < 2; ++tt) { const int tile = w * 2 + tt, ti = tile >> 2, tj = tile & 3; cbt[tt] = (f32x4){0.f, 0.f, 0.f, 0.f};
            if (tj <= ti) cbt[tt] = tile_bf(Ct_ + 16 * ti * SB, SB, Bt_ + 16 * tj * SB, SB, 128, cbt[tt], l15, q4); }
        for (int hh = 0; hh < 4; ++hh) { const int h = 4 * g + hh; LAS bf16* M = Mb + (hh & 1) * 64 * RS; LAS bf16* xd = xdT + (hh & 1) * 64 * RS; const LAS float* dth = dt + hh * 64; const LAS float* ach = ac + hh * 64;
#pragma unroll
            for (int tt = 0; tt < 2; ++tt) { const int tile = w * 2 + tt, ti = tile >> 2, tj = tile & 3;
#pragma unroll
                for (int r = 0; r < 4; ++r) { const int l = 16 * ti + 4 * q4 + r, s = 16 * tj + l15; M[l * RS + s] = (bf16)f2bf((s <= l) ? cbt[tt][r] * expf(ach[l] - ach[s]) * dth[s] : 0.f); } }
            { const int p = tid >> 3, l0 = 8 * (tid & 7); const u32x4 v = *(const LAS u32x4*)(xT + (hh * 64 + p) * RS + l0); const float a63 = ach[63]; float xv[8] = {bf2f(v.x & 0xffffu), bf2f(v.x >> 16), bf2f(v.y & 0xffffu), bf2f(v.y >> 16), bf2f(v.z & 0xffffu), bf2f(v.z >> 16), bf2f(v.w & 0xffffu), bf2f(v.w >> 16)};
#pragma unroll
              for (int i = 0; i < 8; ++i) xv[i] *= dth[l0 + i] * expf(a63 - ach[l0 + i]);
              *(LAS u32x4*)(xd + p * RS + l0) = pack8(xv); }
            __syncthreads();
#pragma unroll
            for (int tt = 0; tt < 2; ++tt) { const int tile = w * 2 + tt, ti = tile >> 2, tj = tile & 3;
                const f32x4 acc = tile_bf(M + 16 * ti * RS, RS, xT + (hh * 64 + 16 * tj) * RS, RS, 64, (f32x4){0.f, 0.f, 0.f, 0.f}, l15, q4);
                const f32x4 xs = ld_bf16x4((const bf16*)(xT + (hh * 64 + 16 * tj + l15) * RS + 16 * ti + 4 * q4));
#pragma unroll
                for (int r = 0; r < 4; ++r) YD[(tok0 + 16 * ti + 4 * q4 + r) * 512 + h * 64 + 16 * tj + l15] = (bf16)f2bf(acc[r] + dsk[h] * xs[r]); }
            bf16* st = ST + ((size_t)((b * NCH + c) * 8 + h)) * 64 * 128;
#pragma unroll
            for (int tt = 0; tt < 4; ++tt) { const int tile = w * 4 + tt, ti = tile >> 2, tj = tile & 3;
                const f32x4 acc = tile_bf(BT + 16 * ti * RS, RS, xd + 16 * tj * RS, RS, 64, (f32x4){0.f, 0.f, 0.f, 0.f}, l15, q4);
                st_bf16x4(st + (16 * tj + l15) * 128 + 16 * ti + 4 * q4, acc); }
        }
    }
    __syncthreads();
}
__device__ __forceinline__ void phase_ssd_s23(const Frame& F, const Args& A) {
    const bf16* ST = WSP(bf16, S_ST); bf16* YO = WSP(bf16, S_YO); const unsigned char* SCB = WSP(unsigned char, S_C); const float* AC = WSP(float, S_AC);
    LAS bf16* Cimg = (LAS bf16*)F.lds; LAS bf16* Hb = Cimg + 2 * 64 * SB;
    const int w = F.wave;
    const int nunits = BH * 8 * 4;
    constexpr int NCK = SC_IMG / 16;
    for (int unit = F.bid; unit < nunits; unit += F.G) {
        int tid = F.tid; OPAQUE_V(tid); ASSUME(tid >= 0 && tid < 512); const int lane = tid & 63, l15 = lane & 15, q4 = lane >> 4, hp = tid >> 5, hn = 4 * (tid & 31);
        const int ps = unit & 3, h = (unit >> 2) & 7, b = unit >> 5, g = h >> 2;
        __syncthreads();
        f32x4 Hr = (f32x4){0.f, 0.f, 0.f, 0.f};
        u32x4 preA[3], preB[3]; u32x2 pstA, pstB, stc; float eaA[5], eaB[5], eac[5];
        const size_t tokb = (size_t)b * SEQ;
#define S23_LOAD(S, cc) do { const unsigned char* src_ = SCB + (size_t)((b * NCH + (cc)) * 2 + g) * SC_IMG; \
            _Pragma("unroll") for (int q = 0; q < 3; ++q) { const int e = tid + 512 * q; if (e < NCK) pre##S[q] = *(const u32x4*)(src_ + (size_t)e * 16); } \
            pst##S = *(const u32x2*)(ST + ((size_t)((b * NCH + (cc)) * 8 + h)) * 8192 + (16 * ps + hp) * 128 + hn); \
            _Pragma("unroll") for (int r = 0; r < 4; ++r) ea##S[r] = AC[(tokb + (size_t)(cc) * 64 + 16 * (w & 3) + 4 * q4 + r) * 8 + h]; \
            ea##S[4] = AC[(tokb + (size_t)(cc) * 64 + 63) * 8 + h]; } while (0)
#define S23_STORE(S, dst) do { _Pragma("unroll") for (int q = 0; q < 3; ++q) { const int e = tid + 512 * q; if (e < NCK) ((LAS u32x4*)(dst))[e] = pre##S[q]; } } while (0)
#define S23_TAKE(S) do { stc = pst##S; _Pragma("unroll") for (int r = 0; r < 5; ++r) eac[r] = ea##S[r]; } while (0)
        S23_LOAD(A, 0); S23_STORE(A, Cimg); S23_TAKE(A);
        if (NCH > 1) S23_LOAD(A, 1);
#define S23_STEP(c, LS, SS) do { \
            const size_t tok0 = tokb + (size_t)(c) * 64; \
            if ((c) + 2 < NCH) S23_LOAD(LS, (c) + 2); \
            st_bf16x4((bf16*)(Hb + hp * SB + hn), Hr); \
            __syncthreads(); \
            if (w < 4) { const LAS bf16* Ci = Cimg + ((c) & 1) * 64 * SB; \
                const f32x4 acc = tile_bf(Ci + 16 * w * SB, SB, Hb, SB, 128, (f32x4){0.f, 0.f, 0.f, 0.f}, l15, q4); \
                _Pragma("unroll") for (int r = 0; r < 4; ++r) { const size_t tok = tok0 + 16 * w + 4 * q4 + r; YO[tok * 512 + h * 64 + 16 * ps + l15] = (bf16)f2bf(acc[r] * expf(eac[r])); } } \
            { const float dec = expf(eac[4]); Hr.x = dec * Hr.x + bf2f(stc.x & 0xffffu); Hr.y = dec * Hr.y + bf2f(stc.x >> 16); Hr.z = dec * Hr.z + bf2f(stc.y & 0xffffu); Hr.w = dec * Hr.w + bf2f(stc.y >> 16); } \
            if ((c) + 1 < NCH) { S23_STORE(SS, Cimg + (((c) + 1) & 1) * 64 * SB); S23_TAKE(SS); } \
            __syncthreads(); } while (0)
        for (int c = 0; c < NCH; c += 2) { S23_STEP(c, B, A); S23_STEP(c + 1, A, B); }
#undef S23_STEP
#undef S23_TAKE
#undef S23_STORE
#undef S23_LOAD
    }
    __syncthreads();
}
__device__ __forceinline__ void phase_ssd_s4(const Frame& F, const Args& A, int layer) {
    const bf16* YD = WSP(bf16, S_YD); const bf16* YO = WSP(bf16, S_YO); const bf16* P = WSP(bf16, A_P); bf16* Y = WSP(bf16, A_Y) + (size_t)3 * TH * 512; const float* nw = AIN(A, 28) + layer * 512;
    const int lane = F.lane, c0 = 8 * lane;
    for (int m = F.gw; m < TH; m += F.NGW) {
        const f32x4 a = ld_bf16x4(YD + (size_t)m * 512 + c0) + ld_bf16x4(YO + (size_t)m * 512 + c0), b2 = ld_bf16x4(YD + (size_t)m * 512 + c0 + 4) + ld_bf16x4(YO + (size_t)m * 512 + c0 + 4);
        const f32x4 z0 = ld_bf16x4(P + (size_t)m * PW + C_SSD + c0), z1 = ld_bf16x4(P + (size_t)m * PW + C_SSD + c0 + 4);
        float y[8] = {a.x * siluf_(z0.x), a.y * siluf_(z0.y), a.z * siluf_(z0.z), a.w * siluf_(z0.w), b2.x * siluf_(z1.x), b2.y * siluf_(z1.y), b2.z * siluf_(z1.z), b2.w * siluf_(z1.w)};
        float ss = 0.f;
#pragma unroll
        for (int q = 0; q < 8; ++q) ss += y[q] * y[q];
        ss = red_sum<32>(ss);
        const float rstd = RSQRT(ss * (1.0f / 256.0f) + EPS);
#pragma unroll
        for (int q = 0; q < 8; ++q) y[q] = y[q] * rstd * nw[c0 + q];
        u32x4 wv; wv.x = pk2(y[0], y[1]); wv.y = pk2(y[2], y[3]); wv.z = pk2(y[4], y[5]); wv.w = pk2(y[6], y[7]);
        *(u32x4*)(Y + (size_t)m * 512 + c0) = wv;
    }
}

__device__ __forceinline__ f32x4 tile_mm(const LAS float* a, int lda, int ska, const LAS float* b, int ldb, int scb, int K, f32x4 acc, int l15, int q4) {
    const LAS float* ap = a + l15 * lda + q4 * ska; const LAS float* bp = b + q4 * ldb + l15 * scb;
#pragma unroll 8
    for (int ks = 0; ks < K / 4; ++ks) acc = MFMA_F32(ap[ks * 4 * ska], bp[ks * 4 * ldb], acc);
    return acc;
}
constexpr int GS = 132, GS2 = 68;
constexpr int GR_W = 0, GR_QH = 64 * 136 * 2, GR_KT = 2 * 64 * 136 * 2, GR_QK = GR_KT + 128 * 72 * 2, GR_GL = GR_QK + 64 * 72 * 2, GR_COMMON = GR_GL + 16, GR_UT = 128 * 64 * 2, GR_BYTES = GR_COMMON + GR_UT;
static_assert(GR_BYTES == 78864 && GR_COMMON % 16 == 0, "GDN record");
constexpr int GX = 264;
__device__ __forceinline__ void phase_gdn_g1(const Frame& F, const Args& A, int layer) {
    const bf16* P = WSP(bf16, A_P); unsigned char* CHR = WSP(unsigned char, G_CH);
    const float* convw = AIN(A, 19) + (size_t)layer * 4 * 1536; const float* a_log = AIN(A, 20) + layer * 4; const float* dtb = AIN(A, 21) + layer * 4;
    LAS bf16* qb = (LAS bf16*)F.lds; LAS bf16* kb = qb + 64 * SB; LAS bf16* qkimg = kb + 64 * SB;
    LAS float* X = (LAS float*)(qkimg + 64 * RS); LAS float* Lm = X + 64 * GX; LAS float* ssq = Lm + 64 * GS2;
    LAS float* beta = ssq + 2 * 64 * 16; LAS float* gc = beta + 64; LAS float* egc = gc + 64; LAS float* inorm = egc + 64;
    const int w = F.wave;
    const int nunits = BH * 4 * NCH;
    for (int unit = F.bid; unit < nunits; unit += F.G) {
        int tid = F.tid; OPAQUE_V(tid); ASSUME(tid >= 0 && tid < 512); const int lane = tid & 63, l15 = lane & 15, q4 = lane >> 4;
        const int c = unit % NCH, h = (unit / NCH) & 3, b = unit / (NCH * 4);
        const size_t tok0 = (size_t)b * SEQ + (size_t)c * 64;
        unsigned char* rec = CHR + (size_t)unit * GR_BYTES;
        __syncthreads();
        const int rb = tid / 48, pc = tid % 48, part = pc >> 4, cgl = pc & 15;
        float o[8][8];
        if (tid < 384) { const int col = part * 512 + h * 128 + 8 * cgl;
            conv8x8(P + (tok0 + 8 * rb) * PW + C_GDN + col, c * 64 + 8 * rb, convw + col, 1536, nullptr, o);
            if (part < 2) {
#pragma unroll
                for (int i = 0; i < 8; ++i) { float sacc = 0.f;
#pragma unroll
                    for (int ch = 0; ch < 8; ++ch) sacc += o[i][ch] * o[i][ch];
                    ssq[(part * 64 + 8 * rb + i) * 16 + cgl] = sacc; } } }
        if (w == 7) { const size_t tok = tok0 + lane; beta[lane] = sigmoidf_(bf2f(P[tok * PW + C_GDN + 1536 + h]));
            float g = -expf(a_log[h]) * softplusf_(bf2f(P[tok * PW + C_GDN + 1540 + h]) + dtb[h]);
#pragma unroll
            for (int o2 = 1; o2 < 64; o2 <<= 1) { const float t = __shfl_up(g, o2); if (lane >= o2) g += t; }
            gc[lane] = g; egc[lane] = expf(g); }
        __syncthreads();
        if (tid < 128) { float sacc = 0.f;
#pragma unroll
            for (int i = 0; i < 16; ++i) sacc += ssq[tid * 16 + i];
            inorm[tid] = (tid < 64 ? 0.08838834764831845f : 1.0f) * RSQRT(sacc + EPS); }
        __syncthreads();
        if (tid < 384) {
#pragma unroll
            for (int i = 0; i < 8; ++i) { const int l = 8 * rb + i;
                if (part < 2) { const float sc = inorm[part * 64 + l]; float v[8];
#pragma unroll
                    for (int ch = 0; ch < 8; ++ch) v[ch] = o[i][ch] * sc;
                    *(LAS u32x4*)((part ? kb : qb) + l * SB + 8 * cgl) = pack8(v); }
                else { const float bl = beta[l]; *(LAS f32x4*)(X + l * GX + 8 * cgl) = (f32x4){o[i][0] * bl, o[i][1] * bl, o[i][2] * bl, o[i][3] * bl}; *(LAS f32x4*)(X + l * GX + 8 * cgl + 4) = (f32x4){o[i][4] * bl, o[i][5] * bl, o[i][6] * bl, o[i][7] * bl}; } } }
        __syncthreads();
        { const int which = w >> 2, ti = w & 3; const LAS bf16* Aop = which ? qb : kb;
          bf16x8 aF[4]; f32x4 acc[4];
#pragma unroll
          for (int ks = 0; ks < 4; ++ks) aF[ks] = *(const LAS bf16x8*)(Aop + (16 * ti + l15) * SB + 8 * q4 + 32 * ks);
#pragma unroll
          for (int tj = 0; tj < 4; ++tj) { acc[tj] = (f32x4){0.f, 0.f, 0.f, 0.f};
#pragma unroll
              for (int ks = 0; ks < 4; ++ks) acc[tj] = MFMA_BF16(aF[ks], *(const LAS bf16x8*)(kb + (16 * tj + l15) * SB + 8 * q4 + 32 * ks), acc[tj]); }
          if (which) {
#pragma unroll
              for (int tj = 0; tj < 4; ++tj)
#pragma unroll
                  for (int r = 0; r < 4; ++r) { const int i = 16 * ti + 4 * q4 + r, j = 16 * tj + l15; const float v = (j <= i) ? acc[tj][r] * expf(gc[i] - gc[j]) : 0.f; qkimg[i * RS + j] = (bf16)f2bf(v); }
          } else {
#pragma unroll
              for (int tj = 0; tj < 4; ++tj)
#pragma unroll
                  for (int r = 0; r < 4; ++r) { const int i = 16 * ti + 4 * q4 + r, j = 16 * tj + l15; const float v = (j < i) ? acc[tj][r] * expf(gc[i] - gc[j]) * beta[i] : 0.f; Lm[i * GS2 + j] = v; }
          } }
        { const float glast = gc[63];
          for (int e = tid; e < 64 * 16; e += 512) { const int l = e >> 4, d0 = 8 * (e & 15); const u32x4 kv = *(const LAS u32x4*)(kb + l * SB + d0), qv = *(const LAS u32x4*)(qb + l * SB + d0);
              const float kf[8] = {bf2f(kv.x & 0xffffu), bf2f(kv.x >> 16), bf2f(kv.y & 0xffffu), bf2f(kv.y >> 16), bf2f(kv.z & 0xffffu), bf2f(kv.z >> 16), bf2f(kv.w & 0xffffu), bf2f(kv.w >> 16)};
              float qf[8] = {bf2f(qv.x & 0xffffu), bf2f(qv.x >> 16), bf2f(qv.y & 0xffffu), bf2f(qv.y >> 16), bf2f(qv.z & 0xffffu), bf2f(qv.z >> 16), bf2f(qv.w & 0xffffu), bf2f(qv.w >> 16)};
              const float sc = beta[l] * egc[l], eg = egc[l];
              *(LAS f32x4*)(X + l * GX + 128 + d0) = (f32x4){kf[0] * sc, kf[1] * sc, kf[2] * sc, kf[3] * sc}; *(LAS f32x4*)(X + l * GX + 132 + d0) = (f32x4){kf[4] * sc, kf[5] * sc, kf[6] * sc, kf[7] * sc};
#pragma unroll
              for (int q = 0; q < 8; ++q) qf[q] *= eg;
              *(u32x4*)(rec + GR_QH + (size_t)(l * SB + d0) * 2) = pack8(qf); }
          for (int e = tid; e < 128 * 8; e += 512) { const int d = e >> 3, l0 = 8 * (e & 7); float kt[8];
#pragma unroll
              for (int q = 0; q < 8; ++q) kt[q] = bf2f(kb[(l0 + q) * SB + d]) * expf(glast - gc[l0 + q]);
              *(u32x4*)(rec + GR_KT + (size_t)(d * RS + l0) * 2) = pack8(kt); }
          if (tid == 0) *(float*)(rec + GR_GL) = expf(glast); }
        __syncthreads();
        for (int e = tid; e < 64 * RS / 8; e += 512) ((u32x4*)(rec + GR_QK))[e] = ((const LAS u32x4*)qkimg)[e];
        tri_solve64(Lm, GS2, X, GX, 16, ssq, w, l15, q4);
        __syncthreads();
        for (int e = tid; e < 64 * 16; e += 512) { const int l = e >> 4, d0 = 8 * (e & 15); const f32x4 a = *(const LAS f32x4*)(X + l * GX + 128 + d0), b2 = *(const LAS f32x4*)(X + l * GX + 132 + d0);
            const float v[8] = {a.x, a.y, a.z, a.w, b2.x, b2.y, b2.z, b2.w}; *(u32x4*)(rec + GR_W + (size_t)(l * SB + d0) * 2) = pack8(v); }
        for (int e = tid; e < 128 * 8; e += 512) { const int vv = e >> 3, t0 = 8 * (e & 7); float v[8];
#pragma unroll
            for (int q = 0; q < 8; ++q) v[q] = X[(t0 + q) * GX + vv];
            *(u32x4*)((bf16*)(rec + GR_COMMON) + vv * 64 + t0) = pack8(v); }
    }
    __syncthreads();
}
constexpr int G2_STAGE = GR_COMMON;
__device__ __forceinline__ void phase_gdn_g2(const Frame& F, const Args& A) {
    const unsigned char* CHR = WSP(unsigned char, G_CH); bf16* GO = WSP(bf16, G_O);
    LAS unsigned char* buf0 = F.lds; LAS bf16* STt = (LAS bf16*)(F.lds + 2 * G2_STAGE); LAS bf16* vnT = STt + 2 * 32 * SB;
    const int w = F.wave, ti = w >> 1, tj = w & 1;
    const int nunits = BH * 4 * 4;
    constexpr int NCK = G2_STAGE / 16;
    for (int unit = F.bid; unit < nunits; unit += F.G) {
        int tid = F.tid; OPAQUE_V(tid); ASSUME(tid >= 0 && tid < 512); const int lane = tid & 63, l15 = lane & 15, q4 = lane >> 4;
        const int vs = unit & 3, h = (unit >> 2) & 3, b = unit >> 4;
        __syncthreads();
        for (int e = tid; e < 2 * 32 * SB / 2; e += 512) ((LAS unsigned*)STt)[e] = 0u;
        f32x4 Sreg[2] = {(f32x4){0.f, 0.f, 0.f, 0.f}, (f32x4){0.f, 0.f, 0.f, 0.f}};
        u32x4 preA[8], preB[8]; u32x2 uiniA, uiniB, ucur;
        const unsigned char* rec0 = CHR + (size_t)((b * 4 + h) * NCH) * GR_BYTES;
        const int uofs = GR_COMMON + ((32 * vs + 16 * tj + l15) * 64 + 16 * ti + 4 * q4) * 2;
#define G2_LOAD(S, recp) do { _Pragma("unroll") for (int q = 0; q < 8; ++q) { const int e = tid + 512 * q; if (e < NCK) pre##S[q] = *(const u32x4*)((recp) + (size_t)e * 16); } uini##S = *(const u32x2*)((recp) + uofs); } while (0)
#define G2_STORE(S, dst) do { _Pragma("unroll") for (int q = 0; q < 8; ++q) { const int e = tid + 512 * q; if (e < NCK) *(LAS u32x4*)((dst) + (size_t)e * 16) = pre##S[q]; } } while (0)
        G2_LOAD(A, rec0); G2_STORE(A, buf0); ucur = uiniA;
        if (NCH > 1) G2_LOAD(A, rec0 + (size_t)GR_BYTES);
        __syncthreads();
#define G2_STEP(c, LS, SS) do { \
            LAS unsigned char* buf = buf0 + ((c) & 1) * G2_STAGE; LAS unsigned char* nbuf = buf0 + (((c) + 1) & 1) * G2_STAGE; \
            if ((c) + 2 < NCH) G2_LOAD(LS, rec0 + (size_t)((c) + 2) * GR_BYTES); \
            const LAS bf16* Wi = (const LAS bf16*)(buf + GR_W); const LAS bf16* QH = (const LAS bf16*)(buf + GR_QH); const LAS bf16* KT = (const LAS bf16*)(buf + GR_KT); const LAS bf16* QK = (const LAS bf16*)(buf + GR_QK); \
            const float egl = *(const LAS float*)(buf + GR_GL); \
            const LAS bf16* S0 = STt + ((c) & 1) * 32 * SB; LAS bf16* S1 = STt + (((c) + 1) & 1) * 32 * SB; \
            { const f32x4 acc = tile_bf(Wi + 16 * ti * SB, SB, S0 + 16 * tj * SB, SB, 128, (f32x4){0.f, 0.f, 0.f, 0.f}, l15, q4); \
              const f32x4 vn = (f32x4){bf2f(ucur.x & 0xffffu), bf2f(ucur.x >> 16), bf2f(ucur.y & 0xffffu), bf2f(ucur.y >> 16)} - acc; \
              u32x2 pk; pk.x = pk2(vn[0], vn[1]); pk.y = pk2(vn[2], vn[3]); *(LAS u32x2*)(vnT + (16 * tj + l15) * RS + 16 * ti + 4 * q4) = pk; } \
            __syncthreads(); \
            { f32x4 acc = tile_bf(QH + 16 * ti * SB, SB, S0 + 16 * tj * SB, SB, 128, (f32x4){0.f, 0.f, 0.f, 0.f}, l15, q4); \
              acc = tile_bf(QK + 16 * ti * RS, RS, vnT + 16 * tj * RS, RS, 64, acc, l15, q4); \
              _Pragma("unroll") for (int r = 0; r < 4; ++r) GO[((size_t)b * SEQ + (size_t)(c) * 64 + 16 * ti + 4 * q4 + r) * 512 + h * 128 + 32 * vs + 16 * tj + l15] = (bf16)f2bf(acc[r]); } \
            _Pragma("unroll") for (int t2 = 0; t2 < 2; ++t2) { Sreg[t2] = Sreg[t2] * egl; \
                Sreg[t2] = tile_bf(KT + 16 * w * RS, RS, vnT + 16 * t2 * RS, RS, 64, Sreg[t2], l15, q4); \
                u32x2 pk; pk.x = pk2(Sreg[t2][0], Sreg[t2][1]); pk.y = pk2(Sreg[t2][2], Sreg[t2][3]); *(LAS u32x2*)(S1 + (16 * t2 + l15) * SB + 16 * w + 4 * q4) = pk; } \
            if ((c) + 1 < NCH) { G2_STORE(SS, nbuf); ucur = uini##SS; } \
            __syncthreads(); } while (0)
        for (int c = 0; c < NCH; c += 2) { G2_STEP(c, B, A); G2_STEP(c + 1, A, B); }
#undef G2_STEP
#undef G2_STORE
#undef G2_LOAD
    }
    __syncthreads();
}
__device__ __forceinline__ void phase_gdn_g3(const Frame& F, const Args& A, int layer) {
    const bf16* GO = WSP(bf16, G_O); const bf16* P = WSP(bf16, A_P); bf16* Y = WSP(bf16, A_Y) + (size_t)2 * TH * 512; const float* nw = AIN(A, 22) + layer * 128;
    const int lane = F.lane, c0 = 8 * lane;
    for (int m = F.gw; m < TH; m += F.NGW) {
        const f32x4 a = ld_bf16x4(GO + (size_t)m * 512 + c0), b2 = ld_bf16x4(GO + (size_t)m * 512 + c0 + 4);
        float o[8] = {a.x, a.y, a.z, a.w, b2.x, b2.y, b2.z, b2.w}; float ss = 0.f;
#pragma unroll
        for (int q = 0; q < 8; ++q) ss += o[q] * o[q];
        ss = red_sum<16>(ss);
        const float rstd = RSQRT(ss * (1.0f / 128.0f) + EPS);
        const f32x4 z0 = ld_bf16x4(P + (size_t)m * PW + C_GDN + 1544 + c0), z1 = ld_bf16x4(P + (size_t)m * PW + C_GDN + 1544 + c0 + 4);
        const float z[8] = {z0.x, z0.y, z0.z, z0.w, z1.x, z1.y, z1.z, z1.w}; float y[8];
#pragma unroll
        for (int q = 0; q < 8; ++q) y[q] = o[q] * rstd * nw[(c0 + q) & 127] * siluf_(z[q]);
        u32x4 wv; wv.x = pk2(y[0], y[1]); wv.y = pk2(y[2], y[3]); wv.z = pk2(y[4], y[5]); wv.w = pk2(y[6], y[7]);
        *(u32x4*)(Y + (size_t)m * 512 + c0) = wv;
    }
}

__device__ __forceinline__ void phase_merge_z(const Frame& F, const Args& A) {
    pg8::Gemm g{WSP(bf16, A_Y), WSP(bf16, W_BR), 512, 512}; BranchOrder S; S.nP = TH / 256; S.G = F.G; S.c = F.bid;
    EpiZ E{WSP(bf16, A_Z)}; pg8::gemm_phase(F.lds, g, S, E, F.tid);
}
__device__ __forceinline__ void phase_merge_gate(const Frame& F, const Args& A, int layer) {
    pg8::Gemm g{WSP(bf16, A_H), WSP(bf16, W_GATE), D, D}; pg8::StaticOrder S; S.init(TH, 4096, F.G, F.bid);
    EpiMerge E{WSP(bf16, A_Z), AIN(A, 29) + (size_t)layer * 4 * D, WSP(bf16, A_MG)}; pg8::gemm_phase(F.lds, g, S, E, F.tid);
}
__device__ __forceinline__ void phase_merge_out(const Frame& F, const Args& A, const float* xin, float* xout) {
    pg8::Gemm g{WSP(bf16, A_MG), WSP(bf16, W_OUT), D, D}; pg8::StaticOrder S; S.init(TH, D, F.G, F.bid);
    EpiResidual E{xin, xout}; pg8::gemm_phase(F.lds, g, S, E, F.tid);
}
__device__ __forceinline__ void phase_ffn_gu(const Frame& F, const Args& A) {
    pg8::Gemm g{WSP(bf16, A_H), WSP(bf16, W_FGU), D, D}; pg8::StaticOrder S; S.init(TH, 2 * FF_D, F.G, F.bid);
    EpiSwiGLU E{WSP(bf16, F_ACT), FF_D, 1 << 20}; pg8::gemm_phase(F.lds, g, S, E, F.tid);
}
__device__ __forceinline__ void phase_ffn_down(const Frame& F, const Args& A, float* x) {
    pg8::Gemm g{WSP(bf16, F_ACT), WSP(bf16, W_FDN), FF_D, FF_D}; pg8::StaticOrder S; S.init(TH, D, F.G, F.bid);
    EpiResidual E{x, x}; pg8::gemm_phase(F.lds, g, S, E, F.tid);
}
struct MoeLayout { int pstart[NEXP + 1]; };
__device__ __forceinline__ MoeLayout moe_layout(const unsigned* cnt) {
    MoeLayout L; int s = 0;
#pragma unroll
    for (int e = 0; e < NEXP; ++e) { L.pstart[e] = s; s += ((int)cnt[e] + 255) & ~255; }
    L.pstart[NEXP] = s; return L;
}
struct MoeOrder {
    int np, nN, G, c; MoeLayout L;
    __device__ bool next(int i, Unit& u) const {
        const long Lx = (long)i * G + c; if (Lx >= (long)np * nN) return false;
        const int pm = (int)(Lx / nN), pn = (int)(Lx % nN); int e = 0;
#pragma unroll
        for (int k = 1; k < NEXP; ++k) if (pm * 256 >= L.pstart[k]) e = k;
        u.pm = pm; u.pn = e * nN + pn; return true;
    }
    __device__ __forceinline__ void a_ready(const Unit&) const {}
    __device__ __forceinline__ void done(const Unit&) const {}
};
__device__ __forceinline__ void phase_moe_route(const Frame& F, const Args& A, int half) {
    const unsigned* wgc = (const unsigned*)(F.ctl + CW_WGC + half * 8192); unsigned* cnt = (unsigned*)(F.ctl + CW_CNT + half * 16);
    LAS unsigned* tab = (LAS unsigned*)F.lds; LAS unsigned* tot = tab + 8192; LAS unsigned* bef = tot + 8; LAS unsigned* cur = bef + 8;
    __syncthreads();
    for (int e = F.tid; e < F.G * 8; e += 512) tab[e] = wgc[e];
    __syncthreads();
    if (F.tid < 8) { unsigned t = 0, bsum = 0; for (int g = 0; g < F.G; ++g) { const unsigned v = tab[g * 8 + F.tid]; if (g < F.bid) bsum += v; t += v; } tot[F.tid] = t; bef[F.tid] = bsum; cur[F.tid] = 0u; if (F.bid == 0) cnt[F.tid] = t; }
    __syncthreads();
    unsigned totr[8];
#pragma unroll
    for (int e = 0; e < 8; ++e) totr[e] = tot[e];
    const MoeLayout L = moe_layout(totr);
    const bf16* H = WSP(bf16, A_H); bf16* GA = WSP(bf16, F_GA); const int* tope = WSP(int, F_TOPE); int* slot = WSP(int, F_SLOT);
    const int lane = F.lane;
    for (int m = F.gw; m < TH; m += F.NGW) {
        const u32x4 v0 = *(const u32x4*)(H + (size_t)m * D + 8 * lane), v1 = *(const u32x4*)(H + (size_t)m * D + 512 + 8 * lane);
#pragma unroll
        for (int k = 0; k < 2; ++k) { const int e = tope[2 * m + k]; int s = 0;
            int ps = 0;
#pragma unroll
            for (int q = 0; q < NEXP; ++q) ps = (e == q) ? L.pstart[q] : ps;
            if (lane == 0) s = ps + (int)bef[e] + (int)ATOMIC_ADD_LDS(cur + e, 1u);
            s = bcast0(s);
            if (lane == 0) slot[2 * m + k] = s;
            *(u32x4*)(GA + (size_t)s * D + 8 * lane) = v0; *(u32x4*)(GA + (size_t)s * D + 512 + 8 * lane) = v1; }
    }
#pragma unroll
    for (int e = 0; e < NEXP; ++e) { const int r0 = L.pstart[e] + (int)totr[e], r1 = L.pstart[e + 1];
        for (int r = r0 + F.gw; r < r1; r += F.NGW) { *(u32x4*)(GA + (size_t)r * D + 8 * lane) = (u32x4){0u, 0u, 0u, 0u}; *(u32x4*)(GA + (size_t)r * D + 512 + 8 * lane) = (u32x4){0u, 0u, 0u, 0u}; } }
    __syncthreads();
}
__device__ __forceinline__ void phase_moe_gu(const Frame& F, const Args& A, int half) {
    MoeOrder S; S.L = moe_layout((const unsigned*)(F.ctl + CW_CNT + half * 16)); S.np = S.L.pstart[NEXP] / 256; S.nN = 2 * FF_E / 256; S.G = F.G; S.c = F.bid;
    pg8::Gemm g{WSP(bf16, F_GA), WSP(bf16, W_FGU), D, D}; EpiSwiGLU E{WSP(bf16, F_ACT), FF_E, 2 * FF_E / 256}; pg8::gemm_phase(F.lds, g, S, E, F.tid);
}
struct EpiBf16Mod {
    static constexpr bool PERM = true, AFTER_DRAIN = false;
    bf16* C;
    __device__ __forceinline__ void operator()(const f32x4 (&acc)[2][2][4][2], const Unit& u, int wr, int wc, int fr, int fq) const {
        const int row0 = u.pm * 256 + wr * 64 + fr, col0 = (u.pn & 3) * 256 + wc * 32 + 8 * fq;
#pragma unroll
        for (int ai = 0; ai < 2; ++ai)
#pragma unroll
            for (int m = 0; m < 4; ++m) { bf16* rowp = C + (size_t)(row0 + ai * HALFT + m * 16) * D + col0;
#pragma unroll
                for (int bj = 0; bj < 2; ++bj) { const f32x4 v0 = acc[ai][bj][m][0], v1 = acc[ai][bj][m][1];
                    u32x4 w; w.x = pk2(v0[0], v0[1]); w.y = pk2(v0[2], v0[3]); w.z = pk2(v1[0], v1[1]); w.w = pk2(v1[2], v1[3]);
                    *(u32x4*)(rowp + bj * HALFT) = w; } }
    }
};
struct MoeTailOrder {
    int ntail, G, c; MoeLayout L;
    __device__ bool next(int i, Unit& u) const {
        const int j = i * G + c; if (j >= ntail * MOE_KSPLIT) return false;
        const int t = j / MOE_KSPLIT, ch = j % MOE_KSPLIT, pm = MOE_MAINP + (t >> 2); int e = 0;
#pragma unroll
        for (int k = 1; k < NEXP; ++k) if (pm * 256 >= L.pstart[k]) e = k;
        u.pm = pm; u.pn = e * 4 + (t & 3); u.kb = ch * (FF_E / MOE_KSPLIT) * 2; return true;
    }
    __device__ __forceinline__ void a_ready(const Unit&) const {}
    __device__ __forceinline__ void done(const Unit&) const {}
};
struct EpiPart {
    static constexpr bool PERM = false, AFTER_DRAIN = false;
    float* C;
    __device__ __forceinline__ void operator()(const f32x4 (&acc)[2][2][4][2], const Unit& u, int wr, int wc, int fr, int fq) const {
        const int ch = u.kb / ((FF_E / MOE_KSPLIT) * 2);
        const int row0 = ch * (MOE_ROWS - 2 * TH) + (u.pm - MOE_MAINP) * 256 + wr * 64 + fr, col0 = (u.pn & 3) * 256 + wc * 32 + 4 * fq;
#pragma unroll
        for (int ai = 0; ai < 2; ++ai)
#pragma unroll
            for (int m = 0; m < 4; ++m) { float* rowp = C + (size_t)(row0 + ai * HALFT + m * 16) * D + col0;
#pragma unroll
                for (int bj = 0; bj < 2; ++bj)
#pragma unroll
                    for (int n = 0; n < 2; ++n) *(f32x4*)(rowp + bj * HALFT + n * 16) = acc[ai][bj][m][n]; }
    }
};
static_assert(FF_E % (MOE_KSPLIT * 128) == 0, "split-K chunks are an even number of K tiles");
__device__ __forceinline__ void phase_moe_down(const Frame& F, const Args& A, int half) {
    const MoeLayout L = moe_layout((const unsigned*)(F.ctl + CW_CNT + half * 16)); const int np = L.pstart[NEXP] / 256;
    { MoeOrder S; S.L = L; S.np = np < MOE_MAINP ? np : MOE_MAINP; S.nN = D / 256; S.G = F.G; S.c = F.bid;
      pg8::Gemm g{WSP(bf16, F_ACT), WSP(bf16, W_FDN), FF_E, FF_E}; EpiBf16Mod E{WSP(bf16, F_YE)}; pg8::gemm_phase(F.lds, g, S, E, F.tid); }
    __syncthreads();
    { MoeTailOrder S; S.L = L; S.ntail = (np > MOE_MAINP ? np - MOE_MAINP : 0) * 4; S.G = F.G; S.c = F.bid;
      pg8::Gemm g{WSP(bf16, F_ACT), WSP(bf16, W_FDN), FF_E, FF_E / MOE_KSPLIT, FF_E}; EpiPart E{WSP(float, F_PART)}; pg8::gemm_phase(F.lds, g, S, E, F.tid); }
}
__device__ __forceinline__ void phase_moe_combine(const Frame& F, const Args& A, float* x, const float* fgain) {
    const bf16* YE = WSP(bf16, F_YE); const float* PT = WSP(float, F_PART); const int* slot = WSP(int, F_SLOT); const float* topw = WSP(float, F_TOPW); const int lane = F.lane;
    for (int m = F.gw; m < TH; m += F.NGW) { const int s0 = slot[2 * m], s1 = slot[2 * m + 1]; const float w0 = topw[2 * m], w1 = topw[2 * m + 1];
        f32x4 v[4]; float ss = 0.f;
#pragma unroll
        for (int j = 0; j < 4; ++j) { const int c = 4 * lane + 256 * j;
            f32x4 y0, y1;
            if (s0 < 2 * TH) y0 = ld_bf16x4(YE + (size_t)s0 * D + c); else { y0 = (f32x4){0.f, 0.f, 0.f, 0.f};
#pragma unroll
                for (int ch = 0; ch < MOE_KSPLIT; ++ch) y0 = y0 + *(const f32x4*)(PT + ((size_t)ch * (MOE_ROWS - 2 * TH) + (s0 - 2 * TH)) * D + c); }
            if (s1 < 2 * TH) y1 = ld_bf16x4(YE + (size_t)s1 * D + c); else { y1 = (f32x4){0.f, 0.f, 0.f, 0.f};
#pragma unroll
                for (int ch = 0; ch < MOE_KSPLIT; ++ch) y1 = y1 + *(const f32x4*)(PT + ((size_t)ch * (MOE_ROWS - 2 * TH) + (s1 - 2 * TH)) * D + c); }
            v[j] = *(const f32x4*)(x + (size_t)m * D + c) + y0 * w0 + y1 * w1;
            ss += (v[j].x * v[j].x + v[j].y * v[j].y) + (v[j].z * v[j].z + v[j].w * v[j].w); }
        if (fgain) { const float rstd = RSQRT(wave_sum(ss) * (1.0f / D) + EPS);
#pragma unroll
            for (int j = 0; j < 4; ++j) v[j] = v[j] * rstd * *(const f32x4*)(fgain + 4 * lane + 256 * j); }
#pragma unroll
        for (int j = 0; j < 4; ++j) *(f32x4*)(x + (size_t)m * D + 4 * lane + 256 * j) = v[j]; }
}

#ifndef EMU
#define XB_TMO      128
#define XB_XCNT(j)  (256  + 64 * (j))
#define XB_XSUB(j)  (1280 + 64 * (j))
#define XB_XGEN(j)  (2304 + 64 * (j))
#define XB_TOP      3328
#define XB_TOPGEN   3392
#define XCD_BAR_WORDS 3456
#define XB_SPIN_CAP (1u << 22)
__device__ __forceinline__ unsigned xb_ld(unsigned* p)              { return __hip_atomic_load(p, __ATOMIC_RELAXED, __HIP_MEMORY_SCOPE_AGENT); }
__device__ __forceinline__ unsigned xb_add(unsigned* p, unsigned v) { return __hip_atomic_fetch_add(p, v, __ATOMIC_RELAXED, __HIP_MEMORY_SCOPE_AGENT); }
__device__ __forceinline__ unsigned xb_xcc_id() { return (unsigned)__builtin_amdgcn_s_getreg((3 << 11) | 20) & 0xFu; }
#define XB_SPIN(cond, bar) do { unsigned _sp = 0; while (cond) { __builtin_amdgcn_s_sleep(1); \
    if ((++_sp & 255u) == 0u) { if (xb_ld(&(bar)[XB_TMO])) break; if (_sp > XB_SPIN_CAP) { atomicAdd(&(bar)[XB_TMO], 1u); break; } } } } while (0)
struct XcdBarrier { unsigned* bar; unsigned x; volatile LAS unsigned* st; };
__device__ __forceinline__ XcdBarrier xcd_barrier_post(unsigned* bar, volatile LAS unsigned* st) {
    XcdBarrier b; b.bar = bar; b.x = xb_xcc_id(); b.st = st;
    if (threadIdx.x == 0) (void)xb_add(&bar[XB_XCNT(b.x)], 1u);
    return b;
}
__device__ __forceinline__ void xcd_barrier_complete(unsigned* bar, unsigned x, unsigned& nloc, unsigned& nx) {
    const unsigned G = gridDim.x * gridDim.y * gridDim.z;
    unsigned sum, cnt, mine, sp = 0u;
    for (;;) {
        sum = 0u; cnt = 0u; mine = 0u;
#pragma unroll
        for (unsigned j = 0; j < 16; ++j) { const unsigned c = xb_ld(&bar[XB_XCNT(j)]); sum += c; cnt += (c > 0u) ? 1u : 0u; mine = (j == x) ? c : mine; }
        if (sum == G) break;
        __builtin_amdgcn_s_sleep(1);
        if ((++sp & 255u) == 0u) { if (xb_ld(&bar[XB_TMO])) break; if (sp > XB_SPIN_CAP) { atomicAdd(&bar[XB_TMO], 1u); break; } }
    }
    nloc = mine > 0u ? mine : 1u; nx = cnt > 0u ? cnt : 1u;
}
__device__ __forceinline__ void xcd_barrier(const XcdBarrier& b) {
    asm volatile("s_waitcnt vmcnt(0)" ::: "memory");
    __syncthreads();
    if (threadIdx.x == 0) {
        unsigned* bar = b.bar;
        __builtin_amdgcn_s_waitcnt(0);
        unsigned nloc = b.st[0], nx = b.st[1];
        if (nloc == 0u) { xcd_barrier_complete(bar, b.x, nloc, nx); b.st[0] = nloc; b.st[1] = nx; }
        const unsigned old = xb_add(&bar[XB_XSUB(b.x)], 1u);
        const unsigned gen = old / nloc;
        if (old + 1u == (gen + 1u) * nloc) {
            __builtin_amdgcn_fence(__ATOMIC_RELEASE, "agent");
            asm volatile("s_waitcnt vmcnt(0)" ::: "memory");
            const unsigned og = xb_add(&bar[XB_TOP], 1u);
            const unsigned tg = og / nx;
            if (og + 1u == (tg + 1u) * nx) xb_add(&bar[XB_TOPGEN], 1u);
            else XB_SPIN(xb_ld(&bar[XB_TOPGEN]) == tg, bar);
            __builtin_amdgcn_fence(__ATOMIC_ACQUIRE, "agent");
            xb_add(&bar[XB_XGEN(b.x)], 1u);
            asm volatile("s_waitcnt vmcnt(0)" ::: "memory");
        } else {
            XB_SPIN(xb_ld(&bar[XB_XGEN(b.x)]) == gen, bar);
            __builtin_amdgcn_fence(__ATOMIC_ACQUIRE, "agent");
            asm volatile("s_waitcnt vmcnt(0)" ::: "memory");
        }
    }
    __syncthreads();
}
#endif

constexpr int NPHASES = DEPTH + NHALF * (14 + 16);
constexpr int LDS_BYTES = 155648, MISC_OFF = 154624;

__global__ void __launch_bounds__(512, 2) fwd_kernel(Args args_k) {
#ifdef EMU
    unsigned char* lds = emu_lds_ptr;
#else
    extern __shared__ __attribute__((aligned(16))) unsigned char lds[];
#endif
    Frame F0;
    F0.lds = (LAS unsigned char*)lds; F0.tid = threadIdx.x; F0.lane = F0.tid & 63; F0.wave = RFL(F0.tid >> 6); F0.G = gridDim.x; F0.bid = blockIdx.x;
    F0.gw = F0.bid * 8 + F0.wave; F0.NGW = F0.G * 8;
    F0.out = (GAS float*)args_k.out; F0.ws = (GAS unsigned char*)args_k.ws; F0.ctl = (GAS unsigned*)(F0.ws + WS_CTL);
    const int lo = args_k.lo, hi = args_k.hi;
#ifndef EMU
    volatile LAS unsigned* misc = (volatile LAS unsigned*)(F0.lds + MISC_OFF);
    if (F0.tid < 4) misc[F0.tid] = 0u;
    __syncthreads();
    XcdBarrier bar; bar.bar = (unsigned*)(F0.ctl + CW_BAR); bar.x = 0; bar.st = misc;
    if (hi - lo > 1) bar = xcd_barrier_post((unsigned*)(F0.ctl + CW_BAR), misc);
#define GRID_BAR() do { XcdBarrier bq = bar; asm volatile("" : "+s"(bq.bar), "+s"(bq.x)); xcd_barrier(bq); } while (0)
#else
#define GRID_BAR() do { } while (0)
#endif
    int ph = 0;
#ifndef PH_MASK
#define PH_MASK 0xFFFFFFFFFFFFFFFFull
#endif
#define PHASE(...) PHASE_I(31, __VA_ARGS__)
#ifdef EMU
#define LAUNDER(Fq) do { } while (0)
#else
#define LAUNDER(Fq) do { unsigned mq_ = ~0u; asm volatile("" : "+s"(Fq.G), "+s"(Fq.bid), "+s"(Fq.wave), "+s"(Fq.ws), "+s"(Fq.out), "+s"(Fq.ctl), "+s"(mq_)); Fq.lane = (int)__builtin_amdgcn_mbcnt_hi(mq_, __builtin_amdgcn_mbcnt_lo(mq_, 0u)); Fq.tid = Fq.wave * 64 + Fq.lane; Fq.gw = Fq.bid * 8 + Fq.wave; Fq.NGW = Fq.G * 8; } while (0)
#endif
#ifdef EMU
#define ARGS_Q() const Args& args_q = args_k
#else
#define ARGS_Q() const __attribute__((address_space(4))) Args* aq_ = (const __attribute__((address_space(4))) Args*)__builtin_amdgcn_kernarg_segment_ptr(); asm volatile("" : "+s"(aq_)); const Args& args_q = *(const Args*)aq_
#endif
#define PHASE_I(kind, ...) do { if (ph >= lo && ph < hi) { constexpr int reps_ = (((REPEAT_MASK) >> (kind)) & 1u) ? 2 : 1; for (int rr_ = 0; rr_ < reps_; ++rr_) { { Frame Fq = F0; LAUNDER(Fq); const Frame& F = Fq; ARGS_Q(); const Args& args = args_q; __VA_ARGS__; } if (rr_ + 1 < reps_ || ph + 1 < hi) { GRID_BAR(); if (((REPEAT_MASK) >> 26) & 1u) GRID_BAR(); } } } ++ph; } while (0)
#define PHASEK(kind, ...) PHASE_I(kind, __VA_ARGS__)
#define NORM1(layer, half) do { const size_t rn_ = (size_t)(half) * TH; const float* xn_ = ((layer) == 0 ? AIN(args, 0) : (const float*)F.out) + rn_ * D; \
            phase_norm<false>(F, args, xn_, AIN(args, 2) + (layer) * D, WSP(bf16, A_H), nullptr, nullptr, nullptr, nullptr); phase_rope_table(F, args, (const int*)AIN(args, 1) + rn_, WSP(float, A_ROPE)); } while (0)
#define SEGMENT(layer, half) do { \
            const size_t r0 = (size_t)(half) * TH; \
            const float* xin = ((layer) == 0 ? AIN(args_k, 0) : (const float*)F0.out) + r0 * D; float* xo = (float*)F0.out + r0 * D; \
            PHASEK(1, { pg8::Gemm g{WSP(bf16, A_H), WSP(bf16, W_IN), D, D}; pg8::StaticOrder S; S.init(TH, PW, F.G, F.bid); EpiBf16 E{WSP(bf16, A_P), PW, nullptr, 0}; pg8::gemm_phase(F.lds, g, S, E, F.tid); }); \
            PHASEK(2, phase_mla_prep(F, args); phase_rwkv_prep(F, args, layer)); \
            PHASEK(3, phase_mla_q(F, args); __syncthreads(); phase_mla_kv(F, args); __syncthreads(); phase_rwkv_lora(F, args)); \
            PHASEK(8, phase_rwkv_r1(F, args, layer)); \
            PHASEK(5, { const int ns_ = F.G >= 128 ? 64 : (F.G >= 4 ? F.G / 4 : 0); Frame Fa = F;       \
                        unsigned* rfl_ = (unsigned*)(F.ctl + CW_RFLAG + 128 * ((layer) * NHALF + (half))); unsigned* rq_ = (unsigned*)(F.ctl + CW_RFLAG + 2048 + 32 * ((layer) * NHALF + (half))); \
                        if (F.bid < ns_) { Fa.G = ns_; Fa.NGW = ns_ * 8; phase_rwkv_r2(Fa, args, rfl_); } else { Fa.bid = F.bid - ns_; Fa.G = F.G - ns_; Fa.gw = Fa.bid * 8 + Fa.wave; Fa.NGW = Fa.G * 8; phase_attention(Fa, args); if (ns_ == 0) phase_rwkv_r2(F, args, rfl_); } \
                        phase_rwkv_post_queue(F, args, layer, rfl_, rq_); }); \
            PHASEK(9, phase_gdn_g1(F, args, layer); phase_ssd_s1(F, args, layer)); \
            PHASEK(11, { const int ns_ = F.G >= 4 ? F.G / 2 : 0; Frame Fa = F;                               \
                        if (F.bid < ns_) { Fa.G = ns_; Fa.NGW = ns_ * 8; phase_gdn_g2(Fa, args); } else { Fa.bid = F.bid - ns_; Fa.G = F.G - ns_; Fa.gw = Fa.bid * 8 + Fa.wave; Fa.NGW = Fa.G * 8; phase_ssd_s23(Fa, args); if (ns_ == 0) phase_gdn_g2(F, args); } }); \
            PHASEK(12, phase_gdn_g3(F, args, layer); phase_ssd_s4(F, args, layer)); \
            PHASEK(17, phase_merge_z(F, args)); \
            PHASEK(18, phase_merge_gate(F, args, layer)); \
            PHASEK(19, phase_merge_out(F, args, xin, xo)); \
            if ((layer) == 0) { \
                PHASEK(20, phase_norm<false>(F, args, xo, AIN(args, 32) + (layer) * D, WSP(bf16, A_H), nullptr, nullptr, nullptr, nullptr)); \
                PHASEK(21, phase_ffn_gu(F, args)); \
                PHASE(phase_ffn_down(F, args, xo); if ((half) == 0 && NHALF == 2) NORM1(layer, 1)); \
            } else { \
                PHASE(phase_norm<true>(F, args, xo, AIN(args, 32) + (layer) * D, WSP(bf16, A_H), AIN(args, 35), WSP(int, F_TOPE), WSP(float, F_TOPW), (unsigned*)(F.ctl + CW_WGC + (half) * 8192))); \
                PHASE(phase_moe_route(F, args, half)); \
                PHASEK(22, phase_moe_gu(F, args, half)); \
                PHASEK(23, phase_moe_down(F, args, half)); \
                PHASE(phase_moe_combine(F, args, xo, (layer) == DEPTH - 1 ? AIN(args, 38) : nullptr); if ((half) == 0 && NHALF == 2) NORM1(layer, 1)); \
            } } while (0)
    static_assert(DEPTH == 2 && NHALF <= 2, "segment program");
    PHASEK(27, phase_convert(F, args, 0); NORM1(0, 0));
    SEGMENT(0, 0);
    if (NHALF == 2) SEGMENT(0, 1);
    PHASEK(27, phase_convert(F, args, 1); NORM1(1, 0));
    SEGMENT(1, 0);
    if (NHALF == 2) SEGMENT(1, 1);
#undef SEGMENT
#undef PHASE
}

#ifndef ONE_LAUNCH
#define ONE_LAUNCH 1
#endif
extern "C" void kernel_launch(void* const* d_in, const int* in_sizes, int n_in, void* d_out, int out_size, void* d_ws, size_t ws_size, hipStream_t stream) {
    static int grid = 0;
    if (grid == 0) {
#ifdef EMU
        grid = EMU_GRID;
#else
        if (n_in != 39 || out_size != T * D || ws_size < WS_NEED) { fprintf(stderr, "kernel_launch: unexpected problem (n_in %d out %d ws %zu need %zu)\n", n_in, out_size, ws_size, (size_t)WS_NEED); grid = -1; return; }
        int dev = 0, cus = 0;
        if (hipGetDevice(&dev) != hipSuccess || hipDeviceGetAttribute(&cus, hipDeviceAttributeMultiprocessorCount, dev) != hipSuccess) { grid = -1; return; }
        if (hipFuncSetAttribute((const void*)fwd_kernel, hipFuncAttributeMaxDynamicSharedMemorySize, LDS_BYTES) != hipSuccess) { fprintf(stderr, "kernel_launch: hipFuncSetAttribute failed\n"); grid = -1; return; }
        int per_cu = 0;
        if (hipOccupancyMaxActiveBlocksPerMultiprocessor(&per_cu, (const void*)fwd_kernel, 512, LDS_BYTES) != hipSuccess || per_cu < 1) fprintf(stderr, "kernel_launch: occupancy query reports %d\n", per_cu);
        (void)hipGetLastError();
        grid = cus;
#endif
    }
    if (grid < 0) return;
    (void)hipMemsetAsync((char*)d_ws + WS_CTL, 0, CTL_BYTES, stream);
    Args a{};
    for (int i = 0; i < 39; ++i) a.in[i] = (const float*)d_in[i];
    a.out = (float*)d_out; a.ws = (unsigned char*)d_ws;
#ifdef EMU
    for (int p = EMU_PH_LO; p < EMU_PH_HI && p < NPHASES; ++p) { a.lo = p; a.hi = p + 1; emu_launch(fwd_kernel, grid, 512, a); emu_after_phase(p); }
#else
#if ONE_LAUNCH
    a.lo = 0; a.hi = NPHASES;
    hipLaunchKernelGGL(fwd_kernel, dim3(grid), dim3(512), LDS_BYTES, stream, a);
#else
    for (int p = 0; p < NPHASES; ++p) { a.lo = p; a.hi = p + 1; hipLaunchKernelGGL(fwd_kernel, dim3(grid), dim3(512), LDS_BYTES, stream, a); }
#endif
#endif
}
```

```cpp
#ifndef EMU
#include <hip/hip_runtime.h>
#include <cstdio>
#include <cstdint>
#endif

#ifdef EMU
#define FLAG_SET(p) __atomic_store_n((p), 1u, __ATOMIC_RELEASE)
#define FLAG_WAIT(p) do { while (__atomic_load_n((p), __ATOMIC_ACQUIRE) == 0u) { } } while (0)
#else
#define FLAG_SET(p) do { __atomic_thread_fence(__ATOMIC_RELEASE); __hip_atomic_store((p), 1u, __ATOMIC_RELEASE, __HIP_MEMORY_SCOPE_AGENT); } while (0)
#define FLAG_WAIT(p) do { while (__hip_atomic_load((p), __ATOMIC_ACQUIRE, __HIP_MEMORY_SCOPE_AGENT) == 0u) __builtin_amdgcn_s_sleep(8); __atomic_thread_fence(__ATOMIC_ACQUIRE); } while (0)
#endif
constexpr int PQ_SLOT_OFF = 154624 + 512;
#ifndef REPEAT_MASK
#define REPEAT_MASK 0u
#endif
#ifdef EMU
constexpr int BATCH = EMU_B, SEQ = EMU_S, NHALF = EMU_NHALF;
#else
constexpr int BATCH = 16, SEQ = 2048, NHALF = 2;
#endif
constexpr int D = 1024, DEPTH = 2, CH = 64;
constexpr int T = BATCH * SEQ, TH = T / NHALF, BH = BATCH / NHALF, NCH = SEQ / CH;
constexpr int C_MLA = 0, C_RWKV = 704, C_GDN = 2528, C_SSD = 4584, C_GATE = 6128, IN_COLS = 10224, PW = 6144;
constexpr int FF_D = 2816, FF_E = 3584, NEXP = 8;
constexpr int MOE_KSPLIT = 7, MOE_MAINP = TH * 2 / 256;
constexpr int MOE_ROWS = ((TH * 2 + NEXP * 255) / 256) * 256;
constexpr float EPS = 1e-6f;
static_assert(TH % 256 == 0 && SEQ % 128 == 0 && BATCH % NHALF == 0 && (SEQ / 64) % 2 == 0, "shape");

typedef unsigned short bf16;
typedef float f32x4 __attribute__((ext_vector_type(4)));
typedef float f32x2 __attribute__((ext_vector_type(2)));
typedef short bf16x8 __attribute__((ext_vector_type(8)));
typedef short bf16x4 __attribute__((ext_vector_type(4)));
typedef unsigned u32x4 __attribute__((ext_vector_type(4)));
typedef unsigned u32x2 __attribute__((ext_vector_type(2)));
#ifdef EMU
#define LAS
#define GAS
#define MFMA_F32(a, b, c) emu_mfma_16x16x4f32(a, b, c)
#define MFMA_BF16(a, b, c) emu_mfma_16x16x32bf16(a, b, c)
#define ATOMIC_ADD_U32(p, v) emu_atomic_add_u32(p, v)
#define ATOMIC_ADD_LDS(p, v) emu_atomic_add_u32((unsigned*)(p), v)
#define RFL(x) (x)
#define OPAQUE_V(x) do { } while (0)
#define ASSUME(c) do { } while (0)
#define LDS_WAIT()
#define VM_WAIT()
__device__ __forceinline__ float fast_exp(float x) { return expf(x); }
__device__ __forceinline__ float fast_rcp(float x) { return 1.0f / x; }
__device__ __forceinline__ float fast_rsqrt(float x) { return 1.0f / sqrtf(x); }
#else
#define LAS __attribute__((address_space(3)))
#define GAS __attribute__((address_space(1)))
#define MFMA_F32(a, b, c) __builtin_amdgcn_mfma_f32_16x16x4f32(a, b, c, 0, 0, 0)
#define MFMA_BF16(a, b, c) __builtin_amdgcn_mfma_f32_16x16x32_bf16(a, b, c, 0, 0, 0)
#define ATOMIC_ADD_U32(p, v) __hip_atomic_fetch_add(p, v, __ATOMIC_RELAXED, __HIP_MEMORY_SCOPE_AGENT)
#define ATOMIC_ADD_LDS(p, v) __hip_atomic_fetch_add((LAS unsigned*)(p), v, __ATOMIC_RELAXED, __HIP_MEMORY_SCOPE_WORKGROUP)
#define RFL(x) __builtin_amdgcn_readfirstlane(x)
#define ASSUME(c) __builtin_assume(c)
#define OPAQUE_V(x) asm volatile("" : "+v"(x))
#define LDS_WAIT() asm volatile("s_waitcnt lgkmcnt(0)" ::: "memory")
#define VM_WAIT() asm volatile("s_waitcnt vmcnt(0)" ::: "memory")
__device__ __forceinline__ float fast_exp(float x) { return __expf(x); }
__device__ __forceinline__ float fast_rcp(float x) { return __builtin_amdgcn_rcpf(x); }
__device__ __forceinline__ float fast_rsqrt(float x) { return __builtin_amdgcn_rsqf(x); }
#endif
__device__ __forceinline__ unsigned f2u(float f) { return __builtin_bit_cast(unsigned, f); }
__device__ __forceinline__ float u2f(unsigned u) { return __builtin_bit_cast(float, u); }
#ifdef EMU
__device__ __forceinline__ unsigned f2bf(float f) { unsigned u = f2u(f); return (u + 0x7fffu + ((u >> 16) & 1u)) >> 16; }
__device__ __forceinline__ unsigned pk2(float lo, float hi) { return f2bf(lo) | (f2bf(hi) << 16); }
#else
typedef __bf16 bf16v2_ __attribute__((ext_vector_type(2)));
__device__ __forceinline__ unsigned pk2(float lo, float hi) { const f32x2 v = {lo, hi}; return __builtin_bit_cast(unsigned, __builtin_convertvector(v, bf16v2_)); }
__device__ __forceinline__ unsigned f2bf(float f) { return pk2(f, f) & 0xffffu; }
#endif
__device__ __forceinline__ float bf2f(unsigned h) { return u2f(h << 16); }
#ifndef EMU
#define expf(x) __expf(x)
#define exp2f(x) __builtin_amdgcn_exp2f(x)
#define FDIV(a, b) ((a) * __builtin_amdgcn_rcpf(b))
#define RSQRT(x) __builtin_amdgcn_rsqf(x)
__device__ __forceinline__ float softplusf_(float x) { return x > 20.f ? x : __logf(1.0f + __expf(x)); }
#else
#define FDIV(a, b) ((a) / (b))
#define RSQRT(x) (1.0f / sqrtf(x))
__device__ __forceinline__ float softplusf_(float x) { return x > 20.f ? x : log1pf(expf(x)); }
#endif
__device__ __forceinline__ float sigmoidf_(float x) { return FDIV(1.0f, 1.0f + expf(-x)); }
__device__ __forceinline__ float siluf_(float x) { return FDIV(x, 1.0f + expf(-x)); }
__device__ __forceinline__ float tanhf_(float x) { const float e = expf(2.0f * fminf(x, 15.0f)); return FDIV(e - 1.0f, e + 1.0f); }
#ifdef EMU
template <int N> __device__ __forceinline__ float red_sum(float v) {
#pragma unroll
    for (int o = 1; o < N; o <<= 1) v += __shfl_xor(v, o);
    return v; }
template <int N> __device__ __forceinline__ float red_max(float v) {
#pragma unroll
    for (int o = 1; o < N; o <<= 1) v = fmaxf(v, __shfl_xor(v, o));
    return v; }
__device__ __forceinline__ int bcast0(int v) { return __shfl(v, 0); }
#else
template <int CTRL> __device__ __forceinline__ float dpp_mov(float v) { return u2f((unsigned)__builtin_amdgcn_mov_dpp((int)f2u(v), CTRL, 0xF, 0xF, true)); }
template <int N> __device__ __forceinline__ float red_sum(float v) {
    v += dpp_mov<0xB1>(v);
    v += dpp_mov<0x4E>(v);
    v += dpp_mov<0x141>(v);
    if (N >= 16) v += dpp_mov<0x140>(v);
    if (N >= 32) { const auto r = __builtin_amdgcn_permlane16_swap(f2u(v), f2u(v), false, false); v = u2f(r[0]) + u2f(r[1]); }
    if (N >= 64) { const auto r = __builtin_amdgcn_permlane32_swap(f2u(v), f2u(v), false, false); v = u2f(r[0]) + u2f(r[1]); }
    return v; }
template <int N> __device__ __forceinline__ float red_max(float v) {
    v = fmaxf(v, dpp_mov<0xB1>(v)); v = fmaxf(v, dpp_mov<0x4E>(v)); v = fmaxf(v, dpp_mov<0x141>(v));
    if (N >= 16) v = fmaxf(v, dpp_mov<0x140>(v));
    if (N >= 32) { const auto r = __builtin_amdgcn_permlane16_swap(f2u(v), f2u(v), false, false); v = fmaxf(u2f(r[0]), u2f(r[1])); }
    if (N >= 64) { const auto r = __builtin_amdgcn_permlane32_swap(f2u(v), f2u(v), false, false); v = fmaxf(u2f(r[0]), u2f(r[1])); }
    return v; }
__device__ __forceinline__ int bcast0(int v) { return __builtin_amdgcn_readfirstlane(v); }
#endif
__device__ __forceinline__ float wave_sum(float v) { return red_sum<64>(v); }
__device__ __forceinline__ float wave_max(float v) { return red_max<64>(v); }
__device__ __forceinline__ f32x4 ld_bf16x4(const bf16* p) { const u32x2 w = *(const u32x2*)p; return (f32x4){bf2f(w.x & 0xffffu), bf2f(w.x >> 16), bf2f(w.y & 0xffffu), bf2f(w.y >> 16)}; }
__device__ __forceinline__ void st_bf16x4(bf16* p, f32x4 v) { u32x2 w; w.x = pk2(v.x, v.y); w.y = pk2(v.z, v.w); *(u32x2*)p = w; }
__device__ __forceinline__ u32x4 pack8(const float* v) { u32x4 o; o.x = pk2(v[0], v[1]); o.y = pk2(v[2], v[3]); o.z = pk2(v[4], v[5]); o.w = pk2(v[6], v[7]); return o; }

#ifdef EMU
__device__ __forceinline__ float rows_max(float v) { v = fmaxf(v, __shfl_xor(v, 16)); return fmaxf(v, __shfl_xor(v, 32)); }
__device__ __forceinline__ float rows_sum(float v) { v += __shfl_xor(v, 16); return v + __shfl_xor(v, 32); }
#else
typedef unsigned u32x2v __attribute__((ext_vector_type(2)));
__device__ __forceinline__ float rows_max(float v) {
    { const auto r = __builtin_amdgcn_permlane16_swap(f2u(v), f2u(v), false, false); v = fmaxf(u2f(r[0]), u2f(r[1])); }
    { const auto r = __builtin_amdgcn_permlane32_swap(f2u(v), f2u(v), false, false); v = fmaxf(u2f(r[0]), u2f(r[1])); }
    return v; }
__device__ __forceinline__ float rows_sum(float v) {
    { const auto r = __builtin_amdgcn_permlane16_swap(f2u(v), f2u(v), false, false); v = u2f(r[0]) + u2f(r[1]); }
    { const auto r = __builtin_amdgcn_permlane32_swap(f2u(v), f2u(v), false, false); v = u2f(r[0]) + u2f(r[1]); }
    return v; }
#endif

namespace pg8 {
#define PG8_LAS LAS
typedef unsigned short bf16_t;
constexpr int BM = 256, BK = 64, HALF = 128, HTB = HALF * BK * 2, STAGE_BYTES = 8 * HTB, NXCD = 8, WGM = 8;
__host__ __device__ __forceinline__ int lds_byte(int r, int c) { const int st = (r >> 4) * 2 + (c >> 5), rr = r & 15, cc = c & 31, ob = rr * 64 + cc * 2; return st * 1024 + (ob ^ (((ob >> 9) & 1) << 5)); }
__host__ __device__ __forceinline__ void stage_rc(int b, int& R, int& C) { const int st = b / 1024, sb = b % 1024, swz = sb ^ (((sb >> 9) & 1) << 5); R = (st >> 1) * 16 + swz / 64; C = (st & 1) * 32 + (swz % 64) / 2; }
__host__ __device__ __forceinline__ int perm32(int rho) { const int n = rho >> 4, i = rho & 15; return 8 * (i >> 2) + 4 * n + (i & 3); }
struct Unit { int pm, pn, kb = 0; };
struct Gemm { const bf16_t* A; const bf16_t* Bt; int lda, K, ldb = 0; };
struct StaticOrder {
    int nM, nN, nwg, G, c;
    __host__ __device__ void init(int M, int N, int G_, int c_) { nM = M / BM; nN = N / BM; nwg = nM * nN; G = G_; c = c_; }
    __host__ __device__ bool next(int i, Unit& u) const {
        const long L = (long)i * G + c; if (L >= nwg) return false;
        int wgid = (int)L; { const int q = nwg / NXCD, r = nwg % NXCD, xcd = wgid % NXCD, off = wgid / NXCD; wgid = (xcd < r ? xcd * (q + 1) : r * (q + 1) + (xcd - r) * q) + off; }
        const int nig = WGM * nN, gid = wgid / nig, fm = gid * WGM, gsz = (nM - fm) < WGM ? (nM - fm) : WGM;
        u.pm = fm + ((wgid % nig) % gsz); u.pn = (wgid % nig) / gsz; return true;
    }
    __device__ __forceinline__ void a_ready(const Unit&) const {}
    __device__ __forceinline__ void done(const Unit&) const {}
};
#ifndef EMU
template <class Epi, class Sched>
__device__ __forceinline__ void gemm_phase(PG8_LAS unsigned char* lds, const Gemm g, const Sched& S, const Epi& E, const int tid) {
    const int wid = __builtin_amdgcn_readfirstlane(tid >> 6), lane = tid & 63, wr = wid >> 2, wc = wid & 3, fr = lane & 15, fq = lane >> 4;
    int Kq = g.K; asm volatile("" : "+s"(Kq));
    const int K = Kq, nt = K / BK, lda = g.lda, ldb = g.ldb > 0 ? g.ldb : K;
    unsigned voffA[2], voffB[2];
#pragma unroll
    for (int i = 0; i < 2; ++i) { int R, C; stage_rc(tid * 16 + i * 8192, R, C); const int Rb = Epi::PERM ? ((R & ~31) + perm32(R & 31)) : R;
        voffA[i] = (unsigned)(R * lda + C) * 2u; voffB[i] = (unsigned)(Rb * ldb + C) * 2u; }
    const size_t kstep = (size_t)(BK * 2);
    const size_t hstep = (size_t)HALF * ldb * 2, hstepA = (size_t)HALF * lda * 2;
    const size_t tstep = 2 * hstep, tstepA = 2 * hstepA;
    const unsigned ldsw = (unsigned)wid * 1024u;
    const int aoff = lds_byte(wr * 64 + fr, fq * 8), boff = lds_byte(wc * 32 + fr, fq * 8);
#define PG8_SA(b, h) (((b) * 2 + (h)) * HTB)
#define PG8_SB(b, h) ((4 + (b) * 2 + (h)) * HTB)
#define PG8_STAGE(bufoff, gbase, voff) do { _Pragma("unroll") for (int _i = 0; _i < 2; ++_i) \
        __builtin_amdgcn_global_load_lds((const unsigned*)((const char*)(gbase) + (voff)[_i]), (PG8_LAS unsigned*)(lds + (bufoff) + ldsw + _i * 8192), 16, 0, 0); } while (0)
#define PG8_LDA(dst, b, h) do { _Pragma("unroll") for (int m = 0; m < 4; ++m) _Pragma("unroll") for (int k = 0; k < 2; ++k) dst[m][k] = *(const PG8_LAS bf16x8*)(lds + PG8_SA(b, h) + aoff + m * 2048 + k * 1024); } while (0)
#define PG8_LDB(dst, b, h) do { _Pragma("unroll") for (int n = 0; n < 2; ++n) _Pragma("unroll") for (int k = 0; k < 2; ++k) dst[n][k] = *(const PG8_LAS bf16x8*)(lds + PG8_SB(b, h) + boff + n * 2048 + k * 1024); } while (0)
#define PG8_MMA(ai, bj, At, Bt) do { __builtin_amdgcn_s_setprio(1); _Pragma("unroll") for (int m = 0; m < 4; ++m) _Pragma("unroll") for (int n = 0; n < 2; ++n) _Pragma("unroll") for (int k = 0; k < 2; ++k) \
        acc[ai][bj][m][n] = __builtin_amdgcn_mfma_f32_16x16x32_bf16(Bt[n][k], At[m][k], acc[ai][bj][m][n], 0, 0, 0); __builtin_amdgcn_s_setprio(0); } while (0)
#define PG8_WAIT_V(n) asm volatile("s_waitcnt vmcnt(" #n ")" ::: "memory")
#define PG8_WAIT_L(n) asm volatile("s_waitcnt lgkmcnt(" #n ")" ::: "memory")
#define PG8_BAR __builtin_amdgcn_s_barrier()
#define PG8_SCHED __builtin_amdgcn_sched_barrier(0)
    Unit cur, nxt; int ui = 0;
    if (!S.next(0, cur)) return;
    f32x4 acc[2][2][4][2];
#pragma unroll
    for (int a = 0; a < 2; ++a)
#pragma unroll
        for (int b = 0; b < 2; ++b)
#pragma unroll
            for (int m = 0; m < 4; ++m)
#pragma unroll
                for (int n = 0; n < 2; ++n) acc[a][b][m][n] = (f32x4){0.f, 0.f, 0.f, 0.f};
    bf16x8 At[4][2], B0[2][2], B1[2][2];
    const char* cA = (const char*)g.A + (size_t)cur.pm * tstepA + cur.kb; const char* cB = (const char*)g.Bt + (size_t)cur.pn * tstep + cur.kb;
    S.a_ready(cur);
    PG8_STAGE(PG8_SB(0, 0), cB, voffB); PG8_STAGE(PG8_SA(0, 0), cA, voffA); PG8_STAGE(PG8_SB(0, 1), cB + hstep, voffB); PG8_STAGE(PG8_SA(0, 1), cA + hstepA, voffA);
    if (wr == 1) PG8_BAR;
    PG8_WAIT_V(4); PG8_BAR;
    PG8_STAGE(PG8_SB(1, 0), cB + kstep, voffB); PG8_STAGE(PG8_SA(1, 0), cA + kstep, voffA); PG8_STAGE(PG8_SB(1, 1), cB + hstep + kstep, voffB);
    PG8_WAIT_V(6); PG8_BAR;
    for (;;) {
        const bool has_next = S.next(ui + 1, nxt);
        const char* nA = has_next ? (const char*)g.A + (size_t)nxt.pm * tstepA + nxt.kb : cA; const char* nB = has_next ? (const char*)g.Bt + (size_t)nxt.pn * tstep + nxt.kb : cB;
        for (int t = 0; t < nt; t += 2) {
            const bool last = (t == nt - 2);
            const char* a1 = cA + (size_t)(t + 1) * kstep;
            const char* a2 = last ? nA : cA + (size_t)(t + 2) * kstep; const char* b2 = last ? nB : cB + (size_t)(t + 2) * kstep;
            const char* a3 = a2 + kstep; const char* b3 = b2 + kstep;
            if (last && has_next) S.a_ready(nxt);
            PG8_LDB(B0, 0, 0); PG8_SCHED; PG8_LDA(At, 0, 0); PG8_STAGE(PG8_SA(1, 1), a1 + hstepA, voffA);
            PG8_WAIT_L(8); PG8_BAR; PG8_WAIT_L(0); PG8_MMA(0, 0, At, B0); PG8_BAR; PG8_SCHED;
            PG8_LDB(B1, 0, 1); PG8_STAGE(PG8_SB(0, 0), b2, voffB);
            PG8_BAR; PG8_WAIT_L(0); PG8_MMA(0, 1, At, B1); PG8_BAR;
            PG8_LDA(At, 0, 1); PG8_STAGE(PG8_SA(0, 0), a2, voffA);
            PG8_BAR; PG8_WAIT_L(0); PG8_MMA(1, 0, At, B0); PG8_BAR; PG8_SCHED;
            PG8_STAGE(PG8_SB(0, 1), b2 + hstep, voffB);
            PG8_WAIT_V(6); PG8_BAR; PG8_MMA(1, 1, At, B1); PG8_BAR;
            PG8_LDB(B0, 1, 0); PG8_SCHED; PG8_LDA(At, 1, 0); PG8_STAGE(PG8_SA(0, 1), a2 + hstepA, voffA);
            PG8_WAIT_L(8); PG8_BAR; PG8_WAIT_L(0); PG8_MMA(0, 0, At, B0); PG8_BAR; PG8_SCHED;
            PG8_LDB(B1, 1, 1); PG8_STAGE(PG8_SB(1, 0), b3, voffB);
            PG8_BAR; PG8_WAIT_L(0); PG8_MMA(0, 1, At, B1); PG8_BAR;
            PG8_LDA(At, 1, 1); PG8_STAGE(PG8_SA(1, 0), a3, voffA);
            PG8_BAR; PG8_WAIT_L(0); PG8_MMA(1, 0, At, B0); PG8_BAR; PG8_SCHED;
            PG8_STAGE(PG8_SB(1, 1), b3 + hstep, voffB);
            PG8_WAIT_V(6); PG8_BAR; PG8_MMA(1, 1, At, B1); PG8_BAR;
        }
        if constexpr (!Epi::AFTER_DRAIN) { E(acc, cur, wr, wc, fr, fq); S.done(cur); }
        if (!has_next) break;
#pragma unroll
        for (int a = 0; a < 2; ++a)
#pragma unroll
            for (int b = 0; b < 2; ++b)
#pragma unroll
                for (int m = 0; m < 4; ++m)
#pragma unroll
                    for (int n = 0; n < 2; ++n) acc[a][b][m][n] = (f32x4){0.f, 0.f, 0.f, 0.f};
        cur = nxt; cA = nA; cB = nB; ++ui;
    }
    PG8_WAIT_V(0);
    if (wr == 0) PG8_BAR;
    PG8_BAR;
    if constexpr (Epi::AFTER_DRAIN) { E.fused(acc, cur, wr, wc, fr, fq, lds, wid, lane); S.done(cur); }
#undef PG8_SA
#undef PG8_SB
#undef PG8_STAGE
#undef PG8_LDA
#undef PG8_LDB
#undef PG8_MMA
#undef PG8_WAIT_V
#undef PG8_WAIT_L
#undef PG8_BAR
#undef PG8_SCHED
}
#else
template <class Epi, class Sched>
__device__ __forceinline__ void gemm_phase(PG8_LAS unsigned char* lds, const Gemm g, const Sched& S, const Epi& E, const int tid) {
    const int wid = tid >> 6, lane = tid & 63, wr = wid >> 2, wc = wid & 3, fr = lane & 15, fq = lane >> 4;
    Unit cur;
    for (int ui = 0; S.next(ui, cur); ++ui) {
        f32x4 acc[2][2][4][2];
        for (int ai = 0; ai < 2; ++ai) for (int m = 0; m < 4; ++m) {
            const size_t row = (size_t)cur.pm * 256 + ai * 128 + wr * 64 + m * 16 + fr;
            const bf16_t* ap = g.A + row * g.lda + cur.kb / 2;
            for (int bj = 0; bj < 2; ++bj) for (int n = 0; n < 2; ++n) for (int j = 0; j < 4; ++j) {
                const size_t col = (size_t)cur.pn * 256 + bj * 128 + wc * 32 + (Epi::PERM ? 8 * fq + 4 * n : 16 * n + 4 * fq) + j;
                const bf16_t* bp = g.Bt + col * (g.ldb > 0 ? g.ldb : g.K) + cur.kb / 2; float s = 0.f;
                for (int k = 0; k < g.K; ++k) s += bf2f(ap[k]) * bf2f(bp[k]);
                acc[ai][bj][m][n][j] = s; } }
        E(acc, cur, wr, wc, fr, fq);
    }
    __syncthreads();
}
#endif
}

using pg8::Unit;
constexpr int HALFT = 128;
struct EpiF32 {
    static constexpr bool PERM = false, AFTER_DRAIN = false;
    float* C; int ldc;
    __device__ __forceinline__ void operator()(const f32x4 (&acc)[2][2][4][2], const Unit& u, int wr, int wc, int fr, int fq) const {
        const int row0 = u.pm * 256 + wr * 64 + fr, col0 = u.pn * 256 + wc * 32 + 4 * fq;
#pragma unroll
        for (int ai = 0; ai < 2; ++ai)
#pragma unroll
            for (int m = 0; m < 4; ++m) { float* rowp = C + (size_t)(row0 + ai * HALFT + m * 16) * ldc + col0;
#pragma unroll
                for (int bj = 0; bj < 2; ++bj)
#pragma unroll
                    for (int n = 0; n < 2; ++n) *(f32x4*)(rowp + bj * HALFT + n * 16) = acc[ai][bj][m][n]; }
    }
};
struct EpiLora {
    static constexpr bool PERM = true, AFTER_DRAIN = false;
    float* W; bf16* AG;
    __device__ __forceinline__ void operator()(const f32x4 (&acc)[2][2][4][2], const Unit& u, int wr, int wc, int fr, int fq) const {
        const int row0 = u.pm * 256 + wr * 64 + fr, colt = wc * 32 + 8 * fq;
        if (u.pn < 2) {
#pragma unroll
            for (int ai = 0; ai < 2; ++ai)
#pragma unroll
                for (int m = 0; m < 4; ++m) { bf16* rowp = (bf16*)W + (size_t)(row0 + ai * HALFT + m * 16) * 512 + u.pn * 256 + colt;
#pragma unroll
                    for (int bj = 0; bj < 2; ++bj) { const f32x4 v0 = acc[ai][bj][m][0], v1 = acc[ai][bj][m][1];
                        u32x4 w; w.x = pk2(v0[0], v0[1]); w.y = pk2(v0[2], v0[3]); w.z = pk2(v1[0], v1[1]); w.w = pk2(v1[2], v1[3]);
                        *(u32x4*)(rowp + bj * HALFT) = w; } }
        } else {
#pragma unroll
            for (int ai = 0; ai < 2; ++ai)
#pragma unroll
                for (int m = 0; m < 4; ++m) { bf16* rowp = AG + (size_t)(row0 + ai * HALFT + m * 16) * 1024 + (u.pn - 2) * 256 + colt;
#pragma unroll
                    for (int bj = 0; bj < 2; ++bj) { const f32x4 v0 = acc[ai][bj][m][0], v1 = acc[ai][bj][m][1];
                        u32x4 w; w.x = pk2(v0[0], v0[1]); w.y = pk2(v0[2], v0[3]); w.z = pk2(v1[0], v1[1]); w.w = pk2(v1[2], v1[3]);
                        *(u32x4*)(rowp + bj * HALFT) = w; } }
        }
    }
};
struct EpiResidual {
    static constexpr bool PERM = false, AFTER_DRAIN = false;
    const float* res; float* out;
    __device__ __forceinline__ void operator()(const f32x4 (&acc)[2][2][4][2], const Unit& u, int wr, int wc, int fr, int fq) const {
        const int row0 = u.pm * 256 + wr * 64 + fr, col0 = u.pn * 256 + wc * 32 + 4 * fq;
#pragma unroll
        for (int ai = 0; ai < 2; ++ai) {
            f32x4 rv[4][2][2];
#pragma unroll
            for (int m = 0; m < 4; ++m) { const size_t o = (size_t)(row0 + ai * HALFT + m * 16) * D + col0;
#pragma unroll
                for (int bj = 0; bj < 2; ++bj)
#pragma unroll
                    for (int n = 0; n < 2; ++n) rv[m][bj][n] = *(const GAS f32x4*)(res + o + bj * HALFT + n * 16); }
#pragma unroll
            for (int m = 0; m < 4; ++m) { const size_t o = (size_t)(row0 + ai * HALFT + m * 16) * D + col0;
#pragma unroll
                for (int bj = 0; bj < 2; ++bj)
#pragma unroll
                    for (int n = 0; n < 2; ++n) *(GAS f32x4*)(out + o + bj * HALFT + n * 16) = rv[m][bj][n] + acc[ai][bj][m][n]; }
        }
    }
};
struct EpiBf16 {
    static constexpr bool PERM = true, AFTER_DRAIN = false;
    bf16* O; int ldc; const float* rowscale; int rs_stride;
    __device__ __forceinline__ void operator()(const f32x4 (&acc)[2][2][4][2], const Unit& u, int wr, int wc, int fr, int fq) const {
        const int row0 = u.pm * 256 + wr * 64 + fr, col0 = u.pn * 256 + wc * 32 + 8 * fq;
#pragma unroll
        for (int ai = 0; ai < 2; ++ai)
#pragma unroll
            for (int m = 0; m < 4; ++m) { const int row = row0 + ai * HALFT + m * 16; bf16* rowp = O + (size_t)row * ldc + col0;
                const float sc = rowscale ? rowscale[(size_t)row * rs_stride] : 1.0f;
#pragma unroll
                for (int bj = 0; bj < 2; ++bj) { const f32x4 v0 = acc[ai][bj][m][0] * sc, v1 = acc[ai][bj][m][1] * sc;
                    u32x4 w; w.x = pk2(v0[0], v0[1]); w.y = pk2(v0[2], v0[3]); w.z = pk2(v1[0], v1[1]); w.w = pk2(v1[2], v1[3]);
                    *(u32x4*)(rowp + bj * HALFT) = w; } }
    }
};
struct EpiSwiGLU {
    static constexpr bool PERM = true, AFTER_DRAIN = false;
    bf16* O; int ldc; int ntile;
    __device__ __forceinline__ void operator()(const f32x4 (&acc)[2][2][4][2], const Unit& u, int wr, int wc, int fr, int fq) const {
        const int row0 = u.pm * 256 + wr * 64 + fr, col0 = (u.pn % ntile) * 128 + wc * 32 + 8 * fq;
#pragma unroll
        for (int ai = 0; ai < 2; ++ai)
#pragma unroll
            for (int m = 0; m < 4; ++m) { bf16* rowp = O + (size_t)(row0 + ai * HALFT + m * 16) * ldc + col0;
                float a[8];
#pragma unroll
                for (int n = 0; n < 2; ++n)
#pragma unroll
                    for (int j = 0; j < 4; ++j) { const float g = acc[ai][0][m][n][j], up = acc[ai][1][m][n][j]; a[4 * n + j] = g * fast_rcp(1.0f + fast_exp(-g)) * up; }
                u32x4 w; w.x = pk2(a[0], a[1]); w.y = pk2(a[2], a[3]); w.z = pk2(a[4], a[5]); w.w = pk2(a[6], a[7]);
                *(u32x4*)rowp = w; }
    }
};
struct EpiZ {
    static constexpr bool PERM = true, AFTER_DRAIN = false;
    bf16* Z;
    __device__ __forceinline__ void operator()(const f32x4 (&acc)[2][2][4][2], const Unit& u, int wr, int wc, int fr, int fq) const {
        const int i = u.pn >> 2, pnl = u.pn & 3, pml = u.pm - i * (TH / 256);
        const int row0 = pml * 256 + wr * 64 + fr, col0 = i * D + pnl * 256 + wc * 32 + 8 * fq;
#pragma unroll
        for (int ai = 0; ai < 2; ++ai)
#pragma unroll
            for (int m = 0; m < 4; ++m) { bf16* rowp = Z + (size_t)(row0 + ai * HALFT + m * 16) * 4096 + col0;
#pragma unroll
                for (int bj = 0; bj < 2; ++bj) { const f32x4 v0 = acc[ai][bj][m][0], v1 = acc[ai][bj][m][1];
                    u32x4 w; w.x = pk2(v0[0], v0[1]); w.y = pk2(v0[2], v0[3]); w.z = pk2(v1[0], v1[1]); w.w = pk2(v1[2], v1[3]);
                    *(GAS u32x4*)(rowp + bj * HALFT) = w; } }
    }
};
struct BranchOrder {
    int nP, G, c;
    __device__ bool next(int i, Unit& u) const {
        const long L = (long)i * G + c; if (L >= (long)16 * nP) return false;
        const int br = (int)(L / (4 * nP)), r = (int)(L % (4 * nP)); u.pm = br * nP + (r >> 2); u.pn = br * 4 + (r & 3); return true;
    }
    __device__ __forceinline__ void a_ready(const Unit&) const {}
    __device__ __forceinline__ void done(const Unit&) const {}
};
struct EpiMerge {
    static constexpr bool PERM = false, AFTER_DRAIN = false;
    const bf16* Z; const float* gate_b; bf16* MG;
    __device__ __forceinline__ void operator()(const f32x4 (&acc)[2][2][4][2], const Unit& u, int wr, int wc, int fr, int fq) const {
        const int row0 = u.pm * 256 + wr * 64 + fr, col = u.pn * 64 + wc * 16 + 4 * fq;
        f32x4 gb[4];
#pragma unroll
        for (int i = 0; i < 4; ++i) gb[i] = *(const GAS f32x4*)(gate_b + i * D + col);
#pragma unroll
        for (int ai = 0; ai < 2; ++ai) {
            u32x2 zv[4][4];
#pragma unroll
            for (int m = 0; m < 4; ++m)
#pragma unroll
                for (int i = 0; i < 4; ++i) zv[m][i] = *(const GAS u32x2*)(Z + (size_t)(row0 + ai * HALFT + m * 16) * 4096 + i * D + col);
#pragma unroll
            for (int m = 0; m < 4; ++m) { const size_t row = (size_t)(row0 + ai * HALFT + m * 16);
                f32x4 s = (f32x4){0.f, 0.f, 0.f, 0.f};
#pragma unroll
                for (int bj = 0; bj < 2; ++bj)
#pragma unroll
                    for (int n = 0; n < 2; ++n) { const int i = 2 * bj + n; const unsigned z01 = zv[m][i].x, z23 = zv[m][i].y;
                        const f32x4 z = (f32x4){bf2f(z01 & 0xffffu), bf2f(z01 >> 16), bf2f(z23 & 0xffffu), bf2f(z23 >> 16)}; const f32x4 a = acc[ai][bj][m][n] + gb[i];
#pragma unroll
                        for (int j = 0; j < 4; ++j) s[j] += z[j] * fast_rcp(1.0f + fast_exp(-a[j])); }
                u32x2 w; w.x = pk2(s.x, s.y); w.y = pk2(s.z, s.w); *(GAS u32x2*)(MG + row * D + col) = w; }
        }
    }
};

constexpr size_t MiB = 1u << 20;
constexpr size_t al(size_t x) { return (x + 255) & ~(size_t)255; }
constexpr size_t WS_CTL = 0, CTL_BYTES = 1 * MiB;
constexpr size_t W_IN = 1 * MiB;
constexpr size_t W_GATE = W_IN + (size_t)PW * D * 2;
constexpr size_t W_UQ = W_GATE + (size_t)4096 * D * 2;
constexpr size_t W_UKV = W_UQ + (size_t)768 * 384 * 2;
constexpr size_t W_LORA = W_UKV + (size_t)1024 * 256 * 2;
constexpr size_t W_BR = W_LORA + (size_t)1536 * 384 * 2;
constexpr size_t W_OUT = W_BR + (size_t)4 * 1024 * 512 * 2;
constexpr size_t W_FGU = W_OUT + (size_t)D * D * 2;
constexpr size_t W_FDN = W_FGU + (size_t)NEXP * 2 * FF_E * D * 2;
constexpr size_t W_END = W_FDN + (size_t)NEXP * D * FF_E * 2;
constexpr size_t A_H = al(W_END);
constexpr size_t A_ROPE = A_H + (size_t)TH * D * 2;
constexpr size_t A_Y = A_ROPE + (size_t)TH * 64 * 4;
constexpr size_t A_P = A_Y + (size_t)4 * TH * 512 * 2;
constexpr size_t A_MIX = A_P + (size_t)TH * PW * 2;
constexpr size_t R_RKV = A_MIX;
constexpr size_t R_LOUT = R_RKV + (size_t)TH * 1536 * 2;
constexpr size_t R_O = R_LOUT + (size_t)TH * 1536 * 4;
constexpr size_t R_LIN = R_O + (size_t)TH * 512 * 4;
constexpr size_t R_REC = R_LIN + (size_t)TH * 384 * 2;
constexpr size_t R_END = R_REC + (size_t)BH * 8 * NCH * 61696;
constexpr size_t M_KR = al(R_END);
constexpr size_t M_Q = M_KR + (size_t)TH * 64 * 2;
constexpr size_t M_KV = M_Q + (size_t)TH * 768 * 2;
constexpr size_t M_VT = M_KV + (size_t)TH * 1024 * 2;
constexpr size_t M_END = M_VT + (size_t)TH * 512 * 2;
constexpr size_t G_CH = R_LIN;
constexpr size_t G_O = G_CH + al((size_t)BH * 4 * NCH * 78864);
constexpr size_t G_END = G_O + (size_t)TH * 512 * 4;
constexpr size_t S_ST = al(G_END);
constexpr size_t S_YD = S_ST + (size_t)BH * NCH * 8 * 64 * 128 * 2;
constexpr size_t S_C = S_YD + (size_t)TH * 512 * 4;
constexpr size_t S_AC = S_C + (size_t)BH * NCH * 2 * 17408;
constexpr size_t S_YO = S_AC + (size_t)TH * 8 * 4;
constexpr size_t S_END = S_YO + (size_t)TH * 512 * 4;
constexpr size_t A_Z = A_P;
constexpr size_t A_MG = A_MIX;
constexpr size_t F_ACT = A_P;
constexpr size_t F_GA = F_ACT + (size_t)MOE_ROWS * FF_E * 2;
constexpr size_t F_YE = F_GA + (size_t)MOE_ROWS * D * 2;
constexpr size_t F_TOPE = F_YE + (size_t)MOE_ROWS * D * 4;
constexpr size_t F_TOPW = F_TOPE + (size_t)TH * 2 * 4;
constexpr size_t F_SLOT = F_TOPW + (size_t)TH * 2 * 4;
constexpr size_t F_PART = al(F_SLOT + (size_t)TH * 2 * 4);
constexpr size_t F_END = F_PART + (size_t)MOE_KSPLIT * (MOE_ROWS - 2 * TH) * D * 4;
constexpr size_t cmax(size_t a, size_t b) { return a > b ? a : b; }
constexpr size_t WS_NEED = cmax(cmax(cmax(M_END, R_END), cmax(G_END, S_END)), F_END);
#ifndef EMU
static_assert(WS_NEED <= (size_t)896 * MiB, "workspace");
#endif
constexpr int CW_BAR = 4096;
constexpr int CW_ATQ = 12288;
constexpr int CW_RFLAG = 12288;
constexpr int CW_CNT = 16384;
constexpr int CW_WGC = 32768;

#ifdef EMU
#define WAVE_SYNC() emu_wave_sync()
#else
#define WAVE_SYNC() do { asm volatile("s_waitcnt lgkmcnt(0)" ::: "memory"); } while (0)
#endif
struct Frame {
    LAS unsigned char* lds; int tid, lane, wave, G, gw, NGW, bid;
    GAS float* out; GAS unsigned char* ws; GAS unsigned* ctl;
};
struct Args { const float* in[39]; float* out; unsigned char* ws; int lo, hi; };
#define WSP(type, off) ((type*)(F.ws + (off)))
#define AIN(A_, k) ((const float*)(const GAS float*)(A_).in[k])

template <class FN>
__device__ __forceinline__ void cvt_matrix(const Frame& F, const float* W, int ldw, int K, bf16* WT, int Ndst, const float* kscale, FN srccol) {
    LAS float* scr = (LAS float*)(F.lds + F.wave * 16384);
    const int nblk = Ndst / 32, nitems = (K / 64) * nblk, lane = F.lane;
    for (int item = F.gw; item < nitems; item += F.NGW) {
        const int kb = item / nblk, nb = item % nblk, k0 = 64 * kb, n0 = 32 * nb;
        const int sc = srccol(n0 + (lane & 31));
        float wv[32];
#pragma unroll
        for (int i = 0; i < 32; ++i) { const int kk = 2 * i + (lane >> 5); wv[i] = sc >= 0 ? W[(size_t)(k0 + kk) * ldw + sc] : 0.f; }
#pragma unroll
        for (int i = 0; i < 32; ++i) { const int kk = 2 * i + (lane >> 5); float v = wv[i]; if (kscale) v *= kscale[k0 + kk]; scr[kk * 33 + (lane & 31)] = v; }
        WAVE_SYNC();
        const int c = lane & 7;
#pragma unroll
        for (int j = 0; j < 4; ++j) { const int n = (lane >> 3) + 8 * j; const LAS float* s = scr + (8 * c) * 33 + n;
            u32x4 o; o.x = pk2(s[0 * 33], s[1 * 33]); o.y = pk2(s[2 * 33], s[3 * 33]); o.z = pk2(s[4 * 33], s[5 * 33]); o.w = pk2(s[6 * 33], s[7 * 33]);
            *(u32x4*)(WT + (size_t)(n0 + n) * K + k0 + 8 * c) = o; }
        WAVE_SYNC();
    }
}
__device__ __forceinline__ void phase_convert(const Frame& F, const Args& A, int layer) {
    const float* w_in = AIN(A, 3) + (size_t)layer * D * IN_COLS;
    cvt_matrix(F, w_in, IN_COLS, D, WSP(bf16, W_IN), PW, nullptr, [](int n) { return n < C_GATE ? n : -1; });
    cvt_matrix(F, w_in, IN_COLS, D, WSP(bf16, W_GATE), 4096, nullptr, [](int n) {
        const int pn = n >> 8, c = n & 255, bj = c >> 7, wc = (c >> 5) & 3, nn = (c >> 4) & 1, r = c & 15; return C_GATE + (2 * bj + nn) * D + 64 * pn + 16 * wc + r; });
    cvt_matrix(F, AIN(A, 6) + (size_t)layer * 384 * 768, 768, 384, WSP(bf16, W_UQ), 768, AIN(A, 4) + layer * 384, [](int n) { return n; });
    cvt_matrix(F, AIN(A, 7) + (size_t)layer * 256 * 1024, 1024, 256, WSP(bf16, W_UKV), 1024, AIN(A, 5) + layer * 256, [](int n) { return n; });
    for (int i = 0; i < 4; ++i) cvt_matrix(F, AIN(A, 30) + ((size_t)layer * 4 + i) * 512 * D, D, 512, WSP(bf16, W_BR) + (size_t)i * D * 512, D, nullptr, [](int n) { return n; });
    cvt_matrix(F, AIN(A, 31) + (size_t)layer * D * D, D, D, WSP(bf16, W_OUT), D, nullptr, [](int n) { return n; });
    if (layer == 0) {
        cvt_matrix(F, AIN(A, 33), 2 * FF_D, D, WSP(bf16, W_FGU), 2 * FF_D, nullptr, [](int n) { const int pn = n >> 8, c = n & 255; return c < 128 ? 128 * pn + c : FF_D + 128 * pn + (c - 128); });
        cvt_matrix(F, AIN(A, 34), D, FF_D, WSP(bf16, W_FDN), D, nullptr, [](int n) { return n; });
    } else {
        for (int e = 0; e < NEXP; ++e) {
            cvt_matrix(F, AIN(A, 36) + (size_t)e * D * 2 * FF_E, 2 * FF_E, D, WSP(bf16, W_FGU) + (size_t)e * 2 * FF_E * D, 2 * FF_E, nullptr, [](int n) { const int pn = n >> 8, c = n & 255; return c < 128 ? 128 * pn + c : FF_E + 128 * pn + (c - 128); });
            cvt_matrix(F, AIN(A, 37) + (size_t)e * FF_E * D, D, FF_E, WSP(bf16, W_FDN) + (size_t)e * D * FF_E, D, nullptr, [](int n) { return n; });
        }
    }
    { const float* w2 = AIN(A, 10) + (size_t)layer * 64 * 512; const float* a2 = AIN(A, 12) + (size_t)layer * 64 * 512; const float* g2 = AIN(A, 13) + (size_t)layer * 160 * 512;
      bf16* L = WSP(bf16, W_LORA);
      for (int idx = F.bid * 512 + F.tid; idx < 1536 * 384; idx += F.G * 512) { const int n = idx / 384, k = idx % 384; float v = 0.f;
          if (n < 512) { if (k < 64) v = w2[k * 512 + n]; } else if (n < 1024) { if (k >= 64 && k < 128) v = a2[(k - 64) * 512 + (n - 512)]; } else { if (k >= 128 && k < 288) v = g2[(k - 128) * 512 + (n - 1024)]; }
          L[idx] = (bf16)f2bf(v); } }
}

template <bool ROUTER>
__device__ __forceinline__ void phase_norm(const Frame& F, const Args& A, const float* xin, const float* gain, bf16* H, const float* router, int* tope, float* topw, unsigned* cnt) {
    const int lane = F.lane;
    LAS unsigned* lcnt = (LAS unsigned*)F.lds;
    if (ROUTER) { __syncthreads(); if (F.tid < 8) lcnt[F.tid] = 0u; __syncthreads(); }
    f32x4 gv[4];
#pragma unroll
    for (int j = 0; j < 4; ++j) gv[j] = *(const f32x4*)(gain + 4 * lane + 256 * j);
    for (int m = F.gw; m < TH; m += F.NGW) {
        const float* xr = xin + (size_t)m * D; f32x4 v[4]; float ss = 0.f;
#pragma unroll
        for (int j = 0; j < 4; ++j) { v[j] = *(const f32x4*)(xr + 4 * lane + 256 * j); ss += (v[j].x * v[j].x + v[j].y * v[j].y) + (v[j].z * v[j].z + v[j].w * v[j].w); }
        const float rstd = RSQRT(wave_sum(ss) * (1.0f / D) + EPS);
#pragma unroll
        for (int j = 0; j < 4; ++j) { v[j] = v[j] * rstd * gv[j]; st_bf16x4(H + (size_t)m * D + 4 * lane + 256 * j, v[j]); }
        if (ROUTER) {
            float lg[8];
#pragma unroll
            for (int e = 0; e < 8; ++e) lg[e] = 0.f;
#pragma unroll
            for (int j = 0; j < 4; ++j)
#pragma unroll
                for (int q = 0; q < 4; ++q) { const float* rp = router + (size_t)(4 * lane + 256 * j + q) * 8; const f32x4 r0 = *(const f32x4*)rp, r1 = *(const f32x4*)(rp + 4); const float hv = v[j][q];
                    lg[0] += hv * r0.x; lg[1] += hv * r0.y; lg[2] += hv * r0.z; lg[3] += hv * r0.w; lg[4] += hv * r1.x; lg[5] += hv * r1.y; lg[6] += hv * r1.z; lg[7] += hv * r1.w; }
#pragma unroll
            for (int e = 0; e < 8; ++e) lg[e] = wave_sum(lg[e]);
            if (lane == 0) {
                int e1 = 0; float l1 = lg[0];
#pragma unroll
                for (int e = 1; e < 8; ++e) if (lg[e] > l1) { l1 = lg[e]; e1 = e; }
                int e2 = -1; float l2 = -3.0e38f;
#pragma unroll
                for (int e = 0; e < 8; ++e) if (e != e1 && lg[e] > l2) { l2 = lg[e]; e2 = e; }
                const float w1 = 1.0f / (1.0f + expf(l2 - l1));
                tope[2 * m] = e1; tope[2 * m + 1] = e2; topw[2 * m] = w1; topw[2 * m + 1] = 1.0f - w1;
                ATOMIC_ADD_LDS(lcnt + e1, 1u); ATOMIC_ADD_LDS(lcnt + e2, 1u);
            }
        }
    }
    if (ROUTER) { __syncthreads(); if (F.tid < 8) cnt[F.bid * 8 + F.tid] = lcnt[F.tid]; __syncthreads(); }
}
__device__ __forceinline__ void phase_rope_table(const Frame& F, const Args& A, const int* pos, float* rope) {
    for (int idx = F.bid * 512 + F.tid; idx < TH * 32; idx += F.G * 512) { const int t = idx >> 5, i = idx & 31;
        const float inv = powf(10000.0f, -(float)i / 32.0f);
        const float ang = (float)pos[t] * inv; float sn, cs; sincosf(ang, &sn, &cs);
        rope[(size_t)t * 64 + i] = cs; rope[(size_t)t * 64 + 32 + i] = sn; }
}
__device__ __forceinline__ void phase_final_norm(const Frame& F, const Args& A, float* x, const float* gain) {
    const int lane = F.lane;
    for (int m = F.gw; m < T; m += F.NGW) {
        float* xr = x + (size_t)m * D; f32x4 v[4]; float ss = 0.f;
#pragma unroll
        for (int j = 0; j < 4; ++j) { v[j] = *(const f32x4*)(xr + 4 * lane + 256 * j); ss += (v[j].x * v[j].x + v[j].y * v[j].y) + (v[j].z * v[j].z + v[j].w * v[j].w); }
        const float rstd = RSQRT(wave_sum(ss) * (1.0f / D) + EPS);
#pragma unroll
        for (int j = 0; j < 4; ++j) *(f32x4*)(xr + 4 * lane + 256 * j) = v[j] * rstd * *(const f32x4*)(gain + 4 * lane + 256 * j);
    }
}

__device__ __forceinline__ void phase_mla_prep(const Frame& F, const Args& A) {
    bf16* P = WSP(bf16, A_P); bf16* kr = WSP(bf16, M_KR); const float* rope = WSP(float, A_ROPE);
    const int lane = F.lane;
    for (int m = F.gw; m < TH; m += F.NGW) {
        bf16* pr = P + (size_t)m * PW; float sq = 0.f, skv = 0.f; f32x4 v[3];
#pragma unroll
        for (int j = 0; j < 3; ++j) { const int c = 4 * lane + 256 * j; v[j] = ld_bf16x4(pr + c); const float s = (v[j].x * v[j].x + v[j].y * v[j].y) + (v[j].z * v[j].z + v[j].w * v[j].w);
            if (c < 384) sq += s; else if (c < 640) skv += s; }
        sq = wave_sum(sq); skv = wave_sum(skv);
        const float rq = RSQRT(sq * (1.0f / 384.0f) + EPS), rkv = RSQRT(skv * (1.0f / 256.0f) + EPS);
#pragma unroll
        for (int j = 0; j < 3; ++j) { const int c = 4 * lane + 256 * j; if (c < 640) st_bf16x4(pr + c, v[j] * (c < 384 ? rq : rkv)); }
        if (lane < 32) { const float x1 = bf2f(pr[640 + lane]), x2 = bf2f(pr[672 + lane]), c = rope[(size_t)m * 64 + lane], s = rope[(size_t)m * 64 + 32 + lane];
            kr[(size_t)m * 64 + lane] = (bf16)f2bf(x1 * c - x2 * s); kr[(size_t)m * 64 + 32 + lane] = (bf16)f2bf(x2 * c + x1 * s); }
    }
}
__device__ __forceinline__ void phase_mla_q(const Frame& F, const Args& A) {
    pg8::Gemm g{WSP(bf16, A_P) + 0, WSP(bf16, W_UQ), PW, 384}; pg8::StaticOrder S; S.init(TH, 768, F.G, F.bid);
    EpiBf16 E{WSP(bf16, M_Q), 768, nullptr, 0}; pg8::gemm_phase(F.lds, g, S, E, F.tid);
}
struct EpiKV {
    static constexpr bool PERM = true, AFTER_DRAIN = false;
    bf16* KV; bf16* VT;
    __device__ __forceinline__ void operator()(const f32x4 (&acc)[2][2][4][2], const Unit& u, int wr, int wc, int fr, int fq) const {
        const int row0 = u.pm * 256 + wr * 64 + fr, col0 = wc * 32 + 8 * fq;
#pragma unroll
        for (int ai = 0; ai < 2; ++ai)
#pragma unroll
            for (int m = 0; m < 4; ++m) { const int row = row0 + ai * HALFT + m * 16;
                { const f32x4 v0 = acc[ai][0][m][0], v1 = acc[ai][0][m][1]; u32x4 w; w.x = pk2(v0[0], v0[1]); w.y = pk2(v0[2], v0[3]); w.z = pk2(v1[0], v1[1]); w.w = pk2(v1[2], v1[3]);
                  *(u32x4*)(KV + (size_t)row * 1024 + u.pn * 256 + col0) = w; }
                const int b = row / SEQ, t = row % SEQ; bf16* vt = VT + ((size_t)(b * 4 + u.pn) * 128 + col0) * SEQ + t;
#pragma unroll
                for (int n = 0; n < 2; ++n)
#pragma unroll
                    for (int j = 0; j < 4; ++j) vt[(size_t)(4 * n + j) * SEQ] = (bf16)f2bf(acc[ai][1][m][n][j]); }
    }
};
__device__ __forceinline__ void phase_mla_kv(const Frame& F, const Args& A) {
    pg8::Gemm g{WSP(bf16, A_P) + 384, WSP(bf16, W_UKV), PW, 256}; pg8::StaticOrder S; S.init(TH, 1024, F.G, F.bid);
    EpiKV E{WSP(bf16, M_KV), WSP(bf16, M_VT)}; pg8::gemm_phase(F.lds, g, S, E, F.tid);
}
constexpr int AT_KS = 200, AT_VS = 72;
constexpr int AT_KBYTES = 64 * AT_KS * 2, AT_VBYTES = 128 * AT_VS * 2;
__device__ __forceinline__ void phase_attention(const Frame& F, const Args& A) {
    const bf16* Q = WSP(bf16, M_Q); const bf16* KV = WSP(bf16, M_KV); const bf16* KR = WSP(bf16, M_KR); const bf16* VTg = WSP(bf16, M_VT); const float* rope = WSP(float, A_ROPE); bf16* Y = WSP(bf16, A_Y);
    const int lane = F.lane, w = F.wave, l15 = lane & 15, q4 = lane >> 4, tid = F.tid, grp = w >> 2, wq = w & 3;
    const int NQB = SEQ / 128, nunits = BH * 4 * NQB;
    const float sc2 = 0.07216878364870322f * 1.4426950408889634f;
    for (int unit = F.bid; unit < nunits; unit += F.G) {
        const int qb = NQB - 1 - (unit / (BH * 4)), bh = unit % (BH * 4), h = bh & 3, b = bh >> 2;
        const size_t t0 = (size_t)b * SEQ;
        bf16x8 qf[2][6];
#pragma unroll
        for (int f = 0; f < 2; ++f) { const size_t tq = t0 + qb * 128 + wq * 32 + 16 * f + l15;
#pragma unroll
            for (int ks = 0; ks < 6; ++ks) qf[f][ks] = *(const bf16x8*)(Q + tq * 768 + h * 192 + 32 * ks + 8 * q4);
            const bf16x8 a = qf[f][4], c2 = qf[f][5];
#pragma unroll
            for (int j = 0; j < 8; ++j) { const float x1 = bf2f((unsigned short)a[j]), x2 = bf2f((unsigned short)c2[j]), c = rope[tq * 64 + 8 * q4 + j], sn = rope[tq * 64 + 32 + 8 * q4 + j];
                qf[f][4][j] = (short)f2bf(x1 * c - x2 * sn); qf[f][5][j] = (short)f2bf(x2 * c + x1 * sn); } }
        f32x4 o[2][8];
#pragma unroll
        for (int f = 0; f < 2; ++f)
#pragma unroll
            for (int mb = 0; mb < 8; ++mb) o[f][mb] = (f32x4){0.f, 0.f, 0.f, 0.f};
        float mrow[2] = {-3.0e38f, -3.0e38f}, lrow[2] = {0.f, 0.f};
        const int qchunk = 2 * qb + (wq >> 1), ntile = 2 * qb + 2;
        u32x4 pk_[3], pv_[2];
        const int skey = tid >> 3, c8 = tid & 7;
        const int okv = skey * 1024 + 8 * c8, okr = skey * 64 + 8 * c8, ovt = skey * SEQ + 8 * c8;
        const bf16* kvb = KV + t0 * 1024 + h * 256; const bf16* krb = KR + t0 * 64; const bf16* vtb = VTg + (size_t)(b * 4 + h) * 128 * SEQ;
#define AT_LOAD(kt) do { const bf16* kv_ = kvb + (size_t)(kt) * 65536; const bf16* kr_ = krb + (size_t)(kt) * 4096; const bf16* vt_ = vtb + (size_t)(kt) * 64; \
            pk_[0] = *(const u32x4*)(kv_ + okv); pk_[1] = *(const u32x4*)(kv_ + okv + 64); pk_[2] = *(const u32x4*)(kr_ + okr); \
            pv_[0] = *(const u32x4*)(vt_ + ovt); pv_[1] = *(const u32x4*)(vt_ + ovt + 64 * SEQ); } while (0)
#define AT_STORE(bufi) do { LAS bf16* Ks_ = (LAS bf16*)(F.lds + (bufi) * (AT_KBYTES + AT_VBYTES)); LAS bf16* Vt_ = (LAS bf16*)((LAS unsigned char*)Ks_ + AT_KBYTES); \
            *(LAS u32x4*)(Ks_ + skey * AT_KS + 8 * c8) = pk_[0]; *(LAS u32x4*)(Ks_ + skey * AT_KS + 8 * c8 + 64) = pk_[1]; *(LAS u32x4*)(Ks_ + skey * AT_KS + 8 * c8 + 128) = pk_[2]; \
            *(LAS u32x4*)(Vt_ + skey * AT_VS + 8 * c8) = pv_[0]; *(LAS u32x4*)(Vt_ + (skey + 64) * AT_VS + 8 * c8) = pv_[1]; } while (0)
        __syncthreads();
        AT_LOAD(0); AT_STORE(0);
        __syncthreads();
        for (int kt = 0; kt < ntile; ++kt) {
            if (kt + 1 < ntile) AT_LOAD(kt + 1);
            if (kt <= qchunk) {
                const LAS bf16* Ks = (const LAS bf16*)(F.lds + (kt & 1) * (AT_KBYTES + AT_VBYTES)); const LAS bf16* Vt = (const LAS bf16*)((const LAS unsigned char*)Ks + AT_KBYTES);
                f32x4 st[2][2];
#pragma unroll
                for (int kb = 0; kb < 2; ++kb) { st[0][kb] = (f32x4){0.f, 0.f, 0.f, 0.f}; st[1][kb] = (f32x4){0.f, 0.f, 0.f, 0.f};
#pragma unroll
                    for (int ks = 0; ks < 6; ++ks) { const bf16x8 kf = *(const LAS bf16x8*)(Ks + (32 * grp + 16 * kb + l15) * AT_KS + 32 * ks + 8 * q4);
                        st[0][kb] = MFMA_BF16(kf, qf[0][ks], st[0][kb]); st[1][kb] = MFMA_BF16(kf, qf[1][ks], st[1][kb]); } }
                bf16x8 pb[2];
#pragma unroll
                for (int f = 0; f < 2; ++f) {
                    float mx = -3.0e38f;
#pragma unroll
                    for (int kb = 0; kb < 2; ++kb) mx = fmaxf(mx, fmaxf(fmaxf(st[f][kb].x, st[f][kb].y), fmaxf(st[f][kb].z, st[f][kb].w)));
                    mx = rows_max(mx) * sc2;
                    const float mnew = fmaxf(mrow[f], mx), alpha = exp2f(mrow[f] - mnew); mrow[f] = mnew;
                    float ps = 0.f;
#pragma unroll
                    for (int kb = 0; kb < 2; ++kb)
#pragma unroll
                        for (int r = 0; r < 4; ++r) { const float p = exp2f(__builtin_fmaf(st[f][kb][r], sc2, -mnew)); ps += p; pb[f][4 * kb + r] = (short)f2bf(p); }
                    lrow[f] = lrow[f] * alpha + ps;
#pragma unroll
                    for (int mb = 0; mb < 8; ++mb) o[f][mb] = o[f][mb] * alpha;
                }
#pragma unroll
                for (int mb = 0; mb < 8; ++mb) { const LAS bf16* vp = Vt + (16 * mb + l15) * AT_VS + 32 * grp + 4 * q4;
                    const bf16x4 v0 = *(const LAS bf16x4*)vp, v1 = *(const LAS bf16x4*)(vp + 16);
                    bf16x8 vf; vf[0] = v0[0]; vf[1] = v0[1]; vf[2] = v0[2]; vf[3] = v0[3]; vf[4] = v1[0]; vf[5] = v1[1]; vf[6] = v1[2]; vf[7] = v1[3];
                    o[0][mb] = MFMA_BF16(vf, pb[0], o[0][mb]); o[1][mb] = MFMA_BF16(vf, pb[1], o[1][mb]); }
            }
            if (kt + 1 < ntile) AT_STORE((kt + 1) & 1);
            __syncthreads();
        }
#undef AT_LOAD
#undef AT_STORE
#pragma unroll
        for (int f = 0; f < 2; ++f) lrow[f] = rows_sum(lrow[f]);
        LAS float* xo = (LAS float*)F.lds + (size_t)wq * (2 * 8 * 4 * 64 + 4 * 64);
        if (grp == 1) {
#pragma unroll
            for (int f = 0; f < 2; ++f) {
#pragma unroll
                for (int mb = 0; mb < 8; ++mb)
#pragma unroll
                    for (int r = 0; r < 4; ++r) xo[((f * 8 + mb) * 4 + r) * 64 + lane] = o[f][mb][r];
                xo[2 * 8 * 4 * 64 + f * 64 + lane] = mrow[f]; xo[2 * 8 * 4 * 64 + 128 + f * 64 + lane] = lrow[f]; } }
        __syncthreads();
        if (grp == 0) {
#pragma unroll
            for (int f = 0; f < 2; ++f) { const float m1 = xo[2 * 8 * 4 * 64 + f * 64 + lane], l1 = xo[2 * 8 * 4 * 64 + 128 + f * 64 + lane];
                const float m = fmaxf(mrow[f], m1), a0 = exp2f(mrow[f] - m), a1 = exp2f(m1 - m), inv = 1.0f / (lrow[f] * a0 + l1 * a1);
                const size_t tq = t0 + qb * 128 + wq * 32 + 16 * f + l15;
#pragma unroll
                for (int mb = 0; mb < 8; ++mb) { f32x4 v;
#pragma unroll
                    for (int r = 0; r < 4; ++r) v[r] = (o[f][mb][r] * a0 + xo[((f * 8 + mb) * 4 + r) * 64 + lane] * a1) * inv;
                    st_bf16x4(Y + tq * 512 + h * 128 + 16 * mb + 4 * q4, v); } } }
    }
    __syncthreads();
}

__device__ __forceinline__ f32x4 tile_bf(const LAS bf16* a, int lda, const LAS bf16* bt, int ldb, int K, f32x4 acc, int l15, int q4) {
    const LAS bf16* ap = a + l15 * lda + 8 * q4; const LAS bf16* bp = bt + l15 * ldb + 8 * q4;
#pragma unroll 4
    for (int ks = 0; ks < K / 32; ++ks) acc = MFMA_BF16(*(const LAS bf16x8*)(ap + 32 * ks), *(const LAS bf16x8*)(bp + 32 * ks), acc);
    return acc;
}
__device__ __forceinline__ f32x4 tile_mm(const LAS float* a, int lda, int ska, const LAS float* b, int ldb, int scb, int K, f32x4 acc, int l15, int q4);


__device__ __forceinline__ void diag_solve16(const LAS float* Lblk  , int ldl, LAS float* xcol  , int ldx) {
    float x[16];
#pragma unroll
    for (int i = 0; i < 16; ++i) x[i] = xcol[i * ldx];
#pragma unroll
    for (int g = 0; g < 4; ++g) {
        f32x4 av[4][4];
#pragma unroll
        for (int ii = 0; ii < 4; ++ii)
#pragma unroll
            for (int c4 = 0; c4 <= g; ++c4) av[ii][c4] = *(const LAS f32x4*)(Lblk + (4 * g + ii) * ldl + 4 * c4);
#pragma unroll
        for (int ii = 0; ii < 4; ++ii) { const int i = 4 * g + ii; float sacc = x[i];
#pragma unroll
            for (int jj = 0; jj < i; ++jj) sacc -= av[ii][jj >> 2][jj & 3] * x[jj];
            x[i] = sacc; }
    }
#pragma unroll
    for (int i = 1; i < 16; ++i) xcol[i * ldx] = x[i];
}
__device__ __forceinline__ void tri_solve64(const LAS float* L, int ldl, LAS float* X, int ldx, int nct, LAS float* scr, int w, int l15, int q4) {
    LAS float* DI = scr;
    if (w < 4) { LAS float* T = DI + w * 320; LAS float* S = scr + 4 * 320 + w * 320; const LAS float* N = L + 16 * w * ldl + 16 * w;
#pragma unroll
        for (int r = 0; r < 4; ++r) { const int i = 4 * q4 + r; T[i * 20 + l15] = (i == l15 ? 1.0f : 0.0f) - (l15 < i ? N[i * ldl + l15] : 0.0f); }
        { const f32x4 a = tile_mm(N, ldl, 1, N, ldl, 1, 16, (f32x4){0.f, 0.f, 0.f, 0.f}, l15, q4);
#pragma unroll
          for (int r = 0; r < 4; ++r) S[(4 * q4 + r) * 20 + l15] = a[r]; }
        WAVE_SYNC();
#pragma unroll
        for (int it = 0; it < 3; ++it) {
            { const f32x4 a = tile_mm(T, 20, 1, S, 20, 1, 16, (f32x4){0.f, 0.f, 0.f, 0.f}, l15, q4);
#pragma unroll
              for (int r = 0; r < 4; ++r) T[(4 * q4 + r) * 20 + l15] += a[r]; }
            if (it < 2) { const f32x4 a = tile_mm(S, 20, 1, S, 20, 1, 16, (f32x4){0.f, 0.f, 0.f, 0.f}, l15, q4);
#pragma unroll
                for (int r = 0; r < 4; ++r) S[(4 * q4 + r) * 20 + l15] = a[r]; }
            WAVE_SYNC();
        } }
    __syncthreads();
    for (int ct = w; ct < nct; ct += 8) { LAS float* Xc = X + 16 * ct;
#pragma unroll
        for (int rb = 0; rb < 4; ++rb) {
            if (rb > 0) { const f32x4 a = tile_mm(L + 16 * rb * ldl, ldl, 1, Xc, ldx, 1, 16 * rb, (f32x4){0.f, 0.f, 0.f, 0.f}, l15, q4);
#pragma unroll
                for (int r = 0; r < 4; ++r) Xc[(16 * rb + 4 * q4 + r) * ldx + l15] -= a[r];
                WAVE_SYNC(); }
            const f32x4 y = tile_mm(DI + rb * 320, 20, 1, Xc + 16 * rb * ldx, ldx, 1, 16, (f32x4){0.f, 0.f, 0.f, 0.f}, l15, q4);
#pragma unroll
            for (int r = 0; r < 4; ++r) Xc[(16 * rb + 4 * q4 + r) * ldx + l15] = y[r];
            WAVE_SYNC();
        } }
}
__device__ __forceinline__ void phase_rwkv_prep(const Frame& F, const Args& A, int layer) {
    const bf16* P = WSP(bf16, A_P); bf16* RKV = WSP(bf16, R_RKV); bf16* LIN = WSP(bf16, R_LIN); const float* mu = AIN(A, 8) + (size_t)layer * 1824;
    const int lane = F.lane;
    for (int m = F.gw; m < TH; m += F.NGW) {
        const bool first = (m % SEQ) == 0; const bf16* pr = P + (size_t)m * PW + C_RWKV;
#pragma unroll
        for (int j = 0; j < 8; ++j) { const int c = 4 * lane + 256 * j;
            if (c < 1824) { const f32x4 p = ld_bf16x4(pr + c); const f32x4 pv = first ? (f32x4){0.f, 0.f, 0.f, 0.f} : ld_bf16x4(pr - PW + c); const f32x4 muv = *(const f32x4*)(mu + c);
                f32x4 x = p + (pv - p) * muv;
                if (c < 1536) st_bf16x4(RKV + (size_t)m * 1536 + c, x);
                else { if (c < 1600) { x.x = tanhf_(x.x); x.y = tanhf_(x.y); x.z = tanhf_(x.z); x.w = tanhf_(x.w); }
                       else if (c >= 1664) { x.x = sigmoidf_(x.x); x.y = sigmoidf_(x.y); x.z = sigmoidf_(x.z); x.w = sigmoidf_(x.w); }
                       st_bf16x4(LIN + (size_t)m * 384 + (c - 1536), x); } } }
        if (lane < 24) st_bf16x4(LIN + (size_t)m * 384 + 288 + 4 * lane, (f32x4){0.f, 0.f, 0.f, 0.f});
    }
}
__device__ __forceinline__ void phase_rwkv_lora(const Frame& F, const Args& A) {
    pg8::Gemm g{WSP(bf16, R_LIN), WSP(bf16, W_LORA), 384, 384}; pg8::StaticOrder S; S.init(TH, 1536, F.G, (F.bid + F.G / 2) % F.G);
    EpiLora E{WSP(float, R_LOUT), (bf16*)(WSP(float, R_LOUT) + (size_t)TH * 512)}; pg8::gemm_phase(F.lds, g, S, E, F.tid);
}
constexpr int RS = 72;
constexpr int RREC_COMMON = 4 * 64 * RS * 2 + 256;
constexpr int RREC_T = 64 * 64 * 2;
constexpr int RREC_BYTES = RREC_COMMON + 3 * RREC_T;
static_assert(RREC_BYTES == 61696, "record size (see R_REC in the workspace map)");
static_assert(RREC_COMMON % 16 == 0, "record alignment");
__device__ __forceinline__ void phase_rwkv_r1(const Frame& F, const Args& A, int layer) {
    const bf16* RKV = WSP(bf16, R_RKV); const float* LOUT = WSP(float, R_LOUT); unsigned char* REC = WSP(unsigned char, R_REC);
    const float* w0 = AIN(A, 9) + layer * 512; const float* a0 = AIN(A, 11) + layer * 512; const float* k_k = AIN(A, 14) + layer * 512; const float* k_a = AIN(A, 15) + layer * 512;
    LAS bf16* kbar = (LAS bf16*)F.lds; LAS bf16* atil = kbar + 64 * RS; LAS bf16* khat = atil + 64 * RS; LAS bf16* rbar = khat + 64 * RS;
    LAS bf16* atT = rbar + 64 * RS; LAS bf16* khT = atT + 64 * RS; LAS bf16* vT = khT + 64 * RS; LAS bf16* Bm = vT + 64 * RS; LAS bf16* Em = Bm + 64 * RS;
    LAS float* Am = (LAS float*)(Em + 64 * RS);
    LAS float* X = Am + 64 * 68;
    LAS float* lam = Am;
    const int w = F.wave;
    const int nunits = BH * 8 * NCH;
    for (int unit = F.bid; unit < nunits; unit += F.G) {
        int tid = F.tid; OPAQUE_V(tid); ASSUME(tid >= 0 && tid < 512); const int lane = tid & 63, l15 = lane & 15, q4 = lane >> 4;
        const int c = unit % NCH, h = (unit / NCH) & 7, b = unit / (NCH * 8);
        const size_t tok0 = (size_t)b * SEQ + (size_t)c * 64;
        const int j = lane, cj = h * 64 + j;
        __syncthreads();
        float r_[8], km_[8], kk_[8], ka_[8], v_[8], L_[8];
        { const float w0c = w0[cj], a0c = a0[cj], kkc = k_k[cj], kac = k_a[cj]; float run = 0.f;
#pragma unroll
          for (int q = 0; q < 8; ++q) { const int t = 8 * w + q; const size_t tok = tok0 + t;
              const float r = bf2f(RKV[tok * 1536 + cj]), k = bf2f(RKV[tok * 1536 + 512 + cj]); v_[q] = bf2f(RKV[tok * 1536 + 1024 + cj]);
              const float wpre = bf2f(((const bf16*)LOUT)[tok * 512 + cj]), apre = bf2f(((const bf16*)(LOUT + (size_t)TH * 512))[tok * 1024 + cj]);
              const float wl = -softplusf_(-(w0c + wpre)) - 0.5f, a = sigmoidf_(a0c + apre);
              const float kr = k * kkc, ss = wave_sum(kr * kr), kk = kr * RSQRT(ss + EPS);
              r_[q] = r; km_[q] = k * (1.0f + (a - 1.0f) * kac); kk_[q] = kk; ka_[q] = kk * a;
              run += -expf(wl); L_[q] = run; }
          lam[w * 64 + j] = run; }
        __syncthreads();
        { float base = 0.f, Lend = 0.f;
#pragma unroll
          for (int ww = 0; ww < 8; ++ww) { const float tw = lam[ww * 64 + j]; if (ww < w) base += tw; Lend += tw; }
#pragma unroll
          for (int q = 0; q < 8; ++q) { const int t = 8 * w + q; const float L = base + L_[q], Lm1 = q ? base + L_[q - 1] : base;
              const float eG = expf(L), eGi = expf(-L), eGm1 = expf(Lm1), eT = expf(Lend - L);
              const float kb = kk_[q] * eGm1;
              kbar[t * RS + j] = (bf16)f2bf(kb); X[t * 132 + j] = kb;
              atil[t * RS + j] = (bf16)f2bf(ka_[q] * eGi); khat[t * RS + j] = (bf16)f2bf(km_[q] * eGi); rbar[t * RS + j] = (bf16)f2bf(r_[q] * eG);
              atT[j * RS + t] = (bf16)f2bf(-ka_[q] * eT); khT[j * RS + t] = (bf16)f2bf(km_[q] * eT); vT[j * RS + t] = (bf16)f2bf(v_[q]); }
          if (w == 0) { float* gc = (float*)(REC + (size_t)unit * RREC_BYTES + 4 * 64 * RS * 2); gc[j] = expf(Lend); } }
        __syncthreads();
        unsigned char* rec = REC + (size_t)unit * RREC_BYTES;
        { const int which = w >> 1, tib = 2 * (w & 1);
          const LAS bf16* Aop = (which & 2) ? rbar : kbar; const LAS bf16* Bop = (which & 1) ? khat : atil;
          bf16x8 aF[2][2], bF[4][2];
#pragma unroll
          for (int t = 0; t < 2; ++t)
#pragma unroll
              for (int ks = 0; ks < 2; ++ks) aF[t][ks] = *(const LAS bf16x8*)(Aop + (16 * (tib + t) + l15) * RS + 8 * q4 + 32 * ks);
#pragma unroll
          for (int tj = 0; tj < 4; ++tj)
#pragma unroll
              for (int ks = 0; ks < 2; ++ks) bF[tj][ks] = *(const LAS bf16x8*)(Bop + (16 * tj + l15) * RS + 8 * q4 + 32 * ks);
          f32x4 acc[2][4];
#pragma unroll
          for (int t = 0; t < 2; ++t)
#pragma unroll
              for (int tj = 0; tj < 4; ++tj) { acc[t][tj] = MFMA_BF16(aF[t][0], bF[tj][0], ((f32x4){0.f, 0.f, 0.f, 0.f})); acc[t][tj] = MFMA_BF16(aF[t][1], bF[tj][1], acc[t][tj]); }
#pragma unroll
          for (int t = 0; t < 2; ++t)
#pragma unroll
              for (int tj = 0; tj < 4; ++tj)
#pragma unroll
                  for (int r = 0; r < 4; ++r) { const int i = 16 * (tib + t) + 4 * q4 + r, jj = 16 * tj + l15; const bool keep = (which & 2) ? (jj <= i) : (jj < i); acc[t][tj][r] = keep ? acc[t][tj][r] : 0.f; }
#define R1_EPI(STMT) _Pragma("unroll") for (int t = 0; t < 2; ++t) _Pragma("unroll") for (int tj = 0; tj < 4; ++tj) _Pragma("unroll") for (int r = 0; r < 4; ++r) { const int i = 16 * (tib + t) + 4 * q4 + r, jj = 16 * tj + l15; const float v = acc[t][tj][r]; STMT; }
          if (which == 0) { R1_EPI(Am[i * 68 + jj] = v) }
          else if (which == 1) { R1_EPI(Bm[i * RS + jj] = (bf16)f2bf(v)) }
          else if (which == 3) { R1_EPI(Em[i * RS + jj] = (bf16)f2bf(v)) }
          else { bf16* fm = (bf16*)(rec + 2 * 64 * RS * 2); R1_EPI(fm[i * RS + jj] = (bf16)f2bf(-v)) }
#undef R1_EPI
        }
        __syncthreads();
        { const int tj = w & 3, pb = 6 * (w >> 2);
          bf16x8 bF[2]; f32x4 acc[6];
#pragma unroll
          for (int ks = 0; ks < 2; ++ks) bF[ks] = *(const LAS bf16x8*)(vT + (16 * tj + l15) * RS + 8 * q4 + 32 * ks);
#pragma unroll
          for (int pq = 0; pq < 6; ++pq) { const int pair = pb + pq, which = pair >> 2, ti = pair & 3; const LAS bf16* aop = which == 0 ? Bm : which == 1 ? Em : khT;
              const bf16x8 a0 = *(const LAS bf16x8*)(aop + (16 * ti + l15) * RS + 8 * q4), a1 = *(const LAS bf16x8*)(aop + (16 * ti + l15) * RS + 8 * q4 + 32);
              acc[pq] = MFMA_BF16(a0, bF[0], ((f32x4){0.f, 0.f, 0.f, 0.f})); acc[pq] = MFMA_BF16(a1, bF[1], acc[pq]); }
#pragma unroll
          for (int pq = 0; pq < 6; ++pq) { const int pair = pb + pq, which = pair >> 2, ti = pair & 3;
              if (which == 0) {
#pragma unroll
                  for (int r = 0; r < 4; ++r) X[(16 * ti + 4 * q4 + r) * 132 + 64 + 16 * tj + l15] = acc[pq][r]; }
              else st_bf16x4((bf16*)(rec + RREC_COMMON + which * RREC_T) + (16 * tj + l15) * 64 + 16 * ti + 4 * q4, acc[pq]); } }
        __syncthreads();
        tri_solve64(Am, 68, X, 132, 8, X + 64 * 132, w, l15, q4);
        __syncthreads();
        { const int t = tid >> 3, j0 = 8 * (tid & 7); float v[8];
#pragma unroll
          for (int q = 0; q < 8; ++q) v[q] = X[t * 132 + j0 + q];
          *(u32x4*)((bf16*)rec + t * RS + j0) = pack8(v);
          const int vv = tid >> 3, t0 = 8 * (tid & 7);
#pragma unroll
          for (int q = 0; q < 8; ++q) v[q] = X[(t0 + q) * 132 + 64 + vv];
          *(u32x4*)((bf16*)(rec + RREC_COMMON) + vv * 64 + t0) = pack8(v); }
        for (int e = tid; e < 64 * RS / 8; e += 512) { ((u32x4*)(rec + 64 * RS * 2))[e] = ((const LAS u32x4*)rbar)[e]; ((u32x4*)(rec + 3 * 64 * RS * 2))[e] = ((const LAS u32x4*)atT)[e]; }
    }
    __syncthreads();
}
constexpr int R2_BUF = RREC_COMMON;
__device__ __forceinline__ void phase_rwkv_r2(const Frame& F, const Args& A, unsigned* flags) {
    const unsigned char* REC = WSP(unsigned char, R_REC); bf16* RO = WSP(bf16, R_O);
    LAS unsigned char* buf0 = F.lds; LAS bf16* HT = (LAS bf16*)(F.lds + 2 * R2_BUF); LAS bf16* UT = HT + 2 * 64 * RS;
    const int w = F.wave, ti = w >> 1;
    const int nunits = BH * 8;
    constexpr int NCHK = R2_BUF / 16;
    for (int unit = F.bid; unit < nunits; unit += F.G) {
        int tid = F.tid; OPAQUE_V(tid); ASSUME(tid >= 0 && tid < 512); const int lane = tid & 63, l15 = lane & 15, q4 = lane >> 4;
        const int h = unit & 7, b = unit >> 3;
        __syncthreads();
        for (int e = tid; e < 2 * 64 * RS / 2; e += 512) ((LAS unsigned*)HT)[e] = 0u;
        f32x4 Hreg[2] = {(f32x4){0.f, 0.f, 0.f, 0.f}, (f32x4){0.f, 0.f, 0.f, 0.f}};
        u32x4 preA[5], preB[5]; u32x2 iniA[3][2], iniB[3][2], cur[3][2];
        const unsigned char* rec0 = REC + (size_t)((b * 8 + h) * NCH) * RREC_BYTES;
        const int tofs = ((16 * (2 * (w & 1)) + l15) * 64 + 16 * ti + 4 * q4) * 2;
#define R2_LOAD(S, recp) do { _Pragma("unroll") for (int q = 0; q < 5; ++q) { const int e = tid + 512 * q; if (e < NCHK) pre##S[q] = *(const u32x4*)((recp) + (size_t)e * 16); } \
            _Pragma("unroll") for (int mq = 0; mq < 3; ++mq) { ini##S[mq][0] = *(const u32x2*)((recp) + RREC_COMMON + mq * RREC_T + tofs); ini##S[mq][1] = *(const u32x2*)((recp) + RREC_COMMON + mq * RREC_T + tofs + 16 * 64 * 2); } } while (0)
#define R2_STORE(S, dst) do { _Pragma("unroll") for (int q = 0; q < 5; ++q) { const int e = tid + 512 * q; if (e < NCHK) *(LAS u32x4*)((dst) + (size_t)e * 16) = pre##S[q]; } } while (0)
#define R2_TAKE(S) do { _Pragma("unroll") for (int mq = 0; mq < 3; ++mq) { cur[mq][0] = ini##S[mq][0]; cur[mq][1] = ini##S[mq][1]; } } while (0)
        R2_LOAD(A, rec0); R2_STORE(A, buf0); R2_TAKE(A);
        if (NCH > 1) R2_LOAD(A, rec0 + (size_t)RREC_BYTES);
        __syncthreads();
#define R2_STEP(c, LS, SS) do { \
            LAS unsigned char* buf = buf0 + ((c) & 1) * R2_BUF; LAS unsigned char* nbuf = buf0 + (((c) + 1) & 1) * R2_BUF; \
            if ((c) + 2 < NCH) R2_LOAD(LS, rec0 + (size_t)((c) + 2) * RREC_BYTES); \
            const LAS bf16* KB = (const LAS bf16*)buf; const LAS bf16* RB = KB + 64 * RS; const LAS bf16* FMn = RB + 64 * RS; const LAS bf16* ATn = FMn + 64 * RS; \
            const LAS float* GC = (const LAS float*)(buf + 4 * 64 * RS * 2); \
            const LAS bf16* H0 = HT + ((c) & 1) * 64 * RS; LAS bf16* H1 = HT + (((c) + 1) & 1) * 64 * RS; \
              \
            bf16x8 hf[2][2], uf[2][2], af[2]; \
            _Pragma("unroll") for (int t2 = 0; t2 < 2; ++t2) _Pragma("unroll") for (int ks = 0; ks < 2; ++ks) hf[t2][ks] = *(const LAS bf16x8*)(H0 + (16 * (2 * (w & 1) + t2) + l15) * RS + 8 * q4 + 32 * ks); \
            _Pragma("unroll") for (int ks = 0; ks < 2; ++ks) af[ks] = *(const LAS bf16x8*)(KB + (16 * ti + l15) * RS + 8 * q4 + 32 * ks); \
            _Pragma("unroll") for (int t2 = 0; t2 < 2; ++t2) { const int tj = 2 * (w & 1) + t2; \
                f32x4 u = (f32x4){bf2f(cur[0][t2].x & 0xffffu), bf2f(cur[0][t2].x >> 16), bf2f(cur[0][t2].y & 0xffffu), bf2f(cur[0][t2].y >> 16)}; \
                u = MFMA_BF16(af[0], hf[t2][0], u); u = MFMA_BF16(af[1], hf[t2][1], u); \
                u32x2 pk; pk.x = pk2(u[0], u[1]); pk.y = pk2(u[2], u[3]); *(LAS u32x2*)(UT + (16 * tj + l15) * RS + 16 * ti + 4 * q4) = pk; } \
            __syncthreads(); \
            _Pragma("unroll") for (int t2 = 0; t2 < 2; ++t2) _Pragma("unroll") for (int ks = 0; ks < 2; ++ks) uf[t2][ks] = *(const LAS bf16x8*)(UT + (16 * (2 * (w & 1) + t2) + l15) * RS + 8 * q4 + 32 * ks); \
            { bf16x8 rf[2], ff[2], tf[2]; \
              _Pragma("unroll") for (int ks = 0; ks < 2; ++ks) { rf[ks] = *(const LAS bf16x8*)(RB + (16 * ti + l15) * RS + 8 * q4 + 32 * ks); ff[ks] = *(const LAS bf16x8*)(FMn + (16 * ti + l15) * RS + 8 * q4 + 32 * ks); tf[ks] = *(const LAS bf16x8*)(ATn + (16 * ti + l15) * RS + 8 * q4 + 32 * ks); } \
              _Pragma("unroll") for (int t2 = 0; t2 < 2; ++t2) { const int tj = 2 * (w & 1) + t2; \
                f32x4 o = (f32x4){bf2f(cur[1][t2].x & 0xffffu), bf2f(cur[1][t2].x >> 16), bf2f(cur[1][t2].y & 0xffffu), bf2f(cur[1][t2].y >> 16)}; \
                o = MFMA_BF16(rf[0], hf[t2][0], o); o = MFMA_BF16(rf[1], hf[t2][1], o); o = MFMA_BF16(ff[0], uf[t2][0], o); o = MFMA_BF16(ff[1], uf[t2][1], o); \
                _Pragma("unroll") for (int r = 0; r < 4; ++r) RO[((size_t)b * SEQ + (size_t)(c) * 64 + 16 * ti + 4 * q4 + r) * 512 + h * 64 + 16 * tj + l15] = (bf16)f2bf(o[r]); \
                const f32x4 kv = (f32x4){bf2f(cur[2][t2].x & 0xffffu), bf2f(cur[2][t2].x >> 16), bf2f(cur[2][t2].y & 0xffffu), bf2f(cur[2][t2].y >> 16)}; \
                _Pragma("unroll") for (int r = 0; r < 4; ++r) Hreg[t2][r] = Hreg[t2][r] * GC[16 * ti + 4 * q4 + r] + kv[r]; \
                Hreg[t2] = MFMA_BF16(tf[0], uf[t2][0], Hreg[t2]); Hreg[t2] = MFMA_BF16(tf[1], uf[t2][1], Hreg[t2]); \
                u32x2 pk; pk.x = pk2(Hreg[t2][0], Hreg[t2][1]); pk.y = pk2(Hreg[t2][2], Hreg[t2][3]); *(LAS u32x2*)(H1 + (16 * tj + l15) * RS + 16 * ti + 4 * q4) = pk; } } \
            if ((c) + 1 < NCH) { R2_STORE(SS, nbuf); R2_TAKE(SS); } \
            __syncthreads(); } while (0)
        for (int c = 0; c < NCH; c += 2) { R2_STEP(c, B, A); R2_STEP(c + 1, A, B); }
        if (tid == 0) FLAG_SET(flags + unit);
#undef R2_STEP
#undef R2_STORE
#undef R2_TAKE
#undef R2_LOAD
    }
    __syncthreads();
}
__device__ __forceinline__ void phase_rwkv_post_queue(const Frame& F, const Args& A, int layer, unsigned* flags, unsigned* queue) {
    const bf16* RKV = WSP(bf16, R_RKV); const bf16* LAG = (const bf16*)(WSP(float, R_LOUT) + (size_t)TH * 512); const bf16* RO = WSP(bf16, R_O); bf16* Y = WSP(bf16, A_Y) + (size_t)1 * TH * 512;
    LAS unsigned* slot = (LAS unsigned*)(F.lds + PQ_SLOT_OFF);
    const int tid = F.tid, lane = F.lane, w = F.wave, tl = lane >> 3, nitems = BH * 8 * (SEQ / 256);
    for (;;) {
        __syncthreads();
        if (tid == 0) *slot = ATOMIC_ADD_U32(queue, 1u);
        __syncthreads();
        const int item = RFL((int)*slot);
        if (item >= nitems) break;
        const int unit = item / (SEQ / 256), blk = item % (SEQ / 256), h = unit & 7, b = unit >> 3;
        if (tid == 0) FLAG_WAIT(flags + unit);
        __syncthreads();
        const int c0 = h * 64 + 8 * (lane & 7);
        float pa0[8], pka[8], prk[8], plw[8], plb[8];
        { const float* a0 = AIN(A, 11) + layer * 512 + c0; const float* k_a = AIN(A, 15) + layer * 512 + c0; const float* r_k = AIN(A, 16) + layer * 512 + c0; const float* ln_w = AIN(A, 17) + layer * 512 + c0; const float* ln_b = AIN(A, 18) + layer * 512 + c0;
#pragma unroll
          for (int q = 0; q < 8; ++q) { pa0[q] = a0[q]; pka[q] = k_a[q]; prk[q] = r_k[q]; plw[q] = ln_w[q]; plb[q] = ln_b[q]; } }
#pragma unroll 2
        for (int it = 0; it < 4; ++it) { const size_t m = (size_t)b * SEQ + 256 * blk + 32 * w + 8 * it + tl;
            float o[8], r[8], k[8], v[8], ap[8], g[8];
            { const f32x4 a = ld_bf16x4(RO + m * 512 + c0), b2 = ld_bf16x4(RO + m * 512 + c0 + 4); o[0] = a.x; o[1] = a.y; o[2] = a.z; o[3] = a.w; o[4] = b2.x; o[5] = b2.y; o[6] = b2.z; o[7] = b2.w; }
#pragma unroll
            for (int hh = 0; hh < 2; ++hh) { const f32x4 rv = ld_bf16x4(RKV + m * 1536 + c0 + 4 * hh), kv = ld_bf16x4(RKV + m * 1536 + 512 + c0 + 4 * hh), vv = ld_bf16x4(RKV + m * 1536 + 1024 + c0 + 4 * hh);
                const f32x4 av = ld_bf16x4(LAG + m * 1024 + c0 + 4 * hh), gv = ld_bf16x4(LAG + m * 1024 + 512 + c0 + 4 * hh);
#pragma unroll
                for (int q = 0; q < 4; ++q) { r[4 * hh + q] = rv[q]; k[4 * hh + q] = kv[q]; v[4 * hh + q] = vv[q]; ap[4 * hh + q] = av[q]; g[4 * hh + q] = gv[q]; } }
            float bon = 0.f, sm = 0.f;
#pragma unroll
            for (int q = 0; q < 8; ++q) { const float a = sigmoidf_(pa0[q] + ap[q]); const float km = k[q] * (1.0f + (a - 1.0f) * pka[q]); bon += r[q] * km * prk[q]; sm += o[q]; }
            bon = red_sum<8>(bon); sm = red_sum<8>(sm);
            const float mean = sm * (1.0f / 64.0f); float vs = 0.f;
#pragma unroll
            for (int q = 0; q < 8; ++q) { const float d = o[q] - mean; vs += d * d; }
            vs = red_sum<8>(vs);
            const float rstd = RSQRT(vs * (1.0f / 64.0f) + 64e-5f);
            float y[8];
#pragma unroll
            for (int q = 0; q < 8; ++q) y[q] = ((o[q] - mean) * rstd * plw[q] + plb[q] + bon * v[q]) * g[q];
            u32x4 wv; wv.x = pk2(y[0], y[1]); wv.y = pk2(y[2], y[3]); wv.z = pk2(y[4], y[5]); wv.w = pk2(y[6], y[7]);
            *(u32x4*)(Y + m * 512 + c0) = wv; }
    }
    __syncthreads();
}

__device__ __forceinline__ void conv8x8(const bf16* src, int tl0  , const float* w  , int wld, const float* bias, float (&out)[8][8]) {
    float x[11][8];
#pragma unroll
    for (int i = 0; i < 11; ++i) { const int tl = tl0 - 3 + i;
        if (tl >= 0) { const u32x4 v = *(const u32x4*)(src + (ptrdiff_t)(i - 3) * PW);
            x[i][0] = bf2f(v.x & 0xffffu); x[i][1] = bf2f(v.x >> 16); x[i][2] = bf2f(v.y & 0xffffu); x[i][3] = bf2f(v.y >> 16); x[i][4] = bf2f(v.z & 0xffffu); x[i][5] = bf2f(v.z >> 16); x[i][6] = bf2f(v.w & 0xffffu); x[i][7] = bf2f(v.w >> 16); }
        else {
#pragma unroll
            for (int ch = 0; ch < 8; ++ch) x[i][ch] = 0.f; } }
    float wv[4][8], bv[8];
#pragma unroll
    for (int j = 0; j < 4; ++j) { const f32x4 a = *(const f32x4*)(w + j * wld), b = *(const f32x4*)(w + j * wld + 4); wv[j][0] = a.x; wv[j][1] = a.y; wv[j][2] = a.z; wv[j][3] = a.w; wv[j][4] = b.x; wv[j][5] = b.y; wv[j][6] = b.z; wv[j][7] = b.w; }
    if (bias) { const f32x4 a = *(const f32x4*)bias, b = *(const f32x4*)(bias + 4); bv[0] = a.x; bv[1] = a.y; bv[2] = a.z; bv[3] = a.w; bv[4] = b.x; bv[5] = b.y; bv[6] = b.z; bv[7] = b.w; }
    else {
#pragma unroll
        for (int ch = 0; ch < 8; ++ch) bv[ch] = 0.f; }
#pragma unroll
    for (int i = 0; i < 8; ++i)
#pragma unroll
        for (int ch = 0; ch < 8; ++ch) { const float a = bv[ch] + wv[0][ch] * x[i][ch] + wv[1][ch] * x[i + 1][ch] + wv[2][ch] * x[i + 2][ch] + wv[3][ch] * x[i + 3][ch]; out[i][ch] = a * fast_rcp(1.0f + fast_exp(-a)); }
}
constexpr int SB = 136;
constexpr int SC_IMG = 64 * SB * 2;
__device__ __forceinline__ void phase_ssd_s1(const Frame& F, const Args& A, int layer) {
    const bf16* P = WSP(bf16, A_P); bf16* ST = WSP(bf16, S_ST); bf16* YD = WSP(bf16, S_YD); unsigned char* SCB = WSP(unsigned char, S_C); float* AC = WSP(float, S_AC);
    const float* cw = AIN(A, 23) + (size_t)layer * 4 * 1024; const float* cb = AIN(A, 24) + layer * 1024; const float* dtb = AIN(A, 25) + layer * 8; const float* a_log = AIN(A, 26) + layer * 8; const float* dsk = AIN(A, 27) + layer * 8;
    LAS bf16* Bt_ = (LAS bf16*)F.lds; LAS bf16* Ct_ = Bt_ + 64 * SB; LAS bf16* BT = Ct_ + 64 * SB; LAS bf16* xT = BT + 128 * RS;
    LAS bf16* Mb = xT + 4 * 64 * RS; LAS bf16* xdT = Mb + 2 * 64 * RS; LAS float* dt = (LAS float*)(xdT + 2 * 64 * RS); LAS float* ac = dt + 256;
    const int w = F.wave;
    const int nunits = BH * NCH * 2;
    for (int unit = F.bid; unit < nunits; unit += F.G) {
        int tid = F.tid; OPAQUE_V(tid); ASSUME(tid >= 0 && tid < 512); const int lane = tid & 63, l15 = lane & 15, q4 = lane >> 4;
        const int g = unit & 1, c = (unit >> 1) % NCH, b = unit / (2 * NCH);
        const size_t tok0 = (size_t)b * SEQ + (size_t)c * 64;
        __syncthreads();
        {
            const int cg = tid & 63, rb = tid >> 6;
            const int cidx = cg < 32 ? g * 256 + 8 * cg : cg < 48 ? 512 + g * 128 + 8 * (cg - 32) : 768 + g * 128 + 8 * (cg - 48);
            float o[8][8];
            conv8x8(P + (tok0 + 8 * rb) * PW + C_SSD + 512 + cidx, c * 64 + 8 * rb, cw + cidx, 1024, cb + cidx, o);
            if (cg < 32) {
                const int hh = cg >> 3, p0 = 8 * (cg & 7);
#pragma unroll
                for (int ch = 0; ch < 8; ++ch) { float col[8];
#pragma unroll
                    for (int i = 0; i < 8; ++i) col[i] = o[i][ch];
                    *(LAS u32x4*)(xT + (hh * 64 + p0 + ch) * RS + 8 * rb) = pack8(col); }
            } else if (cg < 48) {
                const int n0 = 8 * (cg - 32);
#pragma unroll
                for (int i = 0; i < 8; ++i) *(LAS u32x4*)(Bt_ + (8 * rb + i) * SB + n0) = pack8(o[i]);
#pragma unroll
                for (int ch = 0; ch < 8; ++ch) { float col[8];
#pragma unroll
                    for (int i = 0; i < 8; ++i) col[i] = o[i][ch];
                    *(LAS u32x4*)(BT + (n0 + ch) * RS + 8 * rb) = pack8(col); }
            } else { const int n0 = 8 * (cg - 48);
#pragma unroll
                for (int i = 0; i < 8; ++i) *(LAS u32x4*)(Ct_ + (8 * rb + i) * SB + n0) = pack8(o[i]); }
        }
        if (tid < 256) { const int hh = tid >> 6, h = 4 * g + hh; const float d = softplusf_(bf2f(P[(tok0 + lane) * PW + C_SSD + 1536 + h]) + dtb[h]); float a = -expf(a_log[h]) * d;
#pragma unroll
            for (int o = 1; o < 64; o <<= 1) { const float t = __shfl_up(a, o); if (lane >= o) a += t; }
            dt[tid] = d; ac[tid] = a; AC[(tok0 + lane) * 8 + h] = a; }
        __syncthreads();
        { unsigned char* dst = SCB + (size_t)unit * SC_IMG; for (int e = tid; e < SC_IMG / 16; e += 512) ((u32x4*)dst)[e] = ((const LAS u32x4*)Ct_)[e]; }
        f32x4 cbt[2];
#pragma unroll
        for (int tt = 0; tt < 2; ++tt) { const int tile = w * 2 + tt, ti = tile >> 2, tj = tile & 3; cbt[tt] = (f32x4){0.f, 0.f, 0.f, 0.f};
            if (tj <= ti) cbt[tt] = tile_bf(Ct_ + 16 * ti * SB, SB, Bt_ + 16 * tj * SB, SB, 128, cbt[tt], l15, q4); }
        for (int hh = 0; hh < 4; ++hh) { const int h = 4 * g + hh; LAS bf16* M = Mb + (hh & 1) * 64 * RS; LAS bf16* xd = xdT + (hh & 1) * 64 * RS; const LAS float* dth = dt + hh * 64; const LAS float* ach = ac + hh * 64;
#pragma unroll
            for (int tt = 0; tt < 2; ++tt) { const int tile = w * 2 + tt, ti = tile >> 2, tj = tile & 3;
#pragma unroll
                for (int r = 0; r < 4; ++r) { const int l = 16 * ti + 4 * q4 + r, s = 16 * tj + l15; M[l * RS + s] = (bf16)f2bf((s <= l) ? cbt[tt][r] * expf(ach[l] - ach[s]) * dth[s] : 0.f); } }
            { const int p = tid >> 3, l0 = 8 * (tid & 7); const u32x4 v = *(const LAS u32x4*)(xT + (hh * 64 + p) * RS + l0); const float a63 = ach[63]; float xv[8] = {bf2f(v.x & 0xffffu), bf2f(v.x >> 16), bf2f(v.y & 0xffffu), bf2f(v.y >> 16), bf2f(v.z & 0xffffu), bf2f(v.z >> 16), bf2f(v.w & 0xffffu), bf2f(v.w >> 16)};
#pragma unroll
              for (int i = 0; i < 8; ++i) xv[i] *= dth[l0 + i] * expf(a63 - ach[l0 + i]);
              *(LAS u32x4*)(xd + p * RS + l0) = pack8(xv); }
            __syncthreads();
#pragma unroll
            for (int tt = 0; tt < 2; ++tt) { const int tile = w * 2 + tt, ti = tile >> 2, tj = tile & 3;
                const f32x4 acc = tile_bf(M + 16 * ti * RS, RS, xT + (hh * 64 + 16 * tj) * RS, RS, 64, (f32x4){0.f, 0.f, 0.f, 0.f}, l15, q4);
                const f32x4 xs = ld_bf16x4((const bf16*)(xT + (hh * 64 + 16 * tj + l15) * RS + 16 * ti + 4 * q4));
#pragma unroll
                for (int r = 0; r < 4; ++r) YD[(tok0 + 16 * ti + 4 * q4 + r) * 512 + h * 64 + 16 * tj + l15] = (bf16)f2bf(acc[r] + dsk[h] * xs[r]); }
            bf16* st = ST + ((size_t)((b * NCH + c) * 8 + h)) * 64 * 128;
#pragma unroll
            for (int tt = 0; tt < 4; ++tt) { const int tile = w * 4 + tt, ti = tile >> 2, tj = tile & 3;
                const f32x4 acc = tile_bf(BT + 16 * ti * RS, RS, xd + 16 * tj * RS, RS, 64, (f32x4){0.f, 0.f, 0.f, 0.f}, l15, q4);
                st_bf16x4(st + (16 * tj + l15) * 128 + 16 * ti + 4 * q4, acc); }
        }
    }
    __syncthreads();
}
__device__ __forceinline__ void phase_ssd_s23(const Frame& F, const Args& A) {
    const bf16* ST = WSP(bf16, S_ST); bf16* YO = WSP(bf16, S_YO); const unsigned char* SCB = WSP(unsigned char, S_C); const float* AC = WSP(float, S_AC);
    LAS bf16* Cimg = (LAS bf16*)F.lds; LAS bf16* Hb = Cimg + 2 * 64 * SB;
    const int w = F.wave;
    const int nunits = BH * 8 * 4;
    constexpr int NCK = SC_IMG / 16;
    for (int unit = F.bid; unit < nunits; unit += F.G) {
        int tid = F.tid; OPAQUE_V(tid); ASSUME(tid >= 0 && tid < 512); const int lane = tid & 63, l15 = lane & 15, q4 = lane >> 4, hp = tid >> 5, hn = 4 * (tid & 31);
        const int ps = unit & 3, h = (unit >> 2) & 7, b = unit >> 5, g = h >> 2;
        __syncthreads();
        f32x4 Hr = (f32x4){0.f, 0.f, 0.f, 0.f};
        u32x4 preA[3], preB[3]; u32x2 pstA, pstB, stc; float eaA[5], eaB[5], eac[5];
        const size_t tokb = (size_t)b * SEQ;
#define S23_LOAD(S, cc) do { const unsigned char* src_ = SCB + (size_t)((b * NCH + (cc)) * 2 + g) * SC_IMG; \
            _Pragma("unroll") for (int q = 0; q < 3; ++q) { const int e = tid + 512 * q; if (e < NCK) pre##S[q] = *(const u32x4*)(src_ + (size_t)e * 16); } \
            pst##S = *(const u32x2*)(ST + ((size_t)((b * NCH + (cc)) * 8 + h)) * 8192 + (16 * ps + hp) * 128 + hn); \
            _Pragma("unroll") for (int r = 0; r < 4; ++r) ea##S[r] = AC[(tokb + (size_t)(cc) * 64 + 16 * (w & 3) + 4 * q4 + r) * 8 + h]; \
            ea##S[4] = AC[(tokb + (size_t)(cc) * 64 + 63) * 8 + h]; } while (0)
#define S23_STORE(S, dst) do { _Pragma("unroll") for (int q = 0; q < 3; ++q) { const int e = tid + 512 * q; if (e < NCK) ((LAS u32x4*)(dst))[e] = pre##S[q]; } } while (0)
#define S23_TAKE(S) do { stc = pst##S; _Pragma("unroll") for (int r = 0; r < 5; ++r) eac[r] = ea##S[r]; } while (0)
        S23_LOAD(A, 0); S23_STORE(A, Cimg); S23_TAKE(A);
        if (NCH > 1) S23_LOAD(A, 1);
#define S23_STEP(c, LS, SS) do { \
            const size_t tok0 = tokb + (size_t)(c) * 64; \
            if ((c) + 2 < NCH) S23_LOAD(LS, (c) + 2); \
            st_bf16x4((bf16*)(Hb + hp * SB + hn), Hr); \
            __syncthreads(); \
            if (w < 4) { const LAS bf16* Ci = Cimg + ((c) & 1) * 64 * SB; \
                const f32x4 acc = tile_bf(Ci + 16 * w * SB, SB, Hb, SB, 128, (f32x4){0.f, 0.f, 0.f, 0.f}, l15, q4); \
                _Pragma("unroll") for (int r = 0; r < 4; ++r) { const size_t tok = tok0 + 16 * w + 4 * q4 + r; YO[tok * 512 + h * 64 + 16 * ps + l15] = (bf16)f2bf(acc[r] * expf(eac[r])); } } \
            { const float dec = expf(eac[4]); Hr.x = dec * Hr.x + bf2f(stc.x & 0xffffu); Hr.y = dec * Hr.y + bf2f(stc.x >> 16); Hr.z = dec * Hr.z + bf2f(stc.y & 0xffffu); Hr.w = dec * Hr.w + bf2f(stc.y >> 16); } \
            if ((c) + 1 < NCH) { S23_STORE(SS, Cimg + (((c) + 1) & 1) * 64 * SB); S23_TAKE(SS); } \
            __syncthreads(); } while (0)
        for (int c = 0; c < NCH; c += 2) { S23_STEP(c, B, A); S23_STEP(c + 1, A, B); }
#undef S23_STEP
#undef S23_TAKE
#undef S23_STORE
#undef S23_LOAD
    }
    __syncthreads();
}
__device__ __forceinline__ void phase_ssd_s4(const Frame& F, const Args& A, int layer) {
    const bf16* YD = WSP(bf16, S_YD); const bf16* YO = WSP(bf16, S_YO); const bf16* P = WSP(bf16, A_P); bf16* Y = WSP(bf16, A_Y) + (size_t)3 * TH * 512; const float* nw = AIN(A, 28) + layer * 512;
    const int lane = F.lane, c0 = 8 * lane;
    for (int m = F.gw; m < TH; m += F.NGW) {
        const f32x4 a = ld_bf16x4(YD + (size_t)m * 512 + c0) + ld_bf16x4(YO + (size_t)m * 512 + c0), b2 = ld_bf16x4(YD + (size_t)m * 512 + c0 + 4) + ld_bf16x4(YO + (size_t)m * 512 + c0 + 4);
        const f32x4 z0 = ld_bf16x4(P + (size_t)m * PW + C_SSD + c0), z1 = ld_bf16x4(P + (size_t)m * PW + C_SSD + c0 + 4);
        float y[8] = {a.x * siluf_(z0.x), a.y * siluf_(z0.y), a.z * siluf_(z0.z), a.w * siluf_(z0.w), b2.x * siluf_(z1.x), b2.y * siluf_(z1.y), b2.z * siluf_(z1.z), b2.w * siluf_(z1.w)};
        float ss = 0.f;
#pragma unroll
        for (int q = 0; q < 8; ++q) ss += y[q] * y[q];
        ss = red_sum<32>(ss);
        const float rstd = RSQRT(ss * (1.0f / 256.0f) + EPS);
#pragma unroll
        for (int q = 0; q < 8; ++q) y[q] = y[q] * rstd * nw[c0 + q];
        u32x4 wv; wv.x = pk2(y[0], y[1]); wv.y = pk2(y[2], y[3]); wv.z = pk2(y[4], y[5]); wv.w = pk2(y[6], y[7]);
        *(u32x4*)(Y + (size_t)m * 512 + c0) = wv;
    }
}

__device__ __forceinline__ f32x4 tile_mm(const LAS float* a, int lda, int ska, const LAS float* b, int ldb, int scb, int K, f32x4 acc, int l15, int q4) {
    const LAS float* ap = a + l15 * lda + q4 * ska; const LAS float* bp = b + q4 * ldb + l15 * scb;
#pragma unroll 8
    for (int ks = 0; ks < K / 4; ++ks) acc = MFMA_F32(ap[ks * 4 * ska], bp[ks * 4 * ldb], acc);
    return acc;
}
constexpr int GS = 132, GS2 = 68;
constexpr int GR_W = 0, GR_QH = 64 * 136 * 2, GR_KT = 2 * 64 * 136 * 2, GR_QK = GR_KT + 128 * 72 * 2, GR_GL = GR_QK + 64 * 72 * 2, GR_COMMON = GR_GL + 16, GR_UT = 128 * 64 * 2, GR_BYTES = GR_COMMON + GR_UT;
static_assert(GR_BYTES == 78864 && GR_COMMON % 16 == 0, "GDN record");
constexpr int GX = 264;
__device__ __forceinline__ void phase_gdn_g1(const Frame& F, const Args& A, int layer) {
    const bf16* P = WSP(bf16, A_P); unsigned char* CHR = WSP(unsigned char, G_CH);
    const float* convw = AIN(A, 19) + (size_t)layer * 4 * 1536; const float* a_log = AIN(A, 20) + layer * 4; const float* dtb = AIN(A, 21) + layer * 4;
    LAS bf16* qb = (LAS bf16*)F.lds; LAS bf16* kb = qb + 64 * SB; LAS bf16* qkimg = kb + 64 * SB;
    LAS float* X = (LAS float*)(qkimg + 64 * RS); LAS float* Lm = X + 64 * GX; LAS float* ssq = Lm + 64 * GS2;
    LAS float* beta = ssq + 2 * 64 * 16; LAS float* gc = beta + 64; LAS float* egc = gc + 64; LAS float* inorm = egc + 64;
    const int w = F.wave;
    const int nunits = BH * 4 * NCH;
    for (int unit = F.bid; unit < nunits; unit += F.G) {
        int tid = F.tid; OPAQUE_V(tid); ASSUME(tid >= 0 && tid < 512); const int lane = tid & 63, l15 = lane & 15, q4 = lane >> 4;
        const int c = unit % NCH, h = (unit / NCH) & 3, b = unit / (NCH * 4);
        const size_t tok0 = (size_t)b * SEQ + (size_t)c * 64;
        unsigned char* rec = CHR + (size_t)unit * GR_BYTES;
        __syncthreads();
        const int rb = tid / 48, pc = tid % 48, part = pc >> 4, cgl = pc & 15;
        float o[8][8];
        if (tid < 384) { const int col = part * 512 + h * 128 + 8 * cgl;
            conv8x8(P + (tok0 + 8 * rb) * PW + C_GDN + col, c * 64 + 8 * rb, convw + col, 1536, nullptr, o);
            if (part < 2) {
#pragma unroll
                for (int i = 0; i < 8; ++i) { float sacc = 0.f;
#pragma unroll
                    for (int ch = 0; ch < 8; ++ch) sacc += o[i][ch] * o[i][ch];
                    ssq[(part * 64 + 8 * rb + i) * 16 + cgl] = sacc; } } }
        if (w == 7) { const size_t tok = tok0 + lane; beta[lane] = sigmoidf_(bf2f(P[tok * PW + C_GDN + 1536 + h]));
            float g = -expf(a_log[h]) * softplusf_(bf2f(P[tok * PW + C_GDN + 1540 + h]) + dtb[h]);
#pragma unroll
            for (int o2 = 1; o2 < 64; o2 <<= 1) { const float t = __shfl_up(g, o2); if (lane >= o2) g += t; }
            gc[lane] = g; egc[lane] = expf(g); }
        __syncthreads();
        if (tid < 128) { float sacc = 0.f;
#pragma unroll
            for (int i = 0; i < 16; ++i) sacc += ssq[tid * 16 + i];
            inorm[tid] = (tid < 64 ? 0.08838834764831845f : 1.0f) * RSQRT(sacc + EPS); }
        __syncthreads();
        if (tid < 384) {
#pragma unroll
            for (int i = 0; i < 8; ++i) { const int l = 8 * rb + i;
                if (part < 2) { const float sc = inorm[part * 64 + l]; float v[8];
#pragma unroll
                    for (int ch = 0; ch < 8; ++ch) v[ch] = o[i][ch] * sc;
                    *(LAS u32x4*)((part ? kb : qb) + l * SB + 8 * cgl) = pack8(v); }
                else { const float bl = beta[l]; *(LAS f32x4*)(X + l * GX + 8 * cgl) = (f32x4){o[i][0] * bl, o[i][1] * bl, o[i][2] * bl, o[i][3] * bl}; *(LAS f32x4*)(X + l * GX + 8 * cgl + 4) = (f32x4){o[i][4] * bl, o[i][5] * bl, o[i][6] * bl, o[i][7] * bl}; } } }
        __syncthreads();
        { const int which = w >> 2, ti = w & 3; const LAS bf16* Aop = which ? qb : kb;
          bf16x8 aF[4]; f32x4 acc[4];
#pragma unroll
          for (int ks = 0; ks < 4; ++ks) aF[ks] = *(const LAS bf16x8*)(Aop + (16 * ti + l15) * SB + 8 * q4 + 32 * ks);
#pragma unroll
          for (int tj = 0; tj < 4; ++tj) { acc[tj] = (f32x4){0.f, 0.f, 0.f, 0.f};
#pragma unroll
              for (int ks = 0; ks < 4; ++ks) acc[tj] = MFMA_BF16(aF[ks], *(const LAS bf16x8*)(kb + (16 * tj + l15) * SB + 8 * q4 + 32 * ks), acc[tj]); }
          if (which) {
#pragma unroll
              for (int tj = 0; tj < 4; ++tj)
#pragma unroll
                  for (int r = 0; r < 4; ++r) { const int i = 16 * ti + 4 * q4 + r, j = 16 * tj + l15; const float v = (j <= i) ? acc[tj][r] * expf(gc[i] - gc[j]) : 0.f; qkimg[i * RS + j] = (bf16)f2bf(v); }
          } else {
#pragma unroll
              for (int tj = 0; tj < 4; ++tj)
#pragma unroll
                  for (int r = 0; r < 4; ++r) { const int i = 16 * ti + 4 * q4 + r, j = 16 * tj + l15; const float v = (j < i) ? acc[tj][r] * expf(gc[i] - gc[j]) * beta[i] : 0.f; Lm[i * GS2 + j] = v; }
          } }
        { const float glast = gc[63];
          for (int e = tid; e < 64 * 16; e += 512) { const int l = e >> 4, d0 = 8 * (e & 15); const u32x4 kv = *(const LAS u32x4*)(kb + l * SB + d0), qv = *(const LAS u32x4*)(qb + l * SB + d0);
              const float kf[8] = {bf2f(kv.x & 0xffffu), bf2f(kv.x >> 16), bf2f(kv.y & 0xffffu), bf2f(kv.y >> 16), bf2f(kv.z & 0xffffu), bf2f(kv.z >> 16), bf2f(kv.w & 0xffffu), bf2f(kv.w >> 16)};
              float qf[8] = {bf2f(qv.x & 0xffffu), bf2f(qv.x >> 16), bf2f(qv.y & 0xffffu), bf2f(qv.y >> 16), bf2f(qv.z & 0xffffu), bf2f(qv.z >> 16), bf2f(qv.w & 0xffffu), bf2f(qv.w >> 16)};
              const float sc = beta[l] * egc[l], eg = egc[l];
              *(LAS f32x4*)(X + l * GX + 128 + d0) = (f32x4){kf[0] * sc, kf[1] * sc, kf[2] * sc, kf[3] * sc}; *(LAS f32x4*)(X + l * GX + 132 + d0) = (f32x4){kf[4] * sc, kf[5] * sc, kf[6] * sc, kf[7] * sc};
#pragma unroll
              for (int q = 0; q < 8; ++q) qf[q] *= eg;
              *(u32x4*)(rec + GR_QH + (size_t)(l * SB + d0) * 2) = pack8(qf); }
          for (int e = tid; e < 128 * 8; e += 512) { const int d = e >> 3, l0 = 8 * (e & 7); float kt[8];
#pragma unroll
              for (int q = 0; q < 8; ++q) kt[q] = bf2f(kb[(l0 + q) * SB + d]) * expf(glast - gc[l0 + q]);
              *(u32x4*)(rec + GR_KT + (size_t)(d * RS + l0) * 2) = pack8(kt); }
          if (tid == 0) *(float*)(rec + GR_GL) = expf(glast); }
        __syncthreads();
        for (int e = tid; e < 64 * RS / 8; e += 512) ((u32x4*)(rec + GR_QK))[e] = ((const LAS u32x4*)qkimg)[e];
        tri_solve64(Lm, GS2, X, GX, 16, ssq, w, l15, q4);
        __syncthreads();
        for (int e = tid; e < 64 * 16; e += 512) { const int l = e >> 4, d0 = 8 * (e & 15); const f32x4 a = *(const LAS f32x4*)(X + l * GX + 128 + d0), b2 = *(const LAS f32x4*)(X + l * GX + 132 + d0);
            const float v[8] = {a.x, a.y, a.z, a.w, b2.x, b2.y, b2.z, b2.w}; *(u32x4*)(rec + GR_W + (size_t)(l * SB + d0) * 2) = pack8(v); }
        for (int e = tid; e < 128 * 8; e += 512) { const int vv = e >> 3, t0 = 8 * (e & 7); float v[8];
#pragma unroll
            for (int q = 0; q < 8; ++q) v[q] = X[(t0 + q) * GX + vv];
            *(u32x4*)((bf16*)(rec + GR_COMMON) + vv * 64 + t0) = pack8(v); }
    }
    __syncthreads();
}
constexpr int G2_STAGE = GR_COMMON;
__device__ __forceinline__ void phase_gdn_g2(const Frame& F, const Args& A) {
    const unsigned char* CHR = WSP(unsigned char, G_CH); bf16* GO = WSP(bf16, G_O);
    LAS unsigned char* buf0 = F.lds; LAS bf16* STt = (LAS bf16*)(F.lds + 2 * G2_STAGE); LAS bf16* vnT = STt + 2 * 32 * SB;
    const int w = F.wave, ti = w >> 1, tj = w & 1;
    const int nunits = BH * 4 * 4;
    constexpr int NCK = G2_STAGE / 16;
    for (int unit = F.bid; unit < nunits; unit += F.G) {
        int tid = F.tid; OPAQUE_V(tid); ASSUME(tid >= 0 && tid < 512); const int lane = tid & 63, l15 = lane & 15, q4 = lane >> 4;
        const int vs = unit & 3, h = (unit >> 2) & 3, b = unit >> 4;
        __syncthreads();
        for (int e = tid; e < 2 * 32 * SB / 2; e += 512) ((LAS unsigned*)STt)[e] = 0u;
        f32x4 Sreg[2] = {(f32x4){0.f, 0.f, 0.f, 0.f}, (f32x4){0.f, 0.f, 0.f, 0.f}};
        u32x4 preA[8], preB[8]; u32x2 uiniA, uiniB, ucur;
        const unsigned char* rec0 = CHR + (size_t)((b * 4 + h) * NCH) * GR_BYTES;
        const int uofs = GR_COMMON + ((32 * vs + 16 * tj + l15) * 64 + 16 * ti + 4 * q4) * 2;
#define G2_LOAD(S, recp) do { _Pragma("unroll") for (int q = 0; q < 8; ++q) { const int e = tid + 512 * q; if (e < NCK) pre##S[q] = *(const u32x4*)((recp) + (size_t)e * 16); } uini##S = *(const u32x2*)((recp) + uofs); } while (0)
#define G2_STORE(S, dst) do { _Pragma("unroll") for (int q = 0; q < 8; ++q) { const int e = tid + 512 * q; if (e < NCK) *(LAS u32x4*)((dst) + (size_t)e * 16) = pre##S[q]; } } while (0)
        G2_LOAD(A, rec0); G2_STORE(A, buf0); ucur = uiniA;
        if (NCH > 1) G2_LOAD(A, rec0 + (size_t)GR_BYTES);
        __syncthreads();
#define G2_STEP(c, LS, SS) do { \
            LAS unsigned char* buf = buf0 + ((c) & 1) * G2_STAGE; LAS unsigned char* nbuf = buf0 + (((c) + 1) & 1) * G2_STAGE; \
            if ((c) + 2 < NCH) G2_LOAD(LS, rec0 + (size_t)((c) + 2) * GR_BYTES); \
            const LAS bf16* Wi = (const LAS bf16*)(buf + GR_W); const LAS bf16* QH = (const LAS bf16*)(buf + GR_QH); const LAS bf16* KT = (const LAS bf16*)(buf + GR_KT); const LAS bf16* QK = (const LAS bf16*)(buf + GR_QK); \
            const float egl = *(const LAS float*)(buf + GR_GL); \
            const LAS bf16* S0 = STt + ((c) & 1) * 32 * SB; LAS bf16* S1 = STt + (((c) + 1) & 1) * 32 * SB; \
            { const f32x4 acc = tile_bf(Wi + 16 * ti * SB, SB, S0 + 16 * tj * SB, SB, 128, (f32x4){0.f, 0.f, 0.f, 0.f}, l15, q4); \
              const f32x4 vn = (f32x4){bf2f(ucur.x & 0xffffu), bf2f(ucur.x >> 16), bf2f(ucur.y & 0xffffu), bf2f(ucur.y >> 16)} - acc; \
              u32x2 pk; pk.x = pk2(vn[0], vn[1]); pk.y = pk2(vn[2], vn[3]); *(LAS u32x2*)(vnT + (16 * tj + l15) * RS + 16 * ti + 4 * q4) = pk; } \
            __syncthreads(); \
            { f32x4 acc = tile_bf(QH + 16 * ti * SB, SB, S0 + 16 * tj * SB, SB, 128, (f32x4){0.f, 0.f, 0.f, 0.f}, l15, q4); \
              acc = tile_bf(QK + 16 * ti * RS, RS, vnT + 16 * tj * RS, RS, 64, acc, l15, q4); \
              _Pragma("unroll") for (int r = 0; r < 4; ++r) GO[((size_t)b * SEQ + (size_t)(c) * 64 + 16 * ti + 4 * q4 + r) * 512 + h * 128 + 32 * vs + 16 * tj + l15] = (bf16)f2bf(acc[r]); } \
            _Pragma("unroll") for (int t2 = 0; t2 < 2; ++t2) { Sreg[t2] = Sreg[t2] * egl; \
                Sreg[t2] = tile_bf(KT + 16 * w * RS, RS, vnT + 16 * t2 * RS, RS, 64, Sreg[t2], l15, q4); \
                u32x2 pk; pk.x = pk2(Sreg[t2][0], Sreg[t2][1]); pk.y = pk2(Sreg[t2][2], Sreg[t2][3]); *(LAS u32x2*)(S1 + (16 * t2 + l15) * SB + 16 * w + 4 * q4) = pk; } \
            if ((c) + 1 < NCH) { G2_STORE(SS, nbuf); ucur = uini##SS; } \
            __syncthreads(); } while (0)
        for (int c = 0; c < NCH; c += 2) { G2_STEP(c, B, A); G2_STEP(c + 1, A, B); }
#undef G2_STEP
#undef G2_STORE
#undef G2_LOAD
    }
    __syncthreads();
}
__device__ __forceinline__ void phase_gdn_g3(const Frame& F, const Args& A, int layer) {
    const bf16* GO = WSP(bf16, G_O); const bf16* P = WSP(bf16, A_P); bf16* Y = WSP(bf16, A_Y) + (size_t)2 * TH * 512; const float* nw = AIN(A, 22) + layer * 128;
    const int lane = F.lane, c0 = 8 * lane;
    for (int m = F.gw; m < TH; m += F.NGW) {
        const f32x4 a = ld_bf16x4(GO + (size_t)m * 512 + c0), b2 = ld_bf16x4(GO + (size_t)m * 512 + c0 + 4);
        float o[8] = {a.x, a.y, a.z, a.w, b2.x, b2.y, b2.z, b2.w}; float ss = 0.f;
#pragma unroll
        for (int q = 0; q < 8; ++q) ss += o[q] * o[q];
        ss = red_sum<16>(ss);
        const float rstd = RSQRT(ss * (1.0f / 128.0f) + EPS);
        const f32x4 z0 = ld_bf16x4(P + (size_t)m * PW + C_GDN + 1544 + c0), z1 = ld_bf16x4(P + (size_t)m * PW + C_GDN + 1544 + c0 + 4);
        const float z[8] = {z0.x, z0.y, z0.z, z0.w, z1.x, z1.y, z1.z, z1.w}; float y[8];
#pragma unroll
        for (int q = 0; q < 8; ++q) y[q] = o[q] * rstd * nw[(c0 + q) & 127] * siluf_(z[q]);
        u32x4 wv; wv.x = pk2(y[0], y[1]); wv.y = pk2(y[2], y[3]); wv.z = pk2(y[4], y[5]); wv.w = pk2(y[6], y[7]);
        *(u32x4*)(Y + (size_t)m * 512 + c0) = wv;
    }
}

__device__ __forceinline__ void phase_merge_z(const Frame& F, const Args& A) {
    pg8::Gemm g{WSP(bf16, A_Y), WSP(bf16, W_BR), 512, 512}; BranchOrder S; S.nP = TH / 256; S.G = F.G; S.c = F.bid;
    EpiZ E{WSP(bf16, A_Z)}; pg8::gemm_phase(F.lds, g, S, E, F.tid);
}
__device__ __forceinline__ void phase_merge_gate(const Frame& F, const Args& A, int layer) {
    pg8::Gemm g{WSP(bf16, A_H), WSP(bf16, W_GATE), D, D}; pg8::StaticOrder S; S.init(TH, 4096, F.G, F.bid);
    EpiMerge E{WSP(bf16, A_Z), AIN(A, 29) + (size_t)layer * 4 * D, WSP(bf16, A_MG)}; pg8::gemm_phase(F.lds, g, S, E, F.tid);
}
__device__ __forceinline__ void phase_merge_out(const Frame& F, const Args& A, const float* xin, float* xout) {
    pg8::Gemm g{WSP(bf16, A_MG), WSP(bf16, W_OUT), D, D}; pg8::StaticOrder S; S.init(TH, D, F.G, F.bid);
    EpiResidual E{xin, xout}; pg8::gemm_phase(F.lds, g, S, E, F.tid);
}
__device__ __forceinline__ void phase_ffn_gu(const Frame& F, const Args& A) {
    pg8::Gemm g{WSP(bf16, A_H), WSP(bf16, W_FGU), D, D}; pg8::StaticOrder S; S.init(TH, 2 * FF_D, F.G, F.bid);
    EpiSwiGLU E{WSP(bf16, F_ACT), FF_D, 1 << 20}; pg8::gemm_phase(F.lds, g, S, E, F.tid);
}
__device__ __forceinline__ void phase_ffn_down(const Frame& F, const Args& A, float* x) {
    pg8::Gemm g{WSP(bf16, F_ACT), WSP(bf16, W_FDN), FF_D, FF_D}; pg8::StaticOrder S; S.init(TH, D, F.G, F.bid);
    EpiResidual E{x, x}; pg8::gemm_phase(F.lds, g, S, E, F.tid);
}
struct MoeLayout { int pstart[NEXP + 1]; };
__device__ __forceinline__ MoeLayout moe_layout(const unsigned* cnt) {
    MoeLayout L; int s = 0;
#pragma unroll
    for (int e = 0; e < NEXP; ++e) { L.pstart[e] = s; s += ((int)cnt[e] + 255) & ~255; }
    L.pstart[NEXP] = s; return L;
}
struct MoeOrder {
    int np, nN, G, c; MoeLayout L;
    __device__ bool next(int i, Unit& u) const {
        const long Lx = (long)i * G + c; if (Lx >= (long)np * nN) return false;
        const int pm = (int)(Lx / nN), pn = (int)(Lx % nN); int e = 0;
#pragma unroll
        for (int k = 1; k < NEXP; ++k) if (pm * 256 >= L.pstart[k]) e = k;
        u.pm = pm; u.pn = e * nN + pn; return true;
    }
    __device__ __forceinline__ void a_ready(const Unit&) const {}
    __device__ __forceinline__ void done(const Unit&) const {}
};
__device__ __forceinline__ void phase_moe_route(const Frame& F, const Args& A, int half) {
    const unsigned* wgc = (const unsigned*)(F.ctl + CW_WGC + half * 8192); unsigned* cnt = (unsigned*)(F.ctl + CW_CNT + half * 16);
    LAS unsigned* tab = (LAS unsigned*)F.lds; LAS unsigned* tot = tab + 8192; LAS unsigned* bef = tot + 8; LAS unsigned* cur = bef + 8;
    __syncthreads();
    for (int e = F.tid; e < F.G * 8; e += 512) tab[e] = wgc[e];
    __syncthreads();
    if (F.tid < 8) { unsigned t = 0, bsum = 0; for (int g = 0; g < F.G; ++g) { const unsigned v = tab[g * 8 + F.tid]; if (g < F.bid) bsum += v; t += v; } tot[F.tid] = t; bef[F.tid] = bsum; cur[F.tid] = 0u; if (F.bid == 0) cnt[F.tid] = t; }
    __syncthreads();
    unsigned totr[8];
#pragma unroll
    for (int e = 0; e < 8; ++e) totr[e] = tot[e];
    const MoeLayout L = moe_layout(totr);
    const bf16* H = WSP(bf16, A_H); bf16* GA = WSP(bf16, F_GA); const int* tope = WSP(int, F_TOPE); int* slot = WSP(int, F_SLOT);
    const int lane = F.lane;
    for (int m = F.gw; m < TH; m += F.NGW) {
        const u32x4 v0 = *(const u32x4*)(H + (size_t)m * D + 8 * lane), v1 = *(const u32x4*)(H + (size_t)m * D + 512 + 8 * lane);
#pragma unroll
        for (int k = 0; k < 2; ++k) { const int e = tope[2 * m + k]; int s = 0;
            int ps = 0;
#pragma unroll
            for (int q = 0; q < NEXP; ++q) ps = (e == q) ? L.pstart[q] : ps;
            if (lane == 0) s = ps + (int)bef[e] + (int)ATOMIC_ADD_LDS(cur + e, 1u);
            s = bcast0(s);
            if (lane == 0) slot[2 * m + k] = s;
            *(u32x4*)(GA + (size_t)s * D + 8 * lane) = v0; *(u32x4*)(GA + (size_t)s * D + 512 + 8 * lane) = v1; }
    }
#pragma unroll
    for (int e = 0; e < NEXP; ++e) { const int r0 = L.pstart[e] + (int)totr[e], r1 = L.pstart[e + 1];
        for (int r = r0 + F.gw; r < r1; r += F.NGW) { *(u32x4*)(GA + (size_t)r * D + 8 * lane) = (u32x4){0u, 0u, 0u, 0u}; *(u32x4*)(GA + (size_t)r * D + 512 + 8 * lane) = (u32x4){0u, 0u, 0u, 0u}; } }
    __syncthreads();
}
__device__ __forceinline__ void phase_moe_gu(const Frame& F, const Args& A, int half) {
    MoeOrder S; S.L = moe_layout((const unsigned*)(F.ctl + CW_CNT + half * 16)); S.np = S.L.pstart[NEXP] / 256; S.nN = 2 * FF_E / 256; S.G = F.G; S.c = F.bid;
    pg8::Gemm g{WSP(bf16, F_GA), WSP(bf16, W_FGU), D, D}; EpiSwiGLU E{WSP(bf16, F_ACT), FF_E, 2 * FF_E / 256}; pg8::gemm_phase(F.lds, g, S, E, F.tid);
}
struct EpiBf16Mod {
    static constexpr bool PERM = true, AFTER_DRAIN = false;
    bf16* C;
    __device__ __forceinline__ void operator()(const f32x4 (&acc)[2][2][4][2], const Unit& u, int wr, int wc, int fr, int fq) const {
        const int row0 = u.pm * 256 + wr * 64 + fr, col0 = (u.pn & 3) * 256 + wc * 32 + 8 * fq;
#pragma unroll
        for (int ai = 0; ai < 2; ++ai)
#pragma unroll
            for (int m = 0; m < 4; ++m) { bf16* rowp = C + (size_t)(row0 + ai * HALFT + m * 16) * D + col0;
#pragma unroll
                for (int bj = 0; bj < 2; ++bj) { const f32x4 v0 = acc[ai][bj][m][0], v1 = acc[ai][bj][m][1];
                    u32x4 w; w.x = pk2(v0[0], v0[1]); w.y = pk2(v0[2], v0[3]); w.z = pk2(v1[0], v1[1]); w.w = pk2(v1[2], v1[3]);
                    *(u32x4*)(rowp + bj * HALFT) = w; } }
    }
};
struct MoeTailOrder {
    int ntail, G, c; MoeLayout L;
    __device__ bool next(int i, Unit& u) const {
        const int j = i * G + c; if (j >= ntail * MOE_KSPLIT) return false;
        const int t = j / MOE_KSPLIT, ch = j % MOE_KSPLIT, pm = MOE_MAINP + (t >> 2); int e = 0;
#pragma unroll
        for (int k = 1; k < NEXP; ++k) if (pm * 256 >= L.pstart[k]) e = k;
        u.pm = pm; u.pn = e * 4 + (t & 3); u.kb = ch * (FF_E / MOE_KSPLIT) * 2; return true;
    }
    __device__ __forceinline__ void a_ready(const Unit&) const {}
    __device__ __forceinline__ void done(const Unit&) const {}
};
struct EpiPart {
    static constexpr bool PERM = false, AFTER_DRAIN = false;
    float* C;
    __device__ __forceinline__ void operator()(const f32x4 (&acc)[2][2][4][2], const Unit& u, int wr, int wc, int fr, int fq) const {
        const int ch = u.kb / ((FF_E / MOE_KSPLIT) * 2);
        const int row0 = ch * (MOE_ROWS - 2 * TH) + (u.pm - MOE_MAINP) * 256 + wr * 64 + fr, col0 = (u.pn & 3) * 256 + wc * 32 + 4 * fq;
#pragma unroll
        for (int ai = 0; ai < 2; ++ai)
#pragma unroll
            for (int m = 0; m < 4; ++m) { float* rowp = C + (size_t)(row0 + ai * HALFT + m * 16) * D + col0;
#pragma unroll
                for (int bj = 0; bj < 2; ++bj)
#pragma unroll
                    for (int n = 0; n < 2; ++n) *(f32x4*)(rowp + bj * HALFT + n * 16) = acc[ai][bj][m][n]; }
    }
};
static_assert(FF_E % (MOE_KSPLIT * 128) == 0, "split-K chunks are an even number of K tiles");
__device__ __forceinline__ void phase_moe_down(const Frame& F, const Args& A, int half) {
    const MoeLayout L = moe_layout((const unsigned*)(F.ctl + CW_CNT + half * 16)); const int np = L.pstart[NEXP] / 256;
    { MoeOrder S; S.L = L; S.np = np < MOE_MAINP ? np : MOE_MAINP; S.nN = D / 256; S.G = F.G; S.c = F.bid;
      pg8::Gemm g{WSP(bf16, F_ACT), WSP(bf16, W_FDN), FF_E, FF_E}; EpiBf16Mod E{WSP(bf16, F_YE)}; pg8::gemm_phase(F.lds, g, S, E, F.tid); }
    __syncthreads();
    { MoeTailOrder S; S.L = L; S.ntail = (np > MOE_MAINP ? np - MOE_MAINP : 0) * 4; S.G = F.G; S.c = F.bid;
      pg8::Gemm g{WSP(bf16, F_ACT), WSP(bf16, W_FDN), FF_E, FF_E / MOE_KSPLIT, FF_E}; EpiPart E{WSP(float, F_PART)}; pg8::gemm_phase(F.lds, g, S, E, F.tid); }
}
__device__ __forceinline__ void phase_moe_combine(const Frame& F, const Args& A, float* x, const float* fgain) {
    const bf16* YE = WSP(bf16, F_YE); const float* PT = WSP(float, F_PART); const int* slot = WSP(int, F_SLOT); const float* topw = WSP(float, F_TOPW); const int lane = F.lane;
    for (int m = F.gw; m < TH; m += F.NGW) { const int s0 = slot[2 * m], s1 = slot[2 * m + 1]; const float w0 = topw[2 * m], w1 = topw[2 * m + 1];
        f32x4 v[4]; float ss = 0.f;
#pragma unroll
        for (int j = 0; j < 4; ++j) { const int c = 4 * lane + 256 * j;
            f32x4 y0, y1;
            if (s0 < 2 * TH) y0 = ld_bf16x4(YE + (size_t)s0 * D + c); else { y0 = (f32x4){0.f, 0.f, 0.f, 0.f};
#pragma unroll
                for (int ch = 0; ch < MOE_KSPLIT; ++ch) y0 = y0 + *(const f32x4*)(PT + ((size_t)ch * (MOE_ROWS - 2 * TH) + (s0 - 2 * TH)) * D + c); }
            if (s1 < 2 * TH) y1 = ld_bf16x4(YE + (size_t)s1 * D + c); else { y1 = (f32x4){0.f, 0.f, 0.f, 0.f};
#pragma unroll
                for (int ch = 0; ch < MOE_KSPLIT; ++ch) y1 = y1 + *(const f32x4*)(PT + ((size_t)ch * (MOE_ROWS - 2 * TH) + (s1 - 2 * TH)) * D + c); }
            v[j] = *(const f32x4*)(x + (size_t)m * D + c) + y0 * w0 + y1 * w1;
            ss += (v[j].x * v[j].x + v[j].y * v[j].y) + (v[j].z * v[j].z + v[j].w * v[j].w); }
        if (fgain) { const float rstd = RSQRT(wave_sum(ss) * (1.0f / D) + EPS);
#pragma unroll
            for (int j = 0; j < 4; ++j) v[j] = v[j] * rstd * *(const f32x4*)(fgain + 4 * lane + 256 * j); }
#pragma unroll
        for (int j = 0; j < 4; ++j) *(f32x4*)(x + (size_t)m * D + 4 * lane + 256 * j) = v[j]; }
}

#ifndef EMU
#define XB_TMO      128
#define XB_XCNT(j)  (256  + 64 * (j))
#define XB_XSUB(j)  (1280 + 64 * (j))
#define XB_XGEN(j)  (2304 + 64 * (j))
#define XB_TOP      3328
#define XB_TOPGEN   3392
#define XCD_BAR_WORDS 3456
#define XB_SPIN_CAP (1u << 22)
__device__ __forceinline__ unsigned xb_ld(unsigned* p)              { return __hip_atomic_load(p, __ATOMIC_RELAXED, __HIP_MEMORY_SCOPE_AGENT); }
__device__ __forceinline__ unsigned xb_add(unsigned* p, unsigned v) { return __hip_atomic_fetch_add(p, v, __ATOMIC_RELAXED, __HIP_MEMORY_SCOPE_AGENT); }
__device__ __forceinline__ unsigned xb_xcc_id() { return (unsigned)__builtin_amdgcn_s_getreg((3 << 11) | 20) & 0xFu; }
#define XB_SPIN(cond, bar) do { unsigned _sp = 0; while (cond) { __builtin_amdgcn_s_sleep(1); \
    if ((++_sp & 255u) == 0u) { if (xb_ld(&(bar)[XB_TMO])) break; if (_sp > XB_SPIN_CAP) { atomicAdd(&(bar)[XB_TMO], 1u); break; } } } } while (0)
struct XcdBarrier { unsigned* bar; unsigned x; volatile LAS unsigned* st; };
__device__ __forceinline__ XcdBarrier xcd_barrier_post(unsigned* bar, volatile LAS unsigned* st) {
    XcdBarrier b; b.bar = bar; b.x = xb_xcc_id(); b.st = st;
    if (threadIdx.x == 0) (void)xb_add(&bar[XB_XCNT(b.x)], 1u);
    return b;
}
__device__ __forceinline__ void xcd_barrier_complete(unsigned* bar, unsigned x, unsigned& nloc, unsigned& nx) {
    const unsigned G = gridDim.x * gridDim.y * gridDim.z;
    unsigned sum, cnt, mine, sp = 0u;
    for (;;) {
        sum = 0u; cnt = 0u; mine = 0u;
#pragma unroll
        for (unsigned j = 0; j < 16; ++j) { const unsigned c = xb_ld(&bar[XB_XCNT(j)]); sum += c; cnt += (c > 0u) ? 1u : 0u; mine = (j == x) ? c : mine; }
        if (sum == G) break;
        __builtin_amdgcn_s_sleep(1);
        if ((++sp & 255u) == 0u) { if (xb_ld(&bar[XB_TMO])) break; if (sp > XB_SPIN_CAP) { atomicAdd(&bar[XB_TMO], 1u); break; } }
    }
    nloc = mine > 0u ? mine : 1u; nx = cnt > 0u ? cnt : 1u;
}
__device__ __forceinline__ void xcd_barrier(const XcdBarrier& b) {
    asm volatile("s_waitcnt vmcnt(0)" ::: "memory");
    __syncthreads();
    if (threadIdx.x == 0) {
        unsigned* bar = b.bar;
        __builtin_amdgcn_s_waitcnt(0);
        unsigned nloc = b.st[0], nx = b.st[1];
        if (nloc == 0u) { xcd_barrier_complete(bar, b.x, nloc, nx); b.st[0] = nloc; b.st[1] = nx; }
        const unsigned old = xb_add(&bar[XB_XSUB(b.x)], 1u);
        const unsigned gen = old / nloc;
        if (old + 1u == (gen + 1u) * nloc) {
            __builtin_amdgcn_fence(__ATOMIC_RELEASE, "agent");
            asm volatile("s_waitcnt vmcnt(0)" ::: "memory");
            const unsigned og = xb_add(&bar[XB_TOP], 1u);
            const unsigned tg = og / nx;
            if (og + 1u == (tg + 1u) * nx) xb_add(&bar[XB_TOPGEN], 1u);
            else XB_SPIN(xb_ld(&bar[XB_TOPGEN]) == tg, bar);
            __builtin_amdgcn_fence(__ATOMIC_ACQUIRE, "agent");
            xb_add(&bar[XB_XGEN(b.x)], 1u);
            asm volatile("s_waitcnt vmcnt(0)" ::: "memory");
        } else {
            XB_SPIN(xb_ld(&bar[XB_XGEN(b.x)]) == gen, bar);
            __builtin_amdgcn_fence(__ATOMIC_ACQUIRE, "agent");
            asm volatile("s_waitcnt vmcnt(0)" ::: "memory");
        }
    }
    __syncthreads();
}
#endif

constexpr int NPHASES = DEPTH + NHALF * (14 + 16);
constexpr int LDS_BYTES = 155648, MISC_OFF = 154624;

__global__ void __launch_bounds__(512, 2) fwd_kernel(Args args_k) {
#ifdef EMU
    unsigned char* lds = emu_lds_ptr;
#else
    extern __shared__ __attribute__((aligned(16))) unsigned char lds[];
#endif
    Frame F0;
    F0.lds = (LAS unsigned char*)lds; F0.tid = threadIdx.x; F0.lane = F0.tid & 63; F0.wave = RFL(F0.tid >> 6); F0.G = gridDim.x; F0.bid = blockIdx.x;
    F0.gw = F0.bid * 8 + F0.wave; F0.NGW = F0.G * 8;
    F0.out = (GAS float*)args_k.out; F0.ws = (GAS unsigned char*)args_k.ws; F0.ctl = (GAS unsigned*)(F0.ws + WS_CTL);
    const int lo = args_k.lo, hi = args_k.hi;
#ifndef EMU
    volatile LAS unsigned* misc = (volatile LAS unsigned*)(F0.lds + MISC_OFF);
    if (F0.tid < 4) misc[F0.tid] = 0u;
    __syncthreads();
    XcdBarrier bar; bar.bar = (unsigned*)(F0.ctl + CW_BAR); bar.x = 0; bar.st = misc;
    if (hi - lo > 1) bar = xcd_barrier_post((unsigned*)(F0.ctl + CW_BAR), misc);
#define GRID_BAR() do { XcdBarrier bq = bar; asm volatile("" : "+s"(bq.bar), "+s"(bq.x)); xcd_barrier(bq); } while (0)
#else
#define GRID_BAR() do { } while (0)
#endif
    int ph = 0;
#ifndef PH_MASK
#define PH_MASK 0xFFFFFFFFFFFFFFFFull
#endif
#define PHASE(...) PHASE_I(31, __VA_ARGS__)
#ifdef EMU
#define LAUNDER(Fq) do { } while (0)
#else
#define LAUNDER(Fq) do { unsigned mq_ = ~0u; asm volatile("" : "+s"(Fq.G), "+s"(Fq.bid), "+s"(Fq.wave), "+s"(Fq.ws), "+s"(Fq.out), "+s"(Fq.ctl), "+s"(mq_)); Fq.lane = (int)__builtin_amdgcn_mbcnt_hi(mq_, __builtin_amdgcn_mbcnt_lo(mq_, 0u)); Fq.tid = Fq.wave * 64 + Fq.lane; Fq.gw = Fq.bid * 8 + Fq.wave; Fq.NGW = Fq.G * 8; } while (0)
#endif
#ifdef EMU
#define ARGS_Q() const Args& args_q = args_k
#else
#define ARGS_Q() const __attribute__((address_space(4))) Args* aq_ = (const __attribute__((address_space(4))) Args*)__builtin_amdgcn_kernarg_segment_ptr(); asm volatile("" : "+s"(aq_)); const Args& args_q = *(const Args*)aq_
#endif
#define PHASE_I(kind, ...) do { if (ph >= lo && ph < hi) { constexpr int reps_ = (((REPEAT_MASK) >> (kind)) & 1u) ? 2 : 1; for (int rr_ = 0; rr_ < reps_; ++rr_) { { Frame Fq = F0; LAUNDER(Fq); const Frame& F = Fq; ARGS_Q(); const Args& args = args_q; __VA_ARGS__; } if (rr_ + 1 < reps_ || ph + 1 < hi) { GRID_BAR(); if (((REPEAT_MASK) >> 26) & 1u) GRID_BAR(); } } } ++ph; } while (0)
#define PHASEK(kind, ...) PHASE_I(kind, __VA_ARGS__)
#define NORM1(layer, half) do { const size_t rn_ = (size_t)(half) * TH; const float* xn_ = ((layer) == 0 ? AIN(args, 0) : (const float*)F.out) + rn_ * D; \
            phase_norm<false>(F, args, xn_, AIN(args, 2) + (layer) * D, WSP(bf16, A_H), nullptr, nullptr, nullptr, nullptr); phase_rope_table(F, args, (const int*)AIN(args, 1) + rn_, WSP(float, A_ROPE)); } while (0)
#define SEGMENT(layer, half) do { \
            const size_t r0 = (size_t)(half) * TH; \
            const float* xin = ((layer) == 0 ? AIN(args_k, 0) : (const float*)F0.out) + r0 * D; float* xo = (float*)F0.out + r0 * D; \
            PHASEK(1, { pg8::Gemm g{WSP(bf16, A_H), WSP(bf16, W_IN), D, D}; pg8::StaticOrder S; S.init(TH, PW, F.G, F.bid); EpiBf16 E{WSP(bf16, A_P), PW, nullptr, 0}; pg8::gemm_phase(F.lds, g, S, E, F.tid); }); \
            PHASEK(2, phase_mla_prep(F, args); phase_rwkv_prep(F, args, layer)); \
            PHASEK(3, phase_mla_q(F, args); __syncthreads(); phase_mla_kv(F, args); __syncthreads(); phase_rwkv_lora(F, args)); \
            PHASEK(8, phase_rwkv_r1(F, args, layer)); \
            PHASEK(5, { const int ns_ = F.G >= 128 ? 64 : (F.G >= 4 ? F.G / 4 : 0); Frame Fa = F;       \
                        unsigned* rfl_ = (unsigned*)(F.ctl + CW_RFLAG + 128 * ((layer) * NHALF + (half))); unsigned* rq_ = (unsigned*)(F.ctl + CW_RFLAG + 2048 + 32 * ((layer) * NHALF + (half))); \
                        if (F.bid < ns_) { Fa.G = ns_; Fa.NGW = ns_ * 8; phase_rwkv_r2(Fa, args, rfl_); } else { Fa.bid = F.bid - ns_; Fa.G = F.G - ns_; Fa.gw = Fa.bid * 8 + Fa.wave; Fa.NGW = Fa.G * 8; phase_attention(Fa, args); if (ns_ == 0) phase_rwkv_r2(F, args, rfl_); } \
                        phase_rwkv_post_queue(F, args, layer, rfl_, rq_); }); \
            PHASEK(9, phase_gdn_g1(F, args, layer); phase_ssd_s1(F, args, layer)); \
            PHASEK(11, { const int ns_ = F.G >= 4 ? F.G / 2 : 0; Frame Fa = F;                               \
                        if (F.bid < ns_) { Fa.G = ns_; Fa.NGW = ns_ * 8; phase_gdn_g2(Fa, args); } else { Fa.bid = F.bid - ns_; Fa.G = F.G - ns_; Fa.gw = Fa.bid * 8 + Fa.wave; Fa.NGW = Fa.G * 8; phase_ssd_s23(Fa, args); if (ns_ == 0) phase_gdn_g2(F, args); } }); \
            PHASEK(12, phase_gdn_g3(F, args, layer); phase_ssd_s4(F, args, layer)); \
            PHASEK(17, phase_merge_z(F, args)); \
            PHASEK(18, phase_merge_gate(F, args, layer)); \
            PHASEK(19, phase_merge_out(F, args, xin, xo)); \
            if ((layer) == 0) { \
                PHASEK(20, phase_norm<false>(F, args, xo, AIN(args, 32) + (layer) * D, WSP(bf16, A_H), nullptr, nullptr, nullptr, nullptr)); \
                PHASEK(21, phase_ffn_gu(F, args)); \
                PHASE(phase_ffn_down(F, args, xo); if ((half) == 0 && NHALF == 2) NORM1(layer, 1)); \
            } else { \
                PHASE(phase_norm<true>(F, args, xo, AIN(args, 32) + (layer) * D, WSP(bf16, A_H), AIN(args, 35), WSP(int, F_TOPE), WSP(float, F_TOPW), (unsigned*)(F.ctl + CW_WGC + (half) * 8192))); \
                PHASE(phase_moe_route(F, args, half)); \
                PHASEK(22, phase_moe_gu(F, args, half)); \
                PHASEK(23, phase_moe_down(F, args, half)); \
                PHASE(phase_moe_combine(F, args, xo, (layer) == DEPTH - 1 ? AIN(args, 38) : nullptr); if ((half) == 0 && NHALF == 2) NORM1(layer, 1)); \
            } } while (0)
    static_assert(DEPTH == 2 && NHALF <= 2, "segment program");
    PHASEK(27, phase_convert(F, args, 0); NORM1(0, 0));
    SEGMENT(0, 0);
    if (NHALF == 2) SEGMENT(0, 1);
    PHASEK(27, phase_convert(F, args, 1); NORM1(1, 0));
    SEGMENT(1, 0);
    if (NHALF == 2) SEGMENT(1, 1);
#undef SEGMENT
#undef PHASE
}

#ifndef ONE_LAUNCH
#define ONE_LAUNCH 1
#endif
extern "C" void kernel_launch(void* const* d_in, const int* in_sizes, int n_in, void* d_out, int out_size, void* d_ws, size_t ws_size, hipStream_t stream) {
    static int grid = 0;
    if (grid == 0) {
#ifdef EMU
        grid = EMU_GRID;
#else
        if (n_in != 39 || out_size != T * D || ws_size < WS_NEED) { fprintf(stderr, "kernel_launch: unexpected problem (n_in %d out %d ws %zu need %zu)\n", n_in, out_size, ws_size, (size_t)WS_NEED); grid = -1; return; }
        int dev = 0, cus = 0;
        if (hipGetDevice(&dev) != hipSuccess || hipDeviceGetAttribute(&cus, hipDeviceAttributeMultiprocessorCount, dev) != hipSuccess) { grid = -1; return; }
        if (hipFuncSetAttribute((const void*)fwd_kernel, hipFuncAttributeMaxDynamicSharedMemorySize, LDS_BYTES) != hipSuccess) { fprintf(stderr, "kernel_launch: hipFuncSetAttribute failed\n"); grid = -1; return; }
        int per_cu = 0;
        if (hipOccupancyMaxActiveBlocksPerMultiprocessor(&per_cu, (const void*)fwd_kernel, 512, LDS_BYTES) != hipSuccess || per_cu < 1) fprintf(stderr, "kernel_launch: occupancy query reports %d\n", per_cu);
        (void)hipGetLastError();
        grid = cus;
#endif
    }
    if (grid < 0) return;
    (void)hipMemsetAsync((char*)d_ws + WS_CTL, 0, CTL_BYTES, stream);
    Args a{};
    for (int i = 0; i < 39; ++i) a.in[i] = (const float*)d_in[i];
    a.out = (float*)d_out; a.ws = (unsigned char*)d_ws;
#ifdef EMU
    for (int p = EMU_PH_LO; p < EMU_PH_HI && p < NPHASES; ++p) { a.lo = p; a.hi = p + 1; emu_launch(fwd_kernel, grid, 512, a); emu_after_phase(p); }
#else
#if ONE_LAUNCH
    a.lo = 0; a.hi = NPHASES;
    hipLaunchKernelGGL(fwd_kernel, dim3(grid), dim3(512), LDS_BYTES, stream, a);
#else
    for (int p = 0; p < NPHASES; ++p) { a.lo = p; a.hi = p + 1; hipLaunchKernelGGL(fwd_kernel, dim3(grid), dim3(512), LDS_BYTES, stream, a); }
#endif
#endif
}
```
